# Optimizing an MI355X kernel written in HIP

```python
import math
import jax
import jax.numpy as jnp
from jax import lax
import numpy as np

D_MODEL = 1024
BATCH = 8
SEQ = 4096
DEPTH = 2

CTX_LEN = 256
GRID_W = 64
EPS = 1e-6

ATT_HEADS = 8
ATT_KV_HEADS = 2
ATT_GROUP = ATT_HEADS // ATT_KV_HEADS
HEAD_DIM = 128
ROPE_PAIRS_PER_AXIS = HEAD_DIM // 4
ROPE_THETA = 10000.0
Q_BLOCK = 128

GLA_HEADS = 4
GLA_DK = 64
GLA_DV = 128
GLA_RANK = 16
GLA_TAU = 16.0
GLA_CHUNK = 64

HY_WIDTH = 512
HY_ORDER = 2
HY_BANDS = 16
HY_EMB = 1 + 2 * HY_BANDS
HY_FFN = 64
HY_DECAY_SLOW = -math.log(1e-2) / 1.5
HY_DECAY_FAST = -math.log(1e-2) / 0.3

N_EXPERTS = 16
N_GROUPS = 4
EXPERTS_PER_GROUP = N_EXPERTS // N_GROUPS
TOP_K = 2
D_EXPERT = 512

N_BRANCH = 3
ATT_Q_W = ATT_HEADS * HEAD_DIM
ATT_KV_W = ATT_KV_HEADS * HEAD_DIM
GLA_K_W = GLA_HEADS * GLA_DK
GLA_V_W = GLA_HEADS * GLA_DV
KV_SPLITS = (ATT_KV_W, ATT_KV_W, GLA_K_W, GLA_V_W, 2 * GLA_RANK)
REST_SPLITS = (ATT_Q_W, GLA_K_W, GLA_V_W, 3 * HY_WIDTH, N_BRANCH * D_MODEL)
N_KV_COLS = sum(KV_SPLITS)
N_IN = N_KV_COLS + sum(REST_SPLITS)

kernel_name = 'hybrid_gated_hyena_gla_gqa_moe_dit'


def rms_norm(x, g):
    xf = x.astype(jnp.float32)
    y = xf * lax.rsqrt(jnp.mean(xf * xf, axis=-1, keepdims=True) + EPS)
    return (y * g.astype(jnp.float32)).astype(x.dtype)


def split_cols(t, sizes):
    cuts = [int(v) for v in np.cumsum(sizes)[:-1]]
    return jnp.split(t, cuts, axis=-1)


def modulate(h, shift, scale):
    return h * (1 + scale[..., None, :]) + shift[..., None, :]


def to_heads(t, n_heads):
    b, n, w = t.shape
    return t.reshape(b, n, n_heads, w // n_heads).transpose(0, 2, 1, 3)


def q_heads(t):
    b, n, _ = t.shape
    return t.reshape(b, n, ATT_KV_HEADS, ATT_GROUP, HEAD_DIM).transpose(0, 2, 3, 1, 4)


def tflip(t):
    return jnp.flip(t, axis=2)


def axial_rope_tables(n_tokens):
    rows = n_tokens // GRID_W
    row = jnp.broadcast_to(jnp.arange(rows)[:, None], (rows, GRID_W)).reshape(-1).astype(jnp.float32)
    col = jnp.broadcast_to(jnp.arange(GRID_W)[None, :], (rows, GRID_W)).reshape(-1).astype(jnp.float32)
    inv_freq = ROPE_THETA ** (-jnp.arange(ROPE_PAIRS_PER_AXIS, dtype=jnp.float32) / ROPE_PAIRS_PER_AXIS)
    ang = jnp.concatenate([row[:, None] * inv_freq, col[:, None] * inv_freq], axis=-1)
    return jnp.cos(ang), jnp.sin(ang)


def apply_rope(x, cos, sin):
    xf = x.astype(jnp.float32)
    x1, x2 = xf[..., 0::2], xf[..., 1::2]
    out = jnp.stack([x1 * cos - x2 * sin, x1 * sin + x2 * cos], axis=-1)
    return out.reshape(x.shape).astype(x.dtype)


def gqa_latent(q, k, v):
    b, hkv, g, s, hd = q.shape
    nb = s // Q_BLOCK
    qb = jnp.moveaxis(q.reshape(b, hkv, g, nb, Q_BLOCK, hd), 3, 0)
    scale = HEAD_DIM ** -0.5

    def one_block(qblk):
        sc = jnp.einsum('bkgqd,bknd->bkgqn', qblk, k).astype(jnp.float32) * scale
        p = jax.nn.softmax(sc, axis=-1).astype(v.dtype)
        return jnp.einsum('bkgqn,bknd->bkgqd', p, v)

    o = lax.map(one_block, qb)
    return o.transpose(1, 0, 4, 2, 3, 5).reshape(b, s, hkv * g * hd)


def gqa_context(q, k, v):
    b, hkv, g, n, hd = q.shape
    sc = jnp.einsum('bkgqd,bknd->bkgqn', q, k).astype(jnp.float32) * HEAD_DIM ** -0.5
    p = jax.nn.softmax(sc, axis=-1).astype(v.dtype)
    o = jnp.einsum('bkgqn,bknd->bkgqd', p, v)
    return o.transpose(0, 3, 1, 2, 4).reshape(b, n, hkv * g * hd)


def gla_q(t):
    return to_heads(t, GLA_HEADS).astype(jnp.float32) * GLA_DK ** -0.5


def gla_log_decay(a_low, w_a2, b_a):
    z = (a_low @ w_a2 + b_a).astype(jnp.float32)
    return to_heads(jax.nn.log_sigmoid(z) / GLA_TAU, GLA_HEADS)


def gla_chunked(q, k, v, log_a, s0):
    b, h, n_tok, dk = q.shape
    dv = v.shape[-1]
    n = n_tok // GLA_CHUNK

    def rs(t):
        return t.reshape(b, h, n, GLA_CHUNK, t.shape[-1])

    q, k, v, log_a = rs(q), rs(k), rs(v), rs(log_a)
    cum = jnp.cumsum(log_a, axis=3)
    cum_last = cum[:, :, :, -1:, :]
    q_dec = q * jnp.exp(cum)
    k_inv = k * jnp.exp(-cum)
    k_to_end = k * jnp.exp(cum_last - cum)
    mask = jnp.tril(jnp.ones((GLA_CHUNK, GLA_CHUNK), dtype=bool))
    att = jnp.where(mask, jnp.einsum('bhnqd,bhnsd->bhnqs', q_dec, k_inv), 0.0)
    o_intra = jnp.einsum('bhnqs,bhnsv->bhnqv', att, v)
    chunk_state = jnp.einsum('bhnsd,bhnsv->bhndv', k_to_end, v)
    chunk_decay = jnp.exp(cum_last[:, :, :, 0, :])

    def step(state, xs):
        dec, cs = xs
        return dec[..., None] * state + cs, state

    s_final, s_prev = lax.scan(step, s0, (jnp.moveaxis(chunk_decay, 2, 0), jnp.moveaxis(chunk_state, 2, 0)))
    s_prev = jnp.moveaxis(s_prev, 0, 2)
    o_inter = jnp.einsum('bhnqd,bhndv->bhnqv', q_dec, s_prev)
    return (o_intra + o_inter).reshape(b, h, n_tok, dv), s_final


def gla_final_state(k, v, log_a):
    cum = jnp.cumsum(log_a, axis=2)
    w = jnp.exp(cum[:, :, -1:, :] - cum)
    return jnp.einsum('bhld,bhlv->bhdv', k * w, v)


def gla_bidir(q, k, v, la_f, la_b, s0_f, s0_b):
    o_f, s_f = gla_chunked(q, k, v, la_f, s0_f)
    o_b, s_b = gla_chunked(tflip(q), tflip(k), tflip(v), tflip(la_b), s0_b)
    return o_f + tflip(o_b), s_f, s_b


def gla_output(o, og, norm_g):
    b, h, n, dv = o.shape
    on = rms_norm(o, norm_g).transpose(0, 2, 1, 3).reshape(b, n, h * dv)
    return (on * jax.nn.silu(og.astype(jnp.float32))).astype(og.dtype)


def hyena_filters(n, P):
    f32 = jnp.float32
    t = jnp.arange(n, dtype=f32)
    t_norm = t / n
    bands = jnp.linspace(1e-4, HY_BANDS - 1, HY_BANDS, dtype=f32)
    phase = (2 * math.pi / n) * t[:, None] * bands[None, :]
    z = jnp.concatenate([t_norm[:, None], jnp.cos(phase), -jnp.sin(phase)], axis=-1)
    freq = P['hy_sin_freq'].astype(f32)
    hid = jnp.sin(freq * (z @ P['hy_pos_w1'].astype(f32) + P['hy_pos_b1'].astype(f32)))
    hid = jnp.sin(freq * (hid @ P['hy_pos_w2'].astype(f32) + P['hy_pos_b2'].astype(f32)))
    filt = (hid @ P['hy_pos_w3'].astype(f32)).reshape(n, HY_ORDER, 2, HY_WIDTH)
    filt = filt * jnp.exp(-t_norm[:, None, None, None] * jnp.abs(P['hy_decay'].astype(f32)))
    fwd, bwd = filt[:, :, 0], filt[:, :, 1]
    taps = jnp.concatenate([fwd, jnp.zeros_like(fwd[:1]), jnp.flip(bwd[1:], axis=0)], axis=0)
    taps = taps / (jnp.sum(jnp.abs(taps), axis=0, keepdims=True) + EPS)
    return jnp.fft.rfft(taps, axis=0)


def short_conv(u, w, b):
    up = jnp.pad(u, ((0, 0), (1, 1), (0, 0)))
    return up[:, :-2] * w[0] + up[:, 1:-1] * w[1] + up[:, 2:] * w[2] + b


def hyena_mix(u, P):
    n = u.shape[1]
    filt = hyena_filters(n, P)
    uc = short_conv(u, P['hy_conv_w'], P['hy_conv_b']).astype(jnp.float32)
    x1, x2, z = jnp.split(uc, 3, axis=-1)
    skip = P['hy_skip'].astype(jnp.float32)
    for o, gate in enumerate((x1, x2)):
        zf = jnp.fft.rfft(z, n=2 * n, axis=1)
        conv = jnp.fft.irfft(zf * filt[None, :, o], n=2 * n, axis=1)[:, :n]
        z = gate * (conv + skip[o] * z)
    return z.astype(u.dtype)


def merge_branches(y_hy, y_gla, y_att, br_g, P):
    g_hy, g_gla, g_att = jnp.split(br_g, N_BRANCH, axis=-1)
    m = (jax.nn.sigmoid(g_hy) * (y_hy @ P['w_br_hy'])
         + jax.nn.sigmoid(g_gla) * (y_gla @ P['w_br_gla'])
         + jax.nn.sigmoid(g_att) * (y_att @ P['w_br_att']))
    return m @ P['w_out']


def token_mixer(h, hc, P, last):
    f32 = jnp.float32
    b, s, _ = h.shape
    cos, sin = axial_rope_tables(s)
    proj = h @ P['w_in']
    a_k, a_v, g_k, g_v, g_a = split_cols(proj[..., :N_KV_COLS], KV_SPLITS)
    a_q, g_q, g_og, hy_u, br_g = split_cols(proj[..., N_KV_COLS:], REST_SPLITS)
    cproj = hc @ (P['w_in'][:, :N_KV_COLS] if last else P['w_in'])
    c_ak, c_av, c_gk, c_gv, c_ga = split_cols(cproj[..., :N_KV_COLS], KV_SPLITS)

    k_ctx = rms_norm(to_heads(c_ak, ATT_KV_HEADS), P['k_norm_g'])
    v_ctx = to_heads(c_av, ATT_KV_HEADS)
    k_lat = apply_rope(rms_norm(to_heads(a_k, ATT_KV_HEADS), P['k_norm_g']), cos, sin)
    q_lat = apply_rope(rms_norm(q_heads(a_q), P['q_norm_g']), cos, sin)
    keys = jnp.concatenate([k_lat, k_ctx], axis=2)
    vals = jnp.concatenate([to_heads(a_v, ATT_KV_HEADS), v_ctx], axis=2)
    y_att = gqa_latent(q_lat, keys, vals)

    c_k = to_heads(c_gk, GLA_HEADS).astype(f32)
    c_v = to_heads(c_gv, GLA_HEADS).astype(f32)
    c_la_f = gla_log_decay(c_ga[..., :GLA_RANK], P['gla_wa2'][0], P['gla_ba'][0])
    c_la_b = gla_log_decay(c_ga[..., GLA_RANK:], P['gla_wa2'][1], P['gla_ba'][1])
    if last:
        s_f = gla_final_state(c_k, c_v, c_la_f)
        s_b = gla_final_state(tflip(c_k), tflip(c_v), tflip(c_la_b))
    else:
        c_aq, c_gq, c_og, c_hy, c_brg = split_cols(cproj[..., N_KV_COLS:], REST_SPLITS)
        s0 = jnp.zeros((b, GLA_HEADS, GLA_DK, GLA_DV), f32)
        c_o, s_f, s_b = gla_bidir(gla_q(c_gq), c_k, c_v, c_la_f, c_la_b, s0, s0)
    la_f = gla_log_decay(g_a[..., :GLA_RANK], P['gla_wa2'][0], P['gla_ba'][0])
    la_b = gla_log_decay(g_a[..., GLA_RANK:], P['gla_wa2'][1], P['gla_ba'][1])
    o_lat, _, _ = gla_bidir(gla_q(g_q), to_heads(g_k, GLA_HEADS).astype(f32),
                            to_heads(g_v, GLA_HEADS).astype(f32), la_f, la_b, s_f, s_b)
    y_gla = gla_output(o_lat, g_og, P['gla_norm_g'])

    y_hy = hyena_mix(hy_u, P)

    out = merge_branches(y_hy, y_gla, y_att, br_g, P)
    if last:
        return out, None
    yc_att = gqa_context(rms_norm(q_heads(c_aq), P['q_norm_g']), k_ctx, v_ctx)
    yc_gla = gla_output(c_o, c_og, P['gla_norm_g'])
    yc_hy = hyena_mix(c_hy, P)
    return out, merge_branches(yc_hy, yc_gla, yc_att, c_brg, P)


def grouped_moe(h, router_w, router_b, w_gate, w_up, w_down):
    f32 = jnp.float32
    shape = h.shape
    ht = h.reshape(-1, shape[-1])
    scores = jax.nn.sigmoid((ht @ router_w).astype(f32))
    sel = scores + router_b.astype(f32)
    group_score = lax.top_k(sel.reshape(-1, N_GROUPS, EXPERTS_PER_GROUP), TOP_K)[0].sum(-1)
    group = jnp.argmax(group_score, axis=-1)
    in_group = (jnp.arange(N_EXPERTS) // EXPERTS_PER_GROUP)[None, :] == group[:, None]
    _, idx = lax.top_k(jnp.where(in_group, sel, -jnp.inf), TOP_K)
    w = jnp.take_along_axis(scores, idx, axis=-1)
    w = w / jnp.sum(w, axis=-1, keepdims=True)
    gates = jnp.sum(jax.nn.one_hot(idx, N_EXPERTS, dtype=f32) * w[..., None], axis=1).astype(h.dtype)
    out = jnp.zeros_like(ht)
    for e in range(N_EXPERTS):
        hid = jax.nn.silu(ht @ w_gate[e]) * (ht @ w_up[e])
        out = out + gates[:, e:e + 1] * (hid @ w_down[e])
    return out.reshape(shape)


def setup_inputs(seed: int = 0) -> dict:
    key = jax.random.key(seed)
    keys = iter(jax.random.split(key, 48))

    def nrm(shape, scale):
        return jax.random.normal(next(keys), shape, jnp.float32) * scale

    D = D_MODEL
    decay_base = jnp.linspace(HY_DECAY_SLOW, HY_DECAY_FAST, HY_WIDTH, dtype=jnp.float32)
    return {
        'x': nrm((BATCH, SEQ, D), 1.0),
        'c': nrm((BATCH, D), 1.0),
        'ctx': nrm((BATCH, CTX_LEN, D), 1.0),
        'c_ctx': nrm((D,), 1.0),
        'w_mod': nrm((DEPTH, D, 6 * D), 0.5 * D ** -0.5),
        'b_mod': nrm((DEPTH, 6 * D), 0.02),
        'norm1_g': 1.0 + nrm((DEPTH, D), 0.05),
        'norm2_g': 1.0 + nrm((DEPTH, D), 0.05),
        'w_in': nrm((DEPTH, D, N_IN), D ** -0.5),
        'q_norm_g': 1.0 + nrm((DEPTH, HEAD_DIM), 0.05),
        'k_norm_g': 1.0 + nrm((DEPTH, HEAD_DIM), 0.05),
        'gla_wa2': nrm((DEPTH, 2, GLA_RANK, GLA_K_W), GLA_RANK ** -0.5),
        'gla_ba': nrm((DEPTH, 2, GLA_K_W), 0.02),
        'gla_norm_g': 1.0 + nrm((DEPTH, GLA_DV), 0.05),
        'hy_conv_w': nrm((DEPTH, 3, 3 * HY_WIDTH), 3 ** -0.5),
        'hy_conv_b': nrm((DEPTH, 3 * HY_WIDTH), 0.02),
        'hy_pos_w1': nrm((DEPTH, HY_EMB, HY_FFN), HY_EMB ** -0.5),
        'hy_pos_b1': nrm((DEPTH, HY_FFN), 0.02),
        'hy_sin_freq': 1.0 + nrm((DEPTH, HY_FFN), 0.05),
        'hy_pos_w2': nrm((DEPTH, HY_FFN, HY_FFN), HY_FFN ** -0.5),
        'hy_pos_b2': nrm((DEPTH, HY_FFN), 0.02),
        'hy_pos_w3': nrm((DEPTH, HY_FFN, HY_ORDER * 2 * HY_WIDTH), HY_FFN ** -0.5),
        'hy_decay': decay_base * (1.0 + nrm((DEPTH, HY_ORDER, 2, HY_WIDTH), 0.05)),
        'hy_skip': nrm((DEPTH, HY_ORDER, HY_WIDTH), 1.0),
        'w_br_hy': nrm((DEPTH, HY_WIDTH, D), HY_WIDTH ** -0.5),
        'w_br_gla': nrm((DEPTH, GLA_V_W, D), GLA_V_W ** -0.5),
        'w_br_att': nrm((DEPTH, ATT_Q_W, D), ATT_Q_W ** -0.5),
        'w_out': nrm((DEPTH, D, D), D ** -0.5),
        'router_w': nrm((D, N_EXPERTS), D ** -0.5),
        'router_b': nrm((N_EXPERTS,), 0.01),
        'moe_w_gate': nrm((DEPTH, N_EXPERTS, D, D_EXPERT), D ** -0.5),
        'moe_w_up': nrm((DEPTH, N_EXPERTS, D, D_EXPERT), D ** -0.5),
        'moe_w_down': nrm((DEPTH, N_EXPERTS, D_EXPERT, D), D_EXPERT ** -0.5),
    }


def reference(x, c, ctx, c_ctx, w_mod, b_mod, norm1_g, norm2_g, w_in, q_norm_g, k_norm_g,
              gla_wa2, gla_ba, gla_norm_g, hy_conv_w, hy_conv_b, hy_pos_w1, hy_pos_b1,
              hy_sin_freq, hy_pos_w2, hy_pos_b2, hy_pos_w3, hy_decay, hy_skip,
              w_br_hy, w_br_gla, w_br_att, w_out, router_w, router_b,
              moe_w_gate, moe_w_up, moe_w_down):
    xc = ctx
    sc = jax.nn.silu(c)
    scc = jax.nn.silu(c_ctx)
    for l in range(DEPTH):
        last = l == DEPTH - 1
        P = {
            'w_in': w_in[l], 'q_norm_g': q_norm_g[l], 'k_norm_g': k_norm_g[l],
            'gla_wa2': gla_wa2[l], 'gla_ba': gla_ba[l], 'gla_norm_g': gla_norm_g[l],
            'hy_conv_w': hy_conv_w[l], 'hy_conv_b': hy_conv_b[l],
            'hy_pos_w1': hy_pos_w1[l], 'hy_pos_b1': hy_pos_b1[l], 'hy_sin_freq': hy_sin_freq[l],
            'hy_pos_w2': hy_pos_w2[l], 'hy_pos_b2': hy_pos_b2[l], 'hy_pos_w3': hy_pos_w3[l],
            'hy_decay': hy_decay[l], 'hy_skip': hy_skip[l],
            'w_br_hy': w_br_hy[l], 'w_br_gla': w_br_gla[l], 'w_br_att': w_br_att[l], 'w_out': w_out[l],
        }
        shift1, scale1, gate1, shift2, scale2, gate2 = jnp.split(sc @ w_mod[l] + b_mod[l], 6, axis=-1)
        n_cmod = 2 if last else 6
        cmods = jnp.split(scc @ w_mod[l][:, :n_cmod * D_MODEL] + b_mod[l][:n_cmod * D_MODEL], n_cmod, axis=-1)

        h = modulate(rms_norm(x, norm1_g[l]), shift1, scale1)
        hc = modulate(rms_norm(xc, norm1_g[l]), cmods[0], cmods[1])
        y, yc = token_mixer(h, hc, P, last)
        x = x + gate1[:, None, :] * y
        h = modulate(rms_norm(x, norm2_g[l]), shift2, scale2)
        x = x + gate2[:, None, :] * grouped_moe(h, router_w, router_b, moe_w_gate[l], moe_w_up[l], moe_w_down[l])
        if not last:
            xc = xc + cmods[2] * yc
            hc = modulate(rms_norm(xc, norm2_g[l]), cmods[3], cmods[4])
            xc = xc + cmods[5] * grouped_moe(hc, router_w, router_b, moe_w_gate[l], moe_w_up[l], moe_w_down[l])
    return x
```

```cpp
#include <hip/hip_runtime.h>
#include <cstddef>
#include <math.h>
#ifdef HOST_TEST
#define HD
#else
#define HD __host__ __device__ __forceinline__
#endif

struct FullDims { static constexpr int D=1024,B=8,S=4096,DEPTH=2,C=256,GW=64,AH=8,AKV=2,HDM=128,GH=4,GDK=64,GDV=128,GR=16,HW=512,HB=16,HF=64,NE=16,NG=4,DE=512; };
struct SmallDims { static constexpr int D=64,B=2,S=128,DEPTH=2,C=32,GW=16,AH=4,AKV=2,HDM=16,GH=2,GDK=8,GDV=16,GR=4,HW=32,HB=4,HF=8,NE=8,NG=2,DE=32; };

template <class T> struct DD {
  static constexpr int D=T::D,B=T::B,S=T::S,DEPTH=T::DEPTH,C=T::C,GW=T::GW,AH=T::AH,AKV=T::AKV,HDM=T::HDM,GH=T::GH,GDK=T::GDK,GDV=T::GDV,GR=T::GR,HW=T::HW,HB=T::HB,HF=T::HF,NE=T::NE,NG=T::NG,DE=T::DE;
  static constexpr int R=S+C, AG=AH/AKV, RP=HDM/4, HE=1+2*HB, EPG=NE/NG, AQW=AH*HDM, AKVW=AKV*HDM, GKW=GH*GDK, GVW=GH*GDV;
  static constexpr int NKV=AKVW+AKVW+GKW+GVW+2*GR, NIN=NKV+AQW+GKW+GVW+3*HW+3*D;
  static constexpr int O_AK=0, O_AV=AKVW, O_GK=2*AKVW, O_GV=2*AKVW+GKW, O_GA=2*AKVW+GKW+GVW;
  static constexpr int O_AQ=NKV, O_GQ=NKV+AQW, O_OG=O_GQ+GKW, O_HY=O_OG+GVW, O_BR=O_HY+3*HW;
};

struct NaiveBufs {
  const float *x,*c,*ctx,*c_ctx,*w_mod,*b_mod,*norm1_g,*norm2_g,*w_in,*q_norm_g,*k_norm_g,*gla_wa2,*gla_ba,*gla_norm_g,*hy_conv_w,*hy_conv_b,
    *hy_pos_w1,*hy_pos_b1,*hy_sin_freq,*hy_pos_w2,*hy_pos_b2,*hy_pos_w3,*hy_decay,*hy_skip,*w_br_hy,*w_br_gla,*w_br_att,*w_out,*router_w,*router_b,*moe_w_gate,*moe_w_up,*moe_w_down;
  float* out;
  float *mod;
  float *hid2S,*hid2C;
  float *tapsS,*tapsC;
  float *nrmS,*nrmC;
  float *rs;
  float *h;
  float *proj;
  float *qn,*kn;
  float *yatt;
  float *laf,*lab;
  float *of,*ob;
  float *ygla;
  float *uc;
  float *z1,*yhy;
  float *m;
  int   *ridx;
  float *rw;
  float *hid;
  float *xc;
};

HD float sigmoidf_(float x) { return 1.f / (1.f + expf(-x)); }
HD float siluf_(float x) { return x / (1.f + expf(-x)); }
HD float logsigmoidf_(float x) { return x < 0.f ? x - log1pf(expf(x)) : -log1pf(expf(-x)); }

template <class T> HD void st_mod(const NaiveBufs& a, int l, long idx) {
  using d = DD<T>; const int j = (int)(idx % (6 * d::D)), bb = (int)(idx / (6 * d::D));
  const float* cv = bb < d::B ? a.c + (long)bb * d::D : a.c_ctx; const float* w = a.w_mod + (long)l * d::D * 6 * d::D;
  float acc = a.b_mod[(long)l * 6 * d::D + j];
  for (int k = 0; k < d::D; ++k) acc += siluf_(cv[k]) * w[(long)k * 6 * d::D + j];
  a.mod[idx] = acc;
}
template <class T> HD void st_hyhid(const NaiveBufs& a, int l, int which, long idx) {
  using d = DD<T>; const int n = which ? d::C : d::S; float* dst = which ? a.hid2C : a.hid2S;
  const int j = (int)(idx % d::HF), t = (int)(idx / d::HF);
  const float* w1 = a.hy_pos_w1 + (long)l * d::HE * d::HF; const float* b1 = a.hy_pos_b1 + l * d::HF; const float* fr = a.hy_sin_freq + l * d::HF;
  const float* w2 = a.hy_pos_w2 + (long)l * d::HF * d::HF; const float* b2 = a.hy_pos_b2 + l * d::HF;
  const float tn = (float)t / (float)n; const float w0 = 2.f * 3.14159265358979323846f / (float)n;
  float acc2 = b2[j];
  for (int i = 0; i < d::HF; ++i) {
    float acc = b1[i] + tn * w1[0 * d::HF + i];
    for (int bnd = 0; bnd < d::HB; ++bnd) {
      const float band = 1e-4f + (float)bnd * ((float)(d::HB - 1) - 1e-4f) / (float)(d::HB - 1);
      const float ph = w0 * (float)t * band;
      acc += cosf(ph) * w1[(1 + bnd) * d::HF + i] - sinf(ph) * w1[(1 + d::HB + bnd) * d::HF + i];
    }
    acc2 += sinf(fr[i] * acc) * w2[i * d::HF + j];
  }
  dst[idx] = sinf(fr[j] * acc2);
}
template <class T> HD void st_hytaps(const NaiveBufs& a, int l, int which, long idx) {
  using d = DD<T>; const int n = which ? d::C : d::S; const float* hid2 = which ? a.hid2C : a.hid2S; float* dst = which ? a.tapsC : a.tapsS;
  const int c = (int)(idx % d::HW); const int li = (int)((idx / d::HW) % (2 * n)); const int o = (int)(idx / ((long)d::HW * 2 * n));
  float v = 0.f;
  if (li != n) {
    const int dir = li < n ? 0 : 1; const int t = li < n ? li : 2 * n - li;
    const int col = (o * 2 + dir) * d::HW + c;
    const float* w3 = a.hy_pos_w3 + (long)l * d::HF * 4 * d::HW;
    float acc = 0.f;
    for (int j = 0; j < d::HF; ++j) acc += hid2[(long)t * d::HF + j] * w3[(long)j * 4 * d::HW + col];
    const float dec = fabsf(a.hy_decay[(long)l * 4 * d::HW + col]);
    v = acc * expf(-((float)t / (float)n) * dec);
  }
  dst[idx] = v;
}
template <class T> HD void st_hynorm(const NaiveBufs& a, int which, long idx) {
  using d = DD<T>; const int n = which ? d::C : d::S; const float* tp = which ? a.tapsC : a.tapsS; float* dst = which ? a.nrmC : a.nrmS;
  const int c = (int)(idx % d::HW), o = (int)(idx / d::HW);
  float s = 0.f; for (int li = 0; li < 2 * n; ++li) s += fabsf(tp[((long)o * 2 * n + li) * d::HW + c]);
  dst[idx] = s + 1e-6f;
}

template <class T> HD const float* xrow(const NaiveBufs& a, int l, int b, int r) {
  using d = DD<T>;
  if (r < d::S) return (l == 0 ? a.x : a.out) + ((long)b * d::S + r) * d::D;
  return (l == 0 ? a.ctx : a.xc) + ((long)b * d::C + (r - d::S)) * d::D;
}
template <class T> HD float* xrow_w(const NaiveBufs& a, int b, int r) {
  using d = DD<T>;
  if (r < d::S) return a.out + ((long)b * d::S + r) * d::D;
  return a.xc + ((long)b * d::C + (r - d::S)) * d::D;
}
template <class T> HD void st_rs(const NaiveBufs& a, int l, int b, int src, long idx) {
  using d = DD<T>; const int r = (int)idx; const float* xr = src ? (const float*)xrow_w<T>(a, b, r) : xrow<T>(a, l, b, r);
  float s = 0.f; for (int k = 0; k < d::D; ++k) s += xr[k] * xr[k];
  a.rs[r] = 1.f / sqrtf(s / (float)d::D + 1e-6f);
}
template <class T> HD void st_norm(const NaiveBufs& a, int l, int b, int which, long idx) {
  using d = DD<T>; const int j = (int)(idx % d::D), r = (int)(idx / d::D);
  const float* xr = which ? (const float*)xrow_w<T>(a, b, r) : xrow<T>(a, l, b, r);
  const float* g = (which ? a.norm2_g : a.norm1_g) + (long)l * d::D;
  const float* md = a.mod + (long)(r < d::S ? b : d::B) * 6 * d::D;
  const float shift = md[(which ? 3 : 0) * d::D + j], scale = md[(which ? 4 : 1) * d::D + j];
  a.h[idx] = xr[j] * a.rs[r] * g[j] * (1.f + scale) + shift;
}
struct GemmArgs { const float* A; int lda; const float* W; int ldw; float* Cc; int ldc; int M, N, K;
  const float* gate; int ldg;
  const float* colscale;
  const float* res; int ldr;
  int accumulate; };
HD void st_gemm(const GemmArgs& g, long idx) {
  const int nb = g.N / 4; const int cb = (int)(idx % nb), rb = (int)(idx / nb);
  float acc[4][4];
#pragma unroll
  for (int i = 0; i < 4; ++i) {
#pragma unroll
    for (int j = 0; j < 4; ++j) acc[i][j] = 0.f; }
  const float* a0 = g.A + (long)(rb * 4) * g.lda; const float* w0 = g.W + cb * 4;
  for (int k = 0; k < g.K; ++k) {
    float av[4], wv[4];
#pragma unroll
    for (int i = 0; i < 4; ++i) av[i] = a0[(long)i * g.lda + k];
#pragma unroll
    for (int j = 0; j < 4; ++j) wv[j] = w0[(long)k * g.ldw + j];
#pragma unroll
    for (int i = 0; i < 4; ++i) {
#pragma unroll
      for (int j = 0; j < 4; ++j) acc[i][j] += av[i] * wv[j]; }
  }
#pragma unroll
  for (int i = 0; i < 4; ++i)
#pragma unroll
  for (int j = 0; j < 4; ++j) {
    const int r = rb * 4 + i, c = cb * 4 + j; float v = acc[i][j];
    if (g.gate) v *= sigmoidf_(g.gate[(long)r * g.ldg + c]);
    if (g.colscale) v *= g.colscale[c];
    if (g.res) v += g.res[(long)r * g.ldr + c];
    float* p = g.Cc + (long)r * g.ldc + c;
    if (g.accumulate) v += *p;
    *p = v;
  }
}
template <class T> HD void st_qknorm(const NaiveBufs& a, int l, long idx) {
  using d = DD<T>; const int hh = (int)(idx % (d::AH + d::AKV)), r = (int)(idx / (d::AH + d::AKV));
  const bool isq = hh < d::AH; const int hd = isq ? hh : hh - d::AH;
  const float* src = a.proj + (long)r * d::NIN + (isq ? d::O_AQ : d::O_AK) + hd * d::HDM;
  float* dst = (isq ? a.qn + (long)r * d::AQW : a.kn + (long)r * d::AKVW) + hd * d::HDM;
  const float* g = (isq ? a.q_norm_g : a.k_norm_g) + (long)l * d::HDM;
  float s = 0.f; for (int k = 0; k < d::HDM; ++k) s += src[k] * src[k];
  const float rsq = 1.f / sqrtf(s / (float)d::HDM + 1e-6f);
  if (r < d::S) {
    const int row = r / d::GW, col = r % d::GW;
    for (int p = 0; p < d::HDM / 2; ++p) {
      const int fi = p < d::RP ? p : p - d::RP; const float pos = p < d::RP ? (float)row : (float)col;
      const float inv = powf(10000.f, -(float)fi / (float)d::RP); const float ang = pos * inv;
      const float cs = cosf(ang), sn = sinf(ang);
      const float x1 = src[2 * p] * rsq * g[2 * p], x2 = src[2 * p + 1] * rsq * g[2 * p + 1];
      dst[2 * p] = x1 * cs - x2 * sn; dst[2 * p + 1] = x1 * sn + x2 * cs;
    }
  } else { for (int k = 0; k < d::HDM; ++k) dst[k] = src[k] * rsq * g[k]; }
}
template <class T, int NSPLIT> HD void st_attn(const NaiveBufs& a, int r0, int nrows, long idx) {
  using d = DD<T>; constexpr int OD = d::HDM / NSPLIT;
  const int r = r0 + (int)(idx % nrows); const int hs = (int)(idx / nrows); const int part = hs % NSPLIT, hq = hs / NSPLIT; const int kv = hq / d::AG;
  const int k0 = r < d::S ? 0 : d::S, k1 = d::R;
  float q[d::HDM], o[OD];
  const float scale = 1.f / sqrtf((float)d::HDM);
#pragma unroll
  for (int k = 0; k < d::HDM; ++k) q[k] = a.qn[(long)r * d::AQW + hq * d::HDM + k] * scale;
#pragma unroll
  for (int k = 0; k < OD; ++k) o[k] = 0.f;
  float mx = -1e30f, lsum = 0.f;
  for (int kk = k0; kk < k1; ++kk) {
    const float* kr = a.kn + (long)kk * d::AKVW + kv * d::HDM;
    float s = 0.f;
#pragma unroll
    for (int k = 0; k < d::HDM; ++k) s += q[k] * kr[k];
    if (s > mx) { const float cr = expf(mx - s); lsum *= cr;
#pragma unroll
      for (int k = 0; k < OD; ++k) o[k] *= cr;
      mx = s; }
    const float p = expf(s - mx); lsum += p;
    const float* vr = a.proj + (long)kk * d::NIN + d::O_AV + kv * d::HDM + part * OD;
#pragma unroll
    for (int k = 0; k < OD; ++k) o[k] += p * vr[k];
  }
  const float inv = 1.f / lsum;
#pragma unroll
  for (int k = 0; k < OD; ++k) a.yatt[(long)r * d::AQW + hq * d::HDM + part * OD + k] = o[k] * inv;
}
template <class T> HD void st_glala(const NaiveBufs& a, int l, long idx) {
  using d = DD<T>; const int j = (int)(idx % d::GKW); const int dir = (int)((idx / d::GKW) % 2); const int r = (int)(idx / (2 * d::GKW));
  const float* al = a.proj + (long)r * d::NIN + d::O_GA + dir * d::GR;
  const float* w2 = a.gla_wa2 + ((long)l * 2 + dir) * d::GR * d::GKW; float z = a.gla_ba[((long)l * 2 + dir) * d::GKW + j];
  for (int k = 0; k < d::GR; ++k) z += al[k] * w2[(long)k * d::GKW + j];
  (dir ? a.lab : a.laf)[(long)r * d::GKW + j] = expf(logsigmoidf_(z) / 16.f);
}
template <class T> HD void st_glascan(const NaiveBufs& a, long idx) {
  using d = DD<T>; const int v = (int)(idx % d::GDV); const int hd = (int)((idx / d::GDV) % d::GH); const int dir = (int)(idx / (d::GDV * d::GH));
  float st[d::GDK];
#pragma unroll
  for (int k = 0; k < d::GDK; ++k) st[k] = 0.f;
  const float qs = 1.f / sqrtf((float)d::GDK);
  const float* la = dir ? a.lab : a.laf; float* od = dir ? a.ob : a.of;
  for (int step = 0; step < d::R; ++step) {
    int r;
    if (step < d::C) r = d::S + (dir ? d::C - 1 - step : step); else r = dir ? d::S - 1 - (step - d::C) : step - d::C;
    const float* pr = a.proj + (long)r * d::NIN;
    const float vv = pr[d::O_GV + hd * d::GDV + v];
    float o = 0.f;
#pragma unroll
    for (int k = 0; k < d::GDK; ++k) {
      st[k] = la[(long)r * d::GKW + hd * d::GDK + k] * st[k] + pr[d::O_GK + hd * d::GDK + k] * vv;
      o += pr[d::O_GQ + hd * d::GDK + k] * qs * st[k];
    }
    od[(long)r * d::GVW + hd * d::GDV + v] = o;
  }
}
template <class T> HD void st_glaout(const NaiveBufs& a, int l, long idx) {
  using d = DD<T>; const int hd = (int)(idx % d::GH), r = (int)(idx / d::GH);
  const long base = (long)r * d::GVW + hd * d::GDV; float s = 0.f;
  for (int v = 0; v < d::GDV; ++v) { const float o = a.of[base + v] + a.ob[base + v]; s += o * o; }
  const float rsq = 1.f / sqrtf(s / (float)d::GDV + 1e-6f);
  for (int v = 0; v < d::GDV; ++v) { const float o = a.of[base + v] + a.ob[base + v];
    a.ygla[base + v] = o * rsq * a.gla_norm_g[(long)l * d::GDV + v] * siluf_(a.proj[(long)r * d::NIN + d::O_OG + hd * d::GDV + v]); }
}
template <class T> HD void st_hyconv3(const NaiveBufs& a, int l, long idx) {
  using d = DD<T>; const int j = (int)(idx % (3 * d::HW)), r = (int)(idx / (3 * d::HW));
  const int lo = r < d::S ? 0 : d::S, hi = r < d::S ? d::S : d::R;
  const float* w = a.hy_conv_w + (long)l * 3 * 3 * d::HW;
  float v = a.hy_conv_b[(long)l * 3 * d::HW + j] + a.proj[(long)r * d::NIN + d::O_HY + j] * w[1 * 3 * d::HW + j];
  if (r - 1 >= lo) v += a.proj[(long)(r - 1) * d::NIN + d::O_HY + j] * w[0 * 3 * d::HW + j];
  if (r + 1 < hi) v += a.proj[(long)(r + 1) * d::NIN + d::O_HY + j] * w[2 * 3 * d::HW + j];
  a.uc[idx] = v;
}
template <class T> HD void st_hylong(const NaiveBufs& a, int l, int o, long idx) {
  using d = DD<T>; const int c = (int)(idx % d::HW); const int rb = (int)(idx / d::HW); const int r0 = rb * 4;
  const bool lat = r0 < d::S; const int n = lat ? d::S : d::C; const int base = lat ? 0 : d::S; const int t0 = r0 - base;
  const float* tp = (lat ? a.tapsS : a.tapsC) + (long)o * 2 * n * d::HW + c; const float nr = (lat ? a.nrmS : a.nrmC)[o * d::HW + c];
  const float* zs = o == 0 ? a.uc + 2 * d::HW + c : a.z1 + c; const int ldz = o == 0 ? 3 * d::HW : d::HW;
  float acc0 = 0.f, acc1 = 0.f, acc2 = 0.f, acc3 = 0.f;
  auto tap = [&](int lag) { const int li = lag >= 0 ? lag : 2 * n + lag; return tp[(long)li * d::HW]; };
  float w0 = tap(t0), w1 = tap(t0 + 1), w2 = tap(t0 + 2), w3 = tap(t0 + 3);
  for (int s = 0; s < n; ++s) {
    const float zv = zs[(long)(base + s) * ldz];
    acc0 += w0 * zv; acc1 += w1 * zv; acc2 += w2 * zv; acc3 += w3 * zv;
    w3 = w2; w2 = w1; w1 = w0; w0 = (s + 1 < n) ? tap(t0 - s - 1) : 0.f;
  }
  const float sk = a.hy_skip[((long)l * 2 + o) * d::HW + c];
  float* dst = o == 0 ? a.z1 : a.yhy;
  const float accs[4] = {acc0, acc1, acc2, acc3};
#pragma unroll
  for (int i = 0; i < 4; ++i) { const int r = r0 + i; const float zr = zs[(long)r * ldz];
    dst[(long)r * d::HW + c] = a.uc[(long)r * 3 * d::HW + o * d::HW + c] * (accs[i] / nr + sk * zr); }
}
template <class T> HD void st_router(const NaiveBufs& a, long idx) {
  using d = DD<T>; const int r = (int)idx; const float* hr = a.h + (long)r * d::D;
  float sc[d::NE], sel[d::NE];
#pragma unroll
  for (int e = 0; e < d::NE; ++e) sc[e] = 0.f;
  for (int k = 0; k < d::D; ++k) { const float hv = hr[k];
#pragma unroll
    for (int e = 0; e < d::NE; ++e) sc[e] += hv * a.router_w[(long)k * d::NE + e]; }
#pragma unroll
  for (int e = 0; e < d::NE; ++e) { sc[e] = sigmoidf_(sc[e]); sel[e] = sc[e] + a.router_b[e]; }
  int bestg = 0; float bestgs = -1e30f;
#pragma unroll
  for (int g = 0; g < d::NG; ++g) { float m1 = -1e30f, m2 = -1e30f;
#pragma unroll
    for (int i = 0; i < d::EPG; ++i) { const float v = sel[g * d::EPG + i]; if (v > m1) { m2 = m1; m1 = v; } else if (v > m2) m2 = v; }
    const float gs = m1 + m2; if (gs > bestgs) { bestgs = gs; bestg = g; } }
  int i1 = -1, i2 = -1; float v1 = -1e30f, v2 = -1e30f, s1 = 0.f, s2 = 0.f;
#pragma unroll
  for (int e = 0; e < d::NE; ++e) { if (e / d::EPG == bestg) { const float v = sel[e];
      if (v > v1) { v2 = v1; i2 = i1; s2 = s1; v1 = v; i1 = e; s1 = sc[e]; } else if (v > v2) { v2 = v; i2 = e; s2 = sc[e]; } } }
  const float inv = 1.f / (s1 + s2);
  a.ridx[2 * r] = i1; a.ridx[2 * r + 1] = i2; a.rw[2 * r] = s1 * inv; a.rw[2 * r + 1] = s2 * inv;
}
template <class T> HD void st_moehid(const NaiveBufs& a, int l, long idx) {
  using d = DD<T>; const int j = (int)(idx % d::DE); const int k = (int)((idx / d::DE) % 2); const int r = (int)(idx / (2 * d::DE));
  const int e = a.ridx[2 * r + k]; const float* hr = a.h + (long)r * d::D;
  const float* wg = a.moe_w_gate + (((long)l * d::NE + e) * d::D) * d::DE + j; const float* wu = a.moe_w_up + (((long)l * d::NE + e) * d::D) * d::DE + j;
  float g = 0.f, u = 0.f;
  for (int i = 0; i < d::D; ++i) { const float hv = hr[i]; g += hv * wg[(long)i * d::DE]; u += hv * wu[(long)i * d::DE]; }
  a.hid[idx] = siluf_(g) * u;
}
template <class T> HD void st_moeout(const NaiveBufs& a, int l, int b, long idx) {
  using d = DD<T>; const int dd = (int)(idx % d::D), r = (int)(idx / d::D);
  float acc = 0.f;
  for (int k = 0; k < 2; ++k) { const int e = a.ridx[2 * r + k]; const float* hk = a.hid + ((long)r * 2 + k) * d::DE;
    const float* wd = a.moe_w_down + (((long)l * d::NE + e) * d::DE) * d::D + dd; float s = 0.f;
    for (int j = 0; j < d::DE; ++j) s += hk[j] * wd[(long)j * d::D];
    acc += a.rw[2 * r + k] * s; }
  const float g2 = a.mod[(long)(r < d::S ? b : d::B) * 6 * d::D + 5 * d::D + dd];
  float* xr = xrow_w<T>(a, b, r); xr[dd] += g2 * acc;
}
enum { L_MOD = 0, L_HID_S, L_HID_C, L_TAPS_S, L_TAPS_C, L_NRM_S, L_NRM_C, N_LSTAGES,
       P_RS1 = 16, P_NORM1, P_INPROJ, P_QKNORM, P_ATTN_L, P_ATTN_C, P_GLALA, P_GLASCAN, P_GLAOUT, P_HYC3, P_HYL0, P_HYL1,
       P_MRG_HY, P_MRG_GLA, P_MRG_ATT, P_OUT_L, P_OUT_C, P_RS2, P_NORM2, P_ROUTER, P_MOEHID, P_MOEOUT, P_END };
constexpr int ATT_NSPLIT = 2;

template <class T> HD long stage_items(int st, int l) {
  using d = DD<T>; const bool last = (l == d::DEPTH - 1);
  switch (st) {
    case L_MOD: return (long)(d::B + 1) * 6 * d::D;
    case L_HID_S: return (long)d::S * d::HF;
    case L_HID_C: return (long)d::C * d::HF;
    case L_TAPS_S: return 2L * 2 * d::S * d::HW;
    case L_TAPS_C: return 2L * 2 * d::C * d::HW;
    case L_NRM_S: case L_NRM_C: return 2L * d::HW;
    case P_RS1: case P_RS2: case P_ROUTER: return d::R;
    case P_NORM1: case P_NORM2: return (long)d::R * d::D;
    case P_INPROJ: return (long)(d::R / 4) * (d::NIN / 4);
    case P_QKNORM: return (long)d::R * (d::AH + d::AKV);
    case P_ATTN_L: return (long)d::S * d::AH * ATT_NSPLIT;
    case P_ATTN_C: return last ? 0 : (long)d::C * d::AH * ATT_NSPLIT;
    case P_GLALA: return (long)d::R * 2 * d::GKW;
    case P_GLASCAN: return 2L * d::GH * d::GDV;
    case P_GLAOUT: return (long)d::R * d::GH;
    case P_HYC3: return (long)d::R * 3 * d::HW;
    case P_HYL0: case P_HYL1: return (long)(d::R / 4) * d::HW;
    case P_MRG_HY: case P_MRG_GLA: case P_MRG_ATT: return (long)(d::R / 4) * (d::D / 4);
    case P_OUT_L: return (long)(d::S / 4) * (d::D / 4);
    case P_OUT_C: return last ? 0 : (long)(d::C / 4) * (d::D / 4);
    case P_MOEHID: return (long)d::R * 2 * d::DE;
    case P_MOEOUT: return (long)(last ? d::S : d::R) * d::D;
  }
  return 0;
}

template <class T, int ST> HD void stage_run(const NaiveBufs& a, int l, int b, long idx) {
  using d = DD<T>;
  if constexpr (ST == L_MOD) st_mod<T>(a, l, idx);
  else if constexpr (ST == L_HID_S) st_hyhid<T>(a, l, 0, idx);
  else if constexpr (ST == L_HID_C) st_hyhid<T>(a, l, 1, idx);
  else if constexpr (ST == L_TAPS_S) st_hytaps<T>(a, l, 0, idx);
  else if constexpr (ST == L_TAPS_C) st_hytaps<T>(a, l, 1, idx);
  else if constexpr (ST == L_NRM_S) st_hynorm<T>(a, 0, idx);
  else if constexpr (ST == L_NRM_C) st_hynorm<T>(a, 1, idx);
  else if constexpr (ST == P_RS1) st_rs<T>(a, l, b, 0, idx);
  else if constexpr (ST == P_RS2) st_rs<T>(a, l, b, 1, idx);
  else if constexpr (ST == P_NORM1) st_norm<T>(a, l, b, 0, idx);
  else if constexpr (ST == P_NORM2) st_norm<T>(a, l, b, 1, idx);
  else if constexpr (ST == P_INPROJ) { GemmArgs g{a.h, d::D, a.w_in + (long)l * d::D * d::NIN, d::NIN, a.proj, d::NIN, d::R, d::NIN, d::D, nullptr, 0, nullptr, nullptr, 0, 0}; st_gemm(g, idx); }
  else if constexpr (ST == P_QKNORM) st_qknorm<T>(a, l, idx);
  else if constexpr (ST == P_ATTN_L) st_attn<T, ATT_NSPLIT>(a, 0, d::S, idx);
  else if constexpr (ST == P_ATTN_C) st_attn<T, ATT_NSPLIT>(a, d::S, d::C, idx);
  else if constexpr (ST == P_GLALA) st_glala<T>(a, l, idx);
  else if constexpr (ST == P_GLASCAN) st_glascan<T>(a, idx);
  else if constexpr (ST == P_GLAOUT) st_glaout<T>(a, l, idx);
  else if constexpr (ST == P_HYC3) st_hyconv3<T>(a, l, idx);
  else if constexpr (ST == P_HYL0) st_hylong<T>(a, l, 0, idx);
  else if constexpr (ST == P_HYL1) st_hylong<T>(a, l, 1, idx);
  else if constexpr (ST == P_MRG_HY) { GemmArgs g{a.yhy, d::HW, a.w_br_hy + (long)l * d::HW * d::D, d::D, a.m, d::D, d::R, d::D, d::HW, a.proj + d::O_BR, d::NIN, nullptr, nullptr, 0, 0}; st_gemm(g, idx); }
  else if constexpr (ST == P_MRG_GLA) { GemmArgs g{a.ygla, d::GVW, a.w_br_gla + (long)l * d::GVW * d::D, d::D, a.m, d::D, d::R, d::D, d::GVW, a.proj + d::O_BR + d::D, d::NIN, nullptr, nullptr, 0, 1}; st_gemm(g, idx); }
  else if constexpr (ST == P_MRG_ATT) { GemmArgs g{a.yatt, d::AQW, a.w_br_att + (long)l * d::AQW * d::D, d::D, a.m, d::D, d::R, d::D, d::AQW, a.proj + d::O_BR + 2 * d::D, d::NIN, nullptr, nullptr, 0, 1}; st_gemm(g, idx); }
  else if constexpr (ST == P_OUT_L) { const float* res = (l == 0 ? a.x : (const float*)a.out) + (long)b * d::S * d::D;
    GemmArgs g{a.m, d::D, a.w_out + (long)l * d::D * d::D, d::D, a.out + (long)b * d::S * d::D, d::D, d::S, d::D, d::D, nullptr, 0, a.mod + (long)b * 6 * d::D + 2 * d::D, res, d::D, 0}; st_gemm(g, idx); }
  else if constexpr (ST == P_OUT_C) { const float* res = (l == 0 ? a.ctx : (const float*)a.xc) + (long)b * d::C * d::D;
    GemmArgs g{a.m + (long)d::S * d::D, d::D, a.w_out + (long)l * d::D * d::D, d::D, a.xc + (long)b * d::C * d::D, d::D, d::C, d::D, d::D, nullptr, 0, a.mod + (long)d::B * 6 * d::D + 2 * d::D, res, d::D, 0}; st_gemm(g, idx); }
  else if constexpr (ST == P_ROUTER) st_router<T>(a, idx);
  else if constexpr (ST == P_MOEHID) st_moehid<T>(a, l, idx);
  else if constexpr (ST == P_MOEOUT) st_moeout<T>(a, l, b, idx);
}

template <class T> inline size_t carve(NaiveBufs& a, float* ws) {
  using d = DD<T>; size_t o = 0; auto take = [&](size_t n) { float* p = ws ? ws + o : nullptr; o += (n + 63) & ~(size_t)63; return p; };
  a.mod = take((size_t)(d::B + 1) * 6 * d::D);
  a.hid2S = take((size_t)d::S * d::HF); a.hid2C = take((size_t)d::C * d::HF);
  a.tapsS = take((size_t)2 * 2 * d::S * d::HW); a.tapsC = take((size_t)2 * 2 * d::C * d::HW);
  a.nrmS = take(2 * d::HW); a.nrmC = take(2 * d::HW);
  a.rs = take(d::R); a.h = take((size_t)d::R * d::D); a.proj = take((size_t)d::R * d::NIN);
  a.qn = take((size_t)d::R * d::AQW); a.kn = take((size_t)d::R * d::AKVW); a.yatt = take((size_t)d::R * d::AQW);
  a.laf = take((size_t)d::R * d::GKW); a.lab = take((size_t)d::R * d::GKW);
  a.of = take((size_t)d::R * d::GVW); a.ob = take((size_t)d::R * d::GVW); a.ygla = take((size_t)d::R * d::GVW);
  a.uc = take((size_t)d::R * 3 * d::HW); a.z1 = take((size_t)d::R * d::HW); a.yhy = take((size_t)d::R * d::HW);
  a.m = take((size_t)d::R * d::D); a.ridx = (int*)take((size_t)d::R * 2); a.rw = take((size_t)d::R * 2);
  a.hid = take((size_t)d::R * 2 * d::DE); a.xc = take((size_t)d::B * d::C * d::D);
  return o;
}
template <class T> inline void set_inputs(NaiveBufs& a, const float* const* in) {
  int i = 0;
  a.x = in[i++]; a.c = in[i++]; a.ctx = in[i++]; a.c_ctx = in[i++]; a.w_mod = in[i++]; a.b_mod = in[i++]; a.norm1_g = in[i++]; a.norm2_g = in[i++];
  a.w_in = in[i++]; a.q_norm_g = in[i++]; a.k_norm_g = in[i++]; a.gla_wa2 = in[i++]; a.gla_ba = in[i++]; a.gla_norm_g = in[i++];
  a.hy_conv_w = in[i++]; a.hy_conv_b = in[i++]; a.hy_pos_w1 = in[i++]; a.hy_pos_b1 = in[i++]; a.hy_sin_freq = in[i++]; a.hy_pos_w2 = in[i++];
  a.hy_pos_b2 = in[i++]; a.hy_pos_w3 = in[i++]; a.hy_decay = in[i++]; a.hy_skip = in[i++]; a.w_br_hy = in[i++]; a.w_br_gla = in[i++];
  a.w_br_att = in[i++]; a.w_out = in[i++]; a.router_w = in[i++]; a.router_b = in[i++]; a.moe_w_gate = in[i++]; a.moe_w_up = in[i++]; a.moe_w_down = in[i++];
}

#define LSTAGES(X) X(L_MOD) X(L_HID_S) X(L_HID_C) X(L_TAPS_S) X(L_TAPS_C) X(L_NRM_S) X(L_NRM_C)
#define PSTAGES(X) X(P_RS1) X(P_NORM1) X(P_INPROJ) X(P_QKNORM) X(P_ATTN_L) X(P_ATTN_C) X(P_GLALA) X(P_GLASCAN) X(P_GLAOUT) X(P_HYC3) X(P_HYL0) X(P_HYL1) \
  X(P_MRG_HY) X(P_MRG_GLA) X(P_MRG_ATT) X(P_OUT_L) X(P_OUT_C) X(P_RS2) X(P_NORM2) X(P_ROUTER) X(P_MOEHID) X(P_MOEOUT)
using TD = FullDims;
template <int ST> __global__ void __launch_bounds__(256) k_stage(NaiveBufs a, int l, int b) {
  const long n = stage_items<TD>(ST, l);
  for (long i = (long)blockIdx.x * 256 + threadIdx.x; i < n; i += (long)gridDim.x * 256) stage_run<TD, ST>(a, l, b, i);
}
template <int ST> static void launch_stage(const NaiveBufs& a, int l, int b, hipStream_t s) {
  const long n = stage_items<TD>(ST, l); if (n == 0) return;
  long blocks = (n + 255) / 256; if (blocks > 4096) blocks = 4096;
  hipLaunchKernelGGL((k_stage<ST>), dim3((unsigned)blocks), dim3(256), 0, s, a, l, b);
}
extern "C" void kernel_launch(void* const* d_in, const int* in_sizes, int n_in, void* d_out, int out_size, void* d_ws, size_t ws_size, hipStream_t stream) {
  using d = DD<TD>;
  NaiveBufs a{}; const float* ptrs[33]; for (int i = 0; i < 33; ++i) ptrs[i] = (const float*)d_in[i];
  set_inputs<TD>(a, ptrs); carve<TD>(a, (float*)d_ws); a.out = (float*)d_out;
  for (int l = 0; l < d::DEPTH; ++l) {
#define X(ST) launch_stage<ST>(a, l, 0, stream);
    LSTAGES(X)
#undef X
    for (int b = 0; b < d::B; ++b) {
#define X(ST) launch_stage<ST>(a, l, b, stream);
      PSTAGES(X)
#undef X
    }
  }
}
```

```cpp
#include <hip/hip_runtime.h>
#include <cstddef>
#include <cstdio>
#define XB_TMO      128
#define XB_XCNT(j)  (256  + 64 * (j))
#define XB_XSUB(j)  (1280 + 64 * (j))
#define XB_XGEN(j)  (2304 + 64 * (j))
#define XB_TOP      3328
#define XB_TOPGEN   3392
#define XCD_BAR_WORDS 3456
#define XB_SPIN_CAP (1u << 18)
#define LAS __attribute__((address_space(3)))

__device__ __forceinline__ unsigned xb_ld(unsigned* p)              { return __hip_atomic_load(p, __ATOMIC_RELAXED, __HIP_MEMORY_SCOPE_AGENT); }
__device__ __forceinline__ unsigned xb_add(unsigned* p, unsigned v) { return __hip_atomic_fetch_add(p, v, __ATOMIC_RELAXED, __HIP_MEMORY_SCOPE_AGENT); }
__device__ __forceinline__ unsigned xb_xcc_id() { return (unsigned)__builtin_amdgcn_s_getreg((3 << 11) | 20) & 0xFu; }
#define XB_SPIN(cond, bar) do { unsigned _sp = 0; while (cond) { __builtin_amdgcn_s_sleep(1); \
    if ((++_sp & 255u) == 0u) { if (xb_ld(&(bar)[XB_TMO])) break; if (_sp > XB_SPIN_CAP) { atomicAdd(&(bar)[XB_TMO], 1u); break; } } } } while (0)

struct XcdBarrier {
    unsigned* bar; unsigned x;
    volatile LAS unsigned* st;
};

__device__ __forceinline__ XcdBarrier xcd_barrier_post(unsigned* bar, volatile LAS unsigned* st) {
    XcdBarrier b; b.bar = bar; b.x = xb_xcc_id(); b.st = st;
    if (threadIdx.x == 0) (void)xb_add(&bar[XB_XCNT(b.x)], 1u);
    return b;
}
__device__ __forceinline__ void xcd_barrier_complete(unsigned* bar, unsigned x, unsigned& nloc, unsigned& nx) {
    const unsigned G = gridDim.x * gridDim.y * gridDim.z;
    unsigned sum, cnt, mine, sp = 0u;
    for (;;) {
        sum = 0u; cnt = 0u; mine = 0u;
#pragma unroll
        for (unsigned j = 0; j < 16; ++j) { const unsigned c = xb_ld(&bar[XB_XCNT(j)]); sum += c; cnt += (c > 0u) ? 1u : 0u; mine = (j == x) ? c : mine; }
        if (sum == G) break;
        __builtin_amdgcn_s_sleep(1);
        if ((++sp & 255u) == 0u) { if (xb_ld(&bar[XB_TMO])) break; if (sp > XB_SPIN_CAP) { atomicAdd(&bar[XB_TMO], 1u); break; } }
    }
    nloc = mine > 0u ? mine : 1u; nx = cnt > 0u ? cnt : 1u;
}

__device__ __forceinline__ void xcd_barrier(const XcdBarrier& b) {
    asm volatile("s_waitcnt vmcnt(0)" ::: "memory");
    __syncthreads();
    if (threadIdx.x == 0) {
        unsigned* bar = b.bar;
        __builtin_amdgcn_s_waitcnt(0);
        unsigned nloc = b.st[0], nx = b.st[1];
        if (nloc == 0u) { xcd_barrier_complete(bar, b.x, nloc, nx); b.st[0] = nloc; b.st[1] = nx; }
        const unsigned old = xb_add(&bar[XB_XSUB(b.x)], 1u);
        const unsigned gen = old / nloc;
        if (old + 1u == (gen + 1u) * nloc) {
            __builtin_amdgcn_fence(__ATOMIC_RELEASE, "agent");
            asm volatile("s_waitcnt vmcnt(0)" ::: "memory");
            const unsigned og = xb_add(&bar[XB_TOP], 1u);
            const unsigned tg = og / nx;
            if (og + 1u == (tg + 1u) * nx) xb_add(&bar[XB_TOPGEN], 1u);
            else XB_SPIN(xb_ld(&bar[XB_TOPGEN]) == tg, bar);
            __builtin_amdgcn_fence(__ATOMIC_ACQUIRE, "agent");
            xb_add(&bar[XB_XGEN(b.x)], 1u);
            asm volatile("s_waitcnt vmcnt(0)" ::: "memory");
        } else {
            XB_SPIN(xb_ld(&bar[XB_XGEN(b.x)]) == gen, bar);
            __builtin_amdgcn_fence(__ATOMIC_ACQUIRE, "agent");
            asm volatile("s_waitcnt vmcnt(0)" ::: "memory");
        }
    }
    __syncthreads();
}
#include <math.h>
#ifdef HOST_TEST
#define HD
#else
#define HD __host__ __device__ __forceinline__
#endif

struct FullDims { static constexpr int D=1024,B=8,S=4096,DEPTH=2,C=256,GW=64,AH=8,AKV=2,HDM=128,GH=4,GDK=64,GDV=128,GR=16,HW=512,HB=16,HF=64,NE=16,NG=4,DE=512; };
struct SmallDims { static constexpr int D=64,B=2,S=128,DEPTH=2,C=32,GW=16,AH=4,AKV=2,HDM=16,GH=2,GDK=8,GDV=16,GR=4,HW=32,HB=4,HF=8,NE=8,NG=2,DE=32; };

template <class T> struct DD {
  static constexpr int D=T::D,B=T::B,S=T::S,DEPTH=T::DEPTH,C=T::C,GW=T::GW,AH=T::AH,AKV=T::AKV,HDM=T::HDM,GH=T::GH,GDK=T::GDK,GDV=T::GDV,GR=T::GR,HW=T::HW,HB=T::HB,HF=T::HF,NE=T::NE,NG=T::NG,DE=T::DE;
  static constexpr int R=S+C, AG=AH/AKV, RP=HDM/4, HE=1+2*HB, EPG=NE/NG, AQW=AH*HDM, AKVW=AKV*HDM, GKW=GH*GDK, GVW=GH*GDV;
  static constexpr int NKV=AKVW+AKVW+GKW+GVW+2*GR, NIN=NKV+AQW+GKW+GVW+3*HW+3*D;
  static constexpr int O_AK=0, O_AV=AKVW, O_GK=2*AKVW, O_GV=2*AKVW+GKW, O_GA=2*AKVW+GKW+GVW;
  static constexpr int O_AQ=NKV, O_GQ=NKV+AQW, O_OG=O_GQ+GKW, O_HY=O_OG+GVW, O_BR=O_HY+3*HW;
};

struct NaiveBufs {
  const float *x,*c,*ctx,*c_ctx,*w_mod,*b_mod,*norm1_g,*norm2_g,*w_in,*q_norm_g,*k_norm_g,*gla_wa2,*gla_ba,*gla_norm_g,*hy_conv_w,*hy_conv_b,
    *hy_pos_w1,*hy_pos_b1,*hy_sin_freq,*hy_pos_w2,*hy_pos_b2,*hy_pos_w3,*hy_decay,*hy_skip,*w_br_hy,*w_br_gla,*w_br_att,*w_out,*router_w,*router_b,*moe_w_gate,*moe_w_up,*moe_w_down;
  float* out;
  float *mod;
  float *hid2S,*hid2C;
  float *tapsS,*tapsC;
  float *nrmS,*nrmC;
  float *rs;
  float *h;
  float *proj;
  float *qn,*kn;
  float *yatt;
  float *laf,*lab;
  float *of,*ob;
  float *ygla;
  float *uc;
  float *z1,*yhy;
  float *m;
  int   *ridx;
  float *rw;
  float *hid;
  float *xc;
};

HD float sigmoidf_(float x) { return 1.f / (1.f + expf(-x)); }
HD float siluf_(float x) { return x / (1.f + expf(-x)); }
HD float logsigmoidf_(float x) { return x < 0.f ? x - log1pf(expf(x)) : -log1pf(expf(-x)); }

template <class T> HD void st_mod(const NaiveBufs& a, int l, long idx) {
  using d = DD<T>; const int j = (int)(idx % (6 * d::D)), bb = (int)(idx / (6 * d::D));
  const float* cv = bb < d::B ? a.c + (long)bb * d::D : a.c_ctx; const float* w = a.w_mod + (long)l * d::D * 6 * d::D;
  float acc = a.b_mod[(long)l * 6 * d::D + j];
  for (int k = 0; k < d::D; ++k) acc += siluf_(cv[k]) * w[(long)k * 6 * d::D + j];
  a.mod[idx] = acc;
}
template <class T> HD void st_hyhid(const NaiveBufs& a, int l, int which, long idx) {
  using d = DD<T>; const int n = which ? d::C : d::S; float* dst = which ? a.hid2C : a.hid2S;
  const int j = (int)(idx % d::HF), t = (int)(idx / d::HF);
  const float* w1 = a.hy_pos_w1 + (long)l * d::HE * d::HF; const float* b1 = a.hy_pos_b1 + l * d::HF; const float* fr = a.hy_sin_freq + l * d::HF;
  const float* w2 = a.hy_pos_w2 + (long)l * d::HF * d::HF; const float* b2 = a.hy_pos_b2 + l * d::HF;
  const float tn = (float)t / (float)n; const float w0 = 2.f * 3.14159265358979323846f / (float)n;
  float acc2 = b2[j];
  for (int i = 0; i < d::HF; ++i) {
    float acc = b1[i] + tn * w1[0 * d::HF + i];
    for (int bnd = 0; bnd < d::HB; ++bnd) {
      const float band = 1e-4f + (float)bnd * ((float)(d::HB - 1) - 1e-4f) / (float)(d::HB - 1);
      const float ph = w0 * (float)t * band;
      acc += cosf(ph) * w1[(1 + bnd) * d::HF + i] - sinf(ph) * w1[(1 + d::HB + bnd) * d::HF + i];
    }
    acc2 += sinf(fr[i] * acc) * w2[i * d::HF + j];
  }
  dst[idx] = sinf(fr[j] * acc2);
}
template <class T> HD void st_hytaps(const NaiveBufs& a, int l, int which, long idx) {
  using d = DD<T>; const int n = which ? d::C : d::S; const float* hid2 = which ? a.hid2C : a.hid2S; float* dst = which ? a.tapsC : a.tapsS;
  const int c = (int)(idx % d::HW); const int li = (int)((idx / d::HW) % (2 * n)); const int o = (int)(idx / ((long)d::HW * 2 * n));
  float v = 0.f;
  if (li != n) {
    const int dir = li < n ? 0 : 1; const int t = li < n ? li : 2 * n - li;
    const int col = (o * 2 + dir) * d::HW + c;
    const float* w3 = a.hy_pos_w3 + (long)l * d::HF * 4 * d::HW;
    float acc = 0.f;
    for (int j = 0; j < d::HF; ++j) acc += hid2[(long)t * d::HF + j] * w3[(long)j * 4 * d::HW + col];
    const float dec = fabsf(a.hy_decay[(long)l * 4 * d::HW + col]);
    v = acc * expf(-((float)t / (float)n) * dec);
  }
  dst[idx] = v;
}
template <class T> HD void st_hynorm(const NaiveBufs& a, int which, long idx) {
  using d = DD<T>; const int n = which ? d::C : d::S; const float* tp = which ? a.tapsC : a.tapsS; float* dst = which ? a.nrmC : a.nrmS;
  const int c = (int)(idx % d::HW), o = (int)(idx / d::HW);
  float s = 0.f; for (int li = 0; li < 2 * n; ++li) s += fabsf(tp[((long)o * 2 * n + li) * d::HW + c]);
  dst[idx] = s + 1e-6f;
}

template <class T> HD const float* xrow(const NaiveBufs& a, int l, int b, int r) {
  using d = DD<T>;
  if (r < d::S) return (l == 0 ? a.x : a.out) + ((long)b * d::S + r) * d::D;
  return (l == 0 ? a.ctx : a.xc) + ((long)b * d::C + (r - d::S)) * d::D;
}
template <class T> HD float* xrow_w(const NaiveBufs& a, int b, int r) {
  using d = DD<T>;
  if (r < d::S) return a.out + ((long)b * d::S + r) * d::D;
  return a.xc + ((long)b * d::C + (r - d::S)) * d::D;
}
template <class T> HD void st_rs(const NaiveBufs& a, int l, int b, int src, long idx) {
  using d = DD<T>; const int r = (int)idx; const float* xr = src ? (const float*)xrow_w<T>(a, b, r) : xrow<T>(a, l, b, r);
  float s = 0.f; for (int k = 0; k < d::D; ++k) s += xr[k] * xr[k];
  a.rs[r] = 1.f / sqrtf(s / (float)d::D + 1e-6f);
}
template <class T> HD void st_norm(const NaiveBufs& a, int l, int b, int which, long idx) {
  using d = DD<T>; const int j = (int)(idx % d::D), r = (int)(idx / d::D);
  const float* xr = which ? (const float*)xrow_w<T>(a, b, r) : xrow<T>(a, l, b, r);
  const float* g = (which ? a.norm2_g : a.norm1_g) + (long)l * d::D;
  const float* md = a.mod + (long)(r < d::S ? b : d::B) * 6 * d::D;
  const float shift = md[(which ? 3 : 0) * d::D + j], scale = md[(which ? 4 : 1) * d::D + j];
  a.h[idx] = xr[j] * a.rs[r] * g[j] * (1.f + scale) + shift;
}
struct GemmArgs { const float* A; int lda; const float* W; int ldw; float* Cc; int ldc; int M, N, K;
  const float* gate; int ldg;
  const float* colscale;
  const float* res; int ldr;
  int accumulate; };
HD void st_gemm(const GemmArgs& g, long idx) {
  const int nb = g.N / 4; const int cb = (int)(idx % nb), rb = (int)(idx / nb);
  float acc[4][4];
#pragma unroll
  for (int i = 0; i < 4; ++i) {
#pragma unroll
    for (int j = 0; j < 4; ++j) acc[i][j] = 0.f; }
  const float* a0 = g.A + (long)(rb * 4) * g.lda; const float* w0 = g.W + cb * 4;
  for (int k = 0; k < g.K; ++k) {
    float av[4], wv[4];
#pragma unroll
    for (int i = 0; i < 4; ++i) av[i] = a0[(long)i * g.lda + k];
#pragma unroll
    for (int j = 0; j < 4; ++j) wv[j] = w0[(long)k * g.ldw + j];
#pragma unroll
    for (int i = 0; i < 4; ++i) {
#pragma unroll
      for (int j = 0; j < 4; ++j) acc[i][j] += av[i] * wv[j]; }
  }
#pragma unroll
  for (int i = 0; i < 4; ++i)
#pragma unroll
  for (int j = 0; j < 4; ++j) {
    const int r = rb * 4 + i, c = cb * 4 + j; float v = acc[i][j];
    if (g.gate) v *= sigmoidf_(g.gate[(long)r * g.ldg + c]);
    if (g.colscale) v *= g.colscale[c];
    if (g.res) v += g.res[(long)r * g.ldr + c];
    float* p = g.Cc + (long)r * g.ldc + c;
    if (g.accumulate) v += *p;
    *p = v;
  }
}
template <class T> HD void st_qknorm(const NaiveBufs& a, int l, long idx) {
  using d = DD<T>; const int hh = (int)(idx % (d::AH + d::AKV)), r = (int)(idx / (d::AH + d::AKV));
  const bool isq = hh < d::AH; const int hd = isq ? hh : hh - d::AH;
  const float* src = a.proj + (long)r * d::NIN + (isq ? d::O_AQ : d::O_AK) + hd * d::HDM;
  float* dst = (isq ? a.qn + (long)r * d::AQW : a.kn + (long)r * d::AKVW) + hd * d::HDM;
  const float* g = (isq ? a.q_norm_g : a.k_norm_g) + (long)l * d::HDM;
  float s = 0.f; for (int k = 0; k < d::HDM; ++k) s += src[k] * src[k];
  const float rsq = 1.f / sqrtf(s / (float)d::HDM + 1e-6f);
  if (r < d::S) {
    const int row = r / d::GW, col = r % d::GW;
    for (int p = 0; p < d::HDM / 2; ++p) {
      const int fi = p < d::RP ? p : p - d::RP; const float pos = p < d::RP ? (float)row : (float)col;
      const float inv = powf(10000.f, -(float)fi / (float)d::RP); const float ang = pos * inv;
      const float cs = cosf(ang), sn = sinf(ang);
      const float x1 = src[2 * p] * rsq * g[2 * p], x2 = src[2 * p + 1] * rsq * g[2 * p + 1];
      dst[2 * p] = x1 * cs - x2 * sn; dst[2 * p + 1] = x1 * sn + x2 * cs;
    }
  } else { for (int k = 0; k < d::HDM; ++k) dst[k] = src[k] * rsq * g[k]; }
}
template <class T, int NSPLIT> HD void st_attn(const NaiveBufs& a, int r0, int nrows, long idx) {
  using d = DD<T>; constexpr int OD = d::HDM / NSPLIT;
  const int r = r0 + (int)(idx % nrows); const int hs = (int)(idx / nrows); const int part = hs % NSPLIT, hq = hs / NSPLIT; const int kv = hq / d::AG;
  const int k0 = r < d::S ? 0 : d::S, k1 = d::R;
  float q[d::HDM], o[OD];
  const float scale = 1.f / sqrtf((float)d::HDM);
#pragma unroll
  for (int k = 0; k < d::HDM; ++k) q[k] = a.qn[(long)r * d::AQW + hq * d::HDM + k] * scale;
#pragma unroll
  for (int k = 0; k < OD; ++k) o[k] = 0.f;
  float mx = -1e30f, lsum = 0.f;
  for (int kk = k0; kk < k1; ++kk) {
    const float* kr = a.kn + (long)kk * d::AKVW + kv * d::HDM;
    float s = 0.f;
#pragma unroll
    for (int k = 0; k < d::HDM; ++k) s += q[k] * kr[k];
    if (s > mx) { const float cr = expf(mx - s); lsum *= cr;
#pragma unroll
      for (int k = 0; k < OD; ++k) o[k] *= cr;
      mx = s; }
    const float p = expf(s - mx); lsum += p;
    const float* vr = a.proj + (long)kk * d::NIN + d::O_AV + kv * d::HDM + part * OD;
#pragma unroll
    for (int k = 0; k < OD; ++k) o[k] += p * vr[k];
  }
  const float inv = 1.f / lsum;
#pragma unroll
  for (int k = 0; k < OD; ++k) a.yatt[(long)r * d::AQW + hq * d::HDM + part * OD + k] = o[k] * inv;
}
template <class T> HD void st_glala(const NaiveBufs& a, int l, long idx) {
  using d = DD<T>; const int j = (int)(idx % d::GKW); const int dir = (int)((idx / d::GKW) % 2); const int r = (int)(idx / (2 * d::GKW));
  const float* al = a.proj + (long)r * d::NIN + d::O_GA + dir * d::GR;
  const float* w2 = a.gla_wa2 + ((long)l * 2 + dir) * d::GR * d::GKW; float z = a.gla_ba[((long)l * 2 + dir) * d::GKW + j];
  for (int k = 0; k < d::GR; ++k) z += al[k] * w2[(long)k * d::GKW + j];
  (dir ? a.lab : a.laf)[(long)r * d::GKW + j] = expf(logsigmoidf_(z) / 16.f);
}
template <class T> HD void st_glascan(const NaiveBufs& a, long idx) {
  using d = DD<T>; const int v = (int)(idx % d::GDV); const int hd = (int)((idx / d::GDV) % d::GH); const int dir = (int)(idx / (d::GDV * d::GH));
  float st[d::GDK];
#pragma unroll
  for (int k = 0; k < d::GDK; ++k) st[k] = 0.f;
  const float qs = 1.f / sqrtf((float)d::GDK);
  const float* la = dir ? a.lab : a.laf; float* od = dir ? a.ob : a.of;
  for (int step = 0; step < d::R; ++step) {
    int r;
    if (step < d::C) r = d::S + (dir ? d::C - 1 - step : step); else r = dir ? d::S - 1 - (step - d::C) : step - d::C;
    const float* pr = a.proj + (long)r * d::NIN;
    const float vv = pr[d::O_GV + hd * d::GDV + v];
    float o = 0.f;
#pragma unroll
    for (int k = 0; k < d::GDK; ++k) {
      st[k] = la[(long)r * d::GKW + hd * d::GDK + k] * st[k] + pr[d::O_GK + hd * d::GDK + k] * vv;
      o += pr[d::O_GQ + hd * d::GDK + k] * qs * st[k];
    }
    od[(long)r * d::GVW + hd * d::GDV + v] = o;
  }
}
template <class T> HD void st_glaout(const NaiveBufs& a, int l, long idx) {
  using d = DD<T>; const int hd = (int)(idx % d::GH), r = (int)(idx / d::GH);
  const long base = (long)r * d::GVW + hd * d::GDV; float s = 0.f;
  for (int v = 0; v < d::GDV; ++v) { const float o = a.of[base + v] + a.ob[base + v]; s += o * o; }
  const float rsq = 1.f / sqrtf(s / (float)d::GDV + 1e-6f);
  for (int v = 0; v < d::GDV; ++v) { const float o = a.of[base + v] + a.ob[base + v];
    a.ygla[base + v] = o * rsq * a.gla_norm_g[(long)l * d::GDV + v] * siluf_(a.proj[(long)r * d::NIN + d::O_OG + hd * d::GDV + v]); }
}
template <class T> HD void st_hyconv3(const NaiveBufs& a, int l, long idx) {
  using d = DD<T>; const int j = (int)(idx % (3 * d::HW)), r = (int)(idx / (3 * d::HW));
  const int lo = r < d::S ? 0 : d::S, hi = r < d::S ? d::S : d::R;
  const float* w = a.hy_conv_w + (long)l * 3 * 3 * d::HW;
  float v = a.hy_conv_b[(long)l * 3 * d::HW + j] + a.proj[(long)r * d::NIN + d::O_HY + j] * w[1 * 3 * d::HW + j];
  if (r - 1 >= lo) v += a.proj[(long)(r - 1) * d::NIN + d::O_HY + j] * w[0 * 3 * d::HW + j];
  if (r + 1 < hi) v += a.proj[(long)(r + 1) * d::NIN + d::O_HY + j] * w[2 * 3 * d::HW + j];
  a.uc[idx] = v;
}
template <class T> HD void st_hylong(const NaiveBufs& a, int l, int o, long idx) {
  using d = DD<T>; const int c = (int)(idx % d::HW); const int rb = (int)(idx / d::HW); const int r0 = rb * 4;
  const bool lat = r0 < d::S; const int n = lat ? d::S : d::C; const int base = lat ? 0 : d::S; const int t0 = r0 - base;
  const float* tp = (lat ? a.tapsS : a.tapsC) + (long)o * 2 * n * d::HW + c; const float nr = (lat ? a.nrmS : a.nrmC)[o * d::HW + c];
  const float* zs = o == 0 ? a.uc + 2 * d::HW + c : a.z1 + c; const int ldz = o == 0 ? 3 * d::HW : d::HW;
  float acc0 = 0.f, acc1 = 0.f, acc2 = 0.f, acc3 = 0.f;
  auto tap = [&](int lag) { const int li = lag >= 0 ? lag : 2 * n + lag; return tp[(long)li * d::HW]; };
  float w0 = tap(t0), w1 = tap(t0 + 1), w2 = tap(t0 + 2), w3 = tap(t0 + 3);
  for (int s = 0; s < n; ++s) {
    const float zv = zs[(long)(base + s) * ldz];
    acc0 += w0 * zv; acc1 += w1 * zv; acc2 += w2 * zv; acc3 += w3 * zv;
    w3 = w2; w2 = w1; w1 = w0; w0 = (s + 1 < n) ? tap(t0 - s - 1) : 0.f;
  }
  const float sk = a.hy_skip[((long)l * 2 + o) * d::HW + c];
  float* dst = o == 0 ? a.z1 : a.yhy;
  const float accs[4] = {acc0, acc1, acc2, acc3};
#pragma unroll
  for (int i = 0; i < 4; ++i) { const int r = r0 + i; const float zr = zs[(long)r * ldz];
    dst[(long)r * d::HW + c] = a.uc[(long)r * 3 * d::HW + o * d::HW + c] * (accs[i] / nr + sk * zr); }
}
template <class T> HD void st_router(const NaiveBufs& a, long idx) {
  using d = DD<T>; const int r = (int)idx; const float* hr = a.h + (long)r * d::D;
  float sc[d::NE], sel[d::NE];
#pragma unroll
  for (int e = 0; e < d::NE; ++e) sc[e] = 0.f;
  for (int k = 0; k < d::D; ++k) { const float hv = hr[k];
#pragma unroll
    for (int e = 0; e < d::NE; ++e) sc[e] += hv * a.router_w[(long)k * d::NE + e]; }
#pragma unroll
  for (int e = 0; e < d::NE; ++e) { sc[e] = sigmoidf_(sc[e]); sel[e] = sc[e] + a.router_b[e]; }
  int bestg = 0; float bestgs = -1e30f;
#pragma unroll
  for (int g = 0; g < d::NG; ++g) { float m1 = -1e30f, m2 = -1e30f;
#pragma unroll
    for (int i = 0; i < d::EPG; ++i) { const float v = sel[g * d::EPG + i]; if (v > m1) { m2 = m1; m1 = v; } else if (v > m2) m2 = v; }
    const float gs = m1 + m2; if (gs > bestgs) { bestgs = gs; bestg = g; } }
  int i1 = -1, i2 = -1; float v1 = -1e30f, v2 = -1e30f, s1 = 0.f, s2 = 0.f;
#pragma unroll
  for (int e = 0; e < d::NE; ++e) { if (e / d::EPG == bestg) { const float v = sel[e];
      if (v > v1) { v2 = v1; i2 = i1; s2 = s1; v1 = v; i1 = e; s1 = sc[e]; } else if (v > v2) { v2 = v; i2 = e; s2 = sc[e]; } } }
  const float inv = 1.f / (s1 + s2);
  a.ridx[2 * r] = i1; a.ridx[2 * r + 1] = i2; a.rw[2 * r] = s1 * inv; a.rw[2 * r + 1] = s2 * inv;
}
template <class T> HD void st_moehid(const NaiveBufs& a, int l, long idx) {
  using d = DD<T>; const int j = (int)(idx % d::DE); const int k = (int)((idx / d::DE) % 2); const int r = (int)(idx / (2 * d::DE));
  const int e = a.ridx[2 * r + k]; const float* hr = a.h + (long)r * d::D;
  const float* wg = a.moe_w_gate + (((long)l * d::NE + e) * d::D) * d::DE + j; const float* wu = a.moe_w_up + (((long)l * d::NE + e) * d::D) * d::DE + j;
  float g = 0.f, u = 0.f;
  for (int i = 0; i < d::D; ++i) { const float hv = hr[i]; g += hv * wg[(long)i * d::DE]; u += hv * wu[(long)i * d::DE]; }
  a.hid[idx] = siluf_(g) * u;
}
template <class T> HD void st_moeout(const NaiveBufs& a, int l, int b, long idx) {
  using d = DD<T>; const int dd = (int)(idx % d::D), r = (int)(idx / d::D);
  float acc = 0.f;
  for (int k = 0; k < 2; ++k) { const int e = a.ridx[2 * r + k]; const float* hk = a.hid + ((long)r * 2 + k) * d::DE;
    const float* wd = a.moe_w_down + (((long)l * d::NE + e) * d::DE) * d::D + dd; float s = 0.f;
    for (int j = 0; j < d::DE; ++j) s += hk[j] * wd[(long)j * d::D];
    acc += a.rw[2 * r + k] * s; }
  const float g2 = a.mod[(long)(r < d::S ? b : d::B) * 6 * d::D + 5 * d::D + dd];
  float* xr = xrow_w<T>(a, b, r); xr[dd] += g2 * acc;
}
enum { L_MOD = 0, L_HID_S, L_HID_C, L_TAPS_S, L_TAPS_C, L_NRM_S, L_NRM_C, N_LSTAGES,
       P_RS1 = 16, P_NORM1, P_INPROJ, P_QKNORM, P_ATTN_L, P_ATTN_C, P_GLALA, P_GLASCAN, P_GLAOUT, P_HYC3, P_HYL0, P_HYL1,
       P_MRG_HY, P_MRG_GLA, P_MRG_ATT, P_OUT_L, P_OUT_C, P_RS2, P_NORM2, P_ROUTER, P_MOEHID, P_MOEOUT, P_END };
constexpr int ATT_NSPLIT = 4;

template <class T> HD long stage_items(int st, int l) {
  using d = DD<T>; const bool last = (l == d::DEPTH - 1);
  switch (st) {
    case L_MOD: return (long)(d::B + 1) * 6 * d::D;
    case L_HID_S: return (long)d::S * d::HF;
    case L_HID_C: return (long)d::C * d::HF;
    case L_TAPS_S: return 2L * 2 * d::S * d::HW;
    case L_TAPS_C: return 2L * 2 * d::C * d::HW;
    case L_NRM_S: case L_NRM_C: return 2L * d::HW;
    case P_RS1: case P_RS2: case P_ROUTER: return d::R;
    case P_NORM1: case P_NORM2: return (long)d::R * d::D;
    case P_INPROJ: return (long)(d::R / 4) * (d::NIN / 4);
    case P_QKNORM: return (long)d::R * (d::AH + d::AKV);
    case P_ATTN_L: return (long)d::S * d::AH * ATT_NSPLIT;
    case P_ATTN_C: return last ? 0 : (long)d::C * d::AH * ATT_NSPLIT;
    case P_GLALA: return (long)d::R * 2 * d::GKW;
    case P_GLASCAN: return 2L * d::GH * d::GDV;
    case P_GLAOUT: return (long)d::R * d::GH;
    case P_HYC3: return (long)d::R * 3 * d::HW;
    case P_HYL0: case P_HYL1: return (long)(d::R / 4) * d::HW;
    case P_MRG_HY: case P_MRG_GLA: case P_MRG_ATT: return (long)(d::R / 4) * (d::D / 4);
    case P_OUT_L: return (long)(d::S / 4) * (d::D / 4);
    case P_OUT_C: return last ? 0 : (long)(d::C / 4) * (d::D / 4);
    case P_MOEHID: return (long)d::R * 2 * d::DE;
    case P_MOEOUT: return (long)(last ? d::S : d::R) * d::D;
  }
  return 0;
}

template <class T, int ST> HD void stage_run(const NaiveBufs& a, int l, int b, long idx) {
  using d = DD<T>;
  if constexpr (ST == L_MOD) st_mod<T>(a, l, idx);
  else if constexpr (ST == L_HID_S) st_hyhid<T>(a, l, 0, idx);
  else if constexpr (ST == L_HID_C) st_hyhid<T>(a, l, 1, idx);
  else if constexpr (ST == L_TAPS_S) st_hytaps<T>(a, l, 0, idx);
  else if constexpr (ST == L_TAPS_C) st_hytaps<T>(a, l, 1, idx);
  else if constexpr (ST == L_NRM_S) st_hynorm<T>(a, 0, idx);
  else if constexpr (ST == L_NRM_C) st_hynorm<T>(a, 1, idx);
  else if constexpr (ST == P_RS1) st_rs<T>(a, l, b, 0, idx);
  else if constexpr (ST == P_RS2) st_rs<T>(a, l, b, 1, idx);
  else if constexpr (ST == P_NORM1) st_norm<T>(a, l, b, 0, idx);
  else if constexpr (ST == P_NORM2) st_norm<T>(a, l, b, 1, idx);
  else if constexpr (ST == P_INPROJ) { GemmArgs g{a.h, d::D, a.w_in + (long)l * d::D * d::NIN, d::NIN, a.proj, d::NIN, d::R, d::NIN, d::D, nullptr, 0, nullptr, nullptr, 0, 0}; st_gemm(g, idx); }
  else if constexpr (ST == P_QKNORM) st_qknorm<T>(a, l, idx);
  else if constexpr (ST == P_ATTN_L) st_attn<T, ATT_NSPLIT>(a, 0, d::S, idx);
  else if constexpr (ST == P_ATTN_C) st_attn<T, ATT_NSPLIT>(a, d::S, d::C, idx);
  else if constexpr (ST == P_GLALA) st_glala<T>(a, l, idx);
  else if constexpr (ST == P_GLASCAN) st_glascan<T>(a, idx);
  else if constexpr (ST == P_GLAOUT) st_glaout<T>(a, l, idx);
  else if constexpr (ST == P_HYC3) st_hyconv3<T>(a, l, idx);
  else if constexpr (ST == P_HYL0) st_hylong<T>(a, l, 0, idx);
  else if constexpr (ST == P_HYL1) st_hylong<T>(a, l, 1, idx);
  else if constexpr (ST == P_MRG_HY) { GemmArgs g{a.yhy, d::HW, a.w_br_hy + (long)l * d::HW * d::D, d::D, a.m, d::D, d::R, d::D, d::HW, a.proj + d::O_BR, d::NIN, nullptr, nullptr, 0, 0}; st_gemm(g, idx); }
  else if constexpr (ST == P_MRG_GLA) { GemmArgs g{a.ygla, d::GVW, a.w_br_gla + (long)l * d::GVW * d::D, d::D, a.m, d::D, d::R, d::D, d::GVW, a.proj + d::O_BR + d::D, d::NIN, nullptr, nullptr, 0, 1}; st_gemm(g, idx); }
  else if constexpr (ST == P_MRG_ATT) { GemmArgs g{a.yatt, d::AQW, a.w_br_att + (long)l * d::AQW * d::D, d::D, a.m, d::D, d::R, d::D, d::AQW, a.proj + d::O_BR + 2 * d::D, d::NIN, nullptr, nullptr, 0, 1}; st_gemm(g, idx); }
  else if constexpr (ST == P_OUT_L) { const float* res = (l == 0 ? a.x : (const float*)a.out) + (long)b * d::S * d::D;
    GemmArgs g{a.m, d::D, a.w_out + (long)l * d::D * d::D, d::D, a.out + (long)b * d::S * d::D, d::D, d::S, d::D, d::D, nullptr, 0, a.mod + (long)b * 6 * d::D + 2 * d::D, res, d::D, 0}; st_gemm(g, idx); }
  else if constexpr (ST == P_OUT_C) { const float* res = (l == 0 ? a.ctx : (const float*)a.xc) + (long)b * d::C * d::D;
    GemmArgs g{a.m + (long)d::S * d::D, d::D, a.w_out + (long)l * d::D * d::D, d::D, a.xc + (long)b * d::C * d::D, d::D, d::C, d::D, d::D, nullptr, 0, a.mod + (long)d::B * 6 * d::D + 2 * d::D, res, d::D, 0}; st_gemm(g, idx); }
  else if constexpr (ST == P_ROUTER) st_router<T>(a, idx);
  else if constexpr (ST == P_MOEHID) st_moehid<T>(a, l, idx);
  else if constexpr (ST == P_MOEOUT) st_moeout<T>(a, l, b, idx);
}

template <class T> inline size_t carve(NaiveBufs& a, float* ws) {
  using d = DD<T>; size_t o = 0; auto take = [&](size_t n) { float* p = ws ? ws + o : nullptr; o += (n + 63) & ~(size_t)63; return p; };
  a.mod = take((size_t)(d::B + 1) * 6 * d::D);
  a.hid2S = take((size_t)d::S * d::HF); a.hid2C = take((size_t)d::C * d::HF);
  a.tapsS = take((size_t)2 * 2 * d::S * d::HW); a.tapsC = take((size_t)2 * 2 * d::C * d::HW);
  a.nrmS = take(2 * d::HW); a.nrmC = take(2 * d::HW);
  a.rs = take(d::R); a.h = take((size_t)d::R * d::D); a.proj = take((size_t)d::R * d::NIN);
  a.qn = take((size_t)d::R * d::AQW); a.kn = take((size_t)d::R * d::AKVW); a.yatt = take((size_t)d::R * d::AQW);
  a.laf = take((size_t)d::R * d::GKW); a.lab = take((size_t)d::R * d::GKW);
  a.of = take((size_t)d::R * d::GVW); a.ob = take((size_t)d::R * d::GVW); a.ygla = take((size_t)d::R * d::GVW);
  a.uc = take((size_t)d::R * 3 * d::HW); a.z1 = take((size_t)d::R * d::HW); a.yhy = take((size_t)d::R * d::HW);
  a.m = take((size_t)d::R * d::D); a.ridx = (int*)take((size_t)d::R * 2); a.rw = take((size_t)d::R * 2);
  a.hid = take((size_t)d::R * 2 * d::DE); a.xc = take((size_t)d::B * d::C * d::D);
  return o;
}
template <class T> inline void set_inputs(NaiveBufs& a, const float* const* in) {
  int i = 0;
  a.x = in[i++]; a.c = in[i++]; a.ctx = in[i++]; a.c_ctx = in[i++]; a.w_mod = in[i++]; a.b_mod = in[i++]; a.norm1_g = in[i++]; a.norm2_g = in[i++];
  a.w_in = in[i++]; a.q_norm_g = in[i++]; a.k_norm_g = in[i++]; a.gla_wa2 = in[i++]; a.gla_ba = in[i++]; a.gla_norm_g = in[i++];
  a.hy_conv_w = in[i++]; a.hy_conv_b = in[i++]; a.hy_pos_w1 = in[i++]; a.hy_pos_b1 = in[i++]; a.hy_sin_freq = in[i++]; a.hy_pos_w2 = in[i++];
  a.hy_pos_b2 = in[i++]; a.hy_pos_w3 = in[i++]; a.hy_decay = in[i++]; a.hy_skip = in[i++]; a.w_br_hy = in[i++]; a.w_br_gla = in[i++];
  a.w_br_att = in[i++]; a.w_out = in[i++]; a.router_w = in[i++]; a.router_b = in[i++]; a.moe_w_gate = in[i++]; a.moe_w_up = in[i++]; a.moe_w_down = in[i++];
}

#define LSTAGES(X) X(L_MOD) X(L_HID_S) X(L_HID_C) X(L_TAPS_S) X(L_TAPS_C) X(L_NRM_S) X(L_NRM_C)
#define PSTAGES(X) X(P_RS1) X(P_NORM1) X(P_INPROJ) X(P_QKNORM) X(P_ATTN_L) X(P_ATTN_C) X(P_GLALA) X(P_GLASCAN) X(P_GLAOUT) X(P_HYC3) X(P_HYL0) X(P_HYL1) \
  X(P_MRG_HY) X(P_MRG_GLA) X(P_MRG_ATT) X(P_OUT_L) X(P_OUT_C) X(P_RS2) X(P_NORM2) X(P_ROUTER) X(P_MOEHID) X(P_MOEOUT)
using TD = FullDims;
constexpr size_t BAR_BYTES = 16384;
__global__ void __launch_bounds__(256, 2) mega_kernel(NaiveBufs a, unsigned* bar) {
  using d = DD<TD>;
  __shared__ uint4 xb_words;
  if (threadIdx.x == 0) xb_words = make_uint4(0u, 0u, 0u, 0u);
  __syncthreads();
  XcdBarrier xb = xcd_barrier_post(bar, (volatile LAS unsigned*)&xb_words);
  const long gt = (long)blockIdx.x * 256 + threadIdx.x, gs = (long)gridDim.x * 256;
  for (int l = 0; l < d::DEPTH; ++l) {
#define X(ST) { const long n = stage_items<TD>(ST, l); for (long i = gt; i < n; i += gs) stage_run<TD, ST>(a, l, 0, i); xcd_barrier(xb); }
    LSTAGES(X)
#undef X
    for (int b = 0; b < d::B; ++b) {
#define X(ST) { const long n = stage_items<TD>(ST, l); for (long i = gt; i < n; i += gs) stage_run<TD, ST>(a, l, b, i); xcd_barrier(xb); }
      PSTAGES(X)
#undef X
    }
  }
}
extern "C" void kernel_launch(void* const* d_in, const int* in_sizes, int n_in, void* d_out, int out_size, void* d_ws, size_t ws_size, hipStream_t stream) {
  static int grid = 0;
  if (!grid) {
    int dev = 0, cus = 0, per_cu = 0;
    hipGetDevice(&dev); hipDeviceGetAttribute(&cus, hipDeviceAttributeMultiprocessorCount, dev);
    hipOccupancyMaxActiveBlocksPerMultiprocessor(&per_cu, mega_kernel, 256, 0);
    if (per_cu > 2) per_cu = 2; if (per_cu < 1) per_cu = 1;
    grid = cus * per_cu;
  }
  NaiveBufs a{}; const float* ptrs[33]; for (int i = 0; i < 33; ++i) ptrs[i] = (const float*)d_in[i];
  set_inputs<TD>(a, ptrs); carve<TD>(a, (float*)((char*)d_ws + BAR_BYTES)); a.out = (float*)d_out;
  unsigned* bar = (unsigned*)d_ws;
  hipMemsetAsync(bar, 0, XCD_BAR_WORDS * sizeof(unsigned), stream);
  hipLaunchKernelGGL(mega_kernel, dim3(grid), dim3(256), 0, stream, a, bar);
}
```

```cpp
#include <hip/hip_runtime.h>
#include <cstddef>
#include <cstdio>
#include <cstdint>
#include <hip/hip_bf16.h>
#include <hip/hip_runtime.h>
namespace pg8 {
#define PG8_LAS __attribute__((address_space(3)))
typedef unsigned short bf16_t;
typedef short bf16x8 __attribute__((ext_vector_type(8)));
typedef float f32x4 __attribute__((ext_vector_type(4)));
typedef unsigned u32x4 __attribute__((ext_vector_type(4)));
constexpr int BM = 256, BK = 64, HALF = 128, HTB = HALF * BK * 2  , STAGE_BYTES = 8 * HTB, NXCD = 8, WGM = 8;

__host__ __device__ __forceinline__ int lds_byte(int r, int c) { const int st = (r >> 4) * 2 + (c >> 5), rr = r & 15, cc = c & 31, ob = rr * 64 + cc * 2; return st * 1024 + (ob ^ (((ob >> 9) & 1) << 5)); }
__host__ __device__ __forceinline__ void stage_rc(int b, int& R, int& C) { const int st = b / 1024, sb = b % 1024, swz = sb ^ (((sb >> 9) & 1) << 5); R = (st >> 1) * 16 + swz / 64; C = (st & 1) * 32 + (swz % 64) / 2; }
__host__ __device__ __forceinline__ int perm32(int rho) { const int n = rho >> 4, i = rho & 15; return 8 * (i >> 2) + 4 * n + (i & 3); }

struct Unit { int pm, pn, acol; };
struct Gemm { const bf16_t* A; const bf16_t* Bt; int M, N, K; int lda; };

struct StaticOrder {
    int nM, nN, nwg, G, c;
    __host__ __device__ void init(int M, int N, int G_, int c_) { nM = M / BM; nN = N / BM; nwg = nM * nN; G = G_; c = c_; }
    __host__ __device__ bool next(int i, Unit& u) const {
        const long L = (long)i * G + c; if (L >= nwg) return false;
        int wgid = (int)L; { const int q = nwg / NXCD, r = nwg % NXCD, xcd = wgid % NXCD, off = wgid / NXCD; wgid = (xcd < r ? xcd * (q + 1) : r * (q + 1) + (xcd - r) * q) + off; }
        const int nig = WGM * nN, gid = wgid / nig, fm = gid * WGM, gsz = (nM - fm) < WGM ? (nM - fm) : WGM;
        u.pm = fm + ((wgid % nig) % gsz); u.pn = (wgid % nig) / gsz; u.acol = 0; return true;
    }
    __device__ __forceinline__ void a_ready(const Unit&) const {}
    __device__ __forceinline__ void done(const Unit&) const {}
};
__device__ __forceinline__ unsigned cvt_pk_bf16(float lo, float hi) { unsigned r; asm volatile("v_cvt_pk_bf16_f32 %0, %1, %2" : "=v"(r) : "v"(lo), "v"(hi)); return r; }
typedef float f32x2 __attribute__((ext_vector_type(2)));
template <class Epi, class Sched, bool STAMP = false>
__device__ __forceinline__ void gemm_phase(PG8_LAS unsigned char* lds, const Gemm g, const Sched& S, const Epi& E, unsigned long long* stamps) {
    int tid = threadIdx.x; asm volatile("" : "+v"(tid)); const int wid = __builtin_amdgcn_readfirstlane(tid >> 6), lane = tid & 63, wr = wid >> 2, wc = wid & 3, fr = lane & 15, fq = lane >> 4;
    const int K = g.K, nt = K / BK, LDA = g.lda ? g.lda : g.K;
    int ts_lo = 0, ts_hi = 0, nts = 0; const unsigned long long rt_entry = STAMP ? (unsigned long long)wall_clock64() : 0ull;
#define PG8_STAMP() do { if (STAMP && wid == 0 && nts < 64) { const unsigned long long _c = (unsigned long long)clock64(); \
        ts_lo = (lane == nts) ? (int)(unsigned)_c : ts_lo; ts_hi = (lane == nts) ? (int)(unsigned)(_c >> 32) : ts_hi; ++nts; } } while (0)
    PG8_STAMP();
    unsigned voffA[2], voffB[2];
#pragma unroll
    for (int i = 0; i < 2; ++i) { int R, C; stage_rc(tid * 16 + i * 8192, R, C); const int Rb = Epi::PERM ? ((R & ~31) + perm32(R & 31)) : R;
        voffA[i] = (unsigned)(R * LDA + C) * 2u; voffB[i] = (unsigned)(Rb * K + C) * 2u; }
    const size_t kstep = (size_t)(BK * 2);
    const size_t hstep = (size_t)HALF * K * 2;
    const size_t tstep = 2 * hstep;
    const size_t hstepA = (size_t)HALF * LDA * 2, tstepA = 2 * hstepA;
    const unsigned ldsw = (unsigned)wid * 1024u;
    const int aoff = lds_byte(wr * 64 + fr, fq * 8), boff = lds_byte(wc * 32 + fr, fq * 8);
#define PG8_SA(b, h) (((b) * 2 + (h)) * HTB)
#define PG8_SB(b, h) ((4 + (b) * 2 + (h)) * HTB)
#define PG8_STAGE(bufoff, gbase, voff) do { _Pragma("unroll") for (int _i = 0; _i < 2; ++_i) \
        __builtin_amdgcn_global_load_lds((const unsigned*)((const char*)(gbase) + (voff)[_i]), (PG8_LAS unsigned*)(lds + (bufoff) + ldsw + _i * 8192), 16, 0, 0); } while (0)
#define PG8_LDA(dst, b, h) do { _Pragma("unroll") for (int m = 0; m < 4; ++m) _Pragma("unroll") for (int k = 0; k < 2; ++k) dst[m][k] = *(const PG8_LAS bf16x8*)(lds + PG8_SA(b, h) + aoff + m * 2048 + k * 1024); } while (0)
#define PG8_LDB(dst, b, h) do { _Pragma("unroll") for (int n = 0; n < 2; ++n) _Pragma("unroll") for (int k = 0; k < 2; ++k) dst[n][k] = *(const PG8_LAS bf16x8*)(lds + PG8_SB(b, h) + boff + n * 2048 + k * 1024); } while (0)
#define PG8_MMA(ai, bj, At, Bt) do { __builtin_amdgcn_s_setprio(1); _Pragma("unroll") for (int m = 0; m < 4; ++m) _Pragma("unroll") for (int n = 0; n < 2; ++n) _Pragma("unroll") for (int k = 0; k < 2; ++k) \
        acc[ai][bj][m][n] = __builtin_amdgcn_mfma_f32_16x16x32_bf16(Bt[n][k], At[m][k], acc[ai][bj][m][n], 0, 0, 0); __builtin_amdgcn_s_setprio(0); } while (0)
#define PG8_WAIT_V(n) asm volatile("s_waitcnt vmcnt(" #n ")" ::: "memory")
#define PG8_WAIT_L(n) asm volatile("s_waitcnt lgkmcnt(" #n ")" ::: "memory")
#define PG8_BAR __builtin_amdgcn_s_barrier()
#define PG8_SCHED __builtin_amdgcn_sched_barrier(0)
    Unit cur, nxt; int ui = 0;
    if (!S.next(0, cur)) return;
    f32x4 acc[2][2][4][2];
#pragma unroll
    for (int a = 0; a < 2; ++a)
#pragma unroll
        for (int b = 0; b < 2; ++b)
#pragma unroll
            for (int m = 0; m < 4; ++m)
#pragma unroll
                for (int n = 0; n < 2; ++n) acc[a][b][m][n] = (f32x4){0.f, 0.f, 0.f, 0.f};
    bf16x8 At[4][2], B0[2][2], B1[2][2];
    const char* cA = (const char*)g.A + (size_t)cur.pm * tstepA + (size_t)cur.acol * 2; const char* cB = (const char*)g.Bt + (size_t)cur.pn * tstep;
    S.a_ready(cur);
    PG8_STAGE(PG8_SB(0, 0), cB, voffB); PG8_STAGE(PG8_SA(0, 0), cA, voffA); PG8_STAGE(PG8_SB(0, 1), cB + hstep, voffB); PG8_STAGE(PG8_SA(0, 1), cA + hstepA, voffA);
    if (wr == 1) PG8_BAR;
    PG8_WAIT_V(4); PG8_BAR;
    PG8_STAGE(PG8_SB(1, 0), cB + kstep, voffB); PG8_STAGE(PG8_SA(1, 0), cA + kstep, voffA); PG8_STAGE(PG8_SB(1, 1), cB + hstep + kstep, voffB);
    PG8_WAIT_V(6); PG8_BAR;
    PG8_STAMP();
    for (;;) {
        const bool has_next = S.next(ui + 1, nxt);
        const char* nA = has_next ? (const char*)g.A + (size_t)nxt.pm * tstepA + (size_t)nxt.acol * 2 : cA; const char* nB = has_next ? (const char*)g.Bt + (size_t)nxt.pn * tstep : cB;
        for (int t = 0; t < nt; t += 2) {
            const bool last = (t == nt - 2);
            const char* a1 = cA + (size_t)(t + 1) * kstep;
            const char* a2 = last ? nA : cA + (size_t)(t + 2) * kstep; const char* b2 = last ? nB : cB + (size_t)(t + 2) * kstep;
            const char* a3 = a2 + kstep; const char* b3 = b2 + kstep;
            if (last && has_next) S.a_ready(nxt);
            PG8_LDB(B0, 0, 0); PG8_SCHED; PG8_LDA(At, 0, 0); PG8_STAGE(PG8_SA(1, 1), a1 + hstepA, voffA);
            PG8_WAIT_L(8); PG8_BAR; PG8_WAIT_L(0); PG8_MMA(0, 0, At, B0); PG8_BAR; PG8_SCHED;
            PG8_LDB(B1, 0, 1); PG8_STAGE(PG8_SB(0, 0), b2, voffB);
            PG8_BAR; PG8_WAIT_L(0); PG8_MMA(0, 1, At, B1); PG8_BAR;
            PG8_LDA(At, 0, 1); PG8_STAGE(PG8_SA(0, 0), a2, voffA);
            PG8_BAR; PG8_WAIT_L(0); PG8_MMA(1, 0, At, B0); PG8_BAR; PG8_SCHED;
            PG8_STAGE(PG8_SB(0, 1), b2 + hstep, voffB);
            PG8_WAIT_V(6); PG8_BAR; PG8_MMA(1, 1, At, B1); PG8_BAR;
            PG8_LDB(B0, 1, 0); PG8_SCHED; PG8_LDA(At, 1, 0); PG8_STAGE(PG8_SA(0, 1), a2 + hstepA, voffA);
            PG8_WAIT_L(8); PG8_BAR; PG8_WAIT_L(0); PG8_MMA(0, 0, At, B0); PG8_BAR; PG8_SCHED;
            PG8_LDB(B1, 1, 1); PG8_STAGE(PG8_SB(1, 0), b3, voffB);
            PG8_BAR; PG8_WAIT_L(0); PG8_MMA(0, 1, At, B1); PG8_BAR;
            PG8_LDA(At, 1, 1); PG8_STAGE(PG8_SA(1, 0), a3, voffA);
            PG8_BAR; PG8_WAIT_L(0); PG8_MMA(1, 0, At, B0); PG8_BAR; PG8_SCHED;
            PG8_STAGE(PG8_SB(1, 1), b3 + hstep, voffB);
            PG8_WAIT_V(6); PG8_BAR; PG8_MMA(1, 1, At, B1); PG8_BAR;
        }
        PG8_STAMP();
        if constexpr (!Epi::AFTER_DRAIN) { E(acc, cur, wr, wc, fr, fq); S.done(cur); }
        PG8_STAMP();
        if (!has_next) break;
#pragma unroll
        for (int a = 0; a < 2; ++a)
#pragma unroll
            for (int b = 0; b < 2; ++b)
#pragma unroll
                for (int m = 0; m < 4; ++m)
#pragma unroll
                    for (int n = 0; n < 2; ++n) acc[a][b][m][n] = (f32x4){0.f, 0.f, 0.f, 0.f};
        cur = nxt; cA = nA; cB = nB; ++ui;
    }
    PG8_WAIT_V(0);
    if (wr == 0) PG8_BAR;
    PG8_BAR;
    if constexpr (Epi::AFTER_DRAIN) { E.fused(acc, cur, wr, wc, fr, fq, lds, wid, lane); S.done(cur); }
    PG8_STAMP();
    if (STAMP && wid == 0) { stamps[lane] = lane < nts ? (((unsigned long long)(unsigned)ts_hi << 32) | (unsigned)ts_lo) : 0ull;
        if (lane == 62) stamps[62] = rt_entry; if (lane == 63) stamps[63] = (unsigned long long)wall_clock64(); }
#undef PG8_STAMP
#undef PG8_SA
#undef PG8_SB
#undef PG8_STAGE
#undef PG8_LDA
#undef PG8_LDB
#undef PG8_MMA
#undef PG8_WAIT_V
#undef PG8_WAIT_L
#undef PG8_BAR
#undef PG8_SCHED
}
}

#define LAS __attribute__((address_space(3)))
typedef unsigned short bf16_t;
constexpr int NWAVES = 8, NTHREADS = 512;
constexpr int LDS_BYTES = 147456;
constexpr int RING_OFF = 0;
constexpr int MISC_OFF = 131072;
constexpr int NINP = 7936;

__device__ __forceinline__ unsigned f2bf(float f) { unsigned u = __builtin_bit_cast(unsigned, f); return (u + 0x7fffu + ((u >> 16) & 1u)) >> 16; }
__device__ __forceinline__ unsigned pk2(float lo, float hi) { return f2bf(lo) | (f2bf(hi) << 16); }
__device__ __forceinline__ float bf2f(bf16_t b) { return __builtin_bit_cast(float, ((unsigned)b) << 16); }
typedef unsigned v4u __attribute__((ext_vector_type(4)));

__device__ __forceinline__ void transpose_item(const float* W, int K, int N, bf16_t* WT, int row_off, LAS float* scr, int item, int lane) {
  const int nblk = N / 32, kb = item / nblk, nb = item % nblk, k0 = 64 * kb, n0 = 32 * nb;
  float wreg[32];
#pragma unroll
  for (int i = 0; i < 32; ++i) { const int kk = 2 * i + (lane >> 5); wreg[i] = W[(size_t)(k0 + kk) * N + n0 + (lane & 31)]; }
#pragma unroll
  for (int i = 0; i < 32; ++i) { const int kk = 2 * i + (lane >> 5); scr[kk * 33 + (lane & 31)] = wreg[i]; }
  asm volatile("s_waitcnt lgkmcnt(0)" ::: "memory");
  const int c = lane & 7;
#pragma unroll
  for (int j = 0; j < 4; ++j) { const int n = (lane >> 3) + 8 * j; const LAS float* s = scr + (8 * c) * 33 + n;
    v4u o; o.x = pk2(s[0 * 33], s[1 * 33]); o.y = pk2(s[2 * 33], s[3 * 33]); o.z = pk2(s[4 * 33], s[5 * 33]); o.w = pk2(s[6 * 33], s[7 * 33]);
    *(v4u*)(WT + (size_t)(row_off + n0 + n) * K + k0 + 8 * c) = o; }
  asm volatile("s_waitcnt lgkmcnt(0)" ::: "memory");
}

struct EpiProjF32 {
  static constexpr bool PERM = false, AFTER_DRAIN = false;
  float* C; int ldc; int ncols;
  __device__ __forceinline__ void operator()(const pg8::f32x4 (&acc)[2][2][4][2], const pg8::Unit& u, int wr, int wc, int fr, int fq) const {
    const int row0 = u.pm * 256 + wr * 64 + fr, col0 = u.pn * 256 + wc * 32 + 4 * fq;
#pragma unroll
    for (int ai = 0; ai < 2; ++ai)
#pragma unroll
      for (int m = 0; m < 4; ++m) { float* rowp = C + (size_t)(row0 + ai * 128 + m * 16) * ldc + col0;
#pragma unroll
        for (int bj = 0; bj < 2; ++bj)
#pragma unroll
          for (int n = 0; n < 2; ++n) if (col0 + bj * 128 + n * 16 < ncols) *(pg8::f32x4*)(rowp + bj * 128 + n * 16) = acc[ai][bj][m][n]; }
  }
};

__device__ __forceinline__ float fsigmoid(float x) { return 1.f / (1.f + __expf(-x)); }
template <bool ACCUM> struct EpiMerge {
  static constexpr bool PERM = true, AFTER_DRAIN = false;
  const float* gate; int ldg; bf16_t* M; int ldm;
  __device__ __forceinline__ void operator()(const pg8::f32x4 (&acc)[2][2][4][2], const pg8::Unit& u, int wr, int wc, int fr, int fq) const {
    const int row0 = u.pm * 256 + wr * 64 + fr, col0 = u.pn * 256 + wc * 32 + 8 * fq;
#pragma unroll
    for (int ai = 0; ai < 2; ++ai)
#pragma unroll
      for (int m = 0; m < 4; ++m) { const size_t r = (size_t)(row0 + ai * 128 + m * 16);
#pragma unroll
        for (int bj = 0; bj < 2; ++bj) { const int c = col0 + bj * 128;
          const pg8::f32x4 g0 = *(const pg8::f32x4*)(gate + r * ldg + c), g1 = *(const pg8::f32x4*)(gate + r * ldg + c + 4);
          pg8::f32x4 v0 = acc[ai][bj][m][0], v1 = acc[ai][bj][m][1];
#pragma unroll
          for (int e = 0; e < 4; ++e) { v0[e] *= fsigmoid(g0[e]); v1[e] *= fsigmoid(g1[e]); }
          v4u* dst = (v4u*)(M + r * ldm + c);
          if (ACCUM) { const v4u o = *dst; v0[0] += bf2f(o.x & 0xffff); v0[1] += bf2f(o.x >> 16); v0[2] += bf2f(o.y & 0xffff); v0[3] += bf2f(o.y >> 16);
            v1[0] += bf2f(o.z & 0xffff); v1[1] += bf2f(o.z >> 16); v1[2] += bf2f(o.w & 0xffff); v1[3] += bf2f(o.w >> 16); }
          v4u o2; o2.x = pk2(v0[0], v0[1]); o2.y = pk2(v0[2], v0[3]); o2.z = pk2(v1[0], v1[1]); o2.w = pk2(v1[2], v1[3]); *dst = o2; } }
  }
};
struct EpiOut {
  static constexpr bool PERM = false, AFTER_DRAIN = false;
  const float* resL; float* outL; const float* gL;
  const float* resC; float* outC; const float* gC;
  __device__ __forceinline__ void operator()(const pg8::f32x4 (&acc)[2][2][4][2], const pg8::Unit& u, int wr, int wc, int fr, int fq) const {
    const bool isc = u.pm == 16; if (isc && outC == nullptr) return;
    const float* res = isc ? resC : resL; float* out = isc ? outC : outL; const float* gv = isc ? gC : gL;
    const int row0 = (isc ? 0 : u.pm * 256) + wr * 64 + fr, col0 = u.pn * 256 + wc * 32 + 4 * fq;
    pg8::f32x4 gg[2][2];
#pragma unroll
    for (int bj = 0; bj < 2; ++bj)
#pragma unroll
      for (int n = 0; n < 2; ++n) gg[bj][n] = *(const pg8::f32x4*)(gv + col0 + bj * 128 + n * 16);
#pragma unroll
    for (int ai = 0; ai < 2; ++ai)
#pragma unroll
      for (int m = 0; m < 4; ++m) { const size_t ro = (size_t)(row0 + ai * 128 + m * 16) * 1024 + col0;
#pragma unroll
        for (int bj = 0; bj < 2; ++bj)
#pragma unroll
          for (int n = 0; n < 2; ++n) { const pg8::f32x4 rv = *(const pg8::f32x4*)(res + ro + bj * 128 + n * 16); *(pg8::f32x4*)(out + ro + bj * 128 + n * 16) = rv + gg[bj][n] * acc[ai][bj][m][n]; } }
  }
};
namespace att {
using bf16 = __hip_bfloat16;
constexpr int D = 128, NW = 8, QBLK = 32, KVBLK = 64; constexpr float SCALE = 0.088388347648318440f; constexpr float THR = 8.f; constexpr int SDEPTH = 2;
constexpr size_t SHM_V = KVBLK * D * 2, SHM_K = KVBLK * D * 2, SHM_ATTN = 2 * SHM_V + 2 * SHM_K + NW * 64 * 4;
using bf16x8 = __attribute__((ext_vector_type(8))) short;
using s16x4  = __attribute__((ext_vector_type(4))) short;
using f32x16 = __attribute__((ext_vector_type(16))) float;
using f32x8  = __attribute__((ext_vector_type(8))) float;
using u32x4  = __attribute__((ext_vector_type(4))) unsigned;
#define KSWZ(row, colB) ((row) * 256 + ((colB) ^ (((row) & 7) << 4)))
#define SBAR() __builtin_amdgcn_sched_barrier(0)
__device__ __forceinline__ int crow(int r, int hi) { return (r & 3) + 8 * (r >> 2) + 4 * hi; }
__device__ __forceinline__ unsigned cvtpk(float lo, float hi) {
  unsigned r; asm volatile("v_cvt_pk_bf16_f32 %0, %1, %2" : "=v"(r) : "v"(lo), "v"(hi)); return r;
}
template <typename TIn> struct Stage;
template <> struct Stage<bf16>  { using T = bf16x8;
  __device__ static __forceinline__ T ld8(const bf16* p) { return *reinterpret_cast<const bf16x8*>(p); }
  __device__ static __forceinline__ bf16x8 tobf(T x) { return x; } };
template <> struct Stage<float> { using T = f32x8;
  __device__ static __forceinline__ T ld8(const float* p) { return *reinterpret_cast<const f32x8*>(p); }
  __device__ static __forceinline__ bf16x8 tobf(T x) {
    u32x4 w = {cvtpk(x[0], x[1]), cvtpk(x[2], x[3]), cvtpk(x[4], x[5]), cvtpk(x[6], x[7])}; return *reinterpret_cast<bf16x8*>(&w); } };

__device__ __forceinline__ void partialSM(f32x16& p0, f32x16& p1, float& m_reg, float& mn, float& alpha) {
  constexpr float C = SCALE * 1.4426950408889634f;
  float pmax = p0[0]; for (int r = 1; r < 16; ++r) pmax = fmaxf(pmax, p0[r]); for (int r = 0; r < 16; ++r) pmax = fmaxf(pmax, p1[r]);
  { auto rr = __builtin_amdgcn_permlane32_swap(__float_as_uint(pmax), __float_as_uint(pmax), false, false);
    pmax = fmaxf(__uint_as_float(rr[0]), __uint_as_float(rr[1])); }
  if (__builtin_expect(__all(pmax - m_reg <= THR / SCALE), 1)) { mn = m_reg; alpha = 1.f; }
  else { mn = fmaxf(m_reg, pmax); alpha = __builtin_amdgcn_exp2f((m_reg - mn) * C); m_reg = mn; }
  float mnC = -mn * C;
  for (int r = 0; r < 16; ++r) p0[r] = fmaf(p0[r], C, mnC); for (int r = 0; r < 16; ++r) p1[r] = fmaf(p1[r], C, mnC);
  for (int r = 0; r < 16; ++r) p0[r] = __builtin_amdgcn_exp2f(p0[r]);
}
__device__ __forceinline__ void finishSM(f32x16& p0, f32x16& p1, float alpha, float& l_reg, bf16x8& pa0, bf16x8& pa1, bf16x8& pa2, bf16x8& pa3) {
  for (int r = 0; r < 16; ++r) p1[r] = __builtin_amdgcn_exp2f(p1[r]);
  float ps = 0; for (int r = 0; r < 16; ++r) ps += p0[r]; for (int r = 0; r < 16; ++r) ps += p1[r];
  { auto rr = __builtin_amdgcn_permlane32_swap(__float_as_uint(ps), __float_as_uint(ps), false, false);
    ps = __uint_as_float(rr[0]) + __uint_as_float(rr[1]); }
  l_reg = l_reg * alpha + ps;
#define PK4(P, BASE, OUT) do { unsigned a0 = cvtpk(P[BASE + 0], P[BASE + 1]), a1 = cvtpk(P[BASE + 2], P[BASE + 3]);   \
    unsigned b0 = cvtpk(P[BASE + 4], P[BASE + 5]), b1 = cvtpk(P[BASE + 6], P[BASE + 7]);                              \
    auto r0 = __builtin_amdgcn_permlane32_swap(a0, b0, false, false); auto r1 = __builtin_amdgcn_permlane32_swap(a1, b1, false, false); \
    u32x4 w = {r0[0], r1[0], r0[1], r1[1]}; OUT = *reinterpret_cast<bf16x8*>(&w); } while (0)
  PK4(p0, 0, pa0); PK4(p0, 8, pa1); PK4(p1, 0, pa2); PK4(p1, 8, pa3);
#undef PK4
}
__device__ __forceinline__ void qkt(f32x16& p0, f32x16& p1, const bf16* Ks, const bf16x8* qr, int r32, int hi) {
  p0 = f32x16{}; p1 = f32x16{};
  for (int d0 = 0; d0 < 8; ++d0) { int cb = (d0 * 16 + hi * 8) * 2;
    bf16x8 b0 = *reinterpret_cast<const bf16x8*>((const char*)Ks + KSWZ(r32, cb));
    bf16x8 b1 = *reinterpret_cast<const bf16x8*>((const char*)Ks + KSWZ(32 + r32, cb));
    p0 = __builtin_amdgcn_mfma_f32_32x32x16_bf16(b0, qr[d0], p0, 0, 0, 0);
    p1 = __builtin_amdgcn_mfma_f32_32x32x16_bf16(b1, qr[d0], p1, 0, 0, 0); }
}
__device__ __forceinline__ int v_st(int k, int c) { const int kk = (k & ~0xC) | ((k & 4) << 1) | ((k & 8) >> 1); return ((kk >> 3) * 4 + (c >> 5)) * 512 + ((kk & 7) * 32 + (c & 31)) * 2; }
__device__ __forceinline__ int v_rd_base(int lane) { return ((lane & 3) << 3) | (((lane >> 2) & 3) << 6) | (((lane >> 4) & 1) << 5) | (((lane >> 5) & 1) << 8); }
constexpr int v_rd_off(int d0, int ks, int half) { return d0 * 512 + ks * 4096 + half * 2048; }
template <int OFF> __device__ __forceinline__ s16x4 tr_read(int vb) {
  s16x4 r; asm volatile("ds_read_b64_tr_b16 %0, %1 offset:%2" : "=&v"(r) : "v"(vb), "i"(OFF) : "memory"); return r;
}
template <int D0> __device__ __forceinline__ void pv_one(f32x16& od, int vb, bf16x8 pa0, bf16x8 pa1, bf16x8 pa2, bf16x8 pa3) {
  const s16x4 l0 = tr_read<v_rd_off(D0, 0, 0)>(vb), h0 = tr_read<v_rd_off(D0, 0, 1)>(vb), l1 = tr_read<v_rd_off(D0, 1, 0)>(vb), h1 = tr_read<v_rd_off(D0, 1, 1)>(vb);
  const s16x4 l2 = tr_read<v_rd_off(D0, 2, 0)>(vb), h2 = tr_read<v_rd_off(D0, 2, 1)>(vb), l3 = tr_read<v_rd_off(D0, 3, 0)>(vb), h3 = tr_read<v_rd_off(D0, 3, 1)>(vb);
  asm volatile("s_waitcnt lgkmcnt(0)" ::: "memory"); SBAR();
#define PK(L, H) (bf16x8){L[0], L[1], L[2], L[3], H[0], H[1], H[2], H[3]}
  od = __builtin_amdgcn_mfma_f32_32x32x16_bf16(pa0, PK(l0, h0), od, 0, 0, 0);
  od = __builtin_amdgcn_mfma_f32_32x32x16_bf16(pa1, PK(l1, h1), od, 0, 0, 0);
  od = __builtin_amdgcn_mfma_f32_32x32x16_bf16(pa2, PK(l2, h2), od, 0, 0, 0);
  od = __builtin_amdgcn_mfma_f32_32x32x16_bf16(pa3, PK(l3, h3), od, 0, 0, 0);
#undef PK
}
__device__ __forceinline__ void pv_d0(f32x16* o, int vb, bf16x8 pa0, bf16x8 pa1, bf16x8 pa2, bf16x8 pa3) {
  pv_one<0>(o[0], vb, pa0, pa1, pa2, pa3); pv_one<1>(o[1], vb, pa0, pa1, pa2, pa3); pv_one<2>(o[2], vb, pa0, pa1, pa2, pa3); pv_one<3>(o[3], vb, pa0, pa1, pa2, pa3);
}

template <typename TQ, int LDQ, int LDK, int LDO, bool OBF16>
__device__ __forceinline__ void attn_dense_body(const TQ* Qb, const bf16* Kh, const bf16* Vh,
                                                void* Obv, int seq, char* lds) {
  using St = Stage<bf16>; using SQ = Stage<TQ>;
  int tid = threadIdx.x; asm volatile("" : "+v"(tid)); const int wid = tid >> 6, lane = tid & 63, r32 = lane & 31, hi = lane >> 5;
  bf16* V_lds = (bf16*)lds; bf16* K_lds = (bf16*)(lds + 2 * SHM_V);
  float* ws = (float*)(lds + 2 * SHM_V + 2 * SHM_K) + wid * 64; float* li_l = ws; float* al_l = ws + 32;
  float m_reg = -1e30f, l_reg = 0; f32x16 o[4] = {}; bf16x8 qr[8];
  const TQ* Qw = Qb + (long)(wid * QBLK + r32) * LDQ + hi * 8;
#pragma unroll
  for (int d0 = 0; d0 < 8; ++d0) qr[d0] = SQ::tobf(SQ::ld8(Qw + d0 * 16));
  const int sr = tid >> 4, sc = (tid & 15) * 8, vst0 = v_st(sr, sc), vst1 = v_st(32 + sr, sc);
  const int vb0 = (int)(uintptr_t)V_lds + v_rd_base(lane);
  struct { typename St::T vs0, vs1, ks0, ks1; } sr_[SDEPTH];
#define SLOAD(i, k0) do { sr_[i].vs0 = St::ld8(&Vh[(long)((k0) + sr) * LDK + sc]); sr_[i].vs1 = St::ld8(&Vh[(long)((k0) + 32 + sr) * LDK + sc]); \
    sr_[i].ks0 = St::ld8(&Kh[(long)((k0) + sr) * LDK + sc]); sr_[i].ks1 = St::ld8(&Kh[(long)((k0) + 32 + sr) * LDK + sc]); } while (0)
#define SWRITE(b, i) do { *(bf16x8*)((char*)V_lds + (b) * SHM_V + vst0) = St::tobf(sr_[i].vs0);          \
    *(bf16x8*)((char*)V_lds + (b) * SHM_V + vst1) = St::tobf(sr_[i].vs1); int kc = sc * 2;               \
    *(bf16x8*)((char*)K_lds + (b) * SHM_K + KSWZ(sr, kc)) = St::tobf(sr_[i].ks0);                       \
    *(bf16x8*)((char*)K_lds + (b) * SHM_K + KSWZ(32 + sr, kc)) = St::tobf(sr_[i].ks1); } while (0)
#define SWAIT() do { if constexpr (SDEPTH == 2) asm volatile("s_waitcnt vmcnt(4)" ::: "memory"); else asm volatile("s_waitcnt vmcnt(0)" ::: "memory"); } while (0)
#define RESC(a) do { if (__any((a) < 1.f)) { if (hi == 0) al_l[r32] = (a); asm volatile("s_waitcnt lgkmcnt(0)" ::: "memory"); \
    for (int d = 0; d < 4; ++d) for (int r = 0; r < 16; ++r) o[d][r] *= al_l[crow(r, hi)]; } } while (0)
  f32x16 pA0, pA1, pB0, pB1; float mnA, mnB, alA, alB; bf16x8 pa0, pa1, pa2, pa3; const int NT = seq / KVBLK;
  constexpr int SE = 0, SO = SDEPTH - 1;
  SLOAD(SE, 0); asm volatile("s_waitcnt vmcnt(0)" ::: "memory"); SWRITE(0, SE); __syncthreads();
  qkt(pA0, pA1, K_lds, qr, r32, hi); partialSM(pA0, pA1, m_reg, mnA, alA);
  SLOAD(SO, KVBLK); if constexpr (SDEPTH == 2) { if (2 < NT) SLOAD(SE, 2 * KVBLK); }
  SWAIT(); SWRITE(1, SO); __syncthreads();
  for (int j = 1; j + 1 < NT; j += 2) {
    SBAR(); qkt(pB0, pB1, (bf16*)((char*)K_lds + SHM_K), qr, r32, hi);
    finishSM(pA0, pA1, alA, l_reg, pa0, pa1, pa2, pa3); SBAR();
    SLOAD(SO, (j + SDEPTH) * KVBLK); SBAR();
    pv_d0(o, vb0, pa0, pa1, pa2, pa3); partialSM(pB0, pB1, m_reg, mnB, alB);
    __syncthreads(); SWAIT(); SWRITE(0, SE);
    RESC(alB); __syncthreads();
    SBAR(); qkt(pA0, pA1, K_lds, qr, r32, hi);
    finishSM(pB0, pB1, alB, l_reg, pa0, pa1, pa2, pa3); SBAR();
    if (SDEPTH == 1 || j + 3 < NT) SLOAD(SE, (j + 1 + SDEPTH) * KVBLK); SBAR();
    pv_d0(o, vb0 + (int)SHM_V, pa0, pa1, pa2, pa3); partialSM(pA0, pA1, m_reg, mnA, alA);
    __syncthreads(); SWAIT(); SWRITE(1, SO);
    RESC(alA); __syncthreads();
  }
  SBAR(); qkt(pB0, pB1, (bf16*)((char*)K_lds + SHM_K), qr, r32, hi);
  finishSM(pA0, pA1, alA, l_reg, pa0, pa1, pa2, pa3); SBAR();
  pv_d0(o, vb0, pa0, pa1, pa2, pa3); partialSM(pB0, pB1, m_reg, mnB, alB);
  __syncthreads(); RESC(alB);
  finishSM(pB0, pB1, alB, l_reg, pa0, pa1, pa2, pa3); SBAR();
  pv_d0(o, vb0 + (int)SHM_V, pa0, pa1, pa2, pa3);
  if (hi == 0) li_l[r32] = l_reg; asm volatile("s_waitcnt lgkmcnt(0)" ::: "memory");
  float rli[16];
#pragma unroll
  for (int r = 0; r < 16; ++r) rli[r] = __builtin_amdgcn_rcpf(li_l[crow(r, hi)]);
  if constexpr (!OBF16) { float* Ow = (float*)Obv + (long)(wid * QBLK) * LDO;
#pragma unroll
  for (int r = 0; r < 16; ++r) { int orow = crow(r, hi);
    for (int d0 = 0; d0 < 4; ++d0) Ow[(long)orow * LDO + d0 * 32 + r32] = o[d0][r] * rli[r]; }
  } else { unsigned short* Ow = (unsigned short*)Obv + (long)(wid * QBLK) * LDO;
#pragma unroll
  for (int r = 0; r < 16; ++r) { int orow = crow(r, hi);
    for (int d0 = 0; d0 < 4; ++d0) { const unsigned pk = cvtpk(o[d0][r] * rli[r], 0.f); Ow[(long)orow * LDO + d0 * 32 + r32] = (unsigned short)(pk & 0xffffu); } }
  }
#undef SLOAD
#undef SWRITE
#undef SWAIT
#undef RESC
}
#undef KSWZ
#undef SBAR
}
namespace gla {
typedef float f32x16 __attribute__((ext_vector_type(16)));
typedef float f32x4v __attribute__((ext_vector_type(4)));
constexpr int LD = 65;
constexpr int OX = 0, OY = 2 * 64 * LD * 4, OV = 4 * 64 * LD * 4, OAL = OV + 64 * 128 * 4, OW2 = OAL + 64 * 32 * 4, OBA = OW2 + 2 * 16 * 64 * 4, OTOT = OBA + 2 * 64 * 4, OEND = OTOT + 2 * 64 * 4 * 4;
static_assert(OEND <= 131072, "gla lds");
static_assert(64 * 129 * 4 <= 2 * 64 * LD * 4, "O stage fits in X");

struct In {
  const bf16_t* q; const bf16_t* k; const bf16_t* v; const bf16_t* ga; const bf16_t* og; int ld;
  const float* wa2; const float* ba; const float* gnorm;
  float* cs;
  float* dec;
  bf16_t* y; int ldy;
  int S, C;
};
__device__ __forceinline__ long chunk_row(const In& p, int cid) { return cid < p.S / 64 ? (long)cid * 64 : (long)p.S + (long)(cid - p.S / 64) * 64; }
__device__ __forceinline__ float logsig(float x) { return x < 0.f ? x - __logf(1.f + __expf(x)) : -__logf(1.f + __expf(-x)); }

__device__ __forceinline__ void cum_phase(const In& p, LAS unsigned char* lds, int head, long row0, int tid) {
  LAS float* AL = (LAS float*)(lds + OAL); LAS float* W2 = (LAS float*)(lds + OW2); LAS float* BA = (LAS float*)(lds + OBA); LAS float* TOT = (LAS float*)(lds + OTOT);
  { const int t = tid >> 3, r4 = (tid & 7) * 4; const unsigned long long u = *(const unsigned long long*)(p.ga + (row0 + t) * p.ld + r4);
    f32x4v a4; a4[0] = bf2f((bf16_t)u); a4[1] = bf2f((bf16_t)(u >> 16)); a4[2] = bf2f((bf16_t)(u >> 32)); a4[3] = bf2f((bf16_t)(u >> 48)); *(LAS f32x4v*)(AL + t * 32 + r4) = a4; }
  { const int e = tid * 4, dir = e >> 10, r = (e >> 6) & 15, j = e & 63; *(LAS f32x4v*)(W2 + e) = *(const f32x4v*)(p.wa2 + ((long)dir * 16 + r) * 256 + head * 64 + j); }
  if (tid < 128) BA[tid] = p.ba[(tid >> 6) * 256 + head * 64 + (tid & 63)];
  __syncthreads();
  const int dir = tid >> 8, j = tid & 63, seg = (tid >> 6) & 3;
  float w[16];
#pragma unroll
  for (int r = 0; r < 16; ++r) w[r] = W2[(dir * 16 + r) * 64 + j];
  const float bj = BA[dir * 64 + j];
  float c[16];
#pragma unroll
  for (int k = 0; k < 16; ++k) { const int t = seg * 16 + k; float z = bj;
#pragma unroll
    for (int r = 0; r < 16; ++r) z += AL[t * 32 + dir * 16 + r] * w[r];
    c[k] = logsig(z) * (1.f / 16.f); }
  if (dir == 0) {
#pragma unroll
    for (int k = 1; k < 16; ++k) c[k] += c[k - 1];
    TOT[(dir * 64 + j) * 4 + seg] = c[15];
  } else {
#pragma unroll
    for (int k = 14; k >= 0; --k) c[k] += c[k + 1];
    TOT[(dir * 64 + j) * 4 + seg] = c[0];
  }
  __syncthreads();
  float off = 0.f;
#pragma unroll
  for (int s = 0; s < 4; ++s) { const float tv = TOT[(dir * 64 + j) * 4 + s]; if (dir == 0 ? s < seg : s > seg) off += tv; }
  LAS float* X = (LAS float*)(lds + OX) + dir * 64 * LD;
#pragma unroll
  for (int k = 0; k < 16; ++k) X[(seg * 16 + k) * LD + j] = c[k] + off;
}
struct VRegs { unsigned long long u[4]; };
__device__ __forceinline__ VRegs load_v_regs(const In& p, int head, long row0, int tid) { VRegs r;
#pragma unroll
  for (int m = 0; m < 4; ++m) { const int t = (tid >> 5) + 16 * m, c4 = (tid & 31) * 4; r.u[m] = *(const unsigned long long*)(p.v + (row0 + t) * p.ld + head * 128 + c4); }
  return r; }
__device__ __forceinline__ void store_v(const VRegs& r, LAS unsigned char* lds, int tid) {
  LAS float* V = (LAS float*)(lds + OV);
#pragma unroll
  for (int m = 0; m < 4; ++m) { const int t = (tid >> 5) + 16 * m, c4 = (tid & 31) * 4; const unsigned long long u = r.u[m];
    f32x4v a4; a4[0] = bf2f((bf16_t)u); a4[1] = bf2f((bf16_t)(u >> 16)); a4[2] = bf2f((bf16_t)(u >> 32)); a4[3] = bf2f((bf16_t)(u >> 48)); *(LAS f32x4v*)(V + t * 128 + c4) = a4; }
}

__device__ __forceinline__ void g1_unit(const In& p, LAS unsigned char* lds, int head, int cid, int GH, int NCH) {
  int tid = threadIdx.x; asm volatile("" : "+v"(tid));
  const int lane = tid & 63, w = __builtin_amdgcn_readfirstlane(tid >> 6);
  const long row0 = chunk_row(p, cid);
  const VRegs vr = load_v_regs(p, head, row0, tid);
  bf16_t kreg[8];
#pragma unroll
  for (int m = 0; m < 8; ++m) kreg[m] = p.k[(row0 + (tid >> 6) + 8 * m) * p.ld + head * 64 + (tid & 63)];
  cum_phase(p, lds, head, row0, tid);
  store_v(vr, lds, tid);
  __syncthreads();
  LAS float* TOT = (LAS float*)(lds + OTOT);
  { const int j = tid & 63;
#pragma unroll
    for (int dir = 0; dir < 2; ++dir) { LAS float* X = (LAS float*)(lds + OX) + dir * 64 * LD;
      const float cl = TOT[(dir * 64 + j) * 4 + 0] + TOT[(dir * 64 + j) * 4 + 1] + TOT[(dir * 64 + j) * 4 + 2] + TOT[(dir * 64 + j) * 4 + 3];
#pragma unroll
      for (int m = 0; m < 8; ++m) { const int t = (tid >> 6) + 8 * m; const float kv = bf2f(kreg[m]); X[t * LD + j] = kv * __expf(cl - X[t * LD + j]); }
      if (tid < 64) p.dec[(((long)dir * GH + head) * NCH + cid) * 64 + j] = __expf(cl); }
  }
  __syncthreads();
  { const int dir = w >> 2, di = (w >> 1) & 1, vj0 = (w & 1) * 2; const LAS float* X = (const LAS float*)(lds + OX) + dir * 64 * LD; const LAS float* V = (const LAS float*)(lds + OV);
    f32x16 a0 = {}, a1 = {}; const int li = lane & 31, lk = lane >> 5;
#pragma unroll 4
    for (int s0 = 0; s0 < 64; s0 += 2) { const float av = X[(s0 + lk) * LD + 32 * di + li]; const float b0 = V[(s0 + lk) * 128 + 32 * vj0 + li], b1 = V[(s0 + lk) * 128 + 32 * vj0 + 32 + li];
      a0 = __builtin_amdgcn_mfma_f32_32x32x2f32(av, b0, a0, 0, 0, 0); a1 = __builtin_amdgcn_mfma_f32_32x32x2f32(av, b1, a1, 0, 0, 0); }
    float* dst = p.cs + ((((long)dir * GH + head) * NCH + cid) * 64) * 128;
#pragma unroll
    for (int r = 0; r < 16; ++r) { const int d = 32 * di + (r & 3) + 8 * (r >> 2) + 4 * lk; dst[(long)d * 128 + 32 * vj0 + li] = a0[r]; dst[(long)d * 128 + 32 * vj0 + 32 + li] = a1[r]; }
  }
  __syncthreads();
}
__device__ __forceinline__ void g2_item(const In& p, long idx, int GH, int NCH) {
  const int v = (int)(idx & 127), d = (int)((idx >> 7) & 63); const int hd = (int)((idx >> 13) % GH), dir = (int)((idx >> 13) / GH);
  const int nl = p.S / 64, nc = p.C / 64; float st = 0.f;
  float* base = p.cs + (((long)dir * GH + hd) * NCH) * 64 * 128 + (long)d * 128 + v; const float* db = p.dec + (((long)dir * GH + hd) * NCH) * 64 + d;
  for (int step = 0; step < nl + nc; ++step) {
    int cid; if (step < nc) cid = nl + (dir ? nc - 1 - step : step); else cid = dir ? nl - 1 - (step - nc) : step - nc;
    float* pp = base + (long)cid * 64 * 128; const float c = *pp; *pp = st; st = db[(long)cid * 64] * st + c;
  }
}
__device__ __forceinline__ void g3_unit(const In& p, LAS unsigned char* lds, int head, int cid, int GH, int NCH) {
  int tid = threadIdx.x; asm volatile("" : "+v"(tid));
  const int lane = tid & 63, w = __builtin_amdgcn_readfirstlane(tid >> 6), li = lane & 31, lk = lane >> 5;
  const long row0 = chunk_row(p, cid);
  float spf[2][32];
  { const int vj_ = w & 3;
#pragma unroll
    for (int dir = 0; dir < 2; ++dir) { const float* sp = p.cs + ((((long)dir * GH + head) * NCH + cid) * 64) * 128 + 32 * vj_ + li;
#pragma unroll
      for (int i = 0; i < 32; ++i) spf[dir][i] = sp[(long)(2 * i + lk) * 128]; } }
  const VRegs vr = load_v_regs(p, head, row0, tid);
  bf16_t kreg[8], qreg[8];
#pragma unroll
  for (int m = 0; m < 8; ++m) { const long o_ = (row0 + (tid >> 6) + 8 * m) * p.ld + head * 64 + (tid & 63); kreg[m] = p.k[o_]; qreg[m] = p.q[o_]; }
  cum_phase(p, lds, head, row0, tid);
  store_v(vr, lds, tid);
  __syncthreads();
  { const int j = tid & 63;
#pragma unroll
    for (int dir = 0; dir < 2; ++dir) { LAS float* X = (LAS float*)(lds + OX) + dir * 64 * LD; LAS float* Y = (LAS float*)(lds + OY) + dir * 64 * LD;
#pragma unroll
      for (int m = 0; m < 8; ++m) { const int t = (tid >> 6) + 8 * m; const float c = X[t * LD + j];
        const float qv = bf2f(qreg[m]) * 0.125f, kv = bf2f(kreg[m]);
        X[t * LD + j] = qv * __expf(c); Y[t * LD + j] = kv * __expf(-c); } }
  }
  __syncthreads();
  {
    const int dir = w >> 2, qi = (w >> 1) & 1, si = w & 1; const bool zero = dir == 0 ? si > qi : si < qi;
    const LAS float* X = (const LAS float*)(lds + OX) + dir * 64 * LD; LAS float* Y = (LAS float*)(lds + OY) + dir * 64 * LD;
    f32x16 pa = {};
    if (!zero) {
#pragma unroll 4
      for (int d0 = 0; d0 < 64; d0 += 2) pa = __builtin_amdgcn_mfma_f32_32x32x2f32(X[(32 * qi + li) * LD + d0 + lk], Y[(32 * si + li) * LD + d0 + lk], pa, 0, 0, 0);
    }
    __syncthreads();
#pragma unroll
    for (int r = 0; r < 16; ++r) { const int q = 32 * qi + (r & 3) + 8 * (r >> 2) + 4 * lk, s = 32 * si + li; const bool keep = dir == 0 ? s <= q : s >= q;
      Y[q * LD + s] = keep ? pa[r] : 0.f; }
  }
  __syncthreads();
  f32x16 acc = {};
  { const int qi = w >> 2, vj = w & 3; const LAS float* V = (const LAS float*)(lds + OV);
#pragma unroll
    for (int dir = 0; dir < 2; ++dir) { const LAS float* X = (const LAS float*)(lds + OX) + dir * 64 * LD; const LAS float* Y = (const LAS float*)(lds + OY) + dir * 64 * LD;
#pragma unroll 4
      for (int s0 = 0; s0 < 64; s0 += 2) acc = __builtin_amdgcn_mfma_f32_32x32x2f32(Y[(32 * qi + li) * LD + s0 + lk], V[(s0 + lk) * 128 + 32 * vj + li], acc, 0, 0, 0);
#pragma unroll
      for (int i = 0; i < 32; ++i) acc = __builtin_amdgcn_mfma_f32_32x32x2f32(X[(32 * qi + li) * LD + 2 * i + lk], spf[dir][i], acc, 0, 0, 0);
    }
    __syncthreads();
    LAS float* O = (LAS float*)(lds + OX);
#pragma unroll
    for (int r = 0; r < 16; ++r) { const int q = 32 * qi + (r & 3) + 8 * (r >> 2) + 4 * lk; O[q * 129 + 32 * vj + li] = acc[r]; }
  }
  __syncthreads();
  { const int row = tid >> 3, part = tid & 7; const LAS float* O = (const LAS float*)(lds + OX) + row * 129 + part * 16;
    float o[16]; float ss = 0.f;
#pragma unroll
    for (int k = 0; k < 16; ++k) { o[k] = O[k]; ss += o[k] * o[k]; }
    ss += __shfl_xor(ss, 1); ss += __shfl_xor(ss, 2); ss += __shfl_xor(ss, 4);
    const float rs = 1.f / sqrtf(ss * (1.f / 128.f) + 1e-6f);
    const bf16_t* ogp = p.og + (row0 + row) * p.ld + head * 128 + part * 16; const v4u og0 = *(const v4u*)ogp, og1 = *(const v4u*)(ogp + 8);
    const unsigned ogw[8] = {og0.x, og0.y, og0.z, og0.w, og1.x, og1.y, og1.z, og1.w}; bf16_t* yp = p.y + (row0 + row) * p.ldy + head * 128 + part * 16; float yy[16];
#pragma unroll
    for (int k4 = 0; k4 < 4; ++k4) { f32x4v g4; g4[0] = bf2f((bf16_t)(ogw[2 * k4] & 0xffff)); g4[1] = bf2f((bf16_t)(ogw[2 * k4] >> 16)); g4[2] = bf2f((bf16_t)(ogw[2 * k4 + 1] & 0xffff)); g4[3] = bf2f((bf16_t)(ogw[2 * k4 + 1] >> 16)); const f32x4v n4 = *(const f32x4v*)(p.gnorm + part * 16 + 4 * k4); f32x4v y4;
#pragma unroll
      for (int e = 0; e < 4; ++e) { const float gg = g4[e]; y4[e] = o[4 * k4 + e] * rs * n4[e] * (gg / (1.f + __expf(-gg))); yy[4 * k4 + e] = y4[e]; } }
    { v4u o0, o1; o0.x = pk2(yy[0], yy[1]); o0.y = pk2(yy[2], yy[3]); o0.z = pk2(yy[4], yy[5]); o0.w = pk2(yy[6], yy[7]);
      o1.x = pk2(yy[8], yy[9]); o1.y = pk2(yy[10], yy[11]); o1.z = pk2(yy[12], yy[13]); o1.w = pk2(yy[14], yy[15]); *(v4u*)yp = o0; *(v4u*)(yp + 8) = o1; }
  }
  __syncthreads();
}
}
namespace moe {
constexpr int NE = 16, NG = 4, EPG = 4, DE = 512, D = 1024;
__device__ __forceinline__ float wave_sum(float v) {
#pragma unroll
  for (int o = 1; o < 64; o <<= 1) v += __shfl_xor(v, o);
  return v;
}
struct Route { int e0, r0, e1, r1; };
struct MoeOrder {
  int G, c, NT; const LAS int* poff;
  __device__ __forceinline__ bool next(int i, pg8::Unit& u) const {
    const long L = (long)i * G + c; const int total = poff[NE] * NT; if (L >= total) return false;
    const int panel = (int)L / NT, j = (int)L % NT; int e = 0;
#pragma unroll
    for (int k = 1; k < NE; ++k) e += (panel >= poff[k]) ? 1 : 0;
    u.pm = panel; u.pn = e * NT + j; u.acol = 0; return true;
  }
  __device__ __forceinline__ void a_ready(const pg8::Unit&) const {}
  __device__ __forceinline__ void done(const pg8::Unit&) const {}
};
struct EpiGU {
  static constexpr bool PERM = true, AFTER_DRAIN = false;
  bf16_t* hid;
  __device__ __forceinline__ void operator()(const pg8::f32x4 (&acc)[2][2][4][2], const pg8::Unit& u, int wr, int wc, int fr, int fq) const {
    const int j = u.pn & 3; const int row0 = u.pm * 256 + wr * 64 + fr, col0 = j * 128 + wc * 32 + 8 * fq;
#pragma unroll
    for (int ai = 0; ai < 2; ++ai)
#pragma unroll
      for (int m = 0; m < 4; ++m) { const size_t r = (size_t)(row0 + ai * 128 + m * 16); float hv[8];
#pragma unroll
        for (int n = 0; n < 2; ++n)
#pragma unroll
          for (int e = 0; e < 4; ++e) { const float g = acc[ai][0][m][n][e], up = acc[ai][1][m][n][e]; hv[4 * n + e] = g / (1.f + __expf(-g)) * up; }
        v4u o; o.x = pk2(hv[0], hv[1]); o.y = pk2(hv[2], hv[3]); o.z = pk2(hv[4], hv[5]); o.w = pk2(hv[6], hv[7]);
        *(v4u*)(hid + r * DE + col0) = o; }
  }
};
struct EpiDown {
  static constexpr bool PERM = true, AFTER_DRAIN = false;
  const int* srcrow; const float* wgt; bf16_t* contrib; size_t slot_stride;
  __device__ __forceinline__ void operator()(const pg8::f32x4 (&acc)[2][2][4][2], const pg8::Unit& u, int wr, int wc, int fr, int fq) const {
    const int pn = u.pn & 3; const int row0 = u.pm * 256 + wr * 64 + fr, col0 = pn * 256 + wc * 32 + 8 * fq;
    int srcs[2][4]; float ws_[2][4];
#pragma unroll
    for (int ai = 0; ai < 2; ++ai)
#pragma unroll
      for (int m = 0; m < 4; ++m) { const int r = row0 + ai * 128 + m * 16; srcs[ai][m] = srcrow[r]; ws_[ai][m] = wgt[r]; }
#pragma unroll
    for (int ai = 0; ai < 2; ++ai)
#pragma unroll
      for (int m = 0; m < 4; ++m) { const int src = srcs[ai][m]; if (src < 0) continue; const float w = ws_[ai][m];
        bf16_t* dst = contrib + (size_t)(src & 1) * slot_stride + (size_t)(src >> 1) * D + col0;
#pragma unroll
        for (int bj = 0; bj < 2; ++bj) { const pg8::f32x4 v0 = acc[ai][bj][m][0] * w, v1 = acc[ai][bj][m][1] * w;
          v4u o; o.x = pk2(v0[0], v0[1]); o.y = pk2(v0[2], v0[3]); o.z = pk2(v1[0], v1[1]); o.w = pk2(v1[2], v1[3]); *(v4u*)(dst + bj * 128) = o; } }
  }
};
__device__ __forceinline__ void route_row(const float* xr, const float* gnorm, const float* shift, const float* scale, bf16_t* hrow, const LAS float* rwT, const float* rbias,
                                          LAS int* cnt, Route* rt, float* wts, int lane) {
  typedef float f4 __attribute__((ext_vector_type(4)));
  f4 xv[4]; float ss = 0.f;
#pragma unroll
  for (int j = 0; j < 4; ++j) { xv[j] = *(const f4*)(xr + 4 * lane + 256 * j); ss += xv[j][0] * xv[j][0] + xv[j][1] * xv[j][1] + xv[j][2] * xv[j][2] + xv[j][3] * xv[j][3]; }
  const float rs = 1.f / sqrtf(wave_sum(ss) * (1.f / 1024.f) + 1e-6f);
  float lg[NE];
#pragma unroll
  for (int e = 0; e < NE; ++e) lg[e] = 0.f;
#pragma unroll
  for (int j = 0; j < 4; ++j) { const int c = 4 * lane + 256 * j; const f4 g4 = *(const f4*)(gnorm + c), sh = *(const f4*)(shift + c), sc = *(const f4*)(scale + c);
    f4 h;
#pragma unroll
    for (int i = 0; i < 4; ++i) h[i] = xv[j][i] * rs * g4[i] * (1.f + sc[i]) + sh[i];
    *(unsigned long long*)(hrow + c) = (unsigned long long)pk2(h[0], h[1]) | ((unsigned long long)pk2(h[2], h[3]) << 32);
#pragma unroll
    for (int e = 0; e < NE; ++e) { const f4 w4 = *(const LAS f4*)(rwT + e * 1024 + c); lg[e] += h[0] * w4[0] + h[1] * w4[1] + h[2] * w4[2] + h[3] * w4[3]; } }
  { float v8[8], v4[4], v2[2], v1;
#pragma unroll
    for (int i = 0; i < 8; ++i) { const bool up = lane & 1; const float keep = up ? lg[2 * i + 1] : lg[2 * i], send = up ? lg[2 * i] : lg[2 * i + 1]; v8[i] = keep + __shfl_xor(send, 1); }
#pragma unroll
    for (int i = 0; i < 4; ++i) { const bool up = lane & 2; const float keep = up ? v8[2 * i + 1] : v8[2 * i], send = up ? v8[2 * i] : v8[2 * i + 1]; v4[i] = keep + __shfl_xor(send, 2); }
#pragma unroll
    for (int i = 0; i < 2; ++i) { const bool up = lane & 4; const float keep = up ? v4[2 * i + 1] : v4[2 * i], send = up ? v4[2 * i] : v4[2 * i + 1]; v2[i] = keep + __shfl_xor(send, 4); }
    { const bool up = lane & 8; const float keep = up ? v2[1] : v2[0], send = up ? v2[0] : v2[1]; v1 = keep + __shfl_xor(send, 8); }
    v1 += __shfl_xor(v1, 16); v1 += __shfl_xor(v1, 32);
#pragma unroll
    for (int e = 0; e < NE; ++e) lg[e] = __shfl(v1, e); }
  float sc[NE], sel[NE];
#pragma unroll
  for (int e = 0; e < NE; ++e) { sc[e] = 1.f / (1.f + __expf(-lg[e])); sel[e] = sc[e] + rbias[e]; }
  int bestg = 0; float bestgs = -1e30f;
#pragma unroll
  for (int g = 0; g < NG; ++g) { float m1 = -1e30f, m2 = -1e30f;
#pragma unroll
    for (int i = 0; i < EPG; ++i) { const float v = sel[g * EPG + i]; if (v > m1) { m2 = m1; m1 = v; } else if (v > m2) m2 = v; }
    const float gsum = m1 + m2; if (gsum > bestgs) { bestgs = gsum; bestg = g; } }
  int i1 = -1, i2 = -1; float v1 = -1e30f, v2 = -1e30f, s1 = 0.f, s2 = 0.f;
#pragma unroll
  for (int e = 0; e < NE; ++e) { if (e / EPG == bestg) { const float v = sel[e];
      if (v > v1) { v2 = v1; i2 = i1; s2 = s1; v1 = v; i1 = e; s1 = sc[e]; } else if (v > v2) { v2 = v; i2 = e; s2 = sc[e]; } } }
  if (lane == 0) { const float inv = 1.f / (s1 + s2); Route r; r.e0 = i1; r.e1 = i2; r.r0 = __hip_atomic_fetch_add(cnt + i1, 1, __ATOMIC_RELAXED, __HIP_MEMORY_SCOPE_WORKGROUP); r.r1 = __hip_atomic_fetch_add(cnt + i2, 1, __ATOMIC_RELAXED, __HIP_MEMORY_SCOPE_WORKGROUP); *rt = r; wts[0] = s1 * inv; wts[1] = s2 * inv; }
}
}
namespace hy {
typedef float f32x16 __attribute__((ext_vector_type(16)));
constexpr int S = 4096, NT1 = 128, LDZ = 191, ZPAD = 31, LDX = 129;
constexpr int O_TAPS = 0, O_ZA = 32768, O_ZB = O_ZA + 32 * LDZ * 4, O_X1 = O_ZB + 32 * LDZ * 4, O_X2 = O_X1 + 32 * LDX * 4, O_RED = O_X2 + 32 * LDX * 4, O_END = O_RED + 4 * 64 * 16 * 4;
static_assert(O_END <= 131072, "hyena lds");

struct H0Regs { v4u w0, w1; };
__device__ __forceinline__ H0Regs h0_load(const bf16_t* u, int ld, int tile, int tid) {
  const int tt = tile / 24, jt = tile % 24, t0 = tt * 64, j0 = jt * 64; H0Regs r; r.w0 = (v4u){0u, 0u, 0u, 0u}; r.w1 = r.w0;
  { const int rr = tid >> 3, c8 = (tid & 7) * 8, t = t0 - 1 + rr; if (t >= 0 && t < S) r.w0 = *(const v4u*)(u + (size_t)t * ld + j0 + c8); }
  if (tid < 16) { const int rr = 64 + (tid >> 3), c8 = (tid & 7) * 8, t = t0 - 1 + rr; if (t < S) r.w1 = *(const v4u*)(u + (size_t)t * ld + j0 + c8); }
  return r;
}
__device__ __forceinline__ void h0_compute(const H0Regs& rg, const float* cw, const float* cb, bf16_t* ucT, int tile, LAS unsigned char* lds, int tid) {
  const int tt = tile / 24, jt = tile % 24, t0 = tt * 64, j0 = jt * 64;
  LAS float* U = (LAS float*)lds;
  { const int rr = tid >> 3, c8 = (tid & 7) * 8; const v4u w = rg.w0; LAS float* d = U + rr * 65 + c8;
    d[0] = bf2f(w.x & 0xffff); d[1] = bf2f(w.x >> 16); d[2] = bf2f(w.y & 0xffff); d[3] = bf2f(w.y >> 16); d[4] = bf2f(w.z & 0xffff); d[5] = bf2f(w.z >> 16); d[6] = bf2f(w.w & 0xffff); d[7] = bf2f(w.w >> 16); }
  if (tid < 16) { const int rr = 64 + (tid >> 3), c8 = (tid & 7) * 8; const v4u w = rg.w1; LAS float* d = U + rr * 65 + c8;
    d[0] = bf2f(w.x & 0xffff); d[1] = bf2f(w.x >> 16); d[2] = bf2f(w.y & 0xffff); d[3] = bf2f(w.y >> 16); d[4] = bf2f(w.z & 0xffff); d[5] = bf2f(w.z >> 16); d[6] = bf2f(w.w & 0xffff); d[7] = bf2f(w.w >> 16); }
  __syncthreads();
  { const int jj = tid >> 3, tq = (tid & 7) * 8, j = j0 + jj; const float w0 = cw[j], w1 = cw[1536 + j], w2 = cw[2 * 1536 + j], bb = cb[j]; float v[8];
#pragma unroll
    for (int k = 0; k < 8; ++k) v[k] = bb + w0 * U[(tq + k) * 65 + jj] + w1 * U[(tq + k + 1) * 65 + jj] + w2 * U[(tq + k + 2) * 65 + jj];
    v4u o; o.x = pk2(v[0], v[1]); o.y = pk2(v[2], v[3]); o.z = pk2(v[4], v[5]); o.w = pk2(v[6], v[7]); *(v4u*)(ucT + (size_t)j * S + t0 + tq) = o; }
  __syncthreads();
}
__device__ __forceinline__ void h2_tile(const bf16_t* yT, bf16_t* ybf, int ldy, int tile, LAS unsigned char* lds) {
  int tid = threadIdx.x; asm volatile("" : "+v"(tid));
  const int tt = tile / 8, ct = tile % 8, t0 = tt * 64, c0 = ct * 64;
  LAS bf16_t* T = (LAS bf16_t*)lds;
  { const int cc = tid >> 3, t8 = (tid & 7) * 8; const v4u w = *(const v4u*)(yT + (size_t)(c0 + cc) * S + t0 + t8); LAS unsigned* d = (LAS unsigned*)(T + cc * 66 + t8); d[0] = w.x; d[1] = w.y; d[2] = w.z; d[3] = w.w; }
  __syncthreads();
  { const int t = tid >> 3, c8 = (tid & 7) * 8; unsigned short e[8];
#pragma unroll
    for (int k = 0; k < 8; ++k) e[k] = T[(c8 + k) * 66 + t];
    v4u o; o.x = e[0] | ((unsigned)e[1] << 16); o.y = e[2] | ((unsigned)e[3] << 16); o.z = e[4] | ((unsigned)e[5] << 16); o.w = e[6] | ((unsigned)e[7] << 16);
    *(v4u*)(ybf + (size_t)(t0 + t) * ldy + c0 + c8) = o; }
  __syncthreads();
}
__device__ __forceinline__ void h1_unit(const bf16_t* ucT, const float* tapsT, const float* nrm, const float* skip, bf16_t* yT, int c, LAS unsigned char* lds) {
  int tid = threadIdx.x; asm volatile("" : "+v"(tid));
  const int lane = tid & 63, w = __builtin_amdgcn_readfirstlane(tid >> 6), li = lane & 31, lk = lane >> 5;
  LAS float* TAPS = (LAS float*)(lds + O_TAPS); LAS float* ZA = (LAS float*)(lds + O_ZA); LAS float* ZB = (LAS float*)(lds + O_ZB);
  LAS float* X1 = (LAS float*)(lds + O_X1); LAS float* X2 = (LAS float*)(lds + O_X2); LAS float* RED = (LAS float*)(lds + O_RED);
  for (int e = tid; e < 32 * 62; e += 512) { const int s2 = e / 62, p = e % 62, t1p = p < 31 ? p : 128 + p; ZA[s2 * LDZ + t1p] = 0.f; ZB[s2 * LDZ + t1p] = 0.f; }
  for (int t = tid; t < S; t += 512) { const int t2 = t & 31, t1 = t >> 5;
    X1[t2 * LDX + t1] = bf2f(ucT[(size_t)c * S + t]); X2[t2 * LDX + t1] = bf2f(ucT[(size_t)(512 + c) * S + t]); ZA[t2 * LDZ + t1 + ZPAD] = bf2f(ucT[(size_t)(1024 + c) * S + t]); }
#pragma unroll 1
  for (int o = 0; o < 2; ++o) {
    const float* tp = tapsT + ((size_t)o * 512 + c) * 8192;
    for (int e = tid; e < 8192; e += 512) TAPS[e] = tp[(e + 4096) & 8191];
    __syncthreads();
    const LAS float* Zin = o == 0 ? ZA : ZB;
    const int g = w & 3, dh = w >> 2;
    const int Dlo = 32 * g - 127 + (dh ? 80 : 0), Dn = dh ? 79 : 80;
    f32x16 acc = {};
    { const LAS float* ap = TAPS + 4096 + 32 * Dlo + li - lk - 30;
      const LAS float* bp = Zin + lk * LDZ + (32 * g + li - Dlo + ZPAD);
#pragma unroll 2
      for (int dd = 0; dd < Dn; ++dd) {
#pragma unroll
        for (int kk = 0; kk < 16; ++kk) acc = __builtin_amdgcn_mfma_f32_32x32x2f32(ap[(15 - kk) * 2], bp[2 * kk * LDZ], acc, 0, 0, 0);
        ap += 32; bp -= 1; }
    }
    if (dh) {
#pragma unroll
      for (int r = 0; r < 16; ++r) RED[(g * 64 + lane) * 16 + r] = acc[r]; }
    __syncthreads();
    if (!dh) { const float inv = 1.f / nrm[o * 512 + c], sk = skip[o * 512 + c]; const LAS float* G = o == 0 ? X1 : X2; LAS float* Out = o == 0 ? ZB : ZA;
#pragma unroll
      for (int r = 0; r < 16; ++r) { const int t2 = (r & 3) + 8 * (r >> 2) + 4 * lk, t1 = 32 * g + li;
        const float cv = (acc[r] + RED[(g * 64 + lane) * 16 + r]) * inv; const float zin = Zin[t2 * LDZ + t1 + ZPAD];
        Out[t2 * LDZ + t1 + ZPAD] = G[t2 * LDX + t1] * (cv + sk * zin); } }
    __syncthreads();
  }
  for (int t = tid; t < S; t += 512) yT[(size_t)c * S + t] = (bf16_t)f2bf(ZA[(t & 31) * LDZ + (t >> 5) + ZPAD]);
  __syncthreads();
}

typedef short bf16x8v __attribute__((ext_vector_type(8)));
typedef unsigned u32x2v __attribute__((ext_vector_type(2)));
constexpr int CSB = 16448;
constexpr int ZROW = 80, ZROWS = 190;
constexpr int B_CS = 0, B_ZA = 4 * CSB, B_ZB = B_ZA + 15232, B_X1 = B_ZB + 15232, B_X2 = B_X1 + 8256, B_RED = B_X2 + 8256, B_END = B_RED + 16384;
static_assert(B_END <= 131072 && B_ZA % 16 == 0 && B_X1 % 16 == 0, "hyena bf16 lds");
__device__ __forceinline__ void h1b_unit(const bf16_t* ucT, const bf16_t* tapsB, const float* nrm, const float* skip, bf16_t* yT, int c, LAS unsigned char* lds) {
  int tid = threadIdx.x; asm volatile("" : "+v"(tid));
  const int lane = tid & 63, w = __builtin_amdgcn_readfirstlane(tid >> 6), li = lane & 31, lk = lane >> 5;
  LAS bf16_t* ZA = (LAS bf16_t*)(lds + B_ZA); LAS bf16_t* ZB = (LAS bf16_t*)(lds + B_ZB); LAS bf16_t* X1 = (LAS bf16_t*)(lds + B_X1); LAS bf16_t* X2 = (LAS bf16_t*)(lds + B_X2);
  LAS float* RED = (LAS float*)(lds + B_RED);
  for (int e = tid; e < 62 * 20; e += 512) { const int p = e / 20, d = e % 20, row = p < 31 ? p : 128 + p; ((LAS unsigned*)ZA)[row * 20 + d] = 0u; ((LAS unsigned*)ZB)[row * 20 + d] = 0u; }
  { const v4u zv = *(const v4u*)(ucT + (size_t)(1024 + c) * S + tid * 8); const int t = tid * 8; *(LAS v4u*)((LAS unsigned char*)ZA + ((t >> 5) + ZPAD) * ZROW + (t & 31) * 2) = zv; }
  { const v4u xa = *(const v4u*)(ucT + (size_t)c * S + tid * 8), xb = *(const v4u*)(ucT + (size_t)(512 + c) * S + tid * 8); const int t1 = tid >> 2, t2b = (tid & 3) * 8;
    const unsigned wa[4] = {xa.x, xa.y, xa.z, xa.w}, wb[4] = {xb.x, xb.y, xb.z, xb.w};
#pragma unroll
    for (int k = 0; k < 4; ++k) { X1[(t2b + 2 * k) * LDX + t1] = (bf16_t)(wa[k] & 0xffff); X1[(t2b + 2 * k + 1) * LDX + t1] = (bf16_t)(wa[k] >> 16);
      X2[(t2b + 2 * k) * LDX + t1] = (bf16_t)(wb[k] & 0xffff); X2[(t2b + 2 * k + 1) * LDX + t1] = (bf16_t)(wb[k] >> 16); } }
  typedef unsigned u4a __attribute__((ext_vector_type(4), aligned(4))); typedef const __attribute__((address_space(1))) u4a* gp4;
  v4u cv[9];
#pragma unroll 1
  for (int o = 0; o < 2; ++o) {
#define HTAPS_LOAD(oo) { const __attribute__((address_space(1))) unsigned char* tb = (const __attribute__((address_space(1))) unsigned char*)(tapsB + ((size_t)(oo) * 512 + c) * 2 * 8232); \
      _Pragma("unroll") for (int it = 0; it < 9; ++it) { const int e = tid + 512 * it; const int s = e / 1028, q = e % 1028; cv[it] = (v4u){0u, 0u, 0u, 0u}; if (e < 4 * 1028) cv[it] = *(gp4)(tb + (size_t)(s & 1) * 16464 + 16 * q + 4 * (s >> 1)); } }
    if (o == 0) HTAPS_LOAD(0)
    {
#pragma unroll
      for (int it = 0; it < 9; ++it) { const int e = tid + 512 * it; const int s = e / 1028, q = e % 1028; if (e < 4 * 1028) *(LAS v4u*)(lds + B_CS + s * CSB + 16 * q) = cv[it]; } }
    __syncthreads();
    if (o == 0) HTAPS_LOAD(1)
    const LAS bf16_t* Zin = o == 0 ? ZA : ZB;
    const int g = w & 3, dh = w >> 2;
    const int Dlo = 32 * g - 127 + (dh ? 80 : 0), Dn = dh ? 79 : 80;
    f32x16 acc = {};
    { const int s = (4 - (li & 3)) & 3;
      const LAS unsigned char* ap = lds + B_CS + s * CSB + 2 * (4096 - 32 * Dlo - li + 8 * lk - s);
      const LAS unsigned char* bp = (const LAS unsigned char*)Zin + (32 * g + li - Dlo + ZPAD) * ZROW + 16 * lk;
#define HLD(A0, A1, B0, B1) { const u32x2v p0_ = *(const LAS u32x2v*)(ap), p1_ = *(const LAS u32x2v*)(ap2), p2_ = *(const LAS u32x2v*)(ap3), p3_ = *(const LAS u32x2v*)(ap4); \
        A0 = (v4u){p0_.x, p0_.y, p1_.x, p1_.y}; A1 = (v4u){p2_.x, p2_.y, p3_.x, p3_.y}; B0 = *(const LAS v4u*)(bp); B1 = *(const LAS v4u*)(bp + 32); ap -= 64; ap2 -= 64; ap3 -= 64; ap4 -= 64; bp -= ZROW; }
#define HMM(A, B) acc = __builtin_amdgcn_mfma_f32_32x32x16_bf16(__builtin_bit_cast(bf16x8v, A), __builtin_bit_cast(bf16x8v, B), acc, 0, 0, 0)
#define HOPQ(name, off) unsigned name##i = (unsigned)(unsigned long long)(ap + (off)); asm volatile("" : "+v"(name##i)); const LAS unsigned char* name = (const LAS unsigned char*)(unsigned long long)name##i;
      HOPQ(ap2, 8) HOPQ(ap3, 32) HOPQ(ap4, 40)
#undef HOPQ
      v4u fa0, fa1, fb0, fb1, ga0, ga1, gb0, gb1;
      HLD(fa0, fa1, fb0, fb1)
      int dd_ = 0;
      for (; dd_ + 2 <= Dn; dd_ += 2) {
        HLD(ga0, ga1, gb0, gb1)
        HMM(fa0, fb0); HMM(fa1, fb1);
        if (dd_ + 2 < Dn) HLD(fa0, fa1, fb0, fb1)
        HMM(ga0, gb0); HMM(ga1, gb1);
      }
      if (dd_ < Dn) { HMM(fa0, fb0); HMM(fa1, fb1); }
#undef HLD
#undef HMM
    }
    if (dh) {
#pragma unroll
      for (int r = 0; r < 16; ++r) RED[(g * 64 + lane) * 16 + r] = acc[r]; }
    __syncthreads();
    if (!dh) { const float inv = 1.f / nrm[o * 512 + c], sk = skip[o * 512 + c]; const LAS bf16_t* G = o == 0 ? X1 : X2; LAS bf16_t* Out = o == 0 ? ZB : ZA;
#pragma unroll
      for (int r = 0; r < 16; ++r) { const int t2 = (r & 3) + 8 * (r >> 2) + 4 * lk, t1 = 32 * g + li;
        const float cv = (acc[r] + RED[(g * 64 + lane) * 16 + r]) * inv; const float zin = bf2f(Zin[(t1 + ZPAD) * (ZROW / 2) + t2]);
        Out[(t1 + ZPAD) * (ZROW / 2) + t2] = (bf16_t)f2bf(bf2f(G[t2 * LDX + t1]) * (cv + sk * zin)); } }
    __syncthreads();
  }
  { const int t = tid * 8; *(v4u*)(yT + (size_t)c * S + t) = *(const LAS v4u*)((const LAS unsigned char*)ZA + ((t >> 5) + ZPAD) * ZROW + (t & 31) * 2); }
  __syncthreads();
}
__device__ __forceinline__ void cconv3_item(const bf16_t* u, int ld, const float* cw, const float* cb, float* ucc, long idx) {
  const int j = (int)(idx % 1536); const int tc = (int)(idx / 1536);
  const bf16_t* up = u + (size_t)tc * ld + j;
  float v = cb[j] + cw[1536 + j] * bf2f(up[0]);
  if (tc > 0) v += cw[j] * bf2f(*(up - ld)); if (tc < 255) v += cw[2 * 1536 + j] * bf2f(up[ld]);
  ucc[idx] = v;
}
__device__ __forceinline__ void clong_item(const float* ucc, const float* z1c_in, float* z1c_out, bf16_t* yout, int ldy, const float* tapsC, const float* nrmC, const float* skip, int o, long idx) {
  const int c = (int)(idx % 512), t0 = (int)(idx / 512) * 4; constexpr int n = 256;
  const float* tp = tapsC + (size_t)o * 2 * n * 512 + c; const float nr = nrmC[o * 512 + c];
  const float* zs = o == 0 ? ucc + 1024 + c : z1c_in + c; const int ldz = o == 0 ? 1536 : 512;
  float a0 = 0.f, a1 = 0.f, a2 = 0.f, a3 = 0.f;
  for (int s = 0; s < n; ++s) { const float zv = zs[(size_t)s * ldz];
    const int l0 = t0 - s;
    a0 += tp[(size_t)(l0 >= 0 ? l0 : 2 * n + l0) * 512] * zv; a1 += tp[(size_t)(l0 + 1 >= 0 ? l0 + 1 : 2 * n + l0 + 1) * 512] * zv;
    a2 += tp[(size_t)(l0 + 2 >= 0 ? l0 + 2 : 2 * n + l0 + 2) * 512] * zv; a3 += tp[(size_t)(l0 + 3 >= 0 ? l0 + 3 : 2 * n + l0 + 3) * 512] * zv; }
  const float sk = skip[o * 512 + c]; const float av[4] = {a0, a1, a2, a3};
#pragma unroll
  for (int i = 0; i < 4; ++i) { const int t = t0 + i; const float val = ucc[(size_t)t * 1536 + o * 512 + c] * (av[i] / nr + sk * zs[(size_t)t * ldz]);
    if (o == 0) z1c_out[(size_t)t * 512 + c] = val; else yout[(size_t)t * ldy + c] = (bf16_t)f2bf(val); }
}
}
#define XB_TMO      128
#define XB_XCNT(j)  (256  + 64 * (j))
#define XB_XSUB(j)  (1280 + 64 * (j))
#define XB_XGEN(j)  (2304 + 64 * (j))
#define XB_TOP      3328
#define XB_TOPGEN   3392
#define XCD_BAR_WORDS 3456
#define XB_SPIN_CAP (1u << 18)

__device__ __forceinline__ unsigned xb_ld(unsigned* p)              { return __hip_atomic_load(p, __ATOMIC_RELAXED, __HIP_MEMORY_SCOPE_AGENT); }
__device__ __forceinline__ unsigned xb_add(unsigned* p, unsigned v) { return __hip_atomic_fetch_add(p, v, __ATOMIC_RELAXED, __HIP_MEMORY_SCOPE_AGENT); }
__device__ __forceinline__ unsigned xb_xcc_id() { return (unsigned)__builtin_amdgcn_s_getreg((3 << 11) | 20) & 0xFu; }
#define XB_SPIN(cond, bar) do { unsigned _sp = 0; while (cond) { __builtin_amdgcn_s_sleep(1); \
    if ((++_sp & 255u) == 0u) { if (xb_ld(&(bar)[XB_TMO])) break; if (_sp > XB_SPIN_CAP) { atomicAdd(&(bar)[XB_TMO], 1u); break; } } } } while (0)

struct XcdBarrier {
    unsigned* bar; unsigned x;
    volatile LAS unsigned* st;
};

__device__ __forceinline__ XcdBarrier xcd_barrier_post(unsigned* bar, volatile LAS unsigned* st) {
    XcdBarrier b; b.bar = bar; b.x = xb_xcc_id(); b.st = st;
    if (threadIdx.x == 0) (void)xb_add(&bar[XB_XCNT(b.x)], 1u);
    return b;
}
__device__ __forceinline__ void xcd_barrier_complete(unsigned* bar, unsigned x, unsigned& nloc, unsigned& nx) {
    const unsigned G = gridDim.x * gridDim.y * gridDim.z;
    unsigned sum, cnt, mine, sp = 0u;
    for (;;) {
        sum = 0u; cnt = 0u; mine = 0u;
#pragma unroll
        for (unsigned j = 0; j < 16; ++j) { const unsigned c = xb_ld(&bar[XB_XCNT(j)]); sum += c; cnt += (c > 0u) ? 1u : 0u; mine = (j == x) ? c : mine; }
        if (sum == G) break;
        __builtin_amdgcn_s_sleep(1);
        if ((++sp & 255u) == 0u) { if (xb_ld(&bar[XB_TMO])) break; if (sp > XB_SPIN_CAP) { atomicAdd(&bar[XB_TMO], 1u); break; } }
    }
    nloc = mine > 0u ? mine : 1u; nx = cnt > 0u ? cnt : 1u;
}

__device__ __forceinline__ void xcd_barrier(const XcdBarrier& b) {
    asm volatile("s_waitcnt vmcnt(0)" ::: "memory");
    __syncthreads();
    if (threadIdx.x == 0) {
        unsigned* bar = b.bar;
#define XB_SP(word) ((unsigned*)((((unsigned long long)(unsigned)__builtin_amdgcn_readfirstlane((int)((unsigned long long)(bar + (word)) >> 32))) << 32) | (unsigned)__builtin_amdgcn_readfirstlane((int)(unsigned)(unsigned long long)(bar + (word)))))
        unsigned* const p_xsub = XB_SP(XB_XSUB(b.x)); unsigned* const p_xgen = XB_SP(XB_XGEN(b.x));
        __builtin_amdgcn_s_waitcnt(0);
        unsigned nloc = b.st[0], nx = b.st[1];
        if (nloc == 0u) { xcd_barrier_complete(bar, b.x, nloc, nx); b.st[0] = nloc; b.st[1] = nx; }
        const unsigned old = xb_add(p_xsub, 1u);
        const unsigned gen = old / nloc;
        if (old + 1u == (gen + 1u) * nloc) {
            __builtin_amdgcn_fence(__ATOMIC_RELEASE, "agent");
            asm volatile("s_waitcnt vmcnt(0)" ::: "memory");
            const unsigned og = xb_add(&bar[XB_TOP], 1u);
            const unsigned tg = og / nx;
            if (og + 1u == (tg + 1u) * nx) xb_add(&bar[XB_TOPGEN], 1u);
            else XB_SPIN(xb_ld(&bar[XB_TOPGEN]) == tg, bar);
            __builtin_amdgcn_fence(__ATOMIC_ACQUIRE, "agent");
            xb_add(p_xgen, 1u);
            asm volatile("s_waitcnt vmcnt(0)" ::: "memory");
        } else {
            XB_SPIN(xb_ld(p_xgen) == gen, bar);
            __builtin_amdgcn_fence(__ATOMIC_ACQUIRE, "agent");
            asm volatile("s_waitcnt vmcnt(0)" ::: "memory");
        }
    }
    __syncthreads();
}
#include <math.h>
#ifdef HOST_TEST
#define HD
#define FEXP expf
#define FSIN sinf
#define FCOS cosf
#define FLOG logf
#define FPOW powf
#else
#define HD __device__ __forceinline__
#define FEXP __expf
#define FSIN __sinf
#define FCOS __cosf
#define FLOG __logf
#define FPOW __powf
#endif

struct FullDims { static constexpr int D=1024,B=8,S=4096,DEPTH=2,C=256,GW=64,AH=8,AKV=2,HDM=128,GH=4,GDK=64,GDV=128,GR=16,HW=512,HB=16,HF=64,NE=16,NG=4,DE=512; };
struct SmallDims { static constexpr int D=64,B=2,S=128,DEPTH=2,C=32,GW=16,AH=4,AKV=2,HDM=16,GH=2,GDK=8,GDV=16,GR=4,HW=32,HB=4,HF=8,NE=8,NG=2,DE=32; };

template <class T> struct DD {
  static constexpr int D=T::D,B=T::B,S=T::S,DEPTH=T::DEPTH,C=T::C,GW=T::GW,AH=T::AH,AKV=T::AKV,HDM=T::HDM,GH=T::GH,GDK=T::GDK,GDV=T::GDV,GR=T::GR,HW=T::HW,HB=T::HB,HF=T::HF,NE=T::NE,NG=T::NG,DE=T::DE;
  static constexpr int R=S+C, AG=AH/AKV, RP=HDM/4, HE=1+2*HB, EPG=NE/NG, AQW=AH*HDM, AKVW=AKV*HDM, GKW=GH*GDK, GVW=GH*GDV;
  static constexpr int NKV=AKVW+AKVW+GKW+GVW+2*GR, NIN=NKV+AQW+GKW+GVW+3*HW+3*D;
  static constexpr int O_AK=0, O_AV=AKVW, O_GK=2*AKVW, O_GV=2*AKVW+GKW, O_GA=2*AKVW+GKW+GVW;
  static constexpr int O_AQ=NKV, O_GQ=NKV+AQW, O_OG=O_GQ+GKW, O_HY=O_OG+GVW, O_BR=O_HY+3*HW;
};

struct NaiveBufs {
  const float *x,*c,*ctx,*c_ctx,*w_mod,*b_mod,*norm1_g,*norm2_g,*w_in,*q_norm_g,*k_norm_g,*gla_wa2,*gla_ba,*gla_norm_g,*hy_conv_w,*hy_conv_b,
    *hy_pos_w1,*hy_pos_b1,*hy_sin_freq,*hy_pos_w2,*hy_pos_b2,*hy_pos_w3,*hy_decay,*hy_skip,*w_br_hy,*w_br_gla,*w_br_att,*w_out,*router_w,*router_b,*moe_w_gate,*moe_w_up,*moe_w_down;
  float* out;
  float *mod;
  float *hid2S,*hid2C;
  float *tapsS,*tapsC;
  float *nrmS,*nrmC;
  float *rs;
  float *h;
  float *proj;
  float *qn,*kn;
  float *yatt;
  float *laf,*lab;
  float *of,*ob;
  float *ygla;
  float *uc;
  float *z1,*yhy;
  float *m;
  int   *ridx;
  float *rw;
  float *hid;
  float *xc;
};

HD float sigmoidf_(float x) { return 1.f / (1.f + FEXP(-x)); }
HD float siluf_(float x) { return x / (1.f + FEXP(-x)); }
HD float logsigmoidf_(float x) { return x < 0.f ? x - FLOG(1.f + FEXP(x)) : -FLOG(1.f + FEXP(-x)); }

template <class T> HD void st_mod(const NaiveBufs& a, int l, long idx) {
  using d = DD<T>; const int j = (int)(idx % (6 * d::D)), bb = (int)(idx / (6 * d::D));
  const float* cv = bb < d::B ? a.c + (long)bb * d::D : a.c_ctx; const float* w = a.w_mod + (long)l * d::D * 6 * d::D;
  float acc = a.b_mod[(long)l * 6 * d::D + j];
  for (int k = 0; k < d::D; ++k) acc += siluf_(cv[k]) * w[(long)k * 6 * d::D + j];
  a.mod[idx] = acc;
}
template <class T> HD void st_hyhid(const NaiveBufs& a, int l, int which, long idx) {
  using d = DD<T>; const int n = which ? d::C : d::S; float* dst = which ? a.hid2C : a.hid2S;
  const int j = (int)(idx % d::HF), t = (int)(idx / d::HF);
  const float* w1 = a.hy_pos_w1 + (long)l * d::HE * d::HF; const float* b1 = a.hy_pos_b1 + l * d::HF; const float* fr = a.hy_sin_freq + l * d::HF;
  const float* w2 = a.hy_pos_w2 + (long)l * d::HF * d::HF; const float* b2 = a.hy_pos_b2 + l * d::HF;
  const float tn = (float)t / (float)n; const float w0 = 2.f * 3.14159265358979323846f / (float)n;
  float acc2 = b2[j];
  for (int i = 0; i < d::HF; ++i) {
    float acc = b1[i] + tn * w1[0 * d::HF + i];
    for (int bnd = 0; bnd < d::HB; ++bnd) {
      const float band = 1e-4f + (float)bnd * ((float)(d::HB - 1) - 1e-4f) / (float)(d::HB - 1);
      const float ph = w0 * (float)t * band;
      acc += FCOS(ph) * w1[(1 + bnd) * d::HF + i] - FSIN(ph) * w1[(1 + d::HB + bnd) * d::HF + i];
    }
    acc2 += FSIN(fr[i] * acc) * w2[i * d::HF + j];
  }
  dst[idx] = FSIN(fr[j] * acc2);
}
template <class T> HD void st_hytaps(const NaiveBufs& a, int l, int which, long idx) {
  using d = DD<T>; const int n = which ? d::C : d::S; const float* hid2 = which ? a.hid2C : a.hid2S; float* dst = which ? a.tapsC : a.tapsS;
  const int c = (int)(idx % d::HW); const int li = (int)((idx / d::HW) % (2 * n)); const int o = (int)(idx / ((long)d::HW * 2 * n));
  float v = 0.f;
  if (li != n) {
    const int dir = li < n ? 0 : 1; const int t = li < n ? li : 2 * n - li;
    const int col = (o * 2 + dir) * d::HW + c;
    const float* w3 = a.hy_pos_w3 + (long)l * d::HF * 4 * d::HW;
    float acc = 0.f;
    for (int j = 0; j < d::HF; ++j) acc += hid2[(long)t * d::HF + j] * w3[(long)j * 4 * d::HW + col];
    const float dec = fabsf(a.hy_decay[(long)l * 4 * d::HW + col]);
    v = acc * FEXP(-((float)t / (float)n) * dec);
  }
  if (which == 0) dst[((long)o * d::HW + c) * 2 * n + li] = v; else dst[idx] = v;
}
template <class T> HD void st_hynorm(const NaiveBufs& a, int which, long idx) {
  using d = DD<T>; const int n = which ? d::C : d::S; const float* tp = which ? a.tapsC : a.tapsS; float* dst = which ? a.nrmC : a.nrmS;
  const int c = (int)(idx % d::HW), o = (int)(idx / d::HW);
  float s = 0.f; for (int li = 0; li < 2 * n; ++li) s += fabsf(which == 0 ? tp[((long)o * d::HW + c) * 2 * n + li] : tp[((long)o * 2 * n + li) * d::HW + c]);
  dst[idx] = s + 1e-6f;
}

template <class T> HD const float* xrow(const NaiveBufs& a, int l, int b, int r) {
  using d = DD<T>;
  if (r < d::S) return (l == 0 ? a.x : a.out) + ((long)b * d::S + r) * d::D;
  return (l == 0 ? a.ctx : a.xc) + ((long)b * d::C + (r - d::S)) * d::D;
}
template <class T> HD float* xrow_w(const NaiveBufs& a, int b, int r) {
  using d = DD<T>;
  if (r < d::S) return a.out + ((long)b * d::S + r) * d::D;
  return a.xc + ((long)b * d::C + (r - d::S)) * d::D;
}
template <class T> HD void st_rs(const NaiveBufs& a, int l, int b, int src, long idx) {
  using d = DD<T>; const int r = (int)idx; const float* xr = src ? (const float*)xrow_w<T>(a, b, r) : xrow<T>(a, l, b, r);
  float s = 0.f; for (int k = 0; k < d::D; ++k) s += xr[k] * xr[k];
  a.rs[r] = 1.f / sqrtf(s / (float)d::D + 1e-6f);
}
template <class T> HD void st_norm(const NaiveBufs& a, int l, int b, int which, long idx) {
  using d = DD<T>; const int j = (int)(idx % d::D), r = (int)(idx / d::D);
  const float* xr = which ? (const float*)xrow_w<T>(a, b, r) : xrow<T>(a, l, b, r);
  const float* g = (which ? a.norm2_g : a.norm1_g) + (long)l * d::D;
  const float* md = a.mod + (long)(r < d::S ? b : d::B) * 6 * d::D;
  const float shift = md[(which ? 3 : 0) * d::D + j], scale = md[(which ? 4 : 1) * d::D + j];
  a.h[idx] = xr[j] * a.rs[r] * g[j] * (1.f + scale) + shift;
}
struct GemmArgs { const float* A; int lda; const float* W; int ldw; float* Cc; int ldc; int M, N, K;
  const float* gate; int ldg;
  const float* colscale;
  const float* res; int ldr;
  int accumulate; };
HD void st_gemm(const GemmArgs& g, long idx) {
  const int nb = g.N / 4; const int cb = (int)(idx % nb), rb = (int)(idx / nb);
  float acc[4][4];
#pragma unroll
  for (int i = 0; i < 4; ++i) {
#pragma unroll
    for (int j = 0; j < 4; ++j) acc[i][j] = 0.f; }
  const float* a0 = g.A + (long)(rb * 4) * g.lda; const float* w0 = g.W + cb * 4;
  for (int k = 0; k < g.K; ++k) {
    float av[4], wv[4];
#pragma unroll
    for (int i = 0; i < 4; ++i) av[i] = a0[(long)i * g.lda + k];
#pragma unroll
    for (int j = 0; j < 4; ++j) wv[j] = w0[(long)k * g.ldw + j];
#pragma unroll
    for (int i = 0; i < 4; ++i) {
#pragma unroll
      for (int j = 0; j < 4; ++j) acc[i][j] += av[i] * wv[j]; }
  }
#pragma unroll
  for (int i = 0; i < 4; ++i)
#pragma unroll
  for (int j = 0; j < 4; ++j) {
    const int r = rb * 4 + i, c = cb * 4 + j; float v = acc[i][j];
    if (g.gate) v *= sigmoidf_(g.gate[(long)r * g.ldg + c]);
    if (g.colscale) v *= g.colscale[c];
    if (g.res) v += g.res[(long)r * g.ldr + c];
    float* p = g.Cc + (long)r * g.ldc + c;
    if (g.accumulate) v += *p;
    *p = v;
  }
}
template <class T> HD void st_qknorm(const NaiveBufs& a, int l, long idx) {
  using d = DD<T>; const int hh = (int)(idx % (d::AH + d::AKV)), r = (int)(idx / (d::AH + d::AKV));
  const bool isq = hh < d::AH; const int hd = isq ? hh : hh - d::AH;
  const float* src = a.proj + (long)r * d::NIN + (isq ? d::O_AQ : d::O_AK) + hd * d::HDM;
  float* dst = (isq ? a.qn + (long)r * d::AQW : a.kn + (long)r * d::AKVW) + hd * d::HDM;
  const float* g = (isq ? a.q_norm_g : a.k_norm_g) + (long)l * d::HDM;
  float s = 0.f; for (int k = 0; k < d::HDM; ++k) s += src[k] * src[k];
  const float rsq = 1.f / sqrtf(s / (float)d::HDM + 1e-6f);
  if (r < d::S) {
    const int row = r / d::GW, col = r % d::GW;
    for (int p = 0; p < d::HDM / 2; ++p) {
      const int fi = p < d::RP ? p : p - d::RP; const float pos = p < d::RP ? (float)row : (float)col;
      const float inv = FPOW(10000.f, -(float)fi / (float)d::RP); const float ang = pos * inv;
      const float cs = FCOS(ang), sn = FSIN(ang);
      const float x1 = src[2 * p] * rsq * g[2 * p], x2 = src[2 * p + 1] * rsq * g[2 * p + 1];
      dst[2 * p] = x1 * cs - x2 * sn; dst[2 * p + 1] = x1 * sn + x2 * cs;
    }
  } else { for (int k = 0; k < d::HDM; ++k) dst[k] = src[k] * rsq * g[k]; }
}
template <class T, int NSPLIT> HD void st_attn(const NaiveBufs& a, int r0, int nrows, long idx) {
  using d = DD<T>; constexpr int OD = d::HDM / NSPLIT;
  const int r = r0 + (int)(idx % nrows); const int hs = (int)(idx / nrows); const int part = hs % NSPLIT, hq = hs / NSPLIT; const int kv = hq / d::AG;
  const int k0 = r < d::S ? 0 : d::S, k1 = d::R;
  float q[d::HDM], o[OD];
  const float scale = 1.f / sqrtf((float)d::HDM);
#pragma unroll
  for (int k = 0; k < d::HDM; ++k) q[k] = a.qn[(long)r * d::AQW + hq * d::HDM + k] * scale;
#pragma unroll
  for (int k = 0; k < OD; ++k) o[k] = 0.f;
  float mx = -1e30f, lsum = 0.f;
  for (int kk = k0; kk < k1; ++kk) {
    const float* kr = a.kn + (long)kk * d::AKVW + kv * d::HDM;
    float s = 0.f;
#pragma unroll
    for (int k = 0; k < d::HDM; ++k) s += q[k] * kr[k];
    if (s > mx) { const float cr = FEXP(mx - s); lsum *= cr;
#pragma unroll
      for (int k = 0; k < OD; ++k) o[k] *= cr;
      mx = s; }
    const float p = FEXP(s - mx); lsum += p;
    const float* vr = a.proj + (long)kk * d::NIN + d::O_AV + kv * d::HDM + part * OD;
#pragma unroll
    for (int k = 0; k < OD; ++k) o[k] += p * vr[k];
  }
  const float inv = 1.f / lsum;
#pragma unroll
  for (int k = 0; k < OD; ++k) a.yatt[(long)r * d::AQW + hq * d::HDM + part * OD + k] = o[k] * inv;
}
template <class T> HD void st_glala(const NaiveBufs& a, int l, long idx) {
  using d = DD<T>; const int j = (int)(idx % d::GKW); const int dir = (int)((idx / d::GKW) % 2); const int r = (int)(idx / (2 * d::GKW));
  const float* al = a.proj + (long)r * d::NIN + d::O_GA + dir * d::GR;
  const float* w2 = a.gla_wa2 + ((long)l * 2 + dir) * d::GR * d::GKW; float z = a.gla_ba[((long)l * 2 + dir) * d::GKW + j];
  for (int k = 0; k < d::GR; ++k) z += al[k] * w2[(long)k * d::GKW + j];
  (dir ? a.lab : a.laf)[(long)r * d::GKW + j] = FEXP(logsigmoidf_(z) / 16.f);
}
template <class T> HD void st_glascan(const NaiveBufs& a, long idx) {
  using d = DD<T>; const int v = (int)(idx % d::GDV); const int hd = (int)((idx / d::GDV) % d::GH); const int dir = (int)(idx / (d::GDV * d::GH));
  float st[d::GDK];
#pragma unroll
  for (int k = 0; k < d::GDK; ++k) st[k] = 0.f;
  const float qs = 1.f / sqrtf((float)d::GDK);
  const float* la = dir ? a.lab : a.laf; float* od = dir ? a.ob : a.of;
  for (int step = 0; step < d::R; ++step) {
    int r;
    if (step < d::C) r = d::S + (dir ? d::C - 1 - step : step); else r = dir ? d::S - 1 - (step - d::C) : step - d::C;
    const float* pr = a.proj + (long)r * d::NIN;
    const float vv = pr[d::O_GV + hd * d::GDV + v];
    float o = 0.f;
#pragma unroll
    for (int k = 0; k < d::GDK; ++k) {
      st[k] = la[(long)r * d::GKW + hd * d::GDK + k] * st[k] + pr[d::O_GK + hd * d::GDK + k] * vv;
      o += pr[d::O_GQ + hd * d::GDK + k] * qs * st[k];
    }
    od[(long)r * d::GVW + hd * d::GDV + v] = o;
  }
}
template <class T> HD void st_glaout(const NaiveBufs& a, int l, long idx) {
  using d = DD<T>; const int hd = (int)(idx % d::GH), r = (int)(idx / d::GH);
  const long base = (long)r * d::GVW + hd * d::GDV; float s = 0.f;
  for (int v = 0; v < d::GDV; ++v) { const float o = a.of[base + v] + a.ob[base + v]; s += o * o; }
  const float rsq = 1.f / sqrtf(s / (float)d::GDV + 1e-6f);
  for (int v = 0; v < d::GDV; ++v) { const float o = a.of[base + v] + a.ob[base + v];
    a.ygla[base + v] = o * rsq * a.gla_norm_g[(long)l * d::GDV + v] * siluf_(a.proj[(long)r * d::NIN + d::O_OG + hd * d::GDV + v]); }
}
template <class T> HD void st_hyconv3(const NaiveBufs& a, int l, long idx) {
  using d = DD<T>; const int j = (int)(idx % (3 * d::HW)), r = (int)(idx / (3 * d::HW));
  const int lo = r < d::S ? 0 : d::S, hi = r < d::S ? d::S : d::R;
  const float* w = a.hy_conv_w + (long)l * 3 * 3 * d::HW;
  float v = a.hy_conv_b[(long)l * 3 * d::HW + j] + a.proj[(long)r * d::NIN + d::O_HY + j] * w[1 * 3 * d::HW + j];
  if (r - 1 >= lo) v += a.proj[(long)(r - 1) * d::NIN + d::O_HY + j] * w[0 * 3 * d::HW + j];
  if (r + 1 < hi) v += a.proj[(long)(r + 1) * d::NIN + d::O_HY + j] * w[2 * 3 * d::HW + j];
  a.uc[idx] = v;
}
template <class T> HD void st_hylong(const NaiveBufs& a, int l, int o, long idx) {
  using d = DD<T>; const int c = (int)(idx % d::HW); const int rb = (int)(idx / d::HW); const int r0 = rb * 4;
  const bool lat = r0 < d::S; const int n = lat ? d::S : d::C; const int base = lat ? 0 : d::S; const int t0 = r0 - base;
  const float* tp = (lat ? a.tapsS : a.tapsC) + (long)o * 2 * n * d::HW + c; const float nr = (lat ? a.nrmS : a.nrmC)[o * d::HW + c];
  const float* zs = o == 0 ? a.uc + 2 * d::HW + c : a.z1 + c; const int ldz = o == 0 ? 3 * d::HW : d::HW;
  float acc0 = 0.f, acc1 = 0.f, acc2 = 0.f, acc3 = 0.f;
  auto tap = [&](int lag) { const int li = lag >= 0 ? lag : 2 * n + lag; return tp[(long)li * d::HW]; };
  float w0 = tap(t0), w1 = tap(t0 + 1), w2 = tap(t0 + 2), w3 = tap(t0 + 3);
  for (int s = 0; s < n; ++s) {
    const float zv = zs[(long)(base + s) * ldz];
    acc0 += w0 * zv; acc1 += w1 * zv; acc2 += w2 * zv; acc3 += w3 * zv;
    w3 = w2; w2 = w1; w1 = w0; w0 = (s + 1 < n) ? tap(t0 - s - 1) : 0.f;
  }
  const float sk = a.hy_skip[((long)l * 2 + o) * d::HW + c];
  float* dst = o == 0 ? a.z1 : a.yhy;
  const float accs[4] = {acc0, acc1, acc2, acc3};
#pragma unroll
  for (int i = 0; i < 4; ++i) { const int r = r0 + i; const float zr = zs[(long)r * ldz];
    dst[(long)r * d::HW + c] = a.uc[(long)r * 3 * d::HW + o * d::HW + c] * (accs[i] / nr + sk * zr); }
}
template <class T> HD void st_router(const NaiveBufs& a, long idx) {
  using d = DD<T>; const int r = (int)idx; const float* hr = a.h + (long)r * d::D;
  float sc[d::NE], sel[d::NE];
#pragma unroll
  for (int e = 0; e < d::NE; ++e) sc[e] = 0.f;
  for (int k = 0; k < d::D; ++k) { const float hv = hr[k];
#pragma unroll
    for (int e = 0; e < d::NE; ++e) sc[e] += hv * a.router_w[(long)k * d::NE + e]; }
#pragma unroll
  for (int e = 0; e < d::NE; ++e) { sc[e] = sigmoidf_(sc[e]); sel[e] = sc[e] + a.router_b[e]; }
  int bestg = 0; float bestgs = -1e30f;
#pragma unroll
  for (int g = 0; g < d::NG; ++g) { float m1 = -1e30f, m2 = -1e30f;
#pragma unroll
    for (int i = 0; i < d::EPG; ++i) { const float v = sel[g * d::EPG + i]; if (v > m1) { m2 = m1; m1 = v; } else if (v > m2) m2 = v; }
    const float gs = m1 + m2; if (gs > bestgs) { bestgs = gs; bestg = g; } }
  int i1 = -1, i2 = -1; float v1 = -1e30f, v2 = -1e30f, s1 = 0.f, s2 = 0.f;
#pragma unroll
  for (int e = 0; e < d::NE; ++e) { if (e / d::EPG == bestg) { const float v = sel[e];
      if (v > v1) { v2 = v1; i2 = i1; s2 = s1; v1 = v; i1 = e; s1 = sc[e]; } else if (v > v2) { v2 = v; i2 = e; s2 = sc[e]; } } }
  const float inv = 1.f / (s1 + s2);
  a.ridx[2 * r] = i1; a.ridx[2 * r + 1] = i2; a.rw[2 * r] = s1 * inv; a.rw[2 * r + 1] = s2 * inv;
}
template <class T> HD void st_moehid(const NaiveBufs& a, int l, long idx) {
  using d = DD<T>; const int j = (int)(idx % d::DE); const int k = (int)((idx / d::DE) % 2); const int r = (int)(idx / (2 * d::DE));
  const int e = a.ridx[2 * r + k]; const float* hr = a.h + (long)r * d::D;
  const float* wg = a.moe_w_gate + (((long)l * d::NE + e) * d::D) * d::DE + j; const float* wu = a.moe_w_up + (((long)l * d::NE + e) * d::D) * d::DE + j;
  float g = 0.f, u = 0.f;
  for (int i = 0; i < d::D; ++i) { const float hv = hr[i]; g += hv * wg[(long)i * d::DE]; u += hv * wu[(long)i * d::DE]; }
  a.hid[idx] = siluf_(g) * u;
}
template <class T> HD void st_moeout(const NaiveBufs& a, int l, int b, long idx) {
  using d = DD<T>; const int dd = (int)(idx % d::D), r = (int)(idx / d::D);
  float acc = 0.f;
  for (int k = 0; k < 2; ++k) { const int e = a.ridx[2 * r + k]; const float* hk = a.hid + ((long)r * 2 + k) * d::DE;
    const float* wd = a.moe_w_down + (((long)l * d::NE + e) * d::DE) * d::D + dd; float s = 0.f;
    for (int j = 0; j < d::DE; ++j) s += hk[j] * wd[(long)j * d::D];
    acc += a.rw[2 * r + k] * s; }
  const float g2 = a.mod[(long)(r < d::S ? b : d::B) * 6 * d::D + 5 * d::D + dd];
  float* xr = xrow_w<T>(a, b, r); xr[dd] += g2 * acc;
}
enum { L_MOD = 0, L_HID_S, L_HID_C, L_TAPS_S, L_TAPS_C, L_NRM_S, L_NRM_C, N_LSTAGES,
       P_RS1 = 16, P_NORM1, P_INPROJ, P_QKNORM, P_ATTN_L, P_ATTN_C, P_GLALA, P_GLASCAN, P_GLAOUT, P_HYC3, P_HYL0, P_HYL1,
       P_MRG_HY, P_MRG_GLA, P_MRG_ATT, P_OUT_L, P_OUT_C, P_RS2, P_NORM2, P_ROUTER, P_MOEHID, P_MOEOUT, P_END };
constexpr int ATT_NSPLIT = 4;

template <class T> HD long stage_items(int st, int l) {
  using d = DD<T>; const bool last = (l == d::DEPTH - 1);
  switch (st) {
    case L_MOD: return (long)(d::B + 1) * 6 * d::D;
    case L_HID_S: return (long)d::S * d::HF;
    case L_HID_C: return (long)d::C * d::HF;
    case L_TAPS_S: return 2L * 2 * d::S * d::HW;
    case L_TAPS_C: return 2L * 2 * d::C * d::HW;
    case L_NRM_S: case L_NRM_C: return 2L * d::HW;
    case P_RS1: case P_RS2: case P_ROUTER: return d::R;
    case P_NORM1: case P_NORM2: return (long)d::R * d::D;
    case P_INPROJ: return (long)(d::R / 4) * (d::NIN / 4);
    case P_QKNORM: return (long)d::R * (d::AH + d::AKV);
    case P_ATTN_L: return (long)d::S * d::AH * ATT_NSPLIT;
    case P_ATTN_C: return last ? 0 : (long)d::C * d::AH * ATT_NSPLIT;
    case P_GLALA: return (long)d::R * 2 * d::GKW;
    case P_GLASCAN: return 2L * d::GH * d::GDV;
    case P_GLAOUT: return (long)d::R * d::GH;
    case P_HYC3: return (long)d::R * 3 * d::HW;
    case P_HYL0: case P_HYL1: return (long)(d::R / 4) * d::HW;
    case P_MRG_HY: case P_MRG_GLA: case P_MRG_ATT: return (long)(d::R / 4) * (d::D / 4);
    case P_OUT_L: return (long)(d::S / 4) * (d::D / 4);
    case P_OUT_C: return last ? 0 : (long)(d::C / 4) * (d::D / 4);
    case P_MOEHID: return (long)d::R * 2 * d::DE;
    case P_MOEOUT: return (long)(last ? d::S : d::R) * d::D;
  }
  return 0;
}

template <class T, int ST> HD void stage_run(const NaiveBufs& a, int l, int b, long idx) {
  using d = DD<T>;
  if constexpr (ST == L_MOD) st_mod<T>(a, l, idx);
  else if constexpr (ST == L_HID_S) st_hyhid<T>(a, l, 0, idx);
  else if constexpr (ST == L_HID_C) st_hyhid<T>(a, l, 1, idx);
  else if constexpr (ST == L_TAPS_S) st_hytaps<T>(a, l, 0, idx);
  else if constexpr (ST == L_TAPS_C) st_hytaps<T>(a, l, 1, idx);
  else if constexpr (ST == L_NRM_S) st_hynorm<T>(a, 0, idx);
  else if constexpr (ST == L_NRM_C) st_hynorm<T>(a, 1, idx);
  else if constexpr (ST == P_RS1) st_rs<T>(a, l, b, 0, idx);
  else if constexpr (ST == P_RS2) st_rs<T>(a, l, b, 1, idx);
  else if constexpr (ST == P_NORM1) st_norm<T>(a, l, b, 0, idx);
  else if constexpr (ST == P_NORM2) st_norm<T>(a, l, b, 1, idx);
  else if constexpr (ST == P_INPROJ) { GemmArgs g{a.h, d::D, a.w_in + (long)l * d::D * d::NIN, d::NIN, a.proj, d::NIN, d::R, d::NIN, d::D, nullptr, 0, nullptr, nullptr, 0, 0}; st_gemm(g, idx); }
  else if constexpr (ST == P_QKNORM) st_qknorm<T>(a, l, idx);
  else if constexpr (ST == P_ATTN_L) st_attn<T, ATT_NSPLIT>(a, 0, d::S, idx);
  else if constexpr (ST == P_ATTN_C) st_attn<T, ATT_NSPLIT>(a, d::S, d::C, idx);
  else if constexpr (ST == P_GLALA) st_glala<T>(a, l, idx);
  else if constexpr (ST == P_GLASCAN) st_glascan<T>(a, idx);
  else if constexpr (ST == P_GLAOUT) st_glaout<T>(a, l, idx);
  else if constexpr (ST == P_HYC3) st_hyconv3<T>(a, l, idx);
  else if constexpr (ST == P_HYL0) st_hylong<T>(a, l, 0, idx);
  else if constexpr (ST == P_HYL1) st_hylong<T>(a, l, 1, idx);
  else if constexpr (ST == P_MRG_HY) { GemmArgs g{a.yhy, d::HW, a.w_br_hy + (long)l * d::HW * d::D, d::D, a.m, d::D, d::R, d::D, d::HW, a.proj + d::O_BR, d::NIN, nullptr, nullptr, 0, 0}; st_gemm(g, idx); }
  else if constexpr (ST == P_MRG_GLA) { GemmArgs g{a.ygla, d::GVW, a.w_br_gla + (long)l * d::GVW * d::D, d::D, a.m, d::D, d::R, d::D, d::GVW, a.proj + d::O_BR + d::D, d::NIN, nullptr, nullptr, 0, 1}; st_gemm(g, idx); }
  else if constexpr (ST == P_MRG_ATT) { GemmArgs g{a.yatt, d::AQW, a.w_br_att + (long)l * d::AQW * d::D, d::D, a.m, d::D, d::R, d::D, d::AQW, a.proj + d::O_BR + 2 * d::D, d::NIN, nullptr, nullptr, 0, 1}; st_gemm(g, idx); }
  else if constexpr (ST == P_OUT_L) { const float* res = (l == 0 ? a.x : (const float*)a.out) + (long)b * d::S * d::D;
    GemmArgs g{a.m, d::D, a.w_out + (long)l * d::D * d::D, d::D, a.out + (long)b * d::S * d::D, d::D, d::S, d::D, d::D, nullptr, 0, a.mod + (long)b * 6 * d::D + 2 * d::D, res, d::D, 0}; st_gemm(g, idx); }
  else if constexpr (ST == P_OUT_C) { const float* res = (l == 0 ? a.ctx : (const float*)a.xc) + (long)b * d::C * d::D;
    GemmArgs g{a.m + (long)d::S * d::D, d::D, a.w_out + (long)l * d::D * d::D, d::D, a.xc + (long)b * d::C * d::D, d::D, d::C, d::D, d::D, nullptr, 0, a.mod + (long)d::B * 6 * d::D + 2 * d::D, res, d::D, 0}; st_gemm(g, idx); }
  else if constexpr (ST == P_ROUTER) st_router<T>(a, idx);
  else if constexpr (ST == P_MOEHID) st_moehid<T>(a, l, idx);
  else if constexpr (ST == P_MOEOUT) st_moeout<T>(a, l, b, idx);
}

template <class T> inline size_t carve(NaiveBufs& a, float* ws) {
  using d = DD<T>; size_t o = 0; auto take = [&](size_t n) { float* p = ws ? ws + o : nullptr; o += (n + 63) & ~(size_t)63; return p; };
  a.mod = take((size_t)(d::B + 1) * 6 * d::D);
  a.hid2S = take((size_t)d::S * d::HF); a.hid2C = take((size_t)d::C * d::HF);
  a.tapsS = take((size_t)2 * 2 * d::S * d::HW); a.tapsC = take((size_t)2 * 2 * d::C * d::HW);
  a.nrmS = take(2 * d::HW); a.nrmC = take(2 * d::HW);
  a.rs = take(d::R); a.h = take((size_t)d::R * d::D); a.proj = take((size_t)d::R * d::NIN);
  a.qn = take((size_t)d::R * d::AQW); a.kn = take((size_t)d::R * d::AKVW);
  a.uc = take((size_t)d::R * 3 * d::HW); a.z1 = take((size_t)d::R * d::HW); a.yhy = take((size_t)d::R * d::HW);
  a.xc = take((size_t)d::B * d::C * d::D);
#ifdef HOST_TEST
  a.yatt = take((size_t)d::R * d::AQW); a.laf = take((size_t)d::R * d::GKW); a.lab = take((size_t)d::R * d::GKW);
  a.of = take((size_t)d::R * d::GVW); a.ob = take((size_t)d::R * d::GVW); a.ygla = take((size_t)d::R * d::GVW);
  a.m = take((size_t)d::R * d::D); a.ridx = (int*)take((size_t)d::R * 2); a.rw = take((size_t)d::R * 2); a.hid = take((size_t)d::R * 2 * d::DE);
#endif
  return o;
}
template <class T> inline void set_inputs(NaiveBufs& a, const float* const* in) {
  int i = 0;
  a.x = in[i++]; a.c = in[i++]; a.ctx = in[i++]; a.c_ctx = in[i++]; a.w_mod = in[i++]; a.b_mod = in[i++]; a.norm1_g = in[i++]; a.norm2_g = in[i++];
  a.w_in = in[i++]; a.q_norm_g = in[i++]; a.k_norm_g = in[i++]; a.gla_wa2 = in[i++]; a.gla_ba = in[i++]; a.gla_norm_g = in[i++];
  a.hy_conv_w = in[i++]; a.hy_conv_b = in[i++]; a.hy_pos_w1 = in[i++]; a.hy_pos_b1 = in[i++]; a.hy_sin_freq = in[i++]; a.hy_pos_w2 = in[i++];
  a.hy_pos_b2 = in[i++]; a.hy_pos_w3 = in[i++]; a.hy_decay = in[i++]; a.hy_skip = in[i++]; a.w_br_hy = in[i++]; a.w_br_gla = in[i++];
  a.w_br_att = in[i++]; a.w_out = in[i++]; a.router_w = in[i++]; a.router_b = in[i++]; a.moe_w_gate = in[i++]; a.moe_w_up = in[i++]; a.moe_w_down = in[i++];
}

#define LSTAGES(X) X(L_MOD) X(L_HID_S) X(L_HID_C) X(L_TAPS_S) X(L_TAPS_C) X(L_NRM_S) X(L_NRM_C)
#define PSTAGES(X) X(P_RS1) X(P_NORM1) X(P_INPROJ) X(P_QKNORM) X(P_ATTN_L) X(P_ATTN_C) X(P_GLALA) X(P_GLASCAN) X(P_GLAOUT) X(P_HYC3) X(P_HYL0) X(P_HYL1) \
  X(P_MRG_HY) X(P_MRG_GLA) X(P_MRG_ATT) X(P_OUT_L) X(P_OUT_C) X(P_RS2) X(P_NORM2) X(P_ROUTER) X(P_MOEHID) X(P_MOEOUT)
namespace pro {
__device__ __forceinline__ void mod_phase(const NaiveBufs& a, int l, LAS unsigned char* lds) {
  int tz = threadIdx.x; asm volatile("" : "+v"(tz));
  __syncthreads();
  LAS float* sl = (LAS float*)lds; LAS float* part = sl + 9 * 1024;
  for (int e = tz; e < 9 * 1024; e += NTHREADS) { const int bb = e >> 10, k = e & 1023; const float cv = bb < 8 ? a.c[bb * 1024 + k] : a.c_ctx[k]; sl[e] = cv / (1.f + __expf(-cv)); }
  __syncthreads();
  const float* w = a.w_mod + (size_t)l * 1024 * 6144;
  const int jl = tz & 63, ks = tz >> 6;
  for (int cb = blockIdx.x; cb < 96; cb += gridDim.x) { const int j = cb * 64 + jl; float acc[9];
#pragma unroll
    for (int q = 0; q < 9; ++q) acc[q] = 0.f;
#pragma unroll 4
    for (int k = ks * 128; k < ks * 128 + 128; ++k) { const float wv = w[(size_t)k * 6144 + j];
#pragma unroll
      for (int q = 0; q < 9; ++q) acc[q] += sl[q * 1024 + k] * wv; }
#pragma unroll
    for (int q = 0; q < 9; ++q) part[(ks * 9 + q) * 64 + jl] = acc[q];
    __syncthreads();
    for (int e = tz; e < 9 * 64; e += NTHREADS) { const int q = e >> 6, jj = e & 63; float s = a.b_mod[(size_t)l * 6144 + cb * 64 + jj];
#pragma unroll
      for (int k8 = 0; k8 < 8; ++k8) s += part[(k8 * 9 + q) * 64 + jj];
      a.mod[(size_t)q * 6144 + cb * 64 + jj] = s; }
    __syncthreads(); }
  __syncthreads();
}
__device__ __forceinline__ void hid_phase(const NaiveBufs& a, int l, int n, float* dst, LAS unsigned char* lds) {
  int tz = threadIdx.x; asm volatile("" : "+v"(tz));
  LAS float* Z = (LAS float*)(lds + 40960); LAS float* H1 = Z + 8 * 36;
  const float* w1 = a.hy_pos_w1 + (size_t)l * 33 * 64; const float* b1 = a.hy_pos_b1 + l * 64; const float* fr = a.hy_sin_freq + l * 64;
  const float* w2 = a.hy_pos_w2 + (size_t)l * 64 * 64; const float* b2 = a.hy_pos_b2 + l * 64;
  const float w0 = 2.f * 3.14159265358979323846f / (float)n;
  for (int t0 = blockIdx.x * 8; t0 < n; t0 += gridDim.x * 8) {
    if (tz < 8 * 33) { const int tt = tz / 33, e = tz % 33, t = t0 + tt; float v;
      if (e == 0) v = (float)t / (float)n; else { const int bnd = (e - 1) & 15; const float band = 1e-4f + (float)bnd * (15.f - 1e-4f) / 15.f; const float ph = w0 * (float)t * band; v = e <= 16 ? cosf(ph) : -sinf(ph); }
      Z[tt * 36 + e] = v; }
    __syncthreads();
    { const int tt = tz >> 6, i = tz & 63; float acc = b1[i];
#pragma unroll
      for (int e = 0; e < 33; ++e) acc += Z[tt * 36 + e] * w1[e * 64 + i];
      H1[tt * 64 + i] = sinf(fr[i] * acc); }
    __syncthreads();
    { const int tt = tz >> 6, j = tz & 63; float acc = b2[j];
#pragma unroll 8
      for (int i = 0; i < 64; ++i) acc += H1[tt * 64 + i] * w2[i * 64 + j];
      if (t0 + tt < n) dst[(size_t)(t0 + tt) * 64 + j] = sinf(fr[j] * acc); }
    __syncthreads();
  }
}
__device__ __forceinline__ void nrmS_phase(const NaiveBufs& a) {
  int tz = threadIdx.x; asm volatile("" : "+v"(tz)); const int lane = tz & 63, wave = __builtin_amdgcn_readfirstlane(tz >> 6);
  for (int oc = blockIdx.x * NWAVES + wave; oc < 1024; oc += gridDim.x * NWAVES) { const float* tp = a.tapsS + (size_t)oc * 8192; float s = 0.f;
#pragma unroll 8
    for (int k = lane; k < 8192; k += 64) s += fabsf(tp[k]);
    s = moe::wave_sum(s); if (lane == 0) a.nrmS[oc] = s + 1e-6f; }
}
constexpr int TCOPY = 8232;
__device__ __forceinline__ void tapsB_phase(const NaiveBufs& a, int l, bf16_t* tapsB, LAS unsigned char* lds) {
  int tz = threadIdx.x; asm volatile("" : "+v"(tz));
  const float* w3 = a.hy_pos_w3 + (size_t)l * 64 * 2048; const float* dcy = a.hy_decay + (size_t)l * 2048;
  typedef float f4 __attribute__((ext_vector_type(4)));
  LAS float* W = (LAS float*)lds;
  for (int cp = blockIdx.x; cp < 256; cp += gridDim.x) {
    __syncthreads();
    { const int ch = tz >> 8, e = tz & 255, c = cp + 256 * ch; W[tz] = w3[(size_t)(e >> 2) * 2048 + (e & 3) * 512 + c]; if (tz < 8) W[512 + tz] = fabsf(dcy[(tz & 3) * 512 + cp + 256 * (tz >> 2)]); }
    __syncthreads();
    for (int t = tz; t < 4096; t += NTHREADS) {
      const f4* h2 = (const f4*)(a.hid2S + (size_t)t * 64); f4 acc0 = {0.f, 0.f, 0.f, 0.f}, acc1 = {0.f, 0.f, 0.f, 0.f};
#pragma unroll 4
      for (int j4 = 0; j4 < 16; ++j4) { const f4 h = h2[j4];
#pragma unroll
        for (int e = 0; e < 4; ++e) { acc0 += h[e] * *(const LAS f4*)(W + (4 * j4 + e) * 4); acc1 += h[e] * *(const LAS f4*)(W + 256 + (4 * j4 + e) * 4); } }
      const float tn = (float)t * (1.f / 4096.f);
#pragma unroll
      for (int ch = 0; ch < 2; ++ch)
#pragma unroll
        for (int q = 0; q < 4; ++q) { const int o = q >> 1, dir = q & 1; if (dir == 1 && t == 0) continue; const int c = cp + 256 * ch;
          const bf16_t bv = (bf16_t)f2bf((ch ? acc1[q] : acc0[q]) * __expf(-tn * W[512 + 4 * ch + q]));
          bf16_t* base = tapsB + ((size_t)o * 512 + c) * 2 * TCOPY; const int x0 = dir ? 4096 + t : 4096 - t;
          base[x0] = bv; base[TCOPY + x0 - 1] = bv; } } }
  for (long idx = (long)blockIdx.x * NTHREADS + tz; idx < 1024L * 96; idx += (long)gridDim.x * NTHREADS) { const int oc = (int)(idx / 96), e = (int)(idx % 96); bf16_t* base = tapsB + (size_t)oc * 2 * TCOPY;
    if (e < 40) base[8192 + e] = 0; else if (e < 81) base[TCOPY + 8191 + (e - 40)] = 0; else if (e == 81) base[0] = 0; }
}
__device__ __forceinline__ void nrmB_phase(const NaiveBufs& a, const bf16_t* tapsB) {
  int tz = threadIdx.x; asm volatile("" : "+v"(tz)); const int lane = tz & 63, wave = __builtin_amdgcn_readfirstlane(tz >> 6);
  for (int oc = blockIdx.x * NWAVES + wave; oc < 1024; oc += gridDim.x * NWAVES) { const bf16_t* tp = tapsB + (size_t)oc * 2 * TCOPY; float s = 0.f;
#pragma unroll 8
    for (int k = lane; k < 8192; k += 64) s += fabsf(bf2f(tp[k]));
    s = moe::wave_sum(s); if (lane == 0) a.nrmS[oc] = s + 1e-6f; }
}
}
using TD = FullDims;
using dd = DD<TD>;
constexpr int GB = 4, NGRP = 2, RB = dd::R  , RG = GB * RB, PLD = dd::NIN, PANELS = RG / 256, PPB = RB / 256  ;
constexpr size_t BAR_BYTES = 16384 + 4 * 4096; constexpr int CNT_OFF = 16384;
constexpr int MPG = 38912;
constexpr size_t CS_BYTES = (size_t)2 * 4 * 68 * 64 * 128 * 4, DEC_BYTES = (size_t)2 * 4 * 68 * 64 * 4;
constexpr size_t UCT_BYTES = (size_t)1536 * 4096 * 2, YT_BYTES = (size_t)512 * 4096 * 2, UCC_BYTES = (size_t)256 * 1536 * 4, Z1C_BYTES = (size_t)256 * 512 * 4;
constexpr size_t MIX_BYTES = GB * (CS_BYTES + DEC_BYTES) > GB * (UCT_BYTES + YT_BYTES + UCC_BYTES + Z1C_BYTES) ? GB * (CS_BYTES + DEC_BYTES) : GB * (UCT_BYTES + YT_BYTES + UCC_BYTES + Z1C_BYTES);

struct KArgs { NaiveBufs a; unsigned* bar; int* cnt; bf16_t *WinT, *WhyT, *WglaT, *WattT, *WoutT, *WguT, *WdT, *hb, *proj; unsigned char* mix;
  bf16_t *hp, *hid, *contrib; int* srcrow; float* wgt; moe::Route* route; float* wts; };

struct EpiProjBf16 {
  static constexpr bool PERM = true, AFTER_DRAIN = false;
  bf16_t* P;
  __device__ __forceinline__ void operator()(const pg8::f32x4 (&acc)[2][2][4][2], const pg8::Unit& u, int wr, int wc, int fr, int fq) const {
    const int row0 = u.pm * 256 + wr * 64 + fr, col0 = u.pn * 256 + wc * 32 + 8 * fq;
#pragma unroll
    for (int ai = 0; ai < 2; ++ai)
#pragma unroll
      for (int m = 0; m < 4; ++m) { bf16_t* rowp = P + (size_t)(row0 + ai * 128 + m * 16) * PLD + col0;
#pragma unroll
        for (int bj = 0; bj < 2; ++bj) if (col0 + bj * 128 < PLD) { const pg8::f32x4 v0 = acc[ai][bj][m][0], v1 = acc[ai][bj][m][1];
          v4u o; o.x = pk2(v0[0], v0[1]); o.y = pk2(v0[2], v0[3]); o.z = pk2(v1[0], v1[1]); o.w = pk2(v1[2], v1[3]); *(v4u*)(rowp + bj * 128) = o; } }
  }
};
template <bool ACCUM> struct EpiMergeB {
  static constexpr bool PERM = true, AFTER_DRAIN = false;
  const bf16_t* gate; bf16_t* M;
  __device__ __forceinline__ void operator()(const pg8::f32x4 (&acc)[2][2][4][2], const pg8::Unit& u, int wr, int wc, int fr, int fq) const {
    const int row0 = u.pm * 256 + wr * 64 + fr, col0 = u.pn * 256 + wc * 32 + 8 * fq;
#pragma unroll
    for (int ai2 = 0; ai2 < 4; ++ai2) { const int ai = ai2 >> 1, m0 = (ai2 & 1) * 2;
      v4u gw[4][2], mo[4][2];
#pragma unroll
      for (int m = m0; m < m0 + 2; ++m)
#pragma unroll
        for (int bj = 0; bj < 2; ++bj) { const size_t r = (size_t)(row0 + ai * 128 + m * 16); const int c = col0 + bj * 128; gw[m][bj] = *(const v4u*)(gate + r * PLD + c); if (ACCUM) mo[m][bj] = *(const v4u*)(M + r * 1024 + c); }
#pragma unroll
      for (int m = m0; m < m0 + 2; ++m)
#pragma unroll
        for (int bj = 0; bj < 2; ++bj) { const size_t r = (size_t)(row0 + ai * 128 + m * 16); const int c = col0 + bj * 128; const v4u g4 = gw[m][bj];
          pg8::f32x4 v0 = acc[ai][bj][m][0], v1 = acc[ai][bj][m][1];
          v0[0] *= fsigmoid(bf2f(g4.x & 0xffff)); v0[1] *= fsigmoid(bf2f(g4.x >> 16)); v0[2] *= fsigmoid(bf2f(g4.y & 0xffff)); v0[3] *= fsigmoid(bf2f(g4.y >> 16));
          v1[0] *= fsigmoid(bf2f(g4.z & 0xffff)); v1[1] *= fsigmoid(bf2f(g4.z >> 16)); v1[2] *= fsigmoid(bf2f(g4.w & 0xffff)); v1[3] *= fsigmoid(bf2f(g4.w >> 16));
          if (ACCUM) { const v4u o = mo[m][bj]; v0[0] += bf2f(o.x & 0xffff); v0[1] += bf2f(o.x >> 16); v0[2] += bf2f(o.y & 0xffff); v0[3] += bf2f(o.y >> 16);
            v1[0] += bf2f(o.z & 0xffff); v1[1] += bf2f(o.z >> 16); v1[2] += bf2f(o.w & 0xffff); v1[3] += bf2f(o.w >> 16); }
          v4u o2; o2.x = pk2(v0[0], v0[1]); o2.y = pk2(v0[2], v0[3]); o2.z = pk2(v1[0], v1[1]); o2.w = pk2(v1[2], v1[3]); *(v4u*)(M + r * 1024 + c) = o2; } }
  }
};
struct EpiOutG {
  static constexpr bool PERM = false, AFTER_DRAIN = false;
  const float* resL; float* outL; const float* resC; float* outC; const float* mod; int b0; bool ctx_on;
  __device__ __forceinline__ void operator()(const pg8::f32x4 (&acc)[2][2][4][2], const pg8::Unit& u, int wr, int wc, int fr, int fq) const {
    const int bl = u.pm / PPB, lp = u.pm % PPB; const bool isc = lp == PPB - 1; if (isc && !ctx_on) return;
    const int b = b0 + bl;
    const float* res = isc ? resC + (size_t)b * dd::C * 1024 : resL + ((size_t)b * dd::S + lp * 256) * 1024;
    float* out = isc ? outC + (size_t)b * dd::C * 1024 : outL + ((size_t)b * dd::S + lp * 256) * 1024;
    const float* gv = mod + (size_t)(isc ? dd::B : b) * 6 * 1024 + 2 * 1024;
    const int row0 = wr * 64 + fr, col0 = u.pn * 256 + wc * 32 + 4 * fq;
    pg8::f32x4 gg[2][2];
#pragma unroll
    for (int bj = 0; bj < 2; ++bj)
#pragma unroll
      for (int n = 0; n < 2; ++n) gg[bj][n] = *(const pg8::f32x4*)(gv + col0 + bj * 128 + n * 16);
#pragma unroll
    for (int ai2 = 0; ai2 < 4; ++ai2) { const int ai = ai2 >> 1, m0 = (ai2 & 1) * 2;
      pg8::f32x4 rv[4][2][2];
#pragma unroll
      for (int m = m0; m < m0 + 2; ++m)
#pragma unroll
        for (int bj = 0; bj < 2; ++bj)
#pragma unroll
          for (int n = 0; n < 2; ++n) rv[m][bj][n] = *(const pg8::f32x4*)(res + (size_t)(row0 + ai * 128 + m * 16) * 1024 + col0 + bj * 128 + n * 16);
#pragma unroll
      for (int m = m0; m < m0 + 2; ++m)
#pragma unroll
        for (int bj = 0; bj < 2; ++bj)
#pragma unroll
          for (int n = 0; n < 2; ++n) *(pg8::f32x4*)(out + (size_t)(row0 + ai * 128 + m * 16) * 1024 + col0 + bj * 128 + n * 16) = rv[m][bj][n] + gg[bj][n] * acc[ai][bj][m][n]; }
  }
};
struct GroupOrder {
  int nN, nwg, G, c; bool lat;
  __device__ void init(int N, int G_, int c_, bool lat_) { nN = N / 256; lat = lat_; nwg = (lat ? GB * 16 : PANELS) * nN; G = G_; c = c_; }
  __device__ __forceinline__ bool next(int i, pg8::Unit& u) const { const long L = (long)i * G + c; if (L >= nwg) return false; const int p = (int)L / nN; u.pm = lat ? (p >> 4) * PPB + (p & 15) : p; u.pn = (int)L % nN; u.acol = 0; return true; }
  __device__ __forceinline__ void a_ready(const pg8::Unit&) const {}
  __device__ __forceinline__ void done(const pg8::Unit&) const {}
};
struct MergeOrder {
  int ntiles, G, c; bool lat;
  __device__ void init(int G_, int c_, bool lat_) { lat = lat_; ntiles = (lat ? GB * 16 : PANELS) * 4; G = G_; c = c_; }
  __device__ __forceinline__ bool next(int i, pg8::Unit& u) const { const int rnd = i >> 2, gi = i & 3; const long tile = (long)rnd * G + c; if (tile >= ntiles) return false; const int p = (int)tile >> 2;
    u.pm = lat ? (p >> 4) * PPB + (p & 15) : p; u.pn = gi * 4 + ((int)tile & 3); u.acol = gi == 0 ? dd::O_HY : gi == 1 ? dd::O_OG : gi == 2 ? dd::O_AQ : dd::O_AQ + 512; return true; }
  __device__ __forceinline__ void a_ready(const pg8::Unit&) const {}
  __device__ __forceinline__ void done(const pg8::Unit&) const {}
};
struct EpiMergeS {
  static constexpr bool PERM = true, AFTER_DRAIN = false;
  const bf16_t* gate0; bf16_t* M;
  __device__ __forceinline__ void operator()(const pg8::f32x4 (&acc)[2][2][4][2], const pg8::Unit& u, int wr, int wc, int fr, int fq) const {
    const int gi = u.pn >> 2; const bool accum = gi > 0; const bf16_t* gate = gate0 + (gi > 2 ? 2 : gi) * 1024;
    const int row0 = u.pm * 256 + wr * 64 + fr, col0 = (u.pn & 3) * 256 + wc * 32 + 8 * fq;
#pragma unroll
    for (int ai = 0; ai < 2; ++ai)
#pragma unroll
      for (int m = 0; m < 4; ++m) { const size_t r = (size_t)(row0 + ai * 128 + m * 16);
#pragma unroll
        for (int bj = 0; bj < 2; ++bj) { const int c = col0 + bj * 128; const v4u gw = *(const v4u*)(gate + r * PLD + c);
          pg8::f32x4 v0 = acc[ai][bj][m][0], v1 = acc[ai][bj][m][1];
          v0[0] *= fsigmoid(bf2f(gw.x & 0xffff)); v0[1] *= fsigmoid(bf2f(gw.x >> 16)); v0[2] *= fsigmoid(bf2f(gw.y & 0xffff)); v0[3] *= fsigmoid(bf2f(gw.y >> 16));
          v1[0] *= fsigmoid(bf2f(gw.z & 0xffff)); v1[1] *= fsigmoid(bf2f(gw.z >> 16)); v1[2] *= fsigmoid(bf2f(gw.w & 0xffff)); v1[3] *= fsigmoid(bf2f(gw.w >> 16));
          v4u* dst = (v4u*)(M + r * 1024 + c);
          if (accum) { const v4u o = *dst; v0[0] += bf2f(o.x & 0xffff); v0[1] += bf2f(o.x >> 16); v0[2] += bf2f(o.y & 0xffff); v0[3] += bf2f(o.y >> 16);
            v1[0] += bf2f(o.z & 0xffff); v1[1] += bf2f(o.z >> 16); v1[2] += bf2f(o.w & 0xffff); v1[3] += bf2f(o.w >> 16); }
          v4u o2; o2.x = pk2(v0[0], v0[1]); o2.y = pk2(v0[2], v0[3]); o2.z = pk2(v1[0], v1[1]); o2.w = pk2(v1[2], v1[3]); *dst = o2; } }
  }
};
__device__ __forceinline__ const float* xrow_in(const NaiveBufs& a, int l, int b, int r) {
  if (r < dd::S) return (l == 0 ? a.x : (const float*)a.out) + ((size_t)b * dd::S + r) * 1024;
  return (l == 0 ? a.ctx : (const float*)a.xc) + ((size_t)b * dd::C + (r - dd::S)) * 1024;
}
__device__ __forceinline__ float* xrow_cur(const NaiveBufs& a, int b, int r) {
  if (r < dd::S) return a.out + ((size_t)b * dd::S + r) * 1024;
  return a.xc + ((size_t)b * dd::C + (r - dd::S)) * 1024;
}
__device__ __forceinline__ void norm_row(const float* xr, const float* gnorm, const float* shift, const float* scale, bf16_t* hrow, int lane) {
  typedef float f4 __attribute__((ext_vector_type(4)));
  f4 xv[4]; float ss = 0.f;
#pragma unroll
  for (int j = 0; j < 4; ++j) { xv[j] = *(const f4*)(xr + 4 * lane + 256 * j); ss += xv[j][0] * xv[j][0] + xv[j][1] * xv[j][1] + xv[j][2] * xv[j][2] + xv[j][3] * xv[j][3]; }
  const float rs = 1.f / sqrtf(moe::wave_sum(ss) * (1.f / 1024.f) + 1e-6f);
#pragma unroll
  for (int j = 0; j < 4; ++j) { const int c = 4 * lane + 256 * j; const f4 g4 = *(const f4*)(gnorm + c), sh = *(const f4*)(shift + c), sc = *(const f4*)(scale + c);
    f4 h;
#pragma unroll
    for (int i = 0; i < 4; ++i) h[i] = xv[j][i] * rs * g4[i] * (1.f + sc[i]) + sh[i];
    *(unsigned long long*)(hrow + c) = (unsigned long long)pk2(h[0], h[1]) | ((unsigned long long)pk2(h[2], h[3]) << 32); }
}
__device__ __forceinline__ void qknorm_row(bf16_t* prow, const float* qg, const float* kg, int r, int lane) {
  const bool lat = r < dd::S; const int grow = r / dd::GW, gcol = r % dd::GW;
  const int fi = lane & 31; const float pos = (lane < 32) ? (float)grow : (float)gcol;
  const float ang = pos * __builtin_amdgcn_exp2f(-(float)fi * (13.287712379549449f / 32.f));
  const float cs = lat ? __cosf(ang) : 1.f, sn = lat ? __sinf(ang) : 0.f;
  unsigned wv[10];
#pragma unroll
  for (int hh = 0; hh < 10; ++hh) wv[hh] = *((const unsigned*)(prow + (hh < 8 ? dd::O_AQ + hh * 128 : dd::O_AK + (hh - 8) * 128)) + lane);
  float ss[10];
#pragma unroll
  for (int hh = 0; hh < 10; ++hh) { const float x1 = bf2f(wv[hh] & 0xffff), x2 = bf2f(wv[hh] >> 16); ss[hh] = x1 * x1 + x2 * x2; }
#pragma unroll
  for (int o = 1; o < 64; o <<= 1) {
#pragma unroll
    for (int hh = 0; hh < 10; ++hh) ss[hh] += __shfl_xor(ss[hh], o); }
  const float q1 = qg[2 * lane], q2 = qg[2 * lane + 1], k1 = kg[2 * lane], k2 = kg[2 * lane + 1];
#pragma unroll
  for (int hh = 0; hh < 10; ++hh) { unsigned* p = (unsigned*)(prow + (hh < 8 ? dd::O_AQ + hh * 128 : dd::O_AK + (hh - 8) * 128)) + lane;
    const float x1 = bf2f(wv[hh] & 0xffff), x2 = bf2f(wv[hh] >> 16); const float rs = 1.f / sqrtf(ss[hh] * (1.f / 128.f) + 1e-6f);
    const float y1 = x1 * rs * (hh < 8 ? q1 : k1), y2 = x2 * rs * (hh < 8 ? q2 : k2);
    *p = pk2(y1 * cs - y2 * sn, y1 * sn + y2 * cs); }
}

__global__ void __launch_bounds__(NTHREADS, 2) mega_kernel(KArgs ka_unused) {
  extern __shared__ __attribute__((aligned(16))) unsigned char lds_raw[];
  LAS unsigned char* lds = (LAS unsigned char*)lds_raw;
  volatile LAS unsigned* MISC = (volatile LAS unsigned*)(lds + MISC_OFF);
  constexpr int ARGS_OFF = MISC_OFF + 256;
  static_assert(ARGS_OFF + sizeof(KArgs) <= LDS_BYTES, "LDS map");
  { const unsigned __attribute__((address_space(4)))* kp = (const unsigned __attribute__((address_space(4)))*)__builtin_amdgcn_kernarg_segment_ptr();
    for (int i = threadIdx.x; i < (int)(sizeof(KArgs) / 4); i += NTHREADS) ((LAS unsigned*)(lds + ARGS_OFF))[i] = kp[i]; }
  if (threadIdx.x < 64) MISC[threadIdx.x] = 0u;
  __syncthreads();
  const KArgs& ka = *(const KArgs*)(const LAS KArgs*)(lds + ARGS_OFF);
  const NaiveBufs& a = ka.a;
  unsigned* bar_s; { const unsigned long long bp = (unsigned long long)ka.bar; const unsigned lo_ = __builtin_amdgcn_readfirstlane((unsigned)bp), hi_ = __builtin_amdgcn_readfirstlane((unsigned)(bp >> 32));
    bar_s = (unsigned*)(((unsigned long long)hi_ << 32) | lo_); }
  XcdBarrier xb = xcd_barrier_post(bar_s, MISC);
#define SPTR(T, name, src) T* name; { const unsigned long long bp_ = (unsigned long long)(src); const unsigned lo_ = __builtin_amdgcn_readfirstlane((unsigned)bp_), hi_ = __builtin_amdgcn_readfirstlane((unsigned)(bp_ >> 32)); name = (T*)(((unsigned long long)hi_ << 32) | lo_); }
  SPTR(bf16_t, proj_s, ka.proj) SPTR(bf16_t, hb_s, ka.hb) SPTR(unsigned char, mix_s, ka.mix)
  const long gs = (long)gridDim.x * NTHREADS;
  LAS int* poff = (LAS int*)(lds + MISC_OFF + 64);
#define TID_SETUP int tz = threadIdx.x; asm volatile("" : "+v"(tz)); const int lane = tz & 63, wave = __builtin_amdgcn_readfirstlane(tz >> 6); \
    const int gw = blockIdx.x * NWAVES + wave, NGW = gridDim.x * NWAVES; const long gt = (long)blockIdx.x * NTHREADS + tz; (void)lane; (void)gw; (void)NGW; (void)gt;
#define LSTAGE(ST) { TID_SETUP const long n_ = stage_items<TD>(ST, l); for (long i_ = gt; i_ < n_; i_ += gs) stage_run<TD, ST>(a, l, 0, i_); }
  for (int l = 0; l < dd::DEPTH; ++l) {
    const bool last = (l == dd::DEPTH - 1);
    { TID_SETUP
      LAS float* scr = (LAS float*)(lds + RING_OFF + wave * 16384);
      constexpr int NIT = (dd::D / 64) * (dd::NIN / 32);
      for (int it = gw; it < NIT; it += NGW) transpose_item(a.w_in + (size_t)l * dd::D * dd::NIN, dd::D, dd::NIN, ka.WinT, 0, scr, it, lane);
      { constexpr int I0 = (dd::HW / 64) * (dd::D / 32), I1 = (dd::GVW / 64) * (dd::D / 32), I2 = (dd::AQW / 64) * (dd::D / 32), I3 = (dd::D / 64) * (dd::D / 32);
        for (int it = gw; it < I0 + I1 + I2 + I3; it += NGW) { int r = it;
          if (r < I0) { transpose_item(a.w_br_hy + (size_t)l * dd::HW * dd::D, dd::HW, dd::D, ka.WhyT, 0, scr, r, lane); continue; } r -= I0;
          if (r < I1) { transpose_item(a.w_br_gla + (size_t)l * dd::GVW * dd::D, dd::GVW, dd::D, ka.WglaT, 0, scr, r, lane); continue; } r -= I1;
          if (r < I2) { transpose_item(a.w_br_att + (size_t)l * dd::AQW * dd::D, dd::AQW, dd::D, ka.WattT, 0, scr, r, lane); continue; } r -= I2;
          transpose_item(a.w_out + (size_t)l * dd::D * dd::D, dd::D, dd::D, ka.WoutT, 0, scr, r, lane); } }
      { constexpr int IG = (dd::D / 64) * (dd::DE / 32), IDN = (dd::DE / 64) * (dd::D / 32);
        for (int it = gw; it < dd::NE * (2 * IG + IDN); it += NGW) { const int e = it / (2 * IG + IDN); int r = it % (2 * IG + IDN);
          if (r < 2 * IG) { const int up = r >= IG; if (up) r -= IG; const int n0 = 32 * (r % (dd::DE / 32));
            transpose_item((up ? a.moe_w_up : a.moe_w_gate) + ((size_t)l * dd::NE + e) * dd::D * dd::DE, dd::D, dd::DE, ka.WguT, e * 1024 + 128 * (n0 >> 7) + (up ? 128 : 0), scr, r, lane); }
          else { r -= 2 * IG; transpose_item(a.moe_w_down + ((size_t)l * dd::NE + e) * dd::DE * dd::D, dd::DE, dd::D, ka.WdT, e * 1024, scr, r, lane); } } }
      for (long i = gt; i < (long)(NINP - dd::NIN) * dd::D / 8; i += gs) { unsigned z_ = 0u; asm volatile("" : "+v"(z_)); *(v4u*)(ka.WinT + (size_t)dd::NIN * dd::D + i * 8) = (v4u){z_, z_, z_, z_}; }
    }
    pro::mod_phase(a, l, lds); pro::hid_phase(a, l, dd::S, a.hid2S, lds); if (!last) pro::hid_phase(a, l, dd::C, a.hid2C, lds);
    xcd_barrier(xb);
    pro::tapsB_phase(a, l, (bf16_t*)a.tapsS, lds); if (!last) LSTAGE(L_TAPS_C)
    xcd_barrier(xb);
    pro::nrmB_phase(a, (const bf16_t*)a.tapsS); if (!last) LSTAGE(L_NRM_C)
    xcd_barrier(xb);
    for (int grp = 0; grp < NGRP; ++grp) {
      const int b0 = grp * GB;
      { TID_SETUP
        for (int rg = gw; rg < RG; rg += NGW) { const int bl = rg / RB, r = rg % RB, b = b0 + bl; const float* md = a.mod + (size_t)(r < dd::S ? b : dd::B) * 6 * 1024;
          norm_row(xrow_in(a, l, b, r), a.norm1_g + (size_t)l * 1024, md, md + 1024, hb_s + (size_t)rg * 1024, lane); }
        xcd_barrier(xb); }
      { pg8::Gemm g{hb_s, ka.WinT, RG, NINP, dd::D, 0}; pg8::StaticOrder S; S.init(RG, NINP, (int)gridDim.x, (int)blockIdx.x); EpiProjBf16 E{proj_s};
        pg8::gemm_phase<EpiProjBf16, pg8::StaticOrder, false>((PG8_LAS unsigned char*)(lds + RING_OFF), g, S, E, nullptr);
        xcd_barrier(xb); }
      { TID_SETUP
        for (int rg = gw; rg < RG; rg += NGW) qknorm_row(proj_s + (size_t)rg * PLD, a.q_norm_g + (size_t)l * 128, a.k_norm_g + (size_t)l * 128, rg % RB, lane);
        for (int u = blockIdx.x; u < GB * 4 * 68; u += gridDim.x) { const int bl = u / (4 * 68), hu = u % (4 * 68); const bf16_t* pb = proj_s + (size_t)bl * RB * PLD;
          gla::In gp; gp.q = pb + dd::O_GQ; gp.k = pb + dd::O_GK; gp.v = pb + dd::O_GV; gp.ga = pb + dd::O_GA; gp.og = pb + dd::O_OG; gp.ld = PLD;
          gp.wa2 = a.gla_wa2 + (size_t)l * 2 * 16 * 256; gp.ba = a.gla_ba + (size_t)l * 2 * 256; gp.gnorm = a.gla_norm_g + (size_t)l * 128;
          gp.cs = (float*)(mix_s + (size_t)bl * CS_BYTES); gp.dec = (float*)(mix_s + (size_t)GB * CS_BYTES + (size_t)bl * DEC_BYTES); gp.y = (bf16_t*)pb + dd::O_OG; gp.ldy = PLD; gp.S = dd::S; gp.C = dd::C;
          gla::g1_unit(gp, lds, hu / 68, hu % 68, 4, 68); }
        xcd_barrier(xb); }
      { TID_SETUP
        for (long i_ = gt; i_ < (long)GB * 2 * 4 * 64 * 128; i_ += gs) { const int bl = (int)(i_ / (2 * 4 * 64 * 128)); gla::In gp; gp.cs = (float*)(mix_s + (size_t)bl * CS_BYTES); gp.dec = (float*)(mix_s + (size_t)GB * CS_BYTES + (size_t)bl * DEC_BYTES); gp.S = dd::S; gp.C = dd::C;
          gla::g2_item(gp, i_ % (2 * 4 * 64 * 128), 4, 68); }
        const int combo = blockIdx.x & 7, slot = blockIdx.x >> 3, nslot = gridDim.x >> 3;
        const int per_combo = 64 + (last ? 0 : 4);
        const bool xcdm = (gridDim.x & 7) == 0;
        for (int uu = xcdm ? slot : (int)blockIdx.x; uu < (xcdm ? per_combo : 8 * per_combo); uu += xcdm ? nslot : (int)gridDim.x) { const int cmb = xcdm ? combo : uu / per_combo, ui = xcdm ? uu : uu % per_combo;
          const bool lat = ui < 64; const int bl = cmb >> 1, kvh = cmb & 1;
          const int head = kvh * 4 + (lat ? ui >> 4 : ui - 64), qb = lat ? ui & 15 : 0;
          bf16_t* pb = proj_s + (size_t)bl * RB * PLD; const size_t qrow = lat ? (size_t)qb * 256 : (size_t)dd::S, krow = lat ? 0 : (size_t)dd::S;
          att::attn_dense_body<att::bf16, PLD, PLD, 1024, true>((const att::bf16*)(pb + qrow * PLD + dd::O_AQ + head * 128), (const att::bf16*)(pb + krow * PLD + dd::O_AK + kvh * 128),
              (const att::bf16*)(pb + krow * PLD + dd::O_AV + kvh * 128), hb_s + ((size_t)bl * RB + qrow) * 1024 + head * 128, lat ? RB : dd::C, (char*)lds_raw);
          __syncthreads(); }
        xcd_barrier(xb); }
      { const int n3 = last ? 64 : 68;
        for (int u = blockIdx.x; u < GB * 4 * n3; u += gridDim.x) { const int bl = u / (4 * n3), hu = u % (4 * n3); const bf16_t* pb = proj_s + (size_t)bl * RB * PLD;
          gla::In gp; gp.q = pb + dd::O_GQ; gp.k = pb + dd::O_GK; gp.v = pb + dd::O_GV; gp.ga = pb + dd::O_GA; gp.og = pb + dd::O_OG; gp.ld = PLD;
          gp.wa2 = a.gla_wa2 + (size_t)l * 2 * 16 * 256; gp.ba = a.gla_ba + (size_t)l * 2 * 256; gp.gnorm = a.gla_norm_g + (size_t)l * 128;
          gp.cs = (float*)(mix_s + (size_t)bl * CS_BYTES); gp.dec = (float*)(mix_s + (size_t)GB * CS_BYTES + (size_t)bl * DEC_BYTES); gp.y = (bf16_t*)pb + dd::O_OG; gp.ldy = PLD; gp.S = dd::S; gp.C = dd::C;
          gla::g3_unit(gp, lds, hu / n3, hu % n3, 4, 68); }
        xcd_barrier(xb); }
      {
        bf16_t* ucT0 = (bf16_t*)mix_s; bf16_t* yT0 = (bf16_t*)(mix_s + GB * UCT_BYTES); float* ucc0 = (float*)(mix_s + GB * (UCT_BYTES + YT_BYTES)); float* z1c0 = (float*)(mix_s + GB * (UCT_BYTES + YT_BYTES + UCC_BYTES));
        const float* cw = a.hy_conv_w + (size_t)l * 3 * 1536; const float* cb = a.hy_conv_b + (size_t)l * 1536; const float* skp = a.hy_skip + (size_t)l * 2 * 512;
        { TID_SETUP
        { int t_ = blockIdx.x; hy::H0Regs hr = hy::h0_load(proj_s + (size_t)(t_ / (64 * 24)) * RB * PLD + dd::O_HY, PLD, t_ % (64 * 24), tz);
          for (; t_ < GB * 64 * 24; t_ += gridDim.x) { const int bl = t_ / (64 * 24), tn_ = t_ + gridDim.x; hy::H0Regs hn = hr;
            if (tn_ < GB * 64 * 24) hn = hy::h0_load(proj_s + (size_t)(tn_ / (64 * 24)) * RB * PLD + dd::O_HY, PLD, tn_ % (64 * 24), tz);
            hy::h0_compute(hr, cw, cb, ucT0 + (size_t)bl * 1536 * 4096, t_ % (64 * 24), lds, tz); hr = hn; } }
        if (!last) for (long i_ = gt; i_ < (long)GB * 256 * 1536; i_ += gs) { const int bl = (int)(i_ / (256 * 1536)); hy::cconv3_item(proj_s + ((size_t)bl * RB + dd::S) * PLD + dd::O_HY, PLD, cw, cb, ucc0 + (size_t)bl * 256 * 1536, i_ % (256 * 1536)); } }
        xcd_barrier(xb);
        { TID_SETUP
        for (int u = blockIdx.x; u < GB * 512; u += gridDim.x) { const int bl = u / 512; hy::h1b_unit(ucT0 + (size_t)bl * 1536 * 4096, (const bf16_t*)a.tapsS, a.nrmS, skp, yT0 + (size_t)bl * 512 * 4096, u % 512, lds); }
        if (!last) for (long i_ = gt; i_ < (long)GB * 64 * 512; i_ += gs) { const int bl = (int)(i_ / (64 * 512)); hy::clong_item(ucc0 + (size_t)bl * 256 * 1536, nullptr, z1c0 + (size_t)bl * 256 * 512, nullptr, 0, a.tapsC, a.nrmC, skp, 0, i_ % (64 * 512)); } }
        xcd_barrier(xb);
        { TID_SETUP
        for (int t_ = blockIdx.x; t_ < GB * 64 * 8; t_ += gridDim.x) { const int bl = t_ / (64 * 8); hy::h2_tile(yT0 + (size_t)bl * 512 * 4096, proj_s + (size_t)bl * RB * PLD + dd::O_HY, PLD, t_ % (64 * 8), lds); }
        if (!last) for (long i_ = gt; i_ < (long)GB * 64 * 512; i_ += gs) { const int bl = (int)(i_ / (64 * 512)); hy::clong_item(ucc0 + (size_t)bl * 256 * 1536, z1c0 + (size_t)bl * 256 * 512, nullptr, proj_s + ((size_t)bl * RB + dd::S) * PLD + dd::O_HY, PLD, a.tapsC, a.nrmC, skp, 1, i_ % (64 * 512)); } }
        xcd_barrier(xb); }
      { { pg8::Gemm g{proj_s + dd::O_HY, ka.WhyT, RG, 1024, 512, PLD}; GroupOrder S; S.init(1024, (int)gridDim.x, (int)blockIdx.x, last);
          EpiMergeB<false> E{proj_s + dd::O_BR, (bf16_t*)mix_s}; pg8::gemm_phase<EpiMergeB<false>, GroupOrder, false>((PG8_LAS unsigned char*)(lds + RING_OFF), g, S, E, nullptr); }
        for (int gi = 1; gi < 3; ++gi) { const bool at = gi == 2;
          pg8::Gemm g{at ? (const bf16_t*)hb_s : (const bf16_t*)(proj_s + dd::O_OG), at ? ka.WattT : ka.WglaT, RG, 1024, at ? 1024 : 512, at ? 1024 : PLD}; GroupOrder S; S.init(1024, (int)gridDim.x, (int)blockIdx.x, last);
          EpiMergeB<true> E{proj_s + dd::O_BR + gi * 1024, (bf16_t*)mix_s}; pg8::gemm_phase<EpiMergeB<true>, GroupOrder, false>((PG8_LAS unsigned char*)(lds + RING_OFF), g, S, E, nullptr); }
        xcd_barrier(xb);
        pg8::Gemm g{(const bf16_t*)mix_s, ka.WoutT, RG, 1024, 1024, 0}; GroupOrder S; S.init(1024, (int)gridDim.x, (int)blockIdx.x, last);
        EpiOutG E{l == 0 ? a.x : (const float*)a.out, a.out, l == 0 ? a.ctx : (const float*)a.xc, a.xc, a.mod, b0, !last};
        pg8::gemm_phase<EpiOutG, GroupOrder, false>((PG8_LAS unsigned char*)(lds + RING_OFF), g, S, E, nullptr);
        xcd_barrier(xb); }
      {
        { TID_SETUP int* cnt = ka.cnt + (l * NGRP + grp) * 1024;
          LAS float* rwT = (LAS float*)(lds + RING_OFF);
          for (int k = tz; k < 1024; k += NTHREADS) {
#pragma unroll
            for (int e = 0; e < 16; ++e) rwT[e * 1024 + k] = a.router_w[(size_t)k * 16 + e]; }
          __syncthreads();
          LAS int* lcnt = (LAS int*)(lds + RING_OFF + 65536);
          if (tz < 32) lcnt[tz] = 0;
          __syncthreads();
          for (int rg = gw; rg < RG; rg += NGW) { const int bl = rg / RB, r = rg % RB, b = b0 + bl; if (last && r >= dd::S) continue; const float* md = a.mod + (size_t)(r < dd::S ? b : dd::B) * 6 * 1024;
            moe::route_row(xrow_cur(a, b, r), a.norm2_g + (size_t)l * 1024, md + 3 * 1024, md + 4 * 1024, hb_s + (size_t)rg * 1024, rwT, a.router_b, lcnt, ka.route + rg, ka.wts + 2 * rg, lane); }
          __syncthreads();
          if (tz < 16) lcnt[16 + tz] = atomicAdd(cnt + tz * 64, lcnt[tz]);
          __syncthreads();
          for (int rg = gw; rg < RG; rg += NGW) { if (last && (rg % RB) >= dd::S) continue; moe::Route* rt = ka.route + rg; if (lane == 0) { moe::Route r_ = *rt; r_.r0 += lcnt[16 + r_.e0]; r_.r1 += lcnt[16 + r_.e1]; *rt = r_; } }
          xcd_barrier(xb); }
        { TID_SETUP int* cnt = ka.cnt + (l * NGRP + grp) * 1024;
          if (tz == 0) { int acc_ = 0; for (int e = 0; e < 16; ++e) { poff[e] = acc_; acc_ += (cnt[e * 64] + 255) >> 8; } poff[16] = acc_; }
          __syncthreads();
          for (int rg = gw; rg < RG; rg += NGW) { if (last && (rg % RB) >= dd::S) continue; const moe::Route rt = ka.route[rg];
            const v4u h0 = *(const v4u*)(hb_s + (size_t)rg * 1024 + lane * 16), h1 = *(const v4u*)(hb_s + (size_t)rg * 1024 + lane * 16 + 8);
#pragma unroll
            for (int sl = 0; sl < 2; ++sl) { const int e = sl ? rt.e1 : rt.e0, rk = sl ? rt.r1 : rt.r0; const size_t dst = (size_t)poff[e] * 256 + rk;
              *(v4u*)(ka.hp + dst * 1024 + lane * 16) = h0; *(v4u*)(ka.hp + dst * 1024 + lane * 16 + 8) = h1;
              if (lane == 0) { ka.srcrow[dst] = 2 * rg + sl; ka.wgt[dst] = ka.wts[2 * rg + sl]; } } }
          for (int e = 0; e < 16; ++e) { const int c_ = cnt[e * 64], pe = ((c_ + 255) >> 8) << 8; for (int p_ = c_ + (int)gt; p_ < pe; p_ += (int)gs) ka.srcrow[(size_t)poff[e] * 256 + p_] = -1; }
          xcd_barrier(xb); }
        { pg8::Gemm g{ka.hp, ka.WguT, 0, 0, 1024, 0}; moe::MoeOrder S{(int)gridDim.x, (int)blockIdx.x, 4, poff}; moe::EpiGU E{ka.hid};
          pg8::gemm_phase<moe::EpiGU, moe::MoeOrder, false>((PG8_LAS unsigned char*)(lds + RING_OFF), g, S, E, nullptr);
          xcd_barrier(xb); }
        { pg8::Gemm g{ka.hid, ka.WdT, 0, 0, 512, 0}; moe::MoeOrder S{(int)gridDim.x, (int)blockIdx.x, 4, poff}; moe::EpiDown E{ka.srcrow, ka.wgt, ka.contrib, (size_t)RG * 1024};
          pg8::gemm_phase<moe::EpiDown, moe::MoeOrder, false>((PG8_LAS unsigned char*)(lds + RING_OFF), g, S, E, nullptr);
          xcd_barrier(xb); }
        { TID_SETUP
          for (long i_ = gt; i_ < (long)RG * 256; i_ += gs) { const int rg = (int)(i_ >> 8), c4 = (int)(i_ & 255) * 4; const int bl = rg / RB, r = rg % RB, b = b0 + bl; if (last && r >= dd::S) continue;
            float* xr = xrow_cur(a, b, r) + c4; const float* g2 = a.mod + (size_t)(r < dd::S ? b : dd::B) * 6 * 1024 + 5 * 1024 + c4;
            const unsigned long long u0 = *(const unsigned long long*)(ka.contrib + (size_t)rg * 1024 + c4), u1 = *(const unsigned long long*)(ka.contrib + (size_t)RG * 1024 + (size_t)rg * 1024 + c4);
            pg8::f32x4 xv = *(pg8::f32x4*)xr; const pg8::f32x4 gv = *(const pg8::f32x4*)g2;
#pragma unroll
            for (int e = 0; e < 4; ++e) xv[e] += gv[e] * (bf2f((bf16_t)(u0 >> (16 * e))) + bf2f((bf16_t)(u1 >> (16 * e))));
            *(pg8::f32x4*)xr = xv; }
          xcd_barrier(xb); }
      }
    }
  }
}
extern "C" void kernel_launch(void* const* d_in, const int* in_sizes, int n_in, void* d_out, int out_size, void* d_ws, size_t ws_size, hipStream_t stream) {
  static int grid = 0;
  if (!grid) {
    int dev = 0, cus = 0, per_cu = 0;
    (void)hipGetDevice(&dev); (void)hipDeviceGetAttribute(&cus, hipDeviceAttributeMultiprocessorCount, dev);
    (void)hipFuncSetAttribute((const void*)mega_kernel, hipFuncAttributeMaxDynamicSharedMemorySize, LDS_BYTES);
    (void)hipOccupancyMaxActiveBlocksPerMultiprocessor(&per_cu, mega_kernel, NTHREADS, LDS_BYTES);
    if (per_cu < 1) fprintf(stderr, "occupancy query says %d\n", per_cu);
    grid = cus;
  }
  KArgs ka{}; const float* ptrs[33]; for (int i = 0; i < 33; ++i) ptrs[i] = (const float*)d_in[i];
  set_inputs<TD>(ka.a, ptrs);
  char* wsb = (char*)d_ws; size_t off = BAR_BYTES;
  auto take = [&](size_t bytes) { char* p = wsb + off; off += (bytes + 255) & ~(size_t)255; return p; };
  NaiveBufs& a = ka.a;
  a.mod = (float*)take((size_t)(dd::B + 1) * 6 * 1024 * 4); a.hid2S = (float*)take((size_t)dd::S * 64 * 4); a.hid2C = (float*)take((size_t)dd::C * 64 * 4);
  a.tapsS = (float*)take((size_t)2 * 512 * 2 * 8232 * 2 + 64); a.tapsC = (float*)take((size_t)2 * 512 * 512 * 4); a.nrmS = (float*)take(1024 * 4); a.nrmC = (float*)take(1024 * 4);
  a.xc = (float*)take((size_t)dd::B * dd::C * 1024 * 4);
  ka.WinT = (bf16_t*)take((size_t)NINP * 1024 * 2); ka.WhyT = (bf16_t*)take((size_t)1024 * 512 * 2); ka.WglaT = (bf16_t*)take((size_t)1024 * 512 * 2); ka.WattT = (bf16_t*)take((size_t)1024 * 1024 * 2);
  ka.WoutT = (bf16_t*)take((size_t)1024 * 1024 * 2); ka.WguT = (bf16_t*)take((size_t)16 * 1024 * 1024 * 2); ka.WdT = (bf16_t*)take((size_t)16 * 1024 * 512 * 2);
  ka.hb = (bf16_t*)take((size_t)RG * 1024 * 2); ka.mix = (unsigned char*)take(MIX_BYTES);
  ka.proj = (bf16_t*)take((size_t)RG * PLD * 2);
  { char* p = (char*)ka.proj; ka.hp = (bf16_t*)p; p += (size_t)MPG * 1024 * 2; ka.hid = (bf16_t*)p; p += (size_t)MPG * 512 * 2; ka.contrib = (bf16_t*)p; p += (size_t)2 * RG * 1024 * 2;
    ka.srcrow = (int*)p; p += (size_t)MPG * 4; ka.wgt = (float*)p; p += (size_t)MPG * 4; ka.route = (moe::Route*)p; p += (size_t)RG * 16; ka.wts = (float*)p; p += (size_t)RG * 8;
    if ((size_t)(p - (char*)ka.proj) > (size_t)RG * PLD * 2) fprintf(stderr, "MoE alias region too large\n"); }
  a.out = (float*)d_out; ka.bar = (unsigned*)d_ws; ka.cnt = (int*)(wsb + CNT_OFF);
  if (off > ws_size) fprintf(stderr, "workspace too small: need %zu have %zu\n", off, ws_size);
  (void)hipMemsetAsync(d_ws, 0, BAR_BYTES, stream);
  hipLaunchKernelGGL(mega_kernel, dim3(grid), dim3(NTHREADS), LDS_BYTES, stream, ka);
}
```

```cpp
#include <hip/hip_runtime.h>
#include <cstddef>
#include <cstdio>
#include <cstdint>
#include <hip/hip_bf16.h>
#include <hip/hip_runtime.h>
namespace pg8 {
#define PG8_LAS __attribute__((address_space(3)))
typedef unsigned short bf16_t;
typedef short bf16x8 __attribute__((ext_vector_type(8)));
typedef float f32x4 __attribute__((ext_vector_type(4)));
typedef unsigned u32x4 __attribute__((ext_vector_type(4)));
constexpr int BM = 256, BK = 64, HALF = 128, HTB = HALF * BK * 2  , STAGE_BYTES = 8 * HTB, NXCD = 8, WGM = 8;

__host__ __device__ __forceinline__ int lds_byte(int r, int c) { const int st = (r >> 4) * 2 + (c >> 5), rr = r & 15, cc = c & 31, ob = rr * 64 + cc * 2; return st * 1024 + (ob ^ (((ob >> 9) & 1) << 5)); }
__host__ __device__ __forceinline__ void stage_rc(int b, int& R, int& C) { const int st = b / 1024, sb = b % 1024, swz = sb ^ (((sb >> 9) & 1) << 5); R = (st >> 1) * 16 + swz / 64; C = (st & 1) * 32 + (swz % 64) / 2; }
__host__ __device__ __forceinline__ int perm32(int rho) { const int n = rho >> 4, i = rho & 15; return 8 * (i >> 2) + 4 * n + (i & 3); }

struct Unit { int pm, pn, acol; };
struct Gemm { const bf16_t* A; const bf16_t* Bt; int M, N, K; int lda; };

struct StaticOrder {
    int nM, nN, nwg, G, c;
    __host__ __device__ void init(int M, int N, int G_, int c_) { nM = M / BM; nN = N / BM; nwg = nM * nN; G = G_; c = c_; }
    __host__ __device__ bool next(int i, Unit& u) const {
        const long L = (long)i * G + c; if (L >= nwg) return false;
        int wgid = (int)L; { const int q = nwg / NXCD, r = nwg % NXCD, xcd = wgid % NXCD, off = wgid / NXCD; wgid = (xcd < r ? xcd * (q + 1) : r * (q + 1) + (xcd - r) * q) + off; }
        const int nig = WGM * nN, gid = wgid / nig, fm = gid * WGM, gsz = (nM - fm) < WGM ? (nM - fm) : WGM;
        u.pm = fm + ((wgid % nig) % gsz); u.pn = (wgid % nig) / gsz; u.acol = 0; return true;
    }
    __device__ __forceinline__ void a_ready(const Unit&) const {}
    __device__ __forceinline__ void done(const Unit&) const {}
};
__device__ __forceinline__ unsigned cvt_pk_bf16(float lo, float hi) { unsigned r; asm volatile("v_cvt_pk_bf16_f32 %0, %1, %2" : "=v"(r) : "v"(lo), "v"(hi)); return r; }
typedef float f32x2 __attribute__((ext_vector_type(2)));
template <class Epi, class Sched, bool STAMP = false>
__device__ __forceinline__ void gemm_phase(PG8_LAS unsigned char* lds, const Gemm g, const Sched& S, const Epi& E, unsigned long long* stamps) {
    int tid = threadIdx.x; asm volatile("" : "+v"(tid)); const int wid = __builtin_amdgcn_readfirstlane(tid >> 6), lane = tid & 63, wr = wid >> 2, wc = wid & 3, fr = lane & 15, fq = lane >> 4;
    const int K = g.K, nt = K / BK, LDA = g.lda ? g.lda : g.K;
    int ts_lo = 0, ts_hi = 0, nts = 0; const unsigned long long rt_entry = STAMP ? (unsigned long long)wall_clock64() : 0ull;
#define PG8_STAMP() do { if (STAMP && wid == 0 && nts < 64) { const unsigned long long _c = (unsigned long long)clock64(); \
        ts_lo = (lane == nts) ? (int)(unsigned)_c : ts_lo; ts_hi = (lane == nts) ? (int)(unsigned)(_c >> 32) : ts_hi; ++nts; } } while (0)
    PG8_STAMP();
    unsigned voffA[2], voffB[2];
#pragma unroll
    for (int i = 0; i < 2; ++i) { int R, C; stage_rc(tid * 16 + i * 8192, R, C); const int Rb = Epi::PERM ? ((R & ~31) + perm32(R & 31)) : R;
        voffA[i] = (unsigned)(R * LDA + C) * 2u; voffB[i] = (unsigned)(Rb * K + C) * 2u; }
    const size_t kstep = (size_t)(BK * 2);
    const size_t hstep = (size_t)HALF * K * 2;
    const size_t tstep = 2 * hstep;
    const size_t hstepA = (size_t)HALF * LDA * 2, tstepA = 2 * hstepA;
    const unsigned ldsw = (unsigned)wid * 1024u;
    const int aoff = lds_byte(wr * 64 + fr, fq * 8), boff = lds_byte(wc * 32 + fr, fq * 8);
#define PG8_SA(b, h) (((b) * 2 + (h)) * HTB)
#define PG8_SB(b, h) ((4 + (b) * 2 + (h)) * HTB)
#define PG8_STAGE(bufoff, gbase, voff) do { _Pragma("unroll") for (int _i = 0; _i < 2; ++_i) \
        __builtin_amdgcn_global_load_lds((const unsigned*)((const char*)(gbase) + (voff)[_i]), (PG8_LAS unsigned*)(lds + (bufoff) + ldsw + _i * 8192), 16, 0, 0); } while (0)
#define PG8_LDA(dst, b, h) do { _Pragma("unroll") for (int m = 0; m < 4; ++m) _Pragma("unroll") for (int k = 0; k < 2; ++k) dst[m][k] = *(const PG8_LAS bf16x8*)(lds + PG8_SA(b, h) + aoff + m * 2048 + k * 1024); } while (0)
#define PG8_LDB(dst, b, h) do { _Pragma("unroll") for (int n = 0; n < 2; ++n) _Pragma("unroll") for (int k = 0; k < 2; ++k) dst[n][k] = *(const PG8_LAS bf16x8*)(lds + PG8_SB(b, h) + boff + n * 2048 + k * 1024); } while (0)
#define PG8_MMA(ai, bj, At, Bt) do { __builtin_amdgcn_s_setprio(1); _Pragma("unroll") for (int m = 0; m < 4; ++m) _Pragma("unroll") for (int n = 0; n < 2; ++n) _Pragma("unroll") for (int k = 0; k < 2; ++k) \
        acc[ai][bj][m][n] = __builtin_amdgcn_mfma_f32_16x16x32_bf16(Bt[n][k], At[m][k], acc[ai][bj][m][n], 0, 0, 0); __builtin_amdgcn_s_setprio(0); } while (0)
#define PG8_WAIT_V(n) asm volatile("s_waitcnt vmcnt(" #n ")" ::: "memory")
#define PG8_WAIT_L(n) asm volatile("s_waitcnt lgkmcnt(" #n ")" ::: "memory")
#define PG8_BAR __builtin_amdgcn_s_barrier()
#define PG8_SCHED __builtin_amdgcn_sched_barrier(0)
    Unit cur, nxt; int ui = 0;
    if (!S.next(0, cur)) return;
    f32x4 acc[2][2][4][2];
#pragma unroll
    for (int a = 0; a < 2; ++a)
#pragma unroll
        for (int b = 0; b < 2; ++b)
#pragma unroll
            for (int m = 0; m < 4; ++m)
#pragma unroll
                for (int n = 0; n < 2; ++n) acc[a][b][m][n] = (f32x4){0.f, 0.f, 0.f, 0.f};
    bf16x8 At[4][2], B0[2][2], B1[2][2];
    const char* cA = (const char*)g.A + (size_t)cur.pm * tstepA + (size_t)cur.acol * 2; const char* cB = (const char*)g.Bt + (size_t)cur.pn * tstep;
    S.a_ready(cur);
    PG8_STAGE(PG8_SB(0, 0), cB, voffB); PG8_STAGE(PG8_SA(0, 0), cA, voffA); PG8_STAGE(PG8_SB(0, 1), cB + hstep, voffB); PG8_STAGE(PG8_SA(0, 1), cA + hstepA, voffA);
    if (wr == 1) PG8_BAR;
    PG8_WAIT_V(4); PG8_BAR;
    PG8_STAGE(PG8_SB(1, 0), cB + kstep, voffB); PG8_STAGE(PG8_SA(1, 0), cA + kstep, voffA); PG8_STAGE(PG8_SB(1, 1), cB + hstep + kstep, voffB);
    PG8_WAIT_V(6); PG8_BAR;
    PG8_STAMP();
    for (;;) {
        const bool has_next = S.next(ui + 1, nxt);
        const char* nA = has_next ? (const char*)g.A + (size_t)nxt.pm * tstepA + (size_t)nxt.acol * 2 : cA; const char* nB = has_next ? (const char*)g.Bt + (size_t)nxt.pn * tstep : cB;
        for (int t = 0; t < nt; t += 2) {
            const bool last = (t == nt - 2);
            const char* a1 = cA + (size_t)(t + 1) * kstep;
            const char* a2 = last ? nA : cA + (size_t)(t + 2) * kstep; const char* b2 = last ? nB : cB + (size_t)(t + 2) * kstep;
            const char* a3 = a2 + kstep; const char* b3 = b2 + kstep;
            if (last && has_next) S.a_ready(nxt);
            PG8_LDB(B0, 0, 0); PG8_SCHED; PG8_LDA(At, 0, 0); PG8_STAGE(PG8_SA(1, 1), a1 + hstepA, voffA);
            PG8_WAIT_L(8); PG8_BAR; PG8_WAIT_L(0); PG8_MMA(0, 0, At, B0); PG8_BAR; PG8_SCHED;
            PG8_LDB(B1, 0, 1); PG8_STAGE(PG8_SB(0, 0), b2, voffB);
            PG8_BAR; PG8_WAIT_L(0); PG8_MMA(0, 1, At, B1); PG8_BAR;
            PG8_LDA(At, 0, 1); PG8_STAGE(PG8_SA(0, 0), a2, voffA);
            PG8_BAR; PG8_WAIT_L(0); PG8_MMA(1, 0, At, B0); PG8_BAR; PG8_SCHED;
            PG8_STAGE(PG8_SB(0, 1), b2 + hstep, voffB);
            PG8_WAIT_V(6); PG8_BAR; PG8_MMA(1, 1, At, B1); PG8_BAR;
            PG8_LDB(B0, 1, 0); PG8_SCHED; PG8_LDA(At, 1, 0); PG8_STAGE(PG8_SA(0, 1), a2 + hstepA, voffA);
            PG8_WAIT_L(8); PG8_BAR; PG8_WAIT_L(0); PG8_MMA(0, 0, At, B0); PG8_BAR; PG8_SCHED;
            PG8_LDB(B1, 1, 1); PG8_STAGE(PG8_SB(1, 0), b3, voffB);
            PG8_BAR; PG8_WAIT_L(0); PG8_MMA(0, 1, At, B1); PG8_BAR;
            PG8_LDA(At, 1, 1); PG8_STAGE(PG8_SA(1, 0), a3, voffA);
            PG8_BAR; PG8_WAIT_L(0); PG8_MMA(1, 0, At, B0); PG8_BAR; PG8_SCHED;
            PG8_STAGE(PG8_SB(1, 1), b3 + hstep, voffB);
            PG8_WAIT_V(6); PG8_BAR; PG8_MMA(1, 1, At, B1); PG8_BAR;
        }
        PG8_STAMP();
        if constexpr (!Epi::AFTER_DRAIN) { E(acc, cur, wr, wc, fr, fq); S.done(cur); }
        PG8_STAMP();
        if (!has_next) break;
#pragma unroll
        for (int a = 0; a < 2; ++a)
#pragma unroll
            for (int b = 0; b < 2; ++b)
#pragma unroll
                for (int m = 0; m < 4; ++m)
#pragma unroll
                    for (int n = 0; n < 2; ++n) acc[a][b][m][n] = (f32x4){0.f, 0.f, 0.f, 0.f};
        cur = nxt; cA = nA; cB = nB; ++ui;
    }
    PG8_WAIT_V(0);
    if (wr == 0) PG8_BAR;
    PG8_BAR;
    if constexpr (Epi::AFTER_DRAIN) { E.fused(acc, cur, wr, wc, fr, fq, lds, wid, lane); S.done(cur); }
    PG8_STAMP();
    if (STAMP && wid == 0) { stamps[lane] = lane < nts ? (((unsigned long long)(unsigned)ts_hi << 32) | (unsigned)ts_lo) : 0ull;
        if (lane == 62) stamps[62] = rt_entry; if (lane == 63) stamps[63] = (unsigned long long)wall_clock64(); }
#undef PG8_STAMP
#undef PG8_SA
#undef PG8_SB
#undef PG8_STAGE
#undef PG8_LDA
#undef PG8_LDB
#undef PG8_MMA
#undef PG8_WAIT_V
#undef PG8_WAIT_L
#undef PG8_BAR
#undef PG8_SCHED
}
}

#define LAS __attribute__((address_space(3)))
typedef unsigned short bf16_t;
constexpr int NWAVES = 8, NTHREADS = 512;
constexpr int LDS_BYTES = 147456;
constexpr int RING_OFF = 0;
constexpr int MISC_OFF = 131072;
constexpr int NINP = 7936;

__device__ __forceinline__ unsigned f2bf(float f) { unsigned u = __builtin_bit_cast(unsigned, f); return (u + 0x7fffu + ((u >> 16) & 1u)) >> 16; }
__device__ __forceinline__ unsigned pk2(float lo, float hi) { return f2bf(lo) | (f2bf(hi) << 16); }
__device__ __forceinline__ float bf2f(bf16_t b) { return __builtin_bit_cast(float, ((unsigned)b) << 16); }
typedef unsigned v4u __attribute__((ext_vector_type(4)));

__device__ __forceinline__ void transpose_item(const float* W, int K, int N, bf16_t* WT, int row_off, LAS float* scr, int item, int lane) {
  const int nblk = N / 32, kb = item / nblk, nb = item % nblk, k0 = 64 * kb, n0 = 32 * nb;
  float wreg[32];
#pragma unroll
  for (int i = 0; i < 32; ++i) { const int kk = 2 * i + (lane >> 5); wreg[i] = W[(size_t)(k0 + kk) * N + n0 + (lane & 31)]; }
#pragma unroll
  for (int i = 0; i < 32; ++i) { const int kk = 2 * i + (lane >> 5); scr[kk * 33 + (lane & 31)] = wreg[i]; }
  asm volatile("s_waitcnt lgkmcnt(0)" ::: "memory");
  const int c = lane & 7;
#pragma unroll
  for (int j = 0; j < 4; ++j) { const int n = (lane >> 3) + 8 * j; const LAS float* s = scr + (8 * c) * 33 + n;
    v4u o; o.x = pk2(s[0 * 33], s[1 * 33]); o.y = pk2(s[2 * 33], s[3 * 33]); o.z = pk2(s[4 * 33], s[5 * 33]); o.w = pk2(s[6 * 33], s[7 * 33]);
    *(v4u*)(WT + (size_t)(row_off + n0 + n) * K + k0 + 8 * c) = o; }
  asm volatile("s_waitcnt lgkmcnt(0)" ::: "memory");
}

struct EpiProjF32 {
  static constexpr bool PERM = false, AFTER_DRAIN = false;
  float* C; int ldc; int ncols;
  __device__ __forceinline__ void operator()(const pg8::f32x4 (&acc)[2][2][4][2], const pg8::Unit& u, int wr, int wc, int fr, int fq) const {
    const int row0 = u.pm * 256 + wr * 64 + fr, col0 = u.pn * 256 + wc * 32 + 4 * fq;
#pragma unroll
    for (int ai = 0; ai < 2; ++ai)
#pragma unroll
      for (int m = 0; m < 4; ++m) { float* rowp = C + (size_t)(row0 + ai * 128 + m * 16) * ldc + col0;
#pragma unroll
        for (int bj = 0; bj < 2; ++bj)
#pragma unroll
          for (int n = 0; n < 2; ++n) if (col0 + bj * 128 + n * 16 < ncols) *(pg8::f32x4*)(rowp + bj * 128 + n * 16) = acc[ai][bj][m][n]; }
  }
};

__device__ __forceinline__ float fsigmoid(float x) { return 1.f / (1.f + __expf(-x)); }
template <bool ACCUM> struct EpiMerge {
  static constexpr bool PERM = true, AFTER_DRAIN = false;
  const float* gate; int ldg; bf16_t* M; int ldm;
  __device__ __forceinline__ void operator()(const pg8::f32x4 (&acc)[2][2][4][2], const pg8::Unit& u, int wr, int wc, int fr, int fq) const {
    const int row0 = u.pm * 256 + wr * 64 + fr, col0 = u.pn * 256 + wc * 32 + 8 * fq;
#pragma unroll
    for (int ai = 0; ai < 2; ++ai)
#pragma unroll
      for (int m = 0; m < 4; ++m) { const size_t r = (size_t)(row0 + ai * 128 + m * 16);
#pragma unroll
        for (int bj = 0; bj < 2; ++bj) { const int c = col0 + bj * 128;
          const pg8::f32x4 g0 = *(const pg8::f32x4*)(gate + r * ldg + c), g1 = *(const pg8::f32x4*)(gate + r * ldg + c + 4);
          pg8::f32x4 v0 = acc[ai][bj][m][0], v1 = acc[ai][bj][m][1];
#pragma unroll
          for (int e = 0; e < 4; ++e) { v0[e] *= fsigmoid(g0[e]); v1[e] *= fsigmoid(g1[e]); }
          v4u* dst = (v4u*)(M + r * ldm + c);
          if (ACCUM) { const v4u o = *dst; v0[0] += bf2f(o.x & 0xffff); v0[1] += bf2f(o.x >> 16); v0[2] += bf2f(o.y & 0xffff); v0[3] += bf2f(o.y >> 16);
            v1[0] += bf2f(o.z & 0xffff); v1[1] += bf2f(o.z >> 16); v1[2] += bf2f(o.w & 0xffff); v1[3] += bf2f(o.w >> 16); }
          v4u o2; o2.x = pk2(v0[0], v0[1]); o2.y = pk2(v0[2], v0[3]); o2.z = pk2(v1[0], v1[1]); o2.w = pk2(v1[2], v1[3]); *dst = o2; } }
  }
};
struct EpiOut {
  static constexpr bool PERM = false, AFTER_DRAIN = false;
  const float* resL; float* outL; const float* gL;
  const float* resC; float* outC; const float* gC;
  __device__ __forceinline__ void operator()(const pg8::f32x4 (&acc)[2][2][4][2], const pg8::Unit& u, int wr, int wc, int fr, int fq) const {
    const bool isc = u.pm == 16; if (isc && outC == nullptr) return;
    const float* res = isc ? resC : resL; float* out = isc ? outC : outL; const float* gv = isc ? gC : gL;
    const int row0 = (isc ? 0 : u.pm * 256) + wr * 64 + fr, col0 = u.pn * 256 + wc * 32 + 4 * fq;
    pg8::f32x4 gg[2][2];
#pragma unroll
    for (int bj = 0; bj < 2; ++bj)
#pragma unroll
      for (int n = 0; n < 2; ++n) gg[bj][n] = *(const pg8::f32x4*)(gv + col0 + bj * 128 + n * 16);
#pragma unroll
    for (int ai = 0; ai < 2; ++ai)
#pragma unroll
      for (int m = 0; m < 4; ++m) { const size_t ro = (size_t)(row0 + ai * 128 + m * 16) * 1024 + col0;
#pragma unroll
        for (int bj = 0; bj < 2; ++bj)
#pragma unroll
          for (int n = 0; n < 2; ++n) { const pg8::f32x4 rv = *(const pg8::f32x4*)(res + ro + bj * 128 + n * 16); *(pg8::f32x4*)(out + ro + bj * 128 + n * 16) = rv + gg[bj][n] * acc[ai][bj][m][n]; } }
  }
};
namespace att {
using bf16 = __hip_bfloat16;
constexpr int D = 128, NW = 8, QBLK = 32, KVBLK = 64; constexpr float SCALE = 0.088388347648318440f; constexpr float THR = 8.f; constexpr int SDEPTH = 2;
constexpr size_t SHM_V = KVBLK * D * 2, SHM_K = KVBLK * D * 2, SHM_ATTN = 2 * SHM_V + 2 * SHM_K + NW * 64 * 4;
using bf16x8 = __attribute__((ext_vector_type(8))) short;
using s16x4  = __attribute__((ext_vector_type(4))) short;
using f32x16 = __attribute__((ext_vector_type(16))) float;
using f32x8  = __attribute__((ext_vector_type(8))) float;
using u32x4  = __attribute__((ext_vector_type(4))) unsigned;
#define KSWZ(row, colB) ((row) * 256 + ((colB) ^ (((row) & 7) << 4)))
#define SBAR() __builtin_amdgcn_sched_barrier(0)
__device__ __forceinline__ int crow(int r, int hi) { return (r & 3) + 8 * (r >> 2) + 4 * hi; }
__device__ __forceinline__ unsigned cvtpk(float lo, float hi) {
  unsigned r; asm volatile("v_cvt_pk_bf16_f32 %0, %1, %2" : "=v"(r) : "v"(lo), "v"(hi)); return r;
}
template <typename TIn> struct Stage;
template <> struct Stage<bf16>  { using T = bf16x8;
  __device__ static __forceinline__ T ld8(const bf16* p) { return *reinterpret_cast<const bf16x8*>(p); }
  __device__ static __forceinline__ bf16x8 tobf(T x) { return x; } };
template <> struct Stage<float> { using T = f32x8;
  __device__ static __forceinline__ T ld8(const float* p) { return *reinterpret_cast<const f32x8*>(p); }
  __device__ static __forceinline__ bf16x8 tobf(T x) {
    u32x4 w = {cvtpk(x[0], x[1]), cvtpk(x[2], x[3]), cvtpk(x[4], x[5]), cvtpk(x[6], x[7])}; return *reinterpret_cast<bf16x8*>(&w); } };

__device__ __forceinline__ void partialSM(f32x16& p0, f32x16& p1, float& m_reg, float& mn, float& alpha) {
  constexpr float C = SCALE * 1.4426950408889634f;
  float pmax = p0[0]; for (int r = 1; r < 16; ++r) pmax = fmaxf(pmax, p0[r]); for (int r = 0; r < 16; ++r) pmax = fmaxf(pmax, p1[r]);
  { auto rr = __builtin_amdgcn_permlane32_swap(__float_as_uint(pmax), __float_as_uint(pmax), false, false);
    pmax = fmaxf(__uint_as_float(rr[0]), __uint_as_float(rr[1])); }
  if (__builtin_expect(__all(pmax - m_reg <= THR / SCALE), 1)) { mn = m_reg; alpha = 1.f; }
  else { mn = fmaxf(m_reg, pmax); alpha = __builtin_amdgcn_exp2f((m_reg - mn) * C); m_reg = mn; }
  float mnC = -mn * C;
  for (int r = 0; r < 16; ++r) p0[r] = fmaf(p0[r], C, mnC); for (int r = 0; r < 16; ++r) p1[r] = fmaf(p1[r], C, mnC);
  for (int r = 0; r < 16; ++r) p0[r] = __builtin_amdgcn_exp2f(p0[r]);
}
__device__ __forceinline__ void finishSM(f32x16& p0, f32x16& p1, float alpha, float& l_reg, bf16x8& pa0, bf16x8& pa1, bf16x8& pa2, bf16x8& pa3) {
  for (int r = 0; r < 16; ++r) p1[r] = __builtin_amdgcn_exp2f(p1[r]);
  float ps = 0; for (int r = 0; r < 16; ++r) ps += p0[r]; for (int r = 0; r < 16; ++r) ps += p1[r];
  { auto rr = __builtin_amdgcn_permlane32_swap(__float_as_uint(ps), __float_as_uint(ps), false, false);
    ps = __uint_as_float(rr[0]) + __uint_as_float(rr[1]); }
  l_reg = l_reg * alpha + ps;
#define PK4(P, BASE, OUT) do { unsigned a0 = cvtpk(P[BASE + 0], P[BASE + 1]), a1 = cvtpk(P[BASE + 2], P[BASE + 3]);   \
    unsigned b0 = cvtpk(P[BASE + 4], P[BASE + 5]), b1 = cvtpk(P[BASE + 6], P[BASE + 7]);                              \
    auto r0 = __builtin_amdgcn_permlane32_swap(a0, b0, false, false); auto r1 = __builtin_amdgcn_permlane32_swap(a1, b1, false, false); \
    u32x4 w = {r0[0], r1[0], r0[1], r1[1]}; OUT = *reinterpret_cast<bf16x8*>(&w); } while (0)
  PK4(p0, 0, pa0); PK4(p0, 8, pa1); PK4(p1, 0, pa2); PK4(p1, 8, pa3);
#undef PK4
}
__device__ __forceinline__ void qkt(f32x16& p0, f32x16& p1, const bf16* Ks, const bf16x8* qr, int r32, int hi) {
  p0 = f32x16{}; p1 = f32x16{};
  for (int d0 = 0; d0 < 8; ++d0) { int cb = (d0 * 16 + hi * 8) * 2;
    bf16x8 b0 = *reinterpret_cast<const bf16x8*>((const char*)Ks + KSWZ(r32, cb));
    bf16x8 b1 = *reinterpret_cast<const bf16x8*>((const char*)Ks + KSWZ(32 + r32, cb));
    p0 = __builtin_amdgcn_mfma_f32_32x32x16_bf16(b0, qr[d0], p0, 0, 0, 0);
    p1 = __builtin_amdgcn_mfma_f32_32x32x16_bf16(b1, qr[d0], p1, 0, 0, 0); }
}
__device__ __forceinline__ int v_st(int k, int c) { const int kk = (k & ~0xC) | ((k & 4) << 1) | ((k & 8) >> 1); return ((kk >> 3) * 4 + (c >> 5)) * 512 + ((kk & 7) * 32 + (c & 31)) * 2; }
__device__ __forceinline__ int v_rd_base(int lane) { return ((lane & 3) << 3) | (((lane >> 2) & 3) << 6) | (((lane >> 4) & 1) << 5) | (((lane >> 5) & 1) << 8); }
constexpr int v_rd_off(int d0, int ks, int half) { return d0 * 512 + ks * 4096 + half * 2048; }
template <int OFF> __device__ __forceinline__ s16x4 tr_read(int vb) {
  s16x4 r; asm volatile("ds_read_b64_tr_b16 %0, %1 offset:%2" : "=&v"(r) : "v"(vb), "i"(OFF) : "memory"); return r;
}
template <int D0> __device__ __forceinline__ void pv_one(f32x16& od, int vb, bf16x8 pa0, bf16x8 pa1, bf16x8 pa2, bf16x8 pa3) {
  const s16x4 l0 = tr_read<v_rd_off(D0, 0, 0)>(vb), h0 = tr_read<v_rd_off(D0, 0, 1)>(vb), l1 = tr_read<v_rd_off(D0, 1, 0)>(vb), h1 = tr_read<v_rd_off(D0, 1, 1)>(vb);
  const s16x4 l2 = tr_read<v_rd_off(D0, 2, 0)>(vb), h2 = tr_read<v_rd_off(D0, 2, 1)>(vb), l3 = tr_read<v_rd_off(D0, 3, 0)>(vb), h3 = tr_read<v_rd_off(D0, 3, 1)>(vb);
  asm volatile("s_waitcnt lgkmcnt(0)" ::: "memory"); SBAR();
#define PK(L, H) (bf16x8){L[0], L[1], L[2], L[3], H[0], H[1], H[2], H[3]}
  od = __builtin_amdgcn_mfma_f32_32x32x16_bf16(pa0, PK(l0, h0), od, 0, 0, 0);
  od = __builtin_amdgcn_mfma_f32_32x32x16_bf16(pa1, PK(l1, h1), od, 0, 0, 0);
  od = __builtin_amdgcn_mfma_f32_32x32x16_bf16(pa2, PK(l2, h2), od, 0, 0, 0);
  od = __builtin_amdgcn_mfma_f32_32x32x16_bf16(pa3, PK(l3, h3), od, 0, 0, 0);
#undef PK
}
__device__ __forceinline__ void pv_d0(f32x16* o, int vb, bf16x8 pa0, bf16x8 pa1, bf16x8 pa2, bf16x8 pa3) {
  pv_one<0>(o[0], vb, pa0, pa1, pa2, pa3); pv_one<1>(o[1], vb, pa0, pa1, pa2, pa3); pv_one<2>(o[2], vb, pa0, pa1, pa2, pa3); pv_one<3>(o[3], vb, pa0, pa1, pa2, pa3);
}

template <typename TQ, int LDQ, int LDK, int LDO, bool OBF16>
__device__ __forceinline__ void attn_dense_body(const TQ* Qb, const bf16* Kh, const bf16* Vh,
                                                void* Obv, int seq, char* lds) {
  using St = Stage<bf16>; using SQ = Stage<TQ>;
  int tid = threadIdx.x; asm volatile("" : "+v"(tid)); const int wid = tid >> 6, lane = tid & 63, r32 = lane & 31, hi = lane >> 5;
  bf16* V_lds = (bf16*)lds; bf16* K_lds = (bf16*)(lds + 2 * SHM_V);
  float* ws = (float*)(lds + 2 * SHM_V + 2 * SHM_K) + wid * 64; float* li_l = ws; float* al_l = ws + 32;
  float m_reg = -1e30f, l_reg = 0; f32x16 o[4] = {}; bf16x8 qr[8];
  const TQ* Qw = Qb + (long)(wid * QBLK + r32) * LDQ + hi * 8;
#pragma unroll
  for (int d0 = 0; d0 < 8; ++d0) qr[d0] = SQ::tobf(SQ::ld8(Qw + d0 * 16));
  const int sr = tid >> 4, sc = (tid & 15) * 8, vst0 = v_st(sr, sc), vst1 = v_st(32 + sr, sc);
  const int vb0 = (int)(uintptr_t)V_lds + v_rd_base(lane);
  struct { typename St::T vs0, vs1, ks0, ks1; } sr_[SDEPTH];
#define SLOAD(i, k0) do { sr_[i].vs0 = St::ld8(&Vh[(long)((k0) + sr) * LDK + sc]); sr_[i].vs1 = St::ld8(&Vh[(long)((k0) + 32 + sr) * LDK + sc]); \
    sr_[i].ks0 = St::ld8(&Kh[(long)((k0) + sr) * LDK + sc]); sr_[i].ks1 = St::ld8(&Kh[(long)((k0) + 32 + sr) * LDK + sc]); } while (0)
#define SWRITE(b, i) do { *(bf16x8*)((char*)V_lds + (b) * SHM_V + vst0) = St::tobf(sr_[i].vs0);          \
    *(bf16x8*)((char*)V_lds + (b) * SHM_V + vst1) = St::tobf(sr_[i].vs1); int kc = sc * 2;               \
    *(bf16x8*)((char*)K_lds + (b) * SHM_K + KSWZ(sr, kc)) = St::tobf(sr_[i].ks0);                       \
    *(bf16x8*)((char*)K_lds + (b) * SHM_K + KSWZ(32 + sr, kc)) = St::tobf(sr_[i].ks1); } while (0)
#define SWAIT() do { if constexpr (SDEPTH == 2) asm volatile("s_waitcnt vmcnt(4)" ::: "memory"); else asm volatile("s_waitcnt vmcnt(0)" ::: "memory"); } while (0)
#define RESC(a) do { if (__any((a) < 1.f)) { if (hi == 0) al_l[r32] = (a); asm volatile("s_waitcnt lgkmcnt(0)" ::: "memory"); \
    for (int d = 0; d < 4; ++d) for (int r = 0; r < 16; ++r) o[d][r] *= al_l[crow(r, hi)]; } } while (0)
  f32x16 pA0, pA1, pB0, pB1; float mnA, mnB, alA, alB; bf16x8 pa0, pa1, pa2, pa3; const int NT = seq / KVBLK;
  constexpr int SE = 0, SO = SDEPTH - 1;
  SLOAD(SE, 0); asm volatile("s_waitcnt vmcnt(0)" ::: "memory"); SWRITE(0, SE); __syncthreads();
  qkt(pA0, pA1, K_lds, qr, r32, hi); partialSM(pA0, pA1, m_reg, mnA, alA);
  SLOAD(SO, KVBLK); if constexpr (SDEPTH == 2) { if (2 < NT) SLOAD(SE, 2 * KVBLK); }
  SWAIT(); SWRITE(1, SO); __syncthreads();
  for (int j = 1; j + 1 < NT; j += 2) {
    SBAR(); qkt(pB0, pB1, (bf16*)((char*)K_lds + SHM_K), qr, r32, hi);
    finishSM(pA0, pA1, alA, l_reg, pa0, pa1, pa2, pa3); SBAR();
    SLOAD(SO, (j + SDEPTH) * KVBLK); SBAR();
    pv_d0(o, vb0, pa0, pa1, pa2, pa3); partialSM(pB0, pB1, m_reg, mnB, alB);
    __syncthreads(); SWAIT(); SWRITE(0, SE);
    RESC(alB); __syncthreads();
    SBAR(); qkt(pA0, pA1, K_lds, qr, r32, hi);
    finishSM(pB0, pB1, alB, l_reg, pa0, pa1, pa2, pa3); SBAR();
    if (SDEPTH == 1 || j + 3 < NT) SLOAD(SE, (j + 1 + SDEPTH) * KVBLK); SBAR();
    pv_d0(o, vb0 + (int)SHM_V, pa0, pa1, pa2, pa3); partialSM(pA0, pA1, m_reg, mnA, alA);
    __syncthreads(); SWAIT(); SWRITE(1, SO);
    RESC(alA); __syncthreads();
  }
  SBAR(); qkt(pB0, pB1, (bf16*)((char*)K_lds + SHM_K), qr, r32, hi);
  finishSM(pA0, pA1, alA, l_reg, pa0, pa1, pa2, pa3); SBAR();
  pv_d0(o, vb0, pa0, pa1, pa2, pa3); partialSM(pB0, pB1, m_reg, mnB, alB);
  __syncthreads(); RESC(alB);
  finishSM(pB0, pB1, alB, l_reg, pa0, pa1, pa2, pa3); SBAR();
  pv_d0(o, vb0 + (int)SHM_V, pa0, pa1, pa2, pa3);
  if (hi == 0) li_l[r32] = l_reg; asm volatile("s_waitcnt lgkmcnt(0)" ::: "memory");
  float rli[16];
#pragma unroll
  for (int r = 0; r < 16; ++r) rli[r] = __builtin_amdgcn_rcpf(li_l[crow(r, hi)]);
  if constexpr (!OBF16) { float* Ow = (float*)Obv + (long)(wid * QBLK) * LDO;
#pragma unroll
  for (int r = 0; r < 16; ++r) { int orow = crow(r, hi);
    for (int d0 = 0; d0 < 4; ++d0) Ow[(long)orow * LDO + d0 * 32 + r32] = o[d0][r] * rli[r]; }
  } else { unsigned short* Ow = (unsigned short*)Obv + (long)(wid * QBLK) * LDO;
#pragma unroll
  for (int r = 0; r < 16; ++r) { int orow = crow(r, hi);
    for (int d0 = 0; d0 < 4; ++d0) { const unsigned pk = cvtpk(o[d0][r] * rli[r], 0.f); Ow[(long)orow * LDO + d0 * 32 + r32] = (unsigned short)(pk & 0xffffu); } }
  }
#undef SLOAD
#undef SWRITE
#undef SWAIT
#undef RESC
}
#undef KSWZ
#undef SBAR
}
namespace gla {
typedef float f32x16 __attribute__((ext_vector_type(16)));
typedef float f32x4v __attribute__((ext_vector_type(4)));
constexpr int LD = 65;
constexpr int OX = 0, OY = 2 * 64 * LD * 4, OV = 4 * 64 * LD * 4, OAL = OV + 64 * 128 * 4, OW2 = OAL + 64 * 32 * 4, OBA = OW2 + 2 * 16 * 64 * 4, OTOT = OBA + 2 * 64 * 4, OEND = OTOT + 2 * 64 * 4 * 4;
static_assert(OEND <= 131072, "gla lds");
static_assert(64 * 129 * 4 <= 2 * 64 * LD * 4, "O stage fits in X");

struct In {
  const bf16_t* q; const bf16_t* k; const bf16_t* v; const bf16_t* ga; const bf16_t* og; int ld;
  const float* wa2; const float* ba; const float* gnorm;
  float* cs;
  float* dec;
  bf16_t* y; int ldy;
  int S, C;
};
__device__ __forceinline__ long chunk_row(const In& p, int cid) { return cid < p.S / 64 ? (long)cid * 64 : (long)p.S + (long)(cid - p.S / 64) * 64; }
__device__ __forceinline__ float logsig(float x) { return x < 0.f ? x - __logf(1.f + __expf(x)) : -__logf(1.f + __expf(-x)); }

__device__ __forceinline__ void cum_phase(const In& p, LAS unsigned char* lds, int head, long row0, int tid) {
  LAS float* AL = (LAS float*)(lds + OAL); LAS float* W2 = (LAS float*)(lds + OW2); LAS float* BA = (LAS float*)(lds + OBA); LAS float* TOT = (LAS float*)(lds + OTOT);
  { const int t = tid >> 3, r4 = (tid & 7) * 4; const unsigned long long u = *(const unsigned long long*)(p.ga + (row0 + t) * p.ld + r4);
    f32x4v a4; a4[0] = bf2f((bf16_t)u); a4[1] = bf2f((bf16_t)(u >> 16)); a4[2] = bf2f((bf16_t)(u >> 32)); a4[3] = bf2f((bf16_t)(u >> 48)); *(LAS f32x4v*)(AL + t * 32 + r4) = a4; }
  { const int e = tid * 4, dir = e >> 10, r = (e >> 6) & 15, j = e & 63; *(LAS f32x4v*)(W2 + e) = *(const f32x4v*)(p.wa2 + ((long)dir * 16 + r) * 256 + head * 64 + j); }
  if (tid < 128) BA[tid] = p.ba[(tid >> 6) * 256 + head * 64 + (tid & 63)];
  __syncthreads();
  const int dir = tid >> 8, j = tid & 63, seg = (tid >> 6) & 3;
  float w[16];
#pragma unroll
  for (int r = 0; r < 16; ++r) w[r] = W2[(dir * 16 + r) * 64 + j];
  const float bj = BA[dir * 64 + j];
  float c[16];
#pragma unroll
  for (int k = 0; k < 16; ++k) { const int t = seg * 16 + k; float z = bj;
#pragma unroll
    for (int r = 0; r < 16; ++r) z += AL[t * 32 + dir * 16 + r] * w[r];
    c[k] = logsig(z) * (1.f / 16.f); }
  if (dir == 0) {
#pragma unroll
    for (int k = 1; k < 16; ++k) c[k] += c[k - 1];
    TOT[(dir * 64 + j) * 4 + seg] = c[15];
  } else {
#pragma unroll
    for (int k = 14; k >= 0; --k) c[k] += c[k + 1];
    TOT[(dir * 64 + j) * 4 + seg] = c[0];
  }
  __syncthreads();
  float off = 0.f;
#pragma unroll
  for (int s = 0; s < 4; ++s) { const float tv = TOT[(dir * 64 + j) * 4 + s]; if (dir == 0 ? s < seg : s > seg) off += tv; }
  LAS float* X = (LAS float*)(lds + OX) + dir * 64 * LD;
#pragma unroll
  for (int k = 0; k < 16; ++k) X[(seg * 16 + k) * LD + j] = c[k] + off;
}
struct VRegs { unsigned long long u[4]; };
__device__ __forceinline__ VRegs load_v_regs(const In& p, int head, long row0, int tid) { VRegs r;
#pragma unroll
  for (int m = 0; m < 4; ++m) { const int t = (tid >> 5) + 16 * m, c4 = (tid & 31) * 4; r.u[m] = *(const unsigned long long*)(p.v + (row0 + t) * p.ld + head * 128 + c4); }
  return r; }
__device__ __forceinline__ void store_v(const VRegs& r, LAS unsigned char* lds, int tid) {
  LAS float* V = (LAS float*)(lds + OV);
#pragma unroll
  for (int m = 0; m < 4; ++m) { const int t = (tid >> 5) + 16 * m, c4 = (tid & 31) * 4; const unsigned long long u = r.u[m];
    f32x4v a4; a4[0] = bf2f((bf16_t)u); a4[1] = bf2f((bf16_t)(u >> 16)); a4[2] = bf2f((bf16_t)(u >> 32)); a4[3] = bf2f((bf16_t)(u >> 48)); *(LAS f32x4v*)(V + t * 128 + c4) = a4; }
}

__device__ __forceinline__ void g1_unit(const In& p, LAS unsigned char* lds, int head, int cid, int GH, int NCH) {
  int tid = threadIdx.x; asm volatile("" : "+v"(tid));
  const int lane = tid & 63, w = __builtin_amdgcn_readfirstlane(tid >> 6);
  const long row0 = chunk_row(p, cid);
  const VRegs vr = load_v_regs(p, head, row0, tid);
  bf16_t kreg[8];
#pragma unroll
  for (int m = 0; m < 8; ++m) kreg[m] = p.k[(row0 + (tid >> 6) + 8 * m) * p.ld + head * 64 + (tid & 63)];
  cum_phase(p, lds, head, row0, tid);
  store_v(vr, lds, tid);
  __syncthreads();
  LAS float* TOT = (LAS float*)(lds + OTOT);
  { const int j = tid & 63;
#pragma unroll
    for (int dir = 0; dir < 2; ++dir) { LAS float* X = (LAS float*)(lds + OX) + dir * 64 * LD;
      const float cl = TOT[(dir * 64 + j) * 4 + 0] + TOT[(dir * 64 + j) * 4 + 1] + TOT[(dir * 64 + j) * 4 + 2] + TOT[(dir * 64 + j) * 4 + 3];
#pragma unroll
      for (int m = 0; m < 8; ++m) { const int t = (tid >> 6) + 8 * m; const float kv = bf2f(kreg[m]); X[t * LD + j] = kv * __expf(cl - X[t * LD + j]); }
      if (tid < 64) p.dec[(((long)dir * GH + head) * NCH + cid) * 64 + j] = __expf(cl); }
  }
  __syncthreads();
  { const int dir = w >> 2, di = (w >> 1) & 1, vj0 = (w & 1) * 2; const LAS float* X = (const LAS float*)(lds + OX) + dir * 64 * LD; const LAS float* V = (const LAS float*)(lds + OV);
    f32x16 a0 = {}, a1 = {}; const int li = lane & 31, lk = lane >> 5;
#pragma unroll 4
    for (int s0 = 0; s0 < 64; s0 += 2) { const float av = X[(s0 + lk) * LD + 32 * di + li]; const float b0 = V[(s0 + lk) * 128 + 32 * vj0 + li], b1 = V[(s0 + lk) * 128 + 32 * vj0 + 32 + li];
      a0 = __builtin_amdgcn_mfma_f32_32x32x2f32(av, b0, a0, 0, 0, 0); a1 = __builtin_amdgcn_mfma_f32_32x32x2f32(av, b1, a1, 0, 0, 0); }
    float* dst = p.cs + ((((long)dir * GH + head) * NCH + cid) * 64) * 128;
#pragma unroll
    for (int r = 0; r < 16; ++r) { const int d = 32 * di + (r & 3) + 8 * (r >> 2) + 4 * lk; dst[(long)d * 128 + 32 * vj0 + li] = a0[r]; dst[(long)d * 128 + 32 * vj0 + 32 + li] = a1[r]; }
  }
  __syncthreads();
}
__device__ __forceinline__ void g2_item(const In& p, long idx, int GH, int NCH) {
  const int v = (int)(idx & 127), d = (int)((idx >> 7) & 63); const int hd = (int)((idx >> 13) % GH), dir = (int)((idx >> 13) / GH);
  const int nl = p.S / 64, nc = p.C / 64; float st = 0.f;
  float* base = p.cs + (((long)dir * GH + hd) * NCH) * 64 * 128 + (long)d * 128 + v; const float* db = p.dec + (((long)dir * GH + hd) * NCH) * 64 + d;
  for (int step = 0; step < nl + nc; ++step) {
    int cid; if (step < nc) cid = nl + (dir ? nc - 1 - step : step); else cid = dir ? nl - 1 - (step - nc) : step - nc;
    float* pp = base + (long)cid * 64 * 128; const float c = *pp; *pp = st; st = db[(long)cid * 64] * st + c;
  }
}
__device__ __forceinline__ void g3_unit(const In& p, LAS unsigned char* lds, int head, int cid, int GH, int NCH) {
  int tid = threadIdx.x; asm volatile("" : "+v"(tid));
  const int lane = tid & 63, w = __builtin_amdgcn_readfirstlane(tid >> 6), li = lane & 31, lk = lane >> 5;
  const long row0 = chunk_row(p, cid);
  float spf[2][32];
  { const int vj_ = w & 3;
#pragma unroll
    for (int dir = 0; dir < 2; ++dir) { const float* sp = p.cs + ((((long)dir * GH + head) * NCH + cid) * 64) * 128 + 32 * vj_ + li;
#pragma unroll
      for (int i = 0; i < 32; ++i) spf[dir][i] = sp[(long)(2 * i + lk) * 128]; } }
  const VRegs vr = load_v_regs(p, head, row0, tid);
  bf16_t kreg[8], qreg[8];
#pragma unroll
  for (int m = 0; m < 8; ++m) { const long o_ = (row0 + (tid >> 6) + 8 * m) * p.ld + head * 64 + (tid & 63); kreg[m] = p.k[o_]; qreg[m] = p.q[o_]; }
  cum_phase(p, lds, head, row0, tid);
  store_v(vr, lds, tid);
  __syncthreads();
  { const int j = tid & 63;
#pragma unroll
    for (int dir = 0; dir < 2; ++dir) { LAS float* X = (LAS float*)(lds + OX) + dir * 64 * LD; LAS float* Y = (LAS float*)(lds + OY) + dir * 64 * LD;
#pragma unroll
      for (int m = 0; m < 8; ++m) { const int t = (tid >> 6) + 8 * m; const float c = X[t * LD + j];
        const float qv = bf2f(qreg[m]) * 0.125f, kv = bf2f(kreg[m]);
        X[t * LD + j] = qv * __expf(c); Y[t * LD + j] = kv * __expf(-c); } }
  }
  __syncthreads();
  {
    const int dir = w >> 2, qi = (w >> 1) & 1, si = w & 1; const bool zero = dir == 0 ? si > qi : si < qi;
    const LAS float* X = (const LAS float*)(lds + OX) + dir * 64 * LD; LAS float* Y = (LAS float*)(lds + OY) + dir * 64 * LD;
    f32x16 pa = {};
    if (!zero) {
#pragma unroll 4
      for (int d0 = 0; d0 < 64; d0 += 2) pa = __builtin_amdgcn_mfma_f32_32x32x2f32(X[(32 * qi + li) * LD + d0 + lk], Y[(32 * si + li) * LD + d0 + lk], pa, 0, 0, 0);
    }
    __syncthreads();
#pragma unroll
    for (int r = 0; r < 16; ++r) { const int q = 32 * qi + (r & 3) + 8 * (r >> 2) + 4 * lk, s = 32 * si + li; const bool keep = dir == 0 ? s <= q : s >= q;
      Y[q * LD + s] = keep ? pa[r] : 0.f; }
  }
  __syncthreads();
  f32x16 acc = {};
  { const int qi = w >> 2, vj = w & 3; const LAS float* V = (const LAS float*)(lds + OV);
#pragma unroll
    for (int dir = 0; dir < 2; ++dir) { const LAS float* X = (const LAS float*)(lds + OX) + dir * 64 * LD; const LAS float* Y = (const LAS float*)(lds + OY) + dir * 64 * LD;
#pragma unroll 4
      for (int s0 = 0; s0 < 64; s0 += 2) acc = __builtin_amdgcn_mfma_f32_32x32x2f32(Y[(32 * qi + li) * LD + s0 + lk], V[(s0 + lk) * 128 + 32 * vj + li], acc, 0, 0, 0);
#pragma unroll
      for (int i = 0; i < 32; ++i) acc = __builtin_amdgcn_mfma_f32_32x32x2f32(X[(32 * qi + li) * LD + 2 * i + lk], spf[dir][i], acc, 0, 0, 0);
    }
    __syncthreads();
    LAS float* O = (LAS float*)(lds + OX);
#pragma unroll
    for (int r = 0; r < 16; ++r) { const int q = 32 * qi + (r & 3) + 8 * (r >> 2) + 4 * lk; O[q * 129 + 32 * vj + li] = acc[r]; }
  }
  __syncthreads();
  { const int row = tid >> 3, part = tid & 7; const LAS float* O = (const LAS float*)(lds + OX) + row * 129 + part * 16;
    float o[16]; float ss = 0.f;
#pragma unroll
    for (int k = 0; k < 16; ++k) { o[k] = O[k]; ss += o[k] * o[k]; }
    ss += __shfl_xor(ss, 1); ss += __shfl_xor(ss, 2); ss += __shfl_xor(ss, 4);
    const float rs = 1.f / sqrtf(ss * (1.f / 128.f) + 1e-6f);
    const bf16_t* ogp = p.og + (row0 + row) * p.ld + head * 128 + part * 16; const v4u og0 = *(const v4u*)ogp, og1 = *(const v4u*)(ogp + 8);
    const unsigned ogw[8] = {og0.x, og0.y, og0.z, og0.w, og1.x, og1.y, og1.z, og1.w}; bf16_t* yp = p.y + (row0 + row) * p.ldy + head * 128 + part * 16; float yy[16];
#pragma unroll
    for (int k4 = 0; k4 < 4; ++k4) { f32x4v g4; g4[0] = bf2f((bf16_t)(ogw[2 * k4] & 0xffff)); g4[1] = bf2f((bf16_t)(ogw[2 * k4] >> 16)); g4[2] = bf2f((bf16_t)(ogw[2 * k4 + 1] & 0xffff)); g4[3] = bf2f((bf16_t)(ogw[2 * k4 + 1] >> 16)); const f32x4v n4 = *(const f32x4v*)(p.gnorm + part * 16 + 4 * k4); f32x4v y4;
#pragma unroll
      for (int e = 0; e < 4; ++e) { const float gg = g4[e]; y4[e] = o[4 * k4 + e] * rs * n4[e] * (gg / (1.f + __expf(-gg))); yy[4 * k4 + e] = y4[e]; } }
    { v4u o0, o1; o0.x = pk2(yy[0], yy[1]); o0.y = pk2(yy[2], yy[3]); o0.z = pk2(yy[4], yy[5]); o0.w = pk2(yy[6], yy[7]);
      o1.x = pk2(yy[8], yy[9]); o1.y = pk2(yy[10], yy[11]); o1.z = pk2(yy[12], yy[13]); o1.w = pk2(yy[14], yy[15]); *(v4u*)yp = o0; *(v4u*)(yp + 8) = o1; }
  }
  __syncthreads();
}
}
namespace moe {
constexpr int NE = 16, NG = 4, EPG = 4, DE = 512, D = 1024;
__device__ __forceinline__ float wave_sum(float v) {
#pragma unroll
  for (int o = 1; o < 64; o <<= 1) v += __shfl_xor(v, o);
  return v;
}
struct Route { int e0, r0, e1, r1; };
struct MoeOrder {
  int G, c, NT; const LAS int* poff;
  __device__ __forceinline__ bool next(int i, pg8::Unit& u) const {
    const long L = (long)i * G + c; const int total = poff[NE] * NT; if (L >= total) return false;
    const int panel = (int)L / NT, j = (int)L % NT; int e = 0;
#pragma unroll
    for (int k = 1; k < NE; ++k) e += (panel >= poff[k]) ? 1 : 0;
    u.pm = panel; u.pn = e * NT + j; u.acol = 0; return true;
  }
  __device__ __forceinline__ void a_ready(const pg8::Unit&) const {}
  __device__ __forceinline__ void done(const pg8::Unit&) const {}
};
struct EpiGU {
  static constexpr bool PERM = true, AFTER_DRAIN = false;
  bf16_t* hid;
  __device__ __forceinline__ void operator()(const pg8::f32x4 (&acc)[2][2][4][2], const pg8::Unit& u, int wr, int wc, int fr, int fq) const {
    const int j = u.pn & 3; const int row0 = u.pm * 256 + wr * 64 + fr, col0 = j * 128 + wc * 32 + 8 * fq;
#pragma unroll
    for (int ai = 0; ai < 2; ++ai)
#pragma unroll
      for (int m = 0; m < 4; ++m) { const size_t r = (size_t)(row0 + ai * 128 + m * 16); float hv[8];
#pragma unroll
        for (int n = 0; n < 2; ++n)
#pragma unroll
          for (int e = 0; e < 4; ++e) { const float g = acc[ai][0][m][n][e], up = acc[ai][1][m][n][e]; hv[4 * n + e] = g / (1.f + __expf(-g)) * up; }
        v4u o; o.x = pk2(hv[0], hv[1]); o.y = pk2(hv[2], hv[3]); o.z = pk2(hv[4], hv[5]); o.w = pk2(hv[6], hv[7]);
        *(v4u*)(hid + r * DE + col0) = o; }
  }
};
struct EpiDown {
  static constexpr bool PERM = true, AFTER_DRAIN = false;
  const int* srcrow; const float* wgt; bf16_t* contrib; size_t slot_stride;
  __device__ __forceinline__ void operator()(const pg8::f32x4 (&acc)[2][2][4][2], const pg8::Unit& u, int wr, int wc, int fr, int fq) const {
    const int pn = u.pn & 3; const int row0 = u.pm * 256 + wr * 64 + fr, col0 = pn * 256 + wc * 32 + 8 * fq;
    int srcs[2][4]; float ws_[2][4];
#pragma unroll
    for (int ai = 0; ai < 2; ++ai)
#pragma unroll
      for (int m = 0; m < 4; ++m) { const int r = row0 + ai * 128 + m * 16; srcs[ai][m] = srcrow[r]; ws_[ai][m] = wgt[r]; }
#pragma unroll
    for (int ai = 0; ai < 2; ++ai)
#pragma unroll
      for (int m = 0; m < 4; ++m) { const int src = srcs[ai][m]; if (src < 0) continue; const float w = ws_[ai][m];
        bf16_t* dst = contrib + (size_t)(src & 1) * slot_stride + (size_t)(src >> 1) * D + col0;
#pragma unroll
        for (int bj = 0; bj < 2; ++bj) { const pg8::f32x4 v0 = acc[ai][bj][m][0] * w, v1 = acc[ai][bj][m][1] * w;
          v4u o; o.x = pk2(v0[0], v0[1]); o.y = pk2(v0[2], v0[3]); o.z = pk2(v1[0], v1[1]); o.w = pk2(v1[2], v1[3]); *(v4u*)(dst + bj * 128) = o; } }
  }
};
__device__ __forceinline__ void route_row(const float* xr, const float* gnorm, const float* shift, const float* scale, bf16_t* hrow, const LAS float* rwT, const float* rbias,
                                          LAS int* cnt, Route* rt, float* wts, int lane) {
  typedef float f4 __attribute__((ext_vector_type(4)));
  f4 xv[4]; float ss = 0.f;
#pragma unroll
  for (int j = 0; j < 4; ++j) { xv[j] = *(const f4*)(xr + 4 * lane + 256 * j); ss += xv[j][0] * xv[j][0] + xv[j][1] * xv[j][1] + xv[j][2] * xv[j][2] + xv[j][3] * xv[j][3]; }
  const float rs = 1.f / sqrtf(wave_sum(ss) * (1.f / 1024.f) + 1e-6f);
  float lg[NE];
#pragma unroll
  for (int e = 0; e < NE; ++e) lg[e] = 0.f;
#pragma unroll
  for (int j = 0; j < 4; ++j) { const int c = 4 * lane + 256 * j; const f4 g4 = *(const f4*)(gnorm + c), sh = *(const f4*)(shift + c), sc = *(const f4*)(scale + c);
    f4 h;
#pragma unroll
    for (int i = 0; i < 4; ++i) h[i] = xv[j][i] * rs * g4[i] * (1.f + sc[i]) + sh[i];
    *(unsigned long long*)(hrow + c) = (unsigned long long)pk2(h[0], h[1]) | ((unsigned long long)pk2(h[2], h[3]) << 32);
#pragma unroll
    for (int e = 0; e < NE; ++e) { const f4 w4 = *(const LAS f4*)(rwT + e * 1024 + c); lg[e] += h[0] * w4[0] + h[1] * w4[1] + h[2] * w4[2] + h[3] * w4[3]; } }
  { float v8[8], v4[4], v2[2], v1;
#pragma unroll
    for (int i = 0; i < 8; ++i) { const bool up = lane & 1; const float keep = up ? lg[2 * i + 1] : lg[2 * i], send = up ? lg[2 * i] : lg[2 * i + 1]; v8[i] = keep + __shfl_xor(send, 1); }
#pragma unroll
    for (int i = 0; i < 4; ++i) { const bool up = lane & 2; const float keep = up ? v8[2 * i + 1] : v8[2 * i], send = up ? v8[2 * i] : v8[2 * i + 1]; v4[i] = keep + __shfl_xor(send, 2); }
#pragma unroll
    for (int i = 0; i < 2; ++i) { const bool up = lane & 4; const float keep = up ? v4[2 * i + 1] : v4[2 * i], send = up ? v4[2 * i] : v4[2 * i + 1]; v2[i] = keep + __shfl_xor(send, 4); }
    { const bool up = lane & 8; const float keep = up ? v2[1] : v2[0], send = up ? v2[0] : v2[1]; v1 = keep + __shfl_xor(send, 8); }
    v1 += __shfl_xor(v1, 16); v1 += __shfl_xor(v1, 32);
#pragma unroll
    for (int e = 0; e < NE; ++e) lg[e] = __shfl(v1, e); }
  float sc[NE], sel[NE];
#pragma unroll
  for (int e = 0; e < NE; ++e) { sc[e] = 1.f / (1.f + __expf(-lg[e])); sel[e] = sc[e] + rbias[e]; }
  int bestg = 0; float bestgs = -1e30f;
#pragma unroll
  for (int g = 0; g < NG; ++g) { float m1 = -1e30f, m2 = -1e30f;
#pragma unroll
    for (int i = 0; i < EPG; ++i) { const float v = sel[g * EPG + i]; if (v > m1) { m2 = m1; m1 = v; } else if (v > m2) m2 = v; }
    const float gsum = m1 + m2; if (gsum > bestgs) { bestgs = gsum; bestg = g; } }
  int i1 = -1, i2 = -1; float v1 = -1e30f, v2 = -1e30f, s1 = 0.f, s2 = 0.f;
#pragma unroll
  for (int e = 0; e < NE; ++e) { if (e / EPG == bestg) { const float v = sel[e];
      if (v > v1) { v2 = v1; i2 = i1; s2 = s1; v1 = v; i1 = e; s1 = sc[e]; } else if (v > v2) { v2 = v; i2 = e; s2 = sc[e]; } } }
  if (lane == 0) { const float inv = 1.f / (s1 + s2); Route r; r.e0 = i1; r.e1 = i2; r.r0 = __hip_atomic_fetch_add(cnt + i1, 1, __ATOMIC_RELAXED, __HIP_MEMORY_SCOPE_WORKGROUP); r.r1 = __hip_atomic_fetch_add(cnt + i2, 1, __ATOMIC_RELAXED, __HIP_MEMORY_SCOPE_WORKGROUP); *rt = r; wts[0] = s1 * inv; wts[1] = s2 * inv; }
}
}
namespace hy {
typedef float f32x16 __attribute__((ext_vector_type(16)));
constexpr int S = 4096, NT1 = 128, LDZ = 191, ZPAD = 31, LDX = 129;
constexpr int O_TAPS = 0, O_ZA = 32768, O_ZB = O_ZA + 32 * LDZ * 4, O_X1 = O_ZB + 32 * LDZ * 4, O_X2 = O_X1 + 32 * LDX * 4, O_RED = O_X2 + 32 * LDX * 4, O_END = O_RED + 4 * 64 * 16 * 4;
static_assert(O_END <= 131072, "hyena lds");

struct H0Regs { v4u w0, w1; };
__device__ __forceinline__ H0Regs h0_load(const bf16_t* u, int ld, int tile, int tid) {
  const int tt = tile / 24, jt = tile % 24, t0 = tt * 64, j0 = jt * 64; H0Regs r; r.w0 = (v4u){0u, 0u, 0u, 0u}; r.w1 = r.w0;
  { const int rr = tid >> 3, c8 = (tid & 7) * 8, t = t0 - 1 + rr; if (t >= 0 && t < S) r.w0 = *(const v4u*)(u + (size_t)t * ld + j0 + c8); }
  if (tid < 16) { const int rr = 64 + (tid >> 3), c8 = (tid & 7) * 8, t = t0 - 1 + rr; if (t < S) r.w1 = *(const v4u*)(u + (size_t)t * ld + j0 + c8); }
  return r;
}
__device__ __forceinline__ void h0_compute(const H0Regs& rg, const float* cw, const float* cb, bf16_t* ucT, int tile, LAS unsigned char* lds, int tid) {
  const int tt = tile / 24, jt = tile % 24, t0 = tt * 64, j0 = jt * 64;
  LAS float* U = (LAS float*)lds;
  { const int rr = tid >> 3, c8 = (tid & 7) * 8; const v4u w = rg.w0; LAS float* d = U + rr * 65 + c8;
    d[0] = bf2f(w.x & 0xffff); d[1] = bf2f(w.x >> 16); d[2] = bf2f(w.y & 0xffff); d[3] = bf2f(w.y >> 16); d[4] = bf2f(w.z & 0xffff); d[5] = bf2f(w.z >> 16); d[6] = bf2f(w.w & 0xffff); d[7] = bf2f(w.w >> 16); }
  if (tid < 16) { const int rr = 64 + (tid >> 3), c8 = (tid & 7) * 8; const v4u w = rg.w1; LAS float* d = U + rr * 65 + c8;
    d[0] = bf2f(w.x & 0xffff); d[1] = bf2f(w.x >> 16); d[2] = bf2f(w.y & 0xffff); d[3] = bf2f(w.y >> 16); d[4] = bf2f(w.z & 0xffff); d[5] = bf2f(w.z >> 16); d[6] = bf2f(w.w & 0xffff); d[7] = bf2f(w.w >> 16); }
  __syncthreads();
  { const int jj = tid >> 3, tq = (tid & 7) * 8, j = j0 + jj; const float w0 = cw[j], w1 = cw[1536 + j], w2 = cw[2 * 1536 + j], bb = cb[j]; float v[8];
#pragma unroll
    for (int k = 0; k < 8; ++k) v[k] = bb + w0 * U[(tq + k) * 65 + jj] + w1 * U[(tq + k + 1) * 65 + jj] + w2 * U[(tq + k + 2) * 65 + jj];
    v4u o; o.x = pk2(v[0], v[1]); o.y = pk2(v[2], v[3]); o.z = pk2(v[4], v[5]); o.w = pk2(v[6], v[7]); *(v4u*)(ucT + (size_t)j * S + t0 + tq) = o; }
  __syncthreads();
}
__device__ __forceinline__ void h2_tile(const bf16_t* yT, bf16_t* ybf, int ldy, int tile, LAS unsigned char* lds) {
  int tid = threadIdx.x; asm volatile("" : "+v"(tid));
  const int tt = tile / 8, ct = tile % 8, t0 = tt * 64, c0 = ct * 64;
  LAS bf16_t* T = (LAS bf16_t*)lds;
  { const int cc = tid >> 3, t8 = (tid & 7) * 8; const v4u w = *(const v4u*)(yT + (size_t)(c0 + cc) * S + t0 + t8); LAS unsigned* d = (LAS unsigned*)(T + cc * 66 + t8); d[0] = w.x; d[1] = w.y; d[2] = w.z; d[3] = w.w; }
  __syncthreads();
  { const int t = tid >> 3, c8 = (tid & 7) * 8; unsigned short e[8];
#pragma unroll
    for (int k = 0; k < 8; ++k) e[k] = T[(c8 + k) * 66 + t];
    v4u o; o.x = e[0] | ((unsigned)e[1] << 16); o.y = e[2] | ((unsigned)e[3] << 16); o.z = e[4] | ((unsigned)e[5] << 16); o.w = e[6] | ((unsigned)e[7] << 16);
    *(v4u*)(ybf + (size_t)(t0 + t) * ldy + c0 + c8) = o; }
  __syncthreads();
}
__device__ __forceinline__ void h1_unit(const bf16_t* ucT, const float* tapsT, const float* nrm, const float* skip, bf16_t* yT, int c, LAS unsigned char* lds) {
  int tid = threadIdx.x; asm volatile("" : "+v"(tid));
  const int lane = tid & 63, w = __builtin_amdgcn_readfirstlane(tid >> 6), li = lane & 31, lk = lane >> 5;
  LAS float* TAPS = (LAS float*)(lds + O_TAPS); LAS float* ZA = (LAS float*)(lds + O_ZA); LAS float* ZB = (LAS float*)(lds + O_ZB);
  LAS float* X1 = (LAS float*)(lds + O_X1); LAS float* X2 = (LAS float*)(lds + O_X2); LAS float* RED = (LAS float*)(lds + O_RED);
  for (int e = tid; e < 32 * 62; e += 512) { const int s2 = e / 62, p = e % 62, t1p = p < 31 ? p : 128 + p; ZA[s2 * LDZ + t1p] = 0.f; ZB[s2 * LDZ + t1p] = 0.f; }
  for (int t = tid; t < S; t += 512) { const int t2 = t & 31, t1 = t >> 5;
    X1[t2 * LDX + t1] = bf2f(ucT[(size_t)c * S + t]); X2[t2 * LDX + t1] = bf2f(ucT[(size_t)(512 + c) * S + t]); ZA[t2 * LDZ + t1 + ZPAD] = bf2f(ucT[(size_t)(1024 + c) * S + t]); }
#pragma unroll 1
  for (int o = 0; o < 2; ++o) {
    const float* tp = tapsT + ((size_t)o * 512 + c) * 8192;
    for (int e = tid; e < 8192; e += 512) TAPS[e] = tp[(e + 4096) & 8191];
    __syncthreads();
    const LAS float* Zin = o == 0 ? ZA : ZB;
    const int g = w & 3, dh = w >> 2;
    const int Dlo = 32 * g - 127 + (dh ? 80 : 0), Dn = dh ? 79 : 80;
    f32x16 acc = {};
    { const LAS float* ap = TAPS + 4096 + 32 * Dlo + li - lk - 30;
      const LAS float* bp = Zin + lk * LDZ + (32 * g + li - Dlo + ZPAD);
#pragma unroll 2
      for (int dd = 0; dd < Dn; ++dd) {
#pragma unroll
        for (int kk = 0; kk < 16; ++kk) acc = __builtin_amdgcn_mfma_f32_32x32x2f32(ap[(15 - kk) * 2], bp[2 * kk * LDZ], acc, 0, 0, 0);
        ap += 32; bp -= 1; }
    }
    if (dh) {
#pragma unroll
      for (int r = 0; r < 16; ++r) RED[(g * 64 + lane) * 16 + r] = acc[r]; }
    __syncthreads();
    if (!dh) { const float inv = 1.f / nrm[o * 512 + c], sk = skip[o * 512 + c]; const LAS float* G = o == 0 ? X1 : X2; LAS float* Out = o == 0 ? ZB : ZA;
#pragma unroll
      for (int r = 0; r < 16; ++r) { const int t2 = (r & 3) + 8 * (r >> 2) + 4 * lk, t1 = 32 * g + li;
        const float cv = (acc[r] + RED[(g * 64 + lane) * 16 + r]) * inv; const float zin = Zin[t2 * LDZ + t1 + ZPAD];
        Out[t2 * LDZ + t1 + ZPAD] = G[t2 * LDX + t1] * (cv + sk * zin); } }
    __syncthreads();
  }
  for (int t = tid; t < S; t += 512) yT[(size_t)c * S + t] = (bf16_t)f2bf(ZA[(t & 31) * LDZ + (t >> 5) + ZPAD]);
  __syncthreads();
}

typedef short bf16x8v __attribute__((ext_vector_type(8)));
typedef unsigned u32x2v __attribute__((ext_vector_type(2)));
constexpr int CSB = 16448;
constexpr int ZROW = 80, ZROWS = 190;
constexpr int B_CS = 0, B_ZA = 4 * CSB, B_ZB = B_ZA + 15232, B_X1 = B_ZB + 15232, B_X2 = B_X1 + 8256, B_RED = B_X2 + 8256, B_END = B_RED + 16384;
static_assert(B_END <= 131072 && B_ZA % 16 == 0 && B_X1 % 16 == 0, "hyena bf16 lds");
__device__ __forceinline__ void h1b_unit(const bf16_t* ucT, const bf16_t* tapsB, const float* nrm, const float* skip, bf16_t* yT, int c, LAS unsigned char* lds) {
  int tid = threadIdx.x; asm volatile("" : "+v"(tid));
  const int lane = tid & 63, w = __builtin_amdgcn_readfirstlane(tid >> 6), li = lane & 31, lk = lane >> 5;
  LAS bf16_t* ZA = (LAS bf16_t*)(lds + B_ZA); LAS bf16_t* ZB = (LAS bf16_t*)(lds + B_ZB); LAS bf16_t* X1 = (LAS bf16_t*)(lds + B_X1); LAS bf16_t* X2 = (LAS bf16_t*)(lds + B_X2);
  LAS float* RED = (LAS float*)(lds + B_RED);
  for (int e = tid; e < 62 * 20; e += 512) { const int p = e / 20, d = e % 20, row = p < 31 ? p : 128 + p; ((LAS unsigned*)ZA)[row * 20 + d] = 0u; ((LAS unsigned*)ZB)[row * 20 + d] = 0u; }
  { const v4u zv = *(const v4u*)(ucT + (size_t)(1024 + c) * S + tid * 8); const int t = tid * 8; *(LAS v4u*)((LAS unsigned char*)ZA + ((t >> 5) + ZPAD) * ZROW + (t & 31) * 2) = zv; }
  { const v4u xa = *(const v4u*)(ucT + (size_t)c * S + tid * 8), xb = *(const v4u*)(ucT + (size_t)(512 + c) * S + tid * 8); const int t1 = tid >> 2, t2b = (tid & 3) * 8;
    const unsigned wa[4] = {xa.x, xa.y, xa.z, xa.w}, wb[4] = {xb.x, xb.y, xb.z, xb.w};
#pragma unroll
    for (int k = 0; k < 4; ++k) { X1[(t2b + 2 * k) * LDX + t1] = (bf16_t)(wa[k] & 0xffff); X1[(t2b + 2 * k + 1) * LDX + t1] = (bf16_t)(wa[k] >> 16);
      X2[(t2b + 2 * k) * LDX + t1] = (bf16_t)(wb[k] & 0xffff); X2[(t2b + 2 * k + 1) * LDX + t1] = (bf16_t)(wb[k] >> 16); } }
  typedef unsigned u4a __attribute__((ext_vector_type(4), aligned(4))); typedef const __attribute__((address_space(1))) u4a* gp4;
  v4u cv[9];
#pragma unroll 1
  for (int o = 0; o < 2; ++o) {
#define HTAPS_LOAD(oo) { const __attribute__((address_space(1))) unsigned char* tb = (const __attribute__((address_space(1))) unsigned char*)(tapsB + ((size_t)(oo) * 512 + c) * 2 * 8232); \
      _Pragma("unroll") for (int it = 0; it < 9; ++it) { const int e = tid + 512 * it; const int s = e / 1028, q = e % 1028; cv[it] = (v4u){0u, 0u, 0u, 0u}; if (e < 4 * 1028) cv[it] = *(gp4)(tb + (size_t)(s & 1) * 16464 + 16 * q + 4 * (s >> 1)); } }
    if (o == 0) HTAPS_LOAD(0)
    {
#pragma unroll
      for (int it = 0; it < 9; ++it) { const int e = tid + 512 * it; const int s = e / 1028, q = e % 1028; if (e < 4 * 1028) *(LAS v4u*)(lds + B_CS + s * CSB + 16 * q) = cv[it]; } }
    __syncthreads();
    if (o == 0) HTAPS_LOAD(1)
    const LAS bf16_t* Zin = o == 0 ? ZA : ZB;
    const int g = w & 3, dh = w >> 2;
    const int Dlo = 32 * g - 127 + (dh ? 81 : 0), Dn = dh ? 78 : 81;
    f32x16 acc = {};
    { const int s = (4 - (li & 3)) & 3;
      const LAS unsigned char* ap = lds + B_CS + s * CSB + 2 * (4096 - 32 * Dlo - li + 8 * lk - s);
      const LAS unsigned char* bp = (const LAS unsigned char*)Zin + (32 * g + li - Dlo + ZPAD) * ZROW + 16 * lk;
#define HLD(A0, A1, B0, B1) { const u32x2v p0_ = *(const LAS u32x2v*)(ap), p1_ = *(const LAS u32x2v*)(ap2), p2_ = *(const LAS u32x2v*)(ap3), p3_ = *(const LAS u32x2v*)(ap4); \
        A0 = (v4u){p0_.x, p0_.y, p1_.x, p1_.y}; A1 = (v4u){p2_.x, p2_.y, p3_.x, p3_.y}; B0 = *(const LAS v4u*)(bp); B1 = *(const LAS v4u*)(bp + 32); ap -= 64; ap2 -= 64; ap3 -= 64; ap4 -= 64; bp -= ZROW; }
#define HMM(A, B) acc = __builtin_amdgcn_mfma_f32_32x32x16_bf16(__builtin_bit_cast(bf16x8v, A), __builtin_bit_cast(bf16x8v, B), acc, 0, 0, 0)
#define HOPQ(name, off) unsigned name##i = (unsigned)(unsigned long long)(ap + (off)); asm volatile("" : "+v"(name##i)); const LAS unsigned char* name = (const LAS unsigned char*)(unsigned long long)name##i;
      HOPQ(ap2, 8) HOPQ(ap3, 32) HOPQ(ap4, 40)
#undef HOPQ
      v4u fa0, fa1, fb0, fb1, ga0, ga1, gb0, gb1, ha0, ha1, hb0, hb1;
      HLD(fa0, fa1, fb0, fb1)
      HLD(ga0, ga1, gb0, gb1)
      for (int dd_ = 0; dd_ < Dn - 3; dd_ += 3) {
        HLD(ha0, ha1, hb0, hb1)
        HMM(fa0, fb0); HMM(fa1, fb1);
        HLD(fa0, fa1, fb0, fb1)
        HMM(ga0, gb0); HMM(ga1, gb1);
        HLD(ga0, ga1, gb0, gb1)
        HMM(ha0, hb0); HMM(ha1, hb1);
      }
      HLD(ha0, ha1, hb0, hb1)
      HMM(fa0, fb0); HMM(fa1, fb1); HMM(ga0, gb0); HMM(ga1, gb1); HMM(ha0, hb0); HMM(ha1, hb1);
#undef HLD
#undef HMM
    }
    if (dh) {
#pragma unroll
      for (int r = 0; r < 16; ++r) RED[(g * 64 + lane) * 16 + r] = acc[r]; }
    __syncthreads();
    if (!dh) { const float inv = 1.f / nrm[o * 512 + c], sk = skip[o * 512 + c]; const LAS bf16_t* G = o == 0 ? X1 : X2; LAS bf16_t* Out = o == 0 ? ZB : ZA;
#pragma unroll
      for (int r = 0; r < 16; ++r) { const int t2 = (r & 3) + 8 * (r >> 2) + 4 * lk, t1 = 32 * g + li;
        const float cv = (acc[r] + RED[(g * 64 + lane) * 16 + r]) * inv; const float zin = bf2f(Zin[(t1 + ZPAD) * (ZROW / 2) + t2]);
        Out[(t1 + ZPAD) * (ZROW / 2) + t2] = (bf16_t)f2bf(bf2f(G[t2 * LDX + t1]) * (cv + sk * zin)); } }
    __syncthreads();
  }
  { const int t = tid * 8; *(v4u*)(yT + (size_t)c * S + t) = *(const LAS v4u*)((const LAS unsigned char*)ZA + ((t >> 5) + ZPAD) * ZROW + (t & 31) * 2); }
  __syncthreads();
}
__device__ __forceinline__ void cconv3_item(const bf16_t* u, int ld, const float* cw, const float* cb, float* ucc, long idx) {
  const int j = (int)(idx % 1536); const int tc = (int)(idx / 1536);
  const bf16_t* up = u + (size_t)tc * ld + j;
  float v = cb[j] + cw[1536 + j] * bf2f(up[0]);
  if (tc > 0) v += cw[j] * bf2f(*(up - ld)); if (tc < 255) v += cw[2 * 1536 + j] * bf2f(up[ld]);
  ucc[idx] = v;
}
__device__ __forceinline__ void clong_item(const float* ucc, const float* z1c_in, float* z1c_out, bf16_t* yout, int ldy, const float* tapsC, const float* nrmC, const float* skip, int o, long idx) {
  const int c = (int)(idx % 512), t0 = (int)(idx / 512) * 8; constexpr int n = 256;
  const float* tp = tapsC + (size_t)o * 2 * n * 512 + c; const float nr = nrmC[o * 512 + c];
  const float* zs = o == 0 ? ucc + 1024 + c : z1c_in + c; const int ldz = o == 0 ? 1536 : 512;
  float acc[8], w[8];
#pragma unroll
  for (int i = 0; i < 8; ++i) { acc[i] = 0.f; const int lag = t0 + i; w[i] = tp[(size_t)lag * 512]; }
#pragma unroll 4
  for (int s = 0; s < n; ++s) { const float zv = zs[(size_t)s * ldz];
#pragma unroll
    for (int i = 0; i < 8; ++i) acc[i] += w[i] * zv;
    const int lag = t0 - s - 1;
    const float nw = tp[(size_t)(lag >= 0 ? lag : 2 * n + lag) * 512];
#pragma unroll
    for (int i = 7; i > 0; --i) w[i] = w[i - 1];
    w[0] = nw; }
  const float sk = skip[o * 512 + c];
#pragma unroll
  for (int i = 0; i < 8; ++i) { const int t = t0 + i; const float val = ucc[(size_t)t * 1536 + o * 512 + c] * (acc[i] / nr + sk * zs[(size_t)t * ldz]);
    if (o == 0) z1c_out[(size_t)t * 512 + c] = val; else yout[(size_t)t * ldy + c] = (bf16_t)f2bf(val); }
}
}
#define XB_TMO      128
#define XB_XCNT(j)  (256  + 64 * (j))
#define XB_XSUB(j)  (1280 + 64 * (j))
#define XB_XGEN(j)  (2304 + 64 * (j))
#define XB_TOP      3328
#define XB_TOPGEN   3392
#define XCD_BAR_WORDS 3456
#define XB_SPIN_CAP (1u << 18)

__device__ __forceinline__ unsigned xb_ld(unsigned* p)              { return __hip_atomic_load(p, __ATOMIC_RELAXED, __HIP_MEMORY_SCOPE_AGENT); }
__device__ __forceinline__ unsigned xb_add(unsigned* p, unsigned v) { return __hip_atomic_fetch_add(p, v, __ATOMIC_RELAXED, __HIP_MEMORY_SCOPE_AGENT); }
__device__ __forceinline__ unsigned xb_xcc_id() { return (unsigned)__builtin_amdgcn_s_getreg((3 << 11) | 20) & 0xFu; }
#define XB_SPIN(cond, bar) do { unsigned _sp = 0; while (cond) { __builtin_amdgcn_s_sleep(1); \
    if ((++_sp & 255u) == 0u) { if (xb_ld(&(bar)[XB_TMO])) break; if (_sp > XB_SPIN_CAP) { atomicAdd(&(bar)[XB_TMO], 1u); break; } } } } while (0)

struct XcdBarrier {
    unsigned* bar; unsigned x;
    volatile LAS unsigned* st;
};

__device__ __forceinline__ XcdBarrier xcd_barrier_post(unsigned* bar, volatile LAS unsigned* st) {
    XcdBarrier b; b.bar = bar; b.x = xb_xcc_id(); b.st = st;
    if (threadIdx.x == 0) (void)xb_add(&bar[XB_XCNT(b.x)], 1u);
    return b;
}
__device__ __forceinline__ void xcd_barrier_complete(unsigned* bar, unsigned x, unsigned& nloc, unsigned& nx) {
    const unsigned G = gridDim.x * gridDim.y * gridDim.z;
    unsigned sum, cnt, mine, sp = 0u;
    for (;;) {
        sum = 0u; cnt = 0u; mine = 0u;
#pragma unroll
        for (unsigned j = 0; j < 16; ++j) { const unsigned c = xb_ld(&bar[XB_XCNT(j)]); sum += c; cnt += (c > 0u) ? 1u : 0u; mine = (j == x) ? c : mine; }
        if (sum == G) break;
        __builtin_amdgcn_s_sleep(1);
        if ((++sp & 255u) == 0u) { if (xb_ld(&bar[XB_TMO])) break; if (sp > XB_SPIN_CAP) { atomicAdd(&bar[XB_TMO], 1u); break; } }
    }
    nloc = mine > 0u ? mine : 1u; nx = cnt > 0u ? cnt : 1u;
}

__device__ __forceinline__ void xcd_barrier(const XcdBarrier& b) {
    asm volatile("s_waitcnt vmcnt(0)" ::: "memory");
    __syncthreads();
    if (threadIdx.x == 0) {
        unsigned* bar = b.bar;
#define XB_SP(word) ((unsigned*)((((unsigned long long)(unsigned)__builtin_amdgcn_readfirstlane((int)((unsigned long long)(bar + (word)) >> 32))) << 32) | (unsigned)__builtin_amdgcn_readfirstlane((int)(unsigned)(unsigned long long)(bar + (word)))))
        unsigned* const p_xsub = XB_SP(XB_XSUB(b.x)); unsigned* const p_xgen = XB_SP(XB_XGEN(b.x));
        __builtin_amdgcn_s_waitcnt(0);
        unsigned nloc = b.st[0], nx = b.st[1];
        if (nloc == 0u) { xcd_barrier_complete(bar, b.x, nloc, nx); b.st[0] = nloc; b.st[1] = nx; }
        const unsigned old = xb_add(p_xsub, 1u);
        const unsigned gen = old / nloc;
        if (old + 1u == (gen + 1u) * nloc) {
            __builtin_amdgcn_fence(__ATOMIC_RELEASE, "agent");
            asm volatile("s_waitcnt vmcnt(0)" ::: "memory");
            const unsigned og = xb_add(&bar[XB_TOP], 1u);
            const unsigned tg = og / nx;
            if (og + 1u == (tg + 1u) * nx) xb_add(&bar[XB_TOPGEN], 1u);
            else XB_SPIN(xb_ld(&bar[XB_TOPGEN]) == tg, bar);
            __builtin_amdgcn_fence(__ATOMIC_ACQUIRE, "agent");
            xb_add(p_xgen, 1u);
            asm volatile("s_waitcnt vmcnt(0)" ::: "memory");
        } else {
            XB_SPIN(xb_ld(p_xgen) == gen, bar);
            __builtin_amdgcn_fence(__ATOMIC_ACQUIRE, "agent");
            asm volatile("s_waitcnt vmcnt(0)" ::: "memory");
        }
    }
    __syncthreads();
}
#include <math.h>
#ifdef HOST_TEST
#define HD
#define FEXP expf
#define FSIN sinf
#define FCOS cosf
#define FLOG logf
#define FPOW powf
#else
#define HD __device__ __forceinline__
#define FEXP __expf
#define FSIN __sinf
#define FCOS __cosf
#define FLOG __logf
#define FPOW __powf
#endif

struct FullDims { static constexpr int D=1024,B=8,S=4096,DEPTH=2,C=256,GW=64,AH=8,AKV=2,HDM=128,GH=4,GDK=64,GDV=128,GR=16,HW=512,HB=16,HF=64,NE=16,NG=4,DE=512; };
struct SmallDims { static constexpr int D=64,B=2,S=128,DEPTH=2,C=32,GW=16,AH=4,AKV=2,HDM=16,GH=2,GDK=8,GDV=16,GR=4,HW=32,HB=4,HF=8,NE=8,NG=2,DE=32; };

template <class T> struct DD {
  static constexpr int D=T::D,B=T::B,S=T::S,DEPTH=T::DEPTH,C=T::C,GW=T::GW,AH=T::AH,AKV=T::AKV,HDM=T::HDM,GH=T::GH,GDK=T::GDK,GDV=T::GDV,GR=T::GR,HW=T::HW,HB=T::HB,HF=T::HF,NE=T::NE,NG=T::NG,DE=T::DE;
  static constexpr int R=S+C, AG=AH/AKV, RP=HDM/4, HE=1+2*HB, EPG=NE/NG, AQW=AH*HDM, AKVW=AKV*HDM, GKW=GH*GDK, GVW=GH*GDV;
  static constexpr int NKV=AKVW+AKVW+GKW+GVW+2*GR, NIN=NKV+AQW+GKW+GVW+3*HW+3*D;
  static constexpr int O_AK=0, O_AV=AKVW, O_GK=2*AKVW, O_GV=2*AKVW+GKW, O_GA=2*AKVW+GKW+GVW;
  static constexpr int O_AQ=NKV, O_GQ=NKV+AQW, O_OG=O_GQ+GKW, O_HY=O_OG+GVW, O_BR=O_HY+3*HW;
};

struct NaiveBufs {
  const float *x,*c,*ctx,*c_ctx,*w_mod,*b_mod,*norm1_g,*norm2_g,*w_in,*q_norm_g,*k_norm_g,*gla_wa2,*gla_ba,*gla_norm_g,*hy_conv_w,*hy_conv_b,
    *hy_pos_w1,*hy_pos_b1,*hy_sin_freq,*hy_pos_w2,*hy_pos_b2,*hy_pos_w3,*hy_decay,*hy_skip,*w_br_hy,*w_br_gla,*w_br_att,*w_out,*router_w,*router_b,*moe_w_gate,*moe_w_up,*moe_w_down;
  float* out;
  float *mod;
  float *hid2S,*hid2C;
  float *tapsS,*tapsC;
  float *nrmS,*nrmC;
  float *rs;
  float *h;
  float *proj;
  float *qn,*kn;
  float *yatt;
  float *laf,*lab;
  float *of,*ob;
  float *ygla;
  float *uc;
  float *z1,*yhy;
  float *m;
  int   *ridx;
  float *rw;
  float *hid;
  float *xc;
};

HD float sigmoidf_(float x) { return 1.f / (1.f + FEXP(-x)); }
HD float siluf_(float x) { return x / (1.f + FEXP(-x)); }
HD float logsigmoidf_(float x) { return x < 0.f ? x - FLOG(1.f + FEXP(x)) : -FLOG(1.f + FEXP(-x)); }

template <class T> HD void st_mod(const NaiveBufs& a, int l, long idx) {
  using d = DD<T>; const int j = (int)(idx % (6 * d::D)), bb = (int)(idx / (6 * d::D));
  const float* cv = bb < d::B ? a.c + (long)bb * d::D : a.c_ctx; const float* w = a.w_mod + (long)l * d::D * 6 * d::D;
  float acc = a.b_mod[(long)l * 6 * d::D + j];
  for (int k = 0; k < d::D; ++k) acc += siluf_(cv[k]) * w[(long)k * 6 * d::D + j];
  a.mod[idx] = acc;
}
template <class T> HD void st_hyhid(const NaiveBufs& a, int l, int which, long idx) {
  using d = DD<T>; const int n = which ? d::C : d::S; float* dst = which ? a.hid2C : a.hid2S;
  const int j = (int)(idx % d::HF), t = (int)(idx / d::HF);
  const float* w1 = a.hy_pos_w1 + (long)l * d::HE * d::HF; const float* b1 = a.hy_pos_b1 + l * d::HF; const float* fr = a.hy_sin_freq + l * d::HF;
  const float* w2 = a.hy_pos_w2 + (long)l * d::HF * d::HF; const float* b2 = a.hy_pos_b2 + l * d::HF;
  const float tn = (float)t / (float)n; const float w0 = 2.f * 3.14159265358979323846f / (float)n;
  float acc2 = b2[j];
  for (int i = 0; i < d::HF; ++i) {
    float acc = b1[i] + tn * w1[0 * d::HF + i];
    for (int bnd = 0; bnd < d::HB; ++bnd) {
      const float band = 1e-4f + (float)bnd * ((float)(d::HB - 1) - 1e-4f) / (float)(d::HB - 1);
      const float ph = w0 * (float)t * band;
      acc += FCOS(ph) * w1[(1 + bnd) * d::HF + i] - FSIN(ph) * w1[(1 + d::HB + bnd) * d::HF + i];
    }
    acc2 += FSIN(fr[i] * acc) * w2[i * d::HF + j];
  }
  dst[idx] = FSIN(fr[j] * acc2);
}
template <class T> HD void st_hytaps(const NaiveBufs& a, int l, int which, long idx) {
  using d = DD<T>; const int n = which ? d::C : d::S; const float* hid2 = which ? a.hid2C : a.hid2S; float* dst = which ? a.tapsC : a.tapsS;
  const int c = (int)(idx % d::HW); const int li = (int)((idx / d::HW) % (2 * n)); const int o = (int)(idx / ((long)d::HW * 2 * n));
  float v = 0.f;
  if (li != n) {
    const int dir = li < n ? 0 : 1; const int t = li < n ? li : 2 * n - li;
    const int col = (o * 2 + dir) * d::HW + c;
    const float* w3 = a.hy_pos_w3 + (long)l * d::HF * 4 * d::HW;
    float acc = 0.f;
    for (int j = 0; j < d::HF; ++j) acc += hid2[(long)t * d::HF + j] * w3[(long)j * 4 * d::HW + col];
    const float dec = fabsf(a.hy_decay[(long)l * 4 * d::HW + col]);
    v = acc * FEXP(-((float)t / (float)n) * dec);
  }
  if (which == 0) dst[((long)o * d::HW + c) * 2 * n + li] = v; else dst[idx] = v;
}
template <class T> HD void st_hynorm(const NaiveBufs& a, int which, long idx) {
  using d = DD<T>; const int n = which ? d::C : d::S; const float* tp = which ? a.tapsC : a.tapsS; float* dst = which ? a.nrmC : a.nrmS;
  const int c = (int)(idx % d::HW), o = (int)(idx / d::HW);
  float s = 0.f; for (int li = 0; li < 2 * n; ++li) s += fabsf(which == 0 ? tp[((long)o * d::HW + c) * 2 * n + li] : tp[((long)o * 2 * n + li) * d::HW + c]);
  dst[idx] = s + 1e-6f;
}

template <class T> HD const float* xrow(const NaiveBufs& a, int l, int b, int r) {
  using d = DD<T>;
  if (r < d::S) return (l == 0 ? a.x : a.out) + ((long)b * d::S + r) * d::D;
  return (l == 0 ? a.ctx : a.xc) + ((long)b * d::C + (r - d::S)) * d::D;
}
template <class T> HD float* xrow_w(const NaiveBufs& a, int b, int r) {
  using d = DD<T>;
  if (r < d::S) return a.out + ((long)b * d::S + r) * d::D;
  return a.xc + ((long)b * d::C + (r - d::S)) * d::D;
}
template <class T> HD void st_rs(const NaiveBufs& a, int l, int b, int src, long idx) {
  using d = DD<T>; const int r = (int)idx; const float* xr = src ? (const float*)xrow_w<T>(a, b, r) : xrow<T>(a, l, b, r);
  float s = 0.f; for (int k = 0; k < d::D; ++k) s += xr[k] * xr[k];
  a.rs[r] = 1.f / sqrtf(s / (float)d::D + 1e-6f);
}
template <class T> HD void st_norm(const NaiveBufs& a, int l, int b, int which, long idx) {
  using d = DD<T>; const int j = (int)(idx % d::D), r = (int)(idx / d::D);
  const float* xr = which ? (const float*)xrow_w<T>(a, b, r) : xrow<T>(a, l, b, r);
  const float* g = (which ? a.norm2_g : a.norm1_g) + (long)l * d::D;
  const float* md = a.mod + (long)(r < d::S ? b : d::B) * 6 * d::D;
  const float shift = md[(which ? 3 : 0) * d::D + j], scale = md[(which ? 4 : 1) * d::D + j];
  a.h[idx] = xr[j] * a.rs[r] * g[j] * (1.f + scale) + shift;
}
struct GemmArgs { const float* A; int lda; const float* W; int ldw; float* Cc; int ldc; int M, N, K;
  const float* gate; int ldg;
  const float* colscale;
  const float* res; int ldr;
  int accumulate; };
HD void st_gemm(const GemmArgs& g, long idx) {
  const int nb = g.N / 4; const int cb = (int)(idx % nb), rb = (int)(idx / nb);
  float acc[4][4];
#pragma unroll
  for (int i = 0; i < 4; ++i) {
#pragma unroll
    for (int j = 0; j < 4; ++j) acc[i][j] = 0.f; }
  const float* a0 = g.A + (long)(rb * 4) * g.lda; const float* w0 = g.W + cb * 4;
  for (int k = 0; k < g.K; ++k) {
    float av[4], wv[4];
#pragma unroll
    for (int i = 0; i < 4; ++i) av[i] = a0[(long)i * g.lda + k];
#pragma unroll
    for (int j = 0; j < 4; ++j) wv[j] = w0[(long)k * g.ldw + j];
#pragma unroll
    for (int i = 0; i < 4; ++i) {
#pragma unroll
      for (int j = 0; j < 4; ++j) acc[i][j] += av[i] * wv[j]; }
  }
#pragma unroll
  for (int i = 0; i < 4; ++i)
#pragma unroll
  for (int j = 0; j < 4; ++j) {
    const int r = rb * 4 + i, c = cb * 4 + j; float v = acc[i][j];
    if (g.gate) v *= sigmoidf_(g.gate[(long)r * g.ldg + c]);
    if (g.colscale) v *= g.colscale[c];
    if (g.res) v += g.res[(long)r * g.ldr + c];
    float* p = g.Cc + (long)r * g.ldc + c;
    if (g.accumulate) v += *p;
    *p = v;
  }
}
template <class T> HD void st_qknorm(const NaiveBufs& a, int l, long idx) {
  using d = DD<T>; const int hh = (int)(idx % (d::AH + d::AKV)), r = (int)(idx / (d::AH + d::AKV));
  const bool isq = hh < d::AH; const int hd = isq ? hh : hh - d::AH;
  const float* src = a.proj + (long)r * d::NIN + (isq ? d::O_AQ : d::O_AK) + hd * d::HDM;
  float* dst = (isq ? a.qn + (long)r * d::AQW : a.kn + (long)r * d::AKVW) + hd * d::HDM;
  const float* g = (isq ? a.q_norm_g : a.k_norm_g) + (long)l * d::HDM;
  float s = 0.f; for (int k = 0; k < d::HDM; ++k) s += src[k] * src[k];
  const float rsq = 1.f / sqrtf(s / (float)d::HDM + 1e-6f);
  if (r < d::S) {
    const int row = r / d::GW, col = r % d::GW;
    for (int p = 0; p < d::HDM / 2; ++p) {
      const int fi = p < d::RP ? p : p - d::RP; const float pos = p < d::RP ? (float)row : (float)col;
      const float inv = FPOW(10000.f, -(float)fi / (float)d::RP); const float ang = pos * inv;
      const float cs = FCOS(ang), sn = FSIN(ang);
      const float x1 = src[2 * p] * rsq * g[2 * p], x2 = src[2 * p + 1] * rsq * g[2 * p + 1];
      dst[2 * p] = x1 * cs - x2 * sn; dst[2 * p + 1] = x1 * sn + x2 * cs;
    }
  } else { for (int k = 0; k < d::HDM; ++k) dst[k] = src[k] * rsq * g[k]; }
}
template <class T, int NSPLIT> HD void st_attn(const NaiveBufs& a, int r0, int nrows, long idx) {
  using d = DD<T>; constexpr int OD = d::HDM / NSPLIT;
  const int r = r0 + (int)(idx % nrows); const int hs = (int)(idx / nrows); const int part = hs % NSPLIT, hq = hs / NSPLIT; const int kv = hq / d::AG;
  const int k0 = r < d::S ? 0 : d::S, k1 = d::R;
  float q[d::HDM], o[OD];
  const float scale = 1.f / sqrtf((float)d::HDM);
#pragma unroll
  for (int k = 0; k < d::HDM; ++k) q[k] = a.qn[(long)r * d::AQW + hq * d::HDM + k] * scale;
#pragma unroll
  for (int k = 0; k < OD; ++k) o[k] = 0.f;
  float mx = -1e30f, lsum = 0.f;
  for (int kk = k0; kk < k1; ++kk) {
    const float* kr = a.kn + (long)kk * d::AKVW + kv * d::HDM;
    float s = 0.f;
#pragma unroll
    for (int k = 0; k < d::HDM; ++k) s += q[k] * kr[k];
    if (s > mx) { const float cr = FEXP(mx - s); lsum *= cr;
#pragma unroll
      for (int k = 0; k < OD; ++k) o[k] *= cr;
      mx = s; }
    const float p = FEXP(s - mx); lsum += p;
    const float* vr = a.proj + (long)kk * d::NIN + d::O_AV + kv * d::HDM + part * OD;
#pragma unroll
    for (int k = 0; k < OD; ++k) o[k] += p * vr[k];
  }
  const float inv = 1.f / lsum;
#pragma unroll
  for (int k = 0; k < OD; ++k) a.yatt[(long)r * d::AQW + hq * d::HDM + part * OD + k] = o[k] * inv;
}
template <class T> HD void st_glala(const NaiveBufs& a, int l, long idx) {
  using d = DD<T>; const int j = (int)(idx % d::GKW); const int dir = (int)((idx / d::GKW) % 2); const int r = (int)(idx / (2 * d::GKW));
  const float* al = a.proj + (long)r * d::NIN + d::O_GA + dir * d::GR;
  const float* w2 = a.gla_wa2 + ((long)l * 2 + dir) * d::GR * d::GKW; float z = a.gla_ba[((long)l * 2 + dir) * d::GKW + j];
  for (int k = 0; k < d::GR; ++k) z += al[k] * w2[(long)k * d::GKW + j];
  (dir ? a.lab : a.laf)[(long)r * d::GKW + j] = FEXP(logsigmoidf_(z) / 16.f);
}
template <class T> HD void st_glascan(const NaiveBufs& a, long idx) {
  using d = DD<T>; const int v = (int)(idx % d::GDV); const int hd = (int)((idx / d::GDV) % d::GH); const int dir = (int)(idx / (d::GDV * d::GH));
  float st[d::GDK];
#pragma unroll
  for (int k = 0; k < d::GDK; ++k) st[k] = 0.f;
  const float qs = 1.f / sqrtf((float)d::GDK);
  const float* la = dir ? a.lab : a.laf; float* od = dir ? a.ob : a.of;
  for (int step = 0; step < d::R; ++step) {
    int r;
    if (step < d::C) r = d::S + (dir ? d::C - 1 - step : step); else r = dir ? d::S - 1 - (step - d::C) : step - d::C;
    const float* pr = a.proj + (long)r * d::NIN;
    const float vv = pr[d::O_GV + hd * d::GDV + v];
    float o = 0.f;
#pragma unroll
    for (int k = 0; k < d::GDK; ++k) {
      st[k] = la[(long)r * d::GKW + hd * d::GDK + k] * st[k] + pr[d::O_GK + hd * d::GDK + k] * vv;
      o += pr[d::O_GQ + hd * d::GDK + k] * qs * st[k];
    }
    od[(long)r * d::GVW + hd * d::GDV + v] = o;
  }
}
template <class T> HD void st_glaout(const NaiveBufs& a, int l, long idx) {
  using d = DD<T>; const int hd = (int)(idx % d::GH), r = (int)(idx / d::GH);
  const long base = (long)r * d::GVW + hd * d::GDV; float s = 0.f;
  for (int v = 0; v < d::GDV; ++v) { const float o = a.of[base + v] + a.ob[base + v]; s += o * o; }
  const float rsq = 1.f / sqrtf(s / (float)d::GDV + 1e-6f);
  for (int v = 0; v < d::GDV; ++v) { const float o = a.of[base + v] + a.ob[base + v];
    a.ygla[base + v] = o * rsq * a.gla_norm_g[(long)l * d::GDV + v] * siluf_(a.proj[(long)r * d::NIN + d::O_OG + hd * d::GDV + v]); }
}
template <class T> HD void st_hyconv3(const NaiveBufs& a, int l, long idx) {
  using d = DD<T>; const int j = (int)(idx % (3 * d::HW)), r = (int)(idx / (3 * d::HW));
  const int lo = r < d::S ? 0 : d::S, hi = r < d::S ? d::S : d::R;
  const float* w = a.hy_conv_w + (long)l * 3 * 3 * d::HW;
  float v = a.hy_conv_b[(long)l * 3 * d::HW + j] + a.proj[(long)r * d::NIN + d::O_HY + j] * w[1 * 3 * d::HW + j];
  if (r - 1 >= lo) v += a.proj[(long)(r - 1) * d::NIN + d::O_HY + j] * w[0 * 3 * d::HW + j];
  if (r + 1 < hi) v += a.proj[(long)(r + 1) * d::NIN + d::O_HY + j] * w[2 * 3 * d::HW + j];
  a.uc[idx] = v;
}
template <class T> HD void st_hylong(const NaiveBufs& a, int l, int o, long idx) {
  using d = DD<T>; const int c = (int)(idx % d::HW); const int rb = (int)(idx / d::HW); const int r0 = rb * 4;
  const bool lat = r0 < d::S; const int n = lat ? d::S : d::C; const int base = lat ? 0 : d::S; const int t0 = r0 - base;
  const float* tp = (lat ? a.tapsS : a.tapsC) + (long)o * 2 * n * d::HW + c; const float nr = (lat ? a.nrmS : a.nrmC)[o * d::HW + c];
  const float* zs = o == 0 ? a.uc + 2 * d::HW + c : a.z1 + c; const int ldz = o == 0 ? 3 * d::HW : d::HW;
  float acc0 = 0.f, acc1 = 0.f, acc2 = 0.f, acc3 = 0.f;
  auto tap = [&](int lag) { const int li = lag >= 0 ? lag : 2 * n + lag; return tp[(long)li * d::HW]; };
  float w0 = tap(t0), w1 = tap(t0 + 1), w2 = tap(t0 + 2), w3 = tap(t0 + 3);
  for (int s = 0; s < n; ++s) {
    const float zv = zs[(long)(base + s) * ldz];
    acc0 += w0 * zv; acc1 += w1 * zv; acc2 += w2 * zv; acc3 += w3 * zv;
    w3 = w2; w2 = w1; w1 = w0; w0 = (s + 1 < n) ? tap(t0 - s - 1) : 0.f;
  }
  const float sk = a.hy_skip[((long)l * 2 + o) * d::HW + c];
  float* dst = o == 0 ? a.z1 : a.yhy;
  const float accs[4] = {acc0, acc1, acc2, acc3};
#pragma unroll
  for (int i = 0; i < 4; ++i) { const int r = r0 + i; const float zr = zs[(long)r * ldz];
    dst[(long)r * d::HW + c] = a.uc[(long)r * 3 * d::HW + o * d::HW + c] * (accs[i] / nr + sk * zr); }
}
template <class T> HD void st_router(const NaiveBufs& a, long idx) {
  using d = DD<T>; const int r = (int)idx; const float* hr = a.h + (long)r * d::D;
  float sc[d::NE], sel[d::NE];
#pragma unroll
  for (int e = 0; e < d::NE; ++e) sc[e] = 0.f;
  for (int k = 0; k < d::D; ++k) { const float hv = hr[k];
#pragma unroll
    for (int e = 0; e < d::NE; ++e) sc[e] += hv * a.router_w[(long)k * d::NE + e]; }
#pragma unroll
  for (int e = 0; e < d::NE; ++e) { sc[e] = sigmoidf_(sc[e]); sel[e] = sc[e] + a.router_b[e]; }
  int bestg = 0; float bestgs = -1e30f;
#pragma unroll
  for (int g = 0; g < d::NG; ++g) { float m1 = -1e30f, m2 = -1e30f;
#pragma unroll
    for (int i = 0; i < d::EPG; ++i) { const float v = sel[g * d::EPG + i]; if (v > m1) { m2 = m1; m1 = v; } else if (v > m2) m2 = v; }
    const float gs = m1 + m2; if (gs > bestgs) { bestgs = gs; bestg = g; } }
  int i1 = -1, i2 = -1; float v1 = -1e30f, v2 = -1e30f, s1 = 0.f, s2 = 0.f;
#pragma unroll
  for (int e = 0; e < d::NE; ++e) { if (e / d::EPG == bestg) { const float v = sel[e];
      if (v > v1) { v2 = v1; i2 = i1; s2 = s1; v1 = v; i1 = e; s1 = sc[e]; } else if (v > v2) { v2 = v; i2 = e; s2 = sc[e]; } } }
  const float inv = 1.f / (s1 + s2);
  a.ridx[2 * r] = i1; a.ridx[2 * r + 1] = i2; a.rw[2 * r] = s1 * inv; a.rw[2 * r + 1] = s2 * inv;
}
template <class T> HD void st_moehid(const NaiveBufs& a, int l, long idx) {
  using d = DD<T>; const int j = (int)(idx % d::DE); const int k = (int)((idx / d::DE) % 2); const int r = (int)(idx / (2 * d::DE));
  const int e = a.ridx[2 * r + k]; const float* hr = a.h + (long)r * d::D;
  const float* wg = a.moe_w_gate + (((long)l * d::NE + e) * d::D) * d::DE + j; const float* wu = a.moe_w_up + (((long)l * d::NE + e) * d::D) * d::DE + j;
  float g = 0.f, u = 0.f;
  for (int i = 0; i < d::D; ++i) { const float hv = hr[i]; g += hv * wg[(long)i * d::DE]; u += hv * wu[(long)i * d::DE]; }
  a.hid[idx] = siluf_(g) * u;
}
template <class T> HD void st_moeout(const NaiveBufs& a, int l, int b, long idx) {
  using d = DD<T>; const int dd = (int)(idx % d::D), r = (int)(idx / d::D);
  float acc = 0.f;
  for (int k = 0; k < 2; ++k) { const int e = a.ridx[2 * r + k]; const float* hk = a.hid + ((long)r * 2 + k) * d::DE;
    const float* wd = a.moe_w_down + (((long)l * d::NE + e) * d::DE) * d::D + dd; float s = 0.f;
    for (int j = 0; j < d::DE; ++j) s += hk[j] * wd[(long)j * d::D];
    acc += a.rw[2 * r + k] * s; }
  const float g2 = a.mod[(long)(r < d::S ? b : d::B) * 6 * d::D + 5 * d::D + dd];
  float* xr = xrow_w<T>(a, b, r); xr[dd] += g2 * acc;
}
enum { L_MOD = 0, L_HID_S, L_HID_C, L_TAPS_S, L_TAPS_C, L_NRM_S, L_NRM_C, N_LSTAGES,
       P_RS1 = 16, P_NORM1, P_INPROJ, P_QKNORM, P_ATTN_L, P_ATTN_C, P_GLALA, P_GLASCAN, P_GLAOUT, P_HYC3, P_HYL0, P_HYL1,
       P_MRG_HY, P_MRG_GLA, P_MRG_ATT, P_OUT_L, P_OUT_C, P_RS2, P_NORM2, P_ROUTER, P_MOEHID, P_MOEOUT, P_END };
constexpr int ATT_NSPLIT = 4;

template <class T> HD long stage_items(int st, int l) {
  using d = DD<T>; const bool last = (l == d::DEPTH - 1);
  switch (st) {
    case L_MOD: return (long)(d::B + 1) * 6 * d::D;
    case L_HID_S: return (long)d::S * d::HF;
    case L_HID_C: return (long)d::C * d::HF;
    case L_TAPS_S: return 2L * 2 * d::S * d::HW;
    case L_TAPS_C: return 2L * 2 * d::C * d::HW;
    case L_NRM_S: case L_NRM_C: return 2L * d::HW;
    case P_RS1: case P_RS2: case P_ROUTER: return d::R;
    case P_NORM1: case P_NORM2: return (long)d::R * d::D;
    case P_INPROJ: return (long)(d::R / 4) * (d::NIN / 4);
    case P_QKNORM: return (long)d::R * (d::AH + d::AKV);
    case P_ATTN_L: return (long)d::S * d::AH * ATT_NSPLIT;
    case P_ATTN_C: return last ? 0 : (long)d::C * d::AH * ATT_NSPLIT;
    case P_GLALA: return (long)d::R * 2 * d::GKW;
    case P_GLASCAN: return 2L * d::GH * d::GDV;
    case P_GLAOUT: return (long)d::R * d::GH;
    case P_HYC3: return (long)d::R * 3 * d::HW;
    case P_HYL0: case P_HYL1: return (long)(d::R / 4) * d::HW;
    case P_MRG_HY: case P_MRG_GLA: case P_MRG_ATT: return (long)(d::R / 4) * (d::D / 4);
    case P_OUT_L: return (long)(d::S / 4) * (d::D / 4);
    case P_OUT_C: return last ? 0 : (long)(d::C / 4) * (d::D / 4);
    case P_MOEHID: return (long)d::R * 2 * d::DE;
    case P_MOEOUT: return (long)(last ? d::S : d::R) * d::D;
  }
  return 0;
}

template <class T, int ST> HD void stage_run(const NaiveBufs& a, int l, int b, long idx) {
  using d = DD<T>;
  if constexpr (ST == L_MOD) st_mod<T>(a, l, idx);
  else if constexpr (ST == L_HID_S) st_hyhid<T>(a, l, 0, idx);
  else if constexpr (ST == L_HID_C) st_hyhid<T>(a, l, 1, idx);
  else if constexpr (ST == L_TAPS_S) st_hytaps<T>(a, l, 0, idx);
  else if constexpr (ST == L_TAPS_C) st_hytaps<T>(a, l, 1, idx);
  else if constexpr (ST == L_NRM_S) st_hynorm<T>(a, 0, idx);
  else if constexpr (ST == L_NRM_C) st_hynorm<T>(a, 1, idx);
  else if constexpr (ST == P_RS1) st_rs<T>(a, l, b, 0, idx);
  else if constexpr (ST == P_RS2) st_rs<T>(a, l, b, 1, idx);
  else if constexpr (ST == P_NORM1) st_norm<T>(a, l, b, 0, idx);
  else if constexpr (ST == P_NORM2) st_norm<T>(a, l, b, 1, idx);
  else if constexpr (ST == P_INPROJ) { GemmArgs g{a.h, d::D, a.w_in + (long)l * d::D * d::NIN, d::NIN, a.proj, d::NIN, d::R, d::NIN, d::D, nullptr, 0, nullptr, nullptr, 0, 0}; st_gemm(g, idx); }
  else if constexpr (ST == P_QKNORM) st_qknorm<T>(a, l, idx);
  else if constexpr (ST == P_ATTN_L) st_attn<T, ATT_NSPLIT>(a, 0, d::S, idx);
  else if constexpr (ST == P_ATTN_C) st_attn<T, ATT_NSPLIT>(a, d::S, d::C, idx);
  else if constexpr (ST == P_GLALA) st_glala<T>(a, l, idx);
  else if constexpr (ST == P_GLASCAN) st_glascan<T>(a, idx);
  else if constexpr (ST == P_GLAOUT) st_glaout<T>(a, l, idx);
  else if constexpr (ST == P_HYC3) st_hyconv3<T>(a, l, idx);
  else if constexpr (ST == P_HYL0) st_hylong<T>(a, l, 0, idx);
  else if constexpr (ST == P_HYL1) st_hylong<T>(a, l, 1, idx);
  else if constexpr (ST == P_MRG_HY) { GemmArgs g{a.yhy, d::HW, a.w_br_hy + (long)l * d::HW * d::D, d::D, a.m, d::D, d::R, d::D, d::HW, a.proj + d::O_BR, d::NIN, nullptr, nullptr, 0, 0}; st_gemm(g, idx); }
  else if constexpr (ST == P_MRG_GLA) { GemmArgs g{a.ygla, d::GVW, a.w_br_gla + (long)l * d::GVW * d::D, d::D, a.m, d::D, d::R, d::D, d::GVW, a.proj + d::O_BR + d::D, d::NIN, nullptr, nullptr, 0, 1}; st_gemm(g, idx); }
  else if constexpr (ST == P_MRG_ATT) { GemmArgs g{a.yatt, d::AQW, a.w_br_att + (long)l * d::AQW * d::D, d::D, a.m, d::D, d::R, d::D, d::AQW, a.proj + d::O_BR + 2 * d::D, d::NIN, nullptr, nullptr, 0, 1}; st_gemm(g, idx); }
  else if constexpr (ST == P_OUT_L) { const float* res = (l == 0 ? a.x : (const float*)a.out) + (long)b * d::S * d::D;
    GemmArgs g{a.m, d::D, a.w_out + (long)l * d::D * d::D, d::D, a.out + (long)b * d::S * d::D, d::D, d::S, d::D, d::D, nullptr, 0, a.mod + (long)b * 6 * d::D + 2 * d::D, res, d::D, 0}; st_gemm(g, idx); }
  else if constexpr (ST == P_OUT_C) { const float* res = (l == 0 ? a.ctx : (const float*)a.xc) + (long)b * d::C * d::D;
    GemmArgs g{a.m + (long)d::S * d::D, d::D, a.w_out + (long)l * d::D * d::D, d::D, a.xc + (long)b * d::C * d::D, d::D, d::C, d::D, d::D, nullptr, 0, a.mod + (long)d::B * 6 * d::D + 2 * d::D, res, d::D, 0}; st_gemm(g, idx); }
  else if constexpr (ST == P_ROUTER) st_router<T>(a, idx);
  else if constexpr (ST == P_MOEHID) st_moehid<T>(a, l, idx);
  else if constexpr (ST == P_MOEOUT) st_moeout<T>(a, l, b, idx);
}

template <class T> inline size_t carve(NaiveBufs& a, float* ws) {
  using d = DD<T>; size_t o = 0; auto take = [&](size_t n) { float* p = ws ? ws + o : nullptr; o += (n + 63) & ~(size_t)63; return p; };
  a.mod = take((size_t)(d::B + 1) * 6 * d::D);
  a.hid2S = take((size_t)d::S * d::HF); a.hid2C = take((size_t)d::C * d::HF);
  a.tapsS = take((size_t)2 * 2 * d::S * d::HW); a.tapsC = take((size_t)2 * 2 * d::C * d::HW);
  a.nrmS = take(2 * d::HW); a.nrmC = take(2 * d::HW);
  a.rs = take(d::R); a.h = take((size_t)d::R * d::D); a.proj = take((size_t)d::R * d::NIN);
  a.qn = take((size_t)d::R * d::AQW); a.kn = take((size_t)d::R * d::AKVW);
  a.uc = take((size_t)d::R * 3 * d::HW); a.z1 = take((size_t)d::R * d::HW); a.yhy = take((size_t)d::R * d::HW);
  a.xc = take((size_t)d::B * d::C * d::D);
#ifdef HOST_TEST
  a.yatt = take((size_t)d::R * d::AQW); a.laf = take((size_t)d::R * d::GKW); a.lab = take((size_t)d::R * d::GKW);
  a.of = take((size_t)d::R * d::GVW); a.ob = take((size_t)d::R * d::GVW); a.ygla = take((size_t)d::R * d::GVW);
  a.m = take((size_t)d::R * d::D); a.ridx = (int*)take((size_t)d::R * 2); a.rw = take((size_t)d::R * 2); a.hid = take((size_t)d::R * 2 * d::DE);
#endif
  return o;
}
template <class T> inline void set_inputs(NaiveBufs& a, const float* const* in) {
  int i = 0;
  a.x = in[i++]; a.c = in[i++]; a.ctx = in[i++]; a.c_ctx = in[i++]; a.w_mod = in[i++]; a.b_mod = in[i++]; a.norm1_g = in[i++]; a.norm2_g = in[i++];
  a.w_in = in[i++]; a.q_norm_g = in[i++]; a.k_norm_g = in[i++]; a.gla_wa2 = in[i++]; a.gla_ba = in[i++]; a.gla_norm_g = in[i++];
  a.hy_conv_w = in[i++]; a.hy_conv_b = in[i++]; a.hy_pos_w1 = in[i++]; a.hy_pos_b1 = in[i++]; a.hy_sin_freq = in[i++]; a.hy_pos_w2 = in[i++];
  a.hy_pos_b2 = in[i++]; a.hy_pos_w3 = in[i++]; a.hy_decay = in[i++]; a.hy_skip = in[i++]; a.w_br_hy = in[i++]; a.w_br_gla = in[i++];
  a.w_br_att = in[i++]; a.w_out = in[i++]; a.router_w = in[i++]; a.router_b = in[i++]; a.moe_w_gate = in[i++]; a.moe_w_up = in[i++]; a.moe_w_down = in[i++];
}

#define LSTAGES(X) X(L_MOD) X(L_HID_S) X(L_HID_C) X(L_TAPS_S) X(L_TAPS_C) X(L_NRM_S) X(L_NRM_C)
#define PSTAGES(X) X(P_RS1) X(P_NORM1) X(P_INPROJ) X(P_QKNORM) X(P_ATTN_L) X(P_ATTN_C) X(P_GLALA) X(P_GLASCAN) X(P_GLAOUT) X(P_HYC3) X(P_HYL0) X(P_HYL1) \
  X(P_MRG_HY) X(P_MRG_GLA) X(P_MRG_ATT) X(P_OUT_L) X(P_OUT_C) X(P_RS2) X(P_NORM2) X(P_ROUTER) X(P_MOEHID) X(P_MOEOUT)
namespace pro {
__device__ __forceinline__ void mod_phase(const NaiveBufs& a, int l, LAS unsigned char* lds) {
  int tz = threadIdx.x; asm volatile("" : "+v"(tz));
  __syncthreads();
  LAS float* sl = (LAS float*)lds; LAS float* part = sl + 9 * 1024;
  for (int e = tz; e < 9 * 1024; e += NTHREADS) { const int bb = e >> 10, k = e & 1023; const float cv = bb < 8 ? a.c[bb * 1024 + k] : a.c_ctx[k]; sl[e] = cv / (1.f + __expf(-cv)); }
  __syncthreads();
  const float* w = a.w_mod + (size_t)l * 1024 * 6144;
  const int jl = tz & 63, ks = tz >> 6;
  for (int cb = blockIdx.x; cb < 96; cb += gridDim.x) { const int j = cb * 64 + jl; float acc[9];
#pragma unroll
    for (int q = 0; q < 9; ++q) acc[q] = 0.f;
#pragma unroll 4
    for (int k = ks * 128; k < ks * 128 + 128; ++k) { const float wv = w[(size_t)k * 6144 + j];
#pragma unroll
      for (int q = 0; q < 9; ++q) acc[q] += sl[q * 1024 + k] * wv; }
#pragma unroll
    for (int q = 0; q < 9; ++q) part[(ks * 9 + q) * 64 + jl] = acc[q];
    __syncthreads();
    for (int e = tz; e < 9 * 64; e += NTHREADS) { const int q = e >> 6, jj = e & 63; float s = a.b_mod[(size_t)l * 6144 + cb * 64 + jj];
#pragma unroll
      for (int k8 = 0; k8 < 8; ++k8) s += part[(k8 * 9 + q) * 64 + jj];
      a.mod[(size_t)q * 6144 + cb * 64 + jj] = s; }
    __syncthreads(); }
  __syncthreads();
}
__device__ __forceinline__ void hid_phase(const NaiveBufs& a, int l, int n, float* dst, LAS unsigned char* lds) {
  int tz = threadIdx.x; asm volatile("" : "+v"(tz));
  LAS float* Z = (LAS float*)(lds + 40960); LAS float* H1 = Z + 8 * 36;
  const float* w1 = a.hy_pos_w1 + (size_t)l * 33 * 64; const float* b1 = a.hy_pos_b1 + l * 64; const float* fr = a.hy_sin_freq + l * 64;
  const float* w2 = a.hy_pos_w2 + (size_t)l * 64 * 64; const float* b2 = a.hy_pos_b2 + l * 64;
  const float w0 = 2.f * 3.14159265358979323846f / (float)n;
  for (int t0 = blockIdx.x * 8; t0 < n; t0 += gridDim.x * 8) {
    if (tz < 8 * 33) { const int tt = tz / 33, e = tz % 33, t = t0 + tt; float v;
      if (e == 0) v = (float)t / (float)n; else { const int bnd = (e - 1) & 15; const float band = 1e-4f + (float)bnd * (15.f - 1e-4f) / 15.f; const float ph = w0 * (float)t * band; v = e <= 16 ? cosf(ph) : -sinf(ph); }
      Z[tt * 36 + e] = v; }
    __syncthreads();
    { const int tt = tz >> 6, i = tz & 63; float acc = b1[i];
#pragma unroll
      for (int e = 0; e < 33; ++e) acc += Z[tt * 36 + e] * w1[e * 64 + i];
      H1[tt * 64 + i] = sinf(fr[i] * acc); }
    __syncthreads();
    { const int tt = tz >> 6, j = tz & 63; float acc = b2[j];
#pragma unroll 8
      for (int i = 0; i < 64; ++i) acc += H1[tt * 64 + i] * w2[i * 64 + j];
      if (t0 + tt < n) dst[(size_t)(t0 + tt) * 64 + j] = sinf(fr[j] * acc); }
    __syncthreads();
  }
}
__device__ __forceinline__ void nrmS_phase(const NaiveBufs& a) {
  int tz = threadIdx.x; asm volatile("" : "+v"(tz)); const int lane = tz & 63, wave = __builtin_amdgcn_readfirstlane(tz >> 6);
  for (int oc = blockIdx.x * NWAVES + wave; oc < 1024; oc += gridDim.x * NWAVES) { const float* tp = a.tapsS + (size_t)oc * 8192; float s = 0.f;
#pragma unroll 8
    for (int k = lane; k < 8192; k += 64) s += fabsf(tp[k]);
    s = moe::wave_sum(s); if (lane == 0) a.nrmS[oc] = s + 1e-6f; }
}
constexpr int TCOPY = 8232;
__device__ __forceinline__ void tapsB_phase(const NaiveBufs& a, int l, bf16_t* tapsB, LAS unsigned char* lds) {
  int tz = threadIdx.x; asm volatile("" : "+v"(tz));
  const float* w3 = a.hy_pos_w3 + (size_t)l * 64 * 2048; const float* dcy = a.hy_decay + (size_t)l * 2048;
  typedef float f4 __attribute__((ext_vector_type(4)));
  LAS float* W = (LAS float*)lds;
  for (int cp = blockIdx.x; cp < 256; cp += gridDim.x) {
    __syncthreads();
    { const int ch = tz >> 8, e = tz & 255, c = cp + 256 * ch; W[tz] = w3[(size_t)(e >> 2) * 2048 + (e & 3) * 512 + c]; if (tz < 8) W[512 + tz] = fabsf(dcy[(tz & 3) * 512 + cp + 256 * (tz >> 2)]); }
    __syncthreads();
    for (int t = tz; t < 4096; t += NTHREADS) {
      const f4* h2 = (const f4*)(a.hid2S + (size_t)t * 64); f4 acc0 = {0.f, 0.f, 0.f, 0.f}, acc1 = {0.f, 0.f, 0.f, 0.f};
#pragma unroll 4
      for (int j4 = 0; j4 < 16; ++j4) { const f4 h = h2[j4];
#pragma unroll
        for (int e = 0; e < 4; ++e) { acc0 += h[e] * *(const LAS f4*)(W + (4 * j4 + e) * 4); acc1 += h[e] * *(const LAS f4*)(W + 256 + (4 * j4 + e) * 4); } }
      const float tn = (float)t * (1.f / 4096.f);
#pragma unroll
      for (int ch = 0; ch < 2; ++ch)
#pragma unroll
        for (int q = 0; q < 4; ++q) { const int o = q >> 1, dir = q & 1; if (dir == 1 && t == 0) continue; const int c = cp + 256 * ch;
          const bf16_t bv = (bf16_t)f2bf((ch ? acc1[q] : acc0[q]) * __expf(-tn * W[512 + 4 * ch + q]));
          bf16_t* base = tapsB + ((size_t)o * 512 + c) * 2 * TCOPY; const int x0 = dir ? 4096 + t : 4096 - t;
          base[x0] = bv; base[TCOPY + x0 - 1] = bv; } } }
  for (long idx = (long)blockIdx.x * NTHREADS + tz; idx < 1024L * 96; idx += (long)gridDim.x * NTHREADS) { const int oc = (int)(idx / 96), e = (int)(idx % 96); bf16_t* base = tapsB + (size_t)oc * 2 * TCOPY;
    if (e < 40) base[8192 + e] = 0; else if (e < 81) base[TCOPY + 8191 + (e - 40)] = 0; else if (e == 81) base[0] = 0; }
}
__device__ __forceinline__ void nrmB_phase(const NaiveBufs& a, const bf16_t* tapsB) {
  int tz = threadIdx.x; asm volatile("" : "+v"(tz)); const int lane = tz & 63, wave = __builtin_amdgcn_readfirstlane(tz >> 6);
  for (int oc = blockIdx.x * NWAVES + wave; oc < 1024; oc += gridDim.x * NWAVES) { const bf16_t* tp = tapsB + (size_t)oc * 2 * TCOPY; float s = 0.f;
#pragma unroll 8
    for (int k = lane; k < 8192; k += 64) s += fabsf(bf2f(tp[k]));
    s = moe::wave_sum(s); if (lane == 0) a.nrmS[oc] = s + 1e-6f; }
}
}
using TD = FullDims;
using dd = DD<TD>;
constexpr int GB = 4, NGRP = 2, RB = dd::R  , RG = GB * RB, PLD = dd::NIN, PANELS = RG / 256, PPB = RB / 256  ;
constexpr size_t BAR_BYTES = 16384 + 4 * 4096; constexpr int CNT_OFF = 16384;
constexpr int MPG = 38912;
constexpr size_t CS_BYTES = (size_t)2 * 4 * 68 * 64 * 128 * 4, DEC_BYTES = (size_t)2 * 4 * 68 * 64 * 4;
constexpr size_t UCT_BYTES = (size_t)1536 * 4096 * 2, YT_BYTES = (size_t)512 * 4096 * 2, UCC_BYTES = (size_t)256 * 1536 * 4, Z1C_BYTES = (size_t)256 * 512 * 4;
constexpr size_t MIX_BYTES = GB * (CS_BYTES + DEC_BYTES) > GB * (UCT_BYTES + YT_BYTES + UCC_BYTES + Z1C_BYTES) ? GB * (CS_BYTES + DEC_BYTES) : GB * (UCT_BYTES + YT_BYTES + UCC_BYTES + Z1C_BYTES);

struct KArgs { NaiveBufs a; unsigned* bar; int* cnt; bf16_t *WinT, *WhyT, *WglaT, *WattT, *WoutT, *WguT, *WdT, *hb, *proj; unsigned char* mix;
  bf16_t *hp, *hid, *contrib; int* srcrow; float* wgt; moe::Route* route; float* wts; };

struct EpiProjBf16 {
  static constexpr bool PERM = true, AFTER_DRAIN = false;
  bf16_t* P;
  __device__ __forceinline__ void operator()(const pg8::f32x4 (&acc)[2][2][4][2], const pg8::Unit& u, int wr, int wc, int fr, int fq) const {
    const int row0 = u.pm * 256 + wr * 64 + fr, col0 = u.pn * 256 + wc * 32 + 8 * fq;
#pragma unroll
    for (int ai = 0; ai < 2; ++ai)
#pragma unroll
      for (int m = 0; m < 4; ++m) { bf16_t* rowp = P + (size_t)(row0 + ai * 128 + m * 16) * PLD + col0;
#pragma unroll
        for (int bj = 0; bj < 2; ++bj) if (col0 + bj * 128 < PLD) { const pg8::f32x4 v0 = acc[ai][bj][m][0], v1 = acc[ai][bj][m][1];
          v4u o; o.x = pk2(v0[0], v0[1]); o.y = pk2(v0[2], v0[3]); o.z = pk2(v1[0], v1[1]); o.w = pk2(v1[2], v1[3]); *(v4u*)(rowp + bj * 128) = o; } }
  }
};
template <bool ACCUM> struct EpiMergeB {
  static constexpr bool PERM = true, AFTER_DRAIN = false;
  const bf16_t* gate; bf16_t* M;
  __device__ __forceinline__ void operator()(const pg8::f32x4 (&acc)[2][2][4][2], const pg8::Unit& u, int wr, int wc, int fr, int fq) const {
    const int row0 = u.pm * 256 + wr * 64 + fr, col0 = u.pn * 256 + wc * 32 + 8 * fq;
#pragma unroll
    for (int ai2 = 0; ai2 < 4; ++ai2) { const int ai = ai2 >> 1, m0 = (ai2 & 1) * 2;
      v4u gw[4][2], mo[4][2];
#pragma unroll
      for (int m = m0; m < m0 + 2; ++m)
#pragma unroll
        for (int bj = 0; bj < 2; ++bj) { const size_t r = (size_t)(row0 + ai * 128 + m * 16); const int c = col0 + bj * 128; gw[m][bj] = *(const v4u*)(gate + r * PLD + c); if (ACCUM) mo[m][bj] = *(const v4u*)(M + r * 1024 + c); }
#pragma unroll
      for (int m = m0; m < m0 + 2; ++m)
#pragma unroll
        for (int bj = 0; bj < 2; ++bj) { const size_t r = (size_t)(row0 + ai * 128 + m * 16); const int c = col0 + bj * 128; const v4u g4 = gw[m][bj];
          pg8::f32x4 v0 = acc[ai][bj][m][0], v1 = acc[ai][bj][m][1];
          v0[0] *= fsigmoid(bf2f(g4.x & 0xffff)); v0[1] *= fsigmoid(bf2f(g4.x >> 16)); v0[2] *= fsigmoid(bf2f(g4.y & 0xffff)); v0[3] *= fsigmoid(bf2f(g4.y >> 16));
          v1[0] *= fsigmoid(bf2f(g4.z & 0xffff)); v1[1] *= fsigmoid(bf2f(g4.z >> 16)); v1[2] *= fsigmoid(bf2f(g4.w & 0xffff)); v1[3] *= fsigmoid(bf2f(g4.w >> 16));
          if (ACCUM) { const v4u o = mo[m][bj]; v0[0] += bf2f(o.x & 0xffff); v0[1] += bf2f(o.x >> 16); v0[2] += bf2f(o.y & 0xffff); v0[3] += bf2f(o.y >> 16);
            v1[0] += bf2f(o.z & 0xffff); v1[1] += bf2f(o.z >> 16); v1[2] += bf2f(o.w & 0xffff); v1[3] += bf2f(o.w >> 16); }
          v4u o2; o2.x = pk2(v0[0], v0[1]); o2.y = pk2(v0[2], v0[3]); o2.z = pk2(v1[0], v1[1]); o2.w = pk2(v1[2], v1[3]); *(v4u*)(M + r * 1024 + c) = o2; } }
  }
};
struct EpiOutG {
  static constexpr bool PERM = false, AFTER_DRAIN = false;
  const float* resL; float* outL; const float* resC; float* outC; const float* mod; int b0; bool ctx_on;
  __device__ __forceinline__ void operator()(const pg8::f32x4 (&acc)[2][2][4][2], const pg8::Unit& u, int wr, int wc, int fr, int fq) const {
    const int bl = u.pm / PPB, lp = u.pm % PPB; const bool isc = lp == PPB - 1; if (isc && !ctx_on) return;
    const int b = b0 + bl;
    const float* res = isc ? resC + (size_t)b * dd::C * 1024 : resL + ((size_t)b * dd::S + lp * 256) * 1024;
    float* out = isc ? outC + (size_t)b * dd::C * 1024 : outL + ((size_t)b * dd::S + lp * 256) * 1024;
    const float* gv = mod + (size_t)(isc ? dd::B : b) * 6 * 1024 + 2 * 1024;
    const int row0 = wr * 64 + fr, col0 = u.pn * 256 + wc * 32 + 4 * fq;
    pg8::f32x4 gg[2][2];
#pragma unroll
    for (int bj = 0; bj < 2; ++bj)
#pragma unroll
      for (int n = 0; n < 2; ++n) gg[bj][n] = *(const pg8::f32x4*)(gv + col0 + bj * 128 + n * 16);
#pragma unroll
    for (int ai2 = 0; ai2 < 4; ++ai2) { const int ai = ai2 >> 1, m0 = (ai2 & 1) * 2;
      pg8::f32x4 rv[4][2][2];
#pragma unroll
      for (int m = m0; m < m0 + 2; ++m)
#pragma unroll
        for (int bj = 0; bj < 2; ++bj)
#pragma unroll
          for (int n = 0; n < 2; ++n) rv[m][bj][n] = *(const pg8::f32x4*)(res + (size_t)(row0 + ai * 128 + m * 16) * 1024 + col0 + bj * 128 + n * 16);
#pragma unroll
      for (int m = m0; m < m0 + 2; ++m)
#pragma unroll
        for (int bj = 0; bj < 2; ++bj)
#pragma unroll
          for (int n = 0; n < 2; ++n) *(pg8::f32x4*)(out + (size_t)(row0 + ai * 128 + m * 16) * 1024 + col0 + bj * 128 + n * 16) = rv[m][bj][n] + gg[bj][n] * acc[ai][bj][m][n]; }
  }
};
struct GroupOrder {
  int nN, nwg, G, c; bool lat;
  __device__ void init(int N, int G_, int c_, bool lat_) { nN = N / 256; lat = lat_; nwg = (lat ? GB * 16 : PANELS) * nN; G = G_; c = c_; }
  __device__ __forceinline__ bool next(int i, pg8::Unit& u) const { const long L = (long)i * G + c; if (L >= nwg) return false; const int p = (int)L / nN; u.pm = lat ? (p >> 4) * PPB + (p & 15) : p; u.pn = (int)L % nN; u.acol = 0; return true; }
  __device__ __forceinline__ void a_ready(const pg8::Unit&) const {}
  __device__ __forceinline__ void done(const pg8::Unit&) const {}
};
struct MergeOrder {
  int ntiles, G, c; bool lat;
  __device__ void init(int G_, int c_, bool lat_) { lat = lat_; ntiles = (lat ? GB * 16 : PANELS) * 4; G = G_; c = c_; }
  __device__ __forceinline__ bool next(int i, pg8::Unit& u) const { const int rnd = i >> 2, gi = i & 3; const long tile = (long)rnd * G + c; if (tile >= ntiles) return false; const int p = (int)tile >> 2;
    u.pm = lat ? (p >> 4) * PPB + (p & 15) : p; u.pn = gi * 4 + ((int)tile & 3); u.acol = gi == 0 ? dd::O_HY : gi == 1 ? dd::O_OG : gi == 2 ? dd::O_AQ : dd::O_AQ + 512; return true; }
  __device__ __forceinline__ void a_ready(const pg8::Unit&) const {}
  __device__ __forceinline__ void done(const pg8::Unit&) const {}
};
struct EpiMergeS {
  static constexpr bool PERM = true, AFTER_DRAIN = false;
  const bf16_t* gate0; bf16_t* M;
  __device__ __forceinline__ void operator()(const pg8::f32x4 (&acc)[2][2][4][2], const pg8::Unit& u, int wr, int wc, int fr, int fq) const {
    const int gi = u.pn >> 2; const bool accum = gi > 0; const bf16_t* gate = gate0 + (gi > 2 ? 2 : gi) * 1024;
    const int row0 = u.pm * 256 + wr * 64 + fr, col0 = (u.pn & 3) * 256 + wc * 32 + 8 * fq;
#pragma unroll
    for (int ai = 0; ai < 2; ++ai)
#pragma unroll
      for (int m = 0; m < 4; ++m) { const size_t r = (size_t)(row0 + ai * 128 + m * 16);
#pragma unroll
        for (int bj = 0; bj < 2; ++bj) { const int c = col0 + bj * 128; const v4u gw = *(const v4u*)(gate + r * PLD + c);
          pg8::f32x4 v0 = acc[ai][bj][m][0], v1 = acc[ai][bj][m][1];
          v0[0] *= fsigmoid(bf2f(gw.x & 0xffff)); v0[1] *= fsigmoid(bf2f(gw.x >> 16)); v0[2] *= fsigmoid(bf2f(gw.y & 0xffff)); v0[3] *= fsigmoid(bf2f(gw.y >> 16));
          v1[0] *= fsigmoid(bf2f(gw.z & 0xffff)); v1[1] *= fsigmoid(bf2f(gw.z >> 16)); v1[2] *= fsigmoid(bf2f(gw.w & 0xffff)); v1[3] *= fsigmoid(bf2f(gw.w >> 16));
          v4u* dst = (v4u*)(M + r * 1024 + c);
          if (accum) { const v4u o = *dst; v0[0] += bf2f(o.x & 0xffff); v0[1] += bf2f(o.x >> 16); v0[2] += bf2f(o.y & 0xffff); v0[3] += bf2f(o.y >> 16);
            v1[0] += bf2f(o.z & 0xffff); v1[1] += bf2f(o.z >> 16); v1[2] += bf2f(o.w & 0xffff); v1[3] += bf2f(o.w >> 16); }
          v4u o2; o2.x = pk2(v0[0], v0[1]); o2.y = pk2(v0[2], v0[3]); o2.z = pk2(v1[0], v1[1]); o2.w = pk2(v1[2], v1[3]); *dst = o2; } }
  }
};
__device__ __forceinline__ const float* xrow_in(const NaiveBufs& a, int l, int b, int r) {
  if (r < dd::S) return (l == 0 ? a.x : (const float*)a.out) + ((size_t)b * dd::S + r) * 1024;
  return (l == 0 ? a.ctx : (const float*)a.xc) + ((size_t)b * dd::C + (r - dd::S)) * 1024;
}
__device__ __forceinline__ float* xrow_cur(const NaiveBufs& a, int b, int r) {
  if (r < dd::S) return a.out + ((size_t)b * dd::S + r) * 1024;
  return a.xc + ((size_t)b * dd::C + (r - dd::S)) * 1024;
}
__device__ __forceinline__ void norm_row(const float* xr, const float* gnorm, const float* shift, const float* scale, bf16_t* hrow, int lane) {
  typedef float f4 __attribute__((ext_vector_type(4)));
  f4 xv[4]; float ss = 0.f;
#pragma unroll
  for (int j = 0; j < 4; ++j) { xv[j] = *(const f4*)(xr + 4 * lane + 256 * j); ss += xv[j][0] * xv[j][0] + xv[j][1] * xv[j][1] + xv[j][2] * xv[j][2] + xv[j][3] * xv[j][3]; }
  const float rs = 1.f / sqrtf(moe::wave_sum(ss) * (1.f / 1024.f) + 1e-6f);
#pragma unroll
  for (int j = 0; j < 4; ++j) { const int c = 4 * lane + 256 * j; const f4 g4 = *(const f4*)(gnorm + c), sh = *(const f4*)(shift + c), sc = *(const f4*)(scale + c);
    f4 h;
#pragma unroll
    for (int i = 0; i < 4; ++i) h[i] = xv[j][i] * rs * g4[i] * (1.f + sc[i]) + sh[i];
    *(unsigned long long*)(hrow + c) = (unsigned long long)pk2(h[0], h[1]) | ((unsigned long long)pk2(h[2], h[3]) << 32); }
}
__device__ __forceinline__ void qknorm_row(bf16_t* prow, const float* qg, const float* kg, int r, int lane) {
  const bool lat = r < dd::S; const int grow = r / dd::GW, gcol = r % dd::GW;
  const int fi = lane & 31; const float pos = (lane < 32) ? (float)grow : (float)gcol;
  const float ang = pos * __builtin_amdgcn_exp2f(-(float)fi * (13.287712379549449f / 32.f));
  const float cs = lat ? __cosf(ang) : 1.f, sn = lat ? __sinf(ang) : 0.f;
  unsigned wv[10];
#pragma unroll
  for (int hh = 0; hh < 10; ++hh) wv[hh] = *((const unsigned*)(prow + (hh < 8 ? dd::O_AQ + hh * 128 : dd::O_AK + (hh - 8) * 128)) + lane);
  float ss[10];
#pragma unroll
  for (int hh = 0; hh < 10; ++hh) { const float x1 = bf2f(wv[hh] & 0xffff), x2 = bf2f(wv[hh] >> 16); ss[hh] = x1 * x1 + x2 * x2; }
#pragma unroll
  for (int o = 1; o < 64; o <<= 1) {
#pragma unroll
    for (int hh = 0; hh < 10; ++hh) ss[hh] += __shfl_xor(ss[hh], o); }
  const float q1 = qg[2 * lane], q2 = qg[2 * lane + 1], k1 = kg[2 * lane], k2 = kg[2 * lane + 1];
#pragma unroll
  for (int hh = 0; hh < 10; ++hh) { unsigned* p = (unsigned*)(prow + (hh < 8 ? dd::O_AQ + hh * 128 : dd::O_AK + (hh - 8) * 128)) + lane;
    const float x1 = bf2f(wv[hh] & 0xffff), x2 = bf2f(wv[hh] >> 16); const float rs = 1.f / sqrtf(ss[hh] * (1.f / 128.f) + 1e-6f);
    const float y1 = x1 * rs * (hh < 8 ? q1 : k1), y2 = x2 * rs * (hh < 8 ? q2 : k2);
    *p = pk2(y1 * cs - y2 * sn, y1 * sn + y2 * cs); }
}

__global__ void __launch_bounds__(NTHREADS, 2) mega_kernel(KArgs ka_unused) {
  extern __shared__ __attribute__((aligned(16))) unsigned char lds_raw[];
  LAS unsigned char* lds = (LAS unsigned char*)lds_raw;
  volatile LAS unsigned* MISC = (volatile LAS unsigned*)(lds + MISC_OFF);
  constexpr int ARGS_OFF = MISC_OFF + 256;
  static_assert(ARGS_OFF + sizeof(KArgs) <= LDS_BYTES, "LDS map");
  { const unsigned __attribute__((address_space(4)))* kp = (const unsigned __attribute__((address_space(4)))*)__builtin_amdgcn_kernarg_segment_ptr();
    for (int i = threadIdx.x; i < (int)(sizeof(KArgs) / 4); i += NTHREADS) ((LAS unsigned*)(lds + ARGS_OFF))[i] = kp[i]; }
  if (threadIdx.x < 64) MISC[threadIdx.x] = 0u;
  __syncthreads();
  const KArgs& ka = *(const KArgs*)(const LAS KArgs*)(lds + ARGS_OFF);
  const NaiveBufs& a = ka.a;
  unsigned* bar_s; { const unsigned long long bp = (unsigned long long)ka.bar; const unsigned lo_ = __builtin_amdgcn_readfirstlane((unsigned)bp), hi_ = __builtin_amdgcn_readfirstlane((unsigned)(bp >> 32));
    bar_s = (unsigned*)(((unsigned long long)hi_ << 32) | lo_); }
  XcdBarrier xb = xcd_barrier_post(bar_s, MISC);
#define SPTR(T, name, src) T* name; { const unsigned long long bp_ = (unsigned long long)(src); const unsigned lo_ = __builtin_amdgcn_readfirstlane((unsigned)bp_), hi_ = __builtin_amdgcn_readfirstlane((unsigned)(bp_ >> 32)); name = (T*)(((unsigned long long)hi_ << 32) | lo_); }
  SPTR(bf16_t, proj_s, ka.proj) SPTR(bf16_t, hb_s, ka.hb) SPTR(unsigned char, mix_s, ka.mix)
  const long gs = (long)gridDim.x * NTHREADS;
  LAS int* poff = (LAS int*)(lds + MISC_OFF + 64);
#define TID_SETUP int tz = threadIdx.x; asm volatile("" : "+v"(tz)); const int lane = tz & 63, wave = __builtin_amdgcn_readfirstlane(tz >> 6); \
    const int gw = blockIdx.x * NWAVES + wave, NGW = gridDim.x * NWAVES; const long gt = (long)blockIdx.x * NTHREADS + tz; (void)lane; (void)gw; (void)NGW; (void)gt;
#define LSTAGE(ST) { TID_SETUP const long n_ = stage_items<TD>(ST, l); for (long i_ = gt; i_ < n_; i_ += gs) stage_run<TD, ST>(a, l, 0, i_); }
  for (int l = 0; l < dd::DEPTH; ++l) {
    const bool last = (l == dd::DEPTH - 1);
    { TID_SETUP
      LAS float* scr = (LAS float*)(lds + RING_OFF + wave * 16384);
      constexpr int NIT = (dd::D / 64) * (dd::NIN / 32);
      for (int it = gw; it < NIT; it += NGW) transpose_item(a.w_in + (size_t)l * dd::D * dd::NIN, dd::D, dd::NIN, ka.WinT, 0, scr, it, lane);
      { constexpr int I0 = (dd::HW / 64) * (dd::D / 32), I1 = (dd::GVW / 64) * (dd::D / 32), I2 = (dd::AQW / 64) * (dd::D / 32), I3 = (dd::D / 64) * (dd::D / 32);
        for (int it = gw; it < I0 + I1 + I2 + I3; it += NGW) { int r = it;
          if (r < I0) { transpose_item(a.w_br_hy + (size_t)l * dd::HW * dd::D, dd::HW, dd::D, ka.WhyT, 0, scr, r, lane); continue; } r -= I0;
          if (r < I1) { transpose_item(a.w_br_gla + (size_t)l * dd::GVW * dd::D, dd::GVW, dd::D, ka.WglaT, 0, scr, r, lane); continue; } r -= I1;
          if (r < I2) { transpose_item(a.w_br_att + (size_t)l * dd::AQW * dd::D, dd::AQW, dd::D, ka.WattT, 0, scr, r, lane); continue; } r -= I2;
          transpose_item(a.w_out + (size_t)l * dd::D * dd::D, dd::D, dd::D, ka.WoutT, 0, scr, r, lane); } }
      { constexpr int IG = (dd::D / 64) * (dd::DE / 32), IDN = (dd::DE / 64) * (dd::D / 32);
        for (int it = gw; it < dd::NE * (2 * IG + IDN); it += NGW) { const int e = it / (2 * IG + IDN); int r = it % (2 * IG + IDN);
          if (r < 2 * IG) { const int up = r >= IG; if (up) r -= IG; const int n0 = 32 * (r % (dd::DE / 32));
            transpose_item((up ? a.moe_w_up : a.moe_w_gate) + ((size_t)l * dd::NE + e) * dd::D * dd::DE, dd::D, dd::DE, ka.WguT, e * 1024 + 128 * (n0 >> 7) + (up ? 128 : 0), scr, r, lane); }
          else { r -= 2 * IG; transpose_item(a.moe_w_down + ((size_t)l * dd::NE + e) * dd::DE * dd::D, dd::DE, dd::D, ka.WdT, e * 1024, scr, r, lane); } } }
      for (long i = gt; i < (long)(NINP - dd::NIN) * dd::D / 8; i += gs) { unsigned z_ = 0u; asm volatile("" : "+v"(z_)); *(v4u*)(ka.WinT + (size_t)dd::NIN * dd::D + i * 8) = (v4u){z_, z_, z_, z_}; }
    }
    pro::mod_phase(a, l, lds); pro::hid_phase(a, l, dd::S, a.hid2S, lds); if (!last) pro::hid_phase(a, l, dd::C, a.hid2C, lds);
    xcd_barrier(xb);
    pro::tapsB_phase(a, l, (bf16_t*)a.tapsS, lds); if (!last) LSTAGE(L_TAPS_C)
    xcd_barrier(xb);
    pro::nrmB_phase(a, (const bf16_t*)a.tapsS); if (!last) LSTAGE(L_NRM_C)
    xcd_barrier(xb);
    for (int grp = 0; grp < NGRP; ++grp) {
      const int b0 = grp * GB;
      { TID_SETUP
        for (int rg = gw; rg < RG; rg += NGW) { const int bl = rg / RB, r = rg % RB, b = b0 + bl; const float* md = a.mod + (size_t)(r < dd::S ? b : dd::B) * 6 * 1024;
          norm_row(xrow_in(a, l, b, r), a.norm1_g + (size_t)l * 1024, md, md + 1024, hb_s + (size_t)rg * 1024, lane); }
        xcd_barrier(xb); }
      { pg8::Gemm g{hb_s, ka.WinT, RG, NINP, dd::D, 0}; pg8::StaticOrder S; S.init(RG, NINP, (int)gridDim.x, (int)blockIdx.x); EpiProjBf16 E{proj_s};
        pg8::gemm_phase<EpiProjBf16, pg8::StaticOrder, false>((PG8_LAS unsigned char*)(lds + RING_OFF), g, S, E, nullptr);
        xcd_barrier(xb); }
      { TID_SETUP
        for (int rg = gw; rg < RG; rg += NGW) qknorm_row(proj_s + (size_t)rg * PLD, a.q_norm_g + (size_t)l * 128, a.k_norm_g + (size_t)l * 128, rg % RB, lane);
        for (int u = blockIdx.x; u < GB * 4 * 68; u += gridDim.x) { const int bl = u / (4 * 68), hu = u % (4 * 68); const bf16_t* pb = proj_s + (size_t)bl * RB * PLD;
          gla::In gp; gp.q = pb + dd::O_GQ; gp.k = pb + dd::O_GK; gp.v = pb + dd::O_GV; gp.ga = pb + dd::O_GA; gp.og = pb + dd::O_OG; gp.ld = PLD;
          gp.wa2 = a.gla_wa2 + (size_t)l * 2 * 16 * 256; gp.ba = a.gla_ba + (size_t)l * 2 * 256; gp.gnorm = a.gla_norm_g + (size_t)l * 128;
          gp.cs = (float*)(mix_s + (size_t)bl * CS_BYTES); gp.dec = (float*)(mix_s + (size_t)GB * CS_BYTES + (size_t)bl * DEC_BYTES); gp.y = (bf16_t*)pb + dd::O_OG; gp.ldy = PLD; gp.S = dd::S; gp.C = dd::C;
          gla::g1_unit(gp, lds, hu / 68, hu % 68, 4, 68); }
        xcd_barrier(xb); }
      { TID_SETUP
        for (long i_ = gt; i_ < (long)GB * 2 * 4 * 64 * 128; i_ += gs) { const int bl = (int)(i_ / (2 * 4 * 64 * 128)); gla::In gp; gp.cs = (float*)(mix_s + (size_t)bl * CS_BYTES); gp.dec = (float*)(mix_s + (size_t)GB * CS_BYTES + (size_t)bl * DEC_BYTES); gp.S = dd::S; gp.C = dd::C;
          gla::g2_item(gp, i_ % (2 * 4 * 64 * 128), 4, 68); }
        const int combo = blockIdx.x & 7, slot = blockIdx.x >> 3, nslot = gridDim.x >> 3;
        const int per_combo = 64 + (last ? 0 : 4);
        const bool xcdm = (gridDim.x & 7) == 0;
        for (int uu = xcdm ? slot : (int)blockIdx.x; uu < (xcdm ? per_combo : 8 * per_combo); uu += xcdm ? nslot : (int)gridDim.x) { const int cmb = xcdm ? combo : uu / per_combo, ui = xcdm ? uu : uu % per_combo;
          const bool lat = ui < 64; const int bl = cmb >> 1, kvh = cmb & 1;
          const int head = kvh * 4 + (lat ? ui >> 4 : ui - 64), qb = lat ? ui & 15 : 0;
          bf16_t* pb = proj_s + (size_t)bl * RB * PLD; const size_t qrow = lat ? (size_t)qb * 256 : (size_t)dd::S, krow = lat ? 0 : (size_t)dd::S;
          att::attn_dense_body<att::bf16, PLD, PLD, 1024, true>((const att::bf16*)(pb + qrow * PLD + dd::O_AQ + head * 128), (const att::bf16*)(pb + krow * PLD + dd::O_AK + kvh * 128),
              (const att::bf16*)(pb + krow * PLD + dd::O_AV + kvh * 128), hb_s + ((size_t)bl * RB + qrow) * 1024 + head * 128, lat ? RB : dd::C, (char*)lds_raw);
          __syncthreads(); }
        xcd_barrier(xb); }
      { const int n3 = last ? 64 : 68;
        for (int u = blockIdx.x; u < GB * 4 * n3; u += gridDim.x) { const int bl = u / (4 * n3), hu = u % (4 * n3); const bf16_t* pb = proj_s + (size_t)bl * RB * PLD;
          gla::In gp; gp.q = pb + dd::O_GQ; gp.k = pb + dd::O_GK; gp.v = pb + dd::O_GV; gp.ga = pb + dd::O_GA; gp.og = pb + dd::O_OG; gp.ld = PLD;
          gp.wa2 = a.gla_wa2 + (size_t)l * 2 * 16 * 256; gp.ba = a.gla_ba + (size_t)l * 2 * 256; gp.gnorm = a.gla_norm_g + (size_t)l * 128;
          gp.cs = (float*)(mix_s + (size_t)bl * CS_BYTES); gp.dec = (float*)(mix_s + (size_t)GB * CS_BYTES + (size_t)bl * DEC_BYTES); gp.y = (bf16_t*)pb + dd::O_OG; gp.ldy = PLD; gp.S = dd::S; gp.C = dd::C;
          gla::g3_unit(gp, lds, hu / n3, hu % n3, 4, 68); }
        xcd_barrier(xb); }
      {
        bf16_t* ucT0 = (bf16_t*)mix_s; bf16_t* yT0 = (bf16_t*)(mix_s + GB * UCT_BYTES); float* ucc0 = (float*)(mix_s + GB * (UCT_BYTES + YT_BYTES)); float* z1c0 = (float*)(mix_s + GB * (UCT_BYTES + YT_BYTES + UCC_BYTES));
        const float* cw = a.hy_conv_w + (size_t)l * 3 * 1536; const float* cb = a.hy_conv_b + (size_t)l * 1536; const float* skp = a.hy_skip + (size_t)l * 2 * 512;
        { TID_SETUP
        { int t_ = blockIdx.x; hy::H0Regs hr = hy::h0_load(proj_s + (size_t)(t_ / (64 * 24)) * RB * PLD + dd::O_HY, PLD, t_ % (64 * 24), tz);
          for (; t_ < GB * 64 * 24; t_ += gridDim.x) { const int bl = t_ / (64 * 24), tn_ = t_ + gridDim.x; hy::H0Regs hn = hr;
            if (tn_ < GB * 64 * 24) hn = hy::h0_load(proj_s + (size_t)(tn_ / (64 * 24)) * RB * PLD + dd::O_HY, PLD, tn_ % (64 * 24), tz);
            hy::h0_compute(hr, cw, cb, ucT0 + (size_t)bl * 1536 * 4096, t_ % (64 * 24), lds, tz); hr = hn; } }
        if (!last) for (long i_ = gt; i_ < (long)GB * 256 * 1536; i_ += gs) { const int bl = (int)(i_ / (256 * 1536)); hy::cconv3_item(proj_s + ((size_t)bl * RB + dd::S) * PLD + dd::O_HY, PLD, cw, cb, ucc0 + (size_t)bl * 256 * 1536, i_ % (256 * 1536)); } }
        xcd_barrier(xb);
        { TID_SETUP
        for (int u = blockIdx.x; u < GB * 512; u += gridDim.x) { const int bl = u / 512; hy::h1b_unit(ucT0 + (size_t)bl * 1536 * 4096, (const bf16_t*)a.tapsS, a.nrmS, skp, yT0 + (size_t)bl * 512 * 4096, u % 512, lds); }
        if (!last) for (long i_ = gt; i_ < (long)GB * 32 * 512; i_ += gs) { const int bl = (int)(i_ / (32 * 512)); hy::clong_item(ucc0 + (size_t)bl * 256 * 1536, nullptr, z1c0 + (size_t)bl * 256 * 512, nullptr, 0, a.tapsC, a.nrmC, skp, 0, i_ % (32 * 512)); } }
        xcd_barrier(xb);
        { TID_SETUP
        for (int t_ = blockIdx.x; t_ < GB * 64 * 8; t_ += gridDim.x) { const int bl = t_ / (64 * 8); hy::h2_tile(yT0 + (size_t)bl * 512 * 4096, proj_s + (size_t)bl * RB * PLD + dd::O_HY, PLD, t_ % (64 * 8), lds); }
        if (!last) for (long i_ = gt; i_ < (long)GB * 32 * 512; i_ += gs) { const int bl = (int)(i_ / (32 * 512)); hy::clong_item(ucc0 + (size_t)bl * 256 * 1536, z1c0 + (size_t)bl * 256 * 512, nullptr, proj_s + ((size_t)bl * RB + dd::S) * PLD + dd::O_HY, PLD, a.tapsC, a.nrmC, skp, 1, i_ % (32 * 512)); } }
        xcd_barrier(xb); }
      { { pg8::Gemm g{proj_s + dd::O_HY, ka.WhyT, RG, 1024, 512, PLD}; GroupOrder S; S.init(1024, (int)gridDim.x, (int)blockIdx.x, last);
          EpiMergeB<false> E{proj_s + dd::O_BR, (bf16_t*)mix_s}; pg8::gemm_phase<EpiMergeB<false>, GroupOrder, false>((PG8_LAS unsigned char*)(lds + RING_OFF), g, S, E, nullptr); }
        for (int gi = 1; gi < 3; ++gi) { const bool at = gi == 2;
          pg8::Gemm g{at ? (const bf16_t*)hb_s : (const bf16_t*)(proj_s + dd::O_OG), at ? ka.WattT : ka.WglaT, RG, 1024, at ? 1024 : 512, at ? 1024 : PLD}; GroupOrder S; S.init(1024, (int)gridDim.x, (int)blockIdx.x, last);
          EpiMergeB<true> E{proj_s + dd::O_BR + gi * 1024, (bf16_t*)mix_s}; pg8::gemm_phase<EpiMergeB<true>, GroupOrder, false>((PG8_LAS unsigned char*)(lds + RING_OFF), g, S, E, nullptr); }
        xcd_barrier(xb);
        pg8::Gemm g{(const bf16_t*)mix_s, ka.WoutT, RG, 1024, 1024, 0}; GroupOrder S; S.init(1024, (int)gridDim.x, (int)blockIdx.x, last);
        EpiOutG E{l == 0 ? a.x : (const float*)a.out, a.out, l == 0 ? a.ctx : (const float*)a.xc, a.xc, a.mod, b0, !last};
        pg8::gemm_phase<EpiOutG, GroupOrder, false>((PG8_LAS unsigned char*)(lds + RING_OFF), g, S, E, nullptr);
        xcd_barrier(xb); }
      {
        { TID_SETUP int* cnt = ka.cnt + (l * NGRP + grp) * 1024;
          LAS float* rwT = (LAS float*)(lds + RING_OFF);
          for (int k = tz; k < 1024; k += NTHREADS) {
#pragma unroll
            for (int e = 0; e < 16; ++e) rwT[e * 1024 + k] = a.router_w[(size_t)k * 16 + e]; }
          __syncthreads();
          LAS int* lcnt = (LAS int*)(lds + RING_OFF + 65536);
          if (tz < 32) lcnt[tz] = 0;
          __syncthreads();
          for (int rg = gw; rg < RG; rg += NGW) { const int bl = rg / RB, r = rg % RB, b = b0 + bl; if (last && r >= dd::S) continue; const float* md = a.mod + (size_t)(r < dd::S ? b : dd::B) * 6 * 1024;
            moe::route_row(xrow_cur(a, b, r), a.norm2_g + (size_t)l * 1024, md + 3 * 1024, md + 4 * 1024, hb_s + (size_t)rg * 1024, rwT, a.router_b, lcnt, ka.route + rg, ka.wts + 2 * rg, lane); }
          __syncthreads();
          if (tz < 16) lcnt[16 + tz] = atomicAdd(cnt + tz * 64, lcnt[tz]);
          __syncthreads();
          for (int rg = gw; rg < RG; rg += NGW) { if (last && (rg % RB) >= dd::S) continue; moe::Route* rt = ka.route + rg; if (lane == 0) { moe::Route r_ = *rt; r_.r0 += lcnt[16 + r_.e0]; r_.r1 += lcnt[16 + r_.e1]; *rt = r_; } }
          xcd_barrier(xb); }
        { TID_SETUP int* cnt = ka.cnt + (l * NGRP + grp) * 1024;
          if (tz == 0) { int acc_ = 0; for (int e = 0; e < 16; ++e) { poff[e] = acc_; acc_ += (cnt[e * 64] + 255) >> 8; } poff[16] = acc_; }
          __syncthreads();
          for (int rg = gw; rg < RG; rg += NGW) { if (last && (rg % RB) >= dd::S) continue; const moe::Route rt = ka.route[rg];
            const v4u h0 = *(const v4u*)(hb_s + (size_t)rg * 1024 + lane * 16), h1 = *(const v4u*)(hb_s + (size_t)rg * 1024 + lane * 16 + 8);
#pragma unroll
            for (int sl = 0; sl < 2; ++sl) { const int e = sl ? rt.e1 : rt.e0, rk = sl ? rt.r1 : rt.r0; const size_t dst = (size_t)poff[e] * 256 + rk;
              *(v4u*)(ka.hp + dst * 1024 + lane * 16) = h0; *(v4u*)(ka.hp + dst * 1024 + lane * 16 + 8) = h1;
              if (lane == 0) { ka.srcrow[dst] = 2 * rg + sl; ka.wgt[dst] = ka.wts[2 * rg + sl]; } } }
          for (int e = 0; e < 16; ++e) { const int c_ = cnt[e * 64], pe = ((c_ + 255) >> 8) << 8; for (int p_ = c_ + (int)gt; p_ < pe; p_ += (int)gs) ka.srcrow[(size_t)poff[e] * 256 + p_] = -1; }
          xcd_barrier(xb); }
        { pg8::Gemm g{ka.hp, ka.WguT, 0, 0, 1024, 0}; moe::MoeOrder S{(int)gridDim.x, (int)blockIdx.x, 4, poff}; moe::EpiGU E{ka.hid};
          pg8::gemm_phase<moe::EpiGU, moe::MoeOrder, false>((PG8_LAS unsigned char*)(lds + RING_OFF), g, S, E, nullptr);
          xcd_barrier(xb); }
        { pg8::Gemm g{ka.hid, ka.WdT, 0, 0, 512, 0}; moe::MoeOrder S{(int)gridDim.x, (int)blockIdx.x, 4, poff}; moe::EpiDown E{ka.srcrow, ka.wgt, ka.contrib, (size_t)RG * 1024};
          pg8::gemm_phase<moe::EpiDown, moe::MoeOrder, false>((PG8_LAS unsigned char*)(lds + RING_OFF), g, S, E, nullptr);
          xcd_barrier(xb); }
        { TID_SETUP
#pragma unroll 4
          for (long i_ = gt; i_ < (long)RG * 256; i_ += gs) { const int rg = (int)(i_ >> 8), c4 = (int)(i_ & 255) * 4; const int bl = rg / RB, r = rg % RB, b = b0 + bl; if (last && r >= dd::S) continue;
            float* xr = xrow_cur(a, b, r) + c4; const float* g2 = a.mod + (size_t)(r < dd::S ? b : dd::B) * 6 * 1024 + 5 * 1024 + c4;
            const unsigned long long u0 = *(const unsigned long long*)(ka.contrib + (size_t)rg * 1024 + c4), u1 = *(const unsigned long long*)(ka.contrib + (size_t)RG * 1024 + (size_t)rg * 1024 + c4);
            pg8::f32x4 xv = *(pg8::f32x4*)xr; const pg8::f32x4 gv = *(const pg8::f32x4*)g2;
#pragma unroll
            for (int e = 0; e < 4; ++e) xv[e] += gv[e] * (bf2f((bf16_t)(u0 >> (16 * e))) + bf2f((bf16_t)(u1 >> (16 * e))));
            *(pg8::f32x4*)xr = xv; }
          xcd_barrier(xb); }
      }
    }
  }
}
extern "C" void kernel_launch(void* const* d_in, const int* in_sizes, int n_in, void* d_out, int out_size, void* d_ws, size_t ws_size, hipStream_t stream) {
  static int grid = 0;
  if (!grid) {
    int dev = 0, cus = 0, per_cu = 0;
    (void)hipGetDevice(&dev); (void)hipDeviceGetAttribute(&cus, hipDeviceAttributeMultiprocessorCount, dev);
    (void)hipFuncSetAttribute((const void*)mega_kernel, hipFuncAttributeMaxDynamicSharedMemorySize, LDS_BYTES);
    (void)hipOccupancyMaxActiveBlocksPerMultiprocessor(&per_cu, mega_kernel, NTHREADS, LDS_BYTES);
    if (per_cu < 1) fprintf(stderr, "occupancy query says %d\n", per_cu);
    grid = cus;
  }
  KArgs ka{}; const float* ptrs[33]; for (int i = 0; i < 33; ++i) ptrs[i] = (const float*)d_in[i];
  set_inputs<TD>(ka.a, ptrs);
  char* wsb = (char*)d_ws; size_t off = BAR_BYTES;
  auto take = [&](size_t bytes) { char* p = wsb + off; off += (bytes + 255) & ~(size_t)255; return p; };
  NaiveBufs& a = ka.a;
  a.mod = (float*)take((size_t)(dd::B + 1) * 6 * 1024 * 4); a.hid2S = (float*)take((size_t)dd::S * 64 * 4); a.hid2C = (float*)take((size_t)dd::C * 64 * 4);
  a.tapsS = (float*)take((size_t)2 * 512 * 2 * 8232 * 2 + 64); a.tapsC = (float*)take((size_t)2 * 512 * 512 * 4); a.nrmS = (float*)take(1024 * 4); a.nrmC = (float*)take(1024 * 4);
  a.xc = (float*)take((size_t)dd::B * dd::C * 1024 * 4);
  ka.WinT = (bf16_t*)take((size_t)NINP * 1024 * 2); ka.WhyT = (bf16_t*)take((size_t)1024 * 512 * 2); ka.WglaT = (bf16_t*)take((size_t)1024 * 512 * 2); ka.WattT = (bf16_t*)take((size_t)1024 * 1024 * 2);
  ka.WoutT = (bf16_t*)take((size_t)1024 * 1024 * 2); ka.WguT = (bf16_t*)take((size_t)16 * 1024 * 1024 * 2); ka.WdT = (bf16_t*)take((size_t)16 * 1024 * 512 * 2);
  ka.hb = (bf16_t*)take((size_t)RG * 1024 * 2); ka.mix = (unsigned char*)take(MIX_BYTES);
  ka.proj = (bf16_t*)take((size_t)RG * PLD * 2);
  { char* p = (char*)ka.proj; ka.hp = (bf16_t*)p; p += (size_t)MPG * 1024 * 2; ka.hid = (bf16_t*)p; p += (size_t)MPG * 512 * 2; ka.contrib = (bf16_t*)p; p += (size_t)2 * RG * 1024 * 2;
    ka.srcrow = (int*)p; p += (size_t)MPG * 4; ka.wgt = (float*)p; p += (size_t)MPG * 4; ka.route = (moe::Route*)p; p += (size_t)RG * 16; ka.wts = (float*)p; p += (size_t)RG * 8;
    if ((size_t)(p - (char*)ka.proj) > (size_t)RG * PLD * 2) fprintf(stderr, "MoE alias region too large\n"); }
  a.out = (float*)d_out; ka.bar = (unsigned*)d_ws; ka.cnt = (int*)(wsb + CNT_OFF);
  if (off > ws_size) fprintf(stderr, "workspace too small: need %zu have %zu\n", off, ws_size);
  (void)hipMemsetAsync(d_ws, 0, BAR_BYTES, stream);
  hipLaunchKernelGGL(mega_kernel, dim3(grid), dim3(NTHREADS), LDS_BYTES, stream, ka);
}
```

```cpp
#include <hip/hip_runtime.h>
#include <cstddef>
#include <cstdio>
#include <cstdint>
#include <hip/hip_bf16.h>
#include <hip/hip_runtime.h>
namespace pg8 {
#define PG8_LAS __attribute__((address_space(3)))
typedef unsigned short bf16_t;
typedef short bf16x8 __attribute__((ext_vector_type(8)));
typedef float f32x4 __attribute__((ext_vector_type(4)));
typedef unsigned u32x4 __attribute__((ext_vector_type(4)));
constexpr int BM = 256, BK = 64, HALF = 128, HTB = HALF * BK * 2  , STAGE_BYTES = 8 * HTB, NXCD = 8, WGM = 8;

__host__ __device__ __forceinline__ int lds_byte(int r, int c) { const int st = (r >> 4) * 2 + (c >> 5), rr = r & 15, cc = c & 31, ob = rr * 64 + cc * 2; return st * 1024 + (ob ^ (((ob >> 9) & 1) << 5)); }
__host__ __device__ __forceinline__ void stage_rc(int b, int& R, int& C) { const int st = b / 1024, sb = b % 1024, swz = sb ^ (((sb >> 9) & 1) << 5); R = (st >> 1) * 16 + swz / 64; C = (st & 1) * 32 + (swz % 64) / 2; }
__host__ __device__ __forceinline__ int perm32(int rho) { const int n = rho >> 4, i = rho & 15; return 8 * (i >> 2) + 4 * n + (i & 3); }

struct Unit { int pm, pn, acol; };
struct Gemm { const bf16_t* A; const bf16_t* Bt; int M, N, K; int lda; };

struct StaticOrder {
    int nM, nN, nwg, G, c;
    __host__ __device__ void init(int M, int N, int G_, int c_) { nM = M / BM; nN = N / BM; nwg = nM * nN; G = G_; c = c_; }
    __host__ __device__ bool next(int i, Unit& u) const {
        const long L = (long)i * G + c; if (L >= nwg) return false;
        int wgid = (int)L; { const int q = nwg / NXCD, r = nwg % NXCD, xcd = wgid % NXCD, off = wgid / NXCD; wgid = (xcd < r ? xcd * (q + 1) : r * (q + 1) + (xcd - r) * q) + off; }
        const int nig = WGM * nN, gid = wgid / nig, fm = gid * WGM, gsz = (nM - fm) < WGM ? (nM - fm) : WGM;
        u.pm = fm + ((wgid % nig) % gsz); u.pn = (wgid % nig) / gsz; u.acol = 0; return true;
    }
    __device__ __forceinline__ void a_ready(const Unit&) const {}
    __device__ __forceinline__ void done(const Unit&) const {}
};
__device__ __forceinline__ unsigned cvt_pk_bf16(float lo, float hi) { unsigned r; asm volatile("v_cvt_pk_bf16_f32 %0, %1, %2" : "=v"(r) : "v"(lo), "v"(hi)); return r; }
typedef float f32x2 __attribute__((ext_vector_type(2)));
template <class Epi, class Sched, bool STAMP = false>
__device__ __forceinline__ void gemm_phase(PG8_LAS unsigned char* lds, const Gemm g, const Sched& S, const Epi& E, unsigned long long* stamps) {
    int tid = threadIdx.x; asm volatile("" : "+v"(tid)); const int wid = __builtin_amdgcn_readfirstlane(tid >> 6), lane = tid & 63, wr = wid >> 2, wc = wid & 3, fr = lane & 15, fq = lane >> 4;
    const int K = g.K, nt = K / BK, LDA = g.lda ? g.lda : g.K;
    int ts_lo = 0, ts_hi = 0, nts = 0; const unsigned long long rt_entry = STAMP ? (unsigned long long)wall_clock64() : 0ull;
#define PG8_STAMP() do { if (STAMP && wid == 0 && nts < 64) { const unsigned long long _c = (unsigned long long)clock64(); \
        ts_lo = (lane == nts) ? (int)(unsigned)_c : ts_lo; ts_hi = (lane == nts) ? (int)(unsigned)(_c >> 32) : ts_hi; ++nts; } } while (0)
    PG8_STAMP();
    unsigned voffA[2], voffB[2];
#pragma unroll
    for (int i = 0; i < 2; ++i) { int R, C; stage_rc(tid * 16 + i * 8192, R, C); const int Rb = Epi::PERM ? ((R & ~31) + perm32(R & 31)) : R;
        voffA[i] = (unsigned)(R * LDA + C) * 2u; voffB[i] = (unsigned)(Rb * K + C) * 2u; }
    const size_t kstep = (size_t)(BK * 2);
    const size_t hstep = (size_t)HALF * K * 2;
    const size_t tstep = 2 * hstep;
    const size_t hstepA = (size_t)HALF * LDA * 2, tstepA = 2 * hstepA;
    const unsigned ldsw = (unsigned)wid * 1024u;
    const int aoff = lds_byte(wr * 64 + fr, fq * 8), boff = lds_byte(wc * 32 + fr, fq * 8);
#define PG8_SA(b, h) (((b) * 2 + (h)) * HTB)
#define PG8_SB(b, h) ((4 + (b) * 2 + (h)) * HTB)
#define PG8_STAGE(bufoff, gbase, voff) do { _Pragma("unroll") for (int _i = 0; _i < 2; ++_i) \
        __builtin_amdgcn_global_load_lds((const unsigned*)((const char*)(gbase) + (voff)[_i]), (PG8_LAS unsigned*)(lds + (bufoff) + ldsw + _i * 8192), 16, 0, 0); } while (0)
#define PG8_LDA(dst, b, h) do { _Pragma("unroll") for (int m = 0; m < 4; ++m) _Pragma("unroll") for (int k = 0; k < 2; ++k) dst[m][k] = *(const PG8_LAS bf16x8*)(lds + PG8_SA(b, h) + aoff + m * 2048 + k * 1024); } while (0)
#define PG8_LDB(dst, b, h) do { _Pragma("unroll") for (int n = 0; n < 2; ++n) _Pragma("unroll") for (int k = 0; k < 2; ++k) dst[n][k] = *(const PG8_LAS bf16x8*)(lds + PG8_SB(b, h) + boff + n * 2048 + k * 1024); } while (0)
#define PG8_MMA(ai, bj, At, Bt) do { __builtin_amdgcn_s_setprio(1); _Pragma("unroll") for (int m = 0; m < 4; ++m) _Pragma("unroll") for (int n = 0; n < 2; ++n) _Pragma("unroll") for (int k = 0; k < 2; ++k) \
        acc[ai][bj][m][n] = __builtin_amdgcn_mfma_f32_16x16x32_bf16(Bt[n][k], At[m][k], acc[ai][bj][m][n], 0, 0, 0); __builtin_amdgcn_s_setprio(0); } while (0)
#define PG8_WAIT_V(n) asm volatile("s_waitcnt vmcnt(" #n ")" ::: "memory")
#define PG8_WAIT_L(n) asm volatile("s_waitcnt lgkmcnt(" #n ")" ::: "memory")
#define PG8_BAR __builtin_amdgcn_s_barrier()
#define PG8_SCHED __builtin_amdgcn_sched_barrier(0)
    Unit cur, nxt; int ui = 0;
    if (!S.next(0, cur)) return;
    f32x4 acc[2][2][4][2];
#pragma unroll
    for (int a = 0; a < 2; ++a)
#pragma unroll
        for (int b = 0; b < 2; ++b)
#pragma unroll
            for (int m = 0; m < 4; ++m)
#pragma unroll
                for (int n = 0; n < 2; ++n) acc[a][b][m][n] = (f32x4){0.f, 0.f, 0.f, 0.f};
    bf16x8 At[4][2], B0[2][2], B1[2][2];
    const char* cA = (const char*)g.A + (size_t)cur.pm * tstepA + (size_t)cur.acol * 2; const char* cB = (const char*)g.Bt + (size_t)cur.pn * tstep;
    S.a_ready(cur);
    PG8_STAGE(PG8_SB(0, 0), cB, voffB); PG8_STAGE(PG8_SA(0, 0), cA, voffA); PG8_STAGE(PG8_SB(0, 1), cB + hstep, voffB); PG8_STAGE(PG8_SA(0, 1), cA + hstepA, voffA);
    if (wr == 1) PG8_BAR;
    PG8_WAIT_V(4); PG8_BAR;
    PG8_STAGE(PG8_SB(1, 0), cB + kstep, voffB); PG8_STAGE(PG8_SA(1, 0), cA + kstep, voffA); PG8_STAGE(PG8_SB(1, 1), cB + hstep + kstep, voffB);
    PG8_WAIT_V(6); PG8_BAR;
    PG8_STAMP();
    for (;;) {
        const bool has_next = S.next(ui + 1, nxt);
        const char* nA = has_next ? (const char*)g.A + (size_t)nxt.pm * tstepA + (size_t)nxt.acol * 2 : cA; const char* nB = has_next ? (const char*)g.Bt + (size_t)nxt.pn * tstep : cB;
        for (int t = 0; t < nt; t += 2) {
            const bool last = (t == nt - 2);
            const char* a1 = cA + (size_t)(t + 1) * kstep;
            const char* a2 = last ? nA : cA + (size_t)(t + 2) * kstep; const char* b2 = last ? nB : cB + (size_t)(t + 2) * kstep;
            const char* a3 = a2 + kstep; const char* b3 = b2 + kstep;
            if (last && has_next) S.a_ready(nxt);
            PG8_LDB(B0, 0, 0); PG8_SCHED; PG8_LDA(At, 0, 0); PG8_STAGE(PG8_SA(1, 1), a1 + hstepA, voffA);
            PG8_WAIT_L(8); PG8_BAR; PG8_WAIT_L(0); PG8_MMA(0, 0, At, B0); PG8_BAR; PG8_SCHED;
            PG8_LDB(B1, 0, 1); PG8_STAGE(PG8_SB(0, 0), b2, voffB);
            PG8_BAR; PG8_WAIT_L(0); PG8_MMA(0, 1, At, B1); PG8_BAR;
            PG8_LDA(At, 0, 1); PG8_STAGE(PG8_SA(0, 0), a2, voffA);
            PG8_BAR; PG8_WAIT_L(0); PG8_MMA(1, 0, At, B0); PG8_BAR; PG8_SCHED;
            PG8_STAGE(PG8_SB(0, 1), b2 + hstep, voffB);
            PG8_WAIT_V(6); PG8_BAR; PG8_MMA(1, 1, At, B1); PG8_BAR;
            PG8_LDB(B0, 1, 0); PG8_SCHED; PG8_LDA(At, 1, 0); PG8_STAGE(PG8_SA(0, 1), a2 + hstepA, voffA);
            PG8_WAIT_L(8); PG8_BAR; PG8_WAIT_L(0); PG8_MMA(0, 0, At, B0); PG8_BAR; PG8_SCHED;
            PG8_LDB(B1, 1, 1); PG8_STAGE(PG8_SB(1, 0), b3, voffB);
            PG8_BAR; PG8_WAIT_L(0); PG8_MMA(0, 1, At, B1); PG8_BAR;
            PG8_LDA(At, 1, 1); PG8_STAGE(PG8_SA(1, 0), a3, voffA);
            PG8_BAR; PG8_WAIT_L(0); PG8_MMA(1, 0, At, B0); PG8_BAR; PG8_SCHED;
            PG8_STAGE(PG8_SB(1, 1), b3 + hstep, voffB);
            PG8_WAIT_V(6); PG8_BAR; PG8_MMA(1, 1, At, B1); PG8_BAR;
        }
        PG8_STAMP();
        if constexpr (!Epi::AFTER_DRAIN) { E(acc, cur, wr, wc, fr, fq); S.done(cur); }
        PG8_STAMP();
        if (!has_next) break;
#pragma unroll
        for (int a = 0; a < 2; ++a)
#pragma unroll
            for (int b = 0; b < 2; ++b)
#pragma unroll
                for (int m = 0; m < 4; ++m)
#pragma unroll
                    for (int n = 0; n < 2; ++n) acc[a][b][m][n] = (f32x4){0.f, 0.f, 0.f, 0.f};
        cur = nxt; cA = nA; cB = nB; ++ui;
    }
    PG8_WAIT_V(0);
    if (wr == 0) PG8_BAR;
    PG8_BAR;
    if constexpr (Epi::AFTER_DRAIN) { E.fused(acc, cur, wr, wc, fr, fq, lds, wid, lane); S.done(cur); }
    PG8_STAMP();
    if (STAMP && wid == 0) { stamps[lane] = lane < nts ? (((unsigned long long)(unsigned)ts_hi << 32) | (unsigned)ts_lo) : 0ull;
        if (lane == 62) stamps[62] = rt_entry; if (lane == 63) stamps[63] = (unsigned long long)wall_clock64(); }
#undef PG8_STAMP
#undef PG8_SA
#undef PG8_SB
#undef PG8_STAGE
#undef PG8_LDA
#undef PG8_LDB
#undef PG8_MMA
#undef PG8_WAIT_V
#undef PG8_WAIT_L
#undef PG8_BAR
#undef PG8_SCHED
}
}

#define LAS __attribute__((address_space(3)))
typedef unsigned short bf16_t;
constexpr int NWAVES = 8, NTHREADS = 512;
constexpr int LDS_BYTES = 147456;
constexpr int RING_OFF = 0;
constexpr int MISC_OFF = 131072;
constexpr int NINP = 7936;

__device__ __forceinline__ unsigned f2bf(float f) { unsigned u = __builtin_bit_cast(unsigned, f); return (u + 0x7fffu + ((u >> 16) & 1u)) >> 16; }
__device__ __forceinline__ unsigned pk2(float lo, float hi) { return f2bf(lo) | (f2bf(hi) << 16); }
__device__ __forceinline__ float bf2f(bf16_t b) { return __builtin_bit_cast(float, ((unsigned)b) << 16); }
typedef unsigned v4u __attribute__((ext_vector_type(4)));

__device__ __forceinline__ void transpose_item(const float* W, int K, int N, bf16_t* WT, int row_off, LAS float* scr, int item, int lane) {
  const int nblk = N / 32, kb = item / nblk, nb = item % nblk, k0 = 64 * kb, n0 = 32 * nb;
  float wreg[32];
#pragma unroll
  for (int i = 0; i < 32; ++i) { const int kk = 2 * i + (lane >> 5); wreg[i] = W[(size_t)(k0 + kk) * N + n0 + (lane & 31)]; }
#pragma unroll
  for (int i = 0; i < 32; ++i) { const int kk = 2 * i + (lane >> 5); scr[kk * 33 + (lane & 31)] = wreg[i]; }
  asm volatile("s_waitcnt lgkmcnt(0)" ::: "memory");
  const int c = lane & 7;
#pragma unroll
  for (int j = 0; j < 4; ++j) { const int n = (lane >> 3) + 8 * j; const LAS float* s = scr + (8 * c) * 33 + n;
    v4u o; o.x = pk2(s[0 * 33], s[1 * 33]); o.y = pk2(s[2 * 33], s[3 * 33]); o.z = pk2(s[4 * 33], s[5 * 33]); o.w = pk2(s[6 * 33], s[7 * 33]);
    *(v4u*)(WT + (size_t)(row_off + n0 + n) * K + k0 + 8 * c) = o; }
  asm volatile("s_waitcnt lgkmcnt(0)" ::: "memory");
}

struct EpiProjF32 {
  static constexpr bool PERM = false, AFTER_DRAIN = false;
  float* C; int ldc; int ncols;
  __device__ __forceinline__ void operator()(const pg8::f32x4 (&acc)[2][2][4][2], const pg8::Unit& u, int wr, int wc, int fr, int fq) const {
    const int row0 = u.pm * 256 + wr * 64 + fr, col0 = u.pn * 256 + wc * 32 + 4 * fq;
#pragma unroll
    for (int ai = 0; ai < 2; ++ai)
#pragma unroll
      for (int m = 0; m < 4; ++m) { float* rowp = C + (size_t)(row0 + ai * 128 + m * 16) * ldc + col0;
#pragma unroll
        for (int bj = 0; bj < 2; ++bj)
#pragma unroll
          for (int n = 0; n < 2; ++n) if (col0 + bj * 128 + n * 16 < ncols) *(pg8::f32x4*)(rowp + bj * 128 + n * 16) = acc[ai][bj][m][n]; }
  }
};

__device__ __forceinline__ float fsigmoid(float x) { return 1.f / (1.f + __expf(-x)); }
template <bool ACCUM> struct EpiMerge {
  static constexpr bool PERM = true, AFTER_DRAIN = false;
  const float* gate; int ldg; bf16_t* M; int ldm;
  __device__ __forceinline__ void operator()(const pg8::f32x4 (&acc)[2][2][4][2], const pg8::Unit& u, int wr, int wc, int fr, int fq) const {
    const int row0 = u.pm * 256 + wr * 64 + fr, col0 = u.pn * 256 + wc * 32 + 8 * fq;
#pragma unroll
    for (int ai = 0; ai < 2; ++ai)
#pragma unroll
      for (int m = 0; m < 4; ++m) { const size_t r = (size_t)(row0 + ai * 128 + m * 16);
#pragma unroll
        for (int bj = 0; bj < 2; ++bj) { const int c = col0 + bj * 128;
          const pg8::f32x4 g0 = *(const pg8::f32x4*)(gate + r * ldg + c), g1 = *(const pg8::f32x4*)(gate + r * ldg + c + 4);
          pg8::f32x4 v0 = acc[ai][bj][m][0], v1 = acc[ai][bj][m][1];
#pragma unroll
          for (int e = 0; e < 4; ++e) { v0[e] *= fsigmoid(g0[e]); v1[e] *= fsigmoid(g1[e]); }
          v4u* dst = (v4u*)(M + r * ldm + c);
          if (ACCUM) { const v4u o = *dst; v0[0] += bf2f(o.x & 0xffff); v0[1] += bf2f(o.x >> 16); v0[2] += bf2f(o.y & 0xffff); v0[3] += bf2f(o.y >> 16);
            v1[0] += bf2f(o.z & 0xffff); v1[1] += bf2f(o.z >> 16); v1[2] += bf2f(o.w & 0xffff); v1[3] += bf2f(o.w >> 16); }
          v4u o2; o2.x = pk2(v0[0], v0[1]); o2.y = pk2(v0[2], v0[3]); o2.z = pk2(v1[0], v1[1]); o2.w = pk2(v1[2], v1[3]); *dst = o2; } }
  }
};
struct EpiOut {
  static constexpr bool PERM = false, AFTER_DRAIN = false;
  const float* resL; float* outL; const float* gL;
  const float* resC; float* outC; const float* gC;
  __device__ __forceinline__ void operator()(const pg8::f32x4 (&acc)[2][2][4][2], const pg8::Unit& u, int wr, int wc, int fr, int fq) const {
    const bool isc = u.pm == 16; if (isc && outC == nullptr) return;
    const float* res = isc ? resC : resL; float* out = isc ? outC : outL; const float* gv = isc ? gC : gL;
    const int row0 = (isc ? 0 : u.pm * 256) + wr * 64 + fr, col0 = u.pn * 256 + wc * 32 + 4 * fq;
    pg8::f32x4 gg[2][2];
#pragma unroll
    for (int bj = 0; bj < 2; ++bj)
#pragma unroll
      for (int n = 0; n < 2; ++n) gg[bj][n] = *(const pg8::f32x4*)(gv + col0 + bj * 128 + n * 16);
#pragma unroll
    for (int ai = 0; ai < 2; ++ai)
#pragma unroll
      for (int m = 0; m < 4; ++m) { const size_t ro = (size_t)(row0 + ai * 128 + m * 16) * 1024 + col0;
#pragma unroll
        for (int bj = 0; bj < 2; ++bj)
#pragma unroll
          for (int n = 0; n < 2; ++n) { const pg8::f32x4 rv = *(const pg8::f32x4*)(res + ro + bj * 128 + n * 16); *(pg8::f32x4*)(out + ro + bj * 128 + n * 16) = rv + gg[bj][n] * acc[ai][bj][m][n]; } }
  }
};
namespace att {
using bf16 = __hip_bfloat16;
constexpr int D = 128, NW = 8, QBLK = 32, KVBLK = 64; constexpr float SCALE = 0.088388347648318440f; constexpr float THR = 8.f; constexpr int SDEPTH = 2;
constexpr size_t SHM_V = KVBLK * D * 2, SHM_K = KVBLK * D * 2, SHM_ATTN = 2 * SHM_V + 2 * SHM_K + NW * 64 * 4;
using bf16x8 = __attribute__((ext_vector_type(8))) short;
using s16x4  = __attribute__((ext_vector_type(4))) short;
using f32x16 = __attribute__((ext_vector_type(16))) float;
using f32x8  = __attribute__((ext_vector_type(8))) float;
using u32x4  = __attribute__((ext_vector_type(4))) unsigned;
#define KSWZ(row, colB) ((row) * 256 + ((colB) ^ (((row) & 7) << 4)))
#define SBAR() __builtin_amdgcn_sched_barrier(0)
__device__ __forceinline__ int crow(int r, int hi) { return (r & 3) + 8 * (r >> 2) + 4 * hi; }
__device__ __forceinline__ unsigned cvtpk(float lo, float hi) {
  unsigned r; asm volatile("v_cvt_pk_bf16_f32 %0, %1, %2" : "=v"(r) : "v"(lo), "v"(hi)); return r;
}
template <typename TIn> struct Stage;
template <> struct Stage<bf16>  { using T = bf16x8;
  __device__ static __forceinline__ T ld8(const bf16* p) { return *reinterpret_cast<const bf16x8*>(p); }
  __device__ static __forceinline__ bf16x8 tobf(T x) { return x; } };
template <> struct Stage<float> { using T = f32x8;
  __device__ static __forceinline__ T ld8(const float* p) { return *reinterpret_cast<const f32x8*>(p); }
  __device__ static __forceinline__ bf16x8 tobf(T x) {
    u32x4 w = {cvtpk(x[0], x[1]), cvtpk(x[2], x[3]), cvtpk(x[4], x[5]), cvtpk(x[6], x[7])}; return *reinterpret_cast<bf16x8*>(&w); } };

__device__ __forceinline__ void partialSM(f32x16& p0, f32x16& p1, float& m_reg, float& mn, float& alpha) {
  constexpr float C = SCALE * 1.4426950408889634f;
  float pmax = p0[0]; for (int r = 1; r < 16; ++r) pmax = fmaxf(pmax, p0[r]); for (int r = 0; r < 16; ++r) pmax = fmaxf(pmax, p1[r]);
  { auto rr = __builtin_amdgcn_permlane32_swap(__float_as_uint(pmax), __float_as_uint(pmax), false, false);
    pmax = fmaxf(__uint_as_float(rr[0]), __uint_as_float(rr[1])); }
  if (__builtin_expect(__all(pmax - m_reg <= THR / SCALE), 1)) { mn = m_reg; alpha = 1.f; }
  else { mn = fmaxf(m_reg, pmax); alpha = __builtin_amdgcn_exp2f((m_reg - mn) * C); m_reg = mn; }
  float mnC = -mn * C;
  for (int r = 0; r < 16; ++r) p0[r] = fmaf(p0[r], C, mnC); for (int r = 0; r < 16; ++r) p1[r] = fmaf(p1[r], C, mnC);
  for (int r = 0; r < 16; ++r) p0[r] = __builtin_amdgcn_exp2f(p0[r]);
}
__device__ __forceinline__ void finishSM(f32x16& p0, f32x16& p1, float alpha, float& l_reg, bf16x8& pa0, bf16x8& pa1, bf16x8& pa2, bf16x8& pa3) {
  for (int r = 0; r < 16; ++r) p1[r] = __builtin_amdgcn_exp2f(p1[r]);
  float ps = 0; for (int r = 0; r < 16; ++r) ps += p0[r]; for (int r = 0; r < 16; ++r) ps += p1[r];
  { auto rr = __builtin_amdgcn_permlane32_swap(__float_as_uint(ps), __float_as_uint(ps), false, false);
    ps = __uint_as_float(rr[0]) + __uint_as_float(rr[1]); }
  l_reg = l_reg * alpha + ps;
#define PK4(P, BASE, OUT) do { unsigned a0 = cvtpk(P[BASE + 0], P[BASE + 1]), a1 = cvtpk(P[BASE + 2], P[BASE + 3]);   \
    unsigned b0 = cvtpk(P[BASE + 4], P[BASE + 5]), b1 = cvtpk(P[BASE + 6], P[BASE + 7]);                              \
    auto r0 = __builtin_amdgcn_permlane32_swap(a0, b0, false, false); auto r1 = __builtin_amdgcn_permlane32_swap(a1, b1, false, false); \
    u32x4 w = {r0[0], r1[0], r0[1], r1[1]}; OUT = *reinterpret_cast<bf16x8*>(&w); } while (0)
  PK4(p0, 0, pa0); PK4(p0, 8, pa1); PK4(p1, 0, pa2); PK4(p1, 8, pa3);
#undef PK4
}
__device__ __forceinline__ void qkt(f32x16& p0, f32x16& p1, const bf16* Ks, const bf16x8* qr, int r32, int hi) {
  p0 = f32x16{}; p1 = f32x16{};
  for (int d0 = 0; d0 < 8; ++d0) { int cb = (d0 * 16 + hi * 8) * 2;
    bf16x8 b0 = *reinterpret_cast<const bf16x8*>((const char*)Ks + KSWZ(r32, cb));
    bf16x8 b1 = *reinterpret_cast<const bf16x8*>((const char*)Ks + KSWZ(32 + r32, cb));
    p0 = __builtin_amdgcn_mfma_f32_32x32x16_bf16(b0, qr[d0], p0, 0, 0, 0);
    p1 = __builtin_amdgcn_mfma_f32_32x32x16_bf16(b1, qr[d0], p1, 0, 0, 0); }
}
__device__ __forceinline__ int v_st(int k, int c) { const int kk = (k & ~0xC) | ((k & 4) << 1) | ((k & 8) >> 1); return ((kk >> 3) * 4 + (c >> 5)) * 512 + ((kk & 7) * 32 + (c & 31)) * 2; }
__device__ __forceinline__ int v_rd_base(int lane) { return ((lane & 3) << 3) | (((lane >> 2) & 3) << 6) | (((lane >> 4) & 1) << 5) | (((lane >> 5) & 1) << 8); }
constexpr int v_rd_off(int d0, int ks, int half) { return d0 * 512 + ks * 4096 + half * 2048; }
template <int OFF> __device__ __forceinline__ s16x4 tr_read(int vb) {
  s16x4 r; asm volatile("ds_read_b64_tr_b16 %0, %1 offset:%2" : "=&v"(r) : "v"(vb), "i"(OFF) : "memory"); return r;
}
template <int D0> __device__ __forceinline__ void pv_one(f32x16& od, int vb, bf16x8 pa0, bf16x8 pa1, bf16x8 pa2, bf16x8 pa3) {
  const s16x4 l0 = tr_read<v_rd_off(D0, 0, 0)>(vb), h0 = tr_read<v_rd_off(D0, 0, 1)>(vb), l1 = tr_read<v_rd_off(D0, 1, 0)>(vb), h1 = tr_read<v_rd_off(D0, 1, 1)>(vb);
  const s16x4 l2 = tr_read<v_rd_off(D0, 2, 0)>(vb), h2 = tr_read<v_rd_off(D0, 2, 1)>(vb), l3 = tr_read<v_rd_off(D0, 3, 0)>(vb), h3 = tr_read<v_rd_off(D0, 3, 1)>(vb);
  asm volatile("s_waitcnt lgkmcnt(0)" ::: "memory"); SBAR();
#define PK(L, H) (bf16x8){L[0], L[1], L[2], L[3], H[0], H[1], H[2], H[3]}
  od = __builtin_amdgcn_mfma_f32_32x32x16_bf16(pa0, PK(l0, h0), od, 0, 0, 0);
  od = __builtin_amdgcn_mfma_f32_32x32x16_bf16(pa1, PK(l1, h1), od, 0, 0, 0);
  od = __builtin_amdgcn_mfma_f32_32x32x16_bf16(pa2, PK(l2, h2), od, 0, 0, 0);
  od = __builtin_amdgcn_mfma_f32_32x32x16_bf16(pa3, PK(l3, h3), od, 0, 0, 0);
#undef PK
}
__device__ __forceinline__ void pv_d0(f32x16* o, int vb, bf16x8 pa0, bf16x8 pa1, bf16x8 pa2, bf16x8 pa3) {
  pv_one<0>(o[0], vb, pa0, pa1, pa2, pa3); pv_one<1>(o[1], vb, pa0, pa1, pa2, pa3); pv_one<2>(o[2], vb, pa0, pa1, pa2, pa3); pv_one<3>(o[3], vb, pa0, pa1, pa2, pa3);
}

template <typename TQ, int LDQ, int LDK, int LDO, bool OBF16>
__device__ __forceinline__ void attn_dense_body(const TQ* Qb, const bf16* Kh, const bf16* Vh,
                                                void* Obv, int seq, char* lds) {
  using St = Stage<bf16>; using SQ = Stage<TQ>;
  int tid = threadIdx.x; asm volatile("" : "+v"(tid)); const int wid = tid >> 6, lane = tid & 63, r32 = lane & 31, hi = lane >> 5;
  bf16* V_lds = (bf16*)lds; bf16* K_lds = (bf16*)(lds + 2 * SHM_V);
  float* ws = (float*)(lds + 2 * SHM_V + 2 * SHM_K) + wid * 64; float* li_l = ws; float* al_l = ws + 32;
  float m_reg = -1e30f, l_reg = 0; f32x16 o[4] = {}; bf16x8 qr[8];
  const TQ* Qw = Qb + (long)(wid * QBLK + r32) * LDQ + hi * 8;
#pragma unroll
  for (int d0 = 0; d0 < 8; ++d0) qr[d0] = SQ::tobf(SQ::ld8(Qw + d0 * 16));
  const int sr = tid >> 4, sc = (tid & 15) * 8, vst0 = v_st(sr, sc), vst1 = v_st(32 + sr, sc);
  const int vb0 = (int)(uintptr_t)V_lds + v_rd_base(lane);
  struct { typename St::T vs0, vs1, ks0, ks1; } sr_[SDEPTH];
#define SLOAD(i, k0) do { sr_[i].vs0 = St::ld8(&Vh[(long)((k0) + sr) * LDK + sc]); sr_[i].vs1 = St::ld8(&Vh[(long)((k0) + 32 + sr) * LDK + sc]); \
    sr_[i].ks0 = St::ld8(&Kh[(long)((k0) + sr) * LDK + sc]); sr_[i].ks1 = St::ld8(&Kh[(long)((k0) + 32 + sr) * LDK + sc]); } while (0)
#define SWRITE(b, i) do { *(bf16x8*)((char*)V_lds + (b) * SHM_V + vst0) = St::tobf(sr_[i].vs0);          \
    *(bf16x8*)((char*)V_lds + (b) * SHM_V + vst1) = St::tobf(sr_[i].vs1); int kc = sc * 2;               \
    *(bf16x8*)((char*)K_lds + (b) * SHM_K + KSWZ(sr, kc)) = St::tobf(sr_[i].ks0);                       \
    *(bf16x8*)((char*)K_lds + (b) * SHM_K + KSWZ(32 + sr, kc)) = St::tobf(sr_[i].ks1); } while (0)
#define SWAIT() do { if constexpr (SDEPTH == 2) asm volatile("s_waitcnt vmcnt(4)" ::: "memory"); else asm volatile("s_waitcnt vmcnt(0)" ::: "memory"); } while (0)
#define RESC(a) do { if (__any((a) < 1.f)) { if (hi == 0) al_l[r32] = (a); asm volatile("s_waitcnt lgkmcnt(0)" ::: "memory"); \
    for (int d = 0; d < 4; ++d) for (int r = 0; r < 16; ++r) o[d][r] *= al_l[crow(r, hi)]; } } while (0)
  f32x16 pA0, pA1, pB0, pB1; float mnA, mnB, alA, alB; bf16x8 pa0, pa1, pa2, pa3; const int NT = seq / KVBLK;
  constexpr int SE = 0, SO = SDEPTH - 1;
  SLOAD(SE, 0); asm volatile("s_waitcnt vmcnt(0)" ::: "memory"); SWRITE(0, SE); __syncthreads();
  qkt(pA0, pA1, K_lds, qr, r32, hi); partialSM(pA0, pA1, m_reg, mnA, alA);
  SLOAD(SO, KVBLK); if constexpr (SDEPTH == 2) { if (2 < NT) SLOAD(SE, 2 * KVBLK); }
  SWAIT(); SWRITE(1, SO); __syncthreads();
  for (int j = 1; j + 1 < NT; j += 2) {
    SBAR(); qkt(pB0, pB1, (bf16*)((char*)K_lds + SHM_K), qr, r32, hi);
    finishSM(pA0, pA1, alA, l_reg, pa0, pa1, pa2, pa3); SBAR();
    SLOAD(SO, (j + SDEPTH) * KVBLK); SBAR();
    pv_d0(o, vb0, pa0, pa1, pa2, pa3); partialSM(pB0, pB1, m_reg, mnB, alB);
    __syncthreads(); SWAIT(); SWRITE(0, SE);
    RESC(alB); __syncthreads();
    SBAR(); qkt(pA0, pA1, K_lds, qr, r32, hi);
    finishSM(pB0, pB1, alB, l_reg, pa0, pa1, pa2, pa3); SBAR();
    if (SDEPTH == 1 || j + 3 < NT) SLOAD(SE, (j + 1 + SDEPTH) * KVBLK); SBAR();
    pv_d0(o, vb0 + (int)SHM_V, pa0, pa1, pa2, pa3); partialSM(pA0, pA1, m_reg, mnA, alA);
    __syncthreads(); SWAIT(); SWRITE(1, SO);
    RESC(alA); __syncthreads();
  }
  SBAR(); qkt(pB0, pB1, (bf16*)((char*)K_lds + SHM_K), qr, r32, hi);
  finishSM(pA0, pA1, alA, l_reg, pa0, pa1, pa2, pa3); SBAR();
  pv_d0(o, vb0, pa0, pa1, pa2, pa3); partialSM(pB0, pB1, m_reg, mnB, alB);
  __syncthreads(); RESC(alB);
  finishSM(pB0, pB1, alB, l_reg, pa0, pa1, pa2, pa3); SBAR();
  pv_d0(o, vb0 + (int)SHM_V, pa0, pa1, pa2, pa3);
  if (hi == 0) li_l[r32] = l_reg; asm volatile("s_waitcnt lgkmcnt(0)" ::: "memory");
  float rli[16];
#pragma unroll
  for (int r = 0; r < 16; ++r) rli[r] = __builtin_amdgcn_rcpf(li_l[crow(r, hi)]);
  if constexpr (!OBF16) { float* Ow = (float*)Obv + (long)(wid * QBLK) * LDO;
#pragma unroll
  for (int r = 0; r < 16; ++r) { int orow = crow(r, hi);
    for (int d0 = 0; d0 < 4; ++d0) Ow[(long)orow * LDO + d0 * 32 + r32] = o[d0][r] * rli[r]; }
  } else { unsigned short* Ow = (unsigned short*)Obv + (long)(wid * QBLK) * LDO;
#pragma unroll
  for (int r = 0; r < 16; ++r) { int orow = crow(r, hi);
    for (int d0 = 0; d0 < 4; ++d0) { const unsigned pk = cvtpk(o[d0][r] * rli[r], 0.f); Ow[(long)orow * LDO + d0 * 32 + r32] = (unsigned short)(pk & 0xffffu); } }
  }
#undef SLOAD
#undef SWRITE
#undef SWAIT
#undef RESC
}
#undef KSWZ
#undef SBAR
}
namespace gla {
typedef float f32x16 __attribute__((ext_vector_type(16)));
typedef float f32x4v __attribute__((ext_vector_type(4)));
constexpr int LD = 65;
constexpr int OX = 0, OY = 2 * 64 * LD * 4, OV = 4 * 64 * LD * 4, OAL = OV + 64 * 128 * 4, OW2 = OAL + 64 * 32 * 4, OBA = OW2 + 2 * 16 * 64 * 4, OTOT = OBA + 2 * 64 * 4, OEND = OTOT + 2 * 64 * 4 * 4;
static_assert(OEND <= 131072, "gla lds");
static_assert(64 * 129 * 4 <= 2 * 64 * LD * 4, "O stage fits in X");

struct In {
  const bf16_t* q; const bf16_t* k; const bf16_t* v; const bf16_t* ga; const bf16_t* og; int ld;
  const float* wa2; const float* ba; const float* gnorm;
  float* cs;
  float* dec;
  bf16_t* y; int ldy;
  int S, C;
};
__device__ __forceinline__ long chunk_row(const In& p, int cid) { return cid < p.S / 64 ? (long)cid * 64 : (long)p.S + (long)(cid - p.S / 64) * 64; }
__device__ __forceinline__ float logsig(float x) { return x < 0.f ? x - __logf(1.f + __expf(x)) : -__logf(1.f + __expf(-x)); }

__device__ __forceinline__ void cum_phase(const In& p, LAS unsigned char* lds, int head, long row0, int tid) {
  LAS float* AL = (LAS float*)(lds + OAL); LAS float* W2 = (LAS float*)(lds + OW2); LAS float* BA = (LAS float*)(lds + OBA); LAS float* TOT = (LAS float*)(lds + OTOT);
  { const int t = tid >> 3, r4 = (tid & 7) * 4; const unsigned long long u = *(const unsigned long long*)(p.ga + (row0 + t) * p.ld + r4);
    f32x4v a4; a4[0] = bf2f((bf16_t)u); a4[1] = bf2f((bf16_t)(u >> 16)); a4[2] = bf2f((bf16_t)(u >> 32)); a4[3] = bf2f((bf16_t)(u >> 48)); *(LAS f32x4v*)(AL + t * 32 + r4) = a4; }
  { const int e = tid * 4, dir = e >> 10, r = (e >> 6) & 15, j = e & 63; *(LAS f32x4v*)(W2 + e) = *(const f32x4v*)(p.wa2 + ((long)dir * 16 + r) * 256 + head * 64 + j); }
  if (tid < 128) BA[tid] = p.ba[(tid >> 6) * 256 + head * 64 + (tid & 63)];
  __syncthreads();
  const int dir = tid >> 8, j = tid & 63, seg = (tid >> 6) & 3;
  float w[16];
#pragma unroll
  for (int r = 0; r < 16; ++r) w[r] = W2[(dir * 16 + r) * 64 + j];
  const float bj = BA[dir * 64 + j];
  float c[16];
#pragma unroll
  for (int k = 0; k < 16; ++k) { const int t = seg * 16 + k; float z = bj;
#pragma unroll
    for (int r = 0; r < 16; ++r) z += AL[t * 32 + dir * 16 + r] * w[r];
    c[k] = logsig(z) * (1.f / 16.f); }
  if (dir == 0) {
#pragma unroll
    for (int k = 1; k < 16; ++k) c[k] += c[k - 1];
    TOT[(dir * 64 + j) * 4 + seg] = c[15];
  } else {
#pragma unroll
    for (int k = 14; k >= 0; --k) c[k] += c[k + 1];
    TOT[(dir * 64 + j) * 4 + seg] = c[0];
  }
  __syncthreads();
  float off = 0.f;
#pragma unroll
  for (int s = 0; s < 4; ++s) { const float tv = TOT[(dir * 64 + j) * 4 + s]; if (dir == 0 ? s < seg : s > seg) off += tv; }
  LAS float* X = (LAS float*)(lds + OX) + dir * 64 * LD;
#pragma unroll
  for (int k = 0; k < 16; ++k) X[(seg * 16 + k) * LD + j] = c[k] + off;
}
struct VRegs { unsigned long long u[4]; };
__device__ __forceinline__ VRegs load_v_regs(const In& p, int head, long row0, int tid) { VRegs r;
#pragma unroll
  for (int m = 0; m < 4; ++m) { const int t = (tid >> 5) + 16 * m, c4 = (tid & 31) * 4; r.u[m] = *(const unsigned long long*)(p.v + (row0 + t) * p.ld + head * 128 + c4); }
  return r; }
__device__ __forceinline__ void store_v(const VRegs& r, LAS unsigned char* lds, int tid) {
  LAS float* V = (LAS float*)(lds + OV);
#pragma unroll
  for (int m = 0; m < 4; ++m) { const int t = (tid >> 5) + 16 * m, c4 = (tid & 31) * 4; const unsigned long long u = r.u[m];
    f32x4v a4; a4[0] = bf2f((bf16_t)u); a4[1] = bf2f((bf16_t)(u >> 16)); a4[2] = bf2f((bf16_t)(u >> 32)); a4[3] = bf2f((bf16_t)(u >> 48)); *(LAS f32x4v*)(V + t * 128 + c4) = a4; }
}

__device__ __forceinline__ void g1_unit(const In& p, LAS unsigned char* lds, int head, int cid, int GH, int NCH) {
  int tid = threadIdx.x; asm volatile("" : "+v"(tid));
  const int lane = tid & 63, w = __builtin_amdgcn_readfirstlane(tid >> 6);
  const long row0 = chunk_row(p, cid);
  const VRegs vr = load_v_regs(p, head, row0, tid);
  bf16_t kreg[8];
#pragma unroll
  for (int m = 0; m < 8; ++m) kreg[m] = p.k[(row0 + (tid >> 6) + 8 * m) * p.ld + head * 64 + (tid & 63)];
  cum_phase(p, lds, head, row0, tid);
  store_v(vr, lds, tid);
  __syncthreads();
  LAS float* TOT = (LAS float*)(lds + OTOT);
  { const int j = tid & 63;
#pragma unroll
    for (int dir = 0; dir < 2; ++dir) { LAS float* X = (LAS float*)(lds + OX) + dir * 64 * LD;
      const float cl = TOT[(dir * 64 + j) * 4 + 0] + TOT[(dir * 64 + j) * 4 + 1] + TOT[(dir * 64 + j) * 4 + 2] + TOT[(dir * 64 + j) * 4 + 3];
#pragma unroll
      for (int m = 0; m < 8; ++m) { const int t = (tid >> 6) + 8 * m; const float kv = bf2f(kreg[m]); X[t * LD + j] = kv * __expf(cl - X[t * LD + j]); }
      if (tid < 64) p.dec[(((long)dir * GH + head) * NCH + cid) * 64 + j] = __expf(cl); }
  }
  __syncthreads();
  { const int dir = w >> 2, di = (w >> 1) & 1, vj0 = (w & 1) * 2; const LAS float* X = (const LAS float*)(lds + OX) + dir * 64 * LD; const LAS float* V = (const LAS float*)(lds + OV);
    f32x16 a0 = {}, a1 = {}; const int li = lane & 31, lk = lane >> 5;
#pragma unroll 4
    for (int s0 = 0; s0 < 64; s0 += 2) { const float av = X[(s0 + lk) * LD + 32 * di + li]; const float b0 = V[(s0 + lk) * 128 + 32 * vj0 + li], b1 = V[(s0 + lk) * 128 + 32 * vj0 + 32 + li];
      a0 = __builtin_amdgcn_mfma_f32_32x32x2f32(av, b0, a0, 0, 0, 0); a1 = __builtin_amdgcn_mfma_f32_32x32x2f32(av, b1, a1, 0, 0, 0); }
    float* dst = p.cs + ((((long)dir * GH + head) * NCH + cid) * 64) * 128;
#pragma unroll
    for (int r = 0; r < 16; ++r) { const int d = 32 * di + (r & 3) + 8 * (r >> 2) + 4 * lk; dst[(long)d * 128 + 32 * vj0 + li] = a0[r]; dst[(long)d * 128 + 32 * vj0 + 32 + li] = a1[r]; }
  }
  __syncthreads();
}
__device__ __forceinline__ void g2_item(const In& p, long idx, int GH, int NCH) {
  const int v = (int)(idx & 127), d = (int)((idx >> 7) & 63); const int hd = (int)((idx >> 13) % GH), dir = (int)((idx >> 13) / GH);
  const int nl = p.S / 64, nc = p.C / 64; float st = 0.f;
  float* base = p.cs + (((long)dir * GH + hd) * NCH) * 64 * 128 + (long)d * 128 + v; const float* db = p.dec + (((long)dir * GH + hd) * NCH) * 64 + d;
  for (int s0 = 0; s0 < nl + nc; s0 += 4) { float c[4], dc[4]; float* pp[4];
#pragma unroll
    for (int k = 0; k < 4; ++k) { const int step = s0 + k; int cid; if (step < nc) cid = nl + (dir ? nc - 1 - step : step); else cid = dir ? nl - 1 - (step - nc) : step - nc;
      pp[k] = base + (long)cid * 64 * 128; c[k] = *pp[k]; dc[k] = db[(long)cid * 64]; }
#pragma unroll
    for (int k = 0; k < 4; ++k) { *pp[k] = st; st = dc[k] * st + c[k]; } }
}
__device__ __forceinline__ void g3_unit(const In& p, LAS unsigned char* lds, int head, int cid, int GH, int NCH) {
  int tid = threadIdx.x; asm volatile("" : "+v"(tid));
  const int lane = tid & 63, w = __builtin_amdgcn_readfirstlane(tid >> 6), li = lane & 31, lk = lane >> 5;
  const long row0 = chunk_row(p, cid);
  float spf[2][32];
  { const int vj_ = w & 3;
#pragma unroll
    for (int dir = 0; dir < 2; ++dir) { const float* sp = p.cs + ((((long)dir * GH + head) * NCH + cid) * 64) * 128 + 32 * vj_ + li;
#pragma unroll
      for (int i = 0; i < 32; ++i) spf[dir][i] = sp[(long)(2 * i + lk) * 128]; } }
  const VRegs vr = load_v_regs(p, head, row0, tid);
  bf16_t kreg[8], qreg[8];
#pragma unroll
  for (int m = 0; m < 8; ++m) { const long o_ = (row0 + (tid >> 6) + 8 * m) * p.ld + head * 64 + (tid & 63); kreg[m] = p.k[o_]; qreg[m] = p.q[o_]; }
  cum_phase(p, lds, head, row0, tid);
  store_v(vr, lds, tid);
  __syncthreads();
  { const int j = tid & 63;
#pragma unroll
    for (int dir = 0; dir < 2; ++dir) { LAS float* X = (LAS float*)(lds + OX) + dir * 64 * LD; LAS float* Y = (LAS float*)(lds + OY) + dir * 64 * LD;
#pragma unroll
      for (int m = 0; m < 8; ++m) { const int t = (tid >> 6) + 8 * m; const float c = X[t * LD + j];
        const float qv = bf2f(qreg[m]) * 0.125f, kv = bf2f(kreg[m]);
        X[t * LD + j] = qv * __expf(c); Y[t * LD + j] = kv * __expf(-c); } }
  }
  __syncthreads();
  {
    const int dir = w >> 2, qi = (w >> 1) & 1, si = w & 1; const bool zero = dir == 0 ? si > qi : si < qi;
    const LAS float* X = (const LAS float*)(lds + OX) + dir * 64 * LD; LAS float* Y = (LAS float*)(lds + OY) + dir * 64 * LD;
    f32x16 pa = {};
    if (!zero) {
#pragma unroll 4
      for (int d0 = 0; d0 < 64; d0 += 2) pa = __builtin_amdgcn_mfma_f32_32x32x2f32(X[(32 * qi + li) * LD + d0 + lk], Y[(32 * si + li) * LD + d0 + lk], pa, 0, 0, 0);
    }
    __syncthreads();
#pragma unroll
    for (int r = 0; r < 16; ++r) { const int q = 32 * qi + (r & 3) + 8 * (r >> 2) + 4 * lk, s = 32 * si + li; const bool keep = dir == 0 ? s <= q : s >= q;
      Y[q * LD + s] = keep ? pa[r] : 0.f; }
  }
  __syncthreads();
  f32x16 acc = {};
  { const int qi = w >> 2, vj = w & 3; const LAS float* V = (const LAS float*)(lds + OV);
#pragma unroll
    for (int dir = 0; dir < 2; ++dir) { const LAS float* X = (const LAS float*)(lds + OX) + dir * 64 * LD; const LAS float* Y = (const LAS float*)(lds + OY) + dir * 64 * LD;
#pragma unroll 4
      for (int s0 = 0; s0 < 64; s0 += 2) acc = __builtin_amdgcn_mfma_f32_32x32x2f32(Y[(32 * qi + li) * LD + s0 + lk], V[(s0 + lk) * 128 + 32 * vj + li], acc, 0, 0, 0);
#pragma unroll
      for (int i = 0; i < 32; ++i) acc = __builtin_amdgcn_mfma_f32_32x32x2f32(X[(32 * qi + li) * LD + 2 * i + lk], spf[dir][i], acc, 0, 0, 0);
    }
    __syncthreads();
    LAS float* O = (LAS float*)(lds + OX);
#pragma unroll
    for (int r = 0; r < 16; ++r) { const int q = 32 * qi + (r & 3) + 8 * (r >> 2) + 4 * lk; O[q * 129 + 32 * vj + li] = acc[r]; }
  }
  __syncthreads();
  { const int row = tid >> 3, part = tid & 7; const LAS float* O = (const LAS float*)(lds + OX) + row * 129 + part * 16;
    float o[16]; float ss = 0.f;
#pragma unroll
    for (int k = 0; k < 16; ++k) { o[k] = O[k]; ss += o[k] * o[k]; }
    ss += __shfl_xor(ss, 1); ss += __shfl_xor(ss, 2); ss += __shfl_xor(ss, 4);
    const float rs = 1.f / sqrtf(ss * (1.f / 128.f) + 1e-6f);
    const bf16_t* ogp = p.og + (row0 + row) * p.ld + head * 128 + part * 16; const v4u og0 = *(const v4u*)ogp, og1 = *(const v4u*)(ogp + 8);
    const unsigned ogw[8] = {og0.x, og0.y, og0.z, og0.w, og1.x, og1.y, og1.z, og1.w}; bf16_t* yp = p.y + (row0 + row) * p.ldy + head * 128 + part * 16; float yy[16];
#pragma unroll
    for (int k4 = 0; k4 < 4; ++k4) { f32x4v g4; g4[0] = bf2f((bf16_t)(ogw[2 * k4] & 0xffff)); g4[1] = bf2f((bf16_t)(ogw[2 * k4] >> 16)); g4[2] = bf2f((bf16_t)(ogw[2 * k4 + 1] & 0xffff)); g4[3] = bf2f((bf16_t)(ogw[2 * k4 + 1] >> 16)); const f32x4v n4 = *(const f32x4v*)(p.gnorm + part * 16 + 4 * k4); f32x4v y4;
#pragma unroll
      for (int e = 0; e < 4; ++e) { const float gg = g4[e]; y4[e] = o[4 * k4 + e] * rs * n4[e] * (gg / (1.f + __expf(-gg))); yy[4 * k4 + e] = y4[e]; } }
    { v4u o0, o1; o0.x = pk2(yy[0], yy[1]); o0.y = pk2(yy[2], yy[3]); o0.z = pk2(yy[4], yy[5]); o0.w = pk2(yy[6], yy[7]);
      o1.x = pk2(yy[8], yy[9]); o1.y = pk2(yy[10], yy[11]); o1.z = pk2(yy[12], yy[13]); o1.w = pk2(yy[14], yy[15]); *(v4u*)yp = o0; *(v4u*)(yp + 8) = o1; }
  }
  __syncthreads();
}
}
namespace moe {
constexpr int NE = 16, NG = 4, EPG = 4, DE = 512, D = 1024;
__device__ __forceinline__ float wave_sum(float v) {
#pragma unroll
  for (int o = 1; o < 64; o <<= 1) v += __shfl_xor(v, o);
  return v;
}
struct Route { int e0, r0, e1, r1; };
struct MoeOrder {
  int G, c, NT; const LAS int* poff;
  __device__ __forceinline__ bool next(int i, pg8::Unit& u) const {
    const long L = (long)i * G + c; const int total = poff[NE] * NT; if (L >= total) return false;
    const int panel = (int)L / NT, j = (int)L % NT; int e = 0;
#pragma unroll
    for (int k = 1; k < NE; ++k) e += (panel >= poff[k]) ? 1 : 0;
    u.pm = panel; u.pn = e * NT + j; u.acol = 0; return true;
  }
  __device__ __forceinline__ void a_ready(const pg8::Unit&) const {}
  __device__ __forceinline__ void done(const pg8::Unit&) const {}
};
struct EpiGU {
  static constexpr bool PERM = true, AFTER_DRAIN = false;
  bf16_t* hid;
  __device__ __forceinline__ void operator()(const pg8::f32x4 (&acc)[2][2][4][2], const pg8::Unit& u, int wr, int wc, int fr, int fq) const {
    const int j = u.pn & 3; const int row0 = u.pm * 256 + wr * 64 + fr, col0 = j * 128 + wc * 32 + 8 * fq;
#pragma unroll
    for (int ai = 0; ai < 2; ++ai)
#pragma unroll
      for (int m = 0; m < 4; ++m) { const size_t r = (size_t)(row0 + ai * 128 + m * 16); float hv[8];
#pragma unroll
        for (int n = 0; n < 2; ++n)
#pragma unroll
          for (int e = 0; e < 4; ++e) { const float g = acc[ai][0][m][n][e], up = acc[ai][1][m][n][e]; hv[4 * n + e] = g / (1.f + __expf(-g)) * up; }
        v4u o; o.x = pk2(hv[0], hv[1]); o.y = pk2(hv[2], hv[3]); o.z = pk2(hv[4], hv[5]); o.w = pk2(hv[6], hv[7]);
        *(v4u*)(hid + r * DE + col0) = o; }
  }
};
struct EpiDown {
  static constexpr bool PERM = true, AFTER_DRAIN = false;
  const int* srcrow; const float* wgt; bf16_t* contrib; size_t slot_stride;
  __device__ __forceinline__ void operator()(const pg8::f32x4 (&acc)[2][2][4][2], const pg8::Unit& u, int wr, int wc, int fr, int fq) const {
    const int pn = u.pn & 3; const int row0 = u.pm * 256 + wr * 64 + fr, col0 = pn * 256 + wc * 32 + 8 * fq;
    int srcs[2][4]; float ws_[2][4];
#pragma unroll
    for (int ai = 0; ai < 2; ++ai)
#pragma unroll
      for (int m = 0; m < 4; ++m) { const int r = row0 + ai * 128 + m * 16; srcs[ai][m] = srcrow[r]; ws_[ai][m] = wgt[r]; }
#pragma unroll
    for (int ai = 0; ai < 2; ++ai)
#pragma unroll
      for (int m = 0; m < 4; ++m) { const int src = srcs[ai][m]; if (src < 0) continue; const float w = ws_[ai][m];
        bf16_t* dst = contrib + (size_t)(src & 1) * slot_stride + (size_t)(src >> 1) * D + col0;
#pragma unroll
        for (int bj = 0; bj < 2; ++bj) { const pg8::f32x4 v0 = acc[ai][bj][m][0] * w, v1 = acc[ai][bj][m][1] * w;
          v4u o; o.x = pk2(v0[0], v0[1]); o.y = pk2(v0[2], v0[3]); o.z = pk2(v1[0], v1[1]); o.w = pk2(v1[2], v1[3]); *(v4u*)(dst + bj * 128) = o; } }
  }
};
__device__ __forceinline__ void route_row(const float* xr, const float* gnorm, const float* shift, const float* scale, bf16_t* hrow, const LAS float* rwT, const float* rbias,
                                          LAS int* cnt, Route* rt, float* wts, int lane) {
  typedef float f4 __attribute__((ext_vector_type(4)));
  f4 xv[4]; float ss = 0.f;
#pragma unroll
  for (int j = 0; j < 4; ++j) { xv[j] = *(const f4*)(xr + 4 * lane + 256 * j); ss += xv[j][0] * xv[j][0] + xv[j][1] * xv[j][1] + xv[j][2] * xv[j][2] + xv[j][3] * xv[j][3]; }
  const float rs = 1.f / sqrtf(wave_sum(ss) * (1.f / 1024.f) + 1e-6f);
  float lg[NE];
#pragma unroll
  for (int e = 0; e < NE; ++e) lg[e] = 0.f;
#pragma unroll
  for (int j = 0; j < 4; ++j) { const int c = 4 * lane + 256 * j; const f4 g4 = *(const f4*)(gnorm + c), sh = *(const f4*)(shift + c), sc = *(const f4*)(scale + c);
    f4 h;
#pragma unroll
    for (int i = 0; i < 4; ++i) h[i] = xv[j][i] * rs * g4[i] * (1.f + sc[i]) + sh[i];
    *(unsigned long long*)(hrow + c) = (unsigned long long)pk2(h[0], h[1]) | ((unsigned long long)pk2(h[2], h[3]) << 32);
#pragma unroll
    for (int e = 0; e < NE; ++e) { const f4 w4 = *(const LAS f4*)(rwT + e * 1024 + c); lg[e] += h[0] * w4[0] + h[1] * w4[1] + h[2] * w4[2] + h[3] * w4[3]; } }
  { float v8[8], v4[4], v2[2], v1;
#pragma unroll
    for (int i = 0; i < 8; ++i) { const bool up = lane & 1; const float keep = up ? lg[2 * i + 1] : lg[2 * i], send = up ? lg[2 * i] : lg[2 * i + 1]; v8[i] = keep + __shfl_xor(send, 1); }
#pragma unroll
    for (int i = 0; i < 4; ++i) { const bool up = lane & 2; const float keep = up ? v8[2 * i + 1] : v8[2 * i], send = up ? v8[2 * i] : v8[2 * i + 1]; v4[i] = keep + __shfl_xor(send, 2); }
#pragma unroll
    for (int i = 0; i < 2; ++i) { const bool up = lane & 4; const float keep = up ? v4[2 * i + 1] : v4[2 * i], send = up ? v4[2 * i] : v4[2 * i + 1]; v2[i] = keep + __shfl_xor(send, 4); }
    { const bool up = lane & 8; const float keep = up ? v2[1] : v2[0], send = up ? v2[0] : v2[1]; v1 = keep + __shfl_xor(send, 8); }
    v1 += __shfl_xor(v1, 16); v1 += __shfl_xor(v1, 32);
#pragma unroll
    for (int e = 0; e < NE; ++e) lg[e] = __shfl(v1, e); }
  float sc[NE], sel[NE];
#pragma unroll
  for (int e = 0; e < NE; ++e) { sc[e] = 1.f / (1.f + __expf(-lg[e])); sel[e] = sc[e] + rbias[e]; }
  int bestg = 0; float bestgs = -1e30f;
#pragma unroll
  for (int g = 0; g < NG; ++g) { float m1 = -1e30f, m2 = -1e30f;
#pragma unroll
    for (int i = 0; i < EPG; ++i) { const float v = sel[g * EPG + i]; if (v > m1) { m2 = m1; m1 = v; } else if (v > m2) m2 = v; }
    const float gsum = m1 + m2; if (gsum > bestgs) { bestgs = gsum; bestg = g; } }
  int i1 = -1, i2 = -1; float v1 = -1e30f, v2 = -1e30f, s1 = 0.f, s2 = 0.f;
#pragma unroll
  for (int e = 0; e < NE; ++e) { if (e / EPG == bestg) { const float v = sel[e];
      if (v > v1) { v2 = v1; i2 = i1; s2 = s1; v1 = v; i1 = e; s1 = sc[e]; } else if (v > v2) { v2 = v; i2 = e; s2 = sc[e]; } } }
  if (lane == 0) { const float inv = 1.f / (s1 + s2); Route r; r.e0 = i1; r.e1 = i2; r.r0 = __hip_atomic_fetch_add(cnt + i1, 1, __ATOMIC_RELAXED, __HIP_MEMORY_SCOPE_WORKGROUP); r.r1 = __hip_atomic_fetch_add(cnt + i2, 1, __ATOMIC_RELAXED, __HIP_MEMORY_SCOPE_WORKGROUP); *rt = r; wts[0] = s1 * inv; wts[1] = s2 * inv; }
}
}
namespace hy {
typedef float f32x16 __attribute__((ext_vector_type(16)));
constexpr int S = 4096, NT1 = 128, LDZ = 191, ZPAD = 31, LDX = 129;
constexpr int O_TAPS = 0, O_ZA = 32768, O_ZB = O_ZA + 32 * LDZ * 4, O_X1 = O_ZB + 32 * LDZ * 4, O_X2 = O_X1 + 32 * LDX * 4, O_RED = O_X2 + 32 * LDX * 4, O_END = O_RED + 4 * 64 * 16 * 4;
static_assert(O_END <= 131072, "hyena lds");

struct H0Regs { v4u w0, w1; };
__device__ __forceinline__ H0Regs h0_load(const bf16_t* u, int ld, int tile, int tid) {
  const int tt = tile / 24, jt = tile % 24, t0 = tt * 64, j0 = jt * 64; H0Regs r; r.w0 = (v4u){0u, 0u, 0u, 0u}; r.w1 = r.w0;
  { const int rr = tid >> 3, c8 = (tid & 7) * 8, t = t0 - 1 + rr; if (t >= 0 && t < S) r.w0 = *(const v4u*)(u + (size_t)t * ld + j0 + c8); }
  if (tid < 16) { const int rr = 64 + (tid >> 3), c8 = (tid & 7) * 8, t = t0 - 1 + rr; if (t < S) r.w1 = *(const v4u*)(u + (size_t)t * ld + j0 + c8); }
  return r;
}
__device__ __forceinline__ void h0_compute(const H0Regs& rg, const float* cw, const float* cb, bf16_t* ucT, int tile, LAS unsigned char* lds, int tid) {
  const int tt = tile / 24, jt = tile % 24, t0 = tt * 64, j0 = jt * 64;
  LAS float* U = (LAS float*)lds;
  { const int rr = tid >> 3, c8 = (tid & 7) * 8; const v4u w = rg.w0; LAS float* d = U + rr * 65 + c8;
    d[0] = bf2f(w.x & 0xffff); d[1] = bf2f(w.x >> 16); d[2] = bf2f(w.y & 0xffff); d[3] = bf2f(w.y >> 16); d[4] = bf2f(w.z & 0xffff); d[5] = bf2f(w.z >> 16); d[6] = bf2f(w.w & 0xffff); d[7] = bf2f(w.w >> 16); }
  if (tid < 16) { const int rr = 64 + (tid >> 3), c8 = (tid & 7) * 8; const v4u w = rg.w1; LAS float* d = U + rr * 65 + c8;
    d[0] = bf2f(w.x & 0xffff); d[1] = bf2f(w.x >> 16); d[2] = bf2f(w.y & 0xffff); d[3] = bf2f(w.y >> 16); d[4] = bf2f(w.z & 0xffff); d[5] = bf2f(w.z >> 16); d[6] = bf2f(w.w & 0xffff); d[7] = bf2f(w.w >> 16); }
  __syncthreads();
  { const int jj = tid >> 3, tq = (tid & 7) * 8, j = j0 + jj; const float w0 = cw[j], w1 = cw[1536 + j], w2 = cw[2 * 1536 + j], bb = cb[j]; float v[8];
#pragma unroll
    for (int k = 0; k < 8; ++k) v[k] = bb + w0 * U[(tq + k) * 65 + jj] + w1 * U[(tq + k + 1) * 65 + jj] + w2 * U[(tq + k + 2) * 65 + jj];
    v4u o; o.x = pk2(v[0], v[1]); o.y = pk2(v[2], v[3]); o.z = pk2(v[4], v[5]); o.w = pk2(v[6], v[7]); *(v4u*)(ucT + (size_t)j * S + t0 + tq) = o; }
  __syncthreads();
}
__device__ __forceinline__ void h2_tile(const bf16_t* yT, bf16_t* ybf, int ldy, int tile, LAS unsigned char* lds) {
  int tid = threadIdx.x; asm volatile("" : "+v"(tid));
  const int tt = tile / 8, ct = tile % 8, t0 = tt * 64, c0 = ct * 64;
  LAS bf16_t* T = (LAS bf16_t*)lds;
  { const int cc = tid >> 3, t8 = (tid & 7) * 8; const v4u w = *(const v4u*)(yT + (size_t)(c0 + cc) * S + t0 + t8); LAS unsigned* d = (LAS unsigned*)(T + cc * 66 + t8); d[0] = w.x; d[1] = w.y; d[2] = w.z; d[3] = w.w; }
  __syncthreads();
  { const int t = tid >> 3, c8 = (tid & 7) * 8; unsigned short e[8];
#pragma unroll
    for (int k = 0; k < 8; ++k) e[k] = T[(c8 + k) * 66 + t];
    v4u o; o.x = e[0] | ((unsigned)e[1] << 16); o.y = e[2] | ((unsigned)e[3] << 16); o.z = e[4] | ((unsigned)e[5] << 16); o.w = e[6] | ((unsigned)e[7] << 16);
    *(v4u*)(ybf + (size_t)(t0 + t) * ldy + c0 + c8) = o; }
  __syncthreads();
}
__device__ __forceinline__ void h1_unit(const bf16_t* ucT, const float* tapsT, const float* nrm, const float* skip, bf16_t* yT, int c, LAS unsigned char* lds) {
  int tid = threadIdx.x; asm volatile("" : "+v"(tid));
  const int lane = tid & 63, w = __builtin_amdgcn_readfirstlane(tid >> 6), li = lane & 31, lk = lane >> 5;
  LAS float* TAPS = (LAS float*)(lds + O_TAPS); LAS float* ZA = (LAS float*)(lds + O_ZA); LAS float* ZB = (LAS float*)(lds + O_ZB);
  LAS float* X1 = (LAS float*)(lds + O_X1); LAS float* X2 = (LAS float*)(lds + O_X2); LAS float* RED = (LAS float*)(lds + O_RED);
  for (int e = tid; e < 32 * 62; e += 512) { const int s2 = e / 62, p = e % 62, t1p = p < 31 ? p : 128 + p; ZA[s2 * LDZ + t1p] = 0.f; ZB[s2 * LDZ + t1p] = 0.f; }
  for (int t = tid; t < S; t += 512) { const int t2 = t & 31, t1 = t >> 5;
    X1[t2 * LDX + t1] = bf2f(ucT[(size_t)c * S + t]); X2[t2 * LDX + t1] = bf2f(ucT[(size_t)(512 + c) * S + t]); ZA[t2 * LDZ + t1 + ZPAD] = bf2f(ucT[(size_t)(1024 + c) * S + t]); }
#pragma unroll 1
  for (int o = 0; o < 2; ++o) {
    const float* tp = tapsT + ((size_t)o * 512 + c) * 8192;
    for (int e = tid; e < 8192; e += 512) TAPS[e] = tp[(e + 4096) & 8191];
    __syncthreads();
    const LAS float* Zin = o == 0 ? ZA : ZB;
    const int g = w & 3, dh = w >> 2;
    const int Dlo = 32 * g - 127 + (dh ? 80 : 0), Dn = dh ? 79 : 80;
    f32x16 acc = {};
    { const LAS float* ap = TAPS + 4096 + 32 * Dlo + li - lk - 30;
      const LAS float* bp = Zin + lk * LDZ + (32 * g + li - Dlo + ZPAD);
#pragma unroll 2
      for (int dd = 0; dd < Dn; ++dd) {
#pragma unroll
        for (int kk = 0; kk < 16; ++kk) acc = __builtin_amdgcn_mfma_f32_32x32x2f32(ap[(15 - kk) * 2], bp[2 * kk * LDZ], acc, 0, 0, 0);
        ap += 32; bp -= 1; }
    }
    if (dh) {
#pragma unroll
      for (int r = 0; r < 16; ++r) RED[(g * 64 + lane) * 16 + r] = acc[r]; }
    __syncthreads();
    if (!dh) { const float inv = 1.f / nrm[o * 512 + c], sk = skip[o * 512 + c]; const LAS float* G = o == 0 ? X1 : X2; LAS float* Out = o == 0 ? ZB : ZA;
#pragma unroll
      for (int r = 0; r < 16; ++r) { const int t2 = (r & 3) + 8 * (r >> 2) + 4 * lk, t1 = 32 * g + li;
        const float cv = (acc[r] + RED[(g * 64 + lane) * 16 + r]) * inv; const float zin = Zin[t2 * LDZ + t1 + ZPAD];
        Out[t2 * LDZ + t1 + ZPAD] = G[t2 * LDX + t1] * (cv + sk * zin); } }
    __syncthreads();
  }
  for (int t = tid; t < S; t += 512) yT[(size_t)c * S + t] = (bf16_t)f2bf(ZA[(t & 31) * LDZ + (t >> 5) + ZPAD]);
  __syncthreads();
}

typedef short bf16x8v __attribute__((ext_vector_type(8)));
typedef unsigned u32x2v __attribute__((ext_vector_type(2)));
constexpr int CSB = 16448;
constexpr int ZROW = 80, ZROWS = 190;
constexpr int B_CS = 0, B_ZA = 4 * CSB, B_ZB = B_ZA + 15232, B_X1 = B_ZB + 15232, B_X2 = B_X1 + 8256, B_RED = B_X2 + 8256, B_END = B_RED + 16384;
static_assert(B_END <= 131072 && B_ZA % 16 == 0 && B_X1 % 16 == 0, "hyena bf16 lds");
__device__ __forceinline__ void h1b_unit(const bf16_t* ucT, const bf16_t* tapsB, const float* nrm, const float* skip, bf16_t* yT, int c, LAS unsigned char* lds) {
  int tid = threadIdx.x; asm volatile("" : "+v"(tid));
  const int lane = tid & 63, w = __builtin_amdgcn_readfirstlane(tid >> 6), li = lane & 31, lk = lane >> 5;
  LAS bf16_t* ZA = (LAS bf16_t*)(lds + B_ZA); LAS bf16_t* ZB = (LAS bf16_t*)(lds + B_ZB); LAS bf16_t* X1 = (LAS bf16_t*)(lds + B_X1); LAS bf16_t* X2 = (LAS bf16_t*)(lds + B_X2);
  LAS float* RED = (LAS float*)(lds + B_RED);
  for (int e = tid; e < 62 * 20; e += 512) { const int p = e / 20, d = e % 20, row = p < 31 ? p : 128 + p; ((LAS unsigned*)ZA)[row * 20 + d] = 0u; ((LAS unsigned*)ZB)[row * 20 + d] = 0u; }
  { const v4u zv = *(const v4u*)(ucT + (size_t)(1024 + c) * S + tid * 8); const int t = tid * 8; *(LAS v4u*)((LAS unsigned char*)ZA + ((t >> 5) + ZPAD) * ZROW + (t & 31) * 2) = zv; }
  { const v4u xa = *(const v4u*)(ucT + (size_t)c * S + tid * 8), xb = *(const v4u*)(ucT + (size_t)(512 + c) * S + tid * 8); const int t1 = tid >> 2, t2b = (tid & 3) * 8;
    const unsigned wa[4] = {xa.x, xa.y, xa.z, xa.w}, wb[4] = {xb.x, xb.y, xb.z, xb.w};
#pragma unroll
    for (int k = 0; k < 4; ++k) { X1[(t2b + 2 * k) * LDX + t1] = (bf16_t)(wa[k] & 0xffff); X1[(t2b + 2 * k + 1) * LDX + t1] = (bf16_t)(wa[k] >> 16);
      X2[(t2b + 2 * k) * LDX + t1] = (bf16_t)(wb[k] & 0xffff); X2[(t2b + 2 * k + 1) * LDX + t1] = (bf16_t)(wb[k] >> 16); } }
  typedef unsigned u4a __attribute__((ext_vector_type(4), aligned(4))); typedef const __attribute__((address_space(1))) u4a* gp4;
  v4u cv[9];
#pragma unroll 1
  for (int o = 0; o < 2; ++o) {
#define HTAPS_LOAD(oo) { const __attribute__((address_space(1))) unsigned char* tb = (const __attribute__((address_space(1))) unsigned char*)(tapsB + ((size_t)(oo) * 512 + c) * 2 * 8232); \
      _Pragma("unroll") for (int it = 0; it < 9; ++it) { const int e = tid + 512 * it; const int s = e / 1028, q = e % 1028; cv[it] = (v4u){0u, 0u, 0u, 0u}; if (e < 4 * 1028) cv[it] = *(gp4)(tb + (size_t)(s & 1) * 16464 + 16 * q + 4 * (s >> 1)); } }
    if (o == 0) HTAPS_LOAD(0)
    {
#pragma unroll
      for (int it = 0; it < 9; ++it) { const int e = tid + 512 * it; const int s = e / 1028, q = e % 1028; if (e < 4 * 1028) *(LAS v4u*)(lds + B_CS + s * CSB + 16 * q) = cv[it]; } }
    __syncthreads();
    if (o == 0) HTAPS_LOAD(1)
    const LAS bf16_t* Zin = o == 0 ? ZA : ZB;
    const int g = w & 3, dh = w >> 2;
    const int Dlo = 32 * g - 127 + (dh ? 81 : 0), Dn = dh ? 78 : 81;
    f32x16 acc = {};
    { const int s = (4 - (li & 3)) & 3;
      const LAS unsigned char* ap = lds + B_CS + s * CSB + 2 * (4096 - 32 * Dlo - li + 8 * lk - s);
      const LAS unsigned char* bp = (const LAS unsigned char*)Zin + (32 * g + li - Dlo + ZPAD) * ZROW + 16 * lk;
#define HLD(A0, A1, B0, B1) { const u32x2v p0_ = *(const LAS u32x2v*)(ap), p1_ = *(const LAS u32x2v*)(ap2), p2_ = *(const LAS u32x2v*)(ap3), p3_ = *(const LAS u32x2v*)(ap4); \
        A0 = (v4u){p0_.x, p0_.y, p1_.x, p1_.y}; A1 = (v4u){p2_.x, p2_.y, p3_.x, p3_.y}; B0 = *(const LAS v4u*)(bp); B1 = *(const LAS v4u*)(bp + 32); ap -= 64; ap2 -= 64; ap3 -= 64; ap4 -= 64; bp -= ZROW; }
#define HMM(A, B) acc = __builtin_amdgcn_mfma_f32_32x32x16_bf16(__builtin_bit_cast(bf16x8v, A), __builtin_bit_cast(bf16x8v, B), acc, 0, 0, 0)
#define HOPQ(name, off) unsigned name##i = (unsigned)(unsigned long long)(ap + (off)); asm volatile("" : "+v"(name##i)); const LAS unsigned char* name = (const LAS unsigned char*)(unsigned long long)name##i;
      HOPQ(ap2, 8) HOPQ(ap3, 32) HOPQ(ap4, 40)
#undef HOPQ
      v4u fa0, fa1, fb0, fb1, ga0, ga1, gb0, gb1, ha0, ha1, hb0, hb1;
      HLD(fa0, fa1, fb0, fb1)
      HLD(ga0, ga1, gb0, gb1)
      for (int dd_ = 0; dd_ < Dn - 3; dd_ += 3) {
        HLD(ha0, ha1, hb0, hb1)
        HMM(fa0, fb0); HMM(fa1, fb1);
        HLD(fa0, fa1, fb0, fb1)
        HMM(ga0, gb0); HMM(ga1, gb1);
        HLD(ga0, ga1, gb0, gb1)
        HMM(ha0, hb0); HMM(ha1, hb1);
      }
      HLD(ha0, ha1, hb0, hb1)
      HMM(fa0, fb0); HMM(fa1, fb1); HMM(ga0, gb0); HMM(ga1, gb1); HMM(ha0, hb0); HMM(ha1, hb1);
#undef HLD
#undef HMM
    }
    if (dh) {
#pragma unroll
      for (int r = 0; r < 16; ++r) RED[(g * 64 + lane) * 16 + r] = acc[r]; }
    __syncthreads();
    if (!dh) { const float inv = 1.f / nrm[o * 512 + c], sk = skip[o * 512 + c]; const LAS bf16_t* G = o == 0 ? X1 : X2; LAS bf16_t* Out = o == 0 ? ZB : ZA;
#pragma unroll
      for (int r = 0; r < 16; ++r) { const int t2 = (r & 3) + 8 * (r >> 2) + 4 * lk, t1 = 32 * g + li;
        const float cv = (acc[r] + RED[(g * 64 + lane) * 16 + r]) * inv; const float zin = bf2f(Zin[(t1 + ZPAD) * (ZROW / 2) + t2]);
        Out[(t1 + ZPAD) * (ZROW / 2) + t2] = (bf16_t)f2bf(bf2f(G[t2 * LDX + t1]) * (cv + sk * zin)); } }
    __syncthreads();
  }
  { const int t = tid * 8; *(v4u*)(yT + (size_t)c * S + t) = *(const LAS v4u*)((const LAS unsigned char*)ZA + ((t >> 5) + ZPAD) * ZROW + (t & 31) * 2); }
  __syncthreads();
}
__device__ __forceinline__ void cconv3_item(const bf16_t* u, int ld, const float* cw, const float* cb, float* ucc, long idx) {
  const int j = (int)(idx % 1536); const int tc = (int)(idx / 1536);
  const bf16_t* up = u + (size_t)tc * ld + j;
  float v = cb[j] + cw[1536 + j] * bf2f(up[0]);
  if (tc > 0) v += cw[j] * bf2f(*(up - ld)); if (tc < 255) v += cw[2 * 1536 + j] * bf2f(up[ld]);
  ucc[idx] = v;
}
__device__ __forceinline__ void clong_item(const float* ucc, const float* z1c_in, float* z1c_out, bf16_t* yout, int ldy, const float* tapsC, const float* nrmC, const float* skip, int o, long idx) {
  const int c = (int)(idx % 512), t0 = (int)(idx / 512) * 8; constexpr int n = 256;
  const float* tp = tapsC + (size_t)o * 2 * n * 512 + c; const float nr = nrmC[o * 512 + c];
  const float* zs = o == 0 ? ucc + 1024 + c : z1c_in + c; const int ldz = o == 0 ? 1536 : 512;
  float acc[8], w[8];
#pragma unroll
  for (int i = 0; i < 8; ++i) { acc[i] = 0.f; const int lag = t0 + i; w[i] = tp[(size_t)lag * 512]; }
#pragma unroll 4
  for (int s = 0; s < n; ++s) { const float zv = zs[(size_t)s * ldz];
#pragma unroll
    for (int i = 0; i < 8; ++i) acc[i] += w[i] * zv;
    const int lag = t0 - s - 1;
    const float nw = tp[(size_t)(lag >= 0 ? lag : 2 * n + lag) * 512];
#pragma unroll
    for (int i = 7; i > 0; --i) w[i] = w[i - 1];
    w[0] = nw; }
  const float sk = skip[o * 512 + c];
#pragma unroll
  for (int i = 0; i < 8; ++i) { const int t = t0 + i; const float val = ucc[(size_t)t * 1536 + o * 512 + c] * (acc[i] / nr + sk * zs[(size_t)t * ldz]);
    if (o == 0) z1c_out[(size_t)t * 512 + c] = val; else yout[(size_t)t * ldy + c] = (bf16_t)f2bf(val); }
}
}
#define XB_TMO      128
#define XB_XCNT(j)  (256  + 64 * (j))
#define XB_XSUB(j)  (1280 + 64 * (j))
#define XB_XGEN(j)  (2304 + 64 * (j))
#define XB_TOP      3328
#define XB_TOPGEN   3392
#define XCD_BAR_WORDS 3456
#define XB_SPIN_CAP (1u << 18)

__device__ __forceinline__ unsigned xb_ld(unsigned* p)              { return __hip_atomic_load(p, __ATOMIC_RELAXED, __HIP_MEMORY_SCOPE_AGENT); }
__device__ __forceinline__ unsigned xb_add(unsigned* p, unsigned v) { return __hip_atomic_fetch_add(p, v, __ATOMIC_RELAXED, __HIP_MEMORY_SCOPE_AGENT); }
__device__ __forceinline__ unsigned xb_xcc_id() { return (unsigned)__builtin_amdgcn_s_getreg((3 << 11) | 20) & 0xFu; }
#define XB_SPIN(cond, bar) do { unsigned _sp = 0; while (cond) { __builtin_amdgcn_s_sleep(1); \
    if ((++_sp & 255u) == 0u) { if (xb_ld(&(bar)[XB_TMO])) break; if (_sp > XB_SPIN_CAP) { atomicAdd(&(bar)[XB_TMO], 1u); break; } } } } while (0)

struct XcdBarrier {
    unsigned* bar; unsigned x;
    volatile LAS unsigned* st;
};

__device__ __forceinline__ XcdBarrier xcd_barrier_post(unsigned* bar, volatile LAS unsigned* st) {
    XcdBarrier b; b.bar = bar; b.x = xb_xcc_id(); b.st = st;
    if (threadIdx.x == 0) (void)xb_add(&bar[XB_XCNT(b.x)], 1u);
    return b;
}
__device__ __forceinline__ void xcd_barrier_complete(unsigned* bar, unsigned x, unsigned& nloc, unsigned& nx) {
    const unsigned G = gridDim.x * gridDim.y * gridDim.z;
    unsigned sum, cnt, mine, sp = 0u;
    for (;;) {
        sum = 0u; cnt = 0u; mine = 0u;
#pragma unroll
        for (unsigned j = 0; j < 16; ++j) { const unsigned c = xb_ld(&bar[XB_XCNT(j)]); sum += c; cnt += (c > 0u) ? 1u : 0u; mine = (j == x) ? c : mine; }
        if (sum == G) break;
        __builtin_amdgcn_s_sleep(1);
        if ((++sp & 255u) == 0u) { if (xb_ld(&bar[XB_TMO])) break; if (sp > XB_SPIN_CAP) { atomicAdd(&bar[XB_TMO], 1u); break; } }
    }
    nloc = mine > 0u ? mine : 1u; nx = cnt > 0u ? cnt : 1u;
}

__device__ __forceinline__ void xcd_barrier(const XcdBarrier& b) {
    asm volatile("s_waitcnt vmcnt(0)" ::: "memory");
    __syncthreads();
    if (threadIdx.x == 0) {
        unsigned* bar = b.bar;
#define XB_SP(word) ((unsigned*)((((unsigned long long)(unsigned)__builtin_amdgcn_readfirstlane((int)((unsigned long long)(bar + (word)) >> 32))) << 32) | (unsigned)__builtin_amdgcn_readfirstlane((int)(unsigned)(unsigned long long)(bar + (word)))))
        unsigned* const p_xsub = XB_SP(XB_XSUB(b.x)); unsigned* const p_xgen = XB_SP(XB_XGEN(b.x));
        __builtin_amdgcn_s_waitcnt(0);
        unsigned nloc = b.st[0], nx = b.st[1];
        if (nloc == 0u) { xcd_barrier_complete(bar, b.x, nloc, nx); b.st[0] = nloc; b.st[1] = nx; }
        const unsigned old = xb_add(p_xsub, 1u);
        const unsigned gen = old / nloc;
        if (old + 1u == (gen + 1u) * nloc) {
            __builtin_amdgcn_fence(__ATOMIC_RELEASE, "agent");
            asm volatile("s_waitcnt vmcnt(0)" ::: "memory");
            const unsigned og = xb_add(&bar[XB_TOP], 1u);
            const unsigned tg = og / nx;
            if (og + 1u == (tg + 1u) * nx) xb_add(&bar[XB_TOPGEN], 1u);
            else XB_SPIN(xb_ld(&bar[XB_TOPGEN]) == tg, bar);
            __builtin_amdgcn_fence(__ATOMIC_ACQUIRE, "agent");
            xb_add(p_xgen, 1u);
            asm volatile("s_waitcnt vmcnt(0)" ::: "memory");
        } else {
            XB_SPIN(xb_ld(p_xgen) == gen, bar);
            __builtin_amdgcn_fence(__ATOMIC_ACQUIRE, "agent");
            asm volatile("s_waitcnt vmcnt(0)" ::: "memory");
        }
    }
    __syncthreads();
}
#include <math.h>
#ifdef HOST_TEST
#define HD
#define FEXP expf
#define FSIN sinf
#define FCOS cosf
#define FLOG logf
#define FPOW powf
#else
#define HD __device__ __forceinline__
#define FEXP __expf
#define FSIN __sinf
#define FCOS __cosf
#define FLOG __logf
#define FPOW __powf
#endif

struct FullDims { static constexpr int D=1024,B=8,S=4096,DEPTH=2,C=256,GW=64,AH=8,AKV=2,HDM=128,GH=4,GDK=64,GDV=128,GR=16,HW=512,HB=16,HF=64,NE=16,NG=4,DE=512; };
struct SmallDims { static constexpr int D=64,B=2,S=128,DEPTH=2,C=32,GW=16,AH=4,AKV=2,HDM=16,GH=2,GDK=8,GDV=16,GR=4,HW=32,HB=4,HF=8,NE=8,NG=2,DE=32; };

template <class T> struct DD {
  static constexpr int D=T::D,B=T::B,S=T::S,DEPTH=T::DEPTH,C=T::C,GW=T::GW,AH=T::AH,AKV=T::AKV,HDM=T::HDM,GH=T::GH,GDK=T::GDK,GDV=T::GDV,GR=T::GR,HW=T::HW,HB=T::HB,HF=T::HF,NE=T::NE,NG=T::NG,DE=T::DE;
  static constexpr int R=S+C, AG=AH/AKV, RP=HDM/4, HE=1+2*HB, EPG=NE/NG, AQW=AH*HDM, AKVW=AKV*HDM, GKW=GH*GDK, GVW=GH*GDV;
  static constexpr int NKV=AKVW+AKVW+GKW+GVW+2*GR, NIN=NKV+AQW+GKW+GVW+3*HW+3*D;
  static constexpr int O_AK=0, O_AV=AKVW, O_GK=2*AKVW, O_GV=2*AKVW+GKW, O_GA=2*AKVW+GKW+GVW;
  static constexpr int O_AQ=NKV, O_GQ=NKV+AQW, O_OG=O_GQ+GKW, O_HY=O_OG+GVW, O_BR=O_HY+3*HW;
};

struct NaiveBufs {
  const float *x,*c,*ctx,*c_ctx,*w_mod,*b_mod,*norm1_g,*norm2_g,*w_in,*q_norm_g,*k_norm_g,*gla_wa2,*gla_ba,*gla_norm_g,*hy_conv_w,*hy_conv_b,
    *hy_pos_w1,*hy_pos_b1,*hy_sin_freq,*hy_pos_w2,*hy_pos_b2,*hy_pos_w3,*hy_decay,*hy_skip,*w_br_hy,*w_br_gla,*w_br_att,*w_out,*router_w,*router_b,*moe_w_gate,*moe_w_up,*moe_w_down;
  float* out;
  float *mod;
  float *hid2S,*hid2C;
  float *tapsS,*tapsC;
  float *nrmS,*nrmC;
  float *rs;
  float *h;
  float *proj;
  float *qn,*kn;
  float *yatt;
  float *laf,*lab;
  float *of,*ob;
  float *ygla;
  float *uc;
  float *z1,*yhy;
  float *m;
  int   *ridx;
  float *rw;
  float *hid;
  float *xc;
};

HD float sigmoidf_(float x) { return 1.f / (1.f + FEXP(-x)); }
HD float siluf_(float x) { return x / (1.f + FEXP(-x)); }
HD float logsigmoidf_(float x) { return x < 0.f ? x - FLOG(1.f + FEXP(x)) : -FLOG(1.f + FEXP(-x)); }

template <class T> HD void st_mod(const NaiveBufs& a, int l, long idx) {
  using d = DD<T>; const int j = (int)(idx % (6 * d::D)), bb = (int)(idx / (6 * d::D));
  const float* cv = bb < d::B ? a.c + (long)bb * d::D : a.c_ctx; const float* w = a.w_mod + (long)l * d::D * 6 * d::D;
  float acc = a.b_mod[(long)l * 6 * d::D + j];
  for (int k = 0; k < d::D; ++k) acc += siluf_(cv[k]) * w[(long)k * 6 * d::D + j];
  a.mod[idx] = acc;
}
template <class T> HD void st_hyhid(const NaiveBufs& a, int l, int which, long idx) {
  using d = DD<T>; const int n = which ? d::C : d::S; float* dst = which ? a.hid2C : a.hid2S;
  const int j = (int)(idx % d::HF), t = (int)(idx / d::HF);
  const float* w1 = a.hy_pos_w1 + (long)l * d::HE * d::HF; const float* b1 = a.hy_pos_b1 + l * d::HF; const float* fr = a.hy_sin_freq + l * d::HF;
  const float* w2 = a.hy_pos_w2 + (long)l * d::HF * d::HF; const float* b2 = a.hy_pos_b2 + l * d::HF;
  const float tn = (float)t / (float)n; const float w0 = 2.f * 3.14159265358979323846f / (float)n;
  float acc2 = b2[j];
  for (int i = 0; i < d::HF; ++i) {
    float acc = b1[i] + tn * w1[0 * d::HF + i];
    for (int bnd = 0; bnd < d::HB; ++bnd) {
      const float band = 1e-4f + (float)bnd * ((float)(d::HB - 1) - 1e-4f) / (float)(d::HB - 1);
      const float ph = w0 * (float)t * band;
      acc += FCOS(ph) * w1[(1 + bnd) * d::HF + i] - FSIN(ph) * w1[(1 + d::HB + bnd) * d::HF + i];
    }
    acc2 += FSIN(fr[i] * acc) * w2[i * d::HF + j];
  }
  dst[idx] = FSIN(fr[j] * acc2);
}
template <class T> HD void st_hytaps(const NaiveBufs& a, int l, int which, long idx) {
  using d = DD<T>; const int n = which ? d::C : d::S; const float* hid2 = which ? a.hid2C : a.hid2S; float* dst = which ? a.tapsC : a.tapsS;
  const int c = (int)(idx % d::HW); const int li = (int)((idx / d::HW) % (2 * n)); const int o = (int)(idx / ((long)d::HW * 2 * n));
  float v = 0.f;
  if (li != n) {
    const int dir = li < n ? 0 : 1; const int t = li < n ? li : 2 * n - li;
    const int col = (o * 2 + dir) * d::HW + c;
    const float* w3 = a.hy_pos_w3 + (long)l * d::HF * 4 * d::HW;
    float acc = 0.f;
    for (int j = 0; j < d::HF; ++j) acc += hid2[(long)t * d::HF + j] * w3[(long)j * 4 * d::HW + col];
    const float dec = fabsf(a.hy_decay[(long)l * 4 * d::HW + col]);
    v = acc * FEXP(-((float)t / (float)n) * dec);
  }
  if (which == 0) dst[((long)o * d::HW + c) * 2 * n + li] = v; else dst[idx] = v;
}
template <class T> HD void st_hynorm(const NaiveBufs& a, int which, long idx) {
  using d = DD<T>; const int n = which ? d::C : d::S; const float* tp = which ? a.tapsC : a.tapsS; float* dst = which ? a.nrmC : a.nrmS;
  const int c = (int)(idx % d::HW), o = (int)(idx / d::HW);
  float s = 0.f; for (int li = 0; li < 2 * n; ++li) s += fabsf(which == 0 ? tp[((long)o * d::HW + c) * 2 * n + li] : tp[((long)o * 2 * n + li) * d::HW + c]);
  dst[idx] = s + 1e-6f;
}

template <class T> HD const float* xrow(const NaiveBufs& a, int l, int b, int r) {
  using d = DD<T>;
  if (r < d::S) return (l == 0 ? a.x : a.out) + ((long)b * d::S + r) * d::D;
  return (l == 0 ? a.ctx : a.xc) + ((long)b * d::C + (r - d::S)) * d::D;
}
template <class T> HD float* xrow_w(const NaiveBufs& a, int b, int r) {
  using d = DD<T>;
  if (r < d::S) return a.out + ((long)b * d::S + r) * d::D;
  return a.xc + ((long)b * d::C + (r - d::S)) * d::D;
}
template <class T> HD void st_rs(const NaiveBufs& a, int l, int b, int src, long idx) {
  using d = DD<T>; const int r = (int)idx; const float* xr = src ? (const float*)xrow_w<T>(a, b, r) : xrow<T>(a, l, b, r);
  float s = 0.f; for (int k = 0; k < d::D; ++k) s += xr[k] * xr[k];
  a.rs[r] = 1.f / sqrtf(s / (float)d::D + 1e-6f);
}
template <class T> HD void st_norm(const NaiveBufs& a, int l, int b, int which, long idx) {
  using d = DD<T>; const int j = (int)(idx % d::D), r = (int)(idx / d::D);
  const float* xr = which ? (const float*)xrow_w<T>(a, b, r) : xrow<T>(a, l, b, r);
  const float* g = (which ? a.norm2_g : a.norm1_g) + (long)l * d::D;
  const float* md = a.mod + (long)(r < d::S ? b : d::B) * 6 * d::D;
  const float shift = md[(which ? 3 : 0) * d::D + j], scale = md[(which ? 4 : 1) * d::D + j];
  a.h[idx] = xr[j] * a.rs[r] * g[j] * (1.f + scale) + shift;
}
struct GemmArgs { const float* A; int lda; const float* W; int ldw; float* Cc; int ldc; int M, N, K;
  const float* gate; int ldg;
  const float* colscale;
  const float* res; int ldr;
  int accumulate; };
HD void st_gemm(const GemmArgs& g, long idx) {
  const int nb = g.N / 4; const int cb = (int)(idx % nb), rb = (int)(idx / nb);
  float acc[4][4];
#pragma unroll
  for (int i = 0; i < 4; ++i) {
#pragma unroll
    for (int j = 0; j < 4; ++j) acc[i][j] = 0.f; }
  const float* a0 = g.A + (long)(rb * 4) * g.lda; const float* w0 = g.W + cb * 4;
  for (int k = 0; k < g.K; ++k) {
    float av[4], wv[4];
#pragma unroll
    for (int i = 0; i < 4; ++i) av[i] = a0[(long)i * g.lda + k];
#pragma unroll
    for (int j = 0; j < 4; ++j) wv[j] = w0[(long)k * g.ldw + j];
#pragma unroll
    for (int i = 0; i < 4; ++i) {
#pragma unroll
      for (int j = 0; j < 4; ++j) acc[i][j] += av[i] * wv[j]; }
  }
#pragma unroll
  for (int i = 0; i < 4; ++i)
#pragma unroll
  for (int j = 0; j < 4; ++j) {
    const int r = rb * 4 + i, c = cb * 4 + j; float v = acc[i][j];
    if (g.gate) v *= sigmoidf_(g.gate[(long)r * g.ldg + c]);
    if (g.colscale) v *= g.colscale[c];
    if (g.res) v += g.res[(long)r * g.ldr + c];
    float* p = g.Cc + (long)r * g.ldc + c;
    if (g.accumulate) v += *p;
    *p = v;
  }
}
template <class T> HD void st_qknorm(const NaiveBufs& a, int l, long idx) {
  using d = DD<T>; const int hh = (int)(idx % (d::AH + d::AKV)), r = (int)(idx / (d::AH + d::AKV));
  const bool isq = hh < d::AH; const int hd = isq ? hh : hh - d::AH;
  const float* src = a.proj + (long)r * d::NIN + (isq ? d::O_AQ : d::O_AK) + hd * d::HDM;
  float* dst = (isq ? a.qn + (long)r * d::AQW : a.kn + (long)r * d::AKVW) + hd * d::HDM;
  const float* g = (isq ? a.q_norm_g : a.k_norm_g) + (long)l * d::HDM;
  float s = 0.f; for (int k = 0; k < d::HDM; ++k) s += src[k] * src[k];
  const float rsq = 1.f / sqrtf(s / (float)d::HDM + 1e-6f);
  if (r < d::S) {
    const int row = r / d::GW, col = r % d::GW;
    for (int p = 0; p < d::HDM / 2; ++p) {
      const int fi = p < d::RP ? p : p - d::RP; const float pos = p < d::RP ? (float)row : (float)col;
      const float inv = FPOW(10000.f, -(float)fi / (float)d::RP); const float ang = pos * inv;
      const float cs = FCOS(ang), sn = FSIN(ang);
      const float x1 = src[2 * p] * rsq * g[2 * p], x2 = src[2 * p + 1] * rsq * g[2 * p + 1];
      dst[2 * p] = x1 * cs - x2 * sn; dst[2 * p + 1] = x1 * sn + x2 * cs;
    }
  } else { for (int k = 0; k < d::HDM; ++k) dst[k] = src[k] * rsq * g[k]; }
}
template <class T, int NSPLIT> HD void st_attn(const NaiveBufs& a, int r0, int nrows, long idx) {
  using d = DD<T>; constexpr int OD = d::HDM / NSPLIT;
  const int r = r0 + (int)(idx % nrows); const int hs = (int)(idx / nrows); const int part = hs % NSPLIT, hq = hs / NSPLIT; const int kv = hq / d::AG;
  const int k0 = r < d::S ? 0 : d::S, k1 = d::R;
  float q[d::HDM], o[OD];
  const float scale = 1.f / sqrtf((float)d::HDM);
#pragma unroll
  for (int k = 0; k < d::HDM; ++k) q[k] = a.qn[(long)r * d::AQW + hq * d::HDM + k] * scale;
#pragma unroll
  for (int k = 0; k < OD; ++k) o[k] = 0.f;
  float mx = -1e30f, lsum = 0.f;
  for (int kk = k0; kk < k1; ++kk) {
    const float* kr = a.kn + (long)kk * d::AKVW + kv * d::HDM;
    float s = 0.f;
#pragma unroll
    for (int k = 0; k < d::HDM; ++k) s += q[k] * kr[k];
    if (s > mx) { const float cr = FEXP(mx - s); lsum *= cr;
#pragma unroll
      for (int k = 0; k < OD; ++k) o[k] *= cr;
      mx = s; }
    const float p = FEXP(s - mx); lsum += p;
    const float* vr = a.proj + (long)kk * d::NIN + d::O_AV + kv * d::HDM + part * OD;
#pragma unroll
    for (int k = 0; k < OD; ++k) o[k] += p * vr[k];
  }
  const float inv = 1.f / lsum;
#pragma unroll
  for (int k = 0; k < OD; ++k) a.yatt[(long)r * d::AQW + hq * d::HDM + part * OD + k] = o[k] * inv;
}
template <class T> HD void st_glala(const NaiveBufs& a, int l, long idx) {
  using d = DD<T>; const int j = (int)(idx % d::GKW); const int dir = (int)((idx / d::GKW) % 2); const int r = (int)(idx / (2 * d::GKW));
  const float* al = a.proj + (long)r * d::NIN + d::O_GA + dir * d::GR;
  const float* w2 = a.gla_wa2 + ((long)l * 2 + dir) * d::GR * d::GKW; float z = a.gla_ba[((long)l * 2 + dir) * d::GKW + j];
  for (int k = 0; k < d::GR; ++k) z += al[k] * w2[(long)k * d::GKW + j];
  (dir ? a.lab : a.laf)[(long)r * d::GKW + j] = FEXP(logsigmoidf_(z) / 16.f);
}
template <class T> HD void st_glascan(const NaiveBufs& a, long idx) {
  using d = DD<T>; const int v = (int)(idx % d::GDV); const int hd = (int)((idx / d::GDV) % d::GH); const int dir = (int)(idx / (d::GDV * d::GH));
  float st[d::GDK];
#pragma unroll
  for (int k = 0; k < d::GDK; ++k) st[k] = 0.f;
  const float qs = 1.f / sqrtf((float)d::GDK);
  const float* la = dir ? a.lab : a.laf; float* od = dir ? a.ob : a.of;
  for (int step = 0; step < d::R; ++step) {
    int r;
    if (step < d::C) r = d::S + (dir ? d::C - 1 - step : step); else r = dir ? d::S - 1 - (step - d::C) : step - d::C;
    const float* pr = a.proj + (long)r * d::NIN;
    const float vv = pr[d::O_GV + hd * d::GDV + v];
    float o = 0.f;
#pragma unroll
    for (int k = 0; k < d::GDK; ++k) {
      st[k] = la[(long)r * d::GKW + hd * d::GDK + k] * st[k] + pr[d::O_GK + hd * d::GDK + k] * vv;
      o += pr[d::O_GQ + hd * d::GDK + k] * qs * st[k];
    }
    od[(long)r * d::GVW + hd * d::GDV + v] = o;
  }
}
template <class T> HD void st_glaout(const NaiveBufs& a, int l, long idx) {
  using d = DD<T>; const int hd = (int)(idx % d::GH), r = (int)(idx / d::GH);
  const long base = (long)r * d::GVW + hd * d::GDV; float s = 0.f;
  for (int v = 0; v < d::GDV; ++v) { const float o = a.of[base + v] + a.ob[base + v]; s += o * o; }
  const float rsq = 1.f / sqrtf(s / (float)d::GDV + 1e-6f);
  for (int v = 0; v < d::GDV; ++v) { const float o = a.of[base + v] + a.ob[base + v];
    a.ygla[base + v] = o * rsq * a.gla_norm_g[(long)l * d::GDV + v] * siluf_(a.proj[(long)r * d::NIN + d::O_OG + hd * d::GDV + v]); }
}
template <class T> HD void st_hyconv3(const NaiveBufs& a, int l, long idx) {
  using d = DD<T>; const int j = (int)(idx % (3 * d::HW)), r = (int)(idx / (3 * d::HW));
  const int lo = r < d::S ? 0 : d::S, hi = r < d::S ? d::S : d::R;
  const float* w = a.hy_conv_w + (long)l * 3 * 3 * d::HW;
  float v = a.hy_conv_b[(long)l * 3 * d::HW + j] + a.proj[(long)r * d::NIN + d::O_HY + j] * w[1 * 3 * d::HW + j];
  if (r - 1 >= lo) v += a.proj[(long)(r - 1) * d::NIN + d::O_HY + j] * w[0 * 3 * d::HW + j];
  if (r + 1 < hi) v += a.proj[(long)(r + 1) * d::NIN + d::O_HY + j] * w[2 * 3 * d::HW + j];
  a.uc[idx] = v;
}
template <class T> HD void st_hylong(const NaiveBufs& a, int l, int o, long idx) {
  using d = DD<T>; const int c = (int)(idx % d::HW); const int rb = (int)(idx / d::HW); const int r0 = rb * 4;
  const bool lat = r0 < d::S; const int n = lat ? d::S : d::C; const int base = lat ? 0 : d::S; const int t0 = r0 - base;
  const float* tp = (lat ? a.tapsS : a.tapsC) + (long)o * 2 * n * d::HW + c; const float nr = (lat ? a.nrmS : a.nrmC)[o * d::HW + c];
  const float* zs = o == 0 ? a.uc + 2 * d::HW + c : a.z1 + c; const int ldz = o == 0 ? 3 * d::HW : d::HW;
  float acc0 = 0.f, acc1 = 0.f, acc2 = 0.f, acc3 = 0.f;
  auto tap = [&](int lag) { const int li = lag >= 0 ? lag : 2 * n + lag; return tp[(long)li * d::HW]; };
  float w0 = tap(t0), w1 = tap(t0 + 1), w2 = tap(t0 + 2), w3 = tap(t0 + 3);
  for (int s = 0; s < n; ++s) {
    const float zv = zs[(long)(base + s) * ldz];
    acc0 += w0 * zv; acc1 += w1 * zv; acc2 += w2 * zv; acc3 += w3 * zv;
    w3 = w2; w2 = w1; w1 = w0; w0 = (s + 1 < n) ? tap(t0 - s - 1) : 0.f;
  }
  const float sk = a.hy_skip[((long)l * 2 + o) * d::HW + c];
  float* dst = o == 0 ? a.z1 : a.yhy;
  const float accs[4] = {acc0, acc1, acc2, acc3};
#pragma unroll
  for (int i = 0; i < 4; ++i) { const int r = r0 + i; const float zr = zs[(long)r * ldz];
    dst[(long)r * d::HW + c] = a.uc[(long)r * 3 * d::HW + o * d::HW + c] * (accs[i] / nr + sk * zr); }
}
template <class T> HD void st_router(const NaiveBufs& a, long idx) {
  using d = DD<T>; const int r = (int)idx; const float* hr = a.h + (long)r * d::D;
  float sc[d::NE], sel[d::NE];
#pragma unroll
  for (int e = 0; e < d::NE; ++e) sc[e] = 0.f;
  for (int k = 0; k < d::D; ++k) { const float hv = hr[k];
#pragma unroll
    for (int e = 0; e < d::NE; ++e) sc[e] += hv * a.router_w[(long)k * d::NE + e]; }
#pragma unroll
  for (int e = 0; e < d::NE; ++e) { sc[e] = sigmoidf_(sc[e]); sel[e] = sc[e] + a.router_b[e]; }
  int bestg = 0; float bestgs = -1e30f;
#pragma unroll
  for (int g = 0; g < d::NG; ++g) { float m1 = -1e30f, m2 = -1e30f;
#pragma unroll
    for (int i = 0; i < d::EPG; ++i) { const float v = sel[g * d::EPG + i]; if (v > m1) { m2 = m1; m1 = v; } else if (v > m2) m2 = v; }
    const float gs = m1 + m2; if (gs > bestgs) { bestgs = gs; bestg = g; } }
  int i1 = -1, i2 = -1; float v1 = -1e30f, v2 = -1e30f, s1 = 0.f, s2 = 0.f;
#pragma unroll
  for (int e = 0; e < d::NE; ++e) { if (e / d::EPG == bestg) { const float v = sel[e];
      if (v > v1) { v2 = v1; i2 = i1; s2 = s1; v1 = v; i1 = e; s1 = sc[e]; } else if (v > v2) { v2 = v; i2 = e; s2 = sc[e]; } } }
  const float inv = 1.f / (s1 + s2);
  a.ridx[2 * r] = i1; a.ridx[2 * r + 1] = i2; a.rw[2 * r] = s1 * inv; a.rw[2 * r + 1] = s2 * inv;
}
template <class T> HD void st_moehid(const NaiveBufs& a, int l, long idx) {
  using d = DD<T>; const int j = (int)(idx % d::DE); const int k = (int)((idx / d::DE) % 2); const int r = (int)(idx / (2 * d::DE));
  const int e = a.ridx[2 * r + k]; const float* hr = a.h + (long)r * d::D;
  const float* wg = a.moe_w_gate + (((long)l * d::NE + e) * d::D) * d::DE + j; const float* wu = a.moe_w_up + (((long)l * d::NE + e) * d::D) * d::DE + j;
  float g = 0.f, u = 0.f;
  for (int i = 0; i < d::D; ++i) { const float hv = hr[i]; g += hv * wg[(long)i * d::DE]; u += hv * wu[(long)i * d::DE]; }
  a.hid[idx] = siluf_(g) * u;
}
template <class T> HD void st_moeout(const NaiveBufs& a, int l, int b, long idx) {
  using d = DD<T>; const int dd = (int)(idx % d::D), r = (int)(idx / d::D);
  float acc = 0.f;
  for (int k = 0; k < 2; ++k) { const int e = a.ridx[2 * r + k]; const float* hk = a.hid + ((long)r * 2 + k) * d::DE;
    const float* wd = a.moe_w_down + (((long)l * d::NE + e) * d::DE) * d::D + dd; float s = 0.f;
    for (int j = 0; j < d::DE; ++j) s += hk[j] * wd[(long)j * d::D];
    acc += a.rw[2 * r + k] * s; }
  const float g2 = a.mod[(long)(r < d::S ? b : d::B) * 6 * d::D + 5 * d::D + dd];
  float* xr = xrow_w<T>(a, b, r); xr[dd] += g2 * acc;
}
enum { L_MOD = 0, L_HID_S, L_HID_C, L_TAPS_S, L_TAPS_C, L_NRM_S, L_NRM_C, N_LSTAGES,
       P_RS1 = 16, P_NORM1, P_INPROJ, P_QKNORM, P_ATTN_L, P_ATTN_C, P_GLALA, P_GLASCAN, P_GLAOUT, P_HYC3, P_HYL0, P_HYL1,
       P_MRG_HY, P_MRG_GLA, P_MRG_ATT, P_OUT_L, P_OUT_C, P_RS2, P_NORM2, P_ROUTER, P_MOEHID, P_MOEOUT, P_END };
constexpr int ATT_NSPLIT = 4;

template <class T> HD long stage_items(int st, int l) {
  using d = DD<T>; const bool last = (l == d::DEPTH - 1);
  switch (st) {
    case L_MOD: return (long)(d::B + 1) * 6 * d::D;
    case L_HID_S: return (long)d::S * d::HF;
    case L_HID_C: return (long)d::C * d::HF;
    case L_TAPS_S: return 2L * 2 * d::S * d::HW;
    case L_TAPS_C: return 2L * 2 * d::C * d::HW;
    case L_NRM_S: case L_NRM_C: return 2L * d::HW;
    case P_RS1: case P_RS2: case P_ROUTER: return d::R;
    case P_NORM1: case P_NORM2: return (long)d::R * d::D;
    case P_INPROJ: return (long)(d::R / 4) * (d::NIN / 4);
    case P_QKNORM: return (long)d::R * (d::AH + d::AKV);
    case P_ATTN_L: return (long)d::S * d::AH * ATT_NSPLIT;
    case P_ATTN_C: return last ? 0 : (long)d::C * d::AH * ATT_NSPLIT;
    case P_GLALA: return (long)d::R * 2 * d::GKW;
    case P_GLASCAN: return 2L * d::GH * d::GDV;
    case P_GLAOUT: return (long)d::R * d::GH;
    case P_HYC3: return (long)d::R * 3 * d::HW;
    case P_HYL0: case P_HYL1: return (long)(d::R / 4) * d::HW;
    case P_MRG_HY: case P_MRG_GLA: case P_MRG_ATT: return (long)(d::R / 4) * (d::D / 4);
    case P_OUT_L: return (long)(d::S / 4) * (d::D / 4);
    case P_OUT_C: return last ? 0 : (long)(d::C / 4) * (d::D / 4);
    case P_MOEHID: return (long)d::R * 2 * d::DE;
    case P_MOEOUT: return (long)(last ? d::S : d::R) * d::D;
  }
  return 0;
}

template <class T, int ST> HD void stage_run(const NaiveBufs& a, int l, int b, long idx) {
  using d = DD<T>;
  if constexpr (ST == L_MOD) st_mod<T>(a, l, idx);
  else if constexpr (ST == L_HID_S) st_hyhid<T>(a, l, 0, idx);
  else if constexpr (ST == L_HID_C) st_hyhid<T>(a, l, 1, idx);
  else if constexpr (ST == L_TAPS_S) st_hytaps<T>(a, l, 0, idx);
  else if constexpr (ST == L_TAPS_C) st_hytaps<T>(a, l, 1, idx);
  else if constexpr (ST == L_NRM_S) st_hynorm<T>(a, 0, idx);
  else if constexpr (ST == L_NRM_C) st_hynorm<T>(a, 1, idx);
  else if constexpr (ST == P_RS1) st_rs<T>(a, l, b, 0, idx);
  else if constexpr (ST == P_RS2) st_rs<T>(a, l, b, 1, idx);
  else if constexpr (ST == P_NORM1) st_norm<T>(a, l, b, 0, idx);
  else if constexpr (ST == P_NORM2) st_norm<T>(a, l, b, 1, idx);
  else if constexpr (ST == P_INPROJ) { GemmArgs g{a.h, d::D, a.w_in + (long)l * d::D * d::NIN, d::NIN, a.proj, d::NIN, d::R, d::NIN, d::D, nullptr, 0, nullptr, nullptr, 0, 0}; st_gemm(g, idx); }
  else if constexpr (ST == P_QKNORM) st_qknorm<T>(a, l, idx);
  else if constexpr (ST == P_ATTN_L) st_attn<T, ATT_NSPLIT>(a, 0, d::S, idx);
  else if constexpr (ST == P_ATTN_C) st_attn<T, ATT_NSPLIT>(a, d::S, d::C, idx);
  else if constexpr (ST == P_GLALA) st_glala<T>(a, l, idx);
  else if constexpr (ST == P_GLASCAN) st_glascan<T>(a, idx);
  else if constexpr (ST == P_GLAOUT) st_glaout<T>(a, l, idx);
  else if constexpr (ST == P_HYC3) st_hyconv3<T>(a, l, idx);
  else if constexpr (ST == P_HYL0) st_hylong<T>(a, l, 0, idx);
  else if constexpr (ST == P_HYL1) st_hylong<T>(a, l, 1, idx);
  else if constexpr (ST == P_MRG_HY) { GemmArgs g{a.yhy, d::HW, a.w_br_hy + (long)l * d::HW * d::D, d::D, a.m, d::D, d::R, d::D, d::HW, a.proj + d::O_BR, d::NIN, nullptr, nullptr, 0, 0}; st_gemm(g, idx); }
  else if constexpr (ST == P_MRG_GLA) { GemmArgs g{a.ygla, d::GVW, a.w_br_gla + (long)l * d::GVW * d::D, d::D, a.m, d::D, d::R, d::D, d::GVW, a.proj + d::O_BR + d::D, d::NIN, nullptr, nullptr, 0, 1}; st_gemm(g, idx); }
  else if constexpr (ST == P_MRG_ATT) { GemmArgs g{a.yatt, d::AQW, a.w_br_att + (long)l * d::AQW * d::D, d::D, a.m, d::D, d::R, d::D, d::AQW, a.proj + d::O_BR + 2 * d::D, d::NIN, nullptr, nullptr, 0, 1}; st_gemm(g, idx); }
  else if constexpr (ST == P_OUT_L) { const float* res = (l == 0 ? a.x : (const float*)a.out) + (long)b * d::S * d::D;
    GemmArgs g{a.m, d::D, a.w_out + (long)l * d::D * d::D, d::D, a.out + (long)b * d::S * d::D, d::D, d::S, d::D, d::D, nullptr, 0, a.mod + (long)b * 6 * d::D + 2 * d::D, res, d::D, 0}; st_gemm(g, idx); }
  else if constexpr (ST == P_OUT_C) { const float* res = (l == 0 ? a.ctx : (const float*)a.xc) + (long)b * d::C * d::D;
    GemmArgs g{a.m + (long)d::S * d::D, d::D, a.w_out + (long)l * d::D * d::D, d::D, a.xc + (long)b * d::C * d::D, d::D, d::C, d::D, d::D, nullptr, 0, a.mod + (long)d::B * 6 * d::D + 2 * d::D, res, d::D, 0}; st_gemm(g, idx); }
  else if constexpr (ST == P_ROUTER) st_router<T>(a, idx);
  else if constexpr (ST == P_MOEHID) st_moehid<T>(a, l, idx);
  else if constexpr (ST == P_MOEOUT) st_moeout<T>(a, l, b, idx);
}

template <class T> inline size_t carve(NaiveBufs& a, float* ws) {
  using d = DD<T>; size_t o = 0; auto take = [&](size_t n) { float* p = ws ? ws + o : nullptr; o += (n + 63) & ~(size_t)63; return p; };
  a.mod = take((size_t)(d::B + 1) * 6 * d::D);
  a.hid2S = take((size_t)d::S * d::HF); a.hid2C = take((size_t)d::C * d::HF);
  a.tapsS = take((size_t)2 * 2 * d::S * d::HW); a.tapsC = take((size_t)2 * 2 * d::C * d::HW);
  a.nrmS = take(2 * d::HW); a.nrmC = take(2 * d::HW);
  a.rs = take(d::R); a.h = take((size_t)d::R * d::D); a.proj = take((size_t)d::R * d::NIN);
  a.qn = take((size_t)d::R * d::AQW); a.kn = take((size_t)d::R * d::AKVW);
  a.uc = take((size_t)d::R * 3 * d::HW); a.z1 = take((size_t)d::R * d::HW); a.yhy = take((size_t)d::R * d::HW);
  a.xc = take((size_t)d::B * d::C * d::D);
#ifdef HOST_TEST
  a.yatt = take((size_t)d::R * d::AQW); a.laf = take((size_t)d::R * d::GKW); a.lab = take((size_t)d::R * d::GKW);
  a.of = take((size_t)d::R * d::GVW); a.ob = take((size_t)d::R * d::GVW); a.ygla = take((size_t)d::R * d::GVW);
  a.m = take((size_t)d::R * d::D); a.ridx = (int*)take((size_t)d::R * 2); a.rw = take((size_t)d::R * 2); a.hid = take((size_t)d::R * 2 * d::DE);
#endif
  return o;
}
template <class T> inline void set_inputs(NaiveBufs& a, const float* const* in) {
  int i = 0;
  a.x = in[i++]; a.c = in[i++]; a.ctx = in[i++]; a.c_ctx = in[i++]; a.w_mod = in[i++]; a.b_mod = in[i++]; a.norm1_g = in[i++]; a.norm2_g = in[i++];
  a.w_in = in[i++]; a.q_norm_g = in[i++]; a.k_norm_g = in[i++]; a.gla_wa2 = in[i++]; a.gla_ba = in[i++]; a.gla_norm_g = in[i++];
  a.hy_conv_w = in[i++]; a.hy_conv_b = in[i++]; a.hy_pos_w1 = in[i++]; a.hy_pos_b1 = in[i++]; a.hy_sin_freq = in[i++]; a.hy_pos_w2 = in[i++];
  a.hy_pos_b2 = in[i++]; a.hy_pos_w3 = in[i++]; a.hy_decay = in[i++]; a.hy_skip = in[i++]; a.w_br_hy = in[i++]; a.w_br_gla = in[i++];
  a.w_br_att = in[i++]; a.w_out = in[i++]; a.router_w = in[i++]; a.router_b = in[i++]; a.moe_w_gate = in[i++]; a.moe_w_up = in[i++]; a.moe_w_down = in[i++];
}

#define LSTAGES(X) X(L_MOD) X(L_HID_S) X(L_HID_C) X(L_TAPS_S) X(L_TAPS_C) X(L_NRM_S) X(L_NRM_C)
#define PSTAGES(X) X(P_RS1) X(P_NORM1) X(P_INPROJ) X(P_QKNORM) X(P_ATTN_L) X(P_ATTN_C) X(P_GLALA) X(P_GLASCAN) X(P_GLAOUT) X(P_HYC3) X(P_HYL0) X(P_HYL1) \
  X(P_MRG_HY) X(P_MRG_GLA) X(P_MRG_ATT) X(P_OUT_L) X(P_OUT_C) X(P_RS2) X(P_NORM2) X(P_ROUTER) X(P_MOEHID) X(P_MOEOUT)
namespace pro {
__device__ __forceinline__ void mod_phase(const NaiveBufs& a, int l, LAS unsigned char* lds) {
  int tz = threadIdx.x; asm volatile("" : "+v"(tz));
  __syncthreads();
  LAS float* sl = (LAS float*)lds; LAS float* part = sl + 9 * 1024;
  for (int e = tz; e < 9 * 1024; e += NTHREADS) { const int bb = e >> 10, k = e & 1023; const float cv = bb < 8 ? a.c[bb * 1024 + k] : a.c_ctx[k]; sl[e] = cv / (1.f + __expf(-cv)); }
  __syncthreads();
  const float* w = a.w_mod + (size_t)l * 1024 * 6144;
  const int jl = tz & 63, ks = tz >> 6;
  for (int cb = blockIdx.x; cb < 96; cb += gridDim.x) { const int j = cb * 64 + jl; float acc[9];
#pragma unroll
    for (int q = 0; q < 9; ++q) acc[q] = 0.f;
#pragma unroll 4
    for (int k = ks * 128; k < ks * 128 + 128; ++k) { const float wv = w[(size_t)k * 6144 + j];
#pragma unroll
      for (int q = 0; q < 9; ++q) acc[q] += sl[q * 1024 + k] * wv; }
#pragma unroll
    for (int q = 0; q < 9; ++q) part[(ks * 9 + q) * 64 + jl] = acc[q];
    __syncthreads();
    for (int e = tz; e < 9 * 64; e += NTHREADS) { const int q = e >> 6, jj = e & 63; float s = a.b_mod[(size_t)l * 6144 + cb * 64 + jj];
#pragma unroll
      for (int k8 = 0; k8 < 8; ++k8) s += part[(k8 * 9 + q) * 64 + jj];
      a.mod[(size_t)q * 6144 + cb * 64 + jj] = s; }
    __syncthreads(); }
  __syncthreads();
}
__device__ __forceinline__ void hid_phase(const NaiveBufs& a, int l, int n, float* dst, LAS unsigned char* lds) {
  int tz = threadIdx.x; asm volatile("" : "+v"(tz));
  LAS float* Z = (LAS float*)(lds + 40960); LAS float* H1 = Z + 8 * 36;
  const float* w1 = a.hy_pos_w1 + (size_t)l * 33 * 64; const float* b1 = a.hy_pos_b1 + l * 64; const float* fr = a.hy_sin_freq + l * 64;
  const float* w2 = a.hy_pos_w2 + (size_t)l * 64 * 64; const float* b2 = a.hy_pos_b2 + l * 64;
  const float w0 = 2.f * 3.14159265358979323846f / (float)n;
  for (int t0 = blockIdx.x * 8; t0 < n; t0 += gridDim.x * 8) {
    if (tz < 8 * 33) { const int tt = tz / 33, e = tz % 33, t = t0 + tt; float v;
      if (e == 0) v = (float)t / (float)n; else { const int bnd = (e - 1) & 15; const float band = 1e-4f + (float)bnd * (15.f - 1e-4f) / 15.f; const float ph = w0 * (float)t * band; v = e <= 16 ? cosf(ph) : -sinf(ph); }
      Z[tt * 36 + e] = v; }
    __syncthreads();
    { const int tt = tz >> 6, i = tz & 63; float acc = b1[i];
#pragma unroll
      for (int e = 0; e < 33; ++e) acc += Z[tt * 36 + e] * w1[e * 64 + i];
      H1[tt * 64 + i] = sinf(fr[i] * acc); }
    __syncthreads();
    { const int tt = tz >> 6, j = tz & 63; float acc = b2[j];
#pragma unroll 8
      for (int i = 0; i < 64; ++i) acc += H1[tt * 64 + i] * w2[i * 64 + j];
      if (t0 + tt < n) dst[(size_t)(t0 + tt) * 64 + j] = sinf(fr[j] * acc); }
    __syncthreads();
  }
}
__device__ __forceinline__ void nrmS_phase(const NaiveBufs& a) {
  int tz = threadIdx.x; asm volatile("" : "+v"(tz)); const int lane = tz & 63, wave = __builtin_amdgcn_readfirstlane(tz >> 6);
  for (int oc = blockIdx.x * NWAVES + wave; oc < 1024; oc += gridDim.x * NWAVES) { const float* tp = a.tapsS + (size_t)oc * 8192; float s = 0.f;
#pragma unroll 8
    for (int k = lane; k < 8192; k += 64) s += fabsf(tp[k]);
    s = moe::wave_sum(s); if (lane == 0) a.nrmS[oc] = s + 1e-6f; }
}
constexpr int TCOPY = 8232;
__device__ __forceinline__ void tapsB_phase(const NaiveBufs& a, int l, bf16_t* tapsB, LAS unsigned char* lds) {
  int tz = threadIdx.x; asm volatile("" : "+v"(tz));
  const float* w3 = a.hy_pos_w3 + (size_t)l * 64 * 2048; const float* dcy = a.hy_decay + (size_t)l * 2048;
  typedef float f4 __attribute__((ext_vector_type(4)));
  LAS float* W = (LAS float*)lds;
  for (int cp = blockIdx.x; cp < 256; cp += gridDim.x) {
    __syncthreads();
    { const int ch = tz >> 8, e = tz & 255, c = cp + 256 * ch; W[tz] = w3[(size_t)(e >> 2) * 2048 + (e & 3) * 512 + c]; if (tz < 8) W[512 + tz] = fabsf(dcy[(tz & 3) * 512 + cp + 256 * (tz >> 2)]); }
    __syncthreads();
    for (int t = tz; t < 4096; t += NTHREADS) {
      const f4* h2 = (const f4*)(a.hid2S + (size_t)t * 64); f4 acc0 = {0.f, 0.f, 0.f, 0.f}, acc1 = {0.f, 0.f, 0.f, 0.f};
#pragma unroll 4
      for (int j4 = 0; j4 < 16; ++j4) { const f4 h = h2[j4];
#pragma unroll
        for (int e = 0; e < 4; ++e) { acc0 += h[e] * *(const LAS f4*)(W + (4 * j4 + e) * 4); acc1 += h[e] * *(const LAS f4*)(W + 256 + (4 * j4 + e) * 4); } }
      const float tn = (float)t * (1.f / 4096.f);
#pragma unroll
      for (int ch = 0; ch < 2; ++ch)
#pragma unroll
        for (int q = 0; q < 4; ++q) { const int o = q >> 1, dir = q & 1; if (dir == 1 && t == 0) continue; const int c = cp + 256 * ch;
          const bf16_t bv = (bf16_t)f2bf((ch ? acc1[q] : acc0[q]) * __expf(-tn * W[512 + 4 * ch + q]));
          bf16_t* base = tapsB + ((size_t)o * 512 + c) * 2 * TCOPY; const int x0 = dir ? 4096 + t : 4096 - t;
          base[x0] = bv; base[TCOPY + x0 - 1] = bv; } } }
  for (long idx = (long)blockIdx.x * NTHREADS + tz; idx < 1024L * 96; idx += (long)gridDim.x * NTHREADS) { const int oc = (int)(idx / 96), e = (int)(idx % 96); bf16_t* base = tapsB + (size_t)oc * 2 * TCOPY;
    if (e < 40) base[8192 + e] = 0; else if (e < 81) base[TCOPY + 8191 + (e - 40)] = 0; else if (e == 81) base[0] = 0; }
}
__device__ __forceinline__ void nrmB_phase(const NaiveBufs& a, const bf16_t* tapsB) {
  int tz = threadIdx.x; asm volatile("" : "+v"(tz)); const int lane = tz & 63, wave = __builtin_amdgcn_readfirstlane(tz >> 6);
  for (int oc = blockIdx.x * NWAVES + wave; oc < 1024; oc += gridDim.x * NWAVES) { const bf16_t* tp = tapsB + (size_t)oc * 2 * TCOPY; float s = 0.f;
#pragma unroll 8
    for (int k = lane; k < 8192; k += 64) s += fabsf(bf2f(tp[k]));
    s = moe::wave_sum(s); if (lane == 0) a.nrmS[oc] = s + 1e-6f; }
}
}
using TD = FullDims;
using dd = DD<TD>;
constexpr int GB = 4, NGRP = 2, RB = dd::R  , RG = GB * RB, PLD = dd::NIN, PANELS = RG / 256, PPB = RB / 256  ;
constexpr size_t BAR_BYTES = 16384 + 4 * 4096; constexpr int CNT_OFF = 16384;
constexpr int MPG = 38912;
constexpr size_t CS_BYTES = (size_t)2 * 4 * 68 * 64 * 128 * 4, DEC_BYTES = (size_t)2 * 4 * 68 * 64 * 4;
constexpr size_t UCT_BYTES = (size_t)1536 * 4096 * 2, YT_BYTES = (size_t)512 * 4096 * 2, UCC_BYTES = (size_t)256 * 1536 * 4, Z1C_BYTES = (size_t)256 * 512 * 4;
constexpr size_t MIX_BYTES = GB * (CS_BYTES + DEC_BYTES) > GB * (UCT_BYTES + YT_BYTES + UCC_BYTES + Z1C_BYTES) ? GB * (CS_BYTES + DEC_BYTES) : GB * (UCT_BYTES + YT_BYTES + UCC_BYTES + Z1C_BYTES);

struct KArgs { NaiveBufs a; unsigned* bar; int* cnt; bf16_t *WinT, *WhyT, *WglaT, *WattT, *WoutT, *WguT, *WdT, *hb, *proj; unsigned char* mix;
  bf16_t *hp, *hid, *contrib; int* srcrow; float* wgt; moe::Route* route; float* wts; };

struct EpiProjBf16 {
  static constexpr bool PERM = true, AFTER_DRAIN = false;
  bf16_t* P;
  __device__ __forceinline__ void operator()(const pg8::f32x4 (&acc)[2][2][4][2], const pg8::Unit& u, int wr, int wc, int fr, int fq) const {
    const int row0 = u.pm * 256 + wr * 64 + fr, col0 = u.pn * 256 + wc * 32 + 8 * fq;
#pragma unroll
    for (int ai = 0; ai < 2; ++ai)
#pragma unroll
      for (int m = 0; m < 4; ++m) { bf16_t* rowp = P + (size_t)(row0 + ai * 128 + m * 16) * PLD + col0;
#pragma unroll
        for (int bj = 0; bj < 2; ++bj) if (col0 + bj * 128 < PLD) { const pg8::f32x4 v0 = acc[ai][bj][m][0], v1 = acc[ai][bj][m][1];
          v4u o; o.x = pk2(v0[0], v0[1]); o.y = pk2(v0[2], v0[3]); o.z = pk2(v1[0], v1[1]); o.w = pk2(v1[2], v1[3]); *(v4u*)(rowp + bj * 128) = o; } }
  }
};
template <bool ACCUM> struct EpiMergeB {
  static constexpr bool PERM = true, AFTER_DRAIN = false;
  const bf16_t* gate; bf16_t* M;
  __device__ __forceinline__ void operator()(const pg8::f32x4 (&acc)[2][2][4][2], const pg8::Unit& u, int wr, int wc, int fr, int fq) const {
    const int row0 = u.pm * 256 + wr * 64 + fr, col0 = u.pn * 256 + wc * 32 + 8 * fq;
#pragma unroll
    for (int ai2 = 0; ai2 < 4; ++ai2) { const int ai = ai2 >> 1, m0 = (ai2 & 1) * 2;
      v4u gw[4][2], mo[4][2];
#pragma unroll
      for (int m = m0; m < m0 + 2; ++m)
#pragma unroll
        for (int bj = 0; bj < 2; ++bj) { const size_t r = (size_t)(row0 + ai * 128 + m * 16); const int c = col0 + bj * 128; gw[m][bj] = *(const v4u*)(gate + r * PLD + c); if (ACCUM) mo[m][bj] = *(const v4u*)(M + r * 1024 + c); }
#pragma unroll
      for (int m = m0; m < m0 + 2; ++m)
#pragma unroll
        for (int bj = 0; bj < 2; ++bj) { const size_t r = (size_t)(row0 + ai * 128 + m * 16); const int c = col0 + bj * 128; const v4u g4 = gw[m][bj];
          pg8::f32x4 v0 = acc[ai][bj][m][0], v1 = acc[ai][bj][m][1];
          v0[0] *= fsigmoid(bf2f(g4.x & 0xffff)); v0[1] *= fsigmoid(bf2f(g4.x >> 16)); v0[2] *= fsigmoid(bf2f(g4.y & 0xffff)); v0[3] *= fsigmoid(bf2f(g4.y >> 16));
          v1[0] *= fsigmoid(bf2f(g4.z & 0xffff)); v1[1] *= fsigmoid(bf2f(g4.z >> 16)); v1[2] *= fsigmoid(bf2f(g4.w & 0xffff)); v1[3] *= fsigmoid(bf2f(g4.w >> 16));
          if (ACCUM) { const v4u o = mo[m][bj]; v0[0] += bf2f(o.x & 0xffff); v0[1] += bf2f(o.x >> 16); v0[2] += bf2f(o.y & 0xffff); v0[3] += bf2f(o.y >> 16);
            v1[0] += bf2f(o.z & 0xffff); v1[1] += bf2f(o.z >> 16); v1[2] += bf2f(o.w & 0xffff); v1[3] += bf2f(o.w >> 16); }
          v4u o2; o2.x = pk2(v0[0], v0[1]); o2.y = pk2(v0[2], v0[3]); o2.z = pk2(v1[0], v1[1]); o2.w = pk2(v1[2], v1[3]); *(v4u*)(M + r * 1024 + c) = o2; } }
  }
};
struct EpiOutG {
  static constexpr bool PERM = false, AFTER_DRAIN = false;
  const float* resL; float* outL; const float* resC; float* outC; const float* mod; int b0; bool ctx_on;
  __device__ __forceinline__ void operator()(const pg8::f32x4 (&acc)[2][2][4][2], const pg8::Unit& u, int wr, int wc, int fr, int fq) const {
    const int bl = u.pm / PPB, lp = u.pm % PPB; const bool isc = lp == PPB - 1; if (isc && !ctx_on) return;
    const int b = b0 + bl;
    const float* res = isc ? resC + (size_t)b * dd::C * 1024 : resL + ((size_t)b * dd::S + lp * 256) * 1024;
    float* out = isc ? outC + (size_t)b * dd::C * 1024 : outL + ((size_t)b * dd::S + lp * 256) * 1024;
    const float* gv = mod + (size_t)(isc ? dd::B : b) * 6 * 1024 + 2 * 1024;
    const int row0 = wr * 64 + fr, col0 = u.pn * 256 + wc * 32 + 4 * fq;
    pg8::f32x4 gg[2][2];
#pragma unroll
    for (int bj = 0; bj < 2; ++bj)
#pragma unroll
      for (int n = 0; n < 2; ++n) gg[bj][n] = *(const pg8::f32x4*)(gv + col0 + bj * 128 + n * 16);
#pragma unroll
    for (int ai2 = 0; ai2 < 4; ++ai2) { const int ai = ai2 >> 1, m0 = (ai2 & 1) * 2;
      pg8::f32x4 rv[4][2][2];
#pragma unroll
      for (int m = m0; m < m0 + 2; ++m)
#pragma unroll
        for (int bj = 0; bj < 2; ++bj)
#pragma unroll
          for (int n = 0; n < 2; ++n) rv[m][bj][n] = *(const pg8::f32x4*)(res + (size_t)(row0 + ai * 128 + m * 16) * 1024 + col0 + bj * 128 + n * 16);
#pragma unroll
      for (int m = m0; m < m0 + 2; ++m)
#pragma unroll
        for (int bj = 0; bj < 2; ++bj)
#pragma unroll
          for (int n = 0; n < 2; ++n) *(pg8::f32x4*)(out + (size_t)(row0 + ai * 128 + m * 16) * 1024 + col0 + bj * 128 + n * 16) = rv[m][bj][n] + gg[bj][n] * acc[ai][bj][m][n]; }
  }
};
struct GroupOrder {
  int nN, nwg, G, c; bool lat;
  __device__ void init(int N, int G_, int c_, bool lat_) { nN = N / 256; lat = lat_; nwg = (lat ? GB * 16 : PANELS) * nN; G = G_; c = c_; }
  __device__ __forceinline__ bool next(int i, pg8::Unit& u) const { const long L = (long)i * G + c; if (L >= nwg) return false; const int p = (int)L / nN; u.pm = lat ? (p >> 4) * PPB + (p & 15) : p; u.pn = (int)L % nN; u.acol = 0; return true; }
  __device__ __forceinline__ void a_ready(const pg8::Unit&) const {}
  __device__ __forceinline__ void done(const pg8::Unit&) const {}
};
struct MergeOrder {
  int ntiles, G, c; bool lat;
  __device__ void init(int G_, int c_, bool lat_) { lat = lat_; ntiles = (lat ? GB * 16 : PANELS) * 4; G = G_; c = c_; }
  __device__ __forceinline__ bool next(int i, pg8::Unit& u) const { const int rnd = i >> 2, gi = i & 3; const long tile = (long)rnd * G + c; if (tile >= ntiles) return false; const int p = (int)tile >> 2;
    u.pm = lat ? (p >> 4) * PPB + (p & 15) : p; u.pn = gi * 4 + ((int)tile & 3); u.acol = gi == 0 ? dd::O_HY : gi == 1 ? dd::O_OG : gi == 2 ? dd::O_AQ : dd::O_AQ + 512; return true; }
  __device__ __forceinline__ void a_ready(const pg8::Unit&) const {}
  __device__ __forceinline__ void done(const pg8::Unit&) const {}
};
struct EpiMergeS {
  static constexpr bool PERM = true, AFTER_DRAIN = false;
  const bf16_t* gate0; bf16_t* M;
  __device__ __forceinline__ void operator()(const pg8::f32x4 (&acc)[2][2][4][2], const pg8::Unit& u, int wr, int wc, int fr, int fq) const {
    const int gi = u.pn >> 2; const bool accum = gi > 0; const bf16_t* gate = gate0 + (gi > 2 ? 2 : gi) * 1024;
    const int row0 = u.pm * 256 + wr * 64 + fr, col0 = (u.pn & 3) * 256 + wc * 32 + 8 * fq;
#pragma unroll
    for (int ai = 0; ai < 2; ++ai)
#pragma unroll
      for (int m = 0; m < 4; ++m) { const size_t r = (size_t)(row0 + ai * 128 + m * 16);
#pragma unroll
        for (int bj = 0; bj < 2; ++bj) { const int c = col0 + bj * 128; const v4u gw = *(const v4u*)(gate + r * PLD + c);
          pg8::f32x4 v0 = acc[ai][bj][m][0], v1 = acc[ai][bj][m][1];
          v0[0] *= fsigmoid(bf2f(gw.x & 0xffff)); v0[1] *= fsigmoid(bf2f(gw.x >> 16)); v0[2] *= fsigmoid(bf2f(gw.y & 0xffff)); v0[3] *= fsigmoid(bf2f(gw.y >> 16));
          v1[0] *= fsigmoid(bf2f(gw.z & 0xffff)); v1[1] *= fsigmoid(bf2f(gw.z >> 16)); v1[2] *= fsigmoid(bf2f(gw.w & 0xffff)); v1[3] *= fsigmoid(bf2f(gw.w >> 16));
          v4u* dst = (v4u*)(M + r * 1024 + c);
          if (accum) { const v4u o = *dst; v0[0] += bf2f(o.x & 0xffff); v0[1] += bf2f(o.x >> 16); v0[2] += bf2f(o.y & 0xffff); v0[3] += bf2f(o.y >> 16);
            v1[0] += bf2f(o.z & 0xffff); v1[1] += bf2f(o.z >> 16); v1[2] += bf2f(o.w & 0xffff); v1[3] += bf2f(o.w >> 16); }
          v4u o2; o2.x = pk2(v0[0], v0[1]); o2.y = pk2(v0[2], v0[3]); o2.z = pk2(v1[0], v1[1]); o2.w = pk2(v1[2], v1[3]); *dst = o2; } }
  }
};
__device__ __forceinline__ const float* xrow_in(const NaiveBufs& a, int l, int b, int r) {
  if (r < dd::S) return (l == 0 ? a.x : (const float*)a.out) + ((size_t)b * dd::S + r) * 1024;
  return (l == 0 ? a.ctx : (const float*)a.xc) + ((size_t)b * dd::C + (r - dd::S)) * 1024;
}
__device__ __forceinline__ float* xrow_cur(const NaiveBufs& a, int b, int r) {
  if (r < dd::S) return a.out + ((size_t)b * dd::S + r) * 1024;
  return a.xc + ((size_t)b * dd::C + (r - dd::S)) * 1024;
}
__device__ __forceinline__ void norm_row(const float* xr, const float* gnorm, const float* shift, const float* scale, bf16_t* hrow, int lane) {
  typedef float f4 __attribute__((ext_vector_type(4)));
  f4 xv[4]; float ss = 0.f;
#pragma unroll
  for (int j = 0; j < 4; ++j) { xv[j] = *(const f4*)(xr + 4 * lane + 256 * j); ss += xv[j][0] * xv[j][0] + xv[j][1] * xv[j][1] + xv[j][2] * xv[j][2] + xv[j][3] * xv[j][3]; }
  const float rs = 1.f / sqrtf(moe::wave_sum(ss) * (1.f / 1024.f) + 1e-6f);
#pragma unroll
  for (int j = 0; j < 4; ++j) { const int c = 4 * lane + 256 * j; const f4 g4 = *(const f4*)(gnorm + c), sh = *(const f4*)(shift + c), sc = *(const f4*)(scale + c);
    f4 h;
#pragma unroll
    for (int i = 0; i < 4; ++i) h[i] = xv[j][i] * rs * g4[i] * (1.f + sc[i]) + sh[i];
    *(unsigned long long*)(hrow + c) = (unsigned long long)pk2(h[0], h[1]) | ((unsigned long long)pk2(h[2], h[3]) << 32); }
}
__device__ __forceinline__ void qknorm_row(bf16_t* prow, const float* qg, const float* kg, int r, int lane) {
  const bool lat = r < dd::S; const int grow = r / dd::GW, gcol = r % dd::GW;
  const int fi = lane & 31; const float pos = (lane < 32) ? (float)grow : (float)gcol;
  const float ang = pos * __builtin_amdgcn_exp2f(-(float)fi * (13.287712379549449f / 32.f));
  const float cs = lat ? __cosf(ang) : 1.f, sn = lat ? __sinf(ang) : 0.f;
  unsigned wv[10];
#pragma unroll
  for (int hh = 0; hh < 10; ++hh) wv[hh] = *((const unsigned*)(prow + (hh < 8 ? dd::O_AQ + hh * 128 : dd::O_AK + (hh - 8) * 128)) + lane);
  float ss[10];
#pragma unroll
  for (int hh = 0; hh < 10; ++hh) { const float x1 = bf2f(wv[hh] & 0xffff), x2 = bf2f(wv[hh] >> 16); ss[hh] = x1 * x1 + x2 * x2; }
#pragma unroll
  for (int o = 1; o < 64; o <<= 1) {
#pragma unroll
    for (int hh = 0; hh < 10; ++hh) ss[hh] += __shfl_xor(ss[hh], o); }
  const float q1 = qg[2 * lane], q2 = qg[2 * lane + 1], k1 = kg[2 * lane], k2 = kg[2 * lane + 1];
#pragma unroll
  for (int hh = 0; hh < 10; ++hh) { unsigned* p = (unsigned*)(prow + (hh < 8 ? dd::O_AQ + hh * 128 : dd::O_AK + (hh - 8) * 128)) + lane;
    const float x1 = bf2f(wv[hh] & 0xffff), x2 = bf2f(wv[hh] >> 16); const float rs = 1.f / sqrtf(ss[hh] * (1.f / 128.f) + 1e-6f);
    const float y1 = x1 * rs * (hh < 8 ? q1 : k1), y2 = x2 * rs * (hh < 8 ? q2 : k2);
    *p = pk2(y1 * cs - y2 * sn, y1 * sn + y2 * cs); }
}

__global__ void __launch_bounds__(NTHREADS, 2) mega_kernel(KArgs ka_unused) {
  extern __shared__ __attribute__((aligned(16))) unsigned char lds_raw[];
  LAS unsigned char* lds = (LAS unsigned char*)lds_raw;
  volatile LAS unsigned* MISC = (volatile LAS unsigned*)(lds + MISC_OFF);
  constexpr int ARGS_OFF = MISC_OFF + 256;
  static_assert(ARGS_OFF + sizeof(KArgs) <= LDS_BYTES, "LDS map");
  { const unsigned __attribute__((address_space(4)))* kp = (const unsigned __attribute__((address_space(4)))*)__builtin_amdgcn_kernarg_segment_ptr();
    for (int i = threadIdx.x; i < (int)(sizeof(KArgs) / 4); i += NTHREADS) ((LAS unsigned*)(lds + ARGS_OFF))[i] = kp[i]; }
  if (threadIdx.x < 64) MISC[threadIdx.x] = 0u;
  __syncthreads();
  const KArgs& ka = *(const KArgs*)(const LAS KArgs*)(lds + ARGS_OFF);
  const NaiveBufs& a = ka.a;
  unsigned* bar_s; { const unsigned long long bp = (unsigned long long)ka.bar; const unsigned lo_ = __builtin_amdgcn_readfirstlane((unsigned)bp), hi_ = __builtin_amdgcn_readfirstlane((unsigned)(bp >> 32));
    bar_s = (unsigned*)(((unsigned long long)hi_ << 32) | lo_); }
  XcdBarrier xb = xcd_barrier_post(bar_s, MISC);
#define SPTR(T, name, src) T* name; { const unsigned long long bp_ = (unsigned long long)(src); const unsigned lo_ = __builtin_amdgcn_readfirstlane((unsigned)bp_), hi_ = __builtin_amdgcn_readfirstlane((unsigned)(bp_ >> 32)); name = (T*)(((unsigned long long)hi_ << 32) | lo_); }
  SPTR(bf16_t, proj_s, ka.proj) SPTR(bf16_t, hb_s, ka.hb) SPTR(unsigned char, mix_s, ka.mix)
  const long gs = (long)gridDim.x * NTHREADS;
  LAS int* poff = (LAS int*)(lds + MISC_OFF + 64);
#define TID_SETUP int tz = threadIdx.x; asm volatile("" : "+v"(tz)); const int lane = tz & 63, wave = __builtin_amdgcn_readfirstlane(tz >> 6); \
    const int gw = blockIdx.x * NWAVES + wave, NGW = gridDim.x * NWAVES; const long gt = (long)blockIdx.x * NTHREADS + tz; (void)lane; (void)gw; (void)NGW; (void)gt;
#define LSTAGE(ST) { TID_SETUP const long n_ = stage_items<TD>(ST, l); for (long i_ = gt; i_ < n_; i_ += gs) stage_run<TD, ST>(a, l, 0, i_); }
  for (int l = 0; l < dd::DEPTH; ++l) {
    const bool last = (l == dd::DEPTH - 1);
    { TID_SETUP
      LAS float* scr = (LAS float*)(lds + RING_OFF + wave * 16384);
      constexpr int NIT = (dd::D / 64) * (dd::NIN / 32);
      for (int it = gw; it < NIT; it += NGW) transpose_item(a.w_in + (size_t)l * dd::D * dd::NIN, dd::D, dd::NIN, ka.WinT, 0, scr, it, lane);
      { constexpr int I0 = (dd::HW / 64) * (dd::D / 32), I1 = (dd::GVW / 64) * (dd::D / 32), I2 = (dd::AQW / 64) * (dd::D / 32), I3 = (dd::D / 64) * (dd::D / 32);
        for (int it = gw; it < I0 + I1 + I2 + I3; it += NGW) { int r = it;
          if (r < I0) { transpose_item(a.w_br_hy + (size_t)l * dd::HW * dd::D, dd::HW, dd::D, ka.WhyT, 0, scr, r, lane); continue; } r -= I0;
          if (r < I1) { transpose_item(a.w_br_gla + (size_t)l * dd::GVW * dd::D, dd::GVW, dd::D, ka.WglaT, 0, scr, r, lane); continue; } r -= I1;
          if (r < I2) { transpose_item(a.w_br_att + (size_t)l * dd::AQW * dd::D, dd::AQW, dd::D, ka.WattT, 0, scr, r, lane); continue; } r -= I2;
          transpose_item(a.w_out + (size_t)l * dd::D * dd::D, dd::D, dd::D, ka.WoutT, 0, scr, r, lane); } }
      { constexpr int IG = (dd::D / 64) * (dd::DE / 32), IDN = (dd::DE / 64) * (dd::D / 32);
        for (int it = gw; it < dd::NE * (2 * IG + IDN); it += NGW) { const int e = it / (2 * IG + IDN); int r = it % (2 * IG + IDN);
          if (r < 2 * IG) { const int up = r >= IG; if (up) r -= IG; const int n0 = 32 * (r % (dd::DE / 32));
            transpose_item((up ? a.moe_w_up : a.moe_w_gate) + ((size_t)l * dd::NE + e) * dd::D * dd::DE, dd::D, dd::DE, ka.WguT, e * 1024 + 128 * (n0 >> 7) + (up ? 128 : 0), scr, r, lane); }
          else { r -= 2 * IG; transpose_item(a.moe_w_down + ((size_t)l * dd::NE + e) * dd::DE * dd::D, dd::DE, dd::D, ka.WdT, e * 1024, scr, r, lane); } } }
      for (long i = gt; i < (long)(NINP - dd::NIN) * dd::D / 8; i += gs) { unsigned z_ = 0u; asm volatile("" : "+v"(z_)); *(v4u*)(ka.WinT + (size_t)dd::NIN * dd::D + i * 8) = (v4u){z_, z_, z_, z_}; }
    }
    pro::mod_phase(a, l, lds); pro::hid_phase(a, l, dd::S, a.hid2S, lds); if (!last) pro::hid_phase(a, l, dd::C, a.hid2C, lds);
    xcd_barrier(xb);
    pro::tapsB_phase(a, l, (bf16_t*)a.tapsS, lds); if (!last) LSTAGE(L_TAPS_C)
    xcd_barrier(xb);
    pro::nrmB_phase(a, (const bf16_t*)a.tapsS); if (!last) LSTAGE(L_NRM_C)
    xcd_barrier(xb);
    for (int grp = 0; grp < NGRP; ++grp) {
      const int b0 = grp * GB;
      { TID_SETUP
        for (int rg = gw; rg < RG; rg += NGW) { const int bl = rg / RB, r = rg % RB, b = b0 + bl; const float* md = a.mod + (size_t)(r < dd::S ? b : dd::B) * 6 * 1024;
          norm_row(xrow_in(a, l, b, r), a.norm1_g + (size_t)l * 1024, md, md + 1024, hb_s + (size_t)rg * 1024, lane); }
        xcd_barrier(xb); }
      { pg8::Gemm g{hb_s, ka.WinT, RG, NINP, dd::D, 0}; pg8::StaticOrder S; S.init(RG, NINP, (int)gridDim.x, (int)blockIdx.x); EpiProjBf16 E{proj_s};
        pg8::gemm_phase<EpiProjBf16, pg8::StaticOrder, false>((PG8_LAS unsigned char*)(lds + RING_OFF), g, S, E, nullptr);
        xcd_barrier(xb); }
      { TID_SETUP
        for (int rg = gw; rg < RG; rg += NGW) qknorm_row(proj_s + (size_t)rg * PLD, a.q_norm_g + (size_t)l * 128, a.k_norm_g + (size_t)l * 128, rg % RB, lane);
        for (int u = blockIdx.x; u < GB * 4 * 68; u += gridDim.x) { const int bl = u / (4 * 68), hu = u % (4 * 68); const bf16_t* pb = proj_s + (size_t)bl * RB * PLD;
          gla::In gp; gp.q = pb + dd::O_GQ; gp.k = pb + dd::O_GK; gp.v = pb + dd::O_GV; gp.ga = pb + dd::O_GA; gp.og = pb + dd::O_OG; gp.ld = PLD;
          gp.wa2 = a.gla_wa2 + (size_t)l * 2 * 16 * 256; gp.ba = a.gla_ba + (size_t)l * 2 * 256; gp.gnorm = a.gla_norm_g + (size_t)l * 128;
          gp.cs = (float*)(mix_s + (size_t)bl * CS_BYTES); gp.dec = (float*)(mix_s + (size_t)GB * CS_BYTES + (size_t)bl * DEC_BYTES); gp.y = (bf16_t*)pb + dd::O_OG; gp.ldy = PLD; gp.S = dd::S; gp.C = dd::C;
          gla::g1_unit(gp, lds, hu / 68, hu % 68, 4, 68); }
        xcd_barrier(xb); }
      { TID_SETUP
        for (long i_ = gt; i_ < (long)GB * 2 * 4 * 64 * 128; i_ += gs) { const int bl = (int)(i_ / (2 * 4 * 64 * 128)); gla::In gp; gp.cs = (float*)(mix_s + (size_t)bl * CS_BYTES); gp.dec = (float*)(mix_s + (size_t)GB * CS_BYTES + (size_t)bl * DEC_BYTES); gp.S = dd::S; gp.C = dd::C;
          gla::g2_item(gp, i_ % (2 * 4 * 64 * 128), 4, 68); }
        const int combo = blockIdx.x & 7, slot = blockIdx.x >> 3, nslot = gridDim.x >> 3;
        const int per_combo = 64 + (last ? 0 : 4);
        const bool xcdm = (gridDim.x & 7) == 0;
        for (int uu = xcdm ? slot : (int)blockIdx.x; uu < (xcdm ? per_combo : 8 * per_combo); uu += xcdm ? nslot : (int)gridDim.x) { const int cmb = xcdm ? combo : uu / per_combo, ui = xcdm ? uu : uu % per_combo;
          const bool lat = ui < 64; const int bl = cmb >> 1, kvh = cmb & 1;
          const int head = kvh * 4 + (lat ? ui >> 4 : ui - 64), qb = lat ? ui & 15 : 0;
          bf16_t* pb = proj_s + (size_t)bl * RB * PLD; const size_t qrow = lat ? (size_t)qb * 256 : (size_t)dd::S, krow = lat ? 0 : (size_t)dd::S;
          att::attn_dense_body<att::bf16, PLD, PLD, 1024, true>((const att::bf16*)(pb + qrow * PLD + dd::O_AQ + head * 128), (const att::bf16*)(pb + krow * PLD + dd::O_AK + kvh * 128),
              (const att::bf16*)(pb + krow * PLD + dd::O_AV + kvh * 128), hb_s + ((size_t)bl * RB + qrow) * 1024 + head * 128, lat ? RB : dd::C, (char*)lds_raw);
          __syncthreads(); }
        xcd_barrier(xb); }
      { const int n3 = last ? 64 : 68;
        for (int u = blockIdx.x; u < GB * 4 * n3; u += gridDim.x) { const int bl = u / (4 * n3), hu = u % (4 * n3); const bf16_t* pb = proj_s + (size_t)bl * RB * PLD;
          gla::In gp; gp.q = pb + dd::O_GQ; gp.k = pb + dd::O_GK; gp.v = pb + dd::O_GV; gp.ga = pb + dd::O_GA; gp.og = pb + dd::O_OG; gp.ld = PLD;
          gp.wa2 = a.gla_wa2 + (size_t)l * 2 * 16 * 256; gp.ba = a.gla_ba + (size_t)l * 2 * 256; gp.gnorm = a.gla_norm_g + (size_t)l * 128;
          gp.cs = (float*)(mix_s + (size_t)bl * CS_BYTES); gp.dec = (float*)(mix_s + (size_t)GB * CS_BYTES + (size_t)bl * DEC_BYTES); gp.y = (bf16_t*)pb + dd::O_OG; gp.ldy = PLD; gp.S = dd::S; gp.C = dd::C;
          gla::g3_unit(gp, lds, hu / n3, hu % n3, 4, 68); }
        xcd_barrier(xb); }
      {
        bf16_t* ucT0 = (bf16_t*)mix_s; bf16_t* yT0 = (bf16_t*)(mix_s + GB * UCT_BYTES); float* ucc0 = (float*)(mix_s + GB * (UCT_BYTES + YT_BYTES)); float* z1c0 = (float*)(mix_s + GB * (UCT_BYTES + YT_BYTES + UCC_BYTES));
        const float* cw = a.hy_conv_w + (size_t)l * 3 * 1536; const float* cb = a.hy_conv_b + (size_t)l * 1536; const float* skp = a.hy_skip + (size_t)l * 2 * 512;
        { TID_SETUP
        { int t_ = blockIdx.x; hy::H0Regs hr = hy::h0_load(proj_s + (size_t)(t_ / (64 * 24)) * RB * PLD + dd::O_HY, PLD, t_ % (64 * 24), tz);
          for (; t_ < GB * 64 * 24; t_ += gridDim.x) { const int bl = t_ / (64 * 24), tn_ = t_ + gridDim.x; hy::H0Regs hn = hr;
            if (tn_ < GB * 64 * 24) hn = hy::h0_load(proj_s + (size_t)(tn_ / (64 * 24)) * RB * PLD + dd::O_HY, PLD, tn_ % (64 * 24), tz);
            hy::h0_compute(hr, cw, cb, ucT0 + (size_t)bl * 1536 * 4096, t_ % (64 * 24), lds, tz); hr = hn; } }
        if (!last) for (long i_ = gt; i_ < (long)GB * 256 * 1536; i_ += gs) { const int bl = (int)(i_ / (256 * 1536)); hy::cconv3_item(proj_s + ((size_t)bl * RB + dd::S) * PLD + dd::O_HY, PLD, cw, cb, ucc0 + (size_t)bl * 256 * 1536, i_ % (256 * 1536)); } }
        xcd_barrier(xb);
        { TID_SETUP
        for (int u = blockIdx.x; u < GB * 512; u += gridDim.x) { const int bl = u / 512; hy::h1b_unit(ucT0 + (size_t)bl * 1536 * 4096, (const bf16_t*)a.tapsS, a.nrmS, skp, yT0 + (size_t)bl * 512 * 4096, u % 512, lds); }
        if (!last) for (long i_ = gt; i_ < (long)GB * 32 * 512; i_ += gs) { const int bl = (int)(i_ / (32 * 512)); hy::clong_item(ucc0 + (size_t)bl * 256 * 1536, nullptr, z1c0 + (size_t)bl * 256 * 512, nullptr, 0, a.tapsC, a.nrmC, skp, 0, i_ % (32 * 512)); } }
        xcd_barrier(xb);
        { TID_SETUP
        for (int t_ = blockIdx.x; t_ < GB * 64 * 8; t_ += gridDim.x) { const int bl = t_ / (64 * 8); hy::h2_tile(yT0 + (size_t)bl * 512 * 4096, proj_s + (size_t)bl * RB * PLD + dd::O_HY, PLD, t_ % (64 * 8), lds); }
        if (!last) for (long i_ = gt; i_ < (long)GB * 32 * 512; i_ += gs) { const int bl = (int)(i_ / (32 * 512)); hy::clong_item(ucc0 + (size_t)bl * 256 * 1536, z1c0 + (size_t)bl * 256 * 512, nullptr, proj_s + ((size_t)bl * RB + dd::S) * PLD + dd::O_HY, PLD, a.tapsC, a.nrmC, skp, 1, i_ % (32 * 512)); } }
        xcd_barrier(xb); }
      { { pg8::Gemm g{proj_s + dd::O_HY, ka.WhyT, RG, 1024, 512, PLD}; GroupOrder S; S.init(1024, (int)gridDim.x, (int)blockIdx.x, last);
          EpiMergeB<false> E{proj_s + dd::O_BR, (bf16_t*)mix_s}; pg8::gemm_phase<EpiMergeB<false>, GroupOrder, false>((PG8_LAS unsigned char*)(lds + RING_OFF), g, S, E, nullptr); }
        for (int gi = 1; gi < 3; ++gi) { const bool at = gi == 2;
          pg8::Gemm g{at ? (const bf16_t*)hb_s : (const bf16_t*)(proj_s + dd::O_OG), at ? ka.WattT : ka.WglaT, RG, 1024, at ? 1024 : 512, at ? 1024 : PLD}; GroupOrder S; S.init(1024, (int)gridDim.x, (int)blockIdx.x, last);
          EpiMergeB<true> E{proj_s + dd::O_BR + gi * 1024, (bf16_t*)mix_s}; pg8::gemm_phase<EpiMergeB<true>, GroupOrder, false>((PG8_LAS unsigned char*)(lds + RING_OFF), g, S, E, nullptr); }
        xcd_barrier(xb);
        pg8::Gemm g{(const bf16_t*)mix_s, ka.WoutT, RG, 1024, 1024, 0}; GroupOrder S; S.init(1024, (int)gridDim.x, (int)blockIdx.x, last);
        EpiOutG E{l == 0 ? a.x : (const float*)a.out, a.out, l == 0 ? a.ctx : (const float*)a.xc, a.xc, a.mod, b0, !last};
        pg8::gemm_phase<EpiOutG, GroupOrder, false>((PG8_LAS unsigned char*)(lds + RING_OFF), g, S, E, nullptr);
        xcd_barrier(xb); }
      {
        { TID_SETUP int* cnt = ka.cnt + (l * NGRP + grp) * 1024;
          LAS float* rwT = (LAS float*)(lds + RING_OFF);
          for (int k = tz; k < 1024; k += NTHREADS) {
#pragma unroll
            for (int e = 0; e < 16; ++e) rwT[e * 1024 + k] = a.router_w[(size_t)k * 16 + e]; }
          __syncthreads();
          LAS int* lcnt = (LAS int*)(lds + RING_OFF + 65536);
          if (tz < 32) lcnt[tz] = 0;
          __syncthreads();
          for (int rg = gw; rg < RG; rg += NGW) { const int bl = rg / RB, r = rg % RB, b = b0 + bl; if (last && r >= dd::S) continue; const float* md = a.mod + (size_t)(r < dd::S ? b : dd::B) * 6 * 1024;
            moe::route_row(xrow_cur(a, b, r), a.norm2_g + (size_t)l * 1024, md + 3 * 1024, md + 4 * 1024, hb_s + (size_t)rg * 1024, rwT, a.router_b, lcnt, ka.route + rg, ka.wts + 2 * rg, lane); }
          __syncthreads();
          if (tz < 16) lcnt[16 + tz] = atomicAdd(cnt + tz * 64, lcnt[tz]);
          __syncthreads();
          for (int rg = gw; rg < RG; rg += NGW) { if (last && (rg % RB) >= dd::S) continue; moe::Route* rt = ka.route + rg; if (lane == 0) { moe::Route r_ = *rt; r_.r0 += lcnt[16 + r_.e0]; r_.r1 += lcnt[16 + r_.e1]; *rt = r_; } }
          xcd_barrier(xb); }
        { TID_SETUP int* cnt = ka.cnt + (l * NGRP + grp) * 1024;
          if (tz == 0) { int acc_ = 0; for (int e = 0; e < 16; ++e) { poff[e] = acc_; acc_ += (cnt[e * 64] + 255) >> 8; } poff[16] = acc_; }
          __syncthreads();
          for (int rg = gw; rg < RG; rg += NGW) { if (last && (rg % RB) >= dd::S) continue; const moe::Route rt = ka.route[rg];
            const v4u h0 = *(const v4u*)(hb_s + (size_t)rg * 1024 + lane * 16), h1 = *(const v4u*)(hb_s + (size_t)rg * 1024 + lane * 16 + 8);
#pragma unroll
            for (int sl = 0; sl < 2; ++sl) { const int e = sl ? rt.e1 : rt.e0, rk = sl ? rt.r1 : rt.r0; const size_t dst = (size_t)poff[e] * 256 + rk;
              *(v4u*)(ka.hp + dst * 1024 + lane * 16) = h0; *(v4u*)(ka.hp + dst * 1024 + lane * 16 + 8) = h1;
              if (lane == 0) { ka.srcrow[dst] = 2 * rg + sl; ka.wgt[dst] = ka.wts[2 * rg + sl]; } } }
          for (int e = 0; e < 16; ++e) { const int c_ = cnt[e * 64], pe = ((c_ + 255) >> 8) << 8; for (int p_ = c_ + (int)gt; p_ < pe; p_ += (int)gs) ka.srcrow[(size_t)poff[e] * 256 + p_] = -1; }
          xcd_barrier(xb); }
        { pg8::Gemm g{ka.hp, ka.WguT, 0, 0, 1024, 0}; moe::MoeOrder S{(int)gridDim.x, (int)blockIdx.x, 4, poff}; moe::EpiGU E{ka.hid};
          pg8::gemm_phase<moe::EpiGU, moe::MoeOrder, false>((PG8_LAS unsigned char*)(lds + RING_OFF), g, S, E, nullptr);
          xcd_barrier(xb); }
        { pg8::Gemm g{ka.hid, ka.WdT, 0, 0, 512, 0}; moe::MoeOrder S{(int)gridDim.x, (int)blockIdx.x, 4, poff}; moe::EpiDown E{ka.srcrow, ka.wgt, ka.contrib, (size_t)RG * 1024};
          pg8::gemm_phase<moe::EpiDown, moe::MoeOrder, false>((PG8_LAS unsigned char*)(lds + RING_OFF), g, S, E, nullptr);
          xcd_barrier(xb); }
        { TID_SETUP
#pragma unroll 4
          for (long i_ = gt; i_ < (long)RG * 256; i_ += gs) { const int rg = (int)(i_ >> 8), c4 = (int)(i_ & 255) * 4; const int bl = rg / RB, r = rg % RB, b = b0 + bl; if (last && r >= dd::S) continue;
            float* xr = xrow_cur(a, b, r) + c4; const float* g2 = a.mod + (size_t)(r < dd::S ? b : dd::B) * 6 * 1024 + 5 * 1024 + c4;
            const unsigned long long u0 = *(const unsigned long long*)(ka.contrib + (size_t)rg * 1024 + c4), u1 = *(const unsigned long long*)(ka.contrib + (size_t)RG * 1024 + (size_t)rg * 1024 + c4);
            pg8::f32x4 xv = *(pg8::f32x4*)xr; const pg8::f32x4 gv = *(const pg8::f32x4*)g2;
#pragma unroll
            for (int e = 0; e < 4; ++e) xv[e] += gv[e] * (bf2f((bf16_t)(u0 >> (16 * e))) + bf2f((bf16_t)(u1 >> (16 * e))));
            *(pg8::f32x4*)xr = xv; }
          xcd_barrier(xb); }
      }
    }
  }
}
extern "C" void kernel_launch(void* const* d_in, const int* in_sizes, int n_in, void* d_out, int out_size, void* d_ws, size_t ws_size, hipStream_t stream) {
  static int grid = 0;
  if (!grid) {
    int dev = 0, cus = 0, per_cu = 0;
    (void)hipGetDevice(&dev); (void)hipDeviceGetAttribute(&cus, hipDeviceAttributeMultiprocessorCount, dev);
    (void)hipFuncSetAttribute((const void*)mega_kernel, hipFuncAttributeMaxDynamicSharedMemorySize, LDS_BYTES);
    (void)hipOccupancyMaxActiveBlocksPerMultiprocessor(&per_cu, mega_kernel, NTHREADS, LDS_BYTES);
    if (per_cu < 1) fprintf(stderr, "occupancy query says %d\n", per_cu);
    grid = cus;
  }
  KArgs ka{}; const float* ptrs[33]; for (int i = 0; i < 33; ++i) ptrs[i] = (const float*)d_in[i];
  set_inputs<TD>(ka.a, ptrs);
  char* wsb = (char*)d_ws; size_t off = BAR_BYTES;
  auto take = [&](size_t bytes) { char* p = wsb + off; off += (bytes + 255) & ~(size_t)255; return p; };
  NaiveBufs& a = ka.a;
  a.mod = (float*)take((size_t)(dd::B + 1) * 6 * 1024 * 4); a.hid2S = (float*)take((size_t)dd::S * 64 * 4); a.hid2C = (float*)take((size_t)dd::C * 64 * 4);
  a.tapsS = (float*)take((size_t)2 * 512 * 2 * 8232 * 2 + 64); a.tapsC = (float*)take((size_t)2 * 512 * 512 * 4); a.nrmS = (float*)take(1024 * 4); a.nrmC = (float*)take(1024 * 4);
  a.xc = (float*)take((size_t)dd::B * dd::C * 1024 * 4);
  ka.WinT = (bf16_t*)take((size_t)NINP * 1024 * 2); ka.WhyT = (bf16_t*)take((size_t)1024 * 512 * 2); ka.WglaT = (bf16_t*)take((size_t)1024 * 512 * 2); ka.WattT = (bf16_t*)take((size_t)1024 * 1024 * 2);
  ka.WoutT = (bf16_t*)take((size_t)1024 * 1024 * 2); ka.WguT = (bf16_t*)take((size_t)16 * 1024 * 1024 * 2); ka.WdT = (bf16_t*)take((size_t)16 * 1024 * 512 * 2);
  ka.hb = (bf16_t*)take((size_t)RG * 1024 * 2); ka.mix = (unsigned char*)take(MIX_BYTES);
  ka.proj = (bf16_t*)take((size_t)RG * PLD * 2);
  { char* p = (char*)ka.proj; ka.hp = (bf16_t*)p; p += (size_t)MPG * 1024 * 2; ka.hid = (bf16_t*)p; p += (size_t)MPG * 512 * 2; ka.contrib = (bf16_t*)p; p += (size_t)2 * RG * 1024 * 2;
    ka.srcrow = (int*)p; p += (size_t)MPG * 4; ka.wgt = (float*)p; p += (size_t)MPG * 4; ka.route = (moe::Route*)p; p += (size_t)RG * 16; ka.wts = (float*)p; p += (size_t)RG * 8;
    if ((size_t)(p - (char*)ka.proj) > (size_t)RG * PLD * 2) fprintf(stderr, "MoE alias region too large\n"); }
  a.out = (float*)d_out; ka.bar = (unsigned*)d_ws; ka.cnt = (int*)(wsb + CNT_OFF);
  if (off > ws_size) fprintf(stderr, "workspace too small: need %zu have %zu\n", off, ws_size);
  (void)hipMemsetAsync(d_ws, 0, BAR_BYTES, stream);
  hipLaunchKernelGGL(mega_kernel, dim3(grid), dim3(NTHREADS), LDS_BYTES, stream, ka);
}
```

```cpp
#include <hip/hip_runtime.h>
#include <cstddef>
#include <cstdio>
#include <cstdint>
#include <hip/hip_bf16.h>
#include <hip/hip_runtime.h>
namespace pg8 {
#define PG8_LAS __attribute__((address_space(3)))
typedef unsigned short bf16_t;
typedef short bf16x8 __attribute__((ext_vector_type(8)));
typedef float f32x4 __attribute__((ext_vector_type(4)));
typedef unsigned u32x4 __attribute__((ext_vector_type(4)));
constexpr int BM = 256, BK = 64, HALF = 128, HTB = HALF * BK * 2  , STAGE_BYTES = 8 * HTB, NXCD = 8, WGM = 8;

__host__ __device__ __forceinline__ int lds_byte(int r, int c) { const int st = (r >> 4) * 2 + (c >> 5), rr = r & 15, cc = c & 31, ob = rr * 64 + cc * 2; return st * 1024 + (ob ^ (((ob >> 9) & 1) << 5)); }
__host__ __device__ __forceinline__ void stage_rc(int b, int& R, int& C) { const int st = b / 1024, sb = b % 1024, swz = sb ^ (((sb >> 9) & 1) << 5); R = (st >> 1) * 16 + swz / 64; C = (st & 1) * 32 + (swz % 64) / 2; }
__host__ __device__ __forceinline__ int perm32(int rho) { const int n = rho >> 4, i = rho & 15; return 8 * (i >> 2) + 4 * n + (i & 3); }

struct Unit { int pm, pn, acol; };
struct Gemm { const bf16_t* A; const bf16_t* Bt; int M, N, K; int lda; };

struct StaticOrder {
    int nM, nN, nwg, G, c;
    __host__ __device__ void init(int M, int N, int G_, int c_) { nM = M / BM; nN = N / BM; nwg = nM * nN; G = G_; c = c_; }
    __host__ __device__ bool next(int i, Unit& u) const {
        const long L = (long)i * G + c; if (L >= nwg) return false;
        int wgid = (int)L; { const int q = nwg / NXCD, r = nwg % NXCD, xcd = wgid % NXCD, off = wgid / NXCD; wgid = (xcd < r ? xcd * (q + 1) : r * (q + 1) + (xcd - r) * q) + off; }
        const int nig = WGM * nN, gid = wgid / nig, fm = gid * WGM, gsz = (nM - fm) < WGM ? (nM - fm) : WGM;
        u.pm = fm + ((wgid % nig) % gsz); u.pn = (wgid % nig) / gsz; u.acol = 0; return true;
    }
    __device__ __forceinline__ void a_ready(const Unit&) const {}
    __device__ __forceinline__ void done(const Unit&) const {}
};
__device__ __forceinline__ unsigned cvt_pk_bf16(float lo, float hi) { unsigned r; asm volatile("v_cvt_pk_bf16_f32 %0, %1, %2" : "=v"(r) : "v"(lo), "v"(hi)); return r; }
typedef float f32x2 __attribute__((ext_vector_type(2)));
template <class Epi, class Sched, bool STAMP = false>
__device__ __forceinline__ void gemm_phase(PG8_LAS unsigned char* lds, const Gemm g, const Sched& S, const Epi& E, unsigned long long* stamps) {
    int tid = threadIdx.x; asm volatile("" : "+v"(tid)); const int wid = __builtin_amdgcn_readfirstlane(tid >> 6), lane = tid & 63, wr = wid >> 2, wc = wid & 3, fr = lane & 15, fq = lane >> 4;
    const int K = g.K, nt = K / BK, LDA = g.lda ? g.lda : g.K;
    int ts_lo = 0, ts_hi = 0, nts = 0; const unsigned long long rt_entry = STAMP ? (unsigned long long)wall_clock64() : 0ull;
#define PG8_STAMP() do { if (STAMP && wid == 0 && nts < 64) { const unsigned long long _c = (unsigned long long)clock64(); \
        ts_lo = (lane == nts) ? (int)(unsigned)_c : ts_lo; ts_hi = (lane == nts) ? (int)(unsigned)(_c >> 32) : ts_hi; ++nts; } } while (0)
    PG8_STAMP();
    unsigned voffA[2], voffB[2];
#pragma unroll
    for (int i = 0; i < 2; ++i) { int R, C; stage_rc(tid * 16 + i * 8192, R, C); const int Rb = Epi::PERM ? ((R & ~31) + perm32(R & 31)) : R;
        voffA[i] = (unsigned)(R * LDA + C) * 2u; voffB[i] = (unsigned)(Rb * K + C) * 2u; }
    const size_t kstep = (size_t)(BK * 2);
    const size_t hstep = (size_t)HALF * K * 2;
    const size_t tstep = 2 * hstep;
    const size_t hstepA = (size_t)HALF * LDA * 2, tstepA = 2 * hstepA;
    const unsigned ldsw = (unsigned)wid * 1024u;
    const int aoff = lds_byte(wr * 64 + fr, fq * 8), boff = lds_byte(wc * 32 + fr, fq * 8);
#define PG8_SA(b, h) (((b) * 2 + (h)) * HTB)
#define PG8_SB(b, h) ((4 + (b) * 2 + (h)) * HTB)
#define PG8_STAGE(bufoff, gbase, voff) do { _Pragma("unroll") for (int _i = 0; _i < 2; ++_i) \
        __builtin_amdgcn_global_load_lds((const unsigned*)((const char*)(gbase) + (voff)[_i]), (PG8_LAS unsigned*)(lds + (bufoff) + ldsw + _i * 8192), 16, 0, 0); } while (0)
#define PG8_LDA(dst, b, h) do { _Pragma("unroll") for (int m = 0; m < 4; ++m) _Pragma("unroll") for (int k = 0; k < 2; ++k) dst[m][k] = *(const PG8_LAS bf16x8*)(lds + PG8_SA(b, h) + aoff + m * 2048 + k * 1024); } while (0)
#define PG8_LDB(dst, b, h) do { _Pragma("unroll") for (int n = 0; n < 2; ++n) _Pragma("unroll") for (int k = 0; k < 2; ++k) dst[n][k] = *(const PG8_LAS bf16x8*)(lds + PG8_SB(b, h) + boff + n * 2048 + k * 1024); } while (0)
#define PG8_MMA(ai, bj, At, Bt) do { __builtin_amdgcn_s_setprio(1); _Pragma("unroll") for (int m = 0; m < 4; ++m) _Pragma("unroll") for (int n = 0; n < 2; ++n) _Pragma("unroll") for (int k = 0; k < 2; ++k) \
        acc[ai][bj][m][n] = __builtin_amdgcn_mfma_f32_16x16x32_bf16(Bt[n][k], At[m][k], acc[ai][bj][m][n], 0, 0, 0); __builtin_amdgcn_s_setprio(0); } while (0)
#define PG8_WAIT_V(n) asm volatile("s_waitcnt vmcnt(" #n ")" ::: "memory")
#define PG8_WAIT_L(n) asm volatile("s_waitcnt lgkmcnt(" #n ")" ::: "memory")
#define PG8_BAR __builtin_amdgcn_s_barrier()
#define PG8_SCHED __builtin_amdgcn_sched_barrier(0)
    Unit cur, nxt; int ui = 0;
    if (!S.next(0, cur)) return;
    f32x4 acc[2][2][4][2];
#pragma unroll
    for (int a = 0; a < 2; ++a)
#pragma unroll
        for (int b = 0; b < 2; ++b)
#pragma unroll
            for (int m = 0; m < 4; ++m)
#pragma unroll
                for (int n = 0; n < 2; ++n) acc[a][b][m][n] = (f32x4){0.f, 0.f, 0.f, 0.f};
    bf16x8 At[4][2], B0[2][2], B1[2][2];
    const char* cA = (const char*)g.A + (size_t)cur.pm * tstepA + (size_t)cur.acol * 2; const char* cB = (const char*)g.Bt + (size_t)cur.pn * tstep;
    S.a_ready(cur);
    PG8_STAGE(PG8_SB(0, 0), cB, voffB); PG8_STAGE(PG8_SA(0, 0), cA, voffA); PG8_STAGE(PG8_SB(0, 1), cB + hstep, voffB); PG8_STAGE(PG8_SA(0, 1), cA + hstepA, voffA);
    if (wr == 1) PG8_BAR;
    PG8_WAIT_V(4); PG8_BAR;
    PG8_STAGE(PG8_SB(1, 0), cB + kstep, voffB); PG8_STAGE(PG8_SA(1, 0), cA + kstep, voffA); PG8_STAGE(PG8_SB(1, 1), cB + hstep + kstep, voffB);
    PG8_WAIT_V(6); PG8_BAR;
    PG8_STAMP();
    for (;;) {
        const bool has_next = S.next(ui + 1, nxt);
        const char* nA = has_next ? (const char*)g.A + (size_t)nxt.pm * tstepA + (size_t)nxt.acol * 2 : cA; const char* nB = has_next ? (const char*)g.Bt + (size_t)nxt.pn * tstep : cB;
        for (int t = 0; t < nt; t += 2) {
            const bool last = (t == nt - 2);
            const char* a1 = cA + (size_t)(t + 1) * kstep;
            const char* a2 = last ? nA : cA + (size_t)(t + 2) * kstep; const char* b2 = last ? nB : cB + (size_t)(t + 2) * kstep;
            const char* a3 = a2 + kstep; const char* b3 = b2 + kstep;
            if (last && has_next) S.a_ready(nxt);
            PG8_LDB(B0, 0, 0); PG8_SCHED; PG8_LDA(At, 0, 0); PG8_STAGE(PG8_SA(1, 1), a1 + hstepA, voffA);
            PG8_WAIT_L(8); PG8_BAR; PG8_WAIT_L(0); PG8_MMA(0, 0, At, B0); PG8_BAR; PG8_SCHED;
            PG8_LDB(B1, 0, 1); PG8_STAGE(PG8_SB(0, 0), b2, voffB);
            PG8_BAR; PG8_WAIT_L(0); PG8_MMA(0, 1, At, B1); PG8_BAR;
            PG8_LDA(At, 0, 1); PG8_STAGE(PG8_SA(0, 0), a2, voffA);
            PG8_BAR; PG8_WAIT_L(0); PG8_MMA(1, 0, At, B0); PG8_BAR; PG8_SCHED;
            PG8_STAGE(PG8_SB(0, 1), b2 + hstep, voffB);
            PG8_WAIT_V(6); PG8_BAR; PG8_MMA(1, 1, At, B1); PG8_BAR;
            PG8_LDB(B0, 1, 0); PG8_SCHED; PG8_LDA(At, 1, 0); PG8_STAGE(PG8_SA(0, 1), a2 + hstepA, voffA);
            PG8_WAIT_L(8); PG8_BAR; PG8_WAIT_L(0); PG8_MMA(0, 0, At, B0); PG8_BAR; PG8_SCHED;
            PG8_LDB(B1, 1, 1); PG8_STAGE(PG8_SB(1, 0), b3, voffB);
            PG8_BAR; PG8_WAIT_L(0); PG8_MMA(0, 1, At, B1); PG8_BAR;
            PG8_LDA(At, 1, 1); PG8_STAGE(PG8_SA(1, 0), a3, voffA);
            PG8_BAR; PG8_WAIT_L(0); PG8_MMA(1, 0, At, B0); PG8_BAR; PG8_SCHED;
            PG8_STAGE(PG8_SB(1, 1), b3 + hstep, voffB);
            PG8_WAIT_V(6); PG8_BAR; PG8_MMA(1, 1, At, B1); PG8_BAR;
        }
        PG8_STAMP();
        if constexpr (!Epi::AFTER_DRAIN) { E(acc, cur, wr, wc, fr, fq); S.done(cur); }
        PG8_STAMP();
        if (!has_next) break;
#pragma unroll
        for (int a = 0; a < 2; ++a)
#pragma unroll
            for (int b = 0; b < 2; ++b)
#pragma unroll
                for (int m = 0; m < 4; ++m)
#pragma unroll
                    for (int n = 0; n < 2; ++n) acc[a][b][m][n] = (f32x4){0.f, 0.f, 0.f, 0.f};
        cur = nxt; cA = nA; cB = nB; ++ui;
    }
    PG8_WAIT_V(0);
    if (wr == 0) PG8_BAR;
    PG8_BAR;
    if constexpr (Epi::AFTER_DRAIN) { E.fused(acc, cur, wr, wc, fr, fq, lds, wid, lane); S.done(cur); }
    PG8_STAMP();
    if (STAMP && wid == 0) { stamps[lane] = lane < nts ? (((unsigned long long)(unsigned)ts_hi << 32) | (unsigned)ts_lo) : 0ull;
        if (lane == 62) stamps[62] = rt_entry; if (lane == 63) stamps[63] = (unsigned long long)wall_clock64(); }
#undef PG8_STAMP
#undef PG8_SA
#undef PG8_SB
#undef PG8_STAGE
#undef PG8_LDA
#undef PG8_LDB
#undef PG8_MMA
#undef PG8_WAIT_V
#undef PG8_WAIT_L
#undef PG8_BAR
#undef PG8_SCHED
}
}

#define LAS __attribute__((address_space(3)))
typedef unsigned short bf16_t;
constexpr int NWAVES = 8, NTHREADS = 512;
constexpr int LDS_BYTES = 147456;
constexpr int RING_OFF = 0;
constexpr int MISC_OFF = 131072;
constexpr int NINP = 7936;

__device__ __forceinline__ unsigned f2bf(float f) { unsigned u = __builtin_bit_cast(unsigned, f); return (u + 0x7fffu + ((u >> 16) & 1u)) >> 16; }
__device__ __forceinline__ unsigned pk2(float lo, float hi) { return f2bf(lo) | (f2bf(hi) << 16); }
__device__ __forceinline__ float bf2f(bf16_t b) { return __builtin_bit_cast(float, ((unsigned)b) << 16); }
typedef unsigned v4u __attribute__((ext_vector_type(4)));

__device__ __forceinline__ void transpose_item(const float* W, int K, int N, bf16_t* WT, int row_off, LAS float* scr, int item, int lane) {
  const int nblk = N / 32, kb = item / nblk, nb = item % nblk, k0 = 64 * kb, n0 = 32 * nb;
  float wreg[32];
#pragma unroll
  for (int i = 0; i < 32; ++i) { const int kk = 2 * i + (lane >> 5); wreg[i] = W[(size_t)(k0 + kk) * N + n0 + (lane & 31)]; }
#pragma unroll
  for (int i = 0; i < 32; ++i) { const int kk = 2 * i + (lane >> 5); scr[kk * 33 + (lane & 31)] = wreg[i]; }
  asm volatile("s_waitcnt lgkmcnt(0)" ::: "memory");
  const int c = lane & 7;
#pragma unroll
  for (int j = 0; j < 4; ++j) { const int n = (lane >> 3) + 8 * j; const LAS float* s = scr + (8 * c) * 33 + n;
    v4u o; o.x = pk2(s[0 * 33], s[1 * 33]); o.y = pk2(s[2 * 33], s[3 * 33]); o.z = pk2(s[4 * 33], s[5 * 33]); o.w = pk2(s[6 * 33], s[7 * 33]);
    *(v4u*)(WT + (size_t)(row_off + n0 + n) * K + k0 + 8 * c) = o; }
  asm volatile("s_waitcnt lgkmcnt(0)" ::: "memory");
}

struct EpiProjF32 {
  static constexpr bool PERM = false, AFTER_DRAIN = false;
  float* C; int ldc; int ncols;
  __device__ __forceinline__ void operator()(const pg8::f32x4 (&acc)[2][2][4][2], const pg8::Unit& u, int wr, int wc, int fr, int fq) const {
    const int row0 = u.pm * 256 + wr * 64 + fr, col0 = u.pn * 256 + wc * 32 + 4 * fq;
#pragma unroll
    for (int ai = 0; ai < 2; ++ai)
#pragma unroll
      for (int m = 0; m < 4; ++m) { float* rowp = C + (size_t)(row0 + ai * 128 + m * 16) * ldc + col0;
#pragma unroll
        for (int bj = 0; bj < 2; ++bj)
#pragma unroll
          for (int n = 0; n < 2; ++n) if (col0 + bj * 128 + n * 16 < ncols) *(pg8::f32x4*)(rowp + bj * 128 + n * 16) = acc[ai][bj][m][n]; }
  }
};

__device__ __forceinline__ float fsigmoid(float x) { return 1.f / (1.f + __expf(-x)); }
template <bool ACCUM> struct EpiMerge {
  static constexpr bool PERM = true, AFTER_DRAIN = false;
  const float* gate; int ldg; bf16_t* M; int ldm;
  __device__ __forceinline__ void operator()(const pg8::f32x4 (&acc)[2][2][4][2], const pg8::Unit& u, int wr, int wc, int fr, int fq) const {
    const int row0 = u.pm * 256 + wr * 64 + fr, col0 = u.pn * 256 + wc * 32 + 8 * fq;
#pragma unroll
    for (int ai = 0; ai < 2; ++ai)
#pragma unroll
      for (int m = 0; m < 4; ++m) { const size_t r = (size_t)(row0 + ai * 128 + m * 16);
#pragma unroll
        for (int bj = 0; bj < 2; ++bj) { const int c = col0 + bj * 128;
          const pg8::f32x4 g0 = *(const pg8::f32x4*)(gate + r * ldg + c), g1 = *(const pg8::f32x4*)(gate + r * ldg + c + 4);
          pg8::f32x4 v0 = acc[ai][bj][m][0], v1 = acc[ai][bj][m][1];
#pragma unroll
          for (int e = 0; e < 4; ++e) { v0[e] *= fsigmoid(g0[e]); v1[e] *= fsigmoid(g1[e]); }
          v4u* dst = (v4u*)(M + r * ldm + c);
          if (ACCUM) { const v4u o = *dst; v0[0] += bf2f(o.x & 0xffff); v0[1] += bf2f(o.x >> 16); v0[2] += bf2f(o.y & 0xffff); v0[3] += bf2f(o.y >> 16);
            v1[0] += bf2f(o.z & 0xffff); v1[1] += bf2f(o.z >> 16); v1[2] += bf2f(o.w & 0xffff); v1[3] += bf2f(o.w >> 16); }
          v4u o2; o2.x = pk2(v0[0], v0[1]); o2.y = pk2(v0[2], v0[3]); o2.z = pk2(v1[0], v1[1]); o2.w = pk2(v1[2], v1[3]); *dst = o2; } }
  }
};
struct EpiOut {
  static constexpr bool PERM = false, AFTER_DRAIN = false;
  const float* resL; float* outL; const float* gL;
  const float* resC; float* outC; const float* gC;
  __device__ __forceinline__ void operator()(const pg8::f32x4 (&acc)[2][2][4][2], const pg8::Unit& u, int wr, int wc, int fr, int fq) const {
    const bool isc = u.pm == 16; if (isc && outC == nullptr) return;
    const float* res = isc ? resC : resL; float* out = isc ? outC : outL; const float* gv = isc ? gC : gL;
    const int row0 = (isc ? 0 : u.pm * 256) + wr * 64 + fr, col0 = u.pn * 256 + wc * 32 + 4 * fq;
    pg8::f32x4 gg[2][2];
#pragma unroll
    for (int bj = 0; bj < 2; ++bj)
#pragma unroll
      for (int n = 0; n < 2; ++n) gg[bj][n] = *(const pg8::f32x4*)(gv + col0 + bj * 128 + n * 16);
#pragma unroll
    for (int ai = 0; ai < 2; ++ai)
#pragma unroll
      for (int m = 0; m < 4; ++m) { const size_t ro = (size_t)(row0 + ai * 128 + m * 16) * 1024 + col0;
#pragma unroll
        for (int bj = 0; bj < 2; ++bj)
#pragma unroll
          for (int n = 0; n < 2; ++n) { const pg8::f32x4 rv = *(const pg8::f32x4*)(res + ro + bj * 128 + n * 16); *(pg8::f32x4*)(out + ro + bj * 128 + n * 16) = rv + gg[bj][n] * acc[ai][bj][m][n]; } }
  }
};
namespace att {
using bf16 = __hip_bfloat16;
constexpr int D = 128, NW = 8, QBLK = 32, KVBLK = 64; constexpr float SCALE = 0.088388347648318440f; constexpr float THR = 8.f; constexpr int SDEPTH = 2;
constexpr size_t SHM_V = KVBLK * D * 2, SHM_K = KVBLK * D * 2, SHM_ATTN = 2 * SHM_V + 2 * SHM_K + NW * 64 * 4;
using bf16x8 = __attribute__((ext_vector_type(8))) short;
using s16x4  = __attribute__((ext_vector_type(4))) short;
using f32x16 = __attribute__((ext_vector_type(16))) float;
using f32x8  = __attribute__((ext_vector_type(8))) float;
using u32x4  = __attribute__((ext_vector_type(4))) unsigned;
#define KSWZ(row, colB) ((row) * 256 + ((colB) ^ (((row) & 7) << 4)))
#define SBAR() __builtin_amdgcn_sched_barrier(0)
__device__ __forceinline__ int crow(int r, int hi) { return (r & 3) + 8 * (r >> 2) + 4 * hi; }
__device__ __forceinline__ unsigned cvtpk(float lo, float hi) {
  unsigned r; asm volatile("v_cvt_pk_bf16_f32 %0, %1, %2" : "=v"(r) : "v"(lo), "v"(hi)); return r;
}
template <typename TIn> struct Stage;
template <> struct Stage<bf16>  { using T = bf16x8;
  __device__ static __forceinline__ T ld8(const bf16* p) { return *reinterpret_cast<const bf16x8*>(p); }
  __device__ static __forceinline__ bf16x8 tobf(T x) { return x; } };
template <> struct Stage<float> { using T = f32x8;
  __device__ static __forceinline__ T ld8(const float* p) { return *reinterpret_cast<const f32x8*>(p); }
  __device__ static __forceinline__ bf16x8 tobf(T x) {
    u32x4 w = {cvtpk(x[0], x[1]), cvtpk(x[2], x[3]), cvtpk(x[4], x[5]), cvtpk(x[6], x[7])}; return *reinterpret_cast<bf16x8*>(&w); } };

__device__ __forceinline__ void partialSM(f32x16& p0, f32x16& p1, float& m_reg, float& mn, float& alpha) {
  constexpr float C = SCALE * 1.4426950408889634f;
  float pmax = p0[0]; for (int r = 1; r < 16; ++r) pmax = fmaxf(pmax, p0[r]); for (int r = 0; r < 16; ++r) pmax = fmaxf(pmax, p1[r]);
  { auto rr = __builtin_amdgcn_permlane32_swap(__float_as_uint(pmax), __float_as_uint(pmax), false, false);
    pmax = fmaxf(__uint_as_float(rr[0]), __uint_as_float(rr[1])); }
  if (__builtin_expect(__all(pmax - m_reg <= THR / SCALE), 1)) { mn = m_reg; alpha = 1.f; }
  else { mn = fmaxf(m_reg, pmax); alpha = __builtin_amdgcn_exp2f((m_reg - mn) * C); m_reg = mn; }
  float mnC = -mn * C;
  for (int r = 0; r < 16; ++r) p0[r] = fmaf(p0[r], C, mnC); for (int r = 0; r < 16; ++r) p1[r] = fmaf(p1[r], C, mnC);
  for (int r = 0; r < 16; ++r) p0[r] = __builtin_amdgcn_exp2f(p0[r]);
}
__device__ __forceinline__ void finishSM(f32x16& p0, f32x16& p1, float alpha, float& l_reg, bf16x8& pa0, bf16x8& pa1, bf16x8& pa2, bf16x8& pa3) {
  for (int r = 0; r < 16; ++r) p1[r] = __builtin_amdgcn_exp2f(p1[r]);
  float ps = 0; for (int r = 0; r < 16; ++r) ps += p0[r]; for (int r = 0; r < 16; ++r) ps += p1[r];
  { auto rr = __builtin_amdgcn_permlane32_swap(__float_as_uint(ps), __float_as_uint(ps), false, false);
    ps = __uint_as_float(rr[0]) + __uint_as_float(rr[1]); }
  l_reg = l_reg * alpha + ps;
#define PK4(P, BASE, OUT) do { unsigned a0 = cvtpk(P[BASE + 0], P[BASE + 1]), a1 = cvtpk(P[BASE + 2], P[BASE + 3]);   \
    unsigned b0 = cvtpk(P[BASE + 4], P[BASE + 5]), b1 = cvtpk(P[BASE + 6], P[BASE + 7]);                              \
    auto r0 = __builtin_amdgcn_permlane32_swap(a0, b0, false, false); auto r1 = __builtin_amdgcn_permlane32_swap(a1, b1, false, false); \
    u32x4 w = {r0[0], r1[0], r0[1], r1[1]}; OUT = *reinterpret_cast<bf16x8*>(&w); } while (0)
  PK4(p0, 0, pa0); PK4(p0, 8, pa1); PK4(p1, 0, pa2); PK4(p1, 8, pa3);
#undef PK4
}
__device__ __forceinline__ void qkt(f32x16& p0, f32x16& p1, const bf16* Ks, const bf16x8* qr, int r32, int hi) {
  p0 = f32x16{}; p1 = f32x16{};
  for (int d0 = 0; d0 < 8; ++d0) { int cb = (d0 * 16 + hi * 8) * 2;
    bf16x8 b0 = *reinterpret_cast<const bf16x8*>((const char*)Ks + KSWZ(r32, cb));
    bf16x8 b1 = *reinterpret_cast<const bf16x8*>((const char*)Ks + KSWZ(32 + r32, cb));
    p0 = __builtin_amdgcn_mfma_f32_32x32x16_bf16(b0, qr[d0], p0, 0, 0, 0);
    p1 = __builtin_amdgcn_mfma_f32_32x32x16_bf16(b1, qr[d0], p1, 0, 0, 0); }
}
__device__ __forceinline__ int v_st(int k, int c) { const int kk = (k & ~0xC) | ((k & 4) << 1) | ((k & 8) >> 1); return ((kk >> 3) * 4 + (c >> 5)) * 512 + ((kk & 7) * 32 + (c & 31)) * 2; }
__device__ __forceinline__ int v_rd_base(int lane) { return ((lane & 3) << 3) | (((lane >> 2) & 3) << 6) | (((lane >> 4) & 1) << 5) | (((lane >> 5) & 1) << 8); }
constexpr int v_rd_off(int d0, int ks, int half) { return d0 * 512 + ks * 4096 + half * 2048; }
template <int OFF> __device__ __forceinline__ s16x4 tr_read(int vb) {
  s16x4 r; asm volatile("ds_read_b64_tr_b16 %0, %1 offset:%2" : "=&v"(r) : "v"(vb), "i"(OFF) : "memory"); return r;
}
template <int D0> __device__ __forceinline__ void pv_one(f32x16& od, int vb, bf16x8 pa0, bf16x8 pa1, bf16x8 pa2, bf16x8 pa3) {
  const s16x4 l0 = tr_read<v_rd_off(D0, 0, 0)>(vb), h0 = tr_read<v_rd_off(D0, 0, 1)>(vb), l1 = tr_read<v_rd_off(D0, 1, 0)>(vb), h1 = tr_read<v_rd_off(D0, 1, 1)>(vb);
  const s16x4 l2 = tr_read<v_rd_off(D0, 2, 0)>(vb), h2 = tr_read<v_rd_off(D0, 2, 1)>(vb), l3 = tr_read<v_rd_off(D0, 3, 0)>(vb), h3 = tr_read<v_rd_off(D0, 3, 1)>(vb);
  asm volatile("s_waitcnt lgkmcnt(0)" ::: "memory"); SBAR();
#define PK(L, H) (bf16x8){L[0], L[1], L[2], L[3], H[0], H[1], H[2], H[3]}
  od = __builtin_amdgcn_mfma_f32_32x32x16_bf16(pa0, PK(l0, h0), od, 0, 0, 0);
  od = __builtin_amdgcn_mfma_f32_32x32x16_bf16(pa1, PK(l1, h1), od, 0, 0, 0);
  od = __builtin_amdgcn_mfma_f32_32x32x16_bf16(pa2, PK(l2, h2), od, 0, 0, 0);
  od = __builtin_amdgcn_mfma_f32_32x32x16_bf16(pa3, PK(l3, h3), od, 0, 0, 0);
#undef PK
}
__device__ __forceinline__ void pv_d0(f32x16* o, int vb, bf16x8 pa0, bf16x8 pa1, bf16x8 pa2, bf16x8 pa3) {
  pv_one<0>(o[0], vb, pa0, pa1, pa2, pa3); pv_one<1>(o[1], vb, pa0, pa1, pa2, pa3); pv_one<2>(o[2], vb, pa0, pa1, pa2, pa3); pv_one<3>(o[3], vb, pa0, pa1, pa2, pa3);
}

template <typename TQ, int LDQ, int LDK, int LDO, bool OBF16>
__device__ __forceinline__ void attn_dense_body(const TQ* Qb, const bf16* Kh, const bf16* Vh,
                                                void* Obv, int seq, char* lds) {
  using St = Stage<bf16>; using SQ = Stage<TQ>;
  int tid = threadIdx.x; asm volatile("" : "+v"(tid)); const int wid = tid >> 6, lane = tid & 63, r32 = lane & 31, hi = lane >> 5;
  bf16* V_lds = (bf16*)lds; bf16* K_lds = (bf16*)(lds + 2 * SHM_V);
  float* ws = (float*)(lds + 2 * SHM_V + 2 * SHM_K) + wid * 64; float* li_l = ws; float* al_l = ws + 32;
  float m_reg = -1e30f, l_reg = 0; f32x16 o[4] = {}; bf16x8 qr[8];
  const TQ* Qw = Qb + (long)(wid * QBLK + r32) * LDQ + hi * 8;
#pragma unroll
  for (int d0 = 0; d0 < 8; ++d0) qr[d0] = SQ::tobf(SQ::ld8(Qw + d0 * 16));
  const int sr = tid >> 4, sc = (tid & 15) * 8, vst0 = v_st(sr, sc), vst1 = v_st(32 + sr, sc);
  const int vb0 = (int)(uintptr_t)V_lds + v_rd_base(lane);
  struct { typename St::T vs0, vs1, ks0, ks1; } sr_[SDEPTH];
#define SLOAD(i, k0) do { sr_[i].vs0 = St::ld8(&Vh[(long)((k0) + sr) * LDK + sc]); sr_[i].vs1 = St::ld8(&Vh[(long)((k0) + 32 + sr) * LDK + sc]); \
    sr_[i].ks0 = St::ld8(&Kh[(long)((k0) + sr) * LDK + sc]); sr_[i].ks1 = St::ld8(&Kh[(long)((k0) + 32 + sr) * LDK + sc]); } while (0)
#define SWRITE(b, i) do { *(bf16x8*)((char*)V_lds + (b) * SHM_V + vst0) = St::tobf(sr_[i].vs0);          \
    *(bf16x8*)((char*)V_lds + (b) * SHM_V + vst1) = St::tobf(sr_[i].vs1); int kc = sc * 2;               \
    *(bf16x8*)((char*)K_lds + (b) * SHM_K + KSWZ(sr, kc)) = St::tobf(sr_[i].ks0);                       \
    *(bf16x8*)((char*)K_lds + (b) * SHM_K + KSWZ(32 + sr, kc)) = St::tobf(sr_[i].ks1); } while (0)
#define SWAIT() do { if constexpr (SDEPTH == 2) asm volatile("s_waitcnt vmcnt(4)" ::: "memory"); else asm volatile("s_waitcnt vmcnt(0)" ::: "memory"); } while (0)
#define RESC(a) do { if (__any((a) < 1.f)) { if (hi == 0) al_l[r32] = (a); asm volatile("s_waitcnt lgkmcnt(0)" ::: "memory"); \
    for (int d = 0; d < 4; ++d) for (int r = 0; r < 16; ++r) o[d][r] *= al_l[crow(r, hi)]; } } while (0)
  f32x16 pA0, pA1, pB0, pB1; float mnA, mnB, alA, alB; bf16x8 pa0, pa1, pa2, pa3; const int NT = seq / KVBLK;
  constexpr int SE = 0, SO = SDEPTH - 1;
  SLOAD(SE, 0); asm volatile("s_waitcnt vmcnt(0)" ::: "memory"); SWRITE(0, SE); __syncthreads();
  qkt(pA0, pA1, K_lds, qr, r32, hi); partialSM(pA0, pA1, m_reg, mnA, alA);
  SLOAD(SO, KVBLK); if constexpr (SDEPTH == 2) { if (2 < NT) SLOAD(SE, 2 * KVBLK); }
  SWAIT(); SWRITE(1, SO); __syncthreads();
  for (int j = 1; j + 1 < NT; j += 2) {
    SBAR(); qkt(pB0, pB1, (bf16*)((char*)K_lds + SHM_K), qr, r32, hi);
    finishSM(pA0, pA1, alA, l_reg, pa0, pa1, pa2, pa3); SBAR();
    SLOAD(SO, (j + SDEPTH) * KVBLK); SBAR();
    pv_d0(o, vb0, pa0, pa1, pa2, pa3); partialSM(pB0, pB1, m_reg, mnB, alB);
    __syncthreads(); SWAIT(); SWRITE(0, SE);
    RESC(alB); __syncthreads();
    SBAR(); qkt(pA0, pA1, K_lds, qr, r32, hi);
    finishSM(pB0, pB1, alB, l_reg, pa0, pa1, pa2, pa3); SBAR();
    if (SDEPTH == 1 || j + 3 < NT) SLOAD(SE, (j + 1 + SDEPTH) * KVBLK); SBAR();
    pv_d0(o, vb0 + (int)SHM_V, pa0, pa1, pa2, pa3); partialSM(pA0, pA1, m_reg, mnA, alA);
    __syncthreads(); SWAIT(); SWRITE(1, SO);
    RESC(alA); __syncthreads();
  }
  SBAR(); qkt(pB0, pB1, (bf16*)((char*)K_lds + SHM_K), qr, r32, hi);
  finishSM(pA0, pA1, alA, l_reg, pa0, pa1, pa2, pa3); SBAR();
  pv_d0(o, vb0, pa0, pa1, pa2, pa3); partialSM(pB0, pB1, m_reg, mnB, alB);
  __syncthreads(); RESC(alB);
  finishSM(pB0, pB1, alB, l_reg, pa0, pa1, pa2, pa3); SBAR();
  pv_d0(o, vb0 + (int)SHM_V, pa0, pa1, pa2, pa3);
  if (hi == 0) li_l[r32] = l_reg; asm volatile("s_waitcnt lgkmcnt(0)" ::: "memory");
  float rli[16];
#pragma unroll
  for (int r = 0; r < 16; ++r) rli[r] = __builtin_amdgcn_rcpf(li_l[crow(r, hi)]);
  if constexpr (!OBF16) { float* Ow = (float*)Obv + (long)(wid * QBLK) * LDO;
#pragma unroll
  for (int r = 0; r < 16; ++r) { int orow = crow(r, hi);
    for (int d0 = 0; d0 < 4; ++d0) Ow[(long)orow * LDO + d0 * 32 + r32] = o[d0][r] * rli[r]; }
  } else { unsigned short* Ow = (unsigned short*)Obv + (long)(wid * QBLK) * LDO;
#pragma unroll
  for (int r = 0; r < 16; ++r) { int orow = crow(r, hi);
    for (int d0 = 0; d0 < 4; ++d0) { const unsigned pk = cvtpk(o[d0][r] * rli[r], 0.f); Ow[(long)orow * LDO + d0 * 32 + r32] = (unsigned short)(pk & 0xffffu); } }
  }
#undef SLOAD
#undef SWRITE
#undef SWAIT
#undef RESC
}
#undef KSWZ
#undef SBAR
}
namespace gla {
typedef float f32x16 __attribute__((ext_vector_type(16)));
typedef float f32x4v __attribute__((ext_vector_type(4)));
constexpr int LD = 65;
constexpr int OX = 0, OY = 2 * 64 * LD * 4, OV = 4 * 64 * LD * 4, OAL = OV + 64 * 128 * 4, OW2 = OAL + 64 * 32 * 4, OBA = OW2 + 2 * 16 * 64 * 4, OTOT = OBA + 2 * 64 * 4, OEND = OTOT + 2 * 64 * 4 * 4;
static_assert(OEND <= 131072, "gla lds");
static_assert(64 * 129 * 4 <= 2 * 64 * LD * 4, "O stage fits in X");

struct In {
  const bf16_t* q; const bf16_t* k; const bf16_t* v; const bf16_t* ga; const bf16_t* og; int ld;
  const float* wa2; const float* ba; const float* gnorm;
  float* cs;
  float* dec;
  bf16_t* y; int ldy;
  int S, C;
};
__device__ __forceinline__ long chunk_row(const In& p, int cid) { return cid < p.S / 64 ? (long)cid * 64 : (long)p.S + (long)(cid - p.S / 64) * 64; }
__device__ __forceinline__ float logsig(float x) { return x < 0.f ? x - __logf(1.f + __expf(x)) : -__logf(1.f + __expf(-x)); }

__device__ __forceinline__ void cum_phase(const In& p, LAS unsigned char* lds, int head, long row0, int tid) {
  LAS float* AL = (LAS float*)(lds + OAL); LAS float* W2 = (LAS float*)(lds + OW2); LAS float* BA = (LAS float*)(lds + OBA); LAS float* TOT = (LAS float*)(lds + OTOT);
  { const int t = tid >> 3, r4 = (tid & 7) * 4; const unsigned long long u = *(const unsigned long long*)(p.ga + (row0 + t) * p.ld + r4);
    f32x4v a4; a4[0] = bf2f((bf16_t)u); a4[1] = bf2f((bf16_t)(u >> 16)); a4[2] = bf2f((bf16_t)(u >> 32)); a4[3] = bf2f((bf16_t)(u >> 48)); *(LAS f32x4v*)(AL + t * 32 + r4) = a4; }
  { const int e = tid * 4, dir = e >> 10, r = (e >> 6) & 15, j = e & 63; *(LAS f32x4v*)(W2 + e) = *(const f32x4v*)(p.wa2 + ((long)dir * 16 + r) * 256 + head * 64 + j); }
  if (tid < 128) BA[tid] = p.ba[(tid >> 6) * 256 + head * 64 + (tid & 63)];
  __syncthreads();
  const int dir = tid >> 8, j = tid & 63, seg = (tid >> 6) & 3;
  float w[16];
#pragma unroll
  for (int r = 0; r < 16; ++r) w[r] = W2[(dir * 16 + r) * 64 + j];
  const float bj = BA[dir * 64 + j];
  float c[16];
#pragma unroll
  for (int k = 0; k < 16; ++k) { const int t = seg * 16 + k; float z = bj;
#pragma unroll
    for (int r = 0; r < 16; ++r) z += AL[t * 32 + dir * 16 + r] * w[r];
    c[k] = logsig(z) * (1.f / 16.f); }
  if (dir == 0) {
#pragma unroll
    for (int k = 1; k < 16; ++k) c[k] += c[k - 1];
    TOT[(dir * 64 + j) * 4 + seg] = c[15];
  } else {
#pragma unroll
    for (int k = 14; k >= 0; --k) c[k] += c[k + 1];
    TOT[(dir * 64 + j) * 4 + seg] = c[0];
  }
  __syncthreads();
  float off = 0.f;
#pragma unroll
  for (int s = 0; s < 4; ++s) { const float tv = TOT[(dir * 64 + j) * 4 + s]; if (dir == 0 ? s < seg : s > seg) off += tv; }
  LAS float* X = (LAS float*)(lds + OX) + dir * 64 * LD;
#pragma unroll
  for (int k = 0; k < 16; ++k) X[(seg * 16 + k) * LD + j] = c[k] + off;
}
struct VRegs { unsigned long long u[4]; };
__device__ __forceinline__ VRegs load_v_regs(const In& p, int head, long row0, int tid) { VRegs r;
#pragma unroll
  for (int m = 0; m < 4; ++m) { const int t = (tid >> 5) + 16 * m, c4 = (tid & 31) * 4; r.u[m] = *(const unsigned long long*)(p.v + (row0 + t) * p.ld + head * 128 + c4); }
  return r; }
__device__ __forceinline__ void store_v(const VRegs& r, LAS unsigned char* lds, int tid) {
  LAS float* V = (LAS float*)(lds + OV);
#pragma unroll
  for (int m = 0; m < 4; ++m) { const int t = (tid >> 5) + 16 * m, c4 = (tid & 31) * 4; const unsigned long long u = r.u[m];
    f32x4v a4; a4[0] = bf2f((bf16_t)u); a4[1] = bf2f((bf16_t)(u >> 16)); a4[2] = bf2f((bf16_t)(u >> 32)); a4[3] = bf2f((bf16_t)(u >> 48)); *(LAS f32x4v*)(V + t * 128 + c4) = a4; }
}

__device__ __forceinline__ void g1_unit(const In& p, LAS unsigned char* lds, int head, int cid, int GH, int NCH) {
  int tid = threadIdx.x; asm volatile("" : "+v"(tid));
  const int lane = tid & 63, w = __builtin_amdgcn_readfirstlane(tid >> 6);
  const long row0 = chunk_row(p, cid);
  const VRegs vr = load_v_regs(p, head, row0, tid);
  bf16_t kreg[8];
#pragma unroll
  for (int m = 0; m < 8; ++m) kreg[m] = p.k[(row0 + (tid >> 6) + 8 * m) * p.ld + head * 64 + (tid & 63)];
  cum_phase(p, lds, head, row0, tid);
  store_v(vr, lds, tid);
  __syncthreads();
  LAS float* TOT = (LAS float*)(lds + OTOT);
  { const int j = tid & 63;
#pragma unroll
    for (int dir = 0; dir < 2; ++dir) { LAS float* X = (LAS float*)(lds + OX) + dir * 64 * LD;
      const float cl = TOT[(dir * 64 + j) * 4 + 0] + TOT[(dir * 64 + j) * 4 + 1] + TOT[(dir * 64 + j) * 4 + 2] + TOT[(dir * 64 + j) * 4 + 3];
#pragma unroll
      for (int m = 0; m < 8; ++m) { const int t = (tid >> 6) + 8 * m; const float kv = bf2f(kreg[m]); X[t * LD + j] = kv * __expf(cl - X[t * LD + j]); }
      if (tid < 64) p.dec[(((long)dir * GH + head) * NCH + cid) * 64 + j] = __expf(cl); }
  }
  __syncthreads();
  { const int dir = w >> 2, di = (w >> 1) & 1, vj0 = (w & 1) * 2; const LAS float* X = (const LAS float*)(lds + OX) + dir * 64 * LD; const LAS float* V = (const LAS float*)(lds + OV);
    f32x16 a0 = {}, a1 = {}; const int li = lane & 31, lk = lane >> 5;
#pragma unroll 4
    for (int s0 = 0; s0 < 64; s0 += 2) { const float av = X[(s0 + lk) * LD + 32 * di + li]; const float b0 = V[(s0 + lk) * 128 + 32 * vj0 + li], b1 = V[(s0 + lk) * 128 + 32 * vj0 + 32 + li];
      a0 = __builtin_amdgcn_mfma_f32_32x32x2f32(av, b0, a0, 0, 0, 0); a1 = __builtin_amdgcn_mfma_f32_32x32x2f32(av, b1, a1, 0, 0, 0); }
    float* dst = p.cs + ((((long)dir * GH + head) * NCH + cid) * 64) * 128;
#pragma unroll
    for (int r = 0; r < 16; ++r) { const int d = 32 * di + (r & 3) + 8 * (r >> 2) + 4 * lk; dst[(long)d * 128 + 32 * vj0 + li] = a0[r]; dst[(long)d * 128 + 32 * vj0 + 32 + li] = a1[r]; }
  }
  __syncthreads();
}
__device__ __forceinline__ void g2_item(const In& p, long idx, int GH, int NCH) {
  const int v = (int)(idx & 127), d = (int)((idx >> 7) & 63); const int hd = (int)((idx >> 13) % GH), dir = (int)((idx >> 13) / GH);
  const int nl = p.S / 64, nc = p.C / 64; float st = 0.f;
  float* base = p.cs + (((long)dir * GH + hd) * NCH) * 64 * 128 + (long)d * 128 + v; const float* db = p.dec + (((long)dir * GH + hd) * NCH) * 64 + d;
  for (int s0 = 0; s0 < nl + nc; s0 += 4) { float c[4], dc[4]; float* pp[4];
#pragma unroll
    for (int k = 0; k < 4; ++k) { const int step = s0 + k; int cid; if (step < nc) cid = nl + (dir ? nc - 1 - step : step); else cid = dir ? nl - 1 - (step - nc) : step - nc;
      pp[k] = base + (long)cid * 64 * 128; c[k] = *pp[k]; dc[k] = db[(long)cid * 64]; }
#pragma unroll
    for (int k = 0; k < 4; ++k) { *pp[k] = st; st = dc[k] * st + c[k]; } }
}
__device__ __forceinline__ void g3_unit(const In& p, LAS unsigned char* lds, int head, int cid, int GH, int NCH) {
  int tid = threadIdx.x; asm volatile("" : "+v"(tid));
  const int lane = tid & 63, w = __builtin_amdgcn_readfirstlane(tid >> 6), li = lane & 31, lk = lane >> 5;
  const long row0 = chunk_row(p, cid);
  float spf[2][32];
  { const int vj_ = w & 3;
#pragma unroll
    for (int dir = 0; dir < 2; ++dir) { const float* sp = p.cs + ((((long)dir * GH + head) * NCH + cid) * 64) * 128 + 32 * vj_ + li;
#pragma unroll
      for (int i = 0; i < 32; ++i) spf[dir][i] = sp[(long)(2 * i + lk) * 128]; } }
  const VRegs vr = load_v_regs(p, head, row0, tid);
  bf16_t kreg[8], qreg[8];
#pragma unroll
  for (int m = 0; m < 8; ++m) { const long o_ = (row0 + (tid >> 6) + 8 * m) * p.ld + head * 64 + (tid & 63); kreg[m] = p.k[o_]; qreg[m] = p.q[o_]; }
  cum_phase(p, lds, head, row0, tid);
  store_v(vr, lds, tid);
  __syncthreads();
  { const int j = tid & 63;
#pragma unroll
    for (int dir = 0; dir < 2; ++dir) { LAS float* X = (LAS float*)(lds + OX) + dir * 64 * LD; LAS float* Y = (LAS float*)(lds + OY) + dir * 64 * LD;
#pragma unroll
      for (int m = 0; m < 8; ++m) { const int t = (tid >> 6) + 8 * m; const float c = X[t * LD + j];
        const float qv = bf2f(qreg[m]) * 0.125f, kv = bf2f(kreg[m]);
        X[t * LD + j] = qv * __expf(c); Y[t * LD + j] = kv * __expf(-c); } }
  }
  __syncthreads();
  {
    const int dir = w >> 2, qi = (w >> 1) & 1, si = w & 1; const bool zero = dir == 0 ? si > qi : si < qi;
    const LAS float* X = (const LAS float*)(lds + OX) + dir * 64 * LD; LAS float* Y = (LAS float*)(lds + OY) + dir * 64 * LD;
    f32x16 pa = {};
    if (!zero) {
#pragma unroll 4
      for (int d0 = 0; d0 < 64; d0 += 2) pa = __builtin_amdgcn_mfma_f32_32x32x2f32(X[(32 * qi + li) * LD + d0 + lk], Y[(32 * si + li) * LD + d0 + lk], pa, 0, 0, 0);
    }
    __syncthreads();
#pragma unroll
    for (int r = 0; r < 16; ++r) { const int q = 32 * qi + (r & 3) + 8 * (r >> 2) + 4 * lk, s = 32 * si + li; const bool keep = dir == 0 ? s <= q : s >= q;
      Y[q * LD + s] = keep ? pa[r] : 0.f; }
  }
  __syncthreads();
  f32x16 acc = {};
  { const int qi = w >> 2, vj = w & 3; const LAS float* V = (const LAS float*)(lds + OV);
#pragma unroll
    for (int dir = 0; dir < 2; ++dir) { const LAS float* X = (const LAS float*)(lds + OX) + dir * 64 * LD; const LAS float* Y = (const LAS float*)(lds + OY) + dir * 64 * LD;
#pragma unroll 4
      for (int s0 = 0; s0 < 64; s0 += 2) acc = __builtin_amdgcn_mfma_f32_32x32x2f32(Y[(32 * qi + li) * LD + s0 + lk], V[(s0 + lk) * 128 + 32 * vj + li], acc, 0, 0, 0);
#pragma unroll
      for (int i = 0; i < 32; ++i) acc = __builtin_amdgcn_mfma_f32_32x32x2f32(X[(32 * qi + li) * LD + 2 * i + lk], spf[dir][i], acc, 0, 0, 0);
    }
    __syncthreads();
    LAS float* O = (LAS float*)(lds + OX);
#pragma unroll
    for (int r = 0; r < 16; ++r) { const int q = 32 * qi + (r & 3) + 8 * (r >> 2) + 4 * lk; O[q * 129 + 32 * vj + li] = acc[r]; }
  }
  __syncthreads();
  { const int row = tid >> 3, part = tid & 7; const LAS float* O = (const LAS float*)(lds + OX) + row * 129 + part * 16;
    float o[16]; float ss = 0.f;
#pragma unroll
    for (int k = 0; k < 16; ++k) { o[k] = O[k]; ss += o[k] * o[k]; }
    ss += __shfl_xor(ss, 1); ss += __shfl_xor(ss, 2); ss += __shfl_xor(ss, 4);
    const float rs = 1.f / sqrtf(ss * (1.f / 128.f) + 1e-6f);
    const bf16_t* ogp = p.og + (row0 + row) * p.ld + head * 128 + part * 16; const v4u og0 = *(const v4u*)ogp, og1 = *(const v4u*)(ogp + 8);
    const unsigned ogw[8] = {og0.x, og0.y, og0.z, og0.w, og1.x, og1.y, og1.z, og1.w}; bf16_t* yp = p.y + (row0 + row) * p.ldy + head * 128 + part * 16; float yy[16];
#pragma unroll
    for (int k4 = 0; k4 < 4; ++k4) { f32x4v g4; g4[0] = bf2f((bf16_t)(ogw[2 * k4] & 0xffff)); g4[1] = bf2f((bf16_t)(ogw[2 * k4] >> 16)); g4[2] = bf2f((bf16_t)(ogw[2 * k4 + 1] & 0xffff)); g4[3] = bf2f((bf16_t)(ogw[2 * k4 + 1] >> 16)); const f32x4v n4 = *(const f32x4v*)(p.gnorm + part * 16 + 4 * k4); f32x4v y4;
#pragma unroll
      for (int e = 0; e < 4; ++e) { const float gg = g4[e]; y4[e] = o[4 * k4 + e] * rs * n4[e] * (gg / (1.f + __expf(-gg))); yy[4 * k4 + e] = y4[e]; } }
    { v4u o0, o1; o0.x = pk2(yy[0], yy[1]); o0.y = pk2(yy[2], yy[3]); o0.z = pk2(yy[4], yy[5]); o0.w = pk2(yy[6], yy[7]);
      o1.x = pk2(yy[8], yy[9]); o1.y = pk2(yy[10], yy[11]); o1.z = pk2(yy[12], yy[13]); o1.w = pk2(yy[14], yy[15]); *(v4u*)yp = o0; *(v4u*)(yp + 8) = o1; }
  }
  __syncthreads();
}
}
namespace moe {
constexpr int NE = 16, NG = 4, EPG = 4, DE = 512, D = 1024;
__device__ __forceinline__ float wave_sum(float v) {
#pragma unroll
  for (int o = 1; o < 64; o <<= 1) v += __shfl_xor(v, o);
  return v;
}
struct Route { int e0, r0, e1, r1; };
struct MoeOrder {
  int G, c, NT; const LAS int* poff;
  __device__ __forceinline__ bool next(int i, pg8::Unit& u) const {
    const long L = (long)i * G + c; const int total = poff[NE] * NT; if (L >= total) return false;
    const int panel = (int)L / NT, j = (int)L % NT; int e = 0;
#pragma unroll
    for (int k = 1; k < NE; ++k) e += (panel >= poff[k]) ? 1 : 0;
    u.pm = panel; u.pn = e * NT + j; u.acol = 0; return true;
  }
  __device__ __forceinline__ void a_ready(const pg8::Unit&) const {}
  __device__ __forceinline__ void done(const pg8::Unit&) const {}
};
struct EpiGU {
  static constexpr bool PERM = true, AFTER_DRAIN = false;
  bf16_t* hid;
  __device__ __forceinline__ void operator()(const pg8::f32x4 (&acc)[2][2][4][2], const pg8::Unit& u, int wr, int wc, int fr, int fq) const {
    const int j = u.pn & 3; const int row0 = u.pm * 256 + wr * 64 + fr, col0 = j * 128 + wc * 32 + 8 * fq;
#pragma unroll
    for (int ai = 0; ai < 2; ++ai)
#pragma unroll
      for (int m = 0; m < 4; ++m) { const size_t r = (size_t)(row0 + ai * 128 + m * 16); float hv[8];
#pragma unroll
        for (int n = 0; n < 2; ++n)
#pragma unroll
          for (int e = 0; e < 4; ++e) { const float g = acc[ai][0][m][n][e], up = acc[ai][1][m][n][e]; hv[4 * n + e] = g / (1.f + __expf(-g)) * up; }
        v4u o; o.x = pk2(hv[0], hv[1]); o.y = pk2(hv[2], hv[3]); o.z = pk2(hv[4], hv[5]); o.w = pk2(hv[6], hv[7]);
        *(v4u*)(hid + r * DE + col0) = o; }
  }
};
struct EpiDown {
  static constexpr bool PERM = true, AFTER_DRAIN = false;
  const int* srcrow; const float* wgt; bf16_t* contrib; size_t slot_stride;
  __device__ __forceinline__ void operator()(const pg8::f32x4 (&acc)[2][2][4][2], const pg8::Unit& u, int wr, int wc, int fr, int fq) const {
    const int pn = u.pn & 3; const int row0 = u.pm * 256 + wr * 64 + fr, col0 = pn * 256 + wc * 32 + 8 * fq;
    int srcs[2][4]; float ws_[2][4];
#pragma unroll
    for (int ai = 0; ai < 2; ++ai)
#pragma unroll
      for (int m = 0; m < 4; ++m) { const int r = row0 + ai * 128 + m * 16; srcs[ai][m] = srcrow[r]; ws_[ai][m] = wgt[r]; }
#pragma unroll
    for (int ai = 0; ai < 2; ++ai)
#pragma unroll
      for (int m = 0; m < 4; ++m) { const int src = srcs[ai][m]; if (src < 0) continue; const float w = ws_[ai][m];
        bf16_t* dst = contrib + (size_t)(src & 1) * slot_stride + (size_t)(src >> 1) * D + col0;
#pragma unroll
        for (int bj = 0; bj < 2; ++bj) { const pg8::f32x4 v0 = acc[ai][bj][m][0] * w, v1 = acc[ai][bj][m][1] * w;
          v4u o; o.x = pk2(v0[0], v0[1]); o.y = pk2(v0[2], v0[3]); o.z = pk2(v1[0], v1[1]); o.w = pk2(v1[2], v1[3]); *(v4u*)(dst + bj * 128) = o; } }
  }
};
__device__ __forceinline__ void route_row(const float* xr, const float* gnorm, const float* shift, const float* scale, bf16_t* hrow, const LAS float* rwT, const float* rbias,
                                          LAS int* cnt, Route* rt, float* wts, int lane) {
  typedef float f4 __attribute__((ext_vector_type(4)));
  f4 xv[4]; float ss = 0.f;
#pragma unroll
  for (int j = 0; j < 4; ++j) { xv[j] = *(const f4*)(xr + 4 * lane + 256 * j); ss += xv[j][0] * xv[j][0] + xv[j][1] * xv[j][1] + xv[j][2] * xv[j][2] + xv[j][3] * xv[j][3]; }
  const float rs = 1.f / sqrtf(wave_sum(ss) * (1.f / 1024.f) + 1e-6f);
  float lg[NE];
#pragma unroll
  for (int e = 0; e < NE; ++e) lg[e] = 0.f;
#pragma unroll
  for (int j = 0; j < 4; ++j) { const int c = 4 * lane + 256 * j; const f4 g4 = *(const f4*)(gnorm + c), sh = *(const f4*)(shift + c), sc = *(const f4*)(scale + c);
    f4 h;
#pragma unroll
    for (int i = 0; i < 4; ++i) h[i] = xv[j][i] * rs * g4[i] * (1.f + sc[i]) + sh[i];
    *(unsigned long long*)(hrow + c) = (unsigned long long)pk2(h[0], h[1]) | ((unsigned long long)pk2(h[2], h[3]) << 32);
#pragma unroll
    for (int e = 0; e < NE; ++e) { const f4 w4 = *(const LAS f4*)(rwT + e * 1024 + c); lg[e] += h[0] * w4[0] + h[1] * w4[1] + h[2] * w4[2] + h[3] * w4[3]; } }
  { float v8[8], v4[4], v2[2], v1;
#pragma unroll
    for (int i = 0; i < 8; ++i) { const bool up = lane & 1; const float keep = up ? lg[2 * i + 1] : lg[2 * i], send = up ? lg[2 * i] : lg[2 * i + 1]; v8[i] = keep + __shfl_xor(send, 1); }
#pragma unroll
    for (int i = 0; i < 4; ++i) { const bool up = lane & 2; const float keep = up ? v8[2 * i + 1] : v8[2 * i], send = up ? v8[2 * i] : v8[2 * i + 1]; v4[i] = keep + __shfl_xor(send, 2); }
#pragma unroll
    for (int i = 0; i < 2; ++i) { const bool up = lane & 4; const float keep = up ? v4[2 * i + 1] : v4[2 * i], send = up ? v4[2 * i] : v4[2 * i + 1]; v2[i] = keep + __shfl_xor(send, 4); }
    { const bool up = lane & 8; const float keep = up ? v2[1] : v2[0], send = up ? v2[0] : v2[1]; v1 = keep + __shfl_xor(send, 8); }
    v1 += __shfl_xor(v1, 16); v1 += __shfl_xor(v1, 32);
#pragma unroll
    for (int e = 0; e < NE; ++e) lg[e] = __shfl(v1, e); }
  float sc[NE], sel[NE];
#pragma unroll
  for (int e = 0; e < NE; ++e) { sc[e] = 1.f / (1.f + __expf(-lg[e])); sel[e] = sc[e] + rbias[e]; }
  int bestg = 0; float bestgs = -1e30f;
#pragma unroll
  for (int g = 0; g < NG; ++g) { float m1 = -1e30f, m2 = -1e30f;
#pragma unroll
    for (int i = 0; i < EPG; ++i) { const float v = sel[g * EPG + i]; if (v > m1) { m2 = m1; m1 = v; } else if (v > m2) m2 = v; }
    const float gsum = m1 + m2; if (gsum > bestgs) { bestgs = gsum; bestg = g; } }
  int i1 = -1, i2 = -1; float v1 = -1e30f, v2 = -1e30f, s1 = 0.f, s2 = 0.f;
#pragma unroll
  for (int e = 0; e < NE; ++e) { if (e / EPG == bestg) { const float v = sel[e];
      if (v > v1) { v2 = v1; i2 = i1; s2 = s1; v1 = v; i1 = e; s1 = sc[e]; } else if (v > v2) { v2 = v; i2 = e; s2 = sc[e]; } } }
  if (lane == 0) { const float inv = 1.f / (s1 + s2); Route r; r.e0 = i1; r.e1 = i2; r.r0 = __hip_atomic_fetch_add(cnt + i1, 1, __ATOMIC_RELAXED, __HIP_MEMORY_SCOPE_WORKGROUP); r.r1 = __hip_atomic_fetch_add(cnt + i2, 1, __ATOMIC_RELAXED, __HIP_MEMORY_SCOPE_WORKGROUP); *rt = r; wts[0] = s1 * inv; wts[1] = s2 * inv; }
}
}
namespace hy {
typedef float f32x16 __attribute__((ext_vector_type(16)));
constexpr int S = 4096, NT1 = 128, LDZ = 191, ZPAD = 31, LDX = 129;
constexpr int O_TAPS = 0, O_ZA = 32768, O_ZB = O_ZA + 32 * LDZ * 4, O_X1 = O_ZB + 32 * LDZ * 4, O_X2 = O_X1 + 32 * LDX * 4, O_RED = O_X2 + 32 * LDX * 4, O_END = O_RED + 4 * 64 * 16 * 4;
static_assert(O_END <= 131072, "hyena lds");

struct H0Regs { v4u w0, w1; };
__device__ __forceinline__ H0Regs h0_load(const bf16_t* u, int ld, int tile, int tid) {
  const int tt = tile / 24, jt = tile % 24, t0 = tt * 64, j0 = jt * 64; H0Regs r; r.w0 = (v4u){0u, 0u, 0u, 0u}; r.w1 = r.w0;
  { const int rr = tid >> 3, c8 = (tid & 7) * 8, t = t0 - 1 + rr; if (t >= 0 && t < S) r.w0 = *(const v4u*)(u + (size_t)t * ld + j0 + c8); }
  if (tid < 16) { const int rr = 64 + (tid >> 3), c8 = (tid & 7) * 8, t = t0 - 1 + rr; if (t < S) r.w1 = *(const v4u*)(u + (size_t)t * ld + j0 + c8); }
  return r;
}
__device__ __forceinline__ void h0_compute(const H0Regs& rg, const float* cw, const float* cb, bf16_t* ucT, int tile, LAS unsigned char* lds, int tid) {
  const int tt = tile / 24, jt = tile % 24, t0 = tt * 64, j0 = jt * 64;
  LAS float* U = (LAS float*)lds;
  { const int rr = tid >> 3, c8 = (tid & 7) * 8; const v4u w = rg.w0; LAS float* d = U + rr * 65 + c8;
    d[0] = bf2f(w.x & 0xffff); d[1] = bf2f(w.x >> 16); d[2] = bf2f(w.y & 0xffff); d[3] = bf2f(w.y >> 16); d[4] = bf2f(w.z & 0xffff); d[5] = bf2f(w.z >> 16); d[6] = bf2f(w.w & 0xffff); d[7] = bf2f(w.w >> 16); }
  if (tid < 16) { const int rr = 64 + (tid >> 3), c8 = (tid & 7) * 8; const v4u w = rg.w1; LAS float* d = U + rr * 65 + c8;
    d[0] = bf2f(w.x & 0xffff); d[1] = bf2f(w.x >> 16); d[2] = bf2f(w.y & 0xffff); d[3] = bf2f(w.y >> 16); d[4] = bf2f(w.z & 0xffff); d[5] = bf2f(w.z >> 16); d[6] = bf2f(w.w & 0xffff); d[7] = bf2f(w.w >> 16); }
  __syncthreads();
  { const int jj = tid >> 3, tq = (tid & 7) * 8, j = j0 + jj; const float w0 = cw[j], w1 = cw[1536 + j], w2 = cw[2 * 1536 + j], bb = cb[j]; float v[8];
#pragma unroll
    for (int k = 0; k < 8; ++k) v[k] = bb + w0 * U[(tq + k) * 65 + jj] + w1 * U[(tq + k + 1) * 65 + jj] + w2 * U[(tq + k + 2) * 65 + jj];
    v4u o; o.x = pk2(v[0], v[1]); o.y = pk2(v[2], v[3]); o.z = pk2(v[4], v[5]); o.w = pk2(v[6], v[7]); *(v4u*)(ucT + (size_t)j * S + t0 + tq) = o; }
  __syncthreads();
}
__device__ __forceinline__ void h2_tile(const bf16_t* yT, bf16_t* ybf, int ldy, int tile, LAS unsigned char* lds) {
  int tid = threadIdx.x; asm volatile("" : "+v"(tid));
  const int tt = tile / 8, ct = tile % 8, t0 = tt * 64, c0 = ct * 64;
  LAS bf16_t* T = (LAS bf16_t*)lds;
  { const int cc = tid >> 3, t8 = (tid & 7) * 8; const v4u w = *(const v4u*)(yT + (size_t)(c0 + cc) * S + t0 + t8); LAS unsigned* d = (LAS unsigned*)(T + cc * 66 + t8); d[0] = w.x; d[1] = w.y; d[2] = w.z; d[3] = w.w; }
  __syncthreads();
  { const int t = tid >> 3, c8 = (tid & 7) * 8; unsigned short e[8];
#pragma unroll
    for (int k = 0; k < 8; ++k) e[k] = T[(c8 + k) * 66 + t];
    v4u o; o.x = e[0] | ((unsigned)e[1] << 16); o.y = e[2] | ((unsigned)e[3] << 16); o.z = e[4] | ((unsigned)e[5] << 16); o.w = e[6] | ((unsigned)e[7] << 16);
    *(v4u*)(ybf + (size_t)(t0 + t) * ldy + c0 + c8) = o; }
  __syncthreads();
}
__device__ __forceinline__ void h1_unit(const bf16_t* ucT, const float* tapsT, const float* nrm, const float* skip, bf16_t* yT, int c, LAS unsigned char* lds) {
  int tid = threadIdx.x; asm volatile("" : "+v"(tid));
  const int lane = tid & 63, w = __builtin_amdgcn_readfirstlane(tid >> 6), li = lane & 31, lk = lane >> 5;
  LAS float* TAPS = (LAS float*)(lds + O_TAPS); LAS float* ZA = (LAS float*)(lds + O_ZA); LAS float* ZB = (LAS float*)(lds + O_ZB);
  LAS float* X1 = (LAS float*)(lds + O_X1); LAS float* X2 = (LAS float*)(lds + O_X2); LAS float* RED = (LAS float*)(lds + O_RED);
  for (int e = tid; e < 32 * 62; e += 512) { const int s2 = e / 62, p = e % 62, t1p = p < 31 ? p : 128 + p; ZA[s2 * LDZ + t1p] = 0.f; ZB[s2 * LDZ + t1p] = 0.f; }
  for (int t = tid; t < S; t += 512) { const int t2 = t & 31, t1 = t >> 5;
    X1[t2 * LDX + t1] = bf2f(ucT[(size_t)c * S + t]); X2[t2 * LDX + t1] = bf2f(ucT[(size_t)(512 + c) * S + t]); ZA[t2 * LDZ + t1 + ZPAD] = bf2f(ucT[(size_t)(1024 + c) * S + t]); }
#pragma unroll 1
  for (int o = 0; o < 2; ++o) {
    const float* tp = tapsT + ((size_t)o * 512 + c) * 8192;
    for (int e = tid; e < 8192; e += 512) TAPS[e] = tp[(e + 4096) & 8191];
    __syncthreads();
    const LAS float* Zin = o == 0 ? ZA : ZB;
    const int g = w & 3, dh = w >> 2;
    const int Dlo = 32 * g - 127 + (dh ? 80 : 0), Dn = dh ? 79 : 80;
    f32x16 acc = {};
    { const LAS float* ap = TAPS + 4096 + 32 * Dlo + li - lk - 30;
      const LAS float* bp = Zin + lk * LDZ + (32 * g + li - Dlo + ZPAD);
#pragma unroll 2
      for (int dd = 0; dd < Dn; ++dd) {
#pragma unroll
        for (int kk = 0; kk < 16; ++kk) acc = __builtin_amdgcn_mfma_f32_32x32x2f32(ap[(15 - kk) * 2], bp[2 * kk * LDZ], acc, 0, 0, 0);
        ap += 32; bp -= 1; }
    }
    if (dh) {
#pragma unroll
      for (int r = 0; r < 16; ++r) RED[(g * 64 + lane) * 16 + r] = acc[r]; }
    __syncthreads();
    if (!dh) { const float inv = 1.f / nrm[o * 512 + c], sk = skip[o * 512 + c]; const LAS float* G = o == 0 ? X1 : X2; LAS float* Out = o == 0 ? ZB : ZA;
#pragma unroll
      for (int r = 0; r < 16; ++r) { const int t2 = (r & 3) + 8 * (r >> 2) + 4 * lk, t1 = 32 * g + li;
        const float cv = (acc[r] + RED[(g * 64 + lane) * 16 + r]) * inv; const float zin = Zin[t2 * LDZ + t1 + ZPAD];
        Out[t2 * LDZ + t1 + ZPAD] = G[t2 * LDX + t1] * (cv + sk * zin); } }
    __syncthreads();
  }
  for (int t = tid; t < S; t += 512) yT[(size_t)c * S + t] = (bf16_t)f2bf(ZA[(t & 31) * LDZ + (t >> 5) + ZPAD]);
  __syncthreads();
}

typedef short bf16x8v __attribute__((ext_vector_type(8)));
typedef unsigned u32x2v __attribute__((ext_vector_type(2)));
constexpr int CSB = 16448;
constexpr int ZROW = 80, ZROWS = 190;
constexpr int B_CS = 0, B_ZA = 4 * CSB, B_ZB = B_ZA + 15232, B_X1 = B_ZB + 15232, B_X2 = B_X1 + 8256, B_RED = B_X2 + 8256, B_END = B_RED + 16384;
static_assert(B_END <= 131072 && B_ZA % 16 == 0 && B_X1 % 16 == 0, "hyena bf16 lds");
__device__ __forceinline__ void h1b_unit(const bf16_t* ucT, const bf16_t* tapsB, const float* nrm, const float* skip, bf16_t* yT, int c, LAS unsigned char* lds) {
  int tid = threadIdx.x; asm volatile("" : "+v"(tid));
  const int lane = tid & 63, w = __builtin_amdgcn_readfirstlane(tid >> 6), li = lane & 31, lk = lane >> 5;
  LAS bf16_t* ZA = (LAS bf16_t*)(lds + B_ZA); LAS bf16_t* ZB = (LAS bf16_t*)(lds + B_ZB); LAS bf16_t* X1 = (LAS bf16_t*)(lds + B_X1); LAS bf16_t* X2 = (LAS bf16_t*)(lds + B_X2);
  LAS float* RED = (LAS float*)(lds + B_RED);
  for (int e = tid; e < 62 * 20; e += 512) { const int p = e / 20, d = e % 20, row = p < 31 ? p : 128 + p; ((LAS unsigned*)ZA)[row * 20 + d] = 0u; ((LAS unsigned*)ZB)[row * 20 + d] = 0u; }
  { const v4u zv = *(const v4u*)(ucT + (size_t)(1024 + c) * S + tid * 8); const int t = tid * 8; *(LAS v4u*)((LAS unsigned char*)ZA + ((t >> 5) + ZPAD) * ZROW + (t & 31) * 2) = zv; }
  { const v4u xa = *(const v4u*)(ucT + (size_t)c * S + tid * 8), xb = *(const v4u*)(ucT + (size_t)(512 + c) * S + tid * 8); const int t1 = tid >> 2, t2b = (tid & 3) * 8;
    const unsigned wa[4] = {xa.x, xa.y, xa.z, xa.w}, wb[4] = {xb.x, xb.y, xb.z, xb.w};
#pragma unroll
    for (int k = 0; k < 4; ++k) { X1[(t2b + 2 * k) * LDX + t1] = (bf16_t)(wa[k] & 0xffff); X1[(t2b + 2 * k + 1) * LDX + t1] = (bf16_t)(wa[k] >> 16);
      X2[(t2b + 2 * k) * LDX + t1] = (bf16_t)(wb[k] & 0xffff); X2[(t2b + 2 * k + 1) * LDX + t1] = (bf16_t)(wb[k] >> 16); } }
  typedef unsigned u4a __attribute__((ext_vector_type(4), aligned(4))); typedef const __attribute__((address_space(1))) u4a* gp4;
  v4u cv[9];
#pragma unroll 1
  for (int o = 0; o < 2; ++o) {
#define HTAPS_LOAD(oo) { const __attribute__((address_space(1))) unsigned char* tb = (const __attribute__((address_space(1))) unsigned char*)(tapsB + ((size_t)(oo) * 512 + c) * 2 * 8232); \
      _Pragma("unroll") for (int it = 0; it < 9; ++it) { const int e = tid + 512 * it; const int s = e / 1028, q = e % 1028; cv[it] = (v4u){0u, 0u, 0u, 0u}; if (e < 4 * 1028) cv[it] = *(gp4)(tb + (size_t)(s & 1) * 16464 + 16 * q + 4 * (s >> 1)); } }
    if (o == 0) HTAPS_LOAD(0)
    {
#pragma unroll
      for (int it = 0; it < 9; ++it) { const int e = tid + 512 * it; const int s = e / 1028, q = e % 1028; if (e < 4 * 1028) *(LAS v4u*)(lds + B_CS + s * CSB + 16 * q) = cv[it]; } }
    __syncthreads();
    if (o == 0) HTAPS_LOAD(1)
    const LAS bf16_t* Zin = o == 0 ? ZA : ZB;
    const int g = w & 3, dh = w >> 2;
    const int Dlo = 32 * g - 127 + (dh ? 81 : 0), Dn = dh ? 78 : 81;
    f32x16 acc = {};
    { const int s = (4 - (li & 3)) & 3;
      const LAS unsigned char* ap = lds + B_CS + s * CSB + 2 * (4096 - 32 * Dlo - li + 8 * lk - s);
      const LAS unsigned char* bp = (const LAS unsigned char*)Zin + (32 * g + li - Dlo + ZPAD) * ZROW + 16 * lk;
#define HLD(A0, A1, B0, B1) { const u32x2v p0_ = *(const LAS u32x2v*)(ap), p1_ = *(const LAS u32x2v*)(ap2), p2_ = *(const LAS u32x2v*)(ap3), p3_ = *(const LAS u32x2v*)(ap4); \
        A0 = (v4u){p0_.x, p0_.y, p1_.x, p1_.y}; A1 = (v4u){p2_.x, p2_.y, p3_.x, p3_.y}; B0 = *(const LAS v4u*)(bp); B1 = *(const LAS v4u*)(bp + 32); ap -= 64; ap2 -= 64; ap3 -= 64; ap4 -= 64; bp -= ZROW; }
#define HMM(A, B) acc = __builtin_amdgcn_mfma_f32_32x32x16_bf16(__builtin_bit_cast(bf16x8v, A), __builtin_bit_cast(bf16x8v, B), acc, 0, 0, 0)
#define HOPQ(name, off) unsigned name##i = (unsigned)(unsigned long long)(ap + (off)); asm volatile("" : "+v"(name##i)); const LAS unsigned char* name = (const LAS unsigned char*)(unsigned long long)name##i;
      HOPQ(ap2, 8) HOPQ(ap3, 32) HOPQ(ap4, 40)
#undef HOPQ
      v4u fa0, fa1, fb0, fb1, ga0, ga1, gb0, gb1, ha0, ha1, hb0, hb1;
      HLD(fa0, fa1, fb0, fb1)
      HLD(ga0, ga1, gb0, gb1)
      for (int dd_ = 0; dd_ < Dn - 3; dd_ += 3) {
        HLD(ha0, ha1, hb0, hb1)
        HMM(fa0, fb0); HMM(fa1, fb1);
        HLD(fa0, fa1, fb0, fb1)
        HMM(ga0, gb0); HMM(ga1, gb1);
        HLD(ga0, ga1, gb0, gb1)
        HMM(ha0, hb0); HMM(ha1, hb1);
      }
      HLD(ha0, ha1, hb0, hb1)
      HMM(fa0, fb0); HMM(fa1, fb1); HMM(ga0, gb0); HMM(ga1, gb1); HMM(ha0, hb0); HMM(ha1, hb1);
#undef HLD
#undef HMM
    }
    if (dh) {
#pragma unroll
      for (int r = 0; r < 16; ++r) RED[(g * 64 + lane) * 16 + r] = acc[r]; }
    __syncthreads();
    if (!dh) { const float inv = 1.f / nrm[o * 512 + c], sk = skip[o * 512 + c]; const LAS bf16_t* G = o == 0 ? X1 : X2; LAS bf16_t* Out = o == 0 ? ZB : ZA;
#pragma unroll
      for (int r = 0; r < 16; ++r) { const int t2 = (r & 3) + 8 * (r >> 2) + 4 * lk, t1 = 32 * g + li;
        const float cv = (acc[r] + RED[(g * 64 + lane) * 16 + r]) * inv; const float zin = bf2f(Zin[(t1 + ZPAD) * (ZROW / 2) + t2]);
        Out[(t1 + ZPAD) * (ZROW / 2) + t2] = (bf16_t)f2bf(bf2f(G[t2 * LDX + t1]) * (cv + sk * zin)); } }
    __syncthreads();
  }
  { const int t = tid * 8; *(v4u*)(yT + (size_t)c * S + t) = *(const LAS v4u*)((const LAS unsigned char*)ZA + ((t >> 5) + ZPAD) * ZROW + (t & 31) * 2); }
  __syncthreads();
}
#undef HTAPS_LOAD

constexpr int C_ZP = 15, C_ZB = 159 * ZROW  , C_CS = 0, C_Z0 = 4 * CSB, C_X0 = C_Z0 + 2 * C_ZB, C_END = C_X0 + 4 * 8256;
static_assert(C_END <= 131072 && C_Z0 % 16 == 0 && C_ZB % 16 == 0 && C_X0 % 16 == 0, "hyena two-batch lds");
__device__ __forceinline__ void h1c_unit(const bf16_t* ucT2, const bf16_t* tapsB, const float* nrm, const float* skip, bf16_t* yT2, int c, LAS unsigned char* lds) {
  int tid = threadIdx.x; asm volatile("" : "+v"(tid));
  const int lane = tid & 63, g = __builtin_amdgcn_readfirstlane(tid >> 6), li = lane & 31, lk = lane >> 5, bsel = li >> 4, t1l = li & 15;
  for (int e = tid; e < 2 * 31 * 20; e += 512) { const int b = e / (31 * 20), p = (e / 20) % 31, d = e % 20, row = p < 15 ? p : 128 + p; ((LAS unsigned*)(lds + C_Z0 + b * C_ZB))[row * 20 + d] = 0u; }
#pragma unroll
  for (int b = 0; b < 2; ++b) { const bf16_t* uc = ucT2 + (size_t)b * 1536 * S; const int t = tid * 8;
    const v4u zv = *(const v4u*)(uc + (size_t)(1024 + c) * S + t), xa = *(const v4u*)(uc + (size_t)c * S + t), xb = *(const v4u*)(uc + (size_t)(512 + c) * S + t);
    *(LAS v4u*)(lds + C_Z0 + b * C_ZB + ((t >> 5) + C_ZP) * ZROW + (t & 31) * 2) = zv;
    LAS bf16_t* X1 = (LAS bf16_t*)(lds + C_X0 + (2 * b) * 8256); LAS bf16_t* X2 = (LAS bf16_t*)(lds + C_X0 + (2 * b + 1) * 8256); const int t1 = tid >> 2, t2b = (tid & 3) * 8;
    const unsigned wa[4] = {xa.x, xa.y, xa.z, xa.w}, wb[4] = {xb.x, xb.y, xb.z, xb.w};
#pragma unroll
    for (int k = 0; k < 4; ++k) { X1[(t2b + 2 * k) * LDX + t1] = (bf16_t)(wa[k] & 0xffff); X1[(t2b + 2 * k + 1) * LDX + t1] = (bf16_t)(wa[k] >> 16);
      X2[(t2b + 2 * k) * LDX + t1] = (bf16_t)(wb[k] & 0xffff); X2[(t2b + 2 * k + 1) * LDX + t1] = (bf16_t)(wb[k] >> 16); } }
  typedef unsigned u4a __attribute__((ext_vector_type(4), aligned(4))); typedef const __attribute__((address_space(1))) u4a* gp4;
  v4u cv[9];
  LAS bf16_t* Zm = (LAS bf16_t*)(lds + C_Z0 + bsel * C_ZB);
#pragma unroll 1
  for (int o = 0; o < 2; ++o) {
#define HTAPS_LOAD(oo) { const __attribute__((address_space(1))) unsigned char* tb = (const __attribute__((address_space(1))) unsigned char*)(tapsB + ((size_t)(oo) * 512 + c) * 2 * 8232); \
      _Pragma("unroll") for (int it = 0; it < 9; ++it) { const int e = tid + 512 * it; const int s = e / 1028, q = e % 1028; cv[it] = (v4u){0u, 0u, 0u, 0u}; if (e < 4 * 1028) cv[it] = *(gp4)(tb + (size_t)(s & 1) * 16464 + 16 * q + 4 * (s >> 1)); } }
    if (o == 0) HTAPS_LOAD(0)
    {
#pragma unroll
      for (int it = 0; it < 9; ++it) { const int e = tid + 512 * it; const int s = e / 1028, q = e % 1028; if (e < 4 * 1028) *(LAS v4u*)(lds + C_CS + s * CSB + 16 * q) = cv[it]; } }
    __syncthreads();
    if (o == 0) HTAPS_LOAD(1)
    const int Dlo = 16 * g - 128; constexpr int Dn = 144;
    f32x16 acc = {};
    { const int s = (4 - (li & 3)) & 3;
      const LAS unsigned char* ap = lds + C_CS + s * CSB + 2 * (4096 - 32 * Dlo - li + 8 * lk - s);
      const LAS unsigned char* bp = (const LAS unsigned char*)Zm + (16 * g + t1l - Dlo + C_ZP) * ZROW + 16 * lk;
#define HLD(A0, A1, B0, B1) { const u32x2v p0_ = *(const LAS u32x2v*)(ap), p1_ = *(const LAS u32x2v*)(ap2), p2_ = *(const LAS u32x2v*)(ap3), p3_ = *(const LAS u32x2v*)(ap4); \
        A0 = (v4u){p0_.x, p0_.y, p1_.x, p1_.y}; A1 = (v4u){p2_.x, p2_.y, p3_.x, p3_.y}; B0 = *(const LAS v4u*)(bp); B1 = *(const LAS v4u*)(bp + 32); ap -= 64; ap2 -= 64; ap3 -= 64; ap4 -= 64; bp -= ZROW; }
#define HMM(A, B) acc = __builtin_amdgcn_mfma_f32_32x32x16_bf16(__builtin_bit_cast(bf16x8v, A), __builtin_bit_cast(bf16x8v, B), acc, 0, 0, 0)
#define HOPQ(name, off) unsigned name##i = (unsigned)(unsigned long long)(ap + (off)); asm volatile("" : "+v"(name##i)); const LAS unsigned char* name = (const LAS unsigned char*)(unsigned long long)name##i;
      HOPQ(ap2, 8) HOPQ(ap3, 32) HOPQ(ap4, 40)
#undef HOPQ
      v4u fa0, fa1, fb0, fb1, ga0, ga1, gb0, gb1, ha0, ha1, hb0, hb1;
      HLD(fa0, fa1, fb0, fb1)
      HLD(ga0, ga1, gb0, gb1)
      for (int dd_ = 0; dd_ < Dn - 3; dd_ += 3) {
        HLD(ha0, ha1, hb0, hb1)
        HMM(fa0, fb0); HMM(fa1, fb1);
        HLD(fa0, fa1, fb0, fb1)
        HMM(ga0, gb0); HMM(ga1, gb1);
        HLD(ga0, ga1, gb0, gb1)
        HMM(ha0, hb0); HMM(ha1, hb1);
      }
      HLD(ha0, ha1, hb0, hb1)
      HMM(fa0, fb0); HMM(fa1, fb1); HMM(ga0, gb0); HMM(ga1, gb1); HMM(ha0, hb0); HMM(ha1, hb1);
#undef HLD
#undef HMM
    }
    __syncthreads();
    { const float inv = 1.f / nrm[o * 512 + c], sk = skip[o * 512 + c]; const LAS bf16_t* G = (const LAS bf16_t*)(lds + C_X0 + (2 * bsel + o) * 8256);
#pragma unroll
      for (int r = 0; r < 16; ++r) { const int t2 = (r & 3) + 8 * (r >> 2) + 4 * lk, t1 = 16 * g + t1l;
        const float cvv = acc[r] * inv; const float zin = bf2f(Zm[(t1 + C_ZP) * (ZROW / 2) + t2]);
        Zm[(t1 + C_ZP) * (ZROW / 2) + t2] = (bf16_t)f2bf(bf2f(G[t2 * LDX + t1]) * (cvv + sk * zin)); } }
    __syncthreads();
  }
#pragma unroll
  for (int b = 0; b < 2; ++b) { const int t = tid * 8; *(v4u*)(yT2 + (size_t)b * 512 * S + (size_t)c * S + t) = *(const LAS v4u*)(lds + C_Z0 + b * C_ZB + ((t >> 5) + C_ZP) * ZROW + (t & 31) * 2); }
  __syncthreads();
#undef HTAPS_LOAD
}
__device__ __forceinline__ void cconv3_item(const bf16_t* u, int ld, const float* cw, const float* cb, float* ucc, long idx) {
  const int j = (int)(idx % 1536); const int tc = (int)(idx / 1536);
  const bf16_t* up = u + (size_t)tc * ld + j;
  float v = cb[j] + cw[1536 + j] * bf2f(up[0]);
  if (tc > 0) v += cw[j] * bf2f(*(up - ld)); if (tc < 255) v += cw[2 * 1536 + j] * bf2f(up[ld]);
  ucc[idx] = v;
}
__device__ __forceinline__ void clong_item(const float* ucc, const float* z1c_in, float* z1c_out, bf16_t* yout, int ldy, const float* tapsC, const float* nrmC, const float* skip, int o, long idx) {
  const int c = (int)(idx % 512), t0 = (int)(idx / 512) * 8; constexpr int n = 256;
  const float* tp = tapsC + (size_t)o * 2 * n * 512 + c; const float nr = nrmC[o * 512 + c];
  const float* zs = o == 0 ? ucc + 1024 + c : z1c_in + c; const int ldz = o == 0 ? 1536 : 512;
  float acc[8], w[8];
#pragma unroll
  for (int i = 0; i < 8; ++i) { acc[i] = 0.f; const int lag = t0 + i; w[i] = tp[(size_t)lag * 512]; }
#pragma unroll 4
  for (int s = 0; s < n; ++s) { const float zv = zs[(size_t)s * ldz];
#pragma unroll
    for (int i = 0; i < 8; ++i) acc[i] += w[i] * zv;
    const int lag = t0 - s - 1;
    const float nw = tp[(size_t)(lag >= 0 ? lag : 2 * n + lag) * 512];
#pragma unroll
    for (int i = 7; i > 0; --i) w[i] = w[i - 1];
    w[0] = nw; }
  const float sk = skip[o * 512 + c];
#pragma unroll
  for (int i = 0; i < 8; ++i) { const int t = t0 + i; const float val = ucc[(size_t)t * 1536 + o * 512 + c] * (acc[i] / nr + sk * zs[(size_t)t * ldz]);
    if (o == 0) z1c_out[(size_t)t * 512 + c] = val; else yout[(size_t)t * ldy + c] = (bf16_t)f2bf(val); }
}
}
#define XB_TMO      128
#define XB_XCNT(j)  (256  + 64 * (j))
#define XB_XSUB(j)  (1280 + 64 * (j))
#define XB_XGEN(j)  (2304 + 64 * (j))
#define XB_TOP      3328
#define XB_TOPGEN   3392
#define XCD_BAR_WORDS 3456
#define XB_SPIN_CAP (1u << 18)

__device__ __forceinline__ unsigned xb_ld(unsigned* p)              { return __hip_atomic_load(p, __ATOMIC_RELAXED, __HIP_MEMORY_SCOPE_AGENT); }
__device__ __forceinline__ unsigned xb_add(unsigned* p, unsigned v) { return __hip_atomic_fetch_add(p, v, __ATOMIC_RELAXED, __HIP_MEMORY_SCOPE_AGENT); }
__device__ __forceinline__ unsigned xb_xcc_id() { return (unsigned)__builtin_amdgcn_s_getreg((3 << 11) | 20) & 0xFu; }
#define XB_SPIN(cond, bar) do { unsigned _sp = 0; while (cond) { __builtin_amdgcn_s_sleep(1); \
    if ((++_sp & 255u) == 0u) { if (xb_ld(&(bar)[XB_TMO])) break; if (_sp > XB_SPIN_CAP) { atomicAdd(&(bar)[XB_TMO], 1u); break; } } } } while (0)

struct XcdBarrier {
    unsigned* bar; unsigned x;
    volatile LAS unsigned* st;
};

__device__ __forceinline__ XcdBarrier xcd_barrier_post(unsigned* bar, volatile LAS unsigned* st) {
    XcdBarrier b; b.bar = bar; b.x = xb_xcc_id(); b.st = st;
    if (threadIdx.x == 0) (void)xb_add(&bar[XB_XCNT(b.x)], 1u);
    return b;
}
__device__ __forceinline__ void xcd_barrier_complete(unsigned* bar, unsigned x, unsigned& nloc, unsigned& nx) {
    const unsigned G = gridDim.x * gridDim.y * gridDim.z;
    unsigned sum, cnt, mine, sp = 0u;
    for (;;) {
        sum = 0u; cnt = 0u; mine = 0u;
#pragma unroll
        for (unsigned j = 0; j < 16; ++j) { const unsigned c = xb_ld(&bar[XB_XCNT(j)]); sum += c; cnt += (c > 0u) ? 1u : 0u; mine = (j == x) ? c : mine; }
        if (sum == G) break;
        __builtin_amdgcn_s_sleep(1);
        if ((++sp & 255u) == 0u) { if (xb_ld(&bar[XB_TMO])) break; if (sp > XB_SPIN_CAP) { atomicAdd(&bar[XB_TMO], 1u); break; } }
    }
    nloc = mine > 0u ? mine : 1u; nx = cnt > 0u ? cnt : 1u;
}

__device__ __forceinline__ void xcd_barrier(const XcdBarrier& b) {
    asm volatile("s_waitcnt vmcnt(0)" ::: "memory");
    __syncthreads();
    if (threadIdx.x == 0) {
        unsigned* bar = b.bar;
#define XB_SP(word) ((unsigned*)((((unsigned long long)(unsigned)__builtin_amdgcn_readfirstlane((int)((unsigned long long)(bar + (word)) >> 32))) << 32) | (unsigned)__builtin_amdgcn_readfirstlane((int)(unsigned)(unsigned long long)(bar + (word)))))
        unsigned* const p_xsub = XB_SP(XB_XSUB(b.x)); unsigned* const p_xgen = XB_SP(XB_XGEN(b.x));
        __builtin_amdgcn_s_waitcnt(0);
        unsigned nloc = b.st[0], nx = b.st[1];
        if (nloc == 0u) { xcd_barrier_complete(bar, b.x, nloc, nx); b.st[0] = nloc; b.st[1] = nx; }
        const unsigned old = xb_add(p_xsub, 1u);
        const unsigned gen = old / nloc;
        if (old + 1u == (gen + 1u) * nloc) {
            __builtin_amdgcn_fence(__ATOMIC_RELEASE, "agent");
            asm volatile("s_waitcnt vmcnt(0)" ::: "memory");
            const unsigned og = xb_add(&bar[XB_TOP], 1u);
            const unsigned tg = og / nx;
            if (og + 1u == (tg + 1u) * nx) xb_add(&bar[XB_TOPGEN], 1u);
            else XB_SPIN(xb_ld(&bar[XB_TOPGEN]) == tg, bar);
            __builtin_amdgcn_fence(__ATOMIC_ACQUIRE, "agent");
            xb_add(p_xgen, 1u);
            asm volatile("s_waitcnt vmcnt(0)" ::: "memory");
        } else {
            XB_SPIN(xb_ld(p_xgen) == gen, bar);
            __builtin_amdgcn_fence(__ATOMIC_ACQUIRE, "agent");
            asm volatile("s_waitcnt vmcnt(0)" ::: "memory");
        }
    }
    __syncthreads();
}
#include <math.h>
#ifdef HOST_TEST
#define HD
#define FEXP expf
#define FSIN sinf
#define FCOS cosf
#define FLOG logf
#define FPOW powf
#else
#define HD __device__ __forceinline__
#define FEXP __expf
#define FSIN __sinf
#define FCOS __cosf
#define FLOG __logf
#define FPOW __powf
#endif

struct FullDims { static constexpr int D=1024,B=8,S=4096,DEPTH=2,C=256,GW=64,AH=8,AKV=2,HDM=128,GH=4,GDK=64,GDV=128,GR=16,HW=512,HB=16,HF=64,NE=16,NG=4,DE=512; };
struct SmallDims { static constexpr int D=64,B=2,S=128,DEPTH=2,C=32,GW=16,AH=4,AKV=2,HDM=16,GH=2,GDK=8,GDV=16,GR=4,HW=32,HB=4,HF=8,NE=8,NG=2,DE=32; };

template <class T> struct DD {
  static constexpr int D=T::D,B=T::B,S=T::S,DEPTH=T::DEPTH,C=T::C,GW=T::GW,AH=T::AH,AKV=T::AKV,HDM=T::HDM,GH=T::GH,GDK=T::GDK,GDV=T::GDV,GR=T::GR,HW=T::HW,HB=T::HB,HF=T::HF,NE=T::NE,NG=T::NG,DE=T::DE;
  static constexpr int R=S+C, AG=AH/AKV, RP=HDM/4, HE=1+2*HB, EPG=NE/NG, AQW=AH*HDM, AKVW=AKV*HDM, GKW=GH*GDK, GVW=GH*GDV;
  static constexpr int NKV=AKVW+AKVW+GKW+GVW+2*GR, NIN=NKV+AQW+GKW+GVW+3*HW+3*D;
  static constexpr int O_AK=0, O_AV=AKVW, O_GK=2*AKVW, O_GV=2*AKVW+GKW, O_GA=2*AKVW+GKW+GVW;
  static constexpr int O_AQ=NKV, O_GQ=NKV+AQW, O_OG=O_GQ+GKW, O_HY=O_OG+GVW, O_BR=O_HY+3*HW;
};

struct NaiveBufs {
  const float *x,*c,*ctx,*c_ctx,*w_mod,*b_mod,*norm1_g,*norm2_g,*w_in,*q_norm_g,*k_norm_g,*gla_wa2,*gla_ba,*gla_norm_g,*hy_conv_w,*hy_conv_b,
    *hy_pos_w1,*hy_pos_b1,*hy_sin_freq,*hy_pos_w2,*hy_pos_b2,*hy_pos_w3,*hy_decay,*hy_skip,*w_br_hy,*w_br_gla,*w_br_att,*w_out,*router_w,*router_b,*moe_w_gate,*moe_w_up,*moe_w_down;
  float* out;
  float *mod;
  float *hid2S,*hid2C;
  float *tapsS,*tapsC;
  float *nrmS,*nrmC;
  float *rs;
  float *h;
  float *proj;
  float *qn,*kn;
  float *yatt;
  float *laf,*lab;
  float *of,*ob;
  float *ygla;
  float *uc;
  float *z1,*yhy;
  float *m;
  int   *ridx;
  float *rw;
  float *hid;
  float *xc;
};

HD float sigmoidf_(float x) { return 1.f / (1.f + FEXP(-x)); }
HD float siluf_(float x) { return x / (1.f + FEXP(-x)); }
HD float logsigmoidf_(float x) { return x < 0.f ? x - FLOG(1.f + FEXP(x)) : -FLOG(1.f + FEXP(-x)); }

template <class T> HD void st_mod(const NaiveBufs& a, int l, long idx) {
  using d = DD<T>; const int j = (int)(idx % (6 * d::D)), bb = (int)(idx / (6 * d::D));
  const float* cv = bb < d::B ? a.c + (long)bb * d::D : a.c_ctx; const float* w = a.w_mod + (long)l * d::D * 6 * d::D;
  float acc = a.b_mod[(long)l * 6 * d::D + j];
  for (int k = 0; k < d::D; ++k) acc += siluf_(cv[k]) * w[(long)k * 6 * d::D + j];
  a.mod[idx] = acc;
}
template <class T> HD void st_hyhid(const NaiveBufs& a, int l, int which, long idx) {
  using d = DD<T>; const int n = which ? d::C : d::S; float* dst = which ? a.hid2C : a.hid2S;
  const int j = (int)(idx % d::HF), t = (int)(idx / d::HF);
  const float* w1 = a.hy_pos_w1 + (long)l * d::HE * d::HF; const float* b1 = a.hy_pos_b1 + l * d::HF; const float* fr = a.hy_sin_freq + l * d::HF;
  const float* w2 = a.hy_pos_w2 + (long)l * d::HF * d::HF; const float* b2 = a.hy_pos_b2 + l * d::HF;
  const float tn = (float)t / (float)n; const float w0 = 2.f * 3.14159265358979323846f / (float)n;
  float acc2 = b2[j];
  for (int i = 0; i < d::HF; ++i) {
    float acc = b1[i] + tn * w1[0 * d::HF + i];
    for (int bnd = 0; bnd < d::HB; ++bnd) {
      const float band = 1e-4f + (float)bnd * ((float)(d::HB - 1) - 1e-4f) / (float)(d::HB - 1);
      const float ph = w0 * (float)t * band;
      acc += FCOS(ph) * w1[(1 + bnd) * d::HF + i] - FSIN(ph) * w1[(1 + d::HB + bnd) * d::HF + i];
    }
    acc2 += FSIN(fr[i] * acc) * w2[i * d::HF + j];
  }
  dst[idx] = FSIN(fr[j] * acc2);
}
template <class T> HD void st_hytaps(const NaiveBufs& a, int l, int which, long idx) {
  using d = DD<T>; const int n = which ? d::C : d::S; const float* hid2 = which ? a.hid2C : a.hid2S; float* dst = which ? a.tapsC : a.tapsS;
  const int c = (int)(idx % d::HW); const int li = (int)((idx / d::HW) % (2 * n)); const int o = (int)(idx / ((long)d::HW * 2 * n));
  float v = 0.f;
  if (li != n) {
    const int dir = li < n ? 0 : 1; const int t = li < n ? li : 2 * n - li;
    const int col = (o * 2 + dir) * d::HW + c;
    const float* w3 = a.hy_pos_w3 + (long)l * d::HF * 4 * d::HW;
    float acc = 0.f;
    for (int j = 0; j < d::HF; ++j) acc += hid2[(long)t * d::HF + j] * w3[(long)j * 4 * d::HW + col];
    const float dec = fabsf(a.hy_decay[(long)l * 4 * d::HW + col]);
    v = acc * FEXP(-((float)t / (float)n) * dec);
  }
  if (which == 0) dst[((long)o * d::HW + c) * 2 * n + li] = v; else dst[idx] = v;
}
template <class T> HD void st_hynorm(const NaiveBufs& a, int which, long idx) {
  using d = DD<T>; const int n = which ? d::C : d::S; const float* tp = which ? a.tapsC : a.tapsS; float* dst = which ? a.nrmC : a.nrmS;
  const int c = (int)(idx % d::HW), o = (int)(idx / d::HW);
  float s = 0.f; for (int li = 0; li < 2 * n; ++li) s += fabsf(which == 0 ? tp[((long)o * d::HW + c) * 2 * n + li] : tp[((long)o * 2 * n + li) * d::HW + c]);
  dst[idx] = s + 1e-6f;
}

template <class T> HD const float* xrow(const NaiveBufs& a, int l, int b, int r) {
  using d = DD<T>;
  if (r < d::S) return (l == 0 ? a.x : a.out) + ((long)b * d::S + r) * d::D;
  return (l == 0 ? a.ctx : a.xc) + ((long)b * d::C + (r - d::S)) * d::D;
}
template <class T> HD float* xrow_w(const NaiveBufs& a, int b, int r) {
  using d = DD<T>;
  if (r < d::S) return a.out + ((long)b * d::S + r) * d::D;
  return a.xc + ((long)b * d::C + (r - d::S)) * d::D;
}
template <class T> HD void st_rs(const NaiveBufs& a, int l, int b, int src, long idx) {
  using d = DD<T>; const int r = (int)idx; const float* xr = src ? (const float*)xrow_w<T>(a, b, r) : xrow<T>(a, l, b, r);
  float s = 0.f; for (int k = 0; k < d::D; ++k) s += xr[k] * xr[k];
  a.rs[r] = 1.f / sqrtf(s / (float)d::D + 1e-6f);
}
template <class T> HD void st_norm(const NaiveBufs& a, int l, int b, int which, long idx) {
  using d = DD<T>; const int j = (int)(idx % d::D), r = (int)(idx / d::D);
  const float* xr = which ? (const float*)xrow_w<T>(a, b, r) : xrow<T>(a, l, b, r);
  const float* g = (which ? a.norm2_g : a.norm1_g) + (long)l * d::D;
  const float* md = a.mod + (long)(r < d::S ? b : d::B) * 6 * d::D;
  const float shift = md[(which ? 3 : 0) * d::D + j], scale = md[(which ? 4 : 1) * d::D + j];
  a.h[idx] = xr[j] * a.rs[r] * g[j] * (1.f + scale) + shift;
}
struct GemmArgs { const float* A; int lda; const float* W; int ldw; float* Cc; int ldc; int M, N, K;
  const float* gate; int ldg;
  const float* colscale;
  const float* res; int ldr;
  int accumulate; };
HD void st_gemm(const GemmArgs& g, long idx) {
  const int nb = g.N / 4; const int cb = (int)(idx % nb), rb = (int)(idx / nb);
  float acc[4][4];
#pragma unroll
  for (int i = 0; i < 4; ++i) {
#pragma unroll
    for (int j = 0; j < 4; ++j) acc[i][j] = 0.f; }
  const float* a0 = g.A + (long)(rb * 4) * g.lda; const float* w0 = g.W + cb * 4;
  for (int k = 0; k < g.K; ++k) {
    float av[4], wv[4];
#pragma unroll
    for (int i = 0; i < 4; ++i) av[i] = a0[(long)i * g.lda + k];
#pragma unroll
    for (int j = 0; j < 4; ++j) wv[j] = w0[(long)k * g.ldw + j];
#pragma unroll
    for (int i = 0; i < 4; ++i) {
#pragma unroll
      for (int j = 0; j < 4; ++j) acc[i][j] += av[i] * wv[j]; }
  }
#pragma unroll
  for (int i = 0; i < 4; ++i)
#pragma unroll
  for (int j = 0; j < 4; ++j) {
    const int r = rb * 4 + i, c = cb * 4 + j; float v = acc[i][j];
    if (g.gate) v *= sigmoidf_(g.gate[(long)r * g.ldg + c]);
    if (g.colscale) v *= g.colscale[c];
    if (g.res) v += g.res[(long)r * g.ldr + c];
    float* p = g.Cc + (long)r * g.ldc + c;
    if (g.accumulate) v += *p;
    *p = v;
  }
}
template <class T> HD void st_qknorm(const NaiveBufs& a, int l, long idx) {
  using d = DD<T>; const int hh = (int)(idx % (d::AH + d::AKV)), r = (int)(idx / (d::AH + d::AKV));
  const bool isq = hh < d::AH; const int hd = isq ? hh : hh - d::AH;
  const float* src = a.proj + (long)r * d::NIN + (isq ? d::O_AQ : d::O_AK) + hd * d::HDM;
  float* dst = (isq ? a.qn + (long)r * d::AQW : a.kn + (long)r * d::AKVW) + hd * d::HDM;
  const float* g = (isq ? a.q_norm_g : a.k_norm_g) + (long)l * d::HDM;
  float s = 0.f; for (int k = 0; k < d::HDM; ++k) s += src[k] * src[k];
  const float rsq = 1.f / sqrtf(s / (float)d::HDM + 1e-6f);
  if (r < d::S) {
    const int row = r / d::GW, col = r % d::GW;
    for (int p = 0; p < d::HDM / 2; ++p) {
      const int fi = p < d::RP ? p : p - d::RP; const float pos = p < d::RP ? (float)row : (float)col;
      const float inv = FPOW(10000.f, -(float)fi / (float)d::RP); const float ang = pos * inv;
      const float cs = FCOS(ang), sn = FSIN(ang);
      const float x1 = src[2 * p] * rsq * g[2 * p], x2 = src[2 * p + 1] * rsq * g[2 * p + 1];
      dst[2 * p] = x1 * cs - x2 * sn; dst[2 * p + 1] = x1 * sn + x2 * cs;
    }
  } else { for (int k = 0; k < d::HDM; ++k) dst[k] = src[k] * rsq * g[k]; }
}
template <class T, int NSPLIT> HD void st_attn(const NaiveBufs& a, int r0, int nrows, long idx) {
  using d = DD<T>; constexpr int OD = d::HDM / NSPLIT;
  const int r = r0 + (int)(idx % nrows); const int hs = (int)(idx / nrows); const int part = hs % NSPLIT, hq = hs / NSPLIT; const int kv = hq / d::AG;
  const int k0 = r < d::S ? 0 : d::S, k1 = d::R;
  float q[d::HDM], o[OD];
  const float scale = 1.f / sqrtf((float)d::HDM);
#pragma unroll
  for (int k = 0; k < d::HDM; ++k) q[k] = a.qn[(long)r * d::AQW + hq * d::HDM + k] * scale;
#pragma unroll
  for (int k = 0; k < OD; ++k) o[k] = 0.f;
  float mx = -1e30f, lsum = 0.f;
  for (int kk = k0; kk < k1; ++kk) {
    const float* kr = a.kn + (long)kk * d::AKVW + kv * d::HDM;
    float s = 0.f;
#pragma unroll
    for (int k = 0; k < d::HDM; ++k) s += q[k] * kr[k];
    if (s > mx) { const float cr = FEXP(mx - s); lsum *= cr;
#pragma unroll
      for (int k = 0; k < OD; ++k) o[k] *= cr;
      mx = s; }
    const float p = FEXP(s - mx); lsum += p;
    const float* vr = a.proj + (long)kk * d::NIN + d::O_AV + kv * d::HDM + part * OD;
#pragma unroll
    for (int k = 0; k < OD; ++k) o[k] += p * vr[k];
  }
  const float inv = 1.f / lsum;
#pragma unroll
  for (int k = 0; k < OD; ++k) a.yatt[(long)r * d::AQW + hq * d::HDM + part * OD + k] = o[k] * inv;
}
template <class T> HD void st_glala(const NaiveBufs& a, int l, long idx) {
  using d = DD<T>; const int j = (int)(idx % d::GKW); const int dir = (int)((idx / d::GKW) % 2); const int r = (int)(idx / (2 * d::GKW));
  const float* al = a.proj + (long)r * d::NIN + d::O_GA + dir * d::GR;
  const float* w2 = a.gla_wa2 + ((long)l * 2 + dir) * d::GR * d::GKW; float z = a.gla_ba[((long)l * 2 + dir) * d::GKW + j];
  for (int k = 0; k < d::GR; ++k) z += al[k] * w2[(long)k * d::GKW + j];
  (dir ? a.lab : a.laf)[(long)r * d::GKW + j] = FEXP(logsigmoidf_(z) / 16.f);
}
template <class T> HD void st_glascan(const NaiveBufs& a, long idx) {
  using d = DD<T>; const int v = (int)(idx % d::GDV); const int hd = (int)((idx / d::GDV) % d::GH); const int dir = (int)(idx / (d::GDV * d::GH));
  float st[d::GDK];
#pragma unroll
  for (int k = 0; k < d::GDK; ++k) st[k] = 0.f;
  const float qs = 1.f / sqrtf((float)d::GDK);
  const float* la = dir ? a.lab : a.laf; float* od = dir ? a.ob : a.of;
  for (int step = 0; step < d::R; ++step) {
    int r;
    if (step < d::C) r = d::S + (dir ? d::C - 1 - step : step); else r = dir ? d::S - 1 - (step - d::C) : step - d::C;
    const float* pr = a.proj + (long)r * d::NIN;
    const float vv = pr[d::O_GV + hd * d::GDV + v];
    float o = 0.f;
#pragma unroll
    for (int k = 0; k < d::GDK; ++k) {
      st[k] = la[(long)r * d::GKW + hd * d::GDK + k] * st[k] + pr[d::O_GK + hd * d::GDK + k] * vv;
      o += pr[d::O_GQ + hd * d::GDK + k] * qs * st[k];
    }
    od[(long)r * d::GVW + hd * d::GDV + v] = o;
  }
}
template <class T> HD void st_glaout(const NaiveBufs& a, int l, long idx) {
  using d = DD<T>; const int hd = (int)(idx % d::GH), r = (int)(idx / d::GH);
  const long base = (long)r * d::GVW + hd * d::GDV; float s = 0.f;
  for (int v = 0; v < d::GDV; ++v) { const float o = a.of[base + v] + a.ob[base + v]; s += o * o; }
  const float rsq = 1.f / sqrtf(s / (float)d::GDV + 1e-6f);
  for (int v = 0; v < d::GDV; ++v) { const float o = a.of[base + v] + a.ob[base + v];
    a.ygla[base + v] = o * rsq * a.gla_norm_g[(long)l * d::GDV + v] * siluf_(a.proj[(long)r * d::NIN + d::O_OG + hd * d::GDV + v]); }
}
template <class T> HD void st_hyconv3(const NaiveBufs& a, int l, long idx) {
  using d = DD<T>; const int j = (int)(idx % (3 * d::HW)), r = (int)(idx / (3 * d::HW));
  const int lo = r < d::S ? 0 : d::S, hi = r < d::S ? d::S : d::R;
  const float* w = a.hy_conv_w + (long)l * 3 * 3 * d::HW;
  float v = a.hy_conv_b[(long)l * 3 * d::HW + j] + a.proj[(long)r * d::NIN + d::O_HY + j] * w[1 * 3 * d::HW + j];
  if (r - 1 >= lo) v += a.proj[(long)(r - 1) * d::NIN + d::O_HY + j] * w[0 * 3 * d::HW + j];
  if (r + 1 < hi) v += a.proj[(long)(r + 1) * d::NIN + d::O_HY + j] * w[2 * 3 * d::HW + j];
  a.uc[idx] = v;
}
template <class T> HD void st_hylong(const NaiveBufs& a, int l, int o, long idx) {
  using d = DD<T>; const int c = (int)(idx % d::HW); const int rb = (int)(idx / d::HW); const int r0 = rb * 4;
  const bool lat = r0 < d::S; const int n = lat ? d::S : d::C; const int base = lat ? 0 : d::S; const int t0 = r0 - base;
  const float* tp = (lat ? a.tapsS : a.tapsC) + (long)o * 2 * n * d::HW + c; const float nr = (lat ? a.nrmS : a.nrmC)[o * d::HW + c];
  const float* zs = o == 0 ? a.uc + 2 * d::HW + c : a.z1 + c; const int ldz = o == 0 ? 3 * d::HW : d::HW;
  float acc0 = 0.f, acc1 = 0.f, acc2 = 0.f, acc3 = 0.f;
  auto tap = [&](int lag) { const int li = lag >= 0 ? lag : 2 * n + lag; return tp[(long)li * d::HW]; };
  float w0 = tap(t0), w1 = tap(t0 + 1), w2 = tap(t0 + 2), w3 = tap(t0 + 3);
  for (int s = 0; s < n; ++s) {
    const float zv = zs[(long)(base + s) * ldz];
    acc0 += w0 * zv; acc1 += w1 * zv; acc2 += w2 * zv; acc3 += w3 * zv;
    w3 = w2; w2 = w1; w1 = w0; w0 = (s + 1 < n) ? tap(t0 - s - 1) : 0.f;
  }
  const float sk = a.hy_skip[((long)l * 2 + o) * d::HW + c];
  float* dst = o == 0 ? a.z1 : a.yhy;
  const float accs[4] = {acc0, acc1, acc2, acc3};
#pragma unroll
  for (int i = 0; i < 4; ++i) { const int r = r0 + i; const float zr = zs[(long)r * ldz];
    dst[(long)r * d::HW + c] = a.uc[(long)r * 3 * d::HW + o * d::HW + c] * (accs[i] / nr + sk * zr); }
}
template <class T> HD void st_router(const NaiveBufs& a, long idx) {
  using d = DD<T>; const int r = (int)idx; const float* hr = a.h + (long)r * d::D;
  float sc[d::NE], sel[d::NE];
#pragma unroll
  for (int e = 0; e < d::NE; ++e) sc[e] = 0.f;
  for (int k = 0; k < d::D; ++k) { const float hv = hr[k];
#pragma unroll
    for (int e = 0; e < d::NE; ++e) sc[e] += hv * a.router_w[(long)k * d::NE + e]; }
#pragma unroll
  for (int e = 0; e < d::NE; ++e) { sc[e] = sigmoidf_(sc[e]); sel[e] = sc[e] + a.router_b[e]; }
  int bestg = 0; float bestgs = -1e30f;
#pragma unroll
  for (int g = 0; g < d::NG; ++g) { float m1 = -1e30f, m2 = -1e30f;
#pragma unroll
    for (int i = 0; i < d::EPG; ++i) { const float v = sel[g * d::EPG + i]; if (v > m1) { m2 = m1; m1 = v; } else if (v > m2) m2 = v; }
    const float gs = m1 + m2; if (gs > bestgs) { bestgs = gs; bestg = g; } }
  int i1 = -1, i2 = -1; float v1 = -1e30f, v2 = -1e30f, s1 = 0.f, s2 = 0.f;
#pragma unroll
  for (int e = 0; e < d::NE; ++e) { if (e / d::EPG == bestg) { const float v = sel[e];
      if (v > v1) { v2 = v1; i2 = i1; s2 = s1; v1 = v; i1 = e; s1 = sc[e]; } else if (v > v2) { v2 = v; i2 = e; s2 = sc[e]; } } }
  const float inv = 1.f / (s1 + s2);
  a.ridx[2 * r] = i1; a.ridx[2 * r + 1] = i2; a.rw[2 * r] = s1 * inv; a.rw[2 * r + 1] = s2 * inv;
}
template <class T> HD void st_moehid(const NaiveBufs& a, int l, long idx) {
  using d = DD<T>; const int j = (int)(idx % d::DE); const int k = (int)((idx / d::DE) % 2); const int r = (int)(idx / (2 * d::DE));
  const int e = a.ridx[2 * r + k]; const float* hr = a.h + (long)r * d::D;
  const float* wg = a.moe_w_gate + (((long)l * d::NE + e) * d::D) * d::DE + j; const float* wu = a.moe_w_up + (((long)l * d::NE + e) * d::D) * d::DE + j;
  float g = 0.f, u = 0.f;
  for (int i = 0; i < d::D; ++i) { const float hv = hr[i]; g += hv * wg[(long)i * d::DE]; u += hv * wu[(long)i * d::DE]; }
  a.hid[idx] = siluf_(g) * u;
}
template <class T> HD void st_moeout(const NaiveBufs& a, int l, int b, long idx) {
  using d = DD<T>; const int dd = (int)(idx % d::D), r = (int)(idx / d::D);
  float acc = 0.f;
  for (int k = 0; k < 2; ++k) { const int e = a.ridx[2 * r + k]; const float* hk = a.hid + ((long)r * 2 + k) * d::DE;
    const float* wd = a.moe_w_down + (((long)l * d::NE + e) * d::DE) * d::D + dd; float s = 0.f;
    for (int j = 0; j < d::DE; ++j) s += hk[j] * wd[(long)j * d::D];
    acc += a.rw[2 * r + k] * s; }
  const float g2 = a.mod[(long)(r < d::S ? b : d::B) * 6 * d::D + 5 * d::D + dd];
  float* xr = xrow_w<T>(a, b, r); xr[dd] += g2 * acc;
}
enum { L_MOD = 0, L_HID_S, L_HID_C, L_TAPS_S, L_TAPS_C, L_NRM_S, L_NRM_C, N_LSTAGES,
       P_RS1 = 16, P_NORM1, P_INPROJ, P_QKNORM, P_ATTN_L, P_ATTN_C, P_GLALA, P_GLASCAN, P_GLAOUT, P_HYC3, P_HYL0, P_HYL1,
       P_MRG_HY, P_MRG_GLA, P_MRG_ATT, P_OUT_L, P_OUT_C, P_RS2, P_NORM2, P_ROUTER, P_MOEHID, P_MOEOUT, P_END };
constexpr int ATT_NSPLIT = 4;

template <class T> HD long stage_items(int st, int l) {
  using d = DD<T>; const bool last = (l == d::DEPTH - 1);
  switch (st) {
    case L_MOD: return (long)(d::B + 1) * 6 * d::D;
    case L_HID_S: return (long)d::S * d::HF;
    case L_HID_C: return (long)d::C * d::HF;
    case L_TAPS_S: return 2L * 2 * d::S * d::HW;
    case L_TAPS_C: return 2L * 2 * d::C * d::HW;
    case L_NRM_S: case L_NRM_C: return 2L * d::HW;
    case P_RS1: case P_RS2: case P_ROUTER: return d::R;
    case P_NORM1: case P_NORM2: return (long)d::R * d::D;
    case P_INPROJ: return (long)(d::R / 4) * (d::NIN / 4);
    case P_QKNORM: return (long)d::R * (d::AH + d::AKV);
    case P_ATTN_L: return (long)d::S * d::AH * ATT_NSPLIT;
    case P_ATTN_C: return last ? 0 : (long)d::C * d::AH * ATT_NSPLIT;
    case P_GLALA: return (long)d::R * 2 * d::GKW;
    case P_GLASCAN: return 2L * d::GH * d::GDV;
    case P_GLAOUT: return (long)d::R * d::GH;
    case P_HYC3: return (long)d::R * 3 * d::HW;
    case P_HYL0: case P_HYL1: return (long)(d::R / 4) * d::HW;
    case P_MRG_HY: case P_MRG_GLA: case P_MRG_ATT: return (long)(d::R / 4) * (d::D / 4);
    case P_OUT_L: return (long)(d::S / 4) * (d::D / 4);
    case P_OUT_C: return last ? 0 : (long)(d::C / 4) * (d::D / 4);
    case P_MOEHID: return (long)d::R * 2 * d::DE;
    case P_MOEOUT: return (long)(last ? d::S : d::R) * d::D;
  }
  return 0;
}

template <class T, int ST> HD void stage_run(const NaiveBufs& a, int l, int b, long idx) {
  using d = DD<T>;
  if constexpr (ST == L_MOD) st_mod<T>(a, l, idx);
  else if constexpr (ST == L_HID_S) st_hyhid<T>(a, l, 0, idx);
  else if constexpr (ST == L_HID_C) st_hyhid<T>(a, l, 1, idx);
  else if constexpr (ST == L_TAPS_S) st_hytaps<T>(a, l, 0, idx);
  else if constexpr (ST == L_TAPS_C) st_hytaps<T>(a, l, 1, idx);
  else if constexpr (ST == L_NRM_S) st_hynorm<T>(a, 0, idx);
  else if constexpr (ST == L_NRM_C) st_hynorm<T>(a, 1, idx);
  else if constexpr (ST == P_RS1) st_rs<T>(a, l, b, 0, idx);
  else if constexpr (ST == P_RS2) st_rs<T>(a, l, b, 1, idx);
  else if constexpr (ST == P_NORM1) st_norm<T>(a, l, b, 0, idx);
  else if constexpr (ST == P_NORM2) st_norm<T>(a, l, b, 1, idx);
  else if constexpr (ST == P_INPROJ) { GemmArgs g{a.h, d::D, a.w_in + (long)l * d::D * d::NIN, d::NIN, a.proj, d::NIN, d::R, d::NIN, d::D, nullptr, 0, nullptr, nullptr, 0, 0}; st_gemm(g, idx); }
  else if constexpr (ST == P_QKNORM) st_qknorm<T>(a, l, idx);
  else if constexpr (ST == P_ATTN_L) st_attn<T, ATT_NSPLIT>(a, 0, d::S, idx);
  else if constexpr (ST == P_ATTN_C) st_attn<T, ATT_NSPLIT>(a, d::S, d::C, idx);
  else if constexpr (ST == P_GLALA) st_glala<T>(a, l, idx);
  else if constexpr (ST == P_GLASCAN) st_glascan<T>(a, idx);
  else if constexpr (ST == P_GLAOUT) st_glaout<T>(a, l, idx);
  else if constexpr (ST == P_HYC3) st_hyconv3<T>(a, l, idx);
  else if constexpr (ST == P_HYL0) st_hylong<T>(a, l, 0, idx);
  else if constexpr (ST == P_HYL1) st_hylong<T>(a, l, 1, idx);
  else if constexpr (ST == P_MRG_HY) { GemmArgs g{a.yhy, d::HW, a.w_br_hy + (long)l * d::HW * d::D, d::D, a.m, d::D, d::R, d::D, d::HW, a.proj + d::O_BR, d::NIN, nullptr, nullptr, 0, 0}; st_gemm(g, idx); }
  else if constexpr (ST == P_MRG_GLA) { GemmArgs g{a.ygla, d::GVW, a.w_br_gla + (long)l * d::GVW * d::D, d::D, a.m, d::D, d::R, d::D, d::GVW, a.proj + d::O_BR + d::D, d::NIN, nullptr, nullptr, 0, 1}; st_gemm(g, idx); }
  else if constexpr (ST == P_MRG_ATT) { GemmArgs g{a.yatt, d::AQW, a.w_br_att + (long)l * d::AQW * d::D, d::D, a.m, d::D, d::R, d::D, d::AQW, a.proj + d::O_BR + 2 * d::D, d::NIN, nullptr, nullptr, 0, 1}; st_gemm(g, idx); }
  else if constexpr (ST == P_OUT_L) { const float* res = (l == 0 ? a.x : (const float*)a.out) + (long)b * d::S * d::D;
    GemmArgs g{a.m, d::D, a.w_out + (long)l * d::D * d::D, d::D, a.out + (long)b * d::S * d::D, d::D, d::S, d::D, d::D, nullptr, 0, a.mod + (long)b * 6 * d::D + 2 * d::D, res, d::D, 0}; st_gemm(g, idx); }
  else if constexpr (ST == P_OUT_C) { const float* res = (l == 0 ? a.ctx : (const float*)a.xc) + (long)b * d::C * d::D;
    GemmArgs g{a.m + (long)d::S * d::D, d::D, a.w_out + (long)l * d::D * d::D, d::D, a.xc + (long)b * d::C * d::D, d::D, d::C, d::D, d::D, nullptr, 0, a.mod + (long)d::B * 6 * d::D + 2 * d::D, res, d::D, 0}; st_gemm(g, idx); }
  else if constexpr (ST == P_ROUTER) st_router<T>(a, idx);
  else if constexpr (ST == P_MOEHID) st_moehid<T>(a, l, idx);
  else if constexpr (ST == P_MOEOUT) st_moeout<T>(a, l, b, idx);
}

template <class T> inline size_t carve(NaiveBufs& a, float* ws) {
  using d = DD<T>; size_t o = 0; auto take = [&](size_t n) { float* p = ws ? ws + o : nullptr; o += (n + 63) & ~(size_t)63; return p; };
  a.mod = take((size_t)(d::B + 1) * 6 * d::D);
  a.hid2S = take((size_t)d::S * d::HF); a.hid2C = take((size_t)d::C * d::HF);
  a.tapsS = take((size_t)2 * 2 * d::S * d::HW); a.tapsC = take((size_t)2 * 2 * d::C * d::HW);
  a.nrmS = take(2 * d::HW); a.nrmC = take(2 * d::HW);
  a.rs = take(d::R); a.h = take((size_t)d::R * d::D); a.proj = take((size_t)d::R * d::NIN);
  a.qn = take((size_t)d::R * d::AQW); a.kn = take((size_t)d::R * d::AKVW);
  a.uc = take((size_t)d::R * 3 * d::HW); a.z1 = take((size_t)d::R * d::HW); a.yhy = take((size_t)d::R * d::HW);
  a.xc = take((size_t)d::B * d::C * d::D);
#ifdef HOST_TEST
  a.yatt = take((size_t)d::R * d::AQW); a.laf = take((size_t)d::R * d::GKW); a.lab = take((size_t)d::R * d::GKW);
  a.of = take((size_t)d::R * d::GVW); a.ob = take((size_t)d::R * d::GVW); a.ygla = take((size_t)d::R * d::GVW);
  a.m = take((size_t)d::R * d::D); a.ridx = (int*)take((size_t)d::R * 2); a.rw = take((size_t)d::R * 2); a.hid = take((size_t)d::R * 2 * d::DE);
#endif
  return o;
}
template <class T> inline void set_inputs(NaiveBufs& a, const float* const* in) {
  int i = 0;
  a.x = in[i++]; a.c = in[i++]; a.ctx = in[i++]; a.c_ctx = in[i++]; a.w_mod = in[i++]; a.b_mod = in[i++]; a.norm1_g = in[i++]; a.norm2_g = in[i++];
  a.w_in = in[i++]; a.q_norm_g = in[i++]; a.k_norm_g = in[i++]; a.gla_wa2 = in[i++]; a.gla_ba = in[i++]; a.gla_norm_g = in[i++];
  a.hy_conv_w = in[i++]; a.hy_conv_b = in[i++]; a.hy_pos_w1 = in[i++]; a.hy_pos_b1 = in[i++]; a.hy_sin_freq = in[i++]; a.hy_pos_w2 = in[i++];
  a.hy_pos_b2 = in[i++]; a.hy_pos_w3 = in[i++]; a.hy_decay = in[i++]; a.hy_skip = in[i++]; a.w_br_hy = in[i++]; a.w_br_gla = in[i++];
  a.w_br_att = in[i++]; a.w_out = in[i++]; a.router_w = in[i++]; a.router_b = in[i++]; a.moe_w_gate = in[i++]; a.moe_w_up = in[i++]; a.moe_w_down = in[i++];
}

#define LSTAGES(X) X(L_MOD) X(L_HID_S) X(L_HID_C) X(L_TAPS_S) X(L_TAPS_C) X(L_NRM_S) X(L_NRM_C)
#define PSTAGES(X) X(P_RS1) X(P_NORM1) X(P_INPROJ) X(P_QKNORM) X(P_ATTN_L) X(P_ATTN_C) X(P_GLALA) X(P_GLASCAN) X(P_GLAOUT) X(P_HYC3) X(P_HYL0) X(P_HYL1) \
  X(P_MRG_HY) X(P_MRG_GLA) X(P_MRG_ATT) X(P_OUT_L) X(P_OUT_C) X(P_RS2) X(P_NORM2) X(P_ROUTER) X(P_MOEHID) X(P_MOEOUT)
namespace pro {
__device__ __forceinline__ void mod_phase(const NaiveBufs& a, int l, LAS unsigned char* lds) {
  int tz = threadIdx.x; asm volatile("" : "+v"(tz));
  __syncthreads();
  LAS float* sl = (LAS float*)lds; LAS float* part = sl + 9 * 1024;
  for (int e = tz; e < 9 * 1024; e += NTHREADS) { const int bb = e >> 10, k = e & 1023; const float cv = bb < 8 ? a.c[bb * 1024 + k] : a.c_ctx[k]; sl[e] = cv / (1.f + __expf(-cv)); }
  __syncthreads();
  const float* w = a.w_mod + (size_t)l * 1024 * 6144;
  const int jl = tz & 63, ks = tz >> 6;
  for (int cb = blockIdx.x; cb < 96; cb += gridDim.x) { const int j = cb * 64 + jl; float acc[9];
#pragma unroll
    for (int q = 0; q < 9; ++q) acc[q] = 0.f;
#pragma unroll 4
    for (int k = ks * 128; k < ks * 128 + 128; ++k) { const float wv = w[(size_t)k * 6144 + j];
#pragma unroll
      for (int q = 0; q < 9; ++q) acc[q] += sl[q * 1024 + k] * wv; }
#pragma unroll
    for (int q = 0; q < 9; ++q) part[(ks * 9 + q) * 64 + jl] = acc[q];
    __syncthreads();
    for (int e = tz; e < 9 * 64; e += NTHREADS) { const int q = e >> 6, jj = e & 63; float s = a.b_mod[(size_t)l * 6144 + cb * 64 + jj];
#pragma unroll
      for (int k8 = 0; k8 < 8; ++k8) s += part[(k8 * 9 + q) * 64 + jj];
      a.mod[(size_t)q * 6144 + cb * 64 + jj] = s; }
    __syncthreads(); }
  __syncthreads();
}
__device__ __forceinline__ void hid_phase(const NaiveBufs& a, int l, int n, float* dst, LAS unsigned char* lds) {
  int tz = threadIdx.x; asm volatile("" : "+v"(tz));
  LAS float* Z = (LAS float*)(lds + 40960); LAS float* H1 = Z + 8 * 36;
  const float* w1 = a.hy_pos_w1 + (size_t)l * 33 * 64; const float* b1 = a.hy_pos_b1 + l * 64; const float* fr = a.hy_sin_freq + l * 64;
  const float* w2 = a.hy_pos_w2 + (size_t)l * 64 * 64; const float* b2 = a.hy_pos_b2 + l * 64;
  const float w0 = 2.f * 3.14159265358979323846f / (float)n;
  for (int t0 = blockIdx.x * 8; t0 < n; t0 += gridDim.x * 8) {
    if (tz < 8 * 33) { const int tt = tz / 33, e = tz % 33, t = t0 + tt; float v;
      if (e == 0) v = (float)t / (float)n; else { const int bnd = (e - 1) & 15; const float band = 1e-4f + (float)bnd * (15.f - 1e-4f) / 15.f; const float ph = w0 * (float)t * band; v = e <= 16 ? cosf(ph) : -sinf(ph); }
      Z[tt * 36 + e] = v; }
    __syncthreads();
    { const int tt = tz >> 6, i = tz & 63; float acc = b1[i];
#pragma unroll
      for (int e = 0; e < 33; ++e) acc += Z[tt * 36 + e] * w1[e * 64 + i];
      H1[tt * 64 + i] = sinf(fr[i] * acc); }
    __syncthreads();
    { const int tt = tz >> 6, j = tz & 63; float acc = b2[j];
#pragma unroll 8
      for (int i = 0; i < 64; ++i) acc += H1[tt * 64 + i] * w2[i * 64 + j];
      if (t0 + tt < n) dst[(size_t)(t0 + tt) * 64 + j] = sinf(fr[j] * acc); }
    __syncthreads();
  }
}
__device__ __forceinline__ void nrmS_phase(const NaiveBufs& a) {
  int tz = threadIdx.x; asm volatile("" : "+v"(tz)); const int lane = tz & 63, wave = __builtin_amdgcn_readfirstlane(tz >> 6);
  for (int oc = blockIdx.x * NWAVES + wave; oc < 1024; oc += gridDim.x * NWAVES) { const float* tp = a.tapsS + (size_t)oc * 8192; float s = 0.f;
#pragma unroll 8
    for (int k = lane; k < 8192; k += 64) s += fabsf(tp[k]);
    s = moe::wave_sum(s); if (lane == 0) a.nrmS[oc] = s + 1e-6f; }
}
constexpr int TCOPY = 8232;
__device__ __forceinline__ void tapsB_phase(const NaiveBufs& a, int l, bf16_t* tapsB, LAS unsigned char* lds) {
  int tz = threadIdx.x; asm volatile("" : "+v"(tz));
  const float* w3 = a.hy_pos_w3 + (size_t)l * 64 * 2048; const float* dcy = a.hy_decay + (size_t)l * 2048;
  typedef float f4 __attribute__((ext_vector_type(4)));
  LAS float* W = (LAS float*)lds;
  for (int cp = blockIdx.x; cp < 256; cp += gridDim.x) {
    __syncthreads();
    { const int ch = tz >> 8, e = tz & 255, c = cp + 256 * ch; W[tz] = w3[(size_t)(e >> 2) * 2048 + (e & 3) * 512 + c]; if (tz < 8) W[512 + tz] = fabsf(dcy[(tz & 3) * 512 + cp + 256 * (tz >> 2)]); }
    __syncthreads();
    for (int t = tz; t < 4096; t += NTHREADS) {
      const f4* h2 = (const f4*)(a.hid2S + (size_t)t * 64); f4 acc0 = {0.f, 0.f, 0.f, 0.f}, acc1 = {0.f, 0.f, 0.f, 0.f};
#pragma unroll 4
      for (int j4 = 0; j4 < 16; ++j4) { const f4 h = h2[j4];
#pragma unroll
        for (int e = 0; e < 4; ++e) { acc0 += h[e] * *(const LAS f4*)(W + (4 * j4 + e) * 4); acc1 += h[e] * *(const LAS f4*)(W + 256 + (4 * j4 + e) * 4); } }
      const float tn = (float)t * (1.f / 4096.f);
#pragma unroll
      for (int ch = 0; ch < 2; ++ch)
#pragma unroll
        for (int q = 0; q < 4; ++q) { const int o = q >> 1, dir = q & 1; if (dir == 1 && t == 0) continue; const int c = cp + 256 * ch;
          const bf16_t bv = (bf16_t)f2bf((ch ? acc1[q] : acc0[q]) * __expf(-tn * W[512 + 4 * ch + q]));
          bf16_t* base = tapsB + ((size_t)o * 512 + c) * 2 * TCOPY; const int x0 = dir ? 4096 + t : 4096 - t;
          base[x0] = bv; base[TCOPY + x0 - 1] = bv; } } }
  for (long idx = (long)blockIdx.x * NTHREADS + tz; idx < 1024L * 96; idx += (long)gridDim.x * NTHREADS) { const int oc = (int)(idx / 96), e = (int)(idx % 96); bf16_t* base = tapsB + (size_t)oc * 2 * TCOPY;
    if (e < 40) base[8192 + e] = 0; else if (e < 81) base[TCOPY + 8191 + (e - 40)] = 0; else if (e == 81) base[0] = 0; }
}
__device__ __forceinline__ void nrmB_phase(const NaiveBufs& a, const bf16_t* tapsB) {
  int tz = threadIdx.x; asm volatile("" : "+v"(tz)); const int lane = tz & 63, wave = __builtin_amdgcn_readfirstlane(tz >> 6);
  for (int oc = blockIdx.x * NWAVES + wave; oc < 1024; oc += gridDim.x * NWAVES) { const bf16_t* tp = tapsB + (size_t)oc * 2 * TCOPY; float s = 0.f;
#pragma unroll 8
    for (int k = lane; k < 8192; k += 64) s += fabsf(bf2f(tp[k]));
    s = moe::wave_sum(s); if (lane == 0) a.nrmS[oc] = s + 1e-6f; }
}
}
using TD = FullDims;
using dd = DD<TD>;
constexpr int GB = 4, NGRP = 2, RB = dd::R  , RG = GB * RB, PLD = dd::NIN, PANELS = RG / 256, PPB = RB / 256  ;
constexpr size_t BAR_BYTES = 16384 + 4 * 4096; constexpr int CNT_OFF = 16384;
constexpr int MPG = 38912;
constexpr size_t CS_BYTES = (size_t)2 * 4 * 68 * 64 * 128 * 4, DEC_BYTES = (size_t)2 * 4 * 68 * 64 * 4;
constexpr size_t UCT_BYTES = (size_t)1536 * 4096 * 2, YT_BYTES = (size_t)512 * 4096 * 2, UCC_BYTES = (size_t)256 * 1536 * 4, Z1C_BYTES = (size_t)256 * 512 * 4;
constexpr size_t MIX_BYTES = GB * (CS_BYTES + DEC_BYTES) > GB * (UCT_BYTES + YT_BYTES + UCC_BYTES + Z1C_BYTES) ? GB * (CS_BYTES + DEC_BYTES) : GB * (UCT_BYTES + YT_BYTES + UCC_BYTES + Z1C_BYTES);

struct KArgs { NaiveBufs a; unsigned* bar; int* cnt; bf16_t *WinT, *WhyT, *WglaT, *WattT, *WoutT, *WguT, *WdT, *hb, *proj; unsigned char* mix;
  bf16_t *hp, *hid, *contrib; int* srcrow; float* wgt; moe::Route* route; float* wts; };

struct EpiProjBf16 {
  static constexpr bool PERM = true, AFTER_DRAIN = false;
  bf16_t* P;
  __device__ __forceinline__ void operator()(const pg8::f32x4 (&acc)[2][2][4][2], const pg8::Unit& u, int wr, int wc, int fr, int fq) const {
    const int row0 = u.pm * 256 + wr * 64 + fr, col0 = u.pn * 256 + wc * 32 + 8 * fq;
#pragma unroll
    for (int ai = 0; ai < 2; ++ai)
#pragma unroll
      for (int m = 0; m < 4; ++m) { bf16_t* rowp = P + (size_t)(row0 + ai * 128 + m * 16) * PLD + col0;
#pragma unroll
        for (int bj = 0; bj < 2; ++bj) if (col0 + bj * 128 < PLD) { const pg8::f32x4 v0 = acc[ai][bj][m][0], v1 = acc[ai][bj][m][1];
          v4u o; o.x = pk2(v0[0], v0[1]); o.y = pk2(v0[2], v0[3]); o.z = pk2(v1[0], v1[1]); o.w = pk2(v1[2], v1[3]); *(v4u*)(rowp + bj * 128) = o; } }
  }
};
template <bool ACCUM> struct EpiMergeB {
  static constexpr bool PERM = true, AFTER_DRAIN = false;
  const bf16_t* gate; bf16_t* M;
  __device__ __forceinline__ void operator()(const pg8::f32x4 (&acc)[2][2][4][2], const pg8::Unit& u, int wr, int wc, int fr, int fq) const {
    const int row0 = u.pm * 256 + wr * 64 + fr, col0 = u.pn * 256 + wc * 32 + 8 * fq;
#pragma unroll
    for (int ai2 = 0; ai2 < 4; ++ai2) { const int ai = ai2 >> 1, m0 = (ai2 & 1) * 2;
      v4u gw[4][2], mo[4][2];
#pragma unroll
      for (int m = m0; m < m0 + 2; ++m)
#pragma unroll
        for (int bj = 0; bj < 2; ++bj) { const size_t r = (size_t)(row0 + ai * 128 + m * 16); const int c = col0 + bj * 128; gw[m][bj] = *(const v4u*)(gate + r * PLD + c); if (ACCUM) mo[m][bj] = *(const v4u*)(M + r * 1024 + c); }
#pragma unroll
      for (int m = m0; m < m0 + 2; ++m)
#pragma unroll
        for (int bj = 0; bj < 2; ++bj) { const size_t r = (size_t)(row0 + ai * 128 + m * 16); const int c = col0 + bj * 128; const v4u g4 = gw[m][bj];
          pg8::f32x4 v0 = acc[ai][bj][m][0], v1 = acc[ai][bj][m][1];
          v0[0] *= fsigmoid(bf2f(g4.x & 0xffff)); v0[1] *= fsigmoid(bf2f(g4.x >> 16)); v0[2] *= fsigmoid(bf2f(g4.y & 0xffff)); v0[3] *= fsigmoid(bf2f(g4.y >> 16));
          v1[0] *= fsigmoid(bf2f(g4.z & 0xffff)); v1[1] *= fsigmoid(bf2f(g4.z >> 16)); v1[2] *= fsigmoid(bf2f(g4.w & 0xffff)); v1[3] *= fsigmoid(bf2f(g4.w >> 16));
          if (ACCUM) { const v4u o = mo[m][bj]; v0[0] += bf2f(o.x & 0xffff); v0[1] += bf2f(o.x >> 16); v0[2] += bf2f(o.y & 0xffff); v0[3] += bf2f(o.y >> 16);
            v1[0] += bf2f(o.z & 0xffff); v1[1] += bf2f(o.z >> 16); v1[2] += bf2f(o.w & 0xffff); v1[3] += bf2f(o.w >> 16); }
          v4u o2; o2.x = pk2(v0[0], v0[1]); o2.y = pk2(v0[2], v0[3]); o2.z = pk2(v1[0], v1[1]); o2.w = pk2(v1[2], v1[3]); *(v4u*)(M + r * 1024 + c) = o2; } }
  }
};
struct EpiOutG {
  static constexpr bool PERM = false, AFTER_DRAIN = false;
  const float* resL; float* outL; const float* resC; float* outC; const float* mod; int b0; bool ctx_on;
  __device__ __forceinline__ void operator()(const pg8::f32x4 (&acc)[2][2][4][2], const pg8::Unit& u, int wr, int wc, int fr, int fq) const {
    const int bl = u.pm / PPB, lp = u.pm % PPB; const bool isc = lp == PPB - 1; if (isc && !ctx_on) return;
    const int b = b0 + bl;
    const float* res = isc ? resC + (size_t)b * dd::C * 1024 : resL + ((size_t)b * dd::S + lp * 256) * 1024;
    float* out = isc ? outC + (size_t)b * dd::C * 1024 : outL + ((size_t)b * dd::S + lp * 256) * 1024;
    const float* gv = mod + (size_t)(isc ? dd::B : b) * 6 * 1024 + 2 * 1024;
    const int row0 = wr * 64 + fr, col0 = u.pn * 256 + wc * 32 + 4 * fq;
    pg8::f32x4 gg[2][2];
#pragma unroll
    for (int bj = 0; bj < 2; ++bj)
#pragma unroll
      for (int n = 0; n < 2; ++n) gg[bj][n] = *(const pg8::f32x4*)(gv + col0 + bj * 128 + n * 16);
#pragma unroll
    for (int ai2 = 0; ai2 < 4; ++ai2) { const int ai = ai2 >> 1, m0 = (ai2 & 1) * 2;
      pg8::f32x4 rv[4][2][2];
#pragma unroll
      for (int m = m0; m < m0 + 2; ++m)
#pragma unroll
        for (int bj = 0; bj < 2; ++bj)
#pragma unroll
          for (int n = 0; n < 2; ++n) rv[m][bj][n] = *(const pg8::f32x4*)(res + (size_t)(row0 + ai * 128 + m * 16) * 1024 + col0 + bj * 128 + n * 16);
#pragma unroll
      for (int m = m0; m < m0 + 2; ++m)
#pragma unroll
        for (int bj = 0; bj < 2; ++bj)
#pragma unroll
          for (int n = 0; n < 2; ++n) *(pg8::f32x4*)(out + (size_t)(row0 + ai * 128 + m * 16) * 1024 + col0 + bj * 128 + n * 16) = rv[m][bj][n] + gg[bj][n] * acc[ai][bj][m][n]; }
  }
};
struct GroupOrder {
  int nN, nwg, G, c; bool lat;
  __device__ void init(int N, int G_, int c_, bool lat_) { nN = N / 256; lat = lat_; nwg = (lat ? GB * 16 : PANELS) * nN; G = G_; c = c_; }
  __device__ __forceinline__ bool next(int i, pg8::Unit& u) const { const long L = (long)i * G + c; if (L >= nwg) return false; const int p = (int)L / nN; u.pm = lat ? (p >> 4) * PPB + (p & 15) : p; u.pn = (int)L % nN; u.acol = 0; return true; }
  __device__ __forceinline__ void a_ready(const pg8::Unit&) const {}
  __device__ __forceinline__ void done(const pg8::Unit&) const {}
};
struct MergeOrder {
  int ntiles, G, c; bool lat;
  __device__ void init(int G_, int c_, bool lat_) { lat = lat_; ntiles = (lat ? GB * 16 : PANELS) * 4; G = G_; c = c_; }
  __device__ __forceinline__ bool next(int i, pg8::Unit& u) const { const int rnd = i >> 2, gi = i & 3; const long tile = (long)rnd * G + c; if (tile >= ntiles) return false; const int p = (int)tile >> 2;
    u.pm = lat ? (p >> 4) * PPB + (p & 15) : p; u.pn = gi * 4 + ((int)tile & 3); u.acol = gi == 0 ? dd::O_HY : gi == 1 ? dd::O_OG : gi == 2 ? dd::O_AQ : dd::O_AQ + 512; return true; }
  __device__ __forceinline__ void a_ready(const pg8::Unit&) const {}
  __device__ __forceinline__ void done(const pg8::Unit&) const {}
};
struct EpiMergeS {
  static constexpr bool PERM = true, AFTER_DRAIN = false;
  const bf16_t* gate0; bf16_t* M;
  __device__ __forceinline__ void operator()(const pg8::f32x4 (&acc)[2][2][4][2], const pg8::Unit& u, int wr, int wc, int fr, int fq) const {
    const int gi = u.pn >> 2; const bool accum = gi > 0; const bf16_t* gate = gate0 + (gi > 2 ? 2 : gi) * 1024;
    const int row0 = u.pm * 256 + wr * 64 + fr, col0 = (u.pn & 3) * 256 + wc * 32 + 8 * fq;
#pragma unroll
    for (int ai = 0; ai < 2; ++ai)
#pragma unroll
      for (int m = 0; m < 4; ++m) { const size_t r = (size_t)(row0 + ai * 128 + m * 16);
#pragma unroll
        for (int bj = 0; bj < 2; ++bj) { const int c = col0 + bj * 128; const v4u gw = *(const v4u*)(gate + r * PLD + c);
          pg8::f32x4 v0 = acc[ai][bj][m][0], v1 = acc[ai][bj][m][1];
          v0[0] *= fsigmoid(bf2f(gw.x & 0xffff)); v0[1] *= fsigmoid(bf2f(gw.x >> 16)); v0[2] *= fsigmoid(bf2f(gw.y & 0xffff)); v0[3] *= fsigmoid(bf2f(gw.y >> 16));
          v1[0] *= fsigmoid(bf2f(gw.z & 0xffff)); v1[1] *= fsigmoid(bf2f(gw.z >> 16)); v1[2] *= fsigmoid(bf2f(gw.w & 0xffff)); v1[3] *= fsigmoid(bf2f(gw.w >> 16));
          v4u* dst = (v4u*)(M + r * 1024 + c);
          if (accum) { const v4u o = *dst; v0[0] += bf2f(o.x & 0xffff); v0[1] += bf2f(o.x >> 16); v0[2] += bf2f(o.y & 0xffff); v0[3] += bf2f(o.y >> 16);
            v1[0] += bf2f(o.z & 0xffff); v1[1] += bf2f(o.z >> 16); v1[2] += bf2f(o.w & 0xffff); v1[3] += bf2f(o.w >> 16); }
          v4u o2; o2.x = pk2(v0[0], v0[1]); o2.y = pk2(v0[2], v0[3]); o2.z = pk2(v1[0], v1[1]); o2.w = pk2(v1[2], v1[3]); *dst = o2; } }
  }
};
__device__ __forceinline__ const float* xrow_in(const NaiveBufs& a, int l, int b, int r) {
  if (r < dd::S) return (l == 0 ? a.x : (const float*)a.out) + ((size_t)b * dd::S + r) * 1024;
  return (l == 0 ? a.ctx : (const float*)a.xc) + ((size_t)b * dd::C + (r - dd::S)) * 1024;
}
__device__ __forceinline__ float* xrow_cur(const NaiveBufs& a, int b, int r) {
  if (r < dd::S) return a.out + ((size_t)b * dd::S + r) * 1024;
  return a.xc + ((size_t)b * dd::C + (r - dd::S)) * 1024;
}
__device__ __forceinline__ void norm_row(const float* xr, const float* gnorm, const float* shift, const float* scale, bf16_t* hrow, int lane) {
  typedef float f4 __attribute__((ext_vector_type(4)));
  f4 xv[4]; float ss = 0.f;
#pragma unroll
  for (int j = 0; j < 4; ++j) { xv[j] = *(const f4*)(xr + 4 * lane + 256 * j); ss += xv[j][0] * xv[j][0] + xv[j][1] * xv[j][1] + xv[j][2] * xv[j][2] + xv[j][3] * xv[j][3]; }
  const float rs = 1.f / sqrtf(moe::wave_sum(ss) * (1.f / 1024.f) + 1e-6f);
#pragma unroll
  for (int j = 0; j < 4; ++j) { const int c = 4 * lane + 256 * j; const f4 g4 = *(const f4*)(gnorm + c), sh = *(const f4*)(shift + c), sc = *(const f4*)(scale + c);
    f4 h;
#pragma unroll
    for (int i = 0; i < 4; ++i) h[i] = xv[j][i] * rs * g4[i] * (1.f + sc[i]) + sh[i];
    *(unsigned long long*)(hrow + c) = (unsigned long long)pk2(h[0], h[1]) | ((unsigned long long)pk2(h[2], h[3]) << 32); }
}
__device__ __forceinline__ void qknorm_row(bf16_t* prow, const float* qg, const float* kg, int r, int lane) {
  const bool lat = r < dd::S; const int grow = r / dd::GW, gcol = r % dd::GW;
  const int fi = lane & 31; const float pos = (lane < 32) ? (float)grow : (float)gcol;
  const float ang = pos * __builtin_amdgcn_exp2f(-(float)fi * (13.287712379549449f / 32.f));
  const float cs = lat ? __cosf(ang) : 1.f, sn = lat ? __sinf(ang) : 0.f;
  unsigned wv[10];
#pragma unroll
  for (int hh = 0; hh < 10; ++hh) wv[hh] = *((const unsigned*)(prow + (hh < 8 ? dd::O_AQ + hh * 128 : dd::O_AK + (hh - 8) * 128)) + lane);
  float ss[10];
#pragma unroll
  for (int hh = 0; hh < 10; ++hh) { const float x1 = bf2f(wv[hh] & 0xffff), x2 = bf2f(wv[hh] >> 16); ss[hh] = x1 * x1 + x2 * x2; }
#pragma unroll
  for (int o = 1; o < 64; o <<= 1) {
#pragma unroll
    for (int hh = 0; hh < 10; ++hh) ss[hh] += __shfl_xor(ss[hh], o); }
  const float q1 = qg[2 * lane], q2 = qg[2 * lane + 1], k1 = kg[2 * lane], k2 = kg[2 * lane + 1];
#pragma unroll
  for (int hh = 0; hh < 10; ++hh) { unsigned* p = (unsigned*)(prow + (hh < 8 ? dd::O_AQ + hh * 128 : dd::O_AK + (hh - 8) * 128)) + lane;
    const float x1 = bf2f(wv[hh] & 0xffff), x2 = bf2f(wv[hh] >> 16); const float rs = 1.f / sqrtf(ss[hh] * (1.f / 128.f) + 1e-6f);
    const float y1 = x1 * rs * (hh < 8 ? q1 : k1), y2 = x2 * rs * (hh < 8 ? q2 : k2);
    *p = pk2(y1 * cs - y2 * sn, y1 * sn + y2 * cs); }
}

__global__ void __launch_bounds__(NTHREADS, 2) mega_kernel(KArgs ka_unused) {
  extern __shared__ __attribute__((aligned(16))) unsigned char lds_raw[];
  LAS unsigned char* lds = (LAS unsigned char*)lds_raw;
  volatile LAS unsigned* MISC = (volatile LAS unsigned*)(lds + MISC_OFF);
  constexpr int ARGS_OFF = MISC_OFF + 256;
  static_assert(ARGS_OFF + sizeof(KArgs) <= LDS_BYTES, "LDS map");
  { const unsigned __attribute__((address_space(4)))* kp = (const unsigned __attribute__((address_space(4)))*)__builtin_amdgcn_kernarg_segment_ptr();
    for (int i = threadIdx.x; i < (int)(sizeof(KArgs) / 4); i += NTHREADS) ((LAS unsigned*)(lds + ARGS_OFF))[i] = kp[i]; }
  if (threadIdx.x < 64) MISC[threadIdx.x] = 0u;
  __syncthreads();
  const KArgs& ka = *(const KArgs*)(const LAS KArgs*)(lds + ARGS_OFF);
  const NaiveBufs& a = ka.a;
  unsigned* bar_s; { const unsigned long long bp = (unsigned long long)ka.bar; const unsigned lo_ = __builtin_amdgcn_readfirstlane((unsigned)bp), hi_ = __builtin_amdgcn_readfirstlane((unsigned)(bp >> 32));
    bar_s = (unsigned*)(((unsigned long long)hi_ << 32) | lo_); }
  XcdBarrier xb = xcd_barrier_post(bar_s, MISC);
#define SPTR(T, name, src) T* name; { const unsigned long long bp_ = (unsigned long long)(src); const unsigned lo_ = __builtin_amdgcn_readfirstlane((unsigned)bp_), hi_ = __builtin_amdgcn_readfirstlane((unsigned)(bp_ >> 32)); name = (T*)(((unsigned long long)hi_ << 32) | lo_); }
  SPTR(bf16_t, proj_s, ka.proj) SPTR(bf16_t, hb_s, ka.hb) SPTR(unsigned char, mix_s, ka.mix)
  const long gs = (long)gridDim.x * NTHREADS;
  LAS int* poff = (LAS int*)(lds + MISC_OFF + 64);
#define TID_SETUP int tz = threadIdx.x; asm volatile("" : "+v"(tz)); const int lane = tz & 63, wave = __builtin_amdgcn_readfirstlane(tz >> 6); \
    const int gw = blockIdx.x * NWAVES + wave, NGW = gridDim.x * NWAVES; const long gt = (long)blockIdx.x * NTHREADS + tz; (void)lane; (void)gw; (void)NGW; (void)gt;
#define LSTAGE(ST) { TID_SETUP const long n_ = stage_items<TD>(ST, l); for (long i_ = gt; i_ < n_; i_ += gs) stage_run<TD, ST>(a, l, 0, i_); }
  for (int l = 0; l < dd::DEPTH; ++l) {
    const bool last = (l == dd::DEPTH - 1);
    { TID_SETUP
      LAS float* scr = (LAS float*)(lds + RING_OFF + wave * 16384);
      constexpr int NIT = (dd::D / 64) * (dd::NIN / 32);
      for (int it = gw; it < NIT; it += NGW) transpose_item(a.w_in + (size_t)l * dd::D * dd::NIN, dd::D, dd::NIN, ka.WinT, 0, scr, it, lane);
      { constexpr int I0 = (dd::HW / 64) * (dd::D / 32), I1 = (dd::GVW / 64) * (dd::D / 32), I2 = (dd::AQW / 64) * (dd::D / 32), I3 = (dd::D / 64) * (dd::D / 32);
        for (int it = gw; it < I0 + I1 + I2 + I3; it += NGW) { int r = it;
          if (r < I0) { transpose_item(a.w_br_hy + (size_t)l * dd::HW * dd::D, dd::HW, dd::D, ka.WhyT, 0, scr, r, lane); continue; } r -= I0;
          if (r < I1) { transpose_item(a.w_br_gla + (size_t)l * dd::GVW * dd::D, dd::GVW, dd::D, ka.WglaT, 0, scr, r, lane); continue; } r -= I1;
          if (r < I2) { transpose_item(a.w_br_att + (size_t)l * dd::AQW * dd::D, dd::AQW, dd::D, ka.WattT, 0, scr, r, lane); continue; } r -= I2;
          transpose_item(a.w_out + (size_t)l * dd::D * dd::D, dd::D, dd::D, ka.WoutT, 0, scr, r, lane); } }
      { constexpr int IG = (dd::D / 64) * (dd::DE / 32), IDN = (dd::DE / 64) * (dd::D / 32);
        for (int it = gw; it < dd::NE * (2 * IG + IDN); it += NGW) { const int e = it / (2 * IG + IDN); int r = it % (2 * IG + IDN);
          if (r < 2 * IG) { const int up = r >= IG; if (up) r -= IG; const int n0 = 32 * (r % (dd::DE / 32));
            transpose_item((up ? a.moe_w_up : a.moe_w_gate) + ((size_t)l * dd::NE + e) * dd::D * dd::DE, dd::D, dd::DE, ka.WguT, e * 1024 + 128 * (n0 >> 7) + (up ? 128 : 0), scr, r, lane); }
          else { r -= 2 * IG; transpose_item(a.moe_w_down + ((size_t)l * dd::NE + e) * dd::DE * dd::D, dd::DE, dd::D, ka.WdT, e * 1024, scr, r, lane); } } }
      for (long i = gt; i < (long)(NINP - dd::NIN) * dd::D / 8; i += gs) { unsigned z_ = 0u; asm volatile("" : "+v"(z_)); *(v4u*)(ka.WinT + (size_t)dd::NIN * dd::D + i * 8) = (v4u){z_, z_, z_, z_}; }
    }
    pro::mod_phase(a, l, lds); pro::hid_phase(a, l, dd::S, a.hid2S, lds); if (!last) pro::hid_phase(a, l, dd::C, a.hid2C, lds);
    xcd_barrier(xb);
    pro::tapsB_phase(a, l, (bf16_t*)a.tapsS, lds); if (!last) LSTAGE(L_TAPS_C)
    xcd_barrier(xb);
    pro::nrmB_phase(a, (const bf16_t*)a.tapsS); if (!last) LSTAGE(L_NRM_C)
    xcd_barrier(xb);
    for (int grp = 0; grp < NGRP; ++grp) {
      const int b0 = grp * GB;
      { TID_SETUP
        for (int rg = gw; rg < RG; rg += NGW) { const int bl = rg / RB, r = rg % RB, b = b0 + bl; const float* md = a.mod + (size_t)(r < dd::S ? b : dd::B) * 6 * 1024;
          norm_row(xrow_in(a, l, b, r), a.norm1_g + (size_t)l * 1024, md, md + 1024, hb_s + (size_t)rg * 1024, lane); }
        xcd_barrier(xb); }
      { pg8::Gemm g{hb_s, ka.WinT, RG, NINP, dd::D, 0}; pg8::StaticOrder S; S.init(RG, NINP, (int)gridDim.x, (int)blockIdx.x); EpiProjBf16 E{proj_s};
        pg8::gemm_phase<EpiProjBf16, pg8::StaticOrder, false>((PG8_LAS unsigned char*)(lds + RING_OFF), g, S, E, nullptr);
        xcd_barrier(xb); }
      { TID_SETUP
        for (int rg = gw; rg < RG; rg += NGW) qknorm_row(proj_s + (size_t)rg * PLD, a.q_norm_g + (size_t)l * 128, a.k_norm_g + (size_t)l * 128, rg % RB, lane);
        for (int u = blockIdx.x; u < GB * 4 * 68; u += gridDim.x) { const int bl = u / (4 * 68), hu = u % (4 * 68); const bf16_t* pb = proj_s + (size_t)bl * RB * PLD;
          gla::In gp; gp.q = pb + dd::O_GQ; gp.k = pb + dd::O_GK; gp.v = pb + dd::O_GV; gp.ga = pb + dd::O_GA; gp.og = pb + dd::O_OG; gp.ld = PLD;
          gp.wa2 = a.gla_wa2 + (size_t)l * 2 * 16 * 256; gp.ba = a.gla_ba + (size_t)l * 2 * 256; gp.gnorm = a.gla_norm_g + (size_t)l * 128;
          gp.cs = (float*)(mix_s + (size_t)bl * CS_BYTES); gp.dec = (float*)(mix_s + (size_t)GB * CS_BYTES + (size_t)bl * DEC_BYTES); gp.y = (bf16_t*)pb + dd::O_OG; gp.ldy = PLD; gp.S = dd::S; gp.C = dd::C;
          gla::g1_unit(gp, lds, hu / 68, hu % 68, 4, 68); }
        xcd_barrier(xb); }
      { TID_SETUP
        for (long i_ = gt; i_ < (long)GB * 2 * 4 * 64 * 128; i_ += gs) { const int bl = (int)(i_ / (2 * 4 * 64 * 128)); gla::In gp; gp.cs = (float*)(mix_s + (size_t)bl * CS_BYTES); gp.dec = (float*)(mix_s + (size_t)GB * CS_BYTES + (size_t)bl * DEC_BYTES); gp.S = dd::S; gp.C = dd::C;
          gla::g2_item(gp, i_ % (2 * 4 * 64 * 128), 4, 68); }
        const int combo = blockIdx.x & 7, slot = blockIdx.x >> 3, nslot = gridDim.x >> 3;
        const int per_combo = 64 + (last ? 0 : 4);
        const bool xcdm = (gridDim.x & 7) == 0;
        for (int uu = xcdm ? slot : (int)blockIdx.x; uu < (xcdm ? per_combo : 8 * per_combo); uu += xcdm ? nslot : (int)gridDim.x) { const int cmb = xcdm ? combo : uu / per_combo, ui = xcdm ? uu : uu % per_combo;
          const bool lat = ui < 64; const int bl = cmb >> 1, kvh = cmb & 1;
          const int head = kvh * 4 + (lat ? ui >> 4 : ui - 64), qb = lat ? ui & 15 : 0;
          bf16_t* pb = proj_s + (size_t)bl * RB * PLD; const size_t qrow = lat ? (size_t)qb * 256 : (size_t)dd::S, krow = lat ? 0 : (size_t)dd::S;
          att::attn_dense_body<att::bf16, PLD, PLD, 1024, true>((const att::bf16*)(pb + qrow * PLD + dd::O_AQ + head * 128), (const att::bf16*)(pb + krow * PLD + dd::O_AK + kvh * 128),
              (const att::bf16*)(pb + krow * PLD + dd::O_AV + kvh * 128), hb_s + ((size_t)bl * RB + qrow) * 1024 + head * 128, lat ? RB : dd::C, (char*)lds_raw);
          __syncthreads(); }
        xcd_barrier(xb); }
      { const int n3 = last ? 64 : 68;
        for (int u = blockIdx.x; u < GB * 4 * n3; u += gridDim.x) { const int bl = u / (4 * n3), hu = u % (4 * n3); const bf16_t* pb = proj_s + (size_t)bl * RB * PLD;
          gla::In gp; gp.q = pb + dd::O_GQ; gp.k = pb + dd::O_GK; gp.v = pb + dd::O_GV; gp.ga = pb + dd::O_GA; gp.og = pb + dd::O_OG; gp.ld = PLD;
          gp.wa2 = a.gla_wa2 + (size_t)l * 2 * 16 * 256; gp.ba = a.gla_ba + (size_t)l * 2 * 256; gp.gnorm = a.gla_norm_g + (size_t)l * 128;
          gp.cs = (float*)(mix_s + (size_t)bl * CS_BYTES); gp.dec = (float*)(mix_s + (size_t)GB * CS_BYTES + (size_t)bl * DEC_BYTES); gp.y = (bf16_t*)pb + dd::O_OG; gp.ldy = PLD; gp.S = dd::S; gp.C = dd::C;
          gla::g3_unit(gp, lds, hu / n3, hu % n3, 4, 68); }
        xcd_barrier(xb); }
      {
        bf16_t* ucT0 = (bf16_t*)mix_s; bf16_t* yT0 = (bf16_t*)(mix_s + GB * UCT_BYTES); float* ucc0 = (float*)(mix_s + GB * (UCT_BYTES + YT_BYTES)); float* z1c0 = (float*)(mix_s + GB * (UCT_BYTES + YT_BYTES + UCC_BYTES));
        const float* cw = a.hy_conv_w + (size_t)l * 3 * 1536; const float* cb = a.hy_conv_b + (size_t)l * 1536; const float* skp = a.hy_skip + (size_t)l * 2 * 512;
        { TID_SETUP
        { int t_ = blockIdx.x; hy::H0Regs hr = hy::h0_load(proj_s + (size_t)(t_ / (64 * 24)) * RB * PLD + dd::O_HY, PLD, t_ % (64 * 24), tz);
          for (; t_ < GB * 64 * 24; t_ += gridDim.x) { const int bl = t_ / (64 * 24), tn_ = t_ + gridDim.x; hy::H0Regs hn = hr;
            if (tn_ < GB * 64 * 24) hn = hy::h0_load(proj_s + (size_t)(tn_ / (64 * 24)) * RB * PLD + dd::O_HY, PLD, tn_ % (64 * 24), tz);
            hy::h0_compute(hr, cw, cb, ucT0 + (size_t)bl * 1536 * 4096, t_ % (64 * 24), lds, tz); hr = hn; } }
        if (!last) for (long i_ = gt; i_ < (long)GB * 256 * 1536; i_ += gs) { const int bl = (int)(i_ / (256 * 1536)); hy::cconv3_item(proj_s + ((size_t)bl * RB + dd::S) * PLD + dd::O_HY, PLD, cw, cb, ucc0 + (size_t)bl * 256 * 1536, i_ % (256 * 1536)); } }
        xcd_barrier(xb);
        { TID_SETUP
        for (int u = blockIdx.x; u < (GB / 2) * 512; u += gridDim.x) { const int bp_ = u / 512; hy::h1c_unit(ucT0 + (size_t)(2 * bp_) * 1536 * 4096, (const bf16_t*)a.tapsS, a.nrmS, skp, yT0 + (size_t)(2 * bp_) * 512 * 4096, u % 512, lds); }
        if (!last) for (long i_ = gt; i_ < (long)GB * 32 * 512; i_ += gs) { const int bl = (int)(i_ / (32 * 512)); hy::clong_item(ucc0 + (size_t)bl * 256 * 1536, nullptr, z1c0 + (size_t)bl * 256 * 512, nullptr, 0, a.tapsC, a.nrmC, skp, 0, i_ % (32 * 512)); } }
        xcd_barrier(xb);
        { TID_SETUP
        for (int t_ = blockIdx.x; t_ < GB * 64 * 8; t_ += gridDim.x) { const int bl = t_ / (64 * 8); hy::h2_tile(yT0 + (size_t)bl * 512 * 4096, proj_s + (size_t)bl * RB * PLD + dd::O_HY, PLD, t_ % (64 * 8), lds); }
        if (!last) for (long i_ = gt; i_ < (long)GB * 32 * 512; i_ += gs) { const int bl = (int)(i_ / (32 * 512)); hy::clong_item(ucc0 + (size_t)bl * 256 * 1536, z1c0 + (size_t)bl * 256 * 512, nullptr, proj_s + ((size_t)bl * RB + dd::S) * PLD + dd::O_HY, PLD, a.tapsC, a.nrmC, skp, 1, i_ % (32 * 512)); } }
        xcd_barrier(xb); }
      { { pg8::Gemm g{proj_s + dd::O_HY, ka.WhyT, RG, 1024, 512, PLD}; GroupOrder S; S.init(1024, (int)gridDim.x, (int)blockIdx.x, last);
          EpiMergeB<false> E{proj_s + dd::O_BR, (bf16_t*)mix_s}; pg8::gemm_phase<EpiMergeB<false>, GroupOrder, false>((PG8_LAS unsigned char*)(lds + RING_OFF), g, S, E, nullptr); }
        for (int gi = 1; gi < 3; ++gi) { const bool at = gi == 2;
          pg8::Gemm g{at ? (const bf16_t*)hb_s : (const bf16_t*)(proj_s + dd::O_OG), at ? ka.WattT : ka.WglaT, RG, 1024, at ? 1024 : 512, at ? 1024 : PLD}; GroupOrder S; S.init(1024, (int)gridDim.x, (int)blockIdx.x, last);
          EpiMergeB<true> E{proj_s + dd::O_BR + gi * 1024, (bf16_t*)mix_s}; pg8::gemm_phase<EpiMergeB<true>, GroupOrder, false>((PG8_LAS unsigned char*)(lds + RING_OFF), g, S, E, nullptr); }
        xcd_barrier(xb);
        pg8::Gemm g{(const bf16_t*)mix_s, ka.WoutT, RG, 1024, 1024, 0}; GroupOrder S; S.init(1024, (int)gridDim.x, (int)blockIdx.x, last);
        EpiOutG E{l == 0 ? a.x : (const float*)a.out, a.out, l == 0 ? a.ctx : (const float*)a.xc, a.xc, a.mod, b0, !last};
        pg8::gemm_phase<EpiOutG, GroupOrder, false>((PG8_LAS unsigned char*)(lds + RING_OFF), g, S, E, nullptr);
        xcd_barrier(xb); }
      {
        { TID_SETUP int* cnt = ka.cnt + (l * NGRP + grp) * 1024;
          LAS float* rwT = (LAS float*)(lds + RING_OFF);
          for (int k = tz; k < 1024; k += NTHREADS) {
#pragma unroll
            for (int e = 0; e < 16; ++e) rwT[e * 1024 + k] = a.router_w[(size_t)k * 16 + e]; }
          __syncthreads();
          LAS int* lcnt = (LAS int*)(lds + RING_OFF + 65536);
          if (tz < 32) lcnt[tz] = 0;
          __syncthreads();
          for (int rg = gw; rg < RG; rg += NGW) { const int bl = rg / RB, r = rg % RB, b = b0 + bl; if (last && r >= dd::S) continue; const float* md = a.mod + (size_t)(r < dd::S ? b : dd::B) * 6 * 1024;
            moe::route_row(xrow_cur(a, b, r), a.norm2_g + (size_t)l * 1024, md + 3 * 1024, md + 4 * 1024, hb_s + (size_t)rg * 1024, rwT, a.router_b, lcnt, ka.route + rg, ka.wts + 2 * rg, lane); }
          __syncthreads();
          if (tz < 16) lcnt[16 + tz] = atomicAdd(cnt + tz * 64, lcnt[tz]);
          __syncthreads();
          for (int rg = gw; rg < RG; rg += NGW) { if (last && (rg % RB) >= dd::S) continue; moe::Route* rt = ka.route + rg; if (lane == 0) { moe::Route r_ = *rt; r_.r0 += lcnt[16 + r_.e0]; r_.r1 += lcnt[16 + r_.e1]; *rt = r_; } }
          xcd_barrier(xb); }
        { TID_SETUP int* cnt = ka.cnt + (l * NGRP + grp) * 1024;
          if (tz == 0) { int acc_ = 0; for (int e = 0; e < 16; ++e) { poff[e] = acc_; acc_ += (cnt[e * 64] + 255) >> 8; } poff[16] = acc_; }
          __syncthreads();
          for (int rg = gw; rg < RG; rg += NGW) { if (last && (rg % RB) >= dd::S) continue; const moe::Route rt = ka.route[rg];
            const v4u h0 = *(const v4u*)(hb_s + (size_t)rg * 1024 + lane * 16), h1 = *(const v4u*)(hb_s + (size_t)rg * 1024 + lane * 16 + 8);
#pragma unroll
            for (int sl = 0; sl < 2; ++sl) { const int e = sl ? rt.e1 : rt.e0, rk = sl ? rt.r1 : rt.r0; const size_t dst = (size_t)poff[e] * 256 + rk;
              *(v4u*)(ka.hp + dst * 1024 + lane * 16) = h0; *(v4u*)(ka.hp + dst * 1024 + lane * 16 + 8) = h1;
              if (lane == 0) { ka.srcrow[dst] = 2 * rg + sl; ka.wgt[dst] = ka.wts[2 * rg + sl]; } } }
          for (int e = 0; e < 16; ++e) { const int c_ = cnt[e * 64], pe = ((c_ + 255) >> 8) << 8; for (int p_ = c_ + (int)gt; p_ < pe; p_ += (int)gs) ka.srcrow[(size_t)poff[e] * 256 + p_] = -1; }
          xcd_barrier(xb); }
        { pg8::Gemm g{ka.hp, ka.WguT, 0, 0, 1024, 0}; moe::MoeOrder S{(int)gridDim.x, (int)blockIdx.x, 4, poff}; moe::EpiGU E{ka.hid};
          pg8::gemm_phase<moe::EpiGU, moe::MoeOrder, false>((PG8_LAS unsigned char*)(lds + RING_OFF), g, S, E, nullptr);
          xcd_barrier(xb); }
        { pg8::Gemm g{ka.hid, ka.WdT, 0, 0, 512, 0}; moe::MoeOrder S{(int)gridDim.x, (int)blockIdx.x, 4, poff}; moe::EpiDown E{ka.srcrow, ka.wgt, ka.contrib, (size_t)RG * 1024};
          pg8::gemm_phase<moe::EpiDown, moe::MoeOrder, false>((PG8_LAS unsigned char*)(lds + RING_OFF), g, S, E, nullptr);
          xcd_barrier(xb); }
        { TID_SETUP
#pragma unroll 4
          for (long i_ = gt; i_ < (long)RG * 256; i_ += gs) { const int rg = (int)(i_ >> 8), c4 = (int)(i_ & 255) * 4; const int bl = rg / RB, r = rg % RB, b = b0 + bl; if (last && r >= dd::S) continue;
            float* xr = xrow_cur(a, b, r) + c4; const float* g2 = a.mod + (size_t)(r < dd::S ? b : dd::B) * 6 * 1024 + 5 * 1024 + c4;
            const unsigned long long u0 = *(const unsigned long long*)(ka.contrib + (size_t)rg * 1024 + c4), u1 = *(const unsigned long long*)(ka.contrib + (size_t)RG * 1024 + (size_t)rg * 1024 + c4);
            pg8::f32x4 xv = *(pg8::f32x4*)xr; const pg8::f32x4 gv = *(const pg8::f32x4*)g2;
#pragma unroll
            for (int e = 0; e < 4; ++e) xv[e] += gv[e] * (bf2f((bf16_t)(u0 >> (16 * e))) + bf2f((bf16_t)(u1 >> (16 * e))));
            *(pg8::f32x4*)xr = xv; }
          xcd_barrier(xb); }
      }
    }
  }
}
extern "C" void kernel_launch(void* const* d_in, const int* in_sizes, int n_in, void* d_out, int out_size, void* d_ws, size_t ws_size, hipStream_t stream) {
  static int grid = 0;
  if (!grid) {
    int dev = 0, cus = 0, per_cu = 0;
    (void)hipGetDevice(&dev); (void)hipDeviceGetAttribute(&cus, hipDeviceAttributeMultiprocessorCount, dev);
    (void)hipFuncSetAttribute((const void*)mega_kernel, hipFuncAttributeMaxDynamicSharedMemorySize, LDS_BYTES);
    (void)hipOccupancyMaxActiveBlocksPerMultiprocessor(&per_cu, mega_kernel, NTHREADS, LDS_BYTES);
    if (per_cu < 1) fprintf(stderr, "occupancy query says %d\n", per_cu);
    grid = cus;
  }
  KArgs ka{}; const float* ptrs[33]; for (int i = 0; i < 33; ++i) ptrs[i] = (const float*)d_in[i];
  set_inputs<TD>(ka.a, ptrs);
  char* wsb = (char*)d_ws; size_t off = BAR_BYTES;
  auto take = [&](size_t bytes) { char* p = wsb + off; off += (bytes + 255) & ~(size_t)255; return p; };
  NaiveBufs& a = ka.a;
  a.mod = (float*)take((size_t)(dd::B + 1) * 6 * 1024 * 4); a.hid2S = (float*)take((size_t)dd::S * 64 * 4); a.hid2C = (float*)take((size_t)dd::C * 64 * 4);
  a.tapsS = (float*)take((size_t)2 * 512 * 2 * 8232 * 2 + 64); a.tapsC = (float*)take((size_t)2 * 512 * 512 * 4); a.nrmS = (float*)take(1024 * 4); a.nrmC = (float*)take(1024 * 4);
  a.xc = (float*)take((size_t)dd::B * dd::C * 1024 * 4);
  ka.WinT = (bf16_t*)take((size_t)NINP * 1024 * 2); ka.WhyT = (bf16_t*)take((size_t)1024 * 512 * 2); ka.WglaT = (bf16_t*)take((size_t)1024 * 512 * 2); ka.WattT = (bf16_t*)take((size_t)1024 * 1024 * 2);
  ka.WoutT = (bf16_t*)take((size_t)1024 * 1024 * 2); ka.WguT = (bf16_t*)take((size_t)16 * 1024 * 1024 * 2); ka.WdT = (bf16_t*)take((size_t)16 * 1024 * 512 * 2);
  ka.hb = (bf16_t*)take((size_t)RG * 1024 * 2); ka.mix = (unsigned char*)take(MIX_BYTES);
  ka.proj = (bf16_t*)take((size_t)RG * PLD * 2);
  { char* p = (char*)ka.proj; ka.hp = (bf16_t*)p; p += (size_t)MPG * 1024 * 2; ka.hid = (bf16_t*)p; p += (size_t)MPG * 512 * 2; ka.contrib = (bf16_t*)p; p += (size_t)2 * RG * 1024 * 2;
    ka.srcrow = (int*)p; p += (size_t)MPG * 4; ka.wgt = (float*)p; p += (size_t)MPG * 4; ka.route = (moe::Route*)p; p += (size_t)RG * 16; ka.wts = (float*)p; p += (size_t)RG * 8;
    if ((size_t)(p - (char*)ka.proj) > (size_t)RG * PLD * 2) fprintf(stderr, "MoE alias region too large\n"); }
  a.out = (float*)d_out; ka.bar = (unsigned*)d_ws; ka.cnt = (int*)(wsb + CNT_OFF);
  if (off > ws_size) fprintf(stderr, "workspace too small: need %zu have %zu\n", off, ws_size);
  (void)hipMemsetAsync(d_ws, 0, BAR_BYTES, stream);
  hipLaunchKernelGGL(mega_kernel, dim3(grid), dim3(NTHREADS), LDS_BYTES, stream, ka);
}
```

```cpp
#include <hip/hip_runtime.h>
#include <cstddef>
#include <cstdio>
#include <cstdint>
#include <hip/hip_bf16.h>
#include <hip/hip_runtime.h>
namespace pg8 {
#define PG8_LAS __attribute__((address_space(3)))
typedef unsigned short bf16_t;
typedef short bf16x8 __attribute__((ext_vector_type(8)));
typedef float f32x4 __attribute__((ext_vector_type(4)));
typedef unsigned u32x4 __attribute__((ext_vector_type(4)));
constexpr int BM = 256, BK = 64, HALF = 128, HTB = HALF * BK * 2  , STAGE_BYTES = 8 * HTB, NXCD = 8, WGM = 8;

__host__ __device__ __forceinline__ int lds_byte(int r, int c) { const int st = (r >> 4) * 2 + (c >> 5), rr = r & 15, cc = c & 31, ob = rr * 64 + cc * 2; return st * 1024 + (ob ^ (((ob >> 9) & 1) << 5)); }
__host__ __device__ __forceinline__ void stage_rc(int b, int& R, int& C) { const int st = b / 1024, sb = b % 1024, swz = sb ^ (((sb >> 9) & 1) << 5); R = (st >> 1) * 16 + swz / 64; C = (st & 1) * 32 + (swz % 64) / 2; }
__host__ __device__ __forceinline__ int perm32(int rho) { const int n = rho >> 4, i = rho & 15; return 8 * (i >> 2) + 4 * n + (i & 3); }

struct Unit { int pm, pn, acol; };
struct Gemm { const bf16_t* A; const bf16_t* Bt; int M, N, K; int lda; };

struct StaticOrder {
    int nM, nN, nwg, G, c;
    __host__ __device__ void init(int M, int N, int G_, int c_) { nM = M / BM; nN = N / BM; nwg = nM * nN; G = G_; c = c_; }
    __host__ __device__ bool next(int i, Unit& u) const {
        const long L = (long)i * G + c; if (L >= nwg) return false;
        int wgid = (int)L; { const int q = nwg / NXCD, r = nwg % NXCD, xcd = wgid % NXCD, off = wgid / NXCD; wgid = (xcd < r ? xcd * (q + 1) : r * (q + 1) + (xcd - r) * q) + off; }
        const int nig = WGM * nN, gid = wgid / nig, fm = gid * WGM, gsz = (nM - fm) < WGM ? (nM - fm) : WGM;
        u.pm = fm + ((wgid % nig) % gsz); u.pn = (wgid % nig) / gsz; u.acol = 0; return true;
    }
    __device__ __forceinline__ void a_ready(const Unit&) const {}
    __device__ __forceinline__ void done(const Unit&) const {}
};
__device__ __forceinline__ unsigned cvt_pk_bf16(float lo, float hi) { unsigned r; asm volatile("v_cvt_pk_bf16_f32 %0, %1, %2" : "=v"(r) : "v"(lo), "v"(hi)); return r; }
typedef float f32x2 __attribute__((ext_vector_type(2)));
template <class Epi, class Sched, bool STAMP = false>
__device__ __forceinline__ void gemm_phase(PG8_LAS unsigned char* lds, const Gemm g, const Sched& S, const Epi& E, unsigned long long* stamps) {
    int tid = threadIdx.x; asm volatile("" : "+v"(tid)); const int wid = __builtin_amdgcn_readfirstlane(tid >> 6), lane = tid & 63, wr = wid >> 2, wc = wid & 3, fr = lane & 15, fq = lane >> 4;
    const int K = g.K, nt = K / BK, LDA = g.lda ? g.lda : g.K;
    int ts_lo = 0, ts_hi = 0, nts = 0; const unsigned long long rt_entry = STAMP ? (unsigned long long)wall_clock64() : 0ull;
#define PG8_STAMP() do { if (STAMP && wid == 0 && nts < 64) { const unsigned long long _c = (unsigned long long)clock64(); \
        ts_lo = (lane == nts) ? (int)(unsigned)_c : ts_lo; ts_hi = (lane == nts) ? (int)(unsigned)(_c >> 32) : ts_hi; ++nts; } } while (0)
    PG8_STAMP();
    unsigned voffA[2], voffB[2];
#pragma unroll
    for (int i = 0; i < 2; ++i) { int R, C; stage_rc(tid * 16 + i * 8192, R, C); const int Rb = Epi::PERM ? ((R & ~31) + perm32(R & 31)) : R;
        voffA[i] = (unsigned)(R * LDA + C) * 2u; voffB[i] = (unsigned)(Rb * K + C) * 2u; }
    const size_t kstep = (size_t)(BK * 2);
    const size_t hstep = (size_t)HALF * K * 2;
    const size_t tstep = 2 * hstep;
    const size_t hstepA = (size_t)HALF * LDA * 2, tstepA = 2 * hstepA;
    const unsigned ldsw = (unsigned)wid * 1024u;
    const int aoff = lds_byte(wr * 64 + fr, fq * 8), boff = lds_byte(wc * 32 + fr, fq * 8);
#define PG8_SA(b, h) (((b) * 2 + (h)) * HTB)
#define PG8_SB(b, h) ((4 + (b) * 2 + (h)) * HTB)
#define PG8_STAGE(bufoff, gbase, voff) do { _Pragma("unroll") for (int _i = 0; _i < 2; ++_i) \
        __builtin_amdgcn_global_load_lds((const unsigned*)((const char*)(gbase) + (voff)[_i]), (PG8_LAS unsigned*)(lds + (bufoff) + ldsw + _i * 8192), 16, 0, 0); } while (0)
#define PG8_LDA(dst, b, h) do { _Pragma("unroll") for (int m = 0; m < 4; ++m) _Pragma("unroll") for (int k = 0; k < 2; ++k) dst[m][k] = *(const PG8_LAS bf16x8*)(lds + PG8_SA(b, h) + aoff + m * 2048 + k * 1024); } while (0)
#define PG8_LDB(dst, b, h) do { _Pragma("unroll") for (int n = 0; n < 2; ++n) _Pragma("unroll") for (int k = 0; k < 2; ++k) dst[n][k] = *(const PG8_LAS bf16x8*)(lds + PG8_SB(b, h) + boff + n * 2048 + k * 1024); } while (0)
#define PG8_MMA(ai, bj, At, Bt) do { __builtin_amdgcn_s_setprio(1); _Pragma("unroll") for (int m = 0; m < 4; ++m) _Pragma("unroll") for (int n = 0; n < 2; ++n) _Pragma("unroll") for (int k = 0; k < 2; ++k) \
        acc[ai][bj][m][n] = __builtin_amdgcn_mfma_f32_16x16x32_bf16(Bt[n][k], At[m][k], acc[ai][bj][m][n], 0, 0, 0); __builtin_amdgcn_s_setprio(0); } while (0)
#define PG8_WAIT_V(n) asm volatile("s_waitcnt vmcnt(" #n ")" ::: "memory")
#define PG8_WAIT_L(n) asm volatile("s_waitcnt lgkmcnt(" #n ")" ::: "memory")
#define PG8_BAR __builtin_amdgcn_s_barrier()
#define PG8_SCHED __builtin_amdgcn_sched_barrier(0)
    Unit cur, nxt; int ui = 0;
    if (!S.next(0, cur)) return;
    f32x4 acc[2][2][4][2];
#pragma unroll
    for (int a = 0; a < 2; ++a)
#pragma unroll
        for (int b = 0; b < 2; ++b)
#pragma unroll
            for (int m = 0; m < 4; ++m)
#pragma unroll
                for (int n = 0; n < 2; ++n) acc[a][b][m][n] = (f32x4){0.f, 0.f, 0.f, 0.f};
    bf16x8 At[4][2], B0[2][2], B1[2][2];
    const char* cA = (const char*)g.A + (size_t)cur.pm * tstepA + (size_t)cur.acol * 2; const char* cB = (const char*)g.Bt + (size_t)cur.pn * tstep;
    S.a_ready(cur);
    PG8_STAGE(PG8_SB(0, 0), cB, voffB); PG8_STAGE(PG8_SA(0, 0), cA, voffA); PG8_STAGE(PG8_SB(0, 1), cB + hstep, voffB); PG8_STAGE(PG8_SA(0, 1), cA + hstepA, voffA);
    if (wr == 1) PG8_BAR;
    PG8_WAIT_V(4); PG8_BAR;
    PG8_STAGE(PG8_SB(1, 0), cB + kstep, voffB); PG8_STAGE(PG8_SA(1, 0), cA + kstep, voffA); PG8_STAGE(PG8_SB(1, 1), cB + hstep + kstep, voffB);
    PG8_WAIT_V(6); PG8_BAR;
    PG8_STAMP();
    for (;;) {
        const bool has_next = S.next(ui + 1, nxt);
        const char* nA = has_next ? (const char*)g.A + (size_t)nxt.pm * tstepA + (size_t)nxt.acol * 2 : cA; const char* nB = has_next ? (const char*)g.Bt + (size_t)nxt.pn * tstep : cB;
        for (int t = 0; t < nt; t += 2) {
            const bool last = (t == nt - 2);
            const char* a1 = cA + (size_t)(t + 1) * kstep;
            const char* a2 = last ? nA : cA + (size_t)(t + 2) * kstep; const char* b2 = last ? nB : cB + (size_t)(t + 2) * kstep;
            const char* a3 = a2 + kstep; const char* b3 = b2 + kstep;
            if (last && has_next) S.a_ready(nxt);
            PG8_LDB(B0, 0, 0); PG8_SCHED; PG8_LDA(At, 0, 0); PG8_STAGE(PG8_SA(1, 1), a1 + hstepA, voffA);
            PG8_WAIT_L(8); PG8_BAR; PG8_WAIT_L(0); PG8_MMA(0, 0, At, B0); PG8_BAR; PG8_SCHED;
            PG8_LDB(B1, 0, 1); PG8_STAGE(PG8_SB(0, 0), b2, voffB);
            PG8_BAR; PG8_WAIT_L(0); PG8_MMA(0, 1, At, B1); PG8_BAR;
            PG8_LDA(At, 0, 1); PG8_STAGE(PG8_SA(0, 0), a2, voffA);
            PG8_BAR; PG8_WAIT_L(0); PG8_MMA(1, 0, At, B0); PG8_BAR; PG8_SCHED;
            PG8_STAGE(PG8_SB(0, 1), b2 + hstep, voffB);
            PG8_WAIT_V(6); PG8_BAR; PG8_MMA(1, 1, At, B1); PG8_BAR;
            PG8_LDB(B0, 1, 0); PG8_SCHED; PG8_LDA(At, 1, 0); PG8_STAGE(PG8_SA(0, 1), a2 + hstepA, voffA);
            PG8_WAIT_L(8); PG8_BAR; PG8_WAIT_L(0); PG8_MMA(0, 0, At, B0); PG8_BAR; PG8_SCHED;
            PG8_LDB(B1, 1, 1); PG8_STAGE(PG8_SB(1, 0), b3, voffB);
            PG8_BAR; PG8_WAIT_L(0); PG8_MMA(0, 1, At, B1); PG8_BAR;
            PG8_LDA(At, 1, 1); PG8_STAGE(PG8_SA(1, 0), a3, voffA);
            PG8_BAR; PG8_WAIT_L(0); PG8_MMA(1, 0, At, B0); PG8_BAR; PG8_SCHED;
            PG8_STAGE(PG8_SB(1, 1), b3 + hstep, voffB);
            PG8_WAIT_V(6); PG8_BAR; PG8_MMA(1, 1, At, B1); PG8_BAR;
        }
        PG8_STAMP();
        if constexpr (!Epi::AFTER_DRAIN) { E(acc, cur, wr, wc, fr, fq); S.done(cur); }
        PG8_STAMP();
        if (!has_next) break;
#pragma unroll
        for (int a = 0; a < 2; ++a)
#pragma unroll
            for (int b = 0; b < 2; ++b)
#pragma unroll
                for (int m = 0; m < 4; ++m)
#pragma unroll
                    for (int n = 0; n < 2; ++n) acc[a][b][m][n] = (f32x4){0.f, 0.f, 0.f, 0.f};
        cur = nxt; cA = nA; cB = nB; ++ui;
    }
    PG8_WAIT_V(0);
    if (wr == 0) PG8_BAR;
    PG8_BAR;
    if constexpr (Epi::AFTER_DRAIN) { E.fused(acc, cur, wr, wc, fr, fq, lds, wid, lane); S.done(cur); }
    PG8_STAMP();
    if (STAMP && wid == 0) { stamps[lane] = lane < nts ? (((unsigned long long)(unsigned)ts_hi << 32) | (unsigned)ts_lo) : 0ull;
        if (lane == 62) stamps[62] = rt_entry; if (lane == 63) stamps[63] = (unsigned long long)wall_clock64(); }
#undef PG8_STAMP
#undef PG8_SA
#undef PG8_SB
#undef PG8_STAGE
#undef PG8_LDA
#undef PG8_LDB
#undef PG8_MMA
#undef PG8_WAIT_V
#undef PG8_WAIT_L
#undef PG8_BAR
#undef PG8_SCHED
}
}

#define LAS __attribute__((address_space(3)))
typedef unsigned short bf16_t;
constexpr int NWAVES = 8, NTHREADS = 512;
constexpr int LDS_BYTES = 147456;
constexpr int RING_OFF = 0;
constexpr int MISC_OFF = 131072;
constexpr int NINP = 7936;

__device__ __forceinline__ unsigned f2bf(float f) { unsigned u = __builtin_bit_cast(unsigned, f); return (u + 0x7fffu + ((u >> 16) & 1u)) >> 16; }
__device__ __forceinline__ unsigned pk2(float lo, float hi) { return f2bf(lo) | (f2bf(hi) << 16); }
__device__ __forceinline__ float bf2f(bf16_t b) { return __builtin_bit_cast(float, ((unsigned)b) << 16); }
typedef unsigned v4u __attribute__((ext_vector_type(4)));

__device__ __forceinline__ void transpose_item(const float* W, int K, int N, bf16_t* WT, int row_off, LAS float* scr, int item, int lane) {
  const int nblk = N / 32, kb = item / nblk, nb = item % nblk, k0 = 64 * kb, n0 = 32 * nb;
  float wreg[32];
#pragma unroll
  for (int i = 0; i < 32; ++i) { const int kk = 2 * i + (lane >> 5); wreg[i] = W[(size_t)(k0 + kk) * N + n0 + (lane & 31)]; }
#pragma unroll
  for (int i = 0; i < 32; ++i) { const int kk = 2 * i + (lane >> 5); scr[kk * 33 + (lane & 31)] = wreg[i]; }
  asm volatile("s_waitcnt lgkmcnt(0)" ::: "memory");
  const int c = lane & 7;
#pragma unroll
  for (int j = 0; j < 4; ++j) { const int n = (lane >> 3) + 8 * j; const LAS float* s = scr + (8 * c) * 33 + n;
    v4u o; o.x = pk2(s[0 * 33], s[1 * 33]); o.y = pk2(s[2 * 33], s[3 * 33]); o.z = pk2(s[4 * 33], s[5 * 33]); o.w = pk2(s[6 * 33], s[7 * 33]);
    *(v4u*)(WT + (size_t)(row_off + n0 + n) * K + k0 + 8 * c) = o; }
  asm volatile("s_waitcnt lgkmcnt(0)" ::: "memory");
}

struct EpiProjF32 {
  static constexpr bool PERM = false, AFTER_DRAIN = false;
  float* C; int ldc; int ncols;
  __device__ __forceinline__ void operator()(const pg8::f32x4 (&acc)[2][2][4][2], const pg8::Unit& u, int wr, int wc, int fr, int fq) const {
    const int row0 = u.pm * 256 + wr * 64 + fr, col0 = u.pn * 256 + wc * 32 + 4 * fq;
#pragma unroll
    for (int ai = 0; ai < 2; ++ai)
#pragma unroll
      for (int m = 0; m < 4; ++m) { float* rowp = C + (size_t)(row0 + ai * 128 + m * 16) * ldc + col0;
#pragma unroll
        for (int bj = 0; bj < 2; ++bj)
#pragma unroll
          for (int n = 0; n < 2; ++n) if (col0 + bj * 128 + n * 16 < ncols) *(pg8::f32x4*)(rowp + bj * 128 + n * 16) = acc[ai][bj][m][n]; }
  }
};

__device__ __forceinline__ float fsigmoid(float x) { return 1.f / (1.f + __expf(-x)); }
template <bool ACCUM> struct EpiMerge {
  static constexpr bool PERM = true, AFTER_DRAIN = false;
  const float* gate; int ldg; bf16_t* M; int ldm;
  __device__ __forceinline__ void operator()(const pg8::f32x4 (&acc)[2][2][4][2], const pg8::Unit& u, int wr, int wc, int fr, int fq) const {
    const int row0 = u.pm * 256 + wr * 64 + fr, col0 = u.pn * 256 + wc * 32 + 8 * fq;
#pragma unroll
    for (int ai = 0; ai < 2; ++ai)
#pragma unroll
      for (int m = 0; m < 4; ++m) { const size_t r = (size_t)(row0 + ai * 128 + m * 16);
#pragma unroll
        for (int bj = 0; bj < 2; ++bj) { const int c = col0 + bj * 128;
          const pg8::f32x4 g0 = *(const pg8::f32x4*)(gate + r * ldg + c), g1 = *(const pg8::f32x4*)(gate + r * ldg + c + 4);
          pg8::f32x4 v0 = acc[ai][bj][m][0], v1 = acc[ai][bj][m][1];
#pragma unroll
          for (int e = 0; e < 4; ++e) { v0[e] *= fsigmoid(g0[e]); v1[e] *= fsigmoid(g1[e]); }
          v4u* dst = (v4u*)(M + r * ldm + c);
          if (ACCUM) { const v4u o = *dst; v0[0] += bf2f(o.x & 0xffff); v0[1] += bf2f(o.x >> 16); v0[2] += bf2f(o.y & 0xffff); v0[3] += bf2f(o.y >> 16);
            v1[0] += bf2f(o.z & 0xffff); v1[1] += bf2f(o.z >> 16); v1[2] += bf2f(o.w & 0xffff); v1[3] += bf2f(o.w >> 16); }
          v4u o2; o2.x = pk2(v0[0], v0[1]); o2.y = pk2(v0[2], v0[3]); o2.z = pk2(v1[0], v1[1]); o2.w = pk2(v1[2], v1[3]); *dst = o2; } }
  }
};
struct EpiOut {
  static constexpr bool PERM = false, AFTER_DRAIN = false;
  const float* resL; float* outL; const float* gL;
  const float* resC; float* outC; const float* gC;
  __device__ __forceinline__ void operator()(const pg8::f32x4 (&acc)[2][2][4][2], const pg8::Unit& u, int wr, int wc, int fr, int fq) const {
    const bool isc = u.pm == 16; if (isc && outC == nullptr) return;
    const float* res = isc ? resC : resL; float* out = isc ? outC : outL; const float* gv = isc ? gC : gL;
    const int row0 = (isc ? 0 : u.pm * 256) + wr * 64 + fr, col0 = u.pn * 256 + wc * 32 + 4 * fq;
    pg8::f32x4 gg[2][2];
#pragma unroll
    for (int bj = 0; bj < 2; ++bj)
#pragma unroll
      for (int n = 0; n < 2; ++n) gg[bj][n] = *(const pg8::f32x4*)(gv + col0 + bj * 128 + n * 16);
#pragma unroll
    for (int ai = 0; ai < 2; ++ai)
#pragma unroll
      for (int m = 0; m < 4; ++m) { const size_t ro = (size_t)(row0 + ai * 128 + m * 16) * 1024 + col0;
#pragma unroll
        for (int bj = 0; bj < 2; ++bj)
#pragma unroll
          for (int n = 0; n < 2; ++n) { const pg8::f32x4 rv = *(const pg8::f32x4*)(res + ro + bj * 128 + n * 16); *(pg8::f32x4*)(out + ro + bj * 128 + n * 16) = rv + gg[bj][n] * acc[ai][bj][m][n]; } }
  }
};
namespace att {
using bf16 = __hip_bfloat16;
constexpr int D = 128, NW = 8, QBLK = 32, KVBLK = 64; constexpr float SCALE = 0.088388347648318440f; constexpr float THR = 8.f; constexpr int SDEPTH = 2;
constexpr size_t SHM_V = KVBLK * D * 2, SHM_K = KVBLK * D * 2, SHM_ATTN = 2 * SHM_V + 2 * SHM_K + NW * 64 * 4;
using bf16x8 = __attribute__((ext_vector_type(8))) short;
using s16x4  = __attribute__((ext_vector_type(4))) short;
using f32x16 = __attribute__((ext_vector_type(16))) float;
using f32x8  = __attribute__((ext_vector_type(8))) float;
using u32x4  = __attribute__((ext_vector_type(4))) unsigned;
#define KSWZ(row, colB) ((row) * 256 + ((colB) ^ (((row) & 7) << 4)))
#define SBAR() __builtin_amdgcn_sched_barrier(0)
__device__ __forceinline__ int crow(int r, int hi) { return (r & 3) + 8 * (r >> 2) + 4 * hi; }
__device__ __forceinline__ unsigned cvtpk(float lo, float hi) {
  unsigned r; asm volatile("v_cvt_pk_bf16_f32 %0, %1, %2" : "=v"(r) : "v"(lo), "v"(hi)); return r;
}
template <typename TIn> struct Stage;
template <> struct Stage<bf16>  { using T = bf16x8;
  __device__ static __forceinline__ T ld8(const bf16* p) { return *reinterpret_cast<const bf16x8*>(p); }
  __device__ static __forceinline__ bf16x8 tobf(T x) { return x; } };
template <> struct Stage<float> { using T = f32x8;
  __device__ static __forceinline__ T ld8(const float* p) { return *reinterpret_cast<const f32x8*>(p); }
  __device__ static __forceinline__ bf16x8 tobf(T x) {
    u32x4 w = {cvtpk(x[0], x[1]), cvtpk(x[2], x[3]), cvtpk(x[4], x[5]), cvtpk(x[6], x[7])}; return *reinterpret_cast<bf16x8*>(&w); } };

__device__ __forceinline__ void partialSM(f32x16& p0, f32x16& p1, float& m_reg, float& mn, float& alpha) {
  constexpr float C = SCALE * 1.4426950408889634f;
  float pmax = p0[0]; for (int r = 1; r < 16; ++r) pmax = fmaxf(pmax, p0[r]); for (int r = 0; r < 16; ++r) pmax = fmaxf(pmax, p1[r]);
  { auto rr = __builtin_amdgcn_permlane32_swap(__float_as_uint(pmax), __float_as_uint(pmax), false, false);
    pmax = fmaxf(__uint_as_float(rr[0]), __uint_as_float(rr[1])); }
  if (__builtin_expect(__all(pmax - m_reg <= THR / SCALE), 1)) { mn = m_reg; alpha = 1.f; }
  else { mn = fmaxf(m_reg, pmax); alpha = __builtin_amdgcn_exp2f((m_reg - mn) * C); m_reg = mn; }
  float mnC = -mn * C;
  for (int r = 0; r < 16; ++r) p0[r] = fmaf(p0[r], C, mnC); for (int r = 0; r < 16; ++r) p1[r] = fmaf(p1[r], C, mnC);
  for (int r = 0; r < 16; ++r) p0[r] = __builtin_amdgcn_exp2f(p0[r]);
}
__device__ __forceinline__ void finishSM(f32x16& p0, f32x16& p1, float alpha, float& l_reg, bf16x8& pa0, bf16x8& pa1, bf16x8& pa2, bf16x8& pa3) {
  for (int r = 0; r < 16; ++r) p1[r] = __builtin_amdgcn_exp2f(p1[r]);
  float ps = 0; for (int r = 0; r < 16; ++r) ps += p0[r]; for (int r = 0; r < 16; ++r) ps += p1[r];
  { auto rr = __builtin_amdgcn_permlane32_swap(__float_as_uint(ps), __float_as_uint(ps), false, false);
    ps = __uint_as_float(rr[0]) + __uint_as_float(rr[1]); }
  l_reg = l_reg * alpha + ps;
#define PK4(P, BASE, OUT) do { unsigned a0 = cvtpk(P[BASE + 0], P[BASE + 1]), a1 = cvtpk(P[BASE + 2], P[BASE + 3]);   \
    unsigned b0 = cvtpk(P[BASE + 4], P[BASE + 5]), b1 = cvtpk(P[BASE + 6], P[BASE + 7]);                              \
    auto r0 = __builtin_amdgcn_permlane32_swap(a0, b0, false, false); auto r1 = __builtin_amdgcn_permlane32_swap(a1, b1, false, false); \
    u32x4 w = {r0[0], r1[0], r0[1], r1[1]}; OUT = *reinterpret_cast<bf16x8*>(&w); } while (0)
  PK4(p0, 0, pa0); PK4(p0, 8, pa1); PK4(p1, 0, pa2); PK4(p1, 8, pa3);
#undef PK4
}
__device__ __forceinline__ void qkt(f32x16& p0, f32x16& p1, const bf16* Ks, const bf16x8* qr, int r32, int hi) {
  p0 = f32x16{}; p1 = f32x16{};
  for (int d0 = 0; d0 < 8; ++d0) { int cb = (d0 * 16 + hi * 8) * 2;
    bf16x8 b0 = *reinterpret_cast<const bf16x8*>((const char*)Ks + KSWZ(r32, cb));
    bf16x8 b1 = *reinterpret_cast<const bf16x8*>((const char*)Ks + KSWZ(32 + r32, cb));
    p0 = __builtin_amdgcn_mfma_f32_32x32x16_bf16(b0, qr[d0], p0, 0, 0, 0);
    p1 = __builtin_amdgcn_mfma_f32_32x32x16_bf16(b1, qr[d0], p1, 0, 0, 0); }
}
__device__ __forceinline__ int v_st(int k, int c) { const int kk = (k & ~0xC) | ((k & 4) << 1) | ((k & 8) >> 1); return ((kk >> 3) * 4 + (c >> 5)) * 512 + ((kk & 7) * 32 + (c & 31)) * 2; }
__device__ __forceinline__ int v_rd_base(int lane) { return ((lane & 3) << 3) | (((lane >> 2) & 3) << 6) | (((lane >> 4) & 1) << 5) | (((lane >> 5) & 1) << 8); }
constexpr int v_rd_off(int d0, int ks, int half) { return d0 * 512 + ks * 4096 + half * 2048; }
template <int OFF> __device__ __forceinline__ s16x4 tr_read(int vb) {
  s16x4 r; asm volatile("ds_read_b64_tr_b16 %0, %1 offset:%2" : "=&v"(r) : "v"(vb), "i"(OFF) : "memory"); return r;
}
template <int D0> __device__ __forceinline__ void pv_one(f32x16& od, int vb, bf16x8 pa0, bf16x8 pa1, bf16x8 pa2, bf16x8 pa3) {
  const s16x4 l0 = tr_read<v_rd_off(D0, 0, 0)>(vb), h0 = tr_read<v_rd_off(D0, 0, 1)>(vb), l1 = tr_read<v_rd_off(D0, 1, 0)>(vb), h1 = tr_read<v_rd_off(D0, 1, 1)>(vb);
  const s16x4 l2 = tr_read<v_rd_off(D0, 2, 0)>(vb), h2 = tr_read<v_rd_off(D0, 2, 1)>(vb), l3 = tr_read<v_rd_off(D0, 3, 0)>(vb), h3 = tr_read<v_rd_off(D0, 3, 1)>(vb);
  asm volatile("s_waitcnt lgkmcnt(0)" ::: "memory"); SBAR();
#define PK(L, H) (bf16x8){L[0], L[1], L[2], L[3], H[0], H[1], H[2], H[3]}
  od = __builtin_amdgcn_mfma_f32_32x32x16_bf16(pa0, PK(l0, h0), od, 0, 0, 0);
  od = __builtin_amdgcn_mfma_f32_32x32x16_bf16(pa1, PK(l1, h1), od, 0, 0, 0);
  od = __builtin_amdgcn_mfma_f32_32x32x16_bf16(pa2, PK(l2, h2), od, 0, 0, 0);
  od = __builtin_amdgcn_mfma_f32_32x32x16_bf16(pa3, PK(l3, h3), od, 0, 0, 0);
#undef PK
}
__device__ __forceinline__ void pv_d0(f32x16* o, int vb, bf16x8 pa0, bf16x8 pa1, bf16x8 pa2, bf16x8 pa3) {
  pv_one<0>(o[0], vb, pa0, pa1, pa2, pa3); pv_one<1>(o[1], vb, pa0, pa1, pa2, pa3); pv_one<2>(o[2], vb, pa0, pa1, pa2, pa3); pv_one<3>(o[3], vb, pa0, pa1, pa2, pa3);
}

template <typename TQ, int LDQ, int LDK, int LDO, bool OBF16>
__device__ __forceinline__ void attn_dense_body(const TQ* Qb, const bf16* Kh, const bf16* Vh,
                                                void* Obv, int seq, char* lds) {
  using St = Stage<bf16>; using SQ = Stage<TQ>;
  int tid = threadIdx.x; asm volatile("" : "+v"(tid)); const int wid = tid >> 6, lane = tid & 63, r32 = lane & 31, hi = lane >> 5;
  bf16* V_lds = (bf16*)lds; bf16* K_lds = (bf16*)(lds + 2 * SHM_V);
  float* ws = (float*)(lds + 2 * SHM_V + 2 * SHM_K) + wid * 64; float* li_l = ws; float* al_l = ws + 32;
  float m_reg = -1e30f, l_reg = 0; f32x16 o[4] = {}; bf16x8 qr[8];
  const TQ* Qw = Qb + (long)(wid * QBLK + r32) * LDQ + hi * 8;
#pragma unroll
  for (int d0 = 0; d0 < 8; ++d0) qr[d0] = SQ::tobf(SQ::ld8(Qw + d0 * 16));
  const int sr = tid >> 4, sc = (tid & 15) * 8, vst0 = v_st(sr, sc), vst1 = v_st(32 + sr, sc);
  const int vb0 = (int)(uintptr_t)V_lds + v_rd_base(lane);
  struct { typename St::T vs0, vs1, ks0, ks1; } sr_[SDEPTH];
#define SLOAD(i, k0) do { sr_[i].vs0 = St::ld8(&Vh[(long)((k0) + sr) * LDK + sc]); sr_[i].vs1 = St::ld8(&Vh[(long)((k0) + 32 + sr) * LDK + sc]); \
    sr_[i].ks0 = St::ld8(&Kh[(long)((k0) + sr) * LDK + sc]); sr_[i].ks1 = St::ld8(&Kh[(long)((k0) + 32 + sr) * LDK + sc]); } while (0)
#define SWRITE(b, i) do { *(bf16x8*)((char*)V_lds + (b) * SHM_V + vst0) = St::tobf(sr_[i].vs0);          \
    *(bf16x8*)((char*)V_lds + (b) * SHM_V + vst1) = St::tobf(sr_[i].vs1); int kc = sc * 2;               \
    *(bf16x8*)((char*)K_lds + (b) * SHM_K + KSWZ(sr, kc)) = St::tobf(sr_[i].ks0);                       \
    *(bf16x8*)((char*)K_lds + (b) * SHM_K + KSWZ(32 + sr, kc)) = St::tobf(sr_[i].ks1); } while (0)
#define SWAIT() do { if constexpr (SDEPTH == 2) asm volatile("s_waitcnt vmcnt(4)" ::: "memory"); else asm volatile("s_waitcnt vmcnt(0)" ::: "memory"); } while (0)
#define RESC(a) do { if (__any((a) < 1.f)) { if (hi == 0) al_l[r32] = (a); asm volatile("s_waitcnt lgkmcnt(0)" ::: "memory"); \
    for (int d = 0; d < 4; ++d) for (int r = 0; r < 16; ++r) o[d][r] *= al_l[crow(r, hi)]; } } while (0)
  f32x16 pA0, pA1, pB0, pB1; float mnA, mnB, alA, alB; bf16x8 pa0, pa1, pa2, pa3; const int NT = seq / KVBLK;
  constexpr int SE = 0, SO = SDEPTH - 1;
  SLOAD(SE, 0); asm volatile("s_waitcnt vmcnt(0)" ::: "memory"); SWRITE(0, SE); __syncthreads();
  qkt(pA0, pA1, K_lds, qr, r32, hi); partialSM(pA0, pA1, m_reg, mnA, alA);
  SLOAD(SO, KVBLK); if constexpr (SDEPTH == 2) { if (2 < NT) SLOAD(SE, 2 * KVBLK); }
  SWAIT(); SWRITE(1, SO); __syncthreads();
  for (int j = 1; j + 1 < NT; j += 2) {
    SBAR(); qkt(pB0, pB1, (bf16*)((char*)K_lds + SHM_K), qr, r32, hi);
    finishSM(pA0, pA1, alA, l_reg, pa0, pa1, pa2, pa3); SBAR();
    SLOAD(SO, (j + SDEPTH) * KVBLK); SBAR();
    pv_d0(o, vb0, pa0, pa1, pa2, pa3); partialSM(pB0, pB1, m_reg, mnB, alB);
    __syncthreads(); SWAIT(); SWRITE(0, SE);
    RESC(alB); __syncthreads();
    SBAR(); qkt(pA0, pA1, K_lds, qr, r32, hi);
    finishSM(pB0, pB1, alB, l_reg, pa0, pa1, pa2, pa3); SBAR();
    if (SDEPTH == 1 || j + 3 < NT) SLOAD(SE, (j + 1 + SDEPTH) * KVBLK); SBAR();
    pv_d0(o, vb0 + (int)SHM_V, pa0, pa1, pa2, pa3); partialSM(pA0, pA1, m_reg, mnA, alA);
    __syncthreads(); SWAIT(); SWRITE(1, SO);
    RESC(alA); __syncthreads();
  }
  SBAR(); qkt(pB0, pB1, (bf16*)((char*)K_lds + SHM_K), qr, r32, hi);
  finishSM(pA0, pA1, alA, l_reg, pa0, pa1, pa2, pa3); SBAR();
  pv_d0(o, vb0, pa0, pa1, pa2, pa3); partialSM(pB0, pB1, m_reg, mnB, alB);
  __syncthreads(); RESC(alB);
  finishSM(pB0, pB1, alB, l_reg, pa0, pa1, pa2, pa3); SBAR();
  pv_d0(o, vb0 + (int)SHM_V, pa0, pa1, pa2, pa3);
  if (hi == 0) li_l[r32] = l_reg; asm volatile("s_waitcnt lgkmcnt(0)" ::: "memory");
  float rli[16];
#pragma unroll
  for (int r = 0; r < 16; ++r) rli[r] = __builtin_amdgcn_rcpf(li_l[crow(r, hi)]);
  if constexpr (!OBF16) { float* Ow = (float*)Obv + (long)(wid * QBLK) * LDO;
#pragma unroll
  for (int r = 0; r < 16; ++r) { int orow = crow(r, hi);
    for (int d0 = 0; d0 < 4; ++d0) Ow[(long)orow * LDO + d0 * 32 + r32] = o[d0][r] * rli[r]; }
  } else { unsigned short* Ow = (unsigned short*)Obv + (long)(wid * QBLK) * LDO;
#pragma unroll
  for (int r = 0; r < 16; ++r) { int orow = crow(r, hi);
    for (int d0 = 0; d0 < 4; ++d0) { const unsigned pk = cvtpk(o[d0][r] * rli[r], 0.f); Ow[(long)orow * LDO + d0 * 32 + r32] = (unsigned short)(pk & 0xffffu); } }
  }
#undef SLOAD
#undef SWRITE
#undef SWAIT
#undef RESC
}
#undef KSWZ
#undef SBAR
}
namespace gla {
typedef float f32x16 __attribute__((ext_vector_type(16)));
typedef float f32x4v __attribute__((ext_vector_type(4)));
constexpr int LD = 65;
constexpr int OX = 0, OY = 2 * 64 * LD * 4, OV = 4 * 64 * LD * 4, OAL = OV + 64 * 128 * 4, OW2 = OAL + 64 * 32 * 4, OBA = OW2 + 2 * 16 * 64 * 4, OTOT = OBA + 2 * 64 * 4, OEND = OTOT + 2 * 64 * 4 * 4;
static_assert(OEND <= 131072, "gla lds");
static_assert(64 * 129 * 4 <= 2 * 64 * LD * 4, "O stage fits in X");

struct In {
  const bf16_t* q; const bf16_t* k; const bf16_t* v; const bf16_t* ga; const bf16_t* og; int ld;
  const float* wa2; const float* ba; const float* gnorm;
  float* cs;
  float* dec;
  bf16_t* y; int ldy;
  int S, C;
};
__device__ __forceinline__ long chunk_row(const In& p, int cid) { return cid < p.S / 64 ? (long)cid * 64 : (long)p.S + (long)(cid - p.S / 64) * 64; }
__device__ __forceinline__ float logsig(float x) { return x < 0.f ? x - __logf(1.f + __expf(x)) : -__logf(1.f + __expf(-x)); }

__device__ __forceinline__ void cum_phase(const In& p, LAS unsigned char* lds, int head, long row0, int tid) {
  LAS float* AL = (LAS float*)(lds + OAL); LAS float* W2 = (LAS float*)(lds + OW2); LAS float* BA = (LAS float*)(lds + OBA); LAS float* TOT = (LAS float*)(lds + OTOT);
  { const int t = tid >> 3, r4 = (tid & 7) * 4; const unsigned long long u = *(const unsigned long long*)(p.ga + (row0 + t) * p.ld + r4);
    f32x4v a4; a4[0] = bf2f((bf16_t)u); a4[1] = bf2f((bf16_t)(u >> 16)); a4[2] = bf2f((bf16_t)(u >> 32)); a4[3] = bf2f((bf16_t)(u >> 48)); *(LAS f32x4v*)(AL + t * 32 + r4) = a4; }
  { const int e = tid * 4, dir = e >> 10, r = (e >> 6) & 15, j = e & 63; *(LAS f32x4v*)(W2 + e) = *(const f32x4v*)(p.wa2 + ((long)dir * 16 + r) * 256 + head * 64 + j); }
  if (tid < 128) BA[tid] = p.ba[(tid >> 6) * 256 + head * 64 + (tid & 63)];
  __syncthreads();
  const int dir = tid >> 8, j = tid & 63, seg = (tid >> 6) & 3;
  float w[16];
#pragma unroll
  for (int r = 0; r < 16; ++r) w[r] = W2[(dir * 16 + r) * 64 + j];
  const float bj = BA[dir * 64 + j];
  float c[16];
#pragma unroll
  for (int k = 0; k < 16; ++k) { const int t = seg * 16 + k; float z = bj;
#pragma unroll
    for (int r = 0; r < 16; ++r) z += AL[t * 32 + dir * 16 + r] * w[r];
    c[k] = logsig(z) * (1.f / 16.f); }
  if (dir == 0) {
#pragma unroll
    for (int k = 1; k < 16; ++k) c[k] += c[k - 1];
    TOT[(dir * 64 + j) * 4 + seg] = c[15];
  } else {
#pragma unroll
    for (int k = 14; k >= 0; --k) c[k] += c[k + 1];
    TOT[(dir * 64 + j) * 4 + seg] = c[0];
  }
  __syncthreads();
  float off = 0.f;
#pragma unroll
  for (int s = 0; s < 4; ++s) { const float tv = TOT[(dir * 64 + j) * 4 + s]; if (dir == 0 ? s < seg : s > seg) off += tv; }
  LAS float* X = (LAS float*)(lds + OX) + dir * 64 * LD;
#pragma unroll
  for (int k = 0; k < 16; ++k) X[(seg * 16 + k) * LD + j] = c[k] + off;
}
struct VRegs { unsigned long long u[4]; };
__device__ __forceinline__ VRegs load_v_regs(const In& p, int head, long row0, int tid) { VRegs r;
#pragma unroll
  for (int m = 0; m < 4; ++m) { const int t = (tid >> 5) + 16 * m, c4 = (tid & 31) * 4; r.u[m] = *(const unsigned long long*)(p.v + (row0 + t) * p.ld + head * 128 + c4); }
  return r; }
__device__ __forceinline__ void store_v(const VRegs& r, LAS unsigned char* lds, int tid) {
  LAS float* V = (LAS float*)(lds + OV);
#pragma unroll
  for (int m = 0; m < 4; ++m) { const int t = (tid >> 5) + 16 * m, c4 = (tid & 31) * 4; const unsigned long long u = r.u[m];
    f32x4v a4; a4[0] = bf2f((bf16_t)u); a4[1] = bf2f((bf16_t)(u >> 16)); a4[2] = bf2f((bf16_t)(u >> 32)); a4[3] = bf2f((bf16_t)(u >> 48)); *(LAS f32x4v*)(V + t * 128 + c4) = a4; }
}

__device__ __forceinline__ void g1_unit(const In& p, LAS unsigned char* lds, int head, int cid, int GH, int NCH) {
  int tid = threadIdx.x; asm volatile("" : "+v"(tid));
  const int lane = tid & 63, w = __builtin_amdgcn_readfirstlane(tid >> 6);
  const long row0 = chunk_row(p, cid);
  const VRegs vr = load_v_regs(p, head, row0, tid);
  bf16_t kreg[8];
#pragma unroll
  for (int m = 0; m < 8; ++m) kreg[m] = p.k[(row0 + (tid >> 6) + 8 * m) * p.ld + head * 64 + (tid & 63)];
  cum_phase(p, lds, head, row0, tid);
  store_v(vr, lds, tid);
  __syncthreads();
  LAS float* TOT = (LAS float*)(lds + OTOT);
  { const int j = tid & 63;
#pragma unroll
    for (int dir = 0; dir < 2; ++dir) { LAS float* X = (LAS float*)(lds + OX) + dir * 64 * LD;
      const float cl = TOT[(dir * 64 + j) * 4 + 0] + TOT[(dir * 64 + j) * 4 + 1] + TOT[(dir * 64 + j) * 4 + 2] + TOT[(dir * 64 + j) * 4 + 3];
#pragma unroll
      for (int m = 0; m < 8; ++m) { const int t = (tid >> 6) + 8 * m; const float kv = bf2f(kreg[m]); X[t * LD + j] = kv * __expf(cl - X[t * LD + j]); }
      if (tid < 64) p.dec[(((long)dir * GH + head) * NCH + cid) * 64 + j] = __expf(cl); }
  }
  __syncthreads();
  { const int dir = w >> 2, di = (w >> 1) & 1, vj0 = (w & 1) * 2; const LAS float* X = (const LAS float*)(lds + OX) + dir * 64 * LD; const LAS float* V = (const LAS float*)(lds + OV);
    f32x16 a0 = {}, a1 = {}; const int li = lane & 31, lk = lane >> 5;
#pragma unroll 4
    for (int s0 = 0; s0 < 64; s0 += 2) { const float av = X[(s0 + lk) * LD + 32 * di + li]; const float b0 = V[(s0 + lk) * 128 + 32 * vj0 + li], b1 = V[(s0 + lk) * 128 + 32 * vj0 + 32 + li];
      a0 = __builtin_amdgcn_mfma_f32_32x32x2f32(av, b0, a0, 0, 0, 0); a1 = __builtin_amdgcn_mfma_f32_32x32x2f32(av, b1, a1, 0, 0, 0); }
    float* dst = p.cs + ((((long)dir * GH + head) * NCH + cid) * 64) * 128;
#pragma unroll
    for (int r = 0; r < 16; ++r) { const int d = 32 * di + (r & 3) + 8 * (r >> 2) + 4 * lk; dst[(long)d * 128 + 32 * vj0 + li] = a0[r]; dst[(long)d * 128 + 32 * vj0 + 32 + li] = a1[r]; }
  }
  __syncthreads();
}
__device__ __forceinline__ void g2_item(const In& p, long idx, int GH, int NCH) {
  const int v = (int)(idx & 127), d = (int)((idx >> 7) & 63); const int hd = (int)((idx >> 13) % GH), dir = (int)((idx >> 13) / GH);
  const int nl = p.S / 64, nc = p.C / 64; float st = 0.f;
  float* base = p.cs + (((long)dir * GH + hd) * NCH) * 64 * 128 + (long)d * 128 + v; const float* db = p.dec + (((long)dir * GH + hd) * NCH) * 64 + d;
  for (int s0 = 0; s0 < nl + nc; s0 += 4) { float c[4], dc[4]; float* pp[4];
#pragma unroll
    for (int k = 0; k < 4; ++k) { const int step = s0 + k; int cid; if (step < nc) cid = nl + (dir ? nc - 1 - step : step); else cid = dir ? nl - 1 - (step - nc) : step - nc;
      pp[k] = base + (long)cid * 64 * 128; c[k] = *pp[k]; dc[k] = db[(long)cid * 64]; }
#pragma unroll
    for (int k = 0; k < 4; ++k) { *pp[k] = st; st = dc[k] * st + c[k]; } }
}
__device__ __forceinline__ void g3_unit(const In& p, LAS unsigned char* lds, int head, int cid, int GH, int NCH) {
  int tid = threadIdx.x; asm volatile("" : "+v"(tid));
  const int lane = tid & 63, w = __builtin_amdgcn_readfirstlane(tid >> 6), li = lane & 31, lk = lane >> 5;
  const long row0 = chunk_row(p, cid);
  float spf[2][32];
  { const int vj_ = w & 3;
#pragma unroll
    for (int dir = 0; dir < 2; ++dir) { const float* sp = p.cs + ((((long)dir * GH + head) * NCH + cid) * 64) * 128 + 32 * vj_ + li;
#pragma unroll
      for (int i = 0; i < 32; ++i) spf[dir][i] = sp[(long)(2 * i + lk) * 128]; } }
  const VRegs vr = load_v_regs(p, head, row0, tid);
  bf16_t kreg[8], qreg[8];
#pragma unroll
  for (int m = 0; m < 8; ++m) { const long o_ = (row0 + (tid >> 6) + 8 * m) * p.ld + head * 64 + (tid & 63); kreg[m] = p.k[o_]; qreg[m] = p.q[o_]; }
  cum_phase(p, lds, head, row0, tid);
  store_v(vr, lds, tid);
  __syncthreads();
  { const int j = tid & 63;
#pragma unroll
    for (int dir = 0; dir < 2; ++dir) { LAS float* X = (LAS float*)(lds + OX) + dir * 64 * LD; LAS float* Y = (LAS float*)(lds + OY) + dir * 64 * LD;
#pragma unroll
      for (int m = 0; m < 8; ++m) { const int t = (tid >> 6) + 8 * m; const float c = X[t * LD + j];
        const float qv = bf2f(qreg[m]) * 0.125f, kv = bf2f(kreg[m]);
        X[t * LD + j] = qv * __expf(c); Y[t * LD + j] = kv * __expf(-c); } }
  }
  __syncthreads();
  {
    const int dir = w >> 2, qi = (w >> 1) & 1, si = w & 1; const bool zero = dir == 0 ? si > qi : si < qi;
    const LAS float* X = (const LAS float*)(lds + OX) + dir * 64 * LD; LAS float* Y = (LAS float*)(lds + OY) + dir * 64 * LD;
    f32x16 pa = {};
    if (!zero) {
#pragma unroll 4
      for (int d0 = 0; d0 < 64; d0 += 2) pa = __builtin_amdgcn_mfma_f32_32x32x2f32(X[(32 * qi + li) * LD + d0 + lk], Y[(32 * si + li) * LD + d0 + lk], pa, 0, 0, 0);
    }
    __syncthreads();
#pragma unroll
    for (int r = 0; r < 16; ++r) { const int q = 32 * qi + (r & 3) + 8 * (r >> 2) + 4 * lk, s = 32 * si + li; const bool keep = dir == 0 ? s <= q : s >= q;
      Y[q * LD + s] = keep ? pa[r] : 0.f; }
  }
  __syncthreads();
  f32x16 acc = {};
  { const int qi = w >> 2, vj = w & 3; const LAS float* V = (const LAS float*)(lds + OV);
#pragma unroll
    for (int dir = 0; dir < 2; ++dir) { const LAS float* X = (const LAS float*)(lds + OX) + dir * 64 * LD; const LAS float* Y = (const LAS float*)(lds + OY) + dir * 64 * LD;
#pragma unroll 4
      for (int s0 = 0; s0 < 64; s0 += 2) acc = __builtin_amdgcn_mfma_f32_32x32x2f32(Y[(32 * qi + li) * LD + s0 + lk], V[(s0 + lk) * 128 + 32 * vj + li], acc, 0, 0, 0);
#pragma unroll
      for (int i = 0; i < 32; ++i) acc = __builtin_amdgcn_mfma_f32_32x32x2f32(X[(32 * qi + li) * LD + 2 * i + lk], spf[dir][i], acc, 0, 0, 0);
    }
    __syncthreads();
    LAS float* O = (LAS float*)(lds + OX);
#pragma unroll
    for (int r = 0; r < 16; ++r) { const int q = 32 * qi + (r & 3) + 8 * (r >> 2) + 4 * lk; O[q * 129 + 32 * vj + li] = acc[r]; }
  }
  __syncthreads();
  { const int row = tid >> 3, part = tid & 7; const LAS float* O = (const LAS float*)(lds + OX) + row * 129 + part * 16;
    float o[16]; float ss = 0.f;
#pragma unroll
    for (int k = 0; k < 16; ++k) { o[k] = O[k]; ss += o[k] * o[k]; }
    ss += __shfl_xor(ss, 1); ss += __shfl_xor(ss, 2); ss += __shfl_xor(ss, 4);
    const float rs = 1.f / sqrtf(ss * (1.f / 128.f) + 1e-6f);
    const bf16_t* ogp = p.og + (row0 + row) * p.ld + head * 128 + part * 16; const v4u og0 = *(const v4u*)ogp, og1 = *(const v4u*)(ogp + 8);
    const unsigned ogw[8] = {og0.x, og0.y, og0.z, og0.w, og1.x, og1.y, og1.z, og1.w}; bf16_t* yp = p.y + (row0 + row) * p.ldy + head * 128 + part * 16; float yy[16];
#pragma unroll
    for (int k4 = 0; k4 < 4; ++k4) { f32x4v g4; g4[0] = bf2f((bf16_t)(ogw[2 * k4] & 0xffff)); g4[1] = bf2f((bf16_t)(ogw[2 * k4] >> 16)); g4[2] = bf2f((bf16_t)(ogw[2 * k4 + 1] & 0xffff)); g4[3] = bf2f((bf16_t)(ogw[2 * k4 + 1] >> 16)); const f32x4v n4 = *(const f32x4v*)(p.gnorm + part * 16 + 4 * k4); f32x4v y4;
#pragma unroll
      for (int e = 0; e < 4; ++e) { const float gg = g4[e]; y4[e] = o[4 * k4 + e] * rs * n4[e] * (gg / (1.f + __expf(-gg))); yy[4 * k4 + e] = y4[e]; } }
    { v4u o0, o1; o0.x = pk2(yy[0], yy[1]); o0.y = pk2(yy[2], yy[3]); o0.z = pk2(yy[4], yy[5]); o0.w = pk2(yy[6], yy[7]);
      o1.x = pk2(yy[8], yy[9]); o1.y = pk2(yy[10], yy[11]); o1.z = pk2(yy[12], yy[13]); o1.w = pk2(yy[14], yy[15]); *(v4u*)yp = o0; *(v4u*)(yp + 8) = o1; }
  }
  __syncthreads();
}

typedef short bf16x8g __attribute__((ext_vector_type(8)));
constexpr int LB = 72;
constexpr int OQB = 2 * 64 * LD * 4, OKB = OQB + 2 * 64 * LB * 2, OVT = OKB + 2 * 64 * LB * 2, OBEND = OVT + 128 * LB * 2;
static_assert(OBEND <= OAL, "gla bf16 lds");
#define GMM(A, B, C) C = __builtin_amdgcn_mfma_f32_32x32x16_bf16(__builtin_bit_cast(bf16x8g, A), __builtin_bit_cast(bf16x8g, B), C, 0, 0, 0)
__device__ __forceinline__ void store_vt(const VRegs& r, LAS unsigned char* lds, int tid) {
  LAS bf16_t* Vt = (LAS bf16_t*)(lds + OVT);
#pragma unroll
  for (int m = 0; m < 4; ++m) { const int t = (tid >> 5) + 16 * m, c4 = (tid & 31) * 4; const unsigned long long u = r.u[m];
    Vt[(c4 + 0) * LB + t] = (bf16_t)u; Vt[(c4 + 1) * LB + t] = (bf16_t)(u >> 16); Vt[(c4 + 2) * LB + t] = (bf16_t)(u >> 32); Vt[(c4 + 3) * LB + t] = (bf16_t)(u >> 48); }
}
__device__ __forceinline__ void g1b_unit(const In& p, LAS unsigned char* lds, int head, int cid, int GH, int NCH) {
  int tid = threadIdx.x; asm volatile("" : "+v"(tid));
  const int lane = tid & 63, w = __builtin_amdgcn_readfirstlane(tid >> 6), li = lane & 31, lk = lane >> 5;
  const long row0 = chunk_row(p, cid);
  const VRegs vr = load_v_regs(p, head, row0, tid);
  bf16_t kreg[8];
#pragma unroll
  for (int m = 0; m < 8; ++m) kreg[m] = p.k[(row0 + (tid >> 6) + 8 * m) * p.ld + head * 64 + (tid & 63)];
  cum_phase(p, lds, head, row0, tid);
  store_vt(vr, lds, tid);
  __syncthreads();
  LAS float* TOT = (LAS float*)(lds + OTOT);
  { const int j = tid & 63;
#pragma unroll
    for (int dir = 0; dir < 2; ++dir) { const LAS float* X = (const LAS float*)(lds + OX) + dir * 64 * LD; LAS bf16_t* KeT = (LAS bf16_t*)(lds + OQB) + dir * 64 * LB;
      const float cl = TOT[(dir * 64 + j) * 4 + 0] + TOT[(dir * 64 + j) * 4 + 1] + TOT[(dir * 64 + j) * 4 + 2] + TOT[(dir * 64 + j) * 4 + 3];
#pragma unroll
      for (int m = 0; m < 8; ++m) { const int t = (tid >> 6) + 8 * m; KeT[j * LB + t] = (bf16_t)f2bf(bf2f(kreg[m]) * __expf(cl - X[t * LD + j])); }
      if (tid < 64) p.dec[(((long)dir * GH + head) * NCH + cid) * 64 + j] = __expf(cl); }
  }
  __syncthreads();
  { const int dir = w >> 2, di = (w >> 1) & 1, vj0 = (w & 1) * 2; const LAS bf16_t* KeT = (const LAS bf16_t*)(lds + OQB) + dir * 64 * LB; const LAS bf16_t* Vt = (const LAS bf16_t*)(lds + OVT);
    f32x16 a0 = {}, a1 = {};
#pragma unroll
    for (int kk = 0; kk < 4; ++kk) { const v4u av = *(const LAS v4u*)(KeT + (32 * di + li) * LB + 16 * kk + 8 * lk);
      const v4u b0 = *(const LAS v4u*)(Vt + (32 * vj0 + li) * LB + 16 * kk + 8 * lk), b1 = *(const LAS v4u*)(Vt + (32 * vj0 + 32 + li) * LB + 16 * kk + 8 * lk);
      GMM(av, b0, a0); GMM(av, b1, a1); }
    float* dst = p.cs + ((((long)dir * GH + head) * NCH + cid) * 64) * 128;
#pragma unroll
    for (int r = 0; r < 16; ++r) { const int d = 32 * di + (r & 3) + 8 * (r >> 2) + 4 * lk; dst[(long)d * 128 + 32 * vj0 + li] = a0[r]; dst[(long)d * 128 + 32 * vj0 + 32 + li] = a1[r]; }
  }
  __syncthreads();
}
__device__ __forceinline__ void g3b_unit(const In& p, LAS unsigned char* lds, int head, int cid, int GH, int NCH) {
  int tid = threadIdx.x; asm volatile("" : "+v"(tid));
  const int lane = tid & 63, w = __builtin_amdgcn_readfirstlane(tid >> 6), li = lane & 31, lk = lane >> 5;
  const long row0 = chunk_row(p, cid);
  float spf[2][32];
  { const int vj_ = w & 3;
#pragma unroll
    for (int dir = 0; dir < 2; ++dir) { const float* sp = p.cs + ((((long)dir * GH + head) * NCH + cid) * 64) * 128 + 32 * vj_ + li;
#pragma unroll
      for (int i = 0; i < 32; ++i) spf[dir][i] = sp[(long)(16 * (i >> 3) + 8 * lk + (i & 7)) * 128]; } }
  const VRegs vr = load_v_regs(p, head, row0, tid);
  bf16_t kreg[8], qreg[8];
#pragma unroll
  for (int m = 0; m < 8; ++m) { const long o_ = (row0 + (tid >> 6) + 8 * m) * p.ld + head * 64 + (tid & 63); kreg[m] = p.k[o_]; qreg[m] = p.q[o_]; }
  cum_phase(p, lds, head, row0, tid);
  store_vt(vr, lds, tid);
  __syncthreads();
  { const int j = tid & 63;
#pragma unroll
    for (int dir = 0; dir < 2; ++dir) { const LAS float* X = (const LAS float*)(lds + OX) + dir * 64 * LD; LAS bf16_t* Qb = (LAS bf16_t*)(lds + OQB) + dir * 64 * LB; LAS bf16_t* Kb = (LAS bf16_t*)(lds + OKB) + dir * 64 * LB;
#pragma unroll
      for (int m = 0; m < 8; ++m) { const int t = (tid >> 6) + 8 * m; const float c = X[t * LD + j];
        Qb[t * LB + j] = (bf16_t)f2bf(bf2f(qreg[m]) * 0.125f * __expf(c)); Kb[t * LB + j] = (bf16_t)f2bf(bf2f(kreg[m]) * __expf(-c)); } }
  }
  __syncthreads();
  {
    const int dir = w >> 2, qi = (w >> 1) & 1, si = w & 1; const bool zero = dir == 0 ? si > qi : si < qi;
    const LAS bf16_t* Qb = (const LAS bf16_t*)(lds + OQB) + dir * 64 * LB; LAS bf16_t* Kb = (LAS bf16_t*)(lds + OKB) + dir * 64 * LB;
    f32x16 pa = {};
    if (!zero) {
#pragma unroll
      for (int kk = 0; kk < 4; ++kk) { const v4u av = *(const LAS v4u*)(Qb + (32 * qi + li) * LB + 16 * kk + 8 * lk), bv = *(const LAS v4u*)(Kb + (32 * si + li) * LB + 16 * kk + 8 * lk); GMM(av, bv, pa); }
    }
    __syncthreads();
#pragma unroll
    for (int r = 0; r < 16; ++r) { const int q = 32 * qi + (r & 3) + 8 * (r >> 2) + 4 * lk, s = 32 * si + li; const bool keep = dir == 0 ? s <= q : s >= q;
      Kb[q * LB + s] = (bf16_t)f2bf(keep ? pa[r] : 0.f); }
  }
  __syncthreads();
  f32x16 acc = {};
  { const int qi = w >> 2, vj = w & 3; const LAS bf16_t* Vt = (const LAS bf16_t*)(lds + OVT);
#pragma unroll
    for (int dir = 0; dir < 2; ++dir) { const LAS bf16_t* Qb = (const LAS bf16_t*)(lds + OQB) + dir * 64 * LB; const LAS bf16_t* Pb = (const LAS bf16_t*)(lds + OKB) + dir * 64 * LB;
#pragma unroll
      for (int kk = 0; kk < 4; ++kk) { const v4u av = *(const LAS v4u*)(Pb + (32 * qi + li) * LB + 16 * kk + 8 * lk), bv = *(const LAS v4u*)(Vt + (32 * vj + li) * LB + 16 * kk + 8 * lk); GMM(av, bv, acc); }
#pragma unroll
      for (int kk = 0; kk < 4; ++kk) { const v4u av = *(const LAS v4u*)(Qb + (32 * qi + li) * LB + 16 * kk + 8 * lk);
        v4u bv; bv.x = pk2(spf[dir][8 * kk + 0], spf[dir][8 * kk + 1]); bv.y = pk2(spf[dir][8 * kk + 2], spf[dir][8 * kk + 3]); bv.z = pk2(spf[dir][8 * kk + 4], spf[dir][8 * kk + 5]); bv.w = pk2(spf[dir][8 * kk + 6], spf[dir][8 * kk + 7]);
        GMM(av, bv, acc); }
    }
    LAS float* O = (LAS float*)(lds + OX);
#pragma unroll
    for (int r = 0; r < 16; ++r) { const int q = 32 * qi + (r & 3) + 8 * (r >> 2) + 4 * lk; O[q * 129 + 32 * vj + li] = acc[r]; }
  }
  __syncthreads();
  { const int row = tid >> 3, part = tid & 7; const LAS float* O = (const LAS float*)(lds + OX) + row * 129 + part * 16;
    float o[16]; float ss = 0.f;
#pragma unroll
    for (int k = 0; k < 16; ++k) { o[k] = O[k]; ss += o[k] * o[k]; }
    ss += __shfl_xor(ss, 1); ss += __shfl_xor(ss, 2); ss += __shfl_xor(ss, 4);
    const float rs = 1.f / sqrtf(ss * (1.f / 128.f) + 1e-6f);
    const bf16_t* ogp = p.og + (row0 + row) * p.ld + head * 128 + part * 16; const v4u og0 = *(const v4u*)ogp, og1 = *(const v4u*)(ogp + 8);
    const unsigned ogw[8] = {og0.x, og0.y, og0.z, og0.w, og1.x, og1.y, og1.z, og1.w}; bf16_t* yp = p.y + (row0 + row) * p.ldy + head * 128 + part * 16; float yy[16];
#pragma unroll
    for (int k4 = 0; k4 < 4; ++k4) { f32x4v g4; g4[0] = bf2f((bf16_t)(ogw[2 * k4] & 0xffff)); g4[1] = bf2f((bf16_t)(ogw[2 * k4] >> 16)); g4[2] = bf2f((bf16_t)(ogw[2 * k4 + 1] & 0xffff)); g4[3] = bf2f((bf16_t)(ogw[2 * k4 + 1] >> 16)); const f32x4v n4 = *(const f32x4v*)(p.gnorm + part * 16 + 4 * k4);
#pragma unroll
      for (int e = 0; e < 4; ++e) { const float gg = g4[e]; yy[4 * k4 + e] = o[4 * k4 + e] * rs * n4[e] * (gg / (1.f + __expf(-gg))); } }
    { v4u o0, o1; o0.x = pk2(yy[0], yy[1]); o0.y = pk2(yy[2], yy[3]); o0.z = pk2(yy[4], yy[5]); o0.w = pk2(yy[6], yy[7]);
      o1.x = pk2(yy[8], yy[9]); o1.y = pk2(yy[10], yy[11]); o1.z = pk2(yy[12], yy[13]); o1.w = pk2(yy[14], yy[15]); *(v4u*)yp = o0; *(v4u*)(yp + 8) = o1; }
  }
  __syncthreads();
}
#undef GMM
}
namespace moe {
constexpr int NE = 16, NG = 4, EPG = 4, DE = 512, D = 1024;
__device__ __forceinline__ float wave_sum(float v) {
#pragma unroll
  for (int o = 1; o < 64; o <<= 1) v += __shfl_xor(v, o);
  return v;
}
struct Route { int e0, r0, e1, r1; };
struct MoeOrder {
  int G, c, NT; const LAS int* poff;
  __device__ __forceinline__ bool next(int i, pg8::Unit& u) const {
    const long L = (long)i * G + c; const int total = poff[NE] * NT; if (L >= total) return false;
    const int panel = (int)L / NT, j = (int)L % NT; int e = 0;
#pragma unroll
    for (int k = 1; k < NE; ++k) e += (panel >= poff[k]) ? 1 : 0;
    u.pm = panel; u.pn = e * NT + j; u.acol = 0; return true;
  }
  __device__ __forceinline__ void a_ready(const pg8::Unit&) const {}
  __device__ __forceinline__ void done(const pg8::Unit&) const {}
};
struct EpiGU {
  static constexpr bool PERM = true, AFTER_DRAIN = false;
  bf16_t* hid;
  __device__ __forceinline__ void operator()(const pg8::f32x4 (&acc)[2][2][4][2], const pg8::Unit& u, int wr, int wc, int fr, int fq) const {
    const int j = u.pn & 3; const int row0 = u.pm * 256 + wr * 64 + fr, col0 = j * 128 + wc * 32 + 8 * fq;
#pragma unroll
    for (int ai = 0; ai < 2; ++ai)
#pragma unroll
      for (int m = 0; m < 4; ++m) { const size_t r = (size_t)(row0 + ai * 128 + m * 16); float hv[8];
#pragma unroll
        for (int n = 0; n < 2; ++n)
#pragma unroll
          for (int e = 0; e < 4; ++e) { const float g = acc[ai][0][m][n][e], up = acc[ai][1][m][n][e]; hv[4 * n + e] = g / (1.f + __expf(-g)) * up; }
        v4u o; o.x = pk2(hv[0], hv[1]); o.y = pk2(hv[2], hv[3]); o.z = pk2(hv[4], hv[5]); o.w = pk2(hv[6], hv[7]);
        *(v4u*)(hid + r * DE + col0) = o; }
  }
};
struct EpiDown {
  static constexpr bool PERM = true, AFTER_DRAIN = false;
  const int* srcrow; const float* wgt; bf16_t* contrib; size_t slot_stride;
  __device__ __forceinline__ void operator()(const pg8::f32x4 (&acc)[2][2][4][2], const pg8::Unit& u, int wr, int wc, int fr, int fq) const {
    const int pn = u.pn & 3; const int row0 = u.pm * 256 + wr * 64 + fr, col0 = pn * 256 + wc * 32 + 8 * fq;
    int srcs[2][4]; float ws_[2][4];
#pragma unroll
    for (int ai = 0; ai < 2; ++ai)
#pragma unroll
      for (int m = 0; m < 4; ++m) { const int r = row0 + ai * 128 + m * 16; srcs[ai][m] = srcrow[r]; ws_[ai][m] = wgt[r]; }
#pragma unroll
    for (int ai = 0; ai < 2; ++ai)
#pragma unroll
      for (int m = 0; m < 4; ++m) { const int src = srcs[ai][m]; if (src < 0) continue; const float w = ws_[ai][m];
        bf16_t* dst = contrib + (size_t)(src & 1) * slot_stride + (size_t)(src >> 1) * D + col0;
#pragma unroll
        for (int bj = 0; bj < 2; ++bj) { const pg8::f32x4 v0 = acc[ai][bj][m][0] * w, v1 = acc[ai][bj][m][1] * w;
          v4u o; o.x = pk2(v0[0], v0[1]); o.y = pk2(v0[2], v0[3]); o.z = pk2(v1[0], v1[1]); o.w = pk2(v1[2], v1[3]); *(v4u*)(dst + bj * 128) = o; } }
  }
};
__device__ __forceinline__ void route_row(const float* xr, const float* gnorm, const float* shift, const float* scale, bf16_t* hrow, const LAS float* rwT, const float* rbias,
                                          LAS int* cnt, Route* rt, float* wts, int lane) {
  typedef float f4 __attribute__((ext_vector_type(4)));
  f4 xv[4]; float ss = 0.f;
#pragma unroll
  for (int j = 0; j < 4; ++j) { xv[j] = *(const f4*)(xr + 4 * lane + 256 * j); ss += xv[j][0] * xv[j][0] + xv[j][1] * xv[j][1] + xv[j][2] * xv[j][2] + xv[j][3] * xv[j][3]; }
  const float rs = 1.f / sqrtf(wave_sum(ss) * (1.f / 1024.f) + 1e-6f);
  float lg[NE];
#pragma unroll
  for (int e = 0; e < NE; ++e) lg[e] = 0.f;
#pragma unroll
  for (int j = 0; j < 4; ++j) { const int c = 4 * lane + 256 * j; const f4 g4 = *(const f4*)(gnorm + c), sh = *(const f4*)(shift + c), sc = *(const f4*)(scale + c);
    f4 h;
#pragma unroll
    for (int i = 0; i < 4; ++i) h[i] = xv[j][i] * rs * g4[i] * (1.f + sc[i]) + sh[i];
    *(unsigned long long*)(hrow + c) = (unsigned long long)pk2(h[0], h[1]) | ((unsigned long long)pk2(h[2], h[3]) << 32);
#pragma unroll
    for (int e = 0; e < NE; ++e) { const f4 w4 = *(const LAS f4*)(rwT + e * 1024 + c); lg[e] += h[0] * w4[0] + h[1] * w4[1] + h[2] * w4[2] + h[3] * w4[3]; } }
  { float v8[8], v4[4], v2[2], v1;
#pragma unroll
    for (int i = 0; i < 8; ++i) { const bool up = lane & 1; const float keep = up ? lg[2 * i + 1] : lg[2 * i], send = up ? lg[2 * i] : lg[2 * i + 1]; v8[i] = keep + __shfl_xor(send, 1); }
#pragma unroll
    for (int i = 0; i < 4; ++i) { const bool up = lane & 2; const float keep = up ? v8[2 * i + 1] : v8[2 * i], send = up ? v8[2 * i] : v8[2 * i + 1]; v4[i] = keep + __shfl_xor(send, 2); }
#pragma unroll
    for (int i = 0; i < 2; ++i) { const bool up = lane & 4; const float keep = up ? v4[2 * i + 1] : v4[2 * i], send = up ? v4[2 * i] : v4[2 * i + 1]; v2[i] = keep + __shfl_xor(send, 4); }
    { const bool up = lane & 8; const float keep = up ? v2[1] : v2[0], send = up ? v2[0] : v2[1]; v1 = keep + __shfl_xor(send, 8); }
    v1 += __shfl_xor(v1, 16); v1 += __shfl_xor(v1, 32);
#pragma unroll
    for (int e = 0; e < NE; ++e) lg[e] = __shfl(v1, e); }
  float sc[NE], sel[NE];
#pragma unroll
  for (int e = 0; e < NE; ++e) { sc[e] = 1.f / (1.f + __expf(-lg[e])); sel[e] = sc[e] + rbias[e]; }
  int bestg = 0; float bestgs = -1e30f;
#pragma unroll
  for (int g = 0; g < NG; ++g) { float m1 = -1e30f, m2 = -1e30f;
#pragma unroll
    for (int i = 0; i < EPG; ++i) { const float v = sel[g * EPG + i]; if (v > m1) { m2 = m1; m1 = v; } else if (v > m2) m2 = v; }
    const float gsum = m1 + m2; if (gsum > bestgs) { bestgs = gsum; bestg = g; } }
  int i1 = -1, i2 = -1; float v1 = -1e30f, v2 = -1e30f, s1 = 0.f, s2 = 0.f;
#pragma unroll
  for (int e = 0; e < NE; ++e) { if (e / EPG == bestg) { const float v = sel[e];
      if (v > v1) { v2 = v1; i2 = i1; s2 = s1; v1 = v; i1 = e; s1 = sc[e]; } else if (v > v2) { v2 = v; i2 = e; s2 = sc[e]; } } }
  if (lane == 0) { const float inv = 1.f / (s1 + s2); Route r; r.e0 = i1; r.e1 = i2; r.r0 = __hip_atomic_fetch_add(cnt + i1, 1, __ATOMIC_RELAXED, __HIP_MEMORY_SCOPE_WORKGROUP); r.r1 = __hip_atomic_fetch_add(cnt + i2, 1, __ATOMIC_RELAXED, __HIP_MEMORY_SCOPE_WORKGROUP); *rt = r; wts[0] = s1 * inv; wts[1] = s2 * inv; }
}
}
namespace hy {
typedef float f32x16 __attribute__((ext_vector_type(16)));
constexpr int S = 4096, NT1 = 128, LDZ = 191, ZPAD = 31, LDX = 129;
constexpr int O_TAPS = 0, O_ZA = 32768, O_ZB = O_ZA + 32 * LDZ * 4, O_X1 = O_ZB + 32 * LDZ * 4, O_X2 = O_X1 + 32 * LDX * 4, O_RED = O_X2 + 32 * LDX * 4, O_END = O_RED + 4 * 64 * 16 * 4;
static_assert(O_END <= 131072, "hyena lds");

struct H0Regs { v4u w0, w1; };
__device__ __forceinline__ H0Regs h0_load(const bf16_t* u, int ld, int tile, int tid) {
  const int tt = tile / 24, jt = tile % 24, t0 = tt * 64, j0 = jt * 64; H0Regs r; r.w0 = (v4u){0u, 0u, 0u, 0u}; r.w1 = r.w0;
  { const int rr = tid >> 3, c8 = (tid & 7) * 8, t = t0 - 1 + rr; if (t >= 0 && t < S) r.w0 = *(const v4u*)(u + (size_t)t * ld + j0 + c8); }
  if (tid < 16) { const int rr = 64 + (tid >> 3), c8 = (tid & 7) * 8, t = t0 - 1 + rr; if (t < S) r.w1 = *(const v4u*)(u + (size_t)t * ld + j0 + c8); }
  return r;
}
__device__ __forceinline__ void h0_compute(const H0Regs& rg, const float* cw, const float* cb, bf16_t* ucT, int tile, LAS unsigned char* lds, int tid) {
  const int tt = tile / 24, jt = tile % 24, t0 = tt * 64, j0 = jt * 64;
  LAS float* U = (LAS float*)lds;
  { const int rr = tid >> 3, c8 = (tid & 7) * 8; const v4u w = rg.w0; LAS float* d = U + rr * 65 + c8;
    d[0] = bf2f(w.x & 0xffff); d[1] = bf2f(w.x >> 16); d[2] = bf2f(w.y & 0xffff); d[3] = bf2f(w.y >> 16); d[4] = bf2f(w.z & 0xffff); d[5] = bf2f(w.z >> 16); d[6] = bf2f(w.w & 0xffff); d[7] = bf2f(w.w >> 16); }
  if (tid < 16) { const int rr = 64 + (tid >> 3), c8 = (tid & 7) * 8; const v4u w = rg.w1; LAS float* d = U + rr * 65 + c8;
    d[0] = bf2f(w.x & 0xffff); d[1] = bf2f(w.x >> 16); d[2] = bf2f(w.y & 0xffff); d[3] = bf2f(w.y >> 16); d[4] = bf2f(w.z & 0xffff); d[5] = bf2f(w.z >> 16); d[6] = bf2f(w.w & 0xffff); d[7] = bf2f(w.w >> 16); }
  __syncthreads();
  { const int jj = tid >> 3, tq = (tid & 7) * 8, j = j0 + jj; const float w0 = cw[j], w1 = cw[1536 + j], w2 = cw[2 * 1536 + j], bb = cb[j]; float v[8];
#pragma unroll
    for (int k = 0; k < 8; ++k) v[k] = bb + w0 * U[(tq + k) * 65 + jj] + w1 * U[(tq + k + 1) * 65 + jj] + w2 * U[(tq + k + 2) * 65 + jj];
    v4u o; o.x = pk2(v[0], v[1]); o.y = pk2(v[2], v[3]); o.z = pk2(v[4], v[5]); o.w = pk2(v[6], v[7]); *(v4u*)(ucT + (size_t)j * S + t0 + tq) = o; }
  __syncthreads();
}
__device__ __forceinline__ void h2_tile(const bf16_t* yT, bf16_t* ybf, int ldy, int tile, LAS unsigned char* lds) {
  int tid = threadIdx.x; asm volatile("" : "+v"(tid));
  const int tt = tile / 8, ct = tile % 8, t0 = tt * 64, c0 = ct * 64;
  LAS bf16_t* T = (LAS bf16_t*)lds;
  { const int cc = tid >> 3, t8 = (tid & 7) * 8; const v4u w = *(const v4u*)(yT + (size_t)(c0 + cc) * S + t0 + t8); LAS unsigned* d = (LAS unsigned*)(T + cc * 66 + t8); d[0] = w.x; d[1] = w.y; d[2] = w.z; d[3] = w.w; }
  __syncthreads();
  { const int t = tid >> 3, c8 = (tid & 7) * 8; unsigned short e[8];
#pragma unroll
    for (int k = 0; k < 8; ++k) e[k] = T[(c8 + k) * 66 + t];
    v4u o; o.x = e[0] | ((unsigned)e[1] << 16); o.y = e[2] | ((unsigned)e[3] << 16); o.z = e[4] | ((unsigned)e[5] << 16); o.w = e[6] | ((unsigned)e[7] << 16);
    *(v4u*)(ybf + (size_t)(t0 + t) * ldy + c0 + c8) = o; }
  __syncthreads();
}
__device__ __forceinline__ void h1_unit(const bf16_t* ucT, const float* tapsT, const float* nrm, const float* skip, bf16_t* yT, int c, LAS unsigned char* lds) {
  int tid = threadIdx.x; asm volatile("" : "+v"(tid));
  const int lane = tid & 63, w = __builtin_amdgcn_readfirstlane(tid >> 6), li = lane & 31, lk = lane >> 5;
  LAS float* TAPS = (LAS float*)(lds + O_TAPS); LAS float* ZA = (LAS float*)(lds + O_ZA); LAS float* ZB = (LAS float*)(lds + O_ZB);
  LAS float* X1 = (LAS float*)(lds + O_X1); LAS float* X2 = (LAS float*)(lds + O_X2); LAS float* RED = (LAS float*)(lds + O_RED);
  for (int e = tid; e < 32 * 62; e += 512) { const int s2 = e / 62, p = e % 62, t1p = p < 31 ? p : 128 + p; ZA[s2 * LDZ + t1p] = 0.f; ZB[s2 * LDZ + t1p] = 0.f; }
  for (int t = tid; t < S; t += 512) { const int t2 = t & 31, t1 = t >> 5;
    X1[t2 * LDX + t1] = bf2f(ucT[(size_t)c * S + t]); X2[t2 * LDX + t1] = bf2f(ucT[(size_t)(512 + c) * S + t]); ZA[t2 * LDZ + t1 + ZPAD] = bf2f(ucT[(size_t)(1024 + c) * S + t]); }
#pragma unroll 1
  for (int o = 0; o < 2; ++o) {
    const float* tp = tapsT + ((size_t)o * 512 + c) * 8192;
    for (int e = tid; e < 8192; e += 512) TAPS[e] = tp[(e + 4096) & 8191];
    __syncthreads();
    const LAS float* Zin = o == 0 ? ZA : ZB;
    const int g = w & 3, dh = w >> 2;
    const int Dlo = 32 * g - 127 + (dh ? 80 : 0), Dn = dh ? 79 : 80;
    f32x16 acc = {};
    { const LAS float* ap = TAPS + 4096 + 32 * Dlo + li - lk - 30;
      const LAS float* bp = Zin + lk * LDZ + (32 * g + li - Dlo + ZPAD);
#pragma unroll 2
      for (int dd = 0; dd < Dn; ++dd) {
#pragma unroll
        for (int kk = 0; kk < 16; ++kk) acc = __builtin_amdgcn_mfma_f32_32x32x2f32(ap[(15 - kk) * 2], bp[2 * kk * LDZ], acc, 0, 0, 0);
        ap += 32; bp -= 1; }
    }
    if (dh) {
#pragma unroll
      for (int r = 0; r < 16; ++r) RED[(g * 64 + lane) * 16 + r] = acc[r]; }
    __syncthreads();
    if (!dh) { const float inv = 1.f / nrm[o * 512 + c], sk = skip[o * 512 + c]; const LAS float* G = o == 0 ? X1 : X2; LAS float* Out = o == 0 ? ZB : ZA;
#pragma unroll
      for (int r = 0; r < 16; ++r) { const int t2 = (r & 3) + 8 * (r >> 2) + 4 * lk, t1 = 32 * g + li;
        const float cv = (acc[r] + RED[(g * 64 + lane) * 16 + r]) * inv; const float zin = Zin[t2 * LDZ + t1 + ZPAD];
        Out[t2 * LDZ + t1 + ZPAD] = G[t2 * LDX + t1] * (cv + sk * zin); } }
    __syncthreads();
  }
  for (int t = tid; t < S; t += 512) yT[(size_t)c * S + t] = (bf16_t)f2bf(ZA[(t & 31) * LDZ + (t >> 5) + ZPAD]);
  __syncthreads();
}

typedef short bf16x8v __attribute__((ext_vector_type(8)));
typedef unsigned u32x2v __attribute__((ext_vector_type(2)));
constexpr int CSB = 16448;
constexpr int ZROW = 80, ZROWS = 190;
constexpr int B_CS = 0, B_ZA = 4 * CSB, B_ZB = B_ZA + 15232, B_X1 = B_ZB + 15232, B_X2 = B_X1 + 8256, B_RED = B_X2 + 8256, B_END = B_RED + 16384;
static_assert(B_END <= 131072 && B_ZA % 16 == 0 && B_X1 % 16 == 0, "hyena bf16 lds");
__device__ __forceinline__ void h1b_unit(const bf16_t* ucT, const bf16_t* tapsB, const float* nrm, const float* skip, bf16_t* yT, int c, LAS unsigned char* lds) {
  int tid = threadIdx.x; asm volatile("" : "+v"(tid));
  const int lane = tid & 63, w = __builtin_amdgcn_readfirstlane(tid >> 6), li = lane & 31, lk = lane >> 5;
  LAS bf16_t* ZA = (LAS bf16_t*)(lds + B_ZA); LAS bf16_t* ZB = (LAS bf16_t*)(lds + B_ZB); LAS bf16_t* X1 = (LAS bf16_t*)(lds + B_X1); LAS bf16_t* X2 = (LAS bf16_t*)(lds + B_X2);
  LAS float* RED = (LAS float*)(lds + B_RED);
  for (int e = tid; e < 62 * 20; e += 512) { const int p = e / 20, d = e % 20, row = p < 31 ? p : 128 + p; ((LAS unsigned*)ZA)[row * 20 + d] = 0u; ((LAS unsigned*)ZB)[row * 20 + d] = 0u; }
  { const v4u zv = *(const v4u*)(ucT + (size_t)(1024 + c) * S + tid * 8); const int t = tid * 8; *(LAS v4u*)((LAS unsigned char*)ZA + ((t >> 5) + ZPAD) * ZROW + (t & 31) * 2) = zv; }
  { const v4u xa = *(const v4u*)(ucT + (size_t)c * S + tid * 8), xb = *(const v4u*)(ucT + (size_t)(512 + c) * S + tid * 8); const int t1 = tid >> 2, t2b = (tid & 3) * 8;
    const unsigned wa[4] = {xa.x, xa.y, xa.z, xa.w}, wb[4] = {xb.x, xb.y, xb.z, xb.w};
#pragma unroll
    for (int k = 0; k < 4; ++k) { X1[(t2b + 2 * k) * LDX + t1] = (bf16_t)(wa[k] & 0xffff); X1[(t2b + 2 * k + 1) * LDX + t1] = (bf16_t)(wa[k] >> 16);
      X2[(t2b + 2 * k) * LDX + t1] = (bf16_t)(wb[k] & 0xffff); X2[(t2b + 2 * k + 1) * LDX + t1] = (bf16_t)(wb[k] >> 16); } }
  typedef unsigned u4a __attribute__((ext_vector_type(4), aligned(4))); typedef const __attribute__((address_space(1))) u4a* gp4;
  v4u cv[9];
#pragma unroll 1
  for (int o = 0; o < 2; ++o) {
#define HTAPS_LOAD(oo) { const __attribute__((address_space(1))) unsigned char* tb = (const __attribute__((address_space(1))) unsigned char*)(tapsB + ((size_t)(oo) * 512 + c) * 2 * 8232); \
      _Pragma("unroll") for (int it = 0; it < 9; ++it) { const int e = tid + 512 * it; const int s = e / 1028, q = e % 1028; cv[it] = (v4u){0u, 0u, 0u, 0u}; if (e < 4 * 1028) cv[it] = *(gp4)(tb + (size_t)(s & 1) * 16464 + 16 * q + 4 * (s >> 1)); } }
    if (o == 0) HTAPS_LOAD(0)
    {
#pragma unroll
      for (int it = 0; it < 9; ++it) { const int e = tid + 512 * it; const int s = e / 1028, q = e % 1028; if (e < 4 * 1028) *(LAS v4u*)(lds + B_CS + s * CSB + 16 * q) = cv[it]; } }
    __syncthreads();
    if (o == 0) HTAPS_LOAD(1)
    const LAS bf16_t* Zin = o == 0 ? ZA : ZB;
    const int g = w & 3, dh = w >> 2;
    const int Dlo = 32 * g - 127 + (dh ? 81 : 0), Dn = dh ? 78 : 81;
    f32x16 acc = {};
    { const int s = (4 - (li & 3)) & 3;
      const LAS unsigned char* ap = lds + B_CS + s * CSB + 2 * (4096 - 32 * Dlo - li + 8 * lk - s);
      const LAS unsigned char* bp = (const LAS unsigned char*)Zin + (32 * g + li - Dlo + ZPAD) * ZROW + 16 * lk;
#define HLD(A0, A1, B0, B1) { const u32x2v p0_ = *(const LAS u32x2v*)(ap), p1_ = *(const LAS u32x2v*)(ap2), p2_ = *(const LAS u32x2v*)(ap3), p3_ = *(const LAS u32x2v*)(ap4); \
        A0 = (v4u){p0_.x, p0_.y, p1_.x, p1_.y}; A1 = (v4u){p2_.x, p2_.y, p3_.x, p3_.y}; B0 = *(const LAS v4u*)(bp); B1 = *(const LAS v4u*)(bp + 32); ap -= 64; ap2 -= 64; ap3 -= 64; ap4 -= 64; bp -= ZROW; }
#define HMM(A, B) acc = __builtin_amdgcn_mfma_f32_32x32x16_bf16(__builtin_bit_cast(bf16x8v, A), __builtin_bit_cast(bf16x8v, B), acc, 0, 0, 0)
#define HOPQ(name, off) unsigned name##i = (unsigned)(unsigned long long)(ap + (off)); asm volatile("" : "+v"(name##i)); const LAS unsigned char* name = (const LAS unsigned char*)(unsigned long long)name##i;
      HOPQ(ap2, 8) HOPQ(ap3, 32) HOPQ(ap4, 40)
#undef HOPQ
      v4u fa0, fa1, fb0, fb1, ga0, ga1, gb0, gb1, ha0, ha1, hb0, hb1;
      HLD(fa0, fa1, fb0, fb1)
      HLD(ga0, ga1, gb0, gb1)
      for (int dd_ = 0; dd_ < Dn - 3; dd_ += 3) {
        HLD(ha0, ha1, hb0, hb1)
        HMM(fa0, fb0); HMM(fa1, fb1);
        HLD(fa0, fa1, fb0, fb1)
        HMM(ga0, gb0); HMM(ga1, gb1);
        HLD(ga0, ga1, gb0, gb1)
        HMM(ha0, hb0); HMM(ha1, hb1);
      }
      HLD(ha0, ha1, hb0, hb1)
      HMM(fa0, fb0); HMM(fa1, fb1); HMM(ga0, gb0); HMM(ga1, gb1); HMM(ha0, hb0); HMM(ha1, hb1);
#undef HLD
#undef HMM
    }
    if (dh) {
#pragma unroll
      for (int r = 0; r < 16; ++r) RED[(g * 64 + lane) * 16 + r] = acc[r]; }
    __syncthreads();
    if (!dh) { const float inv = 1.f / nrm[o * 512 + c], sk = skip[o * 512 + c]; const LAS bf16_t* G = o == 0 ? X1 : X2; LAS bf16_t* Out = o == 0 ? ZB : ZA;
#pragma unroll
      for (int r = 0; r < 16; ++r) { const int t2 = (r & 3) + 8 * (r >> 2) + 4 * lk, t1 = 32 * g + li;
        const float cv = (acc[r] + RED[(g * 64 + lane) * 16 + r]) * inv; const float zin = bf2f(Zin[(t1 + ZPAD) * (ZROW / 2) + t2]);
        Out[(t1 + ZPAD) * (ZROW / 2) + t2] = (bf16_t)f2bf(bf2f(G[t2 * LDX + t1]) * (cv + sk * zin)); } }
    __syncthreads();
  }
  { const int t = tid * 8; *(v4u*)(yT + (size_t)c * S + t) = *(const LAS v4u*)((const LAS unsigned char*)ZA + ((t >> 5) + ZPAD) * ZROW + (t & 31) * 2); }
  __syncthreads();
}
#undef HTAPS_LOAD

constexpr int C_ZP = 15, C_ZB = 159 * ZROW  , C_CS = 0, C_Z0 = 4 * CSB, C_X0 = C_Z0 + 2 * C_ZB, C_END = C_X0 + 4 * 8256;
static_assert(C_END <= 131072 && C_Z0 % 16 == 0 && C_ZB % 16 == 0 && C_X0 % 16 == 0, "hyena two-batch lds");
__device__ __forceinline__ void h1c_unit(const bf16_t* ucT2, const bf16_t* tapsB, const float* nrm, const float* skip, bf16_t* yT2, int c, LAS unsigned char* lds) {
  int tid = threadIdx.x; asm volatile("" : "+v"(tid));
  const int lane = tid & 63, g = __builtin_amdgcn_readfirstlane(tid >> 6), li = lane & 31, lk = lane >> 5, bsel = li >> 4, t1l = li & 15;
  for (int e = tid; e < 2 * 31 * 20; e += 512) { const int b = e / (31 * 20), p = (e / 20) % 31, d = e % 20, row = p < 15 ? p : 128 + p; ((LAS unsigned*)(lds + C_Z0 + b * C_ZB))[row * 20 + d] = 0u; }
#pragma unroll
  for (int b = 0; b < 2; ++b) { const bf16_t* uc = ucT2 + (size_t)b * 1536 * S; const int t = tid * 8;
    const v4u zv = *(const v4u*)(uc + (size_t)(1024 + c) * S + t), xa = *(const v4u*)(uc + (size_t)c * S + t), xb = *(const v4u*)(uc + (size_t)(512 + c) * S + t);
    *(LAS v4u*)(lds + C_Z0 + b * C_ZB + ((t >> 5) + C_ZP) * ZROW + (t & 31) * 2) = zv;
    LAS bf16_t* X1 = (LAS bf16_t*)(lds + C_X0 + (2 * b) * 8256); LAS bf16_t* X2 = (LAS bf16_t*)(lds + C_X0 + (2 * b + 1) * 8256); const int t1 = tid >> 2, t2b = (tid & 3) * 8;
    const unsigned wa[4] = {xa.x, xa.y, xa.z, xa.w}, wb[4] = {xb.x, xb.y, xb.z, xb.w};
#pragma unroll
    for (int k = 0; k < 4; ++k) { X1[(t2b + 2 * k) * LDX + t1] = (bf16_t)(wa[k] & 0xffff); X1[(t2b + 2 * k + 1) * LDX + t1] = (bf16_t)(wa[k] >> 16);
      X2[(t2b + 2 * k) * LDX + t1] = (bf16_t)(wb[k] & 0xffff); X2[(t2b + 2 * k + 1) * LDX + t1] = (bf16_t)(wb[k] >> 16); } }
  typedef unsigned u4a __attribute__((ext_vector_type(4), aligned(4))); typedef const __attribute__((address_space(1))) u4a* gp4;
  v4u cv[9];
  LAS bf16_t* Zm = (LAS bf16_t*)(lds + C_Z0 + bsel * C_ZB);
#pragma unroll 1
  for (int o = 0; o < 2; ++o) {
#define HTAPS_LOAD(oo) { const __attribute__((address_space(1))) unsigned char* tb = (const __attribute__((address_space(1))) unsigned char*)(tapsB + ((size_t)(oo) * 512 + c) * 2 * 8232); \
      _Pragma("unroll") for (int it = 0; it < 9; ++it) { const int e = tid + 512 * it; const int s = e / 1028, q = e % 1028; cv[it] = (v4u){0u, 0u, 0u, 0u}; if (e < 4 * 1028) cv[it] = *(gp4)(tb + (size_t)(s & 1) * 16464 + 16 * q + 4 * (s >> 1)); } }
    if (o == 0) HTAPS_LOAD(0)
    {
#pragma unroll
      for (int it = 0; it < 9; ++it) { const int e = tid + 512 * it; const int s = e / 1028, q = e % 1028; if (e < 4 * 1028) *(LAS v4u*)(lds + C_CS + s * CSB + 16 * q) = cv[it]; } }
    __syncthreads();
    if (o == 0) HTAPS_LOAD(1)
    const int Dlo = 16 * g - 128; constexpr int Dn = 144;
    f32x16 acc = {};
    { const int s = (4 - (li & 3)) & 3;
      const LAS unsigned char* ap = lds + C_CS + s * CSB + 2 * (4096 - 32 * Dlo - li + 8 * lk - s);
      const LAS unsigned char* bp = (const LAS unsigned char*)Zm + (16 * g + t1l - Dlo + C_ZP) * ZROW + 16 * lk;
#define HLD(A0, A1, B0, B1) { const u32x2v p0_ = *(const LAS u32x2v*)(ap), p1_ = *(const LAS u32x2v*)(ap2), p2_ = *(const LAS u32x2v*)(ap3), p3_ = *(const LAS u32x2v*)(ap4); \
        A0 = (v4u){p0_.x, p0_.y, p1_.x, p1_.y}; A1 = (v4u){p2_.x, p2_.y, p3_.x, p3_.y}; B0 = *(const LAS v4u*)(bp); B1 = *(const LAS v4u*)(bp + 32); ap -= 64; ap2 -= 64; ap3 -= 64; ap4 -= 64; bp -= ZROW; }
#define HMM(A, B) acc = __builtin_amdgcn_mfma_f32_32x32x16_bf16(__builtin_bit_cast(bf16x8v, A), __builtin_bit_cast(bf16x8v, B), acc, 0, 0, 0)
#define HOPQ(name, off) unsigned name##i = (unsigned)(unsigned long long)(ap + (off)); asm volatile("" : "+v"(name##i)); const LAS unsigned char* name = (const LAS unsigned char*)(unsigned long long)name##i;
      HOPQ(ap2, 8) HOPQ(ap3, 32) HOPQ(ap4, 40)
#undef HOPQ
      v4u fa0, fa1, fb0, fb1, ga0, ga1, gb0, gb1, ha0, ha1, hb0, hb1;
      HLD(fa0, fa1, fb0, fb1)
      HLD(ga0, ga1, gb0, gb1)
      for (int dd_ = 0; dd_ < Dn - 3; dd_ += 3) {
        HLD(ha0, ha1, hb0, hb1)
        HMM(fa0, fb0); HMM(fa1, fb1);
        HLD(fa0, fa1, fb0, fb1)
        HMM(ga0, gb0); HMM(ga1, gb1);
        HLD(ga0, ga1, gb0, gb1)
        HMM(ha0, hb0); HMM(ha1, hb1);
      }
      HLD(ha0, ha1, hb0, hb1)
      HMM(fa0, fb0); HMM(fa1, fb1); HMM(ga0, gb0); HMM(ga1, gb1); HMM(ha0, hb0); HMM(ha1, hb1);
#undef HLD
#undef HMM
    }
    __syncthreads();
    { const float inv = 1.f / nrm[o * 512 + c], sk = skip[o * 512 + c]; const LAS bf16_t* G = (const LAS bf16_t*)(lds + C_X0 + (2 * bsel + o) * 8256);
#pragma unroll
      for (int r = 0; r < 16; ++r) { const int t2 = (r & 3) + 8 * (r >> 2) + 4 * lk, t1 = 16 * g + t1l;
        const float cvv = acc[r] * inv; const float zin = bf2f(Zm[(t1 + C_ZP) * (ZROW / 2) + t2]);
        Zm[(t1 + C_ZP) * (ZROW / 2) + t2] = (bf16_t)f2bf(bf2f(G[t2 * LDX + t1]) * (cvv + sk * zin)); } }
    __syncthreads();
  }
#pragma unroll
  for (int b = 0; b < 2; ++b) { const int t = tid * 8; *(v4u*)(yT2 + (size_t)b * 512 * S + (size_t)c * S + t) = *(const LAS v4u*)(lds + C_Z0 + b * C_ZB + ((t >> 5) + C_ZP) * ZROW + (t & 31) * 2); }
  __syncthreads();
#undef HTAPS_LOAD
}
__device__ __forceinline__ void cconv3_item(const bf16_t* u, int ld, const float* cw, const float* cb, float* ucc, long idx) {
  const int j = (int)(idx % 1536); const int tc = (int)(idx / 1536);
  const bf16_t* up = u + (size_t)tc * ld + j;
  float v = cb[j] + cw[1536 + j] * bf2f(up[0]);
  if (tc > 0) v += cw[j] * bf2f(*(up - ld)); if (tc < 255) v += cw[2 * 1536 + j] * bf2f(up[ld]);
  ucc[idx] = v;
}
__device__ __forceinline__ void clong_item(const float* ucc, const float* z1c_in, float* z1c_out, bf16_t* yout, int ldy, const float* tapsC, const float* nrmC, const float* skip, int o, long idx) {
  const int c = (int)(idx % 512), t0 = (int)(idx / 512) * 8; constexpr int n = 256;
  const float* tp = tapsC + (size_t)o * 2 * n * 512 + c; const float nr = nrmC[o * 512 + c];
  const float* zs = o == 0 ? ucc + 1024 + c : z1c_in + c; const int ldz = o == 0 ? 1536 : 512;
  float acc[8], w[8];
#pragma unroll
  for (int i = 0; i < 8; ++i) { acc[i] = 0.f; const int lag = t0 + i; w[i] = tp[(size_t)lag * 512]; }
#pragma unroll 4
  for (int s = 0; s < n; ++s) { const float zv = zs[(size_t)s * ldz];
#pragma unroll
    for (int i = 0; i < 8; ++i) acc[i] += w[i] * zv;
    const int lag = t0 - s - 1;
    const float nw = tp[(size_t)(lag >= 0 ? lag : 2 * n + lag) * 512];
#pragma unroll
    for (int i = 7; i > 0; --i) w[i] = w[i - 1];
    w[0] = nw; }
  const float sk = skip[o * 512 + c];
#pragma unroll
  for (int i = 0; i < 8; ++i) { const int t = t0 + i; const float val = ucc[(size_t)t * 1536 + o * 512 + c] * (acc[i] / nr + sk * zs[(size_t)t * ldz]);
    if (o == 0) z1c_out[(size_t)t * 512 + c] = val; else yout[(size_t)t * ldy + c] = (bf16_t)f2bf(val); }
}
}
#define XB_TMO      128
#define XB_XCNT(j)  (256  + 64 * (j))
#define XB_XSUB(j)  (1280 + 64 * (j))
#define XB_XGEN(j)  (2304 + 64 * (j))
#define XB_TOP      3328
#define XB_TOPGEN   3392
#define XCD_BAR_WORDS 3456
#define XB_SPIN_CAP (1u << 18)

__device__ __forceinline__ unsigned xb_ld(unsigned* p)              { return __hip_atomic_load(p, __ATOMIC_RELAXED, __HIP_MEMORY_SCOPE_AGENT); }
__device__ __forceinline__ unsigned xb_add(unsigned* p, unsigned v) { return __hip_atomic_fetch_add(p, v, __ATOMIC_RELAXED, __HIP_MEMORY_SCOPE_AGENT); }
__device__ __forceinline__ unsigned xb_xcc_id() { return (unsigned)__builtin_amdgcn_s_getreg((3 << 11) | 20) & 0xFu; }
#define XB_SPIN(cond, bar) do { unsigned _sp = 0; while (cond) { __builtin_amdgcn_s_sleep(1); \
    if ((++_sp & 255u) == 0u) { if (xb_ld(&(bar)[XB_TMO])) break; if (_sp > XB_SPIN_CAP) { atomicAdd(&(bar)[XB_TMO], 1u); break; } } } } while (0)

struct XcdBarrier {
    unsigned* bar; unsigned x;
    volatile LAS unsigned* st;
};

__device__ __forceinline__ XcdBarrier xcd_barrier_post(unsigned* bar, volatile LAS unsigned* st) {
    XcdBarrier b; b.bar = bar; b.x = xb_xcc_id(); b.st = st;
    if (threadIdx.x == 0) (void)xb_add(&bar[XB_XCNT(b.x)], 1u);
    return b;
}
__device__ __forceinline__ void xcd_barrier_complete(unsigned* bar, unsigned x, unsigned& nloc, unsigned& nx) {
    const unsigned G = gridDim.x * gridDim.y * gridDim.z;
    unsigned sum, cnt, mine, sp = 0u;
    for (;;) {
        sum = 0u; cnt = 0u; mine = 0u;
#pragma unroll
        for (unsigned j = 0; j < 16; ++j) { const unsigned c = xb_ld(&bar[XB_XCNT(j)]); sum += c; cnt += (c > 0u) ? 1u : 0u; mine = (j == x) ? c : mine; }
        if (sum == G) break;
        __builtin_amdgcn_s_sleep(1);
        if ((++sp & 255u) == 0u) { if (xb_ld(&bar[XB_TMO])) break; if (sp > XB_SPIN_CAP) { atomicAdd(&bar[XB_TMO], 1u); break; } }
    }
    nloc = mine > 0u ? mine : 1u; nx = cnt > 0u ? cnt : 1u;
}

__device__ __forceinline__ void xcd_barrier(const XcdBarrier& b) {
    asm volatile("s_waitcnt vmcnt(0)" ::: "memory");
    __syncthreads();
    if (threadIdx.x == 0) {
        unsigned* bar = b.bar;
#define XB_SP(word) ((unsigned*)((((unsigned long long)(unsigned)__builtin_amdgcn_readfirstlane((int)((unsigned long long)(bar + (word)) >> 32))) << 32) | (unsigned)__builtin_amdgcn_readfirstlane((int)(unsigned)(unsigned long long)(bar + (word)))))
        unsigned* const p_xsub = XB_SP(XB_XSUB(b.x)); unsigned* const p_xgen = XB_SP(XB_XGEN(b.x));
        __builtin_amdgcn_s_waitcnt(0);
        unsigned nloc = b.st[0], nx = b.st[1];
        if (nloc == 0u) { xcd_barrier_complete(bar, b.x, nloc, nx); b.st[0] = nloc; b.st[1] = nx; }
        const unsigned old = xb_add(p_xsub, 1u);
        const unsigned gen = old / nloc;
        if (old + 1u == (gen + 1u) * nloc) {
            __builtin_amdgcn_fence(__ATOMIC_RELEASE, "agent");
            asm volatile("s_waitcnt vmcnt(0)" ::: "memory");
            const unsigned og = xb_add(&bar[XB_TOP], 1u);
            const unsigned tg = og / nx;
            if (og + 1u == (tg + 1u) * nx) xb_add(&bar[XB_TOPGEN], 1u);
            else XB_SPIN(xb_ld(&bar[XB_TOPGEN]) == tg, bar);
            __builtin_amdgcn_fence(__ATOMIC_ACQUIRE, "agent");
            xb_add(p_xgen, 1u);
            asm volatile("s_waitcnt vmcnt(0)" ::: "memory");
        } else {
            XB_SPIN(xb_ld(p_xgen) == gen, bar);
            __builtin_amdgcn_fence(__ATOMIC_ACQUIRE, "agent");
            asm volatile("s_waitcnt vmcnt(0)" ::: "memory");
        }
    }
    __syncthreads();
}
#include <math.h>
#ifdef HOST_TEST
#define HD
#define FEXP expf
#define FSIN sinf
#define FCOS cosf
#define FLOG logf
#define FPOW powf
#else
#define HD __device__ __forceinline__
#define FEXP __expf
#define FSIN __sinf
#define FCOS __cosf
#define FLOG __logf
#define FPOW __powf
#endif

struct FullDims { static constexpr int D=1024,B=8,S=4096,DEPTH=2,C=256,GW=64,AH=8,AKV=2,HDM=128,GH=4,GDK=64,GDV=128,GR=16,HW=512,HB=16,HF=64,NE=16,NG=4,DE=512; };
struct SmallDims { static constexpr int D=64,B=2,S=128,DEPTH=2,C=32,GW=16,AH=4,AKV=2,HDM=16,GH=2,GDK=8,GDV=16,GR=4,HW=32,HB=4,HF=8,NE=8,NG=2,DE=32; };

template <class T> struct DD {
  static constexpr int D=T::D,B=T::B,S=T::S,DEPTH=T::DEPTH,C=T::C,GW=T::GW,AH=T::AH,AKV=T::AKV,HDM=T::HDM,GH=T::GH,GDK=T::GDK,GDV=T::GDV,GR=T::GR,HW=T::HW,HB=T::HB,HF=T::HF,NE=T::NE,NG=T::NG,DE=T::DE;
  static constexpr int R=S+C, AG=AH/AKV, RP=HDM/4, HE=1+2*HB, EPG=NE/NG, AQW=AH*HDM, AKVW=AKV*HDM, GKW=GH*GDK, GVW=GH*GDV;
  static constexpr int NKV=AKVW+AKVW+GKW+GVW+2*GR, NIN=NKV+AQW+GKW+GVW+3*HW+3*D;
  static constexpr int O_AK=0, O_AV=AKVW, O_GK=2*AKVW, O_GV=2*AKVW+GKW, O_GA=2*AKVW+GKW+GVW;
  static constexpr int O_AQ=NKV, O_GQ=NKV+AQW, O_OG=O_GQ+GKW, O_HY=O_OG+GVW, O_BR=O_HY+3*HW;
};

struct NaiveBufs {
  const float *x,*c,*ctx,*c_ctx,*w_mod,*b_mod,*norm1_g,*norm2_g,*w_in,*q_norm_g,*k_norm_g,*gla_wa2,*gla_ba,*gla_norm_g,*hy_conv_w,*hy_conv_b,
    *hy_pos_w1,*hy_pos_b1,*hy_sin_freq,*hy_pos_w2,*hy_pos_b2,*hy_pos_w3,*hy_decay,*hy_skip,*w_br_hy,*w_br_gla,*w_br_att,*w_out,*router_w,*router_b,*moe_w_gate,*moe_w_up,*moe_w_down;
  float* out;
  float *mod;
  float *hid2S,*hid2C;
  float *tapsS,*tapsC;
  float *nrmS,*nrmC;
  float *rs;
  float *h;
  float *proj;
  float *qn,*kn;
  float *yatt;
  float *laf,*lab;
  float *of,*ob;
  float *ygla;
  float *uc;
  float *z1,*yhy;
  float *m;
  int   *ridx;
  float *rw;
  float *hid;
  float *xc;
};

HD float sigmoidf_(float x) { return 1.f / (1.f + FEXP(-x)); }
HD float siluf_(float x) { return x / (1.f + FEXP(-x)); }
HD float logsigmoidf_(float x) { return x < 0.f ? x - FLOG(1.f + FEXP(x)) : -FLOG(1.f + FEXP(-x)); }

template <class T> HD void st_mod(const NaiveBufs& a, int l, long idx) {
  using d = DD<T>; const int j = (int)(idx % (6 * d::D)), bb = (int)(idx / (6 * d::D));
  const float* cv = bb < d::B ? a.c + (long)bb * d::D : a.c_ctx; const float* w = a.w_mod + (long)l * d::D * 6 * d::D;
  float acc = a.b_mod[(long)l * 6 * d::D + j];
  for (int k = 0; k < d::D; ++k) acc += siluf_(cv[k]) * w[(long)k * 6 * d::D + j];
  a.mod[idx] = acc;
}
template <class T> HD void st_hyhid(const NaiveBufs& a, int l, int which, long idx) {
  using d = DD<T>; const int n = which ? d::C : d::S; float* dst = which ? a.hid2C : a.hid2S;
  const int j = (int)(idx % d::HF), t = (int)(idx / d::HF);
  const float* w1 = a.hy_pos_w1 + (long)l * d::HE * d::HF; const float* b1 = a.hy_pos_b1 + l * d::HF; const float* fr = a.hy_sin_freq + l * d::HF;
  const float* w2 = a.hy_pos_w2 + (long)l * d::HF * d::HF; const float* b2 = a.hy_pos_b2 + l * d::HF;
  const float tn = (float)t / (float)n; const float w0 = 2.f * 3.14159265358979323846f / (float)n;
  float acc2 = b2[j];
  for (int i = 0; i < d::HF; ++i) {
    float acc = b1[i] + tn * w1[0 * d::HF + i];
    for (int bnd = 0; bnd < d::HB; ++bnd) {
      const float band = 1e-4f + (float)bnd * ((float)(d::HB - 1) - 1e-4f) / (float)(d::HB - 1);
      const float ph = w0 * (float)t * band;
      acc += FCOS(ph) * w1[(1 + bnd) * d::HF + i] - FSIN(ph) * w1[(1 + d::HB + bnd) * d::HF + i];
    }
    acc2 += FSIN(fr[i] * acc) * w2[i * d::HF + j];
  }
  dst[idx] = FSIN(fr[j] * acc2);
}
template <class T> HD void st_hytaps(const NaiveBufs& a, int l, int which, long idx) {
  using d = DD<T>; const int n = which ? d::C : d::S; const float* hid2 = which ? a.hid2C : a.hid2S; float* dst = which ? a.tapsC : a.tapsS;
  const int c = (int)(idx % d::HW); const int li = (int)((idx / d::HW) % (2 * n)); const int o = (int)(idx / ((long)d::HW * 2 * n));
  float v = 0.f;
  if (li != n) {
    const int dir = li < n ? 0 : 1; const int t = li < n ? li : 2 * n - li;
    const int col = (o * 2 + dir) * d::HW + c;
    const float* w3 = a.hy_pos_w3 + (long)l * d::HF * 4 * d::HW;
    float acc = 0.f;
    for (int j = 0; j < d::HF; ++j) acc += hid2[(long)t * d::HF + j] * w3[(long)j * 4 * d::HW + col];
    const float dec = fabsf(a.hy_decay[(long)l * 4 * d::HW + col]);
    v = acc * FEXP(-((float)t / (float)n) * dec);
  }
  if (which == 0) dst[((long)o * d::HW + c) * 2 * n + li] = v; else dst[idx] = v;
}
template <class T> HD void st_hynorm(const NaiveBufs& a, int which, long idx) {
  using d = DD<T>; const int n = which ? d::C : d::S; const float* tp = which ? a.tapsC : a.tapsS; float* dst = which ? a.nrmC : a.nrmS;
  const int c = (int)(idx % d::HW), o = (int)(idx / d::HW);
  float s = 0.f; for (int li = 0; li < 2 * n; ++li) s += fabsf(which == 0 ? tp[((long)o * d::HW + c) * 2 * n + li] : tp[((long)o * 2 * n + li) * d::HW + c]);
  dst[idx] = s + 1e-6f;
}

template <class T> HD const float* xrow(const NaiveBufs& a, int l, int b, int r) {
  using d = DD<T>;
  if (r < d::S) return (l == 0 ? a.x : a.out) + ((long)b * d::S + r) * d::D;
  return (l == 0 ? a.ctx : a.xc) + ((long)b * d::C + (r - d::S)) * d::D;
}
template <class T> HD float* xrow_w(const NaiveBufs& a, int b, int r) {
  using d = DD<T>;
  if (r < d::S) return a.out + ((long)b * d::S + r) * d::D;
  return a.xc + ((long)b * d::C + (r - d::S)) * d::D;
}
template <class T> HD void st_rs(const NaiveBufs& a, int l, int b, int src, long idx) {
  using d = DD<T>; const int r = (int)idx; const float* xr = src ? (const float*)xrow_w<T>(a, b, r) : xrow<T>(a, l, b, r);
  float s = 0.f; for (int k = 0; k < d::D; ++k) s += xr[k] * xr[k];
  a.rs[r] = 1.f / sqrtf(s / (float)d::D + 1e-6f);
}
template <class T> HD void st_norm(const NaiveBufs& a, int l, int b, int which, long idx) {
  using d = DD<T>; const int j = (int)(idx % d::D), r = (int)(idx / d::D);
  const float* xr = which ? (const float*)xrow_w<T>(a, b, r) : xrow<T>(a, l, b, r);
  const float* g = (which ? a.norm2_g : a.norm1_g) + (long)l * d::D;
  const float* md = a.mod + (long)(r < d::S ? b : d::B) * 6 * d::D;
  const float shift = md[(which ? 3 : 0) * d::D + j], scale = md[(which ? 4 : 1) * d::D + j];
  a.h[idx] = xr[j] * a.rs[r] * g[j] * (1.f + scale) + shift;
}
struct GemmArgs { const float* A; int lda; const float* W; int ldw; float* Cc; int ldc; int M, N, K;
  const float* gate; int ldg;
  const float* colscale;
  const float* res; int ldr;
  int accumulate; };
HD void st_gemm(const GemmArgs& g, long idx) {
  const int nb = g.N / 4; const int cb = (int)(idx % nb), rb = (int)(idx / nb);
  float acc[4][4];
#pragma unroll
  for (int i = 0; i < 4; ++i) {
#pragma unroll
    for (int j = 0; j < 4; ++j) acc[i][j] = 0.f; }
  const float* a0 = g.A + (long)(rb * 4) * g.lda; const float* w0 = g.W + cb * 4;
  for (int k = 0; k < g.K; ++k) {
    float av[4], wv[4];
#pragma unroll
    for (int i = 0; i < 4; ++i) av[i] = a0[(long)i * g.lda + k];
#pragma unroll
    for (int j = 0; j < 4; ++j) wv[j] = w0[(long)k * g.ldw + j];
#pragma unroll
    for (int i = 0; i < 4; ++i) {
#pragma unroll
      for (int j = 0; j < 4; ++j) acc[i][j] += av[i] * wv[j]; }
  }
#pragma unroll
  for (int i = 0; i < 4; ++i)
#pragma unroll
  for (int j = 0; j < 4; ++j) {
    const int r = rb * 4 + i, c = cb * 4 + j; float v = acc[i][j];
    if (g.gate) v *= sigmoidf_(g.gate[(long)r * g.ldg + c]);
    if (g.colscale) v *= g.colscale[c];
    if (g.res) v += g.res[(long)r * g.ldr + c];
    float* p = g.Cc + (long)r * g.ldc + c;
    if (g.accumulate) v += *p;
    *p = v;
  }
}
template <class T> HD void st_qknorm(const NaiveBufs& a, int l, long idx) {
  using d = DD<T>; const int hh = (int)(idx % (d::AH + d::AKV)), r = (int)(idx / (d::AH + d::AKV));
  const bool isq = hh < d::AH; const int hd = isq ? hh : hh - d::AH;
  const float* src = a.proj + (long)r * d::NIN + (isq ? d::O_AQ : d::O_AK) + hd * d::HDM;
  float* dst = (isq ? a.qn + (long)r * d::AQW : a.kn + (long)r * d::AKVW) + hd * d::HDM;
  const float* g = (isq ? a.q_norm_g : a.k_norm_g) + (long)l * d::HDM;
  float s = 0.f; for (int k = 0; k < d::HDM; ++k) s += src[k] * src[k];
  const float rsq = 1.f / sqrtf(s / (float)d::HDM + 1e-6f);
  if (r < d::S) {
    const int row = r / d::GW, col = r % d::GW;
    for (int p = 0; p < d::HDM / 2; ++p) {
      const int fi = p < d::RP ? p : p - d::RP; const float pos = p < d::RP ? (float)row : (float)col;
      const float inv = FPOW(10000.f, -(float)fi / (float)d::RP); const float ang = pos * inv;
      const float cs = FCOS(ang), sn = FSIN(ang);
      const float x1 = src[2 * p] * rsq * g[2 * p], x2 = src[2 * p + 1] * rsq * g[2 * p + 1];
      dst[2 * p] = x1 * cs - x2 * sn; dst[2 * p + 1] = x1 * sn + x2 * cs;
    }
  } else { for (int k = 0; k < d::HDM; ++k) dst[k] = src[k] * rsq * g[k]; }
}
template <class T, int NSPLIT> HD void st_attn(const NaiveBufs& a, int r0, int nrows, long idx) {
  using d = DD<T>; constexpr int OD = d::HDM / NSPLIT;
  const int r = r0 + (int)(idx % nrows); const int hs = (int)(idx / nrows); const int part = hs % NSPLIT, hq = hs / NSPLIT; const int kv = hq / d::AG;
  const int k0 = r < d::S ? 0 : d::S, k1 = d::R;
  float q[d::HDM], o[OD];
  const float scale = 1.f / sqrtf((float)d::HDM);
#pragma unroll
  for (int k = 0; k < d::HDM; ++k) q[k] = a.qn[(long)r * d::AQW + hq * d::HDM + k] * scale;
#pragma unroll
  for (int k = 0; k < OD; ++k) o[k] = 0.f;
  float mx = -1e30f, lsum = 0.f;
  for (int kk = k0; kk < k1; ++kk) {
    const float* kr = a.kn + (long)kk * d::AKVW + kv * d::HDM;
    float s = 0.f;
#pragma unroll
    for (int k = 0; k < d::HDM; ++k) s += q[k] * kr[k];
    if (s > mx) { const float cr = FEXP(mx - s); lsum *= cr;
#pragma unroll
      for (int k = 0; k < OD; ++k) o[k] *= cr;
      mx = s; }
    const float p = FEXP(s - mx); lsum += p;
    const float* vr = a.proj + (long)kk * d::NIN + d::O_AV + kv * d::HDM + part * OD;
#pragma unroll
    for (int k = 0; k < OD; ++k) o[k] += p * vr[k];
  }
  const float inv = 1.f / lsum;
#pragma unroll
  for (int k = 0; k < OD; ++k) a.yatt[(long)r * d::AQW + hq * d::HDM + part * OD + k] = o[k] * inv;
}
template <class T> HD void st_glala(const NaiveBufs& a, int l, long idx) {
  using d = DD<T>; const int j = (int)(idx % d::GKW); const int dir = (int)((idx / d::GKW) % 2); const int r = (int)(idx / (2 * d::GKW));
  const float* al = a.proj + (long)r * d::NIN + d::O_GA + dir * d::GR;
  const float* w2 = a.gla_wa2 + ((long)l * 2 + dir) * d::GR * d::GKW; float z = a.gla_ba[((long)l * 2 + dir) * d::GKW + j];
  for (int k = 0; k < d::GR; ++k) z += al[k] * w2[(long)k * d::GKW + j];
  (dir ? a.lab : a.laf)[(long)r * d::GKW + j] = FEXP(logsigmoidf_(z) / 16.f);
}
template <class T> HD void st_glascan(const NaiveBufs& a, long idx) {
  using d = DD<T>; const int v = (int)(idx % d::GDV); const int hd = (int)((idx / d::GDV) % d::GH); const int dir = (int)(idx / (d::GDV * d::GH));
  float st[d::GDK];
#pragma unroll
  for (int k = 0; k < d::GDK; ++k) st[k] = 0.f;
  const float qs = 1.f / sqrtf((float)d::GDK);
  const float* la = dir ? a.lab : a.laf; float* od = dir ? a.ob : a.of;
  for (int step = 0; step < d::R; ++step) {
    int r;
    if (step < d::C) r = d::S + (dir ? d::C - 1 - step : step); else r = dir ? d::S - 1 - (step - d::C) : step - d::C;
    const float* pr = a.proj + (long)r * d::NIN;
    const float vv = pr[d::O_GV + hd * d::GDV + v];
    float o = 0.f;
#pragma unroll
    for (int k = 0; k < d::GDK; ++k) {
      st[k] = la[(long)r * d::GKW + hd * d::GDK + k] * st[k] + pr[d::O_GK + hd * d::GDK + k] * vv;
      o += pr[d::O_GQ + hd * d::GDK + k] * qs * st[k];
    }
    od[(long)r * d::GVW + hd * d::GDV + v] = o;
  }
}
template <class T> HD void st_glaout(const NaiveBufs& a, int l, long idx) {
  using d = DD<T>; const int hd = (int)(idx % d::GH), r = (int)(idx / d::GH);
  const long base = (long)r * d::GVW + hd * d::GDV; float s = 0.f;
  for (int v = 0; v < d::GDV; ++v) { const float o = a.of[base + v] + a.ob[base + v]; s += o * o; }
  const float rsq = 1.f / sqrtf(s / (float)d::GDV + 1e-6f);
  for (int v = 0; v < d::GDV; ++v) { const float o = a.of[base + v] + a.ob[base + v];
    a.ygla[base + v] = o * rsq * a.gla_norm_g[(long)l * d::GDV + v] * siluf_(a.proj[(long)r * d::NIN + d::O_OG + hd * d::GDV + v]); }
}
template <class T> HD void st_hyconv3(const NaiveBufs& a, int l, long idx) {
  using d = DD<T>; const int j = (int)(idx % (3 * d::HW)), r = (int)(idx / (3 * d::HW));
  const int lo = r < d::S ? 0 : d::S, hi = r < d::S ? d::S : d::R;
  const float* w = a.hy_conv_w + (long)l * 3 * 3 * d::HW;
  float v = a.hy_conv_b[(long)l * 3 * d::HW + j] + a.proj[(long)r * d::NIN + d::O_HY + j] * w[1 * 3 * d::HW + j];
  if (r - 1 >= lo) v += a.proj[(long)(r - 1) * d::NIN + d::O_HY + j] * w[0 * 3 * d::HW + j];
  if (r + 1 < hi) v += a.proj[(long)(r + 1) * d::NIN + d::O_HY + j] * w[2 * 3 * d::HW + j];
  a.uc[idx] = v;
}
template <class T> HD void st_hylong(const NaiveBufs& a, int l, int o, long idx) {
  using d = DD<T>; const int c = (int)(idx % d::HW); const int rb = (int)(idx / d::HW); const int r0 = rb * 4;
  const bool lat = r0 < d::S; const int n = lat ? d::S : d::C; const int base = lat ? 0 : d::S; const int t0 = r0 - base;
  const float* tp = (lat ? a.tapsS : a.tapsC) + (long)o * 2 * n * d::HW + c; const float nr = (lat ? a.nrmS : a.nrmC)[o * d::HW + c];
  const float* zs = o == 0 ? a.uc + 2 * d::HW + c : a.z1 + c; const int ldz = o == 0 ? 3 * d::HW : d::HW;
  float acc0 = 0.f, acc1 = 0.f, acc2 = 0.f, acc3 = 0.f;
  auto tap = [&](int lag) { const int li = lag >= 0 ? lag : 2 * n + lag; return tp[(long)li * d::HW]; };
  float w0 = tap(t0), w1 = tap(t0 + 1), w2 = tap(t0 + 2), w3 = tap(t0 + 3);
  for (int s = 0; s < n; ++s) {
    const float zv = zs[(long)(base + s) * ldz];
    acc0 += w0 * zv; acc1 += w1 * zv; acc2 += w2 * zv; acc3 += w3 * zv;
    w3 = w2; w2 = w1; w1 = w0; w0 = (s + 1 < n) ? tap(t0 - s - 1) : 0.f;
  }
  const float sk = a.hy_skip[((long)l * 2 + o) * d::HW + c];
  float* dst = o == 0 ? a.z1 : a.yhy;
  const float accs[4] = {acc0, acc1, acc2, acc3};
#pragma unroll
  for (int i = 0; i < 4; ++i) { const int r = r0 + i; const float zr = zs[(long)r * ldz];
    dst[(long)r * d::HW + c] = a.uc[(long)r * 3 * d::HW + o * d::HW + c] * (accs[i] / nr + sk * zr); }
}
template <class T> HD void st_router(const NaiveBufs& a, long idx) {
  using d = DD<T>; const int r = (int)idx; const float* hr = a.h + (long)r * d::D;
  float sc[d::NE], sel[d::NE];
#pragma unroll
  for (int e = 0; e < d::NE; ++e) sc[e] = 0.f;
  for (int k = 0; k < d::D; ++k) { const float hv = hr[k];
#pragma unroll
    for (int e = 0; e < d::NE; ++e) sc[e] += hv * a.router_w[(long)k * d::NE + e]; }
#pragma unroll
  for (int e = 0; e < d::NE; ++e) { sc[e] = sigmoidf_(sc[e]); sel[e] = sc[e] + a.router_b[e]; }
  int bestg = 0; float bestgs = -1e30f;
#pragma unroll
  for (int g = 0; g < d::NG; ++g) { float m1 = -1e30f, m2 = -1e30f;
#pragma unroll
    for (int i = 0; i < d::EPG; ++i) { const float v = sel[g * d::EPG + i]; if (v > m1) { m2 = m1; m1 = v; } else if (v > m2) m2 = v; }
    const float gs = m1 + m2; if (gs > bestgs) { bestgs = gs; bestg = g; } }
  int i1 = -1, i2 = -1; float v1 = -1e30f, v2 = -1e30f, s1 = 0.f, s2 = 0.f;
#pragma unroll
  for (int e = 0; e < d::NE; ++e) { if (e / d::EPG == bestg) { const float v = sel[e];
      if (v > v1) { v2 = v1; i2 = i1; s2 = s1; v1 = v; i1 = e; s1 = sc[e]; } else if (v > v2) { v2 = v; i2 = e; s2 = sc[e]; } } }
  const float inv = 1.f / (s1 + s2);
  a.ridx[2 * r] = i1; a.ridx[2 * r + 1] = i2; a.rw[2 * r] = s1 * inv; a.rw[2 * r + 1] = s2 * inv;
}
template <class T> HD void st_moehid(const NaiveBufs& a, int l, long idx) {
  using d = DD<T>; const int j = (int)(idx % d::DE); const int k = (int)((idx / d::DE) % 2); const int r = (int)(idx / (2 * d::DE));
  const int e = a.ridx[2 * r + k]; const float* hr = a.h + (long)r * d::D;
  const float* wg = a.moe_w_gate + (((long)l * d::NE + e) * d::D) * d::DE + j; const float* wu = a.moe_w_up + (((long)l * d::NE + e) * d::D) * d::DE + j;
  float g = 0.f, u = 0.f;
  for (int i = 0; i < d::D; ++i) { const float hv = hr[i]; g += hv * wg[(long)i * d::DE]; u += hv * wu[(long)i * d::DE]; }
  a.hid[idx] = siluf_(g) * u;
}
template <class T> HD void st_moeout(const NaiveBufs& a, int l, int b, long idx) {
  using d = DD<T>; const int dd = (int)(idx % d::D), r = (int)(idx / d::D);
  float acc = 0.f;
  for (int k = 0; k < 2; ++k) { const int e = a.ridx[2 * r + k]; const float* hk = a.hid + ((long)r * 2 + k) * d::DE;
    const float* wd = a.moe_w_down + (((long)l * d::NE + e) * d::DE) * d::D + dd; float s = 0.f;
    for (int j = 0; j < d::DE; ++j) s += hk[j] * wd[(long)j * d::D];
    acc += a.rw[2 * r + k] * s; }
  const float g2 = a.mod[(long)(r < d::S ? b : d::B) * 6 * d::D + 5 * d::D + dd];
  float* xr = xrow_w<T>(a, b, r); xr[dd] += g2 * acc;
}
enum { L_MOD = 0, L_HID_S, L_HID_C, L_TAPS_S, L_TAPS_C, L_NRM_S, L_NRM_C, N_LSTAGES,
       P_RS1 = 16, P_NORM1, P_INPROJ, P_QKNORM, P_ATTN_L, P_ATTN_C, P_GLALA, P_GLASCAN, P_GLAOUT, P_HYC3, P_HYL0, P_HYL1,
       P_MRG_HY, P_MRG_GLA, P_MRG_ATT, P_OUT_L, P_OUT_C, P_RS2, P_NORM2, P_ROUTER, P_MOEHID, P_MOEOUT, P_END };
constexpr int ATT_NSPLIT = 4;

template <class T> HD long stage_items(int st, int l) {
  using d = DD<T>; const bool last = (l == d::DEPTH - 1);
  switch (st) {
    case L_MOD: return (long)(d::B + 1) * 6 * d::D;
    case L_HID_S: return (long)d::S * d::HF;
    case L_HID_C: return (long)d::C * d::HF;
    case L_TAPS_S: return 2L * 2 * d::S * d::HW;
    case L_TAPS_C: return 2L * 2 * d::C * d::HW;
    case L_NRM_S: case L_NRM_C: return 2L * d::HW;
    case P_RS1: case P_RS2: case P_ROUTER: return d::R;
    case P_NORM1: case P_NORM2: return (long)d::R * d::D;
    case P_INPROJ: return (long)(d::R / 4) * (d::NIN / 4);
    case P_QKNORM: return (long)d::R * (d::AH + d::AKV);
    case P_ATTN_L: return (long)d::S * d::AH * ATT_NSPLIT;
    case P_ATTN_C: return last ? 0 : (long)d::C * d::AH * ATT_NSPLIT;
    case P_GLALA: return (long)d::R * 2 * d::GKW;
    case P_GLASCAN: return 2L * d::GH * d::GDV;
    case P_GLAOUT: return (long)d::R * d::GH;
    case P_HYC3: return (long)d::R * 3 * d::HW;
    case P_HYL0: case P_HYL1: return (long)(d::R / 4) * d::HW;
    case P_MRG_HY: case P_MRG_GLA: case P_MRG_ATT: return (long)(d::R / 4) * (d::D / 4);
    case P_OUT_L: return (long)(d::S / 4) * (d::D / 4);
    case P_OUT_C: return last ? 0 : (long)(d::C / 4) * (d::D / 4);
    case P_MOEHID: return (long)d::R * 2 * d::DE;
    case P_MOEOUT: return (long)(last ? d::S : d::R) * d::D;
  }
  return 0;
}

template <class T, int ST> HD void stage_run(const NaiveBufs& a, int l, int b, long idx) {
  using d = DD<T>;
  if constexpr (ST == L_MOD) st_mod<T>(a, l, idx);
  else if constexpr (ST == L_HID_S) st_hyhid<T>(a, l, 0, idx);
  else if constexpr (ST == L_HID_C) st_hyhid<T>(a, l, 1, idx);
  else if constexpr (ST == L_TAPS_S) st_hytaps<T>(a, l, 0, idx);
  else if constexpr (ST == L_TAPS_C) st_hytaps<T>(a, l, 1, idx);
  else if constexpr (ST == L_NRM_S) st_hynorm<T>(a, 0, idx);
  else if constexpr (ST == L_NRM_C) st_hynorm<T>(a, 1, idx);
  else if constexpr (ST == P_RS1) st_rs<T>(a, l, b, 0, idx);
  else if constexpr (ST == P_RS2) st_rs<T>(a, l, b, 1, idx);
  else if constexpr (ST == P_NORM1) st_norm<T>(a, l, b, 0, idx);
  else if constexpr (ST == P_NORM2) st_norm<T>(a, l, b, 1, idx);
  else if constexpr (ST == P_INPROJ) { GemmArgs g{a.h, d::D, a.w_in + (long)l * d::D * d::NIN, d::NIN, a.proj, d::NIN, d::R, d::NIN, d::D, nullptr, 0, nullptr, nullptr, 0, 0}; st_gemm(g, idx); }
  else if constexpr (ST == P_QKNORM) st_qknorm<T>(a, l, idx);
  else if constexpr (ST == P_ATTN_L) st_attn<T, ATT_NSPLIT>(a, 0, d::S, idx);
  else if constexpr (ST == P_ATTN_C) st_attn<T, ATT_NSPLIT>(a, d::S, d::C, idx);
  else if constexpr (ST == P_GLALA) st_glala<T>(a, l, idx);
  else if constexpr (ST == P_GLASCAN) st_glascan<T>(a, idx);
  else if constexpr (ST == P_GLAOUT) st_glaout<T>(a, l, idx);
  else if constexpr (ST == P_HYC3) st_hyconv3<T>(a, l, idx);
  else if constexpr (ST == P_HYL0) st_hylong<T>(a, l, 0, idx);
  else if constexpr (ST == P_HYL1) st_hylong<T>(a, l, 1, idx);
  else if constexpr (ST == P_MRG_HY) { GemmArgs g{a.yhy, d::HW, a.w_br_hy + (long)l * d::HW * d::D, d::D, a.m, d::D, d::R, d::D, d::HW, a.proj + d::O_BR, d::NIN, nullptr, nullptr, 0, 0}; st_gemm(g, idx); }
  else if constexpr (ST == P_MRG_GLA) { GemmArgs g{a.ygla, d::GVW, a.w_br_gla + (long)l * d::GVW * d::D, d::D, a.m, d::D, d::R, d::D, d::GVW, a.proj + d::O_BR + d::D, d::NIN, nullptr, nullptr, 0, 1}; st_gemm(g, idx); }
  else if constexpr (ST == P_MRG_ATT) { GemmArgs g{a.yatt, d::AQW, a.w_br_att + (long)l * d::AQW * d::D, d::D, a.m, d::D, d::R, d::D, d::AQW, a.proj + d::O_BR + 2 * d::D, d::NIN, nullptr, nullptr, 0, 1}; st_gemm(g, idx); }
  else if constexpr (ST == P_OUT_L) { const float* res = (l == 0 ? a.x : (const float*)a.out) + (long)b * d::S * d::D;
    GemmArgs g{a.m, d::D, a.w_out + (long)l * d::D * d::D, d::D, a.out + (long)b * d::S * d::D, d::D, d::S, d::D, d::D, nullptr, 0, a.mod + (long)b * 6 * d::D + 2 * d::D, res, d::D, 0}; st_gemm(g, idx); }
  else if constexpr (ST == P_OUT_C) { const float* res = (l == 0 ? a.ctx : (const float*)a.xc) + (long)b * d::C * d::D;
    GemmArgs g{a.m + (long)d::S * d::D, d::D, a.w_out + (long)l * d::D * d::D, d::D, a.xc + (long)b * d::C * d::D, d::D, d::C, d::D, d::D, nullptr, 0, a.mod + (long)d::B * 6 * d::D + 2 * d::D, res, d::D, 0}; st_gemm(g, idx); }
  else if constexpr (ST == P_ROUTER) st_router<T>(a, idx);
  else if constexpr (ST == P_MOEHID) st_moehid<T>(a, l, idx);
  else if constexpr (ST == P_MOEOUT) st_moeout<T>(a, l, b, idx);
}

template <class T> inline size_t carve(NaiveBufs& a, float* ws) {
  using d = DD<T>; size_t o = 0; auto take = [&](size_t n) { float* p = ws ? ws + o : nullptr; o += (n + 63) & ~(size_t)63; return p; };
  a.mod = take((size_t)(d::B + 1) * 6 * d::D);
  a.hid2S = take((size_t)d::S * d::HF); a.hid2C = take((size_t)d::C * d::HF);
  a.tapsS = take((size_t)2 * 2 * d::S * d::HW); a.tapsC = take((size_t)2 * 2 * d::C * d::HW);
  a.nrmS = take(2 * d::HW); a.nrmC = take(2 * d::HW);
  a.rs = take(d::R); a.h = take((size_t)d::R * d::D); a.proj = take((size_t)d::R * d::NIN);
  a.qn = take((size_t)d::R * d::AQW); a.kn = take((size_t)d::R * d::AKVW);
  a.uc = take((size_t)d::R * 3 * d::HW); a.z1 = take((size_t)d::R * d::HW); a.yhy = take((size_t)d::R * d::HW);
  a.xc = take((size_t)d::B * d::C * d::D);
#ifdef HOST_TEST
  a.yatt = take((size_t)d::R * d::AQW); a.laf = take((size_t)d::R * d::GKW); a.lab = take((size_t)d::R * d::GKW);
  a.of = take((size_t)d::R * d::GVW); a.ob = take((size_t)d::R * d::GVW); a.ygla = take((size_t)d::R * d::GVW);
  a.m = take((size_t)d::R * d::D); a.ridx = (int*)take((size_t)d::R * 2); a.rw = take((size_t)d::R * 2); a.hid = take((size_t)d::R * 2 * d::DE);
#endif
  return o;
}
template <class T> inline void set_inputs(NaiveBufs& a, const float* const* in) {
  int i = 0;
  a.x = in[i++]; a.c = in[i++]; a.ctx = in[i++]; a.c_ctx = in[i++]; a.w_mod = in[i++]; a.b_mod = in[i++]; a.norm1_g = in[i++]; a.norm2_g = in[i++];
  a.w_in = in[i++]; a.q_norm_g = in[i++]; a.k_norm_g = in[i++]; a.gla_wa2 = in[i++]; a.gla_ba = in[i++]; a.gla_norm_g = in[i++];
  a.hy_conv_w = in[i++]; a.hy_conv_b = in[i++]; a.hy_pos_w1 = in[i++]; a.hy_pos_b1 = in[i++]; a.hy_sin_freq = in[i++]; a.hy_pos_w2 = in[i++];
  a.hy_pos_b2 = in[i++]; a.hy_pos_w3 = in[i++]; a.hy_decay = in[i++]; a.hy_skip = in[i++]; a.w_br_hy = in[i++]; a.w_br_gla = in[i++];
  a.w_br_att = in[i++]; a.w_out = in[i++]; a.router_w = in[i++]; a.router_b = in[i++]; a.moe_w_gate = in[i++]; a.moe_w_up = in[i++]; a.moe_w_down = in[i++];
}

#define LSTAGES(X) X(L_MOD) X(L_HID_S) X(L_HID_C) X(L_TAPS_S) X(L_TAPS_C) X(L_NRM_S) X(L_NRM_C)
#define PSTAGES(X) X(P_RS1) X(P_NORM1) X(P_INPROJ) X(P_QKNORM) X(P_ATTN_L) X(P_ATTN_C) X(P_GLALA) X(P_GLASCAN) X(P_GLAOUT) X(P_HYC3) X(P_HYL0) X(P_HYL1) \
  X(P_MRG_HY) X(P_MRG_GLA) X(P_MRG_ATT) X(P_OUT_L) X(P_OUT_C) X(P_RS2) X(P_NORM2) X(P_ROUTER) X(P_MOEHID) X(P_MOEOUT)
namespace pro {
__device__ __forceinline__ void mod_phase(const NaiveBufs& a, int l, LAS unsigned char* lds) {
  int tz = threadIdx.x; asm volatile("" : "+v"(tz));
  __syncthreads();
  LAS float* sl = (LAS float*)lds; LAS float* part = sl + 9 * 1024;
  for (int e = tz; e < 9 * 1024; e += NTHREADS) { const int bb = e >> 10, k = e & 1023; const float cv = bb < 8 ? a.c[bb * 1024 + k] : a.c_ctx[k]; sl[e] = cv / (1.f + __expf(-cv)); }
  __syncthreads();
  const float* w = a.w_mod + (size_t)l * 1024 * 6144;
  const int jl = tz & 63, ks = tz >> 6;
  for (int cb = blockIdx.x; cb < 96; cb += gridDim.x) { const int j = cb * 64 + jl; float acc[9];
#pragma unroll
    for (int q = 0; q < 9; ++q) acc[q] = 0.f;
#pragma unroll 4
    for (int k = ks * 128; k < ks * 128 + 128; ++k) { const float wv = w[(size_t)k * 6144 + j];
#pragma unroll
      for (int q = 0; q < 9; ++q) acc[q] += sl[q * 1024 + k] * wv; }
#pragma unroll
    for (int q = 0; q < 9; ++q) part[(ks * 9 + q) * 64 + jl] = acc[q];
    __syncthreads();
    for (int e = tz; e < 9 * 64; e += NTHREADS) { const int q = e >> 6, jj = e & 63; float s = a.b_mod[(size_t)l * 6144 + cb * 64 + jj];
#pragma unroll
      for (int k8 = 0; k8 < 8; ++k8) s += part[(k8 * 9 + q) * 64 + jj];
      a.mod[(size_t)q * 6144 + cb * 64 + jj] = s; }
    __syncthreads(); }
  __syncthreads();
}
__device__ __forceinline__ void hid_phase(const NaiveBufs& a, int l, int n, float* dst, LAS unsigned char* lds) {
  int tz = threadIdx.x; asm volatile("" : "+v"(tz));
  LAS float* Z = (LAS float*)(lds + 40960); LAS float* H1 = Z + 8 * 36;
  const float* w1 = a.hy_pos_w1 + (size_t)l * 33 * 64; const float* b1 = a.hy_pos_b1 + l * 64; const float* fr = a.hy_sin_freq + l * 64;
  const float* w2 = a.hy_pos_w2 + (size_t)l * 64 * 64; const float* b2 = a.hy_pos_b2 + l * 64;
  const float w0 = 2.f * 3.14159265358979323846f / (float)n;
  for (int t0 = blockIdx.x * 8; t0 < n; t0 += gridDim.x * 8) {
    if (tz < 8 * 33) { const int tt = tz / 33, e = tz % 33, t = t0 + tt; float v;
      if (e == 0) v = (float)t / (float)n; else { const int bnd = (e - 1) & 15; const float band = 1e-4f + (float)bnd * (15.f - 1e-4f) / 15.f; const float ph = w0 * (float)t * band; v = e <= 16 ? cosf(ph) : -sinf(ph); }
      Z[tt * 36 + e] = v; }
    __syncthreads();
    { const int tt = tz >> 6, i = tz & 63; float acc = b1[i];
#pragma unroll
      for (int e = 0; e < 33; ++e) acc += Z[tt * 36 + e] * w1[e * 64 + i];
      H1[tt * 64 + i] = sinf(fr[i] * acc); }
    __syncthreads();
    { const int tt = tz >> 6, j = tz & 63; float acc = b2[j];
#pragma unroll 8
      for (int i = 0; i < 64; ++i) acc += H1[tt * 64 + i] * w2[i * 64 + j];
      if (t0 + tt < n) dst[(size_t)(t0 + tt) * 64 + j] = sinf(fr[j] * acc); }
    __syncthreads();
  }
}
__device__ __forceinline__ void nrmS_phase(const NaiveBufs& a) {
  int tz = threadIdx.x; asm volatile("" : "+v"(tz)); const int lane = tz & 63, wave = __builtin_amdgcn_readfirstlane(tz >> 6);
  for (int oc = blockIdx.x * NWAVES + wave; oc < 1024; oc += gridDim.x * NWAVES) { const float* tp = a.tapsS + (size_t)oc * 8192; float s = 0.f;
#pragma unroll 8
    for (int k = lane; k < 8192; k += 64) s += fabsf(tp[k]);
    s = moe::wave_sum(s); if (lane == 0) a.nrmS[oc] = s + 1e-6f; }
}
constexpr int TCOPY = 8232;
__device__ __forceinline__ void tapsB_phase(const NaiveBufs& a, int l, bf16_t* tapsB, LAS unsigned char* lds) {
  int tz = threadIdx.x; asm volatile("" : "+v"(tz));
  const float* w3 = a.hy_pos_w3 + (size_t)l * 64 * 2048; const float* dcy = a.hy_decay + (size_t)l * 2048;
  typedef float f4 __attribute__((ext_vector_type(4)));
  LAS float* W = (LAS float*)lds;
  for (int cp = blockIdx.x; cp < 256; cp += gridDim.x) {
    __syncthreads();
    { const int ch = tz >> 8, e = tz & 255, c = cp + 256 * ch; W[tz] = w3[(size_t)(e >> 2) * 2048 + (e & 3) * 512 + c]; if (tz < 8) W[512 + tz] = fabsf(dcy[(tz & 3) * 512 + cp + 256 * (tz >> 2)]); }
    __syncthreads();
    for (int t = tz; t < 4096; t += NTHREADS) {
      const f4* h2 = (const f4*)(a.hid2S + (size_t)t * 64); f4 acc0 = {0.f, 0.f, 0.f, 0.f}, acc1 = {0.f, 0.f, 0.f, 0.f};
#pragma unroll 4
      for (int j4 = 0; j4 < 16; ++j4) { const f4 h = h2[j4];
#pragma unroll
        for (int e = 0; e < 4; ++e) { acc0 += h[e] * *(const LAS f4*)(W + (4 * j4 + e) * 4); acc1 += h[e] * *(const LAS f4*)(W + 256 + (4 * j4 + e) * 4); } }
      const float tn = (float)t * (1.f / 4096.f);
#pragma unroll
      for (int ch = 0; ch < 2; ++ch)
#pragma unroll
        for (int q = 0; q < 4; ++q) { const int o = q >> 1, dir = q & 1; if (dir == 1 && t == 0) continue; const int c = cp + 256 * ch;
          const bf16_t bv = (bf16_t)f2bf((ch ? acc1[q] : acc0[q]) * __expf(-tn * W[512 + 4 * ch + q]));
          bf16_t* base = tapsB + ((size_t)o * 512 + c) * 2 * TCOPY; const int x0 = dir ? 4096 + t : 4096 - t;
          base[x0] = bv; base[TCOPY + x0 - 1] = bv; } } }
  for (long idx = (long)blockIdx.x * NTHREADS + tz; idx < 1024L * 96; idx += (long)gridDim.x * NTHREADS) { const int oc = (int)(idx / 96), e = (int)(idx % 96); bf16_t* base = tapsB + (size_t)oc * 2 * TCOPY;
    if (e < 40) base[8192 + e] = 0; else if (e < 81) base[TCOPY + 8191 + (e - 40)] = 0; else if (e == 81) base[0] = 0; }
}
__device__ __forceinline__ void nrmB_phase(const NaiveBufs& a, const bf16_t* tapsB) {
  int tz = threadIdx.x; asm volatile("" : "+v"(tz)); const int lane = tz & 63, wave = __builtin_amdgcn_readfirstlane(tz >> 6);
  for (int oc = blockIdx.x * NWAVES + wave; oc < 1024; oc += gridDim.x * NWAVES) { const bf16_t* tp = tapsB + (size_t)oc * 2 * TCOPY; float s = 0.f;
#pragma unroll 8
    for (int k = lane; k < 8192; k += 64) s += fabsf(bf2f(tp[k]));
    s = moe::wave_sum(s); if (lane == 0) a.nrmS[oc] = s + 1e-6f; }
}
}
using TD = FullDims;
using dd = DD<TD>;
constexpr int GB = 4, NGRP = 2, RB = dd::R  , RG = GB * RB, PLD = dd::NIN, PANELS = RG / 256, PPB = RB / 256  ;
constexpr size_t BAR_BYTES = 16384 + 4 * 4096; constexpr int CNT_OFF = 16384;
constexpr int MPG = 38912;
constexpr size_t CS_BYTES = (size_t)2 * 4 * 68 * 64 * 128 * 4, DEC_BYTES = (size_t)2 * 4 * 68 * 64 * 4;
constexpr size_t UCT_BYTES = (size_t)1536 * 4096 * 2, YT_BYTES = (size_t)512 * 4096 * 2, UCC_BYTES = (size_t)256 * 1536 * 4, Z1C_BYTES = (size_t)256 * 512 * 4;
constexpr size_t MIX_BYTES = GB * (CS_BYTES + DEC_BYTES) > GB * (UCT_BYTES + YT_BYTES + UCC_BYTES + Z1C_BYTES) ? GB * (CS_BYTES + DEC_BYTES) : GB * (UCT_BYTES + YT_BYTES + UCC_BYTES + Z1C_BYTES);

struct KArgs { NaiveBufs a; unsigned* bar; int* cnt; bf16_t *WinT, *WhyT, *WglaT, *WattT, *WoutT, *WguT, *WdT, *hb, *proj; unsigned char* mix;
  bf16_t *hp, *hid, *contrib; int* srcrow; float* wgt; moe::Route* route; float* wts; };

struct EpiProjBf16 {
  static constexpr bool PERM = true, AFTER_DRAIN = false;
  bf16_t* P;
  __device__ __forceinline__ void operator()(const pg8::f32x4 (&acc)[2][2][4][2], const pg8::Unit& u, int wr, int wc, int fr, int fq) const {
    const int row0 = u.pm * 256 + wr * 64 + fr, col0 = u.pn * 256 + wc * 32 + 8 * fq;
#pragma unroll
    for (int ai = 0; ai < 2; ++ai)
#pragma unroll
      for (int m = 0; m < 4; ++m) { bf16_t* rowp = P + (size_t)(row0 + ai * 128 + m * 16) * PLD + col0;
#pragma unroll
        for (int bj = 0; bj < 2; ++bj) if (col0 + bj * 128 < PLD) { const pg8::f32x4 v0 = acc[ai][bj][m][0], v1 = acc[ai][bj][m][1];
          v4u o; o.x = pk2(v0[0], v0[1]); o.y = pk2(v0[2], v0[3]); o.z = pk2(v1[0], v1[1]); o.w = pk2(v1[2], v1[3]); *(v4u*)(rowp + bj * 128) = o; } }
  }
};
template <bool ACCUM> struct EpiMergeB {
  static constexpr bool PERM = true, AFTER_DRAIN = false;
  const bf16_t* gate; bf16_t* M;
  __device__ __forceinline__ void operator()(const pg8::f32x4 (&acc)[2][2][4][2], const pg8::Unit& u, int wr, int wc, int fr, int fq) const {
    const int row0 = u.pm * 256 + wr * 64 + fr, col0 = u.pn * 256 + wc * 32 + 8 * fq;
#pragma unroll
    for (int ai2 = 0; ai2 < 4; ++ai2) { const int ai = ai2 >> 1, m0 = (ai2 & 1) * 2;
      v4u gw[4][2], mo[4][2];
#pragma unroll
      for (int m = m0; m < m0 + 2; ++m)
#pragma unroll
        for (int bj = 0; bj < 2; ++bj) { const size_t r = (size_t)(row0 + ai * 128 + m * 16); const int c = col0 + bj * 128; gw[m][bj] = *(const v4u*)(gate + r * PLD + c); if (ACCUM) mo[m][bj] = *(const v4u*)(M + r * 1024 + c); }
#pragma unroll
      for (int m = m0; m < m0 + 2; ++m)
#pragma unroll
        for (int bj = 0; bj < 2; ++bj) { const size_t r = (size_t)(row0 + ai * 128 + m * 16); const int c = col0 + bj * 128; const v4u g4 = gw[m][bj];
          pg8::f32x4 v0 = acc[ai][bj][m][0], v1 = acc[ai][bj][m][1];
          v0[0] *= fsigmoid(bf2f(g4.x & 0xffff)); v0[1] *= fsigmoid(bf2f(g4.x >> 16)); v0[2] *= fsigmoid(bf2f(g4.y & 0xffff)); v0[3] *= fsigmoid(bf2f(g4.y >> 16));
          v1[0] *= fsigmoid(bf2f(g4.z & 0xffff)); v1[1] *= fsigmoid(bf2f(g4.z >> 16)); v1[2] *= fsigmoid(bf2f(g4.w & 0xffff)); v1[3] *= fsigmoid(bf2f(g4.w >> 16));
          if (ACCUM) { const v4u o = mo[m][bj]; v0[0] += bf2f(o.x & 0xffff); v0[1] += bf2f(o.x >> 16); v0[2] += bf2f(o.y & 0xffff); v0[3] += bf2f(o.y >> 16);
            v1[0] += bf2f(o.z & 0xffff); v1[1] += bf2f(o.z >> 16); v1[2] += bf2f(o.w & 0xffff); v1[3] += bf2f(o.w >> 16); }
          v4u o2; o2.x = pk2(v0[0], v0[1]); o2.y = pk2(v0[2], v0[3]); o2.z = pk2(v1[0], v1[1]); o2.w = pk2(v1[2], v1[3]); *(v4u*)(M + r * 1024 + c) = o2; } }
  }
};
struct EpiOutG {
  static constexpr bool PERM = false, AFTER_DRAIN = false;
  const float* resL; float* outL; const float* resC; float* outC; const float* mod; int b0; bool ctx_on;
  __device__ __forceinline__ void operator()(const pg8::f32x4 (&acc)[2][2][4][2], const pg8::Unit& u, int wr, int wc, int fr, int fq) const {
    const int bl = u.pm / PPB, lp = u.pm % PPB; const bool isc = lp == PPB - 1; if (isc && !ctx_on) return;
    const int b = b0 + bl;
    const float* res = isc ? resC + (size_t)b * dd::C * 1024 : resL + ((size_t)b * dd::S + lp * 256) * 1024;
    float* out = isc ? outC + (size_t)b * dd::C * 1024 : outL + ((size_t)b * dd::S + lp * 256) * 1024;
    const float* gv = mod + (size_t)(isc ? dd::B : b) * 6 * 1024 + 2 * 1024;
    const int row0 = wr * 64 + fr, col0 = u.pn * 256 + wc * 32 + 4 * fq;
    pg8::f32x4 gg[2][2];
#pragma unroll
    for (int bj = 0; bj < 2; ++bj)
#pragma unroll
      for (int n = 0; n < 2; ++n) gg[bj][n] = *(const pg8::f32x4*)(gv + col0 + bj * 128 + n * 16);
#pragma unroll
    for (int ai2 = 0; ai2 < 4; ++ai2) { const int ai = ai2 >> 1, m0 = (ai2 & 1) * 2;
      pg8::f32x4 rv[4][2][2];
#pragma unroll
      for (int m = m0; m < m0 + 2; ++m)
#pragma unroll
        for (int bj = 0; bj < 2; ++bj)
#pragma unroll
          for (int n = 0; n < 2; ++n) rv[m][bj][n] = *(const pg8::f32x4*)(res + (size_t)(row0 + ai * 128 + m * 16) * 1024 + col0 + bj * 128 + n * 16);
#pragma unroll
      for (int m = m0; m < m0 + 2; ++m)
#pragma unroll
        for (int bj = 0; bj < 2; ++bj)
#pragma unroll
          for (int n = 0; n < 2; ++n) *(pg8::f32x4*)(out + (size_t)(row0 + ai * 128 + m * 16) * 1024 + col0 + bj * 128 + n * 16) = rv[m][bj][n] + gg[bj][n] * acc[ai][bj][m][n]; }
  }
};
struct GroupOrder {
  int nN, nwg, G, c; bool lat;
  __device__ void init(int N, int G_, int c_, bool lat_) { nN = N / 256; lat = lat_; nwg = (lat ? GB * 16 : PANELS) * nN; G = G_; c = c_; }
  __device__ __forceinline__ bool next(int i, pg8::Unit& u) const { const long L = (long)i * G + c; if (L >= nwg) return false; const int p = (int)L / nN; u.pm = lat ? (p >> 4) * PPB + (p & 15) : p; u.pn = (int)L % nN; u.acol = 0; return true; }
  __device__ __forceinline__ void a_ready(const pg8::Unit&) const {}
  __device__ __forceinline__ void done(const pg8::Unit&) const {}
};
struct MergeOrder {
  int ntiles, G, c; bool lat;
  __device__ void init(int G_, int c_, bool lat_) { lat = lat_; ntiles = (lat ? GB * 16 : PANELS) * 4; G = G_; c = c_; }
  __device__ __forceinline__ bool next(int i, pg8::Unit& u) const { const int rnd = i >> 2, gi = i & 3; const long tile = (long)rnd * G + c; if (tile >= ntiles) return false; const int p = (int)tile >> 2;
    u.pm = lat ? (p >> 4) * PPB + (p & 15) : p; u.pn = gi * 4 + ((int)tile & 3); u.acol = gi == 0 ? dd::O_HY : gi == 1 ? dd::O_OG : gi == 2 ? dd::O_AQ : dd::O_AQ + 512; return true; }
  __device__ __forceinline__ void a_ready(const pg8::Unit&) const {}
  __device__ __forceinline__ void done(const pg8::Unit&) const {}
};
struct EpiMergeS {
  static constexpr bool PERM = true, AFTER_DRAIN = false;
  const bf16_t* gate0; bf16_t* M;
  __device__ __forceinline__ void operator()(const pg8::f32x4 (&acc)[2][2][4][2], const pg8::Unit& u, int wr, int wc, int fr, int fq) const {
    const int gi = u.pn >> 2; const bool accum = gi > 0; const bf16_t* gate = gate0 + (gi > 2 ? 2 : gi) * 1024;
    const int row0 = u.pm * 256 + wr * 64 + fr, col0 = (u.pn & 3) * 256 + wc * 32 + 8 * fq;
#pragma unroll
    for (int ai = 0; ai < 2; ++ai)
#pragma unroll
      for (int m = 0; m < 4; ++m) { const size_t r = (size_t)(row0 + ai * 128 + m * 16);
#pragma unroll
        for (int bj = 0; bj < 2; ++bj) { const int c = col0 + bj * 128; const v4u gw = *(const v4u*)(gate + r * PLD + c);
          pg8::f32x4 v0 = acc[ai][bj][m][0], v1 = acc[ai][bj][m][1];
          v0[0] *= fsigmoid(bf2f(gw.x & 0xffff)); v0[1] *= fsigmoid(bf2f(gw.x >> 16)); v0[2] *= fsigmoid(bf2f(gw.y & 0xffff)); v0[3] *= fsigmoid(bf2f(gw.y >> 16));
          v1[0] *= fsigmoid(bf2f(gw.z & 0xffff)); v1[1] *= fsigmoid(bf2f(gw.z >> 16)); v1[2] *= fsigmoid(bf2f(gw.w & 0xffff)); v1[3] *= fsigmoid(bf2f(gw.w >> 16));
          v4u* dst = (v4u*)(M + r * 1024 + c);
          if (accum) { const v4u o = *dst; v0[0] += bf2f(o.x & 0xffff); v0[1] += bf2f(o.x >> 16); v0[2] += bf2f(o.y & 0xffff); v0[3] += bf2f(o.y >> 16);
            v1[0] += bf2f(o.z & 0xffff); v1[1] += bf2f(o.z >> 16); v1[2] += bf2f(o.w & 0xffff); v1[3] += bf2f(o.w >> 16); }
          v4u o2; o2.x = pk2(v0[0], v0[1]); o2.y = pk2(v0[2], v0[3]); o2.z = pk2(v1[0], v1[1]); o2.w = pk2(v1[2], v1[3]); *dst = o2; } }
  }
};
__device__ __forceinline__ const float* xrow_in(const NaiveBufs& a, int l, int b, int r) {
  if (r < dd::S) return (l == 0 ? a.x : (const float*)a.out) + ((size_t)b * dd::S + r) * 1024;
  return (l == 0 ? a.ctx : (const float*)a.xc) + ((size_t)b * dd::C + (r - dd::S)) * 1024;
}
__device__ __forceinline__ float* xrow_cur(const NaiveBufs& a, int b, int r) {
  if (r < dd::S) return a.out + ((size_t)b * dd::S + r) * 1024;
  return a.xc + ((size_t)b * dd::C + (r - dd::S)) * 1024;
}
__device__ __forceinline__ void norm_row(const float* xr, const float* gnorm, const float* shift, const float* scale, bf16_t* hrow, int lane) {
  typedef float f4 __attribute__((ext_vector_type(4)));
  f4 xv[4]; float ss = 0.f;
#pragma unroll
  for (int j = 0; j < 4; ++j) { xv[j] = *(const f4*)(xr + 4 * lane + 256 * j); ss += xv[j][0] * xv[j][0] + xv[j][1] * xv[j][1] + xv[j][2] * xv[j][2] + xv[j][3] * xv[j][3]; }
  const float rs = 1.f / sqrtf(moe::wave_sum(ss) * (1.f / 1024.f) + 1e-6f);
#pragma unroll
  for (int j = 0; j < 4; ++j) { const int c = 4 * lane + 256 * j; const f4 g4 = *(const f4*)(gnorm + c), sh = *(const f4*)(shift + c), sc = *(const f4*)(scale + c);
    f4 h;
#pragma unroll
    for (int i = 0; i < 4; ++i) h[i] = xv[j][i] * rs * g4[i] * (1.f + sc[i]) + sh[i];
    *(unsigned long long*)(hrow + c) = (unsigned long long)pk2(h[0], h[1]) | ((unsigned long long)pk2(h[2], h[3]) << 32); }
}
__device__ __forceinline__ void qknorm_row(bf16_t* prow, const float* qg, const float* kg, int r, int lane) {
  const bool lat = r < dd::S; const int grow = r / dd::GW, gcol = r % dd::GW;
  const int fi = lane & 31; const float pos = (lane < 32) ? (float)grow : (float)gcol;
  const float ang = pos * __builtin_amdgcn_exp2f(-(float)fi * (13.287712379549449f / 32.f));
  const float cs = lat ? __cosf(ang) : 1.f, sn = lat ? __sinf(ang) : 0.f;
  unsigned wv[10];
#pragma unroll
  for (int hh = 0; hh < 10; ++hh) wv[hh] = *((const unsigned*)(prow + (hh < 8 ? dd::O_AQ + hh * 128 : dd::O_AK + (hh - 8) * 128)) + lane);
  float ss[10];
#pragma unroll
  for (int hh = 0; hh < 10; ++hh) { const float x1 = bf2f(wv[hh] & 0xffff), x2 = bf2f(wv[hh] >> 16); ss[hh] = x1 * x1 + x2 * x2; }
#pragma unroll
  for (int o = 1; o < 64; o <<= 1) {
#pragma unroll
    for (int hh = 0; hh < 10; ++hh) ss[hh] += __shfl_xor(ss[hh], o); }
  const float q1 = qg[2 * lane], q2 = qg[2 * lane + 1], k1 = kg[2 * lane], k2 = kg[2 * lane + 1];
#pragma unroll
  for (int hh = 0; hh < 10; ++hh) { unsigned* p = (unsigned*)(prow + (hh < 8 ? dd::O_AQ + hh * 128 : dd::O_AK + (hh - 8) * 128)) + lane;
    const float x1 = bf2f(wv[hh] & 0xffff), x2 = bf2f(wv[hh] >> 16); const float rs = 1.f / sqrtf(ss[hh] * (1.f / 128.f) + 1e-6f);
    const float y1 = x1 * rs * (hh < 8 ? q1 : k1), y2 = x2 * rs * (hh < 8 ? q2 : k2);
    *p = pk2(y1 * cs - y2 * sn, y1 * sn + y2 * cs); }
}

__global__ void __launch_bounds__(NTHREADS, 2) mega_kernel(KArgs ka_unused) {
  extern __shared__ __attribute__((aligned(16))) unsigned char lds_raw[];
  LAS unsigned char* lds = (LAS unsigned char*)lds_raw;
  volatile LAS unsigned* MISC = (volatile LAS unsigned*)(lds + MISC_OFF);
  constexpr int ARGS_OFF = MISC_OFF + 256;
  static_assert(ARGS_OFF + sizeof(KArgs) <= LDS_BYTES, "LDS map");
  { const unsigned __attribute__((address_space(4)))* kp = (const unsigned __attribute__((address_space(4)))*)__builtin_amdgcn_kernarg_segment_ptr();
    for (int i = threadIdx.x; i < (int)(sizeof(KArgs) / 4); i += NTHREADS) ((LAS unsigned*)(lds + ARGS_OFF))[i] = kp[i]; }
  if (threadIdx.x < 64) MISC[threadIdx.x] = 0u;
  __syncthreads();
  const KArgs& ka = *(const KArgs*)(const LAS KArgs*)(lds + ARGS_OFF);
  const NaiveBufs& a = ka.a;
  unsigned* bar_s; { const unsigned long long bp = (unsigned long long)ka.bar; const unsigned lo_ = __builtin_amdgcn_readfirstlane((unsigned)bp), hi_ = __builtin_amdgcn_readfirstlane((unsigned)(bp >> 32));
    bar_s = (unsigned*)(((unsigned long long)hi_ << 32) | lo_); }
  XcdBarrier xb = xcd_barrier_post(bar_s, MISC);
#define SPTR(T, name, src) T* name; { const unsigned long long bp_ = (unsigned long long)(src); const unsigned lo_ = __builtin_amdgcn_readfirstlane((unsigned)bp_), hi_ = __builtin_amdgcn_readfirstlane((unsigned)(bp_ >> 32)); name = (T*)(((unsigned long long)hi_ << 32) | lo_); }
  SPTR(bf16_t, proj_s, ka.proj) SPTR(bf16_t, hb_s, ka.hb) SPTR(unsigned char, mix_s, ka.mix)
  const long gs = (long)gridDim.x * NTHREADS;
  LAS int* poff = (LAS int*)(lds + MISC_OFF + 64);
#define TID_SETUP int tz = threadIdx.x; asm volatile("" : "+v"(tz)); const int lane = tz & 63, wave = __builtin_amdgcn_readfirstlane(tz >> 6); \
    const int gw = blockIdx.x * NWAVES + wave, NGW = gridDim.x * NWAVES; const long gt = (long)blockIdx.x * NTHREADS + tz; (void)lane; (void)gw; (void)NGW; (void)gt;
#define LSTAGE(ST) { TID_SETUP const long n_ = stage_items<TD>(ST, l); for (long i_ = gt; i_ < n_; i_ += gs) stage_run<TD, ST>(a, l, 0, i_); }
  for (int l = 0; l < dd::DEPTH; ++l) {
    const bool last = (l == dd::DEPTH - 1);
    { TID_SETUP
      LAS float* scr = (LAS float*)(lds + RING_OFF + wave * 16384);
      constexpr int NIT = (dd::D / 64) * (dd::NIN / 32);
      for (int it = gw; it < NIT; it += NGW) transpose_item(a.w_in + (size_t)l * dd::D * dd::NIN, dd::D, dd::NIN, ka.WinT, 0, scr, it, lane);
      { constexpr int I0 = (dd::HW / 64) * (dd::D / 32), I1 = (dd::GVW / 64) * (dd::D / 32), I2 = (dd::AQW / 64) * (dd::D / 32), I3 = (dd::D / 64) * (dd::D / 32);
        for (int it = gw; it < I0 + I1 + I2 + I3; it += NGW) { int r = it;
          if (r < I0) { transpose_item(a.w_br_hy + (size_t)l * dd::HW * dd::D, dd::HW, dd::D, ka.WhyT, 0, scr, r, lane); continue; } r -= I0;
          if (r < I1) { transpose_item(a.w_br_gla + (size_t)l * dd::GVW * dd::D, dd::GVW, dd::D, ka.WglaT, 0, scr, r, lane); continue; } r -= I1;
          if (r < I2) { transpose_item(a.w_br_att + (size_t)l * dd::AQW * dd::D, dd::AQW, dd::D, ka.WattT, 0, scr, r, lane); continue; } r -= I2;
          transpose_item(a.w_out + (size_t)l * dd::D * dd::D, dd::D, dd::D, ka.WoutT, 0, scr, r, lane); } }
      { constexpr int IG = (dd::D / 64) * (dd::DE / 32), IDN = (dd::DE / 64) * (dd::D / 32);
        for (int it = gw; it < dd::NE * (2 * IG + IDN); it += NGW) { const int e = it / (2 * IG + IDN); int r = it % (2 * IG + IDN);
          if (r < 2 * IG) { const int up = r >= IG; if (up) r -= IG; const int n0 = 32 * (r % (dd::DE / 32));
            transpose_item((up ? a.moe_w_up : a.moe_w_gate) + ((size_t)l * dd::NE + e) * dd::D * dd::DE, dd::D, dd::DE, ka.WguT, e * 1024 + 128 * (n0 >> 7) + (up ? 128 : 0), scr, r, lane); }
          else { r -= 2 * IG; transpose_item(a.moe_w_down + ((size_t)l * dd::NE + e) * dd::DE * dd::D, dd::DE, dd::D, ka.WdT, e * 1024, scr, r, lane); } } }
      for (long i = gt; i < (long)(NINP - dd::NIN) * dd::D / 8; i += gs) { unsigned z_ = 0u; asm volatile("" : "+v"(z_)); *(v4u*)(ka.WinT + (size_t)dd::NIN * dd::D + i * 8) = (v4u){z_, z_, z_, z_}; }
    }
    pro::mod_phase(a, l, lds); pro::hid_phase(a, l, dd::S, a.hid2S, lds); if (!last) pro::hid_phase(a, l, dd::C, a.hid2C, lds);
    xcd_barrier(xb);
    pro::tapsB_phase(a, l, (bf16_t*)a.tapsS, lds); if (!last) LSTAGE(L_TAPS_C)
    xcd_barrier(xb);
    pro::nrmB_phase(a, (const bf16_t*)a.tapsS); if (!last) LSTAGE(L_NRM_C)
    xcd_barrier(xb);
    for (int grp = 0; grp < NGRP; ++grp) {
      const int b0 = grp * GB;
      { TID_SETUP
        for (int rg = gw; rg < RG; rg += NGW) { const int bl = rg / RB, r = rg % RB, b = b0 + bl; const float* md = a.mod + (size_t)(r < dd::S ? b : dd::B) * 6 * 1024;
          norm_row(xrow_in(a, l, b, r), a.norm1_g + (size_t)l * 1024, md, md + 1024, hb_s + (size_t)rg * 1024, lane); }
        xcd_barrier(xb); }
      { pg8::Gemm g{hb_s, ka.WinT, RG, NINP, dd::D, 0}; pg8::StaticOrder S; S.init(RG, NINP, (int)gridDim.x, (int)blockIdx.x); EpiProjBf16 E{proj_s};
        pg8::gemm_phase<EpiProjBf16, pg8::StaticOrder, false>((PG8_LAS unsigned char*)(lds + RING_OFF), g, S, E, nullptr);
        xcd_barrier(xb); }
      { TID_SETUP
        for (int rg = gw; rg < RG; rg += NGW) qknorm_row(proj_s + (size_t)rg * PLD, a.q_norm_g + (size_t)l * 128, a.k_norm_g + (size_t)l * 128, rg % RB, lane);
        for (int u = blockIdx.x; u < GB * 4 * 68; u += gridDim.x) { const int bl = u / (4 * 68), hu = u % (4 * 68); const bf16_t* pb = proj_s + (size_t)bl * RB * PLD;
          gla::In gp; gp.q = pb + dd::O_GQ; gp.k = pb + dd::O_GK; gp.v = pb + dd::O_GV; gp.ga = pb + dd::O_GA; gp.og = pb + dd::O_OG; gp.ld = PLD;
          gp.wa2 = a.gla_wa2 + (size_t)l * 2 * 16 * 256; gp.ba = a.gla_ba + (size_t)l * 2 * 256; gp.gnorm = a.gla_norm_g + (size_t)l * 128;
          gp.cs = (float*)(mix_s + (size_t)bl * CS_BYTES); gp.dec = (float*)(mix_s + (size_t)GB * CS_BYTES + (size_t)bl * DEC_BYTES); gp.y = (bf16_t*)pb + dd::O_OG; gp.ldy = PLD; gp.S = dd::S; gp.C = dd::C;
          gla::g1b_unit(gp, lds, hu / 68, hu % 68, 4, 68); }
        xcd_barrier(xb); }
      { TID_SETUP
        for (long i_ = gt; i_ < (long)GB * 2 * 4 * 64 * 128; i_ += gs) { const int bl = (int)(i_ / (2 * 4 * 64 * 128)); gla::In gp; gp.cs = (float*)(mix_s + (size_t)bl * CS_BYTES); gp.dec = (float*)(mix_s + (size_t)GB * CS_BYTES + (size_t)bl * DEC_BYTES); gp.S = dd::S; gp.C = dd::C;
          gla::g2_item(gp, i_ % (2 * 4 * 64 * 128), 4, 68); }
        const int combo = blockIdx.x & 7, slot = blockIdx.x >> 3, nslot = gridDim.x >> 3;
        const int per_combo = 64 + (last ? 0 : 4);
        const bool xcdm = (gridDim.x & 7) == 0;
        for (int uu = xcdm ? slot : (int)blockIdx.x; uu < (xcdm ? per_combo : 8 * per_combo); uu += xcdm ? nslot : (int)gridDim.x) { const int cmb = xcdm ? combo : uu / per_combo, ui = xcdm ? uu : uu % per_combo;
          const bool lat = ui < 64; const int bl = cmb >> 1, kvh = cmb & 1;
          const int head = kvh * 4 + (lat ? ui >> 4 : ui - 64), qb = lat ? ui & 15 : 0;
          bf16_t* pb = proj_s + (size_t)bl * RB * PLD; const size_t qrow = lat ? (size_t)qb * 256 : (size_t)dd::S, krow = lat ? 0 : (size_t)dd::S;
          att::attn_dense_body<att::bf16, PLD, PLD, 1024, true>((const att::bf16*)(pb + qrow * PLD + dd::O_AQ + head * 128), (const att::bf16*)(pb + krow * PLD + dd::O_AK + kvh * 128),
              (const att::bf16*)(pb + krow * PLD + dd::O_AV + kvh * 128), hb_s + ((size_t)bl * RB + qrow) * 1024 + head * 128, lat ? RB : dd::C, (char*)lds_raw);
          __syncthreads(); }
        xcd_barrier(xb); }
      { const int n3 = last ? 64 : 68;
        for (int u = blockIdx.x; u < GB * 4 * n3; u += gridDim.x) { const int bl = u / (4 * n3), hu = u % (4 * n3); const bf16_t* pb = proj_s + (size_t)bl * RB * PLD;
          gla::In gp; gp.q = pb + dd::O_GQ; gp.k = pb + dd::O_GK; gp.v = pb + dd::O_GV; gp.ga = pb + dd::O_GA; gp.og = pb + dd::O_OG; gp.ld = PLD;
          gp.wa2 = a.gla_wa2 + (size_t)l * 2 * 16 * 256; gp.ba = a.gla_ba + (size_t)l * 2 * 256; gp.gnorm = a.gla_norm_g + (size_t)l * 128;
          gp.cs = (float*)(mix_s + (size_t)bl * CS_BYTES); gp.dec = (float*)(mix_s + (size_t)GB * CS_BYTES + (size_t)bl * DEC_BYTES); gp.y = (bf16_t*)pb + dd::O_OG; gp.ldy = PLD; gp.S = dd::S; gp.C = dd::C;
          gla::g3b_unit(gp, lds, hu / n3, hu % n3, 4, 68); }
        xcd_barrier(xb); }
      {
        bf16_t* ucT0 = (bf16_t*)mix_s; bf16_t* yT0 = (bf16_t*)(mix_s + GB * UCT_BYTES); float* ucc0 = (float*)(mix_s + GB * (UCT_BYTES + YT_BYTES)); float* z1c0 = (float*)(mix_s + GB * (UCT_BYTES + YT_BYTES + UCC_BYTES));
        const float* cw = a.hy_conv_w + (size_t)l * 3 * 1536; const float* cb = a.hy_conv_b + (size_t)l * 1536; const float* skp = a.hy_skip + (size_t)l * 2 * 512;
        { TID_SETUP
        { int t_ = blockIdx.x; hy::H0Regs hr = hy::h0_load(proj_s + (size_t)(t_ / (64 * 24)) * RB * PLD + dd::O_HY, PLD, t_ % (64 * 24), tz);
          for (; t_ < GB * 64 * 24; t_ += gridDim.x) { const int bl = t_ / (64 * 24), tn_ = t_ + gridDim.x; hy::H0Regs hn = hr;
            if (tn_ < GB * 64 * 24) hn = hy::h0_load(proj_s + (size_t)(tn_ / (64 * 24)) * RB * PLD + dd::O_HY, PLD, tn_ % (64 * 24), tz);
            hy::h0_compute(hr, cw, cb, ucT0 + (size_t)bl * 1536 * 4096, t_ % (64 * 24), lds, tz); hr = hn; } }
        if (!last) for (long i_ = gt; i_ < (long)GB * 256 * 1536; i_ += gs) { const int bl = (int)(i_ / (256 * 1536)); hy::cconv3_item(proj_s + ((size_t)bl * RB + dd::S) * PLD + dd::O_HY, PLD, cw, cb, ucc0 + (size_t)bl * 256 * 1536, i_ % (256 * 1536)); } }
        xcd_barrier(xb);
        { TID_SETUP
        for (int u = blockIdx.x; u < (GB / 2) * 512; u += gridDim.x) { const int bp_ = u / 512; hy::h1c_unit(ucT0 + (size_t)(2 * bp_) * 1536 * 4096, (const bf16_t*)a.tapsS, a.nrmS, skp, yT0 + (size_t)(2 * bp_) * 512 * 4096, u % 512, lds); }
        if (!last) for (long i_ = gt; i_ < (long)GB * 32 * 512; i_ += gs) { const int bl = (int)(i_ / (32 * 512)); hy::clong_item(ucc0 + (size_t)bl * 256 * 1536, nullptr, z1c0 + (size_t)bl * 256 * 512, nullptr, 0, a.tapsC, a.nrmC, skp, 0, i_ % (32 * 512)); } }
        xcd_barrier(xb);
        { TID_SETUP
        for (int t_ = blockIdx.x; t_ < GB * 64 * 8; t_ += gridDim.x) { const int bl = t_ / (64 * 8); hy::h2_tile(yT0 + (size_t)bl * 512 * 4096, proj_s + (size_t)bl * RB * PLD + dd::O_HY, PLD, t_ % (64 * 8), lds); }
        if (!last) for (long i_ = gt; i_ < (long)GB * 32 * 512; i_ += gs) { const int bl = (int)(i_ / (32 * 512)); hy::clong_item(ucc0 + (size_t)bl * 256 * 1536, z1c0 + (size_t)bl * 256 * 512, nullptr, proj_s + ((size_t)bl * RB + dd::S) * PLD + dd::O_HY, PLD, a.tapsC, a.nrmC, skp, 1, i_ % (32 * 512)); } }
        xcd_barrier(xb); }
      { { pg8::Gemm g{proj_s + dd::O_HY, ka.WhyT, RG, 1024, 512, PLD}; GroupOrder S; S.init(1024, (int)gridDim.x, (int)blockIdx.x, last);
          EpiMergeB<false> E{proj_s + dd::O_BR, (bf16_t*)mix_s}; pg8::gemm_phase<EpiMergeB<false>, GroupOrder, false>((PG8_LAS unsigned char*)(lds + RING_OFF), g, S, E, nullptr); }
        for (int gi = 1; gi < 3; ++gi) { const bool at = gi == 2;
          pg8::Gemm g{at ? (const bf16_t*)hb_s : (const bf16_t*)(proj_s + dd::O_OG), at ? ka.WattT : ka.WglaT, RG, 1024, at ? 1024 : 512, at ? 1024 : PLD}; GroupOrder S; S.init(1024, (int)gridDim.x, (int)blockIdx.x, last);
          EpiMergeB<true> E{proj_s + dd::O_BR + gi * 1024, (bf16_t*)mix_s}; pg8::gemm_phase<EpiMergeB<true>, GroupOrder, false>((PG8_LAS unsigned char*)(lds + RING_OFF), g, S, E, nullptr); }
        xcd_barrier(xb);
        pg8::Gemm g{(const bf16_t*)mix_s, ka.WoutT, RG, 1024, 1024, 0}; GroupOrder S; S.init(1024, (int)gridDim.x, (int)blockIdx.x, last);
        EpiOutG E{l == 0 ? a.x : (const float*)a.out, a.out, l == 0 ? a.ctx : (const float*)a.xc, a.xc, a.mod, b0, !last};
        pg8::gemm_phase<EpiOutG, GroupOrder, false>((PG8_LAS unsigned char*)(lds + RING_OFF), g, S, E, nullptr);
        xcd_barrier(xb); }
      {
        { TID_SETUP int* cnt = ka.cnt + (l * NGRP + grp) * 1024;
          LAS float* rwT = (LAS float*)(lds + RING_OFF);
          for (int k = tz; k < 1024; k += NTHREADS) {
#pragma unroll
            for (int e = 0; e < 16; ++e) rwT[e * 1024 + k] = a.router_w[(size_t)k * 16 + e]; }
          __syncthreads();
          LAS int* lcnt = (LAS int*)(lds + RING_OFF + 65536);
          if (tz < 32) lcnt[tz] = 0;
          __syncthreads();
          for (int rg = gw; rg < RG; rg += NGW) { const int bl = rg / RB, r = rg % RB, b = b0 + bl; if (last && r >= dd::S) continue; const float* md = a.mod + (size_t)(r < dd::S ? b : dd::B) * 6 * 1024;
            moe::route_row(xrow_cur(a, b, r), a.norm2_g + (size_t)l * 1024, md + 3 * 1024, md + 4 * 1024, hb_s + (size_t)rg * 1024, rwT, a.router_b, lcnt, ka.route + rg, ka.wts + 2 * rg, lane); }
          __syncthreads();
          if (tz < 16) lcnt[16 + tz] = atomicAdd(cnt + tz * 64, lcnt[tz]);
          __syncthreads();
          for (int rg = gw; rg < RG; rg += NGW) { if (last && (rg % RB) >= dd::S) continue; moe::Route* rt = ka.route + rg; if (lane == 0) { moe::Route r_ = *rt; r_.r0 += lcnt[16 + r_.e0]; r_.r1 += lcnt[16 + r_.e1]; *rt = r_; } }
          xcd_barrier(xb); }
        { TID_SETUP int* cnt = ka.cnt + (l * NGRP + grp) * 1024;
          if (tz == 0) { int acc_ = 0; for (int e = 0; e < 16; ++e) { poff[e] = acc_; acc_ += (cnt[e * 64] + 255) >> 8; } poff[16] = acc_; }
          __syncthreads();
          for (int rg = gw; rg < RG; rg += NGW) { if (last && (rg % RB) >= dd::S) continue; const moe::Route rt = ka.route[rg];
            const v4u h0 = *(const v4u*)(hb_s + (size_t)rg * 1024 + lane * 16), h1 = *(const v4u*)(hb_s + (size_t)rg * 1024 + lane * 16 + 8);
#pragma unroll
            for (int sl = 0; sl < 2; ++sl) { const int e = sl ? rt.e1 : rt.e0, rk = sl ? rt.r1 : rt.r0; const size_t dst = (size_t)poff[e] * 256 + rk;
              *(v4u*)(ka.hp + dst * 1024 + lane * 16) = h0; *(v4u*)(ka.hp + dst * 1024 + lane * 16 + 8) = h1;
              if (lane == 0) { ka.srcrow[dst] = 2 * rg + sl; ka.wgt[dst] = ka.wts[2 * rg + sl]; } } }
          for (int e = 0; e < 16; ++e) { const int c_ = cnt[e * 64], pe = ((c_ + 255) >> 8) << 8; for (int p_ = c_ + (int)gt; p_ < pe; p_ += (int)gs) ka.srcrow[(size_t)poff[e] * 256 + p_] = -1; }
          xcd_barrier(xb); }
        { pg8::Gemm g{ka.hp, ka.WguT, 0, 0, 1024, 0}; moe::MoeOrder S{(int)gridDim.x, (int)blockIdx.x, 4, poff}; moe::EpiGU E{ka.hid};
          pg8::gemm_phase<moe::EpiGU, moe::MoeOrder, false>((PG8_LAS unsigned char*)(lds + RING_OFF), g, S, E, nullptr);
          xcd_barrier(xb); }
        { pg8::Gemm g{ka.hid, ka.WdT, 0, 0, 512, 0}; moe::MoeOrder S{(int)gridDim.x, (int)blockIdx.x, 4, poff}; moe::EpiDown E{ka.srcrow, ka.wgt, ka.contrib, (size_t)RG * 1024};
          pg8::gemm_phase<moe::EpiDown, moe::MoeOrder, false>((PG8_LAS unsigned char*)(lds + RING_OFF), g, S, E, nullptr);
          xcd_barrier(xb); }
        { TID_SETUP
#pragma unroll 4
          for (long i_ = gt; i_ < (long)RG * 256; i_ += gs) { const int rg = (int)(i_ >> 8), c4 = (int)(i_ & 255) * 4; const int bl = rg / RB, r = rg % RB, b = b0 + bl; if (last && r >= dd::S) continue;
            float* xr = xrow_cur(a, b, r) + c4; const float* g2 = a.mod + (size_t)(r < dd::S ? b : dd::B) * 6 * 1024 + 5 * 1024 + c4;
            const unsigned long long u0 = *(const unsigned long long*)(ka.contrib + (size_t)rg * 1024 + c4), u1 = *(const unsigned long long*)(ka.contrib + (size_t)RG * 1024 + (size_t)rg * 1024 + c4);
            pg8::f32x4 xv = *(pg8::f32x4*)xr; const pg8::f32x4 gv = *(const pg8::f32x4*)g2;
#pragma unroll
            for (int e = 0; e < 4; ++e) xv[e] += gv[e] * (bf2f((bf16_t)(u0 >> (16 * e))) + bf2f((bf16_t)(u1 >> (16 * e))));
            *(pg8::f32x4*)xr = xv; }
          xcd_barrier(xb); }
      }
    }
  }
}
extern "C" void kernel_launch(void* const* d_in, const int* in_sizes, int n_in, void* d_out, int out_size, void* d_ws, size_t ws_size, hipStream_t stream) {
  static int grid = 0;
  if (!grid) {
    int dev = 0, cus = 0, per_cu = 0;
    (void)hipGetDevice(&dev); (void)hipDeviceGetAttribute(&cus, hipDeviceAttributeMultiprocessorCount, dev);
    (void)hipFuncSetAttribute((const void*)mega_kernel, hipFuncAttributeMaxDynamicSharedMemorySize, LDS_BYTES);
    (void)hipOccupancyMaxActiveBlocksPerMultiprocessor(&per_cu, mega_kernel, NTHREADS, LDS_BYTES);
    if (per_cu < 1) fprintf(stderr, "occupancy query says %d\n", per_cu);
    grid = cus;
  }
  KArgs ka{}; const float* ptrs[33]; for (int i = 0; i < 33; ++i) ptrs[i] = (const float*)d_in[i];
  set_inputs<TD>(ka.a, ptrs);
  char* wsb = (char*)d_ws; size_t off = BAR_BYTES;
  auto take = [&](size_t bytes) { char* p = wsb + off; off += (bytes + 255) & ~(size_t)255; return p; };
  NaiveBufs& a = ka.a;
  a.mod = (float*)take((size_t)(dd::B + 1) * 6 * 1024 * 4); a.hid2S = (float*)take((size_t)dd::S * 64 * 4); a.hid2C = (float*)take((size_t)dd::C * 64 * 4);
  a.tapsS = (float*)take((size_t)2 * 512 * 2 * 8232 * 2 + 64); a.tapsC = (float*)take((size_t)2 * 512 * 512 * 4); a.nrmS = (float*)take(1024 * 4); a.nrmC = (float*)take(1024 * 4);
  a.xc = (float*)take((size_t)dd::B * dd::C * 1024 * 4);
  ka.WinT = (bf16_t*)take((size_t)NINP * 1024 * 2); ka.WhyT = (bf16_t*)take((size_t)1024 * 512 * 2); ka.WglaT = (bf16_t*)take((size_t)1024 * 512 * 2); ka.WattT = (bf16_t*)take((size_t)1024 * 1024 * 2);
  ka.WoutT = (bf16_t*)take((size_t)1024 * 1024 * 2); ka.WguT = (bf16_t*)take((size_t)16 * 1024 * 1024 * 2); ka.WdT = (bf16_t*)take((size_t)16 * 1024 * 512 * 2);
  ka.hb = (bf16_t*)take((size_t)RG * 1024 * 2); ka.mix = (unsigned char*)take(MIX_BYTES);
  ka.proj = (bf16_t*)take((size_t)RG * PLD * 2);
  { char* p = (char*)ka.proj; ka.hp = (bf16_t*)p; p += (size_t)MPG * 1024 * 2; ka.hid = (bf16_t*)p; p += (size_t)MPG * 512 * 2; ka.contrib = (bf16_t*)p; p += (size_t)2 * RG * 1024 * 2;
    ka.srcrow = (int*)p; p += (size_t)MPG * 4; ka.wgt = (float*)p; p += (size_t)MPG * 4; ka.route = (moe::Route*)p; p += (size_t)RG * 16; ka.wts = (float*)p; p += (size_t)RG * 8;
    if ((size_t)(p - (char*)ka.proj) > (size_t)RG * PLD * 2) fprintf(stderr, "MoE alias region too large\n"); }
  a.out = (float*)d_out; ka.bar = (unsigned*)d_ws; ka.cnt = (int*)(wsb + CNT_OFF);
  if (off > ws_size) fprintf(stderr, "workspace too small: need %zu have %zu\n", off, ws_size);
  (void)hipMemsetAsync(d_ws, 0, BAR_BYTES, stream);
  hipLaunchKernelGGL(mega_kernel, dim3(grid), dim3(NTHREADS), LDS_BYTES, stream, ka);
}
```

```cpp
#include <hip/hip_runtime.h>
#include <cstddef>
#include <cstdio>
#include <cstdint>
#include <hip/hip_bf16.h>
#include <hip/hip_runtime.h>
namespace pg8 {
#define PG8_LAS __attribute__((address_space(3)))
typedef unsigned short bf16_t;
typedef short bf16x8 __attribute__((ext_vector_type(8)));
typedef float f32x4 __attribute__((ext_vector_type(4)));
typedef unsigned u32x4 __attribute__((ext_vector_type(4)));
constexpr int BM = 256, BK = 64, HALF = 128, HTB = HALF * BK * 2  , STAGE_BYTES = 8 * HTB, NXCD = 8, WGM = 8;

__host__ __device__ __forceinline__ int lds_byte(int r, int c) { const int st = (r >> 4) * 2 + (c >> 5), rr = r & 15, cc = c & 31, ob = rr * 64 + cc * 2; return st * 1024 + (ob ^ (((ob >> 9) & 1) << 5)); }
__host__ __device__ __forceinline__ void stage_rc(int b, int& R, int& C) { const int st = b / 1024, sb = b % 1024, swz = sb ^ (((sb >> 9) & 1) << 5); R = (st >> 1) * 16 + swz / 64; C = (st & 1) * 32 + (swz % 64) / 2; }
__host__ __device__ __forceinline__ int perm32(int rho) { const int n = rho >> 4, i = rho & 15; return 8 * (i >> 2) + 4 * n + (i & 3); }

struct Unit { int pm, pn, acol, nt; };
struct Gemm { const bf16_t* A; const bf16_t* Bt; int M, N, K; int lda; int ldb; };

struct StaticOrder {
    int nM, nN, nwg, G, c;
    __host__ __device__ void init(int M, int N, int G_, int c_) { nM = M / BM; nN = N / BM; nwg = nM * nN; G = G_; c = c_; }
    __host__ __device__ bool next(int i, Unit& u) const {
        const long L = (long)i * G + c; if (L >= nwg) return false;
        int wgid = (int)L; { const int q = nwg / NXCD, r = nwg % NXCD, xcd = wgid % NXCD, off = wgid / NXCD; wgid = (xcd < r ? xcd * (q + 1) : r * (q + 1) + (xcd - r) * q) + off; }
        const int nig = WGM * nN, gid = wgid / nig, fm = gid * WGM, gsz = (nM - fm) < WGM ? (nM - fm) : WGM;
        u.pm = fm + ((wgid % nig) % gsz); u.pn = (wgid % nig) / gsz; u.acol = 0; u.nt = 0; return true;
    }
    __device__ __forceinline__ void a_ready(const Unit&) const {}
    __device__ __forceinline__ void done(const Unit&) const {}
};
__device__ __forceinline__ unsigned cvt_pk_bf16(float lo, float hi) { unsigned r; asm volatile("v_cvt_pk_bf16_f32 %0, %1, %2" : "=v"(r) : "v"(lo), "v"(hi)); return r; }
typedef float f32x2 __attribute__((ext_vector_type(2)));
template <class Epi, class Sched, bool STAMP = false>
__device__ __forceinline__ void gemm_phase(PG8_LAS unsigned char* lds, const Gemm g, const Sched& S, const Epi& E, unsigned long long* stamps) {
    int tid = threadIdx.x; asm volatile("" : "+v"(tid)); const int wid = __builtin_amdgcn_readfirstlane(tid >> 6), lane = tid & 63, wr = wid >> 2, wc = wid & 3, fr = lane & 15, fq = lane >> 4;
    const int K = g.K, nt = K / BK, LDA = g.lda ? g.lda : g.K, LDB = g.ldb ? g.ldb : g.K;
    int ts_lo = 0, ts_hi = 0, nts = 0; const unsigned long long rt_entry = STAMP ? (unsigned long long)wall_clock64() : 0ull;
#define PG8_STAMP() do { if (STAMP && wid == 0 && nts < 64) { const unsigned long long _c = (unsigned long long)clock64(); \
        ts_lo = (lane == nts) ? (int)(unsigned)_c : ts_lo; ts_hi = (lane == nts) ? (int)(unsigned)(_c >> 32) : ts_hi; ++nts; } } while (0)
    PG8_STAMP();
    unsigned voffA[2], voffB[2];
#pragma unroll
    for (int i = 0; i < 2; ++i) { int R, C; stage_rc(tid * 16 + i * 8192, R, C); const int Rb = Epi::PERM ? ((R & ~31) + perm32(R & 31)) : R;
        voffA[i] = (unsigned)(R * LDA + C) * 2u; voffB[i] = (unsigned)(Rb * LDB + C) * 2u; }
    const size_t kstep = (size_t)(BK * 2);
    const size_t hstep = (size_t)HALF * LDB * 2;
    const size_t tstep = 2 * hstep;
    const size_t hstepA = (size_t)HALF * LDA * 2, tstepA = 2 * hstepA;
    const unsigned ldsw = (unsigned)wid * 1024u;
    const int aoff = lds_byte(wr * 64 + fr, fq * 8), boff = lds_byte(wc * 32 + fr, fq * 8);
#define PG8_SA(b, h) (((b) * 2 + (h)) * HTB)
#define PG8_SB(b, h) ((4 + (b) * 2 + (h)) * HTB)
#define PG8_STAGE(bufoff, gbase, voff) do { _Pragma("unroll") for (int _i = 0; _i < 2; ++_i) \
        __builtin_amdgcn_global_load_lds((const unsigned*)((const char*)(gbase) + (voff)[_i]), (PG8_LAS unsigned*)(lds + (bufoff) + ldsw + _i * 8192), 16, 0, 0); } while (0)
#define PG8_LDA(dst, b, h) do { _Pragma("unroll") for (int m = 0; m < 4; ++m) _Pragma("unroll") for (int k = 0; k < 2; ++k) dst[m][k] = *(const PG8_LAS bf16x8*)(lds + PG8_SA(b, h) + aoff + m * 2048 + k * 1024); } while (0)
#define PG8_LDB(dst, b, h) do { _Pragma("unroll") for (int n = 0; n < 2; ++n) _Pragma("unroll") for (int k = 0; k < 2; ++k) dst[n][k] = *(const PG8_LAS bf16x8*)(lds + PG8_SB(b, h) + boff + n * 2048 + k * 1024); } while (0)
#define PG8_MMA(ai, bj, At, Bt) do { __builtin_amdgcn_s_setprio(1); _Pragma("unroll") for (int m = 0; m < 4; ++m) _Pragma("unroll") for (int n = 0; n < 2; ++n) _Pragma("unroll") for (int k = 0; k < 2; ++k) \
        acc[ai][bj][m][n] = __builtin_amdgcn_mfma_f32_16x16x32_bf16(Bt[n][k], At[m][k], acc[ai][bj][m][n], 0, 0, 0); __builtin_amdgcn_s_setprio(0); } while (0)
#define PG8_WAIT_V(n) asm volatile("s_waitcnt vmcnt(" #n ")" ::: "memory")
#define PG8_WAIT_L(n) asm volatile("s_waitcnt lgkmcnt(" #n ")" ::: "memory")
#define PG8_BAR __builtin_amdgcn_s_barrier()
#define PG8_SCHED __builtin_amdgcn_sched_barrier(0)
    Unit cur, nxt; int ui = 0;
    if (!S.next(0, cur)) return;
    f32x4 acc[2][2][4][2];
#pragma unroll
    for (int a = 0; a < 2; ++a)
#pragma unroll
        for (int b = 0; b < 2; ++b)
#pragma unroll
            for (int m = 0; m < 4; ++m)
#pragma unroll
                for (int n = 0; n < 2; ++n) acc[a][b][m][n] = (f32x4){0.f, 0.f, 0.f, 0.f};
    bf16x8 At[4][2], B0[2][2], B1[2][2];
    const char* cA = (const char*)g.A + (size_t)cur.pm * tstepA + (size_t)cur.acol * 2; const char* cB = (const char*)g.Bt + (size_t)cur.pn * tstep;
    S.a_ready(cur);
    PG8_STAGE(PG8_SB(0, 0), cB, voffB); PG8_STAGE(PG8_SA(0, 0), cA, voffA); PG8_STAGE(PG8_SB(0, 1), cB + hstep, voffB); PG8_STAGE(PG8_SA(0, 1), cA + hstepA, voffA);
    if (wr == 1) PG8_BAR;
    PG8_WAIT_V(4); PG8_BAR;
    PG8_STAGE(PG8_SB(1, 0), cB + kstep, voffB); PG8_STAGE(PG8_SA(1, 0), cA + kstep, voffA); PG8_STAGE(PG8_SB(1, 1), cB + hstep + kstep, voffB);
    PG8_WAIT_V(6); PG8_BAR;
    PG8_STAMP();
    for (;;) {
        const bool has_next = S.next(ui + 1, nxt);
        const char* nA = has_next ? (const char*)g.A + (size_t)nxt.pm * tstepA + (size_t)nxt.acol * 2 : cA; const char* nB = has_next ? (const char*)g.Bt + (size_t)nxt.pn * tstep : cB;
        const int ntu = cur.nt ? cur.nt : nt;
        for (int t = 0; t < ntu; t += 2) {
            const bool last = (t == ntu - 2);
            const char* a1 = cA + (size_t)(t + 1) * kstep;
            const char* a2 = last ? nA : cA + (size_t)(t + 2) * kstep; const char* b2 = last ? nB : cB + (size_t)(t + 2) * kstep;
            const char* a3 = a2 + kstep; const char* b3 = b2 + kstep;
            if (last && has_next) S.a_ready(nxt);
            PG8_LDB(B0, 0, 0); PG8_SCHED; PG8_LDA(At, 0, 0); PG8_STAGE(PG8_SA(1, 1), a1 + hstepA, voffA);
            PG8_WAIT_L(8); PG8_BAR; PG8_WAIT_L(0); PG8_MMA(0, 0, At, B0); PG8_BAR; PG8_SCHED;
            PG8_LDB(B1, 0, 1); PG8_STAGE(PG8_SB(0, 0), b2, voffB);
            PG8_BAR; PG8_WAIT_L(0); PG8_MMA(0, 1, At, B1); PG8_BAR;
            PG8_LDA(At, 0, 1); PG8_STAGE(PG8_SA(0, 0), a2, voffA);
            PG8_BAR; PG8_WAIT_L(0); PG8_MMA(1, 0, At, B0); PG8_BAR; PG8_SCHED;
            PG8_STAGE(PG8_SB(0, 1), b2 + hstep, voffB);
            PG8_WAIT_V(6); PG8_BAR; PG8_MMA(1, 1, At, B1); PG8_BAR;
            PG8_LDB(B0, 1, 0); PG8_SCHED; PG8_LDA(At, 1, 0); PG8_STAGE(PG8_SA(0, 1), a2 + hstepA, voffA);
            PG8_WAIT_L(8); PG8_BAR; PG8_WAIT_L(0); PG8_MMA(0, 0, At, B0); PG8_BAR; PG8_SCHED;
            PG8_LDB(B1, 1, 1); PG8_STAGE(PG8_SB(1, 0), b3, voffB);
            PG8_BAR; PG8_WAIT_L(0); PG8_MMA(0, 1, At, B1); PG8_BAR;
            PG8_LDA(At, 1, 1); PG8_STAGE(PG8_SA(1, 0), a3, voffA);
            PG8_BAR; PG8_WAIT_L(0); PG8_MMA(1, 0, At, B0); PG8_BAR; PG8_SCHED;
            PG8_STAGE(PG8_SB(1, 1), b3 + hstep, voffB);
            PG8_WAIT_V(6); PG8_BAR; PG8_MMA(1, 1, At, B1); PG8_BAR;
        }
        PG8_STAMP();
        if constexpr (!Epi::AFTER_DRAIN) { E(acc, cur, wr, wc, fr, fq); S.done(cur); }
        PG8_STAMP();
        if (!has_next) break;
#pragma unroll
        for (int a = 0; a < 2; ++a)
#pragma unroll
            for (int b = 0; b < 2; ++b)
#pragma unroll
                for (int m = 0; m < 4; ++m)
#pragma unroll
                    for (int n = 0; n < 2; ++n) acc[a][b][m][n] = (f32x4){0.f, 0.f, 0.f, 0.f};
        cur = nxt; cA = nA; cB = nB; ++ui;
    }
    PG8_WAIT_V(0);
    if (wr == 0) PG8_BAR;
    PG8_BAR;
    if constexpr (Epi::AFTER_DRAIN) { E.fused(acc, cur, wr, wc, fr, fq, lds, wid, lane); S.done(cur); }
    PG8_STAMP();
    if (STAMP && wid == 0) { stamps[lane] = lane < nts ? (((unsigned long long)(unsigned)ts_hi << 32) | (unsigned)ts_lo) : 0ull;
        if (lane == 62) stamps[62] = rt_entry; if (lane == 63) stamps[63] = (unsigned long long)wall_clock64(); }
#undef PG8_STAMP
#undef PG8_SA
#undef PG8_SB
#undef PG8_STAGE
#undef PG8_LDA
#undef PG8_LDB
#undef PG8_MMA
#undef PG8_WAIT_V
#undef PG8_WAIT_L
#undef PG8_BAR
#undef PG8_SCHED
}
}

#define LAS __attribute__((address_space(3)))
typedef unsigned short bf16_t;
constexpr int NWAVES = 8, NTHREADS = 512;
constexpr int LDS_BYTES = 147456;
constexpr int RING_OFF = 0;
constexpr int MISC_OFF = 131072;
constexpr int NINP = 7936;

__device__ __forceinline__ unsigned f2bf(float f) { unsigned u = __builtin_bit_cast(unsigned, f); return (u + 0x7fffu + ((u >> 16) & 1u)) >> 16; }
__device__ __forceinline__ unsigned pk2(float lo, float hi) { return f2bf(lo) | (f2bf(hi) << 16); }
__device__ __forceinline__ float bf2f(bf16_t b) { return __builtin_bit_cast(float, ((unsigned)b) << 16); }
typedef unsigned v4u __attribute__((ext_vector_type(4)));

__device__ __forceinline__ void transpose_item(const float* W, int K, int N, bf16_t* WT, int row_off, LAS float* scr, int item, int lane, int ldo = 0) {
  if (ldo == 0) ldo = K;
  const int nblk = N / 32, kb = item / nblk, nb = item % nblk, k0 = 64 * kb, n0 = 32 * nb;
  float wreg[32];
#pragma unroll
  for (int i = 0; i < 32; ++i) { const int kk = 2 * i + (lane >> 5); wreg[i] = W[(size_t)(k0 + kk) * N + n0 + (lane & 31)]; }
#pragma unroll
  for (int i = 0; i < 32; ++i) { const int kk = 2 * i + (lane >> 5); scr[kk * 33 + (lane & 31)] = wreg[i]; }
  asm volatile("s_waitcnt lgkmcnt(0)" ::: "memory");
  const int c = lane & 7;
#pragma unroll
  for (int j = 0; j < 4; ++j) { const int n = (lane >> 3) + 8 * j; const LAS float* s = scr + (8 * c) * 33 + n;
    v4u o; o.x = pk2(s[0 * 33], s[1 * 33]); o.y = pk2(s[2 * 33], s[3 * 33]); o.z = pk2(s[4 * 33], s[5 * 33]); o.w = pk2(s[6 * 33], s[7 * 33]);
    *(v4u*)(WT + (size_t)(row_off + n0 + n) * ldo + k0 + 8 * c) = o; }
  asm volatile("s_waitcnt lgkmcnt(0)" ::: "memory");
}

struct EpiProjF32 {
  static constexpr bool PERM = false, AFTER_DRAIN = false;
  float* C; int ldc; int ncols;
  __device__ __forceinline__ void operator()(const pg8::f32x4 (&acc)[2][2][4][2], const pg8::Unit& u, int wr, int wc, int fr, int fq) const {
    const int row0 = u.pm * 256 + wr * 64 + fr, col0 = u.pn * 256 + wc * 32 + 4 * fq;
#pragma unroll
    for (int ai = 0; ai < 2; ++ai)
#pragma unroll
      for (int m = 0; m < 4; ++m) { float* rowp = C + (size_t)(row0 + ai * 128 + m * 16) * ldc + col0;
#pragma unroll
        for (int bj = 0; bj < 2; ++bj)
#pragma unroll
          for (int n = 0; n < 2; ++n) if (col0 + bj * 128 + n * 16 < ncols) *(pg8::f32x4*)(rowp + bj * 128 + n * 16) = acc[ai][bj][m][n]; }
  }
};

__device__ __forceinline__ float fsigmoid(float x) { return 1.f / (1.f + __expf(-x)); }
template <bool ACCUM> struct EpiMerge {
  static constexpr bool PERM = true, AFTER_DRAIN = false;
  const float* gate; int ldg; bf16_t* M; int ldm;
  __device__ __forceinline__ void operator()(const pg8::f32x4 (&acc)[2][2][4][2], const pg8::Unit& u, int wr, int wc, int fr, int fq) const {
    const int row0 = u.pm * 256 + wr * 64 + fr, col0 = u.pn * 256 + wc * 32 + 8 * fq;
#pragma unroll
    for (int ai = 0; ai < 2; ++ai)
#pragma unroll
      for (int m = 0; m < 4; ++m) { const size_t r = (size_t)(row0 + ai * 128 + m * 16);
#pragma unroll
        for (int bj = 0; bj < 2; ++bj) { const int c = col0 + bj * 128;
          const pg8::f32x4 g0 = *(const pg8::f32x4*)(gate + r * ldg + c), g1 = *(const pg8::f32x4*)(gate + r * ldg + c + 4);
          pg8::f32x4 v0 = acc[ai][bj][m][0], v1 = acc[ai][bj][m][1];
#pragma unroll
          for (int e = 0; e < 4; ++e) { v0[e] *= fsigmoid(g0[e]); v1[e] *= fsigmoid(g1[e]); }
          v4u* dst = (v4u*)(M + r * ldm + c);
          if (ACCUM) { const v4u o = *dst; v0[0] += bf2f(o.x & 0xffff); v0[1] += bf2f(o.x >> 16); v0[2] += bf2f(o.y & 0xffff); v0[3] += bf2f(o.y >> 16);
            v1[0] += bf2f(o.z & 0xffff); v1[1] += bf2f(o.z >> 16); v1[2] += bf2f(o.w & 0xffff); v1[3] += bf2f(o.w >> 16); }
          v4u o2; o2.x = pk2(v0[0], v0[1]); o2.y = pk2(v0[2], v0[3]); o2.z = pk2(v1[0], v1[1]); o2.w = pk2(v1[2], v1[3]); *dst = o2; } }
  }
};
struct EpiOut {
  static constexpr bool PERM = false, AFTER_DRAIN = false;
  const float* resL; float* outL; const float* gL;
  const float* resC; float* outC; const float* gC;
  __device__ __forceinline__ void operator()(const pg8::f32x4 (&acc)[2][2][4][2], const pg8::Unit& u, int wr, int wc, int fr, int fq) const {
    const bool isc = u.pm == 16; if (isc && outC == nullptr) return;
    const float* res = isc ? resC : resL; float* out = isc ? outC : outL; const float* gv = isc ? gC : gL;
    const int row0 = (isc ? 0 : u.pm * 256) + wr * 64 + fr, col0 = u.pn * 256 + wc * 32 + 4 * fq;
    pg8::f32x4 gg[2][2];
#pragma unroll
    for (int bj = 0; bj < 2; ++bj)
#pragma unroll
      for (int n = 0; n < 2; ++n) gg[bj][n] = *(const pg8::f32x4*)(gv + col0 + bj * 128 + n * 16);
#pragma unroll
    for (int ai = 0; ai < 2; ++ai)
#pragma unroll
      for (int m = 0; m < 4; ++m) { const size_t ro = (size_t)(row0 + ai * 128 + m * 16) * 1024 + col0;
#pragma unroll
        for (int bj = 0; bj < 2; ++bj)
#pragma unroll
          for (int n = 0; n < 2; ++n) { const pg8::f32x4 rv = *(const pg8::f32x4*)(res + ro + bj * 128 + n * 16); *(pg8::f32x4*)(out + ro + bj * 128 + n * 16) = rv + gg[bj][n] * acc[ai][bj][m][n]; } }
  }
};
namespace att {
using bf16 = __hip_bfloat16;
constexpr int D = 128, NW = 8, QBLK = 32, KVBLK = 64; constexpr float SCALE = 0.088388347648318440f; constexpr float THR = 8.f; constexpr int SDEPTH = 2;
constexpr size_t SHM_V = KVBLK * D * 2, SHM_K = KVBLK * D * 2, SHM_ATTN = 2 * SHM_V + 2 * SHM_K + NW * 64 * 4;
using bf16x8 = __attribute__((ext_vector_type(8))) short;
using s16x4  = __attribute__((ext_vector_type(4))) short;
using f32x16 = __attribute__((ext_vector_type(16))) float;
using f32x8  = __attribute__((ext_vector_type(8))) float;
using u32x4  = __attribute__((ext_vector_type(4))) unsigned;
#define KSWZ(row, colB) ((row) * 256 + ((colB) ^ (((row) & 7) << 4)))
#define SBAR() __builtin_amdgcn_sched_barrier(0)
__device__ __forceinline__ int crow(int r, int hi) { return (r & 3) + 8 * (r >> 2) + 4 * hi; }
__device__ __forceinline__ unsigned cvtpk(float lo, float hi) {
  unsigned r; asm volatile("v_cvt_pk_bf16_f32 %0, %1, %2" : "=v"(r) : "v"(lo), "v"(hi)); return r;
}
template <typename TIn> struct Stage;
template <> struct Stage<bf16>  { using T = bf16x8;
  __device__ static __forceinline__ T ld8(const bf16* p) { return *reinterpret_cast<const bf16x8*>(p); }
  __device__ static __forceinline__ bf16x8 tobf(T x) { return x; } };
template <> struct Stage<float> { using T = f32x8;
  __device__ static __forceinline__ T ld8(const float* p) { return *reinterpret_cast<const f32x8*>(p); }
  __device__ static __forceinline__ bf16x8 tobf(T x) {
    u32x4 w = {cvtpk(x[0], x[1]), cvtpk(x[2], x[3]), cvtpk(x[4], x[5]), cvtpk(x[6], x[7])}; return *reinterpret_cast<bf16x8*>(&w); } };

__device__ __forceinline__ void partialSM(f32x16& p0, f32x16& p1, float& m_reg, float& mn, float& alpha) {
  constexpr float C = SCALE * 1.4426950408889634f;
  float pmax = p0[0]; for (int r = 1; r < 16; ++r) pmax = fmaxf(pmax, p0[r]); for (int r = 0; r < 16; ++r) pmax = fmaxf(pmax, p1[r]);
  { auto rr = __builtin_amdgcn_permlane32_swap(__float_as_uint(pmax), __float_as_uint(pmax), false, false);
    pmax = fmaxf(__uint_as_float(rr[0]), __uint_as_float(rr[1])); }
  if (__builtin_expect(__all(pmax - m_reg <= THR / SCALE), 1)) { mn = m_reg; alpha = 1.f; }
  else { mn = fmaxf(m_reg, pmax); alpha = __builtin_amdgcn_exp2f((m_reg - mn) * C); m_reg = mn; }
  float mnC = -mn * C;
  for (int r = 0; r < 16; ++r) p0[r] = fmaf(p0[r], C, mnC); for (int r = 0; r < 16; ++r) p1[r] = fmaf(p1[r], C, mnC);
  for (int r = 0; r < 16; ++r) p0[r] = __builtin_amdgcn_exp2f(p0[r]);
}
__device__ __forceinline__ void finishSM(f32x16& p0, f32x16& p1, float alpha, float& l_reg, bf16x8& pa0, bf16x8& pa1, bf16x8& pa2, bf16x8& pa3) {
  for (int r = 0; r < 16; ++r) p1[r] = __builtin_amdgcn_exp2f(p1[r]);
  float ps = 0; for (int r = 0; r < 16; ++r) ps += p0[r]; for (int r = 0; r < 16; ++r) ps += p1[r];
  { auto rr = __builtin_amdgcn_permlane32_swap(__float_as_uint(ps), __float_as_uint(ps), false, false);
    ps = __uint_as_float(rr[0]) + __uint_as_float(rr[1]); }
  l_reg = l_reg * alpha + ps;
#define PK4(P, BASE, OUT) do { unsigned a0 = cvtpk(P[BASE + 0], P[BASE + 1]), a1 = cvtpk(P[BASE + 2], P[BASE + 3]);   \
    unsigned b0 = cvtpk(P[BASE + 4], P[BASE + 5]), b1 = cvtpk(P[BASE + 6], P[BASE + 7]);                              \
    auto r0 = __builtin_amdgcn_permlane32_swap(a0, b0, false, false); auto r1 = __builtin_amdgcn_permlane32_swap(a1, b1, false, false); \
    u32x4 w = {r0[0], r1[0], r0[1], r1[1]}; OUT = *reinterpret_cast<bf16x8*>(&w); } while (0)
  PK4(p0, 0, pa0); PK4(p0, 8, pa1); PK4(p1, 0, pa2); PK4(p1, 8, pa3);
#undef PK4
}
__device__ __forceinline__ void qkt(f32x16& p0, f32x16& p1, const bf16* Ks, const bf16x8* qr, int r32, int hi) {
  p0 = f32x16{}; p1 = f32x16{};
  for (int d0 = 0; d0 < 8; ++d0) { int cb = (d0 * 16 + hi * 8) * 2;
    bf16x8 b0 = *reinterpret_cast<const bf16x8*>((const char*)Ks + KSWZ(r32, cb));
    bf16x8 b1 = *reinterpret_cast<const bf16x8*>((const char*)Ks + KSWZ(32 + r32, cb));
    p0 = __builtin_amdgcn_mfma_f32_32x32x16_bf16(b0, qr[d0], p0, 0, 0, 0);
    p1 = __builtin_amdgcn_mfma_f32_32x32x16_bf16(b1, qr[d0], p1, 0, 0, 0); }
}
__device__ __forceinline__ int v_st(int k, int c) { const int kk = (k & ~0xC) | ((k & 4) << 1) | ((k & 8) >> 1); return ((kk >> 3) * 4 + (c >> 5)) * 512 + ((kk & 7) * 32 + (c & 31)) * 2; }
__device__ __forceinline__ int v_rd_base(int lane) { return ((lane & 3) << 3) | (((lane >> 2) & 3) << 6) | (((lane >> 4) & 1) << 5) | (((lane >> 5) & 1) << 8); }
constexpr int v_rd_off(int d0, int ks, int half) { return d0 * 512 + ks * 4096 + half * 2048; }
template <int OFF> __device__ __forceinline__ s16x4 tr_read(int vb) {
  s16x4 r; asm volatile("ds_read_b64_tr_b16 %0, %1 offset:%2" : "=&v"(r) : "v"(vb), "i"(OFF) : "memory"); return r;
}
template <int D0> __device__ __forceinline__ void pv_one(f32x16& od, int vb, bf16x8 pa0, bf16x8 pa1, bf16x8 pa2, bf16x8 pa3) {
  const s16x4 l0 = tr_read<v_rd_off(D0, 0, 0)>(vb), h0 = tr_read<v_rd_off(D0, 0, 1)>(vb), l1 = tr_read<v_rd_off(D0, 1, 0)>(vb), h1 = tr_read<v_rd_off(D0, 1, 1)>(vb);
  const s16x4 l2 = tr_read<v_rd_off(D0, 2, 0)>(vb), h2 = tr_read<v_rd_off(D0, 2, 1)>(vb), l3 = tr_read<v_rd_off(D0, 3, 0)>(vb), h3 = tr_read<v_rd_off(D0, 3, 1)>(vb);
  asm volatile("s_waitcnt lgkmcnt(0)" ::: "memory"); SBAR();
#define PK(L, H) (bf16x8){L[0], L[1], L[2], L[3], H[0], H[1], H[2], H[3]}
  od = __builtin_amdgcn_mfma_f32_32x32x16_bf16(pa0, PK(l0, h0), od, 0, 0, 0);
  od = __builtin_amdgcn_mfma_f32_32x32x16_bf16(pa1, PK(l1, h1), od, 0, 0, 0);
  od = __builtin_amdgcn_mfma_f32_32x32x16_bf16(pa2, PK(l2, h2), od, 0, 0, 0);
  od = __builtin_amdgcn_mfma_f32_32x32x16_bf16(pa3, PK(l3, h3), od, 0, 0, 0);
#undef PK
}
__device__ __forceinline__ void pv_d0(f32x16* o, int vb, bf16x8 pa0, bf16x8 pa1, bf16x8 pa2, bf16x8 pa3) {
  pv_one<0>(o[0], vb, pa0, pa1, pa2, pa3); pv_one<1>(o[1], vb, pa0, pa1, pa2, pa3); pv_one<2>(o[2], vb, pa0, pa1, pa2, pa3); pv_one<3>(o[3], vb, pa0, pa1, pa2, pa3);
}

template <typename TQ, int LDQ, int LDK, int LDO, bool OBF16>
__device__ __forceinline__ void attn_dense_body(const TQ* Qb, const bf16* Kh, const bf16* Vh,
                                                void* Obv, int seq, char* lds) {
  using St = Stage<bf16>; using SQ = Stage<TQ>;
  int tid = threadIdx.x; asm volatile("" : "+v"(tid)); const int wid = tid >> 6, lane = tid & 63, r32 = lane & 31, hi = lane >> 5;
  bf16* V_lds = (bf16*)lds; bf16* K_lds = (bf16*)(lds + 2 * SHM_V);
  float* ws = (float*)(lds + 2 * SHM_V + 2 * SHM_K) + wid * 64; float* li_l = ws; float* al_l = ws + 32;
  float m_reg = -1e30f, l_reg = 0; f32x16 o[4] = {}; bf16x8 qr[8];
  const TQ* Qw = Qb + (long)(wid * QBLK + r32) * LDQ + hi * 8;
#pragma unroll
  for (int d0 = 0; d0 < 8; ++d0) qr[d0] = SQ::tobf(SQ::ld8(Qw + d0 * 16));
  const int sr = tid >> 4, sc = (tid & 15) * 8, vst0 = v_st(sr, sc), vst1 = v_st(32 + sr, sc);
  const int vb0 = (int)(uintptr_t)V_lds + v_rd_base(lane);
  struct { typename St::T vs0, vs1, ks0, ks1; } sr_[SDEPTH];
#define SLOAD(i, k0) do { sr_[i].vs0 = St::ld8(&Vh[(long)((k0) + sr) * LDK + sc]); sr_[i].vs1 = St::ld8(&Vh[(long)((k0) + 32 + sr) * LDK + sc]); \
    sr_[i].ks0 = St::ld8(&Kh[(long)((k0) + sr) * LDK + sc]); sr_[i].ks1 = St::ld8(&Kh[(long)((k0) + 32 + sr) * LDK + sc]); } while (0)
#define SWRITE(b, i) do { *(bf16x8*)((char*)V_lds + (b) * SHM_V + vst0) = St::tobf(sr_[i].vs0);          \
    *(bf16x8*)((char*)V_lds + (b) * SHM_V + vst1) = St::tobf(sr_[i].vs1); int kc = sc * 2;               \
    *(bf16x8*)((char*)K_lds + (b) * SHM_K + KSWZ(sr, kc)) = St::tobf(sr_[i].ks0);                       \
    *(bf16x8*)((char*)K_lds + (b) * SHM_K + KSWZ(32 + sr, kc)) = St::tobf(sr_[i].ks1); } while (0)
#define SWAIT() do { if constexpr (SDEPTH == 2) asm volatile("s_waitcnt vmcnt(4)" ::: "memory"); else asm volatile("s_waitcnt vmcnt(0)" ::: "memory"); } while (0)
#define RESC(a) do { if (__any((a) < 1.f)) { if (hi == 0) al_l[r32] = (a); asm volatile("s_waitcnt lgkmcnt(0)" ::: "memory"); \
    for (int d = 0; d < 4; ++d) for (int r = 0; r < 16; ++r) o[d][r] *= al_l[crow(r, hi)]; } } while (0)
  f32x16 pA0, pA1, pB0, pB1; float mnA, mnB, alA, alB; bf16x8 pa0, pa1, pa2, pa3; const int NT = seq / KVBLK;
  constexpr int SE = 0, SO = SDEPTH - 1;
  SLOAD(SE, 0); asm volatile("s_waitcnt vmcnt(0)" ::: "memory"); SWRITE(0, SE); __syncthreads();
  qkt(pA0, pA1, K_lds, qr, r32, hi); partialSM(pA0, pA1, m_reg, mnA, alA);
  SLOAD(SO, KVBLK); if constexpr (SDEPTH == 2) { if (2 < NT) SLOAD(SE, 2 * KVBLK); }
  SWAIT(); SWRITE(1, SO); __syncthreads();
  for (int j = 1; j + 1 < NT; j += 2) {
    SBAR(); qkt(pB0, pB1, (bf16*)((char*)K_lds + SHM_K), qr, r32, hi);
    finishSM(pA0, pA1, alA, l_reg, pa0, pa1, pa2, pa3); SBAR();
    SLOAD(SO, (j + SDEPTH) * KVBLK); SBAR();
    pv_d0(o, vb0, pa0, pa1, pa2, pa3); partialSM(pB0, pB1, m_reg, mnB, alB);
    __syncthreads(); SWAIT(); SWRITE(0, SE);
    RESC(alB); __syncthreads();
    SBAR(); qkt(pA0, pA1, K_lds, qr, r32, hi);
    finishSM(pB0, pB1, alB, l_reg, pa0, pa1, pa2, pa3); SBAR();
    if (SDEPTH == 1 || j + 3 < NT) SLOAD(SE, (j + 1 + SDEPTH) * KVBLK); SBAR();
    pv_d0(o, vb0 + (int)SHM_V, pa0, pa1, pa2, pa3); partialSM(pA0, pA1, m_reg, mnA, alA);
    __syncthreads(); SWAIT(); SWRITE(1, SO);
    RESC(alA); __syncthreads();
  }
  SBAR(); qkt(pB0, pB1, (bf16*)((char*)K_lds + SHM_K), qr, r32, hi);
  finishSM(pA0, pA1, alA, l_reg, pa0, pa1, pa2, pa3); SBAR();
  pv_d0(o, vb0, pa0, pa1, pa2, pa3); partialSM(pB0, pB1, m_reg, mnB, alB);
  __syncthreads(); RESC(alB);
  finishSM(pB0, pB1, alB, l_reg, pa0, pa1, pa2, pa3); SBAR();
  pv_d0(o, vb0 + (int)SHM_V, pa0, pa1, pa2, pa3);
  if (hi == 0) li_l[r32] = l_reg; asm volatile("s_waitcnt lgkmcnt(0)" ::: "memory");
  float rli[16];
#pragma unroll
  for (int r = 0; r < 16; ++r) rli[r] = __builtin_amdgcn_rcpf(li_l[crow(r, hi)]);
  if constexpr (!OBF16) { float* Ow = (float*)Obv + (long)(wid * QBLK) * LDO;
#pragma unroll
  for (int r = 0; r < 16; ++r) { int orow = crow(r, hi);
    for (int d0 = 0; d0 < 4; ++d0) Ow[(long)orow * LDO + d0 * 32 + r32] = o[d0][r] * rli[r]; }
  } else { unsigned short* Ow = (unsigned short*)Obv + (long)(wid * QBLK) * LDO;
#pragma unroll
  for (int r = 0; r < 16; ++r) { int orow = crow(r, hi);
    for (int d0 = 0; d0 < 4; ++d0) { const unsigned pk = cvtpk(o[d0][r] * rli[r], 0.f); Ow[(long)orow * LDO + d0 * 32 + r32] = (unsigned short)(pk & 0xffffu); } }
  }
#undef SLOAD
#undef SWRITE
#undef SWAIT
#undef RESC
}
#undef KSWZ
#undef SBAR
}
namespace gla {
typedef float f32x16 __attribute__((ext_vector_type(16)));
typedef float f32x4v __attribute__((ext_vector_type(4)));
constexpr int LD = 65;
constexpr int OX = 0, OY = 2 * 64 * LD * 4, OV = 4 * 64 * LD * 4, OAL = OV + 64 * 128 * 4, OW2 = OAL + 64 * 32 * 4, OBA = OW2 + 2 * 16 * 64 * 4, OTOT = OBA + 2 * 64 * 4, OEND = OTOT + 2 * 64 * 4 * 4;
static_assert(OEND <= 131072, "gla lds");
static_assert(64 * 129 * 4 <= 2 * 64 * LD * 4, "O stage fits in X");

struct In {
  const bf16_t* q; const bf16_t* k; const bf16_t* v; const bf16_t* ga; const bf16_t* og; int ld;
  const float* wa2; const float* ba; const float* gnorm;
  float* cs;
  float* dec;
  bf16_t* y; int ldy;
  int S, C;
};
__device__ __forceinline__ long chunk_row(const In& p, int cid) { return cid < p.S / 64 ? (long)cid * 64 : (long)p.S + (long)(cid - p.S / 64) * 64; }
__device__ __forceinline__ float logsig(float x) { return x < 0.f ? x - __logf(1.f + __expf(x)) : -__logf(1.f + __expf(-x)); }

__device__ __forceinline__ void cum_phase(const In& p, LAS unsigned char* lds, int head, long row0, int tid) {
  LAS float* AL = (LAS float*)(lds + OAL); LAS float* W2 = (LAS float*)(lds + OW2); LAS float* BA = (LAS float*)(lds + OBA); LAS float* TOT = (LAS float*)(lds + OTOT);
  { const int t = tid >> 3, r4 = (tid & 7) * 4; const unsigned long long u = *(const unsigned long long*)(p.ga + (row0 + t) * p.ld + r4);
    f32x4v a4; a4[0] = bf2f((bf16_t)u); a4[1] = bf2f((bf16_t)(u >> 16)); a4[2] = bf2f((bf16_t)(u >> 32)); a4[3] = bf2f((bf16_t)(u >> 48)); *(LAS f32x4v*)(AL + t * 32 + r4) = a4; }
  { const int e = tid * 4, dir = e >> 10, r = (e >> 6) & 15, j = e & 63; *(LAS f32x4v*)(W2 + e) = *(const f32x4v*)(p.wa2 + ((long)dir * 16 + r) * 256 + head * 64 + j); }
  if (tid < 128) BA[tid] = p.ba[(tid >> 6) * 256 + head * 64 + (tid & 63)];
  __syncthreads();
  const int dir = tid >> 8, j = tid & 63, seg = (tid >> 6) & 3;
  float w[16];
#pragma unroll
  for (int r = 0; r < 16; ++r) w[r] = W2[(dir * 16 + r) * 64 + j];
  const float bj = BA[dir * 64 + j];
  float c[16];
#pragma unroll
  for (int k = 0; k < 16; ++k) { const int t = seg * 16 + k; float z = bj;
#pragma unroll
    for (int r4 = 0; r4 < 4; ++r4) { const f32x4v a4 = *(const LAS f32x4v*)(AL + t * 32 + dir * 16 + 4 * r4); z += a4[0] * w[4 * r4] + a4[1] * w[4 * r4 + 1] + a4[2] * w[4 * r4 + 2] + a4[3] * w[4 * r4 + 3]; }
    c[k] = logsig(z) * (1.f / 16.f); }
  if (dir == 0) {
#pragma unroll
    for (int k = 1; k < 16; ++k) c[k] += c[k - 1];
    TOT[(dir * 64 + j) * 4 + seg] = c[15];
  } else {
#pragma unroll
    for (int k = 14; k >= 0; --k) c[k] += c[k + 1];
    TOT[(dir * 64 + j) * 4 + seg] = c[0];
  }
  __syncthreads();
  float off = 0.f;
#pragma unroll
  for (int s = 0; s < 4; ++s) { const float tv = TOT[(dir * 64 + j) * 4 + s]; if (dir == 0 ? s < seg : s > seg) off += tv; }
  LAS float* X = (LAS float*)(lds + OX) + dir * 64 * LD;
#pragma unroll
  for (int k = 0; k < 16; ++k) X[(seg * 16 + k) * LD + j] = c[k] + off;
}
struct VRegs { unsigned long long u[4]; };
__device__ __forceinline__ VRegs load_v_regs(const In& p, int head, long row0, int tid) { VRegs r;
#pragma unroll
  for (int m = 0; m < 4; ++m) { const int t = (tid >> 5) + 16 * m, c4 = (tid & 31) * 4; r.u[m] = *(const unsigned long long*)(p.v + (row0 + t) * p.ld + head * 128 + c4); }
  return r; }
__device__ __forceinline__ void store_v(const VRegs& r, LAS unsigned char* lds, int tid) {
  LAS float* V = (LAS float*)(lds + OV);
#pragma unroll
  for (int m = 0; m < 4; ++m) { const int t = (tid >> 5) + 16 * m, c4 = (tid & 31) * 4; const unsigned long long u = r.u[m];
    f32x4v a4; a4[0] = bf2f((bf16_t)u); a4[1] = bf2f((bf16_t)(u >> 16)); a4[2] = bf2f((bf16_t)(u >> 32)); a4[3] = bf2f((bf16_t)(u >> 48)); *(LAS f32x4v*)(V + t * 128 + c4) = a4; }
}

__device__ __forceinline__ void g1_unit(const In& p, LAS unsigned char* lds, int head, int cid, int GH, int NCH) {
  int tid = threadIdx.x; asm volatile("" : "+v"(tid));
  const int lane = tid & 63, w = __builtin_amdgcn_readfirstlane(tid >> 6);
  const long row0 = chunk_row(p, cid);
  const VRegs vr = load_v_regs(p, head, row0, tid);
  bf16_t kreg[8];
#pragma unroll
  for (int m = 0; m < 8; ++m) kreg[m] = p.k[(row0 + (tid >> 6) + 8 * m) * p.ld + head * 64 + (tid & 63)];
  cum_phase(p, lds, head, row0, tid);
  store_v(vr, lds, tid);
  __syncthreads();
  LAS float* TOT = (LAS float*)(lds + OTOT);
  { const int j = tid & 63;
#pragma unroll
    for (int dir = 0; dir < 2; ++dir) { LAS float* X = (LAS float*)(lds + OX) + dir * 64 * LD;
      const float cl = TOT[(dir * 64 + j) * 4 + 0] + TOT[(dir * 64 + j) * 4 + 1] + TOT[(dir * 64 + j) * 4 + 2] + TOT[(dir * 64 + j) * 4 + 3];
#pragma unroll
      for (int m = 0; m < 8; ++m) { const int t = (tid >> 6) + 8 * m; const float kv = bf2f(kreg[m]); X[t * LD + j] = kv * __expf(cl - X[t * LD + j]); }
      if (tid < 64) p.dec[(((long)dir * GH + head) * NCH + cid) * 64 + j] = __expf(cl); }
  }
  __syncthreads();
  { const int dir = w >> 2, di = (w >> 1) & 1, vj0 = (w & 1) * 2; const LAS float* X = (const LAS float*)(lds + OX) + dir * 64 * LD; const LAS float* V = (const LAS float*)(lds + OV);
    f32x16 a0 = {}, a1 = {}; const int li = lane & 31, lk = lane >> 5;
#pragma unroll 4
    for (int s0 = 0; s0 < 64; s0 += 2) { const float av = X[(s0 + lk) * LD + 32 * di + li]; const float b0 = V[(s0 + lk) * 128 + 32 * vj0 + li], b1 = V[(s0 + lk) * 128 + 32 * vj0 + 32 + li];
      a0 = __builtin_amdgcn_mfma_f32_32x32x2f32(av, b0, a0, 0, 0, 0); a1 = __builtin_amdgcn_mfma_f32_32x32x2f32(av, b1, a1, 0, 0, 0); }
    float* dst = p.cs + ((((long)dir * GH + head) * NCH + cid) * 64) * 128;
#pragma unroll
    for (int r = 0; r < 16; ++r) { const int d = 32 * di + (r & 3) + 8 * (r >> 2) + 4 * lk; dst[(long)d * 128 + 32 * vj0 + li] = a0[r]; dst[(long)d * 128 + 32 * vj0 + 32 + li] = a1[r]; }
  }
  __syncthreads();
}
__device__ __forceinline__ void g2_item(const In& p, long idx, int GH, int NCH) {
  const int v = (int)(idx & 127), d = (int)((idx >> 7) & 63); const int hd = (int)((idx >> 13) % GH), dir = (int)((idx >> 13) / GH);
  const int nl = p.S / 64, nc = p.C / 64; float st = 0.f;
  float* base = p.cs + (((long)dir * GH + hd) * NCH) * 64 * 128 + (long)d * 128 + v; const float* db = p.dec + (((long)dir * GH + hd) * NCH) * 64 + d;
  for (int s0 = 0; s0 < nl + nc; s0 += 4) { float c[4], dc[4]; float* pp[4];
#pragma unroll
    for (int k = 0; k < 4; ++k) { const int step = s0 + k; int cid; if (step < nc) cid = nl + (dir ? nc - 1 - step : step); else cid = dir ? nl - 1 - (step - nc) : step - nc;
      pp[k] = base + (long)cid * 64 * 128; c[k] = *pp[k]; dc[k] = db[(long)cid * 64]; }
#pragma unroll
    for (int k = 0; k < 4; ++k) { *pp[k] = st; st = dc[k] * st + c[k]; } }
}
__device__ __forceinline__ void g3_unit(const In& p, LAS unsigned char* lds, int head, int cid, int GH, int NCH) {
  int tid = threadIdx.x; asm volatile("" : "+v"(tid));
  const int lane = tid & 63, w = __builtin_amdgcn_readfirstlane(tid >> 6), li = lane & 31, lk = lane >> 5;
  const long row0 = chunk_row(p, cid);
  float spf[2][32];
  { const int vj_ = w & 3;
#pragma unroll
    for (int dir = 0; dir < 2; ++dir) { const float* sp = p.cs + ((((long)dir * GH + head) * NCH + cid) * 64) * 128 + 32 * vj_ + li;
#pragma unroll
      for (int i = 0; i < 32; ++i) spf[dir][i] = sp[(long)(2 * i + lk) * 128]; } }
  const VRegs vr = load_v_regs(p, head, row0, tid);
  bf16_t kreg[8], qreg[8];
#pragma unroll
  for (int m = 0; m < 8; ++m) { const long o_ = (row0 + (tid >> 6) + 8 * m) * p.ld + head * 64 + (tid & 63); kreg[m] = p.k[o_]; qreg[m] = p.q[o_]; }
  cum_phase(p, lds, head, row0, tid);
  store_v(vr, lds, tid);
  __syncthreads();
  { const int j = tid & 63;
#pragma unroll
    for (int dir = 0; dir < 2; ++dir) { LAS float* X = (LAS float*)(lds + OX) + dir * 64 * LD; LAS float* Y = (LAS float*)(lds + OY) + dir * 64 * LD;
#pragma unroll
      for (int m = 0; m < 8; ++m) { const int t = (tid >> 6) + 8 * m; const float c = X[t * LD + j];
        const float qv = bf2f(qreg[m]) * 0.125f, kv = bf2f(kreg[m]);
        X[t * LD + j] = qv * __expf(c); Y[t * LD + j] = kv * __expf(-c); } }
  }
  __syncthreads();
  {
    const int dir = w >> 2, qi = (w >> 1) & 1, si = w & 1; const bool zero = dir == 0 ? si > qi : si < qi;
    const LAS float* X = (const LAS float*)(lds + OX) + dir * 64 * LD; LAS float* Y = (LAS float*)(lds + OY) + dir * 64 * LD;
    f32x16 pa = {};
    if (!zero) {
#pragma unroll 4
      for (int d0 = 0; d0 < 64; d0 += 2) pa = __builtin_amdgcn_mfma_f32_32x32x2f32(X[(32 * qi + li) * LD + d0 + lk], Y[(32 * si + li) * LD + d0 + lk], pa, 0, 0, 0);
    }
    __syncthreads();
#pragma unroll
    for (int r = 0; r < 16; ++r) { const int q = 32 * qi + (r & 3) + 8 * (r >> 2) + 4 * lk, s = 32 * si + li; const bool keep = dir == 0 ? s <= q : s >= q;
      Y[q * LD + s] = keep ? pa[r] : 0.f; }
  }
  __syncthreads();
  f32x16 acc = {};
  { const int qi = w >> 2, vj = w & 3; const LAS float* V = (const LAS float*)(lds + OV);
#pragma unroll
    for (int dir = 0; dir < 2; ++dir) { const LAS float* X = (const LAS float*)(lds + OX) + dir * 64 * LD; const LAS float* Y = (const LAS float*)(lds + OY) + dir * 64 * LD;
#pragma unroll 4
      for (int s0 = 0; s0 < 64; s0 += 2) acc = __builtin_amdgcn_mfma_f32_32x32x2f32(Y[(32 * qi + li) * LD + s0 + lk], V[(s0 + lk) * 128 + 32 * vj + li], acc, 0, 0, 0);
#pragma unroll
      for (int i = 0; i < 32; ++i) acc = __builtin_amdgcn_mfma_f32_32x32x2f32(X[(32 * qi + li) * LD + 2 * i + lk], spf[dir][i], acc, 0, 0, 0);
    }
    __syncthreads();
    LAS float* O = (LAS float*)(lds + OX);
#pragma unroll
    for (int r = 0; r < 16; ++r) { const int q = 32 * qi + (r & 3) + 8 * (r >> 2) + 4 * lk; O[q * 129 + 32 * vj + li] = acc[r]; }
  }
  __syncthreads();
  { const int row = tid >> 3, part = tid & 7; const LAS float* O = (const LAS float*)(lds + OX) + row * 129 + part * 16;
    float o[16]; float ss = 0.f;
#pragma unroll
    for (int k = 0; k < 16; ++k) { o[k] = O[k]; ss += o[k] * o[k]; }
    ss += __shfl_xor(ss, 1); ss += __shfl_xor(ss, 2); ss += __shfl_xor(ss, 4);
    const float rs = 1.f / sqrtf(ss * (1.f / 128.f) + 1e-6f);
    const bf16_t* ogp = p.og + (row0 + row) * p.ld + head * 128 + part * 16; const v4u og0 = *(const v4u*)ogp, og1 = *(const v4u*)(ogp + 8);
    const unsigned ogw[8] = {og0.x, og0.y, og0.z, og0.w, og1.x, og1.y, og1.z, og1.w}; bf16_t* yp = p.y + (row0 + row) * p.ldy + head * 128 + part * 16; float yy[16];
#pragma unroll
    for (int k4 = 0; k4 < 4; ++k4) { f32x4v g4; g4[0] = bf2f((bf16_t)(ogw[2 * k4] & 0xffff)); g4[1] = bf2f((bf16_t)(ogw[2 * k4] >> 16)); g4[2] = bf2f((bf16_t)(ogw[2 * k4 + 1] & 0xffff)); g4[3] = bf2f((bf16_t)(ogw[2 * k4 + 1] >> 16)); const f32x4v n4 = *(const f32x4v*)(p.gnorm + part * 16 + 4 * k4); f32x4v y4;
#pragma unroll
      for (int e = 0; e < 4; ++e) { const float gg = g4[e]; y4[e] = o[4 * k4 + e] * rs * n4[e] * (gg / (1.f + __expf(-gg))); yy[4 * k4 + e] = y4[e]; } }
    { v4u o0, o1; o0.x = pk2(yy[0], yy[1]); o0.y = pk2(yy[2], yy[3]); o0.z = pk2(yy[4], yy[5]); o0.w = pk2(yy[6], yy[7]);
      o1.x = pk2(yy[8], yy[9]); o1.y = pk2(yy[10], yy[11]); o1.z = pk2(yy[12], yy[13]); o1.w = pk2(yy[14], yy[15]); *(v4u*)yp = o0; *(v4u*)(yp + 8) = o1; }
  }
  __syncthreads();
}

typedef short bf16x8g __attribute__((ext_vector_type(8)));
constexpr int LB = 72;
constexpr int OQB = 2 * 64 * LD * 4, OKB = OQB + 2 * 64 * LB * 2, OVT = OKB + 2 * 64 * LB * 2, OBEND = OVT + 128 * LB * 2;
static_assert(OBEND <= OAL, "gla bf16 lds");
#define GMM(A, B, C) C = __builtin_amdgcn_mfma_f32_32x32x16_bf16(__builtin_bit_cast(bf16x8g, A), __builtin_bit_cast(bf16x8g, B), C, 0, 0, 0)
__device__ __forceinline__ void store_vt(const VRegs& r, LAS unsigned char* lds, int tid) {
  LAS bf16_t* Vt = (LAS bf16_t*)(lds + OVT);
#pragma unroll
  for (int m = 0; m < 4; ++m) { const int t = (tid >> 5) + 16 * m, c4 = (tid & 31) * 4; const unsigned long long u = r.u[m];
    Vt[(c4 + 0) * LB + t] = (bf16_t)u; Vt[(c4 + 1) * LB + t] = (bf16_t)(u >> 16); Vt[(c4 + 2) * LB + t] = (bf16_t)(u >> 32); Vt[(c4 + 3) * LB + t] = (bf16_t)(u >> 48); }
}
__device__ __forceinline__ void g1b_unit(const In& p, LAS unsigned char* lds, int head, int cid, int GH, int NCH) {
  int tid = threadIdx.x; asm volatile("" : "+v"(tid));
  const int lane = tid & 63, w = __builtin_amdgcn_readfirstlane(tid >> 6), li = lane & 31, lk = lane >> 5;
  const long row0 = chunk_row(p, cid);
  const VRegs vr = load_v_regs(p, head, row0, tid);
  bf16_t kreg[8];
#pragma unroll
  for (int m = 0; m < 8; ++m) kreg[m] = p.k[(row0 + (tid >> 6) + 8 * m) * p.ld + head * 64 + (tid & 63)];
  cum_phase(p, lds, head, row0, tid);
  store_vt(vr, lds, tid);
  __syncthreads();
  LAS float* TOT = (LAS float*)(lds + OTOT);
  { const int j = tid & 63;
#pragma unroll
    for (int dir = 0; dir < 2; ++dir) { const LAS float* X = (const LAS float*)(lds + OX) + dir * 64 * LD; LAS bf16_t* KeT = (LAS bf16_t*)(lds + OQB) + dir * 64 * LB;
      const float cl = TOT[(dir * 64 + j) * 4 + 0] + TOT[(dir * 64 + j) * 4 + 1] + TOT[(dir * 64 + j) * 4 + 2] + TOT[(dir * 64 + j) * 4 + 3];
#pragma unroll
      for (int m = 0; m < 8; ++m) { const int t = (tid >> 6) + 8 * m; KeT[j * LB + t] = (bf16_t)f2bf(bf2f(kreg[m]) * __expf(cl - X[t * LD + j])); }
      if (tid < 64) p.dec[(((long)dir * GH + head) * NCH + cid) * 64 + j] = __expf(cl); }
  }
  __syncthreads();
  { const int dir = w >> 2, di = (w >> 1) & 1, vj0 = (w & 1) * 2; const LAS bf16_t* KeT = (const LAS bf16_t*)(lds + OQB) + dir * 64 * LB; const LAS bf16_t* Vt = (const LAS bf16_t*)(lds + OVT);
    f32x16 a0 = {}, a1 = {};
#pragma unroll
    for (int kk = 0; kk < 4; ++kk) { const v4u av = *(const LAS v4u*)(KeT + (32 * di + li) * LB + 16 * kk + 8 * lk);
      const v4u b0 = *(const LAS v4u*)(Vt + (32 * vj0 + li) * LB + 16 * kk + 8 * lk), b1 = *(const LAS v4u*)(Vt + (32 * vj0 + 32 + li) * LB + 16 * kk + 8 * lk);
      GMM(av, b0, a0); GMM(av, b1, a1); }
    float* dst = p.cs + ((((long)dir * GH + head) * NCH + cid) * 64) * 128;
#pragma unroll
    for (int r = 0; r < 16; ++r) { const int d = 32 * di + (r & 3) + 8 * (r >> 2) + 4 * lk; dst[(long)d * 128 + 32 * vj0 + li] = a0[r]; dst[(long)d * 128 + 32 * vj0 + 32 + li] = a1[r]; }
  }
  __syncthreads();
}
__device__ __forceinline__ void g3b_unit(const In& p, LAS unsigned char* lds, int head, int cid, int GH, int NCH) {
  int tid = threadIdx.x; asm volatile("" : "+v"(tid));
  const int lane = tid & 63, w = __builtin_amdgcn_readfirstlane(tid >> 6), li = lane & 31, lk = lane >> 5;
  const long row0 = chunk_row(p, cid);
  float spf[2][32];
  { const int vj_ = w & 3;
#pragma unroll
    for (int dir = 0; dir < 2; ++dir) { const float* sp = p.cs + ((((long)dir * GH + head) * NCH + cid) * 64) * 128 + 32 * vj_ + li;
#pragma unroll
      for (int i = 0; i < 32; ++i) spf[dir][i] = sp[(long)(16 * (i >> 3) + 8 * lk + (i & 7)) * 128]; } }
  const VRegs vr = load_v_regs(p, head, row0, tid);
  bf16_t kreg[8], qreg[8];
#pragma unroll
  for (int m = 0; m < 8; ++m) { const long o_ = (row0 + (tid >> 6) + 8 * m) * p.ld + head * 64 + (tid & 63); kreg[m] = p.k[o_]; qreg[m] = p.q[o_]; }
  cum_phase(p, lds, head, row0, tid);
  store_vt(vr, lds, tid);
  __syncthreads();
  { const int j = tid & 63;
#pragma unroll
    for (int dir = 0; dir < 2; ++dir) { const LAS float* X = (const LAS float*)(lds + OX) + dir * 64 * LD; LAS bf16_t* Qb = (LAS bf16_t*)(lds + OQB) + dir * 64 * LB; LAS bf16_t* Kb = (LAS bf16_t*)(lds + OKB) + dir * 64 * LB;
#pragma unroll
      for (int m = 0; m < 8; ++m) { const int t = (tid >> 6) + 8 * m; const float c = X[t * LD + j];
        Qb[t * LB + j] = (bf16_t)f2bf(bf2f(qreg[m]) * 0.125f * __expf(c)); Kb[t * LB + j] = (bf16_t)f2bf(bf2f(kreg[m]) * __expf(-c)); } }
  }
  __syncthreads();
  {
    const int dir = w >> 2, qi = (w >> 1) & 1, si = w & 1; const bool zero = dir == 0 ? si > qi : si < qi;
    const LAS bf16_t* Qb = (const LAS bf16_t*)(lds + OQB) + dir * 64 * LB; LAS bf16_t* Kb = (LAS bf16_t*)(lds + OKB) + dir * 64 * LB;
    f32x16 pa = {};
    if (!zero) {
#pragma unroll
      for (int kk = 0; kk < 4; ++kk) { const v4u av = *(const LAS v4u*)(Qb + (32 * qi + li) * LB + 16 * kk + 8 * lk), bv = *(const LAS v4u*)(Kb + (32 * si + li) * LB + 16 * kk + 8 * lk); GMM(av, bv, pa); }
    }
    __syncthreads();
#pragma unroll
    for (int r = 0; r < 16; ++r) { const int q = 32 * qi + (r & 3) + 8 * (r >> 2) + 4 * lk, s = 32 * si + li; const bool keep = dir == 0 ? s <= q : s >= q;
      Kb[q * LB + s] = (bf16_t)f2bf(keep ? pa[r] : 0.f); }
  }
  __syncthreads();
  f32x16 acc = {};
  { const int qi = w >> 2, vj = w & 3; const LAS bf16_t* Vt = (const LAS bf16_t*)(lds + OVT);
#pragma unroll
    for (int dir = 0; dir < 2; ++dir) { const LAS bf16_t* Qb = (const LAS bf16_t*)(lds + OQB) + dir * 64 * LB; const LAS bf16_t* Pb = (const LAS bf16_t*)(lds + OKB) + dir * 64 * LB;
#pragma unroll
      for (int kk = 0; kk < 4; ++kk) { const v4u av = *(const LAS v4u*)(Pb + (32 * qi + li) * LB + 16 * kk + 8 * lk), bv = *(const LAS v4u*)(Vt + (32 * vj + li) * LB + 16 * kk + 8 * lk); GMM(av, bv, acc); }
#pragma unroll
      for (int kk = 0; kk < 4; ++kk) { const v4u av = *(const LAS v4u*)(Qb + (32 * qi + li) * LB + 16 * kk + 8 * lk);
        v4u bv; bv.x = pk2(spf[dir][8 * kk + 0], spf[dir][8 * kk + 1]); bv.y = pk2(spf[dir][8 * kk + 2], spf[dir][8 * kk + 3]); bv.z = pk2(spf[dir][8 * kk + 4], spf[dir][8 * kk + 5]); bv.w = pk2(spf[dir][8 * kk + 6], spf[dir][8 * kk + 7]);
        GMM(av, bv, acc); }
    }
    LAS float* O = (LAS float*)(lds + OX);
#pragma unroll
    for (int r = 0; r < 16; ++r) { const int q = 32 * qi + (r & 3) + 8 * (r >> 2) + 4 * lk; O[q * 129 + 32 * vj + li] = acc[r]; }
  }
  __syncthreads();
  { const int row = tid >> 3, part = tid & 7; const LAS float* O = (const LAS float*)(lds + OX) + row * 129 + part * 16;
    float o[16]; float ss = 0.f;
#pragma unroll
    for (int k = 0; k < 16; ++k) { o[k] = O[k]; ss += o[k] * o[k]; }
    ss += __shfl_xor(ss, 1); ss += __shfl_xor(ss, 2); ss += __shfl_xor(ss, 4);
    const float rs = 1.f / sqrtf(ss * (1.f / 128.f) + 1e-6f);
    const bf16_t* ogp = p.og + (row0 + row) * p.ld + head * 128 + part * 16; const v4u og0 = *(const v4u*)ogp, og1 = *(const v4u*)(ogp + 8);
    const unsigned ogw[8] = {og0.x, og0.y, og0.z, og0.w, og1.x, og1.y, og1.z, og1.w}; bf16_t* yp = p.y + (row0 + row) * p.ldy + head * 128 + part * 16; float yy[16];
#pragma unroll
    for (int k4 = 0; k4 < 4; ++k4) { f32x4v g4; g4[0] = bf2f((bf16_t)(ogw[2 * k4] & 0xffff)); g4[1] = bf2f((bf16_t)(ogw[2 * k4] >> 16)); g4[2] = bf2f((bf16_t)(ogw[2 * k4 + 1] & 0xffff)); g4[3] = bf2f((bf16_t)(ogw[2 * k4 + 1] >> 16)); const f32x4v n4 = *(const f32x4v*)(p.gnorm + part * 16 + 4 * k4);
#pragma unroll
      for (int e = 0; e < 4; ++e) { const float gg = g4[e]; yy[4 * k4 + e] = o[4 * k4 + e] * rs * n4[e] * (gg / (1.f + __expf(-gg))); } }
    { v4u o0, o1; o0.x = pk2(yy[0], yy[1]); o0.y = pk2(yy[2], yy[3]); o0.z = pk2(yy[4], yy[5]); o0.w = pk2(yy[6], yy[7]);
      o1.x = pk2(yy[8], yy[9]); o1.y = pk2(yy[10], yy[11]); o1.z = pk2(yy[12], yy[13]); o1.w = pk2(yy[14], yy[15]); *(v4u*)yp = o0; *(v4u*)(yp + 8) = o1; }
  }
  __syncthreads();
}
#undef GMM
}
namespace moe {
constexpr int NE = 16, NG = 4, EPG = 4, DE = 512, D = 1024;
__device__ __forceinline__ float wave_sum(float v) {
#pragma unroll
  for (int o = 1; o < 64; o <<= 1) v += __shfl_xor(v, o);
  return v;
}
struct Route { int e0, r0, e1, r1; };
struct MoeOrder {
  int G, c, NT; const LAS int* poff;
  __device__ __forceinline__ bool next(int i, pg8::Unit& u) const {
    const long L = (long)i * G + c; const int total = poff[NE] * NT; if (L >= total) return false;
    const int panel = (int)L / NT, j = (int)L % NT; int e = 0;
#pragma unroll
    for (int k = 1; k < NE; ++k) e += (panel >= poff[k]) ? 1 : 0;
    u.pm = panel; u.pn = e * NT + j; u.acol = 0; u.nt = 0; return true;
  }
  __device__ __forceinline__ void a_ready(const pg8::Unit&) const {}
  __device__ __forceinline__ void done(const pg8::Unit&) const {}
};
struct EpiGU {
  static constexpr bool PERM = true, AFTER_DRAIN = false;
  bf16_t* hid;
  __device__ __forceinline__ void operator()(const pg8::f32x4 (&acc)[2][2][4][2], const pg8::Unit& u, int wr, int wc, int fr, int fq) const {
    const int j = u.pn & 3; const int row0 = u.pm * 256 + wr * 64 + fr, col0 = j * 128 + wc * 32 + 8 * fq;
#pragma unroll
    for (int ai = 0; ai < 2; ++ai)
#pragma unroll
      for (int m = 0; m < 4; ++m) { const size_t r = (size_t)(row0 + ai * 128 + m * 16); float hv[8];
#pragma unroll
        for (int n = 0; n < 2; ++n)
#pragma unroll
          for (int e = 0; e < 4; ++e) { const float g = acc[ai][0][m][n][e], up = acc[ai][1][m][n][e]; hv[4 * n + e] = g / (1.f + __expf(-g)) * up; }
        v4u o; o.x = pk2(hv[0], hv[1]); o.y = pk2(hv[2], hv[3]); o.z = pk2(hv[4], hv[5]); o.w = pk2(hv[6], hv[7]);
        *(v4u*)(hid + r * DE + col0) = o; }
  }
};
struct EpiDown {
  static constexpr bool PERM = true, AFTER_DRAIN = false;
  const int* srcrow; const float* wgt; bf16_t* contrib; size_t slot_stride;
  __device__ __forceinline__ void operator()(const pg8::f32x4 (&acc)[2][2][4][2], const pg8::Unit& u, int wr, int wc, int fr, int fq) const {
    const int pn = u.pn & 3; const int row0 = u.pm * 256 + wr * 64 + fr, col0 = pn * 256 + wc * 32 + 8 * fq;
    int srcs[2][4]; float ws_[2][4];
#pragma unroll
    for (int ai = 0; ai < 2; ++ai)
#pragma unroll
      for (int m = 0; m < 4; ++m) { const int r = row0 + ai * 128 + m * 16; srcs[ai][m] = srcrow[r]; ws_[ai][m] = wgt[r]; }
#pragma unroll
    for (int ai = 0; ai < 2; ++ai)
#pragma unroll
      for (int m = 0; m < 4; ++m) { const int src = srcs[ai][m]; if (src < 0) continue; const float w = ws_[ai][m];
        bf16_t* dst = contrib + (size_t)(src & 1) * slot_stride + (size_t)(src >> 1) * D + col0;
#pragma unroll
        for (int bj = 0; bj < 2; ++bj) { const pg8::f32x4 v0 = acc[ai][bj][m][0] * w, v1 = acc[ai][bj][m][1] * w;
          v4u o; o.x = pk2(v0[0], v0[1]); o.y = pk2(v0[2], v0[3]); o.z = pk2(v1[0], v1[1]); o.w = pk2(v1[2], v1[3]); *(v4u*)(dst + bj * 128) = o; } }
  }
};
__device__ __forceinline__ void route_row(const float* xr, const float* gnorm, const float* shift, const float* scale, bf16_t* hrow, const LAS float* rwT, const float* rbias,
                                          LAS int* cnt, Route* rt, float* wts, int lane) {
  typedef float f4 __attribute__((ext_vector_type(4)));
  f4 xv[4]; float ss = 0.f;
#pragma unroll
  for (int j = 0; j < 4; ++j) { xv[j] = *(const f4*)(xr + 4 * lane + 256 * j); ss += xv[j][0] * xv[j][0] + xv[j][1] * xv[j][1] + xv[j][2] * xv[j][2] + xv[j][3] * xv[j][3]; }
  const float rs = 1.f / sqrtf(wave_sum(ss) * (1.f / 1024.f) + 1e-6f);
  float lg[NE];
#pragma unroll
  for (int e = 0; e < NE; ++e) lg[e] = 0.f;
#pragma unroll
  for (int j = 0; j < 4; ++j) { const int c = 4 * lane + 256 * j; const f4 g4 = *(const f4*)(gnorm + c), sh = *(const f4*)(shift + c), sc = *(const f4*)(scale + c);
    f4 h;
#pragma unroll
    for (int i = 0; i < 4; ++i) h[i] = xv[j][i] * rs * g4[i] * (1.f + sc[i]) + sh[i];
    *(unsigned long long*)(hrow + c) = (unsigned long long)pk2(h[0], h[1]) | ((unsigned long long)pk2(h[2], h[3]) << 32);
#pragma unroll
    for (int e = 0; e < NE; ++e) { const f4 w4 = *(const LAS f4*)(rwT + e * 1024 + c); lg[e] += h[0] * w4[0] + h[1] * w4[1] + h[2] * w4[2] + h[3] * w4[3]; } }
  { float v8[8], v4[4], v2[2], v1;
#pragma unroll
    for (int i = 0; i < 8; ++i) { const bool up = lane & 1; const float keep = up ? lg[2 * i + 1] : lg[2 * i], send = up ? lg[2 * i] : lg[2 * i + 1]; v8[i] = keep + __shfl_xor(send, 1); }
#pragma unroll
    for (int i = 0; i < 4; ++i) { const bool up = lane & 2; const float keep = up ? v8[2 * i + 1] : v8[2 * i], send = up ? v8[2 * i] : v8[2 * i + 1]; v4[i] = keep + __shfl_xor(send, 2); }
#pragma unroll
    for (int i = 0; i < 2; ++i) { const bool up = lane & 4; const float keep = up ? v4[2 * i + 1] : v4[2 * i], send = up ? v4[2 * i] : v4[2 * i + 1]; v2[i] = keep + __shfl_xor(send, 4); }
    { const bool up = lane & 8; const float keep = up ? v2[1] : v2[0], send = up ? v2[0] : v2[1]; v1 = keep + __shfl_xor(send, 8); }
    v1 += __shfl_xor(v1, 16); v1 += __shfl_xor(v1, 32);
#pragma unroll
    for (int e = 0; e < NE; ++e) lg[e] = __shfl(v1, e); }
  float sc[NE], sel[NE];
#pragma unroll
  for (int e = 0; e < NE; ++e) { sc[e] = 1.f / (1.f + __expf(-lg[e])); sel[e] = sc[e] + rbias[e]; }
  int bestg = 0; float bestgs = -1e30f;
#pragma unroll
  for (int g = 0; g < NG; ++g) { float m1 = -1e30f, m2 = -1e30f;
#pragma unroll
    for (int i = 0; i < EPG; ++i) { const float v = sel[g * EPG + i]; if (v > m1) { m2 = m1; m1 = v; } else if (v > m2) m2 = v; }
    const float gsum = m1 + m2; if (gsum > bestgs) { bestgs = gsum; bestg = g; } }
  int i1 = -1, i2 = -1; float v1 = -1e30f, v2 = -1e30f, s1 = 0.f, s2 = 0.f;
#pragma unroll
  for (int e = 0; e < NE; ++e) { if (e / EPG == bestg) { const float v = sel[e];
      if (v > v1) { v2 = v1; i2 = i1; s2 = s1; v1 = v; i1 = e; s1 = sc[e]; } else if (v > v2) { v2 = v; i2 = e; s2 = sc[e]; } } }
  if (lane == 0) { const float inv = 1.f / (s1 + s2); Route r; r.e0 = i1; r.e1 = i2; r.r0 = __hip_atomic_fetch_add(cnt + i1, 1, __ATOMIC_RELAXED, __HIP_MEMORY_SCOPE_WORKGROUP); r.r1 = __hip_atomic_fetch_add(cnt + i2, 1, __ATOMIC_RELAXED, __HIP_MEMORY_SCOPE_WORKGROUP); *rt = r; wts[0] = s1 * inv; wts[1] = s2 * inv; }
}
}
namespace hy {
typedef float f32x16 __attribute__((ext_vector_type(16)));
constexpr int S = 4096, NT1 = 128, LDZ = 191, ZPAD = 31, LDX = 129;
constexpr int O_TAPS = 0, O_ZA = 32768, O_ZB = O_ZA + 32 * LDZ * 4, O_X1 = O_ZB + 32 * LDZ * 4, O_X2 = O_X1 + 32 * LDX * 4, O_RED = O_X2 + 32 * LDX * 4, O_END = O_RED + 4 * 64 * 16 * 4;
static_assert(O_END <= 131072, "hyena lds");

struct H0Regs { v4u w0, w1; };
__device__ __forceinline__ H0Regs h0_load(const bf16_t* u, int ld, int tile, int tid) {
  const int tt = tile / 24, jt = tile % 24, t0 = tt * 64, j0 = jt * 64; H0Regs r; r.w0 = (v4u){0u, 0u, 0u, 0u}; r.w1 = r.w0;
  { const int rr = tid >> 3, c8 = (tid & 7) * 8, t = t0 - 1 + rr; if (t >= 0 && t < S) r.w0 = *(const v4u*)(u + (size_t)t * ld + j0 + c8); }
  if (tid < 16) { const int rr = 64 + (tid >> 3), c8 = (tid & 7) * 8, t = t0 - 1 + rr; if (t < S) r.w1 = *(const v4u*)(u + (size_t)t * ld + j0 + c8); }
  return r;
}
__device__ __forceinline__ void h0_compute(const H0Regs& rg, const float* cw, const float* cb, bf16_t* ucT, int tile, LAS unsigned char* lds, int tid) {
  const int tt = tile / 24, jt = tile % 24, t0 = tt * 64, j0 = jt * 64;
  LAS float* U = (LAS float*)lds;
  { const int rr = tid >> 3, c8 = (tid & 7) * 8; const v4u w = rg.w0; LAS float* d = U + rr * 65 + c8;
    d[0] = bf2f(w.x & 0xffff); d[1] = bf2f(w.x >> 16); d[2] = bf2f(w.y & 0xffff); d[3] = bf2f(w.y >> 16); d[4] = bf2f(w.z & 0xffff); d[5] = bf2f(w.z >> 16); d[6] = bf2f(w.w & 0xffff); d[7] = bf2f(w.w >> 16); }
  if (tid < 16) { const int rr = 64 + (tid >> 3), c8 = (tid & 7) * 8; const v4u w = rg.w1; LAS float* d = U + rr * 65 + c8;
    d[0] = bf2f(w.x & 0xffff); d[1] = bf2f(w.x >> 16); d[2] = bf2f(w.y & 0xffff); d[3] = bf2f(w.y >> 16); d[4] = bf2f(w.z & 0xffff); d[5] = bf2f(w.z >> 16); d[6] = bf2f(w.w & 0xffff); d[7] = bf2f(w.w >> 16); }
  __syncthreads();
  { const int jj = tid >> 3, tq = (tid & 7) * 8, j = j0 + jj; const float w0 = cw[j], w1 = cw[1536 + j], w2 = cw[2 * 1536 + j], bb = cb[j]; float v[8];
#pragma unroll
    for (int k = 0; k < 8; ++k) v[k] = bb + w0 * U[(tq + k) * 65 + jj] + w1 * U[(tq + k + 1) * 65 + jj] + w2 * U[(tq + k + 2) * 65 + jj];
    v4u o; o.x = pk2(v[0], v[1]); o.y = pk2(v[2], v[3]); o.z = pk2(v[4], v[5]); o.w = pk2(v[6], v[7]); *(v4u*)(ucT + (size_t)j * S + t0 + tq) = o; }
  __syncthreads();
}
__device__ __forceinline__ void h2_tile(const bf16_t* yT, bf16_t* ybf, int ldy, int tile, LAS unsigned char* lds) {
  int tid = threadIdx.x; asm volatile("" : "+v"(tid));
  const int tt = tile / 8, ct = tile % 8, t0 = tt * 64, c0 = ct * 64;
  LAS bf16_t* T = (LAS bf16_t*)lds;
  { const int cc = tid >> 3, t8 = (tid & 7) * 8; const v4u w = *(const v4u*)(yT + (size_t)(c0 + cc) * S + t0 + t8); LAS unsigned* d = (LAS unsigned*)(T + cc * 66 + t8); d[0] = w.x; d[1] = w.y; d[2] = w.z; d[3] = w.w; }
  __syncthreads();
  { const int t = tid >> 3, c8 = (tid & 7) * 8; unsigned short e[8];
#pragma unroll
    for (int k = 0; k < 8; ++k) e[k] = T[(c8 + k) * 66 + t];
    v4u o; o.x = e[0] | ((unsigned)e[1] << 16); o.y = e[2] | ((unsigned)e[3] << 16); o.z = e[4] | ((unsigned)e[5] << 16); o.w = e[6] | ((unsigned)e[7] << 16);
    *(v4u*)(ybf + (size_t)(t0 + t) * ldy + c0 + c8) = o; }
  __syncthreads();
}
__device__ __forceinline__ void h1_unit(const bf16_t* ucT, const float* tapsT, const float* nrm, const float* skip, bf16_t* yT, int c, LAS unsigned char* lds) {
  int tid = threadIdx.x; asm volatile("" : "+v"(tid));
  const int lane = tid & 63, w = __builtin_amdgcn_readfirstlane(tid >> 6), li = lane & 31, lk = lane >> 5;
  LAS float* TAPS = (LAS float*)(lds + O_TAPS); LAS float* ZA = (LAS float*)(lds + O_ZA); LAS float* ZB = (LAS float*)(lds + O_ZB);
  LAS float* X1 = (LAS float*)(lds + O_X1); LAS float* X2 = (LAS float*)(lds + O_X2); LAS float* RED = (LAS float*)(lds + O_RED);
  for (int e = tid; e < 32 * 62; e += 512) { const int s2 = e / 62, p = e % 62, t1p = p < 31 ? p : 128 + p; ZA[s2 * LDZ + t1p] = 0.f; ZB[s2 * LDZ + t1p] = 0.f; }
  for (int t = tid; t < S; t += 512) { const int t2 = t & 31, t1 = t >> 5;
    X1[t2 * LDX + t1] = bf2f(ucT[(size_t)c * S + t]); X2[t2 * LDX + t1] = bf2f(ucT[(size_t)(512 + c) * S + t]); ZA[t2 * LDZ + t1 + ZPAD] = bf2f(ucT[(size_t)(1024 + c) * S + t]); }
#pragma unroll 1
  for (int o = 0; o < 2; ++o) {
    const float* tp = tapsT + ((size_t)o * 512 + c) * 8192;
    for (int e = tid; e < 8192; e += 512) TAPS[e] = tp[(e + 4096) & 8191];
    __syncthreads();
    const LAS float* Zin = o == 0 ? ZA : ZB;
    const int g = w & 3, dh = w >> 2;
    const int Dlo = 32 * g - 127 + (dh ? 80 : 0), Dn = dh ? 79 : 80;
    f32x16 acc = {};
    { const LAS float* ap = TAPS + 4096 + 32 * Dlo + li - lk - 30;
      const LAS float* bp = Zin + lk * LDZ + (32 * g + li - Dlo + ZPAD);
#pragma unroll 2
      for (int dd = 0; dd < Dn; ++dd) {
#pragma unroll
        for (int kk = 0; kk < 16; ++kk) acc = __builtin_amdgcn_mfma_f32_32x32x2f32(ap[(15 - kk) * 2], bp[2 * kk * LDZ], acc, 0, 0, 0);
        ap += 32; bp -= 1; }
    }
    if (dh) {
#pragma unroll
      for (int r = 0; r < 16; ++r) RED[(g * 64 + lane) * 16 + r] = acc[r]; }
    __syncthreads();
    if (!dh) { const float inv = 1.f / nrm[o * 512 + c], sk = skip[o * 512 + c]; const LAS float* G = o == 0 ? X1 : X2; LAS float* Out = o == 0 ? ZB : ZA;
#pragma unroll
      for (int r = 0; r < 16; ++r) { const int t2 = (r & 3) + 8 * (r >> 2) + 4 * lk, t1 = 32 * g + li;
        const float cv = (acc[r] + RED[(g * 64 + lane) * 16 + r]) * inv; const float zin = Zin[t2 * LDZ + t1 + ZPAD];
        Out[t2 * LDZ + t1 + ZPAD] = G[t2 * LDX + t1] * (cv + sk * zin); } }
    __syncthreads();
  }
  for (int t = tid; t < S; t += 512) yT[(size_t)c * S + t] = (bf16_t)f2bf(ZA[(t & 31) * LDZ + (t >> 5) + ZPAD]);
  __syncthreads();
}

typedef short bf16x8v __attribute__((ext_vector_type(8)));
typedef unsigned u32x2v __attribute__((ext_vector_type(2)));
constexpr int CSB = 16448;
constexpr int ZROW = 80, ZROWS = 190;
constexpr int B_CS = 0, B_ZA = 4 * CSB, B_ZB = B_ZA + 15232, B_X1 = B_ZB + 15232, B_X2 = B_X1 + 8256, B_RED = B_X2 + 8256, B_END = B_RED + 16384;
static_assert(B_END <= 131072 && B_ZA % 16 == 0 && B_X1 % 16 == 0, "hyena bf16 lds");
__device__ __forceinline__ void h1b_unit(const bf16_t* ucT, const bf16_t* tapsB, const float* nrm, const float* skip, bf16_t* yT, int c, LAS unsigned char* lds) {
  int tid = threadIdx.x; asm volatile("" : "+v"(tid));
  const int lane = tid & 63, w = __builtin_amdgcn_readfirstlane(tid >> 6), li = lane & 31, lk = lane >> 5;
  LAS bf16_t* ZA = (LAS bf16_t*)(lds + B_ZA); LAS bf16_t* ZB = (LAS bf16_t*)(lds + B_ZB); LAS bf16_t* X1 = (LAS bf16_t*)(lds + B_X1); LAS bf16_t* X2 = (LAS bf16_t*)(lds + B_X2);
  LAS float* RED = (LAS float*)(lds + B_RED);
  for (int e = tid; e < 62 * 20; e += 512) { const int p = e / 20, d = e % 20, row = p < 31 ? p : 128 + p; ((LAS unsigned*)ZA)[row * 20 + d] = 0u; ((LAS unsigned*)ZB)[row * 20 + d] = 0u; }
  { const v4u zv = *(const v4u*)(ucT + (size_t)(1024 + c) * S + tid * 8); const int t = tid * 8; *(LAS v4u*)((LAS unsigned char*)ZA + ((t >> 5) + ZPAD) * ZROW + (t & 31) * 2) = zv; }
  { const v4u xa = *(const v4u*)(ucT + (size_t)c * S + tid * 8), xb = *(const v4u*)(ucT + (size_t)(512 + c) * S + tid * 8); const int t1 = tid >> 2, t2b = (tid & 3) * 8;
    const unsigned wa[4] = {xa.x, xa.y, xa.z, xa.w}, wb[4] = {xb.x, xb.y, xb.z, xb.w};
#pragma unroll
    for (int k = 0; k < 4; ++k) { X1[(t2b + 2 * k) * LDX + t1] = (bf16_t)(wa[k] & 0xffff); X1[(t2b + 2 * k + 1) * LDX + t1] = (bf16_t)(wa[k] >> 16);
      X2[(t2b + 2 * k) * LDX + t1] = (bf16_t)(wb[k] & 0xffff); X2[(t2b + 2 * k + 1) * LDX + t1] = (bf16_t)(wb[k] >> 16); } }
  typedef unsigned u4a __attribute__((ext_vector_type(4), aligned(4))); typedef const __attribute__((address_space(1))) u4a* gp4;
  v4u cv[9];
#pragma unroll 1
  for (int o = 0; o < 2; ++o) {
#define HTAPS_LOAD(oo) { const __attribute__((address_space(1))) unsigned char* tb = (const __attribute__((address_space(1))) unsigned char*)(tapsB + ((size_t)(oo) * 512 + c) * 2 * 8232); \
      _Pragma("unroll") for (int it = 0; it < 9; ++it) { const int e = tid + 512 * it; const int s = e / 1028, q = e % 1028; cv[it] = (v4u){0u, 0u, 0u, 0u}; if (e < 4 * 1028) cv[it] = *(gp4)(tb + (size_t)(s & 1) * 16464 + 16 * q + 4 * (s >> 1)); } }
    if (o == 0) HTAPS_LOAD(0)
    {
#pragma unroll
      for (int it = 0; it < 9; ++it) { const int e = tid + 512 * it; const int s = e / 1028, q = e % 1028; if (e < 4 * 1028) *(LAS v4u*)(lds + B_CS + s * CSB + 16 * q) = cv[it]; } }
    __syncthreads();
    if (o == 0) HTAPS_LOAD(1)
    const LAS bf16_t* Zin = o == 0 ? ZA : ZB;
    const int g = w & 3, dh = w >> 2;
    const int Dlo = 32 * g - 127 + (dh ? 81 : 0), Dn = dh ? 78 : 81;
    f32x16 acc = {};
    { const int s = (4 - (li & 3)) & 3;
      const LAS unsigned char* ap = lds + B_CS + s * CSB + 2 * (4096 - 32 * Dlo - li + 8 * lk - s);
      const LAS unsigned char* bp = (const LAS unsigned char*)Zin + (32 * g + li - Dlo + ZPAD) * ZROW + 16 * lk;
#define HLD(A0, A1, B0, B1) { const u32x2v p0_ = *(const LAS u32x2v*)(ap), p1_ = *(const LAS u32x2v*)(ap2), p2_ = *(const LAS u32x2v*)(ap3), p3_ = *(const LAS u32x2v*)(ap4); \
        A0 = (v4u){p0_.x, p0_.y, p1_.x, p1_.y}; A1 = (v4u){p2_.x, p2_.y, p3_.x, p3_.y}; B0 = *(const LAS v4u*)(bp); B1 = *(const LAS v4u*)(bp + 32); ap -= 64; ap2 -= 64; ap3 -= 64; ap4 -= 64; bp -= ZROW; }
#define HMM(A, B) acc = __builtin_amdgcn_mfma_f32_32x32x16_bf16(__builtin_bit_cast(bf16x8v, A), __builtin_bit_cast(bf16x8v, B), acc, 0, 0, 0)
#define HOPQ(name, off) unsigned name##i = (unsigned)(unsigned long long)(ap + (off)); asm volatile("" : "+v"(name##i)); const LAS unsigned char* name = (const LAS unsigned char*)(unsigned long long)name##i;
      HOPQ(ap2, 8) HOPQ(ap3, 32) HOPQ(ap4, 40)
#undef HOPQ
      v4u fa0, fa1, fb0, fb1, ga0, ga1, gb0, gb1, ha0, ha1, hb0, hb1;
      HLD(fa0, fa1, fb0, fb1)
      HLD(ga0, ga1, gb0, gb1)
      for (int dd_ = 0; dd_ < Dn - 3; dd_ += 3) {
        HLD(ha0, ha1, hb0, hb1)
        HMM(fa0, fb0); HMM(fa1, fb1);
        HLD(fa0, fa1, fb0, fb1)
        HMM(ga0, gb0); HMM(ga1, gb1);
        HLD(ga0, ga1, gb0, gb1)
        HMM(ha0, hb0); HMM(ha1, hb1);
      }
      HLD(ha0, ha1, hb0, hb1)
      HMM(fa0, fb0); HMM(fa1, fb1); HMM(ga0, gb0); HMM(ga1, gb1); HMM(ha0, hb0); HMM(ha1, hb1);
#undef HLD
#undef HMM
    }
    if (dh) {
#pragma unroll
      for (int r = 0; r < 16; ++r) RED[(g * 64 + lane) * 16 + r] = acc[r]; }
    __syncthreads();
    if (!dh) { const float inv = 1.f / nrm[o * 512 + c], sk = skip[o * 512 + c]; const LAS bf16_t* G = o == 0 ? X1 : X2; LAS bf16_t* Out = o == 0 ? ZB : ZA;
#pragma unroll
      for (int r = 0; r < 16; ++r) { const int t2 = (r & 3) + 8 * (r >> 2) + 4 * lk, t1 = 32 * g + li;
        const float cv = (acc[r] + RED[(g * 64 + lane) * 16 + r]) * inv; const float zin = bf2f(Zin[(t1 + ZPAD) * (ZROW / 2) + t2]);
        Out[(t1 + ZPAD) * (ZROW / 2) + t2] = (bf16_t)f2bf(bf2f(G[t2 * LDX + t1]) * (cv + sk * zin)); } }
    __syncthreads();
  }
  { const int t = tid * 8; *(v4u*)(yT + (size_t)c * S + t) = *(const LAS v4u*)((const LAS unsigned char*)ZA + ((t >> 5) + ZPAD) * ZROW + (t & 31) * 2); }
  __syncthreads();
}
#undef HTAPS_LOAD

constexpr int C_ZP = 15, C_ZB = 159 * ZROW  , C_CS = 0, C_Z0 = 4 * CSB, C_X0 = C_Z0 + 2 * C_ZB, C_END = C_X0 + 4 * 8256;
static_assert(C_END <= 131072 && C_Z0 % 16 == 0 && C_ZB % 16 == 0 && C_X0 % 16 == 0, "hyena two-batch lds");
__device__ __forceinline__ void h1c_unit(const bf16_t* ucT2, const bf16_t* tapsB, const float* nrm, const float* skip, bf16_t* yT2, int c, LAS unsigned char* lds) {
  int tid = threadIdx.x; asm volatile("" : "+v"(tid));
  const int lane = tid & 63, g = __builtin_amdgcn_readfirstlane(tid >> 6), li = lane & 31, lk = lane >> 5, bsel = li >> 4, t1l = li & 15;
  for (int e = tid; e < 2 * 31 * 20; e += 512) { const int b = e / (31 * 20), p = (e / 20) % 31, d = e % 20, row = p < 15 ? p : 128 + p; ((LAS unsigned*)(lds + C_Z0 + b * C_ZB))[row * 20 + d] = 0u; }
#pragma unroll
  for (int b = 0; b < 2; ++b) { const bf16_t* uc = ucT2 + (size_t)b * 1536 * S; const int t = tid * 8;
    const v4u zv = *(const v4u*)(uc + (size_t)(1024 + c) * S + t), xa = *(const v4u*)(uc + (size_t)c * S + t), xb = *(const v4u*)(uc + (size_t)(512 + c) * S + t);
    *(LAS v4u*)(lds + C_Z0 + b * C_ZB + ((t >> 5) + C_ZP) * ZROW + (t & 31) * 2) = zv;
    LAS bf16_t* X1 = (LAS bf16_t*)(lds + C_X0 + (2 * b) * 8256); LAS bf16_t* X2 = (LAS bf16_t*)(lds + C_X0 + (2 * b + 1) * 8256); const int t1 = tid >> 2, t2b = (tid & 3) * 8;
    const unsigned wa[4] = {xa.x, xa.y, xa.z, xa.w}, wb[4] = {xb.x, xb.y, xb.z, xb.w};
#pragma unroll
    for (int k = 0; k < 4; ++k) { X1[(t2b + 2 * k) * LDX + t1] = (bf16_t)(wa[k] & 0xffff); X1[(t2b + 2 * k + 1) * LDX + t1] = (bf16_t)(wa[k] >> 16);
      X2[(t2b + 2 * k) * LDX + t1] = (bf16_t)(wb[k] & 0xffff); X2[(t2b + 2 * k + 1) * LDX + t1] = (bf16_t)(wb[k] >> 16); } }
  typedef unsigned u4a __attribute__((ext_vector_type(4), aligned(4))); typedef const __attribute__((address_space(1))) u4a* gp4;
  v4u cv[9];
  LAS bf16_t* Zm = (LAS bf16_t*)(lds + C_Z0 + bsel * C_ZB);
#pragma unroll 1
  for (int o = 0; o < 2; ++o) {
#define HTAPS_LOAD(oo) { const __attribute__((address_space(1))) unsigned char* tb = (const __attribute__((address_space(1))) unsigned char*)(tapsB + ((size_t)(oo) * 512 + c) * 2 * 8232); \
      _Pragma("unroll") for (int it = 0; it < 9; ++it) { const int e = tid + 512 * it; const int s = e / 1028, q = e % 1028; cv[it] = (v4u){0u, 0u, 0u, 0u}; if (e < 4 * 1028) cv[it] = *(gp4)(tb + (size_t)(s & 1) * 16464 + 16 * q + 4 * (s >> 1)); } }
    if (o == 0) HTAPS_LOAD(0)
    {
#pragma unroll
      for (int it = 0; it < 9; ++it) { const int e = tid + 512 * it; const int s = e / 1028, q = e % 1028; if (e < 4 * 1028) *(LAS v4u*)(lds + C_CS + s * CSB + 16 * q) = cv[it]; } }
    __syncthreads();
    if (o == 0) HTAPS_LOAD(1)
    const int Dlo = 16 * g - 128; constexpr int Dn = 144;
    f32x16 acc = {};
    { const int s = (4 - (li & 3)) & 3;
      const LAS unsigned char* ap = lds + C_CS + s * CSB + 2 * (4096 - 32 * Dlo - li + 8 * lk - s);
      const LAS unsigned char* bp = (const LAS unsigned char*)Zm + (16 * g + t1l - Dlo + C_ZP) * ZROW + 16 * lk;
#define HLD(A0, A1, B0, B1) { const u32x2v p0_ = *(const LAS u32x2v*)(ap), p1_ = *(const LAS u32x2v*)(ap2), p2_ = *(const LAS u32x2v*)(ap3), p3_ = *(const LAS u32x2v*)(ap4); \
        A0 = (v4u){p0_.x, p0_.y, p1_.x, p1_.y}; A1 = (v4u){p2_.x, p2_.y, p3_.x, p3_.y}; B0 = *(const LAS v4u*)(bp); B1 = *(const LAS v4u*)(bp + 32); ap -= 64; ap2 -= 64; ap3 -= 64; ap4 -= 64; bp -= ZROW; }
#define HMM(A, B) acc = __builtin_amdgcn_mfma_f32_32x32x16_bf16(__builtin_bit_cast(bf16x8v, A), __builtin_bit_cast(bf16x8v, B), acc, 0, 0, 0)
#define HOPQ(name, off) unsigned name##i = (unsigned)(unsigned long long)(ap + (off)); asm volatile("" : "+v"(name##i)); const LAS unsigned char* name = (const LAS unsigned char*)(unsigned long long)name##i;
      HOPQ(ap2, 8) HOPQ(ap3, 32) HOPQ(ap4, 40)
#undef HOPQ
      v4u fa0, fa1, fb0, fb1, ga0, ga1, gb0, gb1, ha0, ha1, hb0, hb1;
      HLD(fa0, fa1, fb0, fb1)
      HLD(ga0, ga1, gb0, gb1)
      for (int dd_ = 0; dd_ < Dn - 3; dd_ += 3) {
        HLD(ha0, ha1, hb0, hb1)
        HMM(fa0, fb0); HMM(fa1, fb1);
        HLD(fa0, fa1, fb0, fb1)
        HMM(ga0, gb0); HMM(ga1, gb1);
        HLD(ga0, ga1, gb0, gb1)
        HMM(ha0, hb0); HMM(ha1, hb1);
      }
      HLD(ha0, ha1, hb0, hb1)
      HMM(fa0, fb0); HMM(fa1, fb1); HMM(ga0, gb0); HMM(ga1, gb1); HMM(ha0, hb0); HMM(ha1, hb1);
#undef HLD
#undef HMM
    }
    __syncthreads();
    { const float inv = 1.f / nrm[o * 512 + c], sk = skip[o * 512 + c]; const LAS bf16_t* G = (const LAS bf16_t*)(lds + C_X0 + (2 * bsel + o) * 8256);
#pragma unroll
      for (int r = 0; r < 16; ++r) { const int t2 = (r & 3) + 8 * (r >> 2) + 4 * lk, t1 = 16 * g + t1l;
        const float cvv = acc[r] * inv; const float zin = bf2f(Zm[(t1 + C_ZP) * (ZROW / 2) + t2]);
        Zm[(t1 + C_ZP) * (ZROW / 2) + t2] = (bf16_t)f2bf(bf2f(G[t2 * LDX + t1]) * (cvv + sk * zin)); } }
    __syncthreads();
  }
#pragma unroll
  for (int b = 0; b < 2; ++b) { const int t = tid * 8; *(v4u*)(yT2 + (size_t)b * 512 * S + (size_t)c * S + t) = *(const LAS v4u*)(lds + C_Z0 + b * C_ZB + ((t >> 5) + C_ZP) * ZROW + (t & 31) * 2); }
  __syncthreads();
#undef HTAPS_LOAD
}
__device__ __forceinline__ void cconv3_item(const bf16_t* u, int ld, const float* cw, const float* cb, float* ucc, long idx) {
  const int j = (int)(idx % 1536); const int tc = (int)(idx / 1536);
  const bf16_t* up = u + (size_t)tc * ld + j;
  float v = cb[j] + cw[1536 + j] * bf2f(up[0]);
  if (tc > 0) v += cw[j] * bf2f(*(up - ld)); if (tc < 255) v += cw[2 * 1536 + j] * bf2f(up[ld]);
  ucc[idx] = v;
}
__device__ __forceinline__ void clong_item(const float* ucc, const float* z1c_in, float* z1c_out, bf16_t* yout, int ldy, const float* tapsC, const float* nrmC, const float* skip, int o, long idx) {
  const int c = (int)(idx % 512), t0 = (int)(idx / 512) * 8; constexpr int n = 256;
  const float* tp = tapsC + (size_t)o * 2 * n * 512 + c; const float nr = nrmC[o * 512 + c];
  const float* zs = o == 0 ? ucc + 1024 + c : z1c_in + c; const int ldz = o == 0 ? 1536 : 512;
  float acc[8], w[8];
#pragma unroll
  for (int i = 0; i < 8; ++i) { acc[i] = 0.f; const int lag = t0 + i; w[i] = tp[(size_t)lag * 512]; }
#pragma unroll 4
  for (int s = 0; s < n; ++s) { const float zv = zs[(size_t)s * ldz];
#pragma unroll
    for (int i = 0; i < 8; ++i) acc[i] += w[i] * zv;
    const int lag = t0 - s - 1;
    const float nw = tp[(size_t)(lag >= 0 ? lag : 2 * n + lag) * 512];
#pragma unroll
    for (int i = 7; i > 0; --i) w[i] = w[i - 1];
    w[0] = nw; }
  const float sk = skip[o * 512 + c];
#pragma unroll
  for (int i = 0; i < 8; ++i) { const int t = t0 + i; const float val = ucc[(size_t)t * 1536 + o * 512 + c] * (acc[i] / nr + sk * zs[(size_t)t * ldz]);
    if (o == 0) z1c_out[(size_t)t * 512 + c] = val; else yout[(size_t)t * ldy + c] = (bf16_t)f2bf(val); }
}
}
#define XB_TMO      128
#define XB_XCNT(j)  (256  + 64 * (j))
#define XB_XSUB(j)  (1280 + 64 * (j))
#define XB_XGEN(j)  (2304 + 64 * (j))
#define XB_TOP      3328
#define XB_TOPGEN   3392
#define XCD_BAR_WORDS 3456
#define XB_SPIN_CAP (1u << 18)

__device__ __forceinline__ unsigned xb_ld(unsigned* p)              { return __hip_atomic_load(p, __ATOMIC_RELAXED, __HIP_MEMORY_SCOPE_AGENT); }
__device__ __forceinline__ unsigned xb_add(unsigned* p, unsigned v) { return __hip_atomic_fetch_add(p, v, __ATOMIC_RELAXED, __HIP_MEMORY_SCOPE_AGENT); }
__device__ __forceinline__ unsigned xb_xcc_id() { return (unsigned)__builtin_amdgcn_s_getreg((3 << 11) | 20) & 0xFu; }
#define XB_SPIN(cond, bar) do { unsigned _sp = 0; while (cond) { __builtin_amdgcn_s_sleep(1); \
    if ((++_sp & 255u) == 0u) { if (xb_ld(&(bar)[XB_TMO])) break; if (_sp > XB_SPIN_CAP) { atomicAdd(&(bar)[XB_TMO], 1u); break; } } } } while (0)

struct XcdBarrier {
    unsigned* bar; unsigned x;
    volatile LAS unsigned* st;
};

__device__ __forceinline__ XcdBarrier xcd_barrier_post(unsigned* bar, volatile LAS unsigned* st) {
    XcdBarrier b; b.bar = bar; b.x = xb_xcc_id(); b.st = st;
    if (threadIdx.x == 0) (void)xb_add(&bar[XB_XCNT(b.x)], 1u);
    return b;
}
__device__ __forceinline__ void xcd_barrier_complete(unsigned* bar, unsigned x, unsigned& nloc, unsigned& nx) {
    const unsigned G = gridDim.x * gridDim.y * gridDim.z;
    unsigned sum, cnt, mine, sp = 0u;
    for (;;) {
        sum = 0u; cnt = 0u; mine = 0u;
#pragma unroll
        for (unsigned j = 0; j < 16; ++j) { const unsigned c = xb_ld(&bar[XB_XCNT(j)]); sum += c; cnt += (c > 0u) ? 1u : 0u; mine = (j == x) ? c : mine; }
        if (sum == G) break;
        __builtin_amdgcn_s_sleep(1);
        if ((++sp & 255u) == 0u) { if (xb_ld(&bar[XB_TMO])) break; if (sp > XB_SPIN_CAP) { atomicAdd(&bar[XB_TMO], 1u); break; } }
    }
    nloc = mine > 0u ? mine : 1u; nx = cnt > 0u ? cnt : 1u;
}

__device__ __forceinline__ void xcd_barrier(const XcdBarrier& b) {
    asm volatile("s_waitcnt vmcnt(0)" ::: "memory");
    __syncthreads();
    if (threadIdx.x == 0) {
        unsigned* bar = b.bar;
#define XB_SP(word) ((unsigned*)((((unsigned long long)(unsigned)__builtin_amdgcn_readfirstlane((int)((unsigned long long)(bar + (word)) >> 32))) << 32) | (unsigned)__builtin_amdgcn_readfirstlane((int)(unsigned)(unsigned long long)(bar + (word)))))
        unsigned* const p_xsub = XB_SP(XB_XSUB(b.x)); unsigned* const p_xgen = XB_SP(XB_XGEN(b.x));
        __builtin_amdgcn_s_waitcnt(0);
        unsigned nloc = b.st[0], nx = b.st[1];
        if (nloc == 0u) { xcd_barrier_complete(bar, b.x, nloc, nx); b.st[0] = nloc; b.st[1] = nx; }
        const unsigned old = xb_add(p_xsub, 1u);
        const unsigned gen = old / nloc;
        if (old + 1u == (gen + 1u) * nloc) {
            __builtin_amdgcn_fence(__ATOMIC_RELEASE, "agent");
            asm volatile("s_waitcnt vmcnt(0)" ::: "memory");
            const unsigned og = xb_add(&bar[XB_TOP], 1u);
            const unsigned tg = og / nx;
            if (og + 1u == (tg + 1u) * nx) xb_add(&bar[XB_TOPGEN], 1u);
            else XB_SPIN(xb_ld(&bar[XB_TOPGEN]) == tg, bar);
            __builtin_amdgcn_fence(__ATOMIC_ACQUIRE, "agent");
            xb_add(p_xgen, 1u);
            asm volatile("s_waitcnt vmcnt(0)" ::: "memory");
        } else {
            XB_SPIN(xb_ld(p_xgen) == gen, bar);
            __builtin_amdgcn_fence(__ATOMIC_ACQUIRE, "agent");
            asm volatile("s_waitcnt vmcnt(0)" ::: "memory");
        }
    }
    __syncthreads();
}
#include <math.h>
#ifdef HOST_TEST
#define HD
#define FEXP expf
#define FSIN sinf
#define FCOS cosf
#define FLOG logf
#define FPOW powf
#else
#define HD __device__ __forceinline__
#define FEXP __expf
#define FSIN __sinf
#define FCOS __cosf
#define FLOG __logf
#define FPOW __powf
#endif

struct FullDims { static constexpr int D=1024,B=8,S=4096,DEPTH=2,C=256,GW=64,AH=8,AKV=2,HDM=128,GH=4,GDK=64,GDV=128,GR=16,HW=512,HB=16,HF=64,NE=16,NG=4,DE=512; };
struct SmallDims { static constexpr int D=64,B=2,S=128,DEPTH=2,C=32,GW=16,AH=4,AKV=2,HDM=16,GH=2,GDK=8,GDV=16,GR=4,HW=32,HB=4,HF=8,NE=8,NG=2,DE=32; };

template <class T> struct DD {
  static constexpr int D=T::D,B=T::B,S=T::S,DEPTH=T::DEPTH,C=T::C,GW=T::GW,AH=T::AH,AKV=T::AKV,HDM=T::HDM,GH=T::GH,GDK=T::GDK,GDV=T::GDV,GR=T::GR,HW=T::HW,HB=T::HB,HF=T::HF,NE=T::NE,NG=T::NG,DE=T::DE;
  static constexpr int R=S+C, AG=AH/AKV, RP=HDM/4, HE=1+2*HB, EPG=NE/NG, AQW=AH*HDM, AKVW=AKV*HDM, GKW=GH*GDK, GVW=GH*GDV;
  static constexpr int NKV=AKVW+AKVW+GKW+GVW+2*GR, NIN=NKV+AQW+GKW+GVW+3*HW+3*D;
  static constexpr int O_AK=0, O_AV=AKVW, O_GK=2*AKVW, O_GV=2*AKVW+GKW, O_GA=2*AKVW+GKW+GVW;
  static constexpr int O_AQ=NKV, O_GQ=NKV+AQW, O_OG=O_GQ+GKW, O_HY=O_OG+GVW, O_BR=O_HY+3*HW;
};

struct NaiveBufs {
  const float *x,*c,*ctx,*c_ctx,*w_mod,*b_mod,*norm1_g,*norm2_g,*w_in,*q_norm_g,*k_norm_g,*gla_wa2,*gla_ba,*gla_norm_g,*hy_conv_w,*hy_conv_b,
    *hy_pos_w1,*hy_pos_b1,*hy_sin_freq,*hy_pos_w2,*hy_pos_b2,*hy_pos_w3,*hy_decay,*hy_skip,*w_br_hy,*w_br_gla,*w_br_att,*w_out,*router_w,*router_b,*moe_w_gate,*moe_w_up,*moe_w_down;
  float* out;
  float *mod;
  float *hid2S,*hid2C;
  float *tapsS,*tapsC;
  float *nrmS,*nrmC;
  float *rs;
  float *h;
  float *proj;
  float *qn,*kn;
  float *yatt;
  float *laf,*lab;
  float *of,*ob;
  float *ygla;
  float *uc;
  float *z1,*yhy;
  float *m;
  int   *ridx;
  float *rw;
  float *hid;
  float *xc;
};

HD float sigmoidf_(float x) { return 1.f / (1.f + FEXP(-x)); }
HD float siluf_(float x) { return x / (1.f + FEXP(-x)); }
HD float logsigmoidf_(float x) { return x < 0.f ? x - FLOG(1.f + FEXP(x)) : -FLOG(1.f + FEXP(-x)); }

template <class T> HD void st_mod(const NaiveBufs& a, int l, long idx) {
  using d = DD<T>; const int j = (int)(idx % (6 * d::D)), bb = (int)(idx / (6 * d::D));
  const float* cv = bb < d::B ? a.c + (long)bb * d::D : a.c_ctx; const float* w = a.w_mod + (long)l * d::D * 6 * d::D;
  float acc = a.b_mod[(long)l * 6 * d::D + j];
  for (int k = 0; k < d::D; ++k) acc += siluf_(cv[k]) * w[(long)k * 6 * d::D + j];
  a.mod[idx] = acc;
}
template <class T> HD void st_hyhid(const NaiveBufs& a, int l, int which, long idx) {
  using d = DD<T>; const int n = which ? d::C : d::S; float* dst = which ? a.hid2C : a.hid2S;
  const int j = (int)(idx % d::HF), t = (int)(idx / d::HF);
  const float* w1 = a.hy_pos_w1 + (long)l * d::HE * d::HF; const float* b1 = a.hy_pos_b1 + l * d::HF; const float* fr = a.hy_sin_freq + l * d::HF;
  const float* w2 = a.hy_pos_w2 + (long)l * d::HF * d::HF; const float* b2 = a.hy_pos_b2 + l * d::HF;
  const float tn = (float)t / (float)n; const float w0 = 2.f * 3.14159265358979323846f / (float)n;
  float acc2 = b2[j];
  for (int i = 0; i < d::HF; ++i) {
    float acc = b1[i] + tn * w1[0 * d::HF + i];
    for (int bnd = 0; bnd < d::HB; ++bnd) {
      const float band = 1e-4f + (float)bnd * ((float)(d::HB - 1) - 1e-4f) / (float)(d::HB - 1);
      const float ph = w0 * (float)t * band;
      acc += FCOS(ph) * w1[(1 + bnd) * d::HF + i] - FSIN(ph) * w1[(1 + d::HB + bnd) * d::HF + i];
    }
    acc2 += FSIN(fr[i] * acc) * w2[i * d::HF + j];
  }
  dst[idx] = FSIN(fr[j] * acc2);
}
template <class T> HD void st_hytaps(const NaiveBufs& a, int l, int which, long idx) {
  using d = DD<T>; const int n = which ? d::C : d::S; const float* hid2 = which ? a.hid2C : a.hid2S; float* dst = which ? a.tapsC : a.tapsS;
  const int c = (int)(idx % d::HW); const int li = (int)((idx / d::HW) % (2 * n)); const int o = (int)(idx / ((long)d::HW * 2 * n));
  float v = 0.f;
  if (li != n) {
    const int dir = li < n ? 0 : 1; const int t = li < n ? li : 2 * n - li;
    const int col = (o * 2 + dir) * d::HW + c;
    const float* w3 = a.hy_pos_w3 + (long)l * d::HF * 4 * d::HW;
    float acc = 0.f;
    for (int j = 0; j < d::HF; ++j) acc += hid2[(long)t * d::HF + j] * w3[(long)j * 4 * d::HW + col];
    const float dec = fabsf(a.hy_decay[(long)l * 4 * d::HW + col]);
    v = acc * FEXP(-((float)t / (float)n) * dec);
  }
  if (which == 0) dst[((long)o * d::HW + c) * 2 * n + li] = v; else dst[idx] = v;
}
template <class T> HD void st_hynorm(const NaiveBufs& a, int which, long idx) {
  using d = DD<T>; const int n = which ? d::C : d::S; const float* tp = which ? a.tapsC : a.tapsS; float* dst = which ? a.nrmC : a.nrmS;
  const int c = (int)(idx % d::HW), o = (int)(idx / d::HW);
  float s = 0.f; for (int li = 0; li < 2 * n; ++li) s += fabsf(which == 0 ? tp[((long)o * d::HW + c) * 2 * n + li] : tp[((long)o * 2 * n + li) * d::HW + c]);
  dst[idx] = s + 1e-6f;
}

template <class T> HD const float* xrow(const NaiveBufs& a, int l, int b, int r) {
  using d = DD<T>;
  if (r < d::S) return (l == 0 ? a.x : a.out) + ((long)b * d::S + r) * d::D;
  return (l == 0 ? a.ctx : a.xc) + ((long)b * d::C + (r - d::S)) * d::D;
}
template <class T> HD float* xrow_w(const NaiveBufs& a, int b, int r) {
  using d = DD<T>;
  if (r < d::S) return a.out + ((long)b * d::S + r) * d::D;
  return a.xc + ((long)b * d::C + (r - d::S)) * d::D;
}
template <class T> HD void st_rs(const NaiveBufs& a, int l, int b, int src, long idx) {
  using d = DD<T>; const int r = (int)idx; const float* xr = src ? (const float*)xrow_w<T>(a, b, r) : xrow<T>(a, l, b, r);
  float s = 0.f; for (int k = 0; k < d::D; ++k) s += xr[k] * xr[k];
  a.rs[r] = 1.f / sqrtf(s / (float)d::D + 1e-6f);
}
template <class T> HD void st_norm(const NaiveBufs& a, int l, int b, int which, long idx) {
  using d = DD<T>; const int j = (int)(idx % d::D), r = (int)(idx / d::D);
  const float* xr = which ? (const float*)xrow_w<T>(a, b, r) : xrow<T>(a, l, b, r);
  const float* g = (which ? a.norm2_g : a.norm1_g) + (long)l * d::D;
  const float* md = a.mod + (long)(r < d::S ? b : d::B) * 6 * d::D;
  const float shift = md[(which ? 3 : 0) * d::D + j], scale = md[(which ? 4 : 1) * d::D + j];
  a.h[idx] = xr[j] * a.rs[r] * g[j] * (1.f + scale) + shift;
}
struct GemmArgs { const float* A; int lda; const float* W; int ldw; float* Cc; int ldc; int M, N, K;
  const float* gate; int ldg;
  const float* colscale;
  const float* res; int ldr;
  int accumulate; };
HD void st_gemm(const GemmArgs& g, long idx) {
  const int nb = g.N / 4; const int cb = (int)(idx % nb), rb = (int)(idx / nb);
  float acc[4][4];
#pragma unroll
  for (int i = 0; i < 4; ++i) {
#pragma unroll
    for (int j = 0; j < 4; ++j) acc[i][j] = 0.f; }
  const float* a0 = g.A + (long)(rb * 4) * g.lda; const float* w0 = g.W + cb * 4;
  for (int k = 0; k < g.K; ++k) {
    float av[4], wv[4];
#pragma unroll
    for (int i = 0; i < 4; ++i) av[i] = a0[(long)i * g.lda + k];
#pragma unroll
    for (int j = 0; j < 4; ++j) wv[j] = w0[(long)k * g.ldw + j];
#pragma unroll
    for (int i = 0; i < 4; ++i) {
#pragma unroll
      for (int j = 0; j < 4; ++j) acc[i][j] += av[i] * wv[j]; }
  }
#pragma unroll
  for (int i = 0; i < 4; ++i)
#pragma unroll
  for (int j = 0; j < 4; ++j) {
    const int r = rb * 4 + i, c = cb * 4 + j; float v = acc[i][j];
    if (g.gate) v *= sigmoidf_(g.gate[(long)r * g.ldg + c]);
    if (g.colscale) v *= g.colscale[c];
    if (g.res) v += g.res[(long)r * g.ldr + c];
    float* p = g.Cc + (long)r * g.ldc + c;
    if (g.accumulate) v += *p;
    *p = v;
  }
}
template <class T> HD void st_qknorm(const NaiveBufs& a, int l, long idx) {
  using d = DD<T>; const int hh = (int)(idx % (d::AH + d::AKV)), r = (int)(idx / (d::AH + d::AKV));
  const bool isq = hh < d::AH; const int hd = isq ? hh : hh - d::AH;
  const float* src = a.proj + (long)r * d::NIN + (isq ? d::O_AQ : d::O_AK) + hd * d::HDM;
  float* dst = (isq ? a.qn + (long)r * d::AQW : a.kn + (long)r * d::AKVW) + hd * d::HDM;
  const float* g = (isq ? a.q_norm_g : a.k_norm_g) + (long)l * d::HDM;
  float s = 0.f; for (int k = 0; k < d::HDM; ++k) s += src[k] * src[k];
  const float rsq = 1.f / sqrtf(s / (float)d::HDM + 1e-6f);
  if (r < d::S) {
    const int row = r / d::GW, col = r % d::GW;
    for (int p = 0; p < d::HDM / 2; ++p) {
      const int fi = p < d::RP ? p : p - d::RP; const float pos = p < d::RP ? (float)row : (float)col;
      const float inv = FPOW(10000.f, -(float)fi / (float)d::RP); const float ang = pos * inv;
      const float cs = FCOS(ang), sn = FSIN(ang);
      const float x1 = src[2 * p] * rsq * g[2 * p], x2 = src[2 * p + 1] * rsq * g[2 * p + 1];
      dst[2 * p] = x1 * cs - x2 * sn; dst[2 * p + 1] = x1 * sn + x2 * cs;
    }
  } else { for (int k = 0; k < d::HDM; ++k) dst[k] = src[k] * rsq * g[k]; }
}
template <class T, int NSPLIT> HD void st_attn(const NaiveBufs& a, int r0, int nrows, long idx) {
  using d = DD<T>; constexpr int OD = d::HDM / NSPLIT;
  const int r = r0 + (int)(idx % nrows); const int hs = (int)(idx / nrows); const int part = hs % NSPLIT, hq = hs / NSPLIT; const int kv = hq / d::AG;
  const int k0 = r < d::S ? 0 : d::S, k1 = d::R;
  float q[d::HDM], o[OD];
  const float scale = 1.f / sqrtf((float)d::HDM);
#pragma unroll
  for (int k = 0; k < d::HDM; ++k) q[k] = a.qn[(long)r * d::AQW + hq * d::HDM + k] * scale;
#pragma unroll
  for (int k = 0; k < OD; ++k) o[k] = 0.f;
  float mx = -1e30f, lsum = 0.f;
  for (int kk = k0; kk < k1; ++kk) {
    const float* kr = a.kn + (long)kk * d::AKVW + kv * d::HDM;
    float s = 0.f;
#pragma unroll
    for (int k = 0; k < d::HDM; ++k) s += q[k] * kr[k];
    if (s > mx) { const float cr = FEXP(mx - s); lsum *= cr;
#pragma unroll
      for (int k = 0; k < OD; ++k) o[k] *= cr;
      mx = s; }
    const float p = FEXP(s - mx); lsum += p;
    const float* vr = a.proj + (long)kk * d::NIN + d::O_AV + kv * d::HDM + part * OD;
#pragma unroll
    for (int k = 0; k < OD; ++k) o[k] += p * vr[k];
  }
  const float inv = 1.f / lsum;
#pragma unroll
  for (int k = 0; k < OD; ++k) a.yatt[(long)r * d::AQW + hq * d::HDM + part * OD + k] = o[k] * inv;
}
template <class T> HD void st_glala(const NaiveBufs& a, int l, long idx) {
  using d = DD<T>; const int j = (int)(idx % d::GKW); const int dir = (int)((idx / d::GKW) % 2); const int r = (int)(idx / (2 * d::GKW));
  const float* al = a.proj + (long)r * d::NIN + d::O_GA + dir * d::GR;
  const float* w2 = a.gla_wa2 + ((long)l * 2 + dir) * d::GR * d::GKW; float z = a.gla_ba[((long)l * 2 + dir) * d::GKW + j];
  for (int k = 0; k < d::GR; ++k) z += al[k] * w2[(long)k * d::GKW + j];
  (dir ? a.lab : a.laf)[(long)r * d::GKW + j] = FEXP(logsigmoidf_(z) / 16.f);
}
template <class T> HD void st_glascan(const NaiveBufs& a, long idx) {
  using d = DD<T>; const int v = (int)(idx % d::GDV); const int hd = (int)((idx / d::GDV) % d::GH); const int dir = (int)(idx / (d::GDV * d::GH));
  float st[d::GDK];
#pragma unroll
  for (int k = 0; k < d::GDK; ++k) st[k] = 0.f;
  const float qs = 1.f / sqrtf((float)d::GDK);
  const float* la = dir ? a.lab : a.laf; float* od = dir ? a.ob : a.of;
  for (int step = 0; step < d::R; ++step) {
    int r;
    if (step < d::C) r = d::S + (dir ? d::C - 1 - step : step); else r = dir ? d::S - 1 - (step - d::C) : step - d::C;
    const float* pr = a.proj + (long)r * d::NIN;
    const float vv = pr[d::O_GV + hd * d::GDV + v];
    float o = 0.f;
#pragma unroll
    for (int k = 0; k < d::GDK; ++k) {
      st[k] = la[(long)r * d::GKW + hd * d::GDK + k] * st[k] + pr[d::O_GK + hd * d::GDK + k] * vv;
      o += pr[d::O_GQ + hd * d::GDK + k] * qs * st[k];
    }
    od[(long)r * d::GVW + hd * d::GDV + v] = o;
  }
}
template <class T> HD void st_glaout(const NaiveBufs& a, int l, long idx) {
  using d = DD<T>; const int hd = (int)(idx % d::GH), r = (int)(idx / d::GH);
  const long base = (long)r * d::GVW + hd * d::GDV; float s = 0.f;
  for (int v = 0; v < d::GDV; ++v) { const float o = a.of[base + v] + a.ob[base + v]; s += o * o; }
  const float rsq = 1.f / sqrtf(s / (float)d::GDV + 1e-6f);
  for (int v = 0; v < d::GDV; ++v) { const float o = a.of[base + v] + a.ob[base + v];
    a.ygla[base + v] = o * rsq * a.gla_norm_g[(long)l * d::GDV + v] * siluf_(a.proj[(long)r * d::NIN + d::O_OG + hd * d::GDV + v]); }
}
template <class T> HD void st_hyconv3(const NaiveBufs& a, int l, long idx) {
  using d = DD<T>; const int j = (int)(idx % (3 * d::HW)), r = (int)(idx / (3 * d::HW));
  const int lo = r < d::S ? 0 : d::S, hi = r < d::S ? d::S : d::R;
  const float* w = a.hy_conv_w + (long)l * 3 * 3 * d::HW;
  float v = a.hy_conv_b[(long)l * 3 * d::HW + j] + a.proj[(long)r * d::NIN + d::O_HY + j] * w[1 * 3 * d::HW + j];
  if (r - 1 >= lo) v += a.proj[(long)(r - 1) * d::NIN + d::O_HY + j] * w[0 * 3 * d::HW + j];
  if (r + 1 < hi) v += a.proj[(long)(r + 1) * d::NIN + d::O_HY + j] * w[2 * 3 * d::HW + j];
  a.uc[idx] = v;
}
template <class T> HD void st_hylong(const NaiveBufs& a, int l, int o, long idx) {
  using d = DD<T>; const int c = (int)(idx % d::HW); const int rb = (int)(idx / d::HW); const int r0 = rb * 4;
  const bool lat = r0 < d::S; const int n = lat ? d::S : d::C; const int base = lat ? 0 : d::S; const int t0 = r0 - base;
  const float* tp = (lat ? a.tapsS : a.tapsC) + (long)o * 2 * n * d::HW + c; const float nr = (lat ? a.nrmS : a.nrmC)[o * d::HW + c];
  const float* zs = o == 0 ? a.uc + 2 * d::HW + c : a.z1 + c; const int ldz = o == 0 ? 3 * d::HW : d::HW;
  float acc0 = 0.f, acc1 = 0.f, acc2 = 0.f, acc3 = 0.f;
  auto tap = [&](int lag) { const int li = lag >= 0 ? lag : 2 * n + lag; return tp[(long)li * d::HW]; };
  float w0 = tap(t0), w1 = tap(t0 + 1), w2 = tap(t0 + 2), w3 = tap(t0 + 3);
  for (int s = 0; s < n; ++s) {
    const float zv = zs[(long)(base + s) * ldz];
    acc0 += w0 * zv; acc1 += w1 * zv; acc2 += w2 * zv; acc3 += w3 * zv;
    w3 = w2; w2 = w1; w1 = w0; w0 = (s + 1 < n) ? tap(t0 - s - 1) : 0.f;
  }
  const float sk = a.hy_skip[((long)l * 2 + o) * d::HW + c];
  float* dst = o == 0 ? a.z1 : a.yhy;
  const float accs[4] = {acc0, acc1, acc2, acc3};
#pragma unroll
  for (int i = 0; i < 4; ++i) { const int r = r0 + i; const float zr = zs[(long)r * ldz];
    dst[(long)r * d::HW + c] = a.uc[(long)r * 3 * d::HW + o * d::HW + c] * (accs[i] / nr + sk * zr); }
}
template <class T> HD void st_router(const NaiveBufs& a, long idx) {
  using d = DD<T>; const int r = (int)idx; const float* hr = a.h + (long)r * d::D;
  float sc[d::NE], sel[d::NE];
#pragma unroll
  for (int e = 0; e < d::NE; ++e) sc[e] = 0.f;
  for (int k = 0; k < d::D; ++k) { const float hv = hr[k];
#pragma unroll
    for (int e = 0; e < d::NE; ++e) sc[e] += hv * a.router_w[(long)k * d::NE + e]; }
#pragma unroll
  for (int e = 0; e < d::NE; ++e) { sc[e] = sigmoidf_(sc[e]); sel[e] = sc[e] + a.router_b[e]; }
  int bestg = 0; float bestgs = -1e30f;
#pragma unroll
  for (int g = 0; g < d::NG; ++g) { float m1 = -1e30f, m2 = -1e30f;
#pragma unroll
    for (int i = 0; i < d::EPG; ++i) { const float v = sel[g * d::EPG + i]; if (v > m1) { m2 = m1; m1 = v; } else if (v > m2) m2 = v; }
    const float gs = m1 + m2; if (gs > bestgs) { bestgs = gs; bestg = g; } }
  int i1 = -1, i2 = -1; float v1 = -1e30f, v2 = -1e30f, s1 = 0.f, s2 = 0.f;
#pragma unroll
  for (int e = 0; e < d::NE; ++e) { if (e / d::EPG == bestg) { const float v = sel[e];
      if (v > v1) { v2 = v1; i2 = i1; s2 = s1; v1 = v; i1 = e; s1 = sc[e]; } else if (v > v2) { v2 = v; i2 = e; s2 = sc[e]; } } }
  const float inv = 1.f / (s1 + s2);
  a.ridx[2 * r] = i1; a.ridx[2 * r + 1] = i2; a.rw[2 * r] = s1 * inv; a.rw[2 * r + 1] = s2 * inv;
}
template <class T> HD void st_moehid(const NaiveBufs& a, int l, long idx) {
  using d = DD<T>; const int j = (int)(idx % d::DE); const int k = (int)((idx / d::DE) % 2); const int r = (int)(idx / (2 * d::DE));
  const int e = a.ridx[2 * r + k]; const float* hr = a.h + (long)r * d::D;
  const float* wg = a.moe_w_gate + (((long)l * d::NE + e) * d::D) * d::DE + j; const float* wu = a.moe_w_up + (((long)l * d::NE + e) * d::D) * d::DE + j;
  float g = 0.f, u = 0.f;
  for (int i = 0; i < d::D; ++i) { const float hv = hr[i]; g += hv * wg[(long)i * d::DE]; u += hv * wu[(long)i * d::DE]; }
  a.hid[idx] = siluf_(g) * u;
}
template <class T> HD void st_moeout(const NaiveBufs& a, int l, int b, long idx) {
  using d = DD<T>; const int dd = (int)(idx % d::D), r = (int)(idx / d::D);
  float acc = 0.f;
  for (int k = 0; k < 2; ++k) { const int e = a.ridx[2 * r + k]; const float* hk = a.hid + ((long)r * 2 + k) * d::DE;
    const float* wd = a.moe_w_down + (((long)l * d::NE + e) * d::DE) * d::D + dd; float s = 0.f;
    for (int j = 0; j < d::DE; ++j) s += hk[j] * wd[(long)j * d::D];
    acc += a.rw[2 * r + k] * s; }
  const float g2 = a.mod[(long)(r < d::S ? b : d::B) * 6 * d::D + 5 * d::D + dd];
  float* xr = xrow_w<T>(a, b, r); xr[dd] += g2 * acc;
}
enum { L_MOD = 0, L_HID_S, L_HID_C, L_TAPS_S, L_TAPS_C, L_NRM_S, L_NRM_C, N_LSTAGES,
       P_RS1 = 16, P_NORM1, P_INPROJ, P_QKNORM, P_ATTN_L, P_ATTN_C, P_GLALA, P_GLASCAN, P_GLAOUT, P_HYC3, P_HYL0, P_HYL1,
       P_MRG_HY, P_MRG_GLA, P_MRG_ATT, P_OUT_L, P_OUT_C, P_RS2, P_NORM2, P_ROUTER, P_MOEHID, P_MOEOUT, P_END };
constexpr int ATT_NSPLIT = 4;

template <class T> HD long stage_items(int st, int l) {
  using d = DD<T>; const bool last = (l == d::DEPTH - 1);
  switch (st) {
    case L_MOD: return (long)(d::B + 1) * 6 * d::D;
    case L_HID_S: return (long)d::S * d::HF;
    case L_HID_C: return (long)d::C * d::HF;
    case L_TAPS_S: return 2L * 2 * d::S * d::HW;
    case L_TAPS_C: return 2L * 2 * d::C * d::HW;
    case L_NRM_S: case L_NRM_C: return 2L * d::HW;
    case P_RS1: case P_RS2: case P_ROUTER: return d::R;
    case P_NORM1: case P_NORM2: return (long)d::R * d::D;
    case P_INPROJ: return (long)(d::R / 4) * (d::NIN / 4);
    case P_QKNORM: return (long)d::R * (d::AH + d::AKV);
    case P_ATTN_L: return (long)d::S * d::AH * ATT_NSPLIT;
    case P_ATTN_C: return last ? 0 : (long)d::C * d::AH * ATT_NSPLIT;
    case P_GLALA: return (long)d::R * 2 * d::GKW;
    case P_GLASCAN: return 2L * d::GH * d::GDV;
    case P_GLAOUT: return (long)d::R * d::GH;
    case P_HYC3: return (long)d::R * 3 * d::HW;
    case P_HYL0: case P_HYL1: return (long)(d::R / 4) * d::HW;
    case P_MRG_HY: case P_MRG_GLA: case P_MRG_ATT: return (long)(d::R / 4) * (d::D / 4);
    case P_OUT_L: return (long)(d::S / 4) * (d::D / 4);
    case P_OUT_C: return last ? 0 : (long)(d::C / 4) * (d::D / 4);
    case P_MOEHID: return (long)d::R * 2 * d::DE;
    case P_MOEOUT: return (long)(last ? d::S : d::R) * d::D;
  }
  return 0;
}

template <class T, int ST> HD void stage_run(const NaiveBufs& a, int l, int b, long idx) {
  using d = DD<T>;
  if constexpr (ST == L_MOD) st_mod<T>(a, l, idx);
  else if constexpr (ST == L_HID_S) st_hyhid<T>(a, l, 0, idx);
  else if constexpr (ST == L_HID_C) st_hyhid<T>(a, l, 1, idx);
  else if constexpr (ST == L_TAPS_S) st_hytaps<T>(a, l, 0, idx);
  else if constexpr (ST == L_TAPS_C) st_hytaps<T>(a, l, 1, idx);
  else if constexpr (ST == L_NRM_S) st_hynorm<T>(a, 0, idx);
  else if constexpr (ST == L_NRM_C) st_hynorm<T>(a, 1, idx);
  else if constexpr (ST == P_RS1) st_rs<T>(a, l, b, 0, idx);
  else if constexpr (ST == P_RS2) st_rs<T>(a, l, b, 1, idx);
  else if constexpr (ST == P_NORM1) st_norm<T>(a, l, b, 0, idx);
  else if constexpr (ST == P_NORM2) st_norm<T>(a, l, b, 1, idx);
  else if constexpr (ST == P_INPROJ) { GemmArgs g{a.h, d::D, a.w_in + (long)l * d::D * d::NIN, d::NIN, a.proj, d::NIN, d::R, d::NIN, d::D, nullptr, 0, nullptr, nullptr, 0, 0}; st_gemm(g, idx); }
  else if constexpr (ST == P_QKNORM) st_qknorm<T>(a, l, idx);
  else if constexpr (ST == P_ATTN_L) st_attn<T, ATT_NSPLIT>(a, 0, d::S, idx);
  else if constexpr (ST == P_ATTN_C) st_attn<T, ATT_NSPLIT>(a, d::S, d::C, idx);
  else if constexpr (ST == P_GLALA) st_glala<T>(a, l, idx);
  else if constexpr (ST == P_GLASCAN) st_glascan<T>(a, idx);
  else if constexpr (ST == P_GLAOUT) st_glaout<T>(a, l, idx);
  else if constexpr (ST == P_HYC3) st_hyconv3<T>(a, l, idx);
  else if constexpr (ST == P_HYL0) st_hylong<T>(a, l, 0, idx);
  else if constexpr (ST == P_HYL1) st_hylong<T>(a, l, 1, idx);
  else if constexpr (ST == P_MRG_HY) { GemmArgs g{a.yhy, d::HW, a.w_br_hy + (long)l * d::HW * d::D, d::D, a.m, d::D, d::R, d::D, d::HW, a.proj + d::O_BR, d::NIN, nullptr, nullptr, 0, 0}; st_gemm(g, idx); }
  else if constexpr (ST == P_MRG_GLA) { GemmArgs g{a.ygla, d::GVW, a.w_br_gla + (long)l * d::GVW * d::D, d::D, a.m, d::D, d::R, d::D, d::GVW, a.proj + d::O_BR + d::D, d::NIN, nullptr, nullptr, 0, 1}; st_gemm(g, idx); }
  else if constexpr (ST == P_MRG_ATT) { GemmArgs g{a.yatt, d::AQW, a.w_br_att + (long)l * d::AQW * d::D, d::D, a.m, d::D, d::R, d::D, d::AQW, a.proj + d::O_BR + 2 * d::D, d::NIN, nullptr, nullptr, 0, 1}; st_gemm(g, idx); }
  else if constexpr (ST == P_OUT_L) { const float* res = (l == 0 ? a.x : (const float*)a.out) + (long)b * d::S * d::D;
    GemmArgs g{a.m, d::D, a.w_out + (long)l * d::D * d::D, d::D, a.out + (long)b * d::S * d::D, d::D, d::S, d::D, d::D, nullptr, 0, a.mod + (long)b * 6 * d::D + 2 * d::D, res, d::D, 0}; st_gemm(g, idx); }
  else if constexpr (ST == P_OUT_C) { const float* res = (l == 0 ? a.ctx : (const float*)a.xc) + (long)b * d::C * d::D;
    GemmArgs g{a.m + (long)d::S * d::D, d::D, a.w_out + (long)l * d::D * d::D, d::D, a.xc + (long)b * d::C * d::D, d::D, d::C, d::D, d::D, nullptr, 0, a.mod + (long)d::B * 6 * d::D + 2 * d::D, res, d::D, 0}; st_gemm(g, idx); }
  else if constexpr (ST == P_ROUTER) st_router<T>(a, idx);
  else if constexpr (ST == P_MOEHID) st_moehid<T>(a, l, idx);
  else if constexpr (ST == P_MOEOUT) st_moeout<T>(a, l, b, idx);
}

template <class T> inline size_t carve(NaiveBufs& a, float* ws) {
  using d = DD<T>; size_t o = 0; auto take = [&](size_t n) { float* p = ws ? ws + o : nullptr; o += (n + 63) & ~(size_t)63; return p; };
  a.mod = take((size_t)(d::B + 1) * 6 * d::D);
  a.hid2S = take((size_t)d::S * d::HF); a.hid2C = take((size_t)d::C * d::HF);
  a.tapsS = take((size_t)2 * 2 * d::S * d::HW); a.tapsC = take((size_t)2 * 2 * d::C * d::HW);
  a.nrmS = take(2 * d::HW); a.nrmC = take(2 * d::HW);
  a.rs = take(d::R); a.h = take((size_t)d::R * d::D); a.proj = take((size_t)d::R * d::NIN);
  a.qn = take((size_t)d::R * d::AQW); a.kn = take((size_t)d::R * d::AKVW);
  a.uc = take((size_t)d::R * 3 * d::HW); a.z1 = take((size_t)d::R * d::HW); a.yhy = take((size_t)d::R * d::HW);
  a.xc = take((size_t)d::B * d::C * d::D);
#ifdef HOST_TEST
  a.yatt = take((size_t)d::R * d::AQW); a.laf = take((size_t)d::R * d::GKW); a.lab = take((size_t)d::R * d::GKW);
  a.of = take((size_t)d::R * d::GVW); a.ob = take((size_t)d::R * d::GVW); a.ygla = take((size_t)d::R * d::GVW);
  a.m = take((size_t)d::R * d::D); a.ridx = (int*)take((size_t)d::R * 2); a.rw = take((size_t)d::R * 2); a.hid = take((size_t)d::R * 2 * d::DE);
#endif
  return o;
}
template <class T> inline void set_inputs(NaiveBufs& a, const float* const* in) {
  int i = 0;
  a.x = in[i++]; a.c = in[i++]; a.ctx = in[i++]; a.c_ctx = in[i++]; a.w_mod = in[i++]; a.b_mod = in[i++]; a.norm1_g = in[i++]; a.norm2_g = in[i++];
  a.w_in = in[i++]; a.q_norm_g = in[i++]; a.k_norm_g = in[i++]; a.gla_wa2 = in[i++]; a.gla_ba = in[i++]; a.gla_norm_g = in[i++];
  a.hy_conv_w = in[i++]; a.hy_conv_b = in[i++]; a.hy_pos_w1 = in[i++]; a.hy_pos_b1 = in[i++]; a.hy_sin_freq = in[i++]; a.hy_pos_w2 = in[i++];
  a.hy_pos_b2 = in[i++]; a.hy_pos_w3 = in[i++]; a.hy_decay = in[i++]; a.hy_skip = in[i++]; a.w_br_hy = in[i++]; a.w_br_gla = in[i++];
  a.w_br_att = in[i++]; a.w_out = in[i++]; a.router_w = in[i++]; a.router_b = in[i++]; a.moe_w_gate = in[i++]; a.moe_w_up = in[i++]; a.moe_w_down = in[i++];
}

#define LSTAGES(X) X(L_MOD) X(L_HID_S) X(L_HID_C) X(L_TAPS_S) X(L_TAPS_C) X(L_NRM_S) X(L_NRM_C)
#define PSTAGES(X) X(P_RS1) X(P_NORM1) X(P_INPROJ) X(P_QKNORM) X(P_ATTN_L) X(P_ATTN_C) X(P_GLALA) X(P_GLASCAN) X(P_GLAOUT) X(P_HYC3) X(P_HYL0) X(P_HYL1) \
  X(P_MRG_HY) X(P_MRG_GLA) X(P_MRG_ATT) X(P_OUT_L) X(P_OUT_C) X(P_RS2) X(P_NORM2) X(P_ROUTER) X(P_MOEHID) X(P_MOEOUT)
namespace pro {
__device__ __forceinline__ void mod_phase(const NaiveBufs& a, int l, LAS unsigned char* lds) {
  int tz = threadIdx.x; asm volatile("" : "+v"(tz));
  __syncthreads();
  LAS float* sl = (LAS float*)lds; LAS float* part = sl + 9 * 1024;
  for (int e = tz; e < 9 * 1024; e += NTHREADS) { const int bb = e >> 10, k = e & 1023; const float cv = bb < 8 ? a.c[bb * 1024 + k] : a.c_ctx[k]; sl[e] = cv / (1.f + __expf(-cv)); }
  __syncthreads();
  const float* w = a.w_mod + (size_t)l * 1024 * 6144;
  const int jl = tz & 63, ks = tz >> 6;
  for (int cb = blockIdx.x; cb < 96; cb += gridDim.x) { const int j = cb * 64 + jl; float acc[9];
#pragma unroll
    for (int q = 0; q < 9; ++q) acc[q] = 0.f;
#pragma unroll 4
    for (int k = ks * 128; k < ks * 128 + 128; ++k) { const float wv = w[(size_t)k * 6144 + j];
#pragma unroll
      for (int q = 0; q < 9; ++q) acc[q] += sl[q * 1024 + k] * wv; }
#pragma unroll
    for (int q = 0; q < 9; ++q) part[(ks * 9 + q) * 64 + jl] = acc[q];
    __syncthreads();
    for (int e = tz; e < 9 * 64; e += NTHREADS) { const int q = e >> 6, jj = e & 63; float s = a.b_mod[(size_t)l * 6144 + cb * 64 + jj];
#pragma unroll
      for (int k8 = 0; k8 < 8; ++k8) s += part[(k8 * 9 + q) * 64 + jj];
      a.mod[(size_t)q * 6144 + cb * 64 + jj] = s; }
    __syncthreads(); }
  __syncthreads();
}
__device__ __forceinline__ void hid_phase(const NaiveBufs& a, int l, int n, float* dst, LAS unsigned char* lds) {
  int tz = threadIdx.x; asm volatile("" : "+v"(tz));
  LAS float* Z = (LAS float*)(lds + 40960); LAS float* H1 = Z + 8 * 36;
  const float* w1 = a.hy_pos_w1 + (size_t)l * 33 * 64; const float* b1 = a.hy_pos_b1 + l * 64; const float* fr = a.hy_sin_freq + l * 64;
  const float* w2 = a.hy_pos_w2 + (size_t)l * 64 * 64; const float* b2 = a.hy_pos_b2 + l * 64;
  const float w0 = 2.f * 3.14159265358979323846f / (float)n;
  for (int t0 = blockIdx.x * 8; t0 < n; t0 += gridDim.x * 8) {
    if (tz < 8 * 33) { const int tt = tz / 33, e = tz % 33, t = t0 + tt; float v;
      if (e == 0) v = (float)t / (float)n; else { const int bnd = (e - 1) & 15; const float band = 1e-4f + (float)bnd * (15.f - 1e-4f) / 15.f; const float ph = w0 * (float)t * band; v = e <= 16 ? cosf(ph) : -sinf(ph); }
      Z[tt * 36 + e] = v; }
    __syncthreads();
    { const int tt = tz >> 6, i = tz & 63; float acc = b1[i];
#pragma unroll
      for (int e = 0; e < 33; ++e) acc += Z[tt * 36 + e] * w1[e * 64 + i];
      H1[tt * 64 + i] = sinf(fr[i] * acc); }
    __syncthreads();
    { const int tt = tz >> 6, j = tz & 63; float acc = b2[j];
#pragma unroll 8
      for (int i = 0; i < 64; ++i) acc += H1[tt * 64 + i] * w2[i * 64 + j];
      if (t0 + tt < n) dst[(size_t)(t0 + tt) * 64 + j] = sinf(fr[j] * acc); }
    __syncthreads();
  }
}
__device__ __forceinline__ void nrmS_phase(const NaiveBufs& a) {
  int tz = threadIdx.x; asm volatile("" : "+v"(tz)); const int lane = tz & 63, wave = __builtin_amdgcn_readfirstlane(tz >> 6);
  for (int oc = blockIdx.x * NWAVES + wave; oc < 1024; oc += gridDim.x * NWAVES) { const float* tp = a.tapsS + (size_t)oc * 8192; float s = 0.f;
#pragma unroll 8
    for (int k = lane; k < 8192; k += 64) s += fabsf(tp[k]);
    s = moe::wave_sum(s); if (lane == 0) a.nrmS[oc] = s + 1e-6f; }
}
constexpr int TCOPY = 8232;
__device__ __forceinline__ void tapsB_phase(const NaiveBufs& a, int l, bf16_t* tapsB, LAS unsigned char* lds) {
  int tz = threadIdx.x; asm volatile("" : "+v"(tz));
  const float* w3 = a.hy_pos_w3 + (size_t)l * 64 * 2048; const float* dcy = a.hy_decay + (size_t)l * 2048;
  typedef float f4 __attribute__((ext_vector_type(4)));
  LAS float* W = (LAS float*)lds;
  for (int cp = blockIdx.x; cp < 256; cp += gridDim.x) {
    __syncthreads();
    { const int ch = tz >> 8, e = tz & 255, c = cp + 256 * ch; W[tz] = w3[(size_t)(e >> 2) * 2048 + (e & 3) * 512 + c]; if (tz < 8) W[512 + tz] = fabsf(dcy[(tz & 3) * 512 + cp + 256 * (tz >> 2)]); }
    __syncthreads();
    for (int t = tz; t < 4096; t += NTHREADS) {
      const f4* h2 = (const f4*)(a.hid2S + (size_t)t * 64); f4 acc0 = {0.f, 0.f, 0.f, 0.f}, acc1 = {0.f, 0.f, 0.f, 0.f};
#pragma unroll 4
      for (int j4 = 0; j4 < 16; ++j4) { const f4 h = h2[j4];
#pragma unroll
        for (int e = 0; e < 4; ++e) { acc0 += h[e] * *(const LAS f4*)(W + (4 * j4 + e) * 4); acc1 += h[e] * *(const LAS f4*)(W + 256 + (4 * j4 + e) * 4); } }
      const float tn = (float)t * (1.f / 4096.f);
#pragma unroll
      for (int ch = 0; ch < 2; ++ch)
#pragma unroll
        for (int q = 0; q < 4; ++q) { const int o = q >> 1, dir = q & 1; if (dir == 1 && t == 0) continue; const int c = cp + 256 * ch;
          const bf16_t bv = (bf16_t)f2bf((ch ? acc1[q] : acc0[q]) * __expf(-tn * W[512 + 4 * ch + q]));
          bf16_t* base = tapsB + ((size_t)o * 512 + c) * 2 * TCOPY; const int x0 = dir ? 4096 + t : 4096 - t;
          base[x0] = bv; base[TCOPY + x0 - 1] = bv; } } }
  for (long idx = (long)blockIdx.x * NTHREADS + tz; idx < 1024L * 96; idx += (long)gridDim.x * NTHREADS) { const int oc = (int)(idx / 96), e = (int)(idx % 96); bf16_t* base = tapsB + (size_t)oc * 2 * TCOPY;
    if (e < 40) base[8192 + e] = 0; else if (e < 81) base[TCOPY + 8191 + (e - 40)] = 0; else if (e == 81) base[0] = 0; }
}
__device__ __forceinline__ void nrmB_phase(const NaiveBufs& a, const bf16_t* tapsB) {
  int tz = threadIdx.x; asm volatile("" : "+v"(tz)); const int lane = tz & 63, wave = __builtin_amdgcn_readfirstlane(tz >> 6);
  for (int oc = blockIdx.x * NWAVES + wave; oc < 1024; oc += gridDim.x * NWAVES) { const bf16_t* tp = tapsB + (size_t)oc * 2 * TCOPY; float s = 0.f;
#pragma unroll 8
    for (int k = lane; k < 8192; k += 64) s += fabsf(bf2f(tp[k]));
    s = moe::wave_sum(s); if (lane == 0) a.nrmS[oc] = s + 1e-6f; }
}
}
using TD = FullDims;
using dd = DD<TD>;
constexpr int GB = 4, NGRP = 2, RB = dd::R  , RG = GB * RB, PLD = dd::NIN, PANELS = RG / 256, PPB = RB / 256  ;
constexpr size_t BAR_BYTES = 16384 + 4 * 4096; constexpr int CNT_OFF = 16384;
constexpr int MPG = 38912;
constexpr size_t CS_BYTES = (size_t)2 * 4 * 68 * 64 * 128 * 4, DEC_BYTES = (size_t)2 * 4 * 68 * 64 * 4;
constexpr size_t UCT_BYTES = (size_t)1536 * 4096 * 2, YT_BYTES = (size_t)512 * 4096 * 2, UCC_BYTES = (size_t)256 * 1536 * 4, Z1C_BYTES = (size_t)256 * 512 * 4;
constexpr size_t MIX_BYTES = GB * (CS_BYTES + DEC_BYTES) > GB * (UCT_BYTES + YT_BYTES + UCC_BYTES + Z1C_BYTES) ? GB * (CS_BYTES + DEC_BYTES) : GB * (UCT_BYTES + YT_BYTES + UCC_BYTES + Z1C_BYTES);

struct KArgs { NaiveBufs a; unsigned* bar; int* cnt; bf16_t *WinT, *WhyT, *WglaT, *WattT, *WoutT, *WguT, *WdT, *hb, *proj; unsigned char* mix;
  bf16_t *hp, *hid, *contrib; int* srcrow; float* wgt; moe::Route* route; float* wts; };

struct EpiProjBf16 {
  static constexpr bool PERM = true, AFTER_DRAIN = false;
  bf16_t* P;
  __device__ __forceinline__ void operator()(const pg8::f32x4 (&acc)[2][2][4][2], const pg8::Unit& u, int wr, int wc, int fr, int fq) const {
    const int row0 = u.pm * 256 + wr * 64 + fr, col0 = u.pn * 256 + wc * 32 + 8 * fq;
#pragma unroll
    for (int ai = 0; ai < 2; ++ai)
#pragma unroll
      for (int m = 0; m < 4; ++m) { bf16_t* rowp = P + (size_t)(row0 + ai * 128 + m * 16) * PLD + col0;
#pragma unroll
        for (int bj = 0; bj < 2; ++bj) if (col0 + bj * 128 < PLD) { const pg8::f32x4 v0 = acc[ai][bj][m][0], v1 = acc[ai][bj][m][1];
          v4u o; o.x = pk2(v0[0], v0[1]); o.y = pk2(v0[2], v0[3]); o.z = pk2(v1[0], v1[1]); o.w = pk2(v1[2], v1[3]); *(v4u*)(rowp + bj * 128) = o; } }
  }
};
template <bool ACCUM> struct EpiMergeB {
  static constexpr bool PERM = true, AFTER_DRAIN = false;
  const bf16_t* gate; bf16_t* M;
  __device__ __forceinline__ void operator()(const pg8::f32x4 (&acc)[2][2][4][2], const pg8::Unit& u, int wr, int wc, int fr, int fq) const {
    const int row0 = u.pm * 256 + wr * 64 + fr, col0 = u.pn * 256 + wc * 32 + 8 * fq;
#pragma unroll
    for (int ai2 = 0; ai2 < 4; ++ai2) { const int ai = ai2 >> 1, m0 = (ai2 & 1) * 2;
      v4u gw[4][2], mo[4][2];
#pragma unroll
      for (int m = m0; m < m0 + 2; ++m)
#pragma unroll
        for (int bj = 0; bj < 2; ++bj) { const size_t r = (size_t)(row0 + ai * 128 + m * 16); const int c = col0 + bj * 128; gw[m][bj] = *(const v4u*)(gate + r * PLD + c); if (ACCUM) mo[m][bj] = *(const v4u*)(M + r * 1024 + c); }
#pragma unroll
      for (int m = m0; m < m0 + 2; ++m)
#pragma unroll
        for (int bj = 0; bj < 2; ++bj) { const size_t r = (size_t)(row0 + ai * 128 + m * 16); const int c = col0 + bj * 128; const v4u g4 = gw[m][bj];
          pg8::f32x4 v0 = acc[ai][bj][m][0], v1 = acc[ai][bj][m][1];
          v0[0] *= fsigmoid(bf2f(g4.x & 0xffff)); v0[1] *= fsigmoid(bf2f(g4.x >> 16)); v0[2] *= fsigmoid(bf2f(g4.y & 0xffff)); v0[3] *= fsigmoid(bf2f(g4.y >> 16));
          v1[0] *= fsigmoid(bf2f(g4.z & 0xffff)); v1[1] *= fsigmoid(bf2f(g4.z >> 16)); v1[2] *= fsigmoid(bf2f(g4.w & 0xffff)); v1[3] *= fsigmoid(bf2f(g4.w >> 16));
          if (ACCUM) { const v4u o = mo[m][bj]; v0[0] += bf2f(o.x & 0xffff); v0[1] += bf2f(o.x >> 16); v0[2] += bf2f(o.y & 0xffff); v0[3] += bf2f(o.y >> 16);
            v1[0] += bf2f(o.z & 0xffff); v1[1] += bf2f(o.z >> 16); v1[2] += bf2f(o.w & 0xffff); v1[3] += bf2f(o.w >> 16); }
          v4u o2; o2.x = pk2(v0[0], v0[1]); o2.y = pk2(v0[2], v0[3]); o2.z = pk2(v1[0], v1[1]); o2.w = pk2(v1[2], v1[3]); *(v4u*)(M + r * 1024 + c) = o2; } }
  }
};
struct EpiOutG {
  static constexpr bool PERM = false, AFTER_DRAIN = false;
  const float* resL; float* outL; const float* resC; float* outC; const float* mod; int b0; bool ctx_on;
  __device__ __forceinline__ void operator()(const pg8::f32x4 (&acc)[2][2][4][2], const pg8::Unit& u, int wr, int wc, int fr, int fq) const {
    const int bl = u.pm / PPB, lp = u.pm % PPB; const bool isc = lp == PPB - 1; if (isc && !ctx_on) return;
    const int b = b0 + bl;
    const float* res = isc ? resC + (size_t)b * dd::C * 1024 : resL + ((size_t)b * dd::S + lp * 256) * 1024;
    float* out = isc ? outC + (size_t)b * dd::C * 1024 : outL + ((size_t)b * dd::S + lp * 256) * 1024;
    const float* gv = mod + (size_t)(isc ? dd::B : b) * 6 * 1024 + 2 * 1024;
    const int row0 = wr * 64 + fr, col0 = u.pn * 256 + wc * 32 + 4 * fq;
    pg8::f32x4 gg[2][2];
#pragma unroll
    for (int bj = 0; bj < 2; ++bj)
#pragma unroll
      for (int n = 0; n < 2; ++n) gg[bj][n] = *(const pg8::f32x4*)(gv + col0 + bj * 128 + n * 16);
#pragma unroll
    for (int ai2 = 0; ai2 < 4; ++ai2) { const int ai = ai2 >> 1, m0 = (ai2 & 1) * 2;
      pg8::f32x4 rv[4][2][2];
#pragma unroll
      for (int m = m0; m < m0 + 2; ++m)
#pragma unroll
        for (int bj = 0; bj < 2; ++bj)
#pragma unroll
          for (int n = 0; n < 2; ++n) rv[m][bj][n] = *(const pg8::f32x4*)(res + (size_t)(row0 + ai * 128 + m * 16) * 1024 + col0 + bj * 128 + n * 16);
#pragma unroll
      for (int m = m0; m < m0 + 2; ++m)
#pragma unroll
        for (int bj = 0; bj < 2; ++bj)
#pragma unroll
          for (int n = 0; n < 2; ++n) *(pg8::f32x4*)(out + (size_t)(row0 + ai * 128 + m * 16) * 1024 + col0 + bj * 128 + n * 16) = rv[m][bj][n] + gg[bj][n] * acc[ai][bj][m][n]; }
  }
};
struct GroupOrder {
  int nN, nwg, G, c; bool lat;
  __device__ void init(int N, int G_, int c_, bool lat_) { nN = N / 256; lat = lat_; nwg = (lat ? GB * 16 : PANELS) * nN; G = G_; c = c_; }
  __device__ __forceinline__ bool next(int i, pg8::Unit& u) const { const long L = (long)i * G + c; if (L >= nwg) return false; const int p = (int)L / nN; u.pm = lat ? (p >> 4) * PPB + (p & 15) : p; u.pn = (int)L % nN; u.acol = 0; u.nt = 0; return true; }
  __device__ __forceinline__ void a_ready(const pg8::Unit&) const {}
  __device__ __forceinline__ void done(const pg8::Unit&) const {}
};
struct MergeOrder {
  int ntiles, G, c; bool lat;
  __device__ void init(int G_, int c_, bool lat_) { lat = lat_; ntiles = (lat ? GB * 16 : PANELS) * 4; G = G_; c = c_; }
  __device__ __forceinline__ bool next(int i, pg8::Unit& u) const { const int rnd = i / 3, gi = i - 3 * rnd; const long tile = (long)rnd * G + c; if (tile >= ntiles) return false; const int p = (int)tile >> 2;
    u.pm = lat ? (p >> 4) * PPB + (p & 15) : p; u.pn = gi * 4 + ((int)tile & 3); u.acol = gi == 0 ? dd::O_HY : gi == 1 ? dd::O_OG : dd::O_AQ; u.nt = gi == 2 ? 16 : 8; return true; }
  __device__ __forceinline__ void a_ready(const pg8::Unit&) const {}
  __device__ __forceinline__ void done(const pg8::Unit&) const {}
};
struct EpiMergeS {
  static constexpr bool PERM = true, AFTER_DRAIN = false;
  const bf16_t* gate0; bf16_t* M;
  __device__ __forceinline__ void operator()(const pg8::f32x4 (&acc)[2][2][4][2], const pg8::Unit& u, int wr, int wc, int fr, int fq) const {
    const int gi = u.pn >> 2; const bool accum = gi > 0; const bf16_t* gate = gate0 + gi * 1024;
    const int row0 = u.pm * 256 + wr * 64 + fr, col0 = (u.pn & 3) * 256 + wc * 32 + 8 * fq;
#pragma unroll
    for (int ai2 = 0; ai2 < 4; ++ai2) { const int ai = ai2 >> 1, m0 = (ai2 & 1) * 2;
      v4u gw[4][2], mo[4][2];
#pragma unroll
      for (int m = m0; m < m0 + 2; ++m)
#pragma unroll
        for (int bj = 0; bj < 2; ++bj) { const size_t r = (size_t)(row0 + ai * 128 + m * 16); const int c = col0 + bj * 128; gw[m][bj] = *(const v4u*)(gate + r * PLD + c); mo[m][bj] = (v4u){0u, 0u, 0u, 0u}; if (accum) mo[m][bj] = *(const v4u*)(M + r * 1024 + c); }
#pragma unroll
      for (int m = m0; m < m0 + 2; ++m)
#pragma unroll
        for (int bj = 0; bj < 2; ++bj) { const size_t r = (size_t)(row0 + ai * 128 + m * 16); const int c = col0 + bj * 128; const v4u g4 = gw[m][bj];
          pg8::f32x4 v0 = acc[ai][bj][m][0], v1 = acc[ai][bj][m][1];
          v0[0] *= fsigmoid(bf2f(g4.x & 0xffff)); v0[1] *= fsigmoid(bf2f(g4.x >> 16)); v0[2] *= fsigmoid(bf2f(g4.y & 0xffff)); v0[3] *= fsigmoid(bf2f(g4.y >> 16));
          v1[0] *= fsigmoid(bf2f(g4.z & 0xffff)); v1[1] *= fsigmoid(bf2f(g4.z >> 16)); v1[2] *= fsigmoid(bf2f(g4.w & 0xffff)); v1[3] *= fsigmoid(bf2f(g4.w >> 16));
          { const v4u o = mo[m][bj]; v0[0] += bf2f(o.x & 0xffff); v0[1] += bf2f(o.x >> 16); v0[2] += bf2f(o.y & 0xffff); v0[3] += bf2f(o.y >> 16);
            v1[0] += bf2f(o.z & 0xffff); v1[1] += bf2f(o.z >> 16); v1[2] += bf2f(o.w & 0xffff); v1[3] += bf2f(o.w >> 16); }
          v4u o2; o2.x = pk2(v0[0], v0[1]); o2.y = pk2(v0[2], v0[3]); o2.z = pk2(v1[0], v1[1]); o2.w = pk2(v1[2], v1[3]); *(v4u*)(M + r * 1024 + c) = o2; } }
  }
};
__device__ __forceinline__ const float* xrow_in(const NaiveBufs& a, int l, int b, int r) {
  if (r < dd::S) return (l == 0 ? a.x : (const float*)a.out) + ((size_t)b * dd::S + r) * 1024;
  return (l == 0 ? a.ctx : (const float*)a.xc) + ((size_t)b * dd::C + (r - dd::S)) * 1024;
}
__device__ __forceinline__ float* xrow_cur(const NaiveBufs& a, int b, int r) {
  if (r < dd::S) return a.out + ((size_t)b * dd::S + r) * 1024;
  return a.xc + ((size_t)b * dd::C + (r - dd::S)) * 1024;
}
__device__ __forceinline__ void norm_row(const float* xr, const float* gnorm, const float* shift, const float* scale, bf16_t* hrow, int lane) {
  typedef float f4 __attribute__((ext_vector_type(4)));
  f4 xv[4]; float ss = 0.f;
#pragma unroll
  for (int j = 0; j < 4; ++j) { xv[j] = *(const f4*)(xr + 4 * lane + 256 * j); ss += xv[j][0] * xv[j][0] + xv[j][1] * xv[j][1] + xv[j][2] * xv[j][2] + xv[j][3] * xv[j][3]; }
  const float rs = 1.f / sqrtf(moe::wave_sum(ss) * (1.f / 1024.f) + 1e-6f);
#pragma unroll
  for (int j = 0; j < 4; ++j) { const int c = 4 * lane + 256 * j; const f4 g4 = *(const f4*)(gnorm + c), sh = *(const f4*)(shift + c), sc = *(const f4*)(scale + c);
    f4 h;
#pragma unroll
    for (int i = 0; i < 4; ++i) h[i] = xv[j][i] * rs * g4[i] * (1.f + sc[i]) + sh[i];
    *(unsigned long long*)(hrow + c) = (unsigned long long)pk2(h[0], h[1]) | ((unsigned long long)pk2(h[2], h[3]) << 32); }
}
__device__ __forceinline__ void qknorm_row(bf16_t* prow, const float* qg, const float* kg, int r, int lane) {
  const bool lat = r < dd::S; const int grow = r / dd::GW, gcol = r % dd::GW;
  const int fi = lane & 31; const float pos = (lane < 32) ? (float)grow : (float)gcol;
  const float ang = pos * __builtin_amdgcn_exp2f(-(float)fi * (13.287712379549449f / 32.f));
  const float cs = lat ? __cosf(ang) : 1.f, sn = lat ? __sinf(ang) : 0.f;
  unsigned wv[10];
#pragma unroll
  for (int hh = 0; hh < 10; ++hh) wv[hh] = *((const unsigned*)(prow + (hh < 8 ? dd::O_AQ + hh * 128 : dd::O_AK + (hh - 8) * 128)) + lane);
  float ss[10];
#pragma unroll
  for (int hh = 0; hh < 10; ++hh) { const float x1 = bf2f(wv[hh] & 0xffff), x2 = bf2f(wv[hh] >> 16); ss[hh] = x1 * x1 + x2 * x2; }
#pragma unroll
  for (int o = 1; o < 64; o <<= 1) {
#pragma unroll
    for (int hh = 0; hh < 10; ++hh) ss[hh] += __shfl_xor(ss[hh], o); }
  const float q1 = qg[2 * lane], q2 = qg[2 * lane + 1], k1 = kg[2 * lane], k2 = kg[2 * lane + 1];
#pragma unroll
  for (int hh = 0; hh < 10; ++hh) { unsigned* p = (unsigned*)(prow + (hh < 8 ? dd::O_AQ + hh * 128 : dd::O_AK + (hh - 8) * 128)) + lane;
    const float x1 = bf2f(wv[hh] & 0xffff), x2 = bf2f(wv[hh] >> 16); const float rs = 1.f / sqrtf(ss[hh] * (1.f / 128.f) + 1e-6f);
    const float y1 = x1 * rs * (hh < 8 ? q1 : k1), y2 = x2 * rs * (hh < 8 ? q2 : k2);
    *p = pk2(y1 * cs - y2 * sn, y1 * sn + y2 * cs); }
}

__global__ void __launch_bounds__(NTHREADS, 2) mega_kernel(KArgs ka_unused) {
  extern __shared__ __attribute__((aligned(16))) unsigned char lds_raw[];
  LAS unsigned char* lds = (LAS unsigned char*)lds_raw;
  volatile LAS unsigned* MISC = (volatile LAS unsigned*)(lds + MISC_OFF);
  constexpr int ARGS_OFF = MISC_OFF + 256;
  static_assert(ARGS_OFF + sizeof(KArgs) <= LDS_BYTES, "LDS map");
  { const unsigned __attribute__((address_space(4)))* kp = (const unsigned __attribute__((address_space(4)))*)__builtin_amdgcn_kernarg_segment_ptr();
    for (int i = threadIdx.x; i < (int)(sizeof(KArgs) / 4); i += NTHREADS) ((LAS unsigned*)(lds + ARGS_OFF))[i] = kp[i]; }
  if (threadIdx.x < 64) MISC[threadIdx.x] = 0u;
  __syncthreads();
  const KArgs& ka = *(const KArgs*)(const LAS KArgs*)(lds + ARGS_OFF);
  const NaiveBufs& a = ka.a;
  unsigned* bar_s; { const unsigned long long bp = (unsigned long long)ka.bar; const unsigned lo_ = __builtin_amdgcn_readfirstlane((unsigned)bp), hi_ = __builtin_amdgcn_readfirstlane((unsigned)(bp >> 32));
    bar_s = (unsigned*)(((unsigned long long)hi_ << 32) | lo_); }
  XcdBarrier xb = xcd_barrier_post(bar_s, MISC);
#define SPTR(T, name, src) T* name; { const unsigned long long bp_ = (unsigned long long)(src); const unsigned lo_ = __builtin_amdgcn_readfirstlane((unsigned)bp_), hi_ = __builtin_amdgcn_readfirstlane((unsigned)(bp_ >> 32)); name = (T*)(((unsigned long long)hi_ << 32) | lo_); }
  SPTR(bf16_t, proj_s, ka.proj) SPTR(bf16_t, hb_s, ka.hb) SPTR(unsigned char, mix_s, ka.mix)
  const long gs = (long)gridDim.x * NTHREADS;
  LAS int* poff = (LAS int*)(lds + MISC_OFF + 64);
#define TID_SETUP int tz = threadIdx.x; asm volatile("" : "+v"(tz)); const int lane = tz & 63, wave = __builtin_amdgcn_readfirstlane(tz >> 6); \
    const int gw = blockIdx.x * NWAVES + wave, NGW = gridDim.x * NWAVES; const long gt = (long)blockIdx.x * NTHREADS + tz; (void)lane; (void)gw; (void)NGW; (void)gt;
#define LSTAGE(ST) { TID_SETUP const long n_ = stage_items<TD>(ST, l); for (long i_ = gt; i_ < n_; i_ += gs) stage_run<TD, ST>(a, l, 0, i_); }
  for (int l = 0; l < dd::DEPTH; ++l) {
    const bool last = (l == dd::DEPTH - 1);
    { TID_SETUP
      LAS float* scr = (LAS float*)(lds + RING_OFF + wave * 16384);
      constexpr int NIT = (dd::D / 64) * (dd::NIN / 32);
      for (int it = gw; it < NIT; it += NGW) transpose_item(a.w_in + (size_t)l * dd::D * dd::NIN, dd::D, dd::NIN, ka.WinT, 0, scr, it, lane);
      { constexpr int I0 = (dd::HW / 64) * (dd::D / 32), I1 = (dd::GVW / 64) * (dd::D / 32), I2 = (dd::AQW / 64) * (dd::D / 32), I3 = (dd::D / 64) * (dd::D / 32);
        for (int it = gw; it < I0 + I1 + I2 + I3; it += NGW) { int r = it;
          if (r < I0) { transpose_item(a.w_br_hy + (size_t)l * dd::HW * dd::D, dd::HW, dd::D, ka.WhyT, 0, scr, r, lane, 1024); continue; } r -= I0;
          if (r < I1) { transpose_item(a.w_br_gla + (size_t)l * dd::GVW * dd::D, dd::GVW, dd::D, ka.WglaT, 0, scr, r, lane, 1024); continue; } r -= I1;
          if (r < I2) { transpose_item(a.w_br_att + (size_t)l * dd::AQW * dd::D, dd::AQW, dd::D, ka.WattT, 0, scr, r, lane); continue; } r -= I2;
          transpose_item(a.w_out + (size_t)l * dd::D * dd::D, dd::D, dd::D, ka.WoutT, 0, scr, r, lane); } }
      { constexpr int IG = (dd::D / 64) * (dd::DE / 32), IDN = (dd::DE / 64) * (dd::D / 32);
        for (int it = gw; it < dd::NE * (2 * IG + IDN); it += NGW) { const int e = it / (2 * IG + IDN); int r = it % (2 * IG + IDN);
          if (r < 2 * IG) { const int up = r >= IG; if (up) r -= IG; const int n0 = 32 * (r % (dd::DE / 32));
            transpose_item((up ? a.moe_w_up : a.moe_w_gate) + ((size_t)l * dd::NE + e) * dd::D * dd::DE, dd::D, dd::DE, ka.WguT, e * 1024 + 128 * (n0 >> 7) + (up ? 128 : 0), scr, r, lane); }
          else { r -= 2 * IG; transpose_item(a.moe_w_down + ((size_t)l * dd::NE + e) * dd::DE * dd::D, dd::DE, dd::D, ka.WdT, e * 1024, scr, r, lane); } } }
      for (long i = gt; i < (long)(NINP - dd::NIN) * dd::D / 8; i += gs) { unsigned z_ = 0u; asm volatile("" : "+v"(z_)); *(v4u*)(ka.WinT + (size_t)dd::NIN * dd::D + i * 8) = (v4u){z_, z_, z_, z_}; }
    }
    pro::mod_phase(a, l, lds); pro::hid_phase(a, l, dd::S, a.hid2S, lds); if (!last) pro::hid_phase(a, l, dd::C, a.hid2C, lds);
    xcd_barrier(xb);
    pro::tapsB_phase(a, l, (bf16_t*)a.tapsS, lds); if (!last) LSTAGE(L_TAPS_C)
    xcd_barrier(xb);
    pro::nrmB_phase(a, (const bf16_t*)a.tapsS); if (!last) LSTAGE(L_NRM_C)
    xcd_barrier(xb);
    for (int grp = 0; grp < NGRP; ++grp) {
      const int b0 = grp * GB;
      { TID_SETUP
        for (int rg = gw; rg < RG; rg += NGW) { const int bl = rg / RB, r = rg % RB, b = b0 + bl; const float* md = a.mod + (size_t)(r < dd::S ? b : dd::B) * 6 * 1024;
          norm_row(xrow_in(a, l, b, r), a.norm1_g + (size_t)l * 1024, md, md + 1024, hb_s + (size_t)rg * 1024, lane); }
        xcd_barrier(xb); }
      { pg8::Gemm g{hb_s, ka.WinT, RG, NINP, dd::D, 0}; pg8::StaticOrder S; S.init(RG, NINP, (int)gridDim.x, (int)blockIdx.x); EpiProjBf16 E{proj_s};
        pg8::gemm_phase<EpiProjBf16, pg8::StaticOrder, false>((PG8_LAS unsigned char*)(lds + RING_OFF), g, S, E, nullptr);
        xcd_barrier(xb); }
      { TID_SETUP
        for (int rg = gw; rg < RG; rg += NGW) qknorm_row(proj_s + (size_t)rg * PLD, a.q_norm_g + (size_t)l * 128, a.k_norm_g + (size_t)l * 128, rg % RB, lane);
        for (int u = blockIdx.x; u < GB * 4 * 68; u += gridDim.x) { const int bl = u / (4 * 68), hu = u % (4 * 68); const bf16_t* pb = proj_s + (size_t)bl * RB * PLD;
          gla::In gp; gp.q = pb + dd::O_GQ; gp.k = pb + dd::O_GK; gp.v = pb + dd::O_GV; gp.ga = pb + dd::O_GA; gp.og = pb + dd::O_OG; gp.ld = PLD;
          gp.wa2 = a.gla_wa2 + (size_t)l * 2 * 16 * 256; gp.ba = a.gla_ba + (size_t)l * 2 * 256; gp.gnorm = a.gla_norm_g + (size_t)l * 128;
          gp.cs = (float*)(mix_s + (size_t)bl * CS_BYTES); gp.dec = (float*)(mix_s + (size_t)GB * CS_BYTES + (size_t)bl * DEC_BYTES); gp.y = (bf16_t*)pb + dd::O_OG; gp.ldy = PLD; gp.S = dd::S; gp.C = dd::C;
          gla::g1b_unit(gp, lds, hu / 68, hu % 68, 4, 68); }
        xcd_barrier(xb); }
      { TID_SETUP
        for (long i_ = gt; i_ < (long)GB * 2 * 4 * 64 * 128; i_ += gs) { const int bl = (int)(i_ / (2 * 4 * 64 * 128)); gla::In gp; gp.cs = (float*)(mix_s + (size_t)bl * CS_BYTES); gp.dec = (float*)(mix_s + (size_t)GB * CS_BYTES + (size_t)bl * DEC_BYTES); gp.S = dd::S; gp.C = dd::C;
          gla::g2_item(gp, i_ % (2 * 4 * 64 * 128), 4, 68); }
        const int combo = blockIdx.x & 7, slot = blockIdx.x >> 3, nslot = gridDim.x >> 3;
        const int per_combo = 64 + (last ? 0 : 4);
        const bool xcdm = (gridDim.x & 7) == 0;
        for (int uu = xcdm ? slot : (int)blockIdx.x; uu < (xcdm ? per_combo : 8 * per_combo); uu += xcdm ? nslot : (int)gridDim.x) { const int cmb = xcdm ? combo : uu / per_combo, ui = xcdm ? uu : uu % per_combo;
          const bool lat = ui < 64; const int bl = cmb >> 1, kvh = cmb & 1;
          const int head = kvh * 4 + (lat ? ui >> 4 : ui - 64), qb = lat ? ui & 15 : 0;
          bf16_t* pb = proj_s + (size_t)bl * RB * PLD; const size_t qrow = lat ? (size_t)qb * 256 : (size_t)dd::S, krow = lat ? 0 : (size_t)dd::S;
          att::attn_dense_body<att::bf16, PLD, PLD, PLD, true>((const att::bf16*)(pb + qrow * PLD + dd::O_AQ + head * 128), (const att::bf16*)(pb + krow * PLD + dd::O_AK + kvh * 128),
              (const att::bf16*)(pb + krow * PLD + dd::O_AV + kvh * 128), pb + qrow * PLD + dd::O_AQ + head * 128, lat ? RB : dd::C, (char*)lds_raw);
          __syncthreads(); }
        xcd_barrier(xb); }
      { const int n3 = last ? 64 : 68;
        for (int u = blockIdx.x; u < GB * 4 * n3; u += gridDim.x) { const int bl = u / (4 * n3), hu = u % (4 * n3); const bf16_t* pb = proj_s + (size_t)bl * RB * PLD;
          gla::In gp; gp.q = pb + dd::O_GQ; gp.k = pb + dd::O_GK; gp.v = pb + dd::O_GV; gp.ga = pb + dd::O_GA; gp.og = pb + dd::O_OG; gp.ld = PLD;
          gp.wa2 = a.gla_wa2 + (size_t)l * 2 * 16 * 256; gp.ba = a.gla_ba + (size_t)l * 2 * 256; gp.gnorm = a.gla_norm_g + (size_t)l * 128;
          gp.cs = (float*)(mix_s + (size_t)bl * CS_BYTES); gp.dec = (float*)(mix_s + (size_t)GB * CS_BYTES + (size_t)bl * DEC_BYTES); gp.y = (bf16_t*)pb + dd::O_OG; gp.ldy = PLD; gp.S = dd::S; gp.C = dd::C;
          gla::g3b_unit(gp, lds, hu / n3, hu % n3, 4, 68); }
        xcd_barrier(xb); }
      {
        bf16_t* ucT0 = (bf16_t*)mix_s; bf16_t* yT0 = (bf16_t*)(mix_s + GB * UCT_BYTES); float* ucc0 = (float*)(mix_s + GB * (UCT_BYTES + YT_BYTES)); float* z1c0 = (float*)(mix_s + GB * (UCT_BYTES + YT_BYTES + UCC_BYTES));
        const float* cw = a.hy_conv_w + (size_t)l * 3 * 1536; const float* cb = a.hy_conv_b + (size_t)l * 1536; const float* skp = a.hy_skip + (size_t)l * 2 * 512;
        { TID_SETUP
        { int t_ = blockIdx.x; hy::H0Regs hr = hy::h0_load(proj_s + (size_t)(t_ / (64 * 24)) * RB * PLD + dd::O_HY, PLD, t_ % (64 * 24), tz);
          for (; t_ < GB * 64 * 24; t_ += gridDim.x) { const int bl = t_ / (64 * 24), tn_ = t_ + gridDim.x; hy::H0Regs hn = hr;
            if (tn_ < GB * 64 * 24) hn = hy::h0_load(proj_s + (size_t)(tn_ / (64 * 24)) * RB * PLD + dd::O_HY, PLD, tn_ % (64 * 24), tz);
            hy::h0_compute(hr, cw, cb, ucT0 + (size_t)bl * 1536 * 4096, t_ % (64 * 24), lds, tz); hr = hn; } }
        if (!last) for (long i_ = gt; i_ < (long)GB * 256 * 1536; i_ += gs) { const int bl = (int)(i_ / (256 * 1536)); hy::cconv3_item(proj_s + ((size_t)bl * RB + dd::S) * PLD + dd::O_HY, PLD, cw, cb, ucc0 + (size_t)bl * 256 * 1536, i_ % (256 * 1536)); } }
        xcd_barrier(xb);
        { TID_SETUP
        for (int u = blockIdx.x; u < (GB / 2) * 512; u += gridDim.x) { const int bp_ = u / 512; hy::h1c_unit(ucT0 + (size_t)(2 * bp_) * 1536 * 4096, (const bf16_t*)a.tapsS, a.nrmS, skp, yT0 + (size_t)(2 * bp_) * 512 * 4096, u % 512, lds); }
        if (!last) for (long i_ = gt; i_ < (long)GB * 32 * 512; i_ += gs) { const int bl = (int)(i_ / (32 * 512)); hy::clong_item(ucc0 + (size_t)bl * 256 * 1536, nullptr, z1c0 + (size_t)bl * 256 * 512, nullptr, 0, a.tapsC, a.nrmC, skp, 0, i_ % (32 * 512)); } }
        xcd_barrier(xb);
        { TID_SETUP
        for (int t_ = blockIdx.x; t_ < GB * 64 * 8; t_ += gridDim.x) { const int bl = t_ / (64 * 8); hy::h2_tile(yT0 + (size_t)bl * 512 * 4096, proj_s + (size_t)bl * RB * PLD + dd::O_HY, PLD, t_ % (64 * 8), lds); }
        if (!last) for (long i_ = gt; i_ < (long)GB * 32 * 512; i_ += gs) { const int bl = (int)(i_ / (32 * 512)); hy::clong_item(ucc0 + (size_t)bl * 256 * 1536, z1c0 + (size_t)bl * 256 * 512, nullptr, proj_s + ((size_t)bl * RB + dd::S) * PLD + dd::O_HY, PLD, a.tapsC, a.nrmC, skp, 1, i_ % (32 * 512)); } }
        xcd_barrier(xb); }
      { { pg8::Gemm g{proj_s, ka.WhyT, RG, 1024, 1024, PLD, 1024}; MergeOrder S; S.init((int)gridDim.x, (int)blockIdx.x, last); EpiMergeS E{proj_s + dd::O_BR, (bf16_t*)mix_s};
          pg8::gemm_phase<EpiMergeS, MergeOrder, false>((PG8_LAS unsigned char*)(lds + RING_OFF), g, S, E, nullptr); }
        xcd_barrier(xb);
        pg8::Gemm g{(const bf16_t*)mix_s, ka.WoutT, RG, 1024, 1024, 0}; GroupOrder S; S.init(1024, (int)gridDim.x, (int)blockIdx.x, last);
        EpiOutG E{l == 0 ? a.x : (const float*)a.out, a.out, l == 0 ? a.ctx : (const float*)a.xc, a.xc, a.mod, b0, !last};
        pg8::gemm_phase<EpiOutG, GroupOrder, false>((PG8_LAS unsigned char*)(lds + RING_OFF), g, S, E, nullptr);
        xcd_barrier(xb); }
      {
        { TID_SETUP int* cnt = ka.cnt + (l * NGRP + grp) * 1024;
          LAS float* rwT = (LAS float*)(lds + RING_OFF);
          for (int k = tz; k < 1024; k += NTHREADS) {
#pragma unroll
            for (int e = 0; e < 16; ++e) rwT[e * 1024 + k] = a.router_w[(size_t)k * 16 + e]; }
          __syncthreads();
          LAS int* lcnt = (LAS int*)(lds + RING_OFF + 65536);
          if (tz < 32) lcnt[tz] = 0;
          __syncthreads();
          for (int rg = gw; rg < RG; rg += NGW) { const int bl = rg / RB, r = rg % RB, b = b0 + bl; if (last && r >= dd::S) continue; const float* md = a.mod + (size_t)(r < dd::S ? b : dd::B) * 6 * 1024;
            moe::route_row(xrow_cur(a, b, r), a.norm2_g + (size_t)l * 1024, md + 3 * 1024, md + 4 * 1024, hb_s + (size_t)rg * 1024, rwT, a.router_b, lcnt, ka.route + rg, ka.wts + 2 * rg, lane); }
          __syncthreads();
          if (tz < 16) lcnt[16 + tz] = atomicAdd(cnt + tz * 64, lcnt[tz]);
          __syncthreads();
          for (int rg = gw; rg < RG; rg += NGW) { if (last && (rg % RB) >= dd::S) continue; moe::Route* rt = ka.route + rg; if (lane == 0) { moe::Route r_ = *rt; r_.r0 += lcnt[16 + r_.e0]; r_.r1 += lcnt[16 + r_.e1]; *rt = r_; } }
          xcd_barrier(xb); }
        { TID_SETUP int* cnt = ka.cnt + (l * NGRP + grp) * 1024;
          if (tz == 0) { int acc_ = 0; for (int e = 0; e < 16; ++e) { poff[e] = acc_; acc_ += (cnt[e * 64] + 255) >> 8; } poff[16] = acc_; }
          __syncthreads();
          for (int rg = gw; rg < RG; rg += NGW) { if (last && (rg % RB) >= dd::S) continue; const moe::Route rt = ka.route[rg];
            const v4u h0 = *(const v4u*)(hb_s + (size_t)rg * 1024 + lane * 16), h1 = *(const v4u*)(hb_s + (size_t)rg * 1024 + lane * 16 + 8);
#pragma unroll
            for (int sl = 0; sl < 2; ++sl) { const int e = sl ? rt.e1 : rt.e0, rk = sl ? rt.r1 : rt.r0; const size_t dst = (size_t)poff[e] * 256 + rk;
              *(v4u*)(ka.hp + dst * 1024 + lane * 16) = h0; *(v4u*)(ka.hp + dst * 1024 + lane * 16 + 8) = h1;
              if (lane == 0) { ka.srcrow[dst] = 2 * rg + sl; ka.wgt[dst] = ka.wts[2 * rg + sl]; } } }
          for (int e = 0; e < 16; ++e) { const int c_ = cnt[e * 64], pe = ((c_ + 255) >> 8) << 8; for (int p_ = c_ + (int)gt; p_ < pe; p_ += (int)gs) ka.srcrow[(size_t)poff[e] * 256 + p_] = -1; }
          xcd_barrier(xb); }
        { pg8::Gemm g{ka.hp, ka.WguT, 0, 0, 1024, 0}; moe::MoeOrder S{(int)gridDim.x, (int)blockIdx.x, 4, poff}; moe::EpiGU E{ka.hid};
          pg8::gemm_phase<moe::EpiGU, moe::MoeOrder, false>((PG8_LAS unsigned char*)(lds + RING_OFF), g, S, E, nullptr);
          xcd_barrier(xb); }
        { pg8::Gemm g{ka.hid, ka.WdT, 0, 0, 512, 0}; moe::MoeOrder S{(int)gridDim.x, (int)blockIdx.x, 4, poff}; moe::EpiDown E{ka.srcrow, ka.wgt, ka.contrib, (size_t)RG * 1024};
          pg8::gemm_phase<moe::EpiDown, moe::MoeOrder, false>((PG8_LAS unsigned char*)(lds + RING_OFF), g, S, E, nullptr);
          xcd_barrier(xb); }
        { TID_SETUP
#pragma unroll 4
          for (long i_ = gt; i_ < (long)RG * 256; i_ += gs) { const int rg = (int)(i_ >> 8), c4 = (int)(i_ & 255) * 4; const int bl = rg / RB, r = rg % RB, b = b0 + bl; if (last && r >= dd::S) continue;
            float* xr = xrow_cur(a, b, r) + c4; const float* g2 = a.mod + (size_t)(r < dd::S ? b : dd::B) * 6 * 1024 + 5 * 1024 + c4;
            const unsigned long long u0 = *(const unsigned long long*)(ka.contrib + (size_t)rg * 1024 + c4), u1 = *(const unsigned long long*)(ka.contrib + (size_t)RG * 1024 + (size_t)rg * 1024 + c4);
            pg8::f32x4 xv = *(pg8::f32x4*)xr; const pg8::f32x4 gv = *(const pg8::f32x4*)g2;
#pragma unroll
            for (int e = 0; e < 4; ++e) xv[e] += gv[e] * (bf2f((bf16_t)(u0 >> (16 * e))) + bf2f((bf16_t)(u1 >> (16 * e))));
            *(pg8::f32x4*)xr = xv; }
          xcd_barrier(xb); }
      }
    }
  }
}
extern "C" void kernel_launch(void* const* d_in, const int* in_sizes, int n_in, void* d_out, int out_size, void* d_ws, size_t ws_size, hipStream_t stream) {
  static int grid = 0;
  if (!grid) {
    int dev = 0, cus = 0, per_cu = 0;
    (void)hipGetDevice(&dev); (void)hipDeviceGetAttribute(&cus, hipDeviceAttributeMultiprocessorCount, dev);
    (void)hipFuncSetAttribute((const void*)mega_kernel, hipFuncAttributeMaxDynamicSharedMemorySize, LDS_BYTES);
    (void)hipOccupancyMaxActiveBlocksPerMultiprocessor(&per_cu, mega_kernel, NTHREADS, LDS_BYTES);
    if (per_cu < 1) fprintf(stderr, "occupancy query says %d\n", per_cu);
    grid = cus;
  }
  KArgs ka{}; const float* ptrs[33]; for (int i = 0; i < 33; ++i) ptrs[i] = (const float*)d_in[i];
  set_inputs<TD>(ka.a, ptrs);
  char* wsb = (char*)d_ws; size_t off = BAR_BYTES;
  auto take = [&](size_t bytes) { char* p = wsb + off; off += (bytes + 255) & ~(size_t)255; return p; };
  NaiveBufs& a = ka.a;
  a.mod = (float*)take((size_t)(dd::B + 1) * 6 * 1024 * 4); a.hid2S = (float*)take((size_t)dd::S * 64 * 4); a.hid2C = (float*)take((size_t)dd::C * 64 * 4);
  a.tapsS = (float*)take((size_t)2 * 512 * 2 * 8232 * 2 + 64); a.tapsC = (float*)take((size_t)2 * 512 * 512 * 4); a.nrmS = (float*)take(1024 * 4); a.nrmC = (float*)take(1024 * 4);
  a.xc = (float*)take((size_t)dd::B * dd::C * 1024 * 4);
  ka.WinT = (bf16_t*)take((size_t)NINP * 1024 * 2); ka.WhyT = (bf16_t*)take((size_t)1024 * 1024 * 2); ka.WglaT = (bf16_t*)take((size_t)1024 * 1024 * 2); ka.WattT = (bf16_t*)take((size_t)1024 * 1024 * 2);
  ka.WoutT = (bf16_t*)take((size_t)1024 * 1024 * 2); ka.WguT = (bf16_t*)take((size_t)16 * 1024 * 1024 * 2); ka.WdT = (bf16_t*)take((size_t)16 * 1024 * 512 * 2);
  ka.hb = (bf16_t*)take((size_t)RG * 1024 * 2); ka.mix = (unsigned char*)take(MIX_BYTES);
  ka.proj = (bf16_t*)take((size_t)RG * PLD * 2);
  { char* p = (char*)ka.proj; ka.hp = (bf16_t*)p; p += (size_t)MPG * 1024 * 2; ka.hid = (bf16_t*)p; p += (size_t)MPG * 512 * 2; ka.contrib = (bf16_t*)p; p += (size_t)2 * RG * 1024 * 2;
    ka.srcrow = (int*)p; p += (size_t)MPG * 4; ka.wgt = (float*)p; p += (size_t)MPG * 4; ka.route = (moe::Route*)p; p += (size_t)RG * 16; ka.wts = (float*)p; p += (size_t)RG * 8;
    if ((size_t)(p - (char*)ka.proj) > (size_t)RG * PLD * 2) fprintf(stderr, "MoE alias region too large\n"); }
  a.out = (float*)d_out; ka.bar = (unsigned*)d_ws; ka.cnt = (int*)(wsb + CNT_OFF);
  if (off > ws_size) fprintf(stderr, "workspace too small: need %zu have %zu\n", off, ws_size);
  (void)hipMemsetAsync(d_ws, 0, BAR_BYTES, stream);
  hipLaunchKernelGGL(mega_kernel, dim3(grid), dim3(NTHREADS), LDS_BYTES, stream, ka);
}
```

```cpp
#include <hip/hip_runtime.h>
#include <cstddef>
#include <cstdio>
#include <cstdint>
#include <hip/hip_bf16.h>
#include <hip/hip_runtime.h>
namespace pg8 {
#define PG8_LAS __attribute__((address_space(3)))
typedef unsigned short bf16_t;
typedef short bf16x8 __attribute__((ext_vector_type(8)));
typedef float f32x4 __attribute__((ext_vector_type(4)));
typedef unsigned u32x4 __attribute__((ext_vector_type(4)));
constexpr int BM = 256, BK = 64, HALF = 128, HTB = HALF * BK * 2  , STAGE_BYTES = 8 * HTB, NXCD = 8, WGM = 8;

__host__ __device__ __forceinline__ int lds_byte(int r, int c) { const int st = (r >> 4) * 2 + (c >> 5), rr = r & 15, cc = c & 31, ob = rr * 64 + cc * 2; return st * 1024 + (ob ^ (((ob >> 9) & 1) << 5)); }
__host__ __device__ __forceinline__ void stage_rc(int b, int& R, int& C) { const int st = b / 1024, sb = b % 1024, swz = sb ^ (((sb >> 9) & 1) << 5); R = (st >> 1) * 16 + swz / 64; C = (st & 1) * 32 + (swz % 64) / 2; }
__host__ __device__ __forceinline__ int perm32(int rho) { const int n = rho >> 4, i = rho & 15; return 8 * (i >> 2) + 4 * n + (i & 3); }

struct Unit { int pm, pn, acol, nt; };
struct Gemm { const bf16_t* A; const bf16_t* Bt; int M, N, K; int lda; int ldb; };

struct StaticOrder {
    int nM, nN, nwg, G, c;
    __host__ __device__ void init(int M, int N, int G_, int c_) { nM = M / BM; nN = N / BM; nwg = nM * nN; G = G_; c = c_; }
    __host__ __device__ bool next(int i, Unit& u) const {
        const long L = (long)i * G + c; if (L >= nwg) return false;
        int wgid = (int)L; { const int q = nwg / NXCD, r = nwg % NXCD, xcd = wgid % NXCD, off = wgid / NXCD; wgid = (xcd < r ? xcd * (q + 1) : r * (q + 1) + (xcd - r) * q) + off; }
        const int nig = WGM * nN, gid = wgid / nig, fm = gid * WGM, gsz = (nM - fm) < WGM ? (nM - fm) : WGM;
        u.pm = fm + ((wgid % nig) % gsz); u.pn = (wgid % nig) / gsz; u.acol = 0; u.nt = 0; return true;
    }
    __device__ __forceinline__ void a_ready(const Unit&) const {}
    __device__ __forceinline__ void done(const Unit&) const {}
};
__device__ __forceinline__ unsigned cvt_pk_bf16(float lo, float hi) { unsigned r; asm volatile("v_cvt_pk_bf16_f32 %0, %1, %2" : "=v"(r) : "v"(lo), "v"(hi)); return r; }
typedef float f32x2 __attribute__((ext_vector_type(2)));
template <class Epi, class Sched, bool STAMP = false>
__device__ __forceinline__ void gemm_phase(PG8_LAS unsigned char* lds, const Gemm g, const Sched& S, const Epi& E, unsigned long long* stamps) {
    int tid = threadIdx.x; asm volatile("" : "+v"(tid)); const int wid = __builtin_amdgcn_readfirstlane(tid >> 6), lane = tid & 63, wr = wid >> 2, wc = wid & 3, fr = lane & 15, fq = lane >> 4;
    const int K = g.K, nt = K / BK, LDA = g.lda ? g.lda : g.K, LDB = g.ldb ? g.ldb : g.K;
    int ts_lo = 0, ts_hi = 0, nts = 0; const unsigned long long rt_entry = STAMP ? (unsigned long long)wall_clock64() : 0ull;
#define PG8_STAMP() do { if (STAMP && wid == 0 && nts < 64) { const unsigned long long _c = (unsigned long long)clock64(); \
        ts_lo = (lane == nts) ? (int)(unsigned)_c : ts_lo; ts_hi = (lane == nts) ? (int)(unsigned)(_c >> 32) : ts_hi; ++nts; } } while (0)
    PG8_STAMP();
    unsigned voffA[2], voffB[2];
#pragma unroll
    for (int i = 0; i < 2; ++i) { int R, C; stage_rc(tid * 16 + i * 8192, R, C); const int Rb = Epi::PERM ? ((R & ~31) + perm32(R & 31)) : R;
        voffA[i] = (unsigned)(R * LDA + C) * 2u; voffB[i] = (unsigned)(Rb * LDB + C) * 2u; }
    const size_t kstep = (size_t)(BK * 2);
    const size_t hstep = (size_t)HALF * LDB * 2;
    const size_t tstep = 2 * hstep;
    const size_t hstepA = (size_t)HALF * LDA * 2, tstepA = 2 * hstepA;
    const unsigned ldsw = (unsigned)wid * 1024u;
    const int aoff = lds_byte(wr * 64 + fr, fq * 8), boff = lds_byte(wc * 32 + fr, fq * 8);
#define PG8_SA(b, h) (((b) * 2 + (h)) * HTB)
#define PG8_SB(b, h) ((4 + (b) * 2 + (h)) * HTB)
#define PG8_STAGE(bufoff, gbase, voff) do { _Pragma("unroll") for (int _i = 0; _i < 2; ++_i) \
        __builtin_amdgcn_global_load_lds((const unsigned*)((const char*)(gbase) + (voff)[_i]), (PG8_LAS unsigned*)(lds + (bufoff) + ldsw + _i * 8192), 16, 0, 0); } while (0)
#define PG8_LDA(dst, b, h) do { _Pragma("unroll") for (int m = 0; m < 4; ++m) _Pragma("unroll") for (int k = 0; k < 2; ++k) dst[m][k] = *(const PG8_LAS bf16x8*)(lds + PG8_SA(b, h) + aoff + m * 2048 + k * 1024); } while (0)
#define PG8_LDB(dst, b, h) do { _Pragma("unroll") for (int n = 0; n < 2; ++n) _Pragma("unroll") for (int k = 0; k < 2; ++k) dst[n][k] = *(const PG8_LAS bf16x8*)(lds + PG8_SB(b, h) + boff + n * 2048 + k * 1024); } while (0)
#define PG8_MMA(ai, bj, At, Bt) do { __builtin_amdgcn_s_setprio(1); _Pragma("unroll") for (int m = 0; m < 4; ++m) _Pragma("unroll") for (int n = 0; n < 2; ++n) _Pragma("unroll") for (int k = 0; k < 2; ++k) \
        acc[ai][bj][m][n] = __builtin_amdgcn_mfma_f32_16x16x32_bf16(Bt[n][k], At[m][k], acc[ai][bj][m][n], 0, 0, 0); __builtin_amdgcn_s_setprio(0); } while (0)
#define PG8_WAIT_V(n) asm volatile("s_waitcnt vmcnt(" #n ")" ::: "memory")
#define PG8_WAIT_L(n) asm volatile("s_waitcnt lgkmcnt(" #n ")" ::: "memory")
#define PG8_BAR __builtin_amdgcn_s_barrier()
#define PG8_SCHED __builtin_amdgcn_sched_barrier(0)
    Unit cur, nxt; int ui = 0;
    if (!S.next(0, cur)) return;
    f32x4 acc[2][2][4][2];
#pragma unroll
    for (int a = 0; a < 2; ++a)
#pragma unroll
        for (int b = 0; b < 2; ++b)
#pragma unroll
            for (int m = 0; m < 4; ++m)
#pragma unroll
                for (int n = 0; n < 2; ++n) acc[a][b][m][n] = (f32x4){0.f, 0.f, 0.f, 0.f};
    bf16x8 At[4][2], B0[2][2], B1[2][2];
    const char* cA = (const char*)g.A + (size_t)cur.pm * tstepA + (size_t)cur.acol * 2; const char* cB = (const char*)g.Bt + (size_t)cur.pn * tstep;
    S.a_ready(cur);
    PG8_STAGE(PG8_SB(0, 0), cB, voffB); PG8_STAGE(PG8_SA(0, 0), cA, voffA); PG8_STAGE(PG8_SB(0, 1), cB + hstep, voffB); PG8_STAGE(PG8_SA(0, 1), cA + hstepA, voffA);
    if (wr == 1) PG8_BAR;
    PG8_WAIT_V(4); PG8_BAR;
    PG8_STAGE(PG8_SB(1, 0), cB + kstep, voffB); PG8_STAGE(PG8_SA(1, 0), cA + kstep, voffA); PG8_STAGE(PG8_SB(1, 1), cB + hstep + kstep, voffB);
    PG8_WAIT_V(6); PG8_BAR;
    PG8_STAMP();
    for (;;) {
        const bool has_next = S.next(ui + 1, nxt);
        const char* nA = has_next ? (const char*)g.A + (size_t)nxt.pm * tstepA + (size_t)nxt.acol * 2 : cA; const char* nB = has_next ? (const char*)g.Bt + (size_t)nxt.pn * tstep : cB;
        const int ntu = cur.nt ? cur.nt : nt;
        for (int t = 0; t < ntu; t += 2) {
            const bool last = (t == ntu - 2);
            const char* a1 = cA + (size_t)(t + 1) * kstep;
            const char* a2 = last ? nA : cA + (size_t)(t + 2) * kstep; const char* b2 = last ? nB : cB + (size_t)(t + 2) * kstep;
            const char* a3 = a2 + kstep; const char* b3 = b2 + kstep;
            if (last && has_next) S.a_ready(nxt);
            PG8_LDB(B0, 0, 0); PG8_SCHED; PG8_LDA(At, 0, 0); PG8_STAGE(PG8_SA(1, 1), a1 + hstepA, voffA);
            PG8_WAIT_L(8); PG8_BAR; PG8_WAIT_L(0); PG8_MMA(0, 0, At, B0); PG8_BAR; PG8_SCHED;
            PG8_LDB(B1, 0, 1); PG8_STAGE(PG8_SB(0, 0), b2, voffB);
            PG8_BAR; PG8_WAIT_L(0); PG8_MMA(0, 1, At, B1); PG8_BAR;
            PG8_LDA(At, 0, 1); PG8_STAGE(PG8_SA(0, 0), a2, voffA);
            PG8_BAR; PG8_WAIT_L(0); PG8_MMA(1, 0, At, B0); PG8_BAR; PG8_SCHED;
            PG8_STAGE(PG8_SB(0, 1), b2 + hstep, voffB);
            PG8_WAIT_V(6); PG8_BAR; PG8_MMA(1, 1, At, B1); PG8_BAR;
            PG8_LDB(B0, 1, 0); PG8_SCHED; PG8_LDA(At, 1, 0); PG8_STAGE(PG8_SA(0, 1), a2 + hstepA, voffA);
            PG8_WAIT_L(8); PG8_BAR; PG8_WAIT_L(0); PG8_MMA(0, 0, At, B0); PG8_BAR; PG8_SCHED;
            PG8_LDB(B1, 1, 1); PG8_STAGE(PG8_SB(1, 0), b3, voffB);
            PG8_BAR; PG8_WAIT_L(0); PG8_MMA(0, 1, At, B1); PG8_BAR;
            PG8_LDA(At, 1, 1); PG8_STAGE(PG8_SA(1, 0), a3, voffA);
            PG8_BAR; PG8_WAIT_L(0); PG8_MMA(1, 0, At, B0); PG8_BAR; PG8_SCHED;
            PG8_STAGE(PG8_SB(1, 1), b3 + hstep, voffB);
            PG8_WAIT_V(6); PG8_BAR; PG8_MMA(1, 1, At, B1); PG8_BAR;
        }
        PG8_STAMP();
        if constexpr (!Epi::AFTER_DRAIN) { E(acc, cur, wr, wc, fr, fq); S.done(cur); }
        PG8_STAMP();
        if (!has_next) break;
#pragma unroll
        for (int a = 0; a < 2; ++a)
#pragma unroll
            for (int b = 0; b < 2; ++b)
#pragma unroll
                for (int m = 0; m < 4; ++m)
#pragma unroll
                    for (int n = 0; n < 2; ++n) acc[a][b][m][n] = (f32x4){0.f, 0.f, 0.f, 0.f};
        cur = nxt; cA = nA; cB = nB; ++ui;
    }
    PG8_WAIT_V(0);
    if (wr == 0) PG8_BAR;
    PG8_BAR;
    if constexpr (Epi::AFTER_DRAIN) { E.fused(acc, cur, wr, wc, fr, fq, lds, wid, lane); S.done(cur); }
    PG8_STAMP();
    if (STAMP && wid == 0) { stamps[lane] = lane < nts ? (((unsigned long long)(unsigned)ts_hi << 32) | (unsigned)ts_lo) : 0ull;
        if (lane == 62) stamps[62] = rt_entry; if (lane == 63) stamps[63] = (unsigned long long)wall_clock64(); }
#undef PG8_STAMP
#undef PG8_SA
#undef PG8_SB
#undef PG8_STAGE
#undef PG8_LDA
#undef PG8_LDB
#undef PG8_MMA
#undef PG8_WAIT_V
#undef PG8_WAIT_L
#undef PG8_BAR
#undef PG8_SCHED
}
}

#define LAS __attribute__((address_space(3)))
typedef unsigned short bf16_t;
constexpr int NWAVES = 8, NTHREADS = 512;
constexpr int LDS_BYTES = 147456;
constexpr int RING_OFF = 0;
constexpr int MISC_OFF = 131072;
constexpr int NINP = 7680;

__device__ __forceinline__ unsigned f2bf(float f) { unsigned u = __builtin_bit_cast(unsigned, f); return (u + 0x7fffu + ((u >> 16) & 1u)) >> 16; }
__device__ __forceinline__ unsigned pk2(float lo, float hi) { return f2bf(lo) | (f2bf(hi) << 16); }
__device__ __forceinline__ float bf2f(bf16_t b) { return __builtin_bit_cast(float, ((unsigned)b) << 16); }
typedef unsigned v4u __attribute__((ext_vector_type(4)));

__device__ __forceinline__ void transpose_item(const float* W, int K, int N, bf16_t* WT, int row_off, LAS float* scr, int item, int lane, int ldo = 0) {
  if (ldo == 0) ldo = K;
  const int nblk = N / 32, kb = item / nblk, nb = item % nblk, k0 = 64 * kb, n0 = 32 * nb;
  float wreg[32];
#pragma unroll
  for (int i = 0; i < 32; ++i) { const int kk = 2 * i + (lane >> 5); wreg[i] = W[(size_t)(k0 + kk) * N + n0 + (lane & 31)]; }
#pragma unroll
  for (int i = 0; i < 32; ++i) { const int kk = 2 * i + (lane >> 5); scr[kk * 33 + (lane & 31)] = wreg[i]; }
  asm volatile("s_waitcnt lgkmcnt(0)" ::: "memory");
  const int c = lane & 7;
#pragma unroll
  for (int j = 0; j < 4; ++j) { const int n = (lane >> 3) + 8 * j; const LAS float* s = scr + (8 * c) * 33 + n;
    v4u o; o.x = pk2(s[0 * 33], s[1 * 33]); o.y = pk2(s[2 * 33], s[3 * 33]); o.z = pk2(s[4 * 33], s[5 * 33]); o.w = pk2(s[6 * 33], s[7 * 33]);
    *(v4u*)(WT + (size_t)(row_off + n0 + n) * ldo + k0 + 8 * c) = o; }
  asm volatile("s_waitcnt lgkmcnt(0)" ::: "memory");
}

struct EpiProjF32 {
  static constexpr bool PERM = false, AFTER_DRAIN = false;
  float* C; int ldc; int ncols;
  __device__ __forceinline__ void operator()(const pg8::f32x4 (&acc)[2][2][4][2], const pg8::Unit& u, int wr, int wc, int fr, int fq) const {
    const int row0 = u.pm * 256 + wr * 64 + fr, col0 = u.pn * 256 + wc * 32 + 4 * fq;
#pragma unroll
    for (int ai = 0; ai < 2; ++ai)
#pragma unroll
      for (int m = 0; m < 4; ++m) { float* rowp = C + (size_t)(row0 + ai * 128 + m * 16) * ldc + col0;
#pragma unroll
        for (int bj = 0; bj < 2; ++bj)
#pragma unroll
          for (int n = 0; n < 2; ++n) if (col0 + bj * 128 + n * 16 < ncols) *(pg8::f32x4*)(rowp + bj * 128 + n * 16) = acc[ai][bj][m][n]; }
  }
};

__device__ __forceinline__ float fsigmoid(float x) { return 1.f / (1.f + __expf(-x)); }
template <bool ACCUM> struct EpiMerge {
  static constexpr bool PERM = true, AFTER_DRAIN = false;
  const float* gate; int ldg; bf16_t* M; int ldm;
  __device__ __forceinline__ void operator()(const pg8::f32x4 (&acc)[2][2][4][2], const pg8::Unit& u, int wr, int wc, int fr, int fq) const {
    const int row0 = u.pm * 256 + wr * 64 + fr, col0 = u.pn * 256 + wc * 32 + 8 * fq;
#pragma unroll
    for (int ai = 0; ai < 2; ++ai)
#pragma unroll
      for (int m = 0; m < 4; ++m) { const size_t r = (size_t)(row0 + ai * 128 + m * 16);
#pragma unroll
        for (int bj = 0; bj < 2; ++bj) { const int c = col0 + bj * 128;
          const pg8::f32x4 g0 = *(const pg8::f32x4*)(gate + r * ldg + c), g1 = *(const pg8::f32x4*)(gate + r * ldg + c + 4);
          pg8::f32x4 v0 = acc[ai][bj][m][0], v1 = acc[ai][bj][m][1];
#pragma unroll
          for (int e = 0; e < 4; ++e) { v0[e] *= fsigmoid(g0[e]); v1[e] *= fsigmoid(g1[e]); }
          v4u* dst = (v4u*)(M + r * ldm + c);
          if (ACCUM) { const v4u o = *dst; v0[0] += bf2f(o.x & 0xffff); v0[1] += bf2f(o.x >> 16); v0[2] += bf2f(o.y & 0xffff); v0[3] += bf2f(o.y >> 16);
            v1[0] += bf2f(o.z & 0xffff); v1[1] += bf2f(o.z >> 16); v1[2] += bf2f(o.w & 0xffff); v1[3] += bf2f(o.w >> 16); }
          v4u o2; o2.x = pk2(v0[0], v0[1]); o2.y = pk2(v0[2], v0[3]); o2.z = pk2(v1[0], v1[1]); o2.w = pk2(v1[2], v1[3]); *dst = o2; } }
  }
};
struct EpiOut {
  static constexpr bool PERM = false, AFTER_DRAIN = false;
  const float* resL; float* outL; const float* gL;
  const float* resC; float* outC; const float* gC;
  __device__ __forceinline__ void operator()(const pg8::f32x4 (&acc)[2][2][4][2], const pg8::Unit& u, int wr, int wc, int fr, int fq) const {
    const bool isc = u.pm == 16; if (isc && outC == nullptr) return;
    const float* res = isc ? resC : resL; float* out = isc ? outC : outL; const float* gv = isc ? gC : gL;
    const int row0 = (isc ? 0 : u.pm * 256) + wr * 64 + fr, col0 = u.pn * 256 + wc * 32 + 4 * fq;
    pg8::f32x4 gg[2][2];
#pragma unroll
    for (int bj = 0; bj < 2; ++bj)
#pragma unroll
      for (int n = 0; n < 2; ++n) gg[bj][n] = *(const pg8::f32x4*)(gv + col0 + bj * 128 + n * 16);
#pragma unroll
    for (int ai = 0; ai < 2; ++ai)
#pragma unroll
      for (int m = 0; m < 4; ++m) { const size_t ro = (size_t)(row0 + ai * 128 + m * 16) * 1024 + col0;
#pragma unroll
        for (int bj = 0; bj < 2; ++bj)
#pragma unroll
          for (int n = 0; n < 2; ++n) { const pg8::f32x4 rv = *(const pg8::f32x4*)(res + ro + bj * 128 + n * 16); *(pg8::f32x4*)(out + ro + bj * 128 + n * 16) = rv + gg[bj][n] * acc[ai][bj][m][n]; } }
  }
};
namespace att {
using bf16 = __hip_bfloat16;
constexpr int D = 128, NW = 8, QBLK = 32, KVBLK = 64; constexpr float SCALE = 0.088388347648318440f; constexpr float THR = 8.f; constexpr int SDEPTH = 2;
constexpr size_t SHM_V = KVBLK * D * 2, SHM_K = KVBLK * D * 2, SHM_ATTN = 2 * SHM_V + 2 * SHM_K + NW * 64 * 4;
using bf16x8 = __attribute__((ext_vector_type(8))) short;
using s16x4  = __attribute__((ext_vector_type(4))) short;
using f32x16 = __attribute__((ext_vector_type(16))) float;
using f32x8  = __attribute__((ext_vector_type(8))) float;
using u32x4  = __attribute__((ext_vector_type(4))) unsigned;
#define KSWZ(row, colB) ((row) * 256 + ((colB) ^ (((row) & 7) << 4)))
#define SBAR() __builtin_amdgcn_sched_barrier(0)
__device__ __forceinline__ int crow(int r, int hi) { return (r & 3) + 8 * (r >> 2) + 4 * hi; }
__device__ __forceinline__ unsigned cvtpk(float lo, float hi) {
  unsigned r; asm volatile("v_cvt_pk_bf16_f32 %0, %1, %2" : "=v"(r) : "v"(lo), "v"(hi)); return r;
}
template <typename TIn> struct Stage;
template <> struct Stage<bf16>  { using T = bf16x8;
  __device__ static __forceinline__ T ld8(const bf16* p) { return *reinterpret_cast<const bf16x8*>(p); }
  __device__ static __forceinline__ bf16x8 tobf(T x) { return x; } };
template <> struct Stage<float> { using T = f32x8;
  __device__ static __forceinline__ T ld8(const float* p) { return *reinterpret_cast<const f32x8*>(p); }
  __device__ static __forceinline__ bf16x8 tobf(T x) {
    u32x4 w = {cvtpk(x[0], x[1]), cvtpk(x[2], x[3]), cvtpk(x[4], x[5]), cvtpk(x[6], x[7])}; return *reinterpret_cast<bf16x8*>(&w); } };

__device__ __forceinline__ void partialSM(f32x16& p0, f32x16& p1, float& m_reg, float& mn, float& alpha) {
  constexpr float C = SCALE * 1.4426950408889634f;
  float pmax = p0[0]; for (int r = 1; r < 16; ++r) pmax = fmaxf(pmax, p0[r]); for (int r = 0; r < 16; ++r) pmax = fmaxf(pmax, p1[r]);
  { auto rr = __builtin_amdgcn_permlane32_swap(__float_as_uint(pmax), __float_as_uint(pmax), false, false);
    pmax = fmaxf(__uint_as_float(rr[0]), __uint_as_float(rr[1])); }
  if (__builtin_expect(__all(pmax - m_reg <= THR / SCALE), 1)) { mn = m_reg; alpha = 1.f; }
  else { mn = fmaxf(m_reg, pmax); alpha = __builtin_amdgcn_exp2f((m_reg - mn) * C); m_reg = mn; }
  float mnC = -mn * C;
  for (int r = 0; r < 16; ++r) p0[r] = fmaf(p0[r], C, mnC); for (int r = 0; r < 16; ++r) p1[r] = fmaf(p1[r], C, mnC);
  for (int r = 0; r < 16; ++r) p0[r] = __builtin_amdgcn_exp2f(p0[r]);
}
__device__ __forceinline__ void finishSM(f32x16& p0, f32x16& p1, float alpha, float& l_reg, bf16x8& pa0, bf16x8& pa1, bf16x8& pa2, bf16x8& pa3) {
  for (int r = 0; r < 16; ++r) p1[r] = __builtin_amdgcn_exp2f(p1[r]);
  float ps = 0; for (int r = 0; r < 16; ++r) ps += p0[r]; for (int r = 0; r < 16; ++r) ps += p1[r];
  { auto rr = __builtin_amdgcn_permlane32_swap(__float_as_uint(ps), __float_as_uint(ps), false, false);
    ps = __uint_as_float(rr[0]) + __uint_as_float(rr[1]); }
  l_reg = l_reg * alpha + ps;
#define PK4(P, BASE, OUT) do { unsigned a0 = cvtpk(P[BASE + 0], P[BASE + 1]), a1 = cvtpk(P[BASE + 2], P[BASE + 3]);   \
    unsigned b0 = cvtpk(P[BASE + 4], P[BASE + 5]), b1 = cvtpk(P[BASE + 6], P[BASE + 7]);                              \
    auto r0 = __builtin_amdgcn_permlane32_swap(a0, b0, false, false); auto r1 = __builtin_amdgcn_permlane32_swap(a1, b1, false, false); \
    u32x4 w = {r0[0], r1[0], r0[1], r1[1]}; OUT = *reinterpret_cast<bf16x8*>(&w); } while (0)
  PK4(p0, 0, pa0); PK4(p0, 8, pa1); PK4(p1, 0, pa2); PK4(p1, 8, pa3);
#undef PK4
}
__device__ __forceinline__ void qkt(f32x16& p0, f32x16& p1, const bf16* Ks, const bf16x8* qr, int r32, int hi) {
  p0 = f32x16{}; p1 = f32x16{};
  for (int d0 = 0; d0 < 8; ++d0) { int cb = (d0 * 16 + hi * 8) * 2;
    bf16x8 b0 = *reinterpret_cast<const bf16x8*>((const char*)Ks + KSWZ(r32, cb));
    bf16x8 b1 = *reinterpret_cast<const bf16x8*>((const char*)Ks + KSWZ(32 + r32, cb));
    p0 = __builtin_amdgcn_mfma_f32_32x32x16_bf16(b0, qr[d0], p0, 0, 0, 0);
    p1 = __builtin_amdgcn_mfma_f32_32x32x16_bf16(b1, qr[d0], p1, 0, 0, 0); }
}
__device__ __forceinline__ int v_st(int k, int c) { const int kk = (k & ~0xC) | ((k & 4) << 1) | ((k & 8) >> 1); return ((kk >> 3) * 4 + (c >> 5)) * 512 + ((kk & 7) * 32 + (c & 31)) * 2; }
__device__ __forceinline__ int v_rd_base(int lane) { return ((lane & 3) << 3) | (((lane >> 2) & 3) << 6) | (((lane >> 4) & 1) << 5) | (((lane >> 5) & 1) << 8); }
constexpr int v_rd_off(int d0, int ks, int half) { return d0 * 512 + ks * 4096 + half * 2048; }
template <int OFF> __device__ __forceinline__ s16x4 tr_read(int vb) {
  s16x4 r; asm volatile("ds_read_b64_tr_b16 %0, %1 offset:%2" : "=&v"(r) : "v"(vb), "i"(OFF) : "memory"); return r;
}
template <int D0> __device__ __forceinline__ void pv_one(f32x16& od, int vb, bf16x8 pa0, bf16x8 pa1, bf16x8 pa2, bf16x8 pa3) {
  const s16x4 l0 = tr_read<v_rd_off(D0, 0, 0)>(vb), h0 = tr_read<v_rd_off(D0, 0, 1)>(vb), l1 = tr_read<v_rd_off(D0, 1, 0)>(vb), h1 = tr_read<v_rd_off(D0, 1, 1)>(vb);
  const s16x4 l2 = tr_read<v_rd_off(D0, 2, 0)>(vb), h2 = tr_read<v_rd_off(D0, 2, 1)>(vb), l3 = tr_read<v_rd_off(D0, 3, 0)>(vb), h3 = tr_read<v_rd_off(D0, 3, 1)>(vb);
  asm volatile("s_waitcnt lgkmcnt(0)" ::: "memory"); SBAR();
#define PK(L, H) (bf16x8){L[0], L[1], L[2], L[3], H[0], H[1], H[2], H[3]}
  od = __builtin_amdgcn_mfma_f32_32x32x16_bf16(pa0, PK(l0, h0), od, 0, 0, 0);
  od = __builtin_amdgcn_mfma_f32_32x32x16_bf16(pa1, PK(l1, h1), od, 0, 0, 0);
  od = __builtin_amdgcn_mfma_f32_32x32x16_bf16(pa2, PK(l2, h2), od, 0, 0, 0);
  od = __builtin_amdgcn_mfma_f32_32x32x16_bf16(pa3, PK(l3, h3), od, 0, 0, 0);
#undef PK
}
__device__ __forceinline__ void pv_d0(f32x16* o, int vb, bf16x8 pa0, bf16x8 pa1, bf16x8 pa2, bf16x8 pa3) {
  pv_one<0>(o[0], vb, pa0, pa1, pa2, pa3); pv_one<1>(o[1], vb, pa0, pa1, pa2, pa3); pv_one<2>(o[2], vb, pa0, pa1, pa2, pa3); pv_one<3>(o[3], vb, pa0, pa1, pa2, pa3);
}

template <typename TQ, int LDQ, int LDK, int LDO, bool OBF16>
__device__ __forceinline__ void attn_dense_body(const TQ* Qb, const bf16* Kh, const bf16* Vh,
                                                void* Obv, int seq, char* lds) {
  using St = Stage<bf16>; using SQ = Stage<TQ>;
  int tid = threadIdx.x; asm volatile("" : "+v"(tid)); const int wid = tid >> 6, lane = tid & 63, r32 = lane & 31, hi = lane >> 5;
  bf16* V_lds = (bf16*)lds; bf16* K_lds = (bf16*)(lds + 2 * SHM_V);
  float* ws = (float*)(lds + 2 * SHM_V + 2 * SHM_K) + wid * 64; float* li_l = ws; float* al_l = ws + 32;
  float m_reg = -1e30f, l_reg = 0; f32x16 o[4] = {}; bf16x8 qr[8];
  const TQ* Qw = Qb + (long)(wid * QBLK + r32) * LDQ + hi * 8;
#pragma unroll
  for (int d0 = 0; d0 < 8; ++d0) qr[d0] = SQ::tobf(SQ::ld8(Qw + d0 * 16));
  const int sr = tid >> 4, sc = (tid & 15) * 8, vst0 = v_st(sr, sc), vst1 = v_st(32 + sr, sc);
  const int vb0 = (int)(uintptr_t)V_lds + v_rd_base(lane);
  struct { typename St::T vs0, vs1, ks0, ks1; } sr_[SDEPTH];
#define SLOAD(i, k0) do { sr_[i].vs0 = St::ld8(&Vh[(long)((k0) + sr) * LDK + sc]); sr_[i].vs1 = St::ld8(&Vh[(long)((k0) + 32 + sr) * LDK + sc]); \
    sr_[i].ks0 = St::ld8(&Kh[(long)((k0) + sr) * LDK + sc]); sr_[i].ks1 = St::ld8(&Kh[(long)((k0) + 32 + sr) * LDK + sc]); } while (0)
#define SWRITE(b, i) do { *(bf16x8*)((char*)V_lds + (b) * SHM_V + vst0) = St::tobf(sr_[i].vs0);          \
    *(bf16x8*)((char*)V_lds + (b) * SHM_V + vst1) = St::tobf(sr_[i].vs1); int kc = sc * 2;               \
    *(bf16x8*)((char*)K_lds + (b) * SHM_K + KSWZ(sr, kc)) = St::tobf(sr_[i].ks0);                       \
    *(bf16x8*)((char*)K_lds + (b) * SHM_K + KSWZ(32 + sr, kc)) = St::tobf(sr_[i].ks1); } while (0)
#define SWAIT() do { if constexpr (SDEPTH == 2) asm volatile("s_waitcnt vmcnt(4)" ::: "memory"); else asm volatile("s_waitcnt vmcnt(0)" ::: "memory"); } while (0)
#define RESC(a) do { if (__any((a) < 1.f)) { if (hi == 0) al_l[r32] = (a); asm volatile("s_waitcnt lgkmcnt(0)" ::: "memory"); \
    for (int d = 0; d < 4; ++d) for (int r = 0; r < 16; ++r) o[d][r] *= al_l[crow(r, hi)]; } } while (0)
  f32x16 pA0, pA1, pB0, pB1; float mnA, mnB, alA, alB; bf16x8 pa0, pa1, pa2, pa3; const int NT = seq / KVBLK;
  constexpr int SE = 0, SO = SDEPTH - 1;
  SLOAD(SE, 0); asm volatile("s_waitcnt vmcnt(0)" ::: "memory"); SWRITE(0, SE); __syncthreads();
  qkt(pA0, pA1, K_lds, qr, r32, hi); partialSM(pA0, pA1, m_reg, mnA, alA);
  SLOAD(SO, KVBLK); if constexpr (SDEPTH == 2) { if (2 < NT) SLOAD(SE, 2 * KVBLK); }
  SWAIT(); SWRITE(1, SO); __syncthreads();
  for (int j = 1; j + 1 < NT; j += 2) {
    SBAR(); qkt(pB0, pB1, (bf16*)((char*)K_lds + SHM_K), qr, r32, hi);
    finishSM(pA0, pA1, alA, l_reg, pa0, pa1, pa2, pa3); SBAR();
    SLOAD(SO, (j + SDEPTH) * KVBLK); SBAR();
    pv_d0(o, vb0, pa0, pa1, pa2, pa3); partialSM(pB0, pB1, m_reg, mnB, alB);
    __syncthreads(); SWAIT(); SWRITE(0, SE);
    RESC(alB); __syncthreads();
    SBAR(); qkt(pA0, pA1, K_lds, qr, r32, hi);
    finishSM(pB0, pB1, alB, l_reg, pa0, pa1, pa2, pa3); SBAR();
    if (SDEPTH == 1 || j + 3 < NT) SLOAD(SE, (j + 1 + SDEPTH) * KVBLK); SBAR();
    pv_d0(o, vb0 + (int)SHM_V, pa0, pa1, pa2, pa3); partialSM(pA0, pA1, m_reg, mnA, alA);
    __syncthreads(); SWAIT(); SWRITE(1, SO);
    RESC(alA); __syncthreads();
  }
  SBAR(); qkt(pB0, pB1, (bf16*)((char*)K_lds + SHM_K), qr, r32, hi);
  finishSM(pA0, pA1, alA, l_reg, pa0, pa1, pa2, pa3); SBAR();
  pv_d0(o, vb0, pa0, pa1, pa2, pa3); partialSM(pB0, pB1, m_reg, mnB, alB);
  __syncthreads(); RESC(alB);
  finishSM(pB0, pB1, alB, l_reg, pa0, pa1, pa2, pa3); SBAR();
  pv_d0(o, vb0 + (int)SHM_V, pa0, pa1, pa2, pa3);
  if (hi == 0) li_l[r32] = l_reg; asm volatile("s_waitcnt lgkmcnt(0)" ::: "memory");
  float rli[16];
#pragma unroll
  for (int r = 0; r < 16; ++r) rli[r] = __builtin_amdgcn_rcpf(li_l[crow(r, hi)]);
  if constexpr (!OBF16) { float* Ow = (float*)Obv + (long)(wid * QBLK) * LDO;
#pragma unroll
  for (int r = 0; r < 16; ++r) { int orow = crow(r, hi);
    for (int d0 = 0; d0 < 4; ++d0) Ow[(long)orow * LDO + d0 * 32 + r32] = o[d0][r] * rli[r]; }
  } else { unsigned short* Ow = (unsigned short*)Obv + (long)(wid * QBLK) * LDO;
#pragma unroll
  for (int r = 0; r < 16; ++r) { int orow = crow(r, hi);
    for (int d0 = 0; d0 < 4; ++d0) { const unsigned pk = cvtpk(o[d0][r] * rli[r], 0.f); Ow[(long)orow * LDO + d0 * 32 + r32] = (unsigned short)(pk & 0xffffu); } }
  }
#undef SLOAD
#undef SWRITE
#undef SWAIT
#undef RESC
}
#undef KSWZ
#undef SBAR
}
namespace gla {
typedef float f32x16 __attribute__((ext_vector_type(16)));
typedef float f32x4v __attribute__((ext_vector_type(4)));
constexpr int LD = 65;
constexpr int OX = 0, OY = 2 * 64 * LD * 4, OV = 4 * 64 * LD * 4, OAL = OV + 64 * 128 * 4, OW2 = OAL + 64 * 32 * 4, OBA = OW2 + 2 * 16 * 64 * 4, OTOT = OBA + 2 * 64 * 4, OEND = OTOT + 2 * 64 * 4 * 4;
static_assert(OEND <= 131072, "gla lds");
static_assert(64 * 129 * 4 <= 2 * 64 * LD * 4, "O stage fits in X");

struct In {
  const bf16_t* q; const bf16_t* k; const bf16_t* v; const bf16_t* ga; const bf16_t* og; int ld;
  const float* wa2; const float* ba; const float* gnorm;
  float* cs;
  bf16_t* csb;
  float* dec;
  bf16_t* y; int ldy;
  int S, C;
};
__device__ __forceinline__ long chunk_row(const In& p, int cid) { return cid < p.S / 64 ? (long)cid * 64 : (long)p.S + (long)(cid - p.S / 64) * 64; }
__device__ __forceinline__ float logsig(float x) { return x < 0.f ? x - __logf(1.f + __expf(x)) : -__logf(1.f + __expf(-x)); }

__device__ __forceinline__ void cum_phase(const In& p, LAS unsigned char* lds, int head, long row0, int tid) {
  LAS float* AL = (LAS float*)(lds + OAL); LAS float* W2 = (LAS float*)(lds + OW2); LAS float* BA = (LAS float*)(lds + OBA); LAS float* TOT = (LAS float*)(lds + OTOT);
  { const int t = tid >> 3, r4 = (tid & 7) * 4; const unsigned long long u = *(const unsigned long long*)(p.ga + (row0 + t) * p.ld + r4);
    f32x4v a4; a4[0] = bf2f((bf16_t)u); a4[1] = bf2f((bf16_t)(u >> 16)); a4[2] = bf2f((bf16_t)(u >> 32)); a4[3] = bf2f((bf16_t)(u >> 48)); *(LAS f32x4v*)(AL + t * 32 + r4) = a4; }
  { const int e = tid * 4, dir = e >> 10, r = (e >> 6) & 15, j = e & 63; *(LAS f32x4v*)(W2 + e) = *(const f32x4v*)(p.wa2 + ((long)dir * 16 + r) * 256 + head * 64 + j); }
  if (tid < 128) BA[tid] = p.ba[(tid >> 6) * 256 + head * 64 + (tid & 63)];
  __syncthreads();
  const int dir = tid >> 8, j = tid & 63, seg = (tid >> 6) & 3;
  float w[16];
#pragma unroll
  for (int r = 0; r < 16; ++r) w[r] = W2[(dir * 16 + r) * 64 + j];
  const float bj = BA[dir * 64 + j];
  float c[16];
#pragma unroll
  for (int k = 0; k < 16; ++k) { const int t = seg * 16 + k; float z = bj;
#pragma unroll
    for (int r4 = 0; r4 < 4; ++r4) { const f32x4v a4 = *(const LAS f32x4v*)(AL + t * 32 + dir * 16 + 4 * r4); z += a4[0] * w[4 * r4] + a4[1] * w[4 * r4 + 1] + a4[2] * w[4 * r4 + 2] + a4[3] * w[4 * r4 + 3]; }
    c[k] = logsig(z) * (1.f / 16.f); }
  if (dir == 0) {
#pragma unroll
    for (int k = 1; k < 16; ++k) c[k] += c[k - 1];
    TOT[(dir * 64 + j) * 4 + seg] = c[15];
  } else {
#pragma unroll
    for (int k = 14; k >= 0; --k) c[k] += c[k + 1];
    TOT[(dir * 64 + j) * 4 + seg] = c[0];
  }
  __syncthreads();
  float off = 0.f;
#pragma unroll
  for (int s = 0; s < 4; ++s) { const float tv = TOT[(dir * 64 + j) * 4 + s]; if (dir == 0 ? s < seg : s > seg) off += tv; }
  LAS float* X = (LAS float*)(lds + OX) + dir * 64 * LD;
#pragma unroll
  for (int k = 0; k < 16; ++k) X[(seg * 16 + k) * LD + j] = c[k] + off;
}
struct VRegs { unsigned long long u[4]; };
__device__ __forceinline__ VRegs load_v_regs(const In& p, int head, long row0, int tid) { VRegs r;
#pragma unroll
  for (int m = 0; m < 4; ++m) { const int t = (tid >> 5) + 16 * m, c4 = (tid & 31) * 4; r.u[m] = *(const unsigned long long*)(p.v + (row0 + t) * p.ld + head * 128 + c4); }
  return r; }
__device__ __forceinline__ void store_v(const VRegs& r, LAS unsigned char* lds, int tid) {
  LAS float* V = (LAS float*)(lds + OV);
#pragma unroll
  for (int m = 0; m < 4; ++m) { const int t = (tid >> 5) + 16 * m, c4 = (tid & 31) * 4; const unsigned long long u = r.u[m];
    f32x4v a4; a4[0] = bf2f((bf16_t)u); a4[1] = bf2f((bf16_t)(u >> 16)); a4[2] = bf2f((bf16_t)(u >> 32)); a4[3] = bf2f((bf16_t)(u >> 48)); *(LAS f32x4v*)(V + t * 128 + c4) = a4; }
}

__device__ __forceinline__ void g1_unit(const In& p, LAS unsigned char* lds, int head, int cid, int GH, int NCH) {
  int tid = threadIdx.x; asm volatile("" : "+v"(tid));
  const int lane = tid & 63, w = __builtin_amdgcn_readfirstlane(tid >> 6);
  const long row0 = chunk_row(p, cid);
  const VRegs vr = load_v_regs(p, head, row0, tid);
  bf16_t kreg[8];
#pragma unroll
  for (int m = 0; m < 8; ++m) kreg[m] = p.k[(row0 + (tid >> 6) + 8 * m) * p.ld + head * 64 + (tid & 63)];
  cum_phase(p, lds, head, row0, tid);
  store_v(vr, lds, tid);
  __syncthreads();
  LAS float* TOT = (LAS float*)(lds + OTOT);
  { const int j = tid & 63;
#pragma unroll
    for (int dir = 0; dir < 2; ++dir) { LAS float* X = (LAS float*)(lds + OX) + dir * 64 * LD;
      const float cl = TOT[(dir * 64 + j) * 4 + 0] + TOT[(dir * 64 + j) * 4 + 1] + TOT[(dir * 64 + j) * 4 + 2] + TOT[(dir * 64 + j) * 4 + 3];
#pragma unroll
      for (int m = 0; m < 8; ++m) { const int t = (tid >> 6) + 8 * m; const float kv = bf2f(kreg[m]); X[t * LD + j] = kv * __expf(cl - X[t * LD + j]); }
      if (tid < 64) p.dec[(((long)dir * GH + head) * NCH + cid) * 64 + j] = __expf(cl); }
  }
  __syncthreads();
  { const int dir = w >> 2, di = (w >> 1) & 1, vj0 = (w & 1) * 2; const LAS float* X = (const LAS float*)(lds + OX) + dir * 64 * LD; const LAS float* V = (const LAS float*)(lds + OV);
    f32x16 a0 = {}, a1 = {}; const int li = lane & 31, lk = lane >> 5;
#pragma unroll 4
    for (int s0 = 0; s0 < 64; s0 += 2) { const float av = X[(s0 + lk) * LD + 32 * di + li]; const float b0 = V[(s0 + lk) * 128 + 32 * vj0 + li], b1 = V[(s0 + lk) * 128 + 32 * vj0 + 32 + li];
      a0 = __builtin_amdgcn_mfma_f32_32x32x2f32(av, b0, a0, 0, 0, 0); a1 = __builtin_amdgcn_mfma_f32_32x32x2f32(av, b1, a1, 0, 0, 0); }
    float* dst = p.cs + ((((long)dir * GH + head) * NCH + cid) * 64) * 128;
#pragma unroll
    for (int r = 0; r < 16; ++r) { const int d = 32 * di + (r & 3) + 8 * (r >> 2) + 4 * lk; dst[(long)d * 128 + 32 * vj0 + li] = a0[r]; dst[(long)d * 128 + 32 * vj0 + 32 + li] = a1[r]; }
  }
  __syncthreads();
}
__device__ __forceinline__ void g2_item(const In& p, long idx, int GH, int NCH) {
  const int v = 2 * (int)(idx & 63), d = (int)((idx >> 6) & 63); const int hd = (int)((idx >> 12) % GH), dir = (int)((idx >> 12) / GH);
  const int nl = p.S / 64, nc = p.C / 64; float st0 = 0.f, st1 = 0.f;
  bf16_t* base = p.csb + (((long)dir * GH + hd) * NCH) * 64 * 128 + (long)d * 128 + v; const float* db = p.dec + (((long)dir * GH + hd) * NCH) * 64 + d;
  for (int s0 = 0; s0 < nl + nc; s0 += 4) { unsigned c[4]; float dc[4]; unsigned* pp[4];
#pragma unroll
    for (int k = 0; k < 4; ++k) { const int step = s0 + k; int cid; if (step < nc) cid = nl + (dir ? nc - 1 - step : step); else cid = dir ? nl - 1 - (step - nc) : step - nc;
      pp[k] = (unsigned*)(base + (long)cid * 64 * 128); c[k] = *pp[k]; dc[k] = db[(long)cid * 64]; }
#pragma unroll
    for (int k = 0; k < 4; ++k) { *pp[k] = pk2(st0, st1); st0 = dc[k] * st0 + __uint_as_float(c[k] << 16); st1 = dc[k] * st1 + __uint_as_float(c[k] & 0xffff0000u); } }
}
__device__ __forceinline__ void g3_unit(const In& p, LAS unsigned char* lds, int head, int cid, int GH, int NCH) {
  int tid = threadIdx.x; asm volatile("" : "+v"(tid));
  const int lane = tid & 63, w = __builtin_amdgcn_readfirstlane(tid >> 6), li = lane & 31, lk = lane >> 5;
  const long row0 = chunk_row(p, cid);
  float spf[2][32];
  { const int vj_ = w & 3;
#pragma unroll
    for (int dir = 0; dir < 2; ++dir) { const float* sp = p.cs + ((((long)dir * GH + head) * NCH + cid) * 64) * 128 + 32 * vj_ + li;
#pragma unroll
      for (int i = 0; i < 32; ++i) spf[dir][i] = sp[(long)(2 * i + lk) * 128]; } }
  const VRegs vr = load_v_regs(p, head, row0, tid);
  bf16_t kreg[8], qreg[8];
#pragma unroll
  for (int m = 0; m < 8; ++m) { const long o_ = (row0 + (tid >> 6) + 8 * m) * p.ld + head * 64 + (tid & 63); kreg[m] = p.k[o_]; qreg[m] = p.q[o_]; }
  cum_phase(p, lds, head, row0, tid);
  store_v(vr, lds, tid);
  __syncthreads();
  { const int j = tid & 63;
#pragma unroll
    for (int dir = 0; dir < 2; ++dir) { LAS float* X = (LAS float*)(lds + OX) + dir * 64 * LD; LAS float* Y = (LAS float*)(lds + OY) + dir * 64 * LD;
#pragma unroll
      for (int m = 0; m < 8; ++m) { const int t = (tid >> 6) + 8 * m; const float c = X[t * LD + j];
        const float qv = bf2f(qreg[m]) * 0.125f, kv = bf2f(kreg[m]);
        X[t * LD + j] = qv * __expf(c); Y[t * LD + j] = kv * __expf(-c); } }
  }
  __syncthreads();
  {
    const int dir = w >> 2, qi = (w >> 1) & 1, si = w & 1; const bool zero = dir == 0 ? si > qi : si < qi;
    const LAS float* X = (const LAS float*)(lds + OX) + dir * 64 * LD; LAS float* Y = (LAS float*)(lds + OY) + dir * 64 * LD;
    f32x16 pa = {};
    if (!zero) {
#pragma unroll 4
      for (int d0 = 0; d0 < 64; d0 += 2) pa = __builtin_amdgcn_mfma_f32_32x32x2f32(X[(32 * qi + li) * LD + d0 + lk], Y[(32 * si + li) * LD + d0 + lk], pa, 0, 0, 0);
    }
    __syncthreads();
#pragma unroll
    for (int r = 0; r < 16; ++r) { const int q = 32 * qi + (r & 3) + 8 * (r >> 2) + 4 * lk, s = 32 * si + li; const bool keep = dir == 0 ? s <= q : s >= q;
      Y[q * LD + s] = keep ? pa[r] : 0.f; }
  }
  __syncthreads();
  f32x16 acc = {};
  { const int qi = w >> 2, vj = w & 3; const LAS float* V = (const LAS float*)(lds + OV);
#pragma unroll
    for (int dir = 0; dir < 2; ++dir) { const LAS float* X = (const LAS float*)(lds + OX) + dir * 64 * LD; const LAS float* Y = (const LAS float*)(lds + OY) + dir * 64 * LD;
#pragma unroll 4
      for (int s0 = 0; s0 < 64; s0 += 2) acc = __builtin_amdgcn_mfma_f32_32x32x2f32(Y[(32 * qi + li) * LD + s0 + lk], V[(s0 + lk) * 128 + 32 * vj + li], acc, 0, 0, 0);
#pragma unroll
      for (int i = 0; i < 32; ++i) acc = __builtin_amdgcn_mfma_f32_32x32x2f32(X[(32 * qi + li) * LD + 2 * i + lk], spf[dir][i], acc, 0, 0, 0);
    }
    __syncthreads();
    LAS float* O = (LAS float*)(lds + OX);
#pragma unroll
    for (int r = 0; r < 16; ++r) { const int q = 32 * qi + (r & 3) + 8 * (r >> 2) + 4 * lk; O[q * 129 + 32 * vj + li] = acc[r]; }
  }
  __syncthreads();
  { const int row = tid >> 3, part = tid & 7; const LAS float* O = (const LAS float*)(lds + OX) + row * 129 + part * 16;
    float o[16]; float ss = 0.f;
#pragma unroll
    for (int k = 0; k < 16; ++k) { o[k] = O[k]; ss += o[k] * o[k]; }
    ss += __shfl_xor(ss, 1); ss += __shfl_xor(ss, 2); ss += __shfl_xor(ss, 4);
    const float rs = 1.f / sqrtf(ss * (1.f / 128.f) + 1e-6f);
    const bf16_t* ogp = p.og + (row0 + row) * p.ld + head * 128 + part * 16; const v4u og0 = *(const v4u*)ogp, og1 = *(const v4u*)(ogp + 8);
    const unsigned ogw[8] = {og0.x, og0.y, og0.z, og0.w, og1.x, og1.y, og1.z, og1.w}; bf16_t* yp = p.y + (row0 + row) * p.ldy + head * 128 + part * 16; float yy[16];
#pragma unroll
    for (int k4 = 0; k4 < 4; ++k4) { f32x4v g4; g4[0] = bf2f((bf16_t)(ogw[2 * k4] & 0xffff)); g4[1] = bf2f((bf16_t)(ogw[2 * k4] >> 16)); g4[2] = bf2f((bf16_t)(ogw[2 * k4 + 1] & 0xffff)); g4[3] = bf2f((bf16_t)(ogw[2 * k4 + 1] >> 16)); const f32x4v n4 = *(const f32x4v*)(p.gnorm + part * 16 + 4 * k4); f32x4v y4;
#pragma unroll
      for (int e = 0; e < 4; ++e) { const float gg = g4[e]; y4[e] = o[4 * k4 + e] * rs * n4[e] * (gg / (1.f + __expf(-gg))); yy[4 * k4 + e] = y4[e]; } }
    { v4u o0, o1; o0.x = pk2(yy[0], yy[1]); o0.y = pk2(yy[2], yy[3]); o0.z = pk2(yy[4], yy[5]); o0.w = pk2(yy[6], yy[7]);
      o1.x = pk2(yy[8], yy[9]); o1.y = pk2(yy[10], yy[11]); o1.z = pk2(yy[12], yy[13]); o1.w = pk2(yy[14], yy[15]); *(v4u*)yp = o0; *(v4u*)(yp + 8) = o1; }
  }
  __syncthreads();
}

typedef short bf16x8g __attribute__((ext_vector_type(8)));
constexpr int LB = 72;
constexpr int OQB = 2 * 64 * LD * 4, OKB = OQB + 2 * 64 * LB * 2, OVT = OKB + 2 * 64 * LB * 2, OBEND = OVT + 128 * LB * 2;
static_assert(OBEND <= OAL, "gla bf16 lds");
#define GMM(A, B, C) C = __builtin_amdgcn_mfma_f32_32x32x16_bf16(__builtin_bit_cast(bf16x8g, A), __builtin_bit_cast(bf16x8g, B), C, 0, 0, 0)
__device__ __forceinline__ void store_vt(const VRegs& r, LAS unsigned char* lds, int tid) {
  LAS bf16_t* Vt = (LAS bf16_t*)(lds + OVT);
#pragma unroll
  for (int m = 0; m < 4; ++m) { const int t = (tid >> 5) + 16 * m, c4 = (tid & 31) * 4; const unsigned long long u = r.u[m];
    Vt[(c4 + 0) * LB + t] = (bf16_t)u; Vt[(c4 + 1) * LB + t] = (bf16_t)(u >> 16); Vt[(c4 + 2) * LB + t] = (bf16_t)(u >> 32); Vt[(c4 + 3) * LB + t] = (bf16_t)(u >> 48); }
}
__device__ __forceinline__ void g1b_unit(const In& p, LAS unsigned char* lds, int head, int cid, int GH, int NCH) {
  int tid = threadIdx.x; asm volatile("" : "+v"(tid));
  const int lane = tid & 63, w = __builtin_amdgcn_readfirstlane(tid >> 6), li = lane & 31, lk = lane >> 5;
  const long row0 = chunk_row(p, cid);
  const VRegs vr = load_v_regs(p, head, row0, tid);
  bf16_t kreg[8];
#pragma unroll
  for (int m = 0; m < 8; ++m) kreg[m] = p.k[(row0 + (tid >> 6) + 8 * m) * p.ld + head * 64 + (tid & 63)];
  cum_phase(p, lds, head, row0, tid);
  store_vt(vr, lds, tid);
  __syncthreads();
  LAS float* TOT = (LAS float*)(lds + OTOT);
  { const int j = tid & 63;
#pragma unroll
    for (int dir = 0; dir < 2; ++dir) { const LAS float* X = (const LAS float*)(lds + OX) + dir * 64 * LD; LAS bf16_t* KeT = (LAS bf16_t*)(lds + OQB) + dir * 64 * LB;
      const float cl = TOT[(dir * 64 + j) * 4 + 0] + TOT[(dir * 64 + j) * 4 + 1] + TOT[(dir * 64 + j) * 4 + 2] + TOT[(dir * 64 + j) * 4 + 3];
#pragma unroll
      for (int m = 0; m < 8; ++m) { const int t = (tid >> 6) + 8 * m; KeT[j * LB + t] = (bf16_t)f2bf(bf2f(kreg[m]) * __expf(cl - X[t * LD + j])); }
      if (tid < 64) p.dec[(((long)dir * GH + head) * NCH + cid) * 64 + j] = __expf(cl); }
  }
  __syncthreads();
  { const int dir = w >> 2, di = (w >> 1) & 1, vj0 = (w & 1) * 2; const LAS bf16_t* KeT = (const LAS bf16_t*)(lds + OQB) + dir * 64 * LB; const LAS bf16_t* Vt = (const LAS bf16_t*)(lds + OVT);
    f32x16 a0 = {}, a1 = {};
#pragma unroll
    for (int kk = 0; kk < 4; ++kk) { const v4u av = *(const LAS v4u*)(KeT + (32 * di + li) * LB + 16 * kk + 8 * lk);
      const v4u b0 = *(const LAS v4u*)(Vt + (32 * vj0 + li) * LB + 16 * kk + 8 * lk), b1 = *(const LAS v4u*)(Vt + (32 * vj0 + 32 + li) * LB + 16 * kk + 8 * lk);
      GMM(av, b0, a0); GMM(av, b1, a1); }
    bf16_t* dst = p.csb + ((((long)dir * GH + head) * NCH + cid) * 64) * 128;
#pragma unroll
    for (int r = 0; r < 16; ++r) { const int d = 32 * di + (r & 3) + 8 * (r >> 2) + 4 * lk; dst[(long)d * 128 + 32 * vj0 + li] = (bf16_t)f2bf(a0[r]); dst[(long)d * 128 + 32 * vj0 + 32 + li] = (bf16_t)f2bf(a1[r]); }
  }
  __syncthreads();
}
__device__ __forceinline__ void g3b_unit(const In& p, LAS unsigned char* lds, int head, int cid, int GH, int NCH) {
  int tid = threadIdx.x; asm volatile("" : "+v"(tid));
  const int lane = tid & 63, w = __builtin_amdgcn_readfirstlane(tid >> 6), li = lane & 31, lk = lane >> 5;
  const long row0 = chunk_row(p, cid);
  unsigned spf[2][32];
  { const int vj_ = w & 3;
#pragma unroll
    for (int dir = 0; dir < 2; ++dir) { const bf16_t* sp = p.csb + ((((long)dir * GH + head) * NCH + cid) * 64) * 128 + 32 * vj_ + li;
#pragma unroll
      for (int i = 0; i < 32; ++i) spf[dir][i] = sp[(long)(16 * (i >> 3) + 8 * lk + (i & 7)) * 128]; } }
  const VRegs vr = load_v_regs(p, head, row0, tid);
  bf16_t kreg[8], qreg[8];
#pragma unroll
  for (int m = 0; m < 8; ++m) { const long o_ = (row0 + (tid >> 6) + 8 * m) * p.ld + head * 64 + (tid & 63); kreg[m] = p.k[o_]; qreg[m] = p.q[o_]; }
  cum_phase(p, lds, head, row0, tid);
  store_vt(vr, lds, tid);
  __syncthreads();
  { const int j = tid & 63;
#pragma unroll
    for (int dir = 0; dir < 2; ++dir) { const LAS float* X = (const LAS float*)(lds + OX) + dir * 64 * LD; LAS bf16_t* Qb = (LAS bf16_t*)(lds + OQB) + dir * 64 * LB; LAS bf16_t* Kb = (LAS bf16_t*)(lds + OKB) + dir * 64 * LB;
#pragma unroll
      for (int m = 0; m < 8; ++m) { const int t = (tid >> 6) + 8 * m; const float c = X[t * LD + j];
        Qb[t * LB + j] = (bf16_t)f2bf(bf2f(qreg[m]) * 0.125f * __expf(c)); Kb[t * LB + j] = (bf16_t)f2bf(bf2f(kreg[m]) * __expf(-c)); } }
  }
  __syncthreads();
  {
    const int dir = w >> 2, qi = (w >> 1) & 1, si = w & 1; const bool zero = dir == 0 ? si > qi : si < qi;
    const LAS bf16_t* Qb = (const LAS bf16_t*)(lds + OQB) + dir * 64 * LB; LAS bf16_t* Kb = (LAS bf16_t*)(lds + OKB) + dir * 64 * LB;
    f32x16 pa = {};
    if (!zero) {
#pragma unroll
      for (int kk = 0; kk < 4; ++kk) { const v4u av = *(const LAS v4u*)(Qb + (32 * qi + li) * LB + 16 * kk + 8 * lk), bv = *(const LAS v4u*)(Kb + (32 * si + li) * LB + 16 * kk + 8 * lk); GMM(av, bv, pa); }
    }
    __syncthreads();
#pragma unroll
    for (int r = 0; r < 16; ++r) { const int q = 32 * qi + (r & 3) + 8 * (r >> 2) + 4 * lk, s = 32 * si + li; const bool keep = dir == 0 ? s <= q : s >= q;
      Kb[q * LB + s] = (bf16_t)f2bf(keep ? pa[r] : 0.f); }
  }
  __syncthreads();
  f32x16 acc = {};
  { const int qi = w >> 2, vj = w & 3; const LAS bf16_t* Vt = (const LAS bf16_t*)(lds + OVT);
#pragma unroll
    for (int dir = 0; dir < 2; ++dir) { const LAS bf16_t* Qb = (const LAS bf16_t*)(lds + OQB) + dir * 64 * LB; const LAS bf16_t* Pb = (const LAS bf16_t*)(lds + OKB) + dir * 64 * LB;
#pragma unroll
      for (int kk = 0; kk < 4; ++kk) { const v4u av = *(const LAS v4u*)(Pb + (32 * qi + li) * LB + 16 * kk + 8 * lk), bv = *(const LAS v4u*)(Vt + (32 * vj + li) * LB + 16 * kk + 8 * lk); GMM(av, bv, acc); }
#pragma unroll
      for (int kk = 0; kk < 4; ++kk) { const v4u av = *(const LAS v4u*)(Qb + (32 * qi + li) * LB + 16 * kk + 8 * lk);
        v4u bv; bv.x = spf[dir][8 * kk + 0] | (spf[dir][8 * kk + 1] << 16); bv.y = spf[dir][8 * kk + 2] | (spf[dir][8 * kk + 3] << 16); bv.z = spf[dir][8 * kk + 4] | (spf[dir][8 * kk + 5] << 16); bv.w = spf[dir][8 * kk + 6] | (spf[dir][8 * kk + 7] << 16);
        GMM(av, bv, acc); }
    }
    LAS float* O = (LAS float*)(lds + OX);
#pragma unroll
    for (int r = 0; r < 16; ++r) { const int q = 32 * qi + (r & 3) + 8 * (r >> 2) + 4 * lk; O[q * 129 + 32 * vj + li] = acc[r]; }
  }
  __syncthreads();
  { const int row = tid >> 3, part = tid & 7; const LAS float* O = (const LAS float*)(lds + OX) + row * 129 + part * 16;
    float o[16]; float ss = 0.f;
#pragma unroll
    for (int k = 0; k < 16; ++k) { o[k] = O[k]; ss += o[k] * o[k]; }
    ss += __shfl_xor(ss, 1); ss += __shfl_xor(ss, 2); ss += __shfl_xor(ss, 4);
    const float rs = 1.f / sqrtf(ss * (1.f / 128.f) + 1e-6f);
    const bf16_t* ogp = p.og + (row0 + row) * p.ld + head * 128 + part * 16; const v4u og0 = *(const v4u*)ogp, og1 = *(const v4u*)(ogp + 8);
    const unsigned ogw[8] = {og0.x, og0.y, og0.z, og0.w, og1.x, og1.y, og1.z, og1.w}; bf16_t* yp = p.y + (row0 + row) * p.ldy + head * 128 + part * 16; float yy[16];
#pragma unroll
    for (int k4 = 0; k4 < 4; ++k4) { f32x4v g4; g4[0] = bf2f((bf16_t)(ogw[2 * k4] & 0xffff)); g4[1] = bf2f((bf16_t)(ogw[2 * k4] >> 16)); g4[2] = bf2f((bf16_t)(ogw[2 * k4 + 1] & 0xffff)); g4[3] = bf2f((bf16_t)(ogw[2 * k4 + 1] >> 16)); const f32x4v n4 = *(const f32x4v*)(p.gnorm + part * 16 + 4 * k4);
#pragma unroll
      for (int e = 0; e < 4; ++e) { const float gg = g4[e]; yy[4 * k4 + e] = o[4 * k4 + e] * rs * n4[e] * (gg / (1.f + __expf(-gg))); } }
    { v4u o0, o1; o0.x = pk2(yy[0], yy[1]); o0.y = pk2(yy[2], yy[3]); o0.z = pk2(yy[4], yy[5]); o0.w = pk2(yy[6], yy[7]);
      o1.x = pk2(yy[8], yy[9]); o1.y = pk2(yy[10], yy[11]); o1.z = pk2(yy[12], yy[13]); o1.w = pk2(yy[14], yy[15]); *(v4u*)yp = o0; *(v4u*)(yp + 8) = o1; }
  }
  __syncthreads();
}
#undef GMM
}
namespace moe {
constexpr int NE = 16, NG = 4, EPG = 4, DE = 512, D = 1024;
__device__ __forceinline__ float wave_sum(float v) {
#pragma unroll
  for (int o = 1; o < 64; o <<= 1) v += __shfl_xor(v, o);
  return v;
}
struct Route { int e0, r0, e1, r1; };
struct MoeOrder {
  int G, c, NT; const LAS int* poff;
  __device__ __forceinline__ bool next(int i, pg8::Unit& u) const {
    const long L = (long)i * G + c; const int total = poff[NE] * NT; if (L >= total) return false;
    const int panel = (int)L / NT, j = (int)L % NT; int e = 0;
#pragma unroll
    for (int k = 1; k < NE; ++k) e += (panel >= poff[k]) ? 1 : 0;
    u.pm = panel; u.pn = e * NT + j; u.acol = 0; u.nt = 0; return true;
  }
  __device__ __forceinline__ void a_ready(const pg8::Unit&) const {}
  __device__ __forceinline__ void done(const pg8::Unit&) const {}
};
struct EpiGU {
  static constexpr bool PERM = true, AFTER_DRAIN = false;
  bf16_t* hid;
  __device__ __forceinline__ void operator()(const pg8::f32x4 (&acc)[2][2][4][2], const pg8::Unit& u, int wr, int wc, int fr, int fq) const {
    const int j = u.pn & 3; const int row0 = u.pm * 256 + wr * 64 + fr, col0 = j * 128 + wc * 32 + 8 * fq;
#pragma unroll
    for (int ai = 0; ai < 2; ++ai)
#pragma unroll
      for (int m = 0; m < 4; ++m) { const size_t r = (size_t)(row0 + ai * 128 + m * 16); float hv[8];
#pragma unroll
        for (int n = 0; n < 2; ++n)
#pragma unroll
          for (int e = 0; e < 4; ++e) { const float g = acc[ai][0][m][n][e], up = acc[ai][1][m][n][e]; hv[4 * n + e] = g / (1.f + __expf(-g)) * up; }
        v4u o; o.x = pk2(hv[0], hv[1]); o.y = pk2(hv[2], hv[3]); o.z = pk2(hv[4], hv[5]); o.w = pk2(hv[6], hv[7]);
        *(v4u*)(hid + r * DE + col0) = o; }
  }
};
struct EpiDown {
  static constexpr bool PERM = true, AFTER_DRAIN = false;
  const int* srcrow; const float* wgt; bf16_t* contrib; size_t slot_stride;
  __device__ __forceinline__ void operator()(const pg8::f32x4 (&acc)[2][2][4][2], const pg8::Unit& u, int wr, int wc, int fr, int fq) const {
    const int pn = u.pn & 3; const int row0 = u.pm * 256 + wr * 64 + fr, col0 = pn * 256 + wc * 32 + 8 * fq;
    int srcs[2][4]; float ws_[2][4];
#pragma unroll
    for (int ai = 0; ai < 2; ++ai)
#pragma unroll
      for (int m = 0; m < 4; ++m) { const int r = row0 + ai * 128 + m * 16; srcs[ai][m] = srcrow[r]; ws_[ai][m] = wgt[r]; }
#pragma unroll
    for (int ai = 0; ai < 2; ++ai)
#pragma unroll
      for (int m = 0; m < 4; ++m) { const int src = srcs[ai][m]; if (src < 0) continue; const float w = ws_[ai][m];
        bf16_t* dst = contrib + (size_t)(src & 1) * slot_stride + (size_t)(src >> 1) * D + col0;
#pragma unroll
        for (int bj = 0; bj < 2; ++bj) { const pg8::f32x4 v0 = acc[ai][bj][m][0] * w, v1 = acc[ai][bj][m][1] * w;
          v4u o; o.x = pk2(v0[0], v0[1]); o.y = pk2(v0[2], v0[3]); o.z = pk2(v1[0], v1[1]); o.w = pk2(v1[2], v1[3]); *(v4u*)(dst + bj * 128) = o; } }
  }
};
__device__ __forceinline__ void route_row(const float* xr, const float* gnorm, const float* shift, const float* scale, bf16_t* hrow, const LAS float* rwT, const float* rbias,
                                          LAS int* cnt, Route* rt, float* wts, int lane) {
  typedef float f4 __attribute__((ext_vector_type(4)));
  f4 xv[4]; float ss = 0.f;
#pragma unroll
  for (int j = 0; j < 4; ++j) { xv[j] = *(const f4*)(xr + 4 * lane + 256 * j); ss += xv[j][0] * xv[j][0] + xv[j][1] * xv[j][1] + xv[j][2] * xv[j][2] + xv[j][3] * xv[j][3]; }
  const float rs = 1.f / sqrtf(wave_sum(ss) * (1.f / 1024.f) + 1e-6f);
  float lg[NE];
#pragma unroll
  for (int e = 0; e < NE; ++e) lg[e] = 0.f;
#pragma unroll
  for (int j = 0; j < 4; ++j) { const int c = 4 * lane + 256 * j; const f4 g4 = *(const f4*)(gnorm + c), sh = *(const f4*)(shift + c), sc = *(const f4*)(scale + c);
    f4 h;
#pragma unroll
    for (int i = 0; i < 4; ++i) h[i] = xv[j][i] * rs * g4[i] * (1.f + sc[i]) + sh[i];
    *(unsigned long long*)(hrow + c) = (unsigned long long)pk2(h[0], h[1]) | ((unsigned long long)pk2(h[2], h[3]) << 32);
#pragma unroll
    for (int e = 0; e < NE; ++e) { const f4 w4 = *(const LAS f4*)(rwT + e * 1024 + c); lg[e] += h[0] * w4[0] + h[1] * w4[1] + h[2] * w4[2] + h[3] * w4[3]; } }
  { float v8[8], v4[4], v2[2], v1;
#pragma unroll
    for (int i = 0; i < 8; ++i) { const bool up = lane & 1; const float keep = up ? lg[2 * i + 1] : lg[2 * i], send = up ? lg[2 * i] : lg[2 * i + 1]; v8[i] = keep + __shfl_xor(send, 1); }
#pragma unroll
    for (int i = 0; i < 4; ++i) { const bool up = lane & 2; const float keep = up ? v8[2 * i + 1] : v8[2 * i], send = up ? v8[2 * i] : v8[2 * i + 1]; v4[i] = keep + __shfl_xor(send, 2); }
#pragma unroll
    for (int i = 0; i < 2; ++i) { const bool up = lane & 4; const float keep = up ? v4[2 * i + 1] : v4[2 * i], send = up ? v4[2 * i] : v4[2 * i + 1]; v2[i] = keep + __shfl_xor(send, 4); }
    { const bool up = lane & 8; const float keep = up ? v2[1] : v2[0], send = up ? v2[0] : v2[1]; v1 = keep + __shfl_xor(send, 8); }
    v1 += __shfl_xor(v1, 16); v1 += __shfl_xor(v1, 32);
#pragma unroll
    for (int e = 0; e < NE; ++e) lg[e] = __shfl(v1, e); }
  float sc[NE], sel[NE];
#pragma unroll
  for (int e = 0; e < NE; ++e) { sc[e] = 1.f / (1.f + __expf(-lg[e])); sel[e] = sc[e] + rbias[e]; }
  int bestg = 0; float bestgs = -1e30f;
#pragma unroll
  for (int g = 0; g < NG; ++g) { float m1 = -1e30f, m2 = -1e30f;
#pragma unroll
    for (int i = 0; i < EPG; ++i) { const float v = sel[g * EPG + i]; if (v > m1) { m2 = m1; m1 = v; } else if (v > m2) m2 = v; }
    const float gsum = m1 + m2; if (gsum > bestgs) { bestgs = gsum; bestg = g; } }
  int i1 = -1, i2 = -1; float v1 = -1e30f, v2 = -1e30f, s1 = 0.f, s2 = 0.f;
#pragma unroll
  for (int e = 0; e < NE; ++e) { if (e / EPG == bestg) { const float v = sel[e];
      if (v > v1) { v2 = v1; i2 = i1; s2 = s1; v1 = v; i1 = e; s1 = sc[e]; } else if (v > v2) { v2 = v; i2 = e; s2 = sc[e]; } } }
  if (lane == 0) { const float inv = 1.f / (s1 + s2); Route r; r.e0 = i1; r.e1 = i2; r.r0 = __hip_atomic_fetch_add(cnt + i1, 1, __ATOMIC_RELAXED, __HIP_MEMORY_SCOPE_WORKGROUP); r.r1 = __hip_atomic_fetch_add(cnt + i2, 1, __ATOMIC_RELAXED, __HIP_MEMORY_SCOPE_WORKGROUP); *rt = r; wts[0] = s1 * inv; wts[1] = s2 * inv; }
}
}
namespace hy {
typedef float f32x16 __attribute__((ext_vector_type(16)));
constexpr int S = 4096, NT1 = 128, LDZ = 191, ZPAD = 31, LDX = 129;
constexpr int O_TAPS = 0, O_ZA = 32768, O_ZB = O_ZA + 32 * LDZ * 4, O_X1 = O_ZB + 32 * LDZ * 4, O_X2 = O_X1 + 32 * LDX * 4, O_RED = O_X2 + 32 * LDX * 4, O_END = O_RED + 4 * 64 * 16 * 4;
static_assert(O_END <= 131072, "hyena lds");

struct H0Regs { v4u w0, w1; };
__device__ __forceinline__ H0Regs h0_load(const bf16_t* u, int ld, int tile, int tid) {
  const int tt = tile / 24, jt = tile % 24, t0 = tt * 64, j0 = jt * 64; H0Regs r; r.w0 = (v4u){0u, 0u, 0u, 0u}; r.w1 = r.w0;
  { const int rr = tid >> 3, c8 = (tid & 7) * 8, t = t0 - 1 + rr; if (t >= 0 && t < S) r.w0 = *(const v4u*)(u + (size_t)t * ld + j0 + c8); }
  if (tid < 16) { const int rr = 64 + (tid >> 3), c8 = (tid & 7) * 8, t = t0 - 1 + rr; if (t < S) r.w1 = *(const v4u*)(u + (size_t)t * ld + j0 + c8); }
  return r;
}
__device__ __forceinline__ void h0_compute(const H0Regs& rg, const float* cw, const float* cb, bf16_t* ucT, int tile, LAS unsigned char* lds, int tid) {
  const int tt = tile / 24, jt = tile % 24, t0 = tt * 64, j0 = jt * 64;
  LAS float* U = (LAS float*)lds;
  { const int rr = tid >> 3, c8 = (tid & 7) * 8; const v4u w = rg.w0; LAS float* d = U + rr * 65 + c8;
    d[0] = bf2f(w.x & 0xffff); d[1] = bf2f(w.x >> 16); d[2] = bf2f(w.y & 0xffff); d[3] = bf2f(w.y >> 16); d[4] = bf2f(w.z & 0xffff); d[5] = bf2f(w.z >> 16); d[6] = bf2f(w.w & 0xffff); d[7] = bf2f(w.w >> 16); }
  if (tid < 16) { const int rr = 64 + (tid >> 3), c8 = (tid & 7) * 8; const v4u w = rg.w1; LAS float* d = U + rr * 65 + c8;
    d[0] = bf2f(w.x & 0xffff); d[1] = bf2f(w.x >> 16); d[2] = bf2f(w.y & 0xffff); d[3] = bf2f(w.y >> 16); d[4] = bf2f(w.z & 0xffff); d[5] = bf2f(w.z >> 16); d[6] = bf2f(w.w & 0xffff); d[7] = bf2f(w.w >> 16); }
  __syncthreads();
  { const int jj = tid >> 3, tq = (tid & 7) * 8, j = j0 + jj; const float w0 = cw[j], w1 = cw[1536 + j], w2 = cw[2 * 1536 + j], bb = cb[j]; float v[8];
#pragma unroll
    for (int k = 0; k < 8; ++k) v[k] = bb + w0 * U[(tq + k) * 65 + jj] + w1 * U[(tq + k + 1) * 65 + jj] + w2 * U[(tq + k + 2) * 65 + jj];
    v4u o; o.x = pk2(v[0], v[1]); o.y = pk2(v[2], v[3]); o.z = pk2(v[4], v[5]); o.w = pk2(v[6], v[7]); *(v4u*)(ucT + (size_t)j * S + t0 + tq) = o; }
  __syncthreads();
}
__device__ __forceinline__ void h2_tile(const bf16_t* yT, bf16_t* ybf, int ldy, int tile, LAS unsigned char* lds) {
  int tid = threadIdx.x; asm volatile("" : "+v"(tid));
  const int tt = tile / 8, ct = tile % 8, t0 = tt * 64, c0 = ct * 64;
  LAS bf16_t* T = (LAS bf16_t*)lds;
  { const int cc = tid >> 3, t8 = (tid & 7) * 8; const v4u w = *(const v4u*)(yT + (size_t)(c0 + cc) * S + t0 + t8); LAS unsigned* d = (LAS unsigned*)(T + cc * 66 + t8); d[0] = w.x; d[1] = w.y; d[2] = w.z; d[3] = w.w; }
  __syncthreads();
  { const int t = tid >> 3, c8 = (tid & 7) * 8; unsigned short e[8];
#pragma unroll
    for (int k = 0; k < 8; ++k) e[k] = T[(c8 + k) * 66 + t];
    v4u o; o.x = e[0] | ((unsigned)e[1] << 16); o.y = e[2] | ((unsigned)e[3] << 16); o.z = e[4] | ((unsigned)e[5] << 16); o.w = e[6] | ((unsigned)e[7] << 16);
    *(v4u*)(ybf + (size_t)(t0 + t) * ldy + c0 + c8) = o; }
  __syncthreads();
}
__device__ __forceinline__ void h1_unit(const bf16_t* ucT, const float* tapsT, const float* nrm, const float* skip, bf16_t* yT, int c, LAS unsigned char* lds) {
  int tid = threadIdx.x; asm volatile("" : "+v"(tid));
  const int lane = tid & 63, w = __builtin_amdgcn_readfirstlane(tid >> 6), li = lane & 31, lk = lane >> 5;
  LAS float* TAPS = (LAS float*)(lds + O_TAPS); LAS float* ZA = (LAS float*)(lds + O_ZA); LAS float* ZB = (LAS float*)(lds + O_ZB);
  LAS float* X1 = (LAS float*)(lds + O_X1); LAS float* X2 = (LAS float*)(lds + O_X2); LAS float* RED = (LAS float*)(lds + O_RED);
  for (int e = tid; e < 32 * 62; e += 512) { const int s2 = e / 62, p = e % 62, t1p = p < 31 ? p : 128 + p; ZA[s2 * LDZ + t1p] = 0.f; ZB[s2 * LDZ + t1p] = 0.f; }
  for (int t = tid; t < S; t += 512) { const int t2 = t & 31, t1 = t >> 5;
    X1[t2 * LDX + t1] = bf2f(ucT[(size_t)c * S + t]); X2[t2 * LDX + t1] = bf2f(ucT[(size_t)(512 + c) * S + t]); ZA[t2 * LDZ + t1 + ZPAD] = bf2f(ucT[(size_t)(1024 + c) * S + t]); }
#pragma unroll 1
  for (int o = 0; o < 2; ++o) {
    const float* tp = tapsT + ((size_t)o * 512 + c) * 8192;
    for (int e = tid; e < 8192; e += 512) TAPS[e] = tp[(e + 4096) & 8191];
    __syncthreads();
    const LAS float* Zin = o == 0 ? ZA : ZB;
    const int g = w & 3, dh = w >> 2;
    const int Dlo = 32 * g - 127 + (dh ? 80 : 0), Dn = dh ? 79 : 80;
    f32x16 acc = {};
    { const LAS float* ap = TAPS + 4096 + 32 * Dlo + li - lk - 30;
      const LAS float* bp = Zin + lk * LDZ + (32 * g + li - Dlo + ZPAD);
#pragma unroll 2
      for (int dd = 0; dd < Dn; ++dd) {
#pragma unroll
        for (int kk = 0; kk < 16; ++kk) acc = __builtin_amdgcn_mfma_f32_32x32x2f32(ap[(15 - kk) * 2], bp[2 * kk * LDZ], acc, 0, 0, 0);
        ap += 32; bp -= 1; }
    }
    if (dh) {
#pragma unroll
      for (int r = 0; r < 16; ++r) RED[(g * 64 + lane) * 16 + r] = acc[r]; }
    __syncthreads();
    if (!dh) { const float inv = 1.f / nrm[o * 512 + c], sk = skip[o * 512 + c]; const LAS float* G = o == 0 ? X1 : X2; LAS float* Out = o == 0 ? ZB : ZA;
#pragma unroll
      for (int r = 0; r < 16; ++r) { const int t2 = (r & 3) + 8 * (r >> 2) + 4 * lk, t1 = 32 * g + li;
        const float cv = (acc[r] + RED[(g * 64 + lane) * 16 + r]) * inv; const float zin = Zin[t2 * LDZ + t1 + ZPAD];
        Out[t2 * LDZ + t1 + ZPAD] = G[t2 * LDX + t1] * (cv + sk * zin); } }
    __syncthreads();
  }
  for (int t = tid; t < S; t += 512) yT[(size_t)c * S + t] = (bf16_t)f2bf(ZA[(t & 31) * LDZ + (t >> 5) + ZPAD]);
  __syncthreads();
}

typedef short bf16x8v __attribute__((ext_vector_type(8)));
typedef unsigned u32x2v __attribute__((ext_vector_type(2)));
constexpr int CSB = 16448;
constexpr int ZROW = 80, ZROWS = 190;
constexpr int B_CS = 0, B_ZA = 4 * CSB, B_ZB = B_ZA + 15232, B_X1 = B_ZB + 15232, B_X2 = B_X1 + 8256, B_RED = B_X2 + 8256, B_END = B_RED + 16384;
static_assert(B_END <= 131072 && B_ZA % 16 == 0 && B_X1 % 16 == 0, "hyena bf16 lds");
__device__ __forceinline__ void h1b_unit(const bf16_t* ucT, const bf16_t* tapsB, const float* nrm, const float* skip, bf16_t* yT, int c, LAS unsigned char* lds) {
  int tid = threadIdx.x; asm volatile("" : "+v"(tid));
  const int lane = tid & 63, w = __builtin_amdgcn_readfirstlane(tid >> 6), li = lane & 31, lk = lane >> 5;
  LAS bf16_t* ZA = (LAS bf16_t*)(lds + B_ZA); LAS bf16_t* ZB = (LAS bf16_t*)(lds + B_ZB); LAS bf16_t* X1 = (LAS bf16_t*)(lds + B_X1); LAS bf16_t* X2 = (LAS bf16_t*)(lds + B_X2);
  LAS float* RED = (LAS float*)(lds + B_RED);
  for (int e = tid; e < 62 * 20; e += 512) { const int p = e / 20, d = e % 20, row = p < 31 ? p : 128 + p; ((LAS unsigned*)ZA)[row * 20 + d] = 0u; ((LAS unsigned*)ZB)[row * 20 + d] = 0u; }
  { const v4u zv = *(const v4u*)(ucT + (size_t)(1024 + c) * S + tid * 8); const int t = tid * 8; *(LAS v4u*)((LAS unsigned char*)ZA + ((t >> 5) + ZPAD) * ZROW + (t & 31) * 2) = zv; }
  { const v4u xa = *(const v4u*)(ucT + (size_t)c * S + tid * 8), xb = *(const v4u*)(ucT + (size_t)(512 + c) * S + tid * 8); const int t1 = tid >> 2, t2b = (tid & 3) * 8;
    const unsigned wa[4] = {xa.x, xa.y, xa.z, xa.w}, wb[4] = {xb.x, xb.y, xb.z, xb.w};
#pragma unroll
    for (int k = 0; k < 4; ++k) { X1[(t2b + 2 * k) * LDX + t1] = (bf16_t)(wa[k] & 0xffff); X1[(t2b + 2 * k + 1) * LDX + t1] = (bf16_t)(wa[k] >> 16);
      X2[(t2b + 2 * k) * LDX + t1] = (bf16_t)(wb[k] & 0xffff); X2[(t2b + 2 * k + 1) * LDX + t1] = (bf16_t)(wb[k] >> 16); } }
  typedef unsigned u4a __attribute__((ext_vector_type(4), aligned(4))); typedef const __attribute__((address_space(1))) u4a* gp4;
  v4u cv[9];
#pragma unroll 1
  for (int o = 0; o < 2; ++o) {
#define HTAPS_LOAD(oo) { const __attribute__((address_space(1))) unsigned char* tb = (const __attribute__((address_space(1))) unsigned char*)(tapsB + ((size_t)(oo) * 512 + c) * 2 * 8232); \
      _Pragma("unroll") for (int it = 0; it < 9; ++it) { const int e = tid + 512 * it; const int s = e / 1028, q = e % 1028; cv[it] = (v4u){0u, 0u, 0u, 0u}; if (e < 4 * 1028) cv[it] = *(gp4)(tb + (size_t)(s & 1) * 16464 + 16 * q + 4 * (s >> 1)); } }
    if (o == 0) HTAPS_LOAD(0)
    {
#pragma unroll
      for (int it = 0; it < 9; ++it) { const int e = tid + 512 * it; const int s = e / 1028, q = e % 1028; if (e < 4 * 1028) *(LAS v4u*)(lds + B_CS + s * CSB + 16 * q) = cv[it]; } }
    __syncthreads();
    if (o == 0) HTAPS_LOAD(1)
    const LAS bf16_t* Zin = o == 0 ? ZA : ZB;
    const int g = w & 3, dh = w >> 2;
    const int Dlo = 32 * g - 127 + (dh ? 81 : 0), Dn = dh ? 78 : 81;
    f32x16 acc = {};
    { const int s = (4 - (li & 3)) & 3;
      const LAS unsigned char* ap = lds + B_CS + s * CSB + 2 * (4096 - 32 * Dlo - li + 8 * lk - s);
      const LAS unsigned char* bp = (const LAS unsigned char*)Zin + (32 * g + li - Dlo + ZPAD) * ZROW + 16 * lk;
#define HLD(A0, A1, B0, B1) { const u32x2v p0_ = *(const LAS u32x2v*)(ap), p1_ = *(const LAS u32x2v*)(ap2), p2_ = *(const LAS u32x2v*)(ap3), p3_ = *(const LAS u32x2v*)(ap4); \
        A0 = (v4u){p0_.x, p0_.y, p1_.x, p1_.y}; A1 = (v4u){p2_.x, p2_.y, p3_.x, p3_.y}; B0 = *(const LAS v4u*)(bp); B1 = *(const LAS v4u*)(bp + 32); ap -= 64; ap2 -= 64; ap3 -= 64; ap4 -= 64; bp -= ZROW; }
#define HMM(A, B) acc = __builtin_amdgcn_mfma_f32_32x32x16_bf16(__builtin_bit_cast(bf16x8v, A), __builtin_bit_cast(bf16x8v, B), acc, 0, 0, 0)
#define HOPQ(name, off) unsigned name##i = (unsigned)(unsigned long long)(ap + (off)); asm volatile("" : "+v"(name##i)); const LAS unsigned char* name = (const LAS unsigned char*)(unsigned long long)name##i;
      HOPQ(ap2, 8) HOPQ(ap3, 32) HOPQ(ap4, 40)
#undef HOPQ
      v4u fa0, fa1, fb0, fb1, ga0, ga1, gb0, gb1, ha0, ha1, hb0, hb1;
      HLD(fa0, fa1, fb0, fb1)
      HLD(ga0, ga1, gb0, gb1)
      for (int dd_ = 0; dd_ < Dn - 3; dd_ += 3) {
        HLD(ha0, ha1, hb0, hb1)
        HMM(fa0, fb0); HMM(fa1, fb1);
        HLD(fa0, fa1, fb0, fb1)
        HMM(ga0, gb0); HMM(ga1, gb1);
        HLD(ga0, ga1, gb0, gb1)
        HMM(ha0, hb0); HMM(ha1, hb1);
      }
      HLD(ha0, ha1, hb0, hb1)
      HMM(fa0, fb0); HMM(fa1, fb1); HMM(ga0, gb0); HMM(ga1, gb1); HMM(ha0, hb0); HMM(ha1, hb1);
#undef HLD
#undef HMM
    }
    if (dh) {
#pragma unroll
      for (int r = 0; r < 16; ++r) RED[(g * 64 + lane) * 16 + r] = acc[r]; }
    __syncthreads();
    if (!dh) { const float inv = 1.f / nrm[o * 512 + c], sk = skip[o * 512 + c]; const LAS bf16_t* G = o == 0 ? X1 : X2; LAS bf16_t* Out = o == 0 ? ZB : ZA;
#pragma unroll
      for (int r = 0; r < 16; ++r) { const int t2 = (r & 3) + 8 * (r >> 2) + 4 * lk, t1 = 32 * g + li;
        const float cv = (acc[r] + RED[(g * 64 + lane) * 16 + r]) * inv; const float zin = bf2f(Zin[(t1 + ZPAD) * (ZROW / 2) + t2]);
        Out[(t1 + ZPAD) * (ZROW / 2) + t2] = (bf16_t)f2bf(bf2f(G[t2 * LDX + t1]) * (cv + sk * zin)); } }
    __syncthreads();
  }
  { const int t = tid * 8; *(v4u*)(yT + (size_t)c * S + t) = *(const LAS v4u*)((const LAS unsigned char*)ZA + ((t >> 5) + ZPAD) * ZROW + (t & 31) * 2); }
  __syncthreads();
}
#undef HTAPS_LOAD

constexpr int C_ZP = 15, C_ZB = 159 * ZROW  , C_CS = 0, C_Z0 = 4 * CSB, C_X0 = C_Z0 + 2 * C_ZB, C_END = C_X0 + 4 * 8256;
static_assert(C_END <= 131072 && C_Z0 % 16 == 0 && C_ZB % 16 == 0 && C_X0 % 16 == 0, "hyena two-batch lds");
__device__ __forceinline__ void h1c_unit(const bf16_t* ucT2, const bf16_t* tapsB, const float* nrm, const float* skip, bf16_t* yT2, int c, LAS unsigned char* lds) {
  int tid = threadIdx.x; asm volatile("" : "+v"(tid));
  const int lane = tid & 63, g = __builtin_amdgcn_readfirstlane(tid >> 6), li = lane & 31, lk = lane >> 5, bsel = li >> 4, t1l = li & 15;
  for (int e = tid; e < 2 * 31 * 20; e += 512) { const int b = e / (31 * 20), p = (e / 20) % 31, d = e % 20, row = p < 15 ? p : 128 + p; ((LAS unsigned*)(lds + C_Z0 + b * C_ZB))[row * 20 + d] = 0u; }
#pragma unroll
  for (int b = 0; b < 2; ++b) { const bf16_t* uc = ucT2 + (size_t)b * 1536 * S; const int t = tid * 8;
    const v4u zv = *(const v4u*)(uc + (size_t)(1024 + c) * S + t), xa = *(const v4u*)(uc + (size_t)c * S + t), xb = *(const v4u*)(uc + (size_t)(512 + c) * S + t);
    *(LAS v4u*)(lds + C_Z0 + b * C_ZB + ((t >> 5) + C_ZP) * ZROW + (t & 31) * 2) = zv;
    LAS bf16_t* X1 = (LAS bf16_t*)(lds + C_X0 + (2 * b) * 8256); LAS bf16_t* X2 = (LAS bf16_t*)(lds + C_X0 + (2 * b + 1) * 8256); const int t1 = tid >> 2, t2b = (tid & 3) * 8;
    const unsigned wa[4] = {xa.x, xa.y, xa.z, xa.w}, wb[4] = {xb.x, xb.y, xb.z, xb.w};
#pragma unroll
    for (int k = 0; k < 4; ++k) { X1[(t2b + 2 * k) * LDX + t1] = (bf16_t)(wa[k] & 0xffff); X1[(t2b + 2 * k + 1) * LDX + t1] = (bf16_t)(wa[k] >> 16);
      X2[(t2b + 2 * k) * LDX + t1] = (bf16_t)(wb[k] & 0xffff); X2[(t2b + 2 * k + 1) * LDX + t1] = (bf16_t)(wb[k] >> 16); } }
  typedef unsigned u4a __attribute__((ext_vector_type(4), aligned(4))); typedef const __attribute__((address_space(1))) u4a* gp4;
  v4u cv[9];
  LAS bf16_t* Zm = (LAS bf16_t*)(lds + C_Z0 + bsel * C_ZB);
#pragma unroll 1
  for (int o = 0; o < 2; ++o) {
#define HTAPS_LOAD(oo) { const __attribute__((address_space(1))) unsigned char* tb = (const __attribute__((address_space(1))) unsigned char*)(tapsB + ((size_t)(oo) * 512 + c) * 2 * 8232); \
      _Pragma("unroll") for (int it = 0; it < 9; ++it) { const int e = tid + 512 * it; const int s = e / 1028, q = e % 1028; cv[it] = (v4u){0u, 0u, 0u, 0u}; if (e < 4 * 1028) cv[it] = *(gp4)(tb + (size_t)(s & 1) * 16464 + 16 * q + 4 * (s >> 1)); } }
    if (o == 0) HTAPS_LOAD(0)
    {
#pragma unroll
      for (int it = 0; it < 9; ++it) { const int e = tid + 512 * it; const int s = e / 1028, q = e % 1028; if (e < 4 * 1028) *(LAS v4u*)(lds + C_CS + s * CSB + 16 * q) = cv[it]; } }
    __syncthreads();
    if (o == 0) HTAPS_LOAD(1)
    const int Dlo = 16 * g - 128; constexpr int Dn = 144;
    f32x16 acc = {};
    { const int s = (4 - (li & 3)) & 3;
      const LAS unsigned char* ap = lds + C_CS + s * CSB + 2 * (4096 - 32 * Dlo - li + 8 * lk - s);
      const LAS unsigned char* bp = (const LAS unsigned char*)Zm + (16 * g + t1l - Dlo + C_ZP) * ZROW + 16 * lk;
#define HLD(A0, A1, B0, B1) { const u32x2v p0_ = *(const LAS u32x2v*)(ap), p1_ = *(const LAS u32x2v*)(ap2), p2_ = *(const LAS u32x2v*)(ap3), p3_ = *(const LAS u32x2v*)(ap4); \
        A0 = (v4u){p0_.x, p0_.y, p1_.x, p1_.y}; A1 = (v4u){p2_.x, p2_.y, p3_.x, p3_.y}; B0 = *(const LAS v4u*)(bp); B1 = *(const LAS v4u*)(bp + 32); ap -= 64; ap2 -= 64; ap3 -= 64; ap4 -= 64; bp -= ZROW; }
#define HMM(A, B) acc = __builtin_amdgcn_mfma_f32_32x32x16_bf16(__builtin_bit_cast(bf16x8v, A), __builtin_bit_cast(bf16x8v, B), acc, 0, 0, 0)
#define HOPQ(name, off) unsigned name##i = (unsigned)(unsigned long long)(ap + (off)); asm volatile("" : "+v"(name##i)); const LAS unsigned char* name = (const LAS unsigned char*)(unsigned long long)name##i;
      HOPQ(ap2, 8) HOPQ(ap3, 32) HOPQ(ap4, 40)
#undef HOPQ
      v4u fa0, fa1, fb0, fb1, ga0, ga1, gb0, gb1, ha0, ha1, hb0, hb1;
      HLD(fa0, fa1, fb0, fb1)
      HLD(ga0, ga1, gb0, gb1)
      for (int dd_ = 0; dd_ < Dn - 3; dd_ += 3) {
        HLD(ha0, ha1, hb0, hb1)
        HMM(fa0, fb0); HMM(fa1, fb1);
        HLD(fa0, fa1, fb0, fb1)
        HMM(ga0, gb0); HMM(ga1, gb1);
        HLD(ga0, ga1, gb0, gb1)
        HMM(ha0, hb0); HMM(ha1, hb1);
      }
      HLD(ha0, ha1, hb0, hb1)
      HMM(fa0, fb0); HMM(fa1, fb1); HMM(ga0, gb0); HMM(ga1, gb1); HMM(ha0, hb0); HMM(ha1, hb1);
#undef HLD
#undef HMM
    }
    __syncthreads();
    { const float inv = 1.f / nrm[o * 512 + c], sk = skip[o * 512 + c]; const LAS bf16_t* G = (const LAS bf16_t*)(lds + C_X0 + (2 * bsel + o) * 8256);
#pragma unroll
      for (int r = 0; r < 16; ++r) { const int t2 = (r & 3) + 8 * (r >> 2) + 4 * lk, t1 = 16 * g + t1l;
        const float cvv = acc[r] * inv; const float zin = bf2f(Zm[(t1 + C_ZP) * (ZROW / 2) + t2]);
        Zm[(t1 + C_ZP) * (ZROW / 2) + t2] = (bf16_t)f2bf(bf2f(G[t2 * LDX + t1]) * (cvv + sk * zin)); } }
    __syncthreads();
  }
#pragma unroll
  for (int b = 0; b < 2; ++b) { const int t = tid * 8; *(v4u*)(yT2 + (size_t)b * 512 * S + (size_t)c * S + t) = *(const LAS v4u*)(lds + C_Z0 + b * C_ZB + ((t >> 5) + C_ZP) * ZROW + (t & 31) * 2); }
  __syncthreads();
#undef HTAPS_LOAD
}
__device__ __forceinline__ void cconv3_item(const bf16_t* u, int ld, const float* cw, const float* cb, float* ucc, long idx) {
  const int j = (int)(idx % 1536); const int tc = (int)(idx / 1536);
  const bf16_t* up = u + (size_t)tc * ld + j;
  float v = cb[j] + cw[1536 + j] * bf2f(up[0]);
  if (tc > 0) v += cw[j] * bf2f(*(up - ld)); if (tc < 255) v += cw[2 * 1536 + j] * bf2f(up[ld]);
  ucc[idx] = v;
}
__device__ __forceinline__ void clong_item(const float* ucc, const float* z1c_in, float* z1c_out, bf16_t* yout, int ldy, const float* tapsC, const float* nrmC, const float* skip, int o, long idx) {
  const int c = (int)(idx % 512), t0 = (int)(idx / 512) * 8; constexpr int n = 256;
  const float* tp = tapsC + (size_t)o * 2 * n * 512 + c; const float nr = nrmC[o * 512 + c];
  const float* zs = o == 0 ? ucc + 1024 + c : z1c_in + c; const int ldz = o == 0 ? 1536 : 512;
  float acc[8], w[8];
#pragma unroll
  for (int i = 0; i < 8; ++i) { acc[i] = 0.f; const int lag = t0 + i; w[i] = tp[(size_t)lag * 512]; }
#pragma unroll 4
  for (int s = 0; s < n; ++s) { const float zv = zs[(size_t)s * ldz];
#pragma unroll
    for (int i = 0; i < 8; ++i) acc[i] += w[i] * zv;
    const int lag = t0 - s - 1;
    const float nw = tp[(size_t)(lag >= 0 ? lag : 2 * n + lag) * 512];
#pragma unroll
    for (int i = 7; i > 0; --i) w[i] = w[i - 1];
    w[0] = nw; }
  const float sk = skip[o * 512 + c];
#pragma unroll
  for (int i = 0; i < 8; ++i) { const int t = t0 + i; const float val = ucc[(size_t)t * 1536 + o * 512 + c] * (acc[i] / nr + sk * zs[(size_t)t * ldz]);
    if (o == 0) z1c_out[(size_t)t * 512 + c] = val; else yout[(size_t)t * ldy + c] = (bf16_t)f2bf(val); }
}
}
#define XB_TMO      128
#define XB_XCNT(j)  (256  + 64 * (j))
#define XB_XSUB(j)  (1280 + 64 * (j))
#define XB_XGEN(j)  (2304 + 64 * (j))
#define XB_TOP      3328
#define XB_TOPGEN   3392
#define XCD_BAR_WORDS 3456
#define XB_SPIN_CAP (1u << 18)

__device__ __forceinline__ unsigned xb_ld(unsigned* p)              { return __hip_atomic_load(p, __ATOMIC_RELAXED, __HIP_MEMORY_SCOPE_AGENT); }
__device__ __forceinline__ unsigned xb_add(unsigned* p, unsigned v) { return __hip_atomic_fetch_add(p, v, __ATOMIC_RELAXED, __HIP_MEMORY_SCOPE_AGENT); }
__device__ __forceinline__ unsigned xb_xcc_id() { return (unsigned)__builtin_amdgcn_s_getreg((3 << 11) | 20) & 0xFu; }
#define XB_SPIN(cond, bar) do { unsigned _sp = 0; while (cond) { __builtin_amdgcn_s_sleep(1); \
    if ((++_sp & 255u) == 0u) { if (xb_ld(&(bar)[XB_TMO])) break; if (_sp > XB_SPIN_CAP) { atomicAdd(&(bar)[XB_TMO], 1u); break; } } } } while (0)

struct XcdBarrier {
    unsigned* bar; unsigned x;
    volatile LAS unsigned* st;
};

__device__ __forceinline__ XcdBarrier xcd_barrier_post(unsigned* bar, volatile LAS unsigned* st) {
    XcdBarrier b; b.bar = bar; b.x = xb_xcc_id(); b.st = st;
    if (threadIdx.x == 0) (void)xb_add(&bar[XB_XCNT(b.x)], 1u);
    return b;
}
__device__ __forceinline__ void xcd_barrier_complete(unsigned* bar, unsigned x, unsigned& nloc, unsigned& nx) {
    const unsigned G = gridDim.x * gridDim.y * gridDim.z;
    unsigned sum, cnt, mine, sp = 0u;
    for (;;) {
        sum = 0u; cnt = 0u; mine = 0u;
#pragma unroll
        for (unsigned j = 0; j < 16; ++j) { const unsigned c = xb_ld(&bar[XB_XCNT(j)]); sum += c; cnt += (c > 0u) ? 1u : 0u; mine = (j == x) ? c : mine; }
        if (sum == G) break;
        __builtin_amdgcn_s_sleep(1);
        if ((++sp & 255u) == 0u) { if (xb_ld(&bar[XB_TMO])) break; if (sp > XB_SPIN_CAP) { atomicAdd(&bar[XB_TMO], 1u); break; } }
    }
    nloc = mine > 0u ? mine : 1u; nx = cnt > 0u ? cnt : 1u;
}

__device__ __forceinline__ void xcd_barrier(const XcdBarrier& b) {
    asm volatile("s_waitcnt vmcnt(0)" ::: "memory");
    __syncthreads();
    if (threadIdx.x == 0) {
        unsigned* bar = b.bar;
#define XB_SP(word) ((unsigned*)((((unsigned long long)(unsigned)__builtin_amdgcn_readfirstlane((int)((unsigned long long)(bar + (word)) >> 32))) << 32) | (unsigned)__builtin_amdgcn_readfirstlane((int)(unsigned)(unsigned long long)(bar + (word)))))
        unsigned* const p_xsub = XB_SP(XB_XSUB(b.x)); unsigned* const p_xgen = XB_SP(XB_XGEN(b.x));
        __builtin_amdgcn_s_waitcnt(0);
        unsigned nloc = b.st[0], nx = b.st[1];
        if (nloc == 0u) { xcd_barrier_complete(bar, b.x, nloc, nx); b.st[0] = nloc; b.st[1] = nx; }
        const unsigned old = xb_add(p_xsub, 1u);
        const unsigned gen = old / nloc;
        if (old + 1u == (gen + 1u) * nloc) {
            __builtin_amdgcn_fence(__ATOMIC_RELEASE, "agent");
            asm volatile("s_waitcnt vmcnt(0)" ::: "memory");
            const unsigned og = xb_add(&bar[XB_TOP], 1u);
            const unsigned tg = og / nx;
            if (og + 1u == (tg + 1u) * nx) xb_add(&bar[XB_TOPGEN], 1u);
            else XB_SPIN(xb_ld(&bar[XB_TOPGEN]) == tg, bar);
            __builtin_amdgcn_fence(__ATOMIC_ACQUIRE, "agent");
            xb_add(p_xgen, 1u);
            asm volatile("s_waitcnt vmcnt(0)" ::: "memory");
        } else {
            XB_SPIN(xb_ld(p_xgen) == gen, bar);
            __builtin_amdgcn_fence(__ATOMIC_ACQUIRE, "agent");
            asm volatile("s_waitcnt vmcnt(0)" ::: "memory");
        }
    }
    __syncthreads();
}
#include <math.h>
#ifdef HOST_TEST
#define HD
#define FEXP expf
#define FSIN sinf
#define FCOS cosf
#define FLOG logf
#define FPOW powf
#else
#define HD __device__ __forceinline__
#define FEXP __expf
#define FSIN __sinf
#define FCOS __cosf
#define FLOG __logf
#define FPOW __powf
#endif

struct FullDims { static constexpr int D=1024,B=8,S=4096,DEPTH=2,C=256,GW=64,AH=8,AKV=2,HDM=128,GH=4,GDK=64,GDV=128,GR=16,HW=512,HB=16,HF=64,NE=16,NG=4,DE=512; };
struct SmallDims { static constexpr int D=64,B=2,S=128,DEPTH=2,C=32,GW=16,AH=4,AKV=2,HDM=16,GH=2,GDK=8,GDV=16,GR=4,HW=32,HB=4,HF=8,NE=8,NG=2,DE=32; };

template <class T> struct DD {
  static constexpr int D=T::D,B=T::B,S=T::S,DEPTH=T::DEPTH,C=T::C,GW=T::GW,AH=T::AH,AKV=T::AKV,HDM=T::HDM,GH=T::GH,GDK=T::GDK,GDV=T::GDV,GR=T::GR,HW=T::HW,HB=T::HB,HF=T::HF,NE=T::NE,NG=T::NG,DE=T::DE;
  static constexpr int R=S+C, AG=AH/AKV, RP=HDM/4, HE=1+2*HB, EPG=NE/NG, AQW=AH*HDM, AKVW=AKV*HDM, GKW=GH*GDK, GVW=GH*GDV;
  static constexpr int NKV=AKVW+AKVW+GKW+GVW+2*GR, NIN=NKV+AQW+GKW+GVW+3*HW+3*D;
  static constexpr int O_AK=0, O_AV=AKVW, O_GK=2*AKVW, O_GV=2*AKVW+GKW, O_GA=2*AKVW+GKW+GVW;
  static constexpr int O_AQ=NKV, O_GQ=NKV+AQW, O_OG=O_GQ+GKW, O_HY=O_OG+GVW, O_BR=O_HY+3*HW;
};

struct NaiveBufs {
  const float *x,*c,*ctx,*c_ctx,*w_mod,*b_mod,*norm1_g,*norm2_g,*w_in,*q_norm_g,*k_norm_g,*gla_wa2,*gla_ba,*gla_norm_g,*hy_conv_w,*hy_conv_b,
    *hy_pos_w1,*hy_pos_b1,*hy_sin_freq,*hy_pos_w2,*hy_pos_b2,*hy_pos_w3,*hy_decay,*hy_skip,*w_br_hy,*w_br_gla,*w_br_att,*w_out,*router_w,*router_b,*moe_w_gate,*moe_w_up,*moe_w_down;
  float* out;
  float *mod;
  float *hid2S,*hid2C;
  float *tapsS,*tapsC;
  float *nrmS,*nrmC;
  float *rs;
  float *h;
  float *proj;
  float *qn,*kn;
  float *yatt;
  float *laf,*lab;
  float *of,*ob;
  float *ygla;
  float *uc;
  float *z1,*yhy;
  float *m;
  int   *ridx;
  float *rw;
  float *hid;
  float *xc;
};

HD float sigmoidf_(float x) { return 1.f / (1.f + FEXP(-x)); }
HD float siluf_(float x) { return x / (1.f + FEXP(-x)); }
HD float logsigmoidf_(float x) { return x < 0.f ? x - FLOG(1.f + FEXP(x)) : -FLOG(1.f + FEXP(-x)); }

template <class T> HD void st_mod(const NaiveBufs& a, int l, long idx) {
  using d = DD<T>; const int j = (int)(idx % (6 * d::D)), bb = (int)(idx / (6 * d::D));
  const float* cv = bb < d::B ? a.c + (long)bb * d::D : a.c_ctx; const float* w = a.w_mod + (long)l * d::D * 6 * d::D;
  float acc = a.b_mod[(long)l * 6 * d::D + j];
  for (int k = 0; k < d::D; ++k) acc += siluf_(cv[k]) * w[(long)k * 6 * d::D + j];
  a.mod[idx] = acc;
}
template <class T> HD void st_hyhid(const NaiveBufs& a, int l, int which, long idx) {
  using d = DD<T>; const int n = which ? d::C : d::S; float* dst = which ? a.hid2C : a.hid2S;
  const int j = (int)(idx % d::HF), t = (int)(idx / d::HF);
  const float* w1 = a.hy_pos_w1 + (long)l * d::HE * d::HF; const float* b1 = a.hy_pos_b1 + l * d::HF; const float* fr = a.hy_sin_freq + l * d::HF;
  const float* w2 = a.hy_pos_w2 + (long)l * d::HF * d::HF; const float* b2 = a.hy_pos_b2 + l * d::HF;
  const float tn = (float)t / (float)n; const float w0 = 2.f * 3.14159265358979323846f / (float)n;
  float acc2 = b2[j];
  for (int i = 0; i < d::HF; ++i) {
    float acc = b1[i] + tn * w1[0 * d::HF + i];
    for (int bnd = 0; bnd < d::HB; ++bnd) {
      const float band = 1e-4f + (float)bnd * ((float)(d::HB - 1) - 1e-4f) / (float)(d::HB - 1);
      const float ph = w0 * (float)t * band;
      acc += FCOS(ph) * w1[(1 + bnd) * d::HF + i] - FSIN(ph) * w1[(1 + d::HB + bnd) * d::HF + i];
    }
    acc2 += FSIN(fr[i] * acc) * w2[i * d::HF + j];
  }
  dst[idx] = FSIN(fr[j] * acc2);
}
template <class T> HD void st_hytaps(const NaiveBufs& a, int l, int which, long idx) {
  using d = DD<T>; const int n = which ? d::C : d::S; const float* hid2 = which ? a.hid2C : a.hid2S; float* dst = which ? a.tapsC : a.tapsS;
  const int c = (int)(idx % d::HW); const int li = (int)((idx / d::HW) % (2 * n)); const int o = (int)(idx / ((long)d::HW * 2 * n));
  float v = 0.f;
  if (li != n) {
    const int dir = li < n ? 0 : 1; const int t = li < n ? li : 2 * n - li;
    const int col = (o * 2 + dir) * d::HW + c;
    const float* w3 = a.hy_pos_w3 + (long)l * d::HF * 4 * d::HW;
    float acc = 0.f;
    for (int j = 0; j < d::HF; ++j) acc += hid2[(long)t * d::HF + j] * w3[(long)j * 4 * d::HW + col];
    const float dec = fabsf(a.hy_decay[(long)l * 4 * d::HW + col]);
    v = acc * FEXP(-((float)t / (float)n) * dec);
  }
  if (which == 0) dst[((long)o * d::HW + c) * 2 * n + li] = v; else dst[idx] = v;
}
template <class T> HD void st_hynorm(const NaiveBufs& a, int which, long idx) {
  using d = DD<T>; const int n = which ? d::C : d::S; const float* tp = which ? a.tapsC : a.tapsS; float* dst = which ? a.nrmC : a.nrmS;
  const int c = (int)(idx % d::HW), o = (int)(idx / d::HW);
  float s = 0.f; for (int li = 0; li < 2 * n; ++li) s += fabsf(which == 0 ? tp[((long)o * d::HW + c) * 2 * n + li] : tp[((long)o * 2 * n + li) * d::HW + c]);
  dst[idx] = s + 1e-6f;
}

template <class T> HD const float* xrow(const NaiveBufs& a, int l, int b, int r) {
  using d = DD<T>;
  if (r < d::S) return (l == 0 ? a.x : a.out) + ((long)b * d::S + r) * d::D;
  return (l == 0 ? a.ctx : a.xc) + ((long)b * d::C + (r - d::S)) * d::D;
}
template <class T> HD float* xrow_w(const NaiveBufs& a, int b, int r) {
  using d = DD<T>;
  if (r < d::S) return a.out + ((long)b * d::S + r) * d::D;
  return a.xc + ((long)b * d::C + (r - d::S)) * d::D;
}
template <class T> HD void st_rs(const NaiveBufs& a, int l, int b, int src, long idx) {
  using d = DD<T>; const int r = (int)idx; const float* xr = src ? (const float*)xrow_w<T>(a, b, r) : xrow<T>(a, l, b, r);
  float s = 0.f; for (int k = 0; k < d::D; ++k) s += xr[k] * xr[k];
  a.rs[r] = 1.f / sqrtf(s / (float)d::D + 1e-6f);
}
template <class T> HD void st_norm(const NaiveBufs& a, int l, int b, int which, long idx) {
  using d = DD<T>; const int j = (int)(idx % d::D), r = (int)(idx / d::D);
  const float* xr = which ? (const float*)xrow_w<T>(a, b, r) : xrow<T>(a, l, b, r);
  const float* g = (which ? a.norm2_g : a.norm1_g) + (long)l * d::D;
  const float* md = a.mod + (long)(r < d::S ? b : d::B) * 6 * d::D;
  const float shift = md[(which ? 3 : 0) * d::D + j], scale = md[(which ? 4 : 1) * d::D + j];
  a.h[idx] = xr[j] * a.rs[r] * g[j] * (1.f + scale) + shift;
}
struct GemmArgs { const float* A; int lda; const float* W; int ldw; float* Cc; int ldc; int M, N, K;
  const float* gate; int ldg;
  const float* colscale;
  const float* res; int ldr;
  int accumulate; };
HD void st_gemm(const GemmArgs& g, long idx) {
  const int nb = g.N / 4; const int cb = (int)(idx % nb), rb = (int)(idx / nb);
  float acc[4][4];
#pragma unroll
  for (int i = 0; i < 4; ++i) {
#pragma unroll
    for (int j = 0; j < 4; ++j) acc[i][j] = 0.f; }
  const float* a0 = g.A + (long)(rb * 4) * g.lda; const float* w0 = g.W + cb * 4;
  for (int k = 0; k < g.K; ++k) {
    float av[4], wv[4];
#pragma unroll
    for (int i = 0; i < 4; ++i) av[i] = a0[(long)i * g.lda + k];
#pragma unroll
    for (int j = 0; j < 4; ++j) wv[j] = w0[(long)k * g.ldw + j];
#pragma unroll
    for (int i = 0; i < 4; ++i) {
#pragma unroll
      for (int j = 0; j < 4; ++j) acc[i][j] += av[i] * wv[j]; }
  }
#pragma unroll
  for (int i = 0; i < 4; ++i)
#pragma unroll
  for (int j = 0; j < 4; ++j) {
    const int r = rb * 4 + i, c = cb * 4 + j; float v = acc[i][j];
    if (g.gate) v *= sigmoidf_(g.gate[(long)r * g.ldg + c]);
    if (g.colscale) v *= g.colscale[c];
    if (g.res) v += g.res[(long)r * g.ldr + c];
    float* p = g.Cc + (long)r * g.ldc + c;
    if (g.accumulate) v += *p;
    *p = v;
  }
}
template <class T> HD void st_qknorm(const NaiveBufs& a, int l, long idx) {
  using d = DD<T>; const int hh = (int)(idx % (d::AH + d::AKV)), r = (int)(idx / (d::AH + d::AKV));
  const bool isq = hh < d::AH; const int hd = isq ? hh : hh - d::AH;
  const float* src = a.proj + (long)r * d::NIN + (isq ? d::O_AQ : d::O_AK) + hd * d::HDM;
  float* dst = (isq ? a.qn + (long)r * d::AQW : a.kn + (long)r * d::AKVW) + hd * d::HDM;
  const float* g = (isq ? a.q_norm_g : a.k_norm_g) + (long)l * d::HDM;
  float s = 0.f; for (int k = 0; k < d::HDM; ++k) s += src[k] * src[k];
  const float rsq = 1.f / sqrtf(s / (float)d::HDM + 1e-6f);
  if (r < d::S) {
    const int row = r / d::GW, col = r % d::GW;
    for (int p = 0; p < d::HDM / 2; ++p) {
      const int fi = p < d::RP ? p : p - d::RP; const float pos = p < d::RP ? (float)row : (float)col;
      const float inv = FPOW(10000.f, -(float)fi / (float)d::RP); const float ang = pos * inv;
      const float cs = FCOS(ang), sn = FSIN(ang);
      const float x1 = src[2 * p] * rsq * g[2 * p], x2 = src[2 * p + 1] * rsq * g[2 * p + 1];
      dst[2 * p] = x1 * cs - x2 * sn; dst[2 * p + 1] = x1 * sn + x2 * cs;
    }
  } else { for (int k = 0; k < d::HDM; ++k) dst[k] = src[k] * rsq * g[k]; }
}
template <class T, int NSPLIT> HD void st_attn(const NaiveBufs& a, int r0, int nrows, long idx) {
  using d = DD<T>; constexpr int OD = d::HDM / NSPLIT;
  const int r = r0 + (int)(idx % nrows); const int hs = (int)(idx / nrows); const int part = hs % NSPLIT, hq = hs / NSPLIT; const int kv = hq / d::AG;
  const int k0 = r < d::S ? 0 : d::S, k1 = d::R;
  float q[d::HDM], o[OD];
  const float scale = 1.f / sqrtf((float)d::HDM);
#pragma unroll
  for (int k = 0; k < d::HDM; ++k) q[k] = a.qn[(long)r * d::AQW + hq * d::HDM + k] * scale;
#pragma unroll
  for (int k = 0; k < OD; ++k) o[k] = 0.f;
  float mx = -1e30f, lsum = 0.f;
  for (int kk = k0; kk < k1; ++kk) {
    const float* kr = a.kn + (long)kk * d::AKVW + kv * d::HDM;
    float s = 0.f;
#pragma unroll
    for (int k = 0; k < d::HDM; ++k) s += q[k] * kr[k];
    if (s > mx) { const float cr = FEXP(mx - s); lsum *= cr;
#pragma unroll
      for (int k = 0; k < OD; ++k) o[k] *= cr;
      mx = s; }
    const float p = FEXP(s - mx); lsum += p;
    const float* vr = a.proj + (long)kk * d::NIN + d::O_AV + kv * d::HDM + part * OD;
#pragma unroll
    for (int k = 0; k < OD; ++k) o[k] += p * vr[k];
  }
  const float inv = 1.f / lsum;
#pragma unroll
  for (int k = 0; k < OD; ++k) a.yatt[(long)r * d::AQW + hq * d::HDM + part * OD + k] = o[k] * inv;
}
template <class T> HD void st_glala(const NaiveBufs& a, int l, long idx) {
  using d = DD<T>; const int j = (int)(idx % d::GKW); const int dir = (int)((idx / d::GKW) % 2); const int r = (int)(idx / (2 * d::GKW));
  const float* al = a.proj + (long)r * d::NIN + d::O_GA + dir * d::GR;
  const float* w2 = a.gla_wa2 + ((long)l * 2 + dir) * d::GR * d::GKW; float z = a.gla_ba[((long)l * 2 + dir) * d::GKW + j];
  for (int k = 0; k < d::GR; ++k) z += al[k] * w2[(long)k * d::GKW + j];
  (dir ? a.lab : a.laf)[(long)r * d::GKW + j] = FEXP(logsigmoidf_(z) / 16.f);
}
template <class T> HD void st_glascan(const NaiveBufs& a, long idx) {
  using d = DD<T>; const int v = (int)(idx % d::GDV); const int hd = (int)((idx / d::GDV) % d::GH); const int dir = (int)(idx / (d::GDV * d::GH));
  float st[d::GDK];
#pragma unroll
  for (int k = 0; k < d::GDK; ++k) st[k] = 0.f;
  const float qs = 1.f / sqrtf((float)d::GDK);
  const float* la = dir ? a.lab : a.laf; float* od = dir ? a.ob : a.of;
  for (int step = 0; step < d::R; ++step) {
    int r;
    if (step < d::C) r = d::S + (dir ? d::C - 1 - step : step); else r = dir ? d::S - 1 - (step - d::C) : step - d::C;
    const float* pr = a.proj + (long)r * d::NIN;
    const float vv = pr[d::O_GV + hd * d::GDV + v];
    float o = 0.f;
#pragma unroll
    for (int k = 0; k < d::GDK; ++k) {
      st[k] = la[(long)r * d::GKW + hd * d::GDK + k] * st[k] + pr[d::O_GK + hd * d::GDK + k] * vv;
      o += pr[d::O_GQ + hd * d::GDK + k] * qs * st[k];
    }
    od[(long)r * d::GVW + hd * d::GDV + v] = o;
  }
}
template <class T> HD void st_glaout(const NaiveBufs& a, int l, long idx) {
  using d = DD<T>; const int hd = (int)(idx % d::GH), r = (int)(idx / d::GH);
  const long base = (long)r * d::GVW + hd * d::GDV; float s = 0.f;
  for (int v = 0; v < d::GDV; ++v) { const float o = a.of[base + v] + a.ob[base + v]; s += o * o; }
  const float rsq = 1.f / sqrtf(s / (float)d::GDV + 1e-6f);
  for (int v = 0; v < d::GDV; ++v) { const float o = a.of[base + v] + a.ob[base + v];
    a.ygla[base + v] = o * rsq * a.gla_norm_g[(long)l * d::GDV + v] * siluf_(a.proj[(long)r * d::NIN + d::O_OG + hd * d::GDV + v]); }
}
template <class T> HD void st_hyconv3(const NaiveBufs& a, int l, long idx) {
  using d = DD<T>; const int j = (int)(idx % (3 * d::HW)), r = (int)(idx / (3 * d::HW));
  const int lo = r < d::S ? 0 : d::S, hi = r < d::S ? d::S : d::R;
  const float* w = a.hy_conv_w + (long)l * 3 * 3 * d::HW;
  float v = a.hy_conv_b[(long)l * 3 * d::HW + j] + a.proj[(long)r * d::NIN + d::O_HY + j] * w[1 * 3 * d::HW + j];
  if (r - 1 >= lo) v += a.proj[(long)(r - 1) * d::NIN + d::O_HY + j] * w[0 * 3 * d::HW + j];
  if (r + 1 < hi) v += a.proj[(long)(r + 1) * d::NIN + d::O_HY + j] * w[2 * 3 * d::HW + j];
  a.uc[idx] = v;
}
template <class T> HD void st_hylong(const NaiveBufs& a, int l, int o, long idx) {
  using d = DD<T>; const int c = (int)(idx % d::HW); const int rb = (int)(idx / d::HW); const int r0 = rb * 4;
  const bool lat = r0 < d::S; const int n = lat ? d::S : d::C; const int base = lat ? 0 : d::S; const int t0 = r0 - base;
  const float* tp = (lat ? a.tapsS : a.tapsC) + (long)o * 2 * n * d::HW + c; const float nr = (lat ? a.nrmS : a.nrmC)[o * d::HW + c];
  const float* zs = o == 0 ? a.uc + 2 * d::HW + c : a.z1 + c; const int ldz = o == 0 ? 3 * d::HW : d::HW;
  float acc0 = 0.f, acc1 = 0.f, acc2 = 0.f, acc3 = 0.f;
  auto tap = [&](int lag) { const int li = lag >= 0 ? lag : 2 * n + lag; return tp[(long)li * d::HW]; };
  float w0 = tap(t0), w1 = tap(t0 + 1), w2 = tap(t0 + 2), w3 = tap(t0 + 3);
  for (int s = 0; s < n; ++s) {
    const float zv = zs[(long)(base + s) * ldz];
    acc0 += w0 * zv; acc1 += w1 * zv; acc2 += w2 * zv; acc3 += w3 * zv;
    w3 = w2; w2 = w1; w1 = w0; w0 = (s + 1 < n) ? tap(t0 - s - 1) : 0.f;
  }
  const float sk = a.hy_skip[((long)l * 2 + o) * d::HW + c];
  float* dst = o == 0 ? a.z1 : a.yhy;
  const float accs[4] = {acc0, acc1, acc2, acc3};
#pragma unroll
  for (int i = 0; i < 4; ++i) { const int r = r0 + i; const float zr = zs[(long)r * ldz];
    dst[(long)r * d::HW + c] = a.uc[(long)r * 3 * d::HW + o * d::HW + c] * (accs[i] / nr + sk * zr); }
}
template <class T> HD void st_router(const NaiveBufs& a, long idx) {
  using d = DD<T>; const int r = (int)idx; const float* hr = a.h + (long)r * d::D;
  float sc[d::NE], sel[d::NE];
#pragma unroll
  for (int e = 0; e < d::NE; ++e) sc[e] = 0.f;
  for (int k = 0; k < d::D; ++k) { const float hv = hr[k];
#pragma unroll
    for (int e = 0; e < d::NE; ++e) sc[e] += hv * a.router_w[(long)k * d::NE + e]; }
#pragma unroll
  for (int e = 0; e < d::NE; ++e) { sc[e] = sigmoidf_(sc[e]); sel[e] = sc[e] + a.router_b[e]; }
  int bestg = 0; float bestgs = -1e30f;
#pragma unroll
  for (int g = 0; g < d::NG; ++g) { float m1 = -1e30f, m2 = -1e30f;
#pragma unroll
    for (int i = 0; i < d::EPG; ++i) { const float v = sel[g * d::EPG + i]; if (v > m1) { m2 = m1; m1 = v; } else if (v > m2) m2 = v; }
    const float gs = m1 + m2; if (gs > bestgs) { bestgs = gs; bestg = g; } }
  int i1 = -1, i2 = -1; float v1 = -1e30f, v2 = -1e30f, s1 = 0.f, s2 = 0.f;
#pragma unroll
  for (int e = 0; e < d::NE; ++e) { if (e / d::EPG == bestg) { const float v = sel[e];
      if (v > v1) { v2 = v1; i2 = i1; s2 = s1; v1 = v; i1 = e; s1 = sc[e]; } else if (v > v2) { v2 = v; i2 = e; s2 = sc[e]; } } }
  const float inv = 1.f / (s1 + s2);
  a.ridx[2 * r] = i1; a.ridx[2 * r + 1] = i2; a.rw[2 * r] = s1 * inv; a.rw[2 * r + 1] = s2 * inv;
}
template <class T> HD void st_moehid(const NaiveBufs& a, int l, long idx) {
  using d = DD<T>; const int j = (int)(idx % d::DE); const int k = (int)((idx / d::DE) % 2); const int r = (int)(idx / (2 * d::DE));
  const int e = a.ridx[2 * r + k]; const float* hr = a.h + (long)r * d::D;
  const float* wg = a.moe_w_gate + (((long)l * d::NE + e) * d::D) * d::DE + j; const float* wu = a.moe_w_up + (((long)l * d::NE + e) * d::D) * d::DE + j;
  float g = 0.f, u = 0.f;
  for (int i = 0; i < d::D; ++i) { const float hv = hr[i]; g += hv * wg[(long)i * d::DE]; u += hv * wu[(long)i * d::DE]; }
  a.hid[idx] = siluf_(g) * u;
}
template <class T> HD void st_moeout(const NaiveBufs& a, int l, int b, long idx) {
  using d = DD<T>; const int dd = (int)(idx % d::D), r = (int)(idx / d::D);
  float acc = 0.f;
  for (int k = 0; k < 2; ++k) { const int e = a.ridx[2 * r + k]; const float* hk = a.hid + ((long)r * 2 + k) * d::DE;
    const float* wd = a.moe_w_down + (((long)l * d::NE + e) * d::DE) * d::D + dd; float s = 0.f;
    for (int j = 0; j < d::DE; ++j) s += hk[j] * wd[(long)j * d::D];
    acc += a.rw[2 * r + k] * s; }
  const float g2 = a.mod[(long)(r < d::S ? b : d::B) * 6 * d::D + 5 * d::D + dd];
  float* xr = xrow_w<T>(a, b, r); xr[dd] += g2 * acc;
}
enum { L_MOD = 0, L_HID_S, L_HID_C, L_TAPS_S, L_TAPS_C, L_NRM_S, L_NRM_C, N_LSTAGES,
       P_RS1 = 16, P_NORM1, P_INPROJ, P_QKNORM, P_ATTN_L, P_ATTN_C, P_GLALA, P_GLASCAN, P_GLAOUT, P_HYC3, P_HYL0, P_HYL1,
       P_MRG_HY, P_MRG_GLA, P_MRG_ATT, P_OUT_L, P_OUT_C, P_RS2, P_NORM2, P_ROUTER, P_MOEHID, P_MOEOUT, P_END };
constexpr int ATT_NSPLIT = 4;

template <class T> HD long stage_items(int st, int l) {
  using d = DD<T>; const bool last = (l == d::DEPTH - 1);
  switch (st) {
    case L_MOD: return (long)(d::B + 1) * 6 * d::D;
    case L_HID_S: return (long)d::S * d::HF;
    case L_HID_C: return (long)d::C * d::HF;
    case L_TAPS_S: return 2L * 2 * d::S * d::HW;
    case L_TAPS_C: return 2L * 2 * d::C * d::HW;
    case L_NRM_S: case L_NRM_C: return 2L * d::HW;
    case P_RS1: case P_RS2: case P_ROUTER: return d::R;
    case P_NORM1: case P_NORM2: return (long)d::R * d::D;
    case P_INPROJ: return (long)(d::R / 4) * (d::NIN / 4);
    case P_QKNORM: return (long)d::R * (d::AH + d::AKV);
    case P_ATTN_L: return (long)d::S * d::AH * ATT_NSPLIT;
    case P_ATTN_C: return last ? 0 : (long)d::C * d::AH * ATT_NSPLIT;
    case P_GLALA: return (long)d::R * 2 * d::GKW;
    case P_GLASCAN: return 2L * d::GH * d::GDV;
    case P_GLAOUT: return (long)d::R * d::GH;
    case P_HYC3: return (long)d::R * 3 * d::HW;
    case P_HYL0: case P_HYL1: return (long)(d::R / 4) * d::HW;
    case P_MRG_HY: case P_MRG_GLA: case P_MRG_ATT: return (long)(d::R / 4) * (d::D / 4);
    case P_OUT_L: return (long)(d::S / 4) * (d::D / 4);
    case P_OUT_C: return last ? 0 : (long)(d::C / 4) * (d::D / 4);
    case P_MOEHID: return (long)d::R * 2 * d::DE;
    case P_MOEOUT: return (long)(last ? d::S : d::R) * d::D;
  }
  return 0;
}

template <class T, int ST> HD void stage_run(const NaiveBufs& a, int l, int b, long idx) {
  using d = DD<T>;
  if constexpr (ST == L_MOD) st_mod<T>(a, l, idx);
  else if constexpr (ST == L_HID_S) st_hyhid<T>(a, l, 0, idx);
  else if constexpr (ST == L_HID_C) st_hyhid<T>(a, l, 1, idx);
  else if constexpr (ST == L_TAPS_S) st_hytaps<T>(a, l, 0, idx);
  else if constexpr (ST == L_TAPS_C) st_hytaps<T>(a, l, 1, idx);
  else if constexpr (ST == L_NRM_S) st_hynorm<T>(a, 0, idx);
  else if constexpr (ST == L_NRM_C) st_hynorm<T>(a, 1, idx);
  else if constexpr (ST == P_RS1) st_rs<T>(a, l, b, 0, idx);
  else if constexpr (ST == P_RS2) st_rs<T>(a, l, b, 1, idx);
  else if constexpr (ST == P_NORM1) st_norm<T>(a, l, b, 0, idx);
  else if constexpr (ST == P_NORM2) st_norm<T>(a, l, b, 1, idx);
  else if constexpr (ST == P_INPROJ) { GemmArgs g{a.h, d::D, a.w_in + (long)l * d::D * d::NIN, d::NIN, a.proj, d::NIN, d::R, d::NIN, d::D, nullptr, 0, nullptr, nullptr, 0, 0}; st_gemm(g, idx); }
  else if constexpr (ST == P_QKNORM) st_qknorm<T>(a, l, idx);
  else if constexpr (ST == P_ATTN_L) st_attn<T, ATT_NSPLIT>(a, 0, d::S, idx);
  else if constexpr (ST == P_ATTN_C) st_attn<T, ATT_NSPLIT>(a, d::S, d::C, idx);
  else if constexpr (ST == P_GLALA) st_glala<T>(a, l, idx);
  else if constexpr (ST == P_GLASCAN) st_glascan<T>(a, idx);
  else if constexpr (ST == P_GLAOUT) st_glaout<T>(a, l, idx);
  else if constexpr (ST == P_HYC3) st_hyconv3<T>(a, l, idx);
  else if constexpr (ST == P_HYL0) st_hylong<T>(a, l, 0, idx);
  else if constexpr (ST == P_HYL1) st_hylong<T>(a, l, 1, idx);
  else if constexpr (ST == P_MRG_HY) { GemmArgs g{a.yhy, d::HW, a.w_br_hy + (long)l * d::HW * d::D, d::D, a.m, d::D, d::R, d::D, d::HW, a.proj + d::O_BR, d::NIN, nullptr, nullptr, 0, 0}; st_gemm(g, idx); }
  else if constexpr (ST == P_MRG_GLA) { GemmArgs g{a.ygla, d::GVW, a.w_br_gla + (long)l * d::GVW * d::D, d::D, a.m, d::D, d::R, d::D, d::GVW, a.proj + d::O_BR + d::D, d::NIN, nullptr, nullptr, 0, 1}; st_gemm(g, idx); }
  else if constexpr (ST == P_MRG_ATT) { GemmArgs g{a.yatt, d::AQW, a.w_br_att + (long)l * d::AQW * d::D, d::D, a.m, d::D, d::R, d::D, d::AQW, a.proj + d::O_BR + 2 * d::D, d::NIN, nullptr, nullptr, 0, 1}; st_gemm(g, idx); }
  else if constexpr (ST == P_OUT_L) { const float* res = (l == 0 ? a.x : (const float*)a.out) + (long)b * d::S * d::D;
    GemmArgs g{a.m, d::D, a.w_out + (long)l * d::D * d::D, d::D, a.out + (long)b * d::S * d::D, d::D, d::S, d::D, d::D, nullptr, 0, a.mod + (long)b * 6 * d::D + 2 * d::D, res, d::D, 0}; st_gemm(g, idx); }
  else if constexpr (ST == P_OUT_C) { const float* res = (l == 0 ? a.ctx : (const float*)a.xc) + (long)b * d::C * d::D;
    GemmArgs g{a.m + (long)d::S * d::D, d::D, a.w_out + (long)l * d::D * d::D, d::D, a.xc + (long)b * d::C * d::D, d::D, d::C, d::D, d::D, nullptr, 0, a.mod + (long)d::B * 6 * d::D + 2 * d::D, res, d::D, 0}; st_gemm(g, idx); }
  else if constexpr (ST == P_ROUTER) st_router<T>(a, idx);
  else if constexpr (ST == P_MOEHID) st_moehid<T>(a, l, idx);
  else if constexpr (ST == P_MOEOUT) st_moeout<T>(a, l, b, idx);
}

template <class T> inline size_t carve(NaiveBufs& a, float* ws) {
  using d = DD<T>; size_t o = 0; auto take = [&](size_t n) { float* p = ws ? ws + o : nullptr; o += (n + 63) & ~(size_t)63; return p; };
  a.mod = take((size_t)(d::B + 1) * 6 * d::D);
  a.hid2S = take((size_t)d::S * d::HF); a.hid2C = take((size_t)d::C * d::HF);
  a.tapsS = take((size_t)2 * 2 * d::S * d::HW); a.tapsC = take((size_t)2 * 2 * d::C * d::HW);
  a.nrmS = take(2 * d::HW); a.nrmC = take(2 * d::HW);
  a.rs = take(d::R); a.h = take((size_t)d::R * d::D); a.proj = take((size_t)d::R * d::NIN);
  a.qn = take((size_t)d::R * d::AQW); a.kn = take((size_t)d::R * d::AKVW);
  a.uc = take((size_t)d::R * 3 * d::HW); a.z1 = take((size_t)d::R * d::HW); a.yhy = take((size_t)d::R * d::HW);
  a.xc = take((size_t)d::B * d::C * d::D);
#ifdef HOST_TEST
  a.yatt = take((size_t)d::R * d::AQW); a.laf = take((size_t)d::R * d::GKW); a.lab = take((size_t)d::R * d::GKW);
  a.of = take((size_t)d::R * d::GVW); a.ob = take((size_t)d::R * d::GVW); a.ygla = take((size_t)d::R * d::GVW);
  a.m = take((size_t)d::R * d::D); a.ridx = (int*)take((size_t)d::R * 2); a.rw = take((size_t)d::R * 2); a.hid = take((size_t)d::R * 2 * d::DE);
#endif
  return o;
}
template <class T> inline void set_inputs(NaiveBufs& a, const float* const* in) {
  int i = 0;
  a.x = in[i++]; a.c = in[i++]; a.ctx = in[i++]; a.c_ctx = in[i++]; a.w_mod = in[i++]; a.b_mod = in[i++]; a.norm1_g = in[i++]; a.norm2_g = in[i++];
  a.w_in = in[i++]; a.q_norm_g = in[i++]; a.k_norm_g = in[i++]; a.gla_wa2 = in[i++]; a.gla_ba = in[i++]; a.gla_norm_g = in[i++];
  a.hy_conv_w = in[i++]; a.hy_conv_b = in[i++]; a.hy_pos_w1 = in[i++]; a.hy_pos_b1 = in[i++]; a.hy_sin_freq = in[i++]; a.hy_pos_w2 = in[i++];
  a.hy_pos_b2 = in[i++]; a.hy_pos_w3 = in[i++]; a.hy_decay = in[i++]; a.hy_skip = in[i++]; a.w_br_hy = in[i++]; a.w_br_gla = in[i++];
  a.w_br_att = in[i++]; a.w_out = in[i++]; a.router_w = in[i++]; a.router_b = in[i++]; a.moe_w_gate = in[i++]; a.moe_w_up = in[i++]; a.moe_w_down = in[i++];
}

#define LSTAGES(X) X(L_MOD) X(L_HID_S) X(L_HID_C) X(L_TAPS_S) X(L_TAPS_C) X(L_NRM_S) X(L_NRM_C)
#define PSTAGES(X) X(P_RS1) X(P_NORM1) X(P_INPROJ) X(P_QKNORM) X(P_ATTN_L) X(P_ATTN_C) X(P_GLALA) X(P_GLASCAN) X(P_GLAOUT) X(P_HYC3) X(P_HYL0) X(P_HYL1) \
  X(P_MRG_HY) X(P_MRG_GLA) X(P_MRG_ATT) X(P_OUT_L) X(P_OUT_C) X(P_RS2) X(P_NORM2) X(P_ROUTER) X(P_MOEHID) X(P_MOEOUT)
namespace pro {
__device__ __forceinline__ void mod_phase(const NaiveBufs& a, int l, LAS unsigned char* lds) {
  int tz = threadIdx.x; asm volatile("" : "+v"(tz));
  __syncthreads();
  LAS float* sl = (LAS float*)lds; LAS float* part = sl + 9 * 1024;
  for (int e = tz; e < 9 * 1024; e += NTHREADS) { const int bb = e >> 10, k = e & 1023; const float cv = bb < 8 ? a.c[bb * 1024 + k] : a.c_ctx[k]; sl[e] = cv / (1.f + __expf(-cv)); }
  __syncthreads();
  const float* w = a.w_mod + (size_t)l * 1024 * 6144;
  const int jl = tz & 63, ks = tz >> 6;
  for (int cb = blockIdx.x; cb < 96; cb += gridDim.x) { const int j = cb * 64 + jl; float acc[9];
#pragma unroll
    for (int q = 0; q < 9; ++q) acc[q] = 0.f;
#pragma unroll 4
    for (int k = ks * 128; k < ks * 128 + 128; ++k) { const float wv = w[(size_t)k * 6144 + j];
#pragma unroll
      for (int q = 0; q < 9; ++q) acc[q] += sl[q * 1024 + k] * wv; }
#pragma unroll
    for (int q = 0; q < 9; ++q) part[(ks * 9 + q) * 64 + jl] = acc[q];
    __syncthreads();
    for (int e = tz; e < 9 * 64; e += NTHREADS) { const int q = e >> 6, jj = e & 63; float s = a.b_mod[(size_t)l * 6144 + cb * 64 + jj];
#pragma unroll
      for (int k8 = 0; k8 < 8; ++k8) s += part[(k8 * 9 + q) * 64 + jj];
      a.mod[(size_t)q * 6144 + cb * 64 + jj] = s; }
    __syncthreads(); }
  __syncthreads();
}
__device__ __forceinline__ void hid_phase(const NaiveBufs& a, int l, int n, float* dst, LAS unsigned char* lds) {
  int tz = threadIdx.x; asm volatile("" : "+v"(tz));
  LAS float* Z = (LAS float*)(lds + 40960); LAS float* H1 = Z + 8 * 36;
  const float* w1 = a.hy_pos_w1 + (size_t)l * 33 * 64; const float* b1 = a.hy_pos_b1 + l * 64; const float* fr = a.hy_sin_freq + l * 64;
  const float* w2 = a.hy_pos_w2 + (size_t)l * 64 * 64; const float* b2 = a.hy_pos_b2 + l * 64;
  const float w0 = 2.f * 3.14159265358979323846f / (float)n;
  for (int t0 = blockIdx.x * 8; t0 < n; t0 += gridDim.x * 8) {
    if (tz < 8 * 33) { const int tt = tz / 33, e = tz % 33, t = t0 + tt; float v;
      if (e == 0) v = (float)t / (float)n; else { const int bnd = (e - 1) & 15; const float band = 1e-4f + (float)bnd * (15.f - 1e-4f) / 15.f; const float ph = w0 * (float)t * band; v = e <= 16 ? cosf(ph) : -sinf(ph); }
      Z[tt * 36 + e] = v; }
    __syncthreads();
    { const int tt = tz >> 6, i = tz & 63; float acc = b1[i];
#pragma unroll
      for (int e = 0; e < 33; ++e) acc += Z[tt * 36 + e] * w1[e * 64 + i];
      H1[tt * 64 + i] = sinf(fr[i] * acc); }
    __syncthreads();
    { const int tt = tz >> 6, j = tz & 63; float acc = b2[j];
#pragma unroll 8
      for (int i = 0; i < 64; ++i) acc += H1[tt * 64 + i] * w2[i * 64 + j];
      if (t0 + tt < n) dst[(size_t)(t0 + tt) * 64 + j] = sinf(fr[j] * acc); }
    __syncthreads();
  }
}
__device__ __forceinline__ void nrmS_phase(const NaiveBufs& a) {
  int tz = threadIdx.x; asm volatile("" : "+v"(tz)); const int lane = tz & 63, wave = __builtin_amdgcn_readfirstlane(tz >> 6);
  for (int oc = blockIdx.x * NWAVES + wave; oc < 1024; oc += gridDim.x * NWAVES) { const float* tp = a.tapsS + (size_t)oc * 8192; float s = 0.f;
#pragma unroll 8
    for (int k = lane; k < 8192; k += 64) s += fabsf(tp[k]);
    s = moe::wave_sum(s); if (lane == 0) a.nrmS[oc] = s + 1e-6f; }
}
constexpr int TCOPY = 8232;
__device__ __forceinline__ void tapsB_phase(const NaiveBufs& a, int l, bf16_t* tapsB, LAS unsigned char* lds) {
  int tz = threadIdx.x; asm volatile("" : "+v"(tz));
  const float* w3 = a.hy_pos_w3 + (size_t)l * 64 * 2048; const float* dcy = a.hy_decay + (size_t)l * 2048;
  typedef float f4 __attribute__((ext_vector_type(4)));
  LAS float* W = (LAS float*)lds;
  for (int cp = blockIdx.x; cp < 256; cp += gridDim.x) {
    __syncthreads();
    { const int ch = tz >> 8, e = tz & 255, c = cp + 256 * ch; W[tz] = w3[(size_t)(e >> 2) * 2048 + (e & 3) * 512 + c]; if (tz < 8) W[512 + tz] = fabsf(dcy[(tz & 3) * 512 + cp + 256 * (tz >> 2)]); }
    __syncthreads();
    for (int t = tz; t < 4096; t += NTHREADS) {
      const f4* h2 = (const f4*)(a.hid2S + (size_t)t * 64); f4 acc0 = {0.f, 0.f, 0.f, 0.f}, acc1 = {0.f, 0.f, 0.f, 0.f};
#pragma unroll 4
      for (int j4 = 0; j4 < 16; ++j4) { const f4 h = h2[j4];
#pragma unroll
        for (int e = 0; e < 4; ++e) { acc0 += h[e] * *(const LAS f4*)(W + (4 * j4 + e) * 4); acc1 += h[e] * *(const LAS f4*)(W + 256 + (4 * j4 + e) * 4); } }
      const float tn = (float)t * (1.f / 4096.f);
#pragma unroll
      for (int ch = 0; ch < 2; ++ch)
#pragma unroll
        for (int q = 0; q < 4; ++q) { const int o = q >> 1, dir = q & 1; if (dir == 1 && t == 0) continue; const int c = cp + 256 * ch;
          const bf16_t bv = (bf16_t)f2bf((ch ? acc1[q] : acc0[q]) * __expf(-tn * W[512 + 4 * ch + q]));
          bf16_t* base = tapsB + ((size_t)o * 512 + c) * 2 * TCOPY; const int x0 = dir ? 4096 + t : 4096 - t;
          base[x0] = bv; base[TCOPY + x0 - 1] = bv; } } }
  for (long idx = (long)blockIdx.x * NTHREADS + tz; idx < 1024L * 96; idx += (long)gridDim.x * NTHREADS) { const int oc = (int)(idx / 96), e = (int)(idx % 96); bf16_t* base = tapsB + (size_t)oc * 2 * TCOPY;
    if (e < 40) base[8192 + e] = 0; else if (e < 81) base[TCOPY + 8191 + (e - 40)] = 0; else if (e == 81) base[0] = 0; }
}
__device__ __forceinline__ void nrmB_phase(const NaiveBufs& a, const bf16_t* tapsB) {
  int tz = threadIdx.x; asm volatile("" : "+v"(tz)); const int lane = tz & 63, wave = __builtin_amdgcn_readfirstlane(tz >> 6);
  for (int oc = blockIdx.x * NWAVES + wave; oc < 1024; oc += gridDim.x * NWAVES) { const bf16_t* tp = tapsB + (size_t)oc * 2 * TCOPY; float s = 0.f;
#pragma unroll 8
    for (int k = lane; k < 8192; k += 64) s += fabsf(bf2f(tp[k]));
    s = moe::wave_sum(s); if (lane == 0) a.nrmS[oc] = s + 1e-6f; }
}
}
using TD = FullDims;
using dd = DD<TD>;
constexpr int GB = 4, NGRP = 2, RB = dd::R  , RG = GB * RB, PLD = dd::NIN, PANELS = RG / 256, PPB = RB / 256  ;
constexpr size_t BAR_BYTES = 16384 + 4 * 4096; constexpr int CNT_OFF = 16384;
constexpr int MPG = 38912;
constexpr size_t CS_BYTES = (size_t)2 * 4 * 68 * 64 * 128 * 2, DEC_BYTES = (size_t)2 * 4 * 68 * 64 * 4;
constexpr size_t UCT_BYTES = (size_t)1536 * 4096 * 2, YT_BYTES = (size_t)512 * 4096 * 2, UCC_BYTES = (size_t)256 * 1536 * 4, Z1C_BYTES = (size_t)256 * 512 * 4;
constexpr size_t MIX_BYTES = GB * (CS_BYTES + DEC_BYTES) > GB * (UCT_BYTES + YT_BYTES + UCC_BYTES + Z1C_BYTES) ? GB * (CS_BYTES + DEC_BYTES) : GB * (UCT_BYTES + YT_BYTES + UCC_BYTES + Z1C_BYTES);

struct KArgs { NaiveBufs a; unsigned* bar; int* cnt; bf16_t *WgaT; bf16_t *WinT, *WhyT, *WglaT, *WattT, *WoutT, *WguT, *WdT, *hb, *proj; unsigned char* mix;
  bf16_t *hp, *hid, *contrib; int* srcrow; float* wgt; moe::Route* route; float* wts; };

struct EpiProjBf16 {
  static constexpr bool PERM = true, AFTER_DRAIN = false;
  bf16_t* P;
  __device__ __forceinline__ void operator()(const pg8::f32x4 (&acc)[2][2][4][2], const pg8::Unit& u, int wr, int wc, int fr, int fq) const {
    const int row0 = u.pm * 256 + wr * 64 + fr, col0 = u.pn * 256 + wc * 32 + 8 * fq;
    const int cr0 = col0 + (col0 >= dd::O_GA ? 32 : 0), cr1 = col0 + 128 + (col0 + 128 >= dd::O_GA ? 32 : 0);
#pragma unroll
    for (int ai = 0; ai < 2; ++ai)
#pragma unroll
      for (int m = 0; m < 4; ++m) { bf16_t* rowp = P + (size_t)(row0 + ai * 128 + m * 16) * PLD;
#pragma unroll
        for (int bj = 0; bj < 2; ++bj) { const pg8::f32x4 v0 = acc[ai][bj][m][0], v1 = acc[ai][bj][m][1];
          v4u o; o.x = pk2(v0[0], v0[1]); o.y = pk2(v0[2], v0[3]); o.z = pk2(v1[0], v1[1]); o.w = pk2(v1[2], v1[3]); *(v4u*)(rowp + (bj ? cr1 : cr0)) = o; } }
  }
};
template <bool ACCUM> struct EpiMergeB {
  static constexpr bool PERM = true, AFTER_DRAIN = false;
  const bf16_t* gate; bf16_t* M;
  __device__ __forceinline__ void operator()(const pg8::f32x4 (&acc)[2][2][4][2], const pg8::Unit& u, int wr, int wc, int fr, int fq) const {
    const int row0 = u.pm * 256 + wr * 64 + fr, col0 = u.pn * 256 + wc * 32 + 8 * fq;
#pragma unroll
    for (int ai2 = 0; ai2 < 4; ++ai2) { const int ai = ai2 >> 1, m0 = (ai2 & 1) * 2;
      v4u gw[4][2], mo[4][2];
#pragma unroll
      for (int m = m0; m < m0 + 2; ++m)
#pragma unroll
        for (int bj = 0; bj < 2; ++bj) { const size_t r = (size_t)(row0 + ai * 128 + m * 16); const int c = col0 + bj * 128; gw[m][bj] = *(const v4u*)(gate + r * PLD + c); if (ACCUM) mo[m][bj] = *(const v4u*)(M + r * 1024 + c); }
#pragma unroll
      for (int m = m0; m < m0 + 2; ++m)
#pragma unroll
        for (int bj = 0; bj < 2; ++bj) { const size_t r = (size_t)(row0 + ai * 128 + m * 16); const int c = col0 + bj * 128; const v4u g4 = gw[m][bj];
          pg8::f32x4 v0 = acc[ai][bj][m][0], v1 = acc[ai][bj][m][1];
          v0[0] *= fsigmoid(bf2f(g4.x & 0xffff)); v0[1] *= fsigmoid(bf2f(g4.x >> 16)); v0[2] *= fsigmoid(bf2f(g4.y & 0xffff)); v0[3] *= fsigmoid(bf2f(g4.y >> 16));
          v1[0] *= fsigmoid(bf2f(g4.z & 0xffff)); v1[1] *= fsigmoid(bf2f(g4.z >> 16)); v1[2] *= fsigmoid(bf2f(g4.w & 0xffff)); v1[3] *= fsigmoid(bf2f(g4.w >> 16));
          if (ACCUM) { const v4u o = mo[m][bj]; v0[0] += bf2f(o.x & 0xffff); v0[1] += bf2f(o.x >> 16); v0[2] += bf2f(o.y & 0xffff); v0[3] += bf2f(o.y >> 16);
            v1[0] += bf2f(o.z & 0xffff); v1[1] += bf2f(o.z >> 16); v1[2] += bf2f(o.w & 0xffff); v1[3] += bf2f(o.w >> 16); }
          v4u o2; o2.x = pk2(v0[0], v0[1]); o2.y = pk2(v0[2], v0[3]); o2.z = pk2(v1[0], v1[1]); o2.w = pk2(v1[2], v1[3]); *(v4u*)(M + r * 1024 + c) = o2; } }
  }
};
struct EpiOutG {
  static constexpr bool PERM = false, AFTER_DRAIN = false;
  const float* resL; float* outL; const float* resC; float* outC; const float* mod; int b0; bool ctx_on;
  __device__ __forceinline__ void operator()(const pg8::f32x4 (&acc)[2][2][4][2], const pg8::Unit& u, int wr, int wc, int fr, int fq) const {
    const int bl = u.pm / PPB, lp = u.pm % PPB; const bool isc = lp == PPB - 1; if (isc && !ctx_on) return;
    const int b = b0 + bl;
    const float* res = isc ? resC + (size_t)b * dd::C * 1024 : resL + ((size_t)b * dd::S + lp * 256) * 1024;
    float* out = isc ? outC + (size_t)b * dd::C * 1024 : outL + ((size_t)b * dd::S + lp * 256) * 1024;
    const float* gv = mod + (size_t)(isc ? dd::B : b) * 6 * 1024 + 2 * 1024;
    const int row0 = wr * 64 + fr, col0 = u.pn * 256 + wc * 32 + 4 * fq;
    pg8::f32x4 gg[2][2];
#pragma unroll
    for (int bj = 0; bj < 2; ++bj)
#pragma unroll
      for (int n = 0; n < 2; ++n) gg[bj][n] = *(const pg8::f32x4*)(gv + col0 + bj * 128 + n * 16);
#pragma unroll
    for (int ai2 = 0; ai2 < 4; ++ai2) { const int ai = ai2 >> 1, m0 = (ai2 & 1) * 2;
      pg8::f32x4 rv[4][2][2];
#pragma unroll
      for (int m = m0; m < m0 + 2; ++m)
#pragma unroll
        for (int bj = 0; bj < 2; ++bj)
#pragma unroll
          for (int n = 0; n < 2; ++n) rv[m][bj][n] = *(const pg8::f32x4*)(res + (size_t)(row0 + ai * 128 + m * 16) * 1024 + col0 + bj * 128 + n * 16);
#pragma unroll
      for (int m = m0; m < m0 + 2; ++m)
#pragma unroll
        for (int bj = 0; bj < 2; ++bj)
#pragma unroll
          for (int n = 0; n < 2; ++n) *(pg8::f32x4*)(out + (size_t)(row0 + ai * 128 + m * 16) * 1024 + col0 + bj * 128 + n * 16) = rv[m][bj][n] + gg[bj][n] * acc[ai][bj][m][n]; }
  }
};
struct GroupOrder {
  int nN, nwg, G, c; bool lat;
  __device__ void init(int N, int G_, int c_, bool lat_) { nN = N / 256; lat = lat_; nwg = (lat ? GB * 16 : PANELS) * nN; G = G_; c = c_; }
  __device__ __forceinline__ bool next(int i, pg8::Unit& u) const { const long L = (long)i * G + c; if (L >= nwg) return false; const int p = (int)L / nN; u.pm = lat ? (p >> 4) * PPB + (p & 15) : p; u.pn = (int)L % nN; u.acol = 0; u.nt = 0; return true; }
  __device__ __forceinline__ void a_ready(const pg8::Unit&) const {}
  __device__ __forceinline__ void done(const pg8::Unit&) const {}
};
struct MergeOrder {
  int ntiles, G, c; bool lat;
  __device__ void init(int G_, int c_, bool lat_) { lat = lat_; ntiles = (lat ? GB * 16 : PANELS) * 4; G = G_; c = c_; }
  __device__ __forceinline__ bool next(int i, pg8::Unit& u) const { const int rnd = i / 3, gi = i - 3 * rnd; const long tile = (long)rnd * G + c; if (tile >= ntiles) return false; const int p = (int)tile >> 2;
    u.pm = lat ? (p >> 4) * PPB + (p & 15) : p; u.pn = gi * 4 + ((int)tile & 3); u.acol = gi == 0 ? dd::O_HY : gi == 1 ? dd::O_OG : dd::O_AQ; u.nt = gi == 2 ? 16 : 8; return true; }
  __device__ __forceinline__ void a_ready(const pg8::Unit&) const {}
  __device__ __forceinline__ void done(const pg8::Unit&) const {}
};
struct EpiMergeS {
  static constexpr bool PERM = true, AFTER_DRAIN = false;
  const bf16_t* gate0; bf16_t* M;
  __device__ __forceinline__ void operator()(const pg8::f32x4 (&acc)[2][2][4][2], const pg8::Unit& u, int wr, int wc, int fr, int fq) const {
    const int gi = u.pn >> 2; const bool accum = gi > 0; const bf16_t* gate = gate0 + gi * 1024;
    const int row0 = u.pm * 256 + wr * 64 + fr, col0 = (u.pn & 3) * 256 + wc * 32 + 8 * fq;
#pragma unroll
    for (int ai2 = 0; ai2 < 4; ++ai2) { const int ai = ai2 >> 1, m0 = (ai2 & 1) * 2;
      v4u gw[4][2], mo[4][2];
#pragma unroll
      for (int m = m0; m < m0 + 2; ++m)
#pragma unroll
        for (int bj = 0; bj < 2; ++bj) { const size_t r = (size_t)(row0 + ai * 128 + m * 16); const int c = col0 + bj * 128; gw[m][bj] = *(const v4u*)(gate + r * PLD + c); mo[m][bj] = (v4u){0u, 0u, 0u, 0u}; if (accum) mo[m][bj] = *(const v4u*)(M + r * 1024 + c); }
#pragma unroll
      for (int m = m0; m < m0 + 2; ++m)
#pragma unroll
        for (int bj = 0; bj < 2; ++bj) { const size_t r = (size_t)(row0 + ai * 128 + m * 16); const int c = col0 + bj * 128; const v4u g4 = gw[m][bj];
          pg8::f32x4 v0 = acc[ai][bj][m][0], v1 = acc[ai][bj][m][1];
          v0[0] *= fsigmoid(bf2f(g4.x & 0xffff)); v0[1] *= fsigmoid(bf2f(g4.x >> 16)); v0[2] *= fsigmoid(bf2f(g4.y & 0xffff)); v0[3] *= fsigmoid(bf2f(g4.y >> 16));
          v1[0] *= fsigmoid(bf2f(g4.z & 0xffff)); v1[1] *= fsigmoid(bf2f(g4.z >> 16)); v1[2] *= fsigmoid(bf2f(g4.w & 0xffff)); v1[3] *= fsigmoid(bf2f(g4.w >> 16));
          { const v4u o = mo[m][bj]; v0[0] += bf2f(o.x & 0xffff); v0[1] += bf2f(o.x >> 16); v0[2] += bf2f(o.y & 0xffff); v0[3] += bf2f(o.y >> 16);
            v1[0] += bf2f(o.z & 0xffff); v1[1] += bf2f(o.z >> 16); v1[2] += bf2f(o.w & 0xffff); v1[3] += bf2f(o.w >> 16); }
          v4u o2; o2.x = pk2(v0[0], v0[1]); o2.y = pk2(v0[2], v0[3]); o2.z = pk2(v1[0], v1[1]); o2.w = pk2(v1[2], v1[3]); *(v4u*)(M + r * 1024 + c) = o2; } }
  }
};
__device__ __forceinline__ const float* xrow_in(const NaiveBufs& a, int l, int b, int r) {
  if (r < dd::S) return (l == 0 ? a.x : (const float*)a.out) + ((size_t)b * dd::S + r) * 1024;
  return (l == 0 ? a.ctx : (const float*)a.xc) + ((size_t)b * dd::C + (r - dd::S)) * 1024;
}
__device__ __forceinline__ float* xrow_cur(const NaiveBufs& a, int b, int r) {
  if (r < dd::S) return a.out + ((size_t)b * dd::S + r) * 1024;
  return a.xc + ((size_t)b * dd::C + (r - dd::S)) * 1024;
}
__device__ __forceinline__ void norm_row(const float* xr, const float* gnorm, const float* shift, const float* scale, bf16_t* hrow, int lane) {
  typedef float f4 __attribute__((ext_vector_type(4)));
  f4 xv[4]; float ss = 0.f;
#pragma unroll
  for (int j = 0; j < 4; ++j) { xv[j] = *(const f4*)(xr + 4 * lane + 256 * j); ss += xv[j][0] * xv[j][0] + xv[j][1] * xv[j][1] + xv[j][2] * xv[j][2] + xv[j][3] * xv[j][3]; }
  const float rs = 1.f / sqrtf(moe::wave_sum(ss) * (1.f / 1024.f) + 1e-6f);
#pragma unroll
  for (int j = 0; j < 4; ++j) { const int c = 4 * lane + 256 * j; const f4 g4 = *(const f4*)(gnorm + c), sh = *(const f4*)(shift + c), sc = *(const f4*)(scale + c);
    f4 h;
#pragma unroll
    for (int i = 0; i < 4; ++i) h[i] = xv[j][i] * rs * g4[i] * (1.f + sc[i]) + sh[i];
    *(unsigned long long*)(hrow + c) = (unsigned long long)pk2(h[0], h[1]) | ((unsigned long long)pk2(h[2], h[3]) << 32); }
}
__device__ __forceinline__ void qknorm_row(bf16_t* prow, const float* qg, const float* kg, int r, int lane) {
  const bool lat = r < dd::S; const int grow = r / dd::GW, gcol = r % dd::GW;
  const int fi = lane & 31; const float pos = (lane < 32) ? (float)grow : (float)gcol;
  const float ang = pos * __builtin_amdgcn_exp2f(-(float)fi * (13.287712379549449f / 32.f));
  const float cs = lat ? __cosf(ang) : 1.f, sn = lat ? __sinf(ang) : 0.f;
  unsigned wv[10];
#pragma unroll
  for (int hh = 0; hh < 10; ++hh) wv[hh] = *((const unsigned*)(prow + (hh < 8 ? dd::O_AQ + hh * 128 : dd::O_AK + (hh - 8) * 128)) + lane);
  float ss[10];
#pragma unroll
  for (int hh = 0; hh < 10; ++hh) { const float x1 = bf2f(wv[hh] & 0xffff), x2 = bf2f(wv[hh] >> 16); ss[hh] = x1 * x1 + x2 * x2; }
#pragma unroll
  for (int o = 1; o < 64; o <<= 1) {
#pragma unroll
    for (int hh = 0; hh < 10; ++hh) ss[hh] += __shfl_xor(ss[hh], o); }
  const float q1 = qg[2 * lane], q2 = qg[2 * lane + 1], k1 = kg[2 * lane], k2 = kg[2 * lane + 1];
#pragma unroll
  for (int hh = 0; hh < 10; ++hh) { unsigned* p = (unsigned*)(prow + (hh < 8 ? dd::O_AQ + hh * 128 : dd::O_AK + (hh - 8) * 128)) + lane;
    const float x1 = bf2f(wv[hh] & 0xffff), x2 = bf2f(wv[hh] >> 16); const float rs = 1.f / sqrtf(ss[hh] * (1.f / 128.f) + 1e-6f);
    const float y1 = x1 * rs * (hh < 8 ? q1 : k1), y2 = x2 * rs * (hh < 8 ? q2 : k2);
    *p = pk2(y1 * cs - y2 * sn, y1 * sn + y2 * cs); }
}

__device__ __forceinline__ void ga_task(const bf16_t* hb, const bf16_t* WgaT, bf16_t* proj, int wt) {
  int tid = threadIdx.x; asm volatile("" : "+v"(tid));
  const int lane = tid & 63, li = lane & 31, lk = lane >> 5; typedef short b8 __attribute__((ext_vector_type(8))); typedef float f16v __attribute__((ext_vector_type(16)));
  const bf16_t* ap = hb + ((size_t)wt * 32 + li) * 1024 + 8 * lk; const bf16_t* bp = WgaT + (size_t)li * 1024 + 8 * lk;
  f16v acc = {};
  for (int k8 = 0; k8 < 8; ++k8) { v4u av[8], bv[8];
#pragma unroll
    for (int j = 0; j < 8; ++j) { av[j] = *(const v4u*)(ap + 128 * k8 + 16 * j); bv[j] = *(const v4u*)(bp + 128 * k8 + 16 * j); }
#pragma unroll
    for (int j = 0; j < 8; ++j) acc = __builtin_amdgcn_mfma_f32_32x32x16_bf16(__builtin_bit_cast(b8, av[j]), __builtin_bit_cast(b8, bv[j]), acc, 0, 0, 0); }
#pragma unroll
  for (int r = 0; r < 16; ++r) { const int row = wt * 32 + (r & 3) + 8 * (r >> 2) + 4 * lk; proj[(size_t)row * PLD + dd::O_GA + li] = (bf16_t)f2bf(acc[r]); }
}

__global__ void __launch_bounds__(NTHREADS, 2) mega_kernel(KArgs ka_unused) {
  extern __shared__ __attribute__((aligned(16))) unsigned char lds_raw[];
  LAS unsigned char* lds = (LAS unsigned char*)lds_raw;
  volatile LAS unsigned* MISC = (volatile LAS unsigned*)(lds + MISC_OFF);
  constexpr int ARGS_OFF = MISC_OFF + 256;
  static_assert(ARGS_OFF + sizeof(KArgs) <= LDS_BYTES, "LDS map");
  { const unsigned __attribute__((address_space(4)))* kp = (const unsigned __attribute__((address_space(4)))*)__builtin_amdgcn_kernarg_segment_ptr();
    for (int i = threadIdx.x; i < (int)(sizeof(KArgs) / 4); i += NTHREADS) ((LAS unsigned*)(lds + ARGS_OFF))[i] = kp[i]; }
  if (threadIdx.x < 64) MISC[threadIdx.x] = 0u;
  __syncthreads();
  const KArgs& ka = *(const KArgs*)(const LAS KArgs*)(lds + ARGS_OFF);
  const NaiveBufs& a = ka.a;
  unsigned* bar_s; { const unsigned long long bp = (unsigned long long)ka.bar; const unsigned lo_ = __builtin_amdgcn_readfirstlane((unsigned)bp), hi_ = __builtin_amdgcn_readfirstlane((unsigned)(bp >> 32));
    bar_s = (unsigned*)(((unsigned long long)hi_ << 32) | lo_); }
  XcdBarrier xb = xcd_barrier_post(bar_s, MISC);
#define SPTR(T, name, src) T* name; { const unsigned long long bp_ = (unsigned long long)(src); const unsigned lo_ = __builtin_amdgcn_readfirstlane((unsigned)bp_), hi_ = __builtin_amdgcn_readfirstlane((unsigned)(bp_ >> 32)); name = (T*)(((unsigned long long)hi_ << 32) | lo_); }
  SPTR(bf16_t, proj_s, ka.proj) SPTR(bf16_t, hb_s, ka.hb) SPTR(unsigned char, mix_s, ka.mix)
  const long gs = (long)gridDim.x * NTHREADS;
  LAS int* poff = (LAS int*)(lds + MISC_OFF + 64);
#define TID_SETUP int tz = threadIdx.x; asm volatile("" : "+v"(tz)); const int lane = tz & 63, wave = __builtin_amdgcn_readfirstlane(tz >> 6); \
    const int gw = blockIdx.x * NWAVES + wave, NGW = gridDim.x * NWAVES; const long gt = (long)blockIdx.x * NTHREADS + tz; (void)lane; (void)gw; (void)NGW; (void)gt;
#define LSTAGE(ST) { TID_SETUP const long n_ = stage_items<TD>(ST, l); for (long i_ = gt; i_ < n_; i_ += gs) stage_run<TD, ST>(a, l, 0, i_); }
  for (int l = 0; l < dd::DEPTH; ++l) {
    const bool last = (l == dd::DEPTH - 1);
    { TID_SETUP
      LAS float* scr = (LAS float*)(lds + RING_OFF + wave * 16384);
      constexpr int NIT = (dd::D / 64) * (dd::NIN / 32);
      for (int it = gw; it < NIT; it += NGW) { const int n0 = 32 * (it % (dd::NIN / 32));
        if (n0 == dd::O_GA) transpose_item(a.w_in + (size_t)l * dd::D * dd::NIN, dd::D, dd::NIN, ka.WgaT, -dd::O_GA, scr, it, lane);
        else transpose_item(a.w_in + (size_t)l * dd::D * dd::NIN, dd::D, dd::NIN, ka.WinT, n0 < dd::O_GA ? 0 : -32, scr, it, lane); }
      { constexpr int I0 = (dd::HW / 64) * (dd::D / 32), I1 = (dd::GVW / 64) * (dd::D / 32), I2 = (dd::AQW / 64) * (dd::D / 32), I3 = (dd::D / 64) * (dd::D / 32);
        for (int it = gw; it < I0 + I1 + I2 + I3; it += NGW) { int r = it;
          if (r < I0) { transpose_item(a.w_br_hy + (size_t)l * dd::HW * dd::D, dd::HW, dd::D, ka.WhyT, 0, scr, r, lane, 1024); continue; } r -= I0;
          if (r < I1) { transpose_item(a.w_br_gla + (size_t)l * dd::GVW * dd::D, dd::GVW, dd::D, ka.WglaT, 0, scr, r, lane, 1024); continue; } r -= I1;
          if (r < I2) { transpose_item(a.w_br_att + (size_t)l * dd::AQW * dd::D, dd::AQW, dd::D, ka.WattT, 0, scr, r, lane); continue; } r -= I2;
          transpose_item(a.w_out + (size_t)l * dd::D * dd::D, dd::D, dd::D, ka.WoutT, 0, scr, r, lane); } }
      { constexpr int IG = (dd::D / 64) * (dd::DE / 32), IDN = (dd::DE / 64) * (dd::D / 32);
        for (int it = gw; it < dd::NE * (2 * IG + IDN); it += NGW) { const int e = it / (2 * IG + IDN); int r = it % (2 * IG + IDN);
          if (r < 2 * IG) { const int up = r >= IG; if (up) r -= IG; const int n0 = 32 * (r % (dd::DE / 32));
            transpose_item((up ? a.moe_w_up : a.moe_w_gate) + ((size_t)l * dd::NE + e) * dd::D * dd::DE, dd::D, dd::DE, ka.WguT, e * 1024 + 128 * (n0 >> 7) + (up ? 128 : 0), scr, r, lane); }
          else { r -= 2 * IG; transpose_item(a.moe_w_down + ((size_t)l * dd::NE + e) * dd::DE * dd::D, dd::DE, dd::D, ka.WdT, e * 1024, scr, r, lane); } } }
      (void)gt;
    }
    pro::mod_phase(a, l, lds); pro::hid_phase(a, l, dd::S, a.hid2S, lds); if (!last) pro::hid_phase(a, l, dd::C, a.hid2C, lds);
    xcd_barrier(xb);
    pro::tapsB_phase(a, l, (bf16_t*)a.tapsS, lds); if (!last) LSTAGE(L_TAPS_C)
    xcd_barrier(xb);
    pro::nrmB_phase(a, (const bf16_t*)a.tapsS); if (!last) LSTAGE(L_NRM_C)
    xcd_barrier(xb);
    for (int grp = 0; grp < NGRP; ++grp) {
      const int b0 = grp * GB;
      { TID_SETUP
        for (int rg = gw; rg < RG; rg += NGW) { const int bl = rg / RB, r = rg % RB, b = b0 + bl; const float* md = a.mod + (size_t)(r < dd::S ? b : dd::B) * 6 * 1024;
          norm_row(xrow_in(a, l, b, r), a.norm1_g + (size_t)l * 1024, md, md + 1024, hb_s + (size_t)rg * 1024, lane); }
        xcd_barrier(xb); }
      { pg8::Gemm g{hb_s, ka.WinT, RG, NINP, dd::D, 0}; pg8::StaticOrder S; S.init(RG, NINP, (int)gridDim.x, (int)blockIdx.x); EpiProjBf16 E{proj_s};
        pg8::gemm_phase<EpiProjBf16, pg8::StaticOrder, false>((PG8_LAS unsigned char*)(lds + RING_OFF), g, S, E, nullptr);
        { int tq = threadIdx.x; asm volatile("" : "+v"(tq)); const int wv_ = __builtin_amdgcn_readfirstlane(tq >> 6);
          for (int wt = (int)blockIdx.x + (int)gridDim.x * wv_; wt < PANELS * 8; wt += (int)gridDim.x * NWAVES) ga_task(hb_s, ka.WgaT, proj_s, wt); }
        xcd_barrier(xb); }
      { TID_SETUP
        for (int rg = gw; rg < RG; rg += NGW) qknorm_row(proj_s + (size_t)rg * PLD, a.q_norm_g + (size_t)l * 128, a.k_norm_g + (size_t)l * 128, rg % RB, lane);
        for (int u = blockIdx.x; u < GB * 4 * 68; u += gridDim.x) { const int bl = u / (4 * 68), hu = u % (4 * 68); const bf16_t* pb = proj_s + (size_t)bl * RB * PLD;
          gla::In gp; gp.q = pb + dd::O_GQ; gp.k = pb + dd::O_GK; gp.v = pb + dd::O_GV; gp.ga = pb + dd::O_GA; gp.og = pb + dd::O_OG; gp.ld = PLD;
          gp.wa2 = a.gla_wa2 + (size_t)l * 2 * 16 * 256; gp.ba = a.gla_ba + (size_t)l * 2 * 256; gp.gnorm = a.gla_norm_g + (size_t)l * 128;
          gp.csb = (bf16_t*)(mix_s + (size_t)bl * CS_BYTES); gp.dec = (float*)(mix_s + (size_t)GB * CS_BYTES + (size_t)bl * DEC_BYTES); gp.y = (bf16_t*)pb + dd::O_OG; gp.ldy = PLD; gp.S = dd::S; gp.C = dd::C;
          gla::g1b_unit(gp, lds, hu / 68, hu % 68, 4, 68); }
        xcd_barrier(xb); }
      { TID_SETUP
        for (long i_ = gt; i_ < (long)GB * 2 * 4 * 64 * 64; i_ += gs) { const int bl = (int)(i_ / (2 * 4 * 64 * 64)); gla::In gp; gp.csb = (bf16_t*)(mix_s + (size_t)bl * CS_BYTES); gp.dec = (float*)(mix_s + (size_t)GB * CS_BYTES + (size_t)bl * DEC_BYTES); gp.S = dd::S; gp.C = dd::C;
          gla::g2_item(gp, i_ % (2 * 4 * 64 * 64), 4, 68); }
        const int combo = blockIdx.x & 7, slot = blockIdx.x >> 3, nslot = gridDim.x >> 3;
        const int per_combo = 64 + (last ? 0 : 4);
        const bool xcdm = (gridDim.x & 7) == 0;
        for (int uu = xcdm ? slot : (int)blockIdx.x; uu < (xcdm ? per_combo : 8 * per_combo); uu += xcdm ? nslot : (int)gridDim.x) { const int cmb = xcdm ? combo : uu / per_combo, ui = xcdm ? uu : uu % per_combo;
          const bool lat = ui < 64; const int bl = cmb >> 1, kvh = cmb & 1;
          const int head = kvh * 4 + (lat ? ui >> 4 : ui - 64), qb = lat ? ui & 15 : 0;
          bf16_t* pb = proj_s + (size_t)bl * RB * PLD; const size_t qrow = lat ? (size_t)qb * 256 : (size_t)dd::S, krow = lat ? 0 : (size_t)dd::S;
          att::attn_dense_body<att::bf16, PLD, PLD, PLD, true>((const att::bf16*)(pb + qrow * PLD + dd::O_AQ + head * 128), (const att::bf16*)(pb + krow * PLD + dd::O_AK + kvh * 128),
              (const att::bf16*)(pb + krow * PLD + dd::O_AV + kvh * 128), pb + qrow * PLD + dd::O_AQ + head * 128, lat ? RB : dd::C, (char*)lds_raw);
          __syncthreads(); }
        xcd_barrier(xb); }
      { const int n3 = last ? 64 : 68;
        for (int u = blockIdx.x; u < GB * 4 * n3; u += gridDim.x) { const int bl = u / (4 * n3), hu = u % (4 * n3); const bf16_t* pb = proj_s + (size_t)bl * RB * PLD;
          gla::In gp; gp.q = pb + dd::O_GQ; gp.k = pb + dd::O_GK; gp.v = pb + dd::O_GV; gp.ga = pb + dd::O_GA; gp.og = pb + dd::O_OG; gp.ld = PLD;
          gp.wa2 = a.gla_wa2 + (size_t)l * 2 * 16 * 256; gp.ba = a.gla_ba + (size_t)l * 2 * 256; gp.gnorm = a.gla_norm_g + (size_t)l * 128;
          gp.csb = (bf16_t*)(mix_s + (size_t)bl * CS_BYTES); gp.dec = (float*)(mix_s + (size_t)GB * CS_BYTES + (size_t)bl * DEC_BYTES); gp.y = (bf16_t*)pb + dd::O_OG; gp.ldy = PLD; gp.S = dd::S; gp.C = dd::C;
          gla::g3b_unit(gp, lds, hu / n3, hu % n3, 4, 68); }
        xcd_barrier(xb); }
      {
        bf16_t* ucT0 = (bf16_t*)mix_s; bf16_t* yT0 = (bf16_t*)(mix_s + GB * UCT_BYTES); float* ucc0 = (float*)(mix_s + GB * (UCT_BYTES + YT_BYTES)); float* z1c0 = (float*)(mix_s + GB * (UCT_BYTES + YT_BYTES + UCC_BYTES));
        const float* cw = a.hy_conv_w + (size_t)l * 3 * 1536; const float* cb = a.hy_conv_b + (size_t)l * 1536; const float* skp = a.hy_skip + (size_t)l * 2 * 512;
        { TID_SETUP
        { int t_ = blockIdx.x; hy::H0Regs hr = hy::h0_load(proj_s + (size_t)(t_ / (64 * 24)) * RB * PLD + dd::O_HY, PLD, t_ % (64 * 24), tz);
          for (; t_ < GB * 64 * 24; t_ += gridDim.x) { const int bl = t_ / (64 * 24), tn_ = t_ + gridDim.x; hy::H0Regs hn = hr;
            if (tn_ < GB * 64 * 24) hn = hy::h0_load(proj_s + (size_t)(tn_ / (64 * 24)) * RB * PLD + dd::O_HY, PLD, tn_ % (64 * 24), tz);
            hy::h0_compute(hr, cw, cb, ucT0 + (size_t)bl * 1536 * 4096, t_ % (64 * 24), lds, tz); hr = hn; } }
        if (!last) for (long i_ = gt; i_ < (long)GB * 256 * 1536; i_ += gs) { const int bl = (int)(i_ / (256 * 1536)); hy::cconv3_item(proj_s + ((size_t)bl * RB + dd::S) * PLD + dd::O_HY, PLD, cw, cb, ucc0 + (size_t)bl * 256 * 1536, i_ % (256 * 1536)); } }
        xcd_barrier(xb);
        { TID_SETUP
        for (int u = blockIdx.x; u < (GB / 2) * 512; u += gridDim.x) { const int bp_ = u / 512; hy::h1c_unit(ucT0 + (size_t)(2 * bp_) * 1536 * 4096, (const bf16_t*)a.tapsS, a.nrmS, skp, yT0 + (size_t)(2 * bp_) * 512 * 4096, u % 512, lds); }
        if (!last) for (long i_ = gt; i_ < (long)GB * 32 * 512; i_ += gs) { const int bl = (int)(i_ / (32 * 512)); hy::clong_item(ucc0 + (size_t)bl * 256 * 1536, nullptr, z1c0 + (size_t)bl * 256 * 512, nullptr, 0, a.tapsC, a.nrmC, skp, 0, i_ % (32 * 512)); } }
        xcd_barrier(xb);
        { TID_SETUP
        for (int t_ = blockIdx.x; t_ < GB * 64 * 8; t_ += gridDim.x) { const int bl = t_ / (64 * 8); hy::h2_tile(yT0 + (size_t)bl * 512 * 4096, proj_s + (size_t)bl * RB * PLD + dd::O_HY, PLD, t_ % (64 * 8), lds); }
        if (!last) for (long i_ = gt; i_ < (long)GB * 32 * 512; i_ += gs) { const int bl = (int)(i_ / (32 * 512)); hy::clong_item(ucc0 + (size_t)bl * 256 * 1536, z1c0 + (size_t)bl * 256 * 512, nullptr, proj_s + ((size_t)bl * RB + dd::S) * PLD + dd::O_HY, PLD, a.tapsC, a.nrmC, skp, 1, i_ % (32 * 512)); } }
        xcd_barrier(xb); }
      { { pg8::Gemm g{proj_s, ka.WhyT, RG, 1024, 1024, PLD, 1024}; MergeOrder S; S.init((int)gridDim.x, (int)blockIdx.x, last); EpiMergeS E{proj_s + dd::O_BR, (bf16_t*)mix_s};
          pg8::gemm_phase<EpiMergeS, MergeOrder, false>((PG8_LAS unsigned char*)(lds + RING_OFF), g, S, E, nullptr); }
        xcd_barrier(xb);
        pg8::Gemm g{(const bf16_t*)mix_s, ka.WoutT, RG, 1024, 1024, 0}; GroupOrder S; S.init(1024, (int)gridDim.x, (int)blockIdx.x, last);
        EpiOutG E{l == 0 ? a.x : (const float*)a.out, a.out, l == 0 ? a.ctx : (const float*)a.xc, a.xc, a.mod, b0, !last};
        pg8::gemm_phase<EpiOutG, GroupOrder, false>((PG8_LAS unsigned char*)(lds + RING_OFF), g, S, E, nullptr);
        xcd_barrier(xb); }
      {
        { TID_SETUP int* cnt = ka.cnt + (l * NGRP + grp) * 1024;
          LAS float* rwT = (LAS float*)(lds + RING_OFF);
          for (int k = tz; k < 1024; k += NTHREADS) {
#pragma unroll
            for (int e = 0; e < 16; ++e) rwT[e * 1024 + k] = a.router_w[(size_t)k * 16 + e]; }
          __syncthreads();
          LAS int* lcnt = (LAS int*)(lds + RING_OFF + 65536);
          if (tz < 32) lcnt[tz] = 0;
          __syncthreads();
          for (int rg = gw; rg < RG; rg += NGW) { const int bl = rg / RB, r = rg % RB, b = b0 + bl; if (last && r >= dd::S) continue; const float* md = a.mod + (size_t)(r < dd::S ? b : dd::B) * 6 * 1024;
            moe::route_row(xrow_cur(a, b, r), a.norm2_g + (size_t)l * 1024, md + 3 * 1024, md + 4 * 1024, hb_s + (size_t)rg * 1024, rwT, a.router_b, lcnt, ka.route + rg, ka.wts + 2 * rg, lane); }
          __syncthreads();
          if (tz < 16) lcnt[16 + tz] = atomicAdd(cnt + tz * 64, lcnt[tz]);
          __syncthreads();
          for (int rg = gw; rg < RG; rg += NGW) { if (last && (rg % RB) >= dd::S) continue; moe::Route* rt = ka.route + rg; if (lane == 0) { moe::Route r_ = *rt; r_.r0 += lcnt[16 + r_.e0]; r_.r1 += lcnt[16 + r_.e1]; *rt = r_; } }
          xcd_barrier(xb); }
        { TID_SETUP int* cnt = ka.cnt + (l * NGRP + grp) * 1024;
          if (tz == 0) { int acc_ = 0; for (int e = 0; e < 16; ++e) { poff[e] = acc_; acc_ += (cnt[e * 64] + 255) >> 8; } poff[16] = acc_; }
          __syncthreads();
          for (int rg = gw; rg < RG; rg += NGW) { if (last && (rg % RB) >= dd::S) continue; const moe::Route rt = ka.route[rg];
            const v4u h0 = *(const v4u*)(hb_s + (size_t)rg * 1024 + lane * 16), h1 = *(const v4u*)(hb_s + (size_t)rg * 1024 + lane * 16 + 8);
#pragma unroll
            for (int sl = 0; sl < 2; ++sl) { const int e = sl ? rt.e1 : rt.e0, rk = sl ? rt.r1 : rt.r0; const size_t dst = (size_t)poff[e] * 256 + rk;
              *(v4u*)(ka.hp + dst * 1024 + lane * 16) = h0; *(v4u*)(ka.hp + dst * 1024 + lane * 16 + 8) = h1;
              if (lane == 0) { ka.srcrow[dst] = 2 * rg + sl; ka.wgt[dst] = ka.wts[2 * rg + sl]; } } }
          for (int e = 0; e < 16; ++e) { const int c_ = cnt[e * 64], pe = ((c_ + 255) >> 8) << 8; for (int p_ = c_ + (int)gt; p_ < pe; p_ += (int)gs) ka.srcrow[(size_t)poff[e] * 256 + p_] = -1; }
          xcd_barrier(xb); }
        { pg8::Gemm g{ka.hp, ka.WguT, 0, 0, 1024, 0}; moe::MoeOrder S{(int)gridDim.x, (int)blockIdx.x, 4, poff}; moe::EpiGU E{ka.hid};
          pg8::gemm_phase<moe::EpiGU, moe::MoeOrder, false>((PG8_LAS unsigned char*)(lds + RING_OFF), g, S, E, nullptr);
          xcd_barrier(xb); }
        { pg8::Gemm g{ka.hid, ka.WdT, 0, 0, 512, 0}; moe::MoeOrder S{(int)gridDim.x, (int)blockIdx.x, 4, poff}; moe::EpiDown E{ka.srcrow, ka.wgt, ka.contrib, (size_t)RG * 1024};
          pg8::gemm_phase<moe::EpiDown, moe::MoeOrder, false>((PG8_LAS unsigned char*)(lds + RING_OFF), g, S, E, nullptr);
          xcd_barrier(xb); }
        { TID_SETUP
#pragma unroll 4
          for (long i_ = gt; i_ < (long)RG * 256; i_ += gs) { const int rg = (int)(i_ >> 8), c4 = (int)(i_ & 255) * 4; const int bl = rg / RB, r = rg % RB, b = b0 + bl; if (last && r >= dd::S) continue;
            float* xr = xrow_cur(a, b, r) + c4; const float* g2 = a.mod + (size_t)(r < dd::S ? b : dd::B) * 6 * 1024 + 5 * 1024 + c4;
            const unsigned long long u0 = *(const unsigned long long*)(ka.contrib + (size_t)rg * 1024 + c4), u1 = *(const unsigned long long*)(ka.contrib + (size_t)RG * 1024 + (size_t)rg * 1024 + c4);
            pg8::f32x4 xv = *(pg8::f32x4*)xr; const pg8::f32x4 gv = *(const pg8::f32x4*)g2;
#pragma unroll
            for (int e = 0; e < 4; ++e) xv[e] += gv[e] * (bf2f((bf16_t)(u0 >> (16 * e))) + bf2f((bf16_t)(u1 >> (16 * e))));
            *(pg8::f32x4*)xr = xv; }
          xcd_barrier(xb); }
      }
    }
  }
}
extern "C" void kernel_launch(void* const* d_in, const int* in_sizes, int n_in, void* d_out, int out_size, void* d_ws, size_t ws_size, hipStream_t stream) {
  static int grid = 0;
  if (!grid) {
    int dev = 0, cus = 0, per_cu = 0;
    (void)hipGetDevice(&dev); (void)hipDeviceGetAttribute(&cus, hipDeviceAttributeMultiprocessorCount, dev);
    (void)hipFuncSetAttribute((const void*)mega_kernel, hipFuncAttributeMaxDynamicSharedMemorySize, LDS_BYTES);
    (void)hipOccupancyMaxActiveBlocksPerMultiprocessor(&per_cu, mega_kernel, NTHREADS, LDS_BYTES);
    if (per_cu < 1) fprintf(stderr, "occupancy query says %d\n", per_cu);
    grid = cus;
  }
  KArgs ka{}; const float* ptrs[33]; for (int i = 0; i < 33; ++i) ptrs[i] = (const float*)d_in[i];
  set_inputs<TD>(ka.a, ptrs);
  char* wsb = (char*)d_ws; size_t off = BAR_BYTES;
  auto take = [&](size_t bytes) { char* p = wsb + off; off += (bytes + 255) & ~(size_t)255; return p; };
  NaiveBufs& a = ka.a;
  a.mod = (float*)take((size_t)(dd::B + 1) * 6 * 1024 * 4); a.hid2S = (float*)take((size_t)dd::S * 64 * 4); a.hid2C = (float*)take((size_t)dd::C * 64 * 4);
  a.tapsS = (float*)take((size_t)2 * 512 * 2 * 8232 * 2 + 64); a.tapsC = (float*)take((size_t)2 * 512 * 512 * 4); a.nrmS = (float*)take(1024 * 4); a.nrmC = (float*)take(1024 * 4);
  a.xc = (float*)take((size_t)dd::B * dd::C * 1024 * 4);
  ka.WgaT = (bf16_t*)take((size_t)32 * 1024 * 2); ka.WinT = (bf16_t*)take((size_t)NINP * 1024 * 2); ka.WhyT = (bf16_t*)take((size_t)1024 * 1024 * 2); ka.WglaT = (bf16_t*)take((size_t)1024 * 1024 * 2); ka.WattT = (bf16_t*)take((size_t)1024 * 1024 * 2);
  ka.WoutT = (bf16_t*)take((size_t)1024 * 1024 * 2); ka.WguT = (bf16_t*)take((size_t)16 * 1024 * 1024 * 2); ka.WdT = (bf16_t*)take((size_t)16 * 1024 * 512 * 2);
  ka.hb = (bf16_t*)take((size_t)RG * 1024 * 2); ka.mix = (unsigned char*)take(MIX_BYTES);
  ka.proj = (bf16_t*)take((size_t)RG * PLD * 2);
  { char* p = (char*)ka.proj; ka.hp = (bf16_t*)p; p += (size_t)MPG * 1024 * 2; ka.hid = (bf16_t*)p; p += (size_t)MPG * 512 * 2; ka.contrib = (bf16_t*)p; p += (size_t)2 * RG * 1024 * 2;
    ka.srcrow = (int*)p; p += (size_t)MPG * 4; ka.wgt = (float*)p; p += (size_t)MPG * 4; ka.route = (moe::Route*)p; p += (size_t)RG * 16; ka.wts = (float*)p; p += (size_t)RG * 8;
    if ((size_t)(p - (char*)ka.proj) > (size_t)RG * PLD * 2) fprintf(stderr, "MoE alias region too large\n"); }
  a.out = (float*)d_out; ka.bar = (unsigned*)d_ws; ka.cnt = (int*)(wsb + CNT_OFF);
  if (off > ws_size) fprintf(stderr, "workspace too small: need %zu have %zu\n", off, ws_size);
  (void)hipMemsetAsync(d_ws, 0, BAR_BYTES, stream);
  hipLaunchKernelGGL(mega_kernel, dim3(grid), dim3(NTHREADS), LDS_BYTES, stream, ka);
}
```

```cpp
#include <hip/hip_runtime.h>
#include <cstddef>
#include <cstdio>
#include <cstdint>
#include <hip/hip_bf16.h>
#include <hip/hip_runtime.h>
namespace pg8 {
#define PG8_LAS __attribute__((address_space(3)))
typedef unsigned short bf16_t;
typedef short bf16x8 __attribute__((ext_vector_type(8)));
typedef float f32x4 __attribute__((ext_vector_type(4)));
typedef unsigned u32x4 __attribute__((ext_vector_type(4)));
constexpr int BM = 256, BK = 64, HALF = 128, HTB = HALF * BK * 2  , STAGE_BYTES = 8 * HTB, NXCD = 8, WGM = 8;

__host__ __device__ __forceinline__ int lds_byte(int r, int c) { const int st = (r >> 4) * 2 + (c >> 5), rr = r & 15, cc = c & 31, ob = rr * 64 + cc * 2; return st * 1024 + (ob ^ (((ob >> 9) & 1) << 5)); }
__host__ __device__ __forceinline__ void stage_rc(int b, int& R, int& C) { const int st = b / 1024, sb = b % 1024, swz = sb ^ (((sb >> 9) & 1) << 5); R = (st >> 1) * 16 + swz / 64; C = (st & 1) * 32 + (swz % 64) / 2; }
__host__ __device__ __forceinline__ int perm32(int rho) { const int n = rho >> 4, i = rho & 15; return 8 * (i >> 2) + 4 * n + (i & 3); }

struct Unit { int pm, pn, acol, nt; };
struct Gemm { const bf16_t* A; const bf16_t* Bt; int M, N, K; int lda; int ldb; };

struct StaticOrder {
    int nM, nN, nwg, G, c;
    __host__ __device__ void init(int M, int N, int G_, int c_) { nM = M / BM; nN = N / BM; nwg = nM * nN; G = G_; c = c_; }
    __host__ __device__ bool next(int i, Unit& u) const {
        const long L = (long)i * G + c; if (L >= nwg) return false;
        int wgid = (int)L; { const int q = nwg / NXCD, r = nwg % NXCD, xcd = wgid % NXCD, off = wgid / NXCD; wgid = (xcd < r ? xcd * (q + 1) : r * (q + 1) + (xcd - r) * q) + off; }
        const int nig = WGM * nN, gid = wgid / nig, fm = gid * WGM, gsz = (nM - fm) < WGM ? (nM - fm) : WGM;
        u.pm = fm + ((wgid % nig) % gsz); u.pn = (wgid % nig) / gsz; u.acol = 0; u.nt = 0; return true;
    }
    __device__ __forceinline__ void a_ready(const Unit&) const {}
    __device__ __forceinline__ void done(const Unit&) const {}
};
__device__ __forceinline__ unsigned cvt_pk_bf16(float lo, float hi) { unsigned r; asm volatile("v_cvt_pk_bf16_f32 %0, %1, %2" : "=v"(r) : "v"(lo), "v"(hi)); return r; }
typedef float f32x2 __attribute__((ext_vector_type(2)));
template <class Epi, class Sched, bool STAMP = false>
__device__ __forceinline__ void gemm_phase(PG8_LAS unsigned char* lds, const Gemm g, const Sched& S, const Epi& E, unsigned long long* stamps) {
    int tid = threadIdx.x; asm volatile("" : "+v"(tid)); const int wid = __builtin_amdgcn_readfirstlane(tid >> 6), lane = tid & 63, wr = wid >> 2, wc = wid & 3, fr = lane & 15, fq = lane >> 4;
    const int K = g.K, nt = K / BK, LDA = g.lda ? g.lda : g.K, LDB = g.ldb ? g.ldb : g.K;
    int ts_lo = 0, ts_hi = 0, nts = 0; const unsigned long long rt_entry = STAMP ? (unsigned long long)wall_clock64() : 0ull;
#define PG8_STAMP() do { if (STAMP && wid == 0 && nts < 64) { const unsigned long long _c = (unsigned long long)clock64(); \
        ts_lo = (lane == nts) ? (int)(unsigned)_c : ts_lo; ts_hi = (lane == nts) ? (int)(unsigned)(_c >> 32) : ts_hi; ++nts; } } while (0)
    PG8_STAMP();
    unsigned voffA[2], voffB[2];
#pragma unroll
    for (int i = 0; i < 2; ++i) { int R, C; stage_rc(tid * 16 + i * 8192, R, C); const int Rb = Epi::PERM ? ((R & ~31) + perm32(R & 31)) : R;
        voffA[i] = (unsigned)(R * LDA + C) * 2u; voffB[i] = (unsigned)(Rb * LDB + C) * 2u; }
    const size_t kstep = (size_t)(BK * 2);
    const size_t hstep = (size_t)HALF * LDB * 2;
    const size_t tstep = 2 * hstep;
    const size_t hstepA = (size_t)HALF * LDA * 2, tstepA = 2 * hstepA;
    const unsigned ldsw = (unsigned)wid * 1024u;
    const int aoff = lds_byte(wr * 64 + fr, fq * 8), boff = lds_byte(wc * 32 + fr, fq * 8);
#define PG8_SA(b, h) (((b) * 2 + (h)) * HTB)
#define PG8_SB(b, h) ((4 + (b) * 2 + (h)) * HTB)
#define PG8_STAGE(bufoff, gbase, voff) do { _Pragma("unroll") for (int _i = 0; _i < 2; ++_i) \
        __builtin_amdgcn_global_load_lds((const unsigned*)((const char*)(gbase) + (voff)[_i]), (PG8_LAS unsigned*)(lds + (bufoff) + ldsw + _i * 8192), 16, 0, 0); } while (0)
#define PG8_LDA(dst, b, h) do { _Pragma("unroll") for (int m = 0; m < 4; ++m) _Pragma("unroll") for (int k = 0; k < 2; ++k) dst[m][k] = *(const PG8_LAS bf16x8*)(lds + PG8_SA(b, h) + aoff + m * 2048 + k * 1024); } while (0)
#define PG8_LDB(dst, b, h) do { _Pragma("unroll") for (int n = 0; n < 2; ++n) _Pragma("unroll") for (int k = 0; k < 2; ++k) dst[n][k] = *(const PG8_LAS bf16x8*)(lds + PG8_SB(b, h) + boff + n * 2048 + k * 1024); } while (0)
#define PG8_MMA(ai, bj, At, Bt) do { __builtin_amdgcn_s_setprio(1); _Pragma("unroll") for (int m = 0; m < 4; ++m) _Pragma("unroll") for (int n = 0; n < 2; ++n) _Pragma("unroll") for (int k = 0; k < 2; ++k) \
        acc[ai][bj][m][n] = __builtin_amdgcn_mfma_f32_16x16x32_bf16(Bt[n][k], At[m][k], acc[ai][bj][m][n], 0, 0, 0); __builtin_amdgcn_s_setprio(0); } while (0)
#define PG8_WAIT_V(n) asm volatile("s_waitcnt vmcnt(" #n ")" ::: "memory")
#define PG8_WAIT_L(n) asm volatile("s_waitcnt lgkmcnt(" #n ")" ::: "memory")
#define PG8_BAR __builtin_amdgcn_s_barrier()
#define PG8_SCHED __builtin_amdgcn_sched_barrier(0)
    Unit cur, nxt; int ui = 0;
    if (!S.next(0, cur)) return;
    f32x4 acc[2][2][4][2];
#pragma unroll
    for (int a = 0; a < 2; ++a)
#pragma unroll
        for (int b = 0; b < 2; ++b)
#pragma unroll
            for (int m = 0; m < 4; ++m)
#pragma unroll
                for (int n = 0; n < 2; ++n) acc[a][b][m][n] = (f32x4){0.f, 0.f, 0.f, 0.f};
    bf16x8 At[4][2], B0[2][2], B1[2][2];
    const char* cA = (const char*)g.A + (size_t)cur.pm * tstepA + (size_t)cur.acol * 2; const char* cB = (const char*)g.Bt + (size_t)cur.pn * tstep;
    S.a_ready(cur);
    PG8_STAGE(PG8_SB(0, 0), cB, voffB); PG8_STAGE(PG8_SA(0, 0), cA, voffA); PG8_STAGE(PG8_SB(0, 1), cB + hstep, voffB); PG8_STAGE(PG8_SA(0, 1), cA + hstepA, voffA);
    if (wr == 1) PG8_BAR;
    PG8_WAIT_V(4); PG8_BAR;
    PG8_STAGE(PG8_SB(1, 0), cB + kstep, voffB); PG8_STAGE(PG8_SA(1, 0), cA + kstep, voffA); PG8_STAGE(PG8_SB(1, 1), cB + hstep + kstep, voffB);
    PG8_WAIT_V(6); PG8_BAR;
    PG8_STAMP();
    for (;;) {
        const bool has_next = S.next(ui + 1, nxt);
        const char* nA = has_next ? (const char*)g.A + (size_t)nxt.pm * tstepA + (size_t)nxt.acol * 2 : cA; const char* nB = has_next ? (const char*)g.Bt + (size_t)nxt.pn * tstep : cB;
        const int ntu = cur.nt ? cur.nt : nt;
        for (int t = 0; t < ntu; t += 2) {
            const bool last = (t == ntu - 2);
            const char* a1 = cA + (size_t)(t + 1) * kstep;
            const char* a2 = last ? nA : cA + (size_t)(t + 2) * kstep; const char* b2 = last ? nB : cB + (size_t)(t + 2) * kstep;
            const char* a3 = a2 + kstep; const char* b3 = b2 + kstep;
            if (last && has_next) S.a_ready(nxt);
            PG8_LDB(B0, 0, 0); PG8_SCHED; PG8_LDA(At, 0, 0); PG8_STAGE(PG8_SA(1, 1), a1 + hstepA, voffA);
            PG8_WAIT_L(8); PG8_BAR; PG8_WAIT_L(0); PG8_MMA(0, 0, At, B0); PG8_BAR; PG8_SCHED;
            PG8_LDB(B1, 0, 1); PG8_STAGE(PG8_SB(0, 0), b2, voffB);
            PG8_BAR; PG8_WAIT_L(0); PG8_MMA(0, 1, At, B1); PG8_BAR;
            PG8_LDA(At, 0, 1); PG8_STAGE(PG8_SA(0, 0), a2, voffA);
            PG8_BAR; PG8_WAIT_L(0); PG8_MMA(1, 0, At, B0); PG8_BAR; PG8_SCHED;
            PG8_STAGE(PG8_SB(0, 1), b2 + hstep, voffB);
            PG8_WAIT_V(6); PG8_BAR; PG8_MMA(1, 1, At, B1); PG8_BAR;
            PG8_LDB(B0, 1, 0); PG8_SCHED; PG8_LDA(At, 1, 0); PG8_STAGE(PG8_SA(0, 1), a2 + hstepA, voffA);
            PG8_WAIT_L(8); PG8_BAR; PG8_WAIT_L(0); PG8_MMA(0, 0, At, B0); PG8_BAR; PG8_SCHED;
            PG8_LDB(B1, 1, 1); PG8_STAGE(PG8_SB(1, 0), b3, voffB);
            PG8_BAR; PG8_WAIT_L(0); PG8_MMA(0, 1, At, B1); PG8_BAR;
            PG8_LDA(At, 1, 1); PG8_STAGE(PG8_SA(1, 0), a3, voffA);
            PG8_BAR; PG8_WAIT_L(0); PG8_MMA(1, 0, At, B0); PG8_BAR; PG8_SCHED;
            PG8_STAGE(PG8_SB(1, 1), b3 + hstep, voffB);
            PG8_WAIT_V(6); PG8_BAR; PG8_MMA(1, 1, At, B1); PG8_BAR;
        }
        PG8_STAMP();
        if constexpr (!Epi::AFTER_DRAIN) { E(acc, cur, wr, wc, fr, fq); S.done(cur); }
        PG8_STAMP();
        if (!has_next) break;
#pragma unroll
        for (int a = 0; a < 2; ++a)
#pragma unroll
            for (int b = 0; b < 2; ++b)
#pragma unroll
                for (int m = 0; m < 4; ++m)
#pragma unroll
                    for (int n = 0; n < 2; ++n) acc[a][b][m][n] = (f32x4){0.f, 0.f, 0.f, 0.f};
        cur = nxt; cA = nA; cB = nB; ++ui;
    }
    PG8_WAIT_V(0);
    if (wr == 0) PG8_BAR;
    PG8_BAR;
    if constexpr (Epi::AFTER_DRAIN) { E.fused(acc, cur, wr, wc, fr, fq, lds, wid, lane); S.done(cur); }
    PG8_STAMP();
    if (STAMP && wid == 0) { stamps[lane] = lane < nts ? (((unsigned long long)(unsigned)ts_hi << 32) | (unsigned)ts_lo) : 0ull;
        if (lane == 62) stamps[62] = rt_entry; if (lane == 63) stamps[63] = (unsigned long long)wall_clock64(); }
#undef PG8_STAMP
#undef PG8_SA
#undef PG8_SB
#undef PG8_STAGE
#undef PG8_LDA
#undef PG8_LDB
#undef PG8_MMA
#undef PG8_WAIT_V
#undef PG8_WAIT_L
#undef PG8_BAR
#undef PG8_SCHED
}
}

#define LAS __attribute__((address_space(3)))
typedef unsigned short bf16_t;
constexpr int NWAVES = 8, NTHREADS = 512;
constexpr int LDS_BYTES = 147456;
constexpr int RING_OFF = 0;
constexpr int MISC_OFF = 131072;
constexpr int NINP = 7680;

__device__ __forceinline__ unsigned f2bf(float f) { unsigned u = __builtin_bit_cast(unsigned, f); return (u + 0x7fffu + ((u >> 16) & 1u)) >> 16; }
__device__ __forceinline__ unsigned pk2(float lo, float hi) { return f2bf(lo) | (f2bf(hi) << 16); }
__device__ __forceinline__ float bf2f(bf16_t b) { return __builtin_bit_cast(float, ((unsigned)b) << 16); }
typedef unsigned v4u __attribute__((ext_vector_type(4)));

__device__ __forceinline__ void transpose_item(const float* W, int K, int N, bf16_t* WT, int row_off, LAS float* scr, int item, int lane, int ldo = 0) {
  if (ldo == 0) ldo = K;
  const int nblk = N / 32, kb = item / nblk, nb = item % nblk, k0 = 64 * kb, n0 = 32 * nb;
  float wreg[32];
#pragma unroll
  for (int i = 0; i < 32; ++i) { const int kk = 2 * i + (lane >> 5); wreg[i] = W[(size_t)(k0 + kk) * N + n0 + (lane & 31)]; }
#pragma unroll
  for (int i = 0; i < 32; ++i) { const int kk = 2 * i + (lane >> 5); scr[kk * 33 + (lane & 31)] = wreg[i]; }
  asm volatile("s_waitcnt lgkmcnt(0)" ::: "memory");
  const int c = lane & 7;
#pragma unroll
  for (int j = 0; j < 4; ++j) { const int n = (lane >> 3) + 8 * j; const LAS float* s = scr + (8 * c) * 33 + n;
    v4u o; o.x = pk2(s[0 * 33], s[1 * 33]); o.y = pk2(s[2 * 33], s[3 * 33]); o.z = pk2(s[4 * 33], s[5 * 33]); o.w = pk2(s[6 * 33], s[7 * 33]);
    *(v4u*)(WT + (size_t)(row_off + n0 + n) * ldo + k0 + 8 * c) = o; }
  asm volatile("s_waitcnt lgkmcnt(0)" ::: "memory");
}

struct EpiProjF32 {
  static constexpr bool PERM = false, AFTER_DRAIN = false;
  float* C; int ldc; int ncols;
  __device__ __forceinline__ void operator()(const pg8::f32x4 (&acc)[2][2][4][2], const pg8::Unit& u, int wr, int wc, int fr, int fq) const {
    const int row0 = u.pm * 256 + wr * 64 + fr, col0 = u.pn * 256 + wc * 32 + 4 * fq;
#pragma unroll
    for (int ai = 0; ai < 2; ++ai)
#pragma unroll
      for (int m = 0; m < 4; ++m) { float* rowp = C + (size_t)(row0 + ai * 128 + m * 16) * ldc + col0;
#pragma unroll
        for (int bj = 0; bj < 2; ++bj)
#pragma unroll
          for (int n = 0; n < 2; ++n) if (col0 + bj * 128 + n * 16 < ncols) *(pg8::f32x4*)(rowp + bj * 128 + n * 16) = acc[ai][bj][m][n]; }
  }
};

__device__ __forceinline__ float fsigmoid(float x) { return 1.f / (1.f + __expf(-x)); }
template <bool ACCUM> struct EpiMerge {
  static constexpr bool PERM = true, AFTER_DRAIN = false;
  const float* gate; int ldg; bf16_t* M; int ldm;
  __device__ __forceinline__ void operator()(const pg8::f32x4 (&acc)[2][2][4][2], const pg8::Unit& u, int wr, int wc, int fr, int fq) const {
    const int row0 = u.pm * 256 + wr * 64 + fr, col0 = u.pn * 256 + wc * 32 + 8 * fq;
#pragma unroll
    for (int ai = 0; ai < 2; ++ai)
#pragma unroll
      for (int m = 0; m < 4; ++m) { const size_t r = (size_t)(row0 + ai * 128 + m * 16);
#pragma unroll
        for (int bj = 0; bj < 2; ++bj) { const int c = col0 + bj * 128;
          const pg8::f32x4 g0 = *(const pg8::f32x4*)(gate + r * ldg + c), g1 = *(const pg8::f32x4*)(gate + r * ldg + c + 4);
          pg8::f32x4 v0 = acc[ai][bj][m][0], v1 = acc[ai][bj][m][1];
#pragma unroll
          for (int e = 0; e < 4; ++e) { v0[e] *= fsigmoid(g0[e]); v1[e] *= fsigmoid(g1[e]); }
          v4u* dst = (v4u*)(M + r * ldm + c);
          if (ACCUM) { const v4u o = *dst; v0[0] += bf2f(o.x & 0xffff); v0[1] += bf2f(o.x >> 16); v0[2] += bf2f(o.y & 0xffff); v0[3] += bf2f(o.y >> 16);
            v1[0] += bf2f(o.z & 0xffff); v1[1] += bf2f(o.z >> 16); v1[2] += bf2f(o.w & 0xffff); v1[3] += bf2f(o.w >> 16); }
          v4u o2; o2.x = pk2(v0[0], v0[1]); o2.y = pk2(v0[2], v0[3]); o2.z = pk2(v1[0], v1[1]); o2.w = pk2(v1[2], v1[3]); *dst = o2; } }
  }
};
struct EpiOut {
  static constexpr bool PERM = false, AFTER_DRAIN = false;
  const float* resL; float* outL; const float* gL;
  const float* resC; float* outC; const float* gC;
  __device__ __forceinline__ void operator()(const pg8::f32x4 (&acc)[2][2][4][2], const pg8::Unit& u, int wr, int wc, int fr, int fq) const {
    const bool isc = u.pm == 16; if (isc && outC == nullptr) return;
    const float* res = isc ? resC : resL; float* out = isc ? outC : outL; const float* gv = isc ? gC : gL;
    const int row0 = (isc ? 0 : u.pm * 256) + wr * 64 + fr, col0 = u.pn * 256 + wc * 32 + 4 * fq;
    pg8::f32x4 gg[2][2];
#pragma unroll
    for (int bj = 0; bj < 2; ++bj)
#pragma unroll
      for (int n = 0; n < 2; ++n) gg[bj][n] = *(const pg8::f32x4*)(gv + col0 + bj * 128 + n * 16);
#pragma unroll
    for (int ai = 0; ai < 2; ++ai)
#pragma unroll
      for (int m = 0; m < 4; ++m) { const size_t ro = (size_t)(row0 + ai * 128 + m * 16) * 1024 + col0;
#pragma unroll
        for (int bj = 0; bj < 2; ++bj)
#pragma unroll
          for (int n = 0; n < 2; ++n) { const pg8::f32x4 rv = *(const pg8::f32x4*)(res + ro + bj * 128 + n * 16); *(pg8::f32x4*)(out + ro + bj * 128 + n * 16) = rv + gg[bj][n] * acc[ai][bj][m][n]; } }
  }
};
namespace att {
using bf16 = __hip_bfloat16;
constexpr int D = 128, NW = 8, QBLK = 32, KVBLK = 64; constexpr float SCALE = 0.088388347648318440f; constexpr float THR = 8.f; constexpr int SDEPTH = 2;
constexpr size_t SHM_V = KVBLK * D * 2, SHM_K = KVBLK * D * 2, SHM_ATTN = 2 * SHM_V + 2 * SHM_K + NW * 64 * 4;
using bf16x8 = __attribute__((ext_vector_type(8))) short;
using s16x4  = __attribute__((ext_vector_type(4))) short;
using f32x16 = __attribute__((ext_vector_type(16))) float;
using f32x8  = __attribute__((ext_vector_type(8))) float;
using u32x4  = __attribute__((ext_vector_type(4))) unsigned;
#define KSWZ(row, colB) ((row) * 256 + ((colB) ^ (((row) & 7) << 4)))
#define SBAR() __builtin_amdgcn_sched_barrier(0)
__device__ __forceinline__ int crow(int r, int hi) { return (r & 3) + 8 * (r >> 2) + 4 * hi; }
__device__ __forceinline__ unsigned cvtpk(float lo, float hi) {
  unsigned r; asm volatile("v_cvt_pk_bf16_f32 %0, %1, %2" : "=v"(r) : "v"(lo), "v"(hi)); return r;
}
template <typename TIn> struct Stage;
template <> struct Stage<bf16>  { using T = bf16x8;
  __device__ static __forceinline__ T ld8(const bf16* p) { return *reinterpret_cast<const bf16x8*>(p); }
  __device__ static __forceinline__ bf16x8 tobf(T x) { return x; } };
template <> struct Stage<float> { using T = f32x8;
  __device__ static __forceinline__ T ld8(const float* p) { return *reinterpret_cast<const f32x8*>(p); }
  __device__ static __forceinline__ bf16x8 tobf(T x) {
    u32x4 w = {cvtpk(x[0], x[1]), cvtpk(x[2], x[3]), cvtpk(x[4], x[5]), cvtpk(x[6], x[7])}; return *reinterpret_cast<bf16x8*>(&w); } };

__device__ __forceinline__ void partialSM(f32x16& p0, f32x16& p1, float& m_reg, float& mn, float& alpha) {
  constexpr float C = SCALE * 1.4426950408889634f;
  float pmax = p0[0]; for (int r = 1; r < 16; ++r) pmax = fmaxf(pmax, p0[r]); for (int r = 0; r < 16; ++r) pmax = fmaxf(pmax, p1[r]);
  { auto rr = __builtin_amdgcn_permlane32_swap(__float_as_uint(pmax), __float_as_uint(pmax), false, false);
    pmax = fmaxf(__uint_as_float(rr[0]), __uint_as_float(rr[1])); }
  if (__builtin_expect(__all(pmax - m_reg <= THR / SCALE), 1)) { mn = m_reg; alpha = 1.f; }
  else { mn = fmaxf(m_reg, pmax); alpha = __builtin_amdgcn_exp2f((m_reg - mn) * C); m_reg = mn; }
  float mnC = -mn * C;
  for (int r = 0; r < 16; ++r) p0[r] = fmaf(p0[r], C, mnC); for (int r = 0; r < 16; ++r) p1[r] = fmaf(p1[r], C, mnC);
  for (int r = 0; r < 16; ++r) p0[r] = __builtin_amdgcn_exp2f(p0[r]);
}
__device__ __forceinline__ void finishSM(f32x16& p0, f32x16& p1, float alpha, float& l_reg, bf16x8& pa0, bf16x8& pa1, bf16x8& pa2, bf16x8& pa3) {
  for (int r = 0; r < 16; ++r) p1[r] = __builtin_amdgcn_exp2f(p1[r]);
  float ps = 0; for (int r = 0; r < 16; ++r) ps += p0[r]; for (int r = 0; r < 16; ++r) ps += p1[r];
  { auto rr = __builtin_amdgcn_permlane32_swap(__float_as_uint(ps), __float_as_uint(ps), false, false);
    ps = __uint_as_float(rr[0]) + __uint_as_float(rr[1]); }
  l_reg = l_reg * alpha + ps;
#define PK4(P, BASE, OUT) do { unsigned a0 = cvtpk(P[BASE + 0], P[BASE + 1]), a1 = cvtpk(P[BASE + 2], P[BASE + 3]);   \
    unsigned b0 = cvtpk(P[BASE + 4], P[BASE + 5]), b1 = cvtpk(P[BASE + 6], P[BASE + 7]);                              \
    auto r0 = __builtin_amdgcn_permlane32_swap(a0, b0, false, false); auto r1 = __builtin_amdgcn_permlane32_swap(a1, b1, false, false); \
    u32x4 w = {r0[0], r1[0], r0[1], r1[1]}; OUT = *reinterpret_cast<bf16x8*>(&w); } while (0)
  PK4(p0, 0, pa0); PK4(p0, 8, pa1); PK4(p1, 0, pa2); PK4(p1, 8, pa3);
#undef PK4
}
__device__ __forceinline__ void qkt(f32x16& p0, f32x16& p1, const bf16* Ks, const bf16x8* qr, int r32, int hi) {
  p0 = f32x16{}; p1 = f32x16{};
  for (int d0 = 0; d0 < 8; ++d0) { int cb = (d0 * 16 + hi * 8) * 2;
    bf16x8 b0 = *reinterpret_cast<const bf16x8*>((const char*)Ks + KSWZ(r32, cb));
    bf16x8 b1 = *reinterpret_cast<const bf16x8*>((const char*)Ks + KSWZ(32 + r32, cb));
    p0 = __builtin_amdgcn_mfma_f32_32x32x16_bf16(b0, qr[d0], p0, 0, 0, 0);
    p1 = __builtin_amdgcn_mfma_f32_32x32x16_bf16(b1, qr[d0], p1, 0, 0, 0); }
}
__device__ __forceinline__ int v_st(int k, int c) { const int kk = (k & ~0xC) | ((k & 4) << 1) | ((k & 8) >> 1); return ((kk >> 3) * 4 + (c >> 5)) * 512 + ((kk & 7) * 32 + (c & 31)) * 2; }
__device__ __forceinline__ int v_rd_base(int lane) { return ((lane & 3) << 3) | (((lane >> 2) & 3) << 6) | (((lane >> 4) & 1) << 5) | (((lane >> 5) & 1) << 8); }
constexpr int v_rd_off(int d0, int ks, int half) { return d0 * 512 + ks * 4096 + half * 2048; }
template <int OFF> __device__ __forceinline__ s16x4 tr_read(int vb) {
  s16x4 r; asm volatile("ds_read_b64_tr_b16 %0, %1 offset:%2" : "=&v"(r) : "v"(vb), "i"(OFF) : "memory"); return r;
}
template <int D0> __device__ __forceinline__ void pv_one(f32x16& od, int vb, bf16x8 pa0, bf16x8 pa1, bf16x8 pa2, bf16x8 pa3) {
  const s16x4 l0 = tr_read<v_rd_off(D0, 0, 0)>(vb), h0 = tr_read<v_rd_off(D0, 0, 1)>(vb), l1 = tr_read<v_rd_off(D0, 1, 0)>(vb), h1 = tr_read<v_rd_off(D0, 1, 1)>(vb);
  const s16x4 l2 = tr_read<v_rd_off(D0, 2, 0)>(vb), h2 = tr_read<v_rd_off(D0, 2, 1)>(vb), l3 = tr_read<v_rd_off(D0, 3, 0)>(vb), h3 = tr_read<v_rd_off(D0, 3, 1)>(vb);
  asm volatile("s_waitcnt lgkmcnt(0)" ::: "memory"); SBAR();
#define PK(L, H) (bf16x8){L[0], L[1], L[2], L[3], H[0], H[1], H[2], H[3]}
  od = __builtin_amdgcn_mfma_f32_32x32x16_bf16(pa0, PK(l0, h0), od, 0, 0, 0);
  od = __builtin_amdgcn_mfma_f32_32x32x16_bf16(pa1, PK(l1, h1), od, 0, 0, 0);
  od = __builtin_amdgcn_mfma_f32_32x32x16_bf16(pa2, PK(l2, h2), od, 0, 0, 0);
  od = __builtin_amdgcn_mfma_f32_32x32x16_bf16(pa3, PK(l3, h3), od, 0, 0, 0);
#undef PK
}
__device__ __forceinline__ void pv_d0(f32x16* o, int vb, bf16x8 pa0, bf16x8 pa1, bf16x8 pa2, bf16x8 pa3) {
  pv_one<0>(o[0], vb, pa0, pa1, pa2, pa3); pv_one<1>(o[1], vb, pa0, pa1, pa2, pa3); pv_one<2>(o[2], vb, pa0, pa1, pa2, pa3); pv_one<3>(o[3], vb, pa0, pa1, pa2, pa3);
}

template <typename TQ, int LDQ, int LDK, int LDO, bool OBF16>
__device__ __forceinline__ void attn_dense_body(const TQ* Qb, const bf16* Kh, const bf16* Vh,
                                                void* Obv, int seq, char* lds) {
  using St = Stage<bf16>; using SQ = Stage<TQ>;
  int tid = threadIdx.x; asm volatile("" : "+v"(tid)); const int wid = tid >> 6, lane = tid & 63, r32 = lane & 31, hi = lane >> 5;
  bf16* V_lds = (bf16*)lds; bf16* K_lds = (bf16*)(lds + 2 * SHM_V);
  float* ws = (float*)(lds + 2 * SHM_V + 2 * SHM_K) + wid * 64; float* li_l = ws; float* al_l = ws + 32;
  float m_reg = -1e30f, l_reg = 0; f32x16 o[4] = {}; bf16x8 qr[8];
  const TQ* Qw = Qb + (long)(wid * QBLK + r32) * LDQ + hi * 8;
#pragma unroll
  for (int d0 = 0; d0 < 8; ++d0) qr[d0] = SQ::tobf(SQ::ld8(Qw + d0 * 16));
  const int sr = tid >> 4, sc = (tid & 15) * 8, vst0 = v_st(sr, sc), vst1 = v_st(32 + sr, sc);
  const int vb0 = (int)(uintptr_t)V_lds + v_rd_base(lane);
  struct { typename St::T vs0, vs1, ks0, ks1; } sr_[SDEPTH];
#define SLOAD(i, k0) do { sr_[i].vs0 = St::ld8(&Vh[(long)((k0) + sr) * LDK + sc]); sr_[i].vs1 = St::ld8(&Vh[(long)((k0) + 32 + sr) * LDK + sc]); \
    sr_[i].ks0 = St::ld8(&Kh[(long)((k0) + sr) * LDK + sc]); sr_[i].ks1 = St::ld8(&Kh[(long)((k0) + 32 + sr) * LDK + sc]); } while (0)
#define SWRITE(b, i) do { *(bf16x8*)((char*)V_lds + (b) * SHM_V + vst0) = St::tobf(sr_[i].vs0);          \
    *(bf16x8*)((char*)V_lds + (b) * SHM_V + vst1) = St::tobf(sr_[i].vs1); int kc = sc * 2;               \
    *(bf16x8*)((char*)K_lds + (b) * SHM_K + KSWZ(sr, kc)) = St::tobf(sr_[i].ks0);                       \
    *(bf16x8*)((char*)K_lds + (b) * SHM_K + KSWZ(32 + sr, kc)) = St::tobf(sr_[i].ks1); } while (0)
#define SWAIT() do { if constexpr (SDEPTH == 2) asm volatile("s_waitcnt vmcnt(4)" ::: "memory"); else asm volatile("s_waitcnt vmcnt(0)" ::: "memory"); } while (0)
#define RESC(a) do { if (__any((a) < 1.f)) { if (hi == 0) al_l[r32] = (a); asm volatile("s_waitcnt lgkmcnt(0)" ::: "memory"); \
    for (int d = 0; d < 4; ++d) for (int r = 0; r < 16; ++r) o[d][r] *= al_l[crow(r, hi)]; } } while (0)
  f32x16 pA0, pA1, pB0, pB1; float mnA, mnB, alA, alB; bf16x8 pa0, pa1, pa2, pa3; const int NT = seq / KVBLK;
  constexpr int SE = 0, SO = SDEPTH - 1;
  SLOAD(SE, 0); asm volatile("s_waitcnt vmcnt(0)" ::: "memory"); SWRITE(0, SE); __syncthreads();
  qkt(pA0, pA1, K_lds, qr, r32, hi); partialSM(pA0, pA1, m_reg, mnA, alA);
  SLOAD(SO, KVBLK); if constexpr (SDEPTH == 2) { if (2 < NT) SLOAD(SE, 2 * KVBLK); }
  SWAIT(); SWRITE(1, SO); __syncthreads();
  for (int j = 1; j + 1 < NT; j += 2) {
    SBAR(); qkt(pB0, pB1, (bf16*)((char*)K_lds + SHM_K), qr, r32, hi);
    finishSM(pA0, pA1, alA, l_reg, pa0, pa1, pa2, pa3); SBAR();
    SLOAD(SO, (j + SDEPTH) * KVBLK); SBAR();
    pv_d0(o, vb0, pa0, pa1, pa2, pa3); partialSM(pB0, pB1, m_reg, mnB, alB);
    __syncthreads(); SWAIT(); SWRITE(0, SE);
    RESC(alB); __syncthreads();
    SBAR(); qkt(pA0, pA1, K_lds, qr, r32, hi);
    finishSM(pB0, pB1, alB, l_reg, pa0, pa1, pa2, pa3); SBAR();
    if (SDEPTH == 1 || j + 3 < NT) SLOAD(SE, (j + 1 + SDEPTH) * KVBLK); SBAR();
    pv_d0(o, vb0 + (int)SHM_V, pa0, pa1, pa2, pa3); partialSM(pA0, pA1, m_reg, mnA, alA);
    __syncthreads(); SWAIT(); SWRITE(1, SO);
    RESC(alA); __syncthreads();
  }
  SBAR(); qkt(pB0, pB1, (bf16*)((char*)K_lds + SHM_K), qr, r32, hi);
  finishSM(pA0, pA1, alA, l_reg, pa0, pa1, pa2, pa3); SBAR();
  pv_d0(o, vb0, pa0, pa1, pa2, pa3); partialSM(pB0, pB1, m_reg, mnB, alB);
  __syncthreads(); RESC(alB);
  finishSM(pB0, pB1, alB, l_reg, pa0, pa1, pa2, pa3); SBAR();
  pv_d0(o, vb0 + (int)SHM_V, pa0, pa1, pa2, pa3);
  if (hi == 0) li_l[r32] = l_reg; asm volatile("s_waitcnt lgkmcnt(0)" ::: "memory");
  float rli[16];
#pragma unroll
  for (int r = 0; r < 16; ++r) rli[r] = __builtin_amdgcn_rcpf(li_l[crow(r, hi)]);
  if constexpr (!OBF16) { float* Ow = (float*)Obv + (long)(wid * QBLK) * LDO;
#pragma unroll
  for (int r = 0; r < 16; ++r) { int orow = crow(r, hi);
    for (int d0 = 0; d0 < 4; ++d0) Ow[(long)orow * LDO + d0 * 32 + r32] = o[d0][r] * rli[r]; }
  } else { unsigned short* Ow = (unsigned short*)Obv + (long)(wid * QBLK) * LDO;
#pragma unroll
  for (int r = 0; r < 16; ++r) { int orow = crow(r, hi);
    for (int d0 = 0; d0 < 4; ++d0) { const unsigned pk = cvtpk(o[d0][r] * rli[r], 0.f); Ow[(long)orow * LDO + d0 * 32 + r32] = (unsigned short)(pk & 0xffffu); } }
  }
#undef SLOAD
#undef SWRITE
#undef SWAIT
#undef RESC
}
#undef KSWZ
#undef SBAR
}
namespace gla {
typedef float f32x16 __attribute__((ext_vector_type(16)));
typedef float f32x4v __attribute__((ext_vector_type(4)));
constexpr int LD = 65;
constexpr int OX = 0, OY = 2 * 64 * LD * 4, OV = 4 * 64 * LD * 4, OAL = OV + 64 * 128 * 4, OW2 = OAL + 64 * 32 * 4, OBA = OW2 + 2 * 16 * 64 * 4, OTOT = OBA + 2 * 64 * 4, OEND = OTOT + 2 * 64 * 4 * 4;
static_assert(OEND <= 131072, "gla lds");
static_assert(64 * 129 * 4 <= 2 * 64 * LD * 4, "O stage fits in X");

struct In {
  const bf16_t* q; const bf16_t* k; const bf16_t* v; const bf16_t* ga; const bf16_t* og; int ld;
  const float* wa2; const float* ba; const float* gnorm;
  float* cs;
  bf16_t* csb;
  float* dec;
  bf16_t* y; int ldy;
  int S, C;
};
__device__ __forceinline__ long chunk_row(const In& p, int cid) { return cid < p.S / 64 ? (long)cid * 64 : (long)p.S + (long)(cid - p.S / 64) * 64; }
__device__ __forceinline__ float logsig(float x) { return x < 0.f ? x - __logf(1.f + __expf(x)) : -__logf(1.f + __expf(-x)); }

__device__ __forceinline__ void cum_phase(const In& p, LAS unsigned char* lds, int head, long row0, int tid) {
  LAS float* AL = (LAS float*)(lds + OAL); LAS float* W2 = (LAS float*)(lds + OW2); LAS float* BA = (LAS float*)(lds + OBA); LAS float* TOT = (LAS float*)(lds + OTOT);
  { const int t = tid >> 3, r4 = (tid & 7) * 4; const unsigned long long u = *(const unsigned long long*)(p.ga + (row0 + t) * p.ld + r4);
    f32x4v a4; a4[0] = bf2f((bf16_t)u); a4[1] = bf2f((bf16_t)(u >> 16)); a4[2] = bf2f((bf16_t)(u >> 32)); a4[3] = bf2f((bf16_t)(u >> 48)); *(LAS f32x4v*)(AL + t * 32 + r4) = a4; }
  { const int e = tid * 4, dir = e >> 10, r = (e >> 6) & 15, j = e & 63; *(LAS f32x4v*)(W2 + e) = *(const f32x4v*)(p.wa2 + ((long)dir * 16 + r) * 256 + head * 64 + j); }
  if (tid < 128) BA[tid] = p.ba[(tid >> 6) * 256 + head * 64 + (tid & 63)];
  __syncthreads();
  const int dir = tid >> 8, j = tid & 63, seg = (tid >> 6) & 3;
  float w[16];
#pragma unroll
  for (int r = 0; r < 16; ++r) w[r] = W2[(dir * 16 + r) * 64 + j];
  const float bj = BA[dir * 64 + j];
  float c[16];
#pragma unroll
  for (int k = 0; k < 16; ++k) { const int t = seg * 16 + k; float z = bj;
#pragma unroll
    for (int r4 = 0; r4 < 4; ++r4) { const f32x4v a4 = *(const LAS f32x4v*)(AL + t * 32 + dir * 16 + 4 * r4); z += a4[0] * w[4 * r4] + a4[1] * w[4 * r4 + 1] + a4[2] * w[4 * r4 + 2] + a4[3] * w[4 * r4 + 3]; }
    c[k] = logsig(z) * (1.f / 16.f); }
  if (dir == 0) {
#pragma unroll
    for (int k = 1; k < 16; ++k) c[k] += c[k - 1];
    TOT[(dir * 64 + j) * 4 + seg] = c[15];
  } else {
#pragma unroll
    for (int k = 14; k >= 0; --k) c[k] += c[k + 1];
    TOT[(dir * 64 + j) * 4 + seg] = c[0];
  }
  __syncthreads();
  float off = 0.f;
#pragma unroll
  for (int s = 0; s < 4; ++s) { const float tv = TOT[(dir * 64 + j) * 4 + s]; if (dir == 0 ? s < seg : s > seg) off += tv; }
  LAS float* X = (LAS float*)(lds + OX) + dir * 64 * LD;
#pragma unroll
  for (int k = 0; k < 16; ++k) X[(seg * 16 + k) * LD + j] = c[k] + off;
}
struct VRegs { unsigned long long u[4]; };
__device__ __forceinline__ VRegs load_v_regs(const In& p, int head, long row0, int tid) { VRegs r;
#pragma unroll
  for (int m = 0; m < 4; ++m) { const int t = (tid >> 5) + 16 * m, c4 = (tid & 31) * 4; r.u[m] = *(const unsigned long long*)(p.v + (row0 + t) * p.ld + head * 128 + c4); }
  return r; }
__device__ __forceinline__ void store_v(const VRegs& r, LAS unsigned char* lds, int tid) {
  LAS float* V = (LAS float*)(lds + OV);
#pragma unroll
  for (int m = 0; m < 4; ++m) { const int t = (tid >> 5) + 16 * m, c4 = (tid & 31) * 4; const unsigned long long u = r.u[m];
    f32x4v a4; a4[0] = bf2f((bf16_t)u); a4[1] = bf2f((bf16_t)(u >> 16)); a4[2] = bf2f((bf16_t)(u >> 32)); a4[3] = bf2f((bf16_t)(u >> 48)); *(LAS f32x4v*)(V + t * 128 + c4) = a4; }
}

__device__ __forceinline__ void g1_unit(const In& p, LAS unsigned char* lds, int head, int cid, int GH, int NCH) {
  int tid = threadIdx.x; asm volatile("" : "+v"(tid));
  const int lane = tid & 63, w = __builtin_amdgcn_readfirstlane(tid >> 6);
  const long row0 = chunk_row(p, cid);
  const VRegs vr = load_v_regs(p, head, row0, tid);
  bf16_t kreg[8];
#pragma unroll
  for (int m = 0; m < 8; ++m) kreg[m] = p.k[(row0 + (tid >> 6) + 8 * m) * p.ld + head * 64 + (tid & 63)];
  cum_phase(p, lds, head, row0, tid);
  store_v(vr, lds, tid);
  __syncthreads();
  LAS float* TOT = (LAS float*)(lds + OTOT);
  { const int j = tid & 63;
#pragma unroll
    for (int dir = 0; dir < 2; ++dir) { LAS float* X = (LAS float*)(lds + OX) + dir * 64 * LD;
      const float cl = TOT[(dir * 64 + j) * 4 + 0] + TOT[(dir * 64 + j) * 4 + 1] + TOT[(dir * 64 + j) * 4 + 2] + TOT[(dir * 64 + j) * 4 + 3];
#pragma unroll
      for (int m = 0; m < 8; ++m) { const int t = (tid >> 6) + 8 * m; const float kv = bf2f(kreg[m]); X[t * LD + j] = kv * __expf(cl - X[t * LD + j]); }
      if (tid < 64) p.dec[(((long)dir * GH + head) * NCH + cid) * 64 + j] = __expf(cl); }
  }
  __syncthreads();
  { const int dir = w >> 2, di = (w >> 1) & 1, vj0 = (w & 1) * 2; const LAS float* X = (const LAS float*)(lds + OX) + dir * 64 * LD; const LAS float* V = (const LAS float*)(lds + OV);
    f32x16 a0 = {}, a1 = {}; const int li = lane & 31, lk = lane >> 5;
#pragma unroll 4
    for (int s0 = 0; s0 < 64; s0 += 2) { const float av = X[(s0 + lk) * LD + 32 * di + li]; const float b0 = V[(s0 + lk) * 128 + 32 * vj0 + li], b1 = V[(s0 + lk) * 128 + 32 * vj0 + 32 + li];
      a0 = __builtin_amdgcn_mfma_f32_32x32x2f32(av, b0, a0, 0, 0, 0); a1 = __builtin_amdgcn_mfma_f32_32x32x2f32(av, b1, a1, 0, 0, 0); }
    float* dst = p.cs + ((((long)dir * GH + head) * NCH + cid) * 64) * 128;
#pragma unroll
    for (int r = 0; r < 16; ++r) { const int d = 32 * di + (r & 3) + 8 * (r >> 2) + 4 * lk; dst[(long)d * 128 + 32 * vj0 + li] = a0[r]; dst[(long)d * 128 + 32 * vj0 + 32 + li] = a1[r]; }
  }
  __syncthreads();
}
__device__ __forceinline__ void g2_item(const In& p, long idx, int GH, int NCH) {
  const int v = 2 * (int)(idx & 63), d = (int)((idx >> 6) & 63); const int hd = (int)((idx >> 12) % GH), dir = (int)((idx >> 12) / GH);
  const int nl = p.S / 64, nc = p.C / 64; float st0 = 0.f, st1 = 0.f;
  bf16_t* base = p.csb + (((long)dir * GH + hd) * NCH) * 64 * 128 + (long)d * 128 + v; const float* db = p.dec + (((long)dir * GH + hd) * NCH) * 64 + d;
  for (int s0 = 0; s0 < nl + nc; s0 += 4) { unsigned c[4]; float dc[4]; unsigned* pp[4];
#pragma unroll
    for (int k = 0; k < 4; ++k) { const int step = s0 + k; int cid; if (step < nc) cid = nl + (dir ? nc - 1 - step : step); else cid = dir ? nl - 1 - (step - nc) : step - nc;
      pp[k] = (unsigned*)(base + (long)cid * 64 * 128); c[k] = *pp[k]; dc[k] = db[(long)cid * 64]; }
#pragma unroll
    for (int k = 0; k < 4; ++k) { *pp[k] = pk2(st0, st1); st0 = dc[k] * st0 + __uint_as_float(c[k] << 16); st1 = dc[k] * st1 + __uint_as_float(c[k] & 0xffff0000u); } }
}
__device__ __forceinline__ void g3_unit(const In& p, LAS unsigned char* lds, int head, int cid, int GH, int NCH) {
  int tid = threadIdx.x; asm volatile("" : "+v"(tid));
  const int lane = tid & 63, w = __builtin_amdgcn_readfirstlane(tid >> 6), li = lane & 31, lk = lane >> 5;
  const long row0 = chunk_row(p, cid);
  float spf[2][32];
  { const int vj_ = w & 3;
#pragma unroll
    for (int dir = 0; dir < 2; ++dir) { const float* sp = p.cs + ((((long)dir * GH + head) * NCH + cid) * 64) * 128 + 32 * vj_ + li;
#pragma unroll
      for (int i = 0; i < 32; ++i) spf[dir][i] = sp[(long)(2 * i + lk) * 128]; } }
  const VRegs vr = load_v_regs(p, head, row0, tid);
  bf16_t kreg[8], qreg[8];
#pragma unroll
  for (int m = 0; m < 8; ++m) { const long o_ = (row0 + (tid >> 6) + 8 * m) * p.ld + head * 64 + (tid & 63); kreg[m] = p.k[o_]; qreg[m] = p.q[o_]; }
  cum_phase(p, lds, head, row0, tid);
  store_v(vr, lds, tid);
  __syncthreads();
  { const int j = tid & 63;
#pragma unroll
    for (int dir = 0; dir < 2; ++dir) { LAS float* X = (LAS float*)(lds + OX) + dir * 64 * LD; LAS float* Y = (LAS float*)(lds + OY) + dir * 64 * LD;
#pragma unroll
      for (int m = 0; m < 8; ++m) { const int t = (tid >> 6) + 8 * m; const float c = X[t * LD + j];
        const float qv = bf2f(qreg[m]) * 0.125f, kv = bf2f(kreg[m]);
        X[t * LD + j] = qv * __expf(c); Y[t * LD + j] = kv * __expf(-c); } }
  }
  __syncthreads();
  {
    const int dir = w >> 2, qi = (w >> 1) & 1, si = w & 1; const bool zero = dir == 0 ? si > qi : si < qi;
    const LAS float* X = (const LAS float*)(lds + OX) + dir * 64 * LD; LAS float* Y = (LAS float*)(lds + OY) + dir * 64 * LD;
    f32x16 pa = {};
    if (!zero) {
#pragma unroll 4
      for (int d0 = 0; d0 < 64; d0 += 2) pa = __builtin_amdgcn_mfma_f32_32x32x2f32(X[(32 * qi + li) * LD + d0 + lk], Y[(32 * si + li) * LD + d0 + lk], pa, 0, 0, 0);
    }
    __syncthreads();
#pragma unroll
    for (int r = 0; r < 16; ++r) { const int q = 32 * qi + (r & 3) + 8 * (r >> 2) + 4 * lk, s = 32 * si + li; const bool keep = dir == 0 ? s <= q : s >= q;
      Y[q * LD + s] = keep ? pa[r] : 0.f; }
  }
  __syncthreads();
  f32x16 acc = {};
  { const int qi = w >> 2, vj = w & 3; const LAS float* V = (const LAS float*)(lds + OV);
#pragma unroll
    for (int dir = 0; dir < 2; ++dir) { const LAS float* X = (const LAS float*)(lds + OX) + dir * 64 * LD; const LAS float* Y = (const LAS float*)(lds + OY) + dir * 64 * LD;
#pragma unroll 4
      for (int s0 = 0; s0 < 64; s0 += 2) acc = __builtin_amdgcn_mfma_f32_32x32x2f32(Y[(32 * qi + li) * LD + s0 + lk], V[(s0 + lk) * 128 + 32 * vj + li], acc, 0, 0, 0);
#pragma unroll
      for (int i = 0; i < 32; ++i) acc = __builtin_amdgcn_mfma_f32_32x32x2f32(X[(32 * qi + li) * LD + 2 * i + lk], spf[dir][i], acc, 0, 0, 0);
    }
    __syncthreads();
    LAS float* O = (LAS float*)(lds + OX);
#pragma unroll
    for (int r = 0; r < 16; ++r) { const int q = 32 * qi + (r & 3) + 8 * (r >> 2) + 4 * lk; O[q * 129 + 32 * vj + li] = acc[r]; }
  }
  __syncthreads();
  { const int row = tid >> 3, part = tid & 7; const LAS float* O = (const LAS float*)(lds + OX) + row * 129 + part * 16;
    float o[16]; float ss = 0.f;
#pragma unroll
    for (int k = 0; k < 16; ++k) { o[k] = O[k]; ss += o[k] * o[k]; }
    ss += __shfl_xor(ss, 1); ss += __shfl_xor(ss, 2); ss += __shfl_xor(ss, 4);
    const float rs = 1.f / sqrtf(ss * (1.f / 128.f) + 1e-6f);
    const bf16_t* ogp = p.og + (row0 + row) * p.ld + head * 128 + part * 16; const v4u og0 = *(const v4u*)ogp, og1 = *(const v4u*)(ogp + 8);
    const unsigned ogw[8] = {og0.x, og0.y, og0.z, og0.w, og1.x, og1.y, og1.z, og1.w}; bf16_t* yp = p.y + (row0 + row) * p.ldy + head * 128 + part * 16; float yy[16];
#pragma unroll
    for (int k4 = 0; k4 < 4; ++k4) { f32x4v g4; g4[0] = bf2f((bf16_t)(ogw[2 * k4] & 0xffff)); g4[1] = bf2f((bf16_t)(ogw[2 * k4] >> 16)); g4[2] = bf2f((bf16_t)(ogw[2 * k4 + 1] & 0xffff)); g4[3] = bf2f((bf16_t)(ogw[2 * k4 + 1] >> 16)); const f32x4v n4 = *(const f32x4v*)(p.gnorm + part * 16 + 4 * k4); f32x4v y4;
#pragma unroll
      for (int e = 0; e < 4; ++e) { const float gg = g4[e]; y4[e] = o[4 * k4 + e] * rs * n4[e] * (gg / (1.f + __expf(-gg))); yy[4 * k4 + e] = y4[e]; } }
    { v4u o0, o1; o0.x = pk2(yy[0], yy[1]); o0.y = pk2(yy[2], yy[3]); o0.z = pk2(yy[4], yy[5]); o0.w = pk2(yy[6], yy[7]);
      o1.x = pk2(yy[8], yy[9]); o1.y = pk2(yy[10], yy[11]); o1.z = pk2(yy[12], yy[13]); o1.w = pk2(yy[14], yy[15]); *(v4u*)yp = o0; *(v4u*)(yp + 8) = o1; }
  }
  __syncthreads();
}

typedef short bf16x8g __attribute__((ext_vector_type(8)));
constexpr int LB = 72;
constexpr int OQB = 2 * 64 * LD * 4, OKB = OQB + 2 * 64 * LB * 2, OVT = OKB + 2 * 64 * LB * 2, OBEND = OVT + 128 * LB * 2;
static_assert(OBEND <= OAL, "gla bf16 lds");
#define GMM(A, B, C) C = __builtin_amdgcn_mfma_f32_32x32x16_bf16(__builtin_bit_cast(bf16x8g, A), __builtin_bit_cast(bf16x8g, B), C, 0, 0, 0)
__device__ __forceinline__ void store_vt(const VRegs& r, LAS unsigned char* lds, int tid) {
  LAS bf16_t* Vt = (LAS bf16_t*)(lds + OVT);
#pragma unroll
  for (int m = 0; m < 4; ++m) { const int t = (tid >> 5) + 16 * m, c4 = (tid & 31) * 4; const unsigned long long u = r.u[m];
    Vt[(c4 + 0) * LB + t] = (bf16_t)u; Vt[(c4 + 1) * LB + t] = (bf16_t)(u >> 16); Vt[(c4 + 2) * LB + t] = (bf16_t)(u >> 32); Vt[(c4 + 3) * LB + t] = (bf16_t)(u >> 48); }
}
__device__ __forceinline__ void g1b_unit(const In& p, LAS unsigned char* lds, int head, int cid, int GH, int NCH) {
  int tid = threadIdx.x; asm volatile("" : "+v"(tid));
  const int lane = tid & 63, w = __builtin_amdgcn_readfirstlane(tid >> 6), li = lane & 31, lk = lane >> 5;
  const long row0 = chunk_row(p, cid);
  const VRegs vr = load_v_regs(p, head, row0, tid);
  bf16_t kreg[8];
#pragma unroll
  for (int m = 0; m < 8; ++m) kreg[m] = p.k[(row0 + (tid >> 6) + 8 * m) * p.ld + head * 64 + (tid & 63)];
  cum_phase(p, lds, head, row0, tid);
  store_vt(vr, lds, tid);
  __syncthreads();
  LAS float* TOT = (LAS float*)(lds + OTOT);
  { const int j = tid & 63;
#pragma unroll
    for (int dir = 0; dir < 2; ++dir) { const LAS float* X = (const LAS float*)(lds + OX) + dir * 64 * LD; LAS bf16_t* KeT = (LAS bf16_t*)(lds + OQB) + dir * 64 * LB;
      const float cl = TOT[(dir * 64 + j) * 4 + 0] + TOT[(dir * 64 + j) * 4 + 1] + TOT[(dir * 64 + j) * 4 + 2] + TOT[(dir * 64 + j) * 4 + 3];
#pragma unroll
      for (int m = 0; m < 8; ++m) { const int t = (tid >> 6) + 8 * m; KeT[j * LB + t] = (bf16_t)f2bf(bf2f(kreg[m]) * __expf(cl - X[t * LD + j])); }
      if (tid < 64) p.dec[(((long)dir * GH + head) * NCH + cid) * 64 + j] = __expf(cl); }
  }
  __syncthreads();
  { const int dir = w >> 2, di = (w >> 1) & 1, vj0 = (w & 1) * 2; const LAS bf16_t* KeT = (const LAS bf16_t*)(lds + OQB) + dir * 64 * LB; const LAS bf16_t* Vt = (const LAS bf16_t*)(lds + OVT);
    f32x16 a0 = {}, a1 = {};
#pragma unroll
    for (int kk = 0; kk < 4; ++kk) { const v4u av = *(const LAS v4u*)(KeT + (32 * di + li) * LB + 16 * kk + 8 * lk);
      const v4u b0 = *(const LAS v4u*)(Vt + (32 * vj0 + li) * LB + 16 * kk + 8 * lk), b1 = *(const LAS v4u*)(Vt + (32 * vj0 + 32 + li) * LB + 16 * kk + 8 * lk);
      GMM(av, b0, a0); GMM(av, b1, a1); }
    bf16_t* dst = p.csb + ((((long)dir * GH + head) * NCH + cid) * 64) * 128;
#pragma unroll
    for (int r = 0; r < 16; ++r) { const int d = 32 * di + (r & 3) + 8 * (r >> 2) + 4 * lk; dst[(long)d * 128 + 32 * vj0 + li] = (bf16_t)f2bf(a0[r]); dst[(long)d * 128 + 32 * vj0 + 32 + li] = (bf16_t)f2bf(a1[r]); }
  }
  __syncthreads();
}
__device__ __forceinline__ void g3b_unit(const In& p, LAS unsigned char* lds, int head, int cid, int GH, int NCH) {
  int tid = threadIdx.x; asm volatile("" : "+v"(tid));
  const int lane = tid & 63, w = __builtin_amdgcn_readfirstlane(tid >> 6), li = lane & 31, lk = lane >> 5;
  const long row0 = chunk_row(p, cid);
  unsigned spf[2][32];
  { const int vj_ = w & 3;
#pragma unroll
    for (int dir = 0; dir < 2; ++dir) { const bf16_t* sp = p.csb + ((((long)dir * GH + head) * NCH + cid) * 64) * 128 + 32 * vj_ + li;
#pragma unroll
      for (int i = 0; i < 32; ++i) spf[dir][i] = sp[(long)(16 * (i >> 3) + 8 * lk + (i & 7)) * 128]; } }
  const VRegs vr = load_v_regs(p, head, row0, tid);
  bf16_t kreg[8], qreg[8];
#pragma unroll
  for (int m = 0; m < 8; ++m) { const long o_ = (row0 + (tid >> 6) + 8 * m) * p.ld + head * 64 + (tid & 63); kreg[m] = p.k[o_]; qreg[m] = p.q[o_]; }
  cum_phase(p, lds, head, row0, tid);
  store_vt(vr, lds, tid);
  __syncthreads();
  { const int j = tid & 63;
#pragma unroll
    for (int dir = 0; dir < 2; ++dir) { const LAS float* X = (const LAS float*)(lds + OX) + dir * 64 * LD; LAS bf16_t* Qb = (LAS bf16_t*)(lds + OQB) + dir * 64 * LB; LAS bf16_t* Kb = (LAS bf16_t*)(lds + OKB) + dir * 64 * LB;
#pragma unroll
      for (int m = 0; m < 8; ++m) { const int t = (tid >> 6) + 8 * m; const float c = X[t * LD + j];
        Qb[t * LB + j] = (bf16_t)f2bf(bf2f(qreg[m]) * 0.125f * __expf(c)); Kb[t * LB + j] = (bf16_t)f2bf(bf2f(kreg[m]) * __expf(-c)); } }
  }
  __syncthreads();
  {
    const int dir = w >> 2, qi = (w >> 1) & 1, si = w & 1; const bool zero = dir == 0 ? si > qi : si < qi;
    const LAS bf16_t* Qb = (const LAS bf16_t*)(lds + OQB) + dir * 64 * LB; LAS bf16_t* Kb = (LAS bf16_t*)(lds + OKB) + dir * 64 * LB;
    f32x16 pa = {};
    if (!zero) {
#pragma unroll
      for (int kk = 0; kk < 4; ++kk) { const v4u av = *(const LAS v4u*)(Qb + (32 * qi + li) * LB + 16 * kk + 8 * lk), bv = *(const LAS v4u*)(Kb + (32 * si + li) * LB + 16 * kk + 8 * lk); GMM(av, bv, pa); }
    }
    __syncthreads();
#pragma unroll
    for (int r = 0; r < 16; ++r) { const int q = 32 * qi + (r & 3) + 8 * (r >> 2) + 4 * lk, s = 32 * si + li; const bool keep = dir == 0 ? s <= q : s >= q;
      Kb[q * LB + s] = (bf16_t)f2bf(keep ? pa[r] : 0.f); }
  }
  __syncthreads();
  f32x16 acc = {};
  { const int qi = w >> 2, vj = w & 3; const LAS bf16_t* Vt = (const LAS bf16_t*)(lds + OVT);
#pragma unroll
    for (int dir = 0; dir < 2; ++dir) { const LAS bf16_t* Qb = (const LAS bf16_t*)(lds + OQB) + dir * 64 * LB; const LAS bf16_t* Pb = (const LAS bf16_t*)(lds + OKB) + dir * 64 * LB;
#pragma unroll
      for (int kk = 0; kk < 4; ++kk) { const v4u av = *(const LAS v4u*)(Pb + (32 * qi + li) * LB + 16 * kk + 8 * lk), bv = *(const LAS v4u*)(Vt + (32 * vj + li) * LB + 16 * kk + 8 * lk); GMM(av, bv, acc); }
#pragma unroll
      for (int kk = 0; kk < 4; ++kk) { const v4u av = *(const LAS v4u*)(Qb + (32 * qi + li) * LB + 16 * kk + 8 * lk);
        v4u bv; bv.x = spf[dir][8 * kk + 0] | (spf[dir][8 * kk + 1] << 16); bv.y = spf[dir][8 * kk + 2] | (spf[dir][8 * kk + 3] << 16); bv.z = spf[dir][8 * kk + 4] | (spf[dir][8 * kk + 5] << 16); bv.w = spf[dir][8 * kk + 6] | (spf[dir][8 * kk + 7] << 16);
        GMM(av, bv, acc); }
    }
    LAS float* O = (LAS float*)(lds + OX);
#pragma unroll
    for (int r = 0; r < 16; ++r) { const int q = 32 * qi + (r & 3) + 8 * (r >> 2) + 4 * lk; O[q * 129 + 32 * vj + li] = acc[r]; }
  }
  __syncthreads();
  { const int row = tid >> 3, part = tid & 7; const LAS float* O = (const LAS float*)(lds + OX) + row * 129 + part * 16;
    float o[16]; float ss = 0.f;
#pragma unroll
    for (int k = 0; k < 16; ++k) { o[k] = O[k]; ss += o[k] * o[k]; }
    ss += __shfl_xor(ss, 1); ss += __shfl_xor(ss, 2); ss += __shfl_xor(ss, 4);
    const float rs = 1.f / sqrtf(ss * (1.f / 128.f) + 1e-6f);
    const bf16_t* ogp = p.og + (row0 + row) * p.ld + head * 128 + part * 16; const v4u og0 = *(const v4u*)ogp, og1 = *(const v4u*)(ogp + 8);
    const unsigned ogw[8] = {og0.x, og0.y, og0.z, og0.w, og1.x, og1.y, og1.z, og1.w}; bf16_t* yp = p.y + (row0 + row) * p.ldy + head * 128 + part * 16; float yy[16];
#pragma unroll
    for (int k4 = 0; k4 < 4; ++k4) { f32x4v g4; g4[0] = bf2f((bf16_t)(ogw[2 * k4] & 0xffff)); g4[1] = bf2f((bf16_t)(ogw[2 * k4] >> 16)); g4[2] = bf2f((bf16_t)(ogw[2 * k4 + 1] & 0xffff)); g4[3] = bf2f((bf16_t)(ogw[2 * k4 + 1] >> 16)); const f32x4v n4 = *(const f32x4v*)(p.gnorm + part * 16 + 4 * k4);
#pragma unroll
      for (int e = 0; e < 4; ++e) { const float gg = g4[e]; yy[4 * k4 + e] = o[4 * k4 + e] * rs * n4[e] * (gg / (1.f + __expf(-gg))); } }
    { v4u o0, o1; o0.x = pk2(yy[0], yy[1]); o0.y = pk2(yy[2], yy[3]); o0.z = pk2(yy[4], yy[5]); o0.w = pk2(yy[6], yy[7]);
      o1.x = pk2(yy[8], yy[9]); o1.y = pk2(yy[10], yy[11]); o1.z = pk2(yy[12], yy[13]); o1.w = pk2(yy[14], yy[15]); *(v4u*)yp = o0; *(v4u*)(yp + 8) = o1; }
  }
  __syncthreads();
}
#undef GMM
}
namespace moe {
constexpr int NE = 16, NG = 4, EPG = 4, DE = 512, D = 1024;
__device__ __forceinline__ float wave_sum(float v) {
#pragma unroll
  for (int o = 1; o < 64; o <<= 1) v += __shfl_xor(v, o);
  return v;
}
struct Route { int e0, r0, e1, r1; };
struct MoeOrder {
  int G, c, NT; const LAS int* poff;
  __device__ __forceinline__ bool next(int i, pg8::Unit& u) const {
    const long L = (long)i * G + c; const int total = poff[NE] * NT; if (L >= total) return false;
    const int panel = (int)L / NT, j = (int)L % NT; int e = 0;
#pragma unroll
    for (int k = 1; k < NE; ++k) e += (panel >= poff[k]) ? 1 : 0;
    u.pm = panel; u.pn = e * NT + j; u.acol = 0; u.nt = 0; return true;
  }
  __device__ __forceinline__ void a_ready(const pg8::Unit&) const {}
  __device__ __forceinline__ void done(const pg8::Unit&) const {}
};
struct EpiGU {
  static constexpr bool PERM = true, AFTER_DRAIN = false;
  bf16_t* hid;
  __device__ __forceinline__ void operator()(const pg8::f32x4 (&acc)[2][2][4][2], const pg8::Unit& u, int wr, int wc, int fr, int fq) const {
    const int j = u.pn & 3; const int row0 = u.pm * 256 + wr * 64 + fr, col0 = j * 128 + wc * 32 + 8 * fq;
#pragma unroll
    for (int ai = 0; ai < 2; ++ai)
#pragma unroll
      for (int m = 0; m < 4; ++m) { const size_t r = (size_t)(row0 + ai * 128 + m * 16); float hv[8];
#pragma unroll
        for (int n = 0; n < 2; ++n)
#pragma unroll
          for (int e = 0; e < 4; ++e) { const float g = acc[ai][0][m][n][e], up = acc[ai][1][m][n][e]; hv[4 * n + e] = g / (1.f + __expf(-g)) * up; }
        v4u o; o.x = pk2(hv[0], hv[1]); o.y = pk2(hv[2], hv[3]); o.z = pk2(hv[4], hv[5]); o.w = pk2(hv[6], hv[7]);
        *(v4u*)(hid + r * DE + col0) = o; }
  }
};
struct EpiDown {
  static constexpr bool PERM = true, AFTER_DRAIN = false;
  const int* srcrow; const float* wgt; bf16_t* contrib; size_t slot_stride;
  __device__ __forceinline__ void operator()(const pg8::f32x4 (&acc)[2][2][4][2], const pg8::Unit& u, int wr, int wc, int fr, int fq) const {
    const int pn = u.pn & 3; const int row0 = u.pm * 256 + wr * 64 + fr, col0 = pn * 256 + wc * 32 + 8 * fq;
    int srcs[2][4]; float ws_[2][4];
#pragma unroll
    for (int ai = 0; ai < 2; ++ai)
#pragma unroll
      for (int m = 0; m < 4; ++m) { const int r = row0 + ai * 128 + m * 16; srcs[ai][m] = srcrow[r]; ws_[ai][m] = wgt[r]; }
#pragma unroll
    for (int ai = 0; ai < 2; ++ai)
#pragma unroll
      for (int m = 0; m < 4; ++m) { const int src = srcs[ai][m]; if (src < 0) continue; const float w = ws_[ai][m];
        bf16_t* dst = contrib + (size_t)(src & 1) * slot_stride + (size_t)(src >> 1) * D + col0;
#pragma unroll
        for (int bj = 0; bj < 2; ++bj) { const pg8::f32x4 v0 = acc[ai][bj][m][0] * w, v1 = acc[ai][bj][m][1] * w;
          v4u o; o.x = pk2(v0[0], v0[1]); o.y = pk2(v0[2], v0[3]); o.z = pk2(v1[0], v1[1]); o.w = pk2(v1[2], v1[3]); *(v4u*)(dst + bj * 128) = o; } }
  }
};
__device__ __forceinline__ void route_row(const float* xr, const float* gnorm, const float* shift, const float* scale, bf16_t* hrow, const LAS float* rwT, const float* rbias,
                                          LAS int* cnt, Route* rt, float* wts, int lane) {
  typedef float f4 __attribute__((ext_vector_type(4)));
  f4 xv[4]; float ss = 0.f;
#pragma unroll
  for (int j = 0; j < 4; ++j) { xv[j] = *(const f4*)(xr + 4 * lane + 256 * j); ss += xv[j][0] * xv[j][0] + xv[j][1] * xv[j][1] + xv[j][2] * xv[j][2] + xv[j][3] * xv[j][3]; }
  const float rs = 1.f / sqrtf(wave_sum(ss) * (1.f / 1024.f) + 1e-6f);
  float lg[NE];
#pragma unroll
  for (int e = 0; e < NE; ++e) lg[e] = 0.f;
#pragma unroll
  for (int j = 0; j < 4; ++j) { const int c = 4 * lane + 256 * j; const f4 g4 = *(const f4*)(gnorm + c), sh = *(const f4*)(shift + c), sc = *(const f4*)(scale + c);
    f4 h;
#pragma unroll
    for (int i = 0; i < 4; ++i) h[i] = xv[j][i] * rs * g4[i] * (1.f + sc[i]) + sh[i];
    *(unsigned long long*)(hrow + c) = (unsigned long long)pk2(h[0], h[1]) | ((unsigned long long)pk2(h[2], h[3]) << 32);
#pragma unroll
    for (int e = 0; e < NE; ++e) { const f4 w4 = *(const LAS f4*)(rwT + e * 1024 + c); lg[e] += h[0] * w4[0] + h[1] * w4[1] + h[2] * w4[2] + h[3] * w4[3]; } }
  { float v8[8], v4[4], v2[2], v1;
#pragma unroll
    for (int i = 0; i < 8; ++i) { const bool up = lane & 1; const float keep = up ? lg[2 * i + 1] : lg[2 * i], send = up ? lg[2 * i] : lg[2 * i + 1]; v8[i] = keep + __shfl_xor(send, 1); }
#pragma unroll
    for (int i = 0; i < 4; ++i) { const bool up = lane & 2; const float keep = up ? v8[2 * i + 1] : v8[2 * i], send = up ? v8[2 * i] : v8[2 * i + 1]; v4[i] = keep + __shfl_xor(send, 2); }
#pragma unroll
    for (int i = 0; i < 2; ++i) { const bool up = lane & 4; const float keep = up ? v4[2 * i + 1] : v4[2 * i], send = up ? v4[2 * i] : v4[2 * i + 1]; v2[i] = keep + __shfl_xor(send, 4); }
    { const bool up = lane & 8; const float keep = up ? v2[1] : v2[0], send = up ? v2[0] : v2[1]; v1 = keep + __shfl_xor(send, 8); }
    v1 += __shfl_xor(v1, 16); v1 += __shfl_xor(v1, 32);
#pragma unroll
    for (int e = 0; e < NE; ++e) lg[e] = __shfl(v1, e); }
  float sc[NE], sel[NE];
#pragma unroll
  for (int e = 0; e < NE; ++e) { sc[e] = 1.f / (1.f + __expf(-lg[e])); sel[e] = sc[e] + rbias[e]; }
  int bestg = 0; float bestgs = -1e30f;
#pragma unroll
  for (int g = 0; g < NG; ++g) { float m1 = -1e30f, m2 = -1e30f;
#pragma unroll
    for (int i = 0; i < EPG; ++i) { const float v = sel[g * EPG + i]; if (v > m1) { m2 = m1; m1 = v; } else if (v > m2) m2 = v; }
    const float gsum = m1 + m2; if (gsum > bestgs) { bestgs = gsum; bestg = g; } }
  int i1 = -1, i2 = -1; float v1 = -1e30f, v2 = -1e30f, s1 = 0.f, s2 = 0.f;
#pragma unroll
  for (int e = 0; e < NE; ++e) { if (e / EPG == bestg) { const float v = sel[e];
      if (v > v1) { v2 = v1; i2 = i1; s2 = s1; v1 = v; i1 = e; s1 = sc[e]; } else if (v > v2) { v2 = v; i2 = e; s2 = sc[e]; } } }
  if (lane == 0) { const float inv = 1.f / (s1 + s2); Route r; r.e0 = i1; r.e1 = i2; r.r0 = __hip_atomic_fetch_add(cnt + i1, 1, __ATOMIC_RELAXED, __HIP_MEMORY_SCOPE_WORKGROUP); r.r1 = __hip_atomic_fetch_add(cnt + i2, 1, __ATOMIC_RELAXED, __HIP_MEMORY_SCOPE_WORKGROUP); *rt = r; wts[0] = s1 * inv; wts[1] = s2 * inv; }
}
}
namespace hy {
typedef float f32x16 __attribute__((ext_vector_type(16)));
constexpr int S = 4096, NT1 = 128, LDZ = 191, ZPAD = 31, LDX = 129;
constexpr int O_TAPS = 0, O_ZA = 32768, O_ZB = O_ZA + 32 * LDZ * 4, O_X1 = O_ZB + 32 * LDZ * 4, O_X2 = O_X1 + 32 * LDX * 4, O_RED = O_X2 + 32 * LDX * 4, O_END = O_RED + 4 * 64 * 16 * 4;
static_assert(O_END <= 131072, "hyena lds");

struct H0Regs { v4u w0, w1; };
__device__ __forceinline__ H0Regs h0_load(const bf16_t* u, int ld, int tile, int tid) {
  const int tt = tile / 24, jt = tile % 24, t0 = tt * 64, j0 = jt * 64; H0Regs r; r.w0 = (v4u){0u, 0u, 0u, 0u}; r.w1 = r.w0;
  { const int rr = tid >> 3, c8 = (tid & 7) * 8, t = t0 - 1 + rr; if (t >= 0 && t < S) r.w0 = *(const v4u*)(u + (size_t)t * ld + j0 + c8); }
  if (tid < 16) { const int rr = 64 + (tid >> 3), c8 = (tid & 7) * 8, t = t0 - 1 + rr; if (t < S) r.w1 = *(const v4u*)(u + (size_t)t * ld + j0 + c8); }
  return r;
}
__device__ __forceinline__ void h0_compute(const H0Regs& rg, const float* cw, const float* cb, bf16_t* ucT, int tile, LAS unsigned char* lds, int tid) {
  const int tt = tile / 24, jt = tile % 24, t0 = tt * 64, j0 = jt * 64;
  LAS float* U = (LAS float*)lds;
  { const int rr = tid >> 3, c8 = (tid & 7) * 8; const v4u w = rg.w0; LAS float* d = U + rr * 65 + c8;
    d[0] = bf2f(w.x & 0xffff); d[1] = bf2f(w.x >> 16); d[2] = bf2f(w.y & 0xffff); d[3] = bf2f(w.y >> 16); d[4] = bf2f(w.z & 0xffff); d[5] = bf2f(w.z >> 16); d[6] = bf2f(w.w & 0xffff); d[7] = bf2f(w.w >> 16); }
  if (tid < 16) { const int rr = 64 + (tid >> 3), c8 = (tid & 7) * 8; const v4u w = rg.w1; LAS float* d = U + rr * 65 + c8;
    d[0] = bf2f(w.x & 0xffff); d[1] = bf2f(w.x >> 16); d[2] = bf2f(w.y & 0xffff); d[3] = bf2f(w.y >> 16); d[4] = bf2f(w.z & 0xffff); d[5] = bf2f(w.z >> 16); d[6] = bf2f(w.w & 0xffff); d[7] = bf2f(w.w >> 16); }
  __syncthreads();
  { const int jj = tid >> 3, tq = (tid & 7) * 8, j = j0 + jj; const float w0 = cw[j], w1 = cw[1536 + j], w2 = cw[2 * 1536 + j], bb = cb[j]; float v[8];
#pragma unroll
    for (int k = 0; k < 8; ++k) v[k] = bb + w0 * U[(tq + k) * 65 + jj] + w1 * U[(tq + k + 1) * 65 + jj] + w2 * U[(tq + k + 2) * 65 + jj];
    v4u o; o.x = pk2(v[0], v[1]); o.y = pk2(v[2], v[3]); o.z = pk2(v[4], v[5]); o.w = pk2(v[6], v[7]); *(v4u*)(ucT + (size_t)j * S + t0 + tq) = o; }
  __syncthreads();
}
__device__ __forceinline__ void h2_tile(const bf16_t* yT, bf16_t* ybf, int ldy, int tile, LAS unsigned char* lds) {
  int tid = threadIdx.x; asm volatile("" : "+v"(tid));
  const int tt = tile / 8, ct = tile % 8, t0 = tt * 64, c0 = ct * 64;
  LAS bf16_t* T = (LAS bf16_t*)lds;
  { const int cc = tid >> 3, t8 = (tid & 7) * 8; const v4u w = *(const v4u*)(yT + (size_t)(c0 + cc) * S + t0 + t8); LAS unsigned* d = (LAS unsigned*)(T + cc * 66 + t8); d[0] = w.x; d[1] = w.y; d[2] = w.z; d[3] = w.w; }
  __syncthreads();
  { const int t = tid >> 3, c8 = (tid & 7) * 8; unsigned short e[8];
#pragma unroll
    for (int k = 0; k < 8; ++k) e[k] = T[(c8 + k) * 66 + t];
    v4u o; o.x = e[0] | ((unsigned)e[1] << 16); o.y = e[2] | ((unsigned)e[3] << 16); o.z = e[4] | ((unsigned)e[5] << 16); o.w = e[6] | ((unsigned)e[7] << 16);
    *(v4u*)(ybf + (size_t)(t0 + t) * ldy + c0 + c8) = o; }
  __syncthreads();
}
__device__ __forceinline__ void h1_unit(const bf16_t* ucT, const float* tapsT, const float* nrm, const float* skip, bf16_t* yT, int c, LAS unsigned char* lds) {
  int tid = threadIdx.x; asm volatile("" : "+v"(tid));
  const int lane = tid & 63, w = __builtin_amdgcn_readfirstlane(tid >> 6), li = lane & 31, lk = lane >> 5;
  LAS float* TAPS = (LAS float*)(lds + O_TAPS); LAS float* ZA = (LAS float*)(lds + O_ZA); LAS float* ZB = (LAS float*)(lds + O_ZB);
  LAS float* X1 = (LAS float*)(lds + O_X1); LAS float* X2 = (LAS float*)(lds + O_X2); LAS float* RED = (LAS float*)(lds + O_RED);
  for (int e = tid; e < 32 * 62; e += 512) { const int s2 = e / 62, p = e % 62, t1p = p < 31 ? p : 128 + p; ZA[s2 * LDZ + t1p] = 0.f; ZB[s2 * LDZ + t1p] = 0.f; }
  for (int t = tid; t < S; t += 512) { const int t2 = t & 31, t1 = t >> 5;
    X1[t2 * LDX + t1] = bf2f(ucT[(size_t)c * S + t]); X2[t2 * LDX + t1] = bf2f(ucT[(size_t)(512 + c) * S + t]); ZA[t2 * LDZ + t1 + ZPAD] = bf2f(ucT[(size_t)(1024 + c) * S + t]); }
#pragma unroll 1
  for (int o = 0; o < 2; ++o) {
    const float* tp = tapsT + ((size_t)o * 512 + c) * 8192;
    for (int e = tid; e < 8192; e += 512) TAPS[e] = tp[(e + 4096) & 8191];
    __syncthreads();
    const LAS float* Zin = o == 0 ? ZA : ZB;
    const int g = w & 3, dh = w >> 2;
    const int Dlo = 32 * g - 127 + (dh ? 80 : 0), Dn = dh ? 79 : 80;
    f32x16 acc = {};
    { const LAS float* ap = TAPS + 4096 + 32 * Dlo + li - lk - 30;
      const LAS float* bp = Zin + lk * LDZ + (32 * g + li - Dlo + ZPAD);
#pragma unroll 2
      for (int dd = 0; dd < Dn; ++dd) {
#pragma unroll
        for (int kk = 0; kk < 16; ++kk) acc = __builtin_amdgcn_mfma_f32_32x32x2f32(ap[(15 - kk) * 2], bp[2 * kk * LDZ], acc, 0, 0, 0);
        ap += 32; bp -= 1; }
    }
    if (dh) {
#pragma unroll
      for (int r = 0; r < 16; ++r) RED[(g * 64 + lane) * 16 + r] = acc[r]; }
    __syncthreads();
    if (!dh) { const float inv = 1.f / nrm[o * 512 + c], sk = skip[o * 512 + c]; const LAS float* G = o == 0 ? X1 : X2; LAS float* Out = o == 0 ? ZB : ZA;
#pragma unroll
      for (int r = 0; r < 16; ++r) { const int t2 = (r & 3) + 8 * (r >> 2) + 4 * lk, t1 = 32 * g + li;
        const float cv = (acc[r] + RED[(g * 64 + lane) * 16 + r]) * inv; const float zin = Zin[t2 * LDZ + t1 + ZPAD];
        Out[t2 * LDZ + t1 + ZPAD] = G[t2 * LDX + t1] * (cv + sk * zin); } }
    __syncthreads();
  }
  for (int t = tid; t < S; t += 512) yT[(size_t)c * S + t] = (bf16_t)f2bf(ZA[(t & 31) * LDZ + (t >> 5) + ZPAD]);
  __syncthreads();
}

typedef short bf16x8v __attribute__((ext_vector_type(8)));
typedef unsigned u32x2v __attribute__((ext_vector_type(2)));
constexpr int CSB = 16448;
constexpr int ZROW = 80, ZROWS = 190;
constexpr int B_CS = 0, B_ZA = 4 * CSB, B_ZB = B_ZA + 15232, B_X1 = B_ZB + 15232, B_X2 = B_X1 + 8256, B_RED = B_X2 + 8256, B_END = B_RED + 16384;
static_assert(B_END <= 131072 && B_ZA % 16 == 0 && B_X1 % 16 == 0, "hyena bf16 lds");
__device__ __forceinline__ void h1b_unit(const bf16_t* ucT, const bf16_t* tapsB, const float* nrm, const float* skip, bf16_t* yT, int c, LAS unsigned char* lds) {
  int tid = threadIdx.x; asm volatile("" : "+v"(tid));
  const int lane = tid & 63, w = __builtin_amdgcn_readfirstlane(tid >> 6), li = lane & 31, lk = lane >> 5;
  LAS bf16_t* ZA = (LAS bf16_t*)(lds + B_ZA); LAS bf16_t* ZB = (LAS bf16_t*)(lds + B_ZB); LAS bf16_t* X1 = (LAS bf16_t*)(lds + B_X1); LAS bf16_t* X2 = (LAS bf16_t*)(lds + B_X2);
  LAS float* RED = (LAS float*)(lds + B_RED);
  for (int e = tid; e < 62 * 20; e += 512) { const int p = e / 20, d = e % 20, row = p < 31 ? p : 128 + p; ((LAS unsigned*)ZA)[row * 20 + d] = 0u; ((LAS unsigned*)ZB)[row * 20 + d] = 0u; }
  { const v4u zv = *(const v4u*)(ucT + (size_t)(1024 + c) * S + tid * 8); const int t = tid * 8; *(LAS v4u*)((LAS unsigned char*)ZA + ((t >> 5) + ZPAD) * ZROW + (t & 31) * 2) = zv; }
  { const v4u xa = *(const v4u*)(ucT + (size_t)c * S + tid * 8), xb = *(const v4u*)(ucT + (size_t)(512 + c) * S + tid * 8); const int t1 = tid >> 2, t2b = (tid & 3) * 8;
    const unsigned wa[4] = {xa.x, xa.y, xa.z, xa.w}, wb[4] = {xb.x, xb.y, xb.z, xb.w};
#pragma unroll
    for (int k = 0; k < 4; ++k) { X1[(t2b + 2 * k) * LDX + t1] = (bf16_t)(wa[k] & 0xffff); X1[(t2b + 2 * k + 1) * LDX + t1] = (bf16_t)(wa[k] >> 16);
      X2[(t2b + 2 * k) * LDX + t1] = (bf16_t)(wb[k] & 0xffff); X2[(t2b + 2 * k + 1) * LDX + t1] = (bf16_t)(wb[k] >> 16); } }
  typedef unsigned u4a __attribute__((ext_vector_type(4), aligned(4))); typedef const __attribute__((address_space(1))) u4a* gp4;
  v4u cv[9];
#pragma unroll 1
  for (int o = 0; o < 2; ++o) {
#define HTAPS_LOAD(oo) { const __attribute__((address_space(1))) unsigned char* tb = (const __attribute__((address_space(1))) unsigned char*)(tapsB + ((size_t)(oo) * 512 + c) * 2 * 8232); \
      _Pragma("unroll") for (int it = 0; it < 9; ++it) { const int e = tid + 512 * it; const int s = e / 1028, q = e % 1028; cv[it] = (v4u){0u, 0u, 0u, 0u}; if (e < 4 * 1028) cv[it] = *(gp4)(tb + (size_t)(s & 1) * 16464 + 16 * q + 4 * (s >> 1)); } }
    if (o == 0) HTAPS_LOAD(0)
    {
#pragma unroll
      for (int it = 0; it < 9; ++it) { const int e = tid + 512 * it; const int s = e / 1028, q = e % 1028; if (e < 4 * 1028) *(LAS v4u*)(lds + B_CS + s * CSB + 16 * q) = cv[it]; } }
    __syncthreads();
    if (o == 0) HTAPS_LOAD(1)
    const LAS bf16_t* Zin = o == 0 ? ZA : ZB;
    const int g = w & 3, dh = w >> 2;
    const int Dlo = 32 * g - 127 + (dh ? 81 : 0), Dn = dh ? 78 : 81;
    f32x16 acc = {};
    { const int s = (4 - (li & 3)) & 3;
      const LAS unsigned char* ap = lds + B_CS + s * CSB + 2 * (4096 - 32 * Dlo - li + 8 * lk - s);
      const LAS unsigned char* bp = (const LAS unsigned char*)Zin + (32 * g + li - Dlo + ZPAD) * ZROW + 16 * lk;
#define HLD(A0, A1, B0, B1) { const u32x2v p0_ = *(const LAS u32x2v*)(ap), p1_ = *(const LAS u32x2v*)(ap2), p2_ = *(const LAS u32x2v*)(ap3), p3_ = *(const LAS u32x2v*)(ap4); \
        A0 = (v4u){p0_.x, p0_.y, p1_.x, p1_.y}; A1 = (v4u){p2_.x, p2_.y, p3_.x, p3_.y}; B0 = *(const LAS v4u*)(bp); B1 = *(const LAS v4u*)(bp + 32); ap -= 64; ap2 -= 64; ap3 -= 64; ap4 -= 64; bp -= ZROW; }
#define HMM(A, B) acc = __builtin_amdgcn_mfma_f32_32x32x16_bf16(__builtin_bit_cast(bf16x8v, A), __builtin_bit_cast(bf16x8v, B), acc, 0, 0, 0)
#define HOPQ(name, off) unsigned name##i = (unsigned)(unsigned long long)(ap + (off)); asm volatile("" : "+v"(name##i)); const LAS unsigned char* name = (const LAS unsigned char*)(unsigned long long)name##i;
      HOPQ(ap2, 8) HOPQ(ap3, 32) HOPQ(ap4, 40)
#undef HOPQ
      v4u fa0, fa1, fb0, fb1, ga0, ga1, gb0, gb1, ha0, ha1, hb0, hb1;
      HLD(fa0, fa1, fb0, fb1)
      HLD(ga0, ga1, gb0, gb1)
      for (int dd_ = 0; dd_ < Dn - 3; dd_ += 3) {
        HLD(ha0, ha1, hb0, hb1)
        HMM(fa0, fb0); HMM(fa1, fb1);
        HLD(fa0, fa1, fb0, fb1)
        HMM(ga0, gb0); HMM(ga1, gb1);
        HLD(ga0, ga1, gb0, gb1)
        HMM(ha0, hb0); HMM(ha1, hb1);
      }
      HLD(ha0, ha1, hb0, hb1)
      HMM(fa0, fb0); HMM(fa1, fb1); HMM(ga0, gb0); HMM(ga1, gb1); HMM(ha0, hb0); HMM(ha1, hb1);
#undef HLD
#undef HMM
    }
    if (dh) {
#pragma unroll
      for (int r = 0; r < 16; ++r) RED[(g * 64 + lane) * 16 + r] = acc[r]; }
    __syncthreads();
    if (!dh) { const float inv = 1.f / nrm[o * 512 + c], sk = skip[o * 512 + c]; const LAS bf16_t* G = o == 0 ? X1 : X2; LAS bf16_t* Out = o == 0 ? ZB : ZA;
#pragma unroll
      for (int r = 0; r < 16; ++r) { const int t2 = (r & 3) + 8 * (r >> 2) + 4 * lk, t1 = 32 * g + li;
        const float cv = (acc[r] + RED[(g * 64 + lane) * 16 + r]) * inv; const float zin = bf2f(Zin[(t1 + ZPAD) * (ZROW / 2) + t2]);
        Out[(t1 + ZPAD) * (ZROW / 2) + t2] = (bf16_t)f2bf(bf2f(G[t2 * LDX + t1]) * (cv + sk * zin)); } }
    __syncthreads();
  }
  { const int t = tid * 8; *(v4u*)(yT + (size_t)c * S + t) = *(const LAS v4u*)((const LAS unsigned char*)ZA + ((t >> 5) + ZPAD) * ZROW + (t & 31) * 2); }
  __syncthreads();
}
#undef HTAPS_LOAD

constexpr int C_ZP = 15, C_ZB = 159 * ZROW  , C_CS = 0, C_Z0 = 4 * CSB, C_X0 = C_Z0 + 2 * C_ZB, C_END = C_X0 + 4 * 8256;
static_assert(C_END <= 131072 && C_Z0 % 16 == 0 && C_ZB % 16 == 0 && C_X0 % 16 == 0, "hyena two-batch lds");
__device__ __forceinline__ void h1c_unit(const bf16_t* ucT2, const bf16_t* tapsB, const float* nrm, const float* skip, bf16_t* yT2, int c, LAS unsigned char* lds) {
  int tid = threadIdx.x; asm volatile("" : "+v"(tid));
  const int lane = tid & 63, g = __builtin_amdgcn_readfirstlane(tid >> 6), li = lane & 31, lk = lane >> 5, bsel = li >> 4, t1l = li & 15;
  for (int e = tid; e < 2 * 31 * 20; e += 512) { const int b = e / (31 * 20), p = (e / 20) % 31, d = e % 20, row = p < 15 ? p : 128 + p; ((LAS unsigned*)(lds + C_Z0 + b * C_ZB))[row * 20 + d] = 0u; }
#pragma unroll
  for (int b = 0; b < 2; ++b) { const bf16_t* uc = ucT2 + (size_t)b * 1536 * S; const int t = tid * 8;
    const v4u zv = *(const v4u*)(uc + (size_t)(1024 + c) * S + t), xa = *(const v4u*)(uc + (size_t)c * S + t), xb = *(const v4u*)(uc + (size_t)(512 + c) * S + t);
    *(LAS v4u*)(lds + C_Z0 + b * C_ZB + ((t >> 5) + C_ZP) * ZROW + (t & 31) * 2) = zv;
    LAS bf16_t* X1 = (LAS bf16_t*)(lds + C_X0 + (2 * b) * 8256); LAS bf16_t* X2 = (LAS bf16_t*)(lds + C_X0 + (2 * b + 1) * 8256); const int t1 = tid >> 2, t2b = (tid & 3) * 8;
    const unsigned wa[4] = {xa.x, xa.y, xa.z, xa.w}, wb[4] = {xb.x, xb.y, xb.z, xb.w};
#pragma unroll
    for (int k = 0; k < 4; ++k) { X1[(t2b + 2 * k) * LDX + t1] = (bf16_t)(wa[k] & 0xffff); X1[(t2b + 2 * k + 1) * LDX + t1] = (bf16_t)(wa[k] >> 16);
      X2[(t2b + 2 * k) * LDX + t1] = (bf16_t)(wb[k] & 0xffff); X2[(t2b + 2 * k + 1) * LDX + t1] = (bf16_t)(wb[k] >> 16); } }
  typedef unsigned u4a __attribute__((ext_vector_type(4), aligned(4))); typedef const __attribute__((address_space(1))) u4a* gp4;
  v4u cv[9];
  LAS bf16_t* Zm = (LAS bf16_t*)(lds + C_Z0 + bsel * C_ZB);
#pragma unroll 1
  for (int o = 0; o < 2; ++o) {
#define HTAPS_LOAD(oo) { const __attribute__((address_space(1))) unsigned char* tb = (const __attribute__((address_space(1))) unsigned char*)(tapsB + ((size_t)(oo) * 512 + c) * 2 * 8232); \
      _Pragma("unroll") for (int it = 0; it < 9; ++it) { const int e = tid + 512 * it; const int s = e / 1028, q = e % 1028; cv[it] = (v4u){0u, 0u, 0u, 0u}; if (e < 4 * 1028) cv[it] = *(gp4)(tb + (size_t)(s & 1) * 16464 + 16 * q + 4 * (s >> 1)); } }
    if (o == 0) HTAPS_LOAD(0)
    {
#pragma unroll
      for (int it = 0; it < 9; ++it) { const int e = tid + 512 * it; const int s = e / 1028, q = e % 1028; if (e < 4 * 1028) *(LAS v4u*)(lds + C_CS + s * CSB + 16 * q) = cv[it]; } }
    __syncthreads();
    if (o == 0) HTAPS_LOAD(1)
    const int Dlo = 16 * g - 128; constexpr int Dn = 144;
    f32x16 acc = {};
    { const int s = (4 - (li & 3)) & 3;
      const LAS unsigned char* ap = lds + C_CS + s * CSB + 2 * (4096 - 32 * Dlo - li + 8 * lk - s);
      const LAS unsigned char* bp = (const LAS unsigned char*)Zm + (16 * g + t1l - Dlo + C_ZP) * ZROW + 16 * lk;
#define HLD(A0, A1, B0, B1) { const u32x2v p0_ = *(const LAS u32x2v*)(ap), p1_ = *(const LAS u32x2v*)(ap2), p2_ = *(const LAS u32x2v*)(ap3), p3_ = *(const LAS u32x2v*)(ap4); \
        A0 = (v4u){p0_.x, p0_.y, p1_.x, p1_.y}; A1 = (v4u){p2_.x, p2_.y, p3_.x, p3_.y}; B0 = *(const LAS v4u*)(bp); B1 = *(const LAS v4u*)(bp + 32); ap -= 64; ap2 -= 64; ap3 -= 64; ap4 -= 64; bp -= ZROW; }
#define HMM(A, B) acc = __builtin_amdgcn_mfma_f32_32x32x16_bf16(__builtin_bit_cast(bf16x8v, A), __builtin_bit_cast(bf16x8v, B), acc, 0, 0, 0)
#define HOPQ(name, off) unsigned name##i = (unsigned)(unsigned long long)(ap + (off)); asm volatile("" : "+v"(name##i)); const LAS unsigned char* name = (const LAS unsigned char*)(unsigned long long)name##i;
      HOPQ(ap2, 8) HOPQ(ap3, 32) HOPQ(ap4, 40)
#undef HOPQ
      v4u fa0, fa1, fb0, fb1, ga0, ga1, gb0, gb1, ha0, ha1, hb0, hb1;
      HLD(fa0, fa1, fb0, fb1)
      HLD(ga0, ga1, gb0, gb1)
      for (int dd_ = 0; dd_ < Dn - 3; dd_ += 3) {
        HLD(ha0, ha1, hb0, hb1)
        HMM(fa0, fb0); HMM(fa1, fb1);
        HLD(fa0, fa1, fb0, fb1)
        HMM(ga0, gb0); HMM(ga1, gb1);
        HLD(ga0, ga1, gb0, gb1)
        HMM(ha0, hb0); HMM(ha1, hb1);
      }
      HLD(ha0, ha1, hb0, hb1)
      HMM(fa0, fb0); HMM(fa1, fb1); HMM(ga0, gb0); HMM(ga1, gb1); HMM(ha0, hb0); HMM(ha1, hb1);
#undef HLD
#undef HMM
    }
    __syncthreads();
    { const float inv = 1.f / nrm[o * 512 + c], sk = skip[o * 512 + c]; const LAS bf16_t* G = (const LAS bf16_t*)(lds + C_X0 + (2 * bsel + o) * 8256);
#pragma unroll
      for (int r = 0; r < 16; ++r) { const int t2 = (r & 3) + 8 * (r >> 2) + 4 * lk, t1 = 16 * g + t1l;
        const float cvv = acc[r] * inv; const float zin = bf2f(Zm[(t1 + C_ZP) * (ZROW / 2) + t2]);
        Zm[(t1 + C_ZP) * (ZROW / 2) + t2] = (bf16_t)f2bf(bf2f(G[t2 * LDX + t1]) * (cvv + sk * zin)); } }
    __syncthreads();
  }
#pragma unroll
  for (int b = 0; b < 2; ++b) { const int t = tid * 8; *(v4u*)(yT2 + (size_t)b * 512 * S + (size_t)c * S + t) = *(const LAS v4u*)(lds + C_Z0 + b * C_ZB + ((t >> 5) + C_ZP) * ZROW + (t & 31) * 2); }
  __syncthreads();
#undef HTAPS_LOAD
}
__device__ __forceinline__ void cconv3_item(const bf16_t* u, int ld, const float* cw, const float* cb, float* ucc, long idx) {
  const int j = (int)(idx % 1536); const int tc = (int)(idx / 1536);
  const bf16_t* up = u + (size_t)tc * ld + j;
  float v = cb[j] + cw[1536 + j] * bf2f(up[0]);
  if (tc > 0) v += cw[j] * bf2f(*(up - ld)); if (tc < 255) v += cw[2 * 1536 + j] * bf2f(up[ld]);
  ucc[idx] = v;
}
__device__ __forceinline__ void clong_item(const float* ucc, const float* z1c_in, float* z1c_out, bf16_t* yout, int ldy, const float* tapsC, const float* nrmC, const float* skip, int o, long idx) {
  const int c = (int)(idx % 512), t0 = (int)(idx / 512) * 8; constexpr int n = 256;
  const float* tp = tapsC + (size_t)o * 2 * n * 512 + c; const float nr = nrmC[o * 512 + c];
  const float* zs = o == 0 ? ucc + 1024 + c : z1c_in + c; const int ldz = o == 0 ? 1536 : 512;
  float acc[8], w[8];
#pragma unroll
  for (int i = 0; i < 8; ++i) { acc[i] = 0.f; const int lag = t0 + i; w[i] = tp[(size_t)lag * 512]; }
#pragma unroll 4
  for (int s = 0; s < n; ++s) { const float zv = zs[(size_t)s * ldz];
#pragma unroll
    for (int i = 0; i < 8; ++i) acc[i] += w[i] * zv;
    const int lag = t0 - s - 1;
    const float nw = tp[(size_t)(lag >= 0 ? lag : 2 * n + lag) * 512];
#pragma unroll
    for (int i = 7; i > 0; --i) w[i] = w[i - 1];
    w[0] = nw; }
  const float sk = skip[o * 512 + c];
#pragma unroll
  for (int i = 0; i < 8; ++i) { const int t = t0 + i; const float val = ucc[(size_t)t * 1536 + o * 512 + c] * (acc[i] / nr + sk * zs[(size_t)t * ldz]);
    if (o == 0) z1c_out[(size_t)t * 512 + c] = val; else yout[(size_t)t * ldy + c] = (bf16_t)f2bf(val); }
}
}
#define XB_TMO      128
#define XB_XCNT(j)  (256  + 64 * (j))
#define XB_XSUB(j)  (1280 + 64 * (j))
#define XB_XGEN(j)  (2304 + 64 * (j))
#define XB_TOP      3328
#define XB_TOPGEN   3392
#define XCD_BAR_WORDS 3456
#define XB_SPIN_CAP (1u << 18)

__device__ __forceinline__ unsigned xb_ld(unsigned* p)              { return __hip_atomic_load(p, __ATOMIC_RELAXED, __HIP_MEMORY_SCOPE_AGENT); }
__device__ __forceinline__ unsigned xb_add(unsigned* p, unsigned v) { return __hip_atomic_fetch_add(p, v, __ATOMIC_RELAXED, __HIP_MEMORY_SCOPE_AGENT); }
__device__ __forceinline__ unsigned xb_xcc_id() { return (unsigned)__builtin_amdgcn_s_getreg((3 << 11) | 20) & 0xFu; }
#define XB_SPIN(cond, bar) do { unsigned _sp = 0; while (cond) { __builtin_amdgcn_s_sleep(1); \
    if ((++_sp & 255u) == 0u) { if (xb_ld(&(bar)[XB_TMO])) break; if (_sp > XB_SPIN_CAP) { atomicAdd(&(bar)[XB_TMO], 1u); break; } } } } while (0)

struct XcdBarrier {
    unsigned* bar; unsigned x;
    volatile LAS unsigned* st;
};

__device__ __forceinline__ XcdBarrier xcd_barrier_post(unsigned* bar, volatile LAS unsigned* st) {
    XcdBarrier b; b.bar = bar; b.x = xb_xcc_id(); b.st = st;
    if (threadIdx.x == 0) (void)xb_add(&bar[XB_XCNT(b.x)], 1u);
    return b;
}
__device__ __forceinline__ void xcd_barrier_complete(unsigned* bar, unsigned x, unsigned& nloc, unsigned& nx) {
    const unsigned G = gridDim.x * gridDim.y * gridDim.z;
    unsigned sum, cnt, mine, sp = 0u;
    for (;;) {
        sum = 0u; cnt = 0u; mine = 0u;
#pragma unroll
        for (unsigned j = 0; j < 16; ++j) { const unsigned c = xb_ld(&bar[XB_XCNT(j)]); sum += c; cnt += (c > 0u) ? 1u : 0u; mine = (j == x) ? c : mine; }
        if (sum == G) break;
        __builtin_amdgcn_s_sleep(1);
        if ((++sp & 255u) == 0u) { if (xb_ld(&bar[XB_TMO])) break; if (sp > XB_SPIN_CAP) { atomicAdd(&bar[XB_TMO], 1u); break; } }
    }
    nloc = mine > 0u ? mine : 1u; nx = cnt > 0u ? cnt : 1u;
}

__device__ __forceinline__ void xcd_barrier(const XcdBarrier& b) {
    asm volatile("s_waitcnt vmcnt(0)" ::: "memory");
    __syncthreads();
    if (threadIdx.x == 0) {
        unsigned* bar = b.bar;
#define XB_SP(word) ((unsigned*)((((unsigned long long)(unsigned)__builtin_amdgcn_readfirstlane((int)((unsigned long long)(bar + (word)) >> 32))) << 32) | (unsigned)__builtin_amdgcn_readfirstlane((int)(unsigned)(unsigned long long)(bar + (word)))))
        unsigned* const p_xsub = XB_SP(XB_XSUB(b.x)); unsigned* const p_xgen = XB_SP(XB_XGEN(b.x));
        __builtin_amdgcn_s_waitcnt(0);
        unsigned nloc = b.st[0], nx = b.st[1];
        if (nloc == 0u) { xcd_barrier_complete(bar, b.x, nloc, nx); b.st[0] = nloc; b.st[1] = nx; }
        const unsigned old = xb_add(p_xsub, 1u);
        const unsigned gen = old / nloc;
        if (old + 1u == (gen + 1u) * nloc) {
            __builtin_amdgcn_fence(__ATOMIC_RELEASE, "agent");
            asm volatile("s_waitcnt vmcnt(0)" ::: "memory");
            const unsigned og = xb_add(&bar[XB_TOP], 1u);
            const unsigned tg = og / nx;
            if (og + 1u == (tg + 1u) * nx) xb_add(&bar[XB_TOPGEN], 1u);
            else XB_SPIN(xb_ld(&bar[XB_TOPGEN]) == tg, bar);
            __builtin_amdgcn_fence(__ATOMIC_ACQUIRE, "agent");
            xb_add(p_xgen, 1u);
            asm volatile("s_waitcnt vmcnt(0)" ::: "memory");
        } else {
            XB_SPIN(xb_ld(p_xgen) == gen, bar);
            __builtin_amdgcn_fence(__ATOMIC_ACQUIRE, "agent");
            asm volatile("s_waitcnt vmcnt(0)" ::: "memory");
        }
    }
    __syncthreads();
}
#include <math.h>
#ifdef HOST_TEST
#define HD
#define FEXP expf
#define FSIN sinf
#define FCOS cosf
#define FLOG logf
#define FPOW powf
#else
#define HD __device__ __forceinline__
#define FEXP __expf
#define FSIN __sinf
#define FCOS __cosf
#define FLOG __logf
#define FPOW __powf
#endif

struct FullDims { static constexpr int D=1024,B=8,S=4096,DEPTH=2,C=256,GW=64,AH=8,AKV=2,HDM=128,GH=4,GDK=64,GDV=128,GR=16,HW=512,HB=16,HF=64,NE=16,NG=4,DE=512; };
struct SmallDims { static constexpr int D=64,B=2,S=128,DEPTH=2,C=32,GW=16,AH=4,AKV=2,HDM=16,GH=2,GDK=8,GDV=16,GR=4,HW=32,HB=4,HF=8,NE=8,NG=2,DE=32; };

template <class T> struct DD {
  static constexpr int D=T::D,B=T::B,S=T::S,DEPTH=T::DEPTH,C=T::C,GW=T::GW,AH=T::AH,AKV=T::AKV,HDM=T::HDM,GH=T::GH,GDK=T::GDK,GDV=T::GDV,GR=T::GR,HW=T::HW,HB=T::HB,HF=T::HF,NE=T::NE,NG=T::NG,DE=T::DE;
  static constexpr int R=S+C, AG=AH/AKV, RP=HDM/4, HE=1+2*HB, EPG=NE/NG, AQW=AH*HDM, AKVW=AKV*HDM, GKW=GH*GDK, GVW=GH*GDV;
  static constexpr int NKV=AKVW+AKVW+GKW+GVW+2*GR, NIN=NKV+AQW+GKW+GVW+3*HW+3*D;
  static constexpr int O_AK=0, O_AV=AKVW, O_GK=2*AKVW, O_GV=2*AKVW+GKW, O_GA=2*AKVW+GKW+GVW;
  static constexpr int O_AQ=NKV, O_GQ=NKV+AQW, O_OG=O_GQ+GKW, O_HY=O_OG+GVW, O_BR=O_HY+3*HW;
};

struct NaiveBufs {
  const float *x,*c,*ctx,*c_ctx,*w_mod,*b_mod,*norm1_g,*norm2_g,*w_in,*q_norm_g,*k_norm_g,*gla_wa2,*gla_ba,*gla_norm_g,*hy_conv_w,*hy_conv_b,
    *hy_pos_w1,*hy_pos_b1,*hy_sin_freq,*hy_pos_w2,*hy_pos_b2,*hy_pos_w3,*hy_decay,*hy_skip,*w_br_hy,*w_br_gla,*w_br_att,*w_out,*router_w,*router_b,*moe_w_gate,*moe_w_up,*moe_w_down;
  float* out;
  float *mod;
  float *hid2S,*hid2C;
  float *tapsS,*tapsC;
  float *nrmS,*nrmC;
  float *rs;
  float *h;
  float *proj;
  float *qn,*kn;
  float *yatt;
  float *laf,*lab;
  float *of,*ob;
  float *ygla;
  float *uc;
  float *z1,*yhy;
  float *m;
  int   *ridx;
  float *rw;
  float *hid;
  float *xc;
};

HD float sigmoidf_(float x) { return 1.f / (1.f + FEXP(-x)); }
HD float siluf_(float x) { return x / (1.f + FEXP(-x)); }
HD float logsigmoidf_(float x) { return x < 0.f ? x - FLOG(1.f + FEXP(x)) : -FLOG(1.f + FEXP(-x)); }

template <class T> HD void st_mod(const NaiveBufs& a, int l, long idx) {
  using d = DD<T>; const int j = (int)(idx % (6 * d::D)), bb = (int)(idx / (6 * d::D));
  const float* cv = bb < d::B ? a.c + (long)bb * d::D : a.c_ctx; const float* w = a.w_mod + (long)l * d::D * 6 * d::D;
  float acc = a.b_mod[(long)l * 6 * d::D + j];
  for (int k = 0; k < d::D; ++k) acc += siluf_(cv[k]) * w[(long)k * 6 * d::D + j];
  a.mod[idx] = acc;
}
template <class T> HD void st_hyhid(const NaiveBufs& a, int l, int which, long idx) {
  using d = DD<T>; const int n = which ? d::C : d::S; float* dst = which ? a.hid2C : a.hid2S;
  const int j = (int)(idx % d::HF), t = (int)(idx / d::HF);
  const float* w1 = a.hy_pos_w1 + (long)l * d::HE * d::HF; const float* b1 = a.hy_pos_b1 + l * d::HF; const float* fr = a.hy_sin_freq + l * d::HF;
  const float* w2 = a.hy_pos_w2 + (long)l * d::HF * d::HF; const float* b2 = a.hy_pos_b2 + l * d::HF;
  const float tn = (float)t / (float)n; const float w0 = 2.f * 3.14159265358979323846f / (float)n;
  float acc2 = b2[j];
  for (int i = 0; i < d::HF; ++i) {
    float acc = b1[i] + tn * w1[0 * d::HF + i];
    for (int bnd = 0; bnd < d::HB; ++bnd) {
      const float band = 1e-4f + (float)bnd * ((float)(d::HB - 1) - 1e-4f) / (float)(d::HB - 1);
      const float ph = w0 * (float)t * band;
      acc += FCOS(ph) * w1[(1 + bnd) * d::HF + i] - FSIN(ph) * w1[(1 + d::HB + bnd) * d::HF + i];
    }
    acc2 += FSIN(fr[i] * acc) * w2[i * d::HF + j];
  }
  dst[idx] = FSIN(fr[j] * acc2);
}
template <class T> HD void st_hytaps(const NaiveBufs& a, int l, int which, long idx) {
  using d = DD<T>; const int n = which ? d::C : d::S; const float* hid2 = which ? a.hid2C : a.hid2S; float* dst = which ? a.tapsC : a.tapsS;
  const int c = (int)(idx % d::HW); const int li = (int)((idx / d::HW) % (2 * n)); const int o = (int)(idx / ((long)d::HW * 2 * n));
  float v = 0.f;
  if (li != n) {
    const int dir = li < n ? 0 : 1; const int t = li < n ? li : 2 * n - li;
    const int col = (o * 2 + dir) * d::HW + c;
    const float* w3 = a.hy_pos_w3 + (long)l * d::HF * 4 * d::HW;
    float acc = 0.f;
    for (int j = 0; j < d::HF; ++j) acc += hid2[(long)t * d::HF + j] * w3[(long)j * 4 * d::HW + col];
    const float dec = fabsf(a.hy_decay[(long)l * 4 * d::HW + col]);
    v = acc * FEXP(-((float)t / (float)n) * dec);
  }
  if (which == 0) dst[((long)o * d::HW + c) * 2 * n + li] = v; else dst[idx] = v;
}
template <class T> HD void st_hynorm(const NaiveBufs& a, int which, long idx) {
  using d = DD<T>; const int n = which ? d::C : d::S; const float* tp = which ? a.tapsC : a.tapsS; float* dst = which ? a.nrmC : a.nrmS;
  const int c = (int)(idx % d::HW), o = (int)(idx / d::HW);
  float s = 0.f; for (int li = 0; li < 2 * n; ++li) s += fabsf(which == 0 ? tp[((long)o * d::HW + c) * 2 * n + li] : tp[((long)o * 2 * n + li) * d::HW + c]);
  dst[idx] = s + 1e-6f;
}

template <class T> HD const float* xrow(const NaiveBufs& a, int l, int b, int r) {
  using d = DD<T>;
  if (r < d::S) return (l == 0 ? a.x : a.out) + ((long)b * d::S + r) * d::D;
  return (l == 0 ? a.ctx : a.xc) + ((long)b * d::C + (r - d::S)) * d::D;
}
template <class T> HD float* xrow_w(const NaiveBufs& a, int b, int r) {
  using d = DD<T>;
  if (r < d::S) return a.out + ((long)b * d::S + r) * d::D;
  return a.xc + ((long)b * d::C + (r - d::S)) * d::D;
}
template <class T> HD void st_rs(const NaiveBufs& a, int l, int b, int src, long idx) {
  using d = DD<T>; const int r = (int)idx; const float* xr = src ? (const float*)xrow_w<T>(a, b, r) : xrow<T>(a, l, b, r);
  float s = 0.f; for (int k = 0; k < d::D; ++k) s += xr[k] * xr[k];
  a.rs[r] = 1.f / sqrtf(s / (float)d::D + 1e-6f);
}
template <class T> HD void st_norm(const NaiveBufs& a, int l, int b, int which, long idx) {
  using d = DD<T>; const int j = (int)(idx % d::D), r = (int)(idx / d::D);
  const float* xr = which ? (const float*)xrow_w<T>(a, b, r) : xrow<T>(a, l, b, r);
  const float* g = (which ? a.norm2_g : a.norm1_g) + (long)l * d::D;
  const float* md = a.mod + (long)(r < d::S ? b : d::B) * 6 * d::D;
  const float shift = md[(which ? 3 : 0) * d::D + j], scale = md[(which ? 4 : 1) * d::D + j];
  a.h[idx] = xr[j] * a.rs[r] * g[j] * (1.f + scale) + shift;
}
struct GemmArgs { const float* A; int lda; const float* W; int ldw; float* Cc; int ldc; int M, N, K;
  const float* gate; int ldg;
  const float* colscale;
  const float* res; int ldr;
  int accumulate; };
HD void st_gemm(const GemmArgs& g, long idx) {
  const int nb = g.N / 4; const int cb = (int)(idx % nb), rb = (int)(idx / nb);
  float acc[4][4];
#pragma unroll
  for (int i = 0; i < 4; ++i) {
#pragma unroll
    for (int j = 0; j < 4; ++j) acc[i][j] = 0.f; }
  const float* a0 = g.A + (long)(rb * 4) * g.lda; const float* w0 = g.W + cb * 4;
  for (int k = 0; k < g.K; ++k) {
    float av[4], wv[4];
#pragma unroll
    for (int i = 0; i < 4; ++i) av[i] = a0[(long)i * g.lda + k];
#pragma unroll
    for (int j = 0; j < 4; ++j) wv[j] = w0[(long)k * g.ldw + j];
#pragma unroll
    for (int i = 0; i < 4; ++i) {
#pragma unroll
      for (int j = 0; j < 4; ++j) acc[i][j] += av[i] * wv[j]; }
  }
#pragma unroll
  for (int i = 0; i < 4; ++i)
#pragma unroll
  for (int j = 0; j < 4; ++j) {
    const int r = rb * 4 + i, c = cb * 4 + j; float v = acc[i][j];
    if (g.gate) v *= sigmoidf_(g.gate[(long)r * g.ldg + c]);
    if (g.colscale) v *= g.colscale[c];
    if (g.res) v += g.res[(long)r * g.ldr + c];
    float* p = g.Cc + (long)r * g.ldc + c;
    if (g.accumulate) v += *p;
    *p = v;
  }
}
template <class T> HD void st_qknorm(const NaiveBufs& a, int l, long idx) {
  using d = DD<T>; const int hh = (int)(idx % (d::AH + d::AKV)), r = (int)(idx / (d::AH + d::AKV));
  const bool isq = hh < d::AH; const int hd = isq ? hh : hh - d::AH;
  const float* src = a.proj + (long)r * d::NIN + (isq ? d::O_AQ : d::O_AK) + hd * d::HDM;
  float* dst = (isq ? a.qn + (long)r * d::AQW : a.kn + (long)r * d::AKVW) + hd * d::HDM;
  const float* g = (isq ? a.q_norm_g : a.k_norm_g) + (long)l * d::HDM;
  float s = 0.f; for (int k = 0; k < d::HDM; ++k) s += src[k] * src[k];
  const float rsq = 1.f / sqrtf(s / (float)d::HDM + 1e-6f);
  if (r < d::S) {
    const int row = r / d::GW, col = r % d::GW;
    for (int p = 0; p < d::HDM / 2; ++p) {
      const int fi = p < d::RP ? p : p - d::RP; const float pos = p < d::RP ? (float)row : (float)col;
      const float inv = FPOW(10000.f, -(float)fi / (float)d::RP); const float ang = pos * inv;
      const float cs = FCOS(ang), sn = FSIN(ang);
      const float x1 = src[2 * p] * rsq * g[2 * p], x2 = src[2 * p + 1] * rsq * g[2 * p + 1];
      dst[2 * p] = x1 * cs - x2 * sn; dst[2 * p + 1] = x1 * sn + x2 * cs;
    }
  } else { for (int k = 0; k < d::HDM; ++k) dst[k] = src[k] * rsq * g[k]; }
}
template <class T, int NSPLIT> HD void st_attn(const NaiveBufs& a, int r0, int nrows, long idx) {
  using d = DD<T>; constexpr int OD = d::HDM / NSPLIT;
  const int r = r0 + (int)(idx % nrows); const int hs = (int)(idx / nrows); const int part = hs % NSPLIT, hq = hs / NSPLIT; const int kv = hq / d::AG;
  const int k0 = r < d::S ? 0 : d::S, k1 = d::R;
  float q[d::HDM], o[OD];
  const float scale = 1.f / sqrtf((float)d::HDM);
#pragma unroll
  for (int k = 0; k < d::HDM; ++k) q[k] = a.qn[(long)r * d::AQW + hq * d::HDM + k] * scale;
#pragma unroll
  for (int k = 0; k < OD; ++k) o[k] = 0.f;
  float mx = -1e30f, lsum = 0.f;
  for (int kk = k0; kk < k1; ++kk) {
    const float* kr = a.kn + (long)kk * d::AKVW + kv * d::HDM;
    float s = 0.f;
#pragma unroll
    for (int k = 0; k < d::HDM; ++k) s += q[k] * kr[k];
    if (s > mx) { const float cr = FEXP(mx - s); lsum *= cr;
#pragma unroll
      for (int k = 0; k < OD; ++k) o[k] *= cr;
      mx = s; }
    const float p = FEXP(s - mx); lsum += p;
    const float* vr = a.proj + (long)kk * d::NIN + d::O_AV + kv * d::HDM + part * OD;
#pragma unroll
    for (int k = 0; k < OD; ++k) o[k] += p * vr[k];
  }
  const float inv = 1.f / lsum;
#pragma unroll
  for (int k = 0; k < OD; ++k) a.yatt[(long)r * d::AQW + hq * d::HDM + part * OD + k] = o[k] * inv;
}
template <class T> HD void st_glala(const NaiveBufs& a, int l, long idx) {
  using d = DD<T>; const int j = (int)(idx % d::GKW); const int dir = (int)((idx / d::GKW) % 2); const int r = (int)(idx / (2 * d::GKW));
  const float* al = a.proj + (long)r * d::NIN + d::O_GA + dir * d::GR;
  const float* w2 = a.gla_wa2 + ((long)l * 2 + dir) * d::GR * d::GKW; float z = a.gla_ba[((long)l * 2 + dir) * d::GKW + j];
  for (int k = 0; k < d::GR; ++k) z += al[k] * w2[(long)k * d::GKW + j];
  (dir ? a.lab : a.laf)[(long)r * d::GKW + j] = FEXP(logsigmoidf_(z) / 16.f);
}
template <class T> HD void st_glascan(const NaiveBufs& a, long idx) {
  using d = DD<T>; const int v = (int)(idx % d::GDV); const int hd = (int)((idx / d::GDV) % d::GH); const int dir = (int)(idx / (d::GDV * d::GH));
  float st[d::GDK];
#pragma unroll
  for (int k = 0; k < d::GDK; ++k) st[k] = 0.f;
  const float qs = 1.f / sqrtf((float)d::GDK);
  const float* la = dir ? a.lab : a.laf; float* od = dir ? a.ob : a.of;
  for (int step = 0; step < d::R; ++step) {
    int r;
    if (step < d::C) r = d::S + (dir ? d::C - 1 - step : step); else r = dir ? d::S - 1 - (step - d::C) : step - d::C;
    const float* pr = a.proj + (long)r * d::NIN;
    const float vv = pr[d::O_GV + hd * d::GDV + v];
    float o = 0.f;
#pragma unroll
    for (int k = 0; k < d::GDK; ++k) {
      st[k] = la[(long)r * d::GKW + hd * d::GDK + k] * st[k] + pr[d::O_GK + hd * d::GDK + k] * vv;
      o += pr[d::O_GQ + hd * d::GDK + k] * qs * st[k];
    }
    od[(long)r * d::GVW + hd * d::GDV + v] = o;
  }
}
template <class T> HD void st_glaout(const NaiveBufs& a, int l, long idx) {
  using d = DD<T>; const int hd = (int)(idx % d::GH), r = (int)(idx / d::GH);
  const long base = (long)r * d::GVW + hd * d::GDV; float s = 0.f;
  for (int v = 0; v < d::GDV; ++v) { const float o = a.of[base + v] + a.ob[base + v]; s += o * o; }
  const float rsq = 1.f / sqrtf(s / (float)d::GDV + 1e-6f);
  for (int v = 0; v < d::GDV; ++v) { const float o = a.of[base + v] + a.ob[base + v];
    a.ygla[base + v] = o * rsq * a.gla_norm_g[(long)l * d::GDV + v] * siluf_(a.proj[(long)r * d::NIN + d::O_OG + hd * d::GDV + v]); }
}
template <class T> HD void st_hyconv3(const NaiveBufs& a, int l, long idx) {
  using d = DD<T>; const int j = (int)(idx % (3 * d::HW)), r = (int)(idx / (3 * d::HW));
  const int lo = r < d::S ? 0 : d::S, hi = r < d::S ? d::S : d::R;
  const float* w = a.hy_conv_w + (long)l * 3 * 3 * d::HW;
  float v = a.hy_conv_b[(long)l * 3 * d::HW + j] + a.proj[(long)r * d::NIN + d::O_HY + j] * w[1 * 3 * d::HW + j];
  if (r - 1 >= lo) v += a.proj[(long)(r - 1) * d::NIN + d::O_HY + j] * w[0 * 3 * d::HW + j];
  if (r + 1 < hi) v += a.proj[(long)(r + 1) * d::NIN + d::O_HY + j] * w[2 * 3 * d::HW + j];
  a.uc[idx] = v;
}
template <class T> HD void st_hylong(const NaiveBufs& a, int l, int o, long idx) {
  using d = DD<T>; const int c = (int)(idx % d::HW); const int rb = (int)(idx / d::HW); const int r0 = rb * 4;
  const bool lat = r0 < d::S; const int n = lat ? d::S : d::C; const int base = lat ? 0 : d::S; const int t0 = r0 - base;
  const float* tp = (lat ? a.tapsS : a.tapsC) + (long)o * 2 * n * d::HW + c; const float nr = (lat ? a.nrmS : a.nrmC)[o * d::HW + c];
  const float* zs = o == 0 ? a.uc + 2 * d::HW + c : a.z1 + c; const int ldz = o == 0 ? 3 * d::HW : d::HW;
  float acc0 = 0.f, acc1 = 0.f, acc2 = 0.f, acc3 = 0.f;
  auto tap = [&](int lag) { const int li = lag >= 0 ? lag : 2 * n + lag; return tp[(long)li * d::HW]; };
  float w0 = tap(t0), w1 = tap(t0 + 1), w2 = tap(t0 + 2), w3 = tap(t0 + 3);
  for (int s = 0; s < n; ++s) {
    const float zv = zs[(long)(base + s) * ldz];
    acc0 += w0 * zv; acc1 += w1 * zv; acc2 += w2 * zv; acc3 += w3 * zv;
    w3 = w2; w2 = w1; w1 = w0; w0 = (s + 1 < n) ? tap(t0 - s - 1) : 0.f;
  }
  const float sk = a.hy_skip[((long)l * 2 + o) * d::HW + c];
  float* dst = o == 0 ? a.z1 : a.yhy;
  const float accs[4] = {acc0, acc1, acc2, acc3};
#pragma unroll
  for (int i = 0; i < 4; ++i) { const int r = r0 + i; const float zr = zs[(long)r * ldz];
    dst[(long)r * d::HW + c] = a.uc[(long)r * 3 * d::HW + o * d::HW + c] * (accs[i] / nr + sk * zr); }
}
template <class T> HD void st_router(const NaiveBufs& a, long idx) {
  using d = DD<T>; const int r = (int)idx; const float* hr = a.h + (long)r * d::D;
  float sc[d::NE], sel[d::NE];
#pragma unroll
  for (int e = 0; e < d::NE; ++e) sc[e] = 0.f;
  for (int k = 0; k < d::D; ++k) { const float hv = hr[k];
#pragma unroll
    for (int e = 0; e < d::NE; ++e) sc[e] += hv * a.router_w[(long)k * d::NE + e]; }
#pragma unroll
  for (int e = 0; e < d::NE; ++e) { sc[e] = sigmoidf_(sc[e]); sel[e] = sc[e] + a.router_b[e]; }
  int bestg = 0; float bestgs = -1e30f;
#pragma unroll
  for (int g = 0; g < d::NG; ++g) { float m1 = -1e30f, m2 = -1e30f;
#pragma unroll
    for (int i = 0; i < d::EPG; ++i) { const float v = sel[g * d::EPG + i]; if (v > m1) { m2 = m1; m1 = v; } else if (v > m2) m2 = v; }
    const float gs = m1 + m2; if (gs > bestgs) { bestgs = gs; bestg = g; } }
  int i1 = -1, i2 = -1; float v1 = -1e30f, v2 = -1e30f, s1 = 0.f, s2 = 0.f;
#pragma unroll
  for (int e = 0; e < d::NE; ++e) { if (e / d::EPG == bestg) { const float v = sel[e];
      if (v > v1) { v2 = v1; i2 = i1; s2 = s1; v1 = v; i1 = e; s1 = sc[e]; } else if (v > v2) { v2 = v; i2 = e; s2 = sc[e]; } } }
  const float inv = 1.f / (s1 + s2);
  a.ridx[2 * r] = i1; a.ridx[2 * r + 1] = i2; a.rw[2 * r] = s1 * inv; a.rw[2 * r + 1] = s2 * inv;
}
template <class T> HD void st_moehid(const NaiveBufs& a, int l, long idx) {
  using d = DD<T>; const int j = (int)(idx % d::DE); const int k = (int)((idx / d::DE) % 2); const int r = (int)(idx / (2 * d::DE));
  const int e = a.ridx[2 * r + k]; const float* hr = a.h + (long)r * d::D;
  const float* wg = a.moe_w_gate + (((long)l * d::NE + e) * d::D) * d::DE + j; const float* wu = a.moe_w_up + (((long)l * d::NE + e) * d::D) * d::DE + j;
  float g = 0.f, u = 0.f;
  for (int i = 0; i < d::D; ++i) { const float hv = hr[i]; g += hv * wg[(long)i * d::DE]; u += hv * wu[(long)i * d::DE]; }
  a.hid[idx] = siluf_(g) * u;
}
template <class T> HD void st_moeout(const NaiveBufs& a, int l, int b, long idx) {
  using d = DD<T>; const int dd = (int)(idx % d::D), r = (int)(idx / d::D);
  float acc = 0.f;
  for (int k = 0; k < 2; ++k) { const int e = a.ridx[2 * r + k]; const float* hk = a.hid + ((long)r * 2 + k) * d::DE;
    const float* wd = a.moe_w_down + (((long)l * d::NE + e) * d::DE) * d::D + dd; float s = 0.f;
    for (int j = 0; j < d::DE; ++j) s += hk[j] * wd[(long)j * d::D];
    acc += a.rw[2 * r + k] * s; }
  const float g2 = a.mod[(long)(r < d::S ? b : d::B) * 6 * d::D + 5 * d::D + dd];
  float* xr = xrow_w<T>(a, b, r); xr[dd] += g2 * acc;
}
enum { L_MOD = 0, L_HID_S, L_HID_C, L_TAPS_S, L_TAPS_C, L_NRM_S, L_NRM_C, N_LSTAGES,
       P_RS1 = 16, P_NORM1, P_INPROJ, P_QKNORM, P_ATTN_L, P_ATTN_C, P_GLALA, P_GLASCAN, P_GLAOUT, P_HYC3, P_HYL0, P_HYL1,
       P_MRG_HY, P_MRG_GLA, P_MRG_ATT, P_OUT_L, P_OUT_C, P_RS2, P_NORM2, P_ROUTER, P_MOEHID, P_MOEOUT, P_END };
constexpr int ATT_NSPLIT = 4;

template <class T> HD long stage_items(int st, int l) {
  using d = DD<T>; const bool last = (l == d::DEPTH - 1);
  switch (st) {
    case L_MOD: return (long)(d::B + 1) * 6 * d::D;
    case L_HID_S: return (long)d::S * d::HF;
    case L_HID_C: return (long)d::C * d::HF;
    case L_TAPS_S: return 2L * 2 * d::S * d::HW;
    case L_TAPS_C: return 2L * 2 * d::C * d::HW;
    case L_NRM_S: case L_NRM_C: return 2L * d::HW;
    case P_RS1: case P_RS2: case P_ROUTER: return d::R;
    case P_NORM1: case P_NORM2: return (long)d::R * d::D;
    case P_INPROJ: return (long)(d::R / 4) * (d::NIN / 4);
    case P_QKNORM: return (long)d::R * (d::AH + d::AKV);
    case P_ATTN_L: return (long)d::S * d::AH * ATT_NSPLIT;
    case P_ATTN_C: return last ? 0 : (long)d::C * d::AH * ATT_NSPLIT;
    case P_GLALA: return (long)d::R * 2 * d::GKW;
    case P_GLASCAN: return 2L * d::GH * d::GDV;
    case P_GLAOUT: return (long)d::R * d::GH;
    case P_HYC3: return (long)d::R * 3 * d::HW;
    case P_HYL0: case P_HYL1: return (long)(d::R / 4) * d::HW;
    case P_MRG_HY: case P_MRG_GLA: case P_MRG_ATT: return (long)(d::R / 4) * (d::D / 4);
    case P_OUT_L: return (long)(d::S / 4) * (d::D / 4);
    case P_OUT_C: return last ? 0 : (long)(d::C / 4) * (d::D / 4);
    case P_MOEHID: return (long)d::R * 2 * d::DE;
    case P_MOEOUT: return (long)(last ? d::S : d::R) * d::D;
  }
  return 0;
}

template <class T, int ST> HD void stage_run(const NaiveBufs& a, int l, int b, long idx) {
  using d = DD<T>;
  if constexpr (ST == L_MOD) st_mod<T>(a, l, idx);
  else if constexpr (ST == L_HID_S) st_hyhid<T>(a, l, 0, idx);
  else if constexpr (ST == L_HID_C) st_hyhid<T>(a, l, 1, idx);
  else if constexpr (ST == L_TAPS_S) st_hytaps<T>(a, l, 0, idx);
  else if constexpr (ST == L_TAPS_C) st_hytaps<T>(a, l, 1, idx);
  else if constexpr (ST == L_NRM_S) st_hynorm<T>(a, 0, idx);
  else if constexpr (ST == L_NRM_C) st_hynorm<T>(a, 1, idx);
  else if constexpr (ST == P_RS1) st_rs<T>(a, l, b, 0, idx);
  else if constexpr (ST == P_RS2) st_rs<T>(a, l, b, 1, idx);
  else if constexpr (ST == P_NORM1) st_norm<T>(a, l, b, 0, idx);
  else if constexpr (ST == P_NORM2) st_norm<T>(a, l, b, 1, idx);
  else if constexpr (ST == P_INPROJ) { GemmArgs g{a.h, d::D, a.w_in + (long)l * d::D * d::NIN, d::NIN, a.proj, d::NIN, d::R, d::NIN, d::D, nullptr, 0, nullptr, nullptr, 0, 0}; st_gemm(g, idx); }
  else if constexpr (ST == P_QKNORM) st_qknorm<T>(a, l, idx);
  else if constexpr (ST == P_ATTN_L) st_attn<T, ATT_NSPLIT>(a, 0, d::S, idx);
  else if constexpr (ST == P_ATTN_C) st_attn<T, ATT_NSPLIT>(a, d::S, d::C, idx);
  else if constexpr (ST == P_GLALA) st_glala<T>(a, l, idx);
  else if constexpr (ST == P_GLASCAN) st_glascan<T>(a, idx);
  else if constexpr (ST == P_GLAOUT) st_glaout<T>(a, l, idx);
  else if constexpr (ST == P_HYC3) st_hyconv3<T>(a, l, idx);
  else if constexpr (ST == P_HYL0) st_hylong<T>(a, l, 0, idx);
  else if constexpr (ST == P_HYL1) st_hylong<T>(a, l, 1, idx);
  else if constexpr (ST == P_MRG_HY) { GemmArgs g{a.yhy, d::HW, a.w_br_hy + (long)l * d::HW * d::D, d::D, a.m, d::D, d::R, d::D, d::HW, a.proj + d::O_BR, d::NIN, nullptr, nullptr, 0, 0}; st_gemm(g, idx); }
  else if constexpr (ST == P_MRG_GLA) { GemmArgs g{a.ygla, d::GVW, a.w_br_gla + (long)l * d::GVW * d::D, d::D, a.m, d::D, d::R, d::D, d::GVW, a.proj + d::O_BR + d::D, d::NIN, nullptr, nullptr, 0, 1}; st_gemm(g, idx); }
  else if constexpr (ST == P_MRG_ATT) { GemmArgs g{a.yatt, d::AQW, a.w_br_att + (long)l * d::AQW * d::D, d::D, a.m, d::D, d::R, d::D, d::AQW, a.proj + d::O_BR + 2 * d::D, d::NIN, nullptr, nullptr, 0, 1}; st_gemm(g, idx); }
  else if constexpr (ST == P_OUT_L) { const float* res = (l == 0 ? a.x : (const float*)a.out) + (long)b * d::S * d::D;
    GemmArgs g{a.m, d::D, a.w_out + (long)l * d::D * d::D, d::D, a.out + (long)b * d::S * d::D, d::D, d::S, d::D, d::D, nullptr, 0, a.mod + (long)b * 6 * d::D + 2 * d::D, res, d::D, 0}; st_gemm(g, idx); }
  else if constexpr (ST == P_OUT_C) { const float* res = (l == 0 ? a.ctx : (const float*)a.xc) + (long)b * d::C * d::D;
    GemmArgs g{a.m + (long)d::S * d::D, d::D, a.w_out + (long)l * d::D * d::D, d::D, a.xc + (long)b * d::C * d::D, d::D, d::C, d::D, d::D, nullptr, 0, a.mod + (long)d::B * 6 * d::D + 2 * d::D, res, d::D, 0}; st_gemm(g, idx); }
  else if constexpr (ST == P_ROUTER) st_router<T>(a, idx);
  else if constexpr (ST == P_MOEHID) st_moehid<T>(a, l, idx);
  else if constexpr (ST == P_MOEOUT) st_moeout<T>(a, l, b, idx);
}

template <class T> inline size_t carve(NaiveBufs& a, float* ws) {
  using d = DD<T>; size_t o = 0; auto take = [&](size_t n) { float* p = ws ? ws + o : nullptr; o += (n + 63) & ~(size_t)63; return p; };
  a.mod = take((size_t)(d::B + 1) * 6 * d::D);
  a.hid2S = take((size_t)d::S * d::HF); a.hid2C = take((size_t)d::C * d::HF);
  a.tapsS = take((size_t)2 * 2 * d::S * d::HW); a.tapsC = take((size_t)2 * 2 * d::C * d::HW);
  a.nrmS = take(2 * d::HW); a.nrmC = take(2 * d::HW);
  a.rs = take(d::R); a.h = take((size_t)d::R * d::D); a.proj = take((size_t)d::R * d::NIN);
  a.qn = take((size_t)d::R * d::AQW); a.kn = take((size_t)d::R * d::AKVW);
  a.uc = take((size_t)d::R * 3 * d::HW); a.z1 = take((size_t)d::R * d::HW); a.yhy = take((size_t)d::R * d::HW);
  a.xc = take((size_t)d::B * d::C * d::D);
#ifdef HOST_TEST
  a.yatt = take((size_t)d::R * d::AQW); a.laf = take((size_t)d::R * d::GKW); a.lab = take((size_t)d::R * d::GKW);
  a.of = take((size_t)d::R * d::GVW); a.ob = take((size_t)d::R * d::GVW); a.ygla = take((size_t)d::R * d::GVW);
  a.m = take((size_t)d::R * d::D); a.ridx = (int*)take((size_t)d::R * 2); a.rw = take((size_t)d::R * 2); a.hid = take((size_t)d::R * 2 * d::DE);
#endif
  return o;
}
template <class T> inline void set_inputs(NaiveBufs& a, const float* const* in) {
  int i = 0;
  a.x = in[i++]; a.c = in[i++]; a.ctx = in[i++]; a.c_ctx = in[i++]; a.w_mod = in[i++]; a.b_mod = in[i++]; a.norm1_g = in[i++]; a.norm2_g = in[i++];
  a.w_in = in[i++]; a.q_norm_g = in[i++]; a.k_norm_g = in[i++]; a.gla_wa2 = in[i++]; a.gla_ba = in[i++]; a.gla_norm_g = in[i++];
  a.hy_conv_w = in[i++]; a.hy_conv_b = in[i++]; a.hy_pos_w1 = in[i++]; a.hy_pos_b1 = in[i++]; a.hy_sin_freq = in[i++]; a.hy_pos_w2 = in[i++];
  a.hy_pos_b2 = in[i++]; a.hy_pos_w3 = in[i++]; a.hy_decay = in[i++]; a.hy_skip = in[i++]; a.w_br_hy = in[i++]; a.w_br_gla = in[i++];
  a.w_br_att = in[i++]; a.w_out = in[i++]; a.router_w = in[i++]; a.router_b = in[i++]; a.moe_w_gate = in[i++]; a.moe_w_up = in[i++]; a.moe_w_down = in[i++];
}

#define LSTAGES(X) X(L_MOD) X(L_HID_S) X(L_HID_C) X(L_TAPS_S) X(L_TAPS_C) X(L_NRM_S) X(L_NRM_C)
#define PSTAGES(X) X(P_RS1) X(P_NORM1) X(P_INPROJ) X(P_QKNORM) X(P_ATTN_L) X(P_ATTN_C) X(P_GLALA) X(P_GLASCAN) X(P_GLAOUT) X(P_HYC3) X(P_HYL0) X(P_HYL1) \
  X(P_MRG_HY) X(P_MRG_GLA) X(P_MRG_ATT) X(P_OUT_L) X(P_OUT_C) X(P_RS2) X(P_NORM2) X(P_ROUTER) X(P_MOEHID) X(P_MOEOUT)
namespace pro {
__device__ __forceinline__ void mod_phase(const NaiveBufs& a, int l, LAS unsigned char* lds) {
  int tz = threadIdx.x; asm volatile("" : "+v"(tz));
  __syncthreads();
  LAS float* sl = (LAS float*)lds; LAS float* part = sl + 9 * 1024;
  for (int e = tz; e < 9 * 1024; e += NTHREADS) { const int bb = e >> 10, k = e & 1023; const float cv = bb < 8 ? a.c[bb * 1024 + k] : a.c_ctx[k]; sl[e] = cv / (1.f + __expf(-cv)); }
  __syncthreads();
  const float* w = a.w_mod + (size_t)l * 1024 * 6144;
  const int jl = tz & 63, ks = tz >> 6;
  for (int cb = blockIdx.x; cb < 96; cb += gridDim.x) { const int j = cb * 64 + jl; float acc[9];
#pragma unroll
    for (int q = 0; q < 9; ++q) acc[q] = 0.f;
#pragma unroll 4
    for (int k = ks * 128; k < ks * 128 + 128; ++k) { const float wv = w[(size_t)k * 6144 + j];
#pragma unroll
      for (int q = 0; q < 9; ++q) acc[q] += sl[q * 1024 + k] * wv; }
#pragma unroll
    for (int q = 0; q < 9; ++q) part[(ks * 9 + q) * 64 + jl] = acc[q];
    __syncthreads();
    for (int e = tz; e < 9 * 64; e += NTHREADS) { const int q = e >> 6, jj = e & 63; float s = a.b_mod[(size_t)l * 6144 + cb * 64 + jj];
#pragma unroll
      for (int k8 = 0; k8 < 8; ++k8) s += part[(k8 * 9 + q) * 64 + jj];
      a.mod[(size_t)q * 6144 + cb * 64 + jj] = s; }
    __syncthreads(); }
  __syncthreads();
}
__device__ __forceinline__ void hid_phase(const NaiveBufs& a, int l, int n, float* dst, LAS unsigned char* lds) {
  int tz = threadIdx.x; asm volatile("" : "+v"(tz));
  LAS float* Z = (LAS float*)(lds + 40960); LAS float* H1 = Z + 8 * 36;
  const float* w1 = a.hy_pos_w1 + (size_t)l * 33 * 64; const float* b1 = a.hy_pos_b1 + l * 64; const float* fr = a.hy_sin_freq + l * 64;
  const float* w2 = a.hy_pos_w2 + (size_t)l * 64 * 64; const float* b2 = a.hy_pos_b2 + l * 64;
  const float w0 = 2.f * 3.14159265358979323846f / (float)n;
  for (int t0 = blockIdx.x * 8; t0 < n; t0 += gridDim.x * 8) {
    if (tz < 8 * 33) { const int tt = tz / 33, e = tz % 33, t = t0 + tt; float v;
      if (e == 0) v = (float)t / (float)n; else { const int bnd = (e - 1) & 15; const float band = 1e-4f + (float)bnd * (15.f - 1e-4f) / 15.f; const float ph = w0 * (float)t * band; v = e <= 16 ? cosf(ph) : -sinf(ph); }
      Z[tt * 36 + e] = v; }
    __syncthreads();
    { const int tt = tz >> 6, i = tz & 63; float acc = b1[i];
#pragma unroll
      for (int e = 0; e < 33; ++e) acc += Z[tt * 36 + e] * w1[e * 64 + i];
      H1[tt * 64 + i] = sinf(fr[i] * acc); }
    __syncthreads();
    { const int tt = tz >> 6, j = tz & 63; float acc = b2[j];
#pragma unroll 8
      for (int i = 0; i < 64; ++i) acc += H1[tt * 64 + i] * w2[i * 64 + j];
      if (t0 + tt < n) dst[(size_t)(t0 + tt) * 64 + j] = sinf(fr[j] * acc); }
    __syncthreads();
  }
}
__device__ __forceinline__ void nrmS_phase(const NaiveBufs& a) {
  int tz = threadIdx.x; asm volatile("" : "+v"(tz)); const int lane = tz & 63, wave = __builtin_amdgcn_readfirstlane(tz >> 6);
  for (int oc = blockIdx.x * NWAVES + wave; oc < 1024; oc += gridDim.x * NWAVES) { const float* tp = a.tapsS + (size_t)oc * 8192; float s = 0.f;
#pragma unroll 8
    for (int k = lane; k < 8192; k += 64) s += fabsf(tp[k]);
    s = moe::wave_sum(s); if (lane == 0) a.nrmS[oc] = s + 1e-6f; }
}
constexpr int TCOPY = 8232;
__device__ __forceinline__ void tapsB_phase(const NaiveBufs& a, int l, bf16_t* tapsB, LAS unsigned char* lds) {
  int tz = threadIdx.x; asm volatile("" : "+v"(tz));
  const float* w3 = a.hy_pos_w3 + (size_t)l * 64 * 2048; const float* dcy = a.hy_decay + (size_t)l * 2048;
  typedef float f4 __attribute__((ext_vector_type(4)));
  LAS float* W = (LAS float*)lds;
  for (int cp = blockIdx.x; cp < 256; cp += gridDim.x) {
    __syncthreads();
    { const int ch = tz >> 8, e = tz & 255, c = cp + 256 * ch; W[tz] = w3[(size_t)(e >> 2) * 2048 + (e & 3) * 512 + c]; if (tz < 8) W[512 + tz] = fabsf(dcy[(tz & 3) * 512 + cp + 256 * (tz >> 2)]); }
    __syncthreads();
    for (int t = tz; t < 4096; t += NTHREADS) {
      const f4* h2 = (const f4*)(a.hid2S + (size_t)t * 64); f4 acc0 = {0.f, 0.f, 0.f, 0.f}, acc1 = {0.f, 0.f, 0.f, 0.f};
#pragma unroll 4
      for (int j4 = 0; j4 < 16; ++j4) { const f4 h = h2[j4];
#pragma unroll
        for (int e = 0; e < 4; ++e) { acc0 += h[e] * *(const LAS f4*)(W + (4 * j4 + e) * 4); acc1 += h[e] * *(const LAS f4*)(W + 256 + (4 * j4 + e) * 4); } }
      const float tn = (float)t * (1.f / 4096.f);
#pragma unroll
      for (int ch = 0; ch < 2; ++ch)
#pragma unroll
        for (int q = 0; q < 4; ++q) { const int o = q >> 1, dir = q & 1; if (dir == 1 && t == 0) continue; const int c = cp + 256 * ch;
          const bf16_t bv = (bf16_t)f2bf((ch ? acc1[q] : acc0[q]) * __expf(-tn * W[512 + 4 * ch + q]));
          bf16_t* base = tapsB + ((size_t)o * 512 + c) * 2 * TCOPY; const int x0 = dir ? 4096 + t : 4096 - t;
          base[x0] = bv; base[TCOPY + x0 - 1] = bv; } } }
  for (long idx = (long)blockIdx.x * NTHREADS + tz; idx < 1024L * 96; idx += (long)gridDim.x * NTHREADS) { const int oc = (int)(idx / 96), e = (int)(idx % 96); bf16_t* base = tapsB + (size_t)oc * 2 * TCOPY;
    if (e < 40) base[8192 + e] = 0; else if (e < 81) base[TCOPY + 8191 + (e - 40)] = 0; else if (e == 81) base[0] = 0; }
}
__device__ __forceinline__ void nrmB_phase(const NaiveBufs& a, const bf16_t* tapsB) {
  int tz = threadIdx.x; asm volatile("" : "+v"(tz)); const int lane = tz & 63, wave = __builtin_amdgcn_readfirstlane(tz >> 6);
  for (int oc = blockIdx.x * NWAVES + wave; oc < 1024; oc += gridDim.x * NWAVES) { const bf16_t* tp = tapsB + (size_t)oc * 2 * TCOPY; float s = 0.f;
#pragma unroll 8
    for (int k = lane; k < 8192; k += 64) s += fabsf(bf2f(tp[k]));
    s = moe::wave_sum(s); if (lane == 0) a.nrmS[oc] = s + 1e-6f; }
}
}
using TD = FullDims;
using dd = DD<TD>;
constexpr int GB = 4, NGRP = 2, RB = dd::R  , RG = GB * RB, PLD = dd::O_BR + 1536  , PANELS = RG / 256, PPB = RB / 256  ;
constexpr size_t BAR_BYTES = 16384 + 4 * 4096; constexpr int CNT_OFF = 16384;
constexpr int MPG = 38912;
constexpr size_t CS_BYTES = (size_t)2 * 4 * 68 * 64 * 128 * 2, DEC_BYTES = (size_t)2 * 4 * 68 * 64 * 4;
constexpr size_t UCT_BYTES = (size_t)1536 * 4096 * 2, YT_BYTES = (size_t)512 * 4096 * 2, UCC_BYTES = (size_t)256 * 1536 * 4, Z1C_BYTES = (size_t)256 * 512 * 4;
constexpr size_t MIX_BYTES = GB * (CS_BYTES + DEC_BYTES) > GB * (UCT_BYTES + YT_BYTES + UCC_BYTES + Z1C_BYTES) ? GB * (CS_BYTES + DEC_BYTES) : GB * (UCT_BYTES + YT_BYTES + UCC_BYTES + Z1C_BYTES);

struct KArgs { NaiveBufs a; unsigned* bar; int* cnt; bf16_t *WgaT; bf16_t *WinT, *WhyT, *WglaT, *WattT, *WoutT, *WguT, *WdT, *hb, *proj; unsigned char* mix;
  bf16_t *hp, *hid, *contrib; int* srcrow; float* wgt; moe::Route* route; float* wts; };

struct EpiProjBf16 {
  static constexpr bool PERM = true, AFTER_DRAIN = false;
  bf16_t* P;
  __device__ __forceinline__ void operator()(const pg8::f32x4 (&acc)[2][2][4][2], const pg8::Unit& u, int wr, int wc, int fr, int fq) const {
    const int row0 = u.pm * 256 + wr * 64 + fr, col0 = u.pn * 256 + wc * 32 + 8 * fq;
    const int cr0 = col0 + (col0 >= dd::O_GA ? 32 : 0), cr1 = col0 + 128 + (col0 + 128 >= dd::O_GA ? 32 : 0);
    if (u.pn >= (dd::O_BR - 32) / 256) {
      unsigned char* Pg = (unsigned char*)P + (size_t)dd::O_BR * 2 + (col0 - (dd::O_BR - 32));
#pragma unroll
      for (int ai = 0; ai < 2; ++ai)
#pragma unroll
        for (int m = 0; m < 4; ++m) { unsigned char* rowp = Pg + (size_t)(row0 + ai * 128 + m * 16) * (PLD * 2);
#pragma unroll
          for (int bj = 0; bj < 2; ++bj) { const pg8::f32x4 v0 = acc[ai][bj][m][0], v1 = acc[ai][bj][m][1]; uint2 o;
            o.x = (unsigned)(fsigmoid(v0[0]) * 255.f + 0.5f) | ((unsigned)(fsigmoid(v0[1]) * 255.f + 0.5f) << 8) | ((unsigned)(fsigmoid(v0[2]) * 255.f + 0.5f) << 16) | ((unsigned)(fsigmoid(v0[3]) * 255.f + 0.5f) << 24);
            o.y = (unsigned)(fsigmoid(v1[0]) * 255.f + 0.5f) | ((unsigned)(fsigmoid(v1[1]) * 255.f + 0.5f) << 8) | ((unsigned)(fsigmoid(v1[2]) * 255.f + 0.5f) << 16) | ((unsigned)(fsigmoid(v1[3]) * 255.f + 0.5f) << 24);
            *(uint2*)(rowp + bj * 128) = o; } }
      return; }
#pragma unroll
    for (int ai = 0; ai < 2; ++ai)
#pragma unroll
      for (int m = 0; m < 4; ++m) { bf16_t* rowp = P + (size_t)(row0 + ai * 128 + m * 16) * PLD;
#pragma unroll
        for (int bj = 0; bj < 2; ++bj) { const pg8::f32x4 v0 = acc[ai][bj][m][0], v1 = acc[ai][bj][m][1];
          v4u o; o.x = pk2(v0[0], v0[1]); o.y = pk2(v0[2], v0[3]); o.z = pk2(v1[0], v1[1]); o.w = pk2(v1[2], v1[3]); *(v4u*)(rowp + (bj ? cr1 : cr0)) = o; } }
  }
};
template <bool ACCUM> struct EpiMergeB {
  static constexpr bool PERM = true, AFTER_DRAIN = false;
  const bf16_t* gate; bf16_t* M;
  __device__ __forceinline__ void operator()(const pg8::f32x4 (&acc)[2][2][4][2], const pg8::Unit& u, int wr, int wc, int fr, int fq) const {
    const int row0 = u.pm * 256 + wr * 64 + fr, col0 = u.pn * 256 + wc * 32 + 8 * fq;
#pragma unroll
    for (int ai2 = 0; ai2 < 4; ++ai2) { const int ai = ai2 >> 1, m0 = (ai2 & 1) * 2;
      v4u gw[4][2], mo[4][2];
#pragma unroll
      for (int m = m0; m < m0 + 2; ++m)
#pragma unroll
        for (int bj = 0; bj < 2; ++bj) { const size_t r = (size_t)(row0 + ai * 128 + m * 16); const int c = col0 + bj * 128; gw[m][bj] = *(const v4u*)(gate + r * PLD + c); if (ACCUM) mo[m][bj] = *(const v4u*)(M + r * 1024 + c); }
#pragma unroll
      for (int m = m0; m < m0 + 2; ++m)
#pragma unroll
        for (int bj = 0; bj < 2; ++bj) { const size_t r = (size_t)(row0 + ai * 128 + m * 16); const int c = col0 + bj * 128; const v4u g4 = gw[m][bj];
          pg8::f32x4 v0 = acc[ai][bj][m][0], v1 = acc[ai][bj][m][1];
          v0[0] *= fsigmoid(bf2f(g4.x & 0xffff)); v0[1] *= fsigmoid(bf2f(g4.x >> 16)); v0[2] *= fsigmoid(bf2f(g4.y & 0xffff)); v0[3] *= fsigmoid(bf2f(g4.y >> 16));
          v1[0] *= fsigmoid(bf2f(g4.z & 0xffff)); v1[1] *= fsigmoid(bf2f(g4.z >> 16)); v1[2] *= fsigmoid(bf2f(g4.w & 0xffff)); v1[3] *= fsigmoid(bf2f(g4.w >> 16));
          if (ACCUM) { const v4u o = mo[m][bj]; v0[0] += bf2f(o.x & 0xffff); v0[1] += bf2f(o.x >> 16); v0[2] += bf2f(o.y & 0xffff); v0[3] += bf2f(o.y >> 16);
            v1[0] += bf2f(o.z & 0xffff); v1[1] += bf2f(o.z >> 16); v1[2] += bf2f(o.w & 0xffff); v1[3] += bf2f(o.w >> 16); }
          v4u o2; o2.x = pk2(v0[0], v0[1]); o2.y = pk2(v0[2], v0[3]); o2.z = pk2(v1[0], v1[1]); o2.w = pk2(v1[2], v1[3]); *(v4u*)(M + r * 1024 + c) = o2; } }
  }
};
struct EpiOutG {
  static constexpr bool PERM = false, AFTER_DRAIN = false;
  const float* resL; float* outL; const float* resC; float* outC; const float* mod; int b0; bool ctx_on;
  __device__ __forceinline__ void operator()(const pg8::f32x4 (&acc)[2][2][4][2], const pg8::Unit& u, int wr, int wc, int fr, int fq) const {
    const int bl = u.pm / PPB, lp = u.pm % PPB; const bool isc = lp == PPB - 1; if (isc && !ctx_on) return;
    const int b = b0 + bl;
    const float* res = isc ? resC + (size_t)b * dd::C * 1024 : resL + ((size_t)b * dd::S + lp * 256) * 1024;
    float* out = isc ? outC + (size_t)b * dd::C * 1024 : outL + ((size_t)b * dd::S + lp * 256) * 1024;
    const float* gv = mod + (size_t)(isc ? dd::B : b) * 6 * 1024 + 2 * 1024;
    const int row0 = wr * 64 + fr, col0 = u.pn * 256 + wc * 32 + 4 * fq;
    pg8::f32x4 gg[2][2];
#pragma unroll
    for (int bj = 0; bj < 2; ++bj)
#pragma unroll
      for (int n = 0; n < 2; ++n) gg[bj][n] = *(const pg8::f32x4*)(gv + col0 + bj * 128 + n * 16);
#pragma unroll
    for (int ai2 = 0; ai2 < 4; ++ai2) { const int ai = ai2 >> 1, m0 = (ai2 & 1) * 2;
      pg8::f32x4 rv[4][2][2];
#pragma unroll
      for (int m = m0; m < m0 + 2; ++m)
#pragma unroll
        for (int bj = 0; bj < 2; ++bj)
#pragma unroll
          for (int n = 0; n < 2; ++n) rv[m][bj][n] = *(const pg8::f32x4*)(res + (size_t)(row0 + ai * 128 + m * 16) * 1024 + col0 + bj * 128 + n * 16);
#pragma unroll
      for (int m = m0; m < m0 + 2; ++m)
#pragma unroll
        for (int bj = 0; bj < 2; ++bj)
#pragma unroll
          for (int n = 0; n < 2; ++n) *(pg8::f32x4*)(out + (size_t)(row0 + ai * 128 + m * 16) * 1024 + col0 + bj * 128 + n * 16) = rv[m][bj][n] + gg[bj][n] * acc[ai][bj][m][n]; }
  }
};
struct GroupOrder {
  int nN, nwg, G, c; bool lat;
  __device__ void init(int N, int G_, int c_, bool lat_) { nN = N / 256; lat = lat_; nwg = (lat ? GB * 16 : PANELS) * nN; G = G_; c = c_; }
  __device__ __forceinline__ bool next(int i, pg8::Unit& u) const { const long L = (long)i * G + c; if (L >= nwg) return false; const int p = (int)L / nN; u.pm = lat ? (p >> 4) * PPB + (p & 15) : p; u.pn = (int)L % nN; u.acol = 0; u.nt = 0; return true; }
  __device__ __forceinline__ void a_ready(const pg8::Unit&) const {}
  __device__ __forceinline__ void done(const pg8::Unit&) const {}
};
struct MergeOrder {
  int ntiles, G, c; bool lat;
  __device__ void init(int G_, int c_, bool lat_) { lat = lat_; ntiles = (lat ? GB * 16 : PANELS) * 4; G = G_; c = c_; }
  __device__ __forceinline__ bool next(int i, pg8::Unit& u) const { const int rnd = i / 3, gi = i - 3 * rnd; const long tile = (long)rnd * G + c; if (tile >= ntiles) return false; const int p = (int)tile >> 2;
    u.pm = lat ? (p >> 4) * PPB + (p & 15) : p; u.pn = gi * 4 + ((int)tile & 3); u.acol = gi == 0 ? dd::O_HY : gi == 1 ? dd::O_OG : dd::O_AQ; u.nt = gi == 2 ? 16 : 8; return true; }
  __device__ __forceinline__ void a_ready(const pg8::Unit&) const {}
  __device__ __forceinline__ void done(const pg8::Unit&) const {}
};
struct EpiMergeS {
  static constexpr bool PERM = true, AFTER_DRAIN = false;
  const unsigned char* gate0; bf16_t* M;
  __device__ __forceinline__ void operator()(const pg8::f32x4 (&acc)[2][2][4][2], const pg8::Unit& u, int wr, int wc, int fr, int fq) const {
    const int gi = u.pn >> 2; const bool accum = gi > 0; const unsigned char* gate = gate0 + gi * 1024;
    const int row0 = u.pm * 256 + wr * 64 + fr, col0 = (u.pn & 3) * 256 + wc * 32 + 8 * fq;
#pragma unroll
    for (int ai2 = 0; ai2 < 4; ++ai2) { const int ai = ai2 >> 1, m0 = (ai2 & 1) * 2;
      uint2 gw[4][2]; v4u mo[4][2];
#pragma unroll
      for (int m = m0; m < m0 + 2; ++m)
#pragma unroll
        for (int bj = 0; bj < 2; ++bj) { const size_t r = (size_t)(row0 + ai * 128 + m * 16); const int c = col0 + bj * 128; gw[m][bj] = *(const uint2*)(gate + r * (PLD * 2) + c); mo[m][bj] = (v4u){0u, 0u, 0u, 0u}; if (accum) mo[m][bj] = *(const v4u*)(M + r * 1024 + c); }
#pragma unroll
      for (int m = m0; m < m0 + 2; ++m)
#pragma unroll
        for (int bj = 0; bj < 2; ++bj) { const size_t r = (size_t)(row0 + ai * 128 + m * 16); const int c = col0 + bj * 128; const uint2 g2 = gw[m][bj]; constexpr float q = 1.f / 255.f;
          pg8::f32x4 v0 = acc[ai][bj][m][0], v1 = acc[ai][bj][m][1];
          v0[0] *= (float)(g2.x & 255u) * q; v0[1] *= (float)((g2.x >> 8) & 255u) * q; v0[2] *= (float)((g2.x >> 16) & 255u) * q; v0[3] *= (float)(g2.x >> 24) * q;
          v1[0] *= (float)(g2.y & 255u) * q; v1[1] *= (float)((g2.y >> 8) & 255u) * q; v1[2] *= (float)((g2.y >> 16) & 255u) * q; v1[3] *= (float)(g2.y >> 24) * q;
          { const v4u o = mo[m][bj]; v0[0] += bf2f(o.x & 0xffff); v0[1] += bf2f(o.x >> 16); v0[2] += bf2f(o.y & 0xffff); v0[3] += bf2f(o.y >> 16);
            v1[0] += bf2f(o.z & 0xffff); v1[1] += bf2f(o.z >> 16); v1[2] += bf2f(o.w & 0xffff); v1[3] += bf2f(o.w >> 16); }
          v4u o2; o2.x = pk2(v0[0], v0[1]); o2.y = pk2(v0[2], v0[3]); o2.z = pk2(v1[0], v1[1]); o2.w = pk2(v1[2], v1[3]); *(v4u*)(M + r * 1024 + c) = o2; } }
  }
};
__device__ __forceinline__ const float* xrow_in(const NaiveBufs& a, int l, int b, int r) {
  if (r < dd::S) return (l == 0 ? a.x : (const float*)a.out) + ((size_t)b * dd::S + r) * 1024;
  return (l == 0 ? a.ctx : (const float*)a.xc) + ((size_t)b * dd::C + (r - dd::S)) * 1024;
}
__device__ __forceinline__ float* xrow_cur(const NaiveBufs& a, int b, int r) {
  if (r < dd::S) return a.out + ((size_t)b * dd::S + r) * 1024;
  return a.xc + ((size_t)b * dd::C + (r - dd::S)) * 1024;
}
__device__ __forceinline__ void norm_row(const float* xr, const float* gnorm, const float* shift, const float* scale, bf16_t* hrow, int lane) {
  typedef float f4 __attribute__((ext_vector_type(4)));
  f4 xv[4]; float ss = 0.f;
#pragma unroll
  for (int j = 0; j < 4; ++j) { xv[j] = *(const f4*)(xr + 4 * lane + 256 * j); ss += xv[j][0] * xv[j][0] + xv[j][1] * xv[j][1] + xv[j][2] * xv[j][2] + xv[j][3] * xv[j][3]; }
  const float rs = 1.f / sqrtf(moe::wave_sum(ss) * (1.f / 1024.f) + 1e-6f);
#pragma unroll
  for (int j = 0; j < 4; ++j) { const int c = 4 * lane + 256 * j; const f4 g4 = *(const f4*)(gnorm + c), sh = *(const f4*)(shift + c), sc = *(const f4*)(scale + c);
    f4 h;
#pragma unroll
    for (int i = 0; i < 4; ++i) h[i] = xv[j][i] * rs * g4[i] * (1.f + sc[i]) + sh[i];
    *(unsigned long long*)(hrow + c) = (unsigned long long)pk2(h[0], h[1]) | ((unsigned long long)pk2(h[2], h[3]) << 32); }
}
__device__ __forceinline__ void qknorm_row(bf16_t* prow, const float* qg, const float* kg, int r, int lane) {
  const bool lat = r < dd::S; const int grow = r / dd::GW, gcol = r % dd::GW;
  const int fi = lane & 31; const float pos = (lane < 32) ? (float)grow : (float)gcol;
  const float ang = pos * __builtin_amdgcn_exp2f(-(float)fi * (13.287712379549449f / 32.f));
  const float cs = lat ? __cosf(ang) : 1.f, sn = lat ? __sinf(ang) : 0.f;
  unsigned wv[10];
#pragma unroll
  for (int hh = 0; hh < 10; ++hh) wv[hh] = *((const unsigned*)(prow + (hh < 8 ? dd::O_AQ + hh * 128 : dd::O_AK + (hh - 8) * 128)) + lane);
  float ss[10];
#pragma unroll
  for (int hh = 0; hh < 10; ++hh) { const float x1 = bf2f(wv[hh] & 0xffff), x2 = bf2f(wv[hh] >> 16); ss[hh] = x1 * x1 + x2 * x2; }
#pragma unroll
  for (int o = 1; o < 64; o <<= 1) {
#pragma unroll
    for (int hh = 0; hh < 10; ++hh) ss[hh] += __shfl_xor(ss[hh], o); }
  const float q1 = qg[2 * lane], q2 = qg[2 * lane + 1], k1 = kg[2 * lane], k2 = kg[2 * lane + 1];
#pragma unroll
  for (int hh = 0; hh < 10; ++hh) { unsigned* p = (unsigned*)(prow + (hh < 8 ? dd::O_AQ + hh * 128 : dd::O_AK + (hh - 8) * 128)) + lane;
    const float x1 = bf2f(wv[hh] & 0xffff), x2 = bf2f(wv[hh] >> 16); const float rs = 1.f / sqrtf(ss[hh] * (1.f / 128.f) + 1e-6f);
    const float y1 = x1 * rs * (hh < 8 ? q1 : k1), y2 = x2 * rs * (hh < 8 ? q2 : k2);
    *p = pk2(y1 * cs - y2 * sn, y1 * sn + y2 * cs); }
}

__device__ __forceinline__ void ga_task(const bf16_t* hb, const bf16_t* WgaT, bf16_t* proj, int wt) {
  int tid = threadIdx.x; asm volatile("" : "+v"(tid));
  const int lane = tid & 63, li = lane & 31, lk = lane >> 5; typedef short b8 __attribute__((ext_vector_type(8))); typedef float f16v __attribute__((ext_vector_type(16)));
  const bf16_t* ap = hb + ((size_t)wt * 32 + li) * 1024 + 8 * lk; const bf16_t* bp = WgaT + (size_t)li * 1024 + 8 * lk;
  f16v acc = {};
  for (int k8 = 0; k8 < 8; ++k8) { v4u av[8], bv[8];
#pragma unroll
    for (int j = 0; j < 8; ++j) { av[j] = *(const v4u*)(ap + 128 * k8 + 16 * j); bv[j] = *(const v4u*)(bp + 128 * k8 + 16 * j); }
#pragma unroll
    for (int j = 0; j < 8; ++j) acc = __builtin_amdgcn_mfma_f32_32x32x16_bf16(__builtin_bit_cast(b8, av[j]), __builtin_bit_cast(b8, bv[j]), acc, 0, 0, 0); }
#pragma unroll
  for (int r = 0; r < 16; ++r) { const int row = wt * 32 + (r & 3) + 8 * (r >> 2) + 4 * lk; proj[(size_t)row * PLD + dd::O_GA + li] = (bf16_t)f2bf(acc[r]); }
}

__global__ void __launch_bounds__(NTHREADS, 2) mega_kernel(KArgs ka_unused) {
  extern __shared__ __attribute__((aligned(16))) unsigned char lds_raw[];
  LAS unsigned char* lds = (LAS unsigned char*)lds_raw;
  volatile LAS unsigned* MISC = (volatile LAS unsigned*)(lds + MISC_OFF);
  constexpr int ARGS_OFF = MISC_OFF + 256;
  static_assert(ARGS_OFF + sizeof(KArgs) <= LDS_BYTES, "LDS map");
  { const unsigned __attribute__((address_space(4)))* kp = (const unsigned __attribute__((address_space(4)))*)__builtin_amdgcn_kernarg_segment_ptr();
    for (int i = threadIdx.x; i < (int)(sizeof(KArgs) / 4); i += NTHREADS) ((LAS unsigned*)(lds + ARGS_OFF))[i] = kp[i]; }
  if (threadIdx.x < 64) MISC[threadIdx.x] = 0u;
  __syncthreads();
  const KArgs& ka = *(const KArgs*)(const LAS KArgs*)(lds + ARGS_OFF);
  const NaiveBufs& a = ka.a;
  unsigned* bar_s; { const unsigned long long bp = (unsigned long long)ka.bar; const unsigned lo_ = __builtin_amdgcn_readfirstlane((unsigned)bp), hi_ = __builtin_amdgcn_readfirstlane((unsigned)(bp >> 32));
    bar_s = (unsigned*)(((unsigned long long)hi_ << 32) | lo_); }
  XcdBarrier xb = xcd_barrier_post(bar_s, MISC);
#define SPTR(T, name, src) T* name; { const unsigned long long bp_ = (unsigned long long)(src); const unsigned lo_ = __builtin_amdgcn_readfirstlane((unsigned)bp_), hi_ = __builtin_amdgcn_readfirstlane((unsigned)(bp_ >> 32)); name = (T*)(((unsigned long long)hi_ << 32) | lo_); }
  SPTR(bf16_t, proj_s, ka.proj) SPTR(bf16_t, hb_s, ka.hb) SPTR(unsigned char, mix_s, ka.mix)
  const long gs = (long)gridDim.x * NTHREADS;
  LAS int* poff = (LAS int*)(lds + MISC_OFF + 64);
#define TID_SETUP int tz = threadIdx.x; asm volatile("" : "+v"(tz)); const int lane = tz & 63, wave = __builtin_amdgcn_readfirstlane(tz >> 6); \
    const int gw = blockIdx.x * NWAVES + wave, NGW = gridDim.x * NWAVES; const long gt = (long)blockIdx.x * NTHREADS + tz; (void)lane; (void)gw; (void)NGW; (void)gt;
#define LSTAGE(ST) { TID_SETUP const long n_ = stage_items<TD>(ST, l); for (long i_ = gt; i_ < n_; i_ += gs) stage_run<TD, ST>(a, l, 0, i_); }
  for (int l = 0; l < dd::DEPTH; ++l) {
    const bool last = (l == dd::DEPTH - 1);
    { TID_SETUP
      LAS float* scr = (LAS float*)(lds + RING_OFF + wave * 16384);
      constexpr int NIT = (dd::D / 64) * (dd::NIN / 32);
      for (int it = gw; it < NIT; it += NGW) { const int n0 = 32 * (it % (dd::NIN / 32));
        if (n0 == dd::O_GA) transpose_item(a.w_in + (size_t)l * dd::D * dd::NIN, dd::D, dd::NIN, ka.WgaT, -dd::O_GA, scr, it, lane);
        else transpose_item(a.w_in + (size_t)l * dd::D * dd::NIN, dd::D, dd::NIN, ka.WinT, n0 < dd::O_GA ? 0 : -32, scr, it, lane); }
      { constexpr int I0 = (dd::HW / 64) * (dd::D / 32), I1 = (dd::GVW / 64) * (dd::D / 32), I2 = (dd::AQW / 64) * (dd::D / 32), I3 = (dd::D / 64) * (dd::D / 32);
        for (int it = gw; it < I0 + I1 + I2 + I3; it += NGW) { int r = it;
          if (r < I0) { transpose_item(a.w_br_hy + (size_t)l * dd::HW * dd::D, dd::HW, dd::D, ka.WhyT, 0, scr, r, lane, 1024); continue; } r -= I0;
          if (r < I1) { transpose_item(a.w_br_gla + (size_t)l * dd::GVW * dd::D, dd::GVW, dd::D, ka.WglaT, 0, scr, r, lane, 1024); continue; } r -= I1;
          if (r < I2) { transpose_item(a.w_br_att + (size_t)l * dd::AQW * dd::D, dd::AQW, dd::D, ka.WattT, 0, scr, r, lane); continue; } r -= I2;
          transpose_item(a.w_out + (size_t)l * dd::D * dd::D, dd::D, dd::D, ka.WoutT, 0, scr, r, lane); } }
      { constexpr int IG = (dd::D / 64) * (dd::DE / 32), IDN = (dd::DE / 64) * (dd::D / 32);
        for (int it = gw; it < dd::NE * (2 * IG + IDN); it += NGW) { const int e = it / (2 * IG + IDN); int r = it % (2 * IG + IDN);
          if (r < 2 * IG) { const int up = r >= IG; if (up) r -= IG; const int n0 = 32 * (r % (dd::DE / 32));
            transpose_item((up ? a.moe_w_up : a.moe_w_gate) + ((size_t)l * dd::NE + e) * dd::D * dd::DE, dd::D, dd::DE, ka.WguT, e * 1024 + 128 * (n0 >> 7) + (up ? 128 : 0), scr, r, lane); }
          else { r -= 2 * IG; transpose_item(a.moe_w_down + ((size_t)l * dd::NE + e) * dd::DE * dd::D, dd::DE, dd::D, ka.WdT, e * 1024, scr, r, lane); } } }
      (void)gt;
    }
    pro::mod_phase(a, l, lds); pro::hid_phase(a, l, dd::S, a.hid2S, lds); if (!last) pro::hid_phase(a, l, dd::C, a.hid2C, lds);
    xcd_barrier(xb);
    pro::tapsB_phase(a, l, (bf16_t*)a.tapsS, lds); if (!last) LSTAGE(L_TAPS_C)
    xcd_barrier(xb);
    pro::nrmB_phase(a, (const bf16_t*)a.tapsS); if (!last) LSTAGE(L_NRM_C)
    xcd_barrier(xb);
    for (int grp = 0; grp < NGRP; ++grp) {
      const int b0 = grp * GB;
      { TID_SETUP
        for (int rg = gw; rg < RG; rg += NGW) { const int bl = rg / RB, r = rg % RB, b = b0 + bl; const float* md = a.mod + (size_t)(r < dd::S ? b : dd::B) * 6 * 1024;
          norm_row(xrow_in(a, l, b, r), a.norm1_g + (size_t)l * 1024, md, md + 1024, hb_s + (size_t)rg * 1024, lane); }
        xcd_barrier(xb); }
      { pg8::Gemm g{hb_s, ka.WinT, RG, NINP, dd::D, 0}; pg8::StaticOrder S; S.init(RG, NINP, (int)gridDim.x, (int)blockIdx.x); EpiProjBf16 E{proj_s};
        pg8::gemm_phase<EpiProjBf16, pg8::StaticOrder, false>((PG8_LAS unsigned char*)(lds + RING_OFF), g, S, E, nullptr);
        { int tq = threadIdx.x; asm volatile("" : "+v"(tq)); const int wv_ = __builtin_amdgcn_readfirstlane(tq >> 6);
          for (int wt = (int)blockIdx.x + (int)gridDim.x * wv_; wt < PANELS * 8; wt += (int)gridDim.x * NWAVES) ga_task(hb_s, ka.WgaT, proj_s, wt); }
        xcd_barrier(xb); }
      { TID_SETUP
        for (int rg = gw; rg < RG; rg += NGW) qknorm_row(proj_s + (size_t)rg * PLD, a.q_norm_g + (size_t)l * 128, a.k_norm_g + (size_t)l * 128, rg % RB, lane);
        for (int u = blockIdx.x; u < GB * 4 * 68; u += gridDim.x) { const int bl = u / (4 * 68), hu = u % (4 * 68); const bf16_t* pb = proj_s + (size_t)bl * RB * PLD;
          gla::In gp; gp.q = pb + dd::O_GQ; gp.k = pb + dd::O_GK; gp.v = pb + dd::O_GV; gp.ga = pb + dd::O_GA; gp.og = pb + dd::O_OG; gp.ld = PLD;
          gp.wa2 = a.gla_wa2 + (size_t)l * 2 * 16 * 256; gp.ba = a.gla_ba + (size_t)l * 2 * 256; gp.gnorm = a.gla_norm_g + (size_t)l * 128;
          gp.csb = (bf16_t*)(mix_s + (size_t)bl * CS_BYTES); gp.dec = (float*)(mix_s + (size_t)GB * CS_BYTES + (size_t)bl * DEC_BYTES); gp.y = (bf16_t*)pb + dd::O_OG; gp.ldy = PLD; gp.S = dd::S; gp.C = dd::C;
          gla::g1b_unit(gp, lds, hu / 68, hu % 68, 4, 68); }
        xcd_barrier(xb); }
      { TID_SETUP
        for (long i_ = gt; i_ < (long)GB * 2 * 4 * 64 * 64; i_ += gs) { const int bl = (int)(i_ / (2 * 4 * 64 * 64)); gla::In gp; gp.csb = (bf16_t*)(mix_s + (size_t)bl * CS_BYTES); gp.dec = (float*)(mix_s + (size_t)GB * CS_BYTES + (size_t)bl * DEC_BYTES); gp.S = dd::S; gp.C = dd::C;
          gla::g2_item(gp, i_ % (2 * 4 * 64 * 64), 4, 68); }
        const int combo = blockIdx.x & 7, slot = blockIdx.x >> 3, nslot = gridDim.x >> 3;
        const int per_combo = 64 + (last ? 0 : 4);
        const bool xcdm = (gridDim.x & 7) == 0;
        for (int uu = xcdm ? slot : (int)blockIdx.x; uu < (xcdm ? per_combo : 8 * per_combo); uu += xcdm ? nslot : (int)gridDim.x) { const int cmb = xcdm ? combo : uu / per_combo, ui = xcdm ? uu : uu % per_combo;
          const bool lat = ui < 64; const int bl = cmb >> 1, kvh = cmb & 1;
          const int head = kvh * 4 + (lat ? ui >> 4 : ui - 64), qb = lat ? ui & 15 : 0;
          bf16_t* pb = proj_s + (size_t)bl * RB * PLD; const size_t qrow = lat ? (size_t)qb * 256 : (size_t)dd::S, krow = lat ? 0 : (size_t)dd::S;
          att::attn_dense_body<att::bf16, PLD, PLD, PLD, true>((const att::bf16*)(pb + qrow * PLD + dd::O_AQ + head * 128), (const att::bf16*)(pb + krow * PLD + dd::O_AK + kvh * 128),
              (const att::bf16*)(pb + krow * PLD + dd::O_AV + kvh * 128), pb + qrow * PLD + dd::O_AQ + head * 128, lat ? RB : dd::C, (char*)lds_raw);
          __syncthreads(); }
        xcd_barrier(xb); }
      { const int n3 = last ? 64 : 68;
        for (int u = blockIdx.x; u < GB * 4 * n3; u += gridDim.x) { const int bl = u / (4 * n3), hu = u % (4 * n3); const bf16_t* pb = proj_s + (size_t)bl * RB * PLD;
          gla::In gp; gp.q = pb + dd::O_GQ; gp.k = pb + dd::O_GK; gp.v = pb + dd::O_GV; gp.ga = pb + dd::O_GA; gp.og = pb + dd::O_OG; gp.ld = PLD;
          gp.wa2 = a.gla_wa2 + (size_t)l * 2 * 16 * 256; gp.ba = a.gla_ba + (size_t)l * 2 * 256; gp.gnorm = a.gla_norm_g + (size_t)l * 128;
          gp.csb = (bf16_t*)(mix_s + (size_t)bl * CS_BYTES); gp.dec = (float*)(mix_s + (size_t)GB * CS_BYTES + (size_t)bl * DEC_BYTES); gp.y = (bf16_t*)pb + dd::O_OG; gp.ldy = PLD; gp.S = dd::S; gp.C = dd::C;
          gla::g3b_unit(gp, lds, hu / n3, hu % n3, 4, 68); }
        xcd_barrier(xb); }
      {
        bf16_t* ucT0 = (bf16_t*)mix_s; bf16_t* yT0 = (bf16_t*)(mix_s + GB * UCT_BYTES); float* ucc0 = (float*)(mix_s + GB * (UCT_BYTES + YT_BYTES)); float* z1c0 = (float*)(mix_s + GB * (UCT_BYTES + YT_BYTES + UCC_BYTES));
        const float* cw = a.hy_conv_w + (size_t)l * 3 * 1536; const float* cb = a.hy_conv_b + (size_t)l * 1536; const float* skp = a.hy_skip + (size_t)l * 2 * 512;
        { TID_SETUP
        { int t_ = blockIdx.x; hy::H0Regs hr = hy::h0_load(proj_s + (size_t)(t_ / (64 * 24)) * RB * PLD + dd::O_HY, PLD, t_ % (64 * 24), tz);
          for (; t_ < GB * 64 * 24; t_ += gridDim.x) { const int bl = t_ / (64 * 24), tn_ = t_ + gridDim.x; hy::H0Regs hn = hr;
            if (tn_ < GB * 64 * 24) hn = hy::h0_load(proj_s + (size_t)(tn_ / (64 * 24)) * RB * PLD + dd::O_HY, PLD, tn_ % (64 * 24), tz);
            hy::h0_compute(hr, cw, cb, ucT0 + (size_t)bl * 1536 * 4096, t_ % (64 * 24), lds, tz); hr = hn; } }
        if (!last) for (long i_ = gt; i_ < (long)GB * 256 * 1536; i_ += gs) { const int bl = (int)(i_ / (256 * 1536)); hy::cconv3_item(proj_s + ((size_t)bl * RB + dd::S) * PLD + dd::O_HY, PLD, cw, cb, ucc0 + (size_t)bl * 256 * 1536, i_ % (256 * 1536)); } }
        xcd_barrier(xb);
        { TID_SETUP
        for (int u = blockIdx.x; u < (GB / 2) * 512; u += gridDim.x) { const int bp_ = u / 512; hy::h1c_unit(ucT0 + (size_t)(2 * bp_) * 1536 * 4096, (const bf16_t*)a.tapsS, a.nrmS, skp, yT0 + (size_t)(2 * bp_) * 512 * 4096, u % 512, lds); }
        if (!last) for (long i_ = gt; i_ < (long)GB * 32 * 512; i_ += gs) { const int bl = (int)(i_ / (32 * 512)); hy::clong_item(ucc0 + (size_t)bl * 256 * 1536, nullptr, z1c0 + (size_t)bl * 256 * 512, nullptr, 0, a.tapsC, a.nrmC, skp, 0, i_ % (32 * 512)); } }
        xcd_barrier(xb);
        { TID_SETUP
        for (int t_ = blockIdx.x; t_ < GB * 64 * 8; t_ += gridDim.x) { const int bl = t_ / (64 * 8); hy::h2_tile(yT0 + (size_t)bl * 512 * 4096, proj_s + (size_t)bl * RB * PLD + dd::O_HY, PLD, t_ % (64 * 8), lds); }
        if (!last) for (long i_ = gt; i_ < (long)GB * 32 * 512; i_ += gs) { const int bl = (int)(i_ / (32 * 512)); hy::clong_item(ucc0 + (size_t)bl * 256 * 1536, z1c0 + (size_t)bl * 256 * 512, nullptr, proj_s + ((size_t)bl * RB + dd::S) * PLD + dd::O_HY, PLD, a.tapsC, a.nrmC, skp, 1, i_ % (32 * 512)); } }
        xcd_barrier(xb); }
      { { pg8::Gemm g{proj_s, ka.WhyT, RG, 1024, 1024, PLD, 1024}; MergeOrder S; S.init((int)gridDim.x, (int)blockIdx.x, last); EpiMergeS E{(const unsigned char*)(proj_s + dd::O_BR), (bf16_t*)mix_s};
          pg8::gemm_phase<EpiMergeS, MergeOrder, false>((PG8_LAS unsigned char*)(lds + RING_OFF), g, S, E, nullptr); }
        xcd_barrier(xb);
        pg8::Gemm g{(const bf16_t*)mix_s, ka.WoutT, RG, 1024, 1024, 0}; GroupOrder S; S.init(1024, (int)gridDim.x, (int)blockIdx.x, last);
        EpiOutG E{l == 0 ? a.x : (const float*)a.out, a.out, l == 0 ? a.ctx : (const float*)a.xc, a.xc, a.mod, b0, !last};
        pg8::gemm_phase<EpiOutG, GroupOrder, false>((PG8_LAS unsigned char*)(lds + RING_OFF), g, S, E, nullptr);
        xcd_barrier(xb); }
      {
        { TID_SETUP int* cnt = ka.cnt + (l * NGRP + grp) * 1024;
          LAS float* rwT = (LAS float*)(lds + RING_OFF);
          for (int k = tz; k < 1024; k += NTHREADS) {
#pragma unroll
            for (int e = 0; e < 16; ++e) rwT[e * 1024 + k] = a.router_w[(size_t)k * 16 + e]; }
          __syncthreads();
          LAS int* lcnt = (LAS int*)(lds + RING_OFF + 65536);
          if (tz < 32) lcnt[tz] = 0;
          __syncthreads();
          for (int rg = gw; rg < RG; rg += NGW) { const int bl = rg / RB, r = rg % RB, b = b0 + bl; if (last && r >= dd::S) continue; const float* md = a.mod + (size_t)(r < dd::S ? b : dd::B) * 6 * 1024;
            moe::route_row(xrow_cur(a, b, r), a.norm2_g + (size_t)l * 1024, md + 3 * 1024, md + 4 * 1024, hb_s + (size_t)rg * 1024, rwT, a.router_b, lcnt, ka.route + rg, ka.wts + 2 * rg, lane); }
          __syncthreads();
          if (tz < 16) lcnt[16 + tz] = atomicAdd(cnt + tz * 64, lcnt[tz]);
          __syncthreads();
          for (int rg = gw; rg < RG; rg += NGW) { if (last && (rg % RB) >= dd::S) continue; moe::Route* rt = ka.route + rg; if (lane == 0) { moe::Route r_ = *rt; r_.r0 += lcnt[16 + r_.e0]; r_.r1 += lcnt[16 + r_.e1]; *rt = r_; } }
          xcd_barrier(xb); }
        { TID_SETUP int* cnt = ka.cnt + (l * NGRP + grp) * 1024;
          if (tz == 0) { int acc_ = 0; for (int e = 0; e < 16; ++e) { poff[e] = acc_; acc_ += (cnt[e * 64] + 255) >> 8; } poff[16] = acc_; }
          __syncthreads();
          for (int rg = gw; rg < RG; rg += NGW) { if (last && (rg % RB) >= dd::S) continue; const moe::Route rt = ka.route[rg];
            const v4u h0 = *(const v4u*)(hb_s + (size_t)rg * 1024 + lane * 16), h1 = *(const v4u*)(hb_s + (size_t)rg * 1024 + lane * 16 + 8);
#pragma unroll
            for (int sl = 0; sl < 2; ++sl) { const int e = sl ? rt.e1 : rt.e0, rk = sl ? rt.r1 : rt.r0; const size_t dst = (size_t)poff[e] * 256 + rk;
              *(v4u*)(ka.hp + dst * 1024 + lane * 16) = h0; *(v4u*)(ka.hp + dst * 1024 + lane * 16 + 8) = h1;
              if (lane == 0) { ka.srcrow[dst] = 2 * rg + sl; ka.wgt[dst] = ka.wts[2 * rg + sl]; } } }
          for (int e = 0; e < 16; ++e) { const int c_ = cnt[e * 64], pe = ((c_ + 255) >> 8) << 8; for (int p_ = c_ + (int)gt; p_ < pe; p_ += (int)gs) ka.srcrow[(size_t)poff[e] * 256 + p_] = -1; }
          xcd_barrier(xb); }
        { pg8::Gemm g{ka.hp, ka.WguT, 0, 0, 1024, 0}; moe::MoeOrder S{(int)gridDim.x, (int)blockIdx.x, 4, poff}; moe::EpiGU E{ka.hid};
          pg8::gemm_phase<moe::EpiGU, moe::MoeOrder, false>((PG8_LAS unsigned char*)(lds + RING_OFF), g, S, E, nullptr);
          xcd_barrier(xb); }
        { pg8::Gemm g{ka.hid, ka.WdT, 0, 0, 512, 0}; moe::MoeOrder S{(int)gridDim.x, (int)blockIdx.x, 4, poff}; moe::EpiDown E{ka.srcrow, ka.wgt, ka.contrib, (size_t)RG * 1024};
          pg8::gemm_phase<moe::EpiDown, moe::MoeOrder, false>((PG8_LAS unsigned char*)(lds + RING_OFF), g, S, E, nullptr);
          xcd_barrier(xb); }
        { TID_SETUP
#pragma unroll 4
          for (long i_ = gt; i_ < (long)RG * 256; i_ += gs) { const int rg = (int)(i_ >> 8), c4 = (int)(i_ & 255) * 4; const int bl = rg / RB, r = rg % RB, b = b0 + bl; if (last && r >= dd::S) continue;
            float* xr = xrow_cur(a, b, r) + c4; const float* g2 = a.mod + (size_t)(r < dd::S ? b : dd::B) * 6 * 1024 + 5 * 1024 + c4;
            const unsigned long long u0 = *(const unsigned long long*)(ka.contrib + (size_t)rg * 1024 + c4), u1 = *(const unsigned long long*)(ka.contrib + (size_t)RG * 1024 + (size_t)rg * 1024 + c4);
            pg8::f32x4 xv = *(pg8::f32x4*)xr; const pg8::f32x4 gv = *(const pg8::f32x4*)g2;
#pragma unroll
            for (int e = 0; e < 4; ++e) xv[e] += gv[e] * (bf2f((bf16_t)(u0 >> (16 * e))) + bf2f((bf16_t)(u1 >> (16 * e))));
            *(pg8::f32x4*)xr = xv; }
          xcd_barrier(xb); }
      }
    }
  }
}
extern "C" void kernel_launch(void* const* d_in, const int* in_sizes, int n_in, void* d_out, int out_size, void* d_ws, size_t ws_size, hipStream_t stream) {
  static int grid = 0;
  if (!grid) {
    int dev = 0, cus = 0, per_cu = 0;
    (void)hipGetDevice(&dev); (void)hipDeviceGetAttribute(&cus, hipDeviceAttributeMultiprocessorCount, dev);
    (void)hipFuncSetAttribute((const void*)mega_kernel, hipFuncAttributeMaxDynamicSharedMemorySize, LDS_BYTES);
    (void)hipOccupancyMaxActiveBlocksPerMultiprocessor(&per_cu, mega_kernel, NTHREADS, LDS_BYTES);
    if (per_cu < 1) fprintf(stderr, "occupancy query says %d\n", per_cu);
    grid = cus;
  }
  KArgs ka{}; const float* ptrs[33]; for (int i = 0; i < 33; ++i) ptrs[i] = (const float*)d_in[i];
  set_inputs<TD>(ka.a, ptrs);
  char* wsb = (char*)d_ws; size_t off = BAR_BYTES;
  auto take = [&](size_t bytes) { char* p = wsb + off; off += (bytes + 255) & ~(size_t)255; return p; };
  NaiveBufs& a = ka.a;
  a.mod = (float*)take((size_t)(dd::B + 1) * 6 * 1024 * 4); a.hid2S = (float*)take((size_t)dd::S * 64 * 4); a.hid2C = (float*)take((size_t)dd::C * 64 * 4);
  a.tapsS = (float*)take((size_t)2 * 512 * 2 * 8232 * 2 + 64); a.tapsC = (float*)take((size_t)2 * 512 * 512 * 4); a.nrmS = (float*)take(1024 * 4); a.nrmC = (float*)take(1024 * 4);
  a.xc = (float*)take((size_t)dd::B * dd::C * 1024 * 4);
  ka.WgaT = (bf16_t*)take((size_t)32 * 1024 * 2); ka.WinT = (bf16_t*)take((size_t)NINP * 1024 * 2); ka.WhyT = (bf16_t*)take((size_t)1024 * 1024 * 2); ka.WglaT = (bf16_t*)take((size_t)1024 * 1024 * 2); ka.WattT = (bf16_t*)take((size_t)1024 * 1024 * 2);
  ka.WoutT = (bf16_t*)take((size_t)1024 * 1024 * 2); ka.WguT = (bf16_t*)take((size_t)16 * 1024 * 1024 * 2); ka.WdT = (bf16_t*)take((size_t)16 * 1024 * 512 * 2);
  ka.hb = (bf16_t*)take((size_t)RG * 1024 * 2); ka.mix = (unsigned char*)take(MIX_BYTES);
  ka.proj = (bf16_t*)take((size_t)RG * PLD * 2);
  { char* p = (char*)ka.proj; ka.hp = (bf16_t*)p; p += (size_t)MPG * 1024 * 2; ka.hid = (bf16_t*)p; p += (size_t)MPG * 512 * 2; ka.contrib = (bf16_t*)p; p += (size_t)2 * RG * 1024 * 2;
    ka.srcrow = (int*)p; p += (size_t)MPG * 4; ka.wgt = (float*)p; p += (size_t)MPG * 4; ka.route = (moe::Route*)p; p += (size_t)RG * 16; ka.wts = (float*)p; p += (size_t)RG * 8;
    if ((size_t)(p - (char*)ka.proj) > (size_t)RG * PLD * 2) fprintf(stderr, "MoE alias region too large\n"); }
  a.out = (float*)d_out; ka.bar = (unsigned*)d_ws; ka.cnt = (int*)(wsb + CNT_OFF);
  if (off > ws_size) fprintf(stderr, "workspace too small: need %zu have %zu\n", off, ws_size);
  (void)hipMemsetAsync(d_ws, 0, BAR_BYTES, stream);
  hipLaunchKernelGGL(mega_kernel, dim3(grid), dim3(NTHREADS), LDS_BYTES, stream, ka);
}
```

```cpp
#include <hip/hip_runtime.h>
#include <cstddef>
#include <cstdio>
#include <cstdint>
#include <hip/hip_bf16.h>
#include <hip/hip_runtime.h>
namespace pg8 {
#define PG8_LAS __attribute__((address_space(3)))
typedef unsigned short bf16_t;
typedef short bf16x8 __attribute__((ext_vector_type(8)));
typedef float f32x4 __attribute__((ext_vector_type(4)));
typedef unsigned u32x4 __attribute__((ext_vector_type(4)));
constexpr int BM = 256, BK = 64, HALF = 128, HTB = HALF * BK * 2  , STAGE_BYTES = 8 * HTB, NXCD = 8, WGM = 8;

__host__ __device__ __forceinline__ int lds_byte(int r, int c) { const int st = (r >> 4) * 2 + (c >> 5), rr = r & 15, cc = c & 31, ob = rr * 64 + cc * 2; return st * 1024 + (ob ^ (((ob >> 9) & 1) << 5)); }
__host__ __device__ __forceinline__ void stage_rc(int b, int& R, int& C) { const int st = b / 1024, sb = b % 1024, swz = sb ^ (((sb >> 9) & 1) << 5); R = (st >> 1) * 16 + swz / 64; C = (st & 1) * 32 + (swz % 64) / 2; }
__host__ __device__ __forceinline__ int perm32(int rho) { const int n = rho >> 4, i = rho & 15; return 8 * (i >> 2) + 4 * n + (i & 3); }

struct Unit { int pm, pn, acol, nt; };
struct Gemm { const bf16_t* A; const bf16_t* Bt; int M, N, K; int lda; int ldb; };

struct StaticOrder {
    int nM, nN, nwg, G, c;
    __host__ __device__ void init(int M, int N, int G_, int c_) { nM = M / BM; nN = N / BM; nwg = nM * nN; G = G_; c = c_; }
    __host__ __device__ bool next(int i, Unit& u) const {
        const long L = (long)i * G + c; if (L >= nwg) return false;
        int wgid = (int)L; { const int q = nwg / NXCD, r = nwg % NXCD, xcd = wgid % NXCD, off = wgid / NXCD; wgid = (xcd < r ? xcd * (q + 1) : r * (q + 1) + (xcd - r) * q) + off; }
        const int nig = WGM * nN, gid = wgid / nig, fm = gid * WGM, gsz = (nM - fm) < WGM ? (nM - fm) : WGM;
        u.pm = fm + ((wgid % nig) % gsz); u.pn = (wgid % nig) / gsz; u.acol = 0; u.nt = 0; return true;
    }
    __device__ __forceinline__ void a_ready(const Unit&) const {}
    __device__ __forceinline__ void done(const Unit&) const {}
};
__device__ __forceinline__ unsigned cvt_pk_bf16(float lo, float hi) { unsigned r; asm volatile("v_cvt_pk_bf16_f32 %0, %1, %2" : "=v"(r) : "v"(lo), "v"(hi)); return r; }
typedef float f32x2 __attribute__((ext_vector_type(2)));
template <class Epi, class Sched, bool STAMP = false>
__device__ __forceinline__ void gemm_phase(PG8_LAS unsigned char* lds, const Gemm g, const Sched& S, const Epi& E, unsigned long long* stamps) {
    int tid = threadIdx.x; asm volatile("" : "+v"(tid)); const int wid = __builtin_amdgcn_readfirstlane(tid >> 6), lane = tid & 63, wr = wid >> 2, wc = wid & 3, fr = lane & 15, fq = lane >> 4;
    const int K = g.K, nt = K / BK, LDA = g.lda ? g.lda : g.K, LDB = g.ldb ? g.ldb : g.K;
    int ts_lo = 0, ts_hi = 0, nts = 0; const unsigned long long rt_entry = STAMP ? (unsigned long long)wall_clock64() : 0ull;
#define PG8_STAMP() do { if (STAMP && wid == 0 && nts < 64) { const unsigned long long _c = (unsigned long long)clock64(); \
        ts_lo = (lane == nts) ? (int)(unsigned)_c : ts_lo; ts_hi = (lane == nts) ? (int)(unsigned)(_c >> 32) : ts_hi; ++nts; } } while (0)
    PG8_STAMP();
    unsigned voffA[2], voffB[2];
#pragma unroll
    for (int i = 0; i < 2; ++i) { int R, C; stage_rc(tid * 16 + i * 8192, R, C); const int Rb = Epi::PERM ? ((R & ~31) + perm32(R & 31)) : R;
        voffA[i] = (unsigned)(R * LDA + C) * 2u; voffB[i] = (unsigned)(Rb * LDB + C) * 2u; }
    const size_t kstep = (size_t)(BK * 2);
    const size_t hstep = (size_t)HALF * LDB * 2;
    const size_t tstep = 2 * hstep;
    const size_t hstepA = (size_t)HALF * LDA * 2, tstepA = 2 * hstepA;
    const unsigned ldsw = (unsigned)wid * 1024u;
    const int aoff = lds_byte(wr * 64 + fr, fq * 8), boff = lds_byte(wc * 32 + fr, fq * 8);
#define PG8_SA(b, h) (((b) * 2 + (h)) * HTB)
#define PG8_SB(b, h) ((4 + (b) * 2 + (h)) * HTB)
#define PG8_STAGE(bufoff, gbase, voff) do { _Pragma("unroll") for (int _i = 0; _i < 2; ++_i) \
        __builtin_amdgcn_global_load_lds((const unsigned*)((const char*)(gbase) + (voff)[_i]), (PG8_LAS unsigned*)(lds + (bufoff) + ldsw + _i * 8192), 16, 0, 0); } while (0)
#define PG8_LDA(dst, b, h) do { _Pragma("unroll") for (int m = 0; m < 4; ++m) _Pragma("unroll") for (int k = 0; k < 2; ++k) dst[m][k] = *(const PG8_LAS bf16x8*)(lds + PG8_SA(b, h) + aoff + m * 2048 + k * 1024); } while (0)
#define PG8_LDB(dst, b, h) do { _Pragma("unroll") for (int n = 0; n < 2; ++n) _Pragma("unroll") for (int k = 0; k < 2; ++k) dst[n][k] = *(const PG8_LAS bf16x8*)(lds + PG8_SB(b, h) + boff + n * 2048 + k * 1024); } while (0)
#define PG8_MMA(ai, bj, At, Bt) do { __builtin_amdgcn_s_setprio(1); _Pragma("unroll") for (int m = 0; m < 4; ++m) _Pragma("unroll") for (int n = 0; n < 2; ++n) _Pragma("unroll") for (int k = 0; k < 2; ++k) \
        acc[ai][bj][m][n] = __builtin_amdgcn_mfma_f32_16x16x32_bf16(Bt[n][k], At[m][k], acc[ai][bj][m][n], 0, 0, 0); __builtin_amdgcn_s_setprio(0); } while (0)
#define PG8_WAIT_V(n) asm volatile("s_waitcnt vmcnt(" #n ")" ::: "memory")
#define PG8_WAIT_L(n) asm volatile("s_waitcnt lgkmcnt(" #n ")" ::: "memory")
#define PG8_BAR __builtin_amdgcn_s_barrier()
#define PG8_SCHED __builtin_amdgcn_sched_barrier(0)
    Unit cur, nxt; int ui = 0;
    if (!S.next(0, cur)) return;
    f32x4 acc[2][2][4][2];
#pragma unroll
    for (int a = 0; a < 2; ++a)
#pragma unroll
        for (int b = 0; b < 2; ++b)
#pragma unroll
            for (int m = 0; m < 4; ++m)
#pragma unroll
                for (int n = 0; n < 2; ++n) acc[a][b][m][n] = (f32x4){0.f, 0.f, 0.f, 0.f};
    bf16x8 At[4][2], B0[2][2], B1[2][2];
    const char* cA = (const char*)g.A + (size_t)cur.pm * tstepA + (size_t)cur.acol * 2; const char* cB = (const char*)g.Bt + (size_t)cur.pn * tstep;
    S.a_ready(cur);
    PG8_STAGE(PG8_SB(0, 0), cB, voffB); PG8_STAGE(PG8_SA(0, 0), cA, voffA); PG8_STAGE(PG8_SB(0, 1), cB + hstep, voffB); PG8_STAGE(PG8_SA(0, 1), cA + hstepA, voffA);
    if (wr == 1) PG8_BAR;
    PG8_WAIT_V(4); PG8_BAR;
    PG8_STAGE(PG8_SB(1, 0), cB + kstep, voffB); PG8_STAGE(PG8_SA(1, 0), cA + kstep, voffA); PG8_STAGE(PG8_SB(1, 1), cB + hstep + kstep, voffB);
    PG8_WAIT_V(6); PG8_BAR;
    PG8_STAMP();
    for (;;) {
        const bool has_next = S.next(ui + 1, nxt);
        const char* nA = has_next ? (const char*)g.A + (size_t)nxt.pm * tstepA + (size_t)nxt.acol * 2 : cA; const char* nB = has_next ? (const char*)g.Bt + (size_t)nxt.pn * tstep : cB;
        const int ntu = cur.nt ? cur.nt : nt;
        for (int t = 0; t < ntu; t += 2) {
            const bool last = (t == ntu - 2);
            const char* a1 = cA + (size_t)(t + 1) * kstep;
            const char* a2 = last ? nA : cA + (size_t)(t + 2) * kstep; const char* b2 = last ? nB : cB + (size_t)(t + 2) * kstep;
            const char* a3 = a2 + kstep; const char* b3 = b2 + kstep;
            if (last && has_next) S.a_ready(nxt);
            PG8_LDB(B0, 0, 0); PG8_SCHED; PG8_LDA(At, 0, 0); PG8_STAGE(PG8_SA(1, 1), a1 + hstepA, voffA);
            PG8_WAIT_L(8); PG8_BAR; PG8_WAIT_L(0); PG8_MMA(0, 0, At, B0); PG8_BAR; PG8_SCHED;
            PG8_LDB(B1, 0, 1); PG8_STAGE(PG8_SB(0, 0), b2, voffB);
            PG8_BAR; PG8_WAIT_L(0); PG8_MMA(0, 1, At, B1); PG8_BAR;
            PG8_LDA(At, 0, 1); PG8_STAGE(PG8_SA(0, 0), a2, voffA);
            PG8_BAR; PG8_WAIT_L(0); PG8_MMA(1, 0, At, B0); PG8_BAR; PG8_SCHED;
            PG8_STAGE(PG8_SB(0, 1), b2 + hstep, voffB);
            PG8_WAIT_V(6); PG8_BAR; PG8_MMA(1, 1, At, B1); PG8_BAR;
            PG8_LDB(B0, 1, 0); PG8_SCHED; PG8_LDA(At, 1, 0); PG8_STAGE(PG8_SA(0, 1), a2 + hstepA, voffA);
            PG8_WAIT_L(8); PG8_BAR; PG8_WAIT_L(0); PG8_MMA(0, 0, At, B0); PG8_BAR; PG8_SCHED;
            PG8_LDB(B1, 1, 1); PG8_STAGE(PG8_SB(1, 0), b3, voffB);
            PG8_BAR; PG8_WAIT_L(0); PG8_MMA(0, 1, At, B1); PG8_BAR;
            PG8_LDA(At, 1, 1); PG8_STAGE(PG8_SA(1, 0), a3, voffA);
            PG8_BAR; PG8_WAIT_L(0); PG8_MMA(1, 0, At, B0); PG8_BAR; PG8_SCHED;
            PG8_STAGE(PG8_SB(1, 1), b3 + hstep, voffB);
            PG8_WAIT_V(6); PG8_BAR; PG8_MMA(1, 1, At, B1); PG8_BAR;
        }
        PG8_STAMP();
        if constexpr (!Epi::AFTER_DRAIN) { E(acc, cur, wr, wc, fr, fq); S.done(cur); }
        PG8_STAMP();
        if (!has_next) break;
#pragma unroll
        for (int a = 0; a < 2; ++a)
#pragma unroll
            for (int b = 0; b < 2; ++b)
#pragma unroll
                for (int m = 0; m < 4; ++m)
#pragma unroll
                    for (int n = 0; n < 2; ++n) acc[a][b][m][n] = (f32x4){0.f, 0.f, 0.f, 0.f};
        cur = nxt; cA = nA; cB = nB; ++ui;
    }
    PG8_WAIT_V(0);
    if (wr == 0) PG8_BAR;
    PG8_BAR;
    if constexpr (Epi::AFTER_DRAIN) { E.fused(acc, cur, wr, wc, fr, fq, lds, wid, lane); S.done(cur); }
    PG8_STAMP();
    if (STAMP && wid == 0) { stamps[lane] = lane < nts ? (((unsigned long long)(unsigned)ts_hi << 32) | (unsigned)ts_lo) : 0ull;
        if (lane == 62) stamps[62] = rt_entry; if (lane == 63) stamps[63] = (unsigned long long)wall_clock64(); }
#undef PG8_STAMP
#undef PG8_SA
#undef PG8_SB
#undef PG8_STAGE
#undef PG8_LDA
#undef PG8_LDB
#undef PG8_MMA
#undef PG8_WAIT_V
#undef PG8_WAIT_L
#undef PG8_BAR
#undef PG8_SCHED
}
}

#define LAS __attribute__((address_space(3)))
typedef unsigned short bf16_t;
constexpr int NWAVES = 8, NTHREADS = 512;
constexpr int LDS_BYTES = 147456;
constexpr int RING_OFF = 0;
constexpr int MISC_OFF = 131072;
constexpr int NINP = 7680;

__device__ __forceinline__ unsigned f2bf(float f) { unsigned u = __builtin_bit_cast(unsigned, f); return (u + 0x7fffu + ((u >> 16) & 1u)) >> 16; }
__device__ __forceinline__ unsigned pk2(float lo, float hi) { return f2bf(lo) | (f2bf(hi) << 16); }
__device__ __forceinline__ float bf2f(bf16_t b) { return __builtin_bit_cast(float, ((unsigned)b) << 16); }
typedef unsigned v4u __attribute__((ext_vector_type(4)));

__device__ __forceinline__ void transpose_item(const float* W, int K, int N, bf16_t* WT, int row_off, LAS float* scr, int item, int lane, int ldo = 0) {
  if (ldo == 0) ldo = K;
  const int nblk = N / 32, kb = item / nblk, nb = item % nblk, k0 = 64 * kb, n0 = 32 * nb;
  float wreg[32];
#pragma unroll
  for (int i = 0; i < 32; ++i) { const int kk = 2 * i + (lane >> 5); wreg[i] = W[(size_t)(k0 + kk) * N + n0 + (lane & 31)]; }
#pragma unroll
  for (int i = 0; i < 32; ++i) { const int kk = 2 * i + (lane >> 5); scr[kk * 33 + (lane & 31)] = wreg[i]; }
  asm volatile("s_waitcnt lgkmcnt(0)" ::: "memory");
  const int c = lane & 7;
#pragma unroll
  for (int j = 0; j < 4; ++j) { const int n = (lane >> 3) + 8 * j; const LAS float* s = scr + (8 * c) * 33 + n;
    v4u o; o.x = pk2(s[0 * 33], s[1 * 33]); o.y = pk2(s[2 * 33], s[3 * 33]); o.z = pk2(s[4 * 33], s[5 * 33]); o.w = pk2(s[6 * 33], s[7 * 33]);
    *(v4u*)(WT + (size_t)(row_off + n0 + n) * ldo + k0 + 8 * c) = o; }
  asm volatile("s_waitcnt lgkmcnt(0)" ::: "memory");
}

struct EpiProjF32 {
  static constexpr bool PERM = false, AFTER_DRAIN = false;
  float* C; int ldc; int ncols;
  __device__ __forceinline__ void operator()(const pg8::f32x4 (&acc)[2][2][4][2], const pg8::Unit& u, int wr, int wc, int fr, int fq) const {
    const int row0 = u.pm * 256 + wr * 64 + fr, col0 = u.pn * 256 + wc * 32 + 4 * fq;
#pragma unroll
    for (int ai = 0; ai < 2; ++ai)
#pragma unroll
      for (int m = 0; m < 4; ++m) { float* rowp = C + (size_t)(row0 + ai * 128 + m * 16) * ldc + col0;
#pragma unroll
        for (int bj = 0; bj < 2; ++bj)
#pragma unroll
          for (int n = 0; n < 2; ++n) if (col0 + bj * 128 + n * 16 < ncols) *(pg8::f32x4*)(rowp + bj * 128 + n * 16) = acc[ai][bj][m][n]; }
  }
};

__device__ __forceinline__ float fsigmoid(float x) { return 1.f / (1.f + __expf(-x)); }
template <bool ACCUM> struct EpiMerge {
  static constexpr bool PERM = true, AFTER_DRAIN = false;
  const float* gate; int ldg; bf16_t* M; int ldm;
  __device__ __forceinline__ void operator()(const pg8::f32x4 (&acc)[2][2][4][2], const pg8::Unit& u, int wr, int wc, int fr, int fq) const {
    const int row0 = u.pm * 256 + wr * 64 + fr, col0 = u.pn * 256 + wc * 32 + 8 * fq;
#pragma unroll
    for (int ai = 0; ai < 2; ++ai)
#pragma unroll
      for (int m = 0; m < 4; ++m) { const size_t r = (size_t)(row0 + ai * 128 + m * 16);
#pragma unroll
        for (int bj = 0; bj < 2; ++bj) { const int c = col0 + bj * 128;
          const pg8::f32x4 g0 = *(const pg8::f32x4*)(gate + r * ldg + c), g1 = *(const pg8::f32x4*)(gate + r * ldg + c + 4);
          pg8::f32x4 v0 = acc[ai][bj][m][0], v1 = acc[ai][bj][m][1];
#pragma unroll
          for (int e = 0; e < 4; ++e) { v0[e] *= fsigmoid(g0[e]); v1[e] *= fsigmoid(g1[e]); }
          v4u* dst = (v4u*)(M + r * ldm + c);
          if (ACCUM) { const v4u o = *dst; v0[0] += bf2f(o.x & 0xffff); v0[1] += bf2f(o.x >> 16); v0[2] += bf2f(o.y & 0xffff); v0[3] += bf2f(o.y >> 16);
            v1[0] += bf2f(o.z & 0xffff); v1[1] += bf2f(o.z >> 16); v1[2] += bf2f(o.w & 0xffff); v1[3] += bf2f(o.w >> 16); }
          v4u o2; o2.x = pk2(v0[0], v0[1]); o2.y = pk2(v0[2], v0[3]); o2.z = pk2(v1[0], v1[1]); o2.w = pk2(v1[2], v1[3]); *dst = o2; } }
  }
};
struct EpiOut {
  static constexpr bool PERM = false, AFTER_DRAIN = false;
  const float* resL; float* outL; const float* gL;
  const float* resC; float* outC; const float* gC;
  __device__ __forceinline__ void operator()(const pg8::f32x4 (&acc)[2][2][4][2], const pg8::Unit& u, int wr, int wc, int fr, int fq) const {
    const bool isc = u.pm == 16; if (isc && outC == nullptr) return;
    const float* res = isc ? resC : resL; float* out = isc ? outC : outL; const float* gv = isc ? gC : gL;
    const int row0 = (isc ? 0 : u.pm * 256) + wr * 64 + fr, col0 = u.pn * 256 + wc * 32 + 4 * fq;
    pg8::f32x4 gg[2][2];
#pragma unroll
    for (int bj = 0; bj < 2; ++bj)
#pragma unroll
      for (int n = 0; n < 2; ++n) gg[bj][n] = *(const pg8::f32x4*)(gv + col0 + bj * 128 + n * 16);
#pragma unroll
    for (int ai = 0; ai < 2; ++ai)
#pragma unroll
      for (int m = 0; m < 4; ++m) { const size_t ro = (size_t)(row0 + ai * 128 + m * 16) * 1024 + col0;
#pragma unroll
        for (int bj = 0; bj < 2; ++bj)
#pragma unroll
          for (int n = 0; n < 2; ++n) { const pg8::f32x4 rv = *(const pg8::f32x4*)(res + ro + bj * 128 + n * 16); *(pg8::f32x4*)(out + ro + bj * 128 + n * 16) = rv + gg[bj][n] * acc[ai][bj][m][n]; } }
  }
};
namespace att {
using bf16 = __hip_bfloat16;
constexpr int D = 128, NW = 8, QBLK = 32, KVBLK = 64; constexpr float SCALE = 0.088388347648318440f; constexpr float THR = 8.f; constexpr int SDEPTH = 2;
constexpr size_t SHM_V = KVBLK * D * 2, SHM_K = KVBLK * D * 2, SHM_ATTN = 2 * SHM_V + 2 * SHM_K + NW * 64 * 4;
using bf16x8 = __attribute__((ext_vector_type(8))) short;
using s16x4  = __attribute__((ext_vector_type(4))) short;
using f32x16 = __attribute__((ext_vector_type(16))) float;
using f32x8  = __attribute__((ext_vector_type(8))) float;
using u32x4  = __attribute__((ext_vector_type(4))) unsigned;
#define KSWZ(row, colB) ((row) * 256 + ((colB) ^ (((row) & 7) << 4)))
#define SBAR() __builtin_amdgcn_sched_barrier(0)
__device__ __forceinline__ int crow(int r, int hi) { return (r & 3) + 8 * (r >> 2) + 4 * hi; }
__device__ __forceinline__ unsigned cvtpk(float lo, float hi) {
  unsigned r; asm volatile("v_cvt_pk_bf16_f32 %0, %1, %2" : "=v"(r) : "v"(lo), "v"(hi)); return r;
}
template <typename TIn> struct Stage;
template <> struct Stage<bf16>  { using T = bf16x8;
  __device__ static __forceinline__ T ld8(const bf16* p) { return *reinterpret_cast<const bf16x8*>(p); }
  __device__ static __forceinline__ bf16x8 tobf(T x) { return x; } };
template <> struct Stage<float> { using T = f32x8;
  __device__ static __forceinline__ T ld8(const float* p) { return *reinterpret_cast<const f32x8*>(p); }
  __device__ static __forceinline__ bf16x8 tobf(T x) {
    u32x4 w = {cvtpk(x[0], x[1]), cvtpk(x[2], x[3]), cvtpk(x[4], x[5]), cvtpk(x[6], x[7])}; return *reinterpret_cast<bf16x8*>(&w); } };

__device__ __forceinline__ void partialSM(f32x16& p0, f32x16& p1, float& m_reg, float& mn, float& alpha) {
  constexpr float C = SCALE * 1.4426950408889634f;
  float pmax = p0[0]; for (int r = 1; r < 16; ++r) pmax = fmaxf(pmax, p0[r]); for (int r = 0; r < 16; ++r) pmax = fmaxf(pmax, p1[r]);
  { auto rr = __builtin_amdgcn_permlane32_swap(__float_as_uint(pmax), __float_as_uint(pmax), false, false);
    pmax = fmaxf(__uint_as_float(rr[0]), __uint_as_float(rr[1])); }
  if (__builtin_expect(__all(pmax - m_reg <= THR / SCALE), 1)) { mn = m_reg; alpha = 1.f; }
  else { mn = fmaxf(m_reg, pmax); alpha = __builtin_amdgcn_exp2f((m_reg - mn) * C); m_reg = mn; }
  float mnC = -mn * C;
  for (int r = 0; r < 16; ++r) p0[r] = fmaf(p0[r], C, mnC); for (int r = 0; r < 16; ++r) p1[r] = fmaf(p1[r], C, mnC);
  for (int r = 0; r < 16; ++r) p0[r] = __builtin_amdgcn_exp2f(p0[r]);
}
__device__ __forceinline__ void finishSM(f32x16& p0, f32x16& p1, float alpha, float& l_reg, bf16x8& pa0, bf16x8& pa1, bf16x8& pa2, bf16x8& pa3) {
  for (int r = 0; r < 16; ++r) p1[r] = __builtin_amdgcn_exp2f(p1[r]);
  float ps = 0; for (int r = 0; r < 16; ++r) ps += p0[r]; for (int r = 0; r < 16; ++r) ps += p1[r];
  { auto rr = __builtin_amdgcn_permlane32_swap(__float_as_uint(ps), __float_as_uint(ps), false, false);
    ps = __uint_as_float(rr[0]) + __uint_as_float(rr[1]); }
  l_reg = l_reg * alpha + ps;
#define PK4(P, BASE, OUT) do { unsigned a0 = cvtpk(P[BASE + 0], P[BASE + 1]), a1 = cvtpk(P[BASE + 2], P[BASE + 3]);   \
    unsigned b0 = cvtpk(P[BASE + 4], P[BASE + 5]), b1 = cvtpk(P[BASE + 6], P[BASE + 7]);                              \
    auto r0 = __builtin_amdgcn_permlane32_swap(a0, b0, false, false); auto r1 = __builtin_amdgcn_permlane32_swap(a1, b1, false, false); \
    u32x4 w = {r0[0], r1[0], r0[1], r1[1]}; OUT = *reinterpret_cast<bf16x8*>(&w); } while (0)
  PK4(p0, 0, pa0); PK4(p0, 8, pa1); PK4(p1, 0, pa2); PK4(p1, 8, pa3);
#undef PK4
}
__device__ __forceinline__ void qkt(f32x16& p0, f32x16& p1, const bf16* Ks, const bf16x8* qr, int r32, int hi) {
  p0 = f32x16{}; p1 = f32x16{};
  for (int d0 = 0; d0 < 8; ++d0) { int cb = (d0 * 16 + hi * 8) * 2;
    bf16x8 b0 = *reinterpret_cast<const bf16x8*>((const char*)Ks + KSWZ(r32, cb));
    bf16x8 b1 = *reinterpret_cast<const bf16x8*>((const char*)Ks + KSWZ(32 + r32, cb));
    p0 = __builtin_amdgcn_mfma_f32_32x32x16_bf16(b0, qr[d0], p0, 0, 0, 0);
    p1 = __builtin_amdgcn_mfma_f32_32x32x16_bf16(b1, qr[d0], p1, 0, 0, 0); }
}
__device__ __forceinline__ int v_st(int k, int c) { const int kk = (k & ~0xC) | ((k & 4) << 1) | ((k & 8) >> 1); return ((kk >> 3) * 4 + (c >> 5)) * 512 + ((kk & 7) * 32 + (c & 31)) * 2; }
__device__ __forceinline__ int v_rd_base(int lane) { return ((lane & 3) << 3) | (((lane >> 2) & 3) << 6) | (((lane >> 4) & 1) << 5) | (((lane >> 5) & 1) << 8); }
constexpr int v_rd_off(int d0, int ks, int half) { return d0 * 512 + ks * 4096 + half * 2048; }
template <int OFF> __device__ __forceinline__ s16x4 tr_read(int vb) {
  s16x4 r; asm volatile("ds_read_b64_tr_b16 %0, %1 offset:%2" : "=&v"(r) : "v"(vb), "i"(OFF) : "memory"); return r;
}
template <int D0> __device__ __forceinline__ void pv_one(f32x16& od, int vb, bf16x8 pa0, bf16x8 pa1, bf16x8 pa2, bf16x8 pa3) {
  const s16x4 l0 = tr_read<v_rd_off(D0, 0, 0)>(vb), h0 = tr_read<v_rd_off(D0, 0, 1)>(vb), l1 = tr_read<v_rd_off(D0, 1, 0)>(vb), h1 = tr_read<v_rd_off(D0, 1, 1)>(vb);
  const s16x4 l2 = tr_read<v_rd_off(D0, 2, 0)>(vb), h2 = tr_read<v_rd_off(D0, 2, 1)>(vb), l3 = tr_read<v_rd_off(D0, 3, 0)>(vb), h3 = tr_read<v_rd_off(D0, 3, 1)>(vb);
  asm volatile("s_waitcnt lgkmcnt(0)" ::: "memory"); SBAR();
#define PK(L, H) (bf16x8){L[0], L[1], L[2], L[3], H[0], H[1], H[2], H[3]}
  od = __builtin_amdgcn_mfma_f32_32x32x16_bf16(pa0, PK(l0, h0), od, 0, 0, 0);
  od = __builtin_amdgcn_mfma_f32_32x32x16_bf16(pa1, PK(l1, h1), od, 0, 0, 0);
  od = __builtin_amdgcn_mfma_f32_32x32x16_bf16(pa2, PK(l2, h2), od, 0, 0, 0);
  od = __builtin_amdgcn_mfma_f32_32x32x16_bf16(pa3, PK(l3, h3), od, 0, 0, 0);
#undef PK
}
__device__ __forceinline__ void pv_d0(f32x16* o, int vb, bf16x8 pa0, bf16x8 pa1, bf16x8 pa2, bf16x8 pa3) {
  pv_one<0>(o[0], vb, pa0, pa1, pa2, pa3); pv_one<1>(o[1], vb, pa0, pa1, pa2, pa3); pv_one<2>(o[2], vb, pa0, pa1, pa2, pa3); pv_one<3>(o[3], vb, pa0, pa1, pa2, pa3);
}

template <typename TQ, int LDQ, int LDK, int LDO, bool OBF16>
__device__ __forceinline__ void attn_dense_body(const TQ* Qb, const bf16* Kh, const bf16* Vh,
                                                void* Obv, int seq, char* lds) {
  using St = Stage<bf16>; using SQ = Stage<TQ>;
  int tid = threadIdx.x; asm volatile("" : "+v"(tid)); const int wid = tid >> 6, lane = tid & 63, r32 = lane & 31, hi = lane >> 5;
  bf16* V_lds = (bf16*)lds; bf16* K_lds = (bf16*)(lds + 2 * SHM_V);
  float* ws = (float*)(lds + 2 * SHM_V + 2 * SHM_K) + wid * 64; float* li_l = ws; float* al_l = ws + 32;
  float m_reg = -1e30f, l_reg = 0; f32x16 o[4] = {}; bf16x8 qr[8];
  const TQ* Qw = Qb + (long)(wid * QBLK + r32) * LDQ + hi * 8;
#pragma unroll
  for (int d0 = 0; d0 < 8; ++d0) qr[d0] = SQ::tobf(SQ::ld8(Qw + d0 * 16));
  const int sr = tid >> 4, sc = (tid & 15) * 8, vst0 = v_st(sr, sc), vst1 = v_st(32 + sr, sc);
  const int vb0 = (int)(uintptr_t)V_lds + v_rd_base(lane);
  struct { typename St::T vs0, vs1, ks0, ks1; } sr_[SDEPTH];
#define SLOAD(i, k0) do { sr_[i].vs0 = St::ld8(&Vh[(long)((k0) + sr) * LDK + sc]); sr_[i].vs1 = St::ld8(&Vh[(long)((k0) + 32 + sr) * LDK + sc]); \
    sr_[i].ks0 = St::ld8(&Kh[(long)((k0) + sr) * LDK + sc]); sr_[i].ks1 = St::ld8(&Kh[(long)((k0) + 32 + sr) * LDK + sc]); } while (0)
#define SWRITE(b, i) do { *(bf16x8*)((char*)V_lds + (b) * SHM_V + vst0) = St::tobf(sr_[i].vs0);          \
    *(bf16x8*)((char*)V_lds + (b) * SHM_V + vst1) = St::tobf(sr_[i].vs1); int kc = sc * 2;               \
    *(bf16x8*)((char*)K_lds + (b) * SHM_K + KSWZ(sr, kc)) = St::tobf(sr_[i].ks0);                       \
    *(bf16x8*)((char*)K_lds + (b) * SHM_K + KSWZ(32 + sr, kc)) = St::tobf(sr_[i].ks1); } while (0)
#define SWAIT() do { if constexpr (SDEPTH == 2) asm volatile("s_waitcnt vmcnt(4)" ::: "memory"); else asm volatile("s_waitcnt vmcnt(0)" ::: "memory"); } while (0)
#define RESC(a) do { if (__any((a) < 1.f)) { if (hi == 0) al_l[r32] = (a); asm volatile("s_waitcnt lgkmcnt(0)" ::: "memory"); \
    for (int d = 0; d < 4; ++d) for (int r = 0; r < 16; ++r) o[d][r] *= al_l[crow(r, hi)]; } } while (0)
  f32x16 pA0, pA1, pB0, pB1; float mnA, mnB, alA, alB; bf16x8 pa0, pa1, pa2, pa3; const int NT = seq / KVBLK;
  constexpr int SE = 0, SO = SDEPTH - 1;
  SLOAD(SE, 0); asm volatile("s_waitcnt vmcnt(0)" ::: "memory"); SWRITE(0, SE); __syncthreads();
  qkt(pA0, pA1, K_lds, qr, r32, hi); partialSM(pA0, pA1, m_reg, mnA, alA);
  SLOAD(SO, KVBLK); if constexpr (SDEPTH == 2) { if (2 < NT) SLOAD(SE, 2 * KVBLK); }
  SWAIT(); SWRITE(1, SO); __syncthreads();
  for (int j = 1; j + 1 < NT; j += 2) {
    SBAR(); qkt(pB0, pB1, (bf16*)((char*)K_lds + SHM_K), qr, r32, hi);
    finishSM(pA0, pA1, alA, l_reg, pa0, pa1, pa2, pa3); SBAR();
    SLOAD(SO, (j + SDEPTH) * KVBLK); SBAR();
    pv_d0(o, vb0, pa0, pa1, pa2, pa3); partialSM(pB0, pB1, m_reg, mnB, alB);
    __syncthreads(); SWAIT(); SWRITE(0, SE);
    RESC(alB); __syncthreads();
    SBAR(); qkt(pA0, pA1, K_lds, qr, r32, hi);
    finishSM(pB0, pB1, alB, l_reg, pa0, pa1, pa2, pa3); SBAR();
    if (SDEPTH == 1 || j + 3 < NT) SLOAD(SE, (j + 1 + SDEPTH) * KVBLK); SBAR();
    pv_d0(o, vb0 + (int)SHM_V, pa0, pa1, pa2, pa3); partialSM(pA0, pA1, m_reg, mnA, alA);
    __syncthreads(); SWAIT(); SWRITE(1, SO);
    RESC(alA); __syncthreads();
  }
  SBAR(); qkt(pB0, pB1, (bf16*)((char*)K_lds + SHM_K), qr, r32, hi);
  finishSM(pA0, pA1, alA, l_reg, pa0, pa1, pa2, pa3); SBAR();
  pv_d0(o, vb0, pa0, pa1, pa2, pa3); partialSM(pB0, pB1, m_reg, mnB, alB);
  __syncthreads(); RESC(alB);
  finishSM(pB0, pB1, alB, l_reg, pa0, pa1, pa2, pa3); SBAR();
  pv_d0(o, vb0 + (int)SHM_V, pa0, pa1, pa2, pa3);
  if (hi == 0) li_l[r32] = l_reg; asm volatile("s_waitcnt lgkmcnt(0)" ::: "memory");
  float rli[16];
#pragma unroll
  for (int r = 0; r < 16; ++r) rli[r] = __builtin_amdgcn_rcpf(li_l[crow(r, hi)]);
  if constexpr (!OBF16) { float* Ow = (float*)Obv + (long)(wid * QBLK) * LDO;
#pragma unroll
  for (int r = 0; r < 16; ++r) { int orow = crow(r, hi);
    for (int d0 = 0; d0 < 4; ++d0) Ow[(long)orow * LDO + d0 * 32 + r32] = o[d0][r] * rli[r]; }
  } else { unsigned short* Ow = (unsigned short*)Obv + (long)(wid * QBLK) * LDO;
#pragma unroll
  for (int r = 0; r < 16; ++r) { int orow = crow(r, hi);
    for (int d0 = 0; d0 < 4; ++d0) { const unsigned pk = cvtpk(o[d0][r] * rli[r], 0.f); Ow[(long)orow * LDO + d0 * 32 + r32] = (unsigned short)(pk & 0xffffu); } }
  }
#undef SLOAD
#undef SWRITE
#undef SWAIT
#undef RESC
}
#undef KSWZ
#undef SBAR
}
namespace gla {
typedef float f32x16 __attribute__((ext_vector_type(16)));
typedef float f32x4v __attribute__((ext_vector_type(4)));
constexpr int LD = 65;
constexpr int OX = 0, OY = 2 * 64 * LD * 4, OV = 4 * 64 * LD * 4, OAL = OV + 64 * 128 * 4, OW2 = OAL + 64 * 32 * 4, OBA = OW2 + 2 * 16 * 64 * 4, OTOT = OBA + 2 * 64 * 4, OEND = OTOT + 2 * 64 * 4 * 4;
static_assert(OEND <= 131072, "gla lds");
static_assert(64 * 129 * 4 <= 2 * 64 * LD * 4, "O stage fits in X");

struct In {
  const bf16_t* q; const bf16_t* k; const bf16_t* v; const bf16_t* ga; const bf16_t* og; int ld;
  const float* wa2; const float* ba; const float* gnorm;
  float* cs;
  bf16_t* csb;
  float* dec;
  bf16_t* y; int ldy;
  int S, C;
};
__device__ __forceinline__ long chunk_row(const In& p, int cid) { return cid < p.S / 64 ? (long)cid * 64 : (long)p.S + (long)(cid - p.S / 64) * 64; }
__device__ __forceinline__ float logsig(float x) { return x < 0.f ? x - __logf(1.f + __expf(x)) : -__logf(1.f + __expf(-x)); }

__device__ __forceinline__ void cum_phase(const In& p, LAS unsigned char* lds, int head, long row0, int tid) {
  LAS float* AL = (LAS float*)(lds + OAL); LAS float* W2 = (LAS float*)(lds + OW2); LAS float* BA = (LAS float*)(lds + OBA); LAS float* TOT = (LAS float*)(lds + OTOT);
  { const int t = tid >> 3, r4 = (tid & 7) * 4; const unsigned long long u = *(const unsigned long long*)(p.ga + (row0 + t) * p.ld + r4);
    f32x4v a4; a4[0] = bf2f((bf16_t)u); a4[1] = bf2f((bf16_t)(u >> 16)); a4[2] = bf2f((bf16_t)(u >> 32)); a4[3] = bf2f((bf16_t)(u >> 48)); *(LAS f32x4v*)(AL + t * 32 + r4) = a4; }
  { const int e = tid * 4, dir = e >> 10, r = (e >> 6) & 15, j = e & 63; *(LAS f32x4v*)(W2 + e) = *(const f32x4v*)(p.wa2 + ((long)dir * 16 + r) * 256 + head * 64 + j); }
  if (tid < 128) BA[tid] = p.ba[(tid >> 6) * 256 + head * 64 + (tid & 63)];
  __syncthreads();
  const int dir = tid >> 8, j = tid & 63, seg = (tid >> 6) & 3;
  float w[16];
#pragma unroll
  for (int r = 0; r < 16; ++r) w[r] = W2[(dir * 16 + r) * 64 + j];
  const float bj = BA[dir * 64 + j];
  float c[16];
#pragma unroll
  for (int k = 0; k < 16; ++k) { const int t = seg * 16 + k; float z = bj;
#pragma unroll
    for (int r4 = 0; r4 < 4; ++r4) { const f32x4v a4 = *(const LAS f32x4v*)(AL + t * 32 + dir * 16 + 4 * r4); z += a4[0] * w[4 * r4] + a4[1] * w[4 * r4 + 1] + a4[2] * w[4 * r4 + 2] + a4[3] * w[4 * r4 + 3]; }
    c[k] = logsig(z) * (1.f / 16.f); }
  if (dir == 0) {
#pragma unroll
    for (int k = 1; k < 16; ++k) c[k] += c[k - 1];
    TOT[(dir * 64 + j) * 4 + seg] = c[15];
  } else {
#pragma unroll
    for (int k = 14; k >= 0; --k) c[k] += c[k + 1];
    TOT[(dir * 64 + j) * 4 + seg] = c[0];
  }
  __syncthreads();
  float off = 0.f;
#pragma unroll
  for (int s = 0; s < 4; ++s) { const float tv = TOT[(dir * 64 + j) * 4 + s]; if (dir == 0 ? s < seg : s > seg) off += tv; }
  LAS float* X = (LAS float*)(lds + OX) + dir * 64 * LD;
#pragma unroll
  for (int k = 0; k < 16; ++k) X[(seg * 16 + k) * LD + j] = c[k] + off;
}
struct VRegs { unsigned long long u[4]; };
__device__ __forceinline__ VRegs load_v_regs(const In& p, int head, long row0, int tid) { VRegs r;
#pragma unroll
  for (int m = 0; m < 4; ++m) { const int t = (tid >> 5) + 16 * m, c4 = (tid & 31) * 4; r.u[m] = *(const unsigned long long*)(p.v + (row0 + t) * p.ld + head * 128 + c4); }
  return r; }
__device__ __forceinline__ void store_v(const VRegs& r, LAS unsigned char* lds, int tid) {
  LAS float* V = (LAS float*)(lds + OV);
#pragma unroll
  for (int m = 0; m < 4; ++m) { const int t = (tid >> 5) + 16 * m, c4 = (tid & 31) * 4; const unsigned long long u = r.u[m];
    f32x4v a4; a4[0] = bf2f((bf16_t)u); a4[1] = bf2f((bf16_t)(u >> 16)); a4[2] = bf2f((bf16_t)(u >> 32)); a4[3] = bf2f((bf16_t)(u >> 48)); *(LAS f32x4v*)(V + t * 128 + c4) = a4; }
}

__device__ __forceinline__ void g1_unit(const In& p, LAS unsigned char* lds, int head, int cid, int GH, int NCH) {
  int tid = threadIdx.x; asm volatile("" : "+v"(tid));
  const int lane = tid & 63, w = __builtin_amdgcn_readfirstlane(tid >> 6);
  const long row0 = chunk_row(p, cid);
  const VRegs vr = load_v_regs(p, head, row0, tid);
  bf16_t kreg[8];
#pragma unroll
  for (int m = 0; m < 8; ++m) kreg[m] = p.k[(row0 + (tid >> 6) + 8 * m) * p.ld + head * 64 + (tid & 63)];
  cum_phase(p, lds, head, row0, tid);
  store_v(vr, lds, tid);
  __syncthreads();
  LAS float* TOT = (LAS float*)(lds + OTOT);
  { const int j = tid & 63;
#pragma unroll
    for (int dir = 0; dir < 2; ++dir) { LAS float* X = (LAS float*)(lds + OX) + dir * 64 * LD;
      const float cl = TOT[(dir * 64 + j) * 4 + 0] + TOT[(dir * 64 + j) * 4 + 1] + TOT[(dir * 64 + j) * 4 + 2] + TOT[(dir * 64 + j) * 4 + 3];
#pragma unroll
      for (int m = 0; m < 8; ++m) { const int t = (tid >> 6) + 8 * m; const float kv = bf2f(kreg[m]); X[t * LD + j] = kv * __expf(cl - X[t * LD + j]); }
      if (tid < 64) p.dec[(((long)dir * GH + head) * NCH + cid) * 64 + j] = __expf(cl); }
  }
  __syncthreads();
  { const int dir = w >> 2, di = (w >> 1) & 1, vj0 = (w & 1) * 2; const LAS float* X = (const LAS float*)(lds + OX) + dir * 64 * LD; const LAS float* V = (const LAS float*)(lds + OV);
    f32x16 a0 = {}, a1 = {}; const int li = lane & 31, lk = lane >> 5;
#pragma unroll 4
    for (int s0 = 0; s0 < 64; s0 += 2) { const float av = X[(s0 + lk) * LD + 32 * di + li]; const float b0 = V[(s0 + lk) * 128 + 32 * vj0 + li], b1 = V[(s0 + lk) * 128 + 32 * vj0 + 32 + li];
      a0 = __builtin_amdgcn_mfma_f32_32x32x2f32(av, b0, a0, 0, 0, 0); a1 = __builtin_amdgcn_mfma_f32_32x32x2f32(av, b1, a1, 0, 0, 0); }
    float* dst = p.cs + ((((long)dir * GH + head) * NCH + cid) * 64) * 128;
#pragma unroll
    for (int r = 0; r < 16; ++r) { const int d = 32 * di + (r & 3) + 8 * (r >> 2) + 4 * lk; dst[(long)d * 128 + 32 * vj0 + li] = a0[r]; dst[(long)d * 128 + 32 * vj0 + 32 + li] = a1[r]; }
  }
  __syncthreads();
}
__device__ __forceinline__ void g2_item(const In& p, long idx, int GH, int NCH) {
  const int v = 2 * (int)(idx & 63), d = (int)((idx >> 6) & 63); const int hd = (int)((idx >> 12) % GH), dir = (int)((idx >> 12) / GH);
  const int nl = p.S / 64, nc = p.C / 64; float st0 = 0.f, st1 = 0.f;
  bf16_t* base = p.csb + (((long)dir * GH + hd) * NCH) * 64 * 128 + (long)d * 128 + v; const float* db = p.dec + (((long)dir * GH + hd) * NCH) * 64 + d;
  for (int s0 = 0; s0 < nl + nc; s0 += 4) { unsigned c[4]; float dc[4]; unsigned* pp[4];
#pragma unroll
    for (int k = 0; k < 4; ++k) { const int step = s0 + k; int cid; if (step < nc) cid = nl + (dir ? nc - 1 - step : step); else cid = dir ? nl - 1 - (step - nc) : step - nc;
      pp[k] = (unsigned*)(base + (long)cid * 64 * 128); c[k] = *pp[k]; dc[k] = db[(long)cid * 64]; }
#pragma unroll
    for (int k = 0; k < 4; ++k) { *pp[k] = pk2(st0, st1); st0 = dc[k] * st0 + __uint_as_float(c[k] << 16); st1 = dc[k] * st1 + __uint_as_float(c[k] & 0xffff0000u); } }
}
__device__ __forceinline__ void g3_unit(const In& p, LAS unsigned char* lds, int head, int cid, int GH, int NCH) {
  int tid = threadIdx.x; asm volatile("" : "+v"(tid));
  const int lane = tid & 63, w = __builtin_amdgcn_readfirstlane(tid >> 6), li = lane & 31, lk = lane >> 5;
  const long row0 = chunk_row(p, cid);
  float spf[2][32];
  { const int vj_ = w & 3;
#pragma unroll
    for (int dir = 0; dir < 2; ++dir) { const float* sp = p.cs + ((((long)dir * GH + head) * NCH + cid) * 64) * 128 + 32 * vj_ + li;
#pragma unroll
      for (int i = 0; i < 32; ++i) spf[dir][i] = sp[(long)(2 * i + lk) * 128]; } }
  const VRegs vr = load_v_regs(p, head, row0, tid);
  bf16_t kreg[8], qreg[8];
#pragma unroll
  for (int m = 0; m < 8; ++m) { const long o_ = (row0 + (tid >> 6) + 8 * m) * p.ld + head * 64 + (tid & 63); kreg[m] = p.k[o_]; qreg[m] = p.q[o_]; }
  cum_phase(p, lds, head, row0, tid);
  store_v(vr, lds, tid);
  __syncthreads();
  { const int j = tid & 63;
#pragma unroll
    for (int dir = 0; dir < 2; ++dir) { LAS float* X = (LAS float*)(lds + OX) + dir * 64 * LD; LAS float* Y = (LAS float*)(lds + OY) + dir * 64 * LD;
#pragma unroll
      for (int m = 0; m < 8; ++m) { const int t = (tid >> 6) + 8 * m; const float c = X[t * LD + j];
        const float qv = bf2f(qreg[m]) * 0.125f, kv = bf2f(kreg[m]);
        X[t * LD + j] = qv * __expf(c); Y[t * LD + j] = kv * __expf(-c); } }
  }
  __syncthreads();
  {
    const int dir = w >> 2, qi = (w >> 1) & 1, si = w & 1; const bool zero = dir == 0 ? si > qi : si < qi;
    const LAS float* X = (const LAS float*)(lds + OX) + dir * 64 * LD; LAS float* Y = (LAS float*)(lds + OY) + dir * 64 * LD;
    f32x16 pa = {};
    if (!zero) {
#pragma unroll 4
      for (int d0 = 0; d0 < 64; d0 += 2) pa = __builtin_amdgcn_mfma_f32_32x32x2f32(X[(32 * qi + li) * LD + d0 + lk], Y[(32 * si + li) * LD + d0 + lk], pa, 0, 0, 0);
    }
    __syncthreads();
#pragma unroll
    for (int r = 0; r < 16; ++r) { const int q = 32 * qi + (r & 3) + 8 * (r >> 2) + 4 * lk, s = 32 * si + li; const bool keep = dir == 0 ? s <= q : s >= q;
      Y[q * LD + s] = keep ? pa[r] : 0.f; }
  }
  __syncthreads();
  f32x16 acc = {};
  { const int qi = w >> 2, vj = w & 3; const LAS float* V = (const LAS float*)(lds + OV);
#pragma unroll
    for (int dir = 0; dir < 2; ++dir) { const LAS float* X = (const LAS float*)(lds + OX) + dir * 64 * LD; const LAS float* Y = (const LAS float*)(lds + OY) + dir * 64 * LD;
#pragma unroll 4
      for (int s0 = 0; s0 < 64; s0 += 2) acc = __builtin_amdgcn_mfma_f32_32x32x2f32(Y[(32 * qi + li) * LD + s0 + lk], V[(s0 + lk) * 128 + 32 * vj + li], acc, 0, 0, 0);
#pragma unroll
      for (int i = 0; i < 32; ++i) acc = __builtin_amdgcn_mfma_f32_32x32x2f32(X[(32 * qi + li) * LD + 2 * i + lk], spf[dir][i], acc, 0, 0, 0);
    }
    __syncthreads();
    LAS float* O = (LAS float*)(lds + OX);
#pragma unroll
    for (int r = 0; r < 16; ++r) { const int q = 32 * qi + (r & 3) + 8 * (r >> 2) + 4 * lk; O[q * 129 + 32 * vj + li] = acc[r]; }
  }
  __syncthreads();
  { const int row = tid >> 3, part = tid & 7; const LAS float* O = (const LAS float*)(lds + OX) + row * 129 + part * 16;
    float o[16]; float ss = 0.f;
#pragma unroll
    for (int k = 0; k < 16; ++k) { o[k] = O[k]; ss += o[k] * o[k]; }
    ss += __shfl_xor(ss, 1); ss += __shfl_xor(ss, 2); ss += __shfl_xor(ss, 4);
    const float rs = 1.f / sqrtf(ss * (1.f / 128.f) + 1e-6f);
    const bf16_t* ogp = p.og + (row0 + row) * p.ld + head * 128 + part * 16; const v4u og0 = *(const v4u*)ogp, og1 = *(const v4u*)(ogp + 8);
    const unsigned ogw[8] = {og0.x, og0.y, og0.z, og0.w, og1.x, og1.y, og1.z, og1.w}; bf16_t* yp = p.y + (row0 + row) * p.ldy + head * 128 + part * 16; float yy[16];
#pragma unroll
    for (int k4 = 0; k4 < 4; ++k4) { f32x4v g4; g4[0] = bf2f((bf16_t)(ogw[2 * k4] & 0xffff)); g4[1] = bf2f((bf16_t)(ogw[2 * k4] >> 16)); g4[2] = bf2f((bf16_t)(ogw[2 * k4 + 1] & 0xffff)); g4[3] = bf2f((bf16_t)(ogw[2 * k4 + 1] >> 16)); const f32x4v n4 = *(const f32x4v*)(p.gnorm + part * 16 + 4 * k4); f32x4v y4;
#pragma unroll
      for (int e = 0; e < 4; ++e) { const float gg = g4[e]; y4[e] = o[4 * k4 + e] * rs * n4[e] * (gg / (1.f + __expf(-gg))); yy[4 * k4 + e] = y4[e]; } }
    { v4u o0, o1; o0.x = pk2(yy[0], yy[1]); o0.y = pk2(yy[2], yy[3]); o0.z = pk2(yy[4], yy[5]); o0.w = pk2(yy[6], yy[7]);
      o1.x = pk2(yy[8], yy[9]); o1.y = pk2(yy[10], yy[11]); o1.z = pk2(yy[12], yy[13]); o1.w = pk2(yy[14], yy[15]); *(v4u*)yp = o0; *(v4u*)(yp + 8) = o1; }
  }
  __syncthreads();
}

typedef short bf16x8g __attribute__((ext_vector_type(8)));
constexpr int LB = 72;
constexpr int OQB = 2 * 64 * LD * 4, OKB = OQB + 2 * 64 * LB * 2, OVT = OKB + 2 * 64 * LB * 2, OBEND = OVT + 128 * LB * 2;
static_assert(OBEND <= OAL, "gla bf16 lds");
#define GMM(A, B, C) C = __builtin_amdgcn_mfma_f32_32x32x16_bf16(__builtin_bit_cast(bf16x8g, A), __builtin_bit_cast(bf16x8g, B), C, 0, 0, 0)
__device__ __forceinline__ void store_vt(const VRegs& r, LAS unsigned char* lds, int tid) {
  LAS bf16_t* Vt = (LAS bf16_t*)(lds + OVT);
#pragma unroll
  for (int m = 0; m < 4; ++m) { const int t = (tid >> 5) + 16 * m, c4 = (tid & 31) * 4; const unsigned long long u = r.u[m];
    Vt[(c4 + 0) * LB + t] = (bf16_t)u; Vt[(c4 + 1) * LB + t] = (bf16_t)(u >> 16); Vt[(c4 + 2) * LB + t] = (bf16_t)(u >> 32); Vt[(c4 + 3) * LB + t] = (bf16_t)(u >> 48); }
}
__device__ __forceinline__ void g1b_unit(const In& p, LAS unsigned char* lds, int head, int cid, int GH, int NCH) {
  int tid = threadIdx.x; asm volatile("" : "+v"(tid));
  const int lane = tid & 63, w = __builtin_amdgcn_readfirstlane(tid >> 6), li = lane & 31, lk = lane >> 5;
  const long row0 = chunk_row(p, cid);
  const VRegs vr = load_v_regs(p, head, row0, tid);
  bf16_t kreg[8];
#pragma unroll
  for (int m = 0; m < 8; ++m) kreg[m] = p.k[(row0 + (tid >> 6) + 8 * m) * p.ld + head * 64 + (tid & 63)];
  cum_phase(p, lds, head, row0, tid);
  store_vt(vr, lds, tid);
  __syncthreads();
  LAS float* TOT = (LAS float*)(lds + OTOT);
  { const int j = tid & 63;
#pragma unroll
    for (int dir = 0; dir < 2; ++dir) { const LAS float* X = (const LAS float*)(lds + OX) + dir * 64 * LD; LAS bf16_t* KeT = (LAS bf16_t*)(lds + OQB) + dir * 64 * LB;
      const float cl = TOT[(dir * 64 + j) * 4 + 0] + TOT[(dir * 64 + j) * 4 + 1] + TOT[(dir * 64 + j) * 4 + 2] + TOT[(dir * 64 + j) * 4 + 3];
#pragma unroll
      for (int m = 0; m < 8; ++m) { const int t = (tid >> 6) + 8 * m; KeT[j * LB + t] = (bf16_t)f2bf(bf2f(kreg[m]) * __expf(cl - X[t * LD + j])); }
      if (tid < 64) p.dec[(((long)dir * GH + head) * NCH + cid) * 64 + j] = __expf(cl); }
  }
  __syncthreads();
  { const int dir = w >> 2, di = (w >> 1) & 1, vj0 = (w & 1) * 2; const LAS bf16_t* KeT = (const LAS bf16_t*)(lds + OQB) + dir * 64 * LB; const LAS bf16_t* Vt = (const LAS bf16_t*)(lds + OVT);
    f32x16 a0 = {}, a1 = {};
#pragma unroll
    for (int kk = 0; kk < 4; ++kk) { const v4u av = *(const LAS v4u*)(KeT + (32 * di + li) * LB + 16 * kk + 8 * lk);
      const v4u b0 = *(const LAS v4u*)(Vt + (32 * vj0 + li) * LB + 16 * kk + 8 * lk), b1 = *(const LAS v4u*)(Vt + (32 * vj0 + 32 + li) * LB + 16 * kk + 8 * lk);
      GMM(av, b0, a0); GMM(av, b1, a1); }
    bf16_t* dst = p.csb + ((((long)dir * GH + head) * NCH + cid) * 64) * 128;
#pragma unroll
    for (int r = 0; r < 16; ++r) { const int d = 32 * di + (r & 3) + 8 * (r >> 2) + 4 * lk; dst[(long)d * 128 + 32 * vj0 + li] = (bf16_t)f2bf(a0[r]); dst[(long)d * 128 + 32 * vj0 + 32 + li] = (bf16_t)f2bf(a1[r]); }
  }
  __syncthreads();
}
__device__ __forceinline__ void g3b_unit(const In& p, LAS unsigned char* lds, int head, int cid, int GH, int NCH) {
  int tid = threadIdx.x; asm volatile("" : "+v"(tid));
  const int lane = tid & 63, w = __builtin_amdgcn_readfirstlane(tid >> 6), li = lane & 31, lk = lane >> 5;
  const long row0 = chunk_row(p, cid);
  unsigned spf[2][32];
  { const int vj_ = w & 3;
#pragma unroll
    for (int dir = 0; dir < 2; ++dir) { const bf16_t* sp = p.csb + ((((long)dir * GH + head) * NCH + cid) * 64) * 128 + 32 * vj_ + li;
#pragma unroll
      for (int i = 0; i < 32; ++i) spf[dir][i] = sp[(long)(16 * (i >> 3) + 8 * lk + (i & 7)) * 128]; } }
  const VRegs vr = load_v_regs(p, head, row0, tid);
  bf16_t kreg[8], qreg[8];
#pragma unroll
  for (int m = 0; m < 8; ++m) { const long o_ = (row0 + (tid >> 6) + 8 * m) * p.ld + head * 64 + (tid & 63); kreg[m] = p.k[o_]; qreg[m] = p.q[o_]; }
  cum_phase(p, lds, head, row0, tid);
  store_vt(vr, lds, tid);
  __syncthreads();
  { const int j = tid & 63;
#pragma unroll
    for (int dir = 0; dir < 2; ++dir) { const LAS float* X = (const LAS float*)(lds + OX) + dir * 64 * LD; LAS bf16_t* Qb = (LAS bf16_t*)(lds + OQB) + dir * 64 * LB; LAS bf16_t* Kb = (LAS bf16_t*)(lds + OKB) + dir * 64 * LB;
#pragma unroll
      for (int m = 0; m < 8; ++m) { const int t = (tid >> 6) + 8 * m; const float c = X[t * LD + j];
        Qb[t * LB + j] = (bf16_t)f2bf(bf2f(qreg[m]) * 0.125f * __expf(c)); Kb[t * LB + j] = (bf16_t)f2bf(bf2f(kreg[m]) * __expf(-c)); } }
  }
  __syncthreads();
  {
    const int dir = w >> 2, qi = (w >> 1) & 1, si = w & 1; const bool zero = dir == 0 ? si > qi : si < qi;
    const LAS bf16_t* Qb = (const LAS bf16_t*)(lds + OQB) + dir * 64 * LB; LAS bf16_t* Kb = (LAS bf16_t*)(lds + OKB) + dir * 64 * LB;
    f32x16 pa = {};
    if (!zero) {
#pragma unroll
      for (int kk = 0; kk < 4; ++kk) { const v4u av = *(const LAS v4u*)(Qb + (32 * qi + li) * LB + 16 * kk + 8 * lk), bv = *(const LAS v4u*)(Kb + (32 * si + li) * LB + 16 * kk + 8 * lk); GMM(av, bv, pa); }
    }
    __syncthreads();
#pragma unroll
    for (int r = 0; r < 16; ++r) { const int q = 32 * qi + (r & 3) + 8 * (r >> 2) + 4 * lk, s = 32 * si + li; const bool keep = dir == 0 ? s <= q : s >= q;
      Kb[q * LB + s] = (bf16_t)f2bf(keep ? pa[r] : 0.f); }
  }
  __syncthreads();
  f32x16 acc = {};
  { const int qi = w >> 2, vj = w & 3; const LAS bf16_t* Vt = (const LAS bf16_t*)(lds + OVT);
#pragma unroll
    for (int dir = 0; dir < 2; ++dir) { const LAS bf16_t* Qb = (const LAS bf16_t*)(lds + OQB) + dir * 64 * LB; const LAS bf16_t* Pb = (const LAS bf16_t*)(lds + OKB) + dir * 64 * LB;
#pragma unroll
      for (int kk = 0; kk < 4; ++kk) { const v4u av = *(const LAS v4u*)(Pb + (32 * qi + li) * LB + 16 * kk + 8 * lk), bv = *(const LAS v4u*)(Vt + (32 * vj + li) * LB + 16 * kk + 8 * lk); GMM(av, bv, acc); }
#pragma unroll
      for (int kk = 0; kk < 4; ++kk) { const v4u av = *(const LAS v4u*)(Qb + (32 * qi + li) * LB + 16 * kk + 8 * lk);
        v4u bv; bv.x = spf[dir][8 * kk + 0] | (spf[dir][8 * kk + 1] << 16); bv.y = spf[dir][8 * kk + 2] | (spf[dir][8 * kk + 3] << 16); bv.z = spf[dir][8 * kk + 4] | (spf[dir][8 * kk + 5] << 16); bv.w = spf[dir][8 * kk + 6] | (spf[dir][8 * kk + 7] << 16);
        GMM(av, bv, acc); }
    }
    LAS float* O = (LAS float*)(lds + OX);
#pragma unroll
    for (int r = 0; r < 16; ++r) { const int q = 32 * qi + (r & 3) + 8 * (r >> 2) + 4 * lk; O[q * 129 + 32 * vj + li] = acc[r]; }
  }
  __syncthreads();
  { const int row = tid >> 3, part = tid & 7; const LAS float* O = (const LAS float*)(lds + OX) + row * 129 + part * 16;
    float o[16]; float ss = 0.f;
#pragma unroll
    for (int k = 0; k < 16; ++k) { o[k] = O[k]; ss += o[k] * o[k]; }
    ss += __shfl_xor(ss, 1); ss += __shfl_xor(ss, 2); ss += __shfl_xor(ss, 4);
    const float rs = 1.f / sqrtf(ss * (1.f / 128.f) + 1e-6f);
    const bf16_t* ogp = p.og + (row0 + row) * p.ld + head * 128 + part * 16; const v4u og0 = *(const v4u*)ogp, og1 = *(const v4u*)(ogp + 8);
    const unsigned ogw[8] = {og0.x, og0.y, og0.z, og0.w, og1.x, og1.y, og1.z, og1.w}; bf16_t* yp = p.y + (row0 + row) * p.ldy + head * 128 + part * 16; float yy[16];
#pragma unroll
    for (int k4 = 0; k4 < 4; ++k4) { f32x4v g4; g4[0] = bf2f((bf16_t)(ogw[2 * k4] & 0xffff)); g4[1] = bf2f((bf16_t)(ogw[2 * k4] >> 16)); g4[2] = bf2f((bf16_t)(ogw[2 * k4 + 1] & 0xffff)); g4[3] = bf2f((bf16_t)(ogw[2 * k4 + 1] >> 16)); const f32x4v n4 = *(const f32x4v*)(p.gnorm + part * 16 + 4 * k4);
#pragma unroll
      for (int e = 0; e < 4; ++e) { const float gg = g4[e]; yy[4 * k4 + e] = o[4 * k4 + e] * rs * n4[e] * (gg / (1.f + __expf(-gg))); } }
    { v4u o0, o1; o0.x = pk2(yy[0], yy[1]); o0.y = pk2(yy[2], yy[3]); o0.z = pk2(yy[4], yy[5]); o0.w = pk2(yy[6], yy[7]);
      o1.x = pk2(yy[8], yy[9]); o1.y = pk2(yy[10], yy[11]); o1.z = pk2(yy[12], yy[13]); o1.w = pk2(yy[14], yy[15]); *(v4u*)yp = o0; *(v4u*)(yp + 8) = o1; }
  }
  __syncthreads();
}
#undef GMM
}
namespace moe {
constexpr int NE = 16, NG = 4, EPG = 4, DE = 512, D = 1024;
__device__ __forceinline__ float wave_sum(float v) {
#pragma unroll
  for (int o = 1; o < 64; o <<= 1) v += __shfl_xor(v, o);
  return v;
}
struct Route { int e0, r0, e1, r1; };
struct MoeOrder {
  int G, c, NT; const LAS int* poff;
  __device__ __forceinline__ bool next(int i, pg8::Unit& u) const {
    const long L = (long)i * G + c; const int total = poff[NE] * NT; if (L >= total) return false;
    const int panel = (int)L / NT, j = (int)L % NT; int e = 0;
#pragma unroll
    for (int k = 1; k < NE; ++k) e += (panel >= poff[k]) ? 1 : 0;
    u.pm = panel; u.pn = e * NT + j; u.acol = 0; u.nt = 0; return true;
  }
  __device__ __forceinline__ void a_ready(const pg8::Unit&) const {}
  __device__ __forceinline__ void done(const pg8::Unit&) const {}
};
struct EpiGU {
  static constexpr bool PERM = true, AFTER_DRAIN = false;
  bf16_t* hid;
  __device__ __forceinline__ void operator()(const pg8::f32x4 (&acc)[2][2][4][2], const pg8::Unit& u, int wr, int wc, int fr, int fq) const {
    const int j = u.pn & 3; const int row0 = u.pm * 256 + wr * 64 + fr, col0 = j * 128 + wc * 32 + 8 * fq;
#pragma unroll
    for (int ai = 0; ai < 2; ++ai)
#pragma unroll
      for (int m = 0; m < 4; ++m) { const size_t r = (size_t)(row0 + ai * 128 + m * 16); float hv[8];
#pragma unroll
        for (int n = 0; n < 2; ++n)
#pragma unroll
          for (int e = 0; e < 4; ++e) { const float g = acc[ai][0][m][n][e], up = acc[ai][1][m][n][e]; hv[4 * n + e] = g / (1.f + __expf(-g)) * up; }
        v4u o; o.x = pk2(hv[0], hv[1]); o.y = pk2(hv[2], hv[3]); o.z = pk2(hv[4], hv[5]); o.w = pk2(hv[6], hv[7]);
        *(v4u*)(hid + r * DE + col0) = o; }
  }
};
struct EpiDown {
  static constexpr bool PERM = true, AFTER_DRAIN = false;
  const int* srcrow; const float* wgt; bf16_t* contrib; size_t slot_stride;
  __device__ __forceinline__ void operator()(const pg8::f32x4 (&acc)[2][2][4][2], const pg8::Unit& u, int wr, int wc, int fr, int fq) const {
    const int pn = u.pn & 3; const int row0 = u.pm * 256 + wr * 64 + fr, col0 = pn * 256 + wc * 32 + 8 * fq;
    int srcs[2][4]; float ws_[2][4];
#pragma unroll
    for (int ai = 0; ai < 2; ++ai)
#pragma unroll
      for (int m = 0; m < 4; ++m) { const int r = row0 + ai * 128 + m * 16; srcs[ai][m] = srcrow[r]; ws_[ai][m] = wgt[r]; }
#pragma unroll
    for (int ai = 0; ai < 2; ++ai)
#pragma unroll
      for (int m = 0; m < 4; ++m) { const int src = srcs[ai][m]; if (src < 0) continue; const float w = ws_[ai][m];
        bf16_t* dst = contrib + (size_t)(src & 1) * slot_stride + (size_t)(src >> 1) * D + col0;
#pragma unroll
        for (int bj = 0; bj < 2; ++bj) { const pg8::f32x4 v0 = acc[ai][bj][m][0] * w, v1 = acc[ai][bj][m][1] * w;
          v4u o; o.x = pk2(v0[0], v0[1]); o.y = pk2(v0[2], v0[3]); o.z = pk2(v1[0], v1[1]); o.w = pk2(v1[2], v1[3]); *(v4u*)(dst + bj * 128) = o; } }
  }
};
__device__ __forceinline__ void route_row(const bf16_t* xr, const float* gnorm, const float* shift, const float* scale, bf16_t* hrow, const LAS float* rwT, const float* rbias,
                                          LAS int* cnt, Route* rt, float* wts, int lane) {
  typedef float f4 __attribute__((ext_vector_type(4)));
  f4 xv[4]; float ss = 0.f;
#pragma unroll
  for (int j = 0; j < 4; ++j) { const uint2 rw = *(const uint2*)(xr + 4 * lane + 256 * j); xv[j][0] = __uint_as_float(rw.x << 16); xv[j][1] = __uint_as_float(rw.x & 0xffff0000u); xv[j][2] = __uint_as_float(rw.y << 16); xv[j][3] = __uint_as_float(rw.y & 0xffff0000u); ss += xv[j][0] * xv[j][0] + xv[j][1] * xv[j][1] + xv[j][2] * xv[j][2] + xv[j][3] * xv[j][3]; }
  const float rs = 1.f / sqrtf(wave_sum(ss) * (1.f / 1024.f) + 1e-6f);
  float lg[NE];
#pragma unroll
  for (int e = 0; e < NE; ++e) lg[e] = 0.f;
#pragma unroll
  for (int j = 0; j < 4; ++j) { const int c = 4 * lane + 256 * j; const f4 g4 = *(const f4*)(gnorm + c), sh = *(const f4*)(shift + c), sc = *(const f4*)(scale + c);
    f4 h;
#pragma unroll
    for (int i = 0; i < 4; ++i) h[i] = xv[j][i] * rs * g4[i] * (1.f + sc[i]) + sh[i];
    *(unsigned long long*)(hrow + c) = (unsigned long long)pk2(h[0], h[1]) | ((unsigned long long)pk2(h[2], h[3]) << 32);
#pragma unroll
    for (int e = 0; e < NE; ++e) { const f4 w4 = *(const LAS f4*)(rwT + e * 1024 + c); lg[e] += h[0] * w4[0] + h[1] * w4[1] + h[2] * w4[2] + h[3] * w4[3]; } }
  { float v8[8], v4[4], v2[2], v1;
#pragma unroll
    for (int i = 0; i < 8; ++i) { const bool up = lane & 1; const float keep = up ? lg[2 * i + 1] : lg[2 * i], send = up ? lg[2 * i] : lg[2 * i + 1]; v8[i] = keep + __shfl_xor(send, 1); }
#pragma unroll
    for (int i = 0; i < 4; ++i) { const bool up = lane & 2; const float keep = up ? v8[2 * i + 1] : v8[2 * i], send = up ? v8[2 * i] : v8[2 * i + 1]; v4[i] = keep + __shfl_xor(send, 2); }
#pragma unroll
    for (int i = 0; i < 2; ++i) { const bool up = lane & 4; const float keep = up ? v4[2 * i + 1] : v4[2 * i], send = up ? v4[2 * i] : v4[2 * i + 1]; v2[i] = keep + __shfl_xor(send, 4); }
    { const bool up = lane & 8; const float keep = up ? v2[1] : v2[0], send = up ? v2[0] : v2[1]; v1 = keep + __shfl_xor(send, 8); }
    v1 += __shfl_xor(v1, 16); v1 += __shfl_xor(v1, 32);
#pragma unroll
    for (int e = 0; e < NE; ++e) lg[e] = __shfl(v1, e); }
  float sc[NE], sel[NE];
#pragma unroll
  for (int e = 0; e < NE; ++e) { sc[e] = 1.f / (1.f + __expf(-lg[e])); sel[e] = sc[e] + rbias[e]; }
  int bestg = 0; float bestgs = -1e30f;
#pragma unroll
  for (int g = 0; g < NG; ++g) { float m1 = -1e30f, m2 = -1e30f;
#pragma unroll
    for (int i = 0; i < EPG; ++i) { const float v = sel[g * EPG + i]; if (v > m1) { m2 = m1; m1 = v; } else if (v > m2) m2 = v; }
    const float gsum = m1 + m2; if (gsum > bestgs) { bestgs = gsum; bestg = g; } }
  int i1 = -1, i2 = -1; float v1 = -1e30f, v2 = -1e30f, s1 = 0.f, s2 = 0.f;
#pragma unroll
  for (int e = 0; e < NE; ++e) { if (e / EPG == bestg) { const float v = sel[e];
      if (v > v1) { v2 = v1; i2 = i1; s2 = s1; v1 = v; i1 = e; s1 = sc[e]; } else if (v > v2) { v2 = v; i2 = e; s2 = sc[e]; } } }
  if (lane == 0) { const float inv = 1.f / (s1 + s2); Route r; r.e0 = i1; r.e1 = i2; r.r0 = __hip_atomic_fetch_add(cnt + i1, 1, __ATOMIC_RELAXED, __HIP_MEMORY_SCOPE_WORKGROUP); r.r1 = __hip_atomic_fetch_add(cnt + i2, 1, __ATOMIC_RELAXED, __HIP_MEMORY_SCOPE_WORKGROUP); *rt = r; wts[0] = s1 * inv; wts[1] = s2 * inv; }
}
}
namespace hy {
typedef float f32x16 __attribute__((ext_vector_type(16)));
constexpr int S = 4096, NT1 = 128, LDZ = 191, ZPAD = 31, LDX = 129;
constexpr int O_TAPS = 0, O_ZA = 32768, O_ZB = O_ZA + 32 * LDZ * 4, O_X1 = O_ZB + 32 * LDZ * 4, O_X2 = O_X1 + 32 * LDX * 4, O_RED = O_X2 + 32 * LDX * 4, O_END = O_RED + 4 * 64 * 16 * 4;
static_assert(O_END <= 131072, "hyena lds");

struct H0Regs { v4u w0, w1; };
__device__ __forceinline__ H0Regs h0_load(const bf16_t* u, int ld, int tile, int tid) {
  const int tt = tile / 24, jt = tile % 24, t0 = tt * 64, j0 = jt * 64; H0Regs r; r.w0 = (v4u){0u, 0u, 0u, 0u}; r.w1 = r.w0;
  { const int rr = tid >> 3, c8 = (tid & 7) * 8, t = t0 - 1 + rr; if (t >= 0 && t < S) r.w0 = *(const v4u*)(u + (size_t)t * ld + j0 + c8); }
  if (tid < 16) { const int rr = 64 + (tid >> 3), c8 = (tid & 7) * 8, t = t0 - 1 + rr; if (t < S) r.w1 = *(const v4u*)(u + (size_t)t * ld + j0 + c8); }
  return r;
}
__device__ __forceinline__ void h0_compute(const H0Regs& rg, const float* cw, const float* cb, bf16_t* ucT, int tile, LAS unsigned char* lds, int tid) {
  const int tt = tile / 24, jt = tile % 24, t0 = tt * 64, j0 = jt * 64;
  LAS float* U = (LAS float*)lds;
  { const int rr = tid >> 3, c8 = (tid & 7) * 8; const v4u w = rg.w0; LAS float* d = U + rr * 65 + c8;
    d[0] = bf2f(w.x & 0xffff); d[1] = bf2f(w.x >> 16); d[2] = bf2f(w.y & 0xffff); d[3] = bf2f(w.y >> 16); d[4] = bf2f(w.z & 0xffff); d[5] = bf2f(w.z >> 16); d[6] = bf2f(w.w & 0xffff); d[7] = bf2f(w.w >> 16); }
  if (tid < 16) { const int rr = 64 + (tid >> 3), c8 = (tid & 7) * 8; const v4u w = rg.w1; LAS float* d = U + rr * 65 + c8;
    d[0] = bf2f(w.x & 0xffff); d[1] = bf2f(w.x >> 16); d[2] = bf2f(w.y & 0xffff); d[3] = bf2f(w.y >> 16); d[4] = bf2f(w.z & 0xffff); d[5] = bf2f(w.z >> 16); d[6] = bf2f(w.w & 0xffff); d[7] = bf2f(w.w >> 16); }
  __syncthreads();
  { const int jj = tid >> 3, tq = (tid & 7) * 8, j = j0 + jj; const float w0 = cw[j], w1 = cw[1536 + j], w2 = cw[2 * 1536 + j], bb = cb[j]; float v[8];
#pragma unroll
    for (int k = 0; k < 8; ++k) v[k] = bb + w0 * U[(tq + k) * 65 + jj] + w1 * U[(tq + k + 1) * 65 + jj] + w2 * U[(tq + k + 2) * 65 + jj];
    v4u o; o.x = pk2(v[0], v[1]); o.y = pk2(v[2], v[3]); o.z = pk2(v[4], v[5]); o.w = pk2(v[6], v[7]); *(v4u*)(ucT + (size_t)j * S + t0 + tq) = o; }
  __syncthreads();
}
__device__ __forceinline__ void h2_tile(const bf16_t* yT, bf16_t* ybf, int ldy, int tile, LAS unsigned char* lds) {
  int tid = threadIdx.x; asm volatile("" : "+v"(tid));
  const int tt = tile / 8, ct = tile % 8, t0 = tt * 64, c0 = ct * 64;
  LAS bf16_t* T = (LAS bf16_t*)lds;
  { const int cc = tid >> 3, t8 = (tid & 7) * 8; const v4u w = *(const v4u*)(yT + (size_t)(c0 + cc) * S + t0 + t8); LAS unsigned* d = (LAS unsigned*)(T + cc * 66 + t8); d[0] = w.x; d[1] = w.y; d[2] = w.z; d[3] = w.w; }
  __syncthreads();
  { const int t = tid >> 3, c8 = (tid & 7) * 8; unsigned short e[8];
#pragma unroll
    for (int k = 0; k < 8; ++k) e[k] = T[(c8 + k) * 66 + t];
    v4u o; o.x = e[0] | ((unsigned)e[1] << 16); o.y = e[2] | ((unsigned)e[3] << 16); o.z = e[4] | ((unsigned)e[5] << 16); o.w = e[6] | ((unsigned)e[7] << 16);
    *(v4u*)(ybf + (size_t)(t0 + t) * ldy + c0 + c8) = o; }
  __syncthreads();
}
__device__ __forceinline__ void h1_unit(const bf16_t* ucT, const float* tapsT, const float* nrm, const float* skip, bf16_t* yT, int c, LAS unsigned char* lds) {
  int tid = threadIdx.x; asm volatile("" : "+v"(tid));
  const int lane = tid & 63, w = __builtin_amdgcn_readfirstlane(tid >> 6), li = lane & 31, lk = lane >> 5;
  LAS float* TAPS = (LAS float*)(lds + O_TAPS); LAS float* ZA = (LAS float*)(lds + O_ZA); LAS float* ZB = (LAS float*)(lds + O_ZB);
  LAS float* X1 = (LAS float*)(lds + O_X1); LAS float* X2 = (LAS float*)(lds + O_X2); LAS float* RED = (LAS float*)(lds + O_RED);
  for (int e = tid; e < 32 * 62; e += 512) { const int s2 = e / 62, p = e % 62, t1p = p < 31 ? p : 128 + p; ZA[s2 * LDZ + t1p] = 0.f; ZB[s2 * LDZ + t1p] = 0.f; }
  for (int t = tid; t < S; t += 512) { const int t2 = t & 31, t1 = t >> 5;
    X1[t2 * LDX + t1] = bf2f(ucT[(size_t)c * S + t]); X2[t2 * LDX + t1] = bf2f(ucT[(size_t)(512 + c) * S + t]); ZA[t2 * LDZ + t1 + ZPAD] = bf2f(ucT[(size_t)(1024 + c) * S + t]); }
#pragma unroll 1
  for (int o = 0; o < 2; ++o) {
    const float* tp = tapsT + ((size_t)o * 512 + c) * 8192;
    for (int e = tid; e < 8192; e += 512) TAPS[e] = tp[(e + 4096) & 8191];
    __syncthreads();
    const LAS float* Zin = o == 0 ? ZA : ZB;
    const int g = w & 3, dh = w >> 2;
    const int Dlo = 32 * g - 127 + (dh ? 80 : 0), Dn = dh ? 79 : 80;
    f32x16 acc = {};
    { const LAS float* ap = TAPS + 4096 + 32 * Dlo + li - lk - 30;
      const LAS float* bp = Zin + lk * LDZ + (32 * g + li - Dlo + ZPAD);
#pragma unroll 2
      for (int dd = 0; dd < Dn; ++dd) {
#pragma unroll
        for (int kk = 0; kk < 16; ++kk) acc = __builtin_amdgcn_mfma_f32_32x32x2f32(ap[(15 - kk) * 2], bp[2 * kk * LDZ], acc, 0, 0, 0);
        ap += 32; bp -= 1; }
    }
    if (dh) {
#pragma unroll
      for (int r = 0; r < 16; ++r) RED[(g * 64 + lane) * 16 + r] = acc[r]; }
    __syncthreads();
    if (!dh) { const float inv = 1.f / nrm[o * 512 + c], sk = skip[o * 512 + c]; const LAS float* G = o == 0 ? X1 : X2; LAS float* Out = o == 0 ? ZB : ZA;
#pragma unroll
      for (int r = 0; r < 16; ++r) { const int t2 = (r & 3) + 8 * (r >> 2) + 4 * lk, t1 = 32 * g + li;
        const float cv = (acc[r] + RED[(g * 64 + lane) * 16 + r]) * inv; const float zin = Zin[t2 * LDZ + t1 + ZPAD];
        Out[t2 * LDZ + t1 + ZPAD] = G[t2 * LDX + t1] * (cv + sk * zin); } }
    __syncthreads();
  }
  for (int t = tid; t < S; t += 512) yT[(size_t)c * S + t] = (bf16_t)f2bf(ZA[(t & 31) * LDZ + (t >> 5) + ZPAD]);
  __syncthreads();
}

typedef short bf16x8v __attribute__((ext_vector_type(8)));
typedef unsigned u32x2v __attribute__((ext_vector_type(2)));
constexpr int CSB = 16448;
constexpr int ZROW = 80, ZROWS = 190;
constexpr int B_CS = 0, B_ZA = 4 * CSB, B_ZB = B_ZA + 15232, B_X1 = B_ZB + 15232, B_X2 = B_X1 + 8256, B_RED = B_X2 + 8256, B_END = B_RED + 16384;
static_assert(B_END <= 131072 && B_ZA % 16 == 0 && B_X1 % 16 == 0, "hyena bf16 lds");
__device__ __forceinline__ void h1b_unit(const bf16_t* ucT, const bf16_t* tapsB, const float* nrm, const float* skip, bf16_t* yT, int c, LAS unsigned char* lds) {
  int tid = threadIdx.x; asm volatile("" : "+v"(tid));
  const int lane = tid & 63, w = __builtin_amdgcn_readfirstlane(tid >> 6), li = lane & 31, lk = lane >> 5;
  LAS bf16_t* ZA = (LAS bf16_t*)(lds + B_ZA); LAS bf16_t* ZB = (LAS bf16_t*)(lds + B_ZB); LAS bf16_t* X1 = (LAS bf16_t*)(lds + B_X1); LAS bf16_t* X2 = (LAS bf16_t*)(lds + B_X2);
  LAS float* RED = (LAS float*)(lds + B_RED);
  for (int e = tid; e < 62 * 20; e += 512) { const int p = e / 20, d = e % 20, row = p < 31 ? p : 128 + p; ((LAS unsigned*)ZA)[row * 20 + d] = 0u; ((LAS unsigned*)ZB)[row * 20 + d] = 0u; }
  { const v4u zv = *(const v4u*)(ucT + (size_t)(1024 + c) * S + tid * 8); const int t = tid * 8; *(LAS v4u*)((LAS unsigned char*)ZA + ((t >> 5) + ZPAD) * ZROW + (t & 31) * 2) = zv; }
  { const v4u xa = *(const v4u*)(ucT + (size_t)c * S + tid * 8), xb = *(const v4u*)(ucT + (size_t)(512 + c) * S + tid * 8); const int t1 = tid >> 2, t2b = (tid & 3) * 8;
    const unsigned wa[4] = {xa.x, xa.y, xa.z, xa.w}, wb[4] = {xb.x, xb.y, xb.z, xb.w};
#pragma unroll
    for (int k = 0; k < 4; ++k) { X1[(t2b + 2 * k) * LDX + t1] = (bf16_t)(wa[k] & 0xffff); X1[(t2b + 2 * k + 1) * LDX + t1] = (bf16_t)(wa[k] >> 16);
      X2[(t2b + 2 * k) * LDX + t1] = (bf16_t)(wb[k] & 0xffff); X2[(t2b + 2 * k + 1) * LDX + t1] = (bf16_t)(wb[k] >> 16); } }
  typedef unsigned u4a __attribute__((ext_vector_type(4), aligned(4))); typedef const __attribute__((address_space(1))) u4a* gp4;
  v4u cv[9];
#pragma unroll 1
  for (int o = 0; o < 2; ++o) {
#define HTAPS_LOAD(oo) { const __attribute__((address_space(1))) unsigned char* tb = (const __attribute__((address_space(1))) unsigned char*)(tapsB + ((size_t)(oo) * 512 + c) * 2 * 8232); \
      _Pragma("unroll") for (int it = 0; it < 9; ++it) { const int e = tid + 512 * it; const int s = e / 1028, q = e % 1028; cv[it] = (v4u){0u, 0u, 0u, 0u}; if (e < 4 * 1028) cv[it] = *(gp4)(tb + (size_t)(s & 1) * 16464 + 16 * q + 4 * (s >> 1)); } }
    if (o == 0) HTAPS_LOAD(0)
    {
#pragma unroll
      for (int it = 0; it < 9; ++it) { const int e = tid + 512 * it; const int s = e / 1028, q = e % 1028; if (e < 4 * 1028) *(LAS v4u*)(lds + B_CS + s * CSB + 16 * q) = cv[it]; } }
    __syncthreads();
    if (o == 0) HTAPS_LOAD(1)
    const LAS bf16_t* Zin = o == 0 ? ZA : ZB;
    const int g = w & 3, dh = w >> 2;
    const int Dlo = 32 * g - 127 + (dh ? 81 : 0), Dn = dh ? 78 : 81;
    f32x16 acc = {};
    { const int s = (4 - (li & 3)) & 3;
      const LAS unsigned char* ap = lds + B_CS + s * CSB + 2 * (4096 - 32 * Dlo - li + 8 * lk - s);
      const LAS unsigned char* bp = (const LAS unsigned char*)Zin + (32 * g + li - Dlo + ZPAD) * ZROW + 16 * lk;
#define HLD(A0, A1, B0, B1) { const u32x2v p0_ = *(const LAS u32x2v*)(ap), p1_ = *(const LAS u32x2v*)(ap2), p2_ = *(const LAS u32x2v*)(ap3), p3_ = *(const LAS u32x2v*)(ap4); \
        A0 = (v4u){p0_.x, p0_.y, p1_.x, p1_.y}; A1 = (v4u){p2_.x, p2_.y, p3_.x, p3_.y}; B0 = *(const LAS v4u*)(bp); B1 = *(const LAS v4u*)(bp + 32); ap -= 64; ap2 -= 64; ap3 -= 64; ap4 -= 64; bp -= ZROW; }
#define HMM(A, B) acc = __builtin_amdgcn_mfma_f32_32x32x16_bf16(__builtin_bit_cast(bf16x8v, A), __builtin_bit_cast(bf16x8v, B), acc, 0, 0, 0)
#define HOPQ(name, off) unsigned name##i = (unsigned)(unsigned long long)(ap + (off)); asm volatile("" : "+v"(name##i)); const LAS unsigned char* name = (const LAS unsigned char*)(unsigned long long)name##i;
      HOPQ(ap2, 8) HOPQ(ap3, 32) HOPQ(ap4, 40)
#undef HOPQ
      v4u fa0, fa1, fb0, fb1, ga0, ga1, gb0, gb1, ha0, ha1, hb0, hb1;
      HLD(fa0, fa1, fb0, fb1)
      HLD(ga0, ga1, gb0, gb1)
      for (int dd_ = 0; dd_ < Dn - 3; dd_ += 3) {
        HLD(ha0, ha1, hb0, hb1)
        HMM(fa0, fb0); HMM(fa1, fb1);
        HLD(fa0, fa1, fb0, fb1)
        HMM(ga0, gb0); HMM(ga1, gb1);
        HLD(ga0, ga1, gb0, gb1)
        HMM(ha0, hb0); HMM(ha1, hb1);
      }
      HLD(ha0, ha1, hb0, hb1)
      HMM(fa0, fb0); HMM(fa1, fb1); HMM(ga0, gb0); HMM(ga1, gb1); HMM(ha0, hb0); HMM(ha1, hb1);
#undef HLD
#undef HMM
    }
    if (dh) {
#pragma unroll
      for (int r = 0; r < 16; ++r) RED[(g * 64 + lane) * 16 + r] = acc[r]; }
    __syncthreads();
    if (!dh) { const float inv = 1.f / nrm[o * 512 + c], sk = skip[o * 512 + c]; const LAS bf16_t* G = o == 0 ? X1 : X2; LAS bf16_t* Out = o == 0 ? ZB : ZA;
#pragma unroll
      for (int r = 0; r < 16; ++r) { const int t2 = (r & 3) + 8 * (r >> 2) + 4 * lk, t1 = 32 * g + li;
        const float cv = (acc[r] + RED[(g * 64 + lane) * 16 + r]) * inv; const float zin = bf2f(Zin[(t1 + ZPAD) * (ZROW / 2) + t2]);
        Out[(t1 + ZPAD) * (ZROW / 2) + t2] = (bf16_t)f2bf(bf2f(G[t2 * LDX + t1]) * (cv + sk * zin)); } }
    __syncthreads();
  }
  { const int t = tid * 8; *(v4u*)(yT + (size_t)c * S + t) = *(const LAS v4u*)((const LAS unsigned char*)ZA + ((t >> 5) + ZPAD) * ZROW + (t & 31) * 2); }
  __syncthreads();
}
#undef HTAPS_LOAD

constexpr int C_ZP = 15, C_ZB = 159 * ZROW  , C_CS = 0, C_Z0 = 4 * CSB, C_X0 = C_Z0 + 2 * C_ZB, C_END = C_X0 + 4 * 8256;
static_assert(C_END <= 131072 && C_Z0 % 16 == 0 && C_ZB % 16 == 0 && C_X0 % 16 == 0, "hyena two-batch lds");
__device__ __forceinline__ void h1c_unit(const bf16_t* ucT2, const bf16_t* tapsB, const float* nrm, const float* skip, bf16_t* yT2, int c, LAS unsigned char* lds) {
  int tid = threadIdx.x; asm volatile("" : "+v"(tid));
  const int lane = tid & 63, g = __builtin_amdgcn_readfirstlane(tid >> 6), li = lane & 31, lk = lane >> 5, bsel = li >> 4, t1l = li & 15;
  for (int e = tid; e < 2 * 31 * 20; e += 512) { const int b = e / (31 * 20), p = (e / 20) % 31, d = e % 20, row = p < 15 ? p : 128 + p; ((LAS unsigned*)(lds + C_Z0 + b * C_ZB))[row * 20 + d] = 0u; }
#pragma unroll
  for (int b = 0; b < 2; ++b) { const bf16_t* uc = ucT2 + (size_t)b * 1536 * S; const int t = tid * 8;
    const v4u zv = *(const v4u*)(uc + (size_t)(1024 + c) * S + t), xa = *(const v4u*)(uc + (size_t)c * S + t), xb = *(const v4u*)(uc + (size_t)(512 + c) * S + t);
    *(LAS v4u*)(lds + C_Z0 + b * C_ZB + ((t >> 5) + C_ZP) * ZROW + (t & 31) * 2) = zv;
    LAS bf16_t* X1 = (LAS bf16_t*)(lds + C_X0 + (2 * b) * 8256); LAS bf16_t* X2 = (LAS bf16_t*)(lds + C_X0 + (2 * b + 1) * 8256); const int t1 = tid >> 2, t2b = (tid & 3) * 8;
    const unsigned wa[4] = {xa.x, xa.y, xa.z, xa.w}, wb[4] = {xb.x, xb.y, xb.z, xb.w};
#pragma unroll
    for (int k = 0; k < 4; ++k) { X1[(t2b + 2 * k) * LDX + t1] = (bf16_t)(wa[k] & 0xffff); X1[(t2b + 2 * k + 1) * LDX + t1] = (bf16_t)(wa[k] >> 16);
      X2[(t2b + 2 * k) * LDX + t1] = (bf16_t)(wb[k] & 0xffff); X2[(t2b + 2 * k + 1) * LDX + t1] = (bf16_t)(wb[k] >> 16); } }
  typedef unsigned u4a __attribute__((ext_vector_type(4), aligned(4))); typedef const __attribute__((address_space(1))) u4a* gp4;
  v4u cv[9];
  LAS bf16_t* Zm = (LAS bf16_t*)(lds + C_Z0 + bsel * C_ZB);
#pragma unroll 1
  for (int o = 0; o < 2; ++o) {
#define HTAPS_LOAD(oo) { const __attribute__((address_space(1))) unsigned char* tb = (const __attribute__((address_space(1))) unsigned char*)(tapsB + ((size_t)(oo) * 512 + c) * 2 * 8232); \
      _Pragma("unroll") for (int it = 0; it < 9; ++it) { const int e = tid + 512 * it; const int s = e / 1028, q = e % 1028; cv[it] = (v4u){0u, 0u, 0u, 0u}; if (e < 4 * 1028) cv[it] = *(gp4)(tb + (size_t)(s & 1) * 16464 + 16 * q + 4 * (s >> 1)); } }
    if (o == 0) HTAPS_LOAD(0)
    {
#pragma unroll
      for (int it = 0; it < 9; ++it) { const int e = tid + 512 * it; const int s = e / 1028, q = e % 1028; if (e < 4 * 1028) *(LAS v4u*)(lds + C_CS + s * CSB + 16 * q) = cv[it]; } }
    __syncthreads();
    if (o == 0) HTAPS_LOAD(1)
    const int Dlo = 16 * g - 128; constexpr int Dn = 144;
    f32x16 acc = {};
    { const int s = (4 - (li & 3)) & 3;
      const LAS unsigned char* ap = lds + C_CS + s * CSB + 2 * (4096 - 32 * Dlo - li + 8 * lk - s);
      const LAS unsigned char* bp = (const LAS unsigned char*)Zm + (16 * g + t1l - Dlo + C_ZP) * ZROW + 16 * lk;
#define HLD(A0, A1, B0, B1) { const u32x2v p0_ = *(const LAS u32x2v*)(ap), p1_ = *(const LAS u32x2v*)(ap2), p2_ = *(const LAS u32x2v*)(ap3), p3_ = *(const LAS u32x2v*)(ap4); \
        A0 = (v4u){p0_.x, p0_.y, p1_.x, p1_.y}; A1 = (v4u){p2_.x, p2_.y, p3_.x, p3_.y}; B0 = *(const LAS v4u*)(bp); B1 = *(const LAS v4u*)(bp + 32); ap -= 64; ap2 -= 64; ap3 -= 64; ap4 -= 64; bp -= ZROW; }
#define HMM(A, B) acc = __builtin_amdgcn_mfma_f32_32x32x16_bf16(__builtin_bit_cast(bf16x8v, A), __builtin_bit_cast(bf16x8v, B), acc, 0, 0, 0)
#define HOPQ(name, off) unsigned name##i = (unsigned)(unsigned long long)(ap + (off)); asm volatile("" : "+v"(name##i)); const LAS unsigned char* name = (const LAS unsigned char*)(unsigned long long)name##i;
      HOPQ(ap2, 8) HOPQ(ap3, 32) HOPQ(ap4, 40)
#undef HOPQ
      v4u fa0, fa1, fb0, fb1, ga0, ga1, gb0, gb1, ha0, ha1, hb0, hb1;
      HLD(fa0, fa1, fb0, fb1)
      HLD(ga0, ga1, gb0, gb1)
      for (int dd_ = 0; dd_ < Dn - 3; dd_ += 3) {
        HLD(ha0, ha1, hb0, hb1)
        HMM(fa0, fb0); HMM(fa1, fb1);
        HLD(fa0, fa1, fb0, fb1)
        HMM(ga0, gb0); HMM(ga1, gb1);
        HLD(ga0, ga1, gb0, gb1)
        HMM(ha0, hb0); HMM(ha1, hb1);
      }
      HLD(ha0, ha1, hb0, hb1)
      HMM(fa0, fb0); HMM(fa1, fb1); HMM(ga0, gb0); HMM(ga1, gb1); HMM(ha0, hb0); HMM(ha1, hb1);
#undef HLD
#undef HMM
    }
    __syncthreads();
    { const float inv = 1.f / nrm[o * 512 + c], sk = skip[o * 512 + c]; const LAS bf16_t* G = (const LAS bf16_t*)(lds + C_X0 + (2 * bsel + o) * 8256);
#pragma unroll
      for (int r = 0; r < 16; ++r) { const int t2 = (r & 3) + 8 * (r >> 2) + 4 * lk, t1 = 16 * g + t1l;
        const float cvv = acc[r] * inv; const float zin = bf2f(Zm[(t1 + C_ZP) * (ZROW / 2) + t2]);
        Zm[(t1 + C_ZP) * (ZROW / 2) + t2] = (bf16_t)f2bf(bf2f(G[t2 * LDX + t1]) * (cvv + sk * zin)); } }
    __syncthreads();
  }
#pragma unroll
  for (int b = 0; b < 2; ++b) { const int t = tid * 8; *(v4u*)(yT2 + (size_t)b * 512 * S + (size_t)c * S + t) = *(const LAS v4u*)(lds + C_Z0 + b * C_ZB + ((t >> 5) + C_ZP) * ZROW + (t & 31) * 2); }
  __syncthreads();
#undef HTAPS_LOAD
}
__device__ __forceinline__ void cconv3_item(const bf16_t* u, int ld, const float* cw, const float* cb, float* ucc, long idx) {
  const int j = (int)(idx % 1536); const int tc = (int)(idx / 1536);
  const bf16_t* up = u + (size_t)tc * ld + j;
  float v = cb[j] + cw[1536 + j] * bf2f(up[0]);
  if (tc > 0) v += cw[j] * bf2f(*(up - ld)); if (tc < 255) v += cw[2 * 1536 + j] * bf2f(up[ld]);
  ucc[idx] = v;
}
__device__ __forceinline__ void clong_item(const float* ucc, const float* z1c_in, float* z1c_out, bf16_t* yout, int ldy, const float* tapsC, const float* nrmC, const float* skip, int o, long idx) {
  const int c = (int)(idx % 512), t0 = (int)(idx / 512) * 8; constexpr int n = 256;
  const float* tp = tapsC + (size_t)o * 2 * n * 512 + c; const float nr = nrmC[o * 512 + c];
  const float* zs = o == 0 ? ucc + 1024 + c : z1c_in + c; const int ldz = o == 0 ? 1536 : 512;
  float acc[8], w[8];
#pragma unroll
  for (int i = 0; i < 8; ++i) { acc[i] = 0.f; const int lag = t0 + i; w[i] = tp[(size_t)lag * 512]; }
#pragma unroll 4
  for (int s = 0; s < n; ++s) { const float zv = zs[(size_t)s * ldz];
#pragma unroll
    for (int i = 0; i < 8; ++i) acc[i] += w[i] * zv;
    const int lag = t0 - s - 1;
    const float nw = tp[(size_t)(lag >= 0 ? lag : 2 * n + lag) * 512];
#pragma unroll
    for (int i = 7; i > 0; --i) w[i] = w[i - 1];
    w[0] = nw; }
  const float sk = skip[o * 512 + c];
#pragma unroll
  for (int i = 0; i < 8; ++i) { const int t = t0 + i; const float val = ucc[(size_t)t * 1536 + o * 512 + c] * (acc[i] / nr + sk * zs[(size_t)t * ldz]);
    if (o == 0) z1c_out[(size_t)t * 512 + c] = val; else yout[(size_t)t * ldy + c] = (bf16_t)f2bf(val); }
}
}
#define XB_TMO      128
#define XB_XCNT(j)  (256  + 64 * (j))
#define XB_XSUB(j)  (1280 + 64 * (j))
#define XB_XGEN(j)  (2304 + 64 * (j))
#define XB_TOP      3328
#define XB_TOPGEN   3392
#define XCD_BAR_WORDS 3456
#define XB_SPIN_CAP (1u << 18)

__device__ __forceinline__ unsigned xb_ld(unsigned* p)              { return __hip_atomic_load(p, __ATOMIC_RELAXED, __HIP_MEMORY_SCOPE_AGENT); }
__device__ __forceinline__ unsigned xb_add(unsigned* p, unsigned v) { return __hip_atomic_fetch_add(p, v, __ATOMIC_RELAXED, __HIP_MEMORY_SCOPE_AGENT); }
__device__ __forceinline__ unsigned xb_xcc_id() { return (unsigned)__builtin_amdgcn_s_getreg((3 << 11) | 20) & 0xFu; }
#define XB_SPIN(cond, bar) do { unsigned _sp = 0; while (cond) { __builtin_amdgcn_s_sleep(1); \
    if ((++_sp & 255u) == 0u) { if (xb_ld(&(bar)[XB_TMO])) break; if (_sp > XB_SPIN_CAP) { atomicAdd(&(bar)[XB_TMO], 1u); break; } } } } while (0)

struct XcdBarrier {
    unsigned* bar; unsigned x;
    volatile LAS unsigned* st;
};

__device__ __forceinline__ XcdBarrier xcd_barrier_post(unsigned* bar, volatile LAS unsigned* st) {
    XcdBarrier b; b.bar = bar; b.x = xb_xcc_id(); b.st = st;
    if (threadIdx.x == 0) (void)xb_add(&bar[XB_XCNT(b.x)], 1u);
    return b;
}
__device__ __forceinline__ void xcd_barrier_complete(unsigned* bar, unsigned x, unsigned& nloc, unsigned& nx) {
    const unsigned G = gridDim.x * gridDim.y * gridDim.z;
    unsigned sum, cnt, mine, sp = 0u;
    for (;;) {
        sum = 0u; cnt = 0u; mine = 0u;
#pragma unroll
        for (unsigned j = 0; j < 16; ++j) { const unsigned c = xb_ld(&bar[XB_XCNT(j)]); sum += c; cnt += (c > 0u) ? 1u : 0u; mine = (j == x) ? c : mine; }
        if (sum == G) break;
        __builtin_amdgcn_s_sleep(1);
        if ((++sp & 255u) == 0u) { if (xb_ld(&bar[XB_TMO])) break; if (sp > XB_SPIN_CAP) { atomicAdd(&bar[XB_TMO], 1u); break; } }
    }
    nloc = mine > 0u ? mine : 1u; nx = cnt > 0u ? cnt : 1u;
}

__device__ __forceinline__ void xcd_barrier(const XcdBarrier& b) {
    asm volatile("s_waitcnt vmcnt(0)" ::: "memory");
    __syncthreads();
    if (threadIdx.x == 0) {
        unsigned* bar = b.bar;
#define XB_SP(word) ((unsigned*)((((unsigned long long)(unsigned)__builtin_amdgcn_readfirstlane((int)((unsigned long long)(bar + (word)) >> 32))) << 32) | (unsigned)__builtin_amdgcn_readfirstlane((int)(unsigned)(unsigned long long)(bar + (word)))))
        unsigned* const p_xsub = XB_SP(XB_XSUB(b.x)); unsigned* const p_xgen = XB_SP(XB_XGEN(b.x));
        __builtin_amdgcn_s_waitcnt(0);
        unsigned nloc = b.st[0], nx = b.st[1];
        if (nloc == 0u) { xcd_barrier_complete(bar, b.x, nloc, nx); b.st[0] = nloc; b.st[1] = nx; }
        const unsigned old = xb_add(p_xsub, 1u);
        const unsigned gen = old / nloc;
        if (old + 1u == (gen + 1u) * nloc) {
            __builtin_amdgcn_fence(__ATOMIC_RELEASE, "agent");
            asm volatile("s_waitcnt vmcnt(0)" ::: "memory");
            const unsigned og = xb_add(&bar[XB_TOP], 1u);
            const unsigned tg = og / nx;
            if (og + 1u == (tg + 1u) * nx) xb_add(&bar[XB_TOPGEN], 1u);
            else XB_SPIN(xb_ld(&bar[XB_TOPGEN]) == tg, bar);
            __builtin_amdgcn_fence(__ATOMIC_ACQUIRE, "agent");
            xb_add(p_xgen, 1u);
            asm volatile("s_waitcnt vmcnt(0)" ::: "memory");
        } else {
            XB_SPIN(xb_ld(p_xgen) == gen, bar);
            __builtin_amdgcn_fence(__ATOMIC_ACQUIRE, "agent");
            asm volatile("s_waitcnt vmcnt(0)" ::: "memory");
        }
    }
    __syncthreads();
}
#include <math.h>
#ifdef HOST_TEST
#define HD
#define FEXP expf
#define FSIN sinf
#define FCOS cosf
#define FLOG logf
#define FPOW powf
#else
#define HD __device__ __forceinline__
#define FEXP __expf
#define FSIN __sinf
#define FCOS __cosf
#define FLOG __logf
#define FPOW __powf
#endif

struct FullDims { static constexpr int D=1024,B=8,S=4096,DEPTH=2,C=256,GW=64,AH=8,AKV=2,HDM=128,GH=4,GDK=64,GDV=128,GR=16,HW=512,HB=16,HF=64,NE=16,NG=4,DE=512; };
struct SmallDims { static constexpr int D=64,B=2,S=128,DEPTH=2,C=32,GW=16,AH=4,AKV=2,HDM=16,GH=2,GDK=8,GDV=16,GR=4,HW=32,HB=4,HF=8,NE=8,NG=2,DE=32; };

template <class T> struct DD {
  static constexpr int D=T::D,B=T::B,S=T::S,DEPTH=T::DEPTH,C=T::C,GW=T::GW,AH=T::AH,AKV=T::AKV,HDM=T::HDM,GH=T::GH,GDK=T::GDK,GDV=T::GDV,GR=T::GR,HW=T::HW,HB=T::HB,HF=T::HF,NE=T::NE,NG=T::NG,DE=T::DE;
  static constexpr int R=S+C, AG=AH/AKV, RP=HDM/4, HE=1+2*HB, EPG=NE/NG, AQW=AH*HDM, AKVW=AKV*HDM, GKW=GH*GDK, GVW=GH*GDV;
  static constexpr int NKV=AKVW+AKVW+GKW+GVW+2*GR, NIN=NKV+AQW+GKW+GVW+3*HW+3*D;
  static constexpr int O_AK=0, O_AV=AKVW, O_GK=2*AKVW, O_GV=2*AKVW+GKW, O_GA=2*AKVW+GKW+GVW;
  static constexpr int O_AQ=NKV, O_GQ=NKV+AQW, O_OG=O_GQ+GKW, O_HY=O_OG+GVW, O_BR=O_HY+3*HW;
};

struct NaiveBufs {
  const float *x,*c,*ctx,*c_ctx,*w_mod,*b_mod,*norm1_g,*norm2_g,*w_in,*q_norm_g,*k_norm_g,*gla_wa2,*gla_ba,*gla_norm_g,*hy_conv_w,*hy_conv_b,
    *hy_pos_w1,*hy_pos_b1,*hy_sin_freq,*hy_pos_w2,*hy_pos_b2,*hy_pos_w3,*hy_decay,*hy_skip,*w_br_hy,*w_br_gla,*w_br_att,*w_out,*router_w,*router_b,*moe_w_gate,*moe_w_up,*moe_w_down;
  float* out;
  float *mod;
  float *hid2S,*hid2C;
  float *tapsS,*tapsC;
  float *nrmS,*nrmC;
  float *rs;
  float *h;
  float *proj;
  float *qn,*kn;
  float *yatt;
  float *laf,*lab;
  float *of,*ob;
  float *ygla;
  float *uc;
  float *z1,*yhy;
  float *m;
  int   *ridx;
  float *rw;
  float *hid;
  float *xc;
};

HD float sigmoidf_(float x) { return 1.f / (1.f + FEXP(-x)); }
HD float siluf_(float x) { return x / (1.f + FEXP(-x)); }
HD float logsigmoidf_(float x) { return x < 0.f ? x - FLOG(1.f + FEXP(x)) : -FLOG(1.f + FEXP(-x)); }

template <class T> HD void st_mod(const NaiveBufs& a, int l, long idx) {
  using d = DD<T>; const int j = (int)(idx % (6 * d::D)), bb = (int)(idx / (6 * d::D));
  const float* cv = bb < d::B ? a.c + (long)bb * d::D : a.c_ctx; const float* w = a.w_mod + (long)l * d::D * 6 * d::D;
  float acc = a.b_mod[(long)l * 6 * d::D + j];
  for (int k = 0; k < d::D; ++k) acc += siluf_(cv[k]) * w[(long)k * 6 * d::D + j];
  a.mod[idx] = acc;
}
template <class T> HD void st_hyhid(const NaiveBufs& a, int l, int which, long idx) {
  using d = DD<T>; const int n = which ? d::C : d::S; float* dst = which ? a.hid2C : a.hid2S;
  const int j = (int)(idx % d::HF), t = (int)(idx / d::HF);
  const float* w1 = a.hy_pos_w1 + (long)l * d::HE * d::HF; const float* b1 = a.hy_pos_b1 + l * d::HF; const float* fr = a.hy_sin_freq + l * d::HF;
  const float* w2 = a.hy_pos_w2 + (long)l * d::HF * d::HF; const float* b2 = a.hy_pos_b2 + l * d::HF;
  const float tn = (float)t / (float)n; const float w0 = 2.f * 3.14159265358979323846f / (float)n;
  float acc2 = b2[j];
  for (int i = 0; i < d::HF; ++i) {
    float acc = b1[i] + tn * w1[0 * d::HF + i];
    for (int bnd = 0; bnd < d::HB; ++bnd) {
      const float band = 1e-4f + (float)bnd * ((float)(d::HB - 1) - 1e-4f) / (float)(d::HB - 1);
      const float ph = w0 * (float)t * band;
      acc += FCOS(ph) * w1[(1 + bnd) * d::HF + i] - FSIN(ph) * w1[(1 + d::HB + bnd) * d::HF + i];
    }
    acc2 += FSIN(fr[i] * acc) * w2[i * d::HF + j];
  }
  dst[idx] = FSIN(fr[j] * acc2);
}
template <class T> HD void st_hytaps(const NaiveBufs& a, int l, int which, long idx) {
  using d = DD<T>; const int n = which ? d::C : d::S; const float* hid2 = which ? a.hid2C : a.hid2S; float* dst = which ? a.tapsC : a.tapsS;
  const int c = (int)(idx % d::HW); const int li = (int)((idx / d::HW) % (2 * n)); const int o = (int)(idx / ((long)d::HW * 2 * n));
  float v = 0.f;
  if (li != n) {
    const int dir = li < n ? 0 : 1; const int t = li < n ? li : 2 * n - li;
    const int col = (o * 2 + dir) * d::HW + c;
    const float* w3 = a.hy_pos_w3 + (long)l * d::HF * 4 * d::HW;
    float acc = 0.f;
    for (int j = 0; j < d::HF; ++j) acc += hid2[(long)t * d::HF + j] * w3[(long)j * 4 * d::HW + col];
    const float dec = fabsf(a.hy_decay[(long)l * 4 * d::HW + col]);
    v = acc * FEXP(-((float)t / (float)n) * dec);
  }
  if (which == 0) dst[((long)o * d::HW + c) * 2 * n + li] = v; else dst[idx] = v;
}
template <class T> HD void st_hynorm(const NaiveBufs& a, int which, long idx) {
  using d = DD<T>; const int n = which ? d::C : d::S; const float* tp = which ? a.tapsC : a.tapsS; float* dst = which ? a.nrmC : a.nrmS;
  const int c = (int)(idx % d::HW), o = (int)(idx / d::HW);
  float s = 0.f; for (int li = 0; li < 2 * n; ++li) s += fabsf(which == 0 ? tp[((long)o * d::HW + c) * 2 * n + li] : tp[((long)o * 2 * n + li) * d::HW + c]);
  dst[idx] = s + 1e-6f;
}

template <class T> HD const float* xrow(const NaiveBufs& a, int l, int b, int r) {
  using d = DD<T>;
  if (r < d::S) return (l == 0 ? a.x : a.out) + ((long)b * d::S + r) * d::D;
  return (l == 0 ? a.ctx : a.xc) + ((long)b * d::C + (r - d::S)) * d::D;
}
template <class T> HD float* xrow_w(const NaiveBufs& a, int b, int r) {
  using d = DD<T>;
  if (r < d::S) return a.out + ((long)b * d::S + r) * d::D;
  return a.xc + ((long)b * d::C + (r - d::S)) * d::D;
}
template <class T> HD void st_rs(const NaiveBufs& a, int l, int b, int src, long idx) {
  using d = DD<T>; const int r = (int)idx; const float* xr = src ? (const float*)xrow_w<T>(a, b, r) : xrow<T>(a, l, b, r);
  float s = 0.f; for (int k = 0; k < d::D; ++k) s += xr[k] * xr[k];
  a.rs[r] = 1.f / sqrtf(s / (float)d::D + 1e-6f);
}
template <class T> HD void st_norm(const NaiveBufs& a, int l, int b, int which, long idx) {
  using d = DD<T>; const int j = (int)(idx % d::D), r = (int)(idx / d::D);
  const float* xr = which ? (const float*)xrow_w<T>(a, b, r) : xrow<T>(a, l, b, r);
  const float* g = (which ? a.norm2_g : a.norm1_g) + (long)l * d::D;
  const float* md = a.mod + (long)(r < d::S ? b : d::B) * 6 * d::D;
  const float shift = md[(which ? 3 : 0) * d::D + j], scale = md[(which ? 4 : 1) * d::D + j];
  a.h[idx] = xr[j] * a.rs[r] * g[j] * (1.f + scale) + shift;
}
struct GemmArgs { const float* A; int lda; const float* W; int ldw; float* Cc; int ldc; int M, N, K;
  const float* gate; int ldg;
  const float* colscale;
  const float* res; int ldr;
  int accumulate; };
HD void st_gemm(const GemmArgs& g, long idx) {
  const int nb = g.N / 4; const int cb = (int)(idx % nb), rb = (int)(idx / nb);
  float acc[4][4];
#pragma unroll
  for (int i = 0; i < 4; ++i) {
#pragma unroll
    for (int j = 0; j < 4; ++j) acc[i][j] = 0.f; }
  const float* a0 = g.A + (long)(rb * 4) * g.lda; const float* w0 = g.W + cb * 4;
  for (int k = 0; k < g.K; ++k) {
    float av[4], wv[4];
#pragma unroll
    for (int i = 0; i < 4; ++i) av[i] = a0[(long)i * g.lda + k];
#pragma unroll
    for (int j = 0; j < 4; ++j) wv[j] = w0[(long)k * g.ldw + j];
#pragma unroll
    for (int i = 0; i < 4; ++i) {
#pragma unroll
      for (int j = 0; j < 4; ++j) acc[i][j] += av[i] * wv[j]; }
  }
#pragma unroll
  for (int i = 0; i < 4; ++i)
#pragma unroll
  for (int j = 0; j < 4; ++j) {
    const int r = rb * 4 + i, c = cb * 4 + j; float v = acc[i][j];
    if (g.gate) v *= sigmoidf_(g.gate[(long)r * g.ldg + c]);
    if (g.colscale) v *= g.colscale[c];
    if (g.res) v += g.res[(long)r * g.ldr + c];
    float* p = g.Cc + (long)r * g.ldc + c;
    if (g.accumulate) v += *p;
    *p = v;
  }
}
template <class T> HD void st_qknorm(const NaiveBufs& a, int l, long idx) {
  using d = DD<T>; const int hh = (int)(idx % (d::AH + d::AKV)), r = (int)(idx / (d::AH + d::AKV));
  const bool isq = hh < d::AH; const int hd = isq ? hh : hh - d::AH;
  const float* src = a.proj + (long)r * d::NIN + (isq ? d::O_AQ : d::O_AK) + hd * d::HDM;
  float* dst = (isq ? a.qn + (long)r * d::AQW : a.kn + (long)r * d::AKVW) + hd * d::HDM;
  const float* g = (isq ? a.q_norm_g : a.k_norm_g) + (long)l * d::HDM;
  float s = 0.f; for (int k = 0; k < d::HDM; ++k) s += src[k] * src[k];
  const float rsq = 1.f / sqrtf(s / (float)d::HDM + 1e-6f);
  if (r < d::S) {
    const int row = r / d::GW, col = r % d::GW;
    for (int p = 0; p < d::HDM / 2; ++p) {
      const int fi = p < d::RP ? p : p - d::RP; const float pos = p < d::RP ? (float)row : (float)col;
      const float inv = FPOW(10000.f, -(float)fi / (float)d::RP); const float ang = pos * inv;
      const float cs = FCOS(ang), sn = FSIN(ang);
      const float x1 = src[2 * p] * rsq * g[2 * p], x2 = src[2 * p + 1] * rsq * g[2 * p + 1];
      dst[2 * p] = x1 * cs - x2 * sn; dst[2 * p + 1] = x1 * sn + x2 * cs;
    }
  } else { for (int k = 0; k < d::HDM; ++k) dst[k] = src[k] * rsq * g[k]; }
}
template <class T, int NSPLIT> HD void st_attn(const NaiveBufs& a, int r0, int nrows, long idx) {
  using d = DD<T>; constexpr int OD = d::HDM / NSPLIT;
  const int r = r0 + (int)(idx % nrows); const int hs = (int)(idx / nrows); const int part = hs % NSPLIT, hq = hs / NSPLIT; const int kv = hq / d::AG;
  const int k0 = r < d::S ? 0 : d::S, k1 = d::R;
  float q[d::HDM], o[OD];
  const float scale = 1.f / sqrtf((float)d::HDM);
#pragma unroll
  for (int k = 0; k < d::HDM; ++k) q[k] = a.qn[(long)r * d::AQW + hq * d::HDM + k] * scale;
#pragma unroll
  for (int k = 0; k < OD; ++k) o[k] = 0.f;
  float mx = -1e30f, lsum = 0.f;
  for (int kk = k0; kk < k1; ++kk) {
    const float* kr = a.kn + (long)kk * d::AKVW + kv * d::HDM;
    float s = 0.f;
#pragma unroll
    for (int k = 0; k < d::HDM; ++k) s += q[k] * kr[k];
    if (s > mx) { const float cr = FEXP(mx - s); lsum *= cr;
#pragma unroll
      for (int k = 0; k < OD; ++k) o[k] *= cr;
      mx = s; }
    const float p = FEXP(s - mx); lsum += p;
    const float* vr = a.proj + (long)kk * d::NIN + d::O_AV + kv * d::HDM + part * OD;
#pragma unroll
    for (int k = 0; k < OD; ++k) o[k] += p * vr[k];
  }
  const float inv = 1.f / lsum;
#pragma unroll
  for (int k = 0; k < OD; ++k) a.yatt[(long)r * d::AQW + hq * d::HDM + part * OD + k] = o[k] * inv;
}
template <class T> HD void st_glala(const NaiveBufs& a, int l, long idx) {
  using d = DD<T>; const int j = (int)(idx % d::GKW); const int dir = (int)((idx / d::GKW) % 2); const int r = (int)(idx / (2 * d::GKW));
  const float* al = a.proj + (long)r * d::NIN + d::O_GA + dir * d::GR;
  const float* w2 = a.gla_wa2 + ((long)l * 2 + dir) * d::GR * d::GKW; float z = a.gla_ba[((long)l * 2 + dir) * d::GKW + j];
  for (int k = 0; k < d::GR; ++k) z += al[k] * w2[(long)k * d::GKW + j];
  (dir ? a.lab : a.laf)[(long)r * d::GKW + j] = FEXP(logsigmoidf_(z) / 16.f);
}
template <class T> HD void st_glascan(const NaiveBufs& a, long idx) {
  using d = DD<T>; const int v = (int)(idx % d::GDV); const int hd = (int)((idx / d::GDV) % d::GH); const int dir = (int)(idx / (d::GDV * d::GH));
  float st[d::GDK];
#pragma unroll
  for (int k = 0; k < d::GDK; ++k) st[k] = 0.f;
  const float qs = 1.f / sqrtf((float)d::GDK);
  const float* la = dir ? a.lab : a.laf; float* od = dir ? a.ob : a.of;
  for (int step = 0; step < d::R; ++step) {
    int r;
    if (step < d::C) r = d::S + (dir ? d::C - 1 - step : step); else r = dir ? d::S - 1 - (step - d::C) : step - d::C;
    const float* pr = a.proj + (long)r * d::NIN;
    const float vv = pr[d::O_GV + hd * d::GDV + v];
    float o = 0.f;
#pragma unroll
    for (int k = 0; k < d::GDK; ++k) {
      st[k] = la[(long)r * d::GKW + hd * d::GDK + k] * st[k] + pr[d::O_GK + hd * d::GDK + k] * vv;
      o += pr[d::O_GQ + hd * d::GDK + k] * qs * st[k];
    }
    od[(long)r * d::GVW + hd * d::GDV + v] = o;
  }
}
template <class T> HD void st_glaout(const NaiveBufs& a, int l, long idx) {
  using d = DD<T>; const int hd = (int)(idx % d::GH), r = (int)(idx / d::GH);
  const long base = (long)r * d::GVW + hd * d::GDV; float s = 0.f;
  for (int v = 0; v < d::GDV; ++v) { const float o = a.of[base + v] + a.ob[base + v]; s += o * o; }
  const float rsq = 1.f / sqrtf(s / (float)d::GDV + 1e-6f);
  for (int v = 0; v < d::GDV; ++v) { const float o = a.of[base + v] + a.ob[base + v];
    a.ygla[base + v] = o * rsq * a.gla_norm_g[(long)l * d::GDV + v] * siluf_(a.proj[(long)r * d::NIN + d::O_OG + hd * d::GDV + v]); }
}
template <class T> HD void st_hyconv3(const NaiveBufs& a, int l, long idx) {
  using d = DD<T>; const int j = (int)(idx % (3 * d::HW)), r = (int)(idx / (3 * d::HW));
  const int lo = r < d::S ? 0 : d::S, hi = r < d::S ? d::S : d::R;
  const float* w = a.hy_conv_w + (long)l * 3 * 3 * d::HW;
  float v = a.hy_conv_b[(long)l * 3 * d::HW + j] + a.proj[(long)r * d::NIN + d::O_HY + j] * w[1 * 3 * d::HW + j];
  if (r - 1 >= lo) v += a.proj[(long)(r - 1) * d::NIN + d::O_HY + j] * w[0 * 3 * d::HW + j];
  if (r + 1 < hi) v += a.proj[(long)(r + 1) * d::NIN + d::O_HY + j] * w[2 * 3 * d::HW + j];
  a.uc[idx] = v;
}
template <class T> HD void st_hylong(const NaiveBufs& a, int l, int o, long idx) {
  using d = DD<T>; const int c = (int)(idx % d::HW); const int rb = (int)(idx / d::HW); const int r0 = rb * 4;
  const bool lat = r0 < d::S; const int n = lat ? d::S : d::C; const int base = lat ? 0 : d::S; const int t0 = r0 - base;
  const float* tp = (lat ? a.tapsS : a.tapsC) + (long)o * 2 * n * d::HW + c; const float nr = (lat ? a.nrmS : a.nrmC)[o * d::HW + c];
  const float* zs = o == 0 ? a.uc + 2 * d::HW + c : a.z1 + c; const int ldz = o == 0 ? 3 * d::HW : d::HW;
  float acc0 = 0.f, acc1 = 0.f, acc2 = 0.f, acc3 = 0.f;
  auto tap = [&](int lag) { const int li = lag >= 0 ? lag : 2 * n + lag; return tp[(long)li * d::HW]; };
  float w0 = tap(t0), w1 = tap(t0 + 1), w2 = tap(t0 + 2), w3 = tap(t0 + 3);
  for (int s = 0; s < n; ++s) {
    const float zv = zs[(long)(base + s) * ldz];
    acc0 += w0 * zv; acc1 += w1 * zv; acc2 += w2 * zv; acc3 += w3 * zv;
    w3 = w2; w2 = w1; w1 = w0; w0 = (s + 1 < n) ? tap(t0 - s - 1) : 0.f;
  }
  const float sk = a.hy_skip[((long)l * 2 + o) * d::HW + c];
  float* dst = o == 0 ? a.z1 : a.yhy;
  const float accs[4] = {acc0, acc1, acc2, acc3};
#pragma unroll
  for (int i = 0; i < 4; ++i) { const int r = r0 + i; const float zr = zs[(long)r * ldz];
    dst[(long)r * d::HW + c] = a.uc[(long)r * 3 * d::HW + o * d::HW + c] * (accs[i] / nr + sk * zr); }
}
template <class T> HD void st_router(const NaiveBufs& a, long idx) {
  using d = DD<T>; const int r = (int)idx; const float* hr = a.h + (long)r * d::D;
  float sc[d::NE], sel[d::NE];
#pragma unroll
  for (int e = 0; e < d::NE; ++e) sc[e] = 0.f;
  for (int k = 0; k < d::D; ++k) { const float hv = hr[k];
#pragma unroll
    for (int e = 0; e < d::NE; ++e) sc[e] += hv * a.router_w[(long)k * d::NE + e]; }
#pragma unroll
  for (int e = 0; e < d::NE; ++e) { sc[e] = sigmoidf_(sc[e]); sel[e] = sc[e] + a.router_b[e]; }
  int bestg = 0; float bestgs = -1e30f;
#pragma unroll
  for (int g = 0; g < d::NG; ++g) { float m1 = -1e30f, m2 = -1e30f;
#pragma unroll
    for (int i = 0; i < d::EPG; ++i) { const float v = sel[g * d::EPG + i]; if (v > m1) { m2 = m1; m1 = v; } else if (v > m2) m2 = v; }
    const float gs = m1 + m2; if (gs > bestgs) { bestgs = gs; bestg = g; } }
  int i1 = -1, i2 = -1; float v1 = -1e30f, v2 = -1e30f, s1 = 0.f, s2 = 0.f;
#pragma unroll
  for (int e = 0; e < d::NE; ++e) { if (e / d::EPG == bestg) { const float v = sel[e];
      if (v > v1) { v2 = v1; i2 = i1; s2 = s1; v1 = v; i1 = e; s1 = sc[e]; } else if (v > v2) { v2 = v; i2 = e; s2 = sc[e]; } } }
  const float inv = 1.f / (s1 + s2);
  a.ridx[2 * r] = i1; a.ridx[2 * r + 1] = i2; a.rw[2 * r] = s1 * inv; a.rw[2 * r + 1] = s2 * inv;
}
template <class T> HD void st_moehid(const NaiveBufs& a, int l, long idx) {
  using d = DD<T>; const int j = (int)(idx % d::DE); const int k = (int)((idx / d::DE) % 2); const int r = (int)(idx / (2 * d::DE));
  const int e = a.ridx[2 * r + k]; const float* hr = a.h + (long)r * d::D;
  const float* wg = a.moe_w_gate + (((long)l * d::NE + e) * d::D) * d::DE + j; const float* wu = a.moe_w_up + (((long)l * d::NE + e) * d::D) * d::DE + j;
  float g = 0.f, u = 0.f;
  for (int i = 0; i < d::D; ++i) { const float hv = hr[i]; g += hv * wg[(long)i * d::DE]; u += hv * wu[(long)i * d::DE]; }
  a.hid[idx] = siluf_(g) * u;
}
template <class T> HD void st_moeout(const NaiveBufs& a, int l, int b, long idx) {
  using d = DD<T>; const int dd = (int)(idx % d::D), r = (int)(idx / d::D);
  float acc = 0.f;
  for (int k = 0; k < 2; ++k) { const int e = a.ridx[2 * r + k]; const float* hk = a.hid + ((long)r * 2 + k) * d::DE;
    const float* wd = a.moe_w_down + (((long)l * d::NE + e) * d::DE) * d::D + dd; float s = 0.f;
    for (int j = 0; j < d::DE; ++j) s += hk[j] * wd[(long)j * d::D];
    acc += a.rw[2 * r + k] * s; }
  const float g2 = a.mod[(long)(r < d::S ? b : d::B) * 6 * d::D + 5 * d::D + dd];
  float* xr = xrow_w<T>(a, b, r); xr[dd] += g2 * acc;
}
enum { L_MOD = 0, L_HID_S, L_HID_C, L_TAPS_S, L_TAPS_C, L_NRM_S, L_NRM_C, N_LSTAGES,
       P_RS1 = 16, P_NORM1, P_INPROJ, P_QKNORM, P_ATTN_L, P_ATTN_C, P_GLALA, P_GLASCAN, P_GLAOUT, P_HYC3, P_HYL0, P_HYL1,
       P_MRG_HY, P_MRG_GLA, P_MRG_ATT, P_OUT_L, P_OUT_C, P_RS2, P_NORM2, P_ROUTER, P_MOEHID, P_MOEOUT, P_END };
constexpr int ATT_NSPLIT = 4;

template <class T> HD long stage_items(int st, int l) {
  using d = DD<T>; const bool last = (l == d::DEPTH - 1);
  switch (st) {
    case L_MOD: return (long)(d::B + 1) * 6 * d::D;
    case L_HID_S: return (long)d::S * d::HF;
    case L_HID_C: return (long)d::C * d::HF;
    case L_TAPS_S: return 2L * 2 * d::S * d::HW;
    case L_TAPS_C: return 2L * 2 * d::C * d::HW;
    case L_NRM_S: case L_NRM_C: return 2L * d::HW;
    case P_RS1: case P_RS2: case P_ROUTER: return d::R;
    case P_NORM1: case P_NORM2: return (long)d::R * d::D;
    case P_INPROJ: return (long)(d::R / 4) * (d::NIN / 4);
    case P_QKNORM: return (long)d::R * (d::AH + d::AKV);
    case P_ATTN_L: return (long)d::S * d::AH * ATT_NSPLIT;
    case P_ATTN_C: return last ? 0 : (long)d::C * d::AH * ATT_NSPLIT;
    case P_GLALA: return (long)d::R * 2 * d::GKW;
    case P_GLASCAN: return 2L * d::GH * d::GDV;
    case P_GLAOUT: return (long)d::R * d::GH;
    case P_HYC3: return (long)d::R * 3 * d::HW;
    case P_HYL0: case P_HYL1: return (long)(d::R / 4) * d::HW;
    case P_MRG_HY: case P_MRG_GLA: case P_MRG_ATT: return (long)(d::R / 4) * (d::D / 4);
    case P_OUT_L: return (long)(d::S / 4) * (d::D / 4);
    case P_OUT_C: return last ? 0 : (long)(d::C / 4) * (d::D / 4);
    case P_MOEHID: return (long)d::R * 2 * d::DE;
    case P_MOEOUT: return (long)(last ? d::S : d::R) * d::D;
  }
  return 0;
}

template <class T, int ST> HD void stage_run(const NaiveBufs& a, int l, int b, long idx) {
  using d = DD<T>;
  if constexpr (ST == L_MOD) st_mod<T>(a, l, idx);
  else if constexpr (ST == L_HID_S) st_hyhid<T>(a, l, 0, idx);
  else if constexpr (ST == L_HID_C) st_hyhid<T>(a, l, 1, idx);
  else if constexpr (ST == L_TAPS_S) st_hytaps<T>(a, l, 0, idx);
  else if constexpr (ST == L_TAPS_C) st_hytaps<T>(a, l, 1, idx);
  else if constexpr (ST == L_NRM_S) st_hynorm<T>(a, 0, idx);
  else if constexpr (ST == L_NRM_C) st_hynorm<T>(a, 1, idx);
  else if constexpr (ST == P_RS1) st_rs<T>(a, l, b, 0, idx);
  else if constexpr (ST == P_RS2) st_rs<T>(a, l, b, 1, idx);
  else if constexpr (ST == P_NORM1) st_norm<T>(a, l, b, 0, idx);
  else if constexpr (ST == P_NORM2) st_norm<T>(a, l, b, 1, idx);
  else if constexpr (ST == P_INPROJ) { GemmArgs g{a.h, d::D, a.w_in + (long)l * d::D * d::NIN, d::NIN, a.proj, d::NIN, d::R, d::NIN, d::D, nullptr, 0, nullptr, nullptr, 0, 0}; st_gemm(g, idx); }
  else if constexpr (ST == P_QKNORM) st_qknorm<T>(a, l, idx);
  else if constexpr (ST == P_ATTN_L) st_attn<T, ATT_NSPLIT>(a, 0, d::S, idx);
  else if constexpr (ST == P_ATTN_C) st_attn<T, ATT_NSPLIT>(a, d::S, d::C, idx);
  else if constexpr (ST == P_GLALA) st_glala<T>(a, l, idx);
  else if constexpr (ST == P_GLASCAN) st_glascan<T>(a, idx);
  else if constexpr (ST == P_GLAOUT) st_glaout<T>(a, l, idx);
  else if constexpr (ST == P_HYC3) st_hyconv3<T>(a, l, idx);
  else if constexpr (ST == P_HYL0) st_hylong<T>(a, l, 0, idx);
  else if constexpr (ST == P_HYL1) st_hylong<T>(a, l, 1, idx);
  else if constexpr (ST == P_MRG_HY) { GemmArgs g{a.yhy, d::HW, a.w_br_hy + (long)l * d::HW * d::D, d::D, a.m, d::D, d::R, d::D, d::HW, a.proj + d::O_BR, d::NIN, nullptr, nullptr, 0, 0}; st_gemm(g, idx); }
  else if constexpr (ST == P_MRG_GLA) { GemmArgs g{a.ygla, d::GVW, a.w_br_gla + (long)l * d::GVW * d::D, d::D, a.m, d::D, d::R, d::D, d::GVW, a.proj + d::O_BR + d::D, d::NIN, nullptr, nullptr, 0, 1}; st_gemm(g, idx); }
  else if constexpr (ST == P_MRG_ATT) { GemmArgs g{a.yatt, d::AQW, a.w_br_att + (long)l * d::AQW * d::D, d::D, a.m, d::D, d::R, d::D, d::AQW, a.proj + d::O_BR + 2 * d::D, d::NIN, nullptr, nullptr, 0, 1}; st_gemm(g, idx); }
  else if constexpr (ST == P_OUT_L) { const float* res = (l == 0 ? a.x : (const float*)a.out) + (long)b * d::S * d::D;
    GemmArgs g{a.m, d::D, a.w_out + (long)l * d::D * d::D, d::D, a.out + (long)b * d::S * d::D, d::D, d::S, d::D, d::D, nullptr, 0, a.mod + (long)b * 6 * d::D + 2 * d::D, res, d::D, 0}; st_gemm(g, idx); }
  else if constexpr (ST == P_OUT_C) { const float* res = (l == 0 ? a.ctx : (const float*)a.xc) + (long)b * d::C * d::D;
    GemmArgs g{a.m + (long)d::S * d::D, d::D, a.w_out + (long)l * d::D * d::D, d::D, a.xc + (long)b * d::C * d::D, d::D, d::C, d::D, d::D, nullptr, 0, a.mod + (long)d::B * 6 * d::D + 2 * d::D, res, d::D, 0}; st_gemm(g, idx); }
  else if constexpr (ST == P_ROUTER) st_router<T>(a, idx);
  else if constexpr (ST == P_MOEHID) st_moehid<T>(a, l, idx);
  else if constexpr (ST == P_MOEOUT) st_moeout<T>(a, l, b, idx);
}

template <class T> inline size_t carve(NaiveBufs& a, float* ws) {
  using d = DD<T>; size_t o = 0; auto take = [&](size_t n) { float* p = ws ? ws + o : nullptr; o += (n + 63) & ~(size_t)63; return p; };
  a.mod = take((size_t)(d::B + 1) * 6 * d::D);
  a.hid2S = take((size_t)d::S * d::HF); a.hid2C = take((size_t)d::C * d::HF);
  a.tapsS = take((size_t)2 * 2 * d::S * d::HW); a.tapsC = take((size_t)2 * 2 * d::C * d::HW);
  a.nrmS = take(2 * d::HW); a.nrmC = take(2 * d::HW);
  a.rs = take(d::R); a.h = take((size_t)d::R * d::D); a.proj = take((size_t)d::R * d::NIN);
  a.qn = take((size_t)d::R * d::AQW); a.kn = take((size_t)d::R * d::AKVW);
  a.uc = take((size_t)d::R * 3 * d::HW); a.z1 = take((size_t)d::R * d::HW); a.yhy = take((size_t)d::R * d::HW);
  a.xc = take((size_t)d::B * d::C * d::D);
#ifdef HOST_TEST
  a.yatt = take((size_t)d::R * d::AQW); a.laf = take((size_t)d::R * d::GKW); a.lab = take((size_t)d::R * d::GKW);
  a.of = take((size_t)d::R * d::GVW); a.ob = take((size_t)d::R * d::GVW); a.ygla = take((size_t)d::R * d::GVW);
  a.m = take((size_t)d::R * d::D); a.ridx = (int*)take((size_t)d::R * 2); a.rw = take((size_t)d::R * 2); a.hid = take((size_t)d::R * 2 * d::DE);
#endif
  return o;
}
template <class T> inline void set_inputs(NaiveBufs& a, const float* const* in) {
  int i = 0;
  a.x = in[i++]; a.c = in[i++]; a.ctx = in[i++]; a.c_ctx = in[i++]; a.w_mod = in[i++]; a.b_mod = in[i++]; a.norm1_g = in[i++]; a.norm2_g = in[i++];
  a.w_in = in[i++]; a.q_norm_g = in[i++]; a.k_norm_g = in[i++]; a.gla_wa2 = in[i++]; a.gla_ba = in[i++]; a.gla_norm_g = in[i++];
  a.hy_conv_w = in[i++]; a.hy_conv_b = in[i++]; a.hy_pos_w1 = in[i++]; a.hy_pos_b1 = in[i++]; a.hy_sin_freq = in[i++]; a.hy_pos_w2 = in[i++];
  a.hy_pos_b2 = in[i++]; a.hy_pos_w3 = in[i++]; a.hy_decay = in[i++]; a.hy_skip = in[i++]; a.w_br_hy = in[i++]; a.w_br_gla = in[i++];
  a.w_br_att = in[i++]; a.w_out = in[i++]; a.router_w = in[i++]; a.router_b = in[i++]; a.moe_w_gate = in[i++]; a.moe_w_up = in[i++]; a.moe_w_down = in[i++];
}

#define LSTAGES(X) X(L_MOD) X(L_HID_S) X(L_HID_C) X(L_TAPS_S) X(L_TAPS_C) X(L_NRM_S) X(L_NRM_C)
#define PSTAGES(X) X(P_RS1) X(P_NORM1) X(P_INPROJ) X(P_QKNORM) X(P_ATTN_L) X(P_ATTN_C) X(P_GLALA) X(P_GLASCAN) X(P_GLAOUT) X(P_HYC3) X(P_HYL0) X(P_HYL1) \
  X(P_MRG_HY) X(P_MRG_GLA) X(P_MRG_ATT) X(P_OUT_L) X(P_OUT_C) X(P_RS2) X(P_NORM2) X(P_ROUTER) X(P_MOEHID) X(P_MOEOUT)
namespace pro {
__device__ __forceinline__ void mod_phase(const NaiveBufs& a, int l, LAS unsigned char* lds) {
  int tz = threadIdx.x; asm volatile("" : "+v"(tz));
  __syncthreads();
  LAS float* sl = (LAS float*)lds; LAS float* part = sl + 9 * 1024;
  for (int e = tz; e < 9 * 1024; e += NTHREADS) { const int bb = e >> 10, k = e & 1023; const float cv = bb < 8 ? a.c[bb * 1024 + k] : a.c_ctx[k]; sl[e] = cv / (1.f + __expf(-cv)); }
  __syncthreads();
  const float* w = a.w_mod + (size_t)l * 1024 * 6144;
  const int jl = tz & 63, ks = tz >> 6;
  for (int cb = blockIdx.x; cb < 96; cb += gridDim.x) { const int j = cb * 64 + jl; float acc[9];
#pragma unroll
    for (int q = 0; q < 9; ++q) acc[q] = 0.f;
#pragma unroll 4
    for (int k = ks * 128; k < ks * 128 + 128; ++k) { const float wv = w[(size_t)k * 6144 + j];
#pragma unroll
      for (int q = 0; q < 9; ++q) acc[q] += sl[q * 1024 + k] * wv; }
#pragma unroll
    for (int q = 0; q < 9; ++q) part[(ks * 9 + q) * 64 + jl] = acc[q];
    __syncthreads();
    for (int e = tz; e < 9 * 64; e += NTHREADS) { const int q = e >> 6, jj = e & 63; float s = a.b_mod[(size_t)l * 6144 + cb * 64 + jj];
#pragma unroll
      for (int k8 = 0; k8 < 8; ++k8) s += part[(k8 * 9 + q) * 64 + jj];
      a.mod[(size_t)q * 6144 + cb * 64 + jj] = s; }
    __syncthreads(); }
  __syncthreads();
}
__device__ __forceinline__ void hid_phase(const NaiveBufs& a, int l, int n, float* dst, LAS unsigned char* lds) {
  int tz = threadIdx.x; asm volatile("" : "+v"(tz));
  LAS float* Z = (LAS float*)(lds + 40960); LAS float* H1 = Z + 8 * 36;
  const float* w1 = a.hy_pos_w1 + (size_t)l * 33 * 64; const float* b1 = a.hy_pos_b1 + l * 64; const float* fr = a.hy_sin_freq + l * 64;
  const float* w2 = a.hy_pos_w2 + (size_t)l * 64 * 64; const float* b2 = a.hy_pos_b2 + l * 64;
  const float w0 = 2.f * 3.14159265358979323846f / (float)n;
  for (int t0 = blockIdx.x * 8; t0 < n; t0 += gridDim.x * 8) {
    if (tz < 8 * 33) { const int tt = tz / 33, e = tz % 33, t = t0 + tt; float v;
      if (e == 0) v = (float)t / (float)n; else { const int bnd = (e - 1) & 15; const float band = 1e-4f + (float)bnd * (15.f - 1e-4f) / 15.f; const float ph = w0 * (float)t * band; v = e <= 16 ? cosf(ph) : -sinf(ph); }
      Z[tt * 36 + e] = v; }
    __syncthreads();
    { const int tt = tz >> 6, i = tz & 63; float acc = b1[i];
#pragma unroll
      for (int e = 0; e < 33; ++e) acc += Z[tt * 36 + e] * w1[e * 64 + i];
      H1[tt * 64 + i] = sinf(fr[i] * acc); }
    __syncthreads();
    { const int tt = tz >> 6, j = tz & 63; float acc = b2[j];
#pragma unroll 8
      for (int i = 0; i < 64; ++i) acc += H1[tt * 64 + i] * w2[i * 64 + j];
      if (t0 + tt < n) dst[(size_t)(t0 + tt) * 64 + j] = sinf(fr[j] * acc); }
    __syncthreads();
  }
}
__device__ __forceinline__ void nrmS_phase(const NaiveBufs& a) {
  int tz = threadIdx.x; asm volatile("" : "+v"(tz)); const int lane = tz & 63, wave = __builtin_amdgcn_readfirstlane(tz >> 6);
  for (int oc = blockIdx.x * NWAVES + wave; oc < 1024; oc += gridDim.x * NWAVES) { const float* tp = a.tapsS + (size_t)oc * 8192; float s = 0.f;
#pragma unroll 8
    for (int k = lane; k < 8192; k += 64) s += fabsf(tp[k]);
    s = moe::wave_sum(s); if (lane == 0) a.nrmS[oc] = s + 1e-6f; }
}
constexpr int TCOPY = 8232;
__device__ __forceinline__ void tapsB_phase(const NaiveBufs& a, int l, bf16_t* tapsB, LAS unsigned char* lds) {
  int tz = threadIdx.x; asm volatile("" : "+v"(tz));
  const float* w3 = a.hy_pos_w3 + (size_t)l * 64 * 2048; const float* dcy = a.hy_decay + (size_t)l * 2048;
  typedef float f4 __attribute__((ext_vector_type(4)));
  LAS float* W = (LAS float*)lds;
  for (int cp = blockIdx.x; cp < 256; cp += gridDim.x) {
    __syncthreads();
    { const int ch = tz >> 8, e = tz & 255, c = cp + 256 * ch; W[tz] = w3[(size_t)(e >> 2) * 2048 + (e & 3) * 512 + c]; if (tz < 8) W[512 + tz] = fabsf(dcy[(tz & 3) * 512 + cp + 256 * (tz >> 2)]); }
    __syncthreads();
    for (int t = tz; t < 4096; t += NTHREADS) {
      const f4* h2 = (const f4*)(a.hid2S + (size_t)t * 64); f4 acc0 = {0.f, 0.f, 0.f, 0.f}, acc1 = {0.f, 0.f, 0.f, 0.f};
#pragma unroll 4
      for (int j4 = 0; j4 < 16; ++j4) { const f4 h = h2[j4];
#pragma unroll
        for (int e = 0; e < 4; ++e) { acc0 += h[e] * *(const LAS f4*)(W + (4 * j4 + e) * 4); acc1 += h[e] * *(const LAS f4*)(W + 256 + (4 * j4 + e) * 4); } }
      const float tn = (float)t * (1.f / 4096.f);
#pragma unroll
      for (int ch = 0; ch < 2; ++ch)
#pragma unroll
        for (int q = 0; q < 4; ++q) { const int o = q >> 1, dir = q & 1; if (dir == 1 && t == 0) continue; const int c = cp + 256 * ch;
          const bf16_t bv = (bf16_t)f2bf((ch ? acc1[q] : acc0[q]) * __expf(-tn * W[512 + 4 * ch + q]));
          bf16_t* base = tapsB + ((size_t)o * 512 + c) * 2 * TCOPY; const int x0 = dir ? 4096 + t : 4096 - t;
          base[x0] = bv; base[TCOPY + x0 - 1] = bv; } } }
  for (long idx = (long)blockIdx.x * NTHREADS + tz; idx < 1024L * 96; idx += (long)gridDim.x * NTHREADS) { const int oc = (int)(idx / 96), e = (int)(idx % 96); bf16_t* base = tapsB + (size_t)oc * 2 * TCOPY;
    if (e < 40) base[8192 + e] = 0; else if (e < 81) base[TCOPY + 8191 + (e - 40)] = 0; else if (e == 81) base[0] = 0; }
}
__device__ __forceinline__ void nrmB_phase(const NaiveBufs& a, const bf16_t* tapsB) {
  int tz = threadIdx.x; asm volatile("" : "+v"(tz)); const int lane = tz & 63, wave = __builtin_amdgcn_readfirstlane(tz >> 6);
  for (int oc = blockIdx.x * NWAVES + wave; oc < 1024; oc += gridDim.x * NWAVES) { const bf16_t* tp = tapsB + (size_t)oc * 2 * TCOPY; float s = 0.f;
#pragma unroll 8
    for (int k = lane; k < 8192; k += 64) s += fabsf(bf2f(tp[k]));
    s = moe::wave_sum(s); if (lane == 0) a.nrmS[oc] = s + 1e-6f; }
}
}
using TD = FullDims;
using dd = DD<TD>;
constexpr int GB = 4, NGRP = 2, RB = dd::R  , RG = GB * RB, PLD = dd::O_BR + 1536  , PANELS = RG / 256, PPB = RB / 256  ;
constexpr size_t BAR_BYTES = 16384 + 4 * 4096; constexpr int CNT_OFF = 16384;
constexpr int MPG = 38912;
constexpr size_t CS_BYTES = (size_t)2 * 4 * 68 * 64 * 128 * 2, DEC_BYTES = (size_t)2 * 4 * 68 * 64 * 4;
constexpr size_t UCT_BYTES = (size_t)1536 * 4096 * 2, YT_BYTES = (size_t)512 * 4096 * 2, UCC_BYTES = (size_t)256 * 1536 * 4, Z1C_BYTES = (size_t)256 * 512 * 4;
constexpr size_t MIX_BYTES = GB * (CS_BYTES + DEC_BYTES) > GB * (UCT_BYTES + YT_BYTES + UCC_BYTES + Z1C_BYTES) ? GB * (CS_BYTES + DEC_BYTES) : GB * (UCT_BYTES + YT_BYTES + UCC_BYTES + Z1C_BYTES);

struct KArgs { NaiveBufs a; unsigned* bar; int* cnt; bf16_t *xs; bf16_t *WgaT; bf16_t *WinT, *WhyT, *WglaT, *WattT, *WoutT, *WguT, *WdT, *hb, *proj; unsigned char* mix;
  bf16_t *hp, *hid, *contrib; int* srcrow; float* wgt; moe::Route* route; float* wts; };

struct EpiProjBf16 {
  static constexpr bool PERM = true, AFTER_DRAIN = false;
  bf16_t* P;
  __device__ __forceinline__ void operator()(const pg8::f32x4 (&acc)[2][2][4][2], const pg8::Unit& u, int wr, int wc, int fr, int fq) const {
    const int row0 = u.pm * 256 + wr * 64 + fr, col0 = u.pn * 256 + wc * 32 + 8 * fq;
    const int cr0 = col0 + (col0 >= dd::O_GA ? 32 : 0), cr1 = col0 + 128 + (col0 + 128 >= dd::O_GA ? 32 : 0);
    if (u.pn >= (dd::O_BR - 32) / 256) {
      unsigned char* Pg = (unsigned char*)P + (size_t)dd::O_BR * 2 + (col0 - (dd::O_BR - 32));
#pragma unroll
      for (int ai = 0; ai < 2; ++ai)
#pragma unroll
        for (int m = 0; m < 4; ++m) { unsigned char* rowp = Pg + (size_t)(row0 + ai * 128 + m * 16) * (PLD * 2);
#pragma unroll
          for (int bj = 0; bj < 2; ++bj) { const pg8::f32x4 v0 = acc[ai][bj][m][0], v1 = acc[ai][bj][m][1]; uint2 o;
            o.x = (unsigned)(fsigmoid(v0[0]) * 255.f + 0.5f) | ((unsigned)(fsigmoid(v0[1]) * 255.f + 0.5f) << 8) | ((unsigned)(fsigmoid(v0[2]) * 255.f + 0.5f) << 16) | ((unsigned)(fsigmoid(v0[3]) * 255.f + 0.5f) << 24);
            o.y = (unsigned)(fsigmoid(v1[0]) * 255.f + 0.5f) | ((unsigned)(fsigmoid(v1[1]) * 255.f + 0.5f) << 8) | ((unsigned)(fsigmoid(v1[2]) * 255.f + 0.5f) << 16) | ((unsigned)(fsigmoid(v1[3]) * 255.f + 0.5f) << 24);
            *(uint2*)(rowp + bj * 128) = o; } }
      return; }
#pragma unroll
    for (int ai = 0; ai < 2; ++ai)
#pragma unroll
      for (int m = 0; m < 4; ++m) { bf16_t* rowp = P + (size_t)(row0 + ai * 128 + m * 16) * PLD;
#pragma unroll
        for (int bj = 0; bj < 2; ++bj) { const pg8::f32x4 v0 = acc[ai][bj][m][0], v1 = acc[ai][bj][m][1];
          v4u o; o.x = pk2(v0[0], v0[1]); o.y = pk2(v0[2], v0[3]); o.z = pk2(v1[0], v1[1]); o.w = pk2(v1[2], v1[3]); *(v4u*)(rowp + (bj ? cr1 : cr0)) = o; } }
  }
};
template <bool ACCUM> struct EpiMergeB {
  static constexpr bool PERM = true, AFTER_DRAIN = false;
  const bf16_t* gate; bf16_t* M;
  __device__ __forceinline__ void operator()(const pg8::f32x4 (&acc)[2][2][4][2], const pg8::Unit& u, int wr, int wc, int fr, int fq) const {
    const int row0 = u.pm * 256 + wr * 64 + fr, col0 = u.pn * 256 + wc * 32 + 8 * fq;
#pragma unroll
    for (int ai2 = 0; ai2 < 4; ++ai2) { const int ai = ai2 >> 1, m0 = (ai2 & 1) * 2;
      v4u gw[4][2], mo[4][2];
#pragma unroll
      for (int m = m0; m < m0 + 2; ++m)
#pragma unroll
        for (int bj = 0; bj < 2; ++bj) { const size_t r = (size_t)(row0 + ai * 128 + m * 16); const int c = col0 + bj * 128; gw[m][bj] = *(const v4u*)(gate + r * PLD + c); if (ACCUM) mo[m][bj] = *(const v4u*)(M + r * 1024 + c); }
#pragma unroll
      for (int m = m0; m < m0 + 2; ++m)
#pragma unroll
        for (int bj = 0; bj < 2; ++bj) { const size_t r = (size_t)(row0 + ai * 128 + m * 16); const int c = col0 + bj * 128; const v4u g4 = gw[m][bj];
          pg8::f32x4 v0 = acc[ai][bj][m][0], v1 = acc[ai][bj][m][1];
          v0[0] *= fsigmoid(bf2f(g4.x & 0xffff)); v0[1] *= fsigmoid(bf2f(g4.x >> 16)); v0[2] *= fsigmoid(bf2f(g4.y & 0xffff)); v0[3] *= fsigmoid(bf2f(g4.y >> 16));
          v1[0] *= fsigmoid(bf2f(g4.z & 0xffff)); v1[1] *= fsigmoid(bf2f(g4.z >> 16)); v1[2] *= fsigmoid(bf2f(g4.w & 0xffff)); v1[3] *= fsigmoid(bf2f(g4.w >> 16));
          if (ACCUM) { const v4u o = mo[m][bj]; v0[0] += bf2f(o.x & 0xffff); v0[1] += bf2f(o.x >> 16); v0[2] += bf2f(o.y & 0xffff); v0[3] += bf2f(o.y >> 16);
            v1[0] += bf2f(o.z & 0xffff); v1[1] += bf2f(o.z >> 16); v1[2] += bf2f(o.w & 0xffff); v1[3] += bf2f(o.w >> 16); }
          v4u o2; o2.x = pk2(v0[0], v0[1]); o2.y = pk2(v0[2], v0[3]); o2.z = pk2(v1[0], v1[1]); o2.w = pk2(v1[2], v1[3]); *(v4u*)(M + r * 1024 + c) = o2; } }
  }
};
struct EpiOutG {
  static constexpr bool PERM = true, AFTER_DRAIN = false;
  const float* resL; const float* resC; bf16_t* xs; const float* mod; int b0; bool ctx_on, resbf;
  __device__ __forceinline__ void operator()(const pg8::f32x4 (&acc)[2][2][4][2], const pg8::Unit& u, int wr, int wc, int fr, int fq) const {
    const int bl = u.pm / PPB, lp = u.pm % PPB; const bool isc = lp == PPB - 1; if (isc && !ctx_on) return;
    const int b = b0 + bl;
    const float* res = isc ? resC + (size_t)b * dd::C * 1024 : resL + ((size_t)b * dd::S + lp * 256) * 1024;
    bf16_t* out = xs + (size_t)u.pm * 256 * 1024;
    const float* gv = mod + (size_t)(isc ? dd::B : b) * 6 * 1024 + 2 * 1024;
    int row0 = wr * 64 + fr, col0 = u.pn * 256 + wc * 32 + 8 * fq; asm volatile("" : "+v"(row0), "+v"(col0));
    pg8::f32x4 gg[2][2];
#pragma unroll
    for (int bj = 0; bj < 2; ++bj)
#pragma unroll
      for (int n = 0; n < 2; ++n) gg[bj][n] = *(const pg8::f32x4*)(gv + col0 + bj * 128 + n * 4);
    if (resbf) {
#pragma unroll
      for (int ai2 = 0; ai2 < 4; ++ai2) { const int ai = ai2 >> 1, m0 = (ai2 & 1) * 2; v4u rb[4][2];
#pragma unroll
        for (int m = m0; m < m0 + 2; ++m)
#pragma unroll
          for (int bj = 0; bj < 2; ++bj) rb[m][bj] = *(const v4u*)(out + (size_t)(row0 + ai * 128 + m * 16) * 1024 + col0 + bj * 128);
#pragma unroll
        for (int m = m0; m < m0 + 2; ++m)
#pragma unroll
          for (int bj = 0; bj < 2; ++bj) { const v4u o = rb[m][bj]; const pg8::f32x4 v0 = gg[bj][0] * acc[ai][bj][m][0], v1 = gg[bj][1] * acc[ai][bj][m][1]; v4u w;
            w.x = pk2(v0[0] + __uint_as_float(o.x << 16), v0[1] + __uint_as_float(o.x & 0xffff0000u)); w.y = pk2(v0[2] + __uint_as_float(o.y << 16), v0[3] + __uint_as_float(o.y & 0xffff0000u));
            w.z = pk2(v1[0] + __uint_as_float(o.z << 16), v1[1] + __uint_as_float(o.z & 0xffff0000u)); w.w = pk2(v1[2] + __uint_as_float(o.w << 16), v1[3] + __uint_as_float(o.w & 0xffff0000u));
            *(v4u*)(out + (size_t)(row0 + ai * 128 + m * 16) * 1024 + col0 + bj * 128) = w; } }
    } else {
#pragma unroll
      for (int ai2 = 0; ai2 < 4; ++ai2) { const int ai = ai2 >> 1, m0 = (ai2 & 1) * 2;
        pg8::f32x4 rv[4][2][2];
#pragma unroll
        for (int m = m0; m < m0 + 2; ++m)
#pragma unroll
          for (int bj = 0; bj < 2; ++bj)
#pragma unroll
            for (int n = 0; n < 2; ++n) rv[m][bj][n] = *(const pg8::f32x4*)(res + (size_t)(row0 + ai * 128 + m * 16) * 1024 + col0 + bj * 128 + n * 4);
#pragma unroll
        for (int m = m0; m < m0 + 2; ++m)
#pragma unroll
          for (int bj = 0; bj < 2; ++bj) { const pg8::f32x4 v0 = rv[m][bj][0] + gg[bj][0] * acc[ai][bj][m][0], v1 = rv[m][bj][1] + gg[bj][1] * acc[ai][bj][m][1];
            v4u w; w.x = pk2(v0[0], v0[1]); w.y = pk2(v0[2], v0[3]); w.z = pk2(v1[0], v1[1]); w.w = pk2(v1[2], v1[3]);
            *(v4u*)(out + (size_t)(row0 + ai * 128 + m * 16) * 1024 + col0 + bj * 128) = w; } }
    }
  }
};
struct GroupOrder {
  int nN, nwg, G, c; bool lat;
  __device__ void init(int N, int G_, int c_, bool lat_) { nN = N / 256; lat = lat_; nwg = (lat ? GB * 16 : PANELS) * nN; G = G_; c = c_; }
  __device__ __forceinline__ bool next(int i, pg8::Unit& u) const { const long L = (long)i * G + c; if (L >= nwg) return false; const int p = (int)L / nN; u.pm = lat ? (p >> 4) * PPB + (p & 15) : p; u.pn = (int)L % nN; u.acol = 0; u.nt = 0; return true; }
  __device__ __forceinline__ void a_ready(const pg8::Unit&) const {}
  __device__ __forceinline__ void done(const pg8::Unit&) const {}
};
struct MergeOrder {
  int ntiles, G, c; bool lat;
  __device__ void init(int G_, int c_, bool lat_) { lat = lat_; ntiles = (lat ? GB * 16 : PANELS) * 4; G = G_; c = c_; }
  __device__ __forceinline__ bool next(int i, pg8::Unit& u) const { const int rnd = i / 3, gi = i - 3 * rnd; const long tile = (long)rnd * G + c; if (tile >= ntiles) return false; const int p = (int)tile >> 2;
    u.pm = lat ? (p >> 4) * PPB + (p & 15) : p; u.pn = gi * 4 + ((int)tile & 3); u.acol = gi == 0 ? dd::O_HY : gi == 1 ? dd::O_OG : dd::O_AQ; u.nt = gi == 2 ? 16 : 8; return true; }
  __device__ __forceinline__ void a_ready(const pg8::Unit&) const {}
  __device__ __forceinline__ void done(const pg8::Unit&) const {}
};
struct EpiMergeS {
  static constexpr bool PERM = true, AFTER_DRAIN = false;
  const unsigned char* gate0; bf16_t* M;
  __device__ __forceinline__ void operator()(const pg8::f32x4 (&acc)[2][2][4][2], const pg8::Unit& u, int wr, int wc, int fr, int fq) const {
    const int gi = u.pn >> 2; const bool accum = gi > 0; const unsigned char* gate = gate0 + gi * 1024;
    const int row0 = u.pm * 256 + wr * 64 + fr, col0 = (u.pn & 3) * 256 + wc * 32 + 8 * fq;
#pragma unroll
    for (int ai2 = 0; ai2 < 4; ++ai2) { const int ai = ai2 >> 1, m0 = (ai2 & 1) * 2;
      uint2 gw[4][2]; v4u mo[4][2];
#pragma unroll
      for (int m = m0; m < m0 + 2; ++m)
#pragma unroll
        for (int bj = 0; bj < 2; ++bj) { const size_t r = (size_t)(row0 + ai * 128 + m * 16); const int c = col0 + bj * 128; gw[m][bj] = *(const uint2*)(gate + r * (PLD * 2) + c); mo[m][bj] = (v4u){0u, 0u, 0u, 0u}; if (accum) mo[m][bj] = *(const v4u*)(M + r * 1024 + c); }
#pragma unroll
      for (int m = m0; m < m0 + 2; ++m)
#pragma unroll
        for (int bj = 0; bj < 2; ++bj) { const size_t r = (size_t)(row0 + ai * 128 + m * 16); const int c = col0 + bj * 128; const uint2 g2 = gw[m][bj]; constexpr float q = 1.f / 255.f;
          pg8::f32x4 v0 = acc[ai][bj][m][0], v1 = acc[ai][bj][m][1];
          v0[0] *= (float)(g2.x & 255u) * q; v0[1] *= (float)((g2.x >> 8) & 255u) * q; v0[2] *= (float)((g2.x >> 16) & 255u) * q; v0[3] *= (float)(g2.x >> 24) * q;
          v1[0] *= (float)(g2.y & 255u) * q; v1[1] *= (float)((g2.y >> 8) & 255u) * q; v1[2] *= (float)((g2.y >> 16) & 255u) * q; v1[3] *= (float)(g2.y >> 24) * q;
          { const v4u o = mo[m][bj]; v0[0] += bf2f(o.x & 0xffff); v0[1] += bf2f(o.x >> 16); v0[2] += bf2f(o.y & 0xffff); v0[3] += bf2f(o.y >> 16);
            v1[0] += bf2f(o.z & 0xffff); v1[1] += bf2f(o.z >> 16); v1[2] += bf2f(o.w & 0xffff); v1[3] += bf2f(o.w >> 16); }
          v4u o2; o2.x = pk2(v0[0], v0[1]); o2.y = pk2(v0[2], v0[3]); o2.z = pk2(v1[0], v1[1]); o2.w = pk2(v1[2], v1[3]); *(v4u*)(M + r * 1024 + c) = o2; } }
  }
};
__device__ __forceinline__ const float* xrow_in(const NaiveBufs& a, int l, int b, int r) {
  if (r < dd::S) return (l == 0 ? a.x : (const float*)a.out) + ((size_t)b * dd::S + r) * 1024;
  return (l == 0 ? a.ctx : (const float*)a.xc) + ((size_t)b * dd::C + (r - dd::S)) * 1024;
}
__device__ __forceinline__ float* xrow_cur(const NaiveBufs& a, int b, int r) {
  if (r < dd::S) return a.out + ((size_t)b * dd::S + r) * 1024;
  return a.xc + ((size_t)b * dd::C + (r - dd::S)) * 1024;
}
template <bool BF> __device__ __forceinline__ void norm_row(const void* xr, const float* gnorm, const float* shift, const float* scale, bf16_t* hrow, int lane) {
  typedef float f4 __attribute__((ext_vector_type(4)));
  f4 xv[4]; float ss = 0.f;
#pragma unroll
  for (int j = 0; j < 4; ++j) {
    if (BF) { const uint2 rw = *(const uint2*)((const bf16_t*)xr + 4 * lane + 256 * j); xv[j][0] = __uint_as_float(rw.x << 16); xv[j][1] = __uint_as_float(rw.x & 0xffff0000u); xv[j][2] = __uint_as_float(rw.y << 16); xv[j][3] = __uint_as_float(rw.y & 0xffff0000u); }
    else xv[j] = *(const f4*)((const float*)xr + 4 * lane + 256 * j);
    ss += xv[j][0] * xv[j][0] + xv[j][1] * xv[j][1] + xv[j][2] * xv[j][2] + xv[j][3] * xv[j][3]; }
  const float rs = 1.f / sqrtf(moe::wave_sum(ss) * (1.f / 1024.f) + 1e-6f);
#pragma unroll
  for (int j = 0; j < 4; ++j) { const int c = 4 * lane + 256 * j; const f4 g4 = *(const f4*)(gnorm + c), sh = *(const f4*)(shift + c), sc = *(const f4*)(scale + c);
    f4 h;
#pragma unroll
    for (int i = 0; i < 4; ++i) h[i] = xv[j][i] * rs * g4[i] * (1.f + sc[i]) + sh[i];
    *(unsigned long long*)(hrow + c) = (unsigned long long)pk2(h[0], h[1]) | ((unsigned long long)pk2(h[2], h[3]) << 32); }
}
__device__ __forceinline__ void qknorm_row(bf16_t* prow, const float* qg, const float* kg, int r, int lane) {
  const bool lat = r < dd::S; const int grow = r / dd::GW, gcol = r % dd::GW;
  const int fi = lane & 31; const float pos = (lane < 32) ? (float)grow : (float)gcol;
  const float ang = pos * __builtin_amdgcn_exp2f(-(float)fi * (13.287712379549449f / 32.f));
  const float cs = lat ? __cosf(ang) : 1.f, sn = lat ? __sinf(ang) : 0.f;
  unsigned wv[10];
#pragma unroll
  for (int hh = 0; hh < 10; ++hh) wv[hh] = *((const unsigned*)(prow + (hh < 8 ? dd::O_AQ + hh * 128 : dd::O_AK + (hh - 8) * 128)) + lane);
  float ss[10];
#pragma unroll
  for (int hh = 0; hh < 10; ++hh) { const float x1 = bf2f(wv[hh] & 0xffff), x2 = bf2f(wv[hh] >> 16); ss[hh] = x1 * x1 + x2 * x2; }
#pragma unroll
  for (int o = 1; o < 64; o <<= 1) {
#pragma unroll
    for (int hh = 0; hh < 10; ++hh) ss[hh] += __shfl_xor(ss[hh], o); }
  const float q1 = qg[2 * lane], q2 = qg[2 * lane + 1], k1 = kg[2 * lane], k2 = kg[2 * lane + 1];
#pragma unroll
  for (int hh = 0; hh < 10; ++hh) { unsigned* p = (unsigned*)(prow + (hh < 8 ? dd::O_AQ + hh * 128 : dd::O_AK + (hh - 8) * 128)) + lane;
    const float x1 = bf2f(wv[hh] & 0xffff), x2 = bf2f(wv[hh] >> 16); const float rs = 1.f / sqrtf(ss[hh] * (1.f / 128.f) + 1e-6f);
    const float y1 = x1 * rs * (hh < 8 ? q1 : k1), y2 = x2 * rs * (hh < 8 ? q2 : k2);
    *p = pk2(y1 * cs - y2 * sn, y1 * sn + y2 * cs); }
}

__device__ __forceinline__ void ga_task(const bf16_t* hb, const bf16_t* WgaT, bf16_t* proj, int wt) {
  int tid = threadIdx.x; asm volatile("" : "+v"(tid));
  const int lane = tid & 63, li = lane & 31, lk = lane >> 5; typedef short b8 __attribute__((ext_vector_type(8))); typedef float f16v __attribute__((ext_vector_type(16)));
  const bf16_t* ap = hb + ((size_t)wt * 32 + li) * 1024 + 8 * lk; const bf16_t* bp = WgaT + (size_t)li * 1024 + 8 * lk;
  f16v acc = {};
  for (int k8 = 0; k8 < 8; ++k8) { v4u av[8], bv[8];
#pragma unroll
    for (int j = 0; j < 8; ++j) { av[j] = *(const v4u*)(ap + 128 * k8 + 16 * j); bv[j] = *(const v4u*)(bp + 128 * k8 + 16 * j); }
#pragma unroll
    for (int j = 0; j < 8; ++j) acc = __builtin_amdgcn_mfma_f32_32x32x16_bf16(__builtin_bit_cast(b8, av[j]), __builtin_bit_cast(b8, bv[j]), acc, 0, 0, 0); }
#pragma unroll
  for (int r = 0; r < 16; ++r) { const int row = wt * 32 + (r & 3) + 8 * (r >> 2) + 4 * lk; proj[(size_t)row * PLD + dd::O_GA + li] = (bf16_t)f2bf(acc[r]); }
}

__global__ void __launch_bounds__(NTHREADS, 2) mega_kernel(KArgs ka_unused) {
  extern __shared__ __attribute__((aligned(16))) unsigned char lds_raw[];
  LAS unsigned char* lds = (LAS unsigned char*)lds_raw;
  volatile LAS unsigned* MISC = (volatile LAS unsigned*)(lds + MISC_OFF);
  constexpr int ARGS_OFF = MISC_OFF + 256;
  static_assert(ARGS_OFF + sizeof(KArgs) <= LDS_BYTES, "LDS map");
  { const unsigned __attribute__((address_space(4)))* kp = (const unsigned __attribute__((address_space(4)))*)__builtin_amdgcn_kernarg_segment_ptr();
    for (int i = threadIdx.x; i < (int)(sizeof(KArgs) / 4); i += NTHREADS) ((LAS unsigned*)(lds + ARGS_OFF))[i] = kp[i]; }
  if (threadIdx.x < 64) MISC[threadIdx.x] = 0u;
  __syncthreads();
  const KArgs& ka = *(const KArgs*)(const LAS KArgs*)(lds + ARGS_OFF);
  const NaiveBufs& a = ka.a;
  unsigned* bar_s; { const unsigned long long bp = (unsigned long long)ka.bar; const unsigned lo_ = __builtin_amdgcn_readfirstlane((unsigned)bp), hi_ = __builtin_amdgcn_readfirstlane((unsigned)(bp >> 32));
    bar_s = (unsigned*)(((unsigned long long)hi_ << 32) | lo_); }
  XcdBarrier xb = xcd_barrier_post(bar_s, MISC);
#define SPTR(T, name, src) T* name; { const unsigned long long bp_ = (unsigned long long)(src); const unsigned lo_ = __builtin_amdgcn_readfirstlane((unsigned)bp_), hi_ = __builtin_amdgcn_readfirstlane((unsigned)(bp_ >> 32)); name = (T*)(((unsigned long long)hi_ << 32) | lo_); }
  SPTR(bf16_t, proj_s, ka.proj) SPTR(bf16_t, hb_s, ka.hb) SPTR(unsigned char, mix_s, ka.mix)
  const long gs = (long)gridDim.x * NTHREADS;
  LAS int* poff = (LAS int*)(lds + MISC_OFF + 64);
#define TID_SETUP int tz = threadIdx.x; asm volatile("" : "+v"(tz)); const int lane = tz & 63, wave = __builtin_amdgcn_readfirstlane(tz >> 6); \
    const int gw = blockIdx.x * NWAVES + wave, NGW = gridDim.x * NWAVES; const long gt = (long)blockIdx.x * NTHREADS + tz; (void)lane; (void)gw; (void)NGW; (void)gt;
#define LSTAGE(ST) { TID_SETUP const long n_ = stage_items<TD>(ST, l); for (long i_ = gt; i_ < n_; i_ += gs) stage_run<TD, ST>(a, l, 0, i_); }
  for (int l = 0; l < dd::DEPTH; ++l) {
    const bool last = (l == dd::DEPTH - 1);
    { TID_SETUP
      LAS float* scr = (LAS float*)(lds + RING_OFF + wave * 16384);
      constexpr int NIT = (dd::D / 64) * (dd::NIN / 32);
      for (int it = gw; it < NIT; it += NGW) { const int n0 = 32 * (it % (dd::NIN / 32));
        if (n0 == dd::O_GA) transpose_item(a.w_in + (size_t)l * dd::D * dd::NIN, dd::D, dd::NIN, ka.WgaT, -dd::O_GA, scr, it, lane);
        else transpose_item(a.w_in + (size_t)l * dd::D * dd::NIN, dd::D, dd::NIN, ka.WinT, n0 < dd::O_GA ? 0 : -32, scr, it, lane); }
      { constexpr int I0 = (dd::HW / 64) * (dd::D / 32), I1 = (dd::GVW / 64) * (dd::D / 32), I2 = (dd::AQW / 64) * (dd::D / 32), I3 = (dd::D / 64) * (dd::D / 32);
        for (int it = gw; it < I0 + I1 + I2 + I3; it += NGW) { int r = it;
          if (r < I0) { transpose_item(a.w_br_hy + (size_t)l * dd::HW * dd::D, dd::HW, dd::D, ka.WhyT, 0, scr, r, lane, 1024); continue; } r -= I0;
          if (r < I1) { transpose_item(a.w_br_gla + (size_t)l * dd::GVW * dd::D, dd::GVW, dd::D, ka.WglaT, 0, scr, r, lane, 1024); continue; } r -= I1;
          if (r < I2) { transpose_item(a.w_br_att + (size_t)l * dd::AQW * dd::D, dd::AQW, dd::D, ka.WattT, 0, scr, r, lane); continue; } r -= I2;
          transpose_item(a.w_out + (size_t)l * dd::D * dd::D, dd::D, dd::D, ka.WoutT, 0, scr, r, lane); } }
      { constexpr int IG = (dd::D / 64) * (dd::DE / 32), IDN = (dd::DE / 64) * (dd::D / 32);
        for (int it = gw; it < dd::NE * (2 * IG + IDN); it += NGW) { const int e = it / (2 * IG + IDN); int r = it % (2 * IG + IDN);
          if (r < 2 * IG) { const int up = r >= IG; if (up) r -= IG; const int n0 = 32 * (r % (dd::DE / 32));
            transpose_item((up ? a.moe_w_up : a.moe_w_gate) + ((size_t)l * dd::NE + e) * dd::D * dd::DE, dd::D, dd::DE, ka.WguT, e * 1024 + 128 * (n0 >> 7) + (up ? 128 : 0), scr, r, lane); }
          else { r -= 2 * IG; transpose_item(a.moe_w_down + ((size_t)l * dd::NE + e) * dd::DE * dd::D, dd::DE, dd::D, ka.WdT, e * 1024, scr, r, lane); } } }
      (void)gt;
    }
    pro::mod_phase(a, l, lds); pro::hid_phase(a, l, dd::S, a.hid2S, lds); if (!last) pro::hid_phase(a, l, dd::C, a.hid2C, lds);
    xcd_barrier(xb);
    pro::tapsB_phase(a, l, (bf16_t*)a.tapsS, lds); if (!last) LSTAGE(L_TAPS_C)
    xcd_barrier(xb);
    pro::nrmB_phase(a, (const bf16_t*)a.tapsS); if (!last) LSTAGE(L_NRM_C)
    xcd_barrier(xb);
    for (int grp = 0; grp < NGRP; ++grp) {
      const int b0 = grp * GB;
      { TID_SETUP
        for (int rg = gw; rg < RG; rg += NGW) { const int bl = rg / RB, r = rg % RB, b = b0 + bl; const float* md = a.mod + (size_t)(r < dd::S ? b : dd::B) * 6 * 1024;
          if (l == 0) norm_row<false>(xrow_in(a, 0, b, r), a.norm1_g, md, md + 1024, hb_s + (size_t)rg * 1024, lane);
          else norm_row<true>(ka.xs + ((size_t)grp * RG + rg) * 1024, a.norm1_g + (size_t)l * 1024, md, md + 1024, hb_s + (size_t)rg * 1024, lane); }
        xcd_barrier(xb); }
      { pg8::Gemm g{hb_s, ka.WinT, RG, NINP, dd::D, 0}; pg8::StaticOrder S; S.init(RG, NINP, (int)gridDim.x, (int)blockIdx.x); EpiProjBf16 E{proj_s};
        pg8::gemm_phase<EpiProjBf16, pg8::StaticOrder, false>((PG8_LAS unsigned char*)(lds + RING_OFF), g, S, E, nullptr);
        { int tq = threadIdx.x; asm volatile("" : "+v"(tq)); const int wv_ = __builtin_amdgcn_readfirstlane(tq >> 6);
          for (int wt = (int)blockIdx.x + (int)gridDim.x * wv_; wt < PANELS * 8; wt += (int)gridDim.x * NWAVES) ga_task(hb_s, ka.WgaT, proj_s, wt); }
        xcd_barrier(xb); }
      { TID_SETUP
        for (int rg = gw; rg < RG; rg += NGW) qknorm_row(proj_s + (size_t)rg * PLD, a.q_norm_g + (size_t)l * 128, a.k_norm_g + (size_t)l * 128, rg % RB, lane);
        for (int u = blockIdx.x; u < GB * 4 * 68; u += gridDim.x) { const int bl = u / (4 * 68), hu = u % (4 * 68); const bf16_t* pb = proj_s + (size_t)bl * RB * PLD;
          gla::In gp; gp.q = pb + dd::O_GQ; gp.k = pb + dd::O_GK; gp.v = pb + dd::O_GV; gp.ga = pb + dd::O_GA; gp.og = pb + dd::O_OG; gp.ld = PLD;
          gp.wa2 = a.gla_wa2 + (size_t)l * 2 * 16 * 256; gp.ba = a.gla_ba + (size_t)l * 2 * 256; gp.gnorm = a.gla_norm_g + (size_t)l * 128;
          gp.csb = (bf16_t*)(mix_s + (size_t)bl * CS_BYTES); gp.dec = (float*)(mix_s + (size_t)GB * CS_BYTES + (size_t)bl * DEC_BYTES); gp.y = (bf16_t*)pb + dd::O_OG; gp.ldy = PLD; gp.S = dd::S; gp.C = dd::C;
          gla::g1b_unit(gp, lds, hu / 68, hu % 68, 4, 68); }
        xcd_barrier(xb); }
      { TID_SETUP
        for (long i_ = gt; i_ < (long)GB * 2 * 4 * 64 * 64; i_ += gs) { const int bl = (int)(i_ / (2 * 4 * 64 * 64)); gla::In gp; gp.csb = (bf16_t*)(mix_s + (size_t)bl * CS_BYTES); gp.dec = (float*)(mix_s + (size_t)GB * CS_BYTES + (size_t)bl * DEC_BYTES); gp.S = dd::S; gp.C = dd::C;
          gla::g2_item(gp, i_ % (2 * 4 * 64 * 64), 4, 68); }
        const int combo = blockIdx.x & 7, slot = blockIdx.x >> 3, nslot = gridDim.x >> 3;
        const int per_combo = 64 + (last ? 0 : 4);
        const bool xcdm = (gridDim.x & 7) == 0;
        for (int uu = xcdm ? slot : (int)blockIdx.x; uu < (xcdm ? per_combo : 8 * per_combo); uu += xcdm ? nslot : (int)gridDim.x) { const int cmb = xcdm ? combo : uu / per_combo, ui = xcdm ? uu : uu % per_combo;
          const bool lat = ui < 64; const int bl = cmb >> 1, kvh = cmb & 1;
          const int head = kvh * 4 + (lat ? ui >> 4 : ui - 64), qb = lat ? ui & 15 : 0;
          bf16_t* pb = proj_s + (size_t)bl * RB * PLD; const size_t qrow = lat ? (size_t)qb * 256 : (size_t)dd::S, krow = lat ? 0 : (size_t)dd::S;
          att::attn_dense_body<att::bf16, PLD, PLD, PLD, true>((const att::bf16*)(pb + qrow * PLD + dd::O_AQ + head * 128), (const att::bf16*)(pb + krow * PLD + dd::O_AK + kvh * 128),
              (const att::bf16*)(pb + krow * PLD + dd::O_AV + kvh * 128), pb + qrow * PLD + dd::O_AQ + head * 128, lat ? RB : dd::C, (char*)lds_raw);
          __syncthreads(); }
        xcd_barrier(xb); }
      { const int n3 = last ? 64 : 68;
        for (int u = blockIdx.x; u < GB * 4 * n3; u += gridDim.x) { const int bl = u / (4 * n3), hu = u % (4 * n3); const bf16_t* pb = proj_s + (size_t)bl * RB * PLD;
          gla::In gp; gp.q = pb + dd::O_GQ; gp.k = pb + dd::O_GK; gp.v = pb + dd::O_GV; gp.ga = pb + dd::O_GA; gp.og = pb + dd::O_OG; gp.ld = PLD;
          gp.wa2 = a.gla_wa2 + (size_t)l * 2 * 16 * 256; gp.ba = a.gla_ba + (size_t)l * 2 * 256; gp.gnorm = a.gla_norm_g + (size_t)l * 128;
          gp.csb = (bf16_t*)(mix_s + (size_t)bl * CS_BYTES); gp.dec = (float*)(mix_s + (size_t)GB * CS_BYTES + (size_t)bl * DEC_BYTES); gp.y = (bf16_t*)pb + dd::O_OG; gp.ldy = PLD; gp.S = dd::S; gp.C = dd::C;
          gla::g3b_unit(gp, lds, hu / n3, hu % n3, 4, 68); }
        xcd_barrier(xb); }
      {
        bf16_t* ucT0 = (bf16_t*)mix_s; bf16_t* yT0 = (bf16_t*)(mix_s + GB * UCT_BYTES); float* ucc0 = (float*)(mix_s + GB * (UCT_BYTES + YT_BYTES)); float* z1c0 = (float*)(mix_s + GB * (UCT_BYTES + YT_BYTES + UCC_BYTES));
        const float* cw = a.hy_conv_w + (size_t)l * 3 * 1536; const float* cb = a.hy_conv_b + (size_t)l * 1536; const float* skp = a.hy_skip + (size_t)l * 2 * 512;
        { TID_SETUP
        { int t_ = blockIdx.x; hy::H0Regs hr = hy::h0_load(proj_s + (size_t)(t_ / (64 * 24)) * RB * PLD + dd::O_HY, PLD, t_ % (64 * 24), tz);
          for (; t_ < GB * 64 * 24; t_ += gridDim.x) { const int bl = t_ / (64 * 24), tn_ = t_ + gridDim.x; hy::H0Regs hn = hr;
            if (tn_ < GB * 64 * 24) hn = hy::h0_load(proj_s + (size_t)(tn_ / (64 * 24)) * RB * PLD + dd::O_HY, PLD, tn_ % (64 * 24), tz);
            hy::h0_compute(hr, cw, cb, ucT0 + (size_t)bl * 1536 * 4096, t_ % (64 * 24), lds, tz); hr = hn; } }
        if (!last) for (long i_ = gt; i_ < (long)GB * 256 * 1536; i_ += gs) { const int bl = (int)(i_ / (256 * 1536)); hy::cconv3_item(proj_s + ((size_t)bl * RB + dd::S) * PLD + dd::O_HY, PLD, cw, cb, ucc0 + (size_t)bl * 256 * 1536, i_ % (256 * 1536)); } }
        xcd_barrier(xb);
        { TID_SETUP
        for (int u = blockIdx.x; u < (GB / 2) * 512; u += gridDim.x) { const int bp_ = u / 512; hy::h1c_unit(ucT0 + (size_t)(2 * bp_) * 1536 * 4096, (const bf16_t*)a.tapsS, a.nrmS, skp, yT0 + (size_t)(2 * bp_) * 512 * 4096, u % 512, lds); }
        if (!last) for (long i_ = gt; i_ < (long)GB * 32 * 512; i_ += gs) { const int bl = (int)(i_ / (32 * 512)); hy::clong_item(ucc0 + (size_t)bl * 256 * 1536, nullptr, z1c0 + (size_t)bl * 256 * 512, nullptr, 0, a.tapsC, a.nrmC, skp, 0, i_ % (32 * 512)); } }
        xcd_barrier(xb);
        { TID_SETUP
        for (int t_ = blockIdx.x; t_ < GB * 64 * 8; t_ += gridDim.x) { const int bl = t_ / (64 * 8); hy::h2_tile(yT0 + (size_t)bl * 512 * 4096, proj_s + (size_t)bl * RB * PLD + dd::O_HY, PLD, t_ % (64 * 8), lds); }
        if (!last) for (long i_ = gt; i_ < (long)GB * 32 * 512; i_ += gs) { const int bl = (int)(i_ / (32 * 512)); hy::clong_item(ucc0 + (size_t)bl * 256 * 1536, z1c0 + (size_t)bl * 256 * 512, nullptr, proj_s + ((size_t)bl * RB + dd::S) * PLD + dd::O_HY, PLD, a.tapsC, a.nrmC, skp, 1, i_ % (32 * 512)); } }
        xcd_barrier(xb); }
      { { pg8::Gemm g{proj_s, ka.WhyT, RG, 1024, 1024, PLD, 1024}; MergeOrder S; S.init((int)gridDim.x, (int)blockIdx.x, last); EpiMergeS E{(const unsigned char*)(proj_s + dd::O_BR), (bf16_t*)mix_s};
          pg8::gemm_phase<EpiMergeS, MergeOrder, false>((PG8_LAS unsigned char*)(lds + RING_OFF), g, S, E, nullptr); }
        xcd_barrier(xb);
        pg8::Gemm g{(const bf16_t*)mix_s, ka.WoutT, RG, 1024, 1024, 0}; GroupOrder S; S.init(1024, (int)gridDim.x, (int)blockIdx.x, last);
        EpiOutG E{a.x, a.ctx, ka.xs + (size_t)grp * RG * 1024, a.mod, b0, !last, l != 0};
        pg8::gemm_phase<EpiOutG, GroupOrder, false>((PG8_LAS unsigned char*)(lds + RING_OFF), g, S, E, nullptr);
        xcd_barrier(xb); }
      {
        { TID_SETUP int* cnt = ka.cnt + (l * NGRP + grp) * 1024;
          LAS float* rwT = (LAS float*)(lds + RING_OFF);
          for (int k = tz; k < 1024; k += NTHREADS) {
#pragma unroll
            for (int e = 0; e < 16; ++e) rwT[e * 1024 + k] = a.router_w[(size_t)k * 16 + e]; }
          __syncthreads();
          LAS int* lcnt = (LAS int*)(lds + RING_OFF + 65536);
          if (tz < 32) lcnt[tz] = 0;
          __syncthreads();
          for (int rg = gw; rg < RG; rg += NGW) { const int bl = rg / RB, r = rg % RB, b = b0 + bl; if (last && r >= dd::S) continue; const float* md = a.mod + (size_t)(r < dd::S ? b : dd::B) * 6 * 1024;
            moe::route_row(ka.xs + ((size_t)grp * RG + rg) * 1024, a.norm2_g + (size_t)l * 1024, md + 3 * 1024, md + 4 * 1024, hb_s + (size_t)rg * 1024, rwT, a.router_b, lcnt, ka.route + rg, ka.wts + 2 * rg, lane); }
          __syncthreads();
          if (tz < 16) lcnt[16 + tz] = atomicAdd(cnt + tz * 64, lcnt[tz]);
          __syncthreads();
          for (int rg = gw; rg < RG; rg += NGW) { if (last && (rg % RB) >= dd::S) continue; moe::Route* rt = ka.route + rg; if (lane == 0) { moe::Route r_ = *rt; r_.r0 += lcnt[16 + r_.e0]; r_.r1 += lcnt[16 + r_.e1]; *rt = r_; } }
          xcd_barrier(xb); }
        { TID_SETUP int* cnt = ka.cnt + (l * NGRP + grp) * 1024;
          if (tz == 0) { int acc_ = 0; for (int e = 0; e < 16; ++e) { poff[e] = acc_; acc_ += (cnt[e * 64] + 255) >> 8; } poff[16] = acc_; }
          __syncthreads();
          for (int rg = gw; rg < RG; rg += NGW) { if (last && (rg % RB) >= dd::S) continue; const moe::Route rt = ka.route[rg];
            const v4u h0 = *(const v4u*)(hb_s + (size_t)rg * 1024 + lane * 16), h1 = *(const v4u*)(hb_s + (size_t)rg * 1024 + lane * 16 + 8);
#pragma unroll
            for (int sl = 0; sl < 2; ++sl) { const int e = sl ? rt.e1 : rt.e0, rk = sl ? rt.r1 : rt.r0; const size_t dst = (size_t)poff[e] * 256 + rk;
              *(v4u*)(ka.hp + dst * 1024 + lane * 16) = h0; *(v4u*)(ka.hp + dst * 1024 + lane * 16 + 8) = h1;
              if (lane == 0) { ka.srcrow[dst] = 2 * rg + sl; ka.wgt[dst] = ka.wts[2 * rg + sl]; } } }
          for (int e = 0; e < 16; ++e) { const int c_ = cnt[e * 64], pe = ((c_ + 255) >> 8) << 8; for (int p_ = c_ + (int)gt; p_ < pe; p_ += (int)gs) ka.srcrow[(size_t)poff[e] * 256 + p_] = -1; }
          xcd_barrier(xb); }
        { pg8::Gemm g{ka.hp, ka.WguT, 0, 0, 1024, 0}; moe::MoeOrder S{(int)gridDim.x, (int)blockIdx.x, 4, poff}; moe::EpiGU E{ka.hid};
          pg8::gemm_phase<moe::EpiGU, moe::MoeOrder, false>((PG8_LAS unsigned char*)(lds + RING_OFF), g, S, E, nullptr);
          xcd_barrier(xb); }
        { pg8::Gemm g{ka.hid, ka.WdT, 0, 0, 512, 0}; moe::MoeOrder S{(int)gridDim.x, (int)blockIdx.x, 4, poff}; moe::EpiDown E{ka.srcrow, ka.wgt, ka.contrib, (size_t)RG * 1024};
          pg8::gemm_phase<moe::EpiDown, moe::MoeOrder, false>((PG8_LAS unsigned char*)(lds + RING_OFF), g, S, E, nullptr);
          xcd_barrier(xb); }
        { TID_SETUP
          bf16_t* xsg = ka.xs + (size_t)grp * RG * 1024;
#pragma unroll 2
          for (long i_ = gt; i_ < (long)RG * 128; i_ += gs) { const int rg = (int)(i_ >> 7), c8 = (int)(i_ & 127) * 8; const int bl = rg / RB, r = rg % RB, b = b0 + bl; if (last && r >= dd::S) continue;
            const float* g2 = a.mod + (size_t)(r < dd::S ? b : dd::B) * 6 * 1024 + 5 * 1024 + c8;
            const v4u u0 = *(const v4u*)(ka.contrib + (size_t)rg * 1024 + c8), u1 = *(const v4u*)(ka.contrib + (size_t)RG * 1024 + (size_t)rg * 1024 + c8), xo = *(const v4u*)(xsg + (size_t)rg * 1024 + c8);
            const pg8::f32x4 ga_ = *(const pg8::f32x4*)g2, gb_ = *(const pg8::f32x4*)(g2 + 4);
            pg8::f32x4 ya, yb;
            ya[0] = __uint_as_float(xo.x << 16) + ga_[0] * (__uint_as_float(u0.x << 16) + __uint_as_float(u1.x << 16)); ya[1] = __uint_as_float(xo.x & 0xffff0000u) + ga_[1] * (__uint_as_float(u0.x & 0xffff0000u) + __uint_as_float(u1.x & 0xffff0000u));
            ya[2] = __uint_as_float(xo.y << 16) + ga_[2] * (__uint_as_float(u0.y << 16) + __uint_as_float(u1.y << 16)); ya[3] = __uint_as_float(xo.y & 0xffff0000u) + ga_[3] * (__uint_as_float(u0.y & 0xffff0000u) + __uint_as_float(u1.y & 0xffff0000u));
            yb[0] = __uint_as_float(xo.z << 16) + gb_[0] * (__uint_as_float(u0.z << 16) + __uint_as_float(u1.z << 16)); yb[1] = __uint_as_float(xo.z & 0xffff0000u) + gb_[1] * (__uint_as_float(u0.z & 0xffff0000u) + __uint_as_float(u1.z & 0xffff0000u));
            yb[2] = __uint_as_float(xo.w << 16) + gb_[2] * (__uint_as_float(u0.w << 16) + __uint_as_float(u1.w << 16)); yb[3] = __uint_as_float(xo.w & 0xffff0000u) + gb_[3] * (__uint_as_float(u0.w & 0xffff0000u) + __uint_as_float(u1.w & 0xffff0000u));
            if (last) { float* o = a.out + ((size_t)b * dd::S + r) * 1024 + c8; *(pg8::f32x4*)o = ya; *(pg8::f32x4*)(o + 4) = yb; }
            else { v4u w; w.x = pk2(ya[0], ya[1]); w.y = pk2(ya[2], ya[3]); w.z = pk2(yb[0], yb[1]); w.w = pk2(yb[2], yb[3]); *(v4u*)(xsg + (size_t)rg * 1024 + c8) = w; } }
          xcd_barrier(xb); }
      }
    }
  }
}
extern "C" void kernel_launch(void* const* d_in, const int* in_sizes, int n_in, void* d_out, int out_size, void* d_ws, size_t ws_size, hipStream_t stream) {
  static int grid = 0;
  if (!grid) {
    int dev = 0, cus = 0, per_cu = 0;
    (void)hipGetDevice(&dev); (void)hipDeviceGetAttribute(&cus, hipDeviceAttributeMultiprocessorCount, dev);
    (void)hipFuncSetAttribute((const void*)mega_kernel, hipFuncAttributeMaxDynamicSharedMemorySize, LDS_BYTES);
    (void)hipOccupancyMaxActiveBlocksPerMultiprocessor(&per_cu, mega_kernel, NTHREADS, LDS_BYTES);
    if (per_cu < 1) fprintf(stderr, "occupancy query says %d\n", per_cu);
    grid = cus;
  }
  KArgs ka{}; const float* ptrs[33]; for (int i = 0; i < 33; ++i) ptrs[i] = (const float*)d_in[i];
  set_inputs<TD>(ka.a, ptrs);
  char* wsb = (char*)d_ws; size_t off = BAR_BYTES;
  auto take = [&](size_t bytes) { char* p = wsb + off; off += (bytes + 255) & ~(size_t)255; return p; };
  NaiveBufs& a = ka.a;
  a.mod = (float*)take((size_t)(dd::B + 1) * 6 * 1024 * 4); a.hid2S = (float*)take((size_t)dd::S * 64 * 4); a.hid2C = (float*)take((size_t)dd::C * 64 * 4);
  a.tapsS = (float*)take((size_t)2 * 512 * 2 * 8232 * 2 + 64); a.tapsC = (float*)take((size_t)2 * 512 * 512 * 4); a.nrmS = (float*)take(1024 * 4); a.nrmC = (float*)take(1024 * 4);
  ka.xs = (bf16_t*)take((size_t)dd::B * RB * 1024 * 2);
  ka.WgaT = (bf16_t*)take((size_t)32 * 1024 * 2); ka.WinT = (bf16_t*)take((size_t)NINP * 1024 * 2); ka.WhyT = (bf16_t*)take((size_t)1024 * 1024 * 2); ka.WglaT = (bf16_t*)take((size_t)1024 * 1024 * 2); ka.WattT = (bf16_t*)take((size_t)1024 * 1024 * 2);
  ka.WoutT = (bf16_t*)take((size_t)1024 * 1024 * 2); ka.WguT = (bf16_t*)take((size_t)16 * 1024 * 1024 * 2); ka.WdT = (bf16_t*)take((size_t)16 * 1024 * 512 * 2);
  ka.hb = (bf16_t*)take((size_t)RG * 1024 * 2); ka.mix = (unsigned char*)take(MIX_BYTES);
  ka.proj = (bf16_t*)take((size_t)RG * PLD * 2);
  { char* p = (char*)ka.proj; ka.hp = (bf16_t*)p; p += (size_t)MPG * 1024 * 2; ka.hid = (bf16_t*)p; p += (size_t)MPG * 512 * 2; ka.contrib = (bf16_t*)p; p += (size_t)2 * RG * 1024 * 2;
    ka.srcrow = (int*)p; p += (size_t)MPG * 4; ka.wgt = (float*)p; p += (size_t)MPG * 4; ka.route = (moe::Route*)p; p += (size_t)RG * 16; ka.wts = (float*)p; p += (size_t)RG * 8;
    if ((size_t)(p - (char*)ka.proj) > (size_t)RG * PLD * 2) fprintf(stderr, "MoE alias region too large\n"); }
  a.out = (float*)d_out; ka.bar = (unsigned*)d_ws; ka.cnt = (int*)(wsb + CNT_OFF);
  if (off > ws_size) fprintf(stderr, "workspace too small: need %zu have %zu\n", off, ws_size);
  (void)hipMemsetAsync(d_ws, 0, BAR_BYTES, stream);
  hipLaunchKernelGGL(mega_kernel, dim3(grid), dim3(NTHREADS), LDS_BYTES, stream, ka);
}
```

```cpp
#include <hip/hip_runtime.h>
#include <cstddef>
#include <cstdio>
#include <cstdint>
#include <hip/hip_bf16.h>
#include <hip/hip_runtime.h>
namespace pg8 {
#define PG8_LAS __attribute__((address_space(3)))
typedef unsigned short bf16_t;
typedef short bf16x8 __attribute__((ext_vector_type(8)));
typedef float f32x4 __attribute__((ext_vector_type(4)));
typedef unsigned u32x4 __attribute__((ext_vector_type(4)));
constexpr int BM = 256, BK = 64, HALF = 128, HTB = HALF * BK * 2  , STAGE_BYTES = 8 * HTB, NXCD = 8, WGM = 8;

__host__ __device__ __forceinline__ int lds_byte(int r, int c) { const int st = (r >> 4) * 2 + (c >> 5), rr = r & 15, cc = c & 31, ob = rr * 64 + cc * 2; return st * 1024 + (ob ^ (((ob >> 9) & 1) << 5)); }
__host__ __device__ __forceinline__ void stage_rc(int b, int& R, int& C) { const int st = b / 1024, sb = b % 1024, swz = sb ^ (((sb >> 9) & 1) << 5); R = (st >> 1) * 16 + swz / 64; C = (st & 1) * 32 + (swz % 64) / 2; }
__host__ __device__ __forceinline__ int perm32(int rho) { const int n = rho >> 4, i = rho & 15; return 8 * (i >> 2) + 4 * n + (i & 3); }

struct Unit { int pm, pn, acol, nt; };
struct Gemm { const bf16_t* A; const bf16_t* Bt; int M, N, K; int lda; int ldb; };

struct StaticOrder {
    int nM, nN, nwg, G, c;
    __host__ __device__ void init(int M, int N, int G_, int c_) { nM = M / BM; nN = N / BM; nwg = nM * nN; G = G_; c = c_; }
    __host__ __device__ bool next(int i, Unit& u) const {
        const long L = (long)i * G + c; if (L >= nwg) return false;
        int wgid = (int)L; { const int q = nwg / NXCD, r = nwg % NXCD, xcd = wgid % NXCD, off = wgid / NXCD; wgid = (xcd < r ? xcd * (q + 1) : r * (q + 1) + (xcd - r) * q) + off; }
        const int nig = WGM * nN, gid = wgid / nig, fm = gid * WGM, gsz = (nM - fm) < WGM ? (nM - fm) : WGM;
        u.pm = fm + ((wgid % nig) % gsz); u.pn = (wgid % nig) / gsz; u.acol = 0; u.nt = 0; return true;
    }
    __device__ __forceinline__ void a_ready(const Unit&) const {}
    __device__ __forceinline__ void done(const Unit&) const {}
};
__device__ __forceinline__ unsigned cvt_pk_bf16(float lo, float hi) { unsigned r; asm volatile("v_cvt_pk_bf16_f32 %0, %1, %2" : "=v"(r) : "v"(lo), "v"(hi)); return r; }
typedef float f32x2 __attribute__((ext_vector_type(2)));
template <class Epi, class Sched, bool STAMP = false>
__device__ __forceinline__ void gemm_phase(PG8_LAS unsigned char* lds, const Gemm g, const Sched& S, const Epi& E, unsigned long long* stamps) {
    int tid = threadIdx.x; asm volatile("" : "+v"(tid)); const int wid = __builtin_amdgcn_readfirstlane(tid >> 6), lane = tid & 63, wr = wid >> 2, wc = wid & 3, fr = lane & 15, fq = lane >> 4;
    const int K = g.K, nt = K / BK, LDA = g.lda ? g.lda : g.K, LDB = g.ldb ? g.ldb : g.K;
    int ts_lo = 0, ts_hi = 0, nts = 0; const unsigned long long rt_entry = STAMP ? (unsigned long long)wall_clock64() : 0ull;
#define PG8_STAMP() do { if (STAMP && wid == 0 && nts < 64) { const unsigned long long _c = (unsigned long long)clock64(); \
        ts_lo = (lane == nts) ? (int)(unsigned)_c : ts_lo; ts_hi = (lane == nts) ? (int)(unsigned)(_c >> 32) : ts_hi; ++nts; } } while (0)
    PG8_STAMP();
    unsigned voffA[2], voffB[2];
#pragma unroll
    for (int i = 0; i < 2; ++i) { int R, C; stage_rc(tid * 16 + i * 8192, R, C); const int Rb = Epi::PERM ? ((R & ~31) + perm32(R & 31)) : R;
        voffA[i] = (unsigned)(R * LDA + C) * 2u; voffB[i] = (unsigned)(Rb * LDB + C) * 2u; }
    const size_t kstep = (size_t)(BK * 2);
    const size_t hstep = (size_t)HALF * LDB * 2;
    const size_t tstep = 2 * hstep;
    const size_t hstepA = (size_t)HALF * LDA * 2, tstepA = 2 * hstepA;
    const unsigned ldsw = (unsigned)wid * 1024u;
    const int aoff = lds_byte(wr * 64 + fr, fq * 8), boff = lds_byte(wc * 32 + fr, fq * 8);
#define PG8_SA(b, h) (((b) * 2 + (h)) * HTB)
#define PG8_SB(b, h) ((4 + (b) * 2 + (h)) * HTB)
#define PG8_STAGE(bufoff, gbase, voff) do { _Pragma("unroll") for (int _i = 0; _i < 2; ++_i) \
        __builtin_amdgcn_global_load_lds((const unsigned*)((const char*)(gbase) + (voff)[_i]), (PG8_LAS unsigned*)(lds + (bufoff) + ldsw + _i * 8192), 16, 0, 0); } while (0)
#define PG8_LDA(dst, b, h) do { _Pragma("unroll") for (int m = 0; m < 4; ++m) _Pragma("unroll") for (int k = 0; k < 2; ++k) dst[m][k] = *(const PG8_LAS bf16x8*)(lds + PG8_SA(b, h) + aoff + m * 2048 + k * 1024); } while (0)
#define PG8_LDB(dst, b, h) do { _Pragma("unroll") for (int n = 0; n < 2; ++n) _Pragma("unroll") for (int k = 0; k < 2; ++k) dst[n][k] = *(const PG8_LAS bf16x8*)(lds + PG8_SB(b, h) + boff + n * 2048 + k * 1024); } while (0)
#define PG8_MMA(ai, bj, At, Bt) do { __builtin_amdgcn_s_setprio(1); _Pragma("unroll") for (int m = 0; m < 4; ++m) _Pragma("unroll") for (int n = 0; n < 2; ++n) _Pragma("unroll") for (int k = 0; k < 2; ++k) \
        acc[ai][bj][m][n] = __builtin_amdgcn_mfma_f32_16x16x32_bf16(Bt[n][k], At[m][k], acc[ai][bj][m][n], 0, 0, 0); __builtin_amdgcn_s_setprio(0); } while (0)
#define PG8_WAIT_V(n) asm volatile("s_waitcnt vmcnt(" #n ")" ::: "memory")
#define PG8_WAIT_L(n) asm volatile("s_waitcnt lgkmcnt(" #n ")" ::: "memory")
#define PG8_BAR __builtin_amdgcn_s_barrier()
#define PG8_SCHED __builtin_amdgcn_sched_barrier(0)
    Unit cur, nxt; int ui = 0;
    if (!S.next(0, cur)) return;
    f32x4 acc[2][2][4][2];
#pragma unroll
    for (int a = 0; a < 2; ++a)
#pragma unroll
        for (int b = 0; b < 2; ++b)
#pragma unroll
            for (int m = 0; m < 4; ++m)
#pragma unroll
                for (int n = 0; n < 2; ++n) acc[a][b][m][n] = (f32x4){0.f, 0.f, 0.f, 0.f};
    bf16x8 At[4][2], B0[2][2], B1[2][2];
    const char* cA = (const char*)g.A + (size_t)cur.pm * tstepA + (size_t)cur.acol * 2; const char* cB = (const char*)g.Bt + (size_t)cur.pn * tstep;
    S.a_ready(cur);
    PG8_STAGE(PG8_SB(0, 0), cB, voffB); PG8_STAGE(PG8_SA(0, 0), cA, voffA); PG8_STAGE(PG8_SB(0, 1), cB + hstep, voffB); PG8_STAGE(PG8_SA(0, 1), cA + hstepA, voffA);
    if (wr == 1) PG8_BAR;
    PG8_WAIT_V(4); PG8_BAR;
    PG8_STAGE(PG8_SB(1, 0), cB + kstep, voffB); PG8_STAGE(PG8_SA(1, 0), cA + kstep, voffA); PG8_STAGE(PG8_SB(1, 1), cB + hstep + kstep, voffB);
    PG8_WAIT_V(6); PG8_BAR;
    PG8_STAMP();
    for (;;) {
        const bool has_next = S.next(ui + 1, nxt);
        const char* nA = has_next ? (const char*)g.A + (size_t)nxt.pm * tstepA + (size_t)nxt.acol * 2 : cA; const char* nB = has_next ? (const char*)g.Bt + (size_t)nxt.pn * tstep : cB;
        const int ntu = cur.nt ? cur.nt : nt;
        for (int t = 0; t < ntu; t += 2) {
            const bool last = (t == ntu - 2);
            const char* a1 = cA + (size_t)(t + 1) * kstep;
            const char* a2 = last ? nA : cA + (size_t)(t + 2) * kstep; const char* b2 = last ? nB : cB + (size_t)(t + 2) * kstep;
            const char* a3 = a2 + kstep; const char* b3 = b2 + kstep;
            if (last && has_next) S.a_ready(nxt);
            PG8_LDB(B0, 0, 0); PG8_SCHED; PG8_LDA(At, 0, 0); PG8_STAGE(PG8_SA(1, 1), a1 + hstepA, voffA);
            PG8_WAIT_L(8); PG8_BAR; PG8_WAIT_L(0); PG8_MMA(0, 0, At, B0); PG8_BAR; PG8_SCHED;
            PG8_LDB(B1, 0, 1); PG8_STAGE(PG8_SB(0, 0), b2, voffB);
            PG8_BAR; PG8_WAIT_L(0); PG8_MMA(0, 1, At, B1); PG8_BAR;
            PG8_LDA(At, 0, 1); PG8_STAGE(PG8_SA(0, 0), a2, voffA);
            PG8_BAR; PG8_WAIT_L(0); PG8_MMA(1, 0, At, B0); PG8_BAR; PG8_SCHED;
            PG8_STAGE(PG8_SB(0, 1), b2 + hstep, voffB);
            PG8_WAIT_V(6); PG8_BAR; PG8_MMA(1, 1, At, B1); PG8_BAR;
            PG8_LDB(B0, 1, 0); PG8_SCHED; PG8_LDA(At, 1, 0); PG8_STAGE(PG8_SA(0, 1), a2 + hstepA, voffA);
            PG8_WAIT_L(8); PG8_BAR; PG8_WAIT_L(0); PG8_MMA(0, 0, At, B0); PG8_BAR; PG8_SCHED;
            PG8_LDB(B1, 1, 1); PG8_STAGE(PG8_SB(1, 0), b3, voffB);
            PG8_BAR; PG8_WAIT_L(0); PG8_MMA(0, 1, At, B1); PG8_BAR;
            PG8_LDA(At, 1, 1); PG8_STAGE(PG8_SA(1, 0), a3, voffA);
            PG8_BAR; PG8_WAIT_L(0); PG8_MMA(1, 0, At, B0); PG8_BAR; PG8_SCHED;
            PG8_STAGE(PG8_SB(1, 1), b3 + hstep, voffB);
            PG8_WAIT_V(6); PG8_BAR; PG8_MMA(1, 1, At, B1); PG8_BAR;
        }
        PG8_STAMP();
        if constexpr (!Epi::AFTER_DRAIN) { E(acc, cur, wr, wc, fr, fq); S.done(cur); }
        PG8_STAMP();
        if (!has_next) break;
#pragma unroll
        for (int a = 0; a < 2; ++a)
#pragma unroll
            for (int b = 0; b < 2; ++b)
#pragma unroll
                for (int m = 0; m < 4; ++m)
#pragma unroll
                    for (int n = 0; n < 2; ++n) acc[a][b][m][n] = (f32x4){0.f, 0.f, 0.f, 0.f};
        cur = nxt; cA = nA; cB = nB; ++ui;
    }
    PG8_WAIT_V(0);
    if (wr == 0) PG8_BAR;
    PG8_BAR;
    if constexpr (Epi::AFTER_DRAIN) { E.fused(acc, cur, wr, wc, fr, fq, lds, wid, lane); S.done(cur); }
    PG8_STAMP();
    if (STAMP && wid == 0) { stamps[lane] = lane < nts ? (((unsigned long long)(unsigned)ts_hi << 32) | (unsigned)ts_lo) : 0ull;
        if (lane == 62) stamps[62] = rt_entry; if (lane == 63) stamps[63] = (unsigned long long)wall_clock64(); }
#undef PG8_STAMP
#undef PG8_SA
#undef PG8_SB
#undef PG8_STAGE
#undef PG8_LDA
#undef PG8_LDB
#undef PG8_MMA
#undef PG8_WAIT_V
#undef PG8_WAIT_L
#undef PG8_BAR
#undef PG8_SCHED
}
}

#define LAS __attribute__((address_space(3)))
typedef unsigned short bf16_t;
constexpr int NWAVES = 8, NTHREADS = 512;
constexpr int LDS_BYTES = 147456;
constexpr int RING_OFF = 0;
constexpr int MISC_OFF = 131072;
constexpr int NINP = 7680;

__device__ __forceinline__ unsigned f2bf(float f) { unsigned u = __builtin_bit_cast(unsigned, f); return (u + 0x7fffu + ((u >> 16) & 1u)) >> 16; }
__device__ __forceinline__ unsigned pk2(float lo, float hi) { return f2bf(lo) | (f2bf(hi) << 16); }
__device__ __forceinline__ float bf2f(bf16_t b) { return __builtin_bit_cast(float, ((unsigned)b) << 16); }
typedef unsigned v4u __attribute__((ext_vector_type(4)));

__device__ __forceinline__ void transpose_item(const float* W, int K, int N, bf16_t* WT, int row_off, LAS float* scr, int item, int lane, int ldo = 0) {
  if (ldo == 0) ldo = K;
  const int nblk = N / 32, kb = item / nblk, nb = item % nblk, k0 = 64 * kb, n0 = 32 * nb;
  float wreg[32];
#pragma unroll
  for (int i = 0; i < 32; ++i) { const int kk = 2 * i + (lane >> 5); wreg[i] = W[(size_t)(k0 + kk) * N + n0 + (lane & 31)]; }
#pragma unroll
  for (int i = 0; i < 32; ++i) { const int kk = 2 * i + (lane >> 5); scr[kk * 33 + (lane & 31)] = wreg[i]; }
  asm volatile("s_waitcnt lgkmcnt(0)" ::: "memory");
  const int c = lane & 7;
#pragma unroll
  for (int j = 0; j < 4; ++j) { const int n = (lane >> 3) + 8 * j; const LAS float* s = scr + (8 * c) * 33 + n;
    v4u o; o.x = pk2(s[0 * 33], s[1 * 33]); o.y = pk2(s[2 * 33], s[3 * 33]); o.z = pk2(s[4 * 33], s[5 * 33]); o.w = pk2(s[6 * 33], s[7 * 33]);
    *(v4u*)(WT + (size_t)(row_off + n0 + n) * ldo + k0 + 8 * c) = o; }
  asm volatile("s_waitcnt lgkmcnt(0)" ::: "memory");
}

struct EpiProjF32 {
  static constexpr bool PERM = false, AFTER_DRAIN = false;
  float* C; int ldc; int ncols;
  __device__ __forceinline__ void operator()(const pg8::f32x4 (&acc)[2][2][4][2], const pg8::Unit& u, int wr, int wc, int fr, int fq) const {
    const int row0 = u.pm * 256 + wr * 64 + fr, col0 = u.pn * 256 + wc * 32 + 4 * fq;
#pragma unroll
    for (int ai = 0; ai < 2; ++ai)
#pragma unroll
      for (int m = 0; m < 4; ++m) { float* rowp = C + (size_t)(row0 + ai * 128 + m * 16) * ldc + col0;
#pragma unroll
        for (int bj = 0; bj < 2; ++bj)
#pragma unroll
          for (int n = 0; n < 2; ++n) if (col0 + bj * 128 + n * 16 < ncols) *(pg8::f32x4*)(rowp + bj * 128 + n * 16) = acc[ai][bj][m][n]; }
  }
};

__device__ __forceinline__ float fsigmoid(float x) { return 1.f / (1.f + __expf(-x)); }
template <bool ACCUM> struct EpiMerge {
  static constexpr bool PERM = true, AFTER_DRAIN = false;
  const float* gate; int ldg; bf16_t* M; int ldm;
  __device__ __forceinline__ void operator()(const pg8::f32x4 (&acc)[2][2][4][2], const pg8::Unit& u, int wr, int wc, int fr, int fq) const {
    const int row0 = u.pm * 256 + wr * 64 + fr, col0 = u.pn * 256 + wc * 32 + 8 * fq;
#pragma unroll
    for (int ai = 0; ai < 2; ++ai)
#pragma unroll
      for (int m = 0; m < 4; ++m) { const size_t r = (size_t)(row0 + ai * 128 + m * 16);
#pragma unroll
        for (int bj = 0; bj < 2; ++bj) { const int c = col0 + bj * 128;
          const pg8::f32x4 g0 = *(const pg8::f32x4*)(gate + r * ldg + c), g1 = *(const pg8::f32x4*)(gate + r * ldg + c + 4);
          pg8::f32x4 v0 = acc[ai][bj][m][0], v1 = acc[ai][bj][m][1];
#pragma unroll
          for (int e = 0; e < 4; ++e) { v0[e] *= fsigmoid(g0[e]); v1[e] *= fsigmoid(g1[e]); }
          v4u* dst = (v4u*)(M + r * ldm + c);
          if (ACCUM) { const v4u o = *dst; v0[0] += bf2f(o.x & 0xffff); v0[1] += bf2f(o.x >> 16); v0[2] += bf2f(o.y & 0xffff); v0[3] += bf2f(o.y >> 16);
            v1[0] += bf2f(o.z & 0xffff); v1[1] += bf2f(o.z >> 16); v1[2] += bf2f(o.w & 0xffff); v1[3] += bf2f(o.w >> 16); }
          v4u o2; o2.x = pk2(v0[0], v0[1]); o2.y = pk2(v0[2], v0[3]); o2.z = pk2(v1[0], v1[1]); o2.w = pk2(v1[2], v1[3]); *dst = o2; } }
  }
};
struct EpiOut {
  static constexpr bool PERM = false, AFTER_DRAIN = false;
  const float* resL; float* outL; const float* gL;
  const float* resC; float* outC; const float* gC;
  __device__ __forceinline__ void operator()(const pg8::f32x4 (&acc)[2][2][4][2], const pg8::Unit& u, int wr, int wc, int fr, int fq) const {
    const bool isc = u.pm == 16; if (isc && outC == nullptr) return;
    const float* res = isc ? resC : resL; float* out = isc ? outC : outL; const float* gv = isc ? gC : gL;
    const int row0 = (isc ? 0 : u.pm * 256) + wr * 64 + fr, col0 = u.pn * 256 + wc * 32 + 4 * fq;
    pg8::f32x4 gg[2][2];
#pragma unroll
    for (int bj = 0; bj < 2; ++bj)
#pragma unroll
      for (int n = 0; n < 2; ++n) gg[bj][n] = *(const pg8::f32x4*)(gv + col0 + bj * 128 + n * 16);
#pragma unroll
    for (int ai = 0; ai < 2; ++ai)
#pragma unroll
      for (int m = 0; m < 4; ++m) { const size_t ro = (size_t)(row0 + ai * 128 + m * 16) * 1024 + col0;
#pragma unroll
        for (int bj = 0; bj < 2; ++bj)
#pragma unroll
          for (int n = 0; n < 2; ++n) { const pg8::f32x4 rv = *(const pg8::f32x4*)(res + ro + bj * 128 + n * 16); *(pg8::f32x4*)(out + ro + bj * 128 + n * 16) = rv + gg[bj][n] * acc[ai][bj][m][n]; } }
  }
};
namespace att {
using bf16 = __hip_bfloat16;
constexpr int D = 128, NW = 8, QBLK = 32, KVBLK = 64; constexpr float SCALE = 0.088388347648318440f; constexpr float THR = 8.f; constexpr int SDEPTH = 2;
constexpr size_t SHM_V = KVBLK * D * 2, SHM_K = KVBLK * D * 2, SHM_ATTN = 2 * SHM_V + 2 * SHM_K + NW * 64 * 4;
using bf16x8 = __attribute__((ext_vector_type(8))) short;
using s16x4  = __attribute__((ext_vector_type(4))) short;
using f32x16 = __attribute__((ext_vector_type(16))) float;
using f32x8  = __attribute__((ext_vector_type(8))) float;
using u32x4  = __attribute__((ext_vector_type(4))) unsigned;
#define KSWZ(row, colB) ((row) * 256 + ((colB) ^ (((row) & 7) << 4)))
#define SBAR() __builtin_amdgcn_sched_barrier(0)
__device__ __forceinline__ int crow(int r, int hi) { return (r & 3) + 8 * (r >> 2) + 4 * hi; }
__device__ __forceinline__ unsigned cvtpk(float lo, float hi) {
  unsigned r; asm volatile("v_cvt_pk_bf16_f32 %0, %1, %2" : "=v"(r) : "v"(lo), "v"(hi)); return r;
}
template <typename TIn> struct Stage;
template <> struct Stage<bf16>  { using T = bf16x8;
  __device__ static __forceinline__ T ld8(const bf16* p) { return *reinterpret_cast<const bf16x8*>(p); }
  __device__ static __forceinline__ bf16x8 tobf(T x) { return x; } };
template <> struct Stage<float> { using T = f32x8;
  __device__ static __forceinline__ T ld8(const float* p) { return *reinterpret_cast<const f32x8*>(p); }
  __device__ static __forceinline__ bf16x8 tobf(T x) {
    u32x4 w = {cvtpk(x[0], x[1]), cvtpk(x[2], x[3]), cvtpk(x[4], x[5]), cvtpk(x[6], x[7])}; return *reinterpret_cast<bf16x8*>(&w); } };

__device__ __forceinline__ void partialSM(f32x16& p0, f32x16& p1, float& m_reg, float& mn, float& alpha) {
  constexpr float C = SCALE * 1.4426950408889634f;
  float pmax = p0[0]; for (int r = 1; r < 16; ++r) pmax = fmaxf(pmax, p0[r]); for (int r = 0; r < 16; ++r) pmax = fmaxf(pmax, p1[r]);
  { auto rr = __builtin_amdgcn_permlane32_swap(__float_as_uint(pmax), __float_as_uint(pmax), false, false);
    pmax = fmaxf(__uint_as_float(rr[0]), __uint_as_float(rr[1])); }
  if (__builtin_expect(__all(pmax - m_reg <= THR / SCALE), 1)) { mn = m_reg; alpha = 1.f; }
  else { mn = fmaxf(m_reg, pmax); alpha = __builtin_amdgcn_exp2f((m_reg - mn) * C); m_reg = mn; }
  float mnC = -mn * C;
  for (int r = 0; r < 16; ++r) p0[r] = fmaf(p0[r], C, mnC); for (int r = 0; r < 16; ++r) p1[r] = fmaf(p1[r], C, mnC);
  for (int r = 0; r < 16; ++r) p0[r] = __builtin_amdgcn_exp2f(p0[r]);
}
__device__ __forceinline__ void finishSM(f32x16& p0, f32x16& p1, float alpha, float& l_reg, bf16x8& pa0, bf16x8& pa1, bf16x8& pa2, bf16x8& pa3) {
  for (int r = 0; r < 16; ++r) p1[r] = __builtin_amdgcn_exp2f(p1[r]);
  float ps = 0; for (int r = 0; r < 16; ++r) ps += p0[r]; for (int r = 0; r < 16; ++r) ps += p1[r];
  { auto rr = __builtin_amdgcn_permlane32_swap(__float_as_uint(ps), __float_as_uint(ps), false, false);
    ps = __uint_as_float(rr[0]) + __uint_as_float(rr[1]); }
  l_reg = l_reg * alpha + ps;
#define PK4(P, BASE, OUT) do { unsigned a0 = cvtpk(P[BASE + 0], P[BASE + 1]), a1 = cvtpk(P[BASE + 2], P[BASE + 3]);   \
    unsigned b0 = cvtpk(P[BASE + 4], P[BASE + 5]), b1 = cvtpk(P[BASE + 6], P[BASE + 7]);                              \
    auto r0 = __builtin_amdgcn_permlane32_swap(a0, b0, false, false); auto r1 = __builtin_amdgcn_permlane32_swap(a1, b1, false, false); \
    u32x4 w = {r0[0], r1[0], r0[1], r1[1]}; OUT = *reinterpret_cast<bf16x8*>(&w); } while (0)
  PK4(p0, 0, pa0); PK4(p0, 8, pa1); PK4(p1, 0, pa2); PK4(p1, 8, pa3);
#undef PK4
}
__device__ __forceinline__ void qkt(f32x16& p0, f32x16& p1, const bf16* Ks, const bf16x8* qr, int r32, int hi) {
  p0 = f32x16{}; p1 = f32x16{};
  for (int d0 = 0; d0 < 8; ++d0) { int cb = (d0 * 16 + hi * 8) * 2;
    bf16x8 b0 = *reinterpret_cast<const bf16x8*>((const char*)Ks + KSWZ(r32, cb));
    bf16x8 b1 = *reinterpret_cast<const bf16x8*>((const char*)Ks + KSWZ(32 + r32, cb));
    p0 = __builtin_amdgcn_mfma_f32_32x32x16_bf16(b0, qr[d0], p0, 0, 0, 0);
    p1 = __builtin_amdgcn_mfma_f32_32x32x16_bf16(b1, qr[d0], p1, 0, 0, 0); }
}
__device__ __forceinline__ int v_st(int k, int c) { const int kk = (k & ~0xC) | ((k & 4) << 1) | ((k & 8) >> 1); return ((kk >> 3) * 4 + (c >> 5)) * 512 + ((kk & 7) * 32 + (c & 31)) * 2; }
__device__ __forceinline__ int v_rd_base(int lane) { return ((lane & 3) << 3) | (((lane >> 2) & 3) << 6) | (((lane >> 4) & 1) << 5) | (((lane >> 5) & 1) << 8); }
constexpr int v_rd_off(int d0, int ks, int half) { return d0 * 512 + ks * 4096 + half * 2048; }
template <int OFF> __device__ __forceinline__ s16x4 tr_read(int vb) {
  s16x4 r; asm volatile("ds_read_b64_tr_b16 %0, %1 offset:%2" : "=&v"(r) : "v"(vb), "i"(OFF) : "memory"); return r;
}
template <int D0> __device__ __forceinline__ void pv_one(f32x16& od, int vb, bf16x8 pa0, bf16x8 pa1, bf16x8 pa2, bf16x8 pa3) {
  const s16x4 l0 = tr_read<v_rd_off(D0, 0, 0)>(vb), h0 = tr_read<v_rd_off(D0, 0, 1)>(vb), l1 = tr_read<v_rd_off(D0, 1, 0)>(vb), h1 = tr_read<v_rd_off(D0, 1, 1)>(vb);
  const s16x4 l2 = tr_read<v_rd_off(D0, 2, 0)>(vb), h2 = tr_read<v_rd_off(D0, 2, 1)>(vb), l3 = tr_read<v_rd_off(D0, 3, 0)>(vb), h3 = tr_read<v_rd_off(D0, 3, 1)>(vb);
  asm volatile("s_waitcnt lgkmcnt(0)" ::: "memory"); SBAR();
#define PK(L, H) (bf16x8){L[0], L[1], L[2], L[3], H[0], H[1], H[2], H[3]}
  od = __builtin_amdgcn_mfma_f32_32x32x16_bf16(pa0, PK(l0, h0), od, 0, 0, 0);
  od = __builtin_amdgcn_mfma_f32_32x32x16_bf16(pa1, PK(l1, h1), od, 0, 0, 0);
  od = __builtin_amdgcn_mfma_f32_32x32x16_bf16(pa2, PK(l2, h2), od, 0, 0, 0);
  od = __builtin_amdgcn_mfma_f32_32x32x16_bf16(pa3, PK(l3, h3), od, 0, 0, 0);
#undef PK
}
__device__ __forceinline__ void pv_d0(f32x16* o, int vb, bf16x8 pa0, bf16x8 pa1, bf16x8 pa2, bf16x8 pa3) {
  pv_one<0>(o[0], vb, pa0, pa1, pa2, pa3); pv_one<1>(o[1], vb, pa0, pa1, pa2, pa3); pv_one<2>(o[2], vb, pa0, pa1, pa2, pa3); pv_one<3>(o[3], vb, pa0, pa1, pa2, pa3);
}

template <typename TQ, int LDQ, int LDK, int LDO, bool OBF16>
__device__ __forceinline__ void attn_dense_body(const TQ* Qb, const bf16* Kh, const bf16* Vh,
                                                void* Obv, int seq, char* lds) {
  using St = Stage<bf16>; using SQ = Stage<TQ>;
  int tid = threadIdx.x; asm volatile("" : "+v"(tid)); const int wid = tid >> 6, lane = tid & 63, r32 = lane & 31, hi = lane >> 5;
  bf16* V_lds = (bf16*)lds; bf16* K_lds = (bf16*)(lds + 2 * SHM_V);
  float* ws = (float*)(lds + 2 * SHM_V + 2 * SHM_K) + wid * 64; float* li_l = ws; float* al_l = ws + 32;
  float m_reg = -1e30f, l_reg = 0; f32x16 o[4] = {}; bf16x8 qr[8];
  const TQ* Qw = Qb + (long)(wid * QBLK + r32) * LDQ + hi * 8;
#pragma unroll
  for (int d0 = 0; d0 < 8; ++d0) qr[d0] = SQ::tobf(SQ::ld8(Qw + d0 * 16));
  const int sr = tid >> 4, sc = (tid & 15) * 8, vst0 = v_st(sr, sc), vst1 = v_st(32 + sr, sc);
  const int vb0 = (int)(uintptr_t)V_lds + v_rd_base(lane);
  struct { typename St::T vs0, vs1, ks0, ks1; } sr_[SDEPTH];
#define SLOAD(i, k0) do { sr_[i].vs0 = St::ld8(&Vh[(long)((k0) + sr) * LDK + sc]); sr_[i].vs1 = St::ld8(&Vh[(long)((k0) + 32 + sr) * LDK + sc]); \
    sr_[i].ks0 = St::ld8(&Kh[(long)((k0) + sr) * LDK + sc]); sr_[i].ks1 = St::ld8(&Kh[(long)((k0) + 32 + sr) * LDK + sc]); } while (0)
#define SWRITE(b, i) do { *(bf16x8*)((char*)V_lds + (b) * SHM_V + vst0) = St::tobf(sr_[i].vs0);          \
    *(bf16x8*)((char*)V_lds + (b) * SHM_V + vst1) = St::tobf(sr_[i].vs1); int kc = sc * 2;               \
    *(bf16x8*)((char*)K_lds + (b) * SHM_K + KSWZ(sr, kc)) = St::tobf(sr_[i].ks0);                       \
    *(bf16x8*)((char*)K_lds + (b) * SHM_K + KSWZ(32 + sr, kc)) = St::tobf(sr_[i].ks1); } while (0)
#define SWAIT() do { if constexpr (SDEPTH == 2) asm volatile("s_waitcnt vmcnt(4)" ::: "memory"); else asm volatile("s_waitcnt vmcnt(0)" ::: "memory"); } while (0)
#define RESC(a) do { if (__any((a) < 1.f)) { if (hi == 0) al_l[r32] = (a); asm volatile("s_waitcnt lgkmcnt(0)" ::: "memory"); \
    for (int d = 0; d < 4; ++d) for (int r = 0; r < 16; ++r) o[d][r] *= al_l[crow(r, hi)]; } } while (0)
  f32x16 pA0, pA1, pB0, pB1; float mnA, mnB, alA, alB; bf16x8 pa0, pa1, pa2, pa3; const int NT = seq / KVBLK;
  constexpr int SE = 0, SO = SDEPTH - 1;
  SLOAD(SE, 0); asm volatile("s_waitcnt vmcnt(0)" ::: "memory"); SWRITE(0, SE); __syncthreads();
  qkt(pA0, pA1, K_lds, qr, r32, hi); partialSM(pA0, pA1, m_reg, mnA, alA);
  SLOAD(SO, KVBLK); if constexpr (SDEPTH == 2) { if (2 < NT) SLOAD(SE, 2 * KVBLK); }
  SWAIT(); SWRITE(1, SO); __syncthreads();
  for (int j = 1; j + 1 < NT; j += 2) {
    SBAR(); qkt(pB0, pB1, (bf16*)((char*)K_lds + SHM_K), qr, r32, hi);
    finishSM(pA0, pA1, alA, l_reg, pa0, pa1, pa2, pa3); SBAR();
    SLOAD(SO, (j + SDEPTH) * KVBLK); SBAR();
    pv_d0(o, vb0, pa0, pa1, pa2, pa3); partialSM(pB0, pB1, m_reg, mnB, alB);
    __syncthreads(); SWAIT(); SWRITE(0, SE);
    RESC(alB); __syncthreads();
    SBAR(); qkt(pA0, pA1, K_lds, qr, r32, hi);
    finishSM(pB0, pB1, alB, l_reg, pa0, pa1, pa2, pa3); SBAR();
    if (SDEPTH == 1 || j + 3 < NT) SLOAD(SE, (j + 1 + SDEPTH) * KVBLK); SBAR();
    pv_d0(o, vb0 + (int)SHM_V, pa0, pa1, pa2, pa3); partialSM(pA0, pA1, m_reg, mnA, alA);
    __syncthreads(); SWAIT(); SWRITE(1, SO);
    RESC(alA); __syncthreads();
  }
  SBAR(); qkt(pB0, pB1, (bf16*)((char*)K_lds + SHM_K), qr, r32, hi);
  finishSM(pA0, pA1, alA, l_reg, pa0, pa1, pa2, pa3); SBAR();
  pv_d0(o, vb0, pa0, pa1, pa2, pa3); partialSM(pB0, pB1, m_reg, mnB, alB);
  __syncthreads(); RESC(alB);
  finishSM(pB0, pB1, alB, l_reg, pa0, pa1, pa2, pa3); SBAR();
  pv_d0(o, vb0 + (int)SHM_V, pa0, pa1, pa2, pa3);
  if (hi == 0) li_l[r32] = l_reg; asm volatile("s_waitcnt lgkmcnt(0)" ::: "memory");
  float rli[16];
#pragma unroll
  for (int r = 0; r < 16; ++r) rli[r] = __builtin_amdgcn_rcpf(li_l[crow(r, hi)]);
  if constexpr (!OBF16) { float* Ow = (float*)Obv + (long)(wid * QBLK) * LDO;
#pragma unroll
  for (int r = 0; r < 16; ++r) { int orow = crow(r, hi);
    for (int d0 = 0; d0 < 4; ++d0) Ow[(long)orow * LDO + d0 * 32 + r32] = o[d0][r] * rli[r]; }
  } else { unsigned short* Ow = (unsigned short*)Obv + (long)(wid * QBLK) * LDO;
#pragma unroll
  for (int r = 0; r < 16; ++r) { int orow = crow(r, hi);
    for (int d0 = 0; d0 < 4; ++d0) { const unsigned pk = cvtpk(o[d0][r] * rli[r], 0.f); Ow[(long)orow * LDO + d0 * 32 + r32] = (unsigned short)(pk & 0xffffu); } }
  }
#undef SLOAD
#undef SWRITE
#undef SWAIT
#undef RESC
}
#undef KSWZ
#undef SBAR
}
namespace gla {
typedef float f32x16 __attribute__((ext_vector_type(16)));
typedef float f32x4v __attribute__((ext_vector_type(4)));
constexpr int LD = 65;
constexpr int OX = 0, OY = 2 * 64 * LD * 4, OV = 4 * 64 * LD * 4, OAL = OV + 64 * 128 * 4, OW2 = OAL + 64 * 32 * 4, OBA = OW2 + 2 * 16 * 64 * 4, OTOT = OBA + 2 * 64 * 4, OEND = OTOT + 2 * 64 * 4 * 4;
static_assert(OEND <= 131072, "gla lds");
static_assert(64 * 129 * 4 <= 2 * 64 * LD * 4, "O stage fits in X");

struct In {
  const bf16_t* q; const bf16_t* k; const bf16_t* v; const bf16_t* ga; const bf16_t* og; int ld;
  const float* wa2; const float* ba; const float* gnorm;
  float* cs;
  bf16_t* csb;
  float* dec;
  bf16_t* y; int ldy;
  int S, C;
};
__device__ __forceinline__ long chunk_row(const In& p, int cid) { return cid < p.S / 64 ? (long)cid * 64 : (long)p.S + (long)(cid - p.S / 64) * 64; }
__device__ __forceinline__ float logsig(float x) { return x < 0.f ? x - __logf(1.f + __expf(x)) : -__logf(1.f + __expf(-x)); }

__device__ __forceinline__ void cum_phase(const In& p, LAS unsigned char* lds, int head, long row0, int tid) {
  LAS float* AL = (LAS float*)(lds + OAL); LAS float* W2 = (LAS float*)(lds + OW2); LAS float* BA = (LAS float*)(lds + OBA); LAS float* TOT = (LAS float*)(lds + OTOT);
  { const int t = tid >> 3, r4 = (tid & 7) * 4; const unsigned long long u = *(const unsigned long long*)(p.ga + (row0 + t) * p.ld + r4);
    f32x4v a4; a4[0] = bf2f((bf16_t)u); a4[1] = bf2f((bf16_t)(u >> 16)); a4[2] = bf2f((bf16_t)(u >> 32)); a4[3] = bf2f((bf16_t)(u >> 48)); *(LAS f32x4v*)(AL + t * 32 + r4) = a4; }
  { const int e = tid * 4, dir = e >> 10, r = (e >> 6) & 15, j = e & 63; *(LAS f32x4v*)(W2 + e) = *(const f32x4v*)(p.wa2 + ((long)dir * 16 + r) * 256 + head * 64 + j); }
  if (tid < 128) BA[tid] = p.ba[(tid >> 6) * 256 + head * 64 + (tid & 63)];
  __syncthreads();
  const int dir = tid >> 8, j = tid & 63, seg = (tid >> 6) & 3;
  float w[16];
#pragma unroll
  for (int r = 0; r < 16; ++r) w[r] = W2[(dir * 16 + r) * 64 + j];
  const float bj = BA[dir * 64 + j];
  float c[16];
#pragma unroll
  for (int k = 0; k < 16; ++k) { const int t = seg * 16 + k; float z = bj;
#pragma unroll
    for (int r4 = 0; r4 < 4; ++r4) { const f32x4v a4 = *(const LAS f32x4v*)(AL + t * 32 + dir * 16 + 4 * r4); z += a4[0] * w[4 * r4] + a4[1] * w[4 * r4 + 1] + a4[2] * w[4 * r4 + 2] + a4[3] * w[4 * r4 + 3]; }
    c[k] = logsig(z) * (1.f / 16.f); }
  if (dir == 0) {
#pragma unroll
    for (int k = 1; k < 16; ++k) c[k] += c[k - 1];
    TOT[(dir * 64 + j) * 4 + seg] = c[15];
  } else {
#pragma unroll
    for (int k = 14; k >= 0; --k) c[k] += c[k + 1];
    TOT[(dir * 64 + j) * 4 + seg] = c[0];
  }
  __syncthreads();
  float off = 0.f;
#pragma unroll
  for (int s = 0; s < 4; ++s) { const float tv = TOT[(dir * 64 + j) * 4 + s]; if (dir == 0 ? s < seg : s > seg) off += tv; }
  LAS float* X = (LAS float*)(lds + OX) + dir * 64 * LD;
#pragma unroll
  for (int k = 0; k < 16; ++k) X[(seg * 16 + k) * LD + j] = c[k] + off;
}
struct VRegs { unsigned long long u[4]; };
__device__ __forceinline__ VRegs load_v_regs(const In& p, int head, long row0, int tid) { VRegs r;
#pragma unroll
  for (int m = 0; m < 4; ++m) { const int t = (tid >> 5) + 16 * m, c4 = (tid & 31) * 4; r.u[m] = *(const unsigned long long*)(p.v + (row0 + t) * p.ld + head * 128 + c4); }
  return r; }
__device__ __forceinline__ void store_v(const VRegs& r, LAS unsigned char* lds, int tid) {
  LAS float* V = (LAS float*)(lds + OV);
#pragma unroll
  for (int m = 0; m < 4; ++m) { const int t = (tid >> 5) + 16 * m, c4 = (tid & 31) * 4; const unsigned long long u = r.u[m];
    f32x4v a4; a4[0] = bf2f((bf16_t)u); a4[1] = bf2f((bf16_t)(u >> 16)); a4[2] = bf2f((bf16_t)(u >> 32)); a4[3] = bf2f((bf16_t)(u >> 48)); *(LAS f32x4v*)(V + t * 128 + c4) = a4; }
}

__device__ __forceinline__ void g1_unit(const In& p, LAS unsigned char* lds, int head, int cid, int GH, int NCH) {
  int tid = threadIdx.x; asm volatile("" : "+v"(tid));
  const int lane = tid & 63, w = __builtin_amdgcn_readfirstlane(tid >> 6);
  const long row0 = chunk_row(p, cid);
  const VRegs vr = load_v_regs(p, head, row0, tid);
  bf16_t kreg[8];
#pragma unroll
  for (int m = 0; m < 8; ++m) kreg[m] = p.k[(row0 + (tid >> 6) + 8 * m) * p.ld + head * 64 + (tid & 63)];
  cum_phase(p, lds, head, row0, tid);
  store_v(vr, lds, tid);
  __syncthreads();
  LAS float* TOT = (LAS float*)(lds + OTOT);
  { const int j = tid & 63;
#pragma unroll
    for (int dir = 0; dir < 2; ++dir) { LAS float* X = (LAS float*)(lds + OX) + dir * 64 * LD;
      const float cl = TOT[(dir * 64 + j) * 4 + 0] + TOT[(dir * 64 + j) * 4 + 1] + TOT[(dir * 64 + j) * 4 + 2] + TOT[(dir * 64 + j) * 4 + 3];
#pragma unroll
      for (int m = 0; m < 8; ++m) { const int t = (tid >> 6) + 8 * m; const float kv = bf2f(kreg[m]); X[t * LD + j] = kv * __expf(cl - X[t * LD + j]); }
      if (tid < 64) p.dec[(((long)dir * GH + head) * NCH + cid) * 64 + j] = __expf(cl); }
  }
  __syncthreads();
  { const int dir = w >> 2, di = (w >> 1) & 1, vj0 = (w & 1) * 2; const LAS float* X = (const LAS float*)(lds + OX) + dir * 64 * LD; const LAS float* V = (const LAS float*)(lds + OV);
    f32x16 a0 = {}, a1 = {}; const int li = lane & 31, lk = lane >> 5;
#pragma unroll 4
    for (int s0 = 0; s0 < 64; s0 += 2) { const float av = X[(s0 + lk) * LD + 32 * di + li]; const float b0 = V[(s0 + lk) * 128 + 32 * vj0 + li], b1 = V[(s0 + lk) * 128 + 32 * vj0 + 32 + li];
      a0 = __builtin_amdgcn_mfma_f32_32x32x2f32(av, b0, a0, 0, 0, 0); a1 = __builtin_amdgcn_mfma_f32_32x32x2f32(av, b1, a1, 0, 0, 0); }
    float* dst = p.cs + ((((long)dir * GH + head) * NCH + cid) * 64) * 128;
#pragma unroll
    for (int r = 0; r < 16; ++r) { const int d = 32 * di + (r & 3) + 8 * (r >> 2) + 4 * lk; dst[(long)d * 128 + 32 * vj0 + li] = a0[r]; dst[(long)d * 128 + 32 * vj0 + 32 + li] = a1[r]; }
  }
  __syncthreads();
}
__device__ __forceinline__ void g2_item(const In& p, long idx, int GH, int NCH) {
  const int v = 2 * (int)(idx & 63), d = (int)((idx >> 6) & 63); const int hd = (int)((idx >> 12) % GH), dir = (int)((idx >> 12) / GH);
  const int nl = p.S / 64, nc = p.C / 64; float st0 = 0.f, st1 = 0.f;
  bf16_t* base = p.csb + (((long)dir * GH + hd) * NCH) * 64 * 128 + (long)d * 128 + v; const float* db = p.dec + (((long)dir * GH + hd) * NCH) * 64 + d;
  for (int s0 = 0; s0 < nl + nc; s0 += 4) { unsigned c[4]; float dc[4]; unsigned* pp[4];
#pragma unroll
    for (int k = 0; k < 4; ++k) { const int step = s0 + k; int cid; if (step < nc) cid = nl + (dir ? nc - 1 - step : step); else cid = dir ? nl - 1 - (step - nc) : step - nc;
      pp[k] = (unsigned*)(base + (long)cid * 64 * 128); c[k] = *pp[k]; dc[k] = db[(long)cid * 64]; }
#pragma unroll
    for (int k = 0; k < 4; ++k) { *pp[k] = pk2(st0, st1); st0 = dc[k] * st0 + __uint_as_float(c[k] << 16); st1 = dc[k] * st1 + __uint_as_float(c[k] & 0xffff0000u); } }
}
__device__ __forceinline__ void g3_unit(const In& p, LAS unsigned char* lds, int head, int cid, int GH, int NCH) {
  int tid = threadIdx.x; asm volatile("" : "+v"(tid));
  const int lane = tid & 63, w = __builtin_amdgcn_readfirstlane(tid >> 6), li = lane & 31, lk = lane >> 5;
  const long row0 = chunk_row(p, cid);
  float spf[2][32];
  { const int vj_ = w & 3;
#pragma unroll
    for (int dir = 0; dir < 2; ++dir) { const float* sp = p.cs + ((((long)dir * GH + head) * NCH + cid) * 64) * 128 + 32 * vj_ + li;
#pragma unroll
      for (int i = 0; i < 32; ++i) spf[dir][i] = sp[(long)(2 * i + lk) * 128]; } }
  const VRegs vr = load_v_regs(p, head, row0, tid);
  bf16_t kreg[8], qreg[8];
#pragma unroll
  for (int m = 0; m < 8; ++m) { const long o_ = (row0 + (tid >> 6) + 8 * m) * p.ld + head * 64 + (tid & 63); kreg[m] = p.k[o_]; qreg[m] = p.q[o_]; }
  cum_phase(p, lds, head, row0, tid);
  store_v(vr, lds, tid);
  __syncthreads();
  { const int j = tid & 63;
#pragma unroll
    for (int dir = 0; dir < 2; ++dir) { LAS float* X = (LAS float*)(lds + OX) + dir * 64 * LD; LAS float* Y = (LAS float*)(lds + OY) + dir * 64 * LD;
#pragma unroll
      for (int m = 0; m < 8; ++m) { const int t = (tid >> 6) + 8 * m; const float c = X[t * LD + j];
        const float qv = bf2f(qreg[m]) * 0.125f, kv = bf2f(kreg[m]);
        X[t * LD + j] = qv * __expf(c); Y[t * LD + j] = kv * __expf(-c); } }
  }
  __syncthreads();
  {
    const int dir = w >> 2, qi = (w >> 1) & 1, si = w & 1; const bool zero = dir == 0 ? si > qi : si < qi;
    const LAS float* X = (const LAS float*)(lds + OX) + dir * 64 * LD; LAS float* Y = (LAS float*)(lds + OY) + dir * 64 * LD;
    f32x16 pa = {};
    if (!zero) {
#pragma unroll 4
      for (int d0 = 0; d0 < 64; d0 += 2) pa = __builtin_amdgcn_mfma_f32_32x32x2f32(X[(32 * qi + li) * LD + d0 + lk], Y[(32 * si + li) * LD + d0 + lk], pa, 0, 0, 0);
    }
    __syncthreads();
#pragma unroll
    for (int r = 0; r < 16; ++r) { const int q = 32 * qi + (r & 3) + 8 * (r >> 2) + 4 * lk, s = 32 * si + li; const bool keep = dir == 0 ? s <= q : s >= q;
      Y[q * LD + s] = keep ? pa[r] : 0.f; }
  }
  __syncthreads();
  f32x16 acc = {};
  { const int qi = w >> 2, vj = w & 3; const LAS float* V = (const LAS float*)(lds + OV);
#pragma unroll
    for (int dir = 0; dir < 2; ++dir) { const LAS float* X = (const LAS float*)(lds + OX) + dir * 64 * LD; const LAS float* Y = (const LAS float*)(lds + OY) + dir * 64 * LD;
#pragma unroll 4
      for (int s0 = 0; s0 < 64; s0 += 2) acc = __builtin_amdgcn_mfma_f32_32x32x2f32(Y[(32 * qi + li) * LD + s0 + lk], V[(s0 + lk) * 128 + 32 * vj + li], acc, 0, 0, 0);
#pragma unroll
      for (int i = 0; i < 32; ++i) acc = __builtin_amdgcn_mfma_f32_32x32x2f32(X[(32 * qi + li) * LD + 2 * i + lk], spf[dir][i], acc, 0, 0, 0);
    }
    __syncthreads();
    LAS float* O = (LAS float*)(lds + OX);
#pragma unroll
    for (int r = 0; r < 16; ++r) { const int q = 32 * qi + (r & 3) + 8 * (r >> 2) + 4 * lk; O[q * 129 + 32 * vj + li] = acc[r]; }
  }
  __syncthreads();
  { const int row = tid >> 3, part = tid & 7; const LAS float* O = (const LAS float*)(lds + OX) + row * 129 + part * 16;
    float o[16]; float ss = 0.f;
#pragma unroll
    for (int k = 0; k < 16; ++k) { o[k] = O[k]; ss += o[k] * o[k]; }
    ss += __shfl_xor(ss, 1); ss += __shfl_xor(ss, 2); ss += __shfl_xor(ss, 4);
    const float rs = 1.f / sqrtf(ss * (1.f / 128.f) + 1e-6f);
    const bf16_t* ogp = p.og + (row0 + row) * p.ld + head * 128 + part * 16; const v4u og0 = *(const v4u*)ogp, og1 = *(const v4u*)(ogp + 8);
    const unsigned ogw[8] = {og0.x, og0.y, og0.z, og0.w, og1.x, og1.y, og1.z, og1.w}; bf16_t* yp = p.y + (row0 + row) * p.ldy + head * 128 + part * 16; float yy[16];
#pragma unroll
    for (int k4 = 0; k4 < 4; ++k4) { f32x4v g4; g4[0] = bf2f((bf16_t)(ogw[2 * k4] & 0xffff)); g4[1] = bf2f((bf16_t)(ogw[2 * k4] >> 16)); g4[2] = bf2f((bf16_t)(ogw[2 * k4 + 1] & 0xffff)); g4[3] = bf2f((bf16_t)(ogw[2 * k4 + 1] >> 16)); const f32x4v n4 = *(const f32x4v*)(p.gnorm + part * 16 + 4 * k4); f32x4v y4;
#pragma unroll
      for (int e = 0; e < 4; ++e) { const float gg = g4[e]; y4[e] = o[4 * k4 + e] * rs * n4[e] * (gg / (1.f + __expf(-gg))); yy[4 * k4 + e] = y4[e]; } }
    { v4u o0, o1; o0.x = pk2(yy[0], yy[1]); o0.y = pk2(yy[2], yy[3]); o0.z = pk2(yy[4], yy[5]); o0.w = pk2(yy[6], yy[7]);
      o1.x = pk2(yy[8], yy[9]); o1.y = pk2(yy[10], yy[11]); o1.z = pk2(yy[12], yy[13]); o1.w = pk2(yy[14], yy[15]); *(v4u*)yp = o0; *(v4u*)(yp + 8) = o1; }
  }
  __syncthreads();
}

typedef short bf16x8g __attribute__((ext_vector_type(8)));
constexpr int LB = 72;
constexpr int OQB = 2 * 64 * LD * 4, OKB = OQB + 2 * 64 * LB * 2, OVT = OKB + 2 * 64 * LB * 2, OBEND = OVT + 128 * LB * 2;
static_assert(OBEND <= OAL, "gla bf16 lds");
#define GMM(A, B, C) C = __builtin_amdgcn_mfma_f32_32x32x16_bf16(__builtin_bit_cast(bf16x8g, A), __builtin_bit_cast(bf16x8g, B), C, 0, 0, 0)
__device__ __forceinline__ void store_vt(const VRegs& r, LAS unsigned char* lds, int tid) {
  LAS bf16_t* Vt = (LAS bf16_t*)(lds + OVT);
#pragma unroll
  for (int m = 0; m < 4; ++m) { const int t = (tid >> 5) + 16 * m, c4 = (tid & 31) * 4; const unsigned long long u = r.u[m];
    Vt[(c4 + 0) * LB + t] = (bf16_t)u; Vt[(c4 + 1) * LB + t] = (bf16_t)(u >> 16); Vt[(c4 + 2) * LB + t] = (bf16_t)(u >> 32); Vt[(c4 + 3) * LB + t] = (bf16_t)(u >> 48); }
}
__device__ __forceinline__ void g1b_unit(const In& p, LAS unsigned char* lds, int head, int cid, int GH, int NCH) {
  int tid = threadIdx.x; asm volatile("" : "+v"(tid));
  const int lane = tid & 63, w = __builtin_amdgcn_readfirstlane(tid >> 6), li = lane & 31, lk = lane >> 5;
  const long row0 = chunk_row(p, cid);
  const VRegs vr = load_v_regs(p, head, row0, tid);
  bf16_t kreg[8];
#pragma unroll
  for (int m = 0; m < 8; ++m) kreg[m] = p.k[(row0 + (tid >> 6) + 8 * m) * p.ld + head * 64 + (tid & 63)];
  cum_phase(p, lds, head, row0, tid);
  store_vt(vr, lds, tid);
  __syncthreads();
  LAS float* TOT = (LAS float*)(lds + OTOT);
  { const int j = tid & 63;
#pragma unroll
    for (int dir = 0; dir < 2; ++dir) { const LAS float* X = (const LAS float*)(lds + OX) + dir * 64 * LD; LAS bf16_t* KeT = (LAS bf16_t*)(lds + OQB) + dir * 64 * LB;
      const float cl = TOT[(dir * 64 + j) * 4 + 0] + TOT[(dir * 64 + j) * 4 + 1] + TOT[(dir * 64 + j) * 4 + 2] + TOT[(dir * 64 + j) * 4 + 3];
#pragma unroll
      for (int m = 0; m < 8; ++m) { const int t = (tid >> 6) + 8 * m; KeT[j * LB + t] = (bf16_t)f2bf(bf2f(kreg[m]) * __expf(cl - X[t * LD + j])); }
      if (tid < 64) p.dec[(((long)dir * GH + head) * NCH + cid) * 64 + j] = __expf(cl); }
  }
  __syncthreads();
  { const int dir = w >> 2, di = (w >> 1) & 1, vj0 = (w & 1) * 2; const LAS bf16_t* KeT = (const LAS bf16_t*)(lds + OQB) + dir * 64 * LB; const LAS bf16_t* Vt = (const LAS bf16_t*)(lds + OVT);
    f32x16 a0 = {}, a1 = {};
#pragma unroll
    for (int kk = 0; kk < 4; ++kk) { const v4u av = *(const LAS v4u*)(KeT + (32 * di + li) * LB + 16 * kk + 8 * lk);
      const v4u b0 = *(const LAS v4u*)(Vt + (32 * vj0 + li) * LB + 16 * kk + 8 * lk), b1 = *(const LAS v4u*)(Vt + (32 * vj0 + 32 + li) * LB + 16 * kk + 8 * lk);
      GMM(av, b0, a0); GMM(av, b1, a1); }
    bf16_t* dst = p.csb + ((((long)dir * GH + head) * NCH + cid) * 64) * 128;
#pragma unroll
    for (int r = 0; r < 16; ++r) { const int d = 32 * di + (r & 3) + 8 * (r >> 2) + 4 * lk; dst[(long)d * 128 + 32 * vj0 + li] = (bf16_t)f2bf(a0[r]); dst[(long)d * 128 + 32 * vj0 + 32 + li] = (bf16_t)f2bf(a1[r]); }
  }
  __syncthreads();
}
__device__ __forceinline__ void g3b_unit(const In& p, LAS unsigned char* lds, int head, int cid, int GH, int NCH) {
  int tid = threadIdx.x; asm volatile("" : "+v"(tid));
  const int lane = tid & 63, w = __builtin_amdgcn_readfirstlane(tid >> 6), li = lane & 31, lk = lane >> 5;
  const long row0 = chunk_row(p, cid);
  unsigned spf[2][32];
  { const int vj_ = w & 3;
#pragma unroll
    for (int dir = 0; dir < 2; ++dir) { const bf16_t* sp = p.csb + ((((long)dir * GH + head) * NCH + cid) * 64) * 128 + 32 * vj_ + li;
#pragma unroll
      for (int i = 0; i < 32; ++i) spf[dir][i] = sp[(long)(16 * (i >> 3) + 8 * lk + (i & 7)) * 128]; } }
  const VRegs vr = load_v_regs(p, head, row0, tid);
  bf16_t kreg[8], qreg[8];
#pragma unroll
  for (int m = 0; m < 8; ++m) { const long o_ = (row0 + (tid >> 6) + 8 * m) * p.ld + head * 64 + (tid & 63); kreg[m] = p.k[o_]; qreg[m] = p.q[o_]; }
  cum_phase(p, lds, head, row0, tid);
  store_vt(vr, lds, tid);
  __syncthreads();
  { const int j = tid & 63;
#pragma unroll
    for (int dir = 0; dir < 2; ++dir) { const LAS float* X = (const LAS float*)(lds + OX) + dir * 64 * LD; LAS bf16_t* Qb = (LAS bf16_t*)(lds + OQB) + dir * 64 * LB; LAS bf16_t* Kb = (LAS bf16_t*)(lds + OKB) + dir * 64 * LB;
#pragma unroll
      for (int m = 0; m < 8; ++m) { const int t = (tid >> 6) + 8 * m; const float c = X[t * LD + j];
        Qb[t * LB + j] = (bf16_t)f2bf(bf2f(qreg[m]) * 0.125f * __expf(c)); Kb[t * LB + j] = (bf16_t)f2bf(bf2f(kreg[m]) * __expf(-c)); } }
  }
  __syncthreads();
  {
    const int dir = w >> 2, qi = (w >> 1) & 1, si = w & 1; const bool zero = dir == 0 ? si > qi : si < qi;
    const LAS bf16_t* Qb = (const LAS bf16_t*)(lds + OQB) + dir * 64 * LB; LAS bf16_t* Kb = (LAS bf16_t*)(lds + OKB) + dir * 64 * LB;
    f32x16 pa = {};
    if (!zero) {
#pragma unroll
      for (int kk = 0; kk < 4; ++kk) { const v4u av = *(const LAS v4u*)(Qb + (32 * qi + li) * LB + 16 * kk + 8 * lk), bv = *(const LAS v4u*)(Kb + (32 * si + li) * LB + 16 * kk + 8 * lk); GMM(av, bv, pa); }
    }
    __syncthreads();
#pragma unroll
    for (int r = 0; r < 16; ++r) { const int q = 32 * qi + (r & 3) + 8 * (r >> 2) + 4 * lk, s = 32 * si + li; const bool keep = dir == 0 ? s <= q : s >= q;
      Kb[q * LB + s] = (bf16_t)f2bf(keep ? pa[r] : 0.f); }
  }
  __syncthreads();
  f32x16 acc = {};
  { const int qi = w >> 2, vj = w & 3; const LAS bf16_t* Vt = (const LAS bf16_t*)(lds + OVT);
#pragma unroll
    for (int dir = 0; dir < 2; ++dir) { const LAS bf16_t* Qb = (const LAS bf16_t*)(lds + OQB) + dir * 64 * LB; const LAS bf16_t* Pb = (const LAS bf16_t*)(lds + OKB) + dir * 64 * LB;
#pragma unroll
      for (int kk = 0; kk < 4; ++kk) { const v4u av = *(const LAS v4u*)(Pb + (32 * qi + li) * LB + 16 * kk + 8 * lk), bv = *(const LAS v4u*)(Vt + (32 * vj + li) * LB + 16 * kk + 8 * lk); GMM(av, bv, acc); }
#pragma unroll
      for (int kk = 0; kk < 4; ++kk) { const v4u av = *(const LAS v4u*)(Qb + (32 * qi + li) * LB + 16 * kk + 8 * lk);
        v4u bv; bv.x = spf[dir][8 * kk + 0] | (spf[dir][8 * kk + 1] << 16); bv.y = spf[dir][8 * kk + 2] | (spf[dir][8 * kk + 3] << 16); bv.z = spf[dir][8 * kk + 4] | (spf[dir][8 * kk + 5] << 16); bv.w = spf[dir][8 * kk + 6] | (spf[dir][8 * kk + 7] << 16);
        GMM(av, bv, acc); }
    }
    LAS float* O = (LAS float*)(lds + OX);
#pragma unroll
    for (int r = 0; r < 16; ++r) { const int q = 32 * qi + (r & 3) + 8 * (r >> 2) + 4 * lk; O[q * 129 + 32 * vj + li] = acc[r]; }
  }
  __syncthreads();
  { const int row = tid >> 3, part = tid & 7; const LAS float* O = (const LAS float*)(lds + OX) + row * 129 + part * 16;
    float o[16]; float ss = 0.f;
#pragma unroll
    for (int k = 0; k < 16; ++k) { o[k] = O[k]; ss += o[k] * o[k]; }
    ss += __shfl_xor(ss, 1); ss += __shfl_xor(ss, 2); ss += __shfl_xor(ss, 4);
    const float rs = 1.f / sqrtf(ss * (1.f / 128.f) + 1e-6f);
    const bf16_t* ogp = p.og + (row0 + row) * p.ld + head * 128 + part * 16; const v4u og0 = *(const v4u*)ogp, og1 = *(const v4u*)(ogp + 8);
    const unsigned ogw[8] = {og0.x, og0.y, og0.z, og0.w, og1.x, og1.y, og1.z, og1.w}; bf16_t* yp = p.y + (row0 + row) * p.ldy + head * 128 + part * 16; float yy[16];
#pragma unroll
    for (int k4 = 0; k4 < 4; ++k4) { f32x4v g4; g4[0] = bf2f((bf16_t)(ogw[2 * k4] & 0xffff)); g4[1] = bf2f((bf16_t)(ogw[2 * k4] >> 16)); g4[2] = bf2f((bf16_t)(ogw[2 * k4 + 1] & 0xffff)); g4[3] = bf2f((bf16_t)(ogw[2 * k4 + 1] >> 16)); const f32x4v n4 = *(const f32x4v*)(p.gnorm + part * 16 + 4 * k4);
#pragma unroll
      for (int e = 0; e < 4; ++e) { const float gg = g4[e]; yy[4 * k4 + e] = o[4 * k4 + e] * rs * n4[e] * (gg / (1.f + __expf(-gg))); } }
    { v4u o0, o1; o0.x = pk2(yy[0], yy[1]); o0.y = pk2(yy[2], yy[3]); o0.z = pk2(yy[4], yy[5]); o0.w = pk2(yy[6], yy[7]);
      o1.x = pk2(yy[8], yy[9]); o1.y = pk2(yy[10], yy[11]); o1.z = pk2(yy[12], yy[13]); o1.w = pk2(yy[14], yy[15]); *(v4u*)yp = o0; *(v4u*)(yp + 8) = o1; }
  }
  __syncthreads();
}
#undef GMM
}
namespace moe {
constexpr int NE = 16, NG = 4, EPG = 4, DE = 512, D = 1024;
__device__ __forceinline__ float wave_sum(float v) {
#pragma unroll
  for (int o = 1; o < 64; o <<= 1) v += __shfl_xor(v, o);
  return v;
}
struct Route { int e0, r0, e1, r1; };
struct MoeOrder {
  int G, c, NT; const LAS int* poff;
  __device__ __forceinline__ bool next(int i, pg8::Unit& u) const {
    const long L = (long)i * G + c; const int total = poff[NE] * NT; if (L >= total) return false;
    const int panel = (int)L / NT, j = (int)L % NT; int e = 0;
#pragma unroll
    for (int k = 1; k < NE; ++k) e += (panel >= poff[k]) ? 1 : 0;
    u.pm = panel; u.pn = e * NT + j; u.acol = 0; u.nt = 0; return true;
  }
  __device__ __forceinline__ void a_ready(const pg8::Unit&) const {}
  __device__ __forceinline__ void done(const pg8::Unit&) const {}
};
struct EpiGU {
  static constexpr bool PERM = true, AFTER_DRAIN = false;
  bf16_t* hid;
  __device__ __forceinline__ void operator()(const pg8::f32x4 (&acc)[2][2][4][2], const pg8::Unit& u, int wr, int wc, int fr, int fq) const {
    const int j = u.pn & 3; const int row0 = u.pm * 256 + wr * 64 + fr, col0 = j * 128 + wc * 32 + 8 * fq;
#pragma unroll
    for (int ai = 0; ai < 2; ++ai)
#pragma unroll
      for (int m = 0; m < 4; ++m) { const size_t r = (size_t)(row0 + ai * 128 + m * 16); float hv[8];
#pragma unroll
        for (int n = 0; n < 2; ++n)
#pragma unroll
          for (int e = 0; e < 4; ++e) { const float g = acc[ai][0][m][n][e], up = acc[ai][1][m][n][e]; hv[4 * n + e] = g / (1.f + __expf(-g)) * up; }
        v4u o; o.x = pk2(hv[0], hv[1]); o.y = pk2(hv[2], hv[3]); o.z = pk2(hv[4], hv[5]); o.w = pk2(hv[6], hv[7]);
        *(v4u*)(hid + r * DE + col0) = o; }
  }
};
struct EpiDown {
  static constexpr bool PERM = true, AFTER_DRAIN = false;
  const int* srcrow; const float* wgt; bf16_t* contrib; size_t slot_stride;
  __device__ __forceinline__ void operator()(const pg8::f32x4 (&acc)[2][2][4][2], const pg8::Unit& u, int wr, int wc, int fr, int fq) const {
    const int pn = u.pn & 3; const int row0 = u.pm * 256 + wr * 64 + fr, col0 = pn * 256 + wc * 32 + 8 * fq;
    int srcs[2][4]; float ws_[2][4];
#pragma unroll
    for (int ai = 0; ai < 2; ++ai)
#pragma unroll
      for (int m = 0; m < 4; ++m) { const int r = row0 + ai * 128 + m * 16; srcs[ai][m] = srcrow[r]; ws_[ai][m] = wgt[r]; }
#pragma unroll
    for (int ai = 0; ai < 2; ++ai)
#pragma unroll
      for (int m = 0; m < 4; ++m) { const int src = srcs[ai][m]; if (src < 0) continue; const float w = ws_[ai][m];
        bf16_t* dst = contrib + (size_t)(src & 1) * slot_stride + (size_t)(src >> 1) * D + col0;
#pragma unroll
        for (int bj = 0; bj < 2; ++bj) { const pg8::f32x4 v0 = acc[ai][bj][m][0] * w, v1 = acc[ai][bj][m][1] * w;
          v4u o; o.x = pk2(v0[0], v0[1]); o.y = pk2(v0[2], v0[3]); o.z = pk2(v1[0], v1[1]); o.w = pk2(v1[2], v1[3]); *(v4u*)(dst + bj * 128) = o; } }
  }
};
__device__ __forceinline__ void route_row(const bf16_t* xr, const float* gnorm, const float* shift, const float* scale, bf16_t* hrow, const LAS float* rwT, const float* rbias,
                                          LAS int* cnt, Route* rt, float* wts, int lane) {
  typedef float f4 __attribute__((ext_vector_type(4)));
  f4 xv[4]; float ss = 0.f;
#pragma unroll
  for (int j = 0; j < 4; ++j) { const uint2 rw = *(const uint2*)(xr + 4 * lane + 256 * j); xv[j][0] = __uint_as_float(rw.x << 16); xv[j][1] = __uint_as_float(rw.x & 0xffff0000u); xv[j][2] = __uint_as_float(rw.y << 16); xv[j][3] = __uint_as_float(rw.y & 0xffff0000u); ss += xv[j][0] * xv[j][0] + xv[j][1] * xv[j][1] + xv[j][2] * xv[j][2] + xv[j][3] * xv[j][3]; }
  const float rs = 1.f / sqrtf(wave_sum(ss) * (1.f / 1024.f) + 1e-6f);
  float lg[NE];
#pragma unroll
  for (int e = 0; e < NE; ++e) lg[e] = 0.f;
#pragma unroll
  for (int j = 0; j < 4; ++j) { const int c = 4 * lane + 256 * j; const f4 g4 = *(const f4*)(gnorm + c), sh = *(const f4*)(shift + c), sc = *(const f4*)(scale + c);
    f4 h;
#pragma unroll
    for (int i = 0; i < 4; ++i) h[i] = xv[j][i] * rs * g4[i] * (1.f + sc[i]) + sh[i];
    *(unsigned long long*)(hrow + c) = (unsigned long long)pk2(h[0], h[1]) | ((unsigned long long)pk2(h[2], h[3]) << 32);
#pragma unroll
    for (int e = 0; e < NE; ++e) { const f4 w4 = *(const LAS f4*)(rwT + e * 1024 + c); lg[e] += h[0] * w4[0] + h[1] * w4[1] + h[2] * w4[2] + h[3] * w4[3]; } }
  { float v8[8], v4[4], v2[2], v1;
#pragma unroll
    for (int i = 0; i < 8; ++i) { const bool up = lane & 1; const float keep = up ? lg[2 * i + 1] : lg[2 * i], send = up ? lg[2 * i] : lg[2 * i + 1]; v8[i] = keep + __shfl_xor(send, 1); }
#pragma unroll
    for (int i = 0; i < 4; ++i) { const bool up = lane & 2; const float keep = up ? v8[2 * i + 1] : v8[2 * i], send = up ? v8[2 * i] : v8[2 * i + 1]; v4[i] = keep + __shfl_xor(send, 2); }
#pragma unroll
    for (int i = 0; i < 2; ++i) { const bool up = lane & 4; const float keep = up ? v4[2 * i + 1] : v4[2 * i], send = up ? v4[2 * i] : v4[2 * i + 1]; v2[i] = keep + __shfl_xor(send, 4); }
    { const bool up = lane & 8; const float keep = up ? v2[1] : v2[0], send = up ? v2[0] : v2[1]; v1 = keep + __shfl_xor(send, 8); }
    v1 += __shfl_xor(v1, 16); v1 += __shfl_xor(v1, 32);
#pragma unroll
    for (int e = 0; e < NE; ++e) lg[e] = __shfl(v1, e); }
  float sc[NE], sel[NE];
#pragma unroll
  for (int e = 0; e < NE; ++e) { sc[e] = 1.f / (1.f + __expf(-lg[e])); sel[e] = sc[e] + rbias[e]; }
  int bestg = 0; float bestgs = -1e30f;
#pragma unroll
  for (int g = 0; g < NG; ++g) { float m1 = -1e30f, m2 = -1e30f;
#pragma unroll
    for (int i = 0; i < EPG; ++i) { const float v = sel[g * EPG + i]; if (v > m1) { m2 = m1; m1 = v; } else if (v > m2) m2 = v; }
    const float gsum = m1 + m2; if (gsum > bestgs) { bestgs = gsum; bestg = g; } }
  int i1 = -1, i2 = -1; float v1 = -1e30f, v2 = -1e30f, s1 = 0.f, s2 = 0.f;
#pragma unroll
  for (int e = 0; e < NE; ++e) { if (e / EPG == bestg) { const float v = sel[e];
      if (v > v1) { v2 = v1; i2 = i1; s2 = s1; v1 = v; i1 = e; s1 = sc[e]; } else if (v > v2) { v2 = v; i2 = e; s2 = sc[e]; } } }
  if (lane == 0) { const float inv = 1.f / (s1 + s2); Route r; r.e0 = i1; r.e1 = i2; r.r0 = __hip_atomic_fetch_add(cnt + i1, 1, __ATOMIC_RELAXED, __HIP_MEMORY_SCOPE_WORKGROUP); r.r1 = __hip_atomic_fetch_add(cnt + i2, 1, __ATOMIC_RELAXED, __HIP_MEMORY_SCOPE_WORKGROUP); *rt = r; wts[0] = s1 * inv; wts[1] = s2 * inv; }
}
__device__ __forceinline__ void route16(const bf16_t* x0, const LAS float* gp, const LAS float* sp, bf16_t* h0, const LAS v4u* wfrag, const float* rbias,
                                        LAS int* cnt, Route* rt0, float* wts0, int lane) {
  typedef float f4 __attribute__((ext_vector_type(4))); typedef short b8 __attribute__((ext_vector_type(8)));
  const int fr = lane & 15, fq = lane >> 4;
  const bf16_t* xr = x0 + (size_t)fr * 1024 + 8 * fq; bf16_t* hr = h0 + (size_t)fr * 1024 + 8 * fq;
  v4u xq[32];
#pragma unroll
  for (int kk = 0; kk < 32; ++kk) xq[kk] = *(const v4u*)(xr + 32 * kk);
  float ss = 0.f;
#pragma unroll
  for (int kk = 0; kk < 32; ++kk) { const v4u q = xq[kk]; float t;
    t = __uint_as_float(q.x << 16); ss += t * t; t = __uint_as_float(q.x & 0xffff0000u); ss += t * t; t = __uint_as_float(q.y << 16); ss += t * t; t = __uint_as_float(q.y & 0xffff0000u); ss += t * t;
    t = __uint_as_float(q.z << 16); ss += t * t; t = __uint_as_float(q.z & 0xffff0000u); ss += t * t; t = __uint_as_float(q.w << 16); ss += t * t; t = __uint_as_float(q.w & 0xffff0000u); ss += t * t; }
  ss += __shfl_xor(ss, 16); ss += __shfl_xor(ss, 32);
  const float rs = 1.f / sqrtf(ss * (1.f / 1024.f) + 1e-6f);
#pragma unroll
  for (int kk = 0; kk < 32; ++kk) asm volatile("" : "+v"(xq[kk].x), "+v"(xq[kk].y), "+v"(xq[kk].z), "+v"(xq[kk].w));
  f4 acc = {0.f, 0.f, 0.f, 0.f};
#pragma unroll
  for (int kk = 0; kk < 32; ++kk) { const int c = 32 * kk + 8 * fq; const v4u q = xq[kk];
    const f4 ga = *(const LAS f4*)(gp + c), gb = *(const LAS f4*)(gp + c + 4), ha = *(const LAS f4*)(sp + c), hb = *(const LAS f4*)(sp + c + 4);
    const v4u wh = wfrag[kk * 64 + lane], wl = wfrag[2048 + kk * 64 + lane];
    float h[8];
    h[0] = __uint_as_float(q.x << 16) * (rs * ga[0]) + ha[0]; h[1] = __uint_as_float(q.x & 0xffff0000u) * (rs * ga[1]) + ha[1];
    h[2] = __uint_as_float(q.y << 16) * (rs * ga[2]) + ha[2]; h[3] = __uint_as_float(q.y & 0xffff0000u) * (rs * ga[3]) + ha[3];
    h[4] = __uint_as_float(q.z << 16) * (rs * gb[0]) + hb[0]; h[5] = __uint_as_float(q.z & 0xffff0000u) * (rs * gb[1]) + hb[1];
    h[6] = __uint_as_float(q.w << 16) * (rs * gb[2]) + hb[2]; h[7] = __uint_as_float(q.w & 0xffff0000u) * (rs * gb[3]) + hb[3];
    v4u hq; hq.x = pk2(h[0], h[1]); hq.y = pk2(h[2], h[3]); hq.z = pk2(h[4], h[5]); hq.w = pk2(h[6], h[7]);
    *(v4u*)(hr + 32 * kk) = hq;
    v4u lq; lq.x = pk2(h[0] - __uint_as_float(hq.x << 16), h[1] - __uint_as_float(hq.x & 0xffff0000u)); lq.y = pk2(h[2] - __uint_as_float(hq.y << 16), h[3] - __uint_as_float(hq.y & 0xffff0000u));
    lq.z = pk2(h[4] - __uint_as_float(hq.z << 16), h[5] - __uint_as_float(hq.z & 0xffff0000u)); lq.w = pk2(h[6] - __uint_as_float(hq.w << 16), h[7] - __uint_as_float(hq.w & 0xffff0000u));
    acc = __builtin_amdgcn_mfma_f32_16x16x32_bf16(__builtin_bit_cast(b8, wh), __builtin_bit_cast(b8, hq), acc, 0, 0, 0);
    acc = __builtin_amdgcn_mfma_f32_16x16x32_bf16(__builtin_bit_cast(b8, wl), __builtin_bit_cast(b8, hq), acc, 0, 0, 0);
    acc = __builtin_amdgcn_mfma_f32_16x16x32_bf16(__builtin_bit_cast(b8, wh), __builtin_bit_cast(b8, lq), acc, 0, 0, 0);
    if (kk & 1) asm volatile("" ::: "memory"); }
  float sc[4], sel[4]; const f4 rb4 = *(const f4*)(rbias + 4 * fq);
#pragma unroll
  for (int i = 0; i < 4; ++i) { sc[i] = 1.f / (1.f + __expf(-acc[i])); sel[i] = sc[i] + rb4[i]; }
  int i1 = -1, i2 = -1; float v1 = -1e30f, v2 = -1e30f, s1 = 0.f, s2 = 0.f;
#pragma unroll
  for (int i = 0; i < 4; ++i) { const float v = sel[i]; if (v > v1) { v2 = v1; i2 = i1; s2 = s1; v1 = v; i1 = i; s1 = sc[i]; } else if (v > v2) { v2 = v; i2 = i; s2 = sc[i]; } }
  float bgs = v1 + v2; int bg = fq;
  { float og = __shfl_xor(bgs, 16); int oi = __shfl_xor(bg, 16); if (og > bgs || (og == bgs && oi < bg)) { bgs = og; bg = oi; }
    og = __shfl_xor(bgs, 32); oi = __shfl_xor(bg, 32); if (og > bgs || (og == bgs && oi < bg)) { bgs = og; bg = oi; } }
  if (fq == bg) { const float inv = 1.f / (s1 + s2); Route r; r.e0 = 4 * fq + i1; r.e1 = 4 * fq + i2;
    r.r0 = __hip_atomic_fetch_add(cnt + r.e0, 1, __ATOMIC_RELAXED, __HIP_MEMORY_SCOPE_WORKGROUP); r.r1 = __hip_atomic_fetch_add(cnt + r.e1, 1, __ATOMIC_RELAXED, __HIP_MEMORY_SCOPE_WORKGROUP);
    rt0[fr] = r; wts0[2 * fr] = s1 * inv; wts0[2 * fr + 1] = s2 * inv; }
}
}
namespace hy {
typedef float f32x16 __attribute__((ext_vector_type(16)));
constexpr int S = 4096, NT1 = 128, LDZ = 191, ZPAD = 31, LDX = 129;
constexpr int O_TAPS = 0, O_ZA = 32768, O_ZB = O_ZA + 32 * LDZ * 4, O_X1 = O_ZB + 32 * LDZ * 4, O_X2 = O_X1 + 32 * LDX * 4, O_RED = O_X2 + 32 * LDX * 4, O_END = O_RED + 4 * 64 * 16 * 4;
static_assert(O_END <= 131072, "hyena lds");

struct H0Regs { v4u w0, w1; };
__device__ __forceinline__ H0Regs h0_load(const bf16_t* u, int ld, int tile, int tid) {
  const int tt = tile / 24, jt = tile % 24, t0 = tt * 64, j0 = jt * 64; H0Regs r; r.w0 = (v4u){0u, 0u, 0u, 0u}; r.w1 = r.w0;
  { const int rr = tid >> 3, c8 = (tid & 7) * 8, t = t0 - 1 + rr; if (t >= 0 && t < S) r.w0 = *(const v4u*)(u + (size_t)t * ld + j0 + c8); }
  if (tid < 16) { const int rr = 64 + (tid >> 3), c8 = (tid & 7) * 8, t = t0 - 1 + rr; if (t < S) r.w1 = *(const v4u*)(u + (size_t)t * ld + j0 + c8); }
  return r;
}
__device__ __forceinline__ void h0_compute(const H0Regs& rg, const float* cw, const float* cb, bf16_t* ucT, int tile, LAS unsigned char* lds, int tid) {
  const int tt = tile / 24, jt = tile % 24, t0 = tt * 64, j0 = jt * 64;
  LAS float* U = (LAS float*)lds;
  { const int rr = tid >> 3, c8 = (tid & 7) * 8; const v4u w = rg.w0; LAS float* d = U + rr * 65 + c8;
    d[0] = bf2f(w.x & 0xffff); d[1] = bf2f(w.x >> 16); d[2] = bf2f(w.y & 0xffff); d[3] = bf2f(w.y >> 16); d[4] = bf2f(w.z & 0xffff); d[5] = bf2f(w.z >> 16); d[6] = bf2f(w.w & 0xffff); d[7] = bf2f(w.w >> 16); }
  if (tid < 16) { const int rr = 64 + (tid >> 3), c8 = (tid & 7) * 8; const v4u w = rg.w1; LAS float* d = U + rr * 65 + c8;
    d[0] = bf2f(w.x & 0xffff); d[1] = bf2f(w.x >> 16); d[2] = bf2f(w.y & 0xffff); d[3] = bf2f(w.y >> 16); d[4] = bf2f(w.z & 0xffff); d[5] = bf2f(w.z >> 16); d[6] = bf2f(w.w & 0xffff); d[7] = bf2f(w.w >> 16); }
  __syncthreads();
  { const int jj = tid >> 3, tq = (tid & 7) * 8, j = j0 + jj; const float w0 = cw[j], w1 = cw[1536 + j], w2 = cw[2 * 1536 + j], bb = cb[j]; float v[8];
#pragma unroll
    for (int k = 0; k < 8; ++k) v[k] = bb + w0 * U[(tq + k) * 65 + jj] + w1 * U[(tq + k + 1) * 65 + jj] + w2 * U[(tq + k + 2) * 65 + jj];
    v4u o; o.x = pk2(v[0], v[1]); o.y = pk2(v[2], v[3]); o.z = pk2(v[4], v[5]); o.w = pk2(v[6], v[7]); *(v4u*)(ucT + (size_t)j * S + t0 + tq) = o; }
  __syncthreads();
}
__device__ __forceinline__ void h2_tile(const bf16_t* yT, bf16_t* ybf, int ldy, int tile, LAS unsigned char* lds) {
  int tid = threadIdx.x; asm volatile("" : "+v"(tid));
  const int tt = tile / 8, ct = tile % 8, t0 = tt * 64, c0 = ct * 64;
  LAS bf16_t* T = (LAS bf16_t*)lds;
  { const int cc = tid >> 3, t8 = (tid & 7) * 8; const v4u w = *(const v4u*)(yT + (size_t)(c0 + cc) * S + t0 + t8); LAS unsigned* d = (LAS unsigned*)(T + cc * 66 + t8); d[0] = w.x; d[1] = w.y; d[2] = w.z; d[3] = w.w; }
  __syncthreads();
  { const int t = tid >> 3, c8 = (tid & 7) * 8; unsigned short e[8];
#pragma unroll
    for (int k = 0; k < 8; ++k) e[k] = T[(c8 + k) * 66 + t];
    v4u o; o.x = e[0] | ((unsigned)e[1] << 16); o.y = e[2] | ((unsigned)e[3] << 16); o.z = e[4] | ((unsigned)e[5] << 16); o.w = e[6] | ((unsigned)e[7] << 16);
    *(v4u*)(ybf + (size_t)(t0 + t) * ldy + c0 + c8) = o; }
  __syncthreads();
}
__device__ __forceinline__ void h1_unit(const bf16_t* ucT, const float* tapsT, const float* nrm, const float* skip, bf16_t* yT, int c, LAS unsigned char* lds) {
  int tid = threadIdx.x; asm volatile("" : "+v"(tid));
  const int lane = tid & 63, w = __builtin_amdgcn_readfirstlane(tid >> 6), li = lane & 31, lk = lane >> 5;
  LAS float* TAPS = (LAS float*)(lds + O_TAPS); LAS float* ZA = (LAS float*)(lds + O_ZA); LAS float* ZB = (LAS float*)(lds + O_ZB);
  LAS float* X1 = (LAS float*)(lds + O_X1); LAS float* X2 = (LAS float*)(lds + O_X2); LAS float* RED = (LAS float*)(lds + O_RED);
  for (int e = tid; e < 32 * 62; e += 512) { const int s2 = e / 62, p = e % 62, t1p = p < 31 ? p : 128 + p; ZA[s2 * LDZ + t1p] = 0.f; ZB[s2 * LDZ + t1p] = 0.f; }
  for (int t = tid; t < S; t += 512) { const int t2 = t & 31, t1 = t >> 5;
    X1[t2 * LDX + t1] = bf2f(ucT[(size_t)c * S + t]); X2[t2 * LDX + t1] = bf2f(ucT[(size_t)(512 + c) * S + t]); ZA[t2 * LDZ + t1 + ZPAD] = bf2f(ucT[(size_t)(1024 + c) * S + t]); }
#pragma unroll 1
  for (int o = 0; o < 2; ++o) {
    const float* tp = tapsT + ((size_t)o * 512 + c) * 8192;
    for (int e = tid; e < 8192; e += 512) TAPS[e] = tp[(e + 4096) & 8191];
    __syncthreads();
    const LAS float* Zin = o == 0 ? ZA : ZB;
    const int g = w & 3, dh = w >> 2;
    const int Dlo = 32 * g - 127 + (dh ? 80 : 0), Dn = dh ? 79 : 80;
    f32x16 acc = {};
    { const LAS float* ap = TAPS + 4096 + 32 * Dlo + li - lk - 30;
      const LAS float* bp = Zin + lk * LDZ + (32 * g + li - Dlo + ZPAD);
#pragma unroll 2
      for (int dd = 0; dd < Dn; ++dd) {
#pragma unroll
        for (int kk = 0; kk < 16; ++kk) acc = __builtin_amdgcn_mfma_f32_32x32x2f32(ap[(15 - kk) * 2], bp[2 * kk * LDZ], acc, 0, 0, 0);
        ap += 32; bp -= 1; }
    }
    if (dh) {
#pragma unroll
      for (int r = 0; r < 16; ++r) RED[(g * 64 + lane) * 16 + r] = acc[r]; }
    __syncthreads();
    if (!dh) { const float inv = 1.f / nrm[o * 512 + c], sk = skip[o * 512 + c]; const LAS float* G = o == 0 ? X1 : X2; LAS float* Out = o == 0 ? ZB : ZA;
#pragma unroll
      for (int r = 0; r < 16; ++r) { const int t2 = (r & 3) + 8 * (r >> 2) + 4 * lk, t1 = 32 * g + li;
        const float cv = (acc[r] + RED[(g * 64 + lane) * 16 + r]) * inv; const float zin = Zin[t2 * LDZ + t1 + ZPAD];
        Out[t2 * LDZ + t1 + ZPAD] = G[t2 * LDX + t1] * (cv + sk * zin); } }
    __syncthreads();
  }
  for (int t = tid; t < S; t += 512) yT[(size_t)c * S + t] = (bf16_t)f2bf(ZA[(t & 31) * LDZ + (t >> 5) + ZPAD]);
  __syncthreads();
}

typedef short bf16x8v __attribute__((ext_vector_type(8)));
typedef unsigned u32x2v __attribute__((ext_vector_type(2)));
constexpr int CSB = 16448;
constexpr int ZROW = 80, ZROWS = 190;
constexpr int B_CS = 0, B_ZA = 4 * CSB, B_ZB = B_ZA + 15232, B_X1 = B_ZB + 15232, B_X2 = B_X1 + 8256, B_RED = B_X2 + 8256, B_END = B_RED + 16384;
static_assert(B_END <= 131072 && B_ZA % 16 == 0 && B_X1 % 16 == 0, "hyena bf16 lds");
__device__ __forceinline__ void h1b_unit(const bf16_t* ucT, const bf16_t* tapsB, const float* nrm, const float* skip, bf16_t* yT, int c, LAS unsigned char* lds) {
  int tid = threadIdx.x; asm volatile("" : "+v"(tid));
  const int lane = tid & 63, w = __builtin_amdgcn_readfirstlane(tid >> 6), li = lane & 31, lk = lane >> 5;
  LAS bf16_t* ZA = (LAS bf16_t*)(lds + B_ZA); LAS bf16_t* ZB = (LAS bf16_t*)(lds + B_ZB); LAS bf16_t* X1 = (LAS bf16_t*)(lds + B_X1); LAS bf16_t* X2 = (LAS bf16_t*)(lds + B_X2);
  LAS float* RED = (LAS float*)(lds + B_RED);
  for (int e = tid; e < 62 * 20; e += 512) { const int p = e / 20, d = e % 20, row = p < 31 ? p : 128 + p; ((LAS unsigned*)ZA)[row * 20 + d] = 0u; ((LAS unsigned*)ZB)[row * 20 + d] = 0u; }
  { const v4u zv = *(const v4u*)(ucT + (size_t)(1024 + c) * S + tid * 8); const int t = tid * 8; *(LAS v4u*)((LAS unsigned char*)ZA + ((t >> 5) + ZPAD) * ZROW + (t & 31) * 2) = zv; }
  { const v4u xa = *(const v4u*)(ucT + (size_t)c * S + tid * 8), xb = *(const v4u*)(ucT + (size_t)(512 + c) * S + tid * 8); const int t1 = tid >> 2, t2b = (tid & 3) * 8;
    const unsigned wa[4] = {xa.x, xa.y, xa.z, xa.w}, wb[4] = {xb.x, xb.y, xb.z, xb.w};
#pragma unroll
    for (int k = 0; k < 4; ++k) { X1[(t2b + 2 * k) * LDX + t1] = (bf16_t)(wa[k] & 0xffff); X1[(t2b + 2 * k + 1) * LDX + t1] = (bf16_t)(wa[k] >> 16);
      X2[(t2b + 2 * k) * LDX + t1] = (bf16_t)(wb[k] & 0xffff); X2[(t2b + 2 * k + 1) * LDX + t1] = (bf16_t)(wb[k] >> 16); } }
  typedef unsigned u4a __attribute__((ext_vector_type(4), aligned(4))); typedef const __attribute__((address_space(1))) u4a* gp4;
  v4u cv[9];
#pragma unroll 1
  for (int o = 0; o < 2; ++o) {
#define HTAPS_LOAD(oo) { const __attribute__((address_space(1))) unsigned char* tb = (const __attribute__((address_space(1))) unsigned char*)(tapsB + ((size_t)(oo) * 512 + c) * 2 * 8232); \
      _Pragma("unroll") for (int it = 0; it < 9; ++it) { const int e = tid + 512 * it; const int s = e / 1028, q = e % 1028; cv[it] = (v4u){0u, 0u, 0u, 0u}; if (e < 4 * 1028) cv[it] = *(gp4)(tb + (size_t)(s & 1) * 16464 + 16 * q + 4 * (s >> 1)); } }
    if (o == 0) HTAPS_LOAD(0)
    {
#pragma unroll
      for (int it = 0; it < 9; ++it) { const int e = tid + 512 * it; const int s = e / 1028, q = e % 1028; if (e < 4 * 1028) *(LAS v4u*)(lds + B_CS + s * CSB + 16 * q) = cv[it]; } }
    __syncthreads();
    if (o == 0) HTAPS_LOAD(1)
    const LAS bf16_t* Zin = o == 0 ? ZA : ZB;
    const int g = w & 3, dh = w >> 2;
    const int Dlo = 32 * g - 127 + (dh ? 81 : 0), Dn = dh ? 78 : 81;
    f32x16 acc = {};
    { const int s = (4 - (li & 3)) & 3;
      const LAS unsigned char* ap = lds + B_CS + s * CSB + 2 * (4096 - 32 * Dlo - li + 8 * lk - s);
      const LAS unsigned char* bp = (const LAS unsigned char*)Zin + (32 * g + li - Dlo + ZPAD) * ZROW + 16 * lk;
#define HLD(A0, A1, B0, B1) { const u32x2v p0_ = *(const LAS u32x2v*)(ap), p1_ = *(const LAS u32x2v*)(ap2), p2_ = *(const LAS u32x2v*)(ap3), p3_ = *(const LAS u32x2v*)(ap4); \
        A0 = (v4u){p0_.x, p0_.y, p1_.x, p1_.y}; A1 = (v4u){p2_.x, p2_.y, p3_.x, p3_.y}; B0 = *(const LAS v4u*)(bp); B1 = *(const LAS v4u*)(bp + 32); ap -= 64; ap2 -= 64; ap3 -= 64; ap4 -= 64; bp -= ZROW; }
#define HMM(A, B) acc = __builtin_amdgcn_mfma_f32_32x32x16_bf16(__builtin_bit_cast(bf16x8v, A), __builtin_bit_cast(bf16x8v, B), acc, 0, 0, 0)
#define HOPQ(name, off) unsigned name##i = (unsigned)(unsigned long long)(ap + (off)); asm volatile("" : "+v"(name##i)); const LAS unsigned char* name = (const LAS unsigned char*)(unsigned long long)name##i;
      HOPQ(ap2, 8) HOPQ(ap3, 32) HOPQ(ap4, 40)
#undef HOPQ
      v4u fa0, fa1, fb0, fb1, ga0, ga1, gb0, gb1, ha0, ha1, hb0, hb1;
      HLD(fa0, fa1, fb0, fb1)
      HLD(ga0, ga1, gb0, gb1)
      for (int dd_ = 0; dd_ < Dn - 3; dd_ += 3) {
        HLD(ha0, ha1, hb0, hb1)
        HMM(fa0, fb0); HMM(fa1, fb1);
        HLD(fa0, fa1, fb0, fb1)
        HMM(ga0, gb0); HMM(ga1, gb1);
        HLD(ga0, ga1, gb0, gb1)
        HMM(ha0, hb0); HMM(ha1, hb1);
      }
      HLD(ha0, ha1, hb0, hb1)
      HMM(fa0, fb0); HMM(fa1, fb1); HMM(ga0, gb0); HMM(ga1, gb1); HMM(ha0, hb0); HMM(ha1, hb1);
#undef HLD
#undef HMM
    }
    if (dh) {
#pragma unroll
      for (int r = 0; r < 16; ++r) RED[(g * 64 + lane) * 16 + r] = acc[r]; }
    __syncthreads();
    if (!dh) { const float inv = 1.f / nrm[o * 512 + c], sk = skip[o * 512 + c]; const LAS bf16_t* G = o == 0 ? X1 : X2; LAS bf16_t* Out = o == 0 ? ZB : ZA;
#pragma unroll
      for (int r = 0; r < 16; ++r) { const int t2 = (r & 3) + 8 * (r >> 2) + 4 * lk, t1 = 32 * g + li;
        const float cv = (acc[r] + RED[(g * 64 + lane) * 16 + r]) * inv; const float zin = bf2f(Zin[(t1 + ZPAD) * (ZROW / 2) + t2]);
        Out[(t1 + ZPAD) * (ZROW / 2) + t2] = (bf16_t)f2bf(bf2f(G[t2 * LDX + t1]) * (cv + sk * zin)); } }
    __syncthreads();
  }
  { const int t = tid * 8; *(v4u*)(yT + (size_t)c * S + t) = *(const LAS v4u*)((const LAS unsigned char*)ZA + ((t >> 5) + ZPAD) * ZROW + (t & 31) * 2); }
  __syncthreads();
}
#undef HTAPS_LOAD

constexpr int C_ZP = 15, C_ZB = 159 * ZROW  , C_CS = 0, C_Z0 = 4 * CSB, C_X0 = C_Z0 + 2 * C_ZB, C_END = C_X0 + 4 * 8256;
static_assert(C_END <= 131072 && C_Z0 % 16 == 0 && C_ZB % 16 == 0 && C_X0 % 16 == 0, "hyena two-batch lds");
__device__ __forceinline__ void h1c_unit(const bf16_t* ucT2, const bf16_t* tapsB, const float* nrm, const float* skip, bf16_t* yT2, int c, LAS unsigned char* lds) {
  int tid = threadIdx.x; asm volatile("" : "+v"(tid));
  const int lane = tid & 63, g = __builtin_amdgcn_readfirstlane(tid >> 6), li = lane & 31, lk = lane >> 5, bsel = li >> 4, t1l = li & 15;
  for (int e = tid; e < 2 * 31 * 20; e += 512) { const int b = e / (31 * 20), p = (e / 20) % 31, d = e % 20, row = p < 15 ? p : 128 + p; ((LAS unsigned*)(lds + C_Z0 + b * C_ZB))[row * 20 + d] = 0u; }
#pragma unroll
  for (int b = 0; b < 2; ++b) { const bf16_t* uc = ucT2 + (size_t)b * 1536 * S; const int t = tid * 8;
    const v4u zv = *(const v4u*)(uc + (size_t)(1024 + c) * S + t), xa = *(const v4u*)(uc + (size_t)c * S + t), xb = *(const v4u*)(uc + (size_t)(512 + c) * S + t);
    *(LAS v4u*)(lds + C_Z0 + b * C_ZB + ((t >> 5) + C_ZP) * ZROW + (t & 31) * 2) = zv;
    LAS bf16_t* X1 = (LAS bf16_t*)(lds + C_X0 + (2 * b) * 8256); LAS bf16_t* X2 = (LAS bf16_t*)(lds + C_X0 + (2 * b + 1) * 8256); const int t1 = tid >> 2, t2b = (tid & 3) * 8;
    const unsigned wa[4] = {xa.x, xa.y, xa.z, xa.w}, wb[4] = {xb.x, xb.y, xb.z, xb.w};
#pragma unroll
    for (int k = 0; k < 4; ++k) { X1[(t2b + 2 * k) * LDX + t1] = (bf16_t)(wa[k] & 0xffff); X1[(t2b + 2 * k + 1) * LDX + t1] = (bf16_t)(wa[k] >> 16);
      X2[(t2b + 2 * k) * LDX + t1] = (bf16_t)(wb[k] & 0xffff); X2[(t2b + 2 * k + 1) * LDX + t1] = (bf16_t)(wb[k] >> 16); } }
  typedef unsigned u4a __attribute__((ext_vector_type(4), aligned(4))); typedef const __attribute__((address_space(1))) u4a* gp4;
  v4u cv[9];
  LAS bf16_t* Zm = (LAS bf16_t*)(lds + C_Z0 + bsel * C_ZB);
#pragma unroll 1
  for (int o = 0; o < 2; ++o) {
#define HTAPS_LOAD(oo) { const __attribute__((address_space(1))) unsigned char* tb = (const __attribute__((address_space(1))) unsigned char*)(tapsB + ((size_t)(oo) * 512 + c) * 2 * 8232); \
      _Pragma("unroll") for (int it = 0; it < 9; ++it) { const int e = tid + 512 * it; const int s = e / 1028, q = e % 1028; cv[it] = (v4u){0u, 0u, 0u, 0u}; if (e < 4 * 1028) cv[it] = *(gp4)(tb + (size_t)(s & 1) * 16464 + 16 * q + 4 * (s >> 1)); } }
    if (o == 0) HTAPS_LOAD(0)
    {
#pragma unroll
      for (int it = 0; it < 9; ++it) { const int e = tid + 512 * it; const int s = e / 1028, q = e % 1028; if (e < 4 * 1028) *(LAS v4u*)(lds + C_CS + s * CSB + 16 * q) = cv[it]; } }
    __syncthreads();
    if (o == 0) HTAPS_LOAD(1)
    const int Dlo = 16 * g - 128; constexpr int Dn = 144;
    f32x16 acc = {};
    { const int s = (4 - (li & 3)) & 3;
      const LAS unsigned char* ap = lds + C_CS + s * CSB + 2 * (4096 - 32 * Dlo - li + 8 * lk - s);
      const LAS unsigned char* bp = (const LAS unsigned char*)Zm + (16 * g + t1l - Dlo + C_ZP) * ZROW + 16 * lk;
#define HLD(A0, A1, B0, B1) { const u32x2v p0_ = *(const LAS u32x2v*)(ap), p1_ = *(const LAS u32x2v*)(ap2), p2_ = *(const LAS u32x2v*)(ap3), p3_ = *(const LAS u32x2v*)(ap4); \
        A0 = (v4u){p0_.x, p0_.y, p1_.x, p1_.y}; A1 = (v4u){p2_.x, p2_.y, p3_.x, p3_.y}; B0 = *(const LAS v4u*)(bp); B1 = *(const LAS v4u*)(bp + 32); ap -= 64; ap2 -= 64; ap3 -= 64; ap4 -= 64; bp -= ZROW; }
#define HMM(A, B) acc = __builtin_amdgcn_mfma_f32_32x32x16_bf16(__builtin_bit_cast(bf16x8v, A), __builtin_bit_cast(bf16x8v, B), acc, 0, 0, 0)
#define HOPQ(name, off) unsigned name##i = (unsigned)(unsigned long long)(ap + (off)); asm volatile("" : "+v"(name##i)); const LAS unsigned char* name = (const LAS unsigned char*)(unsigned long long)name##i;
      HOPQ(ap2, 8) HOPQ(ap3, 32) HOPQ(ap4, 40)
#undef HOPQ
      v4u fa0, fa1, fb0, fb1, ga0, ga1, gb0, gb1, ha0, ha1, hb0, hb1;
      HLD(fa0, fa1, fb0, fb1)
      HLD(ga0, ga1, gb0, gb1)
      for (int dd_ = 0; dd_ < Dn - 3; dd_ += 3) {
        HLD(ha0, ha1, hb0, hb1)
        HMM(fa0, fb0); HMM(fa1, fb1);
        HLD(fa0, fa1, fb0, fb1)
        HMM(ga0, gb0); HMM(ga1, gb1);
        HLD(ga0, ga1, gb0, gb1)
        HMM(ha0, hb0); HMM(ha1, hb1);
      }
      HLD(ha0, ha1, hb0, hb1)
      HMM(fa0, fb0); HMM(fa1, fb1); HMM(ga0, gb0); HMM(ga1, gb1); HMM(ha0, hb0); HMM(ha1, hb1);
#undef HLD
#undef HMM
    }
    __syncthreads();
    { const float inv = 1.f / nrm[o * 512 + c], sk = skip[o * 512 + c]; const LAS bf16_t* G = (const LAS bf16_t*)(lds + C_X0 + (2 * bsel + o) * 8256);
#pragma unroll
      for (int r = 0; r < 16; ++r) { const int t2 = (r & 3) + 8 * (r >> 2) + 4 * lk, t1 = 16 * g + t1l;
        const float cvv = acc[r] * inv; const float zin = bf2f(Zm[(t1 + C_ZP) * (ZROW / 2) + t2]);
        Zm[(t1 + C_ZP) * (ZROW / 2) + t2] = (bf16_t)f2bf(bf2f(G[t2 * LDX + t1]) * (cvv + sk * zin)); } }
    __syncthreads();
  }
#pragma unroll
  for (int b = 0; b < 2; ++b) { const int t = tid * 8; *(v4u*)(yT2 + (size_t)b * 512 * S + (size_t)c * S + t) = *(const LAS v4u*)(lds + C_Z0 + b * C_ZB + ((t >> 5) + C_ZP) * ZROW + (t & 31) * 2); }
  __syncthreads();
#undef HTAPS_LOAD
}
__device__ __forceinline__ void cconv3_item(const bf16_t* u, int ld, const float* cw, const float* cb, float* ucc, long idx) {
  const int j = (int)(idx % 1536); const int tc = (int)(idx / 1536);
  const bf16_t* up = u + (size_t)tc * ld + j;
  float v = cb[j] + cw[1536 + j] * bf2f(up[0]);
  if (tc > 0) v += cw[j] * bf2f(*(up - ld)); if (tc < 255) v += cw[2 * 1536 + j] * bf2f(up[ld]);
  ucc[idx] = v;
}
__device__ __forceinline__ void clong_item(const float* ucc, const float* z1c_in, float* z1c_out, bf16_t* yout, int ldy, const float* tapsC, const float* nrmC, const float* skip, int o, long idx) {
  const int c = (int)(idx % 512), t0 = (int)(idx / 512) * 8; constexpr int n = 256;
  const float* tp = tapsC + (size_t)o * 2 * n * 512 + c; const float nr = nrmC[o * 512 + c];
  const float* zs = o == 0 ? ucc + 1024 + c : z1c_in + c; const int ldz = o == 0 ? 1536 : 512;
  float acc[8], w[8];
#pragma unroll
  for (int i = 0; i < 8; ++i) { acc[i] = 0.f; const int lag = t0 + i; w[i] = tp[(size_t)lag * 512]; }
#pragma unroll 4
  for (int s = 0; s < n; ++s) { const float zv = zs[(size_t)s * ldz];
#pragma unroll
    for (int i = 0; i < 8; ++i) acc[i] += w[i] * zv;
    const int lag = t0 - s - 1;
    const float nw = tp[(size_t)(lag >= 0 ? lag : 2 * n + lag) * 512];
#pragma unroll
    for (int i = 7; i > 0; --i) w[i] = w[i - 1];
    w[0] = nw; }
  const float sk = skip[o * 512 + c];
#pragma unroll
  for (int i = 0; i < 8; ++i) { const int t = t0 + i; const float val = ucc[(size_t)t * 1536 + o * 512 + c] * (acc[i] / nr + sk * zs[(size_t)t * ldz]);
    if (o == 0) z1c_out[(size_t)t * 512 + c] = val; else yout[(size_t)t * ldy + c] = (bf16_t)f2bf(val); }
}
}
#define XB_TMO      128
#define XB_XCNT(j)  (256  + 64 * (j))
#define XB_XSUB(j)  (1280 + 64 * (j))
#define XB_XGEN(j)  (2304 + 64 * (j))
#define XB_TOP      3328
#define XB_TOPGEN   3392
#define XCD_BAR_WORDS 3456
#define XB_SPIN_CAP (1u << 18)

__device__ __forceinline__ unsigned xb_ld(unsigned* p)              { return __hip_atomic_load(p, __ATOMIC_RELAXED, __HIP_MEMORY_SCOPE_AGENT); }
__device__ __forceinline__ unsigned xb_add(unsigned* p, unsigned v) { return __hip_atomic_fetch_add(p, v, __ATOMIC_RELAXED, __HIP_MEMORY_SCOPE_AGENT); }
__device__ __forceinline__ unsigned xb_xcc_id() { return (unsigned)__builtin_amdgcn_s_getreg((3 << 11) | 20) & 0xFu; }
#define XB_SPIN(cond, bar) do { unsigned _sp = 0; while (cond) { __builtin_amdgcn_s_sleep(1); \
    if ((++_sp & 255u) == 0u) { if (xb_ld(&(bar)[XB_TMO])) break; if (_sp > XB_SPIN_CAP) { atomicAdd(&(bar)[XB_TMO], 1u); break; } } } } while (0)

struct XcdBarrier {
    unsigned* bar; unsigned x;
    volatile LAS unsigned* st;
};

__device__ __forceinline__ XcdBarrier xcd_barrier_post(unsigned* bar, volatile LAS unsigned* st) {
    XcdBarrier b; b.bar = bar; b.x = xb_xcc_id(); b.st = st;
    if (threadIdx.x == 0) (void)xb_add(&bar[XB_XCNT(b.x)], 1u);
    return b;
}
__device__ __forceinline__ void xcd_barrier_complete(unsigned* bar, unsigned x, unsigned& nloc, unsigned& nx) {
    const unsigned G = gridDim.x * gridDim.y * gridDim.z;
    unsigned sum, cnt, mine, sp = 0u;
    for (;;) {
        sum = 0u; cnt = 0u; mine = 0u;
#pragma unroll
        for (unsigned j = 0; j < 16; ++j) { const unsigned c = xb_ld(&bar[XB_XCNT(j)]); sum += c; cnt += (c > 0u) ? 1u : 0u; mine = (j == x) ? c : mine; }
        if (sum == G) break;
        __builtin_amdgcn_s_sleep(1);
        if ((++sp & 255u) == 0u) { if (xb_ld(&bar[XB_TMO])) break; if (sp > XB_SPIN_CAP) { atomicAdd(&bar[XB_TMO], 1u); break; } }
    }
    nloc = mine > 0u ? mine : 1u; nx = cnt > 0u ? cnt : 1u;
}

__device__ __forceinline__ void xcd_barrier(const XcdBarrier& b) {
    asm volatile("s_waitcnt vmcnt(0)" ::: "memory");
    __syncthreads();
    if (threadIdx.x == 0) {
        unsigned* bar = b.bar;
#define XB_SP(word) ((unsigned*)((((unsigned long long)(unsigned)__builtin_amdgcn_readfirstlane((int)((unsigned long long)(bar + (word)) >> 32))) << 32) | (unsigned)__builtin_amdgcn_readfirstlane((int)(unsigned)(unsigned long long)(bar + (word)))))
        unsigned* const p_xsub = XB_SP(XB_XSUB(b.x)); unsigned* const p_xgen = XB_SP(XB_XGEN(b.x));
        __builtin_amdgcn_s_waitcnt(0);
        unsigned nloc = b.st[0], nx = b.st[1];
        if (nloc == 0u) { xcd_barrier_complete(bar, b.x, nloc, nx); b.st[0] = nloc; b.st[1] = nx; }
        const unsigned old = xb_add(p_xsub, 1u);
        const unsigned gen = old / nloc;
        if (old + 1u == (gen + 1u) * nloc) {
            __builtin_amdgcn_fence(__ATOMIC_RELEASE, "agent");
            asm volatile("s_waitcnt vmcnt(0)" ::: "memory");
            const unsigned og = xb_add(&bar[XB_TOP], 1u);
            const unsigned tg = og / nx;
            if (og + 1u == (tg + 1u) * nx) xb_add(&bar[XB_TOPGEN], 1u);
            else XB_SPIN(xb_ld(&bar[XB_TOPGEN]) == tg, bar);
            __builtin_amdgcn_fence(__ATOMIC_ACQUIRE, "agent");
            xb_add(p_xgen, 1u);
            asm volatile("s_waitcnt vmcnt(0)" ::: "memory");
        } else {
            XB_SPIN(xb_ld(p_xgen) == gen, bar);
            __builtin_amdgcn_fence(__ATOMIC_ACQUIRE, "agent");
            asm volatile("s_waitcnt vmcnt(0)" ::: "memory");
        }
    }
    __syncthreads();
}
#include <math.h>
#ifdef HOST_TEST
#define HD
#define FEXP expf
#define FSIN sinf
#define FCOS cosf
#define FLOG logf
#define FPOW powf
#else
#define HD __device__ __forceinline__
#define FEXP __expf
#define FSIN __sinf
#define FCOS __cosf
#define FLOG __logf
#define FPOW __powf
#endif

struct FullDims { static constexpr int D=1024,B=8,S=4096,DEPTH=2,C=256,GW=64,AH=8,AKV=2,HDM=128,GH=4,GDK=64,GDV=128,GR=16,HW=512,HB=16,HF=64,NE=16,NG=4,DE=512; };
struct SmallDims { static constexpr int D=64,B=2,S=128,DEPTH=2,C=32,GW=16,AH=4,AKV=2,HDM=16,GH=2,GDK=8,GDV=16,GR=4,HW=32,HB=4,HF=8,NE=8,NG=2,DE=32; };

template <class T> struct DD {
  static constexpr int D=T::D,B=T::B,S=T::S,DEPTH=T::DEPTH,C=T::C,GW=T::GW,AH=T::AH,AKV=T::AKV,HDM=T::HDM,GH=T::GH,GDK=T::GDK,GDV=T::GDV,GR=T::GR,HW=T::HW,HB=T::HB,HF=T::HF,NE=T::NE,NG=T::NG,DE=T::DE;
  static constexpr int R=S+C, AG=AH/AKV, RP=HDM/4, HE=1+2*HB, EPG=NE/NG, AQW=AH*HDM, AKVW=AKV*HDM, GKW=GH*GDK, GVW=GH*GDV;
  static constexpr int NKV=AKVW+AKVW+GKW+GVW+2*GR, NIN=NKV+AQW+GKW+GVW+3*HW+3*D;
  static constexpr int O_AK=0, O_AV=AKVW, O_GK=2*AKVW, O_GV=2*AKVW+GKW, O_GA=2*AKVW+GKW+GVW;
  static constexpr int O_AQ=NKV, O_GQ=NKV+AQW, O_OG=O_GQ+GKW, O_HY=O_OG+GVW, O_BR=O_HY+3*HW;
};

struct NaiveBufs {
  const float *x,*c,*ctx,*c_ctx,*w_mod,*b_mod,*norm1_g,*norm2_g,*w_in,*q_norm_g,*k_norm_g,*gla_wa2,*gla_ba,*gla_norm_g,*hy_conv_w,*hy_conv_b,
    *hy_pos_w1,*hy_pos_b1,*hy_sin_freq,*hy_pos_w2,*hy_pos_b2,*hy_pos_w3,*hy_decay,*hy_skip,*w_br_hy,*w_br_gla,*w_br_att,*w_out,*router_w,*router_b,*moe_w_gate,*moe_w_up,*moe_w_down;
  float* out;
  float *mod;
  float *hid2S,*hid2C;
  float *tapsS,*tapsC;
  float *nrmS,*nrmC;
  float *rs;
  float *h;
  float *proj;
  float *qn,*kn;
  float *yatt;
  float *laf,*lab;
  float *of,*ob;
  float *ygla;
  float *uc;
  float *z1,*yhy;
  float *m;
  int   *ridx;
  float *rw;
  float *hid;
  float *xc;
};

HD float sigmoidf_(float x) { return 1.f / (1.f + FEXP(-x)); }
HD float siluf_(float x) { return x / (1.f + FEXP(-x)); }
HD float logsigmoidf_(float x) { return x < 0.f ? x - FLOG(1.f + FEXP(x)) : -FLOG(1.f + FEXP(-x)); }

template <class T> HD void st_mod(const NaiveBufs& a, int l, long idx) {
  using d = DD<T>; const int j = (int)(idx % (6 * d::D)), bb = (int)(idx / (6 * d::D));
  const float* cv = bb < d::B ? a.c + (long)bb * d::D : a.c_ctx; const float* w = a.w_mod + (long)l * d::D * 6 * d::D;
  float acc = a.b_mod[(long)l * 6 * d::D + j];
  for (int k = 0; k < d::D; ++k) acc += siluf_(cv[k]) * w[(long)k * 6 * d::D + j];
  a.mod[idx] = acc;
}
template <class T> HD void st_hyhid(const NaiveBufs& a, int l, int which, long idx) {
  using d = DD<T>; const int n = which ? d::C : d::S; float* dst = which ? a.hid2C : a.hid2S;
  const int j = (int)(idx % d::HF), t = (int)(idx / d::HF);
  const float* w1 = a.hy_pos_w1 + (long)l * d::HE * d::HF; const float* b1 = a.hy_pos_b1 + l * d::HF; const float* fr = a.hy_sin_freq + l * d::HF;
  const float* w2 = a.hy_pos_w2 + (long)l * d::HF * d::HF; const float* b2 = a.hy_pos_b2 + l * d::HF;
  const float tn = (float)t / (float)n; const float w0 = 2.f * 3.14159265358979323846f / (float)n;
  float acc2 = b2[j];
  for (int i = 0; i < d::HF; ++i) {
    float acc = b1[i] + tn * w1[0 * d::HF + i];
    for (int bnd = 0; bnd < d::HB; ++bnd) {
      const float band = 1e-4f + (float)bnd * ((float)(d::HB - 1) - 1e-4f) / (float)(d::HB - 1);
      const float ph = w0 * (float)t * band;
      acc += FCOS(ph) * w1[(1 + bnd) * d::HF + i] - FSIN(ph) * w1[(1 + d::HB + bnd) * d::HF + i];
    }
    acc2 += FSIN(fr[i] * acc) * w2[i * d::HF + j];
  }
  dst[idx] = FSIN(fr[j] * acc2);
}
template <class T> HD void st_hytaps(const NaiveBufs& a, int l, int which, long idx) {
  using d = DD<T>; const int n = which ? d::C : d::S; const float* hid2 = which ? a.hid2C : a.hid2S; float* dst = which ? a.tapsC : a.tapsS;
  const int c = (int)(idx % d::HW); const int li = (int)((idx / d::HW) % (2 * n)); const int o = (int)(idx / ((long)d::HW * 2 * n));
  float v = 0.f;
  if (li != n) {
    const int dir = li < n ? 0 : 1; const int t = li < n ? li : 2 * n - li;
    const int col = (o * 2 + dir) * d::HW + c;
    const float* w3 = a.hy_pos_w3 + (long)l * d::HF * 4 * d::HW;
    float acc = 0.f;
    for (int j = 0; j < d::HF; ++j) acc += hid2[(long)t * d::HF + j] * w3[(long)j * 4 * d::HW + col];
    const float dec = fabsf(a.hy_decay[(long)l * 4 * d::HW + col]);
    v = acc * FEXP(-((float)t / (float)n) * dec);
  }
  if (which == 0) dst[((long)o * d::HW + c) * 2 * n + li] = v; else dst[idx] = v;
}
template <class T> HD void st_hynorm(const NaiveBufs& a, int which, long idx) {
  using d = DD<T>; const int n = which ? d::C : d::S; const float* tp = which ? a.tapsC : a.tapsS; float* dst = which ? a.nrmC : a.nrmS;
  const int c = (int)(idx % d::HW), o = (int)(idx / d::HW);
  float s = 0.f; for (int li = 0; li < 2 * n; ++li) s += fabsf(which == 0 ? tp[((long)o * d::HW + c) * 2 * n + li] : tp[((long)o * 2 * n + li) * d::HW + c]);
  dst[idx] = s + 1e-6f;
}

template <class T> HD const float* xrow(const NaiveBufs& a, int l, int b, int r) {
  using d = DD<T>;
  if (r < d::S) return (l == 0 ? a.x : a.out) + ((long)b * d::S + r) * d::D;
  return (l == 0 ? a.ctx : a.xc) + ((long)b * d::C + (r - d::S)) * d::D;
}
template <class T> HD float* xrow_w(const NaiveBufs& a, int b, int r) {
  using d = DD<T>;
  if (r < d::S) return a.out + ((long)b * d::S + r) * d::D;
  return a.xc + ((long)b * d::C + (r - d::S)) * d::D;
}
template <class T> HD void st_rs(const NaiveBufs& a, int l, int b, int src, long idx) {
  using d = DD<T>; const int r = (int)idx; const float* xr = src ? (const float*)xrow_w<T>(a, b, r) : xrow<T>(a, l, b, r);
  float s = 0.f; for (int k = 0; k < d::D; ++k) s += xr[k] * xr[k];
  a.rs[r] = 1.f / sqrtf(s / (float)d::D + 1e-6f);
}
template <class T> HD void st_norm(const NaiveBufs& a, int l, int b, int which, long idx) {
  using d = DD<T>; const int j = (int)(idx % d::D), r = (int)(idx / d::D);
  const float* xr = which ? (const float*)xrow_w<T>(a, b, r) : xrow<T>(a, l, b, r);
  const float* g = (which ? a.norm2_g : a.norm1_g) + (long)l * d::D;
  const float* md = a.mod + (long)(r < d::S ? b : d::B) * 6 * d::D;
  const float shift = md[(which ? 3 : 0) * d::D + j], scale = md[(which ? 4 : 1) * d::D + j];
  a.h[idx] = xr[j] * a.rs[r] * g[j] * (1.f + scale) + shift;
}
struct GemmArgs { const float* A; int lda; const float* W; int ldw; float* Cc; int ldc; int M, N, K;
  const float* gate; int ldg;
  const float* colscale;
  const float* res; int ldr;
  int accumulate; };
HD void st_gemm(const GemmArgs& g, long idx) {
  const int nb = g.N / 4; const int cb = (int)(idx % nb), rb = (int)(idx / nb);
  float acc[4][4];
#pragma unroll
  for (int i = 0; i < 4; ++i) {
#pragma unroll
    for (int j = 0; j < 4; ++j) acc[i][j] = 0.f; }
  const float* a0 = g.A + (long)(rb * 4) * g.lda; const float* w0 = g.W + cb * 4;
  for (int k = 0; k < g.K; ++k) {
    float av[4], wv[4];
#pragma unroll
    for (int i = 0; i < 4; ++i) av[i] = a0[(long)i * g.lda + k];
#pragma unroll
    for (int j = 0; j < 4; ++j) wv[j] = w0[(long)k * g.ldw + j];
#pragma unroll
    for (int i = 0; i < 4; ++i) {
#pragma unroll
      for (int j = 0; j < 4; ++j) acc[i][j] += av[i] * wv[j]; }
  }
#pragma unroll
  for (int i = 0; i < 4; ++i)
#pragma unroll
  for (int j = 0; j < 4; ++j) {
    const int r = rb * 4 + i, c = cb * 4 + j; float v = acc[i][j];
    if (g.gate) v *= sigmoidf_(g.gate[(long)r * g.ldg + c]);
    if (g.colscale) v *= g.colscale[c];
    if (g.res) v += g.res[(long)r * g.ldr + c];
    float* p = g.Cc + (long)r * g.ldc + c;
    if (g.accumulate) v += *p;
    *p = v;
  }
}
template <class T> HD void st_qknorm(const NaiveBufs& a, int l, long idx) {
  using d = DD<T>; const int hh = (int)(idx % (d::AH + d::AKV)), r = (int)(idx / (d::AH + d::AKV));
  const bool isq = hh < d::AH; const int hd = isq ? hh : hh - d::AH;
  const float* src = a.proj + (long)r * d::NIN + (isq ? d::O_AQ : d::O_AK) + hd * d::HDM;
  float* dst = (isq ? a.qn + (long)r * d::AQW : a.kn + (long)r * d::AKVW) + hd * d::HDM;
  const float* g = (isq ? a.q_norm_g : a.k_norm_g) + (long)l * d::HDM;
  float s = 0.f; for (int k = 0; k < d::HDM; ++k) s += src[k] * src[k];
  const float rsq = 1.f / sqrtf(s / (float)d::HDM + 1e-6f);
  if (r < d::S) {
    const int row = r / d::GW, col = r % d::GW;
    for (int p = 0; p < d::HDM / 2; ++p) {
      const int fi = p < d::RP ? p : p - d::RP; const float pos = p < d::RP ? (float)row : (float)col;
      const float inv = FPOW(10000.f, -(float)fi / (float)d::RP); const float ang = pos * inv;
      const float cs = FCOS(ang), sn = FSIN(ang);
      const float x1 = src[2 * p] * rsq * g[2 * p], x2 = src[2 * p + 1] * rsq * g[2 * p + 1];
      dst[2 * p] = x1 * cs - x2 * sn; dst[2 * p + 1] = x1 * sn + x2 * cs;
    }
  } else { for (int k = 0; k < d::HDM; ++k) dst[k] = src[k] * rsq * g[k]; }
}
template <class T, int NSPLIT> HD void st_attn(const NaiveBufs& a, int r0, int nrows, long idx) {
  using d = DD<T>; constexpr int OD = d::HDM / NSPLIT;
  const int r = r0 + (int)(idx % nrows); const int hs = (int)(idx / nrows); const int part = hs % NSPLIT, hq = hs / NSPLIT; const int kv = hq / d::AG;
  const int k0 = r < d::S ? 0 : d::S, k1 = d::R;
  float q[d::HDM], o[OD];
  const float scale = 1.f / sqrtf((float)d::HDM);
#pragma unroll
  for (int k = 0; k < d::HDM; ++k) q[k] = a.qn[(long)r * d::AQW + hq * d::HDM + k] * scale;
#pragma unroll
  for (int k = 0; k < OD; ++k) o[k] = 0.f;
  float mx = -1e30f, lsum = 0.f;
  for (int kk = k0; kk < k1; ++kk) {
    const float* kr = a.kn + (long)kk * d::AKVW + kv * d::HDM;
    float s = 0.f;
#pragma unroll
    for (int k = 0; k < d::HDM; ++k) s += q[k] * kr[k];
    if (s > mx) { const float cr = FEXP(mx - s); lsum *= cr;
#pragma unroll
      for (int k = 0; k < OD; ++k) o[k] *= cr;
      mx = s; }
    const float p = FEXP(s - mx); lsum += p;
    const float* vr = a.proj + (long)kk * d::NIN + d::O_AV + kv * d::HDM + part * OD;
#pragma unroll
    for (int k = 0; k < OD; ++k) o[k] += p * vr[k];
  }
  const float inv = 1.f / lsum;
#pragma unroll
  for (int k = 0; k < OD; ++k) a.yatt[(long)r * d::AQW + hq * d::HDM + part * OD + k] = o[k] * inv;
}
template <class T> HD void st_glala(const NaiveBufs& a, int l, long idx) {
  using d = DD<T>; const int j = (int)(idx % d::GKW); const int dir = (int)((idx / d::GKW) % 2); const int r = (int)(idx / (2 * d::GKW));
  const float* al = a.proj + (long)r * d::NIN + d::O_GA + dir * d::GR;
  const float* w2 = a.gla_wa2 + ((long)l * 2 + dir) * d::GR * d::GKW; float z = a.gla_ba[((long)l * 2 + dir) * d::GKW + j];
  for (int k = 0; k < d::GR; ++k) z += al[k] * w2[(long)k * d::GKW + j];
  (dir ? a.lab : a.laf)[(long)r * d::GKW + j] = FEXP(logsigmoidf_(z) / 16.f);
}
template <class T> HD void st_glascan(const NaiveBufs& a, long idx) {
  using d = DD<T>; const int v = (int)(idx % d::GDV); const int hd = (int)((idx / d::GDV) % d::GH); const int dir = (int)(idx / (d::GDV * d::GH));
  float st[d::GDK];
#pragma unroll
  for (int k = 0; k < d::GDK; ++k) st[k] = 0.f;
  const float qs = 1.f / sqrtf((float)d::GDK);
  const float* la = dir ? a.lab : a.laf; float* od = dir ? a.ob : a.of;
  for (int step = 0; step < d::R; ++step) {
    int r;
    if (step < d::C) r = d::S + (dir ? d::C - 1 - step : step); else r = dir ? d::S - 1 - (step - d::C) : step - d::C;
    const float* pr = a.proj + (long)r * d::NIN;
    const float vv = pr[d::O_GV + hd * d::GDV + v];
    float o = 0.f;
#pragma unroll
    for (int k = 0; k < d::GDK; ++k) {
      st[k] = la[(long)r * d::GKW + hd * d::GDK + k] * st[k] + pr[d::O_GK + hd * d::GDK + k] * vv;
      o += pr[d::O_GQ + hd * d::GDK + k] * qs * st[k];
    }
    od[(long)r * d::GVW + hd * d::GDV + v] = o;
  }
}
template <class T> HD void st_glaout(const NaiveBufs& a, int l, long idx) {
  using d = DD<T>; const int hd = (int)(idx % d::GH), r = (int)(idx / d::GH);
  const long base = (long)r * d::GVW + hd * d::GDV; float s = 0.f;
  for (int v = 0; v < d::GDV; ++v) { const float o = a.of[base + v] + a.ob[base + v]; s += o * o; }
  const float rsq = 1.f / sqrtf(s / (float)d::GDV + 1e-6f);
  for (int v = 0; v < d::GDV; ++v) { const float o = a.of[base + v] + a.ob[base + v];
    a.ygla[base + v] = o * rsq * a.gla_norm_g[(long)l * d::GDV + v] * siluf_(a.proj[(long)r * d::NIN + d::O_OG + hd * d::GDV + v]); }
}
template <class T> HD void st_hyconv3(const NaiveBufs& a, int l, long idx) {
  using d = DD<T>; const int j = (int)(idx % (3 * d::HW)), r = (int)(idx / (3 * d::HW));
  const int lo = r < d::S ? 0 : d::S, hi = r < d::S ? d::S : d::R;
  const float* w = a.hy_conv_w + (long)l * 3 * 3 * d::HW;
  float v = a.hy_conv_b[(long)l * 3 * d::HW + j] + a.proj[(long)r * d::NIN + d::O_HY + j] * w[1 * 3 * d::HW + j];
  if (r - 1 >= lo) v += a.proj[(long)(r - 1) * d::NIN + d::O_HY + j] * w[0 * 3 * d::HW + j];
  if (r + 1 < hi) v += a.proj[(long)(r + 1) * d::NIN + d::O_HY + j] * w[2 * 3 * d::HW + j];
  a.uc[idx] = v;
}
template <class T> HD void st_hylong(const NaiveBufs& a, int l, int o, long idx) {
  using d = DD<T>; const int c = (int)(idx % d::HW); const int rb = (int)(idx / d::HW); const int r0 = rb * 4;
  const bool lat = r0 < d::S; const int n = lat ? d::S : d::C; const int base = lat ? 0 : d::S; const int t0 = r0 - base;
  const float* tp = (lat ? a.tapsS : a.tapsC) + (long)o * 2 * n * d::HW + c; const float nr = (lat ? a.nrmS : a.nrmC)[o * d::HW + c];
  const float* zs = o == 0 ? a.uc + 2 * d::HW + c : a.z1 + c; const int ldz = o == 0 ? 3 * d::HW : d::HW;
  float acc0 = 0.f, acc1 = 0.f, acc2 = 0.f, acc3 = 0.f;
  auto tap = [&](int lag) { const int li = lag >= 0 ? lag : 2 * n + lag; return tp[(long)li * d::HW]; };
  float w0 = tap(t0), w1 = tap(t0 + 1), w2 = tap(t0 + 2), w3 = tap(t0 + 3);
  for (int s = 0; s < n; ++s) {
    const float zv = zs[(long)(base + s) * ldz];
    acc0 += w0 * zv; acc1 += w1 * zv; acc2 += w2 * zv; acc3 += w3 * zv;
    w3 = w2; w2 = w1; w1 = w0; w0 = (s + 1 < n) ? tap(t0 - s - 1) : 0.f;
  }
  const float sk = a.hy_skip[((long)l * 2 + o) * d::HW + c];
  float* dst = o == 0 ? a.z1 : a.yhy;
  const float accs[4] = {acc0, acc1, acc2, acc3};
#pragma unroll
  for (int i = 0; i < 4; ++i) { const int r = r0 + i; const float zr = zs[(long)r * ldz];
    dst[(long)r * d::HW + c] = a.uc[(long)r * 3 * d::HW + o * d::HW + c] * (accs[i] / nr + sk * zr); }
}
template <class T> HD void st_router(const NaiveBufs& a, long idx) {
  using d = DD<T>; const int r = (int)idx; const float* hr = a.h + (long)r * d::D;
  float sc[d::NE], sel[d::NE];
#pragma unroll
  for (int e = 0; e < d::NE; ++e) sc[e] = 0.f;
  for (int k = 0; k < d::D; ++k) { const float hv = hr[k];
#pragma unroll
    for (int e = 0; e < d::NE; ++e) sc[e] += hv * a.router_w[(long)k * d::NE + e]; }
#pragma unroll
  for (int e = 0; e < d::NE; ++e) { sc[e] = sigmoidf_(sc[e]); sel[e] = sc[e] + a.router_b[e]; }
  int bestg = 0; float bestgs = -1e30f;
#pragma unroll
  for (int g = 0; g < d::NG; ++g) { float m1 = -1e30f, m2 = -1e30f;
#pragma unroll
    for (int i = 0; i < d::EPG; ++i) { const float v = sel[g * d::EPG + i]; if (v > m1) { m2 = m1; m1 = v; } else if (v > m2) m2 = v; }
    const float gs = m1 + m2; if (gs > bestgs) { bestgs = gs; bestg = g; } }
  int i1 = -1, i2 = -1; float v1 = -1e30f, v2 = -1e30f, s1 = 0.f, s2 = 0.f;
#pragma unroll
  for (int e = 0; e < d::NE; ++e) { if (e / d::EPG == bestg) { const float v = sel[e];
      if (v > v1) { v2 = v1; i2 = i1; s2 = s1; v1 = v; i1 = e; s1 = sc[e]; } else if (v > v2) { v2 = v; i2 = e; s2 = sc[e]; } } }
  const float inv = 1.f / (s1 + s2);
  a.ridx[2 * r] = i1; a.ridx[2 * r + 1] = i2; a.rw[2 * r] = s1 * inv; a.rw[2 * r + 1] = s2 * inv;
}
template <class T> HD void st_moehid(const NaiveBufs& a, int l, long idx) {
  using d = DD<T>; const int j = (int)(idx % d::DE); const int k = (int)((idx / d::DE) % 2); const int r = (int)(idx / (2 * d::DE));
  const int e = a.ridx[2 * r + k]; const float* hr = a.h + (long)r * d::D;
  const float* wg = a.moe_w_gate + (((long)l * d::NE + e) * d::D) * d::DE + j; const float* wu = a.moe_w_up + (((long)l * d::NE + e) * d::D) * d::DE + j;
  float g = 0.f, u = 0.f;
  for (int i = 0; i < d::D; ++i) { const float hv = hr[i]; g += hv * wg[(long)i * d::DE]; u += hv * wu[(long)i * d::DE]; }
  a.hid[idx] = siluf_(g) * u;
}
template <class T> HD void st_moeout(const NaiveBufs& a, int l, int b, long idx) {
  using d = DD<T>; const int dd = (int)(idx % d::D), r = (int)(idx / d::D);
  float acc = 0.f;
  for (int k = 0; k < 2; ++k) { const int e = a.ridx[2 * r + k]; const float* hk = a.hid + ((long)r * 2 + k) * d::DE;
    const float* wd = a.moe_w_down + (((long)l * d::NE + e) * d::DE) * d::D + dd; float s = 0.f;
    for (int j = 0; j < d::DE; ++j) s += hk[j] * wd[(long)j * d::D];
    acc += a.rw[2 * r + k] * s; }
  const float g2 = a.mod[(long)(r < d::S ? b : d::B) * 6 * d::D + 5 * d::D + dd];
  float* xr = xrow_w<T>(a, b, r); xr[dd] += g2 * acc;
}
enum { L_MOD = 0, L_HID_S, L_HID_C, L_TAPS_S, L_TAPS_C, L_NRM_S, L_NRM_C, N_LSTAGES,
       P_RS1 = 16, P_NORM1, P_INPROJ, P_QKNORM, P_ATTN_L, P_ATTN_C, P_GLALA, P_GLASCAN, P_GLAOUT, P_HYC3, P_HYL0, P_HYL1,
       P_MRG_HY, P_MRG_GLA, P_MRG_ATT, P_OUT_L, P_OUT_C, P_RS2, P_NORM2, P_ROUTER, P_MOEHID, P_MOEOUT, P_END };
constexpr int ATT_NSPLIT = 4;

template <class T> HD long stage_items(int st, int l) {
  using d = DD<T>; const bool last = (l == d::DEPTH - 1);
  switch (st) {
    case L_MOD: return (long)(d::B + 1) * 6 * d::D;
    case L_HID_S: return (long)d::S * d::HF;
    case L_HID_C: return (long)d::C * d::HF;
    case L_TAPS_S: return 2L * 2 * d::S * d::HW;
    case L_TAPS_C: return 2L * 2 * d::C * d::HW;
    case L_NRM_S: case L_NRM_C: return 2L * d::HW;
    case P_RS1: case P_RS2: case P_ROUTER: return d::R;
    case P_NORM1: case P_NORM2: return (long)d::R * d::D;
    case P_INPROJ: return (long)(d::R / 4) * (d::NIN / 4);
    case P_QKNORM: return (long)d::R * (d::AH + d::AKV);
    case P_ATTN_L: return (long)d::S * d::AH * ATT_NSPLIT;
    case P_ATTN_C: return last ? 0 : (long)d::C * d::AH * ATT_NSPLIT;
    case P_GLALA: return (long)d::R * 2 * d::GKW;
    case P_GLASCAN: return 2L * d::GH * d::GDV;
    case P_GLAOUT: return (long)d::R * d::GH;
    case P_HYC3: return (long)d::R * 3 * d::HW;
    case P_HYL0: case P_HYL1: return (long)(d::R / 4) * d::HW;
    case P_MRG_HY: case P_MRG_GLA: case P_MRG_ATT: return (long)(d::R / 4) * (d::D / 4);
    case P_OUT_L: return (long)(d::S / 4) * (d::D / 4);
    case P_OUT_C: return last ? 0 : (long)(d::C / 4) * (d::D / 4);
    case P_MOEHID: return (long)d::R * 2 * d::DE;
    case P_MOEOUT: return (long)(last ? d::S : d::R) * d::D;
  }
  return 0;
}

template <class T, int ST> HD void stage_run(const NaiveBufs& a, int l, int b, long idx) {
  using d = DD<T>;
  if constexpr (ST == L_MOD) st_mod<T>(a, l, idx);
  else if constexpr (ST == L_HID_S) st_hyhid<T>(a, l, 0, idx);
  else if constexpr (ST == L_HID_C) st_hyhid<T>(a, l, 1, idx);
  else if constexpr (ST == L_TAPS_S) st_hytaps<T>(a, l, 0, idx);
  else if constexpr (ST == L_TAPS_C) st_hytaps<T>(a, l, 1, idx);
  else if constexpr (ST == L_NRM_S) st_hynorm<T>(a, 0, idx);
  else if constexpr (ST == L_NRM_C) st_hynorm<T>(a, 1, idx);
  else if constexpr (ST == P_RS1) st_rs<T>(a, l, b, 0, idx);
  else if constexpr (ST == P_RS2) st_rs<T>(a, l, b, 1, idx);
  else if constexpr (ST == P_NORM1) st_norm<T>(a, l, b, 0, idx);
  else if constexpr (ST == P_NORM2) st_norm<T>(a, l, b, 1, idx);
  else if constexpr (ST == P_INPROJ) { GemmArgs g{a.h, d::D, a.w_in + (long)l * d::D * d::NIN, d::NIN, a.proj, d::NIN, d::R, d::NIN, d::D, nullptr, 0, nullptr, nullptr, 0, 0}; st_gemm(g, idx); }
  else if constexpr (ST == P_QKNORM) st_qknorm<T>(a, l, idx);
  else if constexpr (ST == P_ATTN_L) st_attn<T, ATT_NSPLIT>(a, 0, d::S, idx);
  else if constexpr (ST == P_ATTN_C) st_attn<T, ATT_NSPLIT>(a, d::S, d::C, idx);
  else if constexpr (ST == P_GLALA) st_glala<T>(a, l, idx);
  else if constexpr (ST == P_GLASCAN) st_glascan<T>(a, idx);
  else if constexpr (ST == P_GLAOUT) st_glaout<T>(a, l, idx);
  else if constexpr (ST == P_HYC3) st_hyconv3<T>(a, l, idx);
  else if constexpr (ST == P_HYL0) st_hylong<T>(a, l, 0, idx);
  else if constexpr (ST == P_HYL1) st_hylong<T>(a, l, 1, idx);
  else if constexpr (ST == P_MRG_HY) { GemmArgs g{a.yhy, d::HW, a.w_br_hy + (long)l * d::HW * d::D, d::D, a.m, d::D, d::R, d::D, d::HW, a.proj + d::O_BR, d::NIN, nullptr, nullptr, 0, 0}; st_gemm(g, idx); }
  else if constexpr (ST == P_MRG_GLA) { GemmArgs g{a.ygla, d::GVW, a.w_br_gla + (long)l * d::GVW * d::D, d::D, a.m, d::D, d::R, d::D, d::GVW, a.proj + d::O_BR + d::D, d::NIN, nullptr, nullptr, 0, 1}; st_gemm(g, idx); }
  else if constexpr (ST == P_MRG_ATT) { GemmArgs g{a.yatt, d::AQW, a.w_br_att + (long)l * d::AQW * d::D, d::D, a.m, d::D, d::R, d::D, d::AQW, a.proj + d::O_BR + 2 * d::D, d::NIN, nullptr, nullptr, 0, 1}; st_gemm(g, idx); }
  else if constexpr (ST == P_OUT_L) { const float* res = (l == 0 ? a.x : (const float*)a.out) + (long)b * d::S * d::D;
    GemmArgs g{a.m, d::D, a.w_out + (long)l * d::D * d::D, d::D, a.out + (long)b * d::S * d::D, d::D, d::S, d::D, d::D, nullptr, 0, a.mod + (long)b * 6 * d::D + 2 * d::D, res, d::D, 0}; st_gemm(g, idx); }
  else if constexpr (ST == P_OUT_C) { const float* res = (l == 0 ? a.ctx : (const float*)a.xc) + (long)b * d::C * d::D;
    GemmArgs g{a.m + (long)d::S * d::D, d::D, a.w_out + (long)l * d::D * d::D, d::D, a.xc + (long)b * d::C * d::D, d::D, d::C, d::D, d::D, nullptr, 0, a.mod + (long)d::B * 6 * d::D + 2 * d::D, res, d::D, 0}; st_gemm(g, idx); }
  else if constexpr (ST == P_ROUTER) st_router<T>(a, idx);
  else if constexpr (ST == P_MOEHID) st_moehid<T>(a, l, idx);
  else if constexpr (ST == P_MOEOUT) st_moeout<T>(a, l, b, idx);
}

template <class T> inline size_t carve(NaiveBufs& a, float* ws) {
  using d = DD<T>; size_t o = 0; auto take = [&](size_t n) { float* p = ws ? ws + o : nullptr; o += (n + 63) & ~(size_t)63; return p; };
  a.mod = take((size_t)(d::B + 1) * 6 * d::D);
  a.hid2S = take((size_t)d::S * d::HF); a.hid2C = take((size_t)d::C * d::HF);
  a.tapsS = take((size_t)2 * 2 * d::S * d::HW); a.tapsC = take((size_t)2 * 2 * d::C * d::HW);
  a.nrmS = take(2 * d::HW); a.nrmC = take(2 * d::HW);
  a.rs = take(d::R); a.h = take((size_t)d::R * d::D); a.proj = take((size_t)d::R * d::NIN);
  a.qn = take((size_t)d::R * d::AQW); a.kn = take((size_t)d::R * d::AKVW);
  a.uc = take((size_t)d::R * 3 * d::HW); a.z1 = take((size_t)d::R * d::HW); a.yhy = take((size_t)d::R * d::HW);
  a.xc = take((size_t)d::B * d::C * d::D);
#ifdef HOST_TEST
  a.yatt = take((size_t)d::R * d::AQW); a.laf = take((size_t)d::R * d::GKW); a.lab = take((size_t)d::R * d::GKW);
  a.of = take((size_t)d::R * d::GVW); a.ob = take((size_t)d::R * d::GVW); a.ygla = take((size_t)d::R * d::GVW);
  a.m = take((size_t)d::R * d::D); a.ridx = (int*)take((size_t)d::R * 2); a.rw = take((size_t)d::R * 2); a.hid = take((size_t)d::R * 2 * d::DE);
#endif
  return o;
}
template <class T> inline void set_inputs(NaiveBufs& a, const float* const* in) {
  int i = 0;
  a.x = in[i++]; a.c = in[i++]; a.ctx = in[i++]; a.c_ctx = in[i++]; a.w_mod = in[i++]; a.b_mod = in[i++]; a.norm1_g = in[i++]; a.norm2_g = in[i++];
  a.w_in = in[i++]; a.q_norm_g = in[i++]; a.k_norm_g = in[i++]; a.gla_wa2 = in[i++]; a.gla_ba = in[i++]; a.gla_norm_g = in[i++];
  a.hy_conv_w = in[i++]; a.hy_conv_b = in[i++]; a.hy_pos_w1 = in[i++]; a.hy_pos_b1 = in[i++]; a.hy_sin_freq = in[i++]; a.hy_pos_w2 = in[i++];
  a.hy_pos_b2 = in[i++]; a.hy_pos_w3 = in[i++]; a.hy_decay = in[i++]; a.hy_skip = in[i++]; a.w_br_hy = in[i++]; a.w_br_gla = in[i++];
  a.w_br_att = in[i++]; a.w_out = in[i++]; a.router_w = in[i++]; a.router_b = in[i++]; a.moe_w_gate = in[i++]; a.moe_w_up = in[i++]; a.moe_w_down = in[i++];
}

#define LSTAGES(X) X(L_MOD) X(L_HID_S) X(L_HID_C) X(L_TAPS_S) X(L_TAPS_C) X(L_NRM_S) X(L_NRM_C)
#define PSTAGES(X) X(P_RS1) X(P_NORM1) X(P_INPROJ) X(P_QKNORM) X(P_ATTN_L) X(P_ATTN_C) X(P_GLALA) X(P_GLASCAN) X(P_GLAOUT) X(P_HYC3) X(P_HYL0) X(P_HYL1) \
  X(P_MRG_HY) X(P_MRG_GLA) X(P_MRG_ATT) X(P_OUT_L) X(P_OUT_C) X(P_RS2) X(P_NORM2) X(P_ROUTER) X(P_MOEHID) X(P_MOEOUT)
namespace pro {
__device__ __forceinline__ void mod_phase(const NaiveBufs& a, int l, LAS unsigned char* lds) {
  int tz = threadIdx.x; asm volatile("" : "+v"(tz));
  __syncthreads();
  LAS float* sl = (LAS float*)lds; LAS float* part = sl + 9 * 1024;
  for (int e = tz; e < 9 * 1024; e += NTHREADS) { const int bb = e >> 10, k = e & 1023; const float cv = bb < 8 ? a.c[bb * 1024 + k] : a.c_ctx[k]; sl[e] = cv / (1.f + __expf(-cv)); }
  __syncthreads();
  const float* w = a.w_mod + (size_t)l * 1024 * 6144;
  const int jl = tz & 63, ks = tz >> 6;
  for (int cb = blockIdx.x; cb < 96; cb += gridDim.x) { const int j = cb * 64 + jl; float acc[9];
#pragma unroll
    for (int q = 0; q < 9; ++q) acc[q] = 0.f;
#pragma unroll 4
    for (int k = ks * 128; k < ks * 128 + 128; ++k) { const float wv = w[(size_t)k * 6144 + j];
#pragma unroll
      for (int q = 0; q < 9; ++q) acc[q] += sl[q * 1024 + k] * wv; }
#pragma unroll
    for (int q = 0; q < 9; ++q) part[(ks * 9 + q) * 64 + jl] = acc[q];
    __syncthreads();
    for (int e = tz; e < 9 * 64; e += NTHREADS) { const int q = e >> 6, jj = e & 63; float s = a.b_mod[(size_t)l * 6144 + cb * 64 + jj];
#pragma unroll
      for (int k8 = 0; k8 < 8; ++k8) s += part[(k8 * 9 + q) * 64 + jj];
      a.mod[(size_t)q * 6144 + cb * 64 + jj] = s; }
    __syncthreads(); }
  __syncthreads();
}
__device__ __forceinline__ void hid_phase(const NaiveBufs& a, int l, int n, float* dst, LAS unsigned char* lds) {
  int tz = threadIdx.x; asm volatile("" : "+v"(tz));
  LAS float* Z = (LAS float*)(lds + 40960); LAS float* H1 = Z + 8 * 36;
  const float* w1 = a.hy_pos_w1 + (size_t)l * 33 * 64; const float* b1 = a.hy_pos_b1 + l * 64; const float* fr = a.hy_sin_freq + l * 64;
  const float* w2 = a.hy_pos_w2 + (size_t)l * 64 * 64; const float* b2 = a.hy_pos_b2 + l * 64;
  const float w0 = 2.f * 3.14159265358979323846f / (float)n;
  for (int t0 = blockIdx.x * 8; t0 < n; t0 += gridDim.x * 8) {
    if (tz < 8 * 33) { const int tt = tz / 33, e = tz % 33, t = t0 + tt; float v;
      if (e == 0) v = (float)t / (float)n; else { const int bnd = (e - 1) & 15; const float band = 1e-4f + (float)bnd * (15.f - 1e-4f) / 15.f; const float ph = w0 * (float)t * band; v = e <= 16 ? cosf(ph) : -sinf(ph); }
      Z[tt * 36 + e] = v; }
    __syncthreads();
    { const int tt = tz >> 6, i = tz & 63; float acc = b1[i];
#pragma unroll
      for (int e = 0; e < 33; ++e) acc += Z[tt * 36 + e] * w1[e * 64 + i];
      H1[tt * 64 + i] = sinf(fr[i] * acc); }
    __syncthreads();
    { const int tt = tz >> 6, j = tz & 63; float acc = b2[j];
#pragma unroll 8
      for (int i = 0; i < 64; ++i) acc += H1[tt * 64 + i] * w2[i * 64 + j];
      if (t0 + tt < n) dst[(size_t)(t0 + tt) * 64 + j] = sinf(fr[j] * acc); }
    __syncthreads();
  }
}
__device__ __forceinline__ void nrmS_phase(const NaiveBufs& a) {
  int tz = threadIdx.x; asm volatile("" : "+v"(tz)); const int lane = tz & 63, wave = __builtin_amdgcn_readfirstlane(tz >> 6);
  for (int oc = blockIdx.x * NWAVES + wave; oc < 1024; oc += gridDim.x * NWAVES) { const float* tp = a.tapsS + (size_t)oc * 8192; float s = 0.f;
#pragma unroll 8
    for (int k = lane; k < 8192; k += 64) s += fabsf(tp[k]);
    s = moe::wave_sum(s); if (lane == 0) a.nrmS[oc] = s + 1e-6f; }
}
constexpr int TCOPY = 8232;
__device__ __forceinline__ void tapsB_phase(const NaiveBufs& a, int l, bf16_t* tapsB, LAS unsigned char* lds) {
  int tz = threadIdx.x; asm volatile("" : "+v"(tz));
  const float* w3 = a.hy_pos_w3 + (size_t)l * 64 * 2048; const float* dcy = a.hy_decay + (size_t)l * 2048;
  typedef float f4 __attribute__((ext_vector_type(4)));
  LAS float* W = (LAS float*)lds;
  for (int cp = blockIdx.x; cp < 256; cp += gridDim.x) {
    __syncthreads();
    { const int ch = tz >> 8, e = tz & 255, c = cp + 256 * ch; W[tz] = w3[(size_t)(e >> 2) * 2048 + (e & 3) * 512 + c]; if (tz < 8) W[512 + tz] = fabsf(dcy[(tz & 3) * 512 + cp + 256 * (tz >> 2)]); }
    __syncthreads();
    for (int t = tz; t < 4096; t += NTHREADS) {
      const f4* h2 = (const f4*)(a.hid2S + (size_t)t * 64); f4 acc0 = {0.f, 0.f, 0.f, 0.f}, acc1 = {0.f, 0.f, 0.f, 0.f};
#pragma unroll 4
      for (int j4 = 0; j4 < 16; ++j4) { const f4 h = h2[j4];
#pragma unroll
        for (int e = 0; e < 4; ++e) { acc0 += h[e] * *(const LAS f4*)(W + (4 * j4 + e) * 4); acc1 += h[e] * *(const LAS f4*)(W + 256 + (4 * j4 + e) * 4); } }
      const float tn = (float)t * (1.f / 4096.f);
#pragma unroll
      for (int ch = 0; ch < 2; ++ch)
#pragma unroll
        for (int q = 0; q < 4; ++q) { const int o = q >> 1, dir = q & 1; if (dir == 1 && t == 0) continue; const int c = cp + 256 * ch;
          const bf16_t bv = (bf16_t)f2bf((ch ? acc1[q] : acc0[q]) * __expf(-tn * W[512 + 4 * ch + q]));
          bf16_t* base = tapsB + ((size_t)o * 512 + c) * 2 * TCOPY; const int x0 = dir ? 4096 + t : 4096 - t;
          base[x0] = bv; base[TCOPY + x0 - 1] = bv; } } }
  for (long idx = (long)blockIdx.x * NTHREADS + tz; idx < 1024L * 96; idx += (long)gridDim.x * NTHREADS) { const int oc = (int)(idx / 96), e = (int)(idx % 96); bf16_t* base = tapsB + (size_t)oc * 2 * TCOPY;
    if (e < 40) base[8192 + e] = 0; else if (e < 81) base[TCOPY + 8191 + (e - 40)] = 0; else if (e == 81) base[0] = 0; }
}
__device__ __forceinline__ void nrmB_phase(const NaiveBufs& a, const bf16_t* tapsB) {
  int tz = threadIdx.x; asm volatile("" : "+v"(tz)); const int lane = tz & 63, wave = __builtin_amdgcn_readfirstlane(tz >> 6);
  for (int oc = blockIdx.x * NWAVES + wave; oc < 1024; oc += gridDim.x * NWAVES) { const bf16_t* tp = tapsB + (size_t)oc * 2 * TCOPY; float s = 0.f;
#pragma unroll 8
    for (int k = lane; k < 8192; k += 64) s += fabsf(bf2f(tp[k]));
    s = moe::wave_sum(s); if (lane == 0) a.nrmS[oc] = s + 1e-6f; }
}
}
using TD = FullDims;
using dd = DD<TD>;
constexpr int GB = 4, NGRP = 2, RB = dd::R  , RG = GB * RB, PLD = dd::O_BR + 1536  , PANELS = RG / 256, PPB = RB / 256  ;
constexpr size_t BAR_BYTES = 16384 + 4 * 4096; constexpr int CNT_OFF = 16384;
constexpr int MPG = 38912;
constexpr size_t CS_BYTES = (size_t)2 * 4 * 68 * 64 * 128 * 2, DEC_BYTES = (size_t)2 * 4 * 68 * 64 * 4;
constexpr size_t UCT_BYTES = (size_t)1536 * 4096 * 2, YT_BYTES = (size_t)512 * 4096 * 2, UCC_BYTES = (size_t)256 * 1536 * 4, Z1C_BYTES = (size_t)256 * 512 * 4;
constexpr size_t MIX_BYTES = GB * (CS_BYTES + DEC_BYTES) > GB * (UCT_BYTES + YT_BYTES + UCC_BYTES + Z1C_BYTES) ? GB * (CS_BYTES + DEC_BYTES) : GB * (UCT_BYTES + YT_BYTES + UCC_BYTES + Z1C_BYTES);

struct KArgs { NaiveBufs a; unsigned* bar; int* cnt; bf16_t *xs; bf16_t *WgaT; bf16_t *WinT, *WhyT, *WglaT, *WattT, *WoutT, *WguT, *WdT, *hb, *proj; unsigned char* mix;
  bf16_t *hp, *hid, *contrib; int* srcrow; float* wgt; moe::Route* route; float* wts; };

struct EpiProjBf16 {
  static constexpr bool PERM = true, AFTER_DRAIN = false;
  bf16_t* P;
  __device__ __forceinline__ void operator()(const pg8::f32x4 (&acc)[2][2][4][2], const pg8::Unit& u, int wr, int wc, int fr, int fq) const {
    const int row0 = u.pm * 256 + wr * 64 + fr, col0 = u.pn * 256 + wc * 32 + 8 * fq;
    const int cr0 = col0 + (col0 >= dd::O_GA ? 32 : 0), cr1 = col0 + 128 + (col0 + 128 >= dd::O_GA ? 32 : 0);
    if (u.pn >= (dd::O_BR - 32) / 256) {
      unsigned char* Pg = (unsigned char*)P + (size_t)dd::O_BR * 2 + (col0 - (dd::O_BR - 32));
#pragma unroll
      for (int ai = 0; ai < 2; ++ai)
#pragma unroll
        for (int m = 0; m < 4; ++m) { unsigned char* rowp = Pg + (size_t)(row0 + ai * 128 + m * 16) * (PLD * 2);
#pragma unroll
          for (int bj = 0; bj < 2; ++bj) { const pg8::f32x4 v0 = acc[ai][bj][m][0], v1 = acc[ai][bj][m][1]; uint2 o;
            o.x = (unsigned)(fsigmoid(v0[0]) * 255.f + 0.5f) | ((unsigned)(fsigmoid(v0[1]) * 255.f + 0.5f) << 8) | ((unsigned)(fsigmoid(v0[2]) * 255.f + 0.5f) << 16) | ((unsigned)(fsigmoid(v0[3]) * 255.f + 0.5f) << 24);
            o.y = (unsigned)(fsigmoid(v1[0]) * 255.f + 0.5f) | ((unsigned)(fsigmoid(v1[1]) * 255.f + 0.5f) << 8) | ((unsigned)(fsigmoid(v1[2]) * 255.f + 0.5f) << 16) | ((unsigned)(fsigmoid(v1[3]) * 255.f + 0.5f) << 24);
            *(uint2*)(rowp + bj * 128) = o; } }
      return; }
#pragma unroll
    for (int ai = 0; ai < 2; ++ai)
#pragma unroll
      for (int m = 0; m < 4; ++m) { bf16_t* rowp = P + (size_t)(row0 + ai * 128 + m * 16) * PLD;
#pragma unroll
        for (int bj = 0; bj < 2; ++bj) { const pg8::f32x4 v0 = acc[ai][bj][m][0], v1 = acc[ai][bj][m][1];
          v4u o; o.x = pk2(v0[0], v0[1]); o.y = pk2(v0[2], v0[3]); o.z = pk2(v1[0], v1[1]); o.w = pk2(v1[2], v1[3]); *(v4u*)(rowp + (bj ? cr1 : cr0)) = o; } }
  }
};
template <bool ACCUM> struct EpiMergeB {
  static constexpr bool PERM = true, AFTER_DRAIN = false;
  const bf16_t* gate; bf16_t* M;
  __device__ __forceinline__ void operator()(const pg8::f32x4 (&acc)[2][2][4][2], const pg8::Unit& u, int wr, int wc, int fr, int fq) const {
    const int row0 = u.pm * 256 + wr * 64 + fr, col0 = u.pn * 256 + wc * 32 + 8 * fq;
#pragma unroll
    for (int ai2 = 0; ai2 < 4; ++ai2) { const int ai = ai2 >> 1, m0 = (ai2 & 1) * 2;
      v4u gw[4][2], mo[4][2];
#pragma unroll
      for (int m = m0; m < m0 + 2; ++m)
#pragma unroll
        for (int bj = 0; bj < 2; ++bj) { const size_t r = (size_t)(row0 + ai * 128 + m * 16); const int c = col0 + bj * 128; gw[m][bj] = *(const v4u*)(gate + r * PLD + c); if (ACCUM) mo[m][bj] = *(const v4u*)(M + r * 1024 + c); }
#pragma unroll
      for (int m = m0; m < m0 + 2; ++m)
#pragma unroll
        for (int bj = 0; bj < 2; ++bj) { const size_t r = (size_t)(row0 + ai * 128 + m * 16); const int c = col0 + bj * 128; const v4u g4 = gw[m][bj];
          pg8::f32x4 v0 = acc[ai][bj][m][0], v1 = acc[ai][bj][m][1];
          v0[0] *= fsigmoid(bf2f(g4.x & 0xffff)); v0[1] *= fsigmoid(bf2f(g4.x >> 16)); v0[2] *= fsigmoid(bf2f(g4.y & 0xffff)); v0[3] *= fsigmoid(bf2f(g4.y >> 16));
          v1[0] *= fsigmoid(bf2f(g4.z & 0xffff)); v1[1] *= fsigmoid(bf2f(g4.z >> 16)); v1[2] *= fsigmoid(bf2f(g4.w & 0xffff)); v1[3] *= fsigmoid(bf2f(g4.w >> 16));
          if (ACCUM) { const v4u o = mo[m][bj]; v0[0] += bf2f(o.x & 0xffff); v0[1] += bf2f(o.x >> 16); v0[2] += bf2f(o.y & 0xffff); v0[3] += bf2f(o.y >> 16);
            v1[0] += bf2f(o.z & 0xffff); v1[1] += bf2f(o.z >> 16); v1[2] += bf2f(o.w & 0xffff); v1[3] += bf2f(o.w >> 16); }
          v4u o2; o2.x = pk2(v0[0], v0[1]); o2.y = pk2(v0[2], v0[3]); o2.z = pk2(v1[0], v1[1]); o2.w = pk2(v1[2], v1[3]); *(v4u*)(M + r * 1024 + c) = o2; } }
  }
};
struct EpiOutG {
  static constexpr bool PERM = true, AFTER_DRAIN = false;
  const float* resL; const float* resC; bf16_t* xs; const float* mod; int b0; bool ctx_on, resbf;
  __device__ __forceinline__ void operator()(const pg8::f32x4 (&acc)[2][2][4][2], const pg8::Unit& u, int wr, int wc, int fr, int fq) const {
    const int bl = u.pm / PPB, lp = u.pm % PPB; const bool isc = lp == PPB - 1; if (isc && !ctx_on) return;
    const int b = b0 + bl;
    const float* res = isc ? resC + (size_t)b * dd::C * 1024 : resL + ((size_t)b * dd::S + lp * 256) * 1024;
    bf16_t* out = xs + (size_t)u.pm * 256 * 1024;
    const float* gv = mod + (size_t)(isc ? dd::B : b) * 6 * 1024 + 2 * 1024;
    int row0 = wr * 64 + fr, col0 = u.pn * 256 + wc * 32 + 8 * fq; asm volatile("" : "+v"(row0), "+v"(col0));
    pg8::f32x4 gg[2][2];
#pragma unroll
    for (int bj = 0; bj < 2; ++bj)
#pragma unroll
      for (int n = 0; n < 2; ++n) gg[bj][n] = *(const pg8::f32x4*)(gv + col0 + bj * 128 + n * 4);
    if (resbf) {
#pragma unroll
      for (int ai2 = 0; ai2 < 4; ++ai2) { const int ai = ai2 >> 1, m0 = (ai2 & 1) * 2; v4u rb[4][2];
#pragma unroll
        for (int m = m0; m < m0 + 2; ++m)
#pragma unroll
          for (int bj = 0; bj < 2; ++bj) rb[m][bj] = *(const v4u*)(out + (size_t)(row0 + ai * 128 + m * 16) * 1024 + col0 + bj * 128);
#pragma unroll
        for (int m = m0; m < m0 + 2; ++m)
#pragma unroll
          for (int bj = 0; bj < 2; ++bj) { const v4u o = rb[m][bj]; const pg8::f32x4 v0 = gg[bj][0] * acc[ai][bj][m][0], v1 = gg[bj][1] * acc[ai][bj][m][1]; v4u w;
            w.x = pk2(v0[0] + __uint_as_float(o.x << 16), v0[1] + __uint_as_float(o.x & 0xffff0000u)); w.y = pk2(v0[2] + __uint_as_float(o.y << 16), v0[3] + __uint_as_float(o.y & 0xffff0000u));
            w.z = pk2(v1[0] + __uint_as_float(o.z << 16), v1[1] + __uint_as_float(o.z & 0xffff0000u)); w.w = pk2(v1[2] + __uint_as_float(o.w << 16), v1[3] + __uint_as_float(o.w & 0xffff0000u));
            *(v4u*)(out + (size_t)(row0 + ai * 128 + m * 16) * 1024 + col0 + bj * 128) = w; } }
    } else {
#pragma unroll
      for (int ai2 = 0; ai2 < 4; ++ai2) { const int ai = ai2 >> 1, m0 = (ai2 & 1) * 2;
        pg8::f32x4 rv[4][2][2];
#pragma unroll
        for (int m = m0; m < m0 + 2; ++m)
#pragma unroll
          for (int bj = 0; bj < 2; ++bj)
#pragma unroll
            for (int n = 0; n < 2; ++n) rv[m][bj][n] = *(const pg8::f32x4*)(res + (size_t)(row0 + ai * 128 + m * 16) * 1024 + col0 + bj * 128 + n * 4);
#pragma unroll
        for (int m = m0; m < m0 + 2; ++m)
#pragma unroll
          for (int bj = 0; bj < 2; ++bj) { const pg8::f32x4 v0 = rv[m][bj][0] + gg[bj][0] * acc[ai][bj][m][0], v1 = rv[m][bj][1] + gg[bj][1] * acc[ai][bj][m][1];
            v4u w; w.x = pk2(v0[0], v0[1]); w.y = pk2(v0[2], v0[3]); w.z = pk2(v1[0], v1[1]); w.w = pk2(v1[2], v1[3]);
            *(v4u*)(out + (size_t)(row0 + ai * 128 + m * 16) * 1024 + col0 + bj * 128) = w; } }
    }
  }
};
struct GroupOrder {
  int nN, nwg, G, c; bool lat;
  __device__ void init(int N, int G_, int c_, bool lat_) { nN = N / 256; lat = lat_; nwg = (lat ? GB * 16 : PANELS) * nN; G = G_; c = c_; }
  __device__ __forceinline__ bool next(int i, pg8::Unit& u) const { const long L = (long)i * G + c; if (L >= nwg) return false; const int p = (int)L / nN; u.pm = lat ? (p >> 4) * PPB + (p & 15) : p; u.pn = (int)L % nN; u.acol = 0; u.nt = 0; return true; }
  __device__ __forceinline__ void a_ready(const pg8::Unit&) const {}
  __device__ __forceinline__ void done(const pg8::Unit&) const {}
};
struct MergeOrder {
  int ntiles, G, c; bool lat;
  __device__ void init(int G_, int c_, bool lat_) { lat = lat_; ntiles = (lat ? GB * 16 : PANELS) * 4; G = G_; c = c_; }
  __device__ __forceinline__ bool next(int i, pg8::Unit& u) const { const int rnd = i / 3, gi = i - 3 * rnd; const long tile = (long)rnd * G + c; if (tile >= ntiles) return false; const int p = (int)tile >> 2;
    u.pm = lat ? (p >> 4) * PPB + (p & 15) : p; u.pn = gi * 4 + ((int)tile & 3); u.acol = gi == 0 ? dd::O_HY : gi == 1 ? dd::O_OG : dd::O_AQ; u.nt = gi == 2 ? 16 : 8; return true; }
  __device__ __forceinline__ void a_ready(const pg8::Unit&) const {}
  __device__ __forceinline__ void done(const pg8::Unit&) const {}
};
struct EpiMergeS {
  static constexpr bool PERM = true, AFTER_DRAIN = false;
  const unsigned char* gate0; bf16_t* M;
  __device__ __forceinline__ void operator()(const pg8::f32x4 (&acc)[2][2][4][2], const pg8::Unit& u, int wr, int wc, int fr, int fq) const {
    const int gi = u.pn >> 2; const bool accum = gi > 0; const unsigned char* gate = gate0 + gi * 1024;
    const int row0 = u.pm * 256 + wr * 64 + fr, col0 = (u.pn & 3) * 256 + wc * 32 + 8 * fq;
#pragma unroll
    for (int ai2 = 0; ai2 < 4; ++ai2) { const int ai = ai2 >> 1, m0 = (ai2 & 1) * 2;
      uint2 gw[4][2]; v4u mo[4][2];
#pragma unroll
      for (int m = m0; m < m0 + 2; ++m)
#pragma unroll
        for (int bj = 0; bj < 2; ++bj) { const size_t r = (size_t)(row0 + ai * 128 + m * 16); const int c = col0 + bj * 128; gw[m][bj] = *(const uint2*)(gate + r * (PLD * 2) + c); mo[m][bj] = (v4u){0u, 0u, 0u, 0u}; if (accum) mo[m][bj] = *(const v4u*)(M + r * 1024 + c); }
#pragma unroll
      for (int m = m0; m < m0 + 2; ++m)
#pragma unroll
        for (int bj = 0; bj < 2; ++bj) { const size_t r = (size_t)(row0 + ai * 128 + m * 16); const int c = col0 + bj * 128; const uint2 g2 = gw[m][bj]; constexpr float q = 1.f / 255.f;
          pg8::f32x4 v0 = acc[ai][bj][m][0], v1 = acc[ai][bj][m][1];
          v0[0] *= (float)(g2.x & 255u) * q; v0[1] *= (float)((g2.x >> 8) & 255u) * q; v0[2] *= (float)((g2.x >> 16) & 255u) * q; v0[3] *= (float)(g2.x >> 24) * q;
          v1[0] *= (float)(g2.y & 255u) * q; v1[1] *= (float)((g2.y >> 8) & 255u) * q; v1[2] *= (float)((g2.y >> 16) & 255u) * q; v1[3] *= (float)(g2.y >> 24) * q;
          { const v4u o = mo[m][bj]; v0[0] += bf2f(o.x & 0xffff); v0[1] += bf2f(o.x >> 16); v0[2] += bf2f(o.y & 0xffff); v0[3] += bf2f(o.y >> 16);
            v1[0] += bf2f(o.z & 0xffff); v1[1] += bf2f(o.z >> 16); v1[2] += bf2f(o.w & 0xffff); v1[3] += bf2f(o.w >> 16); }
          v4u o2; o2.x = pk2(v0[0], v0[1]); o2.y = pk2(v0[2], v0[3]); o2.z = pk2(v1[0], v1[1]); o2.w = pk2(v1[2], v1[3]); *(v4u*)(M + r * 1024 + c) = o2; } }
  }
};
__device__ __forceinline__ const float* xrow_in(const NaiveBufs& a, int l, int b, int r) {
  if (r < dd::S) return (l == 0 ? a.x : (const float*)a.out) + ((size_t)b * dd::S + r) * 1024;
  return (l == 0 ? a.ctx : (const float*)a.xc) + ((size_t)b * dd::C + (r - dd::S)) * 1024;
}
__device__ __forceinline__ float* xrow_cur(const NaiveBufs& a, int b, int r) {
  if (r < dd::S) return a.out + ((size_t)b * dd::S + r) * 1024;
  return a.xc + ((size_t)b * dd::C + (r - dd::S)) * 1024;
}
template <bool BF> __device__ __forceinline__ void norm_row(const void* xr, const float* gnorm, const float* shift, const float* scale, bf16_t* hrow, int lane) {
  typedef float f4 __attribute__((ext_vector_type(4)));
  f4 xv[4]; float ss = 0.f;
#pragma unroll
  for (int j = 0; j < 4; ++j) {
    if (BF) { const uint2 rw = *(const uint2*)((const bf16_t*)xr + 4 * lane + 256 * j); xv[j][0] = __uint_as_float(rw.x << 16); xv[j][1] = __uint_as_float(rw.x & 0xffff0000u); xv[j][2] = __uint_as_float(rw.y << 16); xv[j][3] = __uint_as_float(rw.y & 0xffff0000u); }
    else xv[j] = *(const f4*)((const float*)xr + 4 * lane + 256 * j);
    ss += xv[j][0] * xv[j][0] + xv[j][1] * xv[j][1] + xv[j][2] * xv[j][2] + xv[j][3] * xv[j][3]; }
  const float rs = 1.f / sqrtf(moe::wave_sum(ss) * (1.f / 1024.f) + 1e-6f);
#pragma unroll
  for (int j = 0; j < 4; ++j) { const int c = 4 * lane + 256 * j; const f4 g4 = *(const f4*)(gnorm + c), sh = *(const f4*)(shift + c), sc = *(const f4*)(scale + c);
    f4 h;
#pragma unroll
    for (int i = 0; i < 4; ++i) h[i] = xv[j][i] * rs * g4[i] * (1.f + sc[i]) + sh[i];
    *(unsigned long long*)(hrow + c) = (unsigned long long)pk2(h[0], h[1]) | ((unsigned long long)pk2(h[2], h[3]) << 32); }
}
__device__ __forceinline__ void qknorm_row(bf16_t* prow, const float* qg, const float* kg, int r, int lane) {
  const bool lat = r < dd::S; const int grow = r / dd::GW, gcol = r % dd::GW;
  const int fi = lane & 31; const float pos = (lane < 32) ? (float)grow : (float)gcol;
  const float ang = pos * __builtin_amdgcn_exp2f(-(float)fi * (13.287712379549449f / 32.f));
  const float cs = lat ? __cosf(ang) : 1.f, sn = lat ? __sinf(ang) : 0.f;
  unsigned wv[10];
#pragma unroll
  for (int hh = 0; hh < 10; ++hh) wv[hh] = *((const unsigned*)(prow + (hh < 8 ? dd::O_AQ + hh * 128 : dd::O_AK + (hh - 8) * 128)) + lane);
  float ss[10];
#pragma unroll
  for (int hh = 0; hh < 10; ++hh) { const float x1 = bf2f(wv[hh] & 0xffff), x2 = bf2f(wv[hh] >> 16); ss[hh] = x1 * x1 + x2 * x2; }
#pragma unroll
  for (int o = 1; o < 64; o <<= 1) {
#pragma unroll
    for (int hh = 0; hh < 10; ++hh) ss[hh] += __shfl_xor(ss[hh], o); }
  const float q1 = qg[2 * lane], q2 = qg[2 * lane + 1], k1 = kg[2 * lane], k2 = kg[2 * lane + 1];
#pragma unroll
  for (int hh = 0; hh < 10; ++hh) { unsigned* p = (unsigned*)(prow + (hh < 8 ? dd::O_AQ + hh * 128 : dd::O_AK + (hh - 8) * 128)) + lane;
    const float x1 = bf2f(wv[hh] & 0xffff), x2 = bf2f(wv[hh] >> 16); const float rs = 1.f / sqrtf(ss[hh] * (1.f / 128.f) + 1e-6f);
    const float y1 = x1 * rs * (hh < 8 ? q1 : k1), y2 = x2 * rs * (hh < 8 ? q2 : k2);
    *p = pk2(y1 * cs - y2 * sn, y1 * sn + y2 * cs); }
}

__device__ __forceinline__ void ga_task(const bf16_t* hb, const bf16_t* WgaT, bf16_t* proj, int wt) {
  int tid = threadIdx.x; asm volatile("" : "+v"(tid));
  const int lane = tid & 63, li = lane & 31, lk = lane >> 5; typedef short b8 __attribute__((ext_vector_type(8))); typedef float f16v __attribute__((ext_vector_type(16)));
  const bf16_t* ap = hb + ((size_t)wt * 32 + li) * 1024 + 8 * lk; const bf16_t* bp = WgaT + (size_t)li * 1024 + 8 * lk;
  f16v acc = {};
  for (int k8 = 0; k8 < 8; ++k8) { v4u av[8], bv[8];
#pragma unroll
    for (int j = 0; j < 8; ++j) { av[j] = *(const v4u*)(ap + 128 * k8 + 16 * j); bv[j] = *(const v4u*)(bp + 128 * k8 + 16 * j); }
#pragma unroll
    for (int j = 0; j < 8; ++j) acc = __builtin_amdgcn_mfma_f32_32x32x16_bf16(__builtin_bit_cast(b8, av[j]), __builtin_bit_cast(b8, bv[j]), acc, 0, 0, 0); }
#pragma unroll
  for (int r = 0; r < 16; ++r) { const int row = wt * 32 + (r & 3) + 8 * (r >> 2) + 4 * lk; proj[(size_t)row * PLD + dd::O_GA + li] = (bf16_t)f2bf(acc[r]); }
}

__global__ void __launch_bounds__(NTHREADS, 2) mega_kernel(KArgs ka_unused) {
  extern __shared__ __attribute__((aligned(16))) unsigned char lds_raw[];
  LAS unsigned char* lds = (LAS unsigned char*)lds_raw;
  volatile LAS unsigned* MISC = (volatile LAS unsigned*)(lds + MISC_OFF);
  constexpr int ARGS_OFF = MISC_OFF + 256;
  static_assert(ARGS_OFF + sizeof(KArgs) <= LDS_BYTES, "LDS map");
  { const unsigned __attribute__((address_space(4)))* kp = (const unsigned __attribute__((address_space(4)))*)__builtin_amdgcn_kernarg_segment_ptr();
    for (int i = threadIdx.x; i < (int)(sizeof(KArgs) / 4); i += NTHREADS) ((LAS unsigned*)(lds + ARGS_OFF))[i] = kp[i]; }
  if (threadIdx.x < 64) MISC[threadIdx.x] = 0u;
  __syncthreads();
  const KArgs& ka = *(const KArgs*)(const LAS KArgs*)(lds + ARGS_OFF);
  const NaiveBufs& a = ka.a;
  unsigned* bar_s; { const unsigned long long bp = (unsigned long long)ka.bar; const unsigned lo_ = __builtin_amdgcn_readfirstlane((unsigned)bp), hi_ = __builtin_amdgcn_readfirstlane((unsigned)(bp >> 32));
    bar_s = (unsigned*)(((unsigned long long)hi_ << 32) | lo_); }
  XcdBarrier xb = xcd_barrier_post(bar_s, MISC);
#define SPTR(T, name, src) T* name; { const unsigned long long bp_ = (unsigned long long)(src); const unsigned lo_ = __builtin_amdgcn_readfirstlane((unsigned)bp_), hi_ = __builtin_amdgcn_readfirstlane((unsigned)(bp_ >> 32)); name = (T*)(((unsigned long long)hi_ << 32) | lo_); }
  SPTR(bf16_t, proj_s, ka.proj) SPTR(bf16_t, hb_s, ka.hb) SPTR(unsigned char, mix_s, ka.mix)
  const long gs = (long)gridDim.x * NTHREADS;
  LAS int* poff = (LAS int*)(lds + MISC_OFF + 64);
#define TID_SETUP int tz = threadIdx.x; asm volatile("" : "+v"(tz)); const int lane = tz & 63, wave = __builtin_amdgcn_readfirstlane(tz >> 6); \
    const int gw = blockIdx.x * NWAVES + wave, NGW = gridDim.x * NWAVES; const long gt = (long)blockIdx.x * NTHREADS + tz; (void)lane; (void)gw; (void)NGW; (void)gt;
#define LSTAGE(ST) { TID_SETUP const long n_ = stage_items<TD>(ST, l); for (long i_ = gt; i_ < n_; i_ += gs) stage_run<TD, ST>(a, l, 0, i_); }
  for (int l = 0; l < dd::DEPTH; ++l) {
    const bool last = (l == dd::DEPTH - 1);
    { TID_SETUP
      LAS float* scr = (LAS float*)(lds + RING_OFF + wave * 16384);
      constexpr int NIT = (dd::D / 64) * (dd::NIN / 32);
      for (int it = gw; it < NIT; it += NGW) { const int n0 = 32 * (it % (dd::NIN / 32));
        if (n0 == dd::O_GA) transpose_item(a.w_in + (size_t)l * dd::D * dd::NIN, dd::D, dd::NIN, ka.WgaT, -dd::O_GA, scr, it, lane);
        else transpose_item(a.w_in + (size_t)l * dd::D * dd::NIN, dd::D, dd::NIN, ka.WinT, n0 < dd::O_GA ? 0 : -32, scr, it, lane); }
      { constexpr int I0 = (dd::HW / 64) * (dd::D / 32), I1 = (dd::GVW / 64) * (dd::D / 32), I2 = (dd::AQW / 64) * (dd::D / 32), I3 = (dd::D / 64) * (dd::D / 32);
        for (int it = gw; it < I0 + I1 + I2 + I3; it += NGW) { int r = it;
          if (r < I0) { transpose_item(a.w_br_hy + (size_t)l * dd::HW * dd::D, dd::HW, dd::D, ka.WhyT, 0, scr, r, lane, 1024); continue; } r -= I0;
          if (r < I1) { transpose_item(a.w_br_gla + (size_t)l * dd::GVW * dd::D, dd::GVW, dd::D, ka.WglaT, 0, scr, r, lane, 1024); continue; } r -= I1;
          if (r < I2) { transpose_item(a.w_br_att + (size_t)l * dd::AQW * dd::D, dd::AQW, dd::D, ka.WattT, 0, scr, r, lane); continue; } r -= I2;
          transpose_item(a.w_out + (size_t)l * dd::D * dd::D, dd::D, dd::D, ka.WoutT, 0, scr, r, lane); } }
      { constexpr int IG = (dd::D / 64) * (dd::DE / 32), IDN = (dd::DE / 64) * (dd::D / 32);
        for (int it = gw; it < dd::NE * (2 * IG + IDN); it += NGW) { const int e = it / (2 * IG + IDN); int r = it % (2 * IG + IDN);
          if (r < 2 * IG) { const int up = r >= IG; if (up) r -= IG; const int n0 = 32 * (r % (dd::DE / 32));
            transpose_item((up ? a.moe_w_up : a.moe_w_gate) + ((size_t)l * dd::NE + e) * dd::D * dd::DE, dd::D, dd::DE, ka.WguT, e * 1024 + 128 * (n0 >> 7) + (up ? 128 : 0), scr, r, lane); }
          else { r -= 2 * IG; transpose_item(a.moe_w_down + ((size_t)l * dd::NE + e) * dd::DE * dd::D, dd::DE, dd::D, ka.WdT, e * 1024, scr, r, lane); } } }
      (void)gt;
    }
    pro::mod_phase(a, l, lds); pro::hid_phase(a, l, dd::S, a.hid2S, lds); if (!last) pro::hid_phase(a, l, dd::C, a.hid2C, lds);
    xcd_barrier(xb);
    pro::tapsB_phase(a, l, (bf16_t*)a.tapsS, lds); if (!last) LSTAGE(L_TAPS_C)
    xcd_barrier(xb);
    pro::nrmB_phase(a, (const bf16_t*)a.tapsS); if (!last) LSTAGE(L_NRM_C)
    xcd_barrier(xb);
    for (int grp = 0; grp < NGRP; ++grp) {
      const int b0 = grp * GB;
      { TID_SETUP
        for (int rg = gw; rg < RG; rg += NGW) { const int bl = rg / RB, r = rg % RB, b = b0 + bl; const float* md = a.mod + (size_t)(r < dd::S ? b : dd::B) * 6 * 1024;
          if (l == 0) norm_row<false>(xrow_in(a, 0, b, r), a.norm1_g, md, md + 1024, hb_s + (size_t)rg * 1024, lane);
          else norm_row<true>(ka.xs + ((size_t)grp * RG + rg) * 1024, a.norm1_g + (size_t)l * 1024, md, md + 1024, hb_s + (size_t)rg * 1024, lane); }
        xcd_barrier(xb); }
      { pg8::Gemm g{hb_s, ka.WinT, RG, NINP, dd::D, 0}; pg8::StaticOrder S; S.init(RG, NINP, (int)gridDim.x, (int)blockIdx.x); EpiProjBf16 E{proj_s};
        pg8::gemm_phase<EpiProjBf16, pg8::StaticOrder, false>((PG8_LAS unsigned char*)(lds + RING_OFF), g, S, E, nullptr);
        { int tq = threadIdx.x; asm volatile("" : "+v"(tq)); const int wv_ = __builtin_amdgcn_readfirstlane(tq >> 6);
          for (int wt = (int)blockIdx.x + (int)gridDim.x * wv_; wt < PANELS * 8; wt += (int)gridDim.x * NWAVES) ga_task(hb_s, ka.WgaT, proj_s, wt); }
        xcd_barrier(xb); }
      { TID_SETUP
        for (int rg = gw; rg < RG; rg += NGW) qknorm_row(proj_s + (size_t)rg * PLD, a.q_norm_g + (size_t)l * 128, a.k_norm_g + (size_t)l * 128, rg % RB, lane);
        for (int u = blockIdx.x; u < GB * 4 * 68; u += gridDim.x) { const int bl = u / (4 * 68), hu = u % (4 * 68); const bf16_t* pb = proj_s + (size_t)bl * RB * PLD;
          gla::In gp; gp.q = pb + dd::O_GQ; gp.k = pb + dd::O_GK; gp.v = pb + dd::O_GV; gp.ga = pb + dd::O_GA; gp.og = pb + dd::O_OG; gp.ld = PLD;
          gp.wa2 = a.gla_wa2 + (size_t)l * 2 * 16 * 256; gp.ba = a.gla_ba + (size_t)l * 2 * 256; gp.gnorm = a.gla_norm_g + (size_t)l * 128;
          gp.csb = (bf16_t*)(mix_s + (size_t)bl * CS_BYTES); gp.dec = (float*)(mix_s + (size_t)GB * CS_BYTES + (size_t)bl * DEC_BYTES); gp.y = (bf16_t*)pb + dd::O_OG; gp.ldy = PLD; gp.S = dd::S; gp.C = dd::C;
          gla::g1b_unit(gp, lds, hu / 68, hu % 68, 4, 68); }
        xcd_barrier(xb); }
      { TID_SETUP
        for (long i_ = gt; i_ < (long)GB * 2 * 4 * 64 * 64; i_ += gs) { const int bl = (int)(i_ / (2 * 4 * 64 * 64)); gla::In gp; gp.csb = (bf16_t*)(mix_s + (size_t)bl * CS_BYTES); gp.dec = (float*)(mix_s + (size_t)GB * CS_BYTES + (size_t)bl * DEC_BYTES); gp.S = dd::S; gp.C = dd::C;
          gla::g2_item(gp, i_ % (2 * 4 * 64 * 64), 4, 68); }
        const int combo = blockIdx.x & 7, slot = blockIdx.x >> 3, nslot = gridDim.x >> 3;
        const int per_combo = 64 + (last ? 0 : 4);
        const bool xcdm = (gridDim.x & 7) == 0;
        for (int uu = xcdm ? slot : (int)blockIdx.x; uu < (xcdm ? per_combo : 8 * per_combo); uu += xcdm ? nslot : (int)gridDim.x) { const int cmb = xcdm ? combo : uu / per_combo, ui = xcdm ? uu : uu % per_combo;
          const bool lat = ui < 64; const int bl = cmb >> 1, kvh = cmb & 1;
          const int head = kvh * 4 + (lat ? ui >> 4 : ui - 64), qb = lat ? ui & 15 : 0;
          bf16_t* pb = proj_s + (size_t)bl * RB * PLD; const size_t qrow = lat ? (size_t)qb * 256 : (size_t)dd::S, krow = lat ? 0 : (size_t)dd::S;
          att::attn_dense_body<att::bf16, PLD, PLD, PLD, true>((const att::bf16*)(pb + qrow * PLD + dd::O_AQ + head * 128), (const att::bf16*)(pb + krow * PLD + dd::O_AK + kvh * 128),
              (const att::bf16*)(pb + krow * PLD + dd::O_AV + kvh * 128), pb + qrow * PLD + dd::O_AQ + head * 128, lat ? RB : dd::C, (char*)lds_raw);
          __syncthreads(); }
        xcd_barrier(xb); }
      { const int n3 = last ? 64 : 68;
        for (int u = blockIdx.x; u < GB * 4 * n3; u += gridDim.x) { const int bl = u / (4 * n3), hu = u % (4 * n3); const bf16_t* pb = proj_s + (size_t)bl * RB * PLD;
          gla::In gp; gp.q = pb + dd::O_GQ; gp.k = pb + dd::O_GK; gp.v = pb + dd::O_GV; gp.ga = pb + dd::O_GA; gp.og = pb + dd::O_OG; gp.ld = PLD;
          gp.wa2 = a.gla_wa2 + (size_t)l * 2 * 16 * 256; gp.ba = a.gla_ba + (size_t)l * 2 * 256; gp.gnorm = a.gla_norm_g + (size_t)l * 128;
          gp.csb = (bf16_t*)(mix_s + (size_t)bl * CS_BYTES); gp.dec = (float*)(mix_s + (size_t)GB * CS_BYTES + (size_t)bl * DEC_BYTES); gp.y = (bf16_t*)pb + dd::O_OG; gp.ldy = PLD; gp.S = dd::S; gp.C = dd::C;
          gla::g3b_unit(gp, lds, hu / n3, hu % n3, 4, 68); }
        xcd_barrier(xb); }
      {
        bf16_t* ucT0 = (bf16_t*)mix_s; bf16_t* yT0 = (bf16_t*)(mix_s + GB * UCT_BYTES); float* ucc0 = (float*)(mix_s + GB * (UCT_BYTES + YT_BYTES)); float* z1c0 = (float*)(mix_s + GB * (UCT_BYTES + YT_BYTES + UCC_BYTES));
        const float* cw = a.hy_conv_w + (size_t)l * 3 * 1536; const float* cb = a.hy_conv_b + (size_t)l * 1536; const float* skp = a.hy_skip + (size_t)l * 2 * 512;
        { TID_SETUP
        { int t_ = blockIdx.x; hy::H0Regs hr = hy::h0_load(proj_s + (size_t)(t_ / (64 * 24)) * RB * PLD + dd::O_HY, PLD, t_ % (64 * 24), tz);
          for (; t_ < GB * 64 * 24; t_ += gridDim.x) { const int bl = t_ / (64 * 24), tn_ = t_ + gridDim.x; hy::H0Regs hn = hr;
            if (tn_ < GB * 64 * 24) hn = hy::h0_load(proj_s + (size_t)(tn_ / (64 * 24)) * RB * PLD + dd::O_HY, PLD, tn_ % (64 * 24), tz);
            hy::h0_compute(hr, cw, cb, ucT0 + (size_t)bl * 1536 * 4096, t_ % (64 * 24), lds, tz); hr = hn; } }
        if (!last) for (long i_ = gt; i_ < (long)GB * 256 * 1536; i_ += gs) { const int bl = (int)(i_ / (256 * 1536)); hy::cconv3_item(proj_s + ((size_t)bl * RB + dd::S) * PLD + dd::O_HY, PLD, cw, cb, ucc0 + (size_t)bl * 256 * 1536, i_ % (256 * 1536)); } }
        xcd_barrier(xb);
        { TID_SETUP
        for (int u = blockIdx.x; u < (GB / 2) * 512; u += gridDim.x) { const int bp_ = u / 512; hy::h1c_unit(ucT0 + (size_t)(2 * bp_) * 1536 * 4096, (const bf16_t*)a.tapsS, a.nrmS, skp, yT0 + (size_t)(2 * bp_) * 512 * 4096, u % 512, lds); }
        if (!last) for (long i_ = gt; i_ < (long)GB * 32 * 512; i_ += gs) { const int bl = (int)(i_ / (32 * 512)); hy::clong_item(ucc0 + (size_t)bl * 256 * 1536, nullptr, z1c0 + (size_t)bl * 256 * 512, nullptr, 0, a.tapsC, a.nrmC, skp, 0, i_ % (32 * 512)); } }
        xcd_barrier(xb);
        { TID_SETUP
        for (int t_ = blockIdx.x; t_ < GB * 64 * 8; t_ += gridDim.x) { const int bl = t_ / (64 * 8); hy::h2_tile(yT0 + (size_t)bl * 512 * 4096, proj_s + (size_t)bl * RB * PLD + dd::O_HY, PLD, t_ % (64 * 8), lds); }
        if (!last) for (long i_ = gt; i_ < (long)GB * 32 * 512; i_ += gs) { const int bl = (int)(i_ / (32 * 512)); hy::clong_item(ucc0 + (size_t)bl * 256 * 1536, z1c0 + (size_t)bl * 256 * 512, nullptr, proj_s + ((size_t)bl * RB + dd::S) * PLD + dd::O_HY, PLD, a.tapsC, a.nrmC, skp, 1, i_ % (32 * 512)); } }
        xcd_barrier(xb); }
      { { pg8::Gemm g{proj_s, ka.WhyT, RG, 1024, 1024, PLD, 1024}; MergeOrder S; S.init((int)gridDim.x, (int)blockIdx.x, last); EpiMergeS E{(const unsigned char*)(proj_s + dd::O_BR), (bf16_t*)mix_s};
          pg8::gemm_phase<EpiMergeS, MergeOrder, false>((PG8_LAS unsigned char*)(lds + RING_OFF), g, S, E, nullptr); }
        xcd_barrier(xb);
        pg8::Gemm g{(const bf16_t*)mix_s, ka.WoutT, RG, 1024, 1024, 0}; GroupOrder S; S.init(1024, (int)gridDim.x, (int)blockIdx.x, last);
        EpiOutG E{a.x, a.ctx, ka.xs + (size_t)grp * RG * 1024, a.mod, b0, !last, l != 0};
        pg8::gemm_phase<EpiOutG, GroupOrder, false>((PG8_LAS unsigned char*)(lds + RING_OFF), g, S, E, nullptr);
        xcd_barrier(xb); }
      {
        { TID_SETUP int* cnt = ka.cnt + (l * NGRP + grp) * 1024;
          LAS bf16_t* wfr = (LAS bf16_t*)(lds + RING_OFF);
          for (int i_ = tz; i_ < 1024 * 16; i_ += NTHREADS) { const int k = i_ >> 4, e = i_ & 15; const float w = a.router_w[i_]; const unsigned hi = f2bf(w); const unsigned lo = f2bf(w - __uint_as_float(hi << 16));
            const int idx = (((k >> 5) * 64 + ((k >> 3) & 3) * 16 + e) << 3) + (k & 7); wfr[idx] = (bf16_t)hi; wfr[16384 + idx] = (bf16_t)lo; }
          LAS int* lcnt = (LAS int*)(lds + RING_OFF + 65536);
          if (tz < 32) lcnt[tz] = 0;
          LAS float* ptab = (LAS float*)(lds + RING_OFF + 65536 + 1024);
          for (int i_ = tz; i_ < 5 * 1024; i_ += NTHREADS) { const int v_ = i_ >> 10, c_ = i_ & 1023; const float* md = a.mod + (size_t)(v_ < GB ? b0 + v_ : dd::B) * 6 * 1024;
            const float g_ = a.norm2_g[(size_t)l * 1024 + c_]; ptab[v_ * 2048 + c_] = g_ * md[4 * 1024 + c_] + g_; ptab[v_ * 2048 + 1024 + c_] = md[3 * 1024 + c_]; }
          __syncthreads();
          const int wv_ = __builtin_amdgcn_readfirstlane(tz >> 6);
          for (int t_ = (int)blockIdx.x + (int)gridDim.x * wv_; t_ < RG / 16; t_ += (int)gridDim.x * NWAVES) { const int rg = 16 * t_, bl = rg / RB, r = rg % RB, b = b0 + bl; if (last && r >= dd::S) continue;
            const LAS float* pt_ = ptab + (r < dd::S ? bl : GB) * 2048; (void)b;
            moe::route16(ka.xs + ((size_t)grp * RG + rg) * 1024, pt_, pt_ + 1024, hb_s + (size_t)rg * 1024, (const LAS v4u*)wfr, a.router_b, lcnt, ka.route + rg, ka.wts + 2 * rg, lane); }
          __syncthreads();
          if (tz < 16) lcnt[16 + tz] = atomicAdd(cnt + tz * 64, lcnt[tz]);
          __syncthreads();
          for (int t_ = (int)blockIdx.x + (int)gridDim.x * wv_; t_ < RG / 16; t_ += (int)gridDim.x * NWAVES) { const int rg = 16 * t_; if (last && (rg % RB) >= dd::S) continue;
            if (lane < 16) { moe::Route* rt = ka.route + rg + lane; moe::Route r_ = *rt; r_.r0 += lcnt[16 + r_.e0]; r_.r1 += lcnt[16 + r_.e1]; *rt = r_; } }
          xcd_barrier(xb); }
        { TID_SETUP int* cnt = ka.cnt + (l * NGRP + grp) * 1024;
          if (tz == 0) { int acc_ = 0; for (int e = 0; e < 16; ++e) { poff[e] = acc_; acc_ += (cnt[e * 64] + 255) >> 8; } poff[16] = acc_; }
          __syncthreads();
          for (int rg = gw; rg < RG; rg += NGW) { if (last && (rg % RB) >= dd::S) continue; const moe::Route rt = ka.route[rg];
            const v4u h0 = *(const v4u*)(hb_s + (size_t)rg * 1024 + lane * 16), h1 = *(const v4u*)(hb_s + (size_t)rg * 1024 + lane * 16 + 8);
#pragma unroll
            for (int sl = 0; sl < 2; ++sl) { const int e = sl ? rt.e1 : rt.e0, rk = sl ? rt.r1 : rt.r0; const size_t dst = (size_t)poff[e] * 256 + rk;
              *(v4u*)(ka.hp + dst * 1024 + lane * 16) = h0; *(v4u*)(ka.hp + dst * 1024 + lane * 16 + 8) = h1;
              if (lane == 0) { ka.srcrow[dst] = 2 * rg + sl; ka.wgt[dst] = ka.wts[2 * rg + sl]; } } }
          for (int e = 0; e < 16; ++e) { const int c_ = cnt[e * 64], pe = ((c_ + 255) >> 8) << 8; for (int p_ = c_ + (int)gt; p_ < pe; p_ += (int)gs) ka.srcrow[(size_t)poff[e] * 256 + p_] = -1; }
          xcd_barrier(xb); }
        { pg8::Gemm g{ka.hp, ka.WguT, 0, 0, 1024, 0}; moe::MoeOrder S{(int)gridDim.x, (int)blockIdx.x, 4, poff}; moe::EpiGU E{ka.hid};
          pg8::gemm_phase<moe::EpiGU, moe::MoeOrder, false>((PG8_LAS unsigned char*)(lds + RING_OFF), g, S, E, nullptr);
          xcd_barrier(xb); }
        { pg8::Gemm g{ka.hid, ka.WdT, 0, 0, 512, 0}; moe::MoeOrder S{(int)gridDim.x, (int)blockIdx.x, 4, poff}; moe::EpiDown E{ka.srcrow, ka.wgt, ka.contrib, (size_t)RG * 1024};
          pg8::gemm_phase<moe::EpiDown, moe::MoeOrder, false>((PG8_LAS unsigned char*)(lds + RING_OFF), g, S, E, nullptr);
          xcd_barrier(xb); }
        { TID_SETUP
          bf16_t* xsg = ka.xs + (size_t)grp * RG * 1024;
#pragma unroll 2
          for (long i_ = gt; i_ < (long)RG * 128; i_ += gs) { const int rg = (int)(i_ >> 7), c8 = (int)(i_ & 127) * 8; const int bl = rg / RB, r = rg % RB, b = b0 + bl; if (last && r >= dd::S) continue;
            const float* g2 = a.mod + (size_t)(r < dd::S ? b : dd::B) * 6 * 1024 + 5 * 1024 + c8;
            const v4u u0 = *(const v4u*)(ka.contrib + (size_t)rg * 1024 + c8), u1 = *(const v4u*)(ka.contrib + (size_t)RG * 1024 + (size_t)rg * 1024 + c8), xo = *(const v4u*)(xsg + (size_t)rg * 1024 + c8);
            const pg8::f32x4 ga_ = *(const pg8::f32x4*)g2, gb_ = *(const pg8::f32x4*)(g2 + 4);
            pg8::f32x4 ya, yb;
            ya[0] = __uint_as_float(xo.x << 16) + ga_[0] * (__uint_as_float(u0.x << 16) + __uint_as_float(u1.x << 16)); ya[1] = __uint_as_float(xo.x & 0xffff0000u) + ga_[1] * (__uint_as_float(u0.x & 0xffff0000u) + __uint_as_float(u1.x & 0xffff0000u));
            ya[2] = __uint_as_float(xo.y << 16) + ga_[2] * (__uint_as_float(u0.y << 16) + __uint_as_float(u1.y << 16)); ya[3] = __uint_as_float(xo.y & 0xffff0000u) + ga_[3] * (__uint_as_float(u0.y & 0xffff0000u) + __uint_as_float(u1.y & 0xffff0000u));
            yb[0] = __uint_as_float(xo.z << 16) + gb_[0] * (__uint_as_float(u0.z << 16) + __uint_as_float(u1.z << 16)); yb[1] = __uint_as_float(xo.z & 0xffff0000u) + gb_[1] * (__uint_as_float(u0.z & 0xffff0000u) + __uint_as_float(u1.z & 0xffff0000u));
            yb[2] = __uint_as_float(xo.w << 16) + gb_[2] * (__uint_as_float(u0.w << 16) + __uint_as_float(u1.w << 16)); yb[3] = __uint_as_float(xo.w & 0xffff0000u) + gb_[3] * (__uint_as_float(u0.w & 0xffff0000u) + __uint_as_float(u1.w & 0xffff0000u));
            if (last) { float* o = a.out + ((size_t)b * dd::S + r) * 1024 + c8; *(pg8::f32x4*)o = ya; *(pg8::f32x4*)(o + 4) = yb; }
            else { v4u w; w.x = pk2(ya[0], ya[1]); w.y = pk2(ya[2], ya[3]); w.z = pk2(yb[0], yb[1]); w.w = pk2(yb[2], yb[3]); *(v4u*)(xsg + (size_t)rg * 1024 + c8) = w; } }
          xcd_barrier(xb); }
      }
    }
  }
}
extern "C" void kernel_launch(void* const* d_in, const int* in_sizes, int n_in, void* d_out, int out_size, void* d_ws, size_t ws_size, hipStream_t stream) {
  static int grid = 0;
  if (!grid) {
    int dev = 0, cus = 0, per_cu = 0;
    (void)hipGetDevice(&dev); (void)hipDeviceGetAttribute(&cus, hipDeviceAttributeMultiprocessorCount, dev);
    (void)hipFuncSetAttribute((const void*)mega_kernel, hipFuncAttributeMaxDynamicSharedMemorySize, LDS_BYTES);
    (void)hipOccupancyMaxActiveBlocksPerMultiprocessor(&per_cu, mega_kernel, NTHREADS, LDS_BYTES);
    if (per_cu < 1) fprintf(stderr, "occupancy query says %d\n", per_cu);
    grid = cus;
  }
  KArgs ka{}; const float* ptrs[33]; for (int i = 0; i < 33; ++i) ptrs[i] = (const float*)d_in[i];
  set_inputs<TD>(ka.a, ptrs);
  char* wsb = (char*)d_ws; size_t off = BAR_BYTES;
  auto take = [&](size_t bytes) { char* p = wsb + off; off += (bytes + 255) & ~(size_t)255; return p; };
  NaiveBufs& a = ka.a;
  a.mod = (float*)take((size_t)(dd::B + 1) * 6 * 1024 * 4); a.hid2S = (float*)take((size_t)dd::S * 64 * 4); a.hid2C = (float*)take((size_t)dd::C * 64 * 4);
  a.tapsS = (float*)take((size_t)2 * 512 * 2 * 8232 * 2 + 64); a.tapsC = (float*)take((size_t)2 * 512 * 512 * 4); a.nrmS = (float*)take(1024 * 4); a.nrmC = (float*)take(1024 * 4);
  ka.xs = (bf16_t*)take((size_t)dd::B * RB * 1024 * 2);
  ka.WgaT = (bf16_t*)take((size_t)32 * 1024 * 2); ka.WinT = (bf16_t*)take((size_t)NINP * 1024 * 2); ka.WhyT = (bf16_t*)take((size_t)1024 * 1024 * 2); ka.WglaT = (bf16_t*)take((size_t)1024 * 1024 * 2); ka.WattT = (bf16_t*)take((size_t)1024 * 1024 * 2);
  ka.WoutT = (bf16_t*)take((size_t)1024 * 1024 * 2); ka.WguT = (bf16_t*)take((size_t)16 * 1024 * 1024 * 2); ka.WdT = (bf16_t*)take((size_t)16 * 1024 * 512 * 2);
  ka.hb = (bf16_t*)take((size_t)RG * 1024 * 2); ka.mix = (unsigned char*)take(MIX_BYTES);
  ka.proj = (bf16_t*)take((size_t)RG * PLD * 2);
  { char* p = (char*)ka.proj; ka.hp = (bf16_t*)p; p += (size_t)MPG * 1024 * 2; ka.hid = (bf16_t*)p; p += (size_t)MPG * 512 * 2; ka.contrib = (bf16_t*)p; p += (size_t)2 * RG * 1024 * 2;
    ka.srcrow = (int*)p; p += (size_t)MPG * 4; ka.wgt = (float*)p; p += (size_t)MPG * 4; ka.route = (moe::Route*)p; p += (size_t)RG * 16; ka.wts = (float*)p; p += (size_t)RG * 8;
    if ((size_t)(p - (char*)ka.proj) > (size_t)RG * PLD * 2) fprintf(stderr, "MoE alias region too large\n"); }
  a.out = (float*)d_out; ka.bar = (unsigned*)d_ws; ka.cnt = (int*)(wsb + CNT_OFF);
  if (off > ws_size) fprintf(stderr, "workspace too small: need %zu have %zu\n", off, ws_size);
  (void)hipMemsetAsync(d_ws, 0, BAR_BYTES, stream);
  hipLaunchKernelGGL(mega_kernel, dim3(grid), dim3(NTHREADS), LDS_BYTES, stream, ka);
}
```

```cpp
#include <hip/hip_runtime.h>
#include <cstddef>
#include <cstdio>
#include <cstdint>
#include <hip/hip_bf16.h>
#include <hip/hip_runtime.h>
namespace pg8 {
#define PG8_LAS __attribute__((address_space(3)))
typedef unsigned short bf16_t;
typedef short bf16x8 __attribute__((ext_vector_type(8)));
typedef float f32x4 __attribute__((ext_vector_type(4)));
typedef unsigned u32x4 __attribute__((ext_vector_type(4)));
constexpr int BM = 256, BK = 64, HALF = 128, HTB = HALF * BK * 2  , STAGE_BYTES = 8 * HTB, NXCD = 8, WGM = 8;

__host__ __device__ __forceinline__ int lds_byte(int r, int c) { const int st = (r >> 4) * 2 + (c >> 5), rr = r & 15, cc = c & 31, ob = rr * 64 + cc * 2; return st * 1024 + (ob ^ (((ob >> 9) & 1) << 5)); }
__host__ __device__ __forceinline__ void stage_rc(int b, int& R, int& C) { const int st = b / 1024, sb = b % 1024, swz = sb ^ (((sb >> 9) & 1) << 5); R = (st >> 1) * 16 + swz / 64; C = (st & 1) * 32 + (swz % 64) / 2; }
__host__ __device__ __forceinline__ int perm32(int rho) { const int n = rho >> 4, i = rho & 15; return 8 * (i >> 2) + 4 * n + (i & 3); }

struct Unit { int pm, pn, acol, nt; };
struct Gemm { const bf16_t* A; const bf16_t* Bt; int M, N, K; int lda; int ldb; };

struct StaticOrder {
    int nM, nN, nwg, G, c;
    __host__ __device__ void init(int M, int N, int G_, int c_) { nM = M / BM; nN = N / BM; nwg = nM * nN; G = G_; c = c_; }
    __host__ __device__ bool next(int i, Unit& u) const {
        const long L = (long)i * G + c; if (L >= nwg) return false;
        int wgid = (int)L; { const int q = nwg / NXCD, r = nwg % NXCD, xcd = wgid % NXCD, off = wgid / NXCD; wgid = (xcd < r ? xcd * (q + 1) : r * (q + 1) + (xcd - r) * q) + off; }
        const int nig = WGM * nN, gid = wgid / nig, fm = gid * WGM, gsz = (nM - fm) < WGM ? (nM - fm) : WGM;
        u.pm = fm + ((wgid % nig) % gsz); u.pn = (wgid % nig) / gsz; u.acol = 0; u.nt = 0; return true;
    }
    __device__ __forceinline__ void a_ready(const Unit&) const {}
    __device__ __forceinline__ void done(const Unit&) const {}
};
__device__ __forceinline__ unsigned cvt_pk_bf16(float lo, float hi) { unsigned r; asm volatile("v_cvt_pk_bf16_f32 %0, %1, %2" : "=v"(r) : "v"(lo), "v"(hi)); return r; }
typedef float f32x2 __attribute__((ext_vector_type(2)));
template <class Epi, class Sched, bool STAMP = false>
__device__ __forceinline__ void gemm_phase(PG8_LAS unsigned char* lds, const Gemm g, const Sched& S, const Epi& E, unsigned long long* stamps) {
    int tid = threadIdx.x; asm volatile("" : "+v"(tid)); const int wid = __builtin_amdgcn_readfirstlane(tid >> 6), lane = tid & 63, wr = wid >> 2, wc = wid & 3, fr = lane & 15, fq = lane >> 4;
    const int K = g.K, nt = K / BK, LDA = g.lda ? g.lda : g.K, LDB = g.ldb ? g.ldb : g.K;
    int ts_lo = 0, ts_hi = 0, nts = 0; const unsigned long long rt_entry = STAMP ? (unsigned long long)wall_clock64() : 0ull;
#define PG8_STAMP() do { if (STAMP && wid == 0 && nts < 64) { const unsigned long long _c = (unsigned long long)clock64(); \
        ts_lo = (lane == nts) ? (int)(unsigned)_c : ts_lo; ts_hi = (lane == nts) ? (int)(unsigned)(_c >> 32) : ts_hi; ++nts; } } while (0)
    PG8_STAMP();
    unsigned voffA[2], voffB[2];
#pragma unroll
    for (int i = 0; i < 2; ++i) { int R, C; stage_rc(tid * 16 + i * 8192, R, C); const int Rb = Epi::PERM ? ((R & ~31) + perm32(R & 31)) : R;
        voffA[i] = (unsigned)(R * LDA + C) * 2u; voffB[i] = (unsigned)(Rb * LDB + C) * 2u; }
    const size_t kstep = (size_t)(BK * 2);
    const size_t hstep = (size_t)HALF * LDB * 2;
    const size_t tstep = 2 * hstep;
    const size_t hstepA = (size_t)HALF * LDA * 2, tstepA = 2 * hstepA;
    const unsigned ldsw = (unsigned)wid * 1024u;
    const int aoff = lds_byte(wr * 64 + fr, fq * 8), boff = lds_byte(wc * 32 + fr, fq * 8);
#define PG8_SA(b, h) (((b) * 2 + (h)) * HTB)
#define PG8_SB(b, h) ((4 + (b) * 2 + (h)) * HTB)
#define PG8_STAGE(bufoff, gbase, voff) do { _Pragma("unroll") for (int _i = 0; _i < 2; ++_i) \
        __builtin_amdgcn_global_load_lds((const unsigned*)((const char*)(gbase) + (voff)[_i]), (PG8_LAS unsigned*)(lds + (bufoff) + ldsw + _i * 8192), 16, 0, 0); } while (0)
#define PG8_LDA(dst, b, h) do { _Pragma("unroll") for (int m = 0; m < 4; ++m) _Pragma("unroll") for (int k = 0; k < 2; ++k) dst[m][k] = *(const PG8_LAS bf16x8*)(lds + PG8_SA(b, h) + aoff + m * 2048 + k * 1024); } while (0)
#define PG8_LDB(dst, b, h) do { _Pragma("unroll") for (int n = 0; n < 2; ++n) _Pragma("unroll") for (int k = 0; k < 2; ++k) dst[n][k] = *(const PG8_LAS bf16x8*)(lds + PG8_SB(b, h) + boff + n * 2048 + k * 1024); } while (0)
#define PG8_MMA(ai, bj, At, Bt) do { __builtin_amdgcn_s_setprio(1); _Pragma("unroll") for (int m = 0; m < 4; ++m) _Pragma("unroll") for (int n = 0; n < 2; ++n) _Pragma("unroll") for (int k = 0; k < 2; ++k) \
        acc[ai][bj][m][n] = __builtin_amdgcn_mfma_f32_16x16x32_bf16(Bt[n][k], At[m][k], acc[ai][bj][m][n], 0, 0, 0); __builtin_amdgcn_s_setprio(0); } while (0)
#define PG8_WAIT_V(n) asm volatile("s_waitcnt vmcnt(" #n ")" ::: "memory")
#define PG8_WAIT_L(n) asm volatile("s_waitcnt lgkmcnt(" #n ")" ::: "memory")
#define PG8_BAR __builtin_amdgcn_s_barrier()
#define PG8_SCHED __builtin_amdgcn_sched_barrier(0)
    Unit cur, nxt; int ui = 0;
    if (!S.next(0, cur)) return;
    f32x4 acc[2][2][4][2];
#pragma unroll
    for (int a = 0; a < 2; ++a)
#pragma unroll
        for (int b = 0; b < 2; ++b)
#pragma unroll
            for (int m = 0; m < 4; ++m)
#pragma unroll
                for (int n = 0; n < 2; ++n) acc[a][b][m][n] = (f32x4){0.f, 0.f, 0.f, 0.f};
    bf16x8 At[4][2], B0[2][2], B1[2][2];
    const char* cA = (const char*)g.A + (size_t)cur.pm * tstepA + (size_t)cur.acol * 2; const char* cB = (const char*)g.Bt + (size_t)cur.pn * tstep;
    S.a_ready(cur);
    PG8_STAGE(PG8_SB(0, 0), cB, voffB); PG8_STAGE(PG8_SA(0, 0), cA, voffA); PG8_STAGE(PG8_SB(0, 1), cB + hstep, voffB); PG8_STAGE(PG8_SA(0, 1), cA + hstepA, voffA);
    if (wr == 1) PG8_BAR;
    PG8_WAIT_V(4); PG8_BAR;
    PG8_STAGE(PG8_SB(1, 0), cB + kstep, voffB); PG8_STAGE(PG8_SA(1, 0), cA + kstep, voffA); PG8_STAGE(PG8_SB(1, 1), cB + hstep + kstep, voffB);
    PG8_WAIT_V(6); PG8_BAR;
    PG8_STAMP();
    for (;;) {
        const bool has_next = S.next(ui + 1, nxt);
        const char* nA = has_next ? (const char*)g.A + (size_t)nxt.pm * tstepA + (size_t)nxt.acol * 2 : cA; const char* nB = has_next ? (const char*)g.Bt + (size_t)nxt.pn * tstep : cB;
        const int ntu = cur.nt ? cur.nt : nt;
        for (int t = 0; t < ntu; t += 2) {
            const bool last = (t == ntu - 2);
            const char* a1 = cA + (size_t)(t + 1) * kstep;
            const char* a2 = last ? nA : cA + (size_t)(t + 2) * kstep; const char* b2 = last ? nB : cB + (size_t)(t + 2) * kstep;
            const char* a3 = a2 + kstep; const char* b3 = b2 + kstep;
            if (last && has_next) S.a_ready(nxt);
            PG8_LDB(B0, 0, 0); PG8_SCHED; PG8_LDA(At, 0, 0); PG8_STAGE(PG8_SA(1, 1), a1 + hstepA, voffA);
            PG8_WAIT_L(8); PG8_BAR; PG8_WAIT_L(0); PG8_MMA(0, 0, At, B0); PG8_BAR; PG8_SCHED;
            PG8_LDB(B1, 0, 1); PG8_STAGE(PG8_SB(0, 0), b2, voffB);
            PG8_BAR; PG8_WAIT_L(0); PG8_MMA(0, 1, At, B1); PG8_BAR;
            PG8_LDA(At, 0, 1); PG8_STAGE(PG8_SA(0, 0), a2, voffA);
            PG8_BAR; PG8_WAIT_L(0); PG8_MMA(1, 0, At, B0); PG8_BAR; PG8_SCHED;
            PG8_STAGE(PG8_SB(0, 1), b2 + hstep, voffB);
            PG8_WAIT_V(6); PG8_BAR; PG8_MMA(1, 1, At, B1); PG8_BAR;
            PG8_LDB(B0, 1, 0); PG8_SCHED; PG8_LDA(At, 1, 0); PG8_STAGE(PG8_SA(0, 1), a2 + hstepA, voffA);
            PG8_WAIT_L(8); PG8_BAR; PG8_WAIT_L(0); PG8_MMA(0, 0, At, B0); PG8_BAR; PG8_SCHED;
            PG8_LDB(B1, 1, 1); PG8_STAGE(PG8_SB(1, 0), b3, voffB);
            PG8_BAR; PG8_WAIT_L(0); PG8_MMA(0, 1, At, B1); PG8_BAR;
            PG8_LDA(At, 1, 1); PG8_STAGE(PG8_SA(1, 0), a3, voffA);
            PG8_BAR; PG8_WAIT_L(0); PG8_MMA(1, 0, At, B0); PG8_BAR; PG8_SCHED;
            PG8_STAGE(PG8_SB(1, 1), b3 + hstep, voffB);
            PG8_WAIT_V(6); PG8_BAR; PG8_MMA(1, 1, At, B1); PG8_BAR;
        }
        PG8_STAMP();
        if constexpr (!Epi::AFTER_DRAIN) { E(acc, cur, wr, wc, fr, fq); S.done(cur); }
        PG8_STAMP();
        if (!has_next) break;
#pragma unroll
        for (int a = 0; a < 2; ++a)
#pragma unroll
            for (int b = 0; b < 2; ++b)
#pragma unroll
                for (int m = 0; m < 4; ++m)
#pragma unroll
                    for (int n = 0; n < 2; ++n) acc[a][b][m][n] = (f32x4){0.f, 0.f, 0.f, 0.f};
        cur = nxt; cA = nA; cB = nB; ++ui;
    }
    PG8_WAIT_V(0);
    if (wr == 0) PG8_BAR;
    PG8_BAR;
    if constexpr (Epi::AFTER_DRAIN) { E.fused(acc, cur, wr, wc, fr, fq, lds, wid, lane); S.done(cur); }
    PG8_STAMP();
    if (STAMP && wid == 0) { stamps[lane] = lane < nts ? (((unsigned long long)(unsigned)ts_hi << 32) | (unsigned)ts_lo) : 0ull;
        if (lane == 62) stamps[62] = rt_entry; if (lane == 63) stamps[63] = (unsigned long long)wall_clock64(); }
#undef PG8_STAMP
#undef PG8_SA
#undef PG8_SB
#undef PG8_STAGE
#undef PG8_LDA
#undef PG8_LDB
#undef PG8_MMA
#undef PG8_WAIT_V
#undef PG8_WAIT_L
#undef PG8_BAR
#undef PG8_SCHED
}
}

#define LAS __attribute__((address_space(3)))
typedef unsigned short bf16_t;
constexpr int NWAVES = 8, NTHREADS = 512;
constexpr int LDS_BYTES = 147456;
constexpr int RING_OFF = 0;
constexpr int MISC_OFF = 131072;
constexpr int NINP = 7680;

__device__ __forceinline__ unsigned f2bf(float f) { unsigned u = __builtin_bit_cast(unsigned, f); return (u + 0x7fffu + ((u >> 16) & 1u)) >> 16; }
__device__ __forceinline__ unsigned pk2(float lo, float hi) { return f2bf(lo) | (f2bf(hi) << 16); }
typedef __bf16 bf16x2_t __attribute__((ext_vector_type(2))); typedef float f32x2_t __attribute__((ext_vector_type(2)));
__device__ __forceinline__ unsigned pk2h(float lo, float hi) { const f32x2_t v = {lo, hi}; return __builtin_bit_cast(unsigned, __builtin_convertvector(v, bf16x2_t)); }
__device__ __forceinline__ float bf2f(bf16_t b) { return __builtin_bit_cast(float, ((unsigned)b) << 16); }
typedef unsigned v4u __attribute__((ext_vector_type(4)));

__device__ __forceinline__ void transpose_item(const float* W, int K, int N, bf16_t* WT, int row_off, LAS float* scr, int item, int lane, int ldo = 0) {
  if (ldo == 0) ldo = K;
  const int nblk = N / 32, kb = item / nblk, nb = item % nblk, k0 = 64 * kb, n0 = 32 * nb;
  float wreg[32];
#pragma unroll
  for (int i = 0; i < 32; ++i) { const int kk = 2 * i + (lane >> 5); wreg[i] = W[(size_t)(k0 + kk) * N + n0 + (lane & 31)]; }
#pragma unroll
  for (int i = 0; i < 32; ++i) { const int kk = 2 * i + (lane >> 5); scr[kk * 33 + (lane & 31)] = wreg[i]; }
  asm volatile("s_waitcnt lgkmcnt(0)" ::: "memory");
  const int c = lane & 7;
#pragma unroll
  for (int j = 0; j < 4; ++j) { const int n = (lane >> 3) + 8 * j; const LAS float* s = scr + (8 * c) * 33 + n;
    v4u o; o.x = pk2(s[0 * 33], s[1 * 33]); o.y = pk2(s[2 * 33], s[3 * 33]); o.z = pk2(s[4 * 33], s[5 * 33]); o.w = pk2(s[6 * 33], s[7 * 33]);
    *(v4u*)(WT + (size_t)(row_off + n0 + n) * ldo + k0 + 8 * c) = o; }
  asm volatile("s_waitcnt lgkmcnt(0)" ::: "memory");
}

struct EpiProjF32 {
  static constexpr bool PERM = false, AFTER_DRAIN = false;
  float* C; int ldc; int ncols;
  __device__ __forceinline__ void operator()(const pg8::f32x4 (&acc)[2][2][4][2], const pg8::Unit& u, int wr, int wc, int fr, int fq) const {
    const int row0 = u.pm * 256 + wr * 64 + fr, col0 = u.pn * 256 + wc * 32 + 4 * fq;
#pragma unroll
    for (int ai = 0; ai < 2; ++ai)
#pragma unroll
      for (int m = 0; m < 4; ++m) { float* rowp = C + (size_t)(row0 + ai * 128 + m * 16) * ldc + col0;
#pragma unroll
        for (int bj = 0; bj < 2; ++bj)
#pragma unroll
          for (int n = 0; n < 2; ++n) if (col0 + bj * 128 + n * 16 < ncols) *(pg8::f32x4*)(rowp + bj * 128 + n * 16) = acc[ai][bj][m][n]; }
  }
};

__device__ __forceinline__ float fsigmoid(float x) { return 1.f / (1.f + __expf(-x)); }
template <bool ACCUM> struct EpiMerge {
  static constexpr bool PERM = true, AFTER_DRAIN = false;
  const float* gate; int ldg; bf16_t* M; int ldm;
  __device__ __forceinline__ void operator()(const pg8::f32x4 (&acc)[2][2][4][2], const pg8::Unit& u, int wr, int wc, int fr, int fq) const {
    const int row0 = u.pm * 256 + wr * 64 + fr, col0 = u.pn * 256 + wc * 32 + 8 * fq;
#pragma unroll
    for (int ai = 0; ai < 2; ++ai)
#pragma unroll
      for (int m = 0; m < 4; ++m) { const size_t r = (size_t)(row0 + ai * 128 + m * 16);
#pragma unroll
        for (int bj = 0; bj < 2; ++bj) { const int c = col0 + bj * 128;
          const pg8::f32x4 g0 = *(const pg8::f32x4*)(gate + r * ldg + c), g1 = *(const pg8::f32x4*)(gate + r * ldg + c + 4);
          pg8::f32x4 v0 = acc[ai][bj][m][0], v1 = acc[ai][bj][m][1];
#pragma unroll
          for (int e = 0; e < 4; ++e) { v0[e] *= fsigmoid(g0[e]); v1[e] *= fsigmoid(g1[e]); }
          v4u* dst = (v4u*)(M + r * ldm + c);
          if (ACCUM) { const v4u o = *dst; v0[0] += bf2f(o.x & 0xffff); v0[1] += bf2f(o.x >> 16); v0[2] += bf2f(o.y & 0xffff); v0[3] += bf2f(o.y >> 16);
            v1[0] += bf2f(o.z & 0xffff); v1[1] += bf2f(o.z >> 16); v1[2] += bf2f(o.w & 0xffff); v1[3] += bf2f(o.w >> 16); }
          v4u o2; o2.x = pk2(v0[0], v0[1]); o2.y = pk2(v0[2], v0[3]); o2.z = pk2(v1[0], v1[1]); o2.w = pk2(v1[2], v1[3]); *dst = o2; } }
  }
};
struct EpiOut {
  static constexpr bool PERM = false, AFTER_DRAIN = false;
  const float* resL; float* outL; const float* gL;
  const float* resC; float* outC; const float* gC;
  __device__ __forceinline__ void operator()(const pg8::f32x4 (&acc)[2][2][4][2], const pg8::Unit& u, int wr, int wc, int fr, int fq) const {
    const bool isc = u.pm == 16; if (isc && outC == nullptr) return;
    const float* res = isc ? resC : resL; float* out = isc ? outC : outL; const float* gv = isc ? gC : gL;
    const int row0 = (isc ? 0 : u.pm * 256) + wr * 64 + fr, col0 = u.pn * 256 + wc * 32 + 4 * fq;
    pg8::f32x4 gg[2][2];
#pragma unroll
    for (int bj = 0; bj < 2; ++bj)
#pragma unroll
      for (int n = 0; n < 2; ++n) gg[bj][n] = *(const pg8::f32x4*)(gv + col0 + bj * 128 + n * 16);
#pragma unroll
    for (int ai = 0; ai < 2; ++ai)
#pragma unroll
      for (int m = 0; m < 4; ++m) { const size_t ro = (size_t)(row0 + ai * 128 + m * 16) * 1024 + col0;
#pragma unroll
        for (int bj = 0; bj < 2; ++bj)
#pragma unroll
          for (int n = 0; n < 2; ++n) { const pg8::f32x4 rv = *(const pg8::f32x4*)(res + ro + bj * 128 + n * 16); *(pg8::f32x4*)(out + ro + bj * 128 + n * 16) = rv + gg[bj][n] * acc[ai][bj][m][n]; } }
  }
};
namespace att {
using bf16 = __hip_bfloat16;
constexpr int D = 128, NW = 8, QBLK = 32, KVBLK = 64; constexpr float SCALE = 0.088388347648318440f; constexpr float THR = 8.f; constexpr int SDEPTH = 2;
constexpr size_t SHM_V = KVBLK * D * 2, SHM_K = KVBLK * D * 2, SHM_ATTN = 2 * SHM_V + 2 * SHM_K + NW * 64 * 4;
using bf16x8 = __attribute__((ext_vector_type(8))) short;
using s16x4  = __attribute__((ext_vector_type(4))) short;
using f32x16 = __attribute__((ext_vector_type(16))) float;
using f32x8  = __attribute__((ext_vector_type(8))) float;
using u32x4  = __attribute__((ext_vector_type(4))) unsigned;
#define KSWZ(row, colB) ((row) * 256 + ((colB) ^ (((row) & 7) << 4)))
#define SBAR() __builtin_amdgcn_sched_barrier(0)
__device__ __forceinline__ int crow(int r, int hi) { return (r & 3) + 8 * (r >> 2) + 4 * hi; }
__device__ __forceinline__ unsigned cvtpk(float lo, float hi) {
  unsigned r; asm volatile("v_cvt_pk_bf16_f32 %0, %1, %2" : "=v"(r) : "v"(lo), "v"(hi)); return r;
}
template <typename TIn> struct Stage;
template <> struct Stage<bf16>  { using T = bf16x8;
  __device__ static __forceinline__ T ld8(const bf16* p) { return *reinterpret_cast<const bf16x8*>(p); }
  __device__ static __forceinline__ bf16x8 tobf(T x) { return x; } };
template <> struct Stage<float> { using T = f32x8;
  __device__ static __forceinline__ T ld8(const float* p) { return *reinterpret_cast<const f32x8*>(p); }
  __device__ static __forceinline__ bf16x8 tobf(T x) {
    u32x4 w = {cvtpk(x[0], x[1]), cvtpk(x[2], x[3]), cvtpk(x[4], x[5]), cvtpk(x[6], x[7])}; return *reinterpret_cast<bf16x8*>(&w); } };

__device__ __forceinline__ void partialSM(f32x16& p0, f32x16& p1, float& m_reg, float& mn, float& alpha) {
  constexpr float C = SCALE * 1.4426950408889634f;
  float pmax = p0[0]; for (int r = 1; r < 16; ++r) pmax = fmaxf(pmax, p0[r]); for (int r = 0; r < 16; ++r) pmax = fmaxf(pmax, p1[r]);
  { auto rr = __builtin_amdgcn_permlane32_swap(__float_as_uint(pmax), __float_as_uint(pmax), false, false);
    pmax = fmaxf(__uint_as_float(rr[0]), __uint_as_float(rr[1])); }
  if (__builtin_expect(__all(pmax - m_reg <= THR / SCALE), 1)) { mn = m_reg; alpha = 1.f; }
  else { mn = fmaxf(m_reg, pmax); alpha = __builtin_amdgcn_exp2f((m_reg - mn) * C); m_reg = mn; }
  float mnC = -mn * C;
  for (int r = 0; r < 16; ++r) p0[r] = fmaf(p0[r], C, mnC); for (int r = 0; r < 16; ++r) p1[r] = fmaf(p1[r], C, mnC);
  for (int r = 0; r < 16; ++r) p0[r] = __builtin_amdgcn_exp2f(p0[r]);
}
__device__ __forceinline__ void finishSM(f32x16& p0, f32x16& p1, float alpha, float& l_reg, bf16x8& pa0, bf16x8& pa1, bf16x8& pa2, bf16x8& pa3) {
  for (int r = 0; r < 16; ++r) p1[r] = __builtin_amdgcn_exp2f(p1[r]);
  float ps = 0; for (int r = 0; r < 16; ++r) ps += p0[r]; for (int r = 0; r < 16; ++r) ps += p1[r];
  { auto rr = __builtin_amdgcn_permlane32_swap(__float_as_uint(ps), __float_as_uint(ps), false, false);
    ps = __uint_as_float(rr[0]) + __uint_as_float(rr[1]); }
  l_reg = l_reg * alpha + ps;
#define PK4(P, BASE, OUT) do { unsigned a0 = cvtpk(P[BASE + 0], P[BASE + 1]), a1 = cvtpk(P[BASE + 2], P[BASE + 3]);   \
    unsigned b0 = cvtpk(P[BASE + 4], P[BASE + 5]), b1 = cvtpk(P[BASE + 6], P[BASE + 7]);                              \
    auto r0 = __builtin_amdgcn_permlane32_swap(a0, b0, false, false); auto r1 = __builtin_amdgcn_permlane32_swap(a1, b1, false, false); \
    u32x4 w = {r0[0], r1[0], r0[1], r1[1]}; OUT = *reinterpret_cast<bf16x8*>(&w); } while (0)
  PK4(p0, 0, pa0); PK4(p0, 8, pa1); PK4(p1, 0, pa2); PK4(p1, 8, pa3);
#undef PK4
}
__device__ __forceinline__ void qkt(f32x16& p0, f32x16& p1, const bf16* Ks, const bf16x8* qr, int r32, int hi) {
  p0 = f32x16{}; p1 = f32x16{};
  for (int d0 = 0; d0 < 8; ++d0) { int cb = (d0 * 16 + hi * 8) * 2;
    bf16x8 b0 = *reinterpret_cast<const bf16x8*>((const char*)Ks + KSWZ(r32, cb));
    bf16x8 b1 = *reinterpret_cast<const bf16x8*>((const char*)Ks + KSWZ(32 + r32, cb));
    p0 = __builtin_amdgcn_mfma_f32_32x32x16_bf16(b0, qr[d0], p0, 0, 0, 0);
    p1 = __builtin_amdgcn_mfma_f32_32x32x16_bf16(b1, qr[d0], p1, 0, 0, 0); }
}
__device__ __forceinline__ int v_st(int k, int c) { const int kk = (k & ~0xC) | ((k & 4) << 1) | ((k & 8) >> 1); return ((kk >> 3) * 4 + (c >> 5)) * 512 + ((kk & 7) * 32 + (c & 31)) * 2; }
__device__ __forceinline__ int v_rd_base(int lane) { return ((lane & 3) << 3) | (((lane >> 2) & 3) << 6) | (((lane >> 4) & 1) << 5) | (((lane >> 5) & 1) << 8); }
constexpr int v_rd_off(int d0, int ks, int half) { return d0 * 512 + ks * 4096 + half * 2048; }
template <int OFF> __device__ __forceinline__ s16x4 tr_read(int vb) {
  s16x4 r; asm volatile("ds_read_b64_tr_b16 %0, %1 offset:%2" : "=&v"(r) : "v"(vb), "i"(OFF) : "memory"); return r;
}
template <int D0> __device__ __forceinline__ void pv_one(f32x16& od, int vb, bf16x8 pa0, bf16x8 pa1, bf16x8 pa2, bf16x8 pa3) {
  const s16x4 l0 = tr_read<v_rd_off(D0, 0, 0)>(vb), h0 = tr_read<v_rd_off(D0, 0, 1)>(vb), l1 = tr_read<v_rd_off(D0, 1, 0)>(vb), h1 = tr_read<v_rd_off(D0, 1, 1)>(vb);
  const s16x4 l2 = tr_read<v_rd_off(D0, 2, 0)>(vb), h2 = tr_read<v_rd_off(D0, 2, 1)>(vb), l3 = tr_read<v_rd_off(D0, 3, 0)>(vb), h3 = tr_read<v_rd_off(D0, 3, 1)>(vb);
  asm volatile("s_waitcnt lgkmcnt(0)" ::: "memory"); SBAR();
#define PK(L, H) (bf16x8){L[0], L[1], L[2], L[3], H[0], H[1], H[2], H[3]}
  od = __builtin_amdgcn_mfma_f32_32x32x16_bf16(pa0, PK(l0, h0), od, 0, 0, 0);
  od = __builtin_amdgcn_mfma_f32_32x32x16_bf16(pa1, PK(l1, h1), od, 0, 0, 0);
  od = __builtin_amdgcn_mfma_f32_32x32x16_bf16(pa2, PK(l2, h2), od, 0, 0, 0);
  od = __builtin_amdgcn_mfma_f32_32x32x16_bf16(pa3, PK(l3, h3), od, 0, 0, 0);
#undef PK
}
__device__ __forceinline__ void pv_d0(f32x16* o, int vb, bf16x8 pa0, bf16x8 pa1, bf16x8 pa2, bf16x8 pa3) {
  pv_one<0>(o[0], vb, pa0, pa1, pa2, pa3); pv_one<1>(o[1], vb, pa0, pa1, pa2, pa3); pv_one<2>(o[2], vb, pa0, pa1, pa2, pa3); pv_one<3>(o[3], vb, pa0, pa1, pa2, pa3);
}

template <typename TQ, int LDQ, int LDK, int LDO, bool OBF16>
__device__ __forceinline__ void attn_dense_body(const TQ* Qb, const bf16* Kh, const bf16* Vh,
                                                void* Obv, int seq, char* lds) {
  using St = Stage<bf16>; using SQ = Stage<TQ>;
  int tid = threadIdx.x; asm volatile("" : "+v"(tid)); const int wid = tid >> 6, lane = tid & 63, r32 = lane & 31, hi = lane >> 5;
  bf16* V_lds = (bf16*)lds; bf16* K_lds = (bf16*)(lds + 2 * SHM_V);
  float* ws = (float*)(lds + 2 * SHM_V + 2 * SHM_K) + wid * 64; float* li_l = ws; float* al_l = ws + 32;
  float m_reg = -1e30f, l_reg = 0; f32x16 o[4] = {}; bf16x8 qr[8];
  const TQ* Qw = Qb + (long)(wid * QBLK + r32) * LDQ + hi * 8;
#pragma unroll
  for (int d0 = 0; d0 < 8; ++d0) qr[d0] = SQ::tobf(SQ::ld8(Qw + d0 * 16));
  const int sr = tid >> 4, sc = (tid & 15) * 8, vst0 = v_st(sr, sc), vst1 = v_st(32 + sr, sc);
  const int vb0 = (int)(uintptr_t)V_lds + v_rd_base(lane);
  struct { typename St::T vs0, vs1, ks0, ks1; } sr_[SDEPTH];
#define SLOAD(i, k0) do { sr_[i].vs0 = St::ld8(&Vh[(long)((k0) + sr) * LDK + sc]); sr_[i].vs1 = St::ld8(&Vh[(long)((k0) + 32 + sr) * LDK + sc]); \
    sr_[i].ks0 = St::ld8(&Kh[(long)((k0) + sr) * LDK + sc]); sr_[i].ks1 = St::ld8(&Kh[(long)((k0) + 32 + sr) * LDK + sc]); } while (0)
#define SWRITE(b, i) do { *(bf16x8*)((char*)V_lds + (b) * SHM_V + vst0) = St::tobf(sr_[i].vs0);          \
    *(bf16x8*)((char*)V_lds + (b) * SHM_V + vst1) = St::tobf(sr_[i].vs1); int kc = sc * 2;               \
    *(bf16x8*)((char*)K_lds + (b) * SHM_K + KSWZ(sr, kc)) = St::tobf(sr_[i].ks0);                       \
    *(bf16x8*)((char*)K_lds + (b) * SHM_K + KSWZ(32 + sr, kc)) = St::tobf(sr_[i].ks1); } while (0)
#define SWAIT() do { if constexpr (SDEPTH == 2) asm volatile("s_waitcnt vmcnt(4)" ::: "memory"); else asm volatile("s_waitcnt vmcnt(0)" ::: "memory"); } while (0)
#define RESC(a) do { if (__any((a) < 1.f)) { if (hi == 0) al_l[r32] = (a); asm volatile("s_waitcnt lgkmcnt(0)" ::: "memory"); \
    for (int d = 0; d < 4; ++d) for (int r = 0; r < 16; ++r) o[d][r] *= al_l[crow(r, hi)]; } } while (0)
  f32x16 pA0, pA1, pB0, pB1; float mnA, mnB, alA, alB; bf16x8 pa0, pa1, pa2, pa3; const int NT = seq / KVBLK;
  constexpr int SE = 0, SO = SDEPTH - 1;
  SLOAD(SE, 0); asm volatile("s_waitcnt vmcnt(0)" ::: "memory"); SWRITE(0, SE); __syncthreads();
  qkt(pA0, pA1, K_lds, qr, r32, hi); partialSM(pA0, pA1, m_reg, mnA, alA);
  SLOAD(SO, KVBLK); if constexpr (SDEPTH == 2) { if (2 < NT) SLOAD(SE, 2 * KVBLK); }
  SWAIT(); SWRITE(1, SO); __syncthreads();
  for (int j = 1; j + 1 < NT; j += 2) {
    SBAR(); qkt(pB0, pB1, (bf16*)((char*)K_lds + SHM_K), qr, r32, hi);
    finishSM(pA0, pA1, alA, l_reg, pa0, pa1, pa2, pa3); SBAR();
    SLOAD(SO, (j + SDEPTH) * KVBLK); SBAR();
    pv_d0(o, vb0, pa0, pa1, pa2, pa3); partialSM(pB0, pB1, m_reg, mnB, alB);
    __syncthreads(); SWAIT(); SWRITE(0, SE);
    RESC(alB); __syncthreads();
    SBAR(); qkt(pA0, pA1, K_lds, qr, r32, hi);
    finishSM(pB0, pB1, alB, l_reg, pa0, pa1, pa2, pa3); SBAR();
    if (SDEPTH == 1 || j + 3 < NT) SLOAD(SE, (j + 1 + SDEPTH) * KVBLK); SBAR();
    pv_d0(o, vb0 + (int)SHM_V, pa0, pa1, pa2, pa3); partialSM(pA0, pA1, m_reg, mnA, alA);
    __syncthreads(); SWAIT(); SWRITE(1, SO);
    RESC(alA); __syncthreads();
  }
  SBAR(); qkt(pB0, pB1, (bf16*)((char*)K_lds + SHM_K), qr, r32, hi);
  finishSM(pA0, pA1, alA, l_reg, pa0, pa1, pa2, pa3); SBAR();
  pv_d0(o, vb0, pa0, pa1, pa2, pa3); partialSM(pB0, pB1, m_reg, mnB, alB);
  __syncthreads(); RESC(alB);
  finishSM(pB0, pB1, alB, l_reg, pa0, pa1, pa2, pa3); SBAR();
  pv_d0(o, vb0 + (int)SHM_V, pa0, pa1, pa2, pa3);
  if (hi == 0) li_l[r32] = l_reg; asm volatile("s_waitcnt lgkmcnt(0)" ::: "memory");
  float rli[16];
#pragma unroll
  for (int r = 0; r < 16; ++r) rli[r] = __builtin_amdgcn_rcpf(li_l[crow(r, hi)]);
  if constexpr (!OBF16) { float* Ow = (float*)Obv + (long)(wid * QBLK) * LDO;
#pragma unroll
  for (int r = 0; r < 16; ++r) { int orow = crow(r, hi);
    for (int d0 = 0; d0 < 4; ++d0) Ow[(long)orow * LDO + d0 * 32 + r32] = o[d0][r] * rli[r]; }
  } else { unsigned short* Ow = (unsigned short*)Obv + (long)(wid * QBLK) * LDO;
#pragma unroll
  for (int r = 0; r < 16; ++r) { int orow = crow(r, hi);
    for (int d0 = 0; d0 < 4; ++d0) { const unsigned pk = cvtpk(o[d0][r] * rli[r], 0.f); Ow[(long)orow * LDO + d0 * 32 + r32] = (unsigned short)(pk & 0xffffu); } }
  }
#undef SLOAD
#undef SWRITE
#undef SWAIT
#undef RESC
}
#undef KSWZ
#undef SBAR
}
namespace gla {
typedef float f32x16 __attribute__((ext_vector_type(16)));
typedef float f32x4v __attribute__((ext_vector_type(4)));
constexpr int LD = 65;
constexpr int OX = 0, OY = 2 * 64 * LD * 4, OV = 4 * 64 * LD * 4, OAL = OV + 64 * 128 * 4, OW2 = OAL + 64 * 32 * 4, OBA = OW2 + 2 * 16 * 64 * 4, OTOT = OBA + 2 * 64 * 4, OEND = OTOT + 2 * 64 * 4 * 4;
static_assert(OEND <= 131072, "gla lds");
static_assert(64 * 129 * 4 <= 2 * 64 * LD * 4, "O stage fits in X");

struct In {
  const bf16_t* q; const bf16_t* k; const bf16_t* v; const bf16_t* ga; const bf16_t* og; int ld;
  const float* wa2; const float* ba; const float* gnorm;
  float* cs;
  bf16_t* csb;
  float* dec;
  bf16_t* y; int ldy;
  int S, C;
};
__device__ __forceinline__ long chunk_row(const In& p, int cid) { return cid < p.S / 64 ? (long)cid * 64 : (long)p.S + (long)(cid - p.S / 64) * 64; }
__device__ __forceinline__ float logsig(float x) { return x < 0.f ? x - __logf(1.f + __expf(x)) : -__logf(1.f + __expf(-x)); }

__device__ __forceinline__ void cum_phase(const In& p, LAS unsigned char* lds, int head, long row0, int tid) {
  LAS float* AL = (LAS float*)(lds + OAL); LAS float* W2 = (LAS float*)(lds + OW2); LAS float* BA = (LAS float*)(lds + OBA); LAS float* TOT = (LAS float*)(lds + OTOT);
  { const int t = tid >> 3, r4 = (tid & 7) * 4; const unsigned long long u = *(const unsigned long long*)(p.ga + (row0 + t) * p.ld + r4);
    f32x4v a4; a4[0] = bf2f((bf16_t)u); a4[1] = bf2f((bf16_t)(u >> 16)); a4[2] = bf2f((bf16_t)(u >> 32)); a4[3] = bf2f((bf16_t)(u >> 48)); *(LAS f32x4v*)(AL + t * 32 + r4) = a4; }
  { const int e = tid * 4, dir = e >> 10, r = (e >> 6) & 15, j = e & 63; *(LAS f32x4v*)(W2 + e) = *(const f32x4v*)(p.wa2 + ((long)dir * 16 + r) * 256 + head * 64 + j); }
  if (tid < 128) BA[tid] = p.ba[(tid >> 6) * 256 + head * 64 + (tid & 63)];
  __syncthreads();
  const int dir = tid >> 8, j = tid & 63, seg = (tid >> 6) & 3;
  float w[16];
#pragma unroll
  for (int r = 0; r < 16; ++r) w[r] = W2[(dir * 16 + r) * 64 + j];
  const float bj = BA[dir * 64 + j];
  float c[16];
#pragma unroll
  for (int k = 0; k < 16; ++k) { const int t = seg * 16 + k; float z = bj;
#pragma unroll
    for (int r4 = 0; r4 < 4; ++r4) { const f32x4v a4 = *(const LAS f32x4v*)(AL + t * 32 + dir * 16 + 4 * r4); z += a4[0] * w[4 * r4] + a4[1] * w[4 * r4 + 1] + a4[2] * w[4 * r4 + 2] + a4[3] * w[4 * r4 + 3]; }
    c[k] = logsig(z) * (1.f / 16.f); }
  if (dir == 0) {
#pragma unroll
    for (int k = 1; k < 16; ++k) c[k] += c[k - 1];
    TOT[(dir * 64 + j) * 4 + seg] = c[15];
  } else {
#pragma unroll
    for (int k = 14; k >= 0; --k) c[k] += c[k + 1];
    TOT[(dir * 64 + j) * 4 + seg] = c[0];
  }
  __syncthreads();
  float off = 0.f;
#pragma unroll
  for (int s = 0; s < 4; ++s) { const float tv = TOT[(dir * 64 + j) * 4 + s]; if (dir == 0 ? s < seg : s > seg) off += tv; }
  LAS float* X = (LAS float*)(lds + OX) + dir * 64 * LD;
#pragma unroll
  for (int k = 0; k < 16; ++k) X[(seg * 16 + k) * LD + j] = c[k] + off;
}
struct VRegs { unsigned long long u[4]; };
__device__ __forceinline__ VRegs load_v_regs(const In& p, int head, long row0, int tid) { VRegs r;
#pragma unroll
  for (int m = 0; m < 4; ++m) { const int t = (tid >> 5) + 16 * m, c4 = (tid & 31) * 4; r.u[m] = *(const unsigned long long*)(p.v + (row0 + t) * p.ld + head * 128 + c4); }
  return r; }
__device__ __forceinline__ void store_v(const VRegs& r, LAS unsigned char* lds, int tid) {
  LAS float* V = (LAS float*)(lds + OV);
#pragma unroll
  for (int m = 0; m < 4; ++m) { const int t = (tid >> 5) + 16 * m, c4 = (tid & 31) * 4; const unsigned long long u = r.u[m];
    f32x4v a4; a4[0] = bf2f((bf16_t)u); a4[1] = bf2f((bf16_t)(u >> 16)); a4[2] = bf2f((bf16_t)(u >> 32)); a4[3] = bf2f((bf16_t)(u >> 48)); *(LAS f32x4v*)(V + t * 128 + c4) = a4; }
}

__device__ __forceinline__ void g1_unit(const In& p, LAS unsigned char* lds, int head, int cid, int GH, int NCH) {
  int tid = threadIdx.x; asm volatile("" : "+v"(tid));
  const int lane = tid & 63, w = __builtin_amdgcn_readfirstlane(tid >> 6);
  const long row0 = chunk_row(p, cid);
  const VRegs vr = load_v_regs(p, head, row0, tid);
  bf16_t kreg[8];
#pragma unroll
  for (int m = 0; m < 8; ++m) kreg[m] = p.k[(row0 + (tid >> 6) + 8 * m) * p.ld + head * 64 + (tid & 63)];
  cum_phase(p, lds, head, row0, tid);
  store_v(vr, lds, tid);
  __syncthreads();
  LAS float* TOT = (LAS float*)(lds + OTOT);
  { const int j = tid & 63;
#pragma unroll
    for (int dir = 0; dir < 2; ++dir) { LAS float* X = (LAS float*)(lds + OX) + dir * 64 * LD;
      const float cl = TOT[(dir * 64 + j) * 4 + 0] + TOT[(dir * 64 + j) * 4 + 1] + TOT[(dir * 64 + j) * 4 + 2] + TOT[(dir * 64 + j) * 4 + 3];
#pragma unroll
      for (int m = 0; m < 8; ++m) { const int t = (tid >> 6) + 8 * m; const float kv = bf2f(kreg[m]); X[t * LD + j] = kv * __expf(cl - X[t * LD + j]); }
      if (tid < 64) p.dec[(((long)dir * GH + head) * NCH + cid) * 64 + j] = __expf(cl); }
  }
  __syncthreads();
  { const int dir = w >> 2, di = (w >> 1) & 1, vj0 = (w & 1) * 2; const LAS float* X = (const LAS float*)(lds + OX) + dir * 64 * LD; const LAS float* V = (const LAS float*)(lds + OV);
    f32x16 a0 = {}, a1 = {}; const int li = lane & 31, lk = lane >> 5;
#pragma unroll 4
    for (int s0 = 0; s0 < 64; s0 += 2) { const float av = X[(s0 + lk) * LD + 32 * di + li]; const float b0 = V[(s0 + lk) * 128 + 32 * vj0 + li], b1 = V[(s0 + lk) * 128 + 32 * vj0 + 32 + li];
      a0 = __builtin_amdgcn_mfma_f32_32x32x2f32(av, b0, a0, 0, 0, 0); a1 = __builtin_amdgcn_mfma_f32_32x32x2f32(av, b1, a1, 0, 0, 0); }
    float* dst = p.cs + ((((long)dir * GH + head) * NCH + cid) * 64) * 128;
#pragma unroll
    for (int r = 0; r < 16; ++r) { const int d = 32 * di + (r & 3) + 8 * (r >> 2) + 4 * lk; dst[(long)d * 128 + 32 * vj0 + li] = a0[r]; dst[(long)d * 128 + 32 * vj0 + 32 + li] = a1[r]; }
  }
  __syncthreads();
}
__device__ __forceinline__ void g2_item(const In& p, long idx, int GH, int NCH) {
  const int v = 2 * (int)(idx & 63), d = (int)((idx >> 6) & 63); const int hd = (int)((idx >> 12) % GH), dir = (int)((idx >> 12) / GH);
  const int nl = p.S / 64, nc = p.C / 64; float st0 = 0.f, st1 = 0.f;
  bf16_t* base = p.csb + (((long)dir * GH + hd) * NCH) * 64 * 128 + (long)d * 128 + v; const float* db = p.dec + (((long)dir * GH + hd) * NCH) * 64 + d;
  for (int s0 = 0; s0 < nl + nc; s0 += 4) { unsigned c[4]; float dc[4]; unsigned* pp[4];
#pragma unroll
    for (int k = 0; k < 4; ++k) { const int step = s0 + k; int cid; if (step < nc) cid = nl + (dir ? nc - 1 - step : step); else cid = dir ? nl - 1 - (step - nc) : step - nc;
      pp[k] = (unsigned*)(base + (long)cid * 64 * 128); c[k] = *pp[k]; dc[k] = db[(long)cid * 64]; }
#pragma unroll
    for (int k = 0; k < 4; ++k) { *pp[k] = pk2(st0, st1); st0 = dc[k] * st0 + __uint_as_float(c[k] << 16); st1 = dc[k] * st1 + __uint_as_float(c[k] & 0xffff0000u); } }
}
__device__ __forceinline__ void g3_unit(const In& p, LAS unsigned char* lds, int head, int cid, int GH, int NCH) {
  int tid = threadIdx.x; asm volatile("" : "+v"(tid));
  const int lane = tid & 63, w = __builtin_amdgcn_readfirstlane(tid >> 6), li = lane & 31, lk = lane >> 5;
  const long row0 = chunk_row(p, cid);
  float spf[2][32];
  { const int vj_ = w & 3;
#pragma unroll
    for (int dir = 0; dir < 2; ++dir) { const float* sp = p.cs + ((((long)dir * GH + head) * NCH + cid) * 64) * 128 + 32 * vj_ + li;
#pragma unroll
      for (int i = 0; i < 32; ++i) spf[dir][i] = sp[(long)(2 * i + lk) * 128]; } }
  const VRegs vr = load_v_regs(p, head, row0, tid);
  bf16_t kreg[8], qreg[8];
#pragma unroll
  for (int m = 0; m < 8; ++m) { const long o_ = (row0 + (tid >> 6) + 8 * m) * p.ld + head * 64 + (tid & 63); kreg[m] = p.k[o_]; qreg[m] = p.q[o_]; }
  cum_phase(p, lds, head, row0, tid);
  store_v(vr, lds, tid);
  __syncthreads();
  { const int j = tid & 63;
#pragma unroll
    for (int dir = 0; dir < 2; ++dir) { LAS float* X = (LAS float*)(lds + OX) + dir * 64 * LD; LAS float* Y = (LAS float*)(lds + OY) + dir * 64 * LD;
#pragma unroll
      for (int m = 0; m < 8; ++m) { const int t = (tid >> 6) + 8 * m; const float c = X[t * LD + j];
        const float qv = bf2f(qreg[m]) * 0.125f, kv = bf2f(kreg[m]);
        X[t * LD + j] = qv * __expf(c); Y[t * LD + j] = kv * __expf(-c); } }
  }
  __syncthreads();
  {
    const int dir = w >> 2, qi = (w >> 1) & 1, si = w & 1; const bool zero = dir == 0 ? si > qi : si < qi;
    const LAS float* X = (const LAS float*)(lds + OX) + dir * 64 * LD; LAS float* Y = (LAS float*)(lds + OY) + dir * 64 * LD;
    f32x16 pa = {};
    if (!zero) {
#pragma unroll 4
      for (int d0 = 0; d0 < 64; d0 += 2) pa = __builtin_amdgcn_mfma_f32_32x32x2f32(X[(32 * qi + li) * LD + d0 + lk], Y[(32 * si + li) * LD + d0 + lk], pa, 0, 0, 0);
    }
    __syncthreads();
#pragma unroll
    for (int r = 0; r < 16; ++r) { const int q = 32 * qi + (r & 3) + 8 * (r >> 2) + 4 * lk, s = 32 * si + li; const bool keep = dir == 0 ? s <= q : s >= q;
      Y[q * LD + s] = keep ? pa[r] : 0.f; }
  }
  __syncthreads();
  f32x16 acc = {};
  { const int qi = w >> 2, vj = w & 3; const LAS float* V = (const LAS float*)(lds + OV);
#pragma unroll
    for (int dir = 0; dir < 2; ++dir) { const LAS float* X = (const LAS float*)(lds + OX) + dir * 64 * LD; const LAS float* Y = (const LAS float*)(lds + OY) + dir * 64 * LD;
#pragma unroll 4
      for (int s0 = 0; s0 < 64; s0 += 2) acc = __builtin_amdgcn_mfma_f32_32x32x2f32(Y[(32 * qi + li) * LD + s0 + lk], V[(s0 + lk) * 128 + 32 * vj + li], acc, 0, 0, 0);
#pragma unroll
      for (int i = 0; i < 32; ++i) acc = __builtin_amdgcn_mfma_f32_32x32x2f32(X[(32 * qi + li) * LD + 2 * i + lk], spf[dir][i], acc, 0, 0, 0);
    }
    __syncthreads();
    LAS float* O = (LAS float*)(lds + OX);
#pragma unroll
    for (int r = 0; r < 16; ++r) { const int q = 32 * qi + (r & 3) + 8 * (r >> 2) + 4 * lk; O[q * 129 + 32 * vj + li] = acc[r]; }
  }
  __syncthreads();
  { const int row = tid >> 3, part = tid & 7; const LAS float* O = (const LAS float*)(lds + OX) + row * 129 + part * 16;
    float o[16]; float ss = 0.f;
#pragma unroll
    for (int k = 0; k < 16; ++k) { o[k] = O[k]; ss += o[k] * o[k]; }
    ss += __shfl_xor(ss, 1); ss += __shfl_xor(ss, 2); ss += __shfl_xor(ss, 4);
    const float rs = __builtin_amdgcn_rsqf(ss * (1.f / 128.f) + 1e-6f);
    const bf16_t* ogp = p.og + (row0 + row) * p.ld + head * 128 + part * 16; const v4u og0 = *(const v4u*)ogp, og1 = *(const v4u*)(ogp + 8);
    const unsigned ogw[8] = {og0.x, og0.y, og0.z, og0.w, og1.x, og1.y, og1.z, og1.w}; bf16_t* yp = p.y + (row0 + row) * p.ldy + head * 128 + part * 16; float yy[16];
#pragma unroll
    for (int k4 = 0; k4 < 4; ++k4) { f32x4v g4; g4[0] = bf2f((bf16_t)(ogw[2 * k4] & 0xffff)); g4[1] = bf2f((bf16_t)(ogw[2 * k4] >> 16)); g4[2] = bf2f((bf16_t)(ogw[2 * k4 + 1] & 0xffff)); g4[3] = bf2f((bf16_t)(ogw[2 * k4 + 1] >> 16)); const f32x4v n4 = *(const f32x4v*)(p.gnorm + part * 16 + 4 * k4); f32x4v y4;
#pragma unroll
      for (int e = 0; e < 4; ++e) { const float gg = g4[e]; y4[e] = o[4 * k4 + e] * rs * n4[e] * (gg / (1.f + __expf(-gg))); yy[4 * k4 + e] = y4[e]; } }
    { v4u o0, o1; o0.x = pk2(yy[0], yy[1]); o0.y = pk2(yy[2], yy[3]); o0.z = pk2(yy[4], yy[5]); o0.w = pk2(yy[6], yy[7]);
      o1.x = pk2(yy[8], yy[9]); o1.y = pk2(yy[10], yy[11]); o1.z = pk2(yy[12], yy[13]); o1.w = pk2(yy[14], yy[15]); *(v4u*)yp = o0; *(v4u*)(yp + 8) = o1; }
  }
  __syncthreads();
}

typedef short bf16x8g __attribute__((ext_vector_type(8)));
constexpr int LB = 72;
constexpr int OQB = 2 * 64 * LD * 4, OKB = OQB + 2 * 64 * LB * 2, OVT = OKB + 2 * 64 * LB * 2, OBEND = OVT + 128 * LB * 2;
static_assert(OBEND <= OAL, "gla bf16 lds");
#define GMM(A, B, C) C = __builtin_amdgcn_mfma_f32_32x32x16_bf16(__builtin_bit_cast(bf16x8g, A), __builtin_bit_cast(bf16x8g, B), C, 0, 0, 0)
__device__ __forceinline__ void store_vt(const VRegs& r, LAS unsigned char* lds, int tid) {
  LAS bf16_t* Vt = (LAS bf16_t*)(lds + OVT);
#pragma unroll
  for (int m = 0; m < 4; ++m) { const int t = (tid >> 5) + 16 * m, c4 = (tid & 31) * 4; const unsigned long long u = r.u[m];
    Vt[(c4 + 0) * LB + t] = (bf16_t)u; Vt[(c4 + 1) * LB + t] = (bf16_t)(u >> 16); Vt[(c4 + 2) * LB + t] = (bf16_t)(u >> 32); Vt[(c4 + 3) * LB + t] = (bf16_t)(u >> 48); }
}
__device__ __forceinline__ void g1b_unit(const In& p, LAS unsigned char* lds, int head, int cid, int GH, int NCH) {
  int tid = threadIdx.x; asm volatile("" : "+v"(tid));
  const int lane = tid & 63, w = __builtin_amdgcn_readfirstlane(tid >> 6), li = lane & 31, lk = lane >> 5;
  const long row0 = chunk_row(p, cid);
  const VRegs vr = load_v_regs(p, head, row0, tid);
  bf16_t kreg[8];
#pragma unroll
  for (int m = 0; m < 8; ++m) kreg[m] = p.k[(row0 + (tid >> 6) + 8 * m) * p.ld + head * 64 + (tid & 63)];
  cum_phase(p, lds, head, row0, tid);
  store_vt(vr, lds, tid);
  __syncthreads();
  LAS float* TOT = (LAS float*)(lds + OTOT);
  { const int j = tid & 63;
#pragma unroll
    for (int dir = 0; dir < 2; ++dir) { const LAS float* X = (const LAS float*)(lds + OX) + dir * 64 * LD; LAS bf16_t* KeT = (LAS bf16_t*)(lds + OQB) + dir * 64 * LB;
      const float cl = TOT[(dir * 64 + j) * 4 + 0] + TOT[(dir * 64 + j) * 4 + 1] + TOT[(dir * 64 + j) * 4 + 2] + TOT[(dir * 64 + j) * 4 + 3];
#pragma unroll
      for (int m = 0; m < 8; ++m) { const int t = (tid >> 6) + 8 * m; KeT[j * LB + t] = (bf16_t)f2bf(bf2f(kreg[m]) * __expf(cl - X[t * LD + j])); }
      if (tid < 64) p.dec[(((long)dir * GH + head) * NCH + cid) * 64 + j] = __expf(cl); }
  }
  __syncthreads();
  { const int dir = w >> 2, di = (w >> 1) & 1, vj0 = (w & 1) * 2; const LAS bf16_t* KeT = (const LAS bf16_t*)(lds + OQB) + dir * 64 * LB; const LAS bf16_t* Vt = (const LAS bf16_t*)(lds + OVT);
    f32x16 a0 = {}, a1 = {};
#pragma unroll
    for (int kk = 0; kk < 4; ++kk) { const v4u av = *(const LAS v4u*)(KeT + (32 * di + li) * LB + 16 * kk + 8 * lk);
      const v4u b0 = *(const LAS v4u*)(Vt + (32 * vj0 + li) * LB + 16 * kk + 8 * lk), b1 = *(const LAS v4u*)(Vt + (32 * vj0 + 32 + li) * LB + 16 * kk + 8 * lk);
      GMM(av, b0, a0); GMM(av, b1, a1); }
    bf16_t* dst = p.csb + ((((long)dir * GH + head) * NCH + cid) * 64) * 128;
#pragma unroll
    for (int r = 0; r < 16; ++r) { const int d = 32 * di + (r & 3) + 8 * (r >> 2) + 4 * lk; dst[(long)d * 128 + 32 * vj0 + li] = (bf16_t)f2bf(a0[r]); dst[(long)d * 128 + 32 * vj0 + 32 + li] = (bf16_t)f2bf(a1[r]); }
  }
  __syncthreads();
}
__device__ __forceinline__ void g3b_unit(const In& p, LAS unsigned char* lds, int head, int cid, int GH, int NCH) {
  int tid = threadIdx.x; asm volatile("" : "+v"(tid));
  const int lane = tid & 63, w = __builtin_amdgcn_readfirstlane(tid >> 6), li = lane & 31, lk = lane >> 5;
  const long row0 = chunk_row(p, cid);
  unsigned spf[2][32];
  { const int vj_ = w & 3;
#pragma unroll
    for (int dir = 0; dir < 2; ++dir) { const bf16_t* sp = p.csb + ((((long)dir * GH + head) * NCH + cid) * 64) * 128 + 32 * vj_ + li;
#pragma unroll
      for (int i = 0; i < 32; ++i) spf[dir][i] = sp[(long)(16 * (i >> 3) + 8 * lk + (i & 7)) * 128]; } }
  const VRegs vr = load_v_regs(p, head, row0, tid);
  bf16_t kreg[8], qreg[8];
#pragma unroll
  for (int m = 0; m < 8; ++m) { const long o_ = (row0 + (tid >> 6) + 8 * m) * p.ld + head * 64 + (tid & 63); kreg[m] = p.k[o_]; qreg[m] = p.q[o_]; }
  cum_phase(p, lds, head, row0, tid);
  store_vt(vr, lds, tid);
  __syncthreads();
  { const int j = tid & 63;
#pragma unroll
    for (int dir = 0; dir < 2; ++dir) { const LAS float* X = (const LAS float*)(lds + OX) + dir * 64 * LD; LAS bf16_t* Qb = (LAS bf16_t*)(lds + OQB) + dir * 64 * LB; LAS bf16_t* Kb = (LAS bf16_t*)(lds + OKB) + dir * 64 * LB;
#pragma unroll
      for (int m = 0; m < 8; ++m) { const int t = (tid >> 6) + 8 * m; const float c = X[t * LD + j];
        Qb[t * LB + j] = (bf16_t)f2bf(bf2f(qreg[m]) * 0.125f * __expf(c)); Kb[t * LB + j] = (bf16_t)f2bf(bf2f(kreg[m]) * __expf(-c)); } }
  }
  __syncthreads();
  {
    const int dir = w >> 2, qi = (w >> 1) & 1, si = w & 1; const bool zero = dir == 0 ? si > qi : si < qi;
    const LAS bf16_t* Qb = (const LAS bf16_t*)(lds + OQB) + dir * 64 * LB; LAS bf16_t* Kb = (LAS bf16_t*)(lds + OKB) + dir * 64 * LB;
    f32x16 pa = {};
    if (!zero) {
#pragma unroll
      for (int kk = 0; kk < 4; ++kk) { const v4u av = *(const LAS v4u*)(Qb + (32 * qi + li) * LB + 16 * kk + 8 * lk), bv = *(const LAS v4u*)(Kb + (32 * si + li) * LB + 16 * kk + 8 * lk); GMM(av, bv, pa); }
    }
    __syncthreads();
#pragma unroll
    for (int r = 0; r < 16; ++r) { const int q = 32 * qi + (r & 3) + 8 * (r >> 2) + 4 * lk, s = 32 * si + li; const bool keep = dir == 0 ? s <= q : s >= q;
      Kb[q * LB + s] = (bf16_t)f2bf(keep ? pa[r] : 0.f); }
  }
  __syncthreads();
  f32x16 acc = {};
  { const int qi = w >> 2, vj = w & 3; const LAS bf16_t* Vt = (const LAS bf16_t*)(lds + OVT);
#pragma unroll
    for (int dir = 0; dir < 2; ++dir) { const LAS bf16_t* Qb = (const LAS bf16_t*)(lds + OQB) + dir * 64 * LB; const LAS bf16_t* Pb = (const LAS bf16_t*)(lds + OKB) + dir * 64 * LB;
#pragma unroll
      for (int kk = 0; kk < 4; ++kk) { const v4u av = *(const LAS v4u*)(Pb + (32 * qi + li) * LB + 16 * kk + 8 * lk), bv = *(const LAS v4u*)(Vt + (32 * vj + li) * LB + 16 * kk + 8 * lk); GMM(av, bv, acc); }
#pragma unroll
      for (int kk = 0; kk < 4; ++kk) { const v4u av = *(const LAS v4u*)(Qb + (32 * qi + li) * LB + 16 * kk + 8 * lk);
        v4u bv; bv.x = spf[dir][8 * kk + 0] | (spf[dir][8 * kk + 1] << 16); bv.y = spf[dir][8 * kk + 2] | (spf[dir][8 * kk + 3] << 16); bv.z = spf[dir][8 * kk + 4] | (spf[dir][8 * kk + 5] << 16); bv.w = spf[dir][8 * kk + 6] | (spf[dir][8 * kk + 7] << 16);
        GMM(av, bv, acc); }
    }
    LAS float* O = (LAS float*)(lds + OX);
#pragma unroll
    for (int r = 0; r < 16; ++r) { const int q = 32 * qi + (r & 3) + 8 * (r >> 2) + 4 * lk; O[q * 129 + 32 * vj + li] = acc[r]; }
  }
  __syncthreads();
  { const int row = tid >> 3, part = tid & 7; const LAS float* O = (const LAS float*)(lds + OX) + row * 129 + part * 16;
    float o[16]; float ss = 0.f;
#pragma unroll
    for (int k = 0; k < 16; ++k) { o[k] = O[k]; ss += o[k] * o[k]; }
    ss += __shfl_xor(ss, 1); ss += __shfl_xor(ss, 2); ss += __shfl_xor(ss, 4);
    const float rs = __builtin_amdgcn_rsqf(ss * (1.f / 128.f) + 1e-6f);
    const bf16_t* ogp = p.og + (row0 + row) * p.ld + head * 128 + part * 16; const v4u og0 = *(const v4u*)ogp, og1 = *(const v4u*)(ogp + 8);
    const unsigned ogw[8] = {og0.x, og0.y, og0.z, og0.w, og1.x, og1.y, og1.z, og1.w}; bf16_t* yp = p.y + (row0 + row) * p.ldy + head * 128 + part * 16; float yy[16];
#pragma unroll
    for (int k4 = 0; k4 < 4; ++k4) { f32x4v g4; g4[0] = bf2f((bf16_t)(ogw[2 * k4] & 0xffff)); g4[1] = bf2f((bf16_t)(ogw[2 * k4] >> 16)); g4[2] = bf2f((bf16_t)(ogw[2 * k4 + 1] & 0xffff)); g4[3] = bf2f((bf16_t)(ogw[2 * k4 + 1] >> 16)); const f32x4v n4 = *(const f32x4v*)(p.gnorm + part * 16 + 4 * k4);
#pragma unroll
      for (int e = 0; e < 4; ++e) { const float gg = g4[e]; yy[4 * k4 + e] = o[4 * k4 + e] * rs * n4[e] * (gg / (1.f + __expf(-gg))); } }
    { v4u o0, o1; o0.x = pk2(yy[0], yy[1]); o0.y = pk2(yy[2], yy[3]); o0.z = pk2(yy[4], yy[5]); o0.w = pk2(yy[6], yy[7]);
      o1.x = pk2(yy[8], yy[9]); o1.y = pk2(yy[10], yy[11]); o1.z = pk2(yy[12], yy[13]); o1.w = pk2(yy[14], yy[15]); *(v4u*)yp = o0; *(v4u*)(yp + 8) = o1; }
  }
  __syncthreads();
}
#undef GMM
}
namespace moe {
constexpr int NE = 16, NG = 4, EPG = 4, DE = 512, D = 1024;
__device__ __forceinline__ float wave_sum(float v) {
#pragma unroll
  for (int o = 1; o < 64; o <<= 1) v += __shfl_xor(v, o);
  return v;
}
struct Route { int e0, r0, e1, r1; };
struct MoeOrder {
  int G, c, NT; const LAS int* poff;
  __device__ __forceinline__ bool next(int i, pg8::Unit& u) const {
    const long L = (long)i * G + c; const int total = poff[NE] * NT; if (L >= total) return false;
    const int panel = (int)L / NT, j = (int)L % NT; int e = 0;
#pragma unroll
    for (int k = 1; k < NE; ++k) e += (panel >= poff[k]) ? 1 : 0;
    u.pm = panel; u.pn = e * NT + j; u.acol = 0; u.nt = 0; return true;
  }
  __device__ __forceinline__ void a_ready(const pg8::Unit&) const {}
  __device__ __forceinline__ void done(const pg8::Unit&) const {}
};
struct EpiGU {
  static constexpr bool PERM = true, AFTER_DRAIN = false;
  bf16_t* hid;
  __device__ __forceinline__ void operator()(const pg8::f32x4 (&acc)[2][2][4][2], const pg8::Unit& u, int wr, int wc, int fr, int fq) const {
    const int j = u.pn & 3; const int row0 = u.pm * 256 + wr * 64 + fr, col0 = j * 128 + wc * 32 + 8 * fq;
#pragma unroll
    for (int ai = 0; ai < 2; ++ai)
#pragma unroll
      for (int m = 0; m < 4; ++m) { const size_t r = (size_t)(row0 + ai * 128 + m * 16); float hv[8];
#pragma unroll
        for (int n = 0; n < 2; ++n)
#pragma unroll
          for (int e = 0; e < 4; ++e) { const float g = acc[ai][0][m][n][e], up = acc[ai][1][m][n][e]; hv[4 * n + e] = g / (1.f + __expf(-g)) * up; }
        v4u o; o.x = pk2(hv[0], hv[1]); o.y = pk2(hv[2], hv[3]); o.z = pk2(hv[4], hv[5]); o.w = pk2(hv[6], hv[7]);
        *(v4u*)(hid + r * DE + col0) = o; }
  }
};
struct EpiDown {
  static constexpr bool PERM = true, AFTER_DRAIN = false;
  const int* srcrow; const float* wgt; bf16_t* contrib; size_t slot_stride;
  __device__ __forceinline__ void operator()(const pg8::f32x4 (&acc)[2][2][4][2], const pg8::Unit& u, int wr, int wc, int fr, int fq) const {
    const int pn = u.pn & 3; const int row0 = u.pm * 256 + wr * 64 + fr, col0 = pn * 256 + wc * 32 + 8 * fq;
    int srcs[2][4]; float ws_[2][4];
#pragma unroll
    for (int ai = 0; ai < 2; ++ai)
#pragma unroll
      for (int m = 0; m < 4; ++m) { const int r = row0 + ai * 128 + m * 16; srcs[ai][m] = srcrow[r]; ws_[ai][m] = wgt[r]; }
#pragma unroll
    for (int ai = 0; ai < 2; ++ai)
#pragma unroll
      for (int m = 0; m < 4; ++m) { const int src = srcs[ai][m]; if (src < 0) continue; const float w = ws_[ai][m];
        bf16_t* dst = contrib + (size_t)(src & 1) * slot_stride + (size_t)(src >> 1) * D + col0;
#pragma unroll
        for (int bj = 0; bj < 2; ++bj) { const pg8::f32x4 v0 = acc[ai][bj][m][0] * w, v1 = acc[ai][bj][m][1] * w;
          v4u o; o.x = pk2(v0[0], v0[1]); o.y = pk2(v0[2], v0[3]); o.z = pk2(v1[0], v1[1]); o.w = pk2(v1[2], v1[3]); *(v4u*)(dst + bj * 128) = o; } }
  }
};
__device__ __forceinline__ void route_row(const bf16_t* xr, const float* gnorm, const float* shift, const float* scale, bf16_t* hrow, const LAS float* rwT, const float* rbias,
                                          LAS int* cnt, Route* rt, float* wts, int lane) {
  typedef float f4 __attribute__((ext_vector_type(4)));
  f4 xv[4]; float ss = 0.f;
#pragma unroll
  for (int j = 0; j < 4; ++j) { const uint2 rw = *(const uint2*)(xr + 4 * lane + 256 * j); xv[j][0] = __uint_as_float(rw.x << 16); xv[j][1] = __uint_as_float(rw.x & 0xffff0000u); xv[j][2] = __uint_as_float(rw.y << 16); xv[j][3] = __uint_as_float(rw.y & 0xffff0000u); ss += xv[j][0] * xv[j][0] + xv[j][1] * xv[j][1] + xv[j][2] * xv[j][2] + xv[j][3] * xv[j][3]; }
  const float rs = __builtin_amdgcn_rsqf(wave_sum(ss) * (1.f / 1024.f) + 1e-6f);
  float lg[NE];
#pragma unroll
  for (int e = 0; e < NE; ++e) lg[e] = 0.f;
#pragma unroll
  for (int j = 0; j < 4; ++j) { const int c = 4 * lane + 256 * j; const f4 g4 = *(const f4*)(gnorm + c), sh = *(const f4*)(shift + c), sc = *(const f4*)(scale + c);
    f4 h;
#pragma unroll
    for (int i = 0; i < 4; ++i) h[i] = xv[j][i] * rs * g4[i] * (1.f + sc[i]) + sh[i];
    *(unsigned long long*)(hrow + c) = (unsigned long long)pk2(h[0], h[1]) | ((unsigned long long)pk2(h[2], h[3]) << 32);
#pragma unroll
    for (int e = 0; e < NE; ++e) { const f4 w4 = *(const LAS f4*)(rwT + e * 1024 + c); lg[e] += h[0] * w4[0] + h[1] * w4[1] + h[2] * w4[2] + h[3] * w4[3]; } }
  { float v8[8], v4[4], v2[2], v1;
#pragma unroll
    for (int i = 0; i < 8; ++i) { const bool up = lane & 1; const float keep = up ? lg[2 * i + 1] : lg[2 * i], send = up ? lg[2 * i] : lg[2 * i + 1]; v8[i] = keep + __shfl_xor(send, 1); }
#pragma unroll
    for (int i = 0; i < 4; ++i) { const bool up = lane & 2; const float keep = up ? v8[2 * i + 1] : v8[2 * i], send = up ? v8[2 * i] : v8[2 * i + 1]; v4[i] = keep + __shfl_xor(send, 2); }
#pragma unroll
    for (int i = 0; i < 2; ++i) { const bool up = lane & 4; const float keep = up ? v4[2 * i + 1] : v4[2 * i], send = up ? v4[2 * i] : v4[2 * i + 1]; v2[i] = keep + __shfl_xor(send, 4); }
    { const bool up = lane & 8; const float keep = up ? v2[1] : v2[0], send = up ? v2[0] : v2[1]; v1 = keep + __shfl_xor(send, 8); }
    v1 += __shfl_xor(v1, 16); v1 += __shfl_xor(v1, 32);
#pragma unroll
    for (int e = 0; e < NE; ++e) lg[e] = __shfl(v1, e); }
  float sc[NE], sel[NE];
#pragma unroll
  for (int e = 0; e < NE; ++e) { sc[e] = 1.f / (1.f + __expf(-lg[e])); sel[e] = sc[e] + rbias[e]; }
  int bestg = 0; float bestgs = -1e30f;
#pragma unroll
  for (int g = 0; g < NG; ++g) { float m1 = -1e30f, m2 = -1e30f;
#pragma unroll
    for (int i = 0; i < EPG; ++i) { const float v = sel[g * EPG + i]; if (v > m1) { m2 = m1; m1 = v; } else if (v > m2) m2 = v; }
    const float gsum = m1 + m2; if (gsum > bestgs) { bestgs = gsum; bestg = g; } }
  int i1 = -1, i2 = -1; float v1 = -1e30f, v2 = -1e30f, s1 = 0.f, s2 = 0.f;
#pragma unroll
  for (int e = 0; e < NE; ++e) { if (e / EPG == bestg) { const float v = sel[e];
      if (v > v1) { v2 = v1; i2 = i1; s2 = s1; v1 = v; i1 = e; s1 = sc[e]; } else if (v > v2) { v2 = v; i2 = e; s2 = sc[e]; } } }
  if (lane == 0) { const float inv = 1.f / (s1 + s2); Route r; r.e0 = i1; r.e1 = i2; r.r0 = __hip_atomic_fetch_add(cnt + i1, 1, __ATOMIC_RELAXED, __HIP_MEMORY_SCOPE_WORKGROUP); r.r1 = __hip_atomic_fetch_add(cnt + i2, 1, __ATOMIC_RELAXED, __HIP_MEMORY_SCOPE_WORKGROUP); *rt = r; wts[0] = s1 * inv; wts[1] = s2 * inv; }
}
__device__ __forceinline__ void route16(const bf16_t* x0, const LAS float* gp, const LAS float* sp, bf16_t* h0, const LAS v4u* wfrag, const float* rbias,
                                        LAS int* cnt, Route* rt0, float* wts0, int lane) {
  typedef float f4 __attribute__((ext_vector_type(4))); typedef short b8 __attribute__((ext_vector_type(8)));
  const int fr = lane & 15, fq = lane >> 4;
  const bf16_t* xr = x0 + (size_t)fr * 1024 + 8 * fq; bf16_t* hr = h0 + (size_t)fr * 1024 + 8 * fq;
  v4u xq[32];
#pragma unroll
  for (int kk = 0; kk < 32; ++kk) xq[kk] = *(const v4u*)(xr + 32 * kk);
  float ss = 0.f;
#pragma unroll
  for (int kk = 0; kk < 32; ++kk) { const v4u q = xq[kk]; float t;
    t = __uint_as_float(q.x << 16); ss += t * t; t = __uint_as_float(q.x & 0xffff0000u); ss += t * t; t = __uint_as_float(q.y << 16); ss += t * t; t = __uint_as_float(q.y & 0xffff0000u); ss += t * t;
    t = __uint_as_float(q.z << 16); ss += t * t; t = __uint_as_float(q.z & 0xffff0000u); ss += t * t; t = __uint_as_float(q.w << 16); ss += t * t; t = __uint_as_float(q.w & 0xffff0000u); ss += t * t; }
  ss += __shfl_xor(ss, 16); ss += __shfl_xor(ss, 32);
  const float rs = __builtin_amdgcn_rsqf(ss * (1.f / 1024.f) + 1e-6f);
#pragma unroll
  for (int kk = 0; kk < 32; ++kk) asm volatile("" : "+v"(xq[kk].x), "+v"(xq[kk].y), "+v"(xq[kk].z), "+v"(xq[kk].w));
  f4 acc = {0.f, 0.f, 0.f, 0.f};
#pragma unroll
  for (int kk = 0; kk < 32; ++kk) { const int c = 32 * kk + 8 * fq; const v4u q = xq[kk];
    const f4 ga = *(const LAS f4*)(gp + c), gb = *(const LAS f4*)(gp + c + 4), ha = *(const LAS f4*)(sp + c), hb = *(const LAS f4*)(sp + c + 4);
    const v4u wh = wfrag[kk * 64 + lane], wl = wfrag[2048 + kk * 64 + lane];
    float h[8];
    h[0] = __uint_as_float(q.x << 16) * (rs * ga[0]) + ha[0]; h[1] = __uint_as_float(q.x & 0xffff0000u) * (rs * ga[1]) + ha[1];
    h[2] = __uint_as_float(q.y << 16) * (rs * ga[2]) + ha[2]; h[3] = __uint_as_float(q.y & 0xffff0000u) * (rs * ga[3]) + ha[3];
    h[4] = __uint_as_float(q.z << 16) * (rs * gb[0]) + hb[0]; h[5] = __uint_as_float(q.z & 0xffff0000u) * (rs * gb[1]) + hb[1];
    h[6] = __uint_as_float(q.w << 16) * (rs * gb[2]) + hb[2]; h[7] = __uint_as_float(q.w & 0xffff0000u) * (rs * gb[3]) + hb[3];
    v4u hq; hq.x = pk2h(h[0], h[1]); hq.y = pk2h(h[2], h[3]); hq.z = pk2h(h[4], h[5]); hq.w = pk2h(h[6], h[7]);
    *(v4u*)(hr + 32 * kk) = hq;
    v4u lq; lq.x = pk2h(h[0] - __uint_as_float(hq.x << 16), h[1] - __uint_as_float(hq.x & 0xffff0000u)); lq.y = pk2h(h[2] - __uint_as_float(hq.y << 16), h[3] - __uint_as_float(hq.y & 0xffff0000u));
    lq.z = pk2h(h[4] - __uint_as_float(hq.z << 16), h[5] - __uint_as_float(hq.z & 0xffff0000u)); lq.w = pk2h(h[6] - __uint_as_float(hq.w << 16), h[7] - __uint_as_float(hq.w & 0xffff0000u));
    acc = __builtin_amdgcn_mfma_f32_16x16x32_bf16(__builtin_bit_cast(b8, wh), __builtin_bit_cast(b8, hq), acc, 0, 0, 0);
    acc = __builtin_amdgcn_mfma_f32_16x16x32_bf16(__builtin_bit_cast(b8, wl), __builtin_bit_cast(b8, hq), acc, 0, 0, 0);
    acc = __builtin_amdgcn_mfma_f32_16x16x32_bf16(__builtin_bit_cast(b8, wh), __builtin_bit_cast(b8, lq), acc, 0, 0, 0);
    if (kk & 1) asm volatile("" ::: "memory"); }
  float sc[4], sel[4]; const f4 rb4 = *(const f4*)(rbias + 4 * fq);
#pragma unroll
  for (int i = 0; i < 4; ++i) { sc[i] = 1.f / (1.f + __expf(-acc[i])); sel[i] = sc[i] + rb4[i]; }
  int i1 = -1, i2 = -1; float v1 = -1e30f, v2 = -1e30f, s1 = 0.f, s2 = 0.f;
#pragma unroll
  for (int i = 0; i < 4; ++i) { const float v = sel[i]; if (v > v1) { v2 = v1; i2 = i1; s2 = s1; v1 = v; i1 = i; s1 = sc[i]; } else if (v > v2) { v2 = v; i2 = i; s2 = sc[i]; } }
  float bgs = v1 + v2; int bg = fq;
  { float og = __shfl_xor(bgs, 16); int oi = __shfl_xor(bg, 16); if (og > bgs || (og == bgs && oi < bg)) { bgs = og; bg = oi; }
    og = __shfl_xor(bgs, 32); oi = __shfl_xor(bg, 32); if (og > bgs || (og == bgs && oi < bg)) { bgs = og; bg = oi; } }
  if (fq == bg) { const float inv = 1.f / (s1 + s2); Route r; r.e0 = 4 * fq + i1; r.e1 = 4 * fq + i2;
    r.r0 = __hip_atomic_fetch_add(cnt + r.e0, 1, __ATOMIC_RELAXED, __HIP_MEMORY_SCOPE_WORKGROUP); r.r1 = __hip_atomic_fetch_add(cnt + r.e1, 1, __ATOMIC_RELAXED, __HIP_MEMORY_SCOPE_WORKGROUP);
    rt0[fr] = r; wts0[2 * fr] = s1 * inv; wts0[2 * fr + 1] = s2 * inv; }
}
}
namespace hy {
typedef float f32x16 __attribute__((ext_vector_type(16)));
constexpr int S = 4096, NT1 = 128, LDZ = 191, ZPAD = 31, LDX = 129;
constexpr int O_TAPS = 0, O_ZA = 32768, O_ZB = O_ZA + 32 * LDZ * 4, O_X1 = O_ZB + 32 * LDZ * 4, O_X2 = O_X1 + 32 * LDX * 4, O_RED = O_X2 + 32 * LDX * 4, O_END = O_RED + 4 * 64 * 16 * 4;
static_assert(O_END <= 131072, "hyena lds");

struct H0Regs { v4u w0, w1; };
__device__ __forceinline__ H0Regs h0_load(const bf16_t* u, int ld, int tile, int tid) {
  const int tt = tile / 24, jt = tile % 24, t0 = tt * 64, j0 = jt * 64; H0Regs r; r.w0 = (v4u){0u, 0u, 0u, 0u}; r.w1 = r.w0;
  { const int rr = tid >> 3, c8 = (tid & 7) * 8, t = t0 - 1 + rr; if (t >= 0 && t < S) r.w0 = *(const v4u*)(u + (size_t)t * ld + j0 + c8); }
  if (tid < 16) { const int rr = 64 + (tid >> 3), c8 = (tid & 7) * 8, t = t0 - 1 + rr; if (t < S) r.w1 = *(const v4u*)(u + (size_t)t * ld + j0 + c8); }
  return r;
}
__device__ __forceinline__ void h0_compute(const H0Regs& rg, const float* cw, const float* cb, bf16_t* ucT, int tile, LAS unsigned char* lds, int tid) {
  const int tt = tile / 24, jt = tile % 24, t0 = tt * 64, j0 = jt * 64;
  LAS float* U = (LAS float*)lds;
  { const int rr = tid >> 3, c8 = (tid & 7) * 8; const v4u w = rg.w0; LAS float* d = U + rr * 65 + c8;
    d[0] = bf2f(w.x & 0xffff); d[1] = bf2f(w.x >> 16); d[2] = bf2f(w.y & 0xffff); d[3] = bf2f(w.y >> 16); d[4] = bf2f(w.z & 0xffff); d[5] = bf2f(w.z >> 16); d[6] = bf2f(w.w & 0xffff); d[7] = bf2f(w.w >> 16); }
  if (tid < 16) { const int rr = 64 + (tid >> 3), c8 = (tid & 7) * 8; const v4u w = rg.w1; LAS float* d = U + rr * 65 + c8;
    d[0] = bf2f(w.x & 0xffff); d[1] = bf2f(w.x >> 16); d[2] = bf2f(w.y & 0xffff); d[3] = bf2f(w.y >> 16); d[4] = bf2f(w.z & 0xffff); d[5] = bf2f(w.z >> 16); d[6] = bf2f(w.w & 0xffff); d[7] = bf2f(w.w >> 16); }
  __syncthreads();
  { const int jj = tid >> 3, tq = (tid & 7) * 8, j = j0 + jj; const float w0 = cw[j], w1 = cw[1536 + j], w2 = cw[2 * 1536 + j], bb = cb[j]; float v[8];
#pragma unroll
    for (int k = 0; k < 8; ++k) v[k] = bb + w0 * U[(tq + k) * 65 + jj] + w1 * U[(tq + k + 1) * 65 + jj] + w2 * U[(tq + k + 2) * 65 + jj];
    v4u o; o.x = pk2(v[0], v[1]); o.y = pk2(v[2], v[3]); o.z = pk2(v[4], v[5]); o.w = pk2(v[6], v[7]); *(v4u*)(ucT + (size_t)j * S + t0 + tq) = o; }
  __syncthreads();
}
__device__ __forceinline__ void h2_tile(const bf16_t* yT, bf16_t* ybf, int ldy, int tile, LAS unsigned char* lds) {
  int tid = threadIdx.x; asm volatile("" : "+v"(tid));
  const int tt = tile / 8, ct = tile % 8, t0 = tt * 64, c0 = ct * 64;
  LAS bf16_t* T = (LAS bf16_t*)lds;
  { const int cc = tid >> 3, t8 = (tid & 7) * 8; const v4u w = *(const v4u*)(yT + (size_t)(c0 + cc) * S + t0 + t8); LAS unsigned* d = (LAS unsigned*)(T + cc * 66 + t8); d[0] = w.x; d[1] = w.y; d[2] = w.z; d[3] = w.w; }
  __syncthreads();
  { const int t = tid >> 3, c8 = (tid & 7) * 8; unsigned short e[8];
#pragma unroll
    for (int k = 0; k < 8; ++k) e[k] = T[(c8 + k) * 66 + t];
    v4u o; o.x = e[0] | ((unsigned)e[1] << 16); o.y = e[2] | ((unsigned)e[3] << 16); o.z = e[4] | ((unsigned)e[5] << 16); o.w = e[6] | ((unsigned)e[7] << 16);
    *(v4u*)(ybf + (size_t)(t0 + t) * ldy + c0 + c8) = o; }
  __syncthreads();
}
__device__ __forceinline__ void h1_unit(const bf16_t* ucT, const float* tapsT, const float* nrm, const float* skip, bf16_t* yT, int c, LAS unsigned char* lds) {
  int tid = threadIdx.x; asm volatile("" : "+v"(tid));
  const int lane = tid & 63, w = __builtin_amdgcn_readfirstlane(tid >> 6), li = lane & 31, lk = lane >> 5;
  LAS float* TAPS = (LAS float*)(lds + O_TAPS); LAS float* ZA = (LAS float*)(lds + O_ZA); LAS float* ZB = (LAS float*)(lds + O_ZB);
  LAS float* X1 = (LAS float*)(lds + O_X1); LAS float* X2 = (LAS float*)(lds + O_X2); LAS float* RED = (LAS float*)(lds + O_RED);
  for (int e = tid; e < 32 * 62; e += 512) { const int s2 = e / 62, p = e % 62, t1p = p < 31 ? p : 128 + p; ZA[s2 * LDZ + t1p] = 0.f; ZB[s2 * LDZ + t1p] = 0.f; }
  for (int t = tid; t < S; t += 512) { const int t2 = t & 31, t1 = t >> 5;
    X1[t2 * LDX + t1] = bf2f(ucT[(size_t)c * S + t]); X2[t2 * LDX + t1] = bf2f(ucT[(size_t)(512 + c) * S + t]); ZA[t2 * LDZ + t1 + ZPAD] = bf2f(ucT[(size_t)(1024 + c) * S + t]); }
#pragma unroll 1
  for (int o = 0; o < 2; ++o) {
    const float* tp = tapsT + ((size_t)o * 512 + c) * 8192;
    for (int e = tid; e < 8192; e += 512) TAPS[e] = tp[(e + 4096) & 8191];
    __syncthreads();
    const LAS float* Zin = o == 0 ? ZA : ZB;
    const int g = w & 3, dh = w >> 2;
    const int Dlo = 32 * g - 127 + (dh ? 80 : 0), Dn = dh ? 79 : 80;
    f32x16 acc = {};
    { const LAS float* ap = TAPS + 4096 + 32 * Dlo + li - lk - 30;
      const LAS float* bp = Zin + lk * LDZ + (32 * g + li - Dlo + ZPAD);
#pragma unroll 2
      for (int dd = 0; dd < Dn; ++dd) {
#pragma unroll
        for (int kk = 0; kk < 16; ++kk) acc = __builtin_amdgcn_mfma_f32_32x32x2f32(ap[(15 - kk) * 2], bp[2 * kk * LDZ], acc, 0, 0, 0);
        ap += 32; bp -= 1; }
    }
    if (dh) {
#pragma unroll
      for (int r = 0; r < 16; ++r) RED[(g * 64 + lane) * 16 + r] = acc[r]; }
    __syncthreads();
    if (!dh) { const float inv = 1.f / nrm[o * 512 + c], sk = skip[o * 512 + c]; const LAS float* G = o == 0 ? X1 : X2; LAS float* Out = o == 0 ? ZB : ZA;
#pragma unroll
      for (int r = 0; r < 16; ++r) { const int t2 = (r & 3) + 8 * (r >> 2) + 4 * lk, t1 = 32 * g + li;
        const float cv = (acc[r] + RED[(g * 64 + lane) * 16 + r]) * inv; const float zin = Zin[t2 * LDZ + t1 + ZPAD];
        Out[t2 * LDZ + t1 + ZPAD] = G[t2 * LDX + t1] * (cv + sk * zin); } }
    __syncthreads();
  }
  for (int t = tid; t < S; t += 512) yT[(size_t)c * S + t] = (bf16_t)f2bf(ZA[(t & 31) * LDZ + (t >> 5) + ZPAD]);
  __syncthreads();
}

typedef short bf16x8v __attribute__((ext_vector_type(8)));
typedef unsigned u32x2v __attribute__((ext_vector_type(2)));
constexpr int CSB = 16448;
constexpr int ZROW = 80, ZROWS = 190;
constexpr int B_CS = 0, B_ZA = 4 * CSB, B_ZB = B_ZA + 15232, B_X1 = B_ZB + 15232, B_X2 = B_X1 + 8256, B_RED = B_X2 + 8256, B_END = B_RED + 16384;
static_assert(B_END <= 131072 && B_ZA % 16 == 0 && B_X1 % 16 == 0, "hyena bf16 lds");
__device__ __forceinline__ void h1b_unit(const bf16_t* ucT, const bf16_t* tapsB, const float* nrm, const float* skip, bf16_t* yT, int c, LAS unsigned char* lds) {
  int tid = threadIdx.x; asm volatile("" : "+v"(tid));
  const int lane = tid & 63, w = __builtin_amdgcn_readfirstlane(tid >> 6), li = lane & 31, lk = lane >> 5;
  LAS bf16_t* ZA = (LAS bf16_t*)(lds + B_ZA); LAS bf16_t* ZB = (LAS bf16_t*)(lds + B_ZB); LAS bf16_t* X1 = (LAS bf16_t*)(lds + B_X1); LAS bf16_t* X2 = (LAS bf16_t*)(lds + B_X2);
  LAS float* RED = (LAS float*)(lds + B_RED);
  for (int e = tid; e < 62 * 20; e += 512) { const int p = e / 20, d = e % 20, row = p < 31 ? p : 128 + p; ((LAS unsigned*)ZA)[row * 20 + d] = 0u; ((LAS unsigned*)ZB)[row * 20 + d] = 0u; }
  { const v4u zv = *(const v4u*)(ucT + (size_t)(1024 + c) * S + tid * 8); const int t = tid * 8; *(LAS v4u*)((LAS unsigned char*)ZA + ((t >> 5) + ZPAD) * ZROW + (t & 31) * 2) = zv; }
  { const v4u xa = *(const v4u*)(ucT + (size_t)c * S + tid * 8), xb = *(const v4u*)(ucT + (size_t)(512 + c) * S + tid * 8); const int t1 = tid >> 2, t2b = (tid & 3) * 8;
    const unsigned wa[4] = {xa.x, xa.y, xa.z, xa.w}, wb[4] = {xb.x, xb.y, xb.z, xb.w};
#pragma unroll
    for (int k = 0; k < 4; ++k) { X1[(t2b + 2 * k) * LDX + t1] = (bf16_t)(wa[k] & 0xffff); X1[(t2b + 2 * k + 1) * LDX + t1] = (bf16_t)(wa[k] >> 16);
      X2[(t2b + 2 * k) * LDX + t1] = (bf16_t)(wb[k] & 0xffff); X2[(t2b + 2 * k + 1) * LDX + t1] = (bf16_t)(wb[k] >> 16); } }
  typedef unsigned u4a __attribute__((ext_vector_type(4), aligned(4))); typedef const __attribute__((address_space(1))) u4a* gp4;
  v4u cv[9];
#pragma unroll 1
  for (int o = 0; o < 2; ++o) {
#define HTAPS_LOAD(oo) { const __attribute__((address_space(1))) unsigned char* tb = (const __attribute__((address_space(1))) unsigned char*)(tapsB + ((size_t)(oo) * 512 + c) * 2 * 8232); \
      _Pragma("unroll") for (int it = 0; it < 9; ++it) { const int e = tid + 512 * it; const int s = e / 1028, q = e % 1028; cv[it] = (v4u){0u, 0u, 0u, 0u}; if (e < 4 * 1028) cv[it] = *(gp4)(tb + (size_t)(s & 1) * 16464 + 16 * q + 4 * (s >> 1)); } }
    if (o == 0) HTAPS_LOAD(0)
    {
#pragma unroll
      for (int it = 0; it < 9; ++it) { const int e = tid + 512 * it; const int s = e / 1028, q = e % 1028; if (e < 4 * 1028) *(LAS v4u*)(lds + B_CS + s * CSB + 16 * q) = cv[it]; } }
    __syncthreads();
    if (o == 0) HTAPS_LOAD(1)
    const LAS bf16_t* Zin = o == 0 ? ZA : ZB;
    const int g = w & 3, dh = w >> 2;
    const int Dlo = 32 * g - 127 + (dh ? 81 : 0), Dn = dh ? 78 : 81;
    f32x16 acc = {};
    { const int s = (4 - (li & 3)) & 3;
      const LAS unsigned char* ap = lds + B_CS + s * CSB + 2 * (4096 - 32 * Dlo - li + 8 * lk - s);
      const LAS unsigned char* bp = (const LAS unsigned char*)Zin + (32 * g + li - Dlo + ZPAD) * ZROW + 16 * lk;
#define HLD(A0, A1, B0, B1) { const u32x2v p0_ = *(const LAS u32x2v*)(ap), p1_ = *(const LAS u32x2v*)(ap2), p2_ = *(const LAS u32x2v*)(ap3), p3_ = *(const LAS u32x2v*)(ap4); \
        A0 = (v4u){p0_.x, p0_.y, p1_.x, p1_.y}; A1 = (v4u){p2_.x, p2_.y, p3_.x, p3_.y}; B0 = *(const LAS v4u*)(bp); B1 = *(const LAS v4u*)(bp + 32); ap -= 64; ap2 -= 64; ap3 -= 64; ap4 -= 64; bp -= ZROW; }
#define HMM(A, B) acc = __builtin_amdgcn_mfma_f32_32x32x16_bf16(__builtin_bit_cast(bf16x8v, A), __builtin_bit_cast(bf16x8v, B), acc, 0, 0, 0)
#define HOPQ(name, off) unsigned name##i = (unsigned)(unsigned long long)(ap + (off)); asm volatile("" : "+v"(name##i)); const LAS unsigned char* name = (const LAS unsigned char*)(unsigned long long)name##i;
      HOPQ(ap2, 8) HOPQ(ap3, 32) HOPQ(ap4, 40)
#undef HOPQ
      v4u fa0, fa1, fb0, fb1, ga0, ga1, gb0, gb1, ha0, ha1, hb0, hb1;
      HLD(fa0, fa1, fb0, fb1)
      HLD(ga0, ga1, gb0, gb1)
      for (int dd_ = 0; dd_ < Dn - 3; dd_ += 3) {
        HLD(ha0, ha1, hb0, hb1)
        HMM(fa0, fb0); HMM(fa1, fb1);
        HLD(fa0, fa1, fb0, fb1)
        HMM(ga0, gb0); HMM(ga1, gb1);
        HLD(ga0, ga1, gb0, gb1)
        HMM(ha0, hb0); HMM(ha1, hb1);
      }
      HLD(ha0, ha1, hb0, hb1)
      HMM(fa0, fb0); HMM(fa1, fb1); HMM(ga0, gb0); HMM(ga1, gb1); HMM(ha0, hb0); HMM(ha1, hb1);
#undef HLD
#undef HMM
    }
    if (dh) {
#pragma unroll
      for (int r = 0; r < 16; ++r) RED[(g * 64 + lane) * 16 + r] = acc[r]; }
    __syncthreads();
    if (!dh) { const float inv = 1.f / nrm[o * 512 + c], sk = skip[o * 512 + c]; const LAS bf16_t* G = o == 0 ? X1 : X2; LAS bf16_t* Out = o == 0 ? ZB : ZA;
#pragma unroll
      for (int r = 0; r < 16; ++r) { const int t2 = (r & 3) + 8 * (r >> 2) + 4 * lk, t1 = 32 * g + li;
        const float cv = (acc[r] + RED[(g * 64 + lane) * 16 + r]) * inv; const float zin = bf2f(Zin[(t1 + ZPAD) * (ZROW / 2) + t2]);
        Out[(t1 + ZPAD) * (ZROW / 2) + t2] = (bf16_t)f2bf(bf2f(G[t2 * LDX + t1]) * (cv + sk * zin)); } }
    __syncthreads();
  }
  { const int t = tid * 8; *(v4u*)(yT + (size_t)c * S + t) = *(const LAS v4u*)((const LAS unsigned char*)ZA + ((t >> 5) + ZPAD) * ZROW + (t & 31) * 2); }
  __syncthreads();
}
#undef HTAPS_LOAD

constexpr int C_ZP = 15, C_ZB = 159 * ZROW  , C_CS = 0, C_Z0 = 4 * CSB, C_X0 = C_Z0 + 2 * C_ZB, C_END = C_X0 + 4 * 8256;
static_assert(C_END <= 131072 && C_Z0 % 16 == 0 && C_ZB % 16 == 0 && C_X0 % 16 == 0, "hyena two-batch lds");
__device__ __forceinline__ void h1c_unit(const bf16_t* ucT2, const bf16_t* tapsB, const float* nrm, const float* skip, bf16_t* yT2, int c, LAS unsigned char* lds) {
  int tid = threadIdx.x; asm volatile("" : "+v"(tid));
  const int lane = tid & 63, g = __builtin_amdgcn_readfirstlane(tid >> 6), li = lane & 31, lk = lane >> 5, bsel = li >> 4, t1l = li & 15;
  for (int e = tid; e < 2 * 31 * 20; e += 512) { const int b = e / (31 * 20), p = (e / 20) % 31, d = e % 20, row = p < 15 ? p : 128 + p; ((LAS unsigned*)(lds + C_Z0 + b * C_ZB))[row * 20 + d] = 0u; }
#pragma unroll
  for (int b = 0; b < 2; ++b) { const bf16_t* uc = ucT2 + (size_t)b * 1536 * S; const int t = tid * 8;
    const v4u zv = *(const v4u*)(uc + (size_t)(1024 + c) * S + t), xa = *(const v4u*)(uc + (size_t)c * S + t), xb = *(const v4u*)(uc + (size_t)(512 + c) * S + t);
    *(LAS v4u*)(lds + C_Z0 + b * C_ZB + ((t >> 5) + C_ZP) * ZROW + (t & 31) * 2) = zv;
    LAS bf16_t* X1 = (LAS bf16_t*)(lds + C_X0 + (2 * b) * 8256); LAS bf16_t* X2 = (LAS bf16_t*)(lds + C_X0 + (2 * b + 1) * 8256); const int t1 = tid >> 2, t2b = (tid & 3) * 8;
    const unsigned wa[4] = {xa.x, xa.y, xa.z, xa.w}, wb[4] = {xb.x, xb.y, xb.z, xb.w};
#pragma unroll
    for (int k = 0; k < 4; ++k) { X1[(t2b + 2 * k) * LDX + t1] = (bf16_t)(wa[k] & 0xffff); X1[(t2b + 2 * k + 1) * LDX + t1] = (bf16_t)(wa[k] >> 16);
      X2[(t2b + 2 * k) * LDX + t1] = (bf16_t)(wb[k] & 0xffff); X2[(t2b + 2 * k + 1) * LDX + t1] = (bf16_t)(wb[k] >> 16); } }
  typedef unsigned u4a __attribute__((ext_vector_type(4), aligned(4))); typedef const __attribute__((address_space(1))) u4a* gp4;
  v4u cv[9];
  LAS bf16_t* Zm = (LAS bf16_t*)(lds + C_Z0 + bsel * C_ZB);
#pragma unroll 1
  for (int o = 0; o < 2; ++o) {
#define HTAPS_LOAD(oo) { const __attribute__((address_space(1))) unsigned char* tb = (const __attribute__((address_space(1))) unsigned char*)(tapsB + ((size_t)(oo) * 512 + c) * 2 * 8232); \
      _Pragma("unroll") for (int it = 0; it < 9; ++it) { const int e = tid + 512 * it; const int s = e / 1028, q = e % 1028; cv[it] = (v4u){0u, 0u, 0u, 0u}; if (e < 4 * 1028) cv[it] = *(gp4)(tb + (size_t)(s & 1) * 16464 + 16 * q + 4 * (s >> 1)); } }
    if (o == 0) HTAPS_LOAD(0)
    {
#pragma unroll
      for (int it = 0; it < 9; ++it) { const int e = tid + 512 * it; const int s = e / 1028, q = e % 1028; if (e < 4 * 1028) *(LAS v4u*)(lds + C_CS + s * CSB + 16 * q) = cv[it]; } }
    __syncthreads();
    if (o == 0) HTAPS_LOAD(1)
    const int Dlo = 16 * g - 128; constexpr int Dn = 144;
    f32x16 acc = {};
    { const int s = (4 - (li & 3)) & 3;
      const LAS unsigned char* ap = lds + C_CS + s * CSB + 2 * (4096 - 32 * Dlo - li + 8 * lk - s);
      const LAS unsigned char* bp = (const LAS unsigned char*)Zm + (16 * g + t1l - Dlo + C_ZP) * ZROW + 16 * lk;
#define HLD(A0, A1, B0, B1) { const u32x2v p0_ = *(const LAS u32x2v*)(ap), p1_ = *(const LAS u32x2v*)(ap2), p2_ = *(const LAS u32x2v*)(ap3), p3_ = *(const LAS u32x2v*)(ap4); \
        A0 = (v4u){p0_.x, p0_.y, p1_.x, p1_.y}; A1 = (v4u){p2_.x, p2_.y, p3_.x, p3_.y}; B0 = *(const LAS v4u*)(bp); B1 = *(const LAS v4u*)(bp + 32); ap -= 64; ap2 -= 64; ap3 -= 64; ap4 -= 64; bp -= ZROW; }
#define HMM(A, B) acc = __builtin_amdgcn_mfma_f32_32x32x16_bf16(__builtin_bit_cast(bf16x8v, A), __builtin_bit_cast(bf16x8v, B), acc, 0, 0, 0)
#define HOPQ(name, off) unsigned name##i = (unsigned)(unsigned long long)(ap + (off)); asm volatile("" : "+v"(name##i)); const LAS unsigned char* name = (const LAS unsigned char*)(unsigned long long)name##i;
      HOPQ(ap2, 8) HOPQ(ap3, 32) HOPQ(ap4, 40)
#undef HOPQ
      v4u fa0, fa1, fb0, fb1, ga0, ga1, gb0, gb1, ha0, ha1, hb0, hb1;
      HLD(fa0, fa1, fb0, fb1)
      HLD(ga0, ga1, gb0, gb1)
      for (int dd_ = 0; dd_ < Dn - 3; dd_ += 3) {
        HLD(ha0, ha1, hb0, hb1)
        HMM(fa0, fb0); HMM(fa1, fb1);
        HLD(fa0, fa1, fb0, fb1)
        HMM(ga0, gb0); HMM(ga1, gb1);
        HLD(ga0, ga1, gb0, gb1)
        HMM(ha0, hb0); HMM(ha1, hb1);
      }
      HLD(ha0, ha1, hb0, hb1)
      HMM(fa0, fb0); HMM(fa1, fb1); HMM(ga0, gb0); HMM(ga1, gb1); HMM(ha0, hb0); HMM(ha1, hb1);
#undef HLD
#undef HMM
    }
    __syncthreads();
    { const float inv = 1.f / nrm[o * 512 + c], sk = skip[o * 512 + c]; const LAS bf16_t* G = (const LAS bf16_t*)(lds + C_X0 + (2 * bsel + o) * 8256);
#pragma unroll
      for (int r = 0; r < 16; ++r) { const int t2 = (r & 3) + 8 * (r >> 2) + 4 * lk, t1 = 16 * g + t1l;
        const float cvv = acc[r] * inv; const float zin = bf2f(Zm[(t1 + C_ZP) * (ZROW / 2) + t2]);
        Zm[(t1 + C_ZP) * (ZROW / 2) + t2] = (bf16_t)f2bf(bf2f(G[t2 * LDX + t1]) * (cvv + sk * zin)); } }
    __syncthreads();
  }
#pragma unroll
  for (int b = 0; b < 2; ++b) { const int t = tid * 8; *(v4u*)(yT2 + (size_t)b * 512 * S + (size_t)c * S + t) = *(const LAS v4u*)(lds + C_Z0 + b * C_ZB + ((t >> 5) + C_ZP) * ZROW + (t & 31) * 2); }
  __syncthreads();
#undef HTAPS_LOAD
}
__device__ __forceinline__ void cconv3_item(const bf16_t* u, int ld, const float* cw, const float* cb, float* ucc, long idx) {
  const int j = (int)(idx % 1536); const int tc = (int)(idx / 1536);
  const bf16_t* up = u + (size_t)tc * ld + j;
  float v = cb[j] + cw[1536 + j] * bf2f(up[0]);
  if (tc > 0) v += cw[j] * bf2f(*(up - ld)); if (tc < 255) v += cw[2 * 1536 + j] * bf2f(up[ld]);
  ucc[idx] = v;
}
__device__ __forceinline__ void clong_item(const float* ucc, const float* z1c_in, float* z1c_out, bf16_t* yout, int ldy, const float* tapsC, const float* nrmC, const float* skip, int o, long idx) {
  const int c = (int)(idx % 512), t0 = (int)(idx / 512) * 8; constexpr int n = 256;
  const float* tp = tapsC + (size_t)o * 2 * n * 512 + c; const float nr = nrmC[o * 512 + c];
  const float* zs = o == 0 ? ucc + 1024 + c : z1c_in + c; const int ldz = o == 0 ? 1536 : 512;
  float acc[8], w[8];
#pragma unroll
  for (int i = 0; i < 8; ++i) { acc[i] = 0.f; const int lag = t0 + i; w[i] = tp[(size_t)lag * 512]; }
#pragma unroll 4
  for (int s = 0; s < n; ++s) { const float zv = zs[(size_t)s * ldz];
#pragma unroll
    for (int i = 0; i < 8; ++i) acc[i] += w[i] * zv;
    const int lag = t0 - s - 1;
    const float nw = tp[(size_t)(lag >= 0 ? lag : 2 * n + lag) * 512];
#pragma unroll
    for (int i = 7; i > 0; --i) w[i] = w[i - 1];
    w[0] = nw; }
  const float sk = skip[o * 512 + c];
#pragma unroll
  for (int i = 0; i < 8; ++i) { const int t = t0 + i; const float val = ucc[(size_t)t * 1536 + o * 512 + c] * (acc[i] / nr + sk * zs[(size_t)t * ldz]);
    if (o == 0) z1c_out[(size_t)t * 512 + c] = val; else yout[(size_t)t * ldy + c] = (bf16_t)f2bf(val); }
}
}
#define XB_TMO      128
#define XB_XCNT(j)  (256  + 64 * (j))
#define XB_XSUB(j)  (1280 + 64 * (j))
#define XB_XGEN(j)  (2304 + 64 * (j))
#define XB_TOP      3328
#define XB_TOPGEN   3392
#define XCD_BAR_WORDS 3456
#define XB_SPIN_CAP (1u << 18)

__device__ __forceinline__ unsigned xb_ld(unsigned* p)              { return __hip_atomic_load(p, __ATOMIC_RELAXED, __HIP_MEMORY_SCOPE_AGENT); }
__device__ __forceinline__ unsigned xb_add(unsigned* p, unsigned v) { return __hip_atomic_fetch_add(p, v, __ATOMIC_RELAXED, __HIP_MEMORY_SCOPE_AGENT); }
__device__ __forceinline__ unsigned xb_xcc_id() { return (unsigned)__builtin_amdgcn_s_getreg((3 << 11) | 20) & 0xFu; }
#define XB_SPIN(cond, bar) do { unsigned _sp = 0; while (cond) { __builtin_amdgcn_s_sleep(1); \
    if ((++_sp & 255u) == 0u) { if (xb_ld(&(bar)[XB_TMO])) break; if (_sp > XB_SPIN_CAP) { atomicAdd(&(bar)[XB_TMO], 1u); break; } } } } while (0)

struct XcdBarrier {
    unsigned* bar; unsigned x;
    volatile LAS unsigned* st;
};

__device__ __forceinline__ XcdBarrier xcd_barrier_post(unsigned* bar, volatile LAS unsigned* st) {
    XcdBarrier b; b.bar = bar; b.x = xb_xcc_id(); b.st = st;
    if (threadIdx.x == 0) (void)xb_add(&bar[XB_XCNT(b.x)], 1u);
    return b;
}
__device__ __forceinline__ void xcd_barrier_complete(unsigned* bar, unsigned x, unsigned& nloc, unsigned& nx) {
    const unsigned G = gridDim.x * gridDim.y * gridDim.z;
    unsigned sum, cnt, mine, sp = 0u;
    for (;;) {
        sum = 0u; cnt = 0u; mine = 0u;
#pragma unroll
        for (unsigned j = 0; j < 16; ++j) { const unsigned c = xb_ld(&bar[XB_XCNT(j)]); sum += c; cnt += (c > 0u) ? 1u : 0u; mine = (j == x) ? c : mine; }
        if (sum == G) break;
        __builtin_amdgcn_s_sleep(1);
        if ((++sp & 255u) == 0u) { if (xb_ld(&bar[XB_TMO])) break; if (sp > XB_SPIN_CAP) { atomicAdd(&bar[XB_TMO], 1u); break; } }
    }
    nloc = mine > 0u ? mine : 1u; nx = cnt > 0u ? cnt : 1u;
}

__device__ __forceinline__ void xcd_barrier(const XcdBarrier& b) {
    asm volatile("s_waitcnt vmcnt(0)" ::: "memory");
    __syncthreads();
    if (threadIdx.x == 0) {
        unsigned* bar = b.bar;
#define XB_SP(word) ((unsigned*)((((unsigned long long)(unsigned)__builtin_amdgcn_readfirstlane((int)((unsigned long long)(bar + (word)) >> 32))) << 32) | (unsigned)__builtin_amdgcn_readfirstlane((int)(unsigned)(unsigned long long)(bar + (word)))))
        unsigned* const p_xsub = XB_SP(XB_XSUB(b.x)); unsigned* const p_xgen = XB_SP(XB_XGEN(b.x));
        __builtin_amdgcn_s_waitcnt(0);
        unsigned nloc = b.st[0], nx = b.st[1];
        if (nloc == 0u) { xcd_barrier_complete(bar, b.x, nloc, nx); b.st[0] = nloc; b.st[1] = nx; }
        const unsigned old = xb_add(p_xsub, 1u);
        const unsigned gen = old / nloc;
        if (old + 1u == (gen + 1u) * nloc) {
            __builtin_amdgcn_fence(__ATOMIC_RELEASE, "agent");
            asm volatile("s_waitcnt vmcnt(0)" ::: "memory");
            const unsigned og = xb_add(&bar[XB_TOP], 1u);
            const unsigned tg = og / nx;
            if (og + 1u == (tg + 1u) * nx) xb_add(&bar[XB_TOPGEN], 1u);
            else XB_SPIN(xb_ld(&bar[XB_TOPGEN]) == tg, bar);
            __builtin_amdgcn_fence(__ATOMIC_ACQUIRE, "agent");
            xb_add(p_xgen, 1u);
            asm volatile("s_waitcnt vmcnt(0)" ::: "memory");
        } else {
            XB_SPIN(xb_ld(p_xgen) == gen, bar);
            __builtin_amdgcn_fence(__ATOMIC_ACQUIRE, "agent");
            asm volatile("s_waitcnt vmcnt(0)" ::: "memory");
        }
    }
    __syncthreads();
}
#include <math.h>
#ifdef HOST_TEST
#define HD
#define FEXP expf
#define FSIN sinf
#define FCOS cosf
#define FLOG logf
#define FPOW powf
#else
#define HD __device__ __forceinline__
#define FEXP __expf
#define FSIN __sinf
#define FCOS __cosf
#define FLOG __logf
#define FPOW __powf
#endif

struct FullDims { static constexpr int D=1024,B=8,S=4096,DEPTH=2,C=256,GW=64,AH=8,AKV=2,HDM=128,GH=4,GDK=64,GDV=128,GR=16,HW=512,HB=16,HF=64,NE=16,NG=4,DE=512; };
struct SmallDims { static constexpr int D=64,B=2,S=128,DEPTH=2,C=32,GW=16,AH=4,AKV=2,HDM=16,GH=2,GDK=8,GDV=16,GR=4,HW=32,HB=4,HF=8,NE=8,NG=2,DE=32; };

template <class T> struct DD {
  static constexpr int D=T::D,B=T::B,S=T::S,DEPTH=T::DEPTH,C=T::C,GW=T::GW,AH=T::AH,AKV=T::AKV,HDM=T::HDM,GH=T::GH,GDK=T::GDK,GDV=T::GDV,GR=T::GR,HW=T::HW,HB=T::HB,HF=T::HF,NE=T::NE,NG=T::NG,DE=T::DE;
  static constexpr int R=S+C, AG=AH/AKV, RP=HDM/4, HE=1+2*HB, EPG=NE/NG, AQW=AH*HDM, AKVW=AKV*HDM, GKW=GH*GDK, GVW=GH*GDV;
  static constexpr int NKV=AKVW+AKVW+GKW+GVW+2*GR, NIN=NKV+AQW+GKW+GVW+3*HW+3*D;
  static constexpr int O_AK=0, O_AV=AKVW, O_GK=2*AKVW, O_GV=2*AKVW+GKW, O_GA=2*AKVW+GKW+GVW;
  static constexpr int O_AQ=NKV, O_GQ=NKV+AQW, O_OG=O_GQ+GKW, O_HY=O_OG+GVW, O_BR=O_HY+3*HW;
};

struct NaiveBufs {
  const float *x,*c,*ctx,*c_ctx,*w_mod,*b_mod,*norm1_g,*norm2_g,*w_in,*q_norm_g,*k_norm_g,*gla_wa2,*gla_ba,*gla_norm_g,*hy_conv_w,*hy_conv_b,
    *hy_pos_w1,*hy_pos_b1,*hy_sin_freq,*hy_pos_w2,*hy_pos_b2,*hy_pos_w3,*hy_decay,*hy_skip,*w_br_hy,*w_br_gla,*w_br_att,*w_out,*router_w,*router_b,*moe_w_gate,*moe_w_up,*moe_w_down;
  float* out;
  float *mod;
  float *hid2S,*hid2C;
  float *tapsS,*tapsC;
  float *nrmS,*nrmC;
  float *rs;
  float *h;
  float *proj;
  float *qn,*kn;
  float *yatt;
  float *laf,*lab;
  float *of,*ob;
  float *ygla;
  float *uc;
  float *z1,*yhy;
  float *m;
  int   *ridx;
  float *rw;
  float *hid;
  float *xc;
};

HD float sigmoidf_(float x) { return 1.f / (1.f + FEXP(-x)); }
HD float siluf_(float x) { return x / (1.f + FEXP(-x)); }
HD float logsigmoidf_(float x) { return x < 0.f ? x - FLOG(1.f + FEXP(x)) : -FLOG(1.f + FEXP(-x)); }

template <class T> HD void st_mod(const NaiveBufs& a, int l, long idx) {
  using d = DD<T>; const int j = (int)(idx % (6 * d::D)), bb = (int)(idx / (6 * d::D));
  const float* cv = bb < d::B ? a.c + (long)bb * d::D : a.c_ctx; const float* w = a.w_mod + (long)l * d::D * 6 * d::D;
  float acc = a.b_mod[(long)l * 6 * d::D + j];
  for (int k = 0; k < d::D; ++k) acc += siluf_(cv[k]) * w[(long)k * 6 * d::D + j];
  a.mod[idx] = acc;
}
template <class T> HD void st_hyhid(const NaiveBufs& a, int l, int which, long idx) {
  using d = DD<T>; const int n = which ? d::C : d::S; float* dst = which ? a.hid2C : a.hid2S;
  const int j = (int)(idx % d::HF), t = (int)(idx / d::HF);
  const float* w1 = a.hy_pos_w1 + (long)l * d::HE * d::HF; const float* b1 = a.hy_pos_b1 + l * d::HF; const float* fr = a.hy_sin_freq + l * d::HF;
  const float* w2 = a.hy_pos_w2 + (long)l * d::HF * d::HF; const float* b2 = a.hy_pos_b2 + l * d::HF;
  const float tn = (float)t / (float)n; const float w0 = 2.f * 3.14159265358979323846f / (float)n;
  float acc2 = b2[j];
  for (int i = 0; i < d::HF; ++i) {
    float acc = b1[i] + tn * w1[0 * d::HF + i];
    for (int bnd = 0; bnd < d::HB; ++bnd) {
      const float band = 1e-4f + (float)bnd * ((float)(d::HB - 1) - 1e-4f) / (float)(d::HB - 1);
      const float ph = w0 * (float)t * band;
      acc += FCOS(ph) * w1[(1 + bnd) * d::HF + i] - FSIN(ph) * w1[(1 + d::HB + bnd) * d::HF + i];
    }
    acc2 += FSIN(fr[i] * acc) * w2[i * d::HF + j];
  }
  dst[idx] = FSIN(fr[j] * acc2);
}
template <class T> HD void st_hytaps(const NaiveBufs& a, int l, int which, long idx) {
  using d = DD<T>; const int n = which ? d::C : d::S; const float* hid2 = which ? a.hid2C : a.hid2S; float* dst = which ? a.tapsC : a.tapsS;
  const int c = (int)(idx % d::HW); const int li = (int)((idx / d::HW) % (2 * n)); const int o = (int)(idx / ((long)d::HW * 2 * n));
  float v = 0.f;
  if (li != n) {
    const int dir = li < n ? 0 : 1; const int t = li < n ? li : 2 * n - li;
    const int col = (o * 2 + dir) * d::HW + c;
    const float* w3 = a.hy_pos_w3 + (long)l * d::HF * 4 * d::HW;
    float acc = 0.f;
    for (int j = 0; j < d::HF; ++j) acc += hid2[(long)t * d::HF + j] * w3[(long)j * 4 * d::HW + col];
    const float dec = fabsf(a.hy_decay[(long)l * 4 * d::HW + col]);
    v = acc * FEXP(-((float)t / (float)n) * dec);
  }
  if (which == 0) dst[((long)o * d::HW + c) * 2 * n + li] = v; else dst[idx] = v;
}
template <class T> HD void st_hynorm(const NaiveBufs& a, int which, long idx) {
  using d = DD<T>; const int n = which ? d::C : d::S; const float* tp = which ? a.tapsC : a.tapsS; float* dst = which ? a.nrmC : a.nrmS;
  const int c = (int)(idx % d::HW), o = (int)(idx / d::HW);
  float s = 0.f; for (int li = 0; li < 2 * n; ++li) s += fabsf(which == 0 ? tp[((long)o * d::HW + c) * 2 * n + li] : tp[((long)o * 2 * n + li) * d::HW + c]);
  dst[idx] = s + 1e-6f;
}

template <class T> HD const float* xrow(const NaiveBufs& a, int l, int b, int r) {
  using d = DD<T>;
  if (r < d::S) return (l == 0 ? a.x : a.out) + ((long)b * d::S + r) * d::D;
  return (l == 0 ? a.ctx : a.xc) + ((long)b * d::C + (r - d::S)) * d::D;
}
template <class T> HD float* xrow_w(const NaiveBufs& a, int b, int r) {
  using d = DD<T>;
  if (r < d::S) return a.out + ((long)b * d::S + r) * d::D;
  return a.xc + ((long)b * d::C + (r - d::S)) * d::D;
}
template <class T> HD void st_rs(const NaiveBufs& a, int l, int b, int src, long idx) {
  using d = DD<T>; const int r = (int)idx; const float* xr = src ? (const float*)xrow_w<T>(a, b, r) : xrow<T>(a, l, b, r);
  float s = 0.f; for (int k = 0; k < d::D; ++k) s += xr[k] * xr[k];
  a.rs[r] = 1.f / sqrtf(s / (float)d::D + 1e-6f);
}
template <class T> HD void st_norm(const NaiveBufs& a, int l, int b, int which, long idx) {
  using d = DD<T>; const int j = (int)(idx % d::D), r = (int)(idx / d::D);
  const float* xr = which ? (const float*)xrow_w<T>(a, b, r) : xrow<T>(a, l, b, r);
  const float* g = (which ? a.norm2_g : a.norm1_g) + (long)l * d::D;
  const float* md = a.mod + (long)(r < d::S ? b : d::B) * 6 * d::D;
  const float shift = md[(which ? 3 : 0) * d::D + j], scale = md[(which ? 4 : 1) * d::D + j];
  a.h[idx] = xr[j] * a.rs[r] * g[j] * (1.f + scale) + shift;
}
struct GemmArgs { const float* A; int lda; const float* W; int ldw; float* Cc; int ldc; int M, N, K;
  const float* gate; int ldg;
  const float* colscale;
  const float* res; int ldr;
  int accumulate; };
HD void st_gemm(const GemmArgs& g, long idx) {
  const int nb = g.N / 4; const int cb = (int)(idx % nb), rb = (int)(idx / nb);
  float acc[4][4];
#pragma unroll
  for (int i = 0; i < 4; ++i) {
#pragma unroll
    for (int j = 0; j < 4; ++j) acc[i][j] = 0.f; }
  const float* a0 = g.A + (long)(rb * 4) * g.lda; const float* w0 = g.W + cb * 4;
  for (int k = 0; k < g.K; ++k) {
    float av[4], wv[4];
#pragma unroll
    for (int i = 0; i < 4; ++i) av[i] = a0[(long)i * g.lda + k];
#pragma unroll
    for (int j = 0; j < 4; ++j) wv[j] = w0[(long)k * g.ldw + j];
#pragma unroll
    for (int i = 0; i < 4; ++i) {
#pragma unroll
      for (int j = 0; j < 4; ++j) acc[i][j] += av[i] * wv[j]; }
  }
#pragma unroll
  for (int i = 0; i < 4; ++i)
#pragma unroll
  for (int j = 0; j < 4; ++j) {
    const int r = rb * 4 + i, c = cb * 4 + j; float v = acc[i][j];
    if (g.gate) v *= sigmoidf_(g.gate[(long)r * g.ldg + c]);
    if (g.colscale) v *= g.colscale[c];
    if (g.res) v += g.res[(long)r * g.ldr + c];
    float* p = g.Cc + (long)r * g.ldc + c;
    if (g.accumulate) v += *p;
    *p = v;
  }
}
template <class T> HD void st_qknorm(const NaiveBufs& a, int l, long idx) {
  using d = DD<T>; const int hh = (int)(idx % (d::AH + d::AKV)), r = (int)(idx / (d::AH + d::AKV));
  const bool isq = hh < d::AH; const int hd = isq ? hh : hh - d::AH;
  const float* src = a.proj + (long)r * d::NIN + (isq ? d::O_AQ : d::O_AK) + hd * d::HDM;
  float* dst = (isq ? a.qn + (long)r * d::AQW : a.kn + (long)r * d::AKVW) + hd * d::HDM;
  const float* g = (isq ? a.q_norm_g : a.k_norm_g) + (long)l * d::HDM;
  float s = 0.f; for (int k = 0; k < d::HDM; ++k) s += src[k] * src[k];
  const float rsq = 1.f / sqrtf(s / (float)d::HDM + 1e-6f);
  if (r < d::S) {
    const int row = r / d::GW, col = r % d::GW;
    for (int p = 0; p < d::HDM / 2; ++p) {
      const int fi = p < d::RP ? p : p - d::RP; const float pos = p < d::RP ? (float)row : (float)col;
      const float inv = FPOW(10000.f, -(float)fi / (float)d::RP); const float ang = pos * inv;
      const float cs = FCOS(ang), sn = FSIN(ang);
      const float x1 = src[2 * p] * rsq * g[2 * p], x2 = src[2 * p + 1] * rsq * g[2 * p + 1];
      dst[2 * p] = x1 * cs - x2 * sn; dst[2 * p + 1] = x1 * sn + x2 * cs;
    }
  } else { for (int k = 0; k < d::HDM; ++k) dst[k] = src[k] * rsq * g[k]; }
}
template <class T, int NSPLIT> HD void st_attn(const NaiveBufs& a, int r0, int nrows, long idx) {
  using d = DD<T>; constexpr int OD = d::HDM / NSPLIT;
  const int r = r0 + (int)(idx % nrows); const int hs = (int)(idx / nrows); const int part = hs % NSPLIT, hq = hs / NSPLIT; const int kv = hq / d::AG;
  const int k0 = r < d::S ? 0 : d::S, k1 = d::R;
  float q[d::HDM], o[OD];
  const float scale = 1.f / sqrtf((float)d::HDM);
#pragma unroll
  for (int k = 0; k < d::HDM; ++k) q[k] = a.qn[(long)r * d::AQW + hq * d::HDM + k] * scale;
#pragma unroll
  for (int k = 0; k < OD; ++k) o[k] = 0.f;
  float mx = -1e30f, lsum = 0.f;
  for (int kk = k0; kk < k1; ++kk) {
    const float* kr = a.kn + (long)kk * d::AKVW + kv * d::HDM;
    float s = 0.f;
#pragma unroll
    for (int k = 0; k < d::HDM; ++k) s += q[k] * kr[k];
    if (s > mx) { const float cr = FEXP(mx - s); lsum *= cr;
#pragma unroll
      for (int k = 0; k < OD; ++k) o[k] *= cr;
      mx = s; }
    const float p = FEXP(s - mx); lsum += p;
    const float* vr = a.proj + (long)kk * d::NIN + d::O_AV + kv * d::HDM + part * OD;
#pragma unroll
    for (int k = 0; k < OD; ++k) o[k] += p * vr[k];
  }
  const float inv = 1.f / lsum;
#pragma unroll
  for (int k = 0; k < OD; ++k) a.yatt[(long)r * d::AQW + hq * d::HDM + part * OD + k] = o[k] * inv;
}
template <class T> HD void st_glala(const NaiveBufs& a, int l, long idx) {
  using d = DD<T>; const int j = (int)(idx % d::GKW); const int dir = (int)((idx / d::GKW) % 2); const int r = (int)(idx / (2 * d::GKW));
  const float* al = a.proj + (long)r * d::NIN + d::O_GA + dir * d::GR;
  const float* w2 = a.gla_wa2 + ((long)l * 2 + dir) * d::GR * d::GKW; float z = a.gla_ba[((long)l * 2 + dir) * d::GKW + j];
  for (int k = 0; k < d::GR; ++k) z += al[k] * w2[(long)k * d::GKW + j];
  (dir ? a.lab : a.laf)[(long)r * d::GKW + j] = FEXP(logsigmoidf_(z) / 16.f);
}
template <class T> HD void st_glascan(const NaiveBufs& a, long idx) {
  using d = DD<T>; const int v = (int)(idx % d::GDV); const int hd = (int)((idx / d::GDV) % d::GH); const int dir = (int)(idx / (d::GDV * d::GH));
  float st[d::GDK];
#pragma unroll
  for (int k = 0; k < d::GDK; ++k) st[k] = 0.f;
  const float qs = 1.f / sqrtf((float)d::GDK);
  const float* la = dir ? a.lab : a.laf; float* od = dir ? a.ob : a.of;
  for (int step = 0; step < d::R; ++step) {
    int r;
    if (step < d::C) r = d::S + (dir ? d::C - 1 - step : step); else r = dir ? d::S - 1 - (step - d::C) : step - d::C;
    const float* pr = a.proj + (long)r * d::NIN;
    const float vv = pr[d::O_GV + hd * d::GDV + v];
    float o = 0.f;
#pragma unroll
    for (int k = 0; k < d::GDK; ++k) {
      st[k] = la[(long)r * d::GKW + hd * d::GDK + k] * st[k] + pr[d::O_GK + hd * d::GDK + k] * vv;
      o += pr[d::O_GQ + hd * d::GDK + k] * qs * st[k];
    }
    od[(long)r * d::GVW + hd * d::GDV + v] = o;
  }
}
template <class T> HD void st_glaout(const NaiveBufs& a, int l, long idx) {
  using d = DD<T>; const int hd = (int)(idx % d::GH), r = (int)(idx / d::GH);
  const long base = (long)r * d::GVW + hd * d::GDV; float s = 0.f;
  for (int v = 0; v < d::GDV; ++v) { const float o = a.of[base + v] + a.ob[base + v]; s += o * o; }
  const float rsq = 1.f / sqrtf(s / (float)d::GDV + 1e-6f);
  for (int v = 0; v < d::GDV; ++v) { const float o = a.of[base + v] + a.ob[base + v];
    a.ygla[base + v] = o * rsq * a.gla_norm_g[(long)l * d::GDV + v] * siluf_(a.proj[(long)r * d::NIN + d::O_OG + hd * d::GDV + v]); }
}
template <class T> HD void st_hyconv3(const NaiveBufs& a, int l, long idx) {
  using d = DD<T>; const int j = (int)(idx % (3 * d::HW)), r = (int)(idx / (3 * d::HW));
  const int lo = r < d::S ? 0 : d::S, hi = r < d::S ? d::S : d::R;
  const float* w = a.hy_conv_w + (long)l * 3 * 3 * d::HW;
  float v = a.hy_conv_b[(long)l * 3 * d::HW + j] + a.proj[(long)r * d::NIN + d::O_HY + j] * w[1 * 3 * d::HW + j];
  if (r - 1 >= lo) v += a.proj[(long)(r - 1) * d::NIN + d::O_HY + j] * w[0 * 3 * d::HW + j];
  if (r + 1 < hi) v += a.proj[(long)(r + 1) * d::NIN + d::O_HY + j] * w[2 * 3 * d::HW + j];
  a.uc[idx] = v;
}
template <class T> HD void st_hylong(const NaiveBufs& a, int l, int o, long idx) {
  using d = DD<T>; const int c = (int)(idx % d::HW); const int rb = (int)(idx / d::HW); const int r0 = rb * 4;
  const bool lat = r0 < d::S; const int n = lat ? d::S : d::C; const int base = lat ? 0 : d::S; const int t0 = r0 - base;
  const float* tp = (lat ? a.tapsS : a.tapsC) + (long)o * 2 * n * d::HW + c; const float nr = (lat ? a.nrmS : a.nrmC)[o * d::HW + c];
  const float* zs = o == 0 ? a.uc + 2 * d::HW + c : a.z1 + c; const int ldz = o == 0 ? 3 * d::HW : d::HW;
  float acc0 = 0.f, acc1 = 0.f, acc2 = 0.f, acc3 = 0.f;
  auto tap = [&](int lag) { const int li = lag >= 0 ? lag : 2 * n + lag; return tp[(long)li * d::HW]; };
  float w0 = tap(t0), w1 = tap(t0 + 1), w2 = tap(t0 + 2), w3 = tap(t0 + 3);
  for (int s = 0; s < n; ++s) {
    const float zv = zs[(long)(base + s) * ldz];
    acc0 += w0 * zv; acc1 += w1 * zv; acc2 += w2 * zv; acc3 += w3 * zv;
    w3 = w2; w2 = w1; w1 = w0; w0 = (s + 1 < n) ? tap(t0 - s - 1) : 0.f;
  }
  const float sk = a.hy_skip[((long)l * 2 + o) * d::HW + c];
  float* dst = o == 0 ? a.z1 : a.yhy;
  const float accs[4] = {acc0, acc1, acc2, acc3};
#pragma unroll
  for (int i = 0; i < 4; ++i) { const int r = r0 + i; const float zr = zs[(long)r * ldz];
    dst[(long)r * d::HW + c] = a.uc[(long)r * 3 * d::HW + o * d::HW + c] * (accs[i] / nr + sk * zr); }
}
template <class T> HD void st_router(const NaiveBufs& a, long idx) {
  using d = DD<T>; const int r = (int)idx; const float* hr = a.h + (long)r * d::D;
  float sc[d::NE], sel[d::NE];
#pragma unroll
  for (int e = 0; e < d::NE; ++e) sc[e] = 0.f;
  for (int k = 0; k < d::D; ++k) { const float hv = hr[k];
#pragma unroll
    for (int e = 0; e < d::NE; ++e) sc[e] += hv * a.router_w[(long)k * d::NE + e]; }
#pragma unroll
  for (int e = 0; e < d::NE; ++e) { sc[e] = sigmoidf_(sc[e]); sel[e] = sc[e] + a.router_b[e]; }
  int bestg = 0; float bestgs = -1e30f;
#pragma unroll
  for (int g = 0; g < d::NG; ++g) { float m1 = -1e30f, m2 = -1e30f;
#pragma unroll
    for (int i = 0; i < d::EPG; ++i) { const float v = sel[g * d::EPG + i]; if (v > m1) { m2 = m1; m1 = v; } else if (v > m2) m2 = v; }
    const float gs = m1 + m2; if (gs > bestgs) { bestgs = gs; bestg = g; } }
  int i1 = -1, i2 = -1; float v1 = -1e30f, v2 = -1e30f, s1 = 0.f, s2 = 0.f;
#pragma unroll
  for (int e = 0; e < d::NE; ++e) { if (e / d::EPG == bestg) { const float v = sel[e];
      if (v > v1) { v2 = v1; i2 = i1; s2 = s1; v1 = v; i1 = e; s1 = sc[e]; } else if (v > v2) { v2 = v; i2 = e; s2 = sc[e]; } } }
  const float inv = 1.f / (s1 + s2);
  a.ridx[2 * r] = i1; a.ridx[2 * r + 1] = i2; a.rw[2 * r] = s1 * inv; a.rw[2 * r + 1] = s2 * inv;
}
template <class T> HD void st_moehid(const NaiveBufs& a, int l, long idx) {
  using d = DD<T>; const int j = (int)(idx % d::DE); const int k = (int)((idx / d::DE) % 2); const int r = (int)(idx / (2 * d::DE));
  const int e = a.ridx[2 * r + k]; const float* hr = a.h + (long)r * d::D;
  const float* wg = a.moe_w_gate + (((long)l * d::NE + e) * d::D) * d::DE + j; const float* wu = a.moe_w_up + (((long)l * d::NE + e) * d::D) * d::DE + j;
  float g = 0.f, u = 0.f;
  for (int i = 0; i < d::D; ++i) { const float hv = hr[i]; g += hv * wg[(long)i * d::DE]; u += hv * wu[(long)i * d::DE]; }
  a.hid[idx] = siluf_(g) * u;
}
template <class T> HD void st_moeout(const NaiveBufs& a, int l, int b, long idx) {
  using d = DD<T>; const int dd = (int)(idx % d::D), r = (int)(idx / d::D);
  float acc = 0.f;
  for (int k = 0; k < 2; ++k) { const int e = a.ridx[2 * r + k]; const float* hk = a.hid + ((long)r * 2 + k) * d::DE;
    const float* wd = a.moe_w_down + (((long)l * d::NE + e) * d::DE) * d::D + dd; float s = 0.f;
    for (int j = 0; j < d::DE; ++j) s += hk[j] * wd[(long)j * d::D];
    acc += a.rw[2 * r + k] * s; }
  const float g2 = a.mod[(long)(r < d::S ? b : d::B) * 6 * d::D + 5 * d::D + dd];
  float* xr = xrow_w<T>(a, b, r); xr[dd] += g2 * acc;
}
enum { L_MOD = 0, L_HID_S, L_HID_C, L_TAPS_S, L_TAPS_C, L_NRM_S, L_NRM_C, N_LSTAGES,
       P_RS1 = 16, P_NORM1, P_INPROJ, P_QKNORM, P_ATTN_L, P_ATTN_C, P_GLALA, P_GLASCAN, P_GLAOUT, P_HYC3, P_HYL0, P_HYL1,
       P_MRG_HY, P_MRG_GLA, P_MRG_ATT, P_OUT_L, P_OUT_C, P_RS2, P_NORM2, P_ROUTER, P_MOEHID, P_MOEOUT, P_END };
constexpr int ATT_NSPLIT = 4;

template <class T> HD long stage_items(int st, int l) {
  using d = DD<T>; const bool last = (l == d::DEPTH - 1);
  switch (st) {
    case L_MOD: return (long)(d::B + 1) * 6 * d::D;
    case L_HID_S: return (long)d::S * d::HF;
    case L_HID_C: return (long)d::C * d::HF;
    case L_TAPS_S: return 2L * 2 * d::S * d::HW;
    case L_TAPS_C: return 2L * 2 * d::C * d::HW;
    case L_NRM_S: case L_NRM_C: return 2L * d::HW;
    case P_RS1: case P_RS2: case P_ROUTER: return d::R;
    case P_NORM1: case P_NORM2: return (long)d::R * d::D;
    case P_INPROJ: return (long)(d::R / 4) * (d::NIN / 4);
    case P_QKNORM: return (long)d::R * (d::AH + d::AKV);
    case P_ATTN_L: return (long)d::S * d::AH * ATT_NSPLIT;
    case P_ATTN_C: return last ? 0 : (long)d::C * d::AH * ATT_NSPLIT;
    case P_GLALA: return (long)d::R * 2 * d::GKW;
    case P_GLASCAN: return 2L * d::GH * d::GDV;
    case P_GLAOUT: return (long)d::R * d::GH;
    case P_HYC3: return (long)d::R * 3 * d::HW;
    case P_HYL0: case P_HYL1: return (long)(d::R / 4) * d::HW;
    case P_MRG_HY: case P_MRG_GLA: case P_MRG_ATT: return (long)(d::R / 4) * (d::D / 4);
    case P_OUT_L: return (long)(d::S / 4) * (d::D / 4);
    case P_OUT_C: return last ? 0 : (long)(d::C / 4) * (d::D / 4);
    case P_MOEHID: return (long)d::R * 2 * d::DE;
    case P_MOEOUT: return (long)(last ? d::S : d::R) * d::D;
  }
  return 0;
}

template <class T, int ST> HD void stage_run(const NaiveBufs& a, int l, int b, long idx) {
  using d = DD<T>;
  if constexpr (ST == L_MOD) st_mod<T>(a, l, idx);
  else if constexpr (ST == L_HID_S) st_hyhid<T>(a, l, 0, idx);
  else if constexpr (ST == L_HID_C) st_hyhid<T>(a, l, 1, idx);
  else if constexpr (ST == L_TAPS_S) st_hytaps<T>(a, l, 0, idx);
  else if constexpr (ST == L_TAPS_C) st_hytaps<T>(a, l, 1, idx);
  else if constexpr (ST == L_NRM_S) st_hynorm<T>(a, 0, idx);
  else if constexpr (ST == L_NRM_C) st_hynorm<T>(a, 1, idx);
  else if constexpr (ST == P_RS1) st_rs<T>(a, l, b, 0, idx);
  else if constexpr (ST == P_RS2) st_rs<T>(a, l, b, 1, idx);
  else if constexpr (ST == P_NORM1) st_norm<T>(a, l, b, 0, idx);
  else if constexpr (ST == P_NORM2) st_norm<T>(a, l, b, 1, idx);
  else if constexpr (ST == P_INPROJ) { GemmArgs g{a.h, d::D, a.w_in + (long)l * d::D * d::NIN, d::NIN, a.proj, d::NIN, d::R, d::NIN, d::D, nullptr, 0, nullptr, nullptr, 0, 0}; st_gemm(g, idx); }
  else if constexpr (ST == P_QKNORM) st_qknorm<T>(a, l, idx);
  else if constexpr (ST == P_ATTN_L) st_attn<T, ATT_NSPLIT>(a, 0, d::S, idx);
  else if constexpr (ST == P_ATTN_C) st_attn<T, ATT_NSPLIT>(a, d::S, d::C, idx);
  else if constexpr (ST == P_GLALA) st_glala<T>(a, l, idx);
  else if constexpr (ST == P_GLASCAN) st_glascan<T>(a, idx);
  else if constexpr (ST == P_GLAOUT) st_glaout<T>(a, l, idx);
  else if constexpr (ST == P_HYC3) st_hyconv3<T>(a, l, idx);
  else if constexpr (ST == P_HYL0) st_hylong<T>(a, l, 0, idx);
  else if constexpr (ST == P_HYL1) st_hylong<T>(a, l, 1, idx);
  else if constexpr (ST == P_MRG_HY) { GemmArgs g{a.yhy, d::HW, a.w_br_hy + (long)l * d::HW * d::D, d::D, a.m, d::D, d::R, d::D, d::HW, a.proj + d::O_BR, d::NIN, nullptr, nullptr, 0, 0}; st_gemm(g, idx); }
  else if constexpr (ST == P_MRG_GLA) { GemmArgs g{a.ygla, d::GVW, a.w_br_gla + (long)l * d::GVW * d::D, d::D, a.m, d::D, d::R, d::D, d::GVW, a.proj + d::O_BR + d::D, d::NIN, nullptr, nullptr, 0, 1}; st_gemm(g, idx); }
  else if constexpr (ST == P_MRG_ATT) { GemmArgs g{a.yatt, d::AQW, a.w_br_att + (long)l * d::AQW * d::D, d::D, a.m, d::D, d::R, d::D, d::AQW, a.proj + d::O_BR + 2 * d::D, d::NIN, nullptr, nullptr, 0, 1}; st_gemm(g, idx); }
  else if constexpr (ST == P_OUT_L) { const float* res = (l == 0 ? a.x : (const float*)a.out) + (long)b * d::S * d::D;
    GemmArgs g{a.m, d::D, a.w_out + (long)l * d::D * d::D, d::D, a.out + (long)b * d::S * d::D, d::D, d::S, d::D, d::D, nullptr, 0, a.mod + (long)b * 6 * d::D + 2 * d::D, res, d::D, 0}; st_gemm(g, idx); }
  else if constexpr (ST == P_OUT_C) { const float* res = (l == 0 ? a.ctx : (const float*)a.xc) + (long)b * d::C * d::D;
    GemmArgs g{a.m + (long)d::S * d::D, d::D, a.w_out + (long)l * d::D * d::D, d::D, a.xc + (long)b * d::C * d::D, d::D, d::C, d::D, d::D, nullptr, 0, a.mod + (long)d::B * 6 * d::D + 2 * d::D, res, d::D, 0}; st_gemm(g, idx); }
  else if constexpr (ST == P_ROUTER) st_router<T>(a, idx);
  else if constexpr (ST == P_MOEHID) st_moehid<T>(a, l, idx);
  else if constexpr (ST == P_MOEOUT) st_moeout<T>(a, l, b, idx);
}

template <class T> inline size_t carve(NaiveBufs& a, float* ws) {
  using d = DD<T>; size_t o = 0; auto take = [&](size_t n) { float* p = ws ? ws + o : nullptr; o += (n + 63) & ~(size_t)63; return p; };
  a.mod = take((size_t)(d::B + 1) * 6 * d::D);
  a.hid2S = take((size_t)d::S * d::HF); a.hid2C = take((size_t)d::C * d::HF);
  a.tapsS = take((size_t)2 * 2 * d::S * d::HW); a.tapsC = take((size_t)2 * 2 * d::C * d::HW);
  a.nrmS = take(2 * d::HW); a.nrmC = take(2 * d::HW);
  a.rs = take(d::R); a.h = take((size_t)d::R * d::D); a.proj = take((size_t)d::R * d::NIN);
  a.qn = take((size_t)d::R * d::AQW); a.kn = take((size_t)d::R * d::AKVW);
  a.uc = take((size_t)d::R * 3 * d::HW); a.z1 = take((size_t)d::R * d::HW); a.yhy = take((size_t)d::R * d::HW);
  a.xc = take((size_t)d::B * d::C * d::D);
#ifdef HOST_TEST
  a.yatt = take((size_t)d::R * d::AQW); a.laf = take((size_t)d::R * d::GKW); a.lab = take((size_t)d::R * d::GKW);
  a.of = take((size_t)d::R * d::GVW); a.ob = take((size_t)d::R * d::GVW); a.ygla = take((size_t)d::R * d::GVW);
  a.m = take((size_t)d::R * d::D); a.ridx = (int*)take((size_t)d::R * 2); a.rw = take((size_t)d::R * 2); a.hid = take((size_t)d::R * 2 * d::DE);
#endif
  return o;
}
template <class T> inline void set_inputs(NaiveBufs& a, const float* const* in) {
  int i = 0;
  a.x = in[i++]; a.c = in[i++]; a.ctx = in[i++]; a.c_ctx = in[i++]; a.w_mod = in[i++]; a.b_mod = in[i++]; a.norm1_g = in[i++]; a.norm2_g = in[i++];
  a.w_in = in[i++]; a.q_norm_g = in[i++]; a.k_norm_g = in[i++]; a.gla_wa2 = in[i++]; a.gla_ba = in[i++]; a.gla_norm_g = in[i++];
  a.hy_conv_w = in[i++]; a.hy_conv_b = in[i++]; a.hy_pos_w1 = in[i++]; a.hy_pos_b1 = in[i++]; a.hy_sin_freq = in[i++]; a.hy_pos_w2 = in[i++];
  a.hy_pos_b2 = in[i++]; a.hy_pos_w3 = in[i++]; a.hy_decay = in[i++]; a.hy_skip = in[i++]; a.w_br_hy = in[i++]; a.w_br_gla = in[i++];
  a.w_br_att = in[i++]; a.w_out = in[i++]; a.router_w = in[i++]; a.router_b = in[i++]; a.moe_w_gate = in[i++]; a.moe_w_up = in[i++]; a.moe_w_down = in[i++];
}

#define LSTAGES(X) X(L_MOD) X(L_HID_S) X(L_HID_C) X(L_TAPS_S) X(L_TAPS_C) X(L_NRM_S) X(L_NRM_C)
#define PSTAGES(X) X(P_RS1) X(P_NORM1) X(P_INPROJ) X(P_QKNORM) X(P_ATTN_L) X(P_ATTN_C) X(P_GLALA) X(P_GLASCAN) X(P_GLAOUT) X(P_HYC3) X(P_HYL0) X(P_HYL1) \
  X(P_MRG_HY) X(P_MRG_GLA) X(P_MRG_ATT) X(P_OUT_L) X(P_OUT_C) X(P_RS2) X(P_NORM2) X(P_ROUTER) X(P_MOEHID) X(P_MOEOUT)
namespace pro {
__device__ __forceinline__ void mod_phase(const NaiveBufs& a, int l, LAS unsigned char* lds) {
  int tz = threadIdx.x; asm volatile("" : "+v"(tz));
  __syncthreads();
  LAS float* sl = (LAS float*)lds; LAS float* part = sl + 9 * 1024;
  for (int e = tz; e < 9 * 1024; e += NTHREADS) { const int bb = e >> 10, k = e & 1023; const float cv = bb < 8 ? a.c[bb * 1024 + k] : a.c_ctx[k]; sl[e] = cv / (1.f + __expf(-cv)); }
  __syncthreads();
  const float* w = a.w_mod + (size_t)l * 1024 * 6144;
  const int jl = tz & 63, ks = tz >> 6;
  for (int cb = blockIdx.x; cb < 96; cb += gridDim.x) { const int j = cb * 64 + jl; float acc[9];
#pragma unroll
    for (int q = 0; q < 9; ++q) acc[q] = 0.f;
#pragma unroll 4
    for (int k = ks * 128; k < ks * 128 + 128; ++k) { const float wv = w[(size_t)k * 6144 + j];
#pragma unroll
      for (int q = 0; q < 9; ++q) acc[q] += sl[q * 1024 + k] * wv; }
#pragma unroll
    for (int q = 0; q < 9; ++q) part[(ks * 9 + q) * 64 + jl] = acc[q];
    __syncthreads();
    for (int e = tz; e < 9 * 64; e += NTHREADS) { const int q = e >> 6, jj = e & 63; float s = a.b_mod[(size_t)l * 6144 + cb * 64 + jj];
#pragma unroll
      for (int k8 = 0; k8 < 8; ++k8) s += part[(k8 * 9 + q) * 64 + jj];
      a.mod[(size_t)q * 6144 + cb * 64 + jj] = s; }
    __syncthreads(); }
  __syncthreads();
}
__device__ __forceinline__ void hid_phase(const NaiveBufs& a, int l, int n, float* dst, LAS unsigned char* lds) {
  int tz = threadIdx.x; asm volatile("" : "+v"(tz));
  LAS float* Z = (LAS float*)(lds + 40960); LAS float* H1 = Z + 8 * 36;
  const float* w1 = a.hy_pos_w1 + (size_t)l * 33 * 64; const float* b1 = a.hy_pos_b1 + l * 64; const float* fr = a.hy_sin_freq + l * 64;
  const float* w2 = a.hy_pos_w2 + (size_t)l * 64 * 64; const float* b2 = a.hy_pos_b2 + l * 64;
  const float w0 = 2.f * 3.14159265358979323846f / (float)n;
  for (int t0 = blockIdx.x * 8; t0 < n; t0 += gridDim.x * 8) {
    if (tz < 8 * 33) { const int tt = tz / 33, e = tz % 33, t = t0 + tt; float v;
      if (e == 0) v = (float)t / (float)n; else { const int bnd = (e - 1) & 15; const float band = 1e-4f + (float)bnd * (15.f - 1e-4f) / 15.f; const float ph = w0 * (float)t * band; v = e <= 16 ? cosf(ph) : -sinf(ph); }
      Z[tt * 36 + e] = v; }
    __syncthreads();
    { const int tt = tz >> 6, i = tz & 63; float acc = b1[i];
#pragma unroll
      for (int e = 0; e < 33; ++e) acc += Z[tt * 36 + e] * w1[e * 64 + i];
      H1[tt * 64 + i] = sinf(fr[i] * acc); }
    __syncthreads();
    { const int tt = tz >> 6, j = tz & 63; float acc = b2[j];
#pragma unroll 8
      for (int i = 0; i < 64; ++i) acc += H1[tt * 64 + i] * w2[i * 64 + j];
      if (t0 + tt < n) dst[(size_t)(t0 + tt) * 64 + j] = sinf(fr[j] * acc); }
    __syncthreads();
  }
}
__device__ __forceinline__ void nrmS_phase(const NaiveBufs& a) {
  int tz = threadIdx.x; asm volatile("" : "+v"(tz)); const int lane = tz & 63, wave = __builtin_amdgcn_readfirstlane(tz >> 6);
  for (int oc = blockIdx.x * NWAVES + wave; oc < 1024; oc += gridDim.x * NWAVES) { const float* tp = a.tapsS + (size_t)oc * 8192; float s = 0.f;
#pragma unroll 8
    for (int k = lane; k < 8192; k += 64) s += fabsf(tp[k]);
    s = moe::wave_sum(s); if (lane == 0) a.nrmS[oc] = s + 1e-6f; }
}
constexpr int TCOPY = 8232;
__device__ __forceinline__ void tapsB_phase(const NaiveBufs& a, int l, bf16_t* tapsB, LAS unsigned char* lds) {
  int tz = threadIdx.x; asm volatile("" : "+v"(tz));
  const float* w3 = a.hy_pos_w3 + (size_t)l * 64 * 2048; const float* dcy = a.hy_decay + (size_t)l * 2048;
  typedef float f4 __attribute__((ext_vector_type(4)));
  LAS float* W = (LAS float*)lds;
  for (int cp = blockIdx.x; cp < 256; cp += gridDim.x) {
    __syncthreads();
    { const int ch = tz >> 8, e = tz & 255, c = cp + 256 * ch; W[tz] = w3[(size_t)(e >> 2) * 2048 + (e & 3) * 512 + c]; if (tz < 8) W[512 + tz] = fabsf(dcy[(tz & 3) * 512 + cp + 256 * (tz >> 2)]); }
    __syncthreads();
    for (int t = tz; t < 4096; t += NTHREADS) {
      const f4* h2 = (const f4*)(a.hid2S + (size_t)t * 64); f4 acc0 = {0.f, 0.f, 0.f, 0.f}, acc1 = {0.f, 0.f, 0.f, 0.f};
#pragma unroll 4
      for (int j4 = 0; j4 < 16; ++j4) { const f4 h = h2[j4];
#pragma unroll
        for (int e = 0; e < 4; ++e) { acc0 += h[e] * *(const LAS f4*)(W + (4 * j4 + e) * 4); acc1 += h[e] * *(const LAS f4*)(W + 256 + (4 * j4 + e) * 4); } }
      const float tn = (float)t * (1.f / 4096.f);
#pragma unroll
      for (int ch = 0; ch < 2; ++ch)
#pragma unroll
        for (int q = 0; q < 4; ++q) { const int o = q >> 1, dir = q & 1; if (dir == 1 && t == 0) continue; const int c = cp + 256 * ch;
          const bf16_t bv = (bf16_t)f2bf((ch ? acc1[q] : acc0[q]) * __expf(-tn * W[512 + 4 * ch + q]));
          bf16_t* base = tapsB + ((size_t)o * 512 + c) * 2 * TCOPY; const int x0 = dir ? 4096 + t : 4096 - t;
          base[x0] = bv; base[TCOPY + x0 - 1] = bv; } } }
  for (long idx = (long)blockIdx.x * NTHREADS + tz; idx < 1024L * 96; idx += (long)gridDim.x * NTHREADS) { const int oc = (int)(idx / 96), e = (int)(idx % 96); bf16_t* base = tapsB + (size_t)oc * 2 * TCOPY;
    if (e < 40) base[8192 + e] = 0; else if (e < 81) base[TCOPY + 8191 + (e - 40)] = 0; else if (e == 81) base[0] = 0; }
}
__device__ __forceinline__ void nrmB_phase(const NaiveBufs& a, const bf16_t* tapsB) {
  int tz = threadIdx.x; asm volatile("" : "+v"(tz)); const int lane = tz & 63, wave = __builtin_amdgcn_readfirstlane(tz >> 6);
  for (int oc = blockIdx.x * NWAVES + wave; oc < 1024; oc += gridDim.x * NWAVES) { const bf16_t* tp = tapsB + (size_t)oc * 2 * TCOPY; float s = 0.f;
#pragma unroll 8
    for (int k = lane; k < 8192; k += 64) s += fabsf(bf2f(tp[k]));
    s = moe::wave_sum(s); if (lane == 0) a.nrmS[oc] = s + 1e-6f; }
}
}
using TD = FullDims;
using dd = DD<TD>;
constexpr int GB = 4, NGRP = 2, RB = dd::R  , RG = GB * RB, PLD = dd::O_BR + 1536  , PANELS = RG / 256, PPB = RB / 256  ;
constexpr size_t BAR_BYTES = 16384 + 4 * 4096; constexpr int CNT_OFF = 16384;
constexpr int MPG = 38912;
constexpr size_t CS_BYTES = (size_t)2 * 4 * 68 * 64 * 128 * 2, DEC_BYTES = (size_t)2 * 4 * 68 * 64 * 4;
constexpr size_t UCT_BYTES = (size_t)1536 * 4096 * 2, YT_BYTES = (size_t)512 * 4096 * 2, UCC_BYTES = (size_t)256 * 1536 * 4, Z1C_BYTES = (size_t)256 * 512 * 4;
constexpr size_t MIX_BYTES = GB * (CS_BYTES + DEC_BYTES) > GB * (UCT_BYTES + YT_BYTES + UCC_BYTES + Z1C_BYTES) ? GB * (CS_BYTES + DEC_BYTES) : GB * (UCT_BYTES + YT_BYTES + UCC_BYTES + Z1C_BYTES);

struct KArgs { NaiveBufs a; unsigned* bar; int* cnt; bf16_t *xs; bf16_t *WgaT; bf16_t *WinT, *WhyT, *WglaT, *WattT, *WoutT, *WguT, *WdT, *hb, *proj; unsigned char* mix;
  bf16_t *hp, *hid, *contrib; int* srcrow; float* wgt; moe::Route* route; float* wts; };

struct EpiProjBf16 {
  static constexpr bool PERM = true, AFTER_DRAIN = false;
  bf16_t* P;
  __device__ __forceinline__ void operator()(const pg8::f32x4 (&acc)[2][2][4][2], const pg8::Unit& u, int wr, int wc, int fr, int fq) const {
    const int row0 = u.pm * 256 + wr * 64 + fr, col0 = u.pn * 256 + wc * 32 + 8 * fq;
    const int cr0 = col0 + (col0 >= dd::O_GA ? 32 : 0), cr1 = col0 + 128 + (col0 + 128 >= dd::O_GA ? 32 : 0);
    if (u.pn >= (dd::O_BR - 32) / 256) {
      unsigned char* Pg = (unsigned char*)P + (size_t)dd::O_BR * 2 + (col0 - (dd::O_BR - 32));
#pragma unroll
      for (int ai = 0; ai < 2; ++ai)
#pragma unroll
        for (int m = 0; m < 4; ++m) { unsigned char* rowp = Pg + (size_t)(row0 + ai * 128 + m * 16) * (PLD * 2);
#pragma unroll
          for (int bj = 0; bj < 2; ++bj) { const pg8::f32x4 v0 = acc[ai][bj][m][0], v1 = acc[ai][bj][m][1]; uint2 o;
            o.x = (unsigned)(fsigmoid(v0[0]) * 255.f + 0.5f) | ((unsigned)(fsigmoid(v0[1]) * 255.f + 0.5f) << 8) | ((unsigned)(fsigmoid(v0[2]) * 255.f + 0.5f) << 16) | ((unsigned)(fsigmoid(v0[3]) * 255.f + 0.5f) << 24);
            o.y = (unsigned)(fsigmoid(v1[0]) * 255.f + 0.5f) | ((unsigned)(fsigmoid(v1[1]) * 255.f + 0.5f) << 8) | ((unsigned)(fsigmoid(v1[2]) * 255.f + 0.5f) << 16) | ((unsigned)(fsigmoid(v1[3]) * 255.f + 0.5f) << 24);
            *(uint2*)(rowp + bj * 128) = o; } }
      return; }
#pragma unroll
    for (int ai = 0; ai < 2; ++ai)
#pragma unroll
      for (int m = 0; m < 4; ++m) { bf16_t* rowp = P + (size_t)(row0 + ai * 128 + m * 16) * PLD;
#pragma unroll
        for (int bj = 0; bj < 2; ++bj) { const pg8::f32x4 v0 = acc[ai][bj][m][0], v1 = acc[ai][bj][m][1];
          v4u o; o.x = pk2(v0[0], v0[1]); o.y = pk2(v0[2], v0[3]); o.z = pk2(v1[0], v1[1]); o.w = pk2(v1[2], v1[3]); *(v4u*)(rowp + (bj ? cr1 : cr0)) = o; } }
  }
};
template <bool ACCUM> struct EpiMergeB {
  static constexpr bool PERM = true, AFTER_DRAIN = false;
  const bf16_t* gate; bf16_t* M;
  __device__ __forceinline__ void operator()(const pg8::f32x4 (&acc)[2][2][4][2], const pg8::Unit& u, int wr, int wc, int fr, int fq) const {
    const int row0 = u.pm * 256 + wr * 64 + fr, col0 = u.pn * 256 + wc * 32 + 8 * fq;
#pragma unroll
    for (int ai2 = 0; ai2 < 4; ++ai2) { const int ai = ai2 >> 1, m0 = (ai2 & 1) * 2;
      v4u gw[4][2], mo[4][2];
#pragma unroll
      for (int m = m0; m < m0 + 2; ++m)
#pragma unroll
        for (int bj = 0; bj < 2; ++bj) { const size_t r = (size_t)(row0 + ai * 128 + m * 16); const int c = col0 + bj * 128; gw[m][bj] = *(const v4u*)(gate + r * PLD + c); if (ACCUM) mo[m][bj] = *(const v4u*)(M + r * 1024 + c); }
#pragma unroll
      for (int m = m0; m < m0 + 2; ++m)
#pragma unroll
        for (int bj = 0; bj < 2; ++bj) { const size_t r = (size_t)(row0 + ai * 128 + m * 16); const int c = col0 + bj * 128; const v4u g4 = gw[m][bj];
          pg8::f32x4 v0 = acc[ai][bj][m][0], v1 = acc[ai][bj][m][1];
          v0[0] *= fsigmoid(bf2f(g4.x & 0xffff)); v0[1] *= fsigmoid(bf2f(g4.x >> 16)); v0[2] *= fsigmoid(bf2f(g4.y & 0xffff)); v0[3] *= fsigmoid(bf2f(g4.y >> 16));
          v1[0] *= fsigmoid(bf2f(g4.z & 0xffff)); v1[1] *= fsigmoid(bf2f(g4.z >> 16)); v1[2] *= fsigmoid(bf2f(g4.w & 0xffff)); v1[3] *= fsigmoid(bf2f(g4.w >> 16));
          if (ACCUM) { const v4u o = mo[m][bj]; v0[0] += bf2f(o.x & 0xffff); v0[1] += bf2f(o.x >> 16); v0[2] += bf2f(o.y & 0xffff); v0[3] += bf2f(o.y >> 16);
            v1[0] += bf2f(o.z & 0xffff); v1[1] += bf2f(o.z >> 16); v1[2] += bf2f(o.w & 0xffff); v1[3] += bf2f(o.w >> 16); }
          v4u o2; o2.x = pk2(v0[0], v0[1]); o2.y = pk2(v0[2], v0[3]); o2.z = pk2(v1[0], v1[1]); o2.w = pk2(v1[2], v1[3]); *(v4u*)(M + r * 1024 + c) = o2; } }
  }
};
struct EpiOutG {
  static constexpr bool PERM = true, AFTER_DRAIN = false;
  const float* resL; const float* resC; bf16_t* xs; const float* mod; int b0; bool ctx_on, resbf;
  __device__ __forceinline__ void operator()(const pg8::f32x4 (&acc)[2][2][4][2], const pg8::Unit& u, int wr, int wc, int fr, int fq) const {
    const int bl = u.pm / PPB, lp = u.pm % PPB; const bool isc = lp == PPB - 1; if (isc && !ctx_on) return;
    const int b = b0 + bl;
    const float* res = isc ? resC + (size_t)b * dd::C * 1024 : resL + ((size_t)b * dd::S + lp * 256) * 1024;
    bf16_t* out = xs + (size_t)u.pm * 256 * 1024;
    const float* gv = mod + (size_t)(isc ? dd::B : b) * 6 * 1024 + 2 * 1024;
    int row0 = wr * 64 + fr, col0 = u.pn * 256 + wc * 32 + 8 * fq; asm volatile("" : "+v"(row0), "+v"(col0));
    pg8::f32x4 gg[2][2];
#pragma unroll
    for (int bj = 0; bj < 2; ++bj)
#pragma unroll
      for (int n = 0; n < 2; ++n) gg[bj][n] = *(const pg8::f32x4*)(gv + col0 + bj * 128 + n * 4);
    if (resbf) {
#pragma unroll
      for (int ai2 = 0; ai2 < 4; ++ai2) { const int ai = ai2 >> 1, m0 = (ai2 & 1) * 2; v4u rb[4][2];
#pragma unroll
        for (int m = m0; m < m0 + 2; ++m)
#pragma unroll
          for (int bj = 0; bj < 2; ++bj) rb[m][bj] = *(const v4u*)(out + (size_t)(row0 + ai * 128 + m * 16) * 1024 + col0 + bj * 128);
#pragma unroll
        for (int m = m0; m < m0 + 2; ++m)
#pragma unroll
          for (int bj = 0; bj < 2; ++bj) { const v4u o = rb[m][bj]; const pg8::f32x4 v0 = gg[bj][0] * acc[ai][bj][m][0], v1 = gg[bj][1] * acc[ai][bj][m][1]; v4u w;
            w.x = pk2(v0[0] + __uint_as_float(o.x << 16), v0[1] + __uint_as_float(o.x & 0xffff0000u)); w.y = pk2(v0[2] + __uint_as_float(o.y << 16), v0[3] + __uint_as_float(o.y & 0xffff0000u));
            w.z = pk2(v1[0] + __uint_as_float(o.z << 16), v1[1] + __uint_as_float(o.z & 0xffff0000u)); w.w = pk2(v1[2] + __uint_as_float(o.w << 16), v1[3] + __uint_as_float(o.w & 0xffff0000u));
            *(v4u*)(out + (size_t)(row0 + ai * 128 + m * 16) * 1024 + col0 + bj * 128) = w; } }
    } else {
#pragma unroll
      for (int ai2 = 0; ai2 < 4; ++ai2) { const int ai = ai2 >> 1, m0 = (ai2 & 1) * 2;
        pg8::f32x4 rv[4][2][2];
#pragma unroll
        for (int m = m0; m < m0 + 2; ++m)
#pragma unroll
          for (int bj = 0; bj < 2; ++bj)
#pragma unroll
            for (int n = 0; n < 2; ++n) rv[m][bj][n] = *(const pg8::f32x4*)(res + (size_t)(row0 + ai * 128 + m * 16) * 1024 + col0 + bj * 128 + n * 4);
#pragma unroll
        for (int m = m0; m < m0 + 2; ++m)
#pragma unroll
          for (int bj = 0; bj < 2; ++bj) { const pg8::f32x4 v0 = rv[m][bj][0] + gg[bj][0] * acc[ai][bj][m][0], v1 = rv[m][bj][1] + gg[bj][1] * acc[ai][bj][m][1];
            v4u w; w.x = pk2(v0[0], v0[1]); w.y = pk2(v0[2], v0[3]); w.z = pk2(v1[0], v1[1]); w.w = pk2(v1[2], v1[3]);
            *(v4u*)(out + (size_t)(row0 + ai * 128 + m * 16) * 1024 + col0 + bj * 128) = w; } }
    }
  }
};
struct GroupOrder {
  int nN, nwg, G, c; bool lat;
  __device__ void init(int N, int G_, int c_, bool lat_) { nN = N / 256; lat = lat_; nwg = (lat ? GB * 16 : PANELS) * nN; G = G_; c = c_; }
  __device__ __forceinline__ bool next(int i, pg8::Unit& u) const { const long L = (long)i * G + c; if (L >= nwg) return false; const int p = (int)L / nN; u.pm = lat ? (p >> 4) * PPB + (p & 15) : p; u.pn = (int)L % nN; u.acol = 0; u.nt = 0; return true; }
  __device__ __forceinline__ void a_ready(const pg8::Unit&) const {}
  __device__ __forceinline__ void done(const pg8::Unit&) const {}
};
struct MergeOrder {
  int ntiles, G, c; bool lat;
  __device__ void init(int G_, int c_, bool lat_) { lat = lat_; ntiles = (lat ? GB * 16 : PANELS) * 4; G = G_; c = c_; }
  __device__ __forceinline__ bool next(int i, pg8::Unit& u) const { const int rnd = i / 3, gi = i - 3 * rnd; const long tile = (long)rnd * G + c; if (tile >= ntiles) return false; const int p = (int)tile >> 2;
    u.pm = lat ? (p >> 4) * PPB + (p & 15) : p; u.pn = gi * 4 + ((int)tile & 3); u.acol = gi == 0 ? dd::O_HY : gi == 1 ? dd::O_OG : dd::O_AQ; u.nt = gi == 2 ? 16 : 8; return true; }
  __device__ __forceinline__ void a_ready(const pg8::Unit&) const {}
  __device__ __forceinline__ void done(const pg8::Unit&) const {}
};
struct EpiMergeS {
  static constexpr bool PERM = true, AFTER_DRAIN = false;
  const unsigned char* gate0; bf16_t* M;
  __device__ __forceinline__ void operator()(const pg8::f32x4 (&acc)[2][2][4][2], const pg8::Unit& u, int wr, int wc, int fr, int fq) const {
    const int gi = u.pn >> 2; const bool accum = gi > 0; const unsigned char* gate = gate0 + gi * 1024;
    const int row0 = u.pm * 256 + wr * 64 + fr, col0 = (u.pn & 3) * 256 + wc * 32 + 8 * fq;
#pragma unroll
    for (int ai2 = 0; ai2 < 4; ++ai2) { const int ai = ai2 >> 1, m0 = (ai2 & 1) * 2;
      uint2 gw[4][2]; v4u mo[4][2];
#pragma unroll
      for (int m = m0; m < m0 + 2; ++m)
#pragma unroll
        for (int bj = 0; bj < 2; ++bj) { const size_t r = (size_t)(row0 + ai * 128 + m * 16); const int c = col0 + bj * 128; gw[m][bj] = *(const uint2*)(gate + r * (PLD * 2) + c); mo[m][bj] = (v4u){0u, 0u, 0u, 0u}; if (accum) mo[m][bj] = *(const v4u*)(M + r * 1024 + c); }
#pragma unroll
      for (int m = m0; m < m0 + 2; ++m)
#pragma unroll
        for (int bj = 0; bj < 2; ++bj) { const size_t r = (size_t)(row0 + ai * 128 + m * 16); const int c = col0 + bj * 128; const uint2 g2 = gw[m][bj]; constexpr float q = 1.f / 255.f;
          pg8::f32x4 v0 = acc[ai][bj][m][0], v1 = acc[ai][bj][m][1];
          v0[0] *= (float)(g2.x & 255u) * q; v0[1] *= (float)((g2.x >> 8) & 255u) * q; v0[2] *= (float)((g2.x >> 16) & 255u) * q; v0[3] *= (float)(g2.x >> 24) * q;
          v1[0] *= (float)(g2.y & 255u) * q; v1[1] *= (float)((g2.y >> 8) & 255u) * q; v1[2] *= (float)((g2.y >> 16) & 255u) * q; v1[3] *= (float)(g2.y >> 24) * q;
          { const v4u o = mo[m][bj]; v0[0] += bf2f(o.x & 0xffff); v0[1] += bf2f(o.x >> 16); v0[2] += bf2f(o.y & 0xffff); v0[3] += bf2f(o.y >> 16);
            v1[0] += bf2f(o.z & 0xffff); v1[1] += bf2f(o.z >> 16); v1[2] += bf2f(o.w & 0xffff); v1[3] += bf2f(o.w >> 16); }
          v4u o2; o2.x = pk2(v0[0], v0[1]); o2.y = pk2(v0[2], v0[3]); o2.z = pk2(v1[0], v1[1]); o2.w = pk2(v1[2], v1[3]); *(v4u*)(M + r * 1024 + c) = o2; } }
  }
};
__device__ __forceinline__ const float* xrow_in(const NaiveBufs& a, int l, int b, int r) {
  if (r < dd::S) return (l == 0 ? a.x : (const float*)a.out) + ((size_t)b * dd::S + r) * 1024;
  return (l == 0 ? a.ctx : (const float*)a.xc) + ((size_t)b * dd::C + (r - dd::S)) * 1024;
}
__device__ __forceinline__ float* xrow_cur(const NaiveBufs& a, int b, int r) {
  if (r < dd::S) return a.out + ((size_t)b * dd::S + r) * 1024;
  return a.xc + ((size_t)b * dd::C + (r - dd::S)) * 1024;
}
template <bool BF> __device__ __forceinline__ void norm_row(const void* xr, const float* gnorm, const float* shift, const float* scale, bf16_t* hrow, int lane) {
  typedef float f4 __attribute__((ext_vector_type(4)));
  f4 xv[4]; float ss = 0.f;
#pragma unroll
  for (int j = 0; j < 4; ++j) {
    if (BF) { const uint2 rw = *(const uint2*)((const bf16_t*)xr + 4 * lane + 256 * j); xv[j][0] = __uint_as_float(rw.x << 16); xv[j][1] = __uint_as_float(rw.x & 0xffff0000u); xv[j][2] = __uint_as_float(rw.y << 16); xv[j][3] = __uint_as_float(rw.y & 0xffff0000u); }
    else xv[j] = *(const f4*)((const float*)xr + 4 * lane + 256 * j);
    ss += xv[j][0] * xv[j][0] + xv[j][1] * xv[j][1] + xv[j][2] * xv[j][2] + xv[j][3] * xv[j][3]; }
  const float rs = __builtin_amdgcn_rsqf(moe::wave_sum(ss) * (1.f / 1024.f) + 1e-6f);
#pragma unroll
  for (int j = 0; j < 4; ++j) { const int c = 4 * lane + 256 * j; const f4 g4 = *(const f4*)(gnorm + c), sh = *(const f4*)(shift + c), sc = *(const f4*)(scale + c);
    f4 h;
#pragma unroll
    for (int i = 0; i < 4; ++i) h[i] = xv[j][i] * rs * g4[i] * (1.f + sc[i]) + sh[i];
    *(unsigned long long*)(hrow + c) = (unsigned long long)pk2h(h[0], h[1]) | ((unsigned long long)pk2h(h[2], h[3]) << 32); }
}
__device__ __forceinline__ void qknorm_row(bf16_t* prow, const float* qg, const float* kg, int r, int lane) {
  const bool lat = r < dd::S; const int grow = r / dd::GW, gcol = r % dd::GW;
  const int fi = lane & 31; const float pos = (lane < 32) ? (float)grow : (float)gcol;
  const float ang = pos * __builtin_amdgcn_exp2f(-(float)fi * (13.287712379549449f / 32.f));
  const float cs = lat ? __cosf(ang) : 1.f, sn = lat ? __sinf(ang) : 0.f;
  unsigned wv[10];
#pragma unroll
  for (int hh = 0; hh < 10; ++hh) wv[hh] = *((const unsigned*)(prow + (hh < 8 ? dd::O_AQ + hh * 128 : dd::O_AK + (hh - 8) * 128)) + lane);
  float ss[10];
#pragma unroll
  for (int hh = 0; hh < 10; ++hh) { const float x1 = bf2f(wv[hh] & 0xffff), x2 = bf2f(wv[hh] >> 16); ss[hh] = x1 * x1 + x2 * x2; }
#pragma unroll
  for (int o = 1; o < 64; o <<= 1) {
#pragma unroll
    for (int hh = 0; hh < 10; ++hh) ss[hh] += __shfl_xor(ss[hh], o); }
  const float q1 = qg[2 * lane], q2 = qg[2 * lane + 1], k1 = kg[2 * lane], k2 = kg[2 * lane + 1];
#pragma unroll
  for (int hh = 0; hh < 10; ++hh) { unsigned* p = (unsigned*)(prow + (hh < 8 ? dd::O_AQ + hh * 128 : dd::O_AK + (hh - 8) * 128)) + lane;
    const float x1 = bf2f(wv[hh] & 0xffff), x2 = bf2f(wv[hh] >> 16); const float rs = __builtin_amdgcn_rsqf(ss[hh] * (1.f / 128.f) + 1e-6f);
    const float y1 = x1 * rs * (hh < 8 ? q1 : k1), y2 = x2 * rs * (hh < 8 ? q2 : k2);
    *p = pk2h(y1 * cs - y2 * sn, y1 * sn + y2 * cs); }
}

__device__ __forceinline__ void ga_task(const bf16_t* hb, const bf16_t* WgaT, bf16_t* proj, int wt) {
  int tid = threadIdx.x; asm volatile("" : "+v"(tid));
  const int lane = tid & 63, li = lane & 31, lk = lane >> 5; typedef short b8 __attribute__((ext_vector_type(8))); typedef float f16v __attribute__((ext_vector_type(16)));
  const bf16_t* ap = hb + ((size_t)wt * 32 + li) * 1024 + 8 * lk; const bf16_t* bp = WgaT + (size_t)li * 1024 + 8 * lk;
  f16v acc = {};
  for (int k8 = 0; k8 < 8; ++k8) { v4u av[8], bv[8];
#pragma unroll
    for (int j = 0; j < 8; ++j) { av[j] = *(const v4u*)(ap + 128 * k8 + 16 * j); bv[j] = *(const v4u*)(bp + 128 * k8 + 16 * j); }
#pragma unroll
    for (int j = 0; j < 8; ++j) acc = __builtin_amdgcn_mfma_f32_32x32x16_bf16(__builtin_bit_cast(b8, av[j]), __builtin_bit_cast(b8, bv[j]), acc, 0, 0, 0); }
#pragma unroll
  for (int r = 0; r < 16; ++r) { const int row = wt * 32 + (r & 3) + 8 * (r >> 2) + 4 * lk; proj[(size_t)row * PLD + dd::O_GA + li] = (bf16_t)f2bf(acc[r]); }
}

__global__ void __launch_bounds__(NTHREADS, 2) mega_kernel(KArgs ka_unused) {
  extern __shared__ __attribute__((aligned(16))) unsigned char lds_raw[];
  LAS unsigned char* lds = (LAS unsigned char*)lds_raw;
  volatile LAS unsigned* MISC = (volatile LAS unsigned*)(lds + MISC_OFF);
  constexpr int ARGS_OFF = MISC_OFF + 256;
  static_assert(ARGS_OFF + sizeof(KArgs) <= LDS_BYTES, "LDS map");
  { const unsigned __attribute__((address_space(4)))* kp = (const unsigned __attribute__((address_space(4)))*)__builtin_amdgcn_kernarg_segment_ptr();
    for (int i = threadIdx.x; i < (int)(sizeof(KArgs) / 4); i += NTHREADS) ((LAS unsigned*)(lds + ARGS_OFF))[i] = kp[i]; }
  if (threadIdx.x < 64) MISC[threadIdx.x] = 0u;
  __syncthreads();
  const KArgs& ka = *(const KArgs*)(const LAS KArgs*)(lds + ARGS_OFF);
  const NaiveBufs& a = ka.a;
  unsigned* bar_s; { const unsigned long long bp = (unsigned long long)ka.bar; const unsigned lo_ = __builtin_amdgcn_readfirstlane((unsigned)bp), hi_ = __builtin_amdgcn_readfirstlane((unsigned)(bp >> 32));
    bar_s = (unsigned*)(((unsigned long long)hi_ << 32) | lo_); }
  XcdBarrier xb = xcd_barrier_post(bar_s, MISC);
#define SPTR(T, name, src) T* name; { const unsigned long long bp_ = (unsigned long long)(src); const unsigned lo_ = __builtin_amdgcn_readfirstlane((unsigned)bp_), hi_ = __builtin_amdgcn_readfirstlane((unsigned)(bp_ >> 32)); name = (T*)(((unsigned long long)hi_ << 32) | lo_); }
  SPTR(bf16_t, proj_s, ka.proj) SPTR(bf16_t, hb_s, ka.hb) SPTR(unsigned char, mix_s, ka.mix)
  const long gs = (long)gridDim.x * NTHREADS;
  LAS int* poff = (LAS int*)(lds + MISC_OFF + 64);
#define TID_SETUP int tz = threadIdx.x; asm volatile("" : "+v"(tz)); const int lane = tz & 63, wave = __builtin_amdgcn_readfirstlane(tz >> 6); \
    const int gw = blockIdx.x * NWAVES + wave, NGW = gridDim.x * NWAVES; const long gt = (long)blockIdx.x * NTHREADS + tz; (void)lane; (void)gw; (void)NGW; (void)gt;
#define LSTAGE(ST) { TID_SETUP const long n_ = stage_items<TD>(ST, l); for (long i_ = gt; i_ < n_; i_ += gs) stage_run<TD, ST>(a, l, 0, i_); }
  for (int l = 0; l < dd::DEPTH; ++l) {
    const bool last = (l == dd::DEPTH - 1);
    { TID_SETUP
      LAS float* scr = (LAS float*)(lds + RING_OFF + wave * 16384);
      constexpr int NIT = (dd::D / 64) * (dd::NIN / 32);
      for (int it = gw; it < NIT; it += NGW) { const int n0 = 32 * (it % (dd::NIN / 32));
        if (n0 == dd::O_GA) transpose_item(a.w_in + (size_t)l * dd::D * dd::NIN, dd::D, dd::NIN, ka.WgaT, -dd::O_GA, scr, it, lane);
        else transpose_item(a.w_in + (size_t)l * dd::D * dd::NIN, dd::D, dd::NIN, ka.WinT, n0 < dd::O_GA ? 0 : -32, scr, it, lane); }
      { constexpr int I0 = (dd::HW / 64) * (dd::D / 32), I1 = (dd::GVW / 64) * (dd::D / 32), I2 = (dd::AQW / 64) * (dd::D / 32), I3 = (dd::D / 64) * (dd::D / 32);
        for (int it = gw; it < I0 + I1 + I2 + I3; it += NGW) { int r = it;
          if (r < I0) { transpose_item(a.w_br_hy + (size_t)l * dd::HW * dd::D, dd::HW, dd::D, ka.WhyT, 0, scr, r, lane, 1024); continue; } r -= I0;
          if (r < I1) { transpose_item(a.w_br_gla + (size_t)l * dd::GVW * dd::D, dd::GVW, dd::D, ka.WglaT, 0, scr, r, lane, 1024); continue; } r -= I1;
          if (r < I2) { transpose_item(a.w_br_att + (size_t)l * dd::AQW * dd::D, dd::AQW, dd::D, ka.WattT, 0, scr, r, lane); continue; } r -= I2;
          transpose_item(a.w_out + (size_t)l * dd::D * dd::D, dd::D, dd::D, ka.WoutT, 0, scr, r, lane); } }
      { constexpr int IG = (dd::D / 64) * (dd::DE / 32), IDN = (dd::DE / 64) * (dd::D / 32);
        for (int it = gw; it < dd::NE * (2 * IG + IDN); it += NGW) { const int e = it / (2 * IG + IDN); int r = it % (2 * IG + IDN);
          if (r < 2 * IG) { const int up = r >= IG; if (up) r -= IG; const int n0 = 32 * (r % (dd::DE / 32));
            transpose_item((up ? a.moe_w_up : a.moe_w_gate) + ((size_t)l * dd::NE + e) * dd::D * dd::DE, dd::D, dd::DE, ka.WguT, e * 1024 + 128 * (n0 >> 7) + (up ? 128 : 0), scr, r, lane); }
          else { r -= 2 * IG; transpose_item(a.moe_w_down + ((size_t)l * dd::NE + e) * dd::DE * dd::D, dd::DE, dd::D, ka.WdT, e * 1024, scr, r, lane); } } }
      (void)gt;
    }
    pro::mod_phase(a, l, lds); pro::hid_phase(a, l, dd::S, a.hid2S, lds); if (!last) pro::hid_phase(a, l, dd::C, a.hid2C, lds);
    xcd_barrier(xb);
    pro::tapsB_phase(a, l, (bf16_t*)a.tapsS, lds); if (!last) LSTAGE(L_TAPS_C)
    xcd_barrier(xb);
    pro::nrmB_phase(a, (const bf16_t*)a.tapsS); if (!last) LSTAGE(L_NRM_C)
    xcd_barrier(xb);
    for (int grp = 0; grp < NGRP; ++grp) {
      const int b0 = grp * GB;
      { TID_SETUP
        for (int rg = gw; rg < RG; rg += NGW) { const int bl = rg / RB, r = rg % RB, b = b0 + bl; const float* md = a.mod + (size_t)(r < dd::S ? b : dd::B) * 6 * 1024;
          if (l == 0) norm_row<false>(xrow_in(a, 0, b, r), a.norm1_g, md, md + 1024, hb_s + (size_t)rg * 1024, lane);
          else norm_row<true>(ka.xs + ((size_t)grp * RG + rg) * 1024, a.norm1_g + (size_t)l * 1024, md, md + 1024, hb_s + (size_t)rg * 1024, lane); }
        xcd_barrier(xb); }
      { pg8::Gemm g{hb_s, ka.WinT, RG, NINP, dd::D, 0}; pg8::StaticOrder S; S.init(RG, NINP, (int)gridDim.x, (int)blockIdx.x); EpiProjBf16 E{proj_s};
        pg8::gemm_phase<EpiProjBf16, pg8::StaticOrder, false>((PG8_LAS unsigned char*)(lds + RING_OFF), g, S, E, nullptr);
        { int tq = threadIdx.x; asm volatile("" : "+v"(tq)); const int wv_ = __builtin_amdgcn_readfirstlane(tq >> 6);
          for (int wt = (int)blockIdx.x + (int)gridDim.x * wv_; wt < PANELS * 8; wt += (int)gridDim.x * NWAVES) ga_task(hb_s, ka.WgaT, proj_s, wt); }
        xcd_barrier(xb); }
      { TID_SETUP
        for (int rg = gw; rg < RG; rg += NGW) qknorm_row(proj_s + (size_t)rg * PLD, a.q_norm_g + (size_t)l * 128, a.k_norm_g + (size_t)l * 128, rg % RB, lane);
        for (int u = blockIdx.x; u < GB * 4 * 68; u += gridDim.x) { const int bl = u / (4 * 68), hu = u % (4 * 68); const bf16_t* pb = proj_s + (size_t)bl * RB * PLD;
          gla::In gp; gp.q = pb + dd::O_GQ; gp.k = pb + dd::O_GK; gp.v = pb + dd::O_GV; gp.ga = pb + dd::O_GA; gp.og = pb + dd::O_OG; gp.ld = PLD;
          gp.wa2 = a.gla_wa2 + (size_t)l * 2 * 16 * 256; gp.ba = a.gla_ba + (size_t)l * 2 * 256; gp.gnorm = a.gla_norm_g + (size_t)l * 128;
          gp.csb = (bf16_t*)(mix_s + (size_t)bl * CS_BYTES); gp.dec = (float*)(mix_s + (size_t)GB * CS_BYTES + (size_t)bl * DEC_BYTES); gp.y = (bf16_t*)pb + dd::O_OG; gp.ldy = PLD; gp.S = dd::S; gp.C = dd::C;
          gla::g1b_unit(gp, lds, hu / 68, hu % 68, 4, 68); }
        xcd_barrier(xb); }
      { TID_SETUP
        for (long i_ = gt; i_ < (long)GB * 2 * 4 * 64 * 64; i_ += gs) { const int bl = (int)(i_ / (2 * 4 * 64 * 64)); gla::In gp; gp.csb = (bf16_t*)(mix_s + (size_t)bl * CS_BYTES); gp.dec = (float*)(mix_s + (size_t)GB * CS_BYTES + (size_t)bl * DEC_BYTES); gp.S = dd::S; gp.C = dd::C;
          gla::g2_item(gp, i_ % (2 * 4 * 64 * 64), 4, 68); }
        const int combo = blockIdx.x & 7, slot = blockIdx.x >> 3, nslot = gridDim.x >> 3;
        const int per_combo = 64 + (last ? 0 : 4);
        const bool xcdm = (gridDim.x & 7) == 0;
        for (int uu = xcdm ? slot : (int)blockIdx.x; uu < (xcdm ? per_combo : 8 * per_combo); uu += xcdm ? nslot : (int)gridDim.x) { const int cmb = xcdm ? combo : uu / per_combo, ui = xcdm ? uu : uu % per_combo;
          const bool lat = ui < 64; const int bl = cmb >> 1, kvh = cmb & 1;
          const int head = kvh * 4 + (lat ? ui >> 4 : ui - 64), qb = lat ? ui & 15 : 0;
          bf16_t* pb = proj_s + (size_t)bl * RB * PLD; const size_t qrow = lat ? (size_t)qb * 256 : (size_t)dd::S, krow = lat ? 0 : (size_t)dd::S;
          att::attn_dense_body<att::bf16, PLD, PLD, PLD, true>((const att::bf16*)(pb + qrow * PLD + dd::O_AQ + head * 128), (const att::bf16*)(pb + krow * PLD + dd::O_AK + kvh * 128),
              (const att::bf16*)(pb + krow * PLD + dd::O_AV + kvh * 128), pb + qrow * PLD + dd::O_AQ + head * 128, lat ? RB : dd::C, (char*)lds_raw);
          __syncthreads(); }
        xcd_barrier(xb); }
      { const int n3 = last ? 64 : 68;
        for (int u = blockIdx.x; u < GB * 4 * n3; u += gridDim.x) { const int bl = u / (4 * n3), hu = u % (4 * n3); const bf16_t* pb = proj_s + (size_t)bl * RB * PLD;
          gla::In gp; gp.q = pb + dd::O_GQ; gp.k = pb + dd::O_GK; gp.v = pb + dd::O_GV; gp.ga = pb + dd::O_GA; gp.og = pb + dd::O_OG; gp.ld = PLD;
          gp.wa2 = a.gla_wa2 + (size_t)l * 2 * 16 * 256; gp.ba = a.gla_ba + (size_t)l * 2 * 256; gp.gnorm = a.gla_norm_g + (size_t)l * 128;
          gp.csb = (bf16_t*)(mix_s + (size_t)bl * CS_BYTES); gp.dec = (float*)(mix_s + (size_t)GB * CS_BYTES + (size_t)bl * DEC_BYTES); gp.y = (bf16_t*)pb + dd::O_OG; gp.ldy = PLD; gp.S = dd::S; gp.C = dd::C;
          gla::g3b_unit(gp, lds, hu / n3, hu % n3, 4, 68); }
        xcd_barrier(xb); }
      {
        bf16_t* ucT0 = (bf16_t*)mix_s; bf16_t* yT0 = (bf16_t*)(mix_s + GB * UCT_BYTES); float* ucc0 = (float*)(mix_s + GB * (UCT_BYTES + YT_BYTES)); float* z1c0 = (float*)(mix_s + GB * (UCT_BYTES + YT_BYTES + UCC_BYTES));
        const float* cw = a.hy_conv_w + (size_t)l * 3 * 1536; const float* cb = a.hy_conv_b + (size_t)l * 1536; const float* skp = a.hy_skip + (size_t)l * 2 * 512;
        { TID_SETUP
        { int t_ = blockIdx.x; hy::H0Regs hr = hy::h0_load(proj_s + (size_t)(t_ / (64 * 24)) * RB * PLD + dd::O_HY, PLD, t_ % (64 * 24), tz);
          for (; t_ < GB * 64 * 24; t_ += gridDim.x) { const int bl = t_ / (64 * 24), tn_ = t_ + gridDim.x; hy::H0Regs hn = hr;
            if (tn_ < GB * 64 * 24) hn = hy::h0_load(proj_s + (size_t)(tn_ / (64 * 24)) * RB * PLD + dd::O_HY, PLD, tn_ % (64 * 24), tz);
            hy::h0_compute(hr, cw, cb, ucT0 + (size_t)bl * 1536 * 4096, t_ % (64 * 24), lds, tz); hr = hn; } }
        if (!last) for (long i_ = gt; i_ < (long)GB * 256 * 1536; i_ += gs) { const int bl = (int)(i_ / (256 * 1536)); hy::cconv3_item(proj_s + ((size_t)bl * RB + dd::S) * PLD + dd::O_HY, PLD, cw, cb, ucc0 + (size_t)bl * 256 * 1536, i_ % (256 * 1536)); } }
        xcd_barrier(xb);
        { TID_SETUP
        for (int u = blockIdx.x; u < (GB / 2) * 512; u += gridDim.x) { const int bp_ = u / 512; hy::h1c_unit(ucT0 + (size_t)(2 * bp_) * 1536 * 4096, (const bf16_t*)a.tapsS, a.nrmS, skp, yT0 + (size_t)(2 * bp_) * 512 * 4096, u % 512, lds); }
        if (!last) for (long i_ = gt; i_ < (long)GB * 32 * 512; i_ += gs) { const int bl = (int)(i_ / (32 * 512)); hy::clong_item(ucc0 + (size_t)bl * 256 * 1536, nullptr, z1c0 + (size_t)bl * 256 * 512, nullptr, 0, a.tapsC, a.nrmC, skp, 0, i_ % (32 * 512)); } }
        xcd_barrier(xb);
        { TID_SETUP
        for (int t_ = blockIdx.x; t_ < GB * 64 * 8; t_ += gridDim.x) { const int bl = t_ / (64 * 8); hy::h2_tile(yT0 + (size_t)bl * 512 * 4096, proj_s + (size_t)bl * RB * PLD + dd::O_HY, PLD, t_ % (64 * 8), lds); }
        if (!last) for (long i_ = gt; i_ < (long)GB * 32 * 512; i_ += gs) { const int bl = (int)(i_ / (32 * 512)); hy::clong_item(ucc0 + (size_t)bl * 256 * 1536, z1c0 + (size_t)bl * 256 * 512, nullptr, proj_s + ((size_t)bl * RB + dd::S) * PLD + dd::O_HY, PLD, a.tapsC, a.nrmC, skp, 1, i_ % (32 * 512)); } }
        xcd_barrier(xb); }
      { { pg8::Gemm g{proj_s, ka.WhyT, RG, 1024, 1024, PLD, 1024}; MergeOrder S; S.init((int)gridDim.x, (int)blockIdx.x, last); EpiMergeS E{(const unsigned char*)(proj_s + dd::O_BR), (bf16_t*)mix_s};
          pg8::gemm_phase<EpiMergeS, MergeOrder, false>((PG8_LAS unsigned char*)(lds + RING_OFF), g, S, E, nullptr); }
        xcd_barrier(xb);
        pg8::Gemm g{(const bf16_t*)mix_s, ka.WoutT, RG, 1024, 1024, 0}; GroupOrder S; S.init(1024, (int)gridDim.x, (int)blockIdx.x, last);
        EpiOutG E{a.x, a.ctx, ka.xs + (size_t)grp * RG * 1024, a.mod, b0, !last, l != 0};
        pg8::gemm_phase<EpiOutG, GroupOrder, false>((PG8_LAS unsigned char*)(lds + RING_OFF), g, S, E, nullptr);
        xcd_barrier(xb); }
      {
        { TID_SETUP int* cnt = ka.cnt + (l * NGRP + grp) * 1024;
          LAS bf16_t* wfr = (LAS bf16_t*)(lds + RING_OFF);
          for (int i_ = tz; i_ < 1024 * 16; i_ += NTHREADS) { const int k = i_ >> 4, e = i_ & 15; const float w = a.router_w[i_]; const unsigned hi = f2bf(w); const unsigned lo = f2bf(w - __uint_as_float(hi << 16));
            const int idx = (((k >> 5) * 64 + ((k >> 3) & 3) * 16 + e) << 3) + (k & 7); wfr[idx] = (bf16_t)hi; wfr[16384 + idx] = (bf16_t)lo; }
          LAS int* lcnt = (LAS int*)(lds + RING_OFF + 65536);
          if (tz < 32) lcnt[tz] = 0;
          LAS float* ptab = (LAS float*)(lds + RING_OFF + 65536 + 1024);
          for (int i_ = tz; i_ < 5 * 1024; i_ += NTHREADS) { const int v_ = i_ >> 10, c_ = i_ & 1023; const float* md = a.mod + (size_t)(v_ < GB ? b0 + v_ : dd::B) * 6 * 1024;
            const float g_ = a.norm2_g[(size_t)l * 1024 + c_]; ptab[v_ * 2048 + c_] = g_ * md[4 * 1024 + c_] + g_; ptab[v_ * 2048 + 1024 + c_] = md[3 * 1024 + c_]; }
          __syncthreads();
          const int wv_ = __builtin_amdgcn_readfirstlane(tz >> 6);
          for (int t_ = (int)blockIdx.x + (int)gridDim.x * wv_; t_ < RG / 16; t_ += (int)gridDim.x * NWAVES) { const int rg = 16 * t_, bl = rg / RB, r = rg % RB, b = b0 + bl; if (last && r >= dd::S) continue;
            const LAS float* pt_ = ptab + (r < dd::S ? bl : GB) * 2048; (void)b;
            moe::route16(ka.xs + ((size_t)grp * RG + rg) * 1024, pt_, pt_ + 1024, hb_s + (size_t)rg * 1024, (const LAS v4u*)wfr, a.router_b, lcnt, ka.route + rg, ka.wts + 2 * rg, lane); }
          __syncthreads();
          if (tz < 16) lcnt[16 + tz] = atomicAdd(cnt + tz * 64, lcnt[tz]);
          __syncthreads();
          for (int t_ = (int)blockIdx.x + (int)gridDim.x * wv_; t_ < RG / 16; t_ += (int)gridDim.x * NWAVES) { const int rg = 16 * t_; if (last && (rg % RB) >= dd::S) continue;
            if (lane < 16) { moe::Route* rt = ka.route + rg + lane; moe::Route r_ = *rt; r_.r0 += lcnt[16 + r_.e0]; r_.r1 += lcnt[16 + r_.e1]; *rt = r_; } }
          xcd_barrier(xb); }
        { TID_SETUP int* cnt = ka.cnt + (l * NGRP + grp) * 1024;
          if (tz == 0) { int acc_ = 0; for (int e = 0; e < 16; ++e) { poff[e] = acc_; acc_ += (cnt[e * 64] + 255) >> 8; } poff[16] = acc_; }
          __syncthreads();
          for (int rg = gw; rg < RG; rg += NGW) { if (last && (rg % RB) >= dd::S) continue; const moe::Route rt = ka.route[rg];
            const v4u h0 = *(const v4u*)(hb_s + (size_t)rg * 1024 + lane * 16), h1 = *(const v4u*)(hb_s + (size_t)rg * 1024 + lane * 16 + 8);
#pragma unroll
            for (int sl = 0; sl < 2; ++sl) { const int e = sl ? rt.e1 : rt.e0, rk = sl ? rt.r1 : rt.r0; const size_t dst = (size_t)poff[e] * 256 + rk;
              *(v4u*)(ka.hp + dst * 1024 + lane * 16) = h0; *(v4u*)(ka.hp + dst * 1024 + lane * 16 + 8) = h1;
              if (lane == 0) { ka.srcrow[dst] = 2 * rg + sl; ka.wgt[dst] = ka.wts[2 * rg + sl]; } } }
          for (int e = 0; e < 16; ++e) { const int c_ = cnt[e * 64], pe = ((c_ + 255) >> 8) << 8; for (int p_ = c_ + (int)gt; p_ < pe; p_ += (int)gs) ka.srcrow[(size_t)poff[e] * 256 + p_] = -1; }
          xcd_barrier(xb); }
        { pg8::Gemm g{ka.hp, ka.WguT, 0, 0, 1024, 0}; moe::MoeOrder S{(int)gridDim.x, (int)blockIdx.x, 4, poff}; moe::EpiGU E{ka.hid};
          pg8::gemm_phase<moe::EpiGU, moe::MoeOrder, false>((PG8_LAS unsigned char*)(lds + RING_OFF), g, S, E, nullptr);
          xcd_barrier(xb); }
        { pg8::Gemm g{ka.hid, ka.WdT, 0, 0, 512, 0}; moe::MoeOrder S{(int)gridDim.x, (int)blockIdx.x, 4, poff}; moe::EpiDown E{ka.srcrow, ka.wgt, ka.contrib, (size_t)RG * 1024};
          pg8::gemm_phase<moe::EpiDown, moe::MoeOrder, false>((PG8_LAS unsigned char*)(lds + RING_OFF), g, S, E, nullptr);
          xcd_barrier(xb); }
        { TID_SETUP
          bf16_t* xsg = ka.xs + (size_t)grp * RG * 1024;
#pragma unroll 2
          for (long i_ = gt; i_ < (long)RG * 128; i_ += gs) { const int rg = (int)(i_ >> 7), c8 = (int)(i_ & 127) * 8; const int bl = rg / RB, r = rg % RB, b = b0 + bl; if (last && r >= dd::S) continue;
            const float* g2 = a.mod + (size_t)(r < dd::S ? b : dd::B) * 6 * 1024 + 5 * 1024 + c8;
            const v4u u0 = *(const v4u*)(ka.contrib + (size_t)rg * 1024 + c8), u1 = *(const v4u*)(ka.contrib + (size_t)RG * 1024 + (size_t)rg * 1024 + c8), xo = *(const v4u*)(xsg + (size_t)rg * 1024 + c8);
            const pg8::f32x4 ga_ = *(const pg8::f32x4*)g2, gb_ = *(const pg8::f32x4*)(g2 + 4);
            pg8::f32x4 ya, yb;
            ya[0] = __uint_as_float(xo.x << 16) + ga_[0] * (__uint_as_float(u0.x << 16) + __uint_as_float(u1.x << 16)); ya[1] = __uint_as_float(xo.x & 0xffff0000u) + ga_[1] * (__uint_as_float(u0.x & 0xffff0000u) + __uint_as_float(u1.x & 0xffff0000u));
            ya[2] = __uint_as_float(xo.y << 16) + ga_[2] * (__uint_as_float(u0.y << 16) + __uint_as_float(u1.y << 16)); ya[3] = __uint_as_float(xo.y & 0xffff0000u) + ga_[3] * (__uint_as_float(u0.y & 0xffff0000u) + __uint_as_float(u1.y & 0xffff0000u));
            yb[0] = __uint_as_float(xo.z << 16) + gb_[0] * (__uint_as_float(u0.z << 16) + __uint_as_float(u1.z << 16)); yb[1] = __uint_as_float(xo.z & 0xffff0000u) + gb_[1] * (__uint_as_float(u0.z & 0xffff0000u) + __uint_as_float(u1.z & 0xffff0000u));
            yb[2] = __uint_as_float(xo.w << 16) + gb_[2] * (__uint_as_float(u0.w << 16) + __uint_as_float(u1.w << 16)); yb[3] = __uint_as_float(xo.w & 0xffff0000u) + gb_[3] * (__uint_as_float(u0.w & 0xffff0000u) + __uint_as_float(u1.w & 0xffff0000u));
            if (last) { float* o = a.out + ((size_t)b * dd::S + r) * 1024 + c8; *(pg8::f32x4*)o = ya; *(pg8::f32x4*)(o + 4) = yb; }
            else { v4u w; w.x = pk2h(ya[0], ya[1]); w.y = pk2h(ya[2], ya[3]); w.z = pk2h(yb[0], yb[1]); w.w = pk2h(yb[2], yb[3]); *(v4u*)(xsg + (size_t)rg * 1024 + c8) = w; } }
          xcd_barrier(xb); }
      }
    }
  }
}
extern "C" void kernel_launch(void* const* d_in, const int* in_sizes, int n_in, void* d_out, int out_size, void* d_ws, size_t ws_size, hipStream_t stream) {
  static int grid = 0;
  if (!grid) {
    int dev = 0, cus = 0, per_cu = 0;
    (void)hipGetDevice(&dev); (void)hipDeviceGetAttribute(&cus, hipDeviceAttributeMultiprocessorCount, dev);
    (void)hipFuncSetAttribute((const void*)mega_kernel, hipFuncAttributeMaxDynamicSharedMemorySize, LDS_BYTES);
    (void)hipOccupancyMaxActiveBlocksPerMultiprocessor(&per_cu, mega_kernel, NTHREADS, LDS_BYTES);
    if (per_cu < 1) fprintf(stderr, "occupancy query says %d\n", per_cu);
    grid = cus;
  }
  KArgs ka{}; const float* ptrs[33]; for (int i = 0; i < 33; ++i) ptrs[i] = (const float*)d_in[i];
  set_inputs<TD>(ka.a, ptrs);
  char* wsb = (char*)d_ws; size_t off = BAR_BYTES;
  auto take = [&](size_t bytes) { char* p = wsb + off; off += (bytes + 255) & ~(size_t)255; return p; };
  NaiveBufs& a = ka.a;
  a.mod = (float*)take((size_t)(dd::B + 1) * 6 * 1024 * 4); a.hid2S = (float*)take((size_t)dd::S * 64 * 4); a.hid2C = (float*)take((size_t)dd::C * 64 * 4);
  a.tapsS = (float*)take((size_t)2 * 512 * 2 * 8232 * 2 + 64); a.tapsC = (float*)take((size_t)2 * 512 * 512 * 4); a.nrmS = (float*)take(1024 * 4); a.nrmC = (float*)take(1024 * 4);
  ka.xs = (bf16_t*)take((size_t)dd::B * RB * 1024 * 2);
  ka.WgaT = (bf16_t*)take((size_t)32 * 1024 * 2); ka.WinT = (bf16_t*)take((size_t)NINP * 1024 * 2); ka.WhyT = (bf16_t*)take((size_t)1024 * 1024 * 2); ka.WglaT = (bf16_t*)take((size_t)1024 * 1024 * 2); ka.WattT = (bf16_t*)take((size_t)1024 * 1024 * 2);
  ka.WoutT = (bf16_t*)take((size_t)1024 * 1024 * 2); ka.WguT = (bf16_t*)take((size_t)16 * 1024 * 1024 * 2); ka.WdT = (bf16_t*)take((size_t)16 * 1024 * 512 * 2);
  ka.hb = (bf16_t*)take((size_t)RG * 1024 * 2); ka.mix = (unsigned char*)take(MIX_BYTES);
  ka.proj = (bf16_t*)take((size_t)RG * PLD * 2);
  { char* p = (char*)ka.proj; ka.hp = (bf16_t*)p; p += (size_t)MPG * 1024 * 2; ka.hid = (bf16_t*)p; p += (size_t)MPG * 512 * 2; ka.contrib = (bf16_t*)p; p += (size_t)2 * RG * 1024 * 2;
    ka.srcrow = (int*)p; p += (size_t)MPG * 4; ka.wgt = (float*)p; p += (size_t)MPG * 4; ka.route = (moe::Route*)p; p += (size_t)RG * 16; ka.wts = (float*)p; p += (size_t)RG * 8;
    if ((size_t)(p - (char*)ka.proj) > (size_t)RG * PLD * 2) fprintf(stderr, "MoE alias region too large\n"); }
  a.out = (float*)d_out; ka.bar = (unsigned*)d_ws; ka.cnt = (int*)(wsb + CNT_OFF);
  if (off > ws_size) fprintf(stderr, "workspace too small: need %zu have %zu\n", off, ws_size);
  (void)hipMemsetAsync(d_ws, 0, BAR_BYTES, stream);
  hipLaunchKernelGGL(mega_kernel, dim3(grid), dim3(NTHREADS), LDS_BYTES, stream, ka);
}
```

```cpp
#include <hip/hip_runtime.h>
#include <cstddef>
#include <cstdio>
#include <cstdint>
#include <hip/hip_bf16.h>
#include <hip/hip_runtime.h>
namespace pg8 {
#define PG8_LAS __attribute__((address_space(3)))
typedef unsigned short bf16_t;
typedef short bf16x8 __attribute__((ext_vector_type(8)));
typedef float f32x4 __attribute__((ext_vector_type(4)));
typedef unsigned u32x4 __attribute__((ext_vector_type(4)));
constexpr int BM = 256, BK = 64, HALF = 128, HTB = HALF * BK * 2  , STAGE_BYTES = 8 * HTB, NXCD = 8, WGM = 8;

__host__ __device__ __forceinline__ int lds_byte(int r, int c) { const int st = (r >> 4) * 2 + (c >> 5), rr = r & 15, cc = c & 31, ob = rr * 64 + cc * 2; return st * 1024 + (ob ^ (((ob >> 9) & 1) << 5)); }
__host__ __device__ __forceinline__ void stage_rc(int b, int& R, int& C) { const int st = b / 1024, sb = b % 1024, swz = sb ^ (((sb >> 9) & 1) << 5); R = (st >> 1) * 16 + swz / 64; C = (st & 1) * 32 + (swz % 64) / 2; }
__host__ __device__ __forceinline__ int perm32(int rho) { const int n = rho >> 4, i = rho & 15; return 8 * (i >> 2) + 4 * n + (i & 3); }

struct Unit { int pm, pn, acol, nt; };
struct Gemm { const bf16_t* A; const bf16_t* Bt; int M, N, K; int lda; int ldb; };

struct StaticOrder {
    int nM, nN, nwg, G, c;
    __host__ __device__ void init(int M, int N, int G_, int c_) { nM = M / BM; nN = N / BM; nwg = nM * nN; G = G_; c = c_; }
    __host__ __device__ bool next(int i, Unit& u) const {
        const long L = (long)i * G + c; if (L >= nwg) return false;
        int wgid = (int)L; { const int q = nwg / NXCD, r = nwg % NXCD, xcd = wgid % NXCD, off = wgid / NXCD; wgid = (xcd < r ? xcd * (q + 1) : r * (q + 1) + (xcd - r) * q) + off; }
        const int nig = WGM * nN, gid = wgid / nig, fm = gid * WGM, gsz = (nM - fm) < WGM ? (nM - fm) : WGM;
        u.pm = fm + ((wgid % nig) % gsz); u.pn = (wgid % nig) / gsz; u.acol = 0; u.nt = 0; return true;
    }
    __device__ __forceinline__ void a_ready(const Unit&) const {}
    __device__ __forceinline__ void done(const Unit&) const {}
};
__device__ __forceinline__ unsigned cvt_pk_bf16(float lo, float hi) { unsigned r; asm volatile("v_cvt_pk_bf16_f32 %0, %1, %2" : "=v"(r) : "v"(lo), "v"(hi)); return r; }
typedef float f32x2 __attribute__((ext_vector_type(2)));
template <class Epi, class Sched, bool STAMP = false>
__device__ __forceinline__ void gemm_phase(PG8_LAS unsigned char* lds, const Gemm g, const Sched& S, const Epi& E, unsigned long long* stamps) {
    int tid = threadIdx.x; asm volatile("" : "+v"(tid)); const int wid = __builtin_amdgcn_readfirstlane(tid >> 6), lane = tid & 63, wr = wid >> 2, wc = wid & 3, fr = lane & 15, fq = lane >> 4;
    const int K = g.K, nt = K / BK, LDA = g.lda ? g.lda : g.K, LDB = g.ldb ? g.ldb : g.K;
    int ts_lo = 0, ts_hi = 0, nts = 0; const unsigned long long rt_entry = STAMP ? (unsigned long long)wall_clock64() : 0ull;
#define PG8_STAMP() do { if (STAMP && wid == 0 && nts < 64) { const unsigned long long _c = (unsigned long long)clock64(); \
        ts_lo = (lane == nts) ? (int)(unsigned)_c : ts_lo; ts_hi = (lane == nts) ? (int)(unsigned)(_c >> 32) : ts_hi; ++nts; } } while (0)
    PG8_STAMP();
    unsigned voffA[2], voffB[2];
#pragma unroll
    for (int i = 0; i < 2; ++i) { int R, C; stage_rc(tid * 16 + i * 8192, R, C); const int Rb = Epi::PERM ? ((R & ~31) + perm32(R & 31)) : R;
        voffA[i] = (unsigned)(R * LDA + C) * 2u; voffB[i] = (unsigned)(Rb * LDB + C) * 2u; }
    const size_t kstep = (size_t)(BK * 2);
    const size_t hstep = (size_t)HALF * LDB * 2;
    const size_t tstep = 2 * hstep;
    const size_t hstepA = (size_t)HALF * LDA * 2, tstepA = 2 * hstepA;
    const unsigned ldsw = (unsigned)wid * 1024u;
    const int aoff = lds_byte(wr * 64 + fr, fq * 8), boff = lds_byte(wc * 32 + fr, fq * 8);
#define PG8_SA(b, h) (((b) * 2 + (h)) * HTB)
#define PG8_SB(b, h) ((4 + (b) * 2 + (h)) * HTB)
#define PG8_STAGE(bufoff, gbase, voff) do { _Pragma("unroll") for (int _i = 0; _i < 2; ++_i) \
        __builtin_amdgcn_global_load_lds((const unsigned*)((const char*)(gbase) + (voff)[_i]), (PG8_LAS unsigned*)(lds + (bufoff) + ldsw + _i * 8192), 16, 0, 0); } while (0)
#define PG8_LDA(dst, b, h) do { _Pragma("unroll") for (int m = 0; m < 4; ++m) _Pragma("unroll") for (int k = 0; k < 2; ++k) dst[m][k] = *(const PG8_LAS bf16x8*)(lds + PG8_SA(b, h) + aoff + m * 2048 + k * 1024); } while (0)
#define PG8_LDB(dst, b, h) do { _Pragma("unroll") for (int n = 0; n < 2; ++n) _Pragma("unroll") for (int k = 0; k < 2; ++k) dst[n][k] = *(const PG8_LAS bf16x8*)(lds + PG8_SB(b, h) + boff + n * 2048 + k * 1024); } while (0)
#define PG8_MMA(ai, bj, At, Bt) do { __builtin_amdgcn_s_setprio(1); _Pragma("unroll") for (int m = 0; m < 4; ++m) _Pragma("unroll") for (int n = 0; n < 2; ++n) _Pragma("unroll") for (int k = 0; k < 2; ++k) \
        acc[ai][bj][m][n] = __builtin_amdgcn_mfma_f32_16x16x32_bf16(Bt[n][k], At[m][k], acc[ai][bj][m][n], 0, 0, 0); __builtin_amdgcn_s_setprio(0); } while (0)
#define PG8_WAIT_V(n) asm volatile("s_waitcnt vmcnt(" #n ")" ::: "memory")
#define PG8_WAIT_L(n) asm volatile("s_waitcnt lgkmcnt(" #n ")" ::: "memory")
#define PG8_BAR __builtin_amdgcn_s_barrier()
#define PG8_SCHED __builtin_amdgcn_sched_barrier(0)
    Unit cur, nxt; int ui = 0;
    if (!S.next(0, cur)) return;
    f32x4 acc[2][2][4][2];
#pragma unroll
    for (int a = 0; a < 2; ++a)
#pragma unroll
        for (int b = 0; b < 2; ++b)
#pragma unroll
            for (int m = 0; m < 4; ++m)
#pragma unroll
                for (int n = 0; n < 2; ++n) acc[a][b][m][n] = (f32x4){0.f, 0.f, 0.f, 0.f};
    bf16x8 At[4][2], B0[2][2], B1[2][2];
    const char* cA = (const char*)g.A + (size_t)cur.pm * tstepA + (size_t)cur.acol * 2; const char* cB = (const char*)g.Bt + (size_t)cur.pn * tstep;
    S.a_ready(cur);
    PG8_STAGE(PG8_SB(0, 0), cB, voffB); PG8_STAGE(PG8_SA(0, 0), cA, voffA); PG8_STAGE(PG8_SB(0, 1), cB + hstep, voffB); PG8_STAGE(PG8_SA(0, 1), cA + hstepA, voffA);
    if (wr == 1) PG8_BAR;
    PG8_WAIT_V(4); PG8_BAR;
    PG8_STAGE(PG8_SB(1, 0), cB + kstep, voffB); PG8_STAGE(PG8_SA(1, 0), cA + kstep, voffA); PG8_STAGE(PG8_SB(1, 1), cB + hstep + kstep, voffB);
    PG8_WAIT_V(6); PG8_BAR;
    PG8_STAMP();
    for (;;) {
        const bool has_next = S.next(ui + 1, nxt);
        const char* nA = has_next ? (const char*)g.A + (size_t)nxt.pm * tstepA + (size_t)nxt.acol * 2 : cA; const char* nB = has_next ? (const char*)g.Bt + (size_t)nxt.pn * tstep : cB;
        const int ntu = cur.nt ? cur.nt : nt;
        for (int t = 0; t < ntu; t += 2) {
            const bool last = (t == ntu - 2);
            const char* a1 = cA + (size_t)(t + 1) * kstep;
            const char* a2 = last ? nA : cA + (size_t)(t + 2) * kstep; const char* b2 = last ? nB : cB + (size_t)(t + 2) * kstep;
            const char* a3 = a2 + kstep; const char* b3 = b2 + kstep;
            if (last && has_next) S.a_ready(nxt);
            PG8_LDB(B0, 0, 0); PG8_SCHED; PG8_LDA(At, 0, 0); PG8_STAGE(PG8_SA(1, 1), a1 + hstepA, voffA);
            PG8_WAIT_L(8); PG8_BAR; PG8_WAIT_L(0); PG8_MMA(0, 0, At, B0); PG8_BAR; PG8_SCHED;
            PG8_LDB(B1, 0, 1); PG8_STAGE(PG8_SB(0, 0), b2, voffB);
            PG8_BAR; PG8_WAIT_L(0); PG8_MMA(0, 1, At, B1); PG8_BAR;
            PG8_LDA(At, 0, 1); PG8_STAGE(PG8_SA(0, 0), a2, voffA);
            PG8_BAR; PG8_WAIT_L(0); PG8_MMA(1, 0, At, B0); PG8_BAR; PG8_SCHED;
            PG8_STAGE(PG8_SB(0, 1), b2 + hstep, voffB);
            PG8_WAIT_V(6); PG8_BAR; PG8_MMA(1, 1, At, B1); PG8_BAR;
            PG8_LDB(B0, 1, 0); PG8_SCHED; PG8_LDA(At, 1, 0); PG8_STAGE(PG8_SA(0, 1), a2 + hstepA, voffA);
            PG8_WAIT_L(8); PG8_BAR; PG8_WAIT_L(0); PG8_MMA(0, 0, At, B0); PG8_BAR; PG8_SCHED;
            PG8_LDB(B1, 1, 1); PG8_STAGE(PG8_SB(1, 0), b3, voffB);
            PG8_BAR; PG8_WAIT_L(0); PG8_MMA(0, 1, At, B1); PG8_BAR;
            PG8_LDA(At, 1, 1); PG8_STAGE(PG8_SA(1, 0), a3, voffA);
            PG8_BAR; PG8_WAIT_L(0); PG8_MMA(1, 0, At, B0); PG8_BAR; PG8_SCHED;
            PG8_STAGE(PG8_SB(1, 1), b3 + hstep, voffB);
            PG8_WAIT_V(6); PG8_BAR; PG8_MMA(1, 1, At, B1); PG8_BAR;
        }
        PG8_STAMP();
        if constexpr (!Epi::AFTER_DRAIN) { E(acc, cur, wr, wc, fr, fq); S.done(cur); }
        PG8_STAMP();
        if (!has_next) break;
#pragma unroll
        for (int a = 0; a < 2; ++a)
#pragma unroll
            for (int b = 0; b < 2; ++b)
#pragma unroll
                for (int m = 0; m < 4; ++m)
#pragma unroll
                    for (int n = 0; n < 2; ++n) acc[a][b][m][n] = (f32x4){0.f, 0.f, 0.f, 0.f};
        cur = nxt; cA = nA; cB = nB; ++ui;
    }
    PG8_WAIT_V(0);
    if (wr == 0) PG8_BAR;
    PG8_BAR;
    if constexpr (Epi::AFTER_DRAIN) { E.fused(acc, cur, wr, wc, fr, fq, lds, wid, lane); S.done(cur); }
    PG8_STAMP();
    if (STAMP && wid == 0) { stamps[lane] = lane < nts ? (((unsigned long long)(unsigned)ts_hi << 32) | (unsigned)ts_lo) : 0ull;
        if (lane == 62) stamps[62] = rt_entry; if (lane == 63) stamps[63] = (unsigned long long)wall_clock64(); }
#undef PG8_STAMP
#undef PG8_SA
#undef PG8_SB
#undef PG8_STAGE
#undef PG8_LDA
#undef PG8_LDB
#undef PG8_MMA
#undef PG8_WAIT_V
#undef PG8_WAIT_L
#undef PG8_BAR
#undef PG8_SCHED
}
}

#define LAS __attribute__((address_space(3)))
typedef unsigned short bf16_t;
constexpr int NWAVES = 8, NTHREADS = 512;
constexpr int LDS_BYTES = 147456;
constexpr int RING_OFF = 0;
constexpr int MISC_OFF = 131072;
constexpr int NINP = 7680;

__device__ __forceinline__ unsigned f2bf(float f) { return (unsigned)__builtin_bit_cast(unsigned short, (__bf16)f); }
typedef __bf16 bf16x2_t __attribute__((ext_vector_type(2))); typedef float f32x2_t __attribute__((ext_vector_type(2)));
__device__ __forceinline__ unsigned pk2(float lo, float hi) { const f32x2_t v = {lo, hi}; return __builtin_bit_cast(unsigned, __builtin_convertvector(v, bf16x2_t)); }
__device__ __forceinline__ unsigned pk2h(float lo, float hi) { const f32x2_t v = {lo, hi}; return __builtin_bit_cast(unsigned, __builtin_convertvector(v, bf16x2_t)); }
__device__ __forceinline__ float bf2f(bf16_t b) { return __builtin_bit_cast(float, ((unsigned)b) << 16); }
typedef unsigned v4u __attribute__((ext_vector_type(4)));

__device__ __forceinline__ void transpose_item(const float* W, int K, int N, bf16_t* WT, int row_off, LAS float* scr, int item, int lane, int ldo = 0) {
  if (ldo == 0) ldo = K;
  const int nblk = N / 32, kb = item / nblk, nb = item % nblk, k0 = 64 * kb, n0 = 32 * nb;
  float wreg[32];
#pragma unroll
  for (int i = 0; i < 32; ++i) { const int kk = 2 * i + (lane >> 5); wreg[i] = W[(size_t)(k0 + kk) * N + n0 + (lane & 31)]; }
#pragma unroll
  for (int i = 0; i < 32; ++i) { const int kk = 2 * i + (lane >> 5); scr[kk * 33 + (lane & 31)] = wreg[i]; }
  asm volatile("s_waitcnt lgkmcnt(0)" ::: "memory");
  const int c = lane & 7;
#pragma unroll
  for (int j = 0; j < 4; ++j) { const int n = (lane >> 3) + 8 * j; const LAS float* s = scr + (8 * c) * 33 + n;
    v4u o; o.x = pk2(s[0 * 33], s[1 * 33]); o.y = pk2(s[2 * 33], s[3 * 33]); o.z = pk2(s[4 * 33], s[5 * 33]); o.w = pk2(s[6 * 33], s[7 * 33]);
    *(v4u*)(WT + (size_t)(row_off + n0 + n) * ldo + k0 + 8 * c) = o; }
  asm volatile("s_waitcnt lgkmcnt(0)" ::: "memory");
}

struct EpiProjF32 {
  static constexpr bool PERM = false, AFTER_DRAIN = false;
  float* C; int ldc; int ncols;
  __device__ __forceinline__ void operator()(const pg8::f32x4 (&acc)[2][2][4][2], const pg8::Unit& u, int wr, int wc, int fr, int fq) const {
    const int row0 = u.pm * 256 + wr * 64 + fr, col0 = u.pn * 256 + wc * 32 + 4 * fq;
#pragma unroll
    for (int ai = 0; ai < 2; ++ai)
#pragma unroll
      for (int m = 0; m < 4; ++m) { float* rowp = C + (size_t)(row0 + ai * 128 + m * 16) * ldc + col0;
#pragma unroll
        for (int bj = 0; bj < 2; ++bj)
#pragma unroll
          for (int n = 0; n < 2; ++n) if (col0 + bj * 128 + n * 16 < ncols) *(pg8::f32x4*)(rowp + bj * 128 + n * 16) = acc[ai][bj][m][n]; }
  }
};

__device__ __forceinline__ float fsigmoid(float x) { return 1.f / (1.f + __expf(-x)); }
template <bool ACCUM> struct EpiMerge {
  static constexpr bool PERM = true, AFTER_DRAIN = false;
  const float* gate; int ldg; bf16_t* M; int ldm;
  __device__ __forceinline__ void operator()(const pg8::f32x4 (&acc)[2][2][4][2], const pg8::Unit& u, int wr, int wc, int fr, int fq) const {
    const int row0 = u.pm * 256 + wr * 64 + fr, col0 = u.pn * 256 + wc * 32 + 8 * fq;
#pragma unroll
    for (int ai = 0; ai < 2; ++ai)
#pragma unroll
      for (int m = 0; m < 4; ++m) { const size_t r = (size_t)(row0 + ai * 128 + m * 16);
#pragma unroll
        for (int bj = 0; bj < 2; ++bj) { const int c = col0 + bj * 128;
          const pg8::f32x4 g0 = *(const pg8::f32x4*)(gate + r * ldg + c), g1 = *(const pg8::f32x4*)(gate + r * ldg + c + 4);
          pg8::f32x4 v0 = acc[ai][bj][m][0], v1 = acc[ai][bj][m][1];
#pragma unroll
          for (int e = 0; e < 4; ++e) { v0[e] *= fsigmoid(g0[e]); v1[e] *= fsigmoid(g1[e]); }
          v4u* dst = (v4u*)(M + r * ldm + c);
          if (ACCUM) { const v4u o = *dst; v0[0] += bf2f(o.x & 0xffff); v0[1] += bf2f(o.x >> 16); v0[2] += bf2f(o.y & 0xffff); v0[3] += bf2f(o.y >> 16);
            v1[0] += bf2f(o.z & 0xffff); v1[1] += bf2f(o.z >> 16); v1[2] += bf2f(o.w & 0xffff); v1[3] += bf2f(o.w >> 16); }
          v4u o2; o2.x = pk2(v0[0], v0[1]); o2.y = pk2(v0[2], v0[3]); o2.z = pk2(v1[0], v1[1]); o2.w = pk2(v1[2], v1[3]); *dst = o2; } }
  }
};
struct EpiOut {
  static constexpr bool PERM = false, AFTER_DRAIN = false;
  const float* resL; float* outL; const float* gL;
  const float* resC; float* outC; const float* gC;
  __device__ __forceinline__ void operator()(const pg8::f32x4 (&acc)[2][2][4][2], const pg8::Unit& u, int wr, int wc, int fr, int fq) const {
    const bool isc = u.pm == 16; if (isc && outC == nullptr) return;
    const float* res = isc ? resC : resL; float* out = isc ? outC : outL; const float* gv = isc ? gC : gL;
    const int row0 = (isc ? 0 : u.pm * 256) + wr * 64 + fr, col0 = u.pn * 256 + wc * 32 + 4 * fq;
    pg8::f32x4 gg[2][2];
#pragma unroll
    for (int bj = 0; bj < 2; ++bj)
#pragma unroll
      for (int n = 0; n < 2; ++n) gg[bj][n] = *(const pg8::f32x4*)(gv + col0 + bj * 128 + n * 16);
#pragma unroll
    for (int ai = 0; ai < 2; ++ai)
#pragma unroll
      for (int m = 0; m < 4; ++m) { const size_t ro = (size_t)(row0 + ai * 128 + m * 16) * 1024 + col0;
#pragma unroll
        for (int bj = 0; bj < 2; ++bj)
#pragma unroll
          for (int n = 0; n < 2; ++n) { const pg8::f32x4 rv = *(const pg8::f32x4*)(res + ro + bj * 128 + n * 16); *(pg8::f32x4*)(out + ro + bj * 128 + n * 16) = rv + gg[bj][n] * acc[ai][bj][m][n]; } }
  }
};
namespace att {
using bf16 = __hip_bfloat16;
constexpr int D = 128, NW = 8, QBLK = 32, KVBLK = 64; constexpr float SCALE = 0.088388347648318440f; constexpr float THR = 8.f; constexpr int SDEPTH = 2;
constexpr size_t SHM_V = KVBLK * D * 2, SHM_K = KVBLK * D * 2, SHM_ATTN = 2 * SHM_V + 2 * SHM_K + NW * 64 * 4;
using bf16x8 = __attribute__((ext_vector_type(8))) short;
using s16x4  = __attribute__((ext_vector_type(4))) short;
using f32x16 = __attribute__((ext_vector_type(16))) float;
using f32x8  = __attribute__((ext_vector_type(8))) float;
using u32x4  = __attribute__((ext_vector_type(4))) unsigned;
#define KSWZ(row, colB) ((row) * 256 + ((colB) ^ (((row) & 7) << 4)))
#define SBAR() __builtin_amdgcn_sched_barrier(0)
__device__ __forceinline__ int crow(int r, int hi) { return (r & 3) + 8 * (r >> 2) + 4 * hi; }
__device__ __forceinline__ unsigned cvtpk(float lo, float hi) {
  unsigned r; asm volatile("v_cvt_pk_bf16_f32 %0, %1, %2" : "=v"(r) : "v"(lo), "v"(hi)); return r;
}
template <typename TIn> struct Stage;
template <> struct Stage<bf16>  { using T = bf16x8;
  __device__ static __forceinline__ T ld8(const bf16* p) { return *reinterpret_cast<const bf16x8*>(p); }
  __device__ static __forceinline__ bf16x8 tobf(T x) { return x; } };
template <> struct Stage<float> { using T = f32x8;
  __device__ static __forceinline__ T ld8(const float* p) { return *reinterpret_cast<const f32x8*>(p); }
  __device__ static __forceinline__ bf16x8 tobf(T x) {
    u32x4 w = {cvtpk(x[0], x[1]), cvtpk(x[2], x[3]), cvtpk(x[4], x[5]), cvtpk(x[6], x[7])}; return *reinterpret_cast<bf16x8*>(&w); } };

__device__ __forceinline__ void partialSM(f32x16& p0, f32x16& p1, float& m_reg, float& mn, float& alpha) {
  constexpr float C = SCALE * 1.4426950408889634f;
  float pmax = p0[0]; for (int r = 1; r < 16; ++r) pmax = fmaxf(pmax, p0[r]); for (int r = 0; r < 16; ++r) pmax = fmaxf(pmax, p1[r]);
  { auto rr = __builtin_amdgcn_permlane32_swap(__float_as_uint(pmax), __float_as_uint(pmax), false, false);
    pmax = fmaxf(__uint_as_float(rr[0]), __uint_as_float(rr[1])); }
  if (__builtin_expect(__all(pmax - m_reg <= THR / SCALE), 1)) { mn = m_reg; alpha = 1.f; }
  else { mn = fmaxf(m_reg, pmax); alpha = __builtin_amdgcn_exp2f((m_reg - mn) * C); m_reg = mn; }
  float mnC = -mn * C;
  for (int r = 0; r < 16; ++r) p0[r] = fmaf(p0[r], C, mnC); for (int r = 0; r < 16; ++r) p1[r] = fmaf(p1[r], C, mnC);
  for (int r = 0; r < 16; ++r) p0[r] = __builtin_amdgcn_exp2f(p0[r]);
}
__device__ __forceinline__ void finishSM(f32x16& p0, f32x16& p1, float alpha, float& l_reg, bf16x8& pa0, bf16x8& pa1, bf16x8& pa2, bf16x8& pa3) {
  for (int r = 0; r < 16; ++r) p1[r] = __builtin_amdgcn_exp2f(p1[r]);
  float ps = 0; for (int r = 0; r < 16; ++r) ps += p0[r]; for (int r = 0; r < 16; ++r) ps += p1[r];
  { auto rr = __builtin_amdgcn_permlane32_swap(__float_as_uint(ps), __float_as_uint(ps), false, false);
    ps = __uint_as_float(rr[0]) + __uint_as_float(rr[1]); }
  l_reg = l_reg * alpha + ps;
#define PK4(P, BASE, OUT) do { unsigned a0 = cvtpk(P[BASE + 0], P[BASE + 1]), a1 = cvtpk(P[BASE + 2], P[BASE + 3]);   \
    unsigned b0 = cvtpk(P[BASE + 4], P[BASE + 5]), b1 = cvtpk(P[BASE + 6], P[BASE + 7]);                              \
    auto r0 = __builtin_amdgcn_permlane32_swap(a0, b0, false, false); auto r1 = __builtin_amdgcn_permlane32_swap(a1, b1, false, false); \
    u32x4 w = {r0[0], r1[0], r0[1], r1[1]}; OUT = *reinterpret_cast<bf16x8*>(&w); } while (0)
  PK4(p0, 0, pa0); PK4(p0, 8, pa1); PK4(p1, 0, pa2); PK4(p1, 8, pa3);
#undef PK4
}
__device__ __forceinline__ void qkt(f32x16& p0, f32x16& p1, const bf16* Ks, const bf16x8* qr, int r32, int hi) {
  p0 = f32x16{}; p1 = f32x16{};
  for (int d0 = 0; d0 < 8; ++d0) { int cb = (d0 * 16 + hi * 8) * 2;
    bf16x8 b0 = *reinterpret_cast<const bf16x8*>((const char*)Ks + KSWZ(r32, cb));
    bf16x8 b1 = *reinterpret_cast<const bf16x8*>((const char*)Ks + KSWZ(32 + r32, cb));
    p0 = __builtin_amdgcn_mfma_f32_32x32x16_bf16(b0, qr[d0], p0, 0, 0, 0);
    p1 = __builtin_amdgcn_mfma_f32_32x32x16_bf16(b1, qr[d0], p1, 0, 0, 0); }
}
__device__ __forceinline__ int v_st(int k, int c) { const int kk = (k & ~0xC) | ((k & 4) << 1) | ((k & 8) >> 1); return ((kk >> 3) * 4 + (c >> 5)) * 512 + ((kk & 7) * 32 + (c & 31)) * 2; }
__device__ __forceinline__ int v_rd_base(int lane) { return ((lane & 3) << 3) | (((lane >> 2) & 3) << 6) | (((lane >> 4) & 1) << 5) | (((lane >> 5) & 1) << 8); }
constexpr int v_rd_off(int d0, int ks, int half) { return d0 * 512 + ks * 4096 + half * 2048; }
template <int OFF> __device__ __forceinline__ s16x4 tr_read(int vb) {
  s16x4 r; asm volatile("ds_read_b64_tr_b16 %0, %1 offset:%2" : "=&v"(r) : "v"(vb), "i"(OFF) : "memory"); return r;
}
template <int D0> __device__ __forceinline__ void pv_one(f32x16& od, int vb, bf16x8 pa0, bf16x8 pa1, bf16x8 pa2, bf16x8 pa3) {
  const s16x4 l0 = tr_read<v_rd_off(D0, 0, 0)>(vb), h0 = tr_read<v_rd_off(D0, 0, 1)>(vb), l1 = tr_read<v_rd_off(D0, 1, 0)>(vb), h1 = tr_read<v_rd_off(D0, 1, 1)>(vb);
  const s16x4 l2 = tr_read<v_rd_off(D0, 2, 0)>(vb), h2 = tr_read<v_rd_off(D0, 2, 1)>(vb), l3 = tr_read<v_rd_off(D0, 3, 0)>(vb), h3 = tr_read<v_rd_off(D0, 3, 1)>(vb);
  asm volatile("s_waitcnt lgkmcnt(0)" ::: "memory"); SBAR();
#define PK(L, H) (bf16x8){L[0], L[1], L[2], L[3], H[0], H[1], H[2], H[3]}
  od = __builtin_amdgcn_mfma_f32_32x32x16_bf16(pa0, PK(l0, h0), od, 0, 0, 0);
  od = __builtin_amdgcn_mfma_f32_32x32x16_bf16(pa1, PK(l1, h1), od, 0, 0, 0);
  od = __builtin_amdgcn_mfma_f32_32x32x16_bf16(pa2, PK(l2, h2), od, 0, 0, 0);
  od = __builtin_amdgcn_mfma_f32_32x32x16_bf16(pa3, PK(l3, h3), od, 0, 0, 0);
#undef PK
}
__device__ __forceinline__ void pv_d0(f32x16* o, int vb, bf16x8 pa0, bf16x8 pa1, bf16x8 pa2, bf16x8 pa3) {
  pv_one<0>(o[0], vb, pa0, pa1, pa2, pa3); pv_one<1>(o[1], vb, pa0, pa1, pa2, pa3); pv_one<2>(o[2], vb, pa0, pa1, pa2, pa3); pv_one<3>(o[3], vb, pa0, pa1, pa2, pa3);
}

template <typename TQ, int LDQ, int LDK, int LDO, bool OBF16>
__device__ __forceinline__ void attn_dense_body(const TQ* Qb, const bf16* Kh, const bf16* Vh,
                                                void* Obv, int seq, char* lds) {
  using St = Stage<bf16>; using SQ = Stage<TQ>;
  int tid = threadIdx.x; asm volatile("" : "+v"(tid)); const int wid = tid >> 6, lane = tid & 63, r32 = lane & 31, hi = lane >> 5;
  bf16* V_lds = (bf16*)lds; bf16* K_lds = (bf16*)(lds + 2 * SHM_V);
  float* ws = (float*)(lds + 2 * SHM_V + 2 * SHM_K) + wid * 64; float* li_l = ws; float* al_l = ws + 32;
  float m_reg = -1e30f, l_reg = 0; f32x16 o[4] = {}; bf16x8 qr[8];
  const TQ* Qw = Qb + (long)(wid * QBLK + r32) * LDQ + hi * 8;
#pragma unroll
  for (int d0 = 0; d0 < 8; ++d0) qr[d0] = SQ::tobf(SQ::ld8(Qw + d0 * 16));
  const int sr = tid >> 4, sc = (tid & 15) * 8, vst0 = v_st(sr, sc), vst1 = v_st(32 + sr, sc);
  const int vb0 = (int)(uintptr_t)V_lds + v_rd_base(lane);
  struct { typename St::T vs0, vs1, ks0, ks1; } sr_[SDEPTH];
#define SLOAD(i, k0) do { sr_[i].vs0 = St::ld8(&Vh[(long)((k0) + sr) * LDK + sc]); sr_[i].vs1 = St::ld8(&Vh[(long)((k0) + 32 + sr) * LDK + sc]); \
    sr_[i].ks0 = St::ld8(&Kh[(long)((k0) + sr) * LDK + sc]); sr_[i].ks1 = St::ld8(&Kh[(long)((k0) + 32 + sr) * LDK + sc]); } while (0)
#define SWRITE(b, i) do { *(bf16x8*)((char*)V_lds + (b) * SHM_V + vst0) = St::tobf(sr_[i].vs0);          \
    *(bf16x8*)((char*)V_lds + (b) * SHM_V + vst1) = St::tobf(sr_[i].vs1); int kc = sc * 2;               \
    *(bf16x8*)((char*)K_lds + (b) * SHM_K + KSWZ(sr, kc)) = St::tobf(sr_[i].ks0);                       \
    *(bf16x8*)((char*)K_lds + (b) * SHM_K + KSWZ(32 + sr, kc)) = St::tobf(sr_[i].ks1); } while (0)
#define SWAIT() do { if constexpr (SDEPTH == 2) asm volatile("s_waitcnt vmcnt(4)" ::: "memory"); else asm volatile("s_waitcnt vmcnt(0)" ::: "memory"); } while (0)
#define RESC(a) do { if (__any((a) < 1.f)) { if (hi == 0) al_l[r32] = (a); asm volatile("s_waitcnt lgkmcnt(0)" ::: "memory"); \
    for (int d = 0; d < 4; ++d) for (int r = 0; r < 16; ++r) o[d][r] *= al_l[crow(r, hi)]; } } while (0)
  f32x16 pA0, pA1, pB0, pB1; float mnA, mnB, alA, alB; bf16x8 pa0, pa1, pa2, pa3; const int NT = seq / KVBLK;
  constexpr int SE = 0, SO = SDEPTH - 1;
  SLOAD(SE, 0); asm volatile("s_waitcnt vmcnt(0)" ::: "memory"); SWRITE(0, SE); __syncthreads();
  qkt(pA0, pA1, K_lds, qr, r32, hi); partialSM(pA0, pA1, m_reg, mnA, alA);
  SLOAD(SO, KVBLK); if constexpr (SDEPTH == 2) { if (2 < NT) SLOAD(SE, 2 * KVBLK); }
  SWAIT(); SWRITE(1, SO); __syncthreads();
  for (int j = 1; j + 1 < NT; j += 2) {
    SBAR(); qkt(pB0, pB1, (bf16*)((char*)K_lds + SHM_K), qr, r32, hi);
    finishSM(pA0, pA1, alA, l_reg, pa0, pa1, pa2, pa3); SBAR();
    SLOAD(SO, (j + SDEPTH) * KVBLK); SBAR();
    pv_d0(o, vb0, pa0, pa1, pa2, pa3); partialSM(pB0, pB1, m_reg, mnB, alB);
    __syncthreads(); SWAIT(); SWRITE(0, SE);
    RESC(alB); __syncthreads();
    SBAR(); qkt(pA0, pA1, K_lds, qr, r32, hi);
    finishSM(pB0, pB1, alB, l_reg, pa0, pa1, pa2, pa3); SBAR();
    if (SDEPTH == 1 || j + 3 < NT) SLOAD(SE, (j + 1 + SDEPTH) * KVBLK); SBAR();
    pv_d0(o, vb0 + (int)SHM_V, pa0, pa1, pa2, pa3); partialSM(pA0, pA1, m_reg, mnA, alA);
    __syncthreads(); SWAIT(); SWRITE(1, SO);
    RESC(alA); __syncthreads();
  }
  SBAR(); qkt(pB0, pB1, (bf16*)((char*)K_lds + SHM_K), qr, r32, hi);
  finishSM(pA0, pA1, alA, l_reg, pa0, pa1, pa2, pa3); SBAR();
  pv_d0(o, vb0, pa0, pa1, pa2, pa3); partialSM(pB0, pB1, m_reg, mnB, alB);
  __syncthreads(); RESC(alB);
  finishSM(pB0, pB1, alB, l_reg, pa0, pa1, pa2, pa3); SBAR();
  pv_d0(o, vb0 + (int)SHM_V, pa0, pa1, pa2, pa3);
  if (hi == 0) li_l[r32] = l_reg; asm volatile("s_waitcnt lgkmcnt(0)" ::: "memory");
  float rli[16];
#pragma unroll
  for (int r = 0; r < 16; ++r) rli[r] = __builtin_amdgcn_rcpf(li_l[crow(r, hi)]);
  if constexpr (!OBF16) { float* Ow = (float*)Obv + (long)(wid * QBLK) * LDO;
#pragma unroll
  for (int r = 0; r < 16; ++r) { int orow = crow(r, hi);
    for (int d0 = 0; d0 < 4; ++d0) Ow[(long)orow * LDO + d0 * 32 + r32] = o[d0][r] * rli[r]; }
  } else { unsigned short* Ow = (unsigned short*)Obv + (long)(wid * QBLK) * LDO;
#pragma unroll
  for (int r = 0; r < 16; ++r) { int orow = crow(r, hi);
    for (int d0 = 0; d0 < 4; ++d0) { const unsigned pk = cvtpk(o[d0][r] * rli[r], 0.f); Ow[(long)orow * LDO + d0 * 32 + r32] = (unsigned short)(pk & 0xffffu); } }
  }
#undef SLOAD
#undef SWRITE
#undef SWAIT
#undef RESC
}
#undef KSWZ
#undef SBAR
}
namespace gla {
typedef float f32x16 __attribute__((ext_vector_type(16)));
typedef float f32x4v __attribute__((ext_vector_type(4)));
constexpr int LD = 65;
constexpr int OX = 0, OY = 2 * 64 * LD * 4, OV = 4 * 64 * LD * 4, OAL = OV + 64 * 128 * 4, OW2 = OAL + 64 * 32 * 4, OBA = OW2 + 2 * 16 * 64 * 4, OTOT = OBA + 2 * 64 * 4, OEND = OTOT + 2 * 64 * 4 * 4;
static_assert(OEND <= 131072, "gla lds");
static_assert(64 * 129 * 4 <= 2 * 64 * LD * 4, "O stage fits in X");

struct In {
  const bf16_t* q; const bf16_t* k; const bf16_t* v; const bf16_t* ga; const bf16_t* og; int ld;
  const float* wa2; const float* ba; const float* gnorm;
  float* cs;
  bf16_t* csb;
  float* dec;
  bf16_t* y; int ldy;
  int S, C;
};
__device__ __forceinline__ long chunk_row(const In& p, int cid) { return cid < p.S / 64 ? (long)cid * 64 : (long)p.S + (long)(cid - p.S / 64) * 64; }
__device__ __forceinline__ float logsig(float x) { return x < 0.f ? x - __logf(1.f + __expf(x)) : -__logf(1.f + __expf(-x)); }

__device__ __forceinline__ void cum_phase(const In& p, LAS unsigned char* lds, int head, long row0, int tid) {
  LAS float* AL = (LAS float*)(lds + OAL); LAS float* W2 = (LAS float*)(lds + OW2); LAS float* BA = (LAS float*)(lds + OBA); LAS float* TOT = (LAS float*)(lds + OTOT);
  { const int t = tid >> 3, r4 = (tid & 7) * 4; const unsigned long long u = *(const unsigned long long*)(p.ga + (row0 + t) * p.ld + r4);
    f32x4v a4; a4[0] = bf2f((bf16_t)u); a4[1] = bf2f((bf16_t)(u >> 16)); a4[2] = bf2f((bf16_t)(u >> 32)); a4[3] = bf2f((bf16_t)(u >> 48)); *(LAS f32x4v*)(AL + t * 32 + r4) = a4; }
  { const int e = tid * 4, dir = e >> 10, r = (e >> 6) & 15, j = e & 63; *(LAS f32x4v*)(W2 + e) = *(const f32x4v*)(p.wa2 + ((long)dir * 16 + r) * 256 + head * 64 + j); }
  if (tid < 128) BA[tid] = p.ba[(tid >> 6) * 256 + head * 64 + (tid & 63)];
  __syncthreads();
  const int dir = tid >> 8, j = tid & 63, seg = (tid >> 6) & 3;
  float w[16];
#pragma unroll
  for (int r = 0; r < 16; ++r) w[r] = W2[(dir * 16 + r) * 64 + j];
  const float bj = BA[dir * 64 + j];
  float c[16];
#pragma unroll
  for (int k = 0; k < 16; ++k) { const int t = seg * 16 + k; float z = bj;
#pragma unroll
    for (int r4 = 0; r4 < 4; ++r4) { const f32x4v a4 = *(const LAS f32x4v*)(AL + t * 32 + dir * 16 + 4 * r4); z += a4[0] * w[4 * r4] + a4[1] * w[4 * r4 + 1] + a4[2] * w[4 * r4 + 2] + a4[3] * w[4 * r4 + 3]; }
    c[k] = logsig(z) * (1.f / 16.f); }
  if (dir == 0) {
#pragma unroll
    for (int k = 1; k < 16; ++k) c[k] += c[k - 1];
    TOT[(dir * 64 + j) * 4 + seg] = c[15];
  } else {
#pragma unroll
    for (int k = 14; k >= 0; --k) c[k] += c[k + 1];
    TOT[(dir * 64 + j) * 4 + seg] = c[0];
  }
  __syncthreads();
  float off = 0.f;
#pragma unroll
  for (int s = 0; s < 4; ++s) { const float tv = TOT[(dir * 64 + j) * 4 + s]; if (dir == 0 ? s < seg : s > seg) off += tv; }
  LAS float* X = (LAS float*)(lds + OX) + dir * 64 * LD;
#pragma unroll
  for (int k = 0; k < 16; ++k) X[(seg * 16 + k) * LD + j] = c[k] + off;
}
struct VRegs { unsigned long long u[4]; };
__device__ __forceinline__ VRegs load_v_regs(const In& p, int head, long row0, int tid) { VRegs r;
#pragma unroll
  for (int m = 0; m < 4; ++m) { const int t = (tid >> 5) + 16 * m, c4 = (tid & 31) * 4; r.u[m] = *(const unsigned long long*)(p.v + (row0 + t) * p.ld + head * 128 + c4); }
  return r; }
__device__ __forceinline__ void store_v(const VRegs& r, LAS unsigned char* lds, int tid) {
  LAS float* V = (LAS float*)(lds + OV);
#pragma unroll
  for (int m = 0; m < 4; ++m) { const int t = (tid >> 5) + 16 * m, c4 = (tid & 31) * 4; const unsigned long long u = r.u[m];
    f32x4v a4; a4[0] = bf2f((bf16_t)u); a4[1] = bf2f((bf16_t)(u >> 16)); a4[2] = bf2f((bf16_t)(u >> 32)); a4[3] = bf2f((bf16_t)(u >> 48)); *(LAS f32x4v*)(V + t * 128 + c4) = a4; }
}

__device__ __forceinline__ void g1_unit(const In& p, LAS unsigned char* lds, int head, int cid, int GH, int NCH) {
  int tid = threadIdx.x; asm volatile("" : "+v"(tid));
  const int lane = tid & 63, w = __builtin_amdgcn_readfirstlane(tid >> 6);
  const long row0 = chunk_row(p, cid);
  const VRegs vr = load_v_regs(p, head, row0, tid);
  bf16_t kreg[8];
#pragma unroll
  for (int m = 0; m < 8; ++m) kreg[m] = p.k[(row0 + (tid >> 6) + 8 * m) * p.ld + head * 64 + (tid & 63)];
  cum_phase(p, lds, head, row0, tid);
  store_v(vr, lds, tid);
  __syncthreads();
  LAS float* TOT = (LAS float*)(lds + OTOT);
  { const int j = tid & 63;
#pragma unroll
    for (int dir = 0; dir < 2; ++dir) { LAS float* X = (LAS float*)(lds + OX) + dir * 64 * LD;
      const float cl = TOT[(dir * 64 + j) * 4 + 0] + TOT[(dir * 64 + j) * 4 + 1] + TOT[(dir * 64 + j) * 4 + 2] + TOT[(dir * 64 + j) * 4 + 3];
#pragma unroll
      for (int m = 0; m < 8; ++m) { const int t = (tid >> 6) + 8 * m; const float kv = bf2f(kreg[m]); X[t * LD + j] = kv * __expf(cl - X[t * LD + j]); }
      if (tid < 64) p.dec[(((long)dir * GH + head) * NCH + cid) * 64 + j] = __expf(cl); }
  }
  __syncthreads();
  { const int dir = w >> 2, di = (w >> 1) & 1, vj0 = (w & 1) * 2; const LAS float* X = (const LAS float*)(lds + OX) + dir * 64 * LD; const LAS float* V = (const LAS float*)(lds + OV);
    f32x16 a0 = {}, a1 = {}; const int li = lane & 31, lk = lane >> 5;
#pragma unroll 4
    for (int s0 = 0; s0 < 64; s0 += 2) { const float av = X[(s0 + lk) * LD + 32 * di + li]; const float b0 = V[(s0 + lk) * 128 + 32 * vj0 + li], b1 = V[(s0 + lk) * 128 + 32 * vj0 + 32 + li];
      a0 = __builtin_amdgcn_mfma_f32_32x32x2f32(av, b0, a0, 0, 0, 0); a1 = __builtin_amdgcn_mfma_f32_32x32x2f32(av, b1, a1, 0, 0, 0); }
    float* dst = p.cs + ((((long)dir * GH + head) * NCH + cid) * 64) * 128;
#pragma unroll
    for (int r = 0; r < 16; ++r) { const int d = 32 * di + (r & 3) + 8 * (r >> 2) + 4 * lk; dst[(long)d * 128 + 32 * vj0 + li] = a0[r]; dst[(long)d * 128 + 32 * vj0 + 32 + li] = a1[r]; }
  }
  __syncthreads();
}
__device__ __forceinline__ void g2_item(const In& p, long idx, int GH, int NCH) {
  const int v = 2 * (int)(idx & 63), d = (int)((idx >> 6) & 63); const int hd = (int)((idx >> 12) % GH), dir = (int)((idx >> 12) / GH);
  const int nl = p.S / 64, nc = p.C / 64; float st0 = 0.f, st1 = 0.f;
  bf16_t* base = p.csb + (((long)dir * GH + hd) * NCH) * 64 * 128 + (long)d * 128 + v; const float* db = p.dec + (((long)dir * GH + hd) * NCH) * 64 + d;
  for (int s0 = 0; s0 < nl + nc; s0 += 4) { unsigned c[4]; float dc[4]; unsigned* pp[4];
#pragma unroll
    for (int k = 0; k < 4; ++k) { const int step = s0 + k; int cid; if (step < nc) cid = nl + (dir ? nc - 1 - step : step); else cid = dir ? nl - 1 - (step - nc) : step - nc;
      pp[k] = (unsigned*)(base + (long)cid * 64 * 128); c[k] = *pp[k]; dc[k] = db[(long)cid * 64]; }
#pragma unroll
    for (int k = 0; k < 4; ++k) { *pp[k] = pk2(st0, st1); st0 = dc[k] * st0 + __uint_as_float(c[k] << 16); st1 = dc[k] * st1 + __uint_as_float(c[k] & 0xffff0000u); } }
}
__device__ __forceinline__ void g3_unit(const In& p, LAS unsigned char* lds, int head, int cid, int GH, int NCH) {
  int tid = threadIdx.x; asm volatile("" : "+v"(tid));
  const int lane = tid & 63, w = __builtin_amdgcn_readfirstlane(tid >> 6), li = lane & 31, lk = lane >> 5;
  const long row0 = chunk_row(p, cid);
  float spf[2][32];
  { const int vj_ = w & 3;
#pragma unroll
    for (int dir = 0; dir < 2; ++dir) { const float* sp = p.cs + ((((long)dir * GH + head) * NCH + cid) * 64) * 128 + 32 * vj_ + li;
#pragma unroll
      for (int i = 0; i < 32; ++i) spf[dir][i] = sp[(long)(2 * i + lk) * 128]; } }
  const VRegs vr = load_v_regs(p, head, row0, tid);
  bf16_t kreg[8], qreg[8];
#pragma unroll
  for (int m = 0; m < 8; ++m) { const long o_ = (row0 + (tid >> 6) + 8 * m) * p.ld + head * 64 + (tid & 63); kreg[m] = p.k[o_]; qreg[m] = p.q[o_]; }
  cum_phase(p, lds, head, row0, tid);
  store_v(vr, lds, tid);
  __syncthreads();
  { const int j = tid & 63;
#pragma unroll
    for (int dir = 0; dir < 2; ++dir) { LAS float* X = (LAS float*)(lds + OX) + dir * 64 * LD; LAS float* Y = (LAS float*)(lds + OY) + dir * 64 * LD;
#pragma unroll
      for (int m = 0; m < 8; ++m) { const int t = (tid >> 6) + 8 * m; const float c = X[t * LD + j];
        const float qv = bf2f(qreg[m]) * 0.125f, kv = bf2f(kreg[m]);
        X[t * LD + j] = qv * __expf(c); Y[t * LD + j] = kv * __expf(-c); } }
  }
  __syncthreads();
  {
    const int dir = w >> 2, qi = (w >> 1) & 1, si = w & 1; const bool zero = dir == 0 ? si > qi : si < qi;
    const LAS float* X = (const LAS float*)(lds + OX) + dir * 64 * LD; LAS float* Y = (LAS float*)(lds + OY) + dir * 64 * LD;
    f32x16 pa = {};
    if (!zero) {
#pragma unroll 4
      for (int d0 = 0; d0 < 64; d0 += 2) pa = __builtin_amdgcn_mfma_f32_32x32x2f32(X[(32 * qi + li) * LD + d0 + lk], Y[(32 * si + li) * LD + d0 + lk], pa, 0, 0, 0);
    }
    __syncthreads();
#pragma unroll
    for (int r = 0; r < 16; ++r) { const int q = 32 * qi + (r & 3) + 8 * (r >> 2) + 4 * lk, s = 32 * si + li; const bool keep = dir == 0 ? s <= q : s >= q;
      Y[q * LD + s] = keep ? pa[r] : 0.f; }
  }
  __syncthreads();
  f32x16 acc = {};
  { const int qi = w >> 2, vj = w & 3; const LAS float* V = (const LAS float*)(lds + OV);
#pragma unroll
    for (int dir = 0; dir < 2; ++dir) { const LAS float* X = (const LAS float*)(lds + OX) + dir * 64 * LD; const LAS float* Y = (const LAS float*)(lds + OY) + dir * 64 * LD;
#pragma unroll 4
      for (int s0 = 0; s0 < 64; s0 += 2) acc = __builtin_amdgcn_mfma_f32_32x32x2f32(Y[(32 * qi + li) * LD + s0 + lk], V[(s0 + lk) * 128 + 32 * vj + li], acc, 0, 0, 0);
#pragma unroll
      for (int i = 0; i < 32; ++i) acc = __builtin_amdgcn_mfma_f32_32x32x2f32(X[(32 * qi + li) * LD + 2 * i + lk], spf[dir][i], acc, 0, 0, 0);
    }
    __syncthreads();
    LAS float* O = (LAS float*)(lds + OX);
#pragma unroll
    for (int r = 0; r < 16; ++r) { const int q = 32 * qi + (r & 3) + 8 * (r >> 2) + 4 * lk; O[q * 129 + 32 * vj + li] = acc[r]; }
  }
  __syncthreads();
  { const int row = tid >> 3, part = tid & 7; const LAS float* O = (const LAS float*)(lds + OX) + row * 129 + part * 16;
    float o[16]; float ss = 0.f;
#pragma unroll
    for (int k = 0; k < 16; ++k) { o[k] = O[k]; ss += o[k] * o[k]; }
    ss += __shfl_xor(ss, 1); ss += __shfl_xor(ss, 2); ss += __shfl_xor(ss, 4);
    const float rs = __builtin_amdgcn_rsqf(ss * (1.f / 128.f) + 1e-6f);
    const bf16_t* ogp = p.og + (row0 + row) * p.ld + head * 128 + part * 16; const v4u og0 = *(const v4u*)ogp, og1 = *(const v4u*)(ogp + 8);
    const unsigned ogw[8] = {og0.x, og0.y, og0.z, og0.w, og1.x, og1.y, og1.z, og1.w}; bf16_t* yp = p.y + (row0 + row) * p.ldy + head * 128 + part * 16; float yy[16];
#pragma unroll
    for (int k4 = 0; k4 < 4; ++k4) { f32x4v g4; g4[0] = bf2f((bf16_t)(ogw[2 * k4] & 0xffff)); g4[1] = bf2f((bf16_t)(ogw[2 * k4] >> 16)); g4[2] = bf2f((bf16_t)(ogw[2 * k4 + 1] & 0xffff)); g4[3] = bf2f((bf16_t)(ogw[2 * k4 + 1] >> 16)); const f32x4v n4 = *(const f32x4v*)(p.gnorm + part * 16 + 4 * k4); f32x4v y4;
#pragma unroll
      for (int e = 0; e < 4; ++e) { const float gg = g4[e]; y4[e] = o[4 * k4 + e] * rs * n4[e] * (gg / (1.f + __expf(-gg))); yy[4 * k4 + e] = y4[e]; } }
    { v4u o0, o1; o0.x = pk2(yy[0], yy[1]); o0.y = pk2(yy[2], yy[3]); o0.z = pk2(yy[4], yy[5]); o0.w = pk2(yy[6], yy[7]);
      o1.x = pk2(yy[8], yy[9]); o1.y = pk2(yy[10], yy[11]); o1.z = pk2(yy[12], yy[13]); o1.w = pk2(yy[14], yy[15]); *(v4u*)yp = o0; *(v4u*)(yp + 8) = o1; }
  }
  __syncthreads();
}

typedef short bf16x8g __attribute__((ext_vector_type(8)));
constexpr int LB = 72;
constexpr int OQB = 2 * 64 * LD * 4, OKB = OQB + 2 * 64 * LB * 2, OVT = OKB + 2 * 64 * LB * 2, OBEND = OVT + 128 * LB * 2;
static_assert(OBEND <= OAL, "gla bf16 lds");
#define GMM(A, B, C) C = __builtin_amdgcn_mfma_f32_32x32x16_bf16(__builtin_bit_cast(bf16x8g, A), __builtin_bit_cast(bf16x8g, B), C, 0, 0, 0)
__device__ __forceinline__ void store_vt(const VRegs& r, LAS unsigned char* lds, int tid) {
  LAS bf16_t* Vt = (LAS bf16_t*)(lds + OVT);
#pragma unroll
  for (int m = 0; m < 4; ++m) { const int t = (tid >> 5) + 16 * m, c4 = (tid & 31) * 4; const unsigned long long u = r.u[m];
    Vt[(c4 + 0) * LB + t] = (bf16_t)u; Vt[(c4 + 1) * LB + t] = (bf16_t)(u >> 16); Vt[(c4 + 2) * LB + t] = (bf16_t)(u >> 32); Vt[(c4 + 3) * LB + t] = (bf16_t)(u >> 48); }
}
__device__ __forceinline__ void g1b_unit(const In& p, LAS unsigned char* lds, int head, int cid, int GH, int NCH) {
  int tid = threadIdx.x; asm volatile("" : "+v"(tid));
  const int lane = tid & 63, w = __builtin_amdgcn_readfirstlane(tid >> 6), li = lane & 31, lk = lane >> 5;
  const long row0 = chunk_row(p, cid);
  const VRegs vr = load_v_regs(p, head, row0, tid);
  bf16_t kreg[8];
#pragma unroll
  for (int m = 0; m < 8; ++m) kreg[m] = p.k[(row0 + (tid >> 6) + 8 * m) * p.ld + head * 64 + (tid & 63)];
  cum_phase(p, lds, head, row0, tid);
  store_vt(vr, lds, tid);
  __syncthreads();
  LAS float* TOT = (LAS float*)(lds + OTOT);
  { const int j = tid & 63;
#pragma unroll
    for (int dir = 0; dir < 2; ++dir) { const LAS float* X = (const LAS float*)(lds + OX) + dir * 64 * LD; LAS bf16_t* KeT = (LAS bf16_t*)(lds + OQB) + dir * 64 * LB;
      const float cl = TOT[(dir * 64 + j) * 4 + 0] + TOT[(dir * 64 + j) * 4 + 1] + TOT[(dir * 64 + j) * 4 + 2] + TOT[(dir * 64 + j) * 4 + 3];
#pragma unroll
      for (int m = 0; m < 8; ++m) { const int t = (tid >> 6) + 8 * m; KeT[j * LB + t] = (bf16_t)f2bf(bf2f(kreg[m]) * __expf(cl - X[t * LD + j])); }
      if (tid < 64) p.dec[(((long)dir * GH + head) * NCH + cid) * 64 + j] = __expf(cl); }
  }
  __syncthreads();
  { const int dir = w >> 2, di = (w >> 1) & 1, vj0 = (w & 1) * 2; const LAS bf16_t* KeT = (const LAS bf16_t*)(lds + OQB) + dir * 64 * LB; const LAS bf16_t* Vt = (const LAS bf16_t*)(lds + OVT);
    f32x16 a0 = {}, a1 = {};
#pragma unroll
    for (int kk = 0; kk < 4; ++kk) { const v4u av = *(const LAS v4u*)(KeT + (32 * di + li) * LB + 16 * kk + 8 * lk);
      const v4u b0 = *(const LAS v4u*)(Vt + (32 * vj0 + li) * LB + 16 * kk + 8 * lk), b1 = *(const LAS v4u*)(Vt + (32 * vj0 + 32 + li) * LB + 16 * kk + 8 * lk);
      GMM(av, b0, a0); GMM(av, b1, a1); }
    bf16_t* dst = p.csb + ((((long)dir * GH + head) * NCH + cid) * 64) * 128;
#pragma unroll
    for (int r = 0; r < 16; ++r) { const int d = 32 * di + (r & 3) + 8 * (r >> 2) + 4 * lk; dst[(long)d * 128 + 32 * vj0 + li] = (bf16_t)f2bf(a0[r]); dst[(long)d * 128 + 32 * vj0 + 32 + li] = (bf16_t)f2bf(a1[r]); }
  }
  __syncthreads();
}
__device__ __forceinline__ void g3b_unit(const In& p, LAS unsigned char* lds, int head, int cid, int GH, int NCH) {
  int tid = threadIdx.x; asm volatile("" : "+v"(tid));
  const int lane = tid & 63, w = __builtin_amdgcn_readfirstlane(tid >> 6), li = lane & 31, lk = lane >> 5;
  const long row0 = chunk_row(p, cid);
  unsigned spf[2][32];
  { const int vj_ = w & 3;
#pragma unroll
    for (int dir = 0; dir < 2; ++dir) { const bf16_t* sp = p.csb + ((((long)dir * GH + head) * NCH + cid) * 64) * 128 + 32 * vj_ + li;
#pragma unroll
      for (int i = 0; i < 32; ++i) spf[dir][i] = sp[(long)(16 * (i >> 3) + 8 * lk + (i & 7)) * 128]; } }
  const VRegs vr = load_v_regs(p, head, row0, tid);
  bf16_t kreg[8], qreg[8];
#pragma unroll
  for (int m = 0; m < 8; ++m) { const long o_ = (row0 + (tid >> 6) + 8 * m) * p.ld + head * 64 + (tid & 63); kreg[m] = p.k[o_]; qreg[m] = p.q[o_]; }
  cum_phase(p, lds, head, row0, tid);
  store_vt(vr, lds, tid);
  __syncthreads();
  { const int j = tid & 63;
#pragma unroll
    for (int dir = 0; dir < 2; ++dir) { const LAS float* X = (const LAS float*)(lds + OX) + dir * 64 * LD; LAS bf16_t* Qb = (LAS bf16_t*)(lds + OQB) + dir * 64 * LB; LAS bf16_t* Kb = (LAS bf16_t*)(lds + OKB) + dir * 64 * LB;
#pragma unroll
      for (int m = 0; m < 8; ++m) { const int t = (tid >> 6) + 8 * m; const float c = X[t * LD + j];
        Qb[t * LB + j] = (bf16_t)f2bf(bf2f(qreg[m]) * 0.125f * __expf(c)); Kb[t * LB + j] = (bf16_t)f2bf(bf2f(kreg[m]) * __expf(-c)); } }
  }
  __syncthreads();
  {
    const int dir = w >> 2, qi = (w >> 1) & 1, si = w & 1; const bool zero = dir == 0 ? si > qi : si < qi;
    const LAS bf16_t* Qb = (const LAS bf16_t*)(lds + OQB) + dir * 64 * LB; LAS bf16_t* Kb = (LAS bf16_t*)(lds + OKB) + dir * 64 * LB;
    f32x16 pa = {};
    if (!zero) {
#pragma unroll
      for (int kk = 0; kk < 4; ++kk) { const v4u av = *(const LAS v4u*)(Qb + (32 * qi + li) * LB + 16 * kk + 8 * lk), bv = *(const LAS v4u*)(Kb + (32 * si + li) * LB + 16 * kk + 8 * lk); GMM(av, bv, pa); }
    }
    __syncthreads();
#pragma unroll
    for (int r = 0; r < 16; ++r) { const int q = 32 * qi + (r & 3) + 8 * (r >> 2) + 4 * lk, s = 32 * si + li; const bool keep = dir == 0 ? s <= q : s >= q;
      Kb[q * LB + s] = (bf16_t)f2bf(keep ? pa[r] : 0.f); }
  }
  __syncthreads();
  f32x16 acc = {};
  { const int qi = w >> 2, vj = w & 3; const LAS bf16_t* Vt = (const LAS bf16_t*)(lds + OVT);
#pragma unroll
    for (int dir = 0; dir < 2; ++dir) { const LAS bf16_t* Qb = (const LAS bf16_t*)(lds + OQB) + dir * 64 * LB; const LAS bf16_t* Pb = (const LAS bf16_t*)(lds + OKB) + dir * 64 * LB;
#pragma unroll
      for (int kk = 0; kk < 4; ++kk) { const v4u av = *(const LAS v4u*)(Pb + (32 * qi + li) * LB + 16 * kk + 8 * lk), bv = *(const LAS v4u*)(Vt + (32 * vj + li) * LB + 16 * kk + 8 * lk); GMM(av, bv, acc); }
#pragma unroll
      for (int kk = 0; kk < 4; ++kk) { const v4u av = *(const LAS v4u*)(Qb + (32 * qi + li) * LB + 16 * kk + 8 * lk);
        v4u bv; bv.x = spf[dir][8 * kk + 0] | (spf[dir][8 * kk + 1] << 16); bv.y = spf[dir][8 * kk + 2] | (spf[dir][8 * kk + 3] << 16); bv.z = spf[dir][8 * kk + 4] | (spf[dir][8 * kk + 5] << 16); bv.w = spf[dir][8 * kk + 6] | (spf[dir][8 * kk + 7] << 16);
        GMM(av, bv, acc); }
    }
    LAS float* O = (LAS float*)(lds + OX);
#pragma unroll
    for (int r = 0; r < 16; ++r) { const int q = 32 * qi + (r & 3) + 8 * (r >> 2) + 4 * lk; O[q * 129 + 32 * vj + li] = acc[r]; }
  }
  __syncthreads();
  { const int row = tid >> 3, part = tid & 7; const LAS float* O = (const LAS float*)(lds + OX) + row * 129 + part * 16;
    float o[16]; float ss = 0.f;
#pragma unroll
    for (int k = 0; k < 16; ++k) { o[k] = O[k]; ss += o[k] * o[k]; }
    ss += __shfl_xor(ss, 1); ss += __shfl_xor(ss, 2); ss += __shfl_xor(ss, 4);
    const float rs = __builtin_amdgcn_rsqf(ss * (1.f / 128.f) + 1e-6f);
    const bf16_t* ogp = p.og + (row0 + row) * p.ld + head * 128 + part * 16; const v4u og0 = *(const v4u*)ogp, og1 = *(const v4u*)(ogp + 8);
    const unsigned ogw[8] = {og0.x, og0.y, og0.z, og0.w, og1.x, og1.y, og1.z, og1.w}; bf16_t* yp = p.y + (row0 + row) * p.ldy + head * 128 + part * 16; float yy[16];
#pragma unroll
    for (int k4 = 0; k4 < 4; ++k4) { f32x4v g4; g4[0] = bf2f((bf16_t)(ogw[2 * k4] & 0xffff)); g4[1] = bf2f((bf16_t)(ogw[2 * k4] >> 16)); g4[2] = bf2f((bf16_t)(ogw[2 * k4 + 1] & 0xffff)); g4[3] = bf2f((bf16_t)(ogw[2 * k4 + 1] >> 16)); const f32x4v n4 = *(const f32x4v*)(p.gnorm + part * 16 + 4 * k4);
#pragma unroll
      for (int e = 0; e < 4; ++e) { const float gg = g4[e]; yy[4 * k4 + e] = o[4 * k4 + e] * rs * n4[e] * (gg / (1.f + __expf(-gg))); } }
    { v4u o0, o1; o0.x = pk2(yy[0], yy[1]); o0.y = pk2(yy[2], yy[3]); o0.z = pk2(yy[4], yy[5]); o0.w = pk2(yy[6], yy[7]);
      o1.x = pk2(yy[8], yy[9]); o1.y = pk2(yy[10], yy[11]); o1.z = pk2(yy[12], yy[13]); o1.w = pk2(yy[14], yy[15]); *(v4u*)yp = o0; *(v4u*)(yp + 8) = o1; }
  }
  __syncthreads();
}
#undef GMM
}
namespace moe {
constexpr int NE = 16, NG = 4, EPG = 4, DE = 512, D = 1024;
__device__ __forceinline__ float wave_sum(float v) {
#pragma unroll
  for (int o = 1; o < 64; o <<= 1) v += __shfl_xor(v, o);
  return v;
}
struct Route { int e0, r0, e1, r1; };
struct MoeOrder {
  int G, c, NT; const LAS int* poff;
  __device__ __forceinline__ bool next(int i, pg8::Unit& u) const {
    const long L = (long)i * G + c; const int total = poff[NE] * NT; if (L >= total) return false;
    const int panel = (int)L / NT, j = (int)L % NT; int e = 0;
#pragma unroll
    for (int k = 1; k < NE; ++k) e += (panel >= poff[k]) ? 1 : 0;
    u.pm = panel; u.pn = e * NT + j; u.acol = 0; u.nt = 0; return true;
  }
  __device__ __forceinline__ void a_ready(const pg8::Unit&) const {}
  __device__ __forceinline__ void done(const pg8::Unit&) const {}
};
struct EpiGU {
  static constexpr bool PERM = true, AFTER_DRAIN = false;
  bf16_t* hid;
  __device__ __forceinline__ void operator()(const pg8::f32x4 (&acc)[2][2][4][2], const pg8::Unit& u, int wr, int wc, int fr, int fq) const {
    const int j = u.pn & 3; const int row0 = u.pm * 256 + wr * 64 + fr, col0 = j * 128 + wc * 32 + 8 * fq;
#pragma unroll
    for (int ai = 0; ai < 2; ++ai)
#pragma unroll
      for (int m = 0; m < 4; ++m) { const size_t r = (size_t)(row0 + ai * 128 + m * 16); float hv[8];
#pragma unroll
        for (int n = 0; n < 2; ++n)
#pragma unroll
          for (int e = 0; e < 4; ++e) { const float g = acc[ai][0][m][n][e], up = acc[ai][1][m][n][e]; hv[4 * n + e] = g / (1.f + __expf(-g)) * up; }
        v4u o; o.x = pk2(hv[0], hv[1]); o.y = pk2(hv[2], hv[3]); o.z = pk2(hv[4], hv[5]); o.w = pk2(hv[6], hv[7]);
        *(v4u*)(hid + r * DE + col0) = o; }
  }
};
struct EpiDown {
  static constexpr bool PERM = true, AFTER_DRAIN = false;
  const int* srcrow; const float* wgt; bf16_t* contrib; size_t slot_stride;
  __device__ __forceinline__ void operator()(const pg8::f32x4 (&acc)[2][2][4][2], const pg8::Unit& u, int wr, int wc, int fr, int fq) const {
    const int pn = u.pn & 3; const int row0 = u.pm * 256 + wr * 64 + fr, col0 = pn * 256 + wc * 32 + 8 * fq;
    int srcs[2][4]; float ws_[2][4];
#pragma unroll
    for (int ai = 0; ai < 2; ++ai)
#pragma unroll
      for (int m = 0; m < 4; ++m) { const int r = row0 + ai * 128 + m * 16; srcs[ai][m] = srcrow[r]; ws_[ai][m] = wgt[r]; }
#pragma unroll
    for (int ai = 0; ai < 2; ++ai)
#pragma unroll
      for (int m = 0; m < 4; ++m) { const int src = srcs[ai][m]; if (src < 0) continue; const float w = ws_[ai][m];
        bf16_t* dst = contrib + (size_t)(src & 1) * slot_stride + (size_t)(src >> 1) * D + col0;
#pragma unroll
        for (int bj = 0; bj < 2; ++bj) { const pg8::f32x4 v0 = acc[ai][bj][m][0] * w, v1 = acc[ai][bj][m][1] * w;
          v4u o; o.x = pk2(v0[0], v0[1]); o.y = pk2(v0[2], v0[3]); o.z = pk2(v1[0], v1[1]); o.w = pk2(v1[2], v1[3]); *(v4u*)(dst + bj * 128) = o; } }
  }
};
__device__ __forceinline__ void route_row(const bf16_t* xr, const float* gnorm, const float* shift, const float* scale, bf16_t* hrow, const LAS float* rwT, const float* rbias,
                                          LAS int* cnt, Route* rt, float* wts, int lane) {
  typedef float f4 __attribute__((ext_vector_type(4)));
  f4 xv[4]; float ss = 0.f;
#pragma unroll
  for (int j = 0; j < 4; ++j) { const uint2 rw = *(const uint2*)(xr + 4 * lane + 256 * j); xv[j][0] = __uint_as_float(rw.x << 16); xv[j][1] = __uint_as_float(rw.x & 0xffff0000u); xv[j][2] = __uint_as_float(rw.y << 16); xv[j][3] = __uint_as_float(rw.y & 0xffff0000u); ss += xv[j][0] * xv[j][0] + xv[j][1] * xv[j][1] + xv[j][2] * xv[j][2] + xv[j][3] * xv[j][3]; }
  const float rs = __builtin_amdgcn_rsqf(wave_sum(ss) * (1.f / 1024.f) + 1e-6f);
  float lg[NE];
#pragma unroll
  for (int e = 0; e < NE; ++e) lg[e] = 0.f;
#pragma unroll
  for (int j = 0; j < 4; ++j) { const int c = 4 * lane + 256 * j; const f4 g4 = *(const f4*)(gnorm + c), sh = *(const f4*)(shift + c), sc = *(const f4*)(scale + c);
    f4 h;
#pragma unroll
    for (int i = 0; i < 4; ++i) h[i] = xv[j][i] * rs * g4[i] * (1.f + sc[i]) + sh[i];
    *(unsigned long long*)(hrow + c) = (unsigned long long)pk2(h[0], h[1]) | ((unsigned long long)pk2(h[2], h[3]) << 32);
#pragma unroll
    for (int e = 0; e < NE; ++e) { const f4 w4 = *(const LAS f4*)(rwT + e * 1024 + c); lg[e] += h[0] * w4[0] + h[1] * w4[1] + h[2] * w4[2] + h[3] * w4[3]; } }
  { float v8[8], v4[4], v2[2], v1;
#pragma unroll
    for (int i = 0; i < 8; ++i) { const bool up = lane & 1; const float keep = up ? lg[2 * i + 1] : lg[2 * i], send = up ? lg[2 * i] : lg[2 * i + 1]; v8[i] = keep + __shfl_xor(send, 1); }
#pragma unroll
    for (int i = 0; i < 4; ++i) { const bool up = lane & 2; const float keep = up ? v8[2 * i + 1] : v8[2 * i], send = up ? v8[2 * i] : v8[2 * i + 1]; v4[i] = keep + __shfl_xor(send, 2); }
#pragma unroll
    for (int i = 0; i < 2; ++i) { const bool up = lane & 4; const float keep = up ? v4[2 * i + 1] : v4[2 * i], send = up ? v4[2 * i] : v4[2 * i + 1]; v2[i] = keep + __shfl_xor(send, 4); }
    { const bool up = lane & 8; const float keep = up ? v2[1] : v2[0], send = up ? v2[0] : v2[1]; v1 = keep + __shfl_xor(send, 8); }
    v1 += __shfl_xor(v1, 16); v1 += __shfl_xor(v1, 32);
#pragma unroll
    for (int e = 0; e < NE; ++e) lg[e] = __shfl(v1, e); }
  float sc[NE], sel[NE];
#pragma unroll
  for (int e = 0; e < NE; ++e) { sc[e] = 1.f / (1.f + __expf(-lg[e])); sel[e] = sc[e] + rbias[e]; }
  int bestg = 0; float bestgs = -1e30f;
#pragma unroll
  for (int g = 0; g < NG; ++g) { float m1 = -1e30f, m2 = -1e30f;
#pragma unroll
    for (int i = 0; i < EPG; ++i) { const float v = sel[g * EPG + i]; if (v > m1) { m2 = m1; m1 = v; } else if (v > m2) m2 = v; }
    const float gsum = m1 + m2; if (gsum > bestgs) { bestgs = gsum; bestg = g; } }
  int i1 = -1, i2 = -1; float v1 = -1e30f, v2 = -1e30f, s1 = 0.f, s2 = 0.f;
#pragma unroll
  for (int e = 0; e < NE; ++e) { if (e / EPG == bestg) { const float v = sel[e];
      if (v > v1) { v2 = v1; i2 = i1; s2 = s1; v1 = v; i1 = e; s1 = sc[e]; } else if (v > v2) { v2 = v; i2 = e; s2 = sc[e]; } } }
  if (lane == 0) { const float inv = 1.f / (s1 + s2); Route r; r.e0 = i1; r.e1 = i2; r.r0 = __hip_atomic_fetch_add(cnt + i1, 1, __ATOMIC_RELAXED, __HIP_MEMORY_SCOPE_WORKGROUP); r.r1 = __hip_atomic_fetch_add(cnt + i2, 1, __ATOMIC_RELAXED, __HIP_MEMORY_SCOPE_WORKGROUP); *rt = r; wts[0] = s1 * inv; wts[1] = s2 * inv; }
}
__device__ __forceinline__ void route16(const bf16_t* x0, const LAS float* gp, const LAS float* sp, bf16_t* h0, const LAS v4u* wfrag, const float* rbias,
                                        LAS int* cnt, Route* rt0, float* wts0, int lane) {
  typedef float f4 __attribute__((ext_vector_type(4))); typedef short b8 __attribute__((ext_vector_type(8)));
  const int fr = lane & 15, fq = lane >> 4;
  const bf16_t* xr = x0 + (size_t)fr * 1024 + 8 * fq; bf16_t* hr = h0 + (size_t)fr * 1024 + 8 * fq;
  v4u xq[32];
#pragma unroll
  for (int kk = 0; kk < 32; ++kk) xq[kk] = *(const v4u*)(xr + 32 * kk);
  float ss = 0.f;
#pragma unroll
  for (int kk = 0; kk < 32; ++kk) { const v4u q = xq[kk]; float t;
    t = __uint_as_float(q.x << 16); ss += t * t; t = __uint_as_float(q.x & 0xffff0000u); ss += t * t; t = __uint_as_float(q.y << 16); ss += t * t; t = __uint_as_float(q.y & 0xffff0000u); ss += t * t;
    t = __uint_as_float(q.z << 16); ss += t * t; t = __uint_as_float(q.z & 0xffff0000u); ss += t * t; t = __uint_as_float(q.w << 16); ss += t * t; t = __uint_as_float(q.w & 0xffff0000u); ss += t * t; }
  ss += __shfl_xor(ss, 16); ss += __shfl_xor(ss, 32);
  const float rs = __builtin_amdgcn_rsqf(ss * (1.f / 1024.f) + 1e-6f);
#pragma unroll
  for (int kk = 0; kk < 32; ++kk) asm volatile("" : "+v"(xq[kk].x), "+v"(xq[kk].y), "+v"(xq[kk].z), "+v"(xq[kk].w));
  f4 acc = {0.f, 0.f, 0.f, 0.f};
#pragma unroll
  for (int kk = 0; kk < 32; ++kk) { const int c = 32 * kk + 8 * fq; const v4u q = xq[kk];
    const f4 ga = *(const LAS f4*)(gp + c), gb = *(const LAS f4*)(gp + c + 4), ha = *(const LAS f4*)(sp + c), hb = *(const LAS f4*)(sp + c + 4);
    const v4u wh = wfrag[kk * 64 + lane], wl = wfrag[2048 + kk * 64 + lane];
    float h[8];
    h[0] = __uint_as_float(q.x << 16) * (rs * ga[0]) + ha[0]; h[1] = __uint_as_float(q.x & 0xffff0000u) * (rs * ga[1]) + ha[1];
    h[2] = __uint_as_float(q.y << 16) * (rs * ga[2]) + ha[2]; h[3] = __uint_as_float(q.y & 0xffff0000u) * (rs * ga[3]) + ha[3];
    h[4] = __uint_as_float(q.z << 16) * (rs * gb[0]) + hb[0]; h[5] = __uint_as_float(q.z & 0xffff0000u) * (rs * gb[1]) + hb[1];
    h[6] = __uint_as_float(q.w << 16) * (rs * gb[2]) + hb[2]; h[7] = __uint_as_float(q.w & 0xffff0000u) * (rs * gb[3]) + hb[3];
    v4u hq; hq.x = pk2h(h[0], h[1]); hq.y = pk2h(h[2], h[3]); hq.z = pk2h(h[4], h[5]); hq.w = pk2h(h[6], h[7]);
    *(v4u*)(hr + 32 * kk) = hq;
    v4u lq; lq.x = pk2h(h[0] - __uint_as_float(hq.x << 16), h[1] - __uint_as_float(hq.x & 0xffff0000u)); lq.y = pk2h(h[2] - __uint_as_float(hq.y << 16), h[3] - __uint_as_float(hq.y & 0xffff0000u));
    lq.z = pk2h(h[4] - __uint_as_float(hq.z << 16), h[5] - __uint_as_float(hq.z & 0xffff0000u)); lq.w = pk2h(h[6] - __uint_as_float(hq.w << 16), h[7] - __uint_as_float(hq.w & 0xffff0000u));
    acc = __builtin_amdgcn_mfma_f32_16x16x32_bf16(__builtin_bit_cast(b8, wh), __builtin_bit_cast(b8, hq), acc, 0, 0, 0);
    acc = __builtin_amdgcn_mfma_f32_16x16x32_bf16(__builtin_bit_cast(b8, wl), __builtin_bit_cast(b8, hq), acc, 0, 0, 0);
    acc = __builtin_amdgcn_mfma_f32_16x16x32_bf16(__builtin_bit_cast(b8, wh), __builtin_bit_cast(b8, lq), acc, 0, 0, 0);
    if (kk & 1) asm volatile("" ::: "memory"); }
  float sc[4], sel[4]; const f4 rb4 = *(const f4*)(rbias + 4 * fq);
#pragma unroll
  for (int i = 0; i < 4; ++i) { sc[i] = 1.f / (1.f + __expf(-acc[i])); sel[i] = sc[i] + rb4[i]; }
  int i1 = -1, i2 = -1; float v1 = -1e30f, v2 = -1e30f, s1 = 0.f, s2 = 0.f;
#pragma unroll
  for (int i = 0; i < 4; ++i) { const float v = sel[i]; if (v > v1) { v2 = v1; i2 = i1; s2 = s1; v1 = v; i1 = i; s1 = sc[i]; } else if (v > v2) { v2 = v; i2 = i; s2 = sc[i]; } }
  float bgs = v1 + v2; int bg = fq;
  { float og = __shfl_xor(bgs, 16); int oi = __shfl_xor(bg, 16); if (og > bgs || (og == bgs && oi < bg)) { bgs = og; bg = oi; }
    og = __shfl_xor(bgs, 32); oi = __shfl_xor(bg, 32); if (og > bgs || (og == bgs && oi < bg)) { bgs = og; bg = oi; } }
  if (fq == bg) { const float inv = 1.f / (s1 + s2); Route r; r.e0 = 4 * fq + i1; r.e1 = 4 * fq + i2;
    r.r0 = __hip_atomic_fetch_add(cnt + r.e0, 1, __ATOMIC_RELAXED, __HIP_MEMORY_SCOPE_WORKGROUP); r.r1 = __hip_atomic_fetch_add(cnt + r.e1, 1, __ATOMIC_RELAXED, __HIP_MEMORY_SCOPE_WORKGROUP);
    rt0[fr] = r; wts0[2 * fr] = s1 * inv; wts0[2 * fr + 1] = s2 * inv; }
}
}
namespace hy {
typedef float f32x16 __attribute__((ext_vector_type(16)));
constexpr int S = 4096, NT1 = 128, LDZ = 191, ZPAD = 31, LDX = 129;
constexpr int O_TAPS = 0, O_ZA = 32768, O_ZB = O_ZA + 32 * LDZ * 4, O_X1 = O_ZB + 32 * LDZ * 4, O_X2 = O_X1 + 32 * LDX * 4, O_RED = O_X2 + 32 * LDX * 4, O_END = O_RED + 4 * 64 * 16 * 4;
static_assert(O_END <= 131072, "hyena lds");

struct H0Regs { v4u w0, w1; };
__device__ __forceinline__ H0Regs h0_load(const bf16_t* u, int ld, int tile, int tid) {
  const int tt = tile / 24, jt = tile % 24, t0 = tt * 64, j0 = jt * 64; H0Regs r; r.w0 = (v4u){0u, 0u, 0u, 0u}; r.w1 = r.w0;
  { const int rr = tid >> 3, c8 = (tid & 7) * 8, t = t0 - 1 + rr; if (t >= 0 && t < S) r.w0 = *(const v4u*)(u + (size_t)t * ld + j0 + c8); }
  if (tid < 16) { const int rr = 64 + (tid >> 3), c8 = (tid & 7) * 8, t = t0 - 1 + rr; if (t < S) r.w1 = *(const v4u*)(u + (size_t)t * ld + j0 + c8); }
  return r;
}
__device__ __forceinline__ void h0_compute(const H0Regs& rg, const float* cw, const float* cb, bf16_t* ucT, int tile, LAS unsigned char* lds, int tid) {
  const int tt = tile / 24, jt = tile % 24, t0 = tt * 64, j0 = jt * 64;
  LAS float* U = (LAS float*)lds;
  { const int rr = tid >> 3, c8 = (tid & 7) * 8; const v4u w = rg.w0; LAS float* d = U + rr * 65 + c8;
    d[0] = bf2f(w.x & 0xffff); d[1] = bf2f(w.x >> 16); d[2] = bf2f(w.y & 0xffff); d[3] = bf2f(w.y >> 16); d[4] = bf2f(w.z & 0xffff); d[5] = bf2f(w.z >> 16); d[6] = bf2f(w.w & 0xffff); d[7] = bf2f(w.w >> 16); }
  if (tid < 16) { const int rr = 64 + (tid >> 3), c8 = (tid & 7) * 8; const v4u w = rg.w1; LAS float* d = U + rr * 65 + c8;
    d[0] = bf2f(w.x & 0xffff); d[1] = bf2f(w.x >> 16); d[2] = bf2f(w.y & 0xffff); d[3] = bf2f(w.y >> 16); d[4] = bf2f(w.z & 0xffff); d[5] = bf2f(w.z >> 16); d[6] = bf2f(w.w & 0xffff); d[7] = bf2f(w.w >> 16); }
  __syncthreads();
  { const int jj = tid >> 3, tq = (tid & 7) * 8, j = j0 + jj; const float w0 = cw[j], w1 = cw[1536 + j], w2 = cw[2 * 1536 + j], bb = cb[j]; float v[8];
#pragma unroll
    for (int k = 0; k < 8; ++k) v[k] = bb + w0 * U[(tq + k) * 65 + jj] + w1 * U[(tq + k + 1) * 65 + jj] + w2 * U[(tq + k + 2) * 65 + jj];
    v4u o; o.x = pk2(v[0], v[1]); o.y = pk2(v[2], v[3]); o.z = pk2(v[4], v[5]); o.w = pk2(v[6], v[7]); *(v4u*)(ucT + (size_t)j * S + t0 + tq) = o; }
  __syncthreads();
}
__device__ __forceinline__ void h2_tile(const bf16_t* yT, bf16_t* ybf, int ldy, int tile, LAS unsigned char* lds) {
  int tid = threadIdx.x; asm volatile("" : "+v"(tid));
  const int tt = tile / 8, ct = tile % 8, t0 = tt * 64, c0 = ct * 64;
  LAS bf16_t* T = (LAS bf16_t*)lds;
  { const int cc = tid >> 3, t8 = (tid & 7) * 8; const v4u w = *(const v4u*)(yT + (size_t)(c0 + cc) * S + t0 + t8); LAS unsigned* d = (LAS unsigned*)(T + cc * 66 + t8); d[0] = w.x; d[1] = w.y; d[2] = w.z; d[3] = w.w; }
  __syncthreads();
  { const int t = tid >> 3, c8 = (tid & 7) * 8; unsigned short e[8];
#pragma unroll
    for (int k = 0; k < 8; ++k) e[k] = T[(c8 + k) * 66 + t];
    v4u o; o.x = e[0] | ((unsigned)e[1] << 16); o.y = e[2] | ((unsigned)e[3] << 16); o.z = e[4] | ((unsigned)e[5] << 16); o.w = e[6] | ((unsigned)e[7] << 16);
    *(v4u*)(ybf + (size_t)(t0 + t) * ldy + c0 + c8) = o; }
  __syncthreads();
}
__device__ __forceinline__ void h1_unit(const bf16_t* ucT, const float* tapsT, const float* nrm, const float* skip, bf16_t* yT, int c, LAS unsigned char* lds) {
  int tid = threadIdx.x; asm volatile("" : "+v"(tid));
  const int lane = tid & 63, w = __builtin_amdgcn_readfirstlane(tid >> 6), li = lane & 31, lk = lane >> 5;
  LAS float* TAPS = (LAS float*)(lds + O_TAPS); LAS float* ZA = (LAS float*)(lds + O_ZA); LAS float* ZB = (LAS float*)(lds + O_ZB);
  LAS float* X1 = (LAS float*)(lds + O_X1); LAS float* X2 = (LAS float*)(lds + O_X2); LAS float* RED = (LAS float*)(lds + O_RED);
  for (int e = tid; e < 32 * 62; e += 512) { const int s2 = e / 62, p = e % 62, t1p = p < 31 ? p : 128 + p; ZA[s2 * LDZ + t1p] = 0.f; ZB[s2 * LDZ + t1p] = 0.f; }
  for (int t = tid; t < S; t += 512) { const int t2 = t & 31, t1 = t >> 5;
    X1[t2 * LDX + t1] = bf2f(ucT[(size_t)c * S + t]); X2[t2 * LDX + t1] = bf2f(ucT[(size_t)(512 + c) * S + t]); ZA[t2 * LDZ + t1 + ZPAD] = bf2f(ucT[(size_t)(1024 + c) * S + t]); }
#pragma unroll 1
  for (int o = 0; o < 2; ++o) {
    const float* tp = tapsT + ((size_t)o * 512 + c) * 8192;
    for (int e = tid; e < 8192; e += 512) TAPS[e] = tp[(e + 4096) & 8191];
    __syncthreads();
    const LAS float* Zin = o == 0 ? ZA : ZB;
    const int g = w & 3, dh = w >> 2;
    const int Dlo = 32 * g - 127 + (dh ? 80 : 0), Dn = dh ? 79 : 80;
    f32x16 acc = {};
    { const LAS float* ap = TAPS + 4096 + 32 * Dlo + li - lk - 30;
      const LAS float* bp = Zin + lk * LDZ + (32 * g + li - Dlo + ZPAD);
#pragma unroll 2
      for (int dd = 0; dd < Dn; ++dd) {
#pragma unroll
        for (int kk = 0; kk < 16; ++kk) acc = __builtin_amdgcn_mfma_f32_32x32x2f32(ap[(15 - kk) * 2], bp[2 * kk * LDZ], acc, 0, 0, 0);
        ap += 32; bp -= 1; }
    }
    if (dh) {
#pragma unroll
      for (int r = 0; r < 16; ++r) RED[(g * 64 + lane) * 16 + r] = acc[r]; }
    __syncthreads();
    if (!dh) { const float inv = 1.f / nrm[o * 512 + c], sk = skip[o * 512 + c]; const LAS float* G = o == 0 ? X1 : X2; LAS float* Out = o == 0 ? ZB : ZA;
#pragma unroll
      for (int r = 0; r < 16; ++r) { const int t2 = (r & 3) + 8 * (r >> 2) + 4 * lk, t1 = 32 * g + li;
        const float cv = (acc[r] + RED[(g * 64 + lane) * 16 + r]) * inv; const float zin = Zin[t2 * LDZ + t1 + ZPAD];
        Out[t2 * LDZ + t1 + ZPAD] = G[t2 * LDX + t1] * (cv + sk * zin); } }
    __syncthreads();
  }
  for (int t = tid; t < S; t += 512) yT[(size_t)c * S + t] = (bf16_t)f2bf(ZA[(t & 31) * LDZ + (t >> 5) + ZPAD]);
  __syncthreads();
}

typedef short bf16x8v __attribute__((ext_vector_type(8)));
typedef unsigned u32x2v __attribute__((ext_vector_type(2)));
constexpr int CSB = 16448;
constexpr int ZROW = 80, ZROWS = 190;
constexpr int B_CS = 0, B_ZA = 4 * CSB, B_ZB = B_ZA + 15232, B_X1 = B_ZB + 15232, B_X2 = B_X1 + 8256, B_RED = B_X2 + 8256, B_END = B_RED + 16384;
static_assert(B_END <= 131072 && B_ZA % 16 == 0 && B_X1 % 16 == 0, "hyena bf16 lds");
__device__ __forceinline__ void h1b_unit(const bf16_t* ucT, const bf16_t* tapsB, const float* nrm, const float* skip, bf16_t* yT, int c, LAS unsigned char* lds) {
  int tid = threadIdx.x; asm volatile("" : "+v"(tid));
  const int lane = tid & 63, w = __builtin_amdgcn_readfirstlane(tid >> 6), li = lane & 31, lk = lane >> 5;
  LAS bf16_t* ZA = (LAS bf16_t*)(lds + B_ZA); LAS bf16_t* ZB = (LAS bf16_t*)(lds + B_ZB); LAS bf16_t* X1 = (LAS bf16_t*)(lds + B_X1); LAS bf16_t* X2 = (LAS bf16_t*)(lds + B_X2);
  LAS float* RED = (LAS float*)(lds + B_RED);
  for (int e = tid; e < 62 * 20; e += 512) { const int p = e / 20, d = e % 20, row = p < 31 ? p : 128 + p; ((LAS unsigned*)ZA)[row * 20 + d] = 0u; ((LAS unsigned*)ZB)[row * 20 + d] = 0u; }
  { const v4u zv = *(const v4u*)(ucT + (size_t)(1024 + c) * S + tid * 8); const int t = tid * 8; *(LAS v4u*)((LAS unsigned char*)ZA + ((t >> 5) + ZPAD) * ZROW + (t & 31) * 2) = zv; }
  { const v4u xa = *(const v4u*)(ucT + (size_t)c * S + tid * 8), xb = *(const v4u*)(ucT + (size_t)(512 + c) * S + tid * 8); const int t1 = tid >> 2, t2b = (tid & 3) * 8;
    const unsigned wa[4] = {xa.x, xa.y, xa.z, xa.w}, wb[4] = {xb.x, xb.y, xb.z, xb.w};
#pragma unroll
    for (int k = 0; k < 4; ++k) { X1[(t2b + 2 * k) * LDX + t1] = (bf16_t)(wa[k] & 0xffff); X1[(t2b + 2 * k + 1) * LDX + t1] = (bf16_t)(wa[k] >> 16);
      X2[(t2b + 2 * k) * LDX + t1] = (bf16_t)(wb[k] & 0xffff); X2[(t2b + 2 * k + 1) * LDX + t1] = (bf16_t)(wb[k] >> 16); } }
  typedef unsigned u4a __attribute__((ext_vector_type(4), aligned(4))); typedef const __attribute__((address_space(1))) u4a* gp4;
  v4u cv[9];
#pragma unroll 1
  for (int o = 0; o < 2; ++o) {
#define HTAPS_LOAD(oo) { const __attribute__((address_space(1))) unsigned char* tb = (const __attribute__((address_space(1))) unsigned char*)(tapsB + ((size_t)(oo) * 512 + c) * 2 * 8232); \
      _Pragma("unroll") for (int it = 0; it < 9; ++it) { const int e = tid + 512 * it; const int s = e / 1028, q = e % 1028; cv[it] = (v4u){0u, 0u, 0u, 0u}; if (e < 4 * 1028) cv[it] = *(gp4)(tb + (size_t)(s & 1) * 16464 + 16 * q + 4 * (s >> 1)); } }
    if (o == 0) HTAPS_LOAD(0)
    {
#pragma unroll
      for (int it = 0; it < 9; ++it) { const int e = tid + 512 * it; const int s = e / 1028, q = e % 1028; if (e < 4 * 1028) *(LAS v4u*)(lds + B_CS + s * CSB + 16 * q) = cv[it]; } }
    __syncthreads();
    if (o == 0) HTAPS_LOAD(1)
    const LAS bf16_t* Zin = o == 0 ? ZA : ZB;
    const int g = w & 3, dh = w >> 2;
    const int Dlo = 32 * g - 127 + (dh ? 81 : 0), Dn = dh ? 78 : 81;
    f32x16 acc = {};
    { const int s = (4 - (li & 3)) & 3;
      const LAS unsigned char* ap = lds + B_CS + s * CSB + 2 * (4096 - 32 * Dlo - li + 8 * lk - s);
      const LAS unsigned char* bp = (const LAS unsigned char*)Zin + (32 * g + li - Dlo + ZPAD) * ZROW + 16 * lk;
#define HLD(A0, A1, B0, B1) { const u32x2v p0_ = *(const LAS u32x2v*)(ap), p1_ = *(const LAS u32x2v*)(ap2), p2_ = *(const LAS u32x2v*)(ap3), p3_ = *(const LAS u32x2v*)(ap4); \
        A0 = (v4u){p0_.x, p0_.y, p1_.x, p1_.y}; A1 = (v4u){p2_.x, p2_.y, p3_.x, p3_.y}; B0 = *(const LAS v4u*)(bp); B1 = *(const LAS v4u*)(bp + 32); ap -= 64; ap2 -= 64; ap3 -= 64; ap4 -= 64; bp -= ZROW; }
#define HMM(A, B) acc = __builtin_amdgcn_mfma_f32_32x32x16_bf16(__builtin_bit_cast(bf16x8v, A), __builtin_bit_cast(bf16x8v, B), acc, 0, 0, 0)
#define HOPQ(name, off) unsigned name##i = (unsigned)(unsigned long long)(ap + (off)); asm volatile("" : "+v"(name##i)); const LAS unsigned char* name = (const LAS unsigned char*)(unsigned long long)name##i;
      HOPQ(ap2, 8) HOPQ(ap3, 32) HOPQ(ap4, 40)
#undef HOPQ
      v4u fa0, fa1, fb0, fb1, ga0, ga1, gb0, gb1, ha0, ha1, hb0, hb1;
      HLD(fa0, fa1, fb0, fb1)
      HLD(ga0, ga1, gb0, gb1)
      for (int dd_ = 0; dd_ < Dn - 3; dd_ += 3) {
        HLD(ha0, ha1, hb0, hb1)
        HMM(fa0, fb0); HMM(fa1, fb1);
        HLD(fa0, fa1, fb0, fb1)
        HMM(ga0, gb0); HMM(ga1, gb1);
        HLD(ga0, ga1, gb0, gb1)
        HMM(ha0, hb0); HMM(ha1, hb1);
      }
      HLD(ha0, ha1, hb0, hb1)
      HMM(fa0, fb0); HMM(fa1, fb1); HMM(ga0, gb0); HMM(ga1, gb1); HMM(ha0, hb0); HMM(ha1, hb1);
#undef HLD
#undef HMM
    }
    if (dh) {
#pragma unroll
      for (int r = 0; r < 16; ++r) RED[(g * 64 + lane) * 16 + r] = acc[r]; }
    __syncthreads();
    if (!dh) { const float inv = 1.f / nrm[o * 512 + c], sk = skip[o * 512 + c]; const LAS bf16_t* G = o == 0 ? X1 : X2; LAS bf16_t* Out = o == 0 ? ZB : ZA;
#pragma unroll
      for (int r = 0; r < 16; ++r) { const int t2 = (r & 3) + 8 * (r >> 2) + 4 * lk, t1 = 32 * g + li;
        const float cv = (acc[r] + RED[(g * 64 + lane) * 16 + r]) * inv; const float zin = bf2f(Zin[(t1 + ZPAD) * (ZROW / 2) + t2]);
        Out[(t1 + ZPAD) * (ZROW / 2) + t2] = (bf16_t)f2bf(bf2f(G[t2 * LDX + t1]) * (cv + sk * zin)); } }
    __syncthreads();
  }
  { const int t = tid * 8; *(v4u*)(yT + (size_t)c * S + t) = *(const LAS v4u*)((const LAS unsigned char*)ZA + ((t >> 5) + ZPAD) * ZROW + (t & 31) * 2); }
  __syncthreads();
}
#undef HTAPS_LOAD

constexpr int C_ZP = 15, C_ZB = 159 * ZROW  , C_CS = 0, C_Z0 = 4 * CSB, C_X0 = C_Z0 + 2 * C_ZB, C_END = C_X0 + 4 * 8256;
static_assert(C_END <= 131072 && C_Z0 % 16 == 0 && C_ZB % 16 == 0 && C_X0 % 16 == 0, "hyena two-batch lds");
__device__ __forceinline__ void h1c_unit(const bf16_t* ucT2, const bf16_t* tapsB, const float* nrm, const float* skip, bf16_t* yT2, int c, LAS unsigned char* lds) {
  int tid = threadIdx.x; asm volatile("" : "+v"(tid));
  const int lane = tid & 63, g = __builtin_amdgcn_readfirstlane(tid >> 6), li = lane & 31, lk = lane >> 5, bsel = li >> 4, t1l = li & 15;
  for (int e = tid; e < 2 * 31 * 20; e += 512) { const int b = e / (31 * 20), p = (e / 20) % 31, d = e % 20, row = p < 15 ? p : 128 + p; ((LAS unsigned*)(lds + C_Z0 + b * C_ZB))[row * 20 + d] = 0u; }
#pragma unroll
  for (int b = 0; b < 2; ++b) { const bf16_t* uc = ucT2 + (size_t)b * 1536 * S; const int t = tid * 8;
    const v4u zv = *(const v4u*)(uc + (size_t)(1024 + c) * S + t), xa = *(const v4u*)(uc + (size_t)c * S + t), xb = *(const v4u*)(uc + (size_t)(512 + c) * S + t);
    *(LAS v4u*)(lds + C_Z0 + b * C_ZB + ((t >> 5) + C_ZP) * ZROW + (t & 31) * 2) = zv;
    LAS bf16_t* X1 = (LAS bf16_t*)(lds + C_X0 + (2 * b) * 8256); LAS bf16_t* X2 = (LAS bf16_t*)(lds + C_X0 + (2 * b + 1) * 8256); const int t1 = tid >> 2, t2b = (tid & 3) * 8;
    const unsigned wa[4] = {xa.x, xa.y, xa.z, xa.w}, wb[4] = {xb.x, xb.y, xb.z, xb.w};
#pragma unroll
    for (int k = 0; k < 4; ++k) { X1[(t2b + 2 * k) * LDX + t1] = (bf16_t)(wa[k] & 0xffff); X1[(t2b + 2 * k + 1) * LDX + t1] = (bf16_t)(wa[k] >> 16);
      X2[(t2b + 2 * k) * LDX + t1] = (bf16_t)(wb[k] & 0xffff); X2[(t2b + 2 * k + 1) * LDX + t1] = (bf16_t)(wb[k] >> 16); } }
  typedef unsigned u4a __attribute__((ext_vector_type(4), aligned(4))); typedef const __attribute__((address_space(1))) u4a* gp4;
  v4u cv[9];
  LAS bf16_t* Zm = (LAS bf16_t*)(lds + C_Z0 + bsel * C_ZB);
#pragma unroll 1
  for (int o = 0; o < 2; ++o) {
#define HTAPS_LOAD(oo) { const __attribute__((address_space(1))) unsigned char* tb = (const __attribute__((address_space(1))) unsigned char*)(tapsB + ((size_t)(oo) * 512 + c) * 2 * 8232); \
      _Pragma("unroll") for (int it = 0; it < 9; ++it) { const int e = tid + 512 * it; const int s = e / 1028, q = e % 1028; cv[it] = (v4u){0u, 0u, 0u, 0u}; if (e < 4 * 1028) cv[it] = *(gp4)(tb + (size_t)(s & 1) * 16464 + 16 * q + 4 * (s >> 1)); } }
    if (o == 0) HTAPS_LOAD(0)
    {
#pragma unroll
      for (int it = 0; it < 9; ++it) { const int e = tid + 512 * it; const int s = e / 1028, q = e % 1028; if (e < 4 * 1028) *(LAS v4u*)(lds + C_CS + s * CSB + 16 * q) = cv[it]; } }
    __syncthreads();
    if (o == 0) HTAPS_LOAD(1)
    const int Dlo = 16 * g - 128; constexpr int Dn = 144;
    f32x16 acc = {};
    { const int s = (4 - (li & 3)) & 3;
      const LAS unsigned char* ap = lds + C_CS + s * CSB + 2 * (4096 - 32 * Dlo - li + 8 * lk - s);
      const LAS unsigned char* bp = (const LAS unsigned char*)Zm + (16 * g + t1l - Dlo + C_ZP) * ZROW + 16 * lk;
#define HLD(A0, A1, B0, B1) { const u32x2v p0_ = *(const LAS u32x2v*)(ap), p1_ = *(const LAS u32x2v*)(ap2), p2_ = *(const LAS u32x2v*)(ap3), p3_ = *(const LAS u32x2v*)(ap4); \
        A0 = (v4u){p0_.x, p0_.y, p1_.x, p1_.y}; A1 = (v4u){p2_.x, p2_.y, p3_.x, p3_.y}; B0 = *(const LAS v4u*)(bp); B1 = *(const LAS v4u*)(bp + 32); ap -= 64; ap2 -= 64; ap3 -= 64; ap4 -= 64; bp -= ZROW; }
#define HMM(A, B) acc = __builtin_amdgcn_mfma_f32_32x32x16_bf16(__builtin_bit_cast(bf16x8v, A), __builtin_bit_cast(bf16x8v, B), acc, 0, 0, 0)
#define HOPQ(name, off) unsigned name##i = (unsigned)(unsigned long long)(ap + (off)); asm volatile("" : "+v"(name##i)); const LAS unsigned char* name = (const LAS unsigned char*)(unsigned long long)name##i;
      HOPQ(ap2, 8) HOPQ(ap3, 32) HOPQ(ap4, 40)
#undef HOPQ
      v4u fa0, fa1, fb0, fb1, ga0, ga1, gb0, gb1, ha0, ha1, hb0, hb1;
      HLD(fa0, fa1, fb0, fb1)
      HLD(ga0, ga1, gb0, gb1)
      for (int dd_ = 0; dd_ < Dn - 3; dd_ += 3) {
        HLD(ha0, ha1, hb0, hb1)
        HMM(fa0, fb0); HMM(fa1, fb1);
        HLD(fa0, fa1, fb0, fb1)
        HMM(ga0, gb0); HMM(ga1, gb1);
        HLD(ga0, ga1, gb0, gb1)
        HMM(ha0, hb0); HMM(ha1, hb1);
      }
      HLD(ha0, ha1, hb0, hb1)
      HMM(fa0, fb0); HMM(fa1, fb1); HMM(ga0, gb0); HMM(ga1, gb1); HMM(ha0, hb0); HMM(ha1, hb1);
#undef HLD
#undef HMM
    }
    __syncthreads();
    { const float inv = 1.f / nrm[o * 512 + c], sk = skip[o * 512 + c]; const LAS bf16_t* G = (const LAS bf16_t*)(lds + C_X0 + (2 * bsel + o) * 8256);
#pragma unroll
      for (int r = 0; r < 16; ++r) { const int t2 = (r & 3) + 8 * (r >> 2) + 4 * lk, t1 = 16 * g + t1l;
        const float cvv = acc[r] * inv; const float zin = bf2f(Zm[(t1 + C_ZP) * (ZROW / 2) + t2]);
        Zm[(t1 + C_ZP) * (ZROW / 2) + t2] = (bf16_t)f2bf(bf2f(G[t2 * LDX + t1]) * (cvv + sk * zin)); } }
    __syncthreads();
  }
#pragma unroll
  for (int b = 0; b < 2; ++b) { const int t = tid * 8; *(v4u*)(yT2 + (size_t)b * 512 * S + (size_t)c * S + t) = *(const LAS v4u*)(lds + C_Z0 + b * C_ZB + ((t >> 5) + C_ZP) * ZROW + (t & 31) * 2); }
  __syncthreads();
#undef HTAPS_LOAD
}
__device__ __forceinline__ void cconv3_item(const bf16_t* u, int ld, const float* cw, const float* cb, float* ucc, long idx) {
  const int j = (int)(idx % 1536); const int tc = (int)(idx / 1536);
  const bf16_t* up = u + (size_t)tc * ld + j;
  float v = cb[j] + cw[1536 + j] * bf2f(up[0]);
  if (tc > 0) v += cw[j] * bf2f(*(up - ld)); if (tc < 255) v += cw[2 * 1536 + j] * bf2f(up[ld]);
  ucc[idx] = v;
}
__device__ __forceinline__ void clong_item(const float* ucc, const float* z1c_in, float* z1c_out, bf16_t* yout, int ldy, const float* tapsC, const float* nrmC, const float* skip, int o, long idx) {
  const int c = (int)(idx % 512), t0 = (int)(idx / 512) * 8; constexpr int n = 256;
  const float* tp = tapsC + (size_t)o * 2 * n * 512 + c; const float nr = nrmC[o * 512 + c];
  const float* zs = o == 0 ? ucc + 1024 + c : z1c_in + c; const int ldz = o == 0 ? 1536 : 512;
  float acc[8], w[8];
#pragma unroll
  for (int i = 0; i < 8; ++i) { acc[i] = 0.f; const int lag = t0 + i; w[i] = tp[(size_t)lag * 512]; }
#pragma unroll 4
  for (int s = 0; s < n; ++s) { const float zv = zs[(size_t)s * ldz];
#pragma unroll
    for (int i = 0; i < 8; ++i) acc[i] += w[i] * zv;
    const int lag = t0 - s - 1;
    const float nw = tp[(size_t)(lag >= 0 ? lag : 2 * n + lag) * 512];
#pragma unroll
    for (int i = 7; i > 0; --i) w[i] = w[i - 1];
    w[0] = nw; }
  const float sk = skip[o * 512 + c];
#pragma unroll
  for (int i = 0; i < 8; ++i) { const int t = t0 + i; const float val = ucc[(size_t)t * 1536 + o * 512 + c] * (acc[i] / nr + sk * zs[(size_t)t * ldz]);
    if (o == 0) z1c_out[(size_t)t * 512 + c] = val; else yout[(size_t)t * ldy + c] = (bf16_t)f2bf(val); }
}
}
#define XB_TMO      128
#define XB_XCNT(j)  (256  + 64 * (j))
#define XB_XSUB(j)  (1280 + 64 * (j))
#define XB_XGEN(j)  (2304 + 64 * (j))
#define XB_TOP      3328
#define XB_TOPGEN   3392
#define XCD_BAR_WORDS 3456
#define XB_SPIN_CAP (1u << 18)

__device__ __forceinline__ unsigned xb_ld(unsigned* p)              { return __hip_atomic_load(p, __ATOMIC_RELAXED, __HIP_MEMORY_SCOPE_AGENT); }
__device__ __forceinline__ unsigned xb_add(unsigned* p, unsigned v) { return __hip_atomic_fetch_add(p, v, __ATOMIC_RELAXED, __HIP_MEMORY_SCOPE_AGENT); }
__device__ __forceinline__ unsigned xb_xcc_id() { return (unsigned)__builtin_amdgcn_s_getreg((3 << 11) | 20) & 0xFu; }
#define XB_SPIN(cond, bar) do { unsigned _sp = 0; while (cond) { __builtin_amdgcn_s_sleep(1); \
    if ((++_sp & 255u) == 0u) { if (xb_ld(&(bar)[XB_TMO])) break; if (_sp > XB_SPIN_CAP) { atomicAdd(&(bar)[XB_TMO], 1u); break; } } } } while (0)

struct XcdBarrier {
    unsigned* bar; unsigned x;
    volatile LAS unsigned* st;
};

__device__ __forceinline__ XcdBarrier xcd_barrier_post(unsigned* bar, volatile LAS unsigned* st) {
    XcdBarrier b; b.bar = bar; b.x = xb_xcc_id(); b.st = st;
    if (threadIdx.x == 0) (void)xb_add(&bar[XB_XCNT(b.x)], 1u);
    return b;
}
__device__ __forceinline__ void xcd_barrier_complete(unsigned* bar, unsigned x, unsigned& nloc, unsigned& nx) {
    const unsigned G = gridDim.x * gridDim.y * gridDim.z;
    unsigned sum, cnt, mine, sp = 0u;
    for (;;) {
        sum = 0u; cnt = 0u; mine = 0u;
#pragma unroll
        for (unsigned j = 0; j < 16; ++j) { const unsigned c = xb_ld(&bar[XB_XCNT(j)]); sum += c; cnt += (c > 0u) ? 1u : 0u; mine = (j == x) ? c : mine; }
        if (sum == G) break;
        __builtin_amdgcn_s_sleep(1);
        if ((++sp & 255u) == 0u) { if (xb_ld(&bar[XB_TMO])) break; if (sp > XB_SPIN_CAP) { atomicAdd(&bar[XB_TMO], 1u); break; } }
    }
    nloc = mine > 0u ? mine : 1u; nx = cnt > 0u ? cnt : 1u;
}

__device__ __forceinline__ void xcd_barrier(const XcdBarrier& b) {
    asm volatile("s_waitcnt vmcnt(0)" ::: "memory");
    __syncthreads();
    if (threadIdx.x == 0) {
        unsigned* bar = b.bar;
#define XB_SP(word) ((unsigned*)((((unsigned long long)(unsigned)__builtin_amdgcn_readfirstlane((int)((unsigned long long)(bar + (word)) >> 32))) << 32) | (unsigned)__builtin_amdgcn_readfirstlane((int)(unsigned)(unsigned long long)(bar + (word)))))
        unsigned* const p_xsub = XB_SP(XB_XSUB(b.x)); unsigned* const p_xgen = XB_SP(XB_XGEN(b.x));
        __builtin_amdgcn_s_waitcnt(0);
        unsigned nloc = b.st[0], nx = b.st[1];
        if (nloc == 0u) { xcd_barrier_complete(bar, b.x, nloc, nx); b.st[0] = nloc; b.st[1] = nx; }
        const unsigned old = xb_add(p_xsub, 1u);
        const unsigned gen = old / nloc;
        if (old + 1u == (gen + 1u) * nloc) {
            __builtin_amdgcn_fence(__ATOMIC_RELEASE, "agent");
            asm volatile("s_waitcnt vmcnt(0)" ::: "memory");
            const unsigned og = xb_add(&bar[XB_TOP], 1u);
            const unsigned tg = og / nx;
            if (og + 1u == (tg + 1u) * nx) xb_add(&bar[XB_TOPGEN], 1u);
            else XB_SPIN(xb_ld(&bar[XB_TOPGEN]) == tg, bar);
            __builtin_amdgcn_fence(__ATOMIC_ACQUIRE, "agent");
            xb_add(p_xgen, 1u);
            asm volatile("s_waitcnt vmcnt(0)" ::: "memory");
        } else {
            XB_SPIN(xb_ld(p_xgen) == gen, bar);
            __builtin_amdgcn_fence(__ATOMIC_ACQUIRE, "agent");
            asm volatile("s_waitcnt vmcnt(0)" ::: "memory");
        }
    }
    __syncthreads();
}
#include <math.h>
#ifdef HOST_TEST
#define HD
#define FEXP expf
#define FSIN sinf
#define FCOS cosf
#define FLOG logf
#define FPOW powf
#else
#define HD __device__ __forceinline__
#define FEXP __expf
#define FSIN __sinf
#define FCOS __cosf
#define FLOG __logf
#define FPOW __powf
#endif

struct FullDims { static constexpr int D=1024,B=8,S=4096,DEPTH=2,C=256,GW=64,AH=8,AKV=2,HDM=128,GH=4,GDK=64,GDV=128,GR=16,HW=512,HB=16,HF=64,NE=16,NG=4,DE=512; };
struct SmallDims { static constexpr int D=64,B=2,S=128,DEPTH=2,C=32,GW=16,AH=4,AKV=2,HDM=16,GH=2,GDK=8,GDV=16,GR=4,HW=32,HB=4,HF=8,NE=8,NG=2,DE=32; };

template <class T> struct DD {
  static constexpr int D=T::D,B=T::B,S=T::S,DEPTH=T::DEPTH,C=T::C,GW=T::GW,AH=T::AH,AKV=T::AKV,HDM=T::HDM,GH=T::GH,GDK=T::GDK,GDV=T::GDV,GR=T::GR,HW=T::HW,HB=T::HB,HF=T::HF,NE=T::NE,NG=T::NG,DE=T::DE;
  static constexpr int R=S+C, AG=AH/AKV, RP=HDM/4, HE=1+2*HB, EPG=NE/NG, AQW=AH*HDM, AKVW=AKV*HDM, GKW=GH*GDK, GVW=GH*GDV;
  static constexpr int NKV=AKVW+AKVW+GKW+GVW+2*GR, NIN=NKV+AQW+GKW+GVW+3*HW+3*D;
  static constexpr int O_AK=0, O_AV=AKVW, O_GK=2*AKVW, O_GV=2*AKVW+GKW, O_GA=2*AKVW+GKW+GVW;
  static constexpr int O_AQ=NKV, O_GQ=NKV+AQW, O_OG=O_GQ+GKW, O_HY=O_OG+GVW, O_BR=O_HY+3*HW;
};

struct NaiveBufs {
  const float *x,*c,*ctx,*c_ctx,*w_mod,*b_mod,*norm1_g,*norm2_g,*w_in,*q_norm_g,*k_norm_g,*gla_wa2,*gla_ba,*gla_norm_g,*hy_conv_w,*hy_conv_b,
    *hy_pos_w1,*hy_pos_b1,*hy_sin_freq,*hy_pos_w2,*hy_pos_b2,*hy_pos_w3,*hy_decay,*hy_skip,*w_br_hy,*w_br_gla,*w_br_att,*w_out,*router_w,*router_b,*moe_w_gate,*moe_w_up,*moe_w_down;
  float* out;
  float *mod;
  float *hid2S,*hid2C;
  float *tapsS,*tapsC;
  float *nrmS,*nrmC;
  float *rs;
  float *h;
  float *proj;
  float *qn,*kn;
  float *yatt;
  float *laf,*lab;
  float *of,*ob;
  float *ygla;
  float *uc;
  float *z1,*yhy;
  float *m;
  int   *ridx;
  float *rw;
  float *hid;
  float *xc;
};

HD float sigmoidf_(float x) { return 1.f / (1.f + FEXP(-x)); }
HD float siluf_(float x) { return x / (1.f + FEXP(-x)); }
HD float logsigmoidf_(float x) { return x < 0.f ? x - FLOG(1.f + FEXP(x)) : -FLOG(1.f + FEXP(-x)); }

template <class T> HD void st_mod(const NaiveBufs& a, int l, long idx) {
  using d = DD<T>; const int j = (int)(idx % (6 * d::D)), bb = (int)(idx / (6 * d::D));
  const float* cv = bb < d::B ? a.c + (long)bb * d::D : a.c_ctx; const float* w = a.w_mod + (long)l * d::D * 6 * d::D;
  float acc = a.b_mod[(long)l * 6 * d::D + j];
  for (int k = 0; k < d::D; ++k) acc += siluf_(cv[k]) * w[(long)k * 6 * d::D + j];
  a.mod[idx] = acc;
}
template <class T> HD void st_hyhid(const NaiveBufs& a, int l, int which, long idx) {
  using d = DD<T>; const int n = which ? d::C : d::S; float* dst = which ? a.hid2C : a.hid2S;
  const int j = (int)(idx % d::HF), t = (int)(idx / d::HF);
  const float* w1 = a.hy_pos_w1 + (long)l * d::HE * d::HF; const float* b1 = a.hy_pos_b1 + l * d::HF; const float* fr = a.hy_sin_freq + l * d::HF;
  const float* w2 = a.hy_pos_w2 + (long)l * d::HF * d::HF; const float* b2 = a.hy_pos_b2 + l * d::HF;
  const float tn = (float)t / (float)n; const float w0 = 2.f * 3.14159265358979323846f / (float)n;
  float acc2 = b2[j];
  for (int i = 0; i < d::HF; ++i) {
    float acc = b1[i] + tn * w1[0 * d::HF + i];
    for (int bnd = 0; bnd < d::HB; ++bnd) {
      const float band = 1e-4f + (float)bnd * ((float)(d::HB - 1) - 1e-4f) / (float)(d::HB - 1);
      const float ph = w0 * (float)t * band;
      acc += FCOS(ph) * w1[(1 + bnd) * d::HF + i] - FSIN(ph) * w1[(1 + d::HB + bnd) * d::HF + i];
    }
    acc2 += FSIN(fr[i] * acc) * w2[i * d::HF + j];
  }
  dst[idx] = FSIN(fr[j] * acc2);
}
template <class T> HD void st_hytaps(const NaiveBufs& a, int l, int which, long idx) {
  using d = DD<T>; const int n = which ? d::C : d::S; const float* hid2 = which ? a.hid2C : a.hid2S; float* dst = which ? a.tapsC : a.tapsS;
  const int c = (int)(idx % d::HW); const int li = (int)((idx / d::HW) % (2 * n)); const int o = (int)(idx / ((long)d::HW * 2 * n));
  float v = 0.f;
  if (li != n) {
    const int dir = li < n ? 0 : 1; const int t = li < n ? li : 2 * n - li;
    const int col = (o * 2 + dir) * d::HW + c;
    const float* w3 = a.hy_pos_w3 + (long)l * d::HF * 4 * d::HW;
    float acc = 0.f;
    for (int j = 0; j < d::HF; ++j) acc += hid2[(long)t * d::HF + j] * w3[(long)j * 4 * d::HW + col];
    const float dec = fabsf(a.hy_decay[(long)l * 4 * d::HW + col]);
    v = acc * FEXP(-((float)t / (float)n) * dec);
  }
  if (which == 0) dst[((long)o * d::HW + c) * 2 * n + li] = v; else dst[idx] = v;
}
template <class T> HD void st_hynorm(const NaiveBufs& a, int which, long idx) {
  using d = DD<T>; const int n = which ? d::C : d::S; const float* tp = which ? a.tapsC : a.tapsS; float* dst = which ? a.nrmC : a.nrmS;
  const int c = (int)(idx % d::HW), o = (int)(idx / d::HW);
  float s = 0.f; for (int li = 0; li < 2 * n; ++li) s += fabsf(which == 0 ? tp[((long)o * d::HW + c) * 2 * n + li] : tp[((long)o * 2 * n + li) * d::HW + c]);
  dst[idx] = s + 1e-6f;
}

template <class T> HD const float* xrow(const NaiveBufs& a, int l, int b, int r) {
  using d = DD<T>;
  if (r < d::S) return (l == 0 ? a.x : a.out) + ((long)b * d::S + r) * d::D;
  return (l == 0 ? a.ctx : a.xc) + ((long)b * d::C + (r - d::S)) * d::D;
}
template <class T> HD float* xrow_w(const NaiveBufs& a, int b, int r) {
  using d = DD<T>;
  if (r < d::S) return a.out + ((long)b * d::S + r) * d::D;
  return a.xc + ((long)b * d::C + (r - d::S)) * d::D;
}
template <class T> HD void st_rs(const NaiveBufs& a, int l, int b, int src, long idx) {
  using d = DD<T>; const int r = (int)idx; const float* xr = src ? (const float*)xrow_w<T>(a, b, r) : xrow<T>(a, l, b, r);
  float s = 0.f; for (int k = 0; k < d::D; ++k) s += xr[k] * xr[k];
  a.rs[r] = 1.f / sqrtf(s / (float)d::D + 1e-6f);
}
template <class T> HD void st_norm(const NaiveBufs& a, int l, int b, int which, long idx) {
  using d = DD<T>; const int j = (int)(idx % d::D), r = (int)(idx / d::D);
  const float* xr = which ? (const float*)xrow_w<T>(a, b, r) : xrow<T>(a, l, b, r);
  const float* g = (which ? a.norm2_g : a.norm1_g) + (long)l * d::D;
  const float* md = a.mod + (long)(r < d::S ? b : d::B) * 6 * d::D;
  const float shift = md[(which ? 3 : 0) * d::D + j], scale = md[(which ? 4 : 1) * d::D + j];
  a.h[idx] = xr[j] * a.rs[r] * g[j] * (1.f + scale) + shift;
}
struct GemmArgs { const float* A; int lda; const float* W; int ldw; float* Cc; int ldc; int M, N, K;
  const float* gate; int ldg;
  const float* colscale;
  const float* res; int ldr;
  int accumulate; };
HD void st_gemm(const GemmArgs& g, long idx) {
  const int nb = g.N / 4; const int cb = (int)(idx % nb), rb = (int)(idx / nb);
  float acc[4][4];
#pragma unroll
  for (int i = 0; i < 4; ++i) {
#pragma unroll
    for (int j = 0; j < 4; ++j) acc[i][j] = 0.f; }
  const float* a0 = g.A + (long)(rb * 4) * g.lda; const float* w0 = g.W + cb * 4;
  for (int k = 0; k < g.K; ++k) {
    float av[4], wv[4];
#pragma unroll
    for (int i = 0; i < 4; ++i) av[i] = a0[(long)i * g.lda + k];
#pragma unroll
    for (int j = 0; j < 4; ++j) wv[j] = w0[(long)k * g.ldw + j];
#pragma unroll
    for (int i = 0; i < 4; ++i) {
#pragma unroll
      for (int j = 0; j < 4; ++j) acc[i][j] += av[i] * wv[j]; }
  }
#pragma unroll
  for (int i = 0; i < 4; ++i)
#pragma unroll
  for (int j = 0; j < 4; ++j) {
    const int r = rb * 4 + i, c = cb * 4 + j; float v = acc[i][j];
    if (g.gate) v *= sigmoidf_(g.gate[(long)r * g.ldg + c]);
    if (g.colscale) v *= g.colscale[c];
    if (g.res) v += g.res[(long)r * g.ldr + c];
    float* p = g.Cc + (long)r * g.ldc + c;
    if (g.accumulate) v += *p;
    *p = v;
  }
}
template <class T> HD void st_qknorm(const NaiveBufs& a, int l, long idx) {
  using d = DD<T>; const int hh = (int)(idx % (d::AH + d::AKV)), r = (int)(idx / (d::AH + d::AKV));
  const bool isq = hh < d::AH; const int hd = isq ? hh : hh - d::AH;
  const float* src = a.proj + (long)r * d::NIN + (isq ? d::O_AQ : d::O_AK) + hd * d::HDM;
  float* dst = (isq ? a.qn + (long)r * d::AQW : a.kn + (long)r * d::AKVW) + hd * d::HDM;
  const float* g = (isq ? a.q_norm_g : a.k_norm_g) + (long)l * d::HDM;
  float s = 0.f; for (int k = 0; k < d::HDM; ++k) s += src[k] * src[k];
  const float rsq = 1.f / sqrtf(s / (float)d::HDM + 1e-6f);
  if (r < d::S) {
    const int row = r / d::GW, col = r % d::GW;
    for (int p = 0; p < d::HDM / 2; ++p) {
      const int fi = p < d::RP ? p : p - d::RP; const float pos = p < d::RP ? (float)row : (float)col;
      const float inv = FPOW(10000.f, -(float)fi / (float)d::RP); const float ang = pos * inv;
      const float cs = FCOS(ang), sn = FSIN(ang);
      const float x1 = src[2 * p] * rsq * g[2 * p], x2 = src[2 * p + 1] * rsq * g[2 * p + 1];
      dst[2 * p] = x1 * cs - x2 * sn; dst[2 * p + 1] = x1 * sn + x2 * cs;
    }
  } else { for (int k = 0; k < d::HDM; ++k) dst[k] = src[k] * rsq * g[k]; }
}
template <class T, int NSPLIT> HD void st_attn(const NaiveBufs& a, int r0, int nrows, long idx) {
  using d = DD<T>; constexpr int OD = d::HDM / NSPLIT;
  const int r = r0 + (int)(idx % nrows); const int hs = (int)(idx / nrows); const int part = hs % NSPLIT, hq = hs / NSPLIT; const int kv = hq / d::AG;
  const int k0 = r < d::S ? 0 : d::S, k1 = d::R;
  float q[d::HDM], o[OD];
  const float scale = 1.f / sqrtf((float)d::HDM);
#pragma unroll
  for (int k = 0; k < d::HDM; ++k) q[k] = a.qn[(long)r * d::AQW + hq * d::HDM + k] * scale;
#pragma unroll
  for (int k = 0; k < OD; ++k) o[k] = 0.f;
  float mx = -1e30f, lsum = 0.f;
  for (int kk = k0; kk < k1; ++kk) {
    const float* kr = a.kn + (long)kk * d::AKVW + kv * d::HDM;
    float s = 0.f;
#pragma unroll
    for (int k = 0; k < d::HDM; ++k) s += q[k] * kr[k];
    if (s > mx) { const float cr = FEXP(mx - s); lsum *= cr;
#pragma unroll
      for (int k = 0; k < OD; ++k) o[k] *= cr;
      mx = s; }
    const float p = FEXP(s - mx); lsum += p;
    const float* vr = a.proj + (long)kk * d::NIN + d::O_AV + kv * d::HDM + part * OD;
#pragma unroll
    for (int k = 0; k < OD; ++k) o[k] += p * vr[k];
  }
  const float inv = 1.f / lsum;
#pragma unroll
  for (int k = 0; k < OD; ++k) a.yatt[(long)r * d::AQW + hq * d::HDM + part * OD + k] = o[k] * inv;
}
template <class T> HD void st_glala(const NaiveBufs& a, int l, long idx) {
  using d = DD<T>; const int j = (int)(idx % d::GKW); const int dir = (int)((idx / d::GKW) % 2); const int r = (int)(idx / (2 * d::GKW));
  const float* al = a.proj + (long)r * d::NIN + d::O_GA + dir * d::GR;
  const float* w2 = a.gla_wa2 + ((long)l * 2 + dir) * d::GR * d::GKW; float z = a.gla_ba[((long)l * 2 + dir) * d::GKW + j];
  for (int k = 0; k < d::GR; ++k) z += al[k] * w2[(long)k * d::GKW + j];
  (dir ? a.lab : a.laf)[(long)r * d::GKW + j] = FEXP(logsigmoidf_(z) / 16.f);
}
template <class T> HD void st_glascan(const NaiveBufs& a, long idx) {
  using d = DD<T>; const int v = (int)(idx % d::GDV); const int hd = (int)((idx / d::GDV) % d::GH); const int dir = (int)(idx / (d::GDV * d::GH));
  float st[d::GDK];
#pragma unroll
  for (int k = 0; k < d::GDK; ++k) st[k] = 0.f;
  const float qs = 1.f / sqrtf((float)d::GDK);
  const float* la = dir ? a.lab : a.laf; float* od = dir ? a.ob : a.of;
  for (int step = 0; step < d::R; ++step) {
    int r;
    if (step < d::C) r = d::S + (dir ? d::C - 1 - step : step); else r = dir ? d::S - 1 - (step - d::C) : step - d::C;
    const float* pr = a.proj + (long)r * d::NIN;
    const float vv = pr[d::O_GV + hd * d::GDV + v];
    float o = 0.f;
#pragma unroll
    for (int k = 0; k < d::GDK; ++k) {
      st[k] = la[(long)r * d::GKW + hd * d::GDK + k] * st[k] + pr[d::O_GK + hd * d::GDK + k] * vv;
      o += pr[d::O_GQ + hd * d::GDK + k] * qs * st[k];
    }
    od[(long)r * d::GVW + hd * d::GDV + v] = o;
  }
}
template <class T> HD void st_glaout(const NaiveBufs& a, int l, long idx) {
  using d = DD<T>; const int hd = (int)(idx % d::GH), r = (int)(idx / d::GH);
  const long base = (long)r * d::GVW + hd * d::GDV; float s = 0.f;
  for (int v = 0; v < d::GDV; ++v) { const float o = a.of[base + v] + a.ob[base + v]; s += o * o; }
  const float rsq = 1.f / sqrtf(s / (float)d::GDV + 1e-6f);
  for (int v = 0; v < d::GDV; ++v) { const float o = a.of[base + v] + a.ob[base + v];
    a.ygla[base + v] = o * rsq * a.gla_norm_g[(long)l * d::GDV + v] * siluf_(a.proj[(long)r * d::NIN + d::O_OG + hd * d::GDV + v]); }
}
template <class T> HD void st_hyconv3(const NaiveBufs& a, int l, long idx) {
  using d = DD<T>; const int j = (int)(idx % (3 * d::HW)), r = (int)(idx / (3 * d::HW));
  const int lo = r < d::S ? 0 : d::S, hi = r < d::S ? d::S : d::R;
  const float* w = a.hy_conv_w + (long)l * 3 * 3 * d::HW;
  float v = a.hy_conv_b[(long)l * 3 * d::HW + j] + a.proj[(long)r * d::NIN + d::O_HY + j] * w[1 * 3 * d::HW + j];
  if (r - 1 >= lo) v += a.proj[(long)(r - 1) * d::NIN + d::O_HY + j] * w[0 * 3 * d::HW + j];
  if (r + 1 < hi) v += a.proj[(long)(r + 1) * d::NIN + d::O_HY + j] * w[2 * 3 * d::HW + j];
  a.uc[idx] = v;
}
template <class T> HD void st_hylong(const NaiveBufs& a, int l, int o, long idx) {
  using d = DD<T>; const int c = (int)(idx % d::HW); const int rb = (int)(idx / d::HW); const int r0 = rb * 4;
  const bool lat = r0 < d::S; const int n = lat ? d::S : d::C; const int base = lat ? 0 : d::S; const int t0 = r0 - base;
  const float* tp = (lat ? a.tapsS : a.tapsC) + (long)o * 2 * n * d::HW + c; const float nr = (lat ? a.nrmS : a.nrmC)[o * d::HW + c];
  const float* zs = o == 0 ? a.uc + 2 * d::HW + c : a.z1 + c; const int ldz = o == 0 ? 3 * d::HW : d::HW;
  float acc0 = 0.f, acc1 = 0.f, acc2 = 0.f, acc3 = 0.f;
  auto tap = [&](int lag) { const int li = lag >= 0 ? lag : 2 * n + lag; return tp[(long)li * d::HW]; };
  float w0 = tap(t0), w1 = tap(t0 + 1), w2 = tap(t0 + 2), w3 = tap(t0 + 3);
  for (int s = 0; s < n; ++s) {
    const float zv = zs[(long)(base + s) * ldz];
    acc0 += w0 * zv; acc1 += w1 * zv; acc2 += w2 * zv; acc3 += w3 * zv;
    w3 = w2; w2 = w1; w1 = w0; w0 = (s + 1 < n) ? tap(t0 - s - 1) : 0.f;
  }
  const float sk = a.hy_skip[((long)l * 2 + o) * d::HW + c];
  float* dst = o == 0 ? a.z1 : a.yhy;
  const float accs[4] = {acc0, acc1, acc2, acc3};
#pragma unroll
  for (int i = 0; i < 4; ++i) { const int r = r0 + i; const float zr = zs[(long)r * ldz];
    dst[(long)r * d::HW + c] = a.uc[(long)r * 3 * d::HW + o * d::HW + c] * (accs[i] / nr + sk * zr); }
}
template <class T> HD void st_router(const NaiveBufs& a, long idx) {
  using d = DD<T>; const int r = (int)idx; const float* hr = a.h + (long)r * d::D;
  float sc[d::NE], sel[d::NE];
#pragma unroll
  for (int e = 0; e < d::NE; ++e) sc[e] = 0.f;
  for (int k = 0; k < d::D; ++k) { const float hv = hr[k];
#pragma unroll
    for (int e = 0; e < d::NE; ++e) sc[e] += hv * a.router_w[(long)k * d::NE + e]; }
#pragma unroll
  for (int e = 0; e < d::NE; ++e) { sc[e] = sigmoidf_(sc[e]); sel[e] = sc[e] + a.router_b[e]; }
  int bestg = 0; float bestgs = -1e30f;
#pragma unroll
  for (int g = 0; g < d::NG; ++g) { float m1 = -1e30f, m2 = -1e30f;
#pragma unroll
    for (int i = 0; i < d::EPG; ++i) { const float v = sel[g * d::EPG + i]; if (v > m1) { m2 = m1; m1 = v; } else if (v > m2) m2 = v; }
    const float gs = m1 + m2; if (gs > bestgs) { bestgs = gs; bestg = g; } }
  int i1 = -1, i2 = -1; float v1 = -1e30f, v2 = -1e30f, s1 = 0.f, s2 = 0.f;
#pragma unroll
  for (int e = 0; e < d::NE; ++e) { if (e / d::EPG == bestg) { const float v = sel[e];
      if (v > v1) { v2 = v1; i2 = i1; s2 = s1; v1 = v; i1 = e; s1 = sc[e]; } else if (v > v2) { v2 = v; i2 = e; s2 = sc[e]; } } }
  const float inv = 1.f / (s1 + s2);
  a.ridx[2 * r] = i1; a.ridx[2 * r + 1] = i2; a.rw[2 * r] = s1 * inv; a.rw[2 * r + 1] = s2 * inv;
}
template <class T> HD void st_moehid(const NaiveBufs& a, int l, long idx) {
  using d = DD<T>; const int j = (int)(idx % d::DE); const int k = (int)((idx / d::DE) % 2); const int r = (int)(idx / (2 * d::DE));
  const int e = a.ridx[2 * r + k]; const float* hr = a.h + (long)r * d::D;
  const float* wg = a.moe_w_gate + (((long)l * d::NE + e) * d::D) * d::DE + j; const float* wu = a.moe_w_up + (((long)l * d::NE + e) * d::D) * d::DE + j;
  float g = 0.f, u = 0.f;
  for (int i = 0; i < d::D; ++i) { const float hv = hr[i]; g += hv * wg[(long)i * d::DE]; u += hv * wu[(long)i * d::DE]; }
  a.hid[idx] = siluf_(g) * u;
}
template <class T> HD void st_moeout(const NaiveBufs& a, int l, int b, long idx) {
  using d = DD<T>; const int dd = (int)(idx % d::D), r = (int)(idx / d::D);
  float acc = 0.f;
  for (int k = 0; k < 2; ++k) { const int e = a.ridx[2 * r + k]; const float* hk = a.hid + ((long)r * 2 + k) * d::DE;
    const float* wd = a.moe_w_down + (((long)l * d::NE + e) * d::DE) * d::D + dd; float s = 0.f;
    for (int j = 0; j < d::DE; ++j) s += hk[j] * wd[(long)j * d::D];
    acc += a.rw[2 * r + k] * s; }
  const float g2 = a.mod[(long)(r < d::S ? b : d::B) * 6 * d::D + 5 * d::D + dd];
  float* xr = xrow_w<T>(a, b, r); xr[dd] += g2 * acc;
}
enum { L_MOD = 0, L_HID_S, L_HID_C, L_TAPS_S, L_TAPS_C, L_NRM_S, L_NRM_C, N_LSTAGES,
       P_RS1 = 16, P_NORM1, P_INPROJ, P_QKNORM, P_ATTN_L, P_ATTN_C, P_GLALA, P_GLASCAN, P_GLAOUT, P_HYC3, P_HYL0, P_HYL1,
       P_MRG_HY, P_MRG_GLA, P_MRG_ATT, P_OUT_L, P_OUT_C, P_RS2, P_NORM2, P_ROUTER, P_MOEHID, P_MOEOUT, P_END };
constexpr int ATT_NSPLIT = 4;

template <class T> HD long stage_items(int st, int l) {
  using d = DD<T>; const bool last = (l == d::DEPTH - 1);
  switch (st) {
    case L_MOD: return (long)(d::B + 1) * 6 * d::D;
    case L_HID_S: return (long)d::S * d::HF;
    case L_HID_C: return (long)d::C * d::HF;
    case L_TAPS_S: return 2L * 2 * d::S * d::HW;
    case L_TAPS_C: return 2L * 2 * d::C * d::HW;
    case L_NRM_S: case L_NRM_C: return 2L * d::HW;
    case P_RS1: case P_RS2: case P_ROUTER: return d::R;
    case P_NORM1: case P_NORM2: return (long)d::R * d::D;
    case P_INPROJ: return (long)(d::R / 4) * (d::NIN / 4);
    case P_QKNORM: return (long)d::R * (d::AH + d::AKV);
    case P_ATTN_L: return (long)d::S * d::AH * ATT_NSPLIT;
    case P_ATTN_C: return last ? 0 : (long)d::C * d::AH * ATT_NSPLIT;
    case P_GLALA: return (long)d::R * 2 * d::GKW;
    case P_GLASCAN: return 2L * d::GH * d::GDV;
    case P_GLAOUT: return (long)d::R * d::GH;
    case P_HYC3: return (long)d::R * 3 * d::HW;
    case P_HYL0: case P_HYL1: return (long)(d::R / 4) * d::HW;
    case P_MRG_HY: case P_MRG_GLA: case P_MRG_ATT: return (long)(d::R / 4) * (d::D / 4);
    case P_OUT_L: return (long)(d::S / 4) * (d::D / 4);
    case P_OUT_C: return last ? 0 : (long)(d::C / 4) * (d::D / 4);
    case P_MOEHID: return (long)d::R * 2 * d::DE;
    case P_MOEOUT: return (long)(last ? d::S : d::R) * d::D;
  }
  return 0;
}

template <class T, int ST> HD void stage_run(const NaiveBufs& a, int l, int b, long idx) {
  using d = DD<T>;
  if constexpr (ST == L_MOD) st_mod<T>(a, l, idx);
  else if constexpr (ST == L_HID_S) st_hyhid<T>(a, l, 0, idx);
  else if constexpr (ST == L_HID_C) st_hyhid<T>(a, l, 1, idx);
  else if constexpr (ST == L_TAPS_S) st_hytaps<T>(a, l, 0, idx);
  else if constexpr (ST == L_TAPS_C) st_hytaps<T>(a, l, 1, idx);
  else if constexpr (ST == L_NRM_S) st_hynorm<T>(a, 0, idx);
  else if constexpr (ST == L_NRM_C) st_hynorm<T>(a, 1, idx);
  else if constexpr (ST == P_RS1) st_rs<T>(a, l, b, 0, idx);
  else if constexpr (ST == P_RS2) st_rs<T>(a, l, b, 1, idx);
  else if constexpr (ST == P_NORM1) st_norm<T>(a, l, b, 0, idx);
  else if constexpr (ST == P_NORM2) st_norm<T>(a, l, b, 1, idx);
  else if constexpr (ST == P_INPROJ) { GemmArgs g{a.h, d::D, a.w_in + (long)l * d::D * d::NIN, d::NIN, a.proj, d::NIN, d::R, d::NIN, d::D, nullptr, 0, nullptr, nullptr, 0, 0}; st_gemm(g, idx); }
  else if constexpr (ST == P_QKNORM) st_qknorm<T>(a, l, idx);
  else if constexpr (ST == P_ATTN_L) st_attn<T, ATT_NSPLIT>(a, 0, d::S, idx);
  else if constexpr (ST == P_ATTN_C) st_attn<T, ATT_NSPLIT>(a, d::S, d::C, idx);
  else if constexpr (ST == P_GLALA) st_glala<T>(a, l, idx);
  else if constexpr (ST == P_GLASCAN) st_glascan<T>(a, idx);
  else if constexpr (ST == P_GLAOUT) st_glaout<T>(a, l, idx);
  else if constexpr (ST == P_HYC3) st_hyconv3<T>(a, l, idx);
  else if constexpr (ST == P_HYL0) st_hylong<T>(a, l, 0, idx);
  else if constexpr (ST == P_HYL1) st_hylong<T>(a, l, 1, idx);
  else if constexpr (ST == P_MRG_HY) { GemmArgs g{a.yhy, d::HW, a.w_br_hy + (long)l * d::HW * d::D, d::D, a.m, d::D, d::R, d::D, d::HW, a.proj + d::O_BR, d::NIN, nullptr, nullptr, 0, 0}; st_gemm(g, idx); }
  else if constexpr (ST == P_MRG_GLA) { GemmArgs g{a.ygla, d::GVW, a.w_br_gla + (long)l * d::GVW * d::D, d::D, a.m, d::D, d::R, d::D, d::GVW, a.proj + d::O_BR + d::D, d::NIN, nullptr, nullptr, 0, 1}; st_gemm(g, idx); }
  else if constexpr (ST == P_MRG_ATT) { GemmArgs g{a.yatt, d::AQW, a.w_br_att + (long)l * d::AQW * d::D, d::D, a.m, d::D, d::R, d::D, d::AQW, a.proj + d::O_BR + 2 * d::D, d::NIN, nullptr, nullptr, 0, 1}; st_gemm(g, idx); }
  else if constexpr (ST == P_OUT_L) { const float* res = (l == 0 ? a.x : (const float*)a.out) + (long)b * d::S * d::D;
    GemmArgs g{a.m, d::D, a.w_out + (long)l * d::D * d::D, d::D, a.out + (long)b * d::S * d::D, d::D, d::S, d::D, d::D, nullptr, 0, a.mod + (long)b * 6 * d::D + 2 * d::D, res, d::D, 0}; st_gemm(g, idx); }
  else if constexpr (ST == P_OUT_C) { const float* res = (l == 0 ? a.ctx : (const float*)a.xc) + (long)b * d::C * d::D;
    GemmArgs g{a.m + (long)d::S * d::D, d::D, a.w_out + (long)l * d::D * d::D, d::D, a.xc + (long)b * d::C * d::D, d::D, d::C, d::D, d::D, nullptr, 0, a.mod + (long)d::B * 6 * d::D + 2 * d::D, res, d::D, 0}; st_gemm(g, idx); }
  else if constexpr (ST == P_ROUTER) st_router<T>(a, idx);
  else if constexpr (ST == P_MOEHID) st_moehid<T>(a, l, idx);
  else if constexpr (ST == P_MOEOUT) st_moeout<T>(a, l, b, idx);
}

template <class T> inline size_t carve(NaiveBufs& a, float* ws) {
  using d = DD<T>; size_t o = 0; auto take = [&](size_t n) { float* p = ws ? ws + o : nullptr; o += (n + 63) & ~(size_t)63; return p; };
  a.mod = take((size_t)(d::B + 1) * 6 * d::D);
  a.hid2S = take((size_t)d::S * d::HF); a.hid2C = take((size_t)d::C * d::HF);
  a.tapsS = take((size_t)2 * 2 * d::S * d::HW); a.tapsC = take((size_t)2 * 2 * d::C * d::HW);
  a.nrmS = take(2 * d::HW); a.nrmC = take(2 * d::HW);
  a.rs = take(d::R); a.h = take((size_t)d::R * d::D); a.proj = take((size_t)d::R * d::NIN);
  a.qn = take((size_t)d::R * d::AQW); a.kn = take((size_t)d::R * d::AKVW);
  a.uc = take((size_t)d::R * 3 * d::HW); a.z1 = take((size_t)d::R * d::HW); a.yhy = take((size_t)d::R * d::HW);
  a.xc = take((size_t)d::B * d::C * d::D);
#ifdef HOST_TEST
  a.yatt = take((size_t)d::R * d::AQW); a.laf = take((size_t)d::R * d::GKW); a.lab = take((size_t)d::R * d::GKW);
  a.of = take((size_t)d::R * d::GVW); a.ob = take((size_t)d::R * d::GVW); a.ygla = take((size_t)d::R * d::GVW);
  a.m = take((size_t)d::R * d::D); a.ridx = (int*)take((size_t)d::R * 2); a.rw = take((size_t)d::R * 2); a.hid = take((size_t)d::R * 2 * d::DE);
#endif
  return o;
}
template <class T> inline void set_inputs(NaiveBufs& a, const float* const* in) {
  int i = 0;
  a.x = in[i++]; a.c = in[i++]; a.ctx = in[i++]; a.c_ctx = in[i++]; a.w_mod = in[i++]; a.b_mod = in[i++]; a.norm1_g = in[i++]; a.norm2_g = in[i++];
  a.w_in = in[i++]; a.q_norm_g = in[i++]; a.k_norm_g = in[i++]; a.gla_wa2 = in[i++]; a.gla_ba = in[i++]; a.gla_norm_g = in[i++];
  a.hy_conv_w = in[i++]; a.hy_conv_b = in[i++]; a.hy_pos_w1 = in[i++]; a.hy_pos_b1 = in[i++]; a.hy_sin_freq = in[i++]; a.hy_pos_w2 = in[i++];
  a.hy_pos_b2 = in[i++]; a.hy_pos_w3 = in[i++]; a.hy_decay = in[i++]; a.hy_skip = in[i++]; a.w_br_hy = in[i++]; a.w_br_gla = in[i++];
  a.w_br_att = in[i++]; a.w_out = in[i++]; a.router_w = in[i++]; a.router_b = in[i++]; a.moe_w_gate = in[i++]; a.moe_w_up = in[i++]; a.moe_w_down = in[i++];
}

#define LSTAGES(X) X(L_MOD) X(L_HID_S) X(L_HID_C) X(L_TAPS_S) X(L_TAPS_C) X(L_NRM_S) X(L_NRM_C)
#define PSTAGES(X) X(P_RS1) X(P_NORM1) X(P_INPROJ) X(P_QKNORM) X(P_ATTN_L) X(P_ATTN_C) X(P_GLALA) X(P_GLASCAN) X(P_GLAOUT) X(P_HYC3) X(P_HYL0) X(P_HYL1) \
  X(P_MRG_HY) X(P_MRG_GLA) X(P_MRG_ATT) X(P_OUT_L) X(P_OUT_C) X(P_RS2) X(P_NORM2) X(P_ROUTER) X(P_MOEHID) X(P_MOEOUT)
namespace pro {
__device__ __forceinline__ void mod_phase(const NaiveBufs& a, int l, LAS unsigned char* lds) {
  int tz = threadIdx.x; asm volatile("" : "+v"(tz));
  __syncthreads();
  LAS float* sl = (LAS float*)lds; LAS float* part = sl + 9 * 1024;
  for (int e = tz; e < 9 * 1024; e += NTHREADS) { const int bb = e >> 10, k = e & 1023; const float cv = bb < 8 ? a.c[bb * 1024 + k] : a.c_ctx[k]; sl[e] = cv / (1.f + __expf(-cv)); }
  __syncthreads();
  const float* w = a.w_mod + (size_t)l * 1024 * 6144;
  const int jl = tz & 63, ks = tz >> 6;
  for (int cb = blockIdx.x; cb < 96; cb += gridDim.x) { const int j = cb * 64 + jl; float acc[9];
#pragma unroll
    for (int q = 0; q < 9; ++q) acc[q] = 0.f;
#pragma unroll 4
    for (int k = ks * 128; k < ks * 128 + 128; ++k) { const float wv = w[(size_t)k * 6144 + j];
#pragma unroll
      for (int q = 0; q < 9; ++q) acc[q] += sl[q * 1024 + k] * wv; }
#pragma unroll
    for (int q = 0; q < 9; ++q) part[(ks * 9 + q) * 64 + jl] = acc[q];
    __syncthreads();
    for (int e = tz; e < 9 * 64; e += NTHREADS) { const int q = e >> 6, jj = e & 63; float s = a.b_mod[(size_t)l * 6144 + cb * 64 + jj];
#pragma unroll
      for (int k8 = 0; k8 < 8; ++k8) s += part[(k8 * 9 + q) * 64 + jj];
      a.mod[(size_t)q * 6144 + cb * 64 + jj] = s; }
    __syncthreads(); }
  __syncthreads();
}
__device__ __forceinline__ void hid_phase(const NaiveBufs& a, int l, int n, float* dst, LAS unsigned char* lds) {
  int tz = threadIdx.x; asm volatile("" : "+v"(tz));
  LAS float* Z = (LAS float*)(lds + 40960); LAS float* H1 = Z + 8 * 36;
  const float* w1 = a.hy_pos_w1 + (size_t)l * 33 * 64; const float* b1 = a.hy_pos_b1 + l * 64; const float* fr = a.hy_sin_freq + l * 64;
  const float* w2 = a.hy_pos_w2 + (size_t)l * 64 * 64; const float* b2 = a.hy_pos_b2 + l * 64;
  const float w0 = 2.f * 3.14159265358979323846f / (float)n;
  for (int t0 = blockIdx.x * 8; t0 < n; t0 += gridDim.x * 8) {
    if (tz < 8 * 33) { const int tt = tz / 33, e = tz % 33, t = t0 + tt; float v;
      if (e == 0) v = (float)t / (float)n; else { const int bnd = (e - 1) & 15; const float band = 1e-4f + (float)bnd * (15.f - 1e-4f) / 15.f; const float ph = w0 * (float)t * band; v = e <= 16 ? cosf(ph) : -sinf(ph); }
      Z[tt * 36 + e] = v; }
    __syncthreads();
    { const int tt = tz >> 6, i = tz & 63; float acc = b1[i];
#pragma unroll
      for (int e = 0; e < 33; ++e) acc += Z[tt * 36 + e] * w1[e * 64 + i];
      H1[tt * 64 + i] = sinf(fr[i] * acc); }
    __syncthreads();
    { const int tt = tz >> 6, j = tz & 63; float acc = b2[j];
#pragma unroll 8
      for (int i = 0; i < 64; ++i) acc += H1[tt * 64 + i] * w2[i * 64 + j];
      if (t0 + tt < n) dst[(size_t)(t0 + tt) * 64 + j] = sinf(fr[j] * acc); }
    __syncthreads();
  }
}
__device__ __forceinline__ void nrmS_phase(const NaiveBufs& a) {
  int tz = threadIdx.x; asm volatile("" : "+v"(tz)); const int lane = tz & 63, wave = __builtin_amdgcn_readfirstlane(tz >> 6);
  for (int oc = blockIdx.x * NWAVES + wave; oc < 1024; oc += gridDim.x * NWAVES) { const float* tp = a.tapsS + (size_t)oc * 8192; float s = 0.f;
#pragma unroll 8
    for (int k = lane; k < 8192; k += 64) s += fabsf(tp[k]);
    s = moe::wave_sum(s); if (lane == 0) a.nrmS[oc] = s + 1e-6f; }
}
constexpr int TCOPY = 8232;
__device__ __forceinline__ void tapsB_phase(const NaiveBufs& a, int l, bf16_t* tapsB, LAS unsigned char* lds) {
  int tz = threadIdx.x; asm volatile("" : "+v"(tz));
  const float* w3 = a.hy_pos_w3 + (size_t)l * 64 * 2048; const float* dcy = a.hy_decay + (size_t)l * 2048;
  typedef float f4 __attribute__((ext_vector_type(4)));
  LAS float* W = (LAS float*)lds;
  for (int cp = blockIdx.x; cp < 256; cp += gridDim.x) {
    __syncthreads();
    { const int ch = tz >> 8, e = tz & 255, c = cp + 256 * ch; W[tz] = w3[(size_t)(e >> 2) * 2048 + (e & 3) * 512 + c]; if (tz < 8) W[512 + tz] = fabsf(dcy[(tz & 3) * 512 + cp + 256 * (tz >> 2)]); }
    __syncthreads();
    for (int t = tz; t < 4096; t += NTHREADS) {
      const f4* h2 = (const f4*)(a.hid2S + (size_t)t * 64); f4 acc0 = {0.f, 0.f, 0.f, 0.f}, acc1 = {0.f, 0.f, 0.f, 0.f};
#pragma unroll 4
      for (int j4 = 0; j4 < 16; ++j4) { const f4 h = h2[j4];
#pragma unroll
        for (int e = 0; e < 4; ++e) { acc0 += h[e] * *(const LAS f4*)(W + (4 * j4 + e) * 4); acc1 += h[e] * *(const LAS f4*)(W + 256 + (4 * j4 + e) * 4); } }
      const float tn = (float)t * (1.f / 4096.f);
#pragma unroll
      for (int ch = 0; ch < 2; ++ch)
#pragma unroll
        for (int q = 0; q < 4; ++q) { const int o = q >> 1, dir = q & 1; if (dir == 1 && t == 0) continue; const int c = cp + 256 * ch;
          const bf16_t bv = (bf16_t)f2bf((ch ? acc1[q] : acc0[q]) * __expf(-tn * W[512 + 4 * ch + q]));
          bf16_t* base = tapsB + ((size_t)o * 512 + c) * 2 * TCOPY; const int x0 = dir ? 4096 + t : 4096 - t;
          base[x0] = bv; base[TCOPY + x0 - 1] = bv; } } }
  for (long idx = (long)blockIdx.x * NTHREADS + tz; idx < 1024L * 96; idx += (long)gridDim.x * NTHREADS) { const int oc = (int)(idx / 96), e = (int)(idx % 96); bf16_t* base = tapsB + (size_t)oc * 2 * TCOPY;
    if (e < 40) base[8192 + e] = 0; else if (e < 81) base[TCOPY + 8191 + (e - 40)] = 0; else if (e == 81) base[0] = 0; }
}
__device__ __forceinline__ void nrmB_phase(const NaiveBufs& a, const bf16_t* tapsB) {
  int tz = threadIdx.x; asm volatile("" : "+v"(tz)); const int lane = tz & 63, wave = __builtin_amdgcn_readfirstlane(tz >> 6);
  for (int oc = blockIdx.x * NWAVES + wave; oc < 1024; oc += gridDim.x * NWAVES) { const bf16_t* tp = tapsB + (size_t)oc * 2 * TCOPY; float s = 0.f;
#pragma unroll 8
    for (int k = lane; k < 8192; k += 64) s += fabsf(bf2f(tp[k]));
    s = moe::wave_sum(s); if (lane == 0) a.nrmS[oc] = s + 1e-6f; }
}
}
using TD = FullDims;
using dd = DD<TD>;
constexpr int GB = 4, NGRP = 2, RB = dd::R  , RG = GB * RB, PLD = dd::O_BR + 1536  , PANELS = RG / 256, PPB = RB / 256  ;
constexpr size_t BAR_BYTES = 16384 + 4 * 4096; constexpr int CNT_OFF = 16384;
constexpr int MPG = 38912;
constexpr size_t CS_BYTES = (size_t)2 * 4 * 68 * 64 * 128 * 2, DEC_BYTES = (size_t)2 * 4 * 68 * 64 * 4;
constexpr size_t UCT_BYTES = (size_t)1536 * 4096 * 2, YT_BYTES = (size_t)512 * 4096 * 2, UCC_BYTES = (size_t)256 * 1536 * 4, Z1C_BYTES = (size_t)256 * 512 * 4;
constexpr size_t MIX_BYTES = GB * (CS_BYTES + DEC_BYTES) > GB * (UCT_BYTES + YT_BYTES + UCC_BYTES + Z1C_BYTES) ? GB * (CS_BYTES + DEC_BYTES) : GB * (UCT_BYTES + YT_BYTES + UCC_BYTES + Z1C_BYTES);

struct KArgs { NaiveBufs a; unsigned* bar; int* cnt; bf16_t *xs; bf16_t *WgaT; bf16_t *WinT, *WhyT, *WglaT, *WattT, *WoutT, *WguT, *WdT, *hb, *proj; unsigned char* mix;
  bf16_t *hp, *hid, *contrib; int* srcrow; float* wgt; moe::Route* route; float* wts; };

struct EpiProjBf16 {
  static constexpr bool PERM = true, AFTER_DRAIN = false;
  bf16_t* P;
  __device__ __forceinline__ void operator()(const pg8::f32x4 (&acc)[2][2][4][2], const pg8::Unit& u, int wr, int wc, int fr, int fq) const {
    const int row0 = u.pm * 256 + wr * 64 + fr, col0 = u.pn * 256 + wc * 32 + 8 * fq;
    const int cr0 = col0 + (col0 >= dd::O_GA ? 32 : 0), cr1 = col0 + 128 + (col0 + 128 >= dd::O_GA ? 32 : 0);
    if (u.pn >= (dd::O_BR - 32) / 256) {
      unsigned char* Pg = (unsigned char*)P + (size_t)dd::O_BR * 2 + (col0 - (dd::O_BR - 32));
#pragma unroll
      for (int ai = 0; ai < 2; ++ai)
#pragma unroll
        for (int m = 0; m < 4; ++m) { unsigned char* rowp = Pg + (size_t)(row0 + ai * 128 + m * 16) * (PLD * 2);
#pragma unroll
          for (int bj = 0; bj < 2; ++bj) { const pg8::f32x4 v0 = acc[ai][bj][m][0], v1 = acc[ai][bj][m][1]; uint2 o;
            o.x = (unsigned)(fsigmoid(v0[0]) * 255.f + 0.5f) | ((unsigned)(fsigmoid(v0[1]) * 255.f + 0.5f) << 8) | ((unsigned)(fsigmoid(v0[2]) * 255.f + 0.5f) << 16) | ((unsigned)(fsigmoid(v0[3]) * 255.f + 0.5f) << 24);
            o.y = (unsigned)(fsigmoid(v1[0]) * 255.f + 0.5f) | ((unsigned)(fsigmoid(v1[1]) * 255.f + 0.5f) << 8) | ((unsigned)(fsigmoid(v1[2]) * 255.f + 0.5f) << 16) | ((unsigned)(fsigmoid(v1[3]) * 255.f + 0.5f) << 24);
            *(uint2*)(rowp + bj * 128) = o; } }
      return; }
#pragma unroll
    for (int ai = 0; ai < 2; ++ai)
#pragma unroll
      for (int m = 0; m < 4; ++m) { bf16_t* rowp = P + (size_t)(row0 + ai * 128 + m * 16) * PLD;
#pragma unroll
        for (int bj = 0; bj < 2; ++bj) { const pg8::f32x4 v0 = acc[ai][bj][m][0], v1 = acc[ai][bj][m][1];
          v4u o; o.x = pk2(v0[0], v0[1]); o.y = pk2(v0[2], v0[3]); o.z = pk2(v1[0], v1[1]); o.w = pk2(v1[2], v1[3]); *(v4u*)(rowp + (bj ? cr1 : cr0)) = o; } }
  }
};
template <bool ACCUM> struct EpiMergeB {
  static constexpr bool PERM = true, AFTER_DRAIN = false;
  const bf16_t* gate; bf16_t* M;
  __device__ __forceinline__ void operator()(const pg8::f32x4 (&acc)[2][2][4][2], const pg8::Unit& u, int wr, int wc, int fr, int fq) const {
    const int row0 = u.pm * 256 + wr * 64 + fr, col0 = u.pn * 256 + wc * 32 + 8 * fq;
#pragma unroll
    for (int ai2 = 0; ai2 < 4; ++ai2) { const int ai = ai2 >> 1, m0 = (ai2 & 1) * 2;
      v4u gw[4][2], mo[4][2];
#pragma unroll
      for (int m = m0; m < m0 + 2; ++m)
#pragma unroll
        for (int bj = 0; bj < 2; ++bj) { const size_t r = (size_t)(row0 + ai * 128 + m * 16); const int c = col0 + bj * 128; gw[m][bj] = *(const v4u*)(gate + r * PLD + c); if (ACCUM) mo[m][bj] = *(const v4u*)(M + r * 1024 + c); }
#pragma unroll
      for (int m = m0; m < m0 + 2; ++m)
#pragma unroll
        for (int bj = 0; bj < 2; ++bj) { const size_t r = (size_t)(row0 + ai * 128 + m * 16); const int c = col0 + bj * 128; const v4u g4 = gw[m][bj];
          pg8::f32x4 v0 = acc[ai][bj][m][0], v1 = acc[ai][bj][m][1];
          v0[0] *= fsigmoid(bf2f(g4.x & 0xffff)); v0[1] *= fsigmoid(bf2f(g4.x >> 16)); v0[2] *= fsigmoid(bf2f(g4.y & 0xffff)); v0[3] *= fsigmoid(bf2f(g4.y >> 16));
          v1[0] *= fsigmoid(bf2f(g4.z & 0xffff)); v1[1] *= fsigmoid(bf2f(g4.z >> 16)); v1[2] *= fsigmoid(bf2f(g4.w & 0xffff)); v1[3] *= fsigmoid(bf2f(g4.w >> 16));
          if (ACCUM) { const v4u o = mo[m][bj]; v0[0] += bf2f(o.x & 0xffff); v0[1] += bf2f(o.x >> 16); v0[2] += bf2f(o.y & 0xffff); v0[3] += bf2f(o.y >> 16);
            v1[0] += bf2f(o.z & 0xffff); v1[1] += bf2f(o.z >> 16); v1[2] += bf2f(o.w & 0xffff); v1[3] += bf2f(o.w >> 16); }
          v4u o2; o2.x = pk2(v0[0], v0[1]); o2.y = pk2(v0[2], v0[3]); o2.z = pk2(v1[0], v1[1]); o2.w = pk2(v1[2], v1[3]); *(v4u*)(M + r * 1024 + c) = o2; } }
  }
};
struct EpiOutG {
  static constexpr bool PERM = true, AFTER_DRAIN = false;
  const float* resL; const float* resC; bf16_t* xs; const float* mod; int b0; bool ctx_on, resbf;
  __device__ __forceinline__ void operator()(const pg8::f32x4 (&acc)[2][2][4][2], const pg8::Unit& u, int wr, int wc, int fr, int fq) const {
    const int bl = u.pm / PPB, lp = u.pm % PPB; const bool isc = lp == PPB - 1; if (isc && !ctx_on) return;
    const int b = b0 + bl;
    const float* res = isc ? resC + (size_t)b * dd::C * 1024 : resL + ((size_t)b * dd::S + lp * 256) * 1024;
    bf16_t* out = xs + (size_t)u.pm * 256 * 1024;
    const float* gv = mod + (size_t)(isc ? dd::B : b) * 6 * 1024 + 2 * 1024;
    int row0 = wr * 64 + fr, col0 = u.pn * 256 + wc * 32 + 8 * fq; asm volatile("" : "+v"(row0), "+v"(col0));
    pg8::f32x4 gg[2][2];
#pragma unroll
    for (int bj = 0; bj < 2; ++bj)
#pragma unroll
      for (int n = 0; n < 2; ++n) gg[bj][n] = *(const pg8::f32x4*)(gv + col0 + bj * 128 + n * 4);
    if (resbf) {
#pragma unroll
      for (int ai2 = 0; ai2 < 4; ++ai2) { const int ai = ai2 >> 1, m0 = (ai2 & 1) * 2; v4u rb[4][2];
#pragma unroll
        for (int m = m0; m < m0 + 2; ++m)
#pragma unroll
          for (int bj = 0; bj < 2; ++bj) rb[m][bj] = *(const v4u*)(out + (size_t)(row0 + ai * 128 + m * 16) * 1024 + col0 + bj * 128);
#pragma unroll
        for (int m = m0; m < m0 + 2; ++m)
#pragma unroll
          for (int bj = 0; bj < 2; ++bj) { const v4u o = rb[m][bj]; const pg8::f32x4 v0 = gg[bj][0] * acc[ai][bj][m][0], v1 = gg[bj][1] * acc[ai][bj][m][1]; v4u w;
            w.x = pk2(v0[0] + __uint_as_float(o.x << 16), v0[1] + __uint_as_float(o.x & 0xffff0000u)); w.y = pk2(v0[2] + __uint_as_float(o.y << 16), v0[3] + __uint_as_float(o.y & 0xffff0000u));
            w.z = pk2(v1[0] + __uint_as_float(o.z << 16), v1[1] + __uint_as_float(o.z & 0xffff0000u)); w.w = pk2(v1[2] + __uint_as_float(o.w << 16), v1[3] + __uint_as_float(o.w & 0xffff0000u));
            *(v4u*)(out + (size_t)(row0 + ai * 128 + m * 16) * 1024 + col0 + bj * 128) = w; } }
    } else {
#pragma unroll
      for (int ai2 = 0; ai2 < 4; ++ai2) { const int ai = ai2 >> 1, m0 = (ai2 & 1) * 2;
        pg8::f32x4 rv[4][2][2];
#pragma unroll
        for (int m = m0; m < m0 + 2; ++m)
#pragma unroll
          for (int bj = 0; bj < 2; ++bj)
#pragma unroll
            for (int n = 0; n < 2; ++n) rv[m][bj][n] = *(const pg8::f32x4*)(res + (size_t)(row0 + ai * 128 + m * 16) * 1024 + col0 + bj * 128 + n * 4);
#pragma unroll
        for (int m = m0; m < m0 + 2; ++m)
#pragma unroll
          for (int bj = 0; bj < 2; ++bj) { const pg8::f32x4 v0 = rv[m][bj][0] + gg[bj][0] * acc[ai][bj][m][0], v1 = rv[m][bj][1] + gg[bj][1] * acc[ai][bj][m][1];
            v4u w; w.x = pk2(v0[0], v0[1]); w.y = pk2(v0[2], v0[3]); w.z = pk2(v1[0], v1[1]); w.w = pk2(v1[2], v1[3]);
            *(v4u*)(out + (size_t)(row0 + ai * 128 + m * 16) * 1024 + col0 + bj * 128) = w; } }
    }
  }
};
struct GroupOrder {
  int nN, nwg, G, c; bool lat;
  __device__ void init(int N, int G_, int c_, bool lat_) { nN = N / 256; lat = lat_; nwg = (lat ? GB * 16 : PANELS) * nN; G = G_; c = c_; }
  __device__ __forceinline__ bool next(int i, pg8::Unit& u) const { const long L = (long)i * G + c; if (L >= nwg) return false; const int p = (int)L / nN; u.pm = lat ? (p >> 4) * PPB + (p & 15) : p; u.pn = (int)L % nN; u.acol = 0; u.nt = 0; return true; }
  __device__ __forceinline__ void a_ready(const pg8::Unit&) const {}
  __device__ __forceinline__ void done(const pg8::Unit&) const {}
};
struct MergeOrder {
  int ntiles, G, c; bool lat;
  __device__ void init(int G_, int c_, bool lat_) { lat = lat_; ntiles = (lat ? GB * 16 : PANELS) * 4; G = G_; c = c_; }
  __device__ __forceinline__ bool next(int i, pg8::Unit& u) const { const int rnd = i / 3, gi = i - 3 * rnd; const long tile = (long)rnd * G + c; if (tile >= ntiles) return false; const int p = (int)tile >> 2;
    u.pm = lat ? (p >> 4) * PPB + (p & 15) : p; u.pn = gi * 4 + ((int)tile & 3); u.acol = gi == 0 ? dd::O_HY : gi == 1 ? dd::O_OG : dd::O_AQ; u.nt = gi == 2 ? 16 : 8; return true; }
  __device__ __forceinline__ void a_ready(const pg8::Unit&) const {}
  __device__ __forceinline__ void done(const pg8::Unit&) const {}
};
struct EpiMergeS {
  static constexpr bool PERM = true, AFTER_DRAIN = false;
  const unsigned char* gate0; bf16_t* M;
  __device__ __forceinline__ void operator()(const pg8::f32x4 (&acc)[2][2][4][2], const pg8::Unit& u, int wr, int wc, int fr, int fq) const {
    const int gi = u.pn >> 2; const bool accum = gi > 0; const unsigned char* gate = gate0 + gi * 1024;
    const int row0 = u.pm * 256 + wr * 64 + fr, col0 = (u.pn & 3) * 256 + wc * 32 + 8 * fq;
#pragma unroll
    for (int ai2 = 0; ai2 < 4; ++ai2) { const int ai = ai2 >> 1, m0 = (ai2 & 1) * 2;
      uint2 gw[4][2]; v4u mo[4][2];
#pragma unroll
      for (int m = m0; m < m0 + 2; ++m)
#pragma unroll
        for (int bj = 0; bj < 2; ++bj) { const size_t r = (size_t)(row0 + ai * 128 + m * 16); const int c = col0 + bj * 128; gw[m][bj] = *(const uint2*)(gate + r * (PLD * 2) + c); mo[m][bj] = (v4u){0u, 0u, 0u, 0u}; if (accum) mo[m][bj] = *(const v4u*)(M + r * 1024 + c); }
#pragma unroll
      for (int m = m0; m < m0 + 2; ++m)
#pragma unroll
        for (int bj = 0; bj < 2; ++bj) { const size_t r = (size_t)(row0 + ai * 128 + m * 16); const int c = col0 + bj * 128; const uint2 g2 = gw[m][bj]; constexpr float q = 1.f / 255.f;
          pg8::f32x4 v0 = acc[ai][bj][m][0], v1 = acc[ai][bj][m][1];
          v0[0] *= (float)(g2.x & 255u) * q; v0[1] *= (float)((g2.x >> 8) & 255u) * q; v0[2] *= (float)((g2.x >> 16) & 255u) * q; v0[3] *= (float)(g2.x >> 24) * q;
          v1[0] *= (float)(g2.y & 255u) * q; v1[1] *= (float)((g2.y >> 8) & 255u) * q; v1[2] *= (float)((g2.y >> 16) & 255u) * q; v1[3] *= (float)(g2.y >> 24) * q;
          { const v4u o = mo[m][bj]; v0[0] += bf2f(o.x & 0xffff); v0[1] += bf2f(o.x >> 16); v0[2] += bf2f(o.y & 0xffff); v0[3] += bf2f(o.y >> 16);
            v1[0] += bf2f(o.z & 0xffff); v1[1] += bf2f(o.z >> 16); v1[2] += bf2f(o.w & 0xffff); v1[3] += bf2f(o.w >> 16); }
          v4u o2; o2.x = pk2(v0[0], v0[1]); o2.y = pk2(v0[2], v0[3]); o2.z = pk2(v1[0], v1[1]); o2.w = pk2(v1[2], v1[3]); *(v4u*)(M + r * 1024 + c) = o2; } }
  }
};
__device__ __forceinline__ const float* xrow_in(const NaiveBufs& a, int l, int b, int r) {
  if (r < dd::S) return (l == 0 ? a.x : (const float*)a.out) + ((size_t)b * dd::S + r) * 1024;
  return (l == 0 ? a.ctx : (const float*)a.xc) + ((size_t)b * dd::C + (r - dd::S)) * 1024;
}
__device__ __forceinline__ float* xrow_cur(const NaiveBufs& a, int b, int r) {
  if (r < dd::S) return a.out + ((size_t)b * dd::S + r) * 1024;
  return a.xc + ((size_t)b * dd::C + (r - dd::S)) * 1024;
}
template <bool BF> __device__ __forceinline__ void norm_row(const void* xr, const float* gnorm, const float* shift, const float* scale, bf16_t* hrow, int lane) {
  typedef float f4 __attribute__((ext_vector_type(4)));
  f4 xv[4]; float ss = 0.f;
#pragma unroll
  for (int j = 0; j < 4; ++j) {
    if (BF) { const uint2 rw = *(const uint2*)((const bf16_t*)xr + 4 * lane + 256 * j); xv[j][0] = __uint_as_float(rw.x << 16); xv[j][1] = __uint_as_float(rw.x & 0xffff0000u); xv[j][2] = __uint_as_float(rw.y << 16); xv[j][3] = __uint_as_float(rw.y & 0xffff0000u); }
    else xv[j] = *(const f4*)((const float*)xr + 4 * lane + 256 * j);
    ss += xv[j][0] * xv[j][0] + xv[j][1] * xv[j][1] + xv[j][2] * xv[j][2] + xv[j][3] * xv[j][3]; }
  const float rs = __builtin_amdgcn_rsqf(moe::wave_sum(ss) * (1.f / 1024.f) + 1e-6f);
#pragma unroll
  for (int j = 0; j < 4; ++j) { const int c = 4 * lane + 256 * j; const f4 g4 = *(const f4*)(gnorm + c), sh = *(const f4*)(shift + c), sc = *(const f4*)(scale + c);
    f4 h;
#pragma unroll
    for (int i = 0; i < 4; ++i) h[i] = xv[j][i] * rs * g4[i] * (1.f + sc[i]) + sh[i];
    *(unsigned long long*)(hrow + c) = (unsigned long long)pk2h(h[0], h[1]) | ((unsigned long long)pk2h(h[2], h[3]) << 32); }
}
__device__ __forceinline__ void qknorm_row(bf16_t* prow, const float* qg, const float* kg, int r, int lane) {
  const bool lat = r < dd::S; const int grow = r / dd::GW, gcol = r % dd::GW;
  const int fi = lane & 31; const float pos = (lane < 32) ? (float)grow : (float)gcol;
  const float ang = pos * __builtin_amdgcn_exp2f(-(float)fi * (13.287712379549449f / 32.f));
  const float cs = lat ? __cosf(ang) : 1.f, sn = lat ? __sinf(ang) : 0.f;
  unsigned wv[10];
#pragma unroll
  for (int hh = 0; hh < 10; ++hh) wv[hh] = *((const unsigned*)(prow + (hh < 8 ? dd::O_AQ + hh * 128 : dd::O_AK + (hh - 8) * 128)) + lane);
  float ss[10];
#pragma unroll
  for (int hh = 0; hh < 10; ++hh) { const float x1 = bf2f(wv[hh] & 0xffff), x2 = bf2f(wv[hh] >> 16); ss[hh] = x1 * x1 + x2 * x2; }
#pragma unroll
  for (int o = 1; o < 64; o <<= 1) {
#pragma unroll
    for (int hh = 0; hh < 10; ++hh) ss[hh] += __shfl_xor(ss[hh], o); }
  const float q1 = qg[2 * lane], q2 = qg[2 * lane + 1], k1 = kg[2 * lane], k2 = kg[2 * lane + 1];
#pragma unroll
  for (int hh = 0; hh < 10; ++hh) { unsigned* p = (unsigned*)(prow + (hh < 8 ? dd::O_AQ + hh * 128 : dd::O_AK + (hh - 8) * 128)) + lane;
    const float x1 = bf2f(wv[hh] & 0xffff), x2 = bf2f(wv[hh] >> 16); const float rs = __builtin_amdgcn_rsqf(ss[hh] * (1.f / 128.f) + 1e-6f);
    const float y1 = x1 * rs * (hh < 8 ? q1 : k1), y2 = x2 * rs * (hh < 8 ? q2 : k2);
    *p = pk2h(y1 * cs - y2 * sn, y1 * sn + y2 * cs); }
}

__device__ __forceinline__ void ga_task(const bf16_t* hb, const bf16_t* WgaT, bf16_t* proj, int wt) {
  int tid = threadIdx.x; asm volatile("" : "+v"(tid));
  const int lane = tid & 63, li = lane & 31, lk = lane >> 5; typedef short b8 __attribute__((ext_vector_type(8))); typedef float f16v __attribute__((ext_vector_type(16)));
  const bf16_t* ap = hb + ((size_t)wt * 32 + li) * 1024 + 8 * lk; const bf16_t* bp = WgaT + (size_t)li * 1024 + 8 * lk;
  f16v acc = {};
  for (int k8 = 0; k8 < 8; ++k8) { v4u av[8], bv[8];
#pragma unroll
    for (int j = 0; j < 8; ++j) { av[j] = *(const v4u*)(ap + 128 * k8 + 16 * j); bv[j] = *(const v4u*)(bp + 128 * k8 + 16 * j); }
#pragma unroll
    for (int j = 0; j < 8; ++j) acc = __builtin_amdgcn_mfma_f32_32x32x16_bf16(__builtin_bit_cast(b8, av[j]), __builtin_bit_cast(b8, bv[j]), acc, 0, 0, 0); }
#pragma unroll
  for (int r = 0; r < 16; ++r) { const int row = wt * 32 + (r & 3) + 8 * (r >> 2) + 4 * lk; proj[(size_t)row * PLD + dd::O_GA + li] = (bf16_t)f2bf(acc[r]); }
}

__global__ void __launch_bounds__(NTHREADS, 2) mega_kernel(KArgs ka_unused) {
  extern __shared__ __attribute__((aligned(16))) unsigned char lds_raw[];
  LAS unsigned char* lds = (LAS unsigned char*)lds_raw;
  volatile LAS unsigned* MISC = (volatile LAS unsigned*)(lds + MISC_OFF);
  constexpr int ARGS_OFF = MISC_OFF + 256;
  static_assert(ARGS_OFF + sizeof(KArgs) <= LDS_BYTES, "LDS map");
  { const unsigned __attribute__((address_space(4)))* kp = (const unsigned __attribute__((address_space(4)))*)__builtin_amdgcn_kernarg_segment_ptr();
    for (int i = threadIdx.x; i < (int)(sizeof(KArgs) / 4); i += NTHREADS) ((LAS unsigned*)(lds + ARGS_OFF))[i] = kp[i]; }
  if (threadIdx.x < 64) MISC[threadIdx.x] = 0u;
  __syncthreads();
  const KArgs& ka = *(const KArgs*)(const LAS KArgs*)(lds + ARGS_OFF);
  const NaiveBufs& a = ka.a;
  unsigned* bar_s; { const unsigned long long bp = (unsigned long long)ka.bar; const unsigned lo_ = __builtin_amdgcn_readfirstlane((unsigned)bp), hi_ = __builtin_amdgcn_readfirstlane((unsigned)(bp >> 32));
    bar_s = (unsigned*)(((unsigned long long)hi_ << 32) | lo_); }
  XcdBarrier xb = xcd_barrier_post(bar_s, MISC);
#define SPTR(T, name, src) T* name; { const unsigned long long bp_ = (unsigned long long)(src); const unsigned lo_ = __builtin_amdgcn_readfirstlane((unsigned)bp_), hi_ = __builtin_amdgcn_readfirstlane((unsigned)(bp_ >> 32)); name = (T*)(((unsigned long long)hi_ << 32) | lo_); }
  SPTR(bf16_t, proj_s, ka.proj) SPTR(bf16_t, hb_s, ka.hb) SPTR(unsigned char, mix_s, ka.mix)
  const long gs = (long)gridDim.x * NTHREADS;
  LAS int* poff = (LAS int*)(lds + MISC_OFF + 64);
#define TID_SETUP int tz = threadIdx.x; asm volatile("" : "+v"(tz)); const int lane = tz & 63, wave = __builtin_amdgcn_readfirstlane(tz >> 6); \
    const int gw = blockIdx.x * NWAVES + wave, NGW = gridDim.x * NWAVES; const long gt = (long)blockIdx.x * NTHREADS + tz; (void)lane; (void)gw; (void)NGW; (void)gt;
#define LSTAGE(ST) { TID_SETUP const long n_ = stage_items<TD>(ST, l); for (long i_ = gt; i_ < n_; i_ += gs) stage_run<TD, ST>(a, l, 0, i_); }
  for (int l = 0; l < dd::DEPTH; ++l) {
    const bool last = (l == dd::DEPTH - 1);
    { TID_SETUP
      LAS float* scr = (LAS float*)(lds + RING_OFF + wave * 16384);
      constexpr int NIT = (dd::D / 64) * (dd::NIN / 32);
      for (int it = gw; it < NIT; it += NGW) { const int n0 = 32 * (it % (dd::NIN / 32));
        if (n0 == dd::O_GA) transpose_item(a.w_in + (size_t)l * dd::D * dd::NIN, dd::D, dd::NIN, ka.WgaT, -dd::O_GA, scr, it, lane);
        else transpose_item(a.w_in + (size_t)l * dd::D * dd::NIN, dd::D, dd::NIN, ka.WinT, n0 < dd::O_GA ? 0 : -32, scr, it, lane); }
      { constexpr int I0 = (dd::HW / 64) * (dd::D / 32), I1 = (dd::GVW / 64) * (dd::D / 32), I2 = (dd::AQW / 64) * (dd::D / 32), I3 = (dd::D / 64) * (dd::D / 32);
        for (int it = gw; it < I0 + I1 + I2 + I3; it += NGW) { int r = it;
          if (r < I0) { transpose_item(a.w_br_hy + (size_t)l * dd::HW * dd::D, dd::HW, dd::D, ka.WhyT, 0, scr, r, lane, 1024); continue; } r -= I0;
          if (r < I1) { transpose_item(a.w_br_gla + (size_t)l * dd::GVW * dd::D, dd::GVW, dd::D, ka.WglaT, 0, scr, r, lane, 1024); continue; } r -= I1;
          if (r < I2) { transpose_item(a.w_br_att + (size_t)l * dd::AQW * dd::D, dd::AQW, dd::D, ka.WattT, 0, scr, r, lane); continue; } r -= I2;
          transpose_item(a.w_out + (size_t)l * dd::D * dd::D, dd::D, dd::D, ka.WoutT, 0, scr, r, lane); } }
      { constexpr int IG = (dd::D / 64) * (dd::DE / 32), IDN = (dd::DE / 64) * (dd::D / 32);
        for (int it = gw; it < dd::NE * (2 * IG + IDN); it += NGW) { const int e = it / (2 * IG + IDN); int r = it % (2 * IG + IDN);
          if (r < 2 * IG) { const int up = r >= IG; if (up) r -= IG; const int n0 = 32 * (r % (dd::DE / 32));
            transpose_item((up ? a.moe_w_up : a.moe_w_gate) + ((size_t)l * dd::NE + e) * dd::D * dd::DE, dd::D, dd::DE, ka.WguT, e * 1024 + 128 * (n0 >> 7) + (up ? 128 : 0), scr, r, lane); }
          else { r -= 2 * IG; transpose_item(a.moe_w_down + ((size_t)l * dd::NE + e) * dd::DE * dd::D, dd::DE, dd::D, ka.WdT, e * 1024, scr, r, lane); } } }
      (void)gt;
    }
    pro::mod_phase(a, l, lds); pro::hid_phase(a, l, dd::S, a.hid2S, lds); if (!last) pro::hid_phase(a, l, dd::C, a.hid2C, lds);
    xcd_barrier(xb);
    pro::tapsB_phase(a, l, (bf16_t*)a.tapsS, lds); if (!last) LSTAGE(L_TAPS_C)
    xcd_barrier(xb);
    pro::nrmB_phase(a, (const bf16_t*)a.tapsS); if (!last) LSTAGE(L_NRM_C)
    xcd_barrier(xb);
    for (int grp = 0; grp < NGRP; ++grp) {
      const int b0 = grp * GB;
      { TID_SETUP
        for (int rg = gw; rg < RG; rg += NGW) { const int bl = rg / RB, r = rg % RB, b = b0 + bl; const float* md = a.mod + (size_t)(r < dd::S ? b : dd::B) * 6 * 1024;
          if (l == 0) norm_row<false>(xrow_in(a, 0, b, r), a.norm1_g, md, md + 1024, hb_s + (size_t)rg * 1024, lane);
          else norm_row<true>(ka.xs + ((size_t)grp * RG + rg) * 1024, a.norm1_g + (size_t)l * 1024, md, md + 1024, hb_s + (size_t)rg * 1024, lane); }
        xcd_barrier(xb); }
      { pg8::Gemm g{hb_s, ka.WinT, RG, NINP, dd::D, 0}; pg8::StaticOrder S; S.init(RG, NINP, (int)gridDim.x, (int)blockIdx.x); EpiProjBf16 E{proj_s};
        pg8::gemm_phase<EpiProjBf16, pg8::StaticOrder, false>((PG8_LAS unsigned char*)(lds + RING_OFF), g, S, E, nullptr);
        { int tq = threadIdx.x; asm volatile("" : "+v"(tq)); const int wv_ = __builtin_amdgcn_readfirstlane(tq >> 6);
          for (int wt = (int)blockIdx.x + (int)gridDim.x * wv_; wt < PANELS * 8; wt += (int)gridDim.x * NWAVES) ga_task(hb_s, ka.WgaT, proj_s, wt); }
        xcd_barrier(xb); }
      { TID_SETUP
        for (int rg = gw; rg < RG; rg += NGW) qknorm_row(proj_s + (size_t)rg * PLD, a.q_norm_g + (size_t)l * 128, a.k_norm_g + (size_t)l * 128, rg % RB, lane);
        for (int u = blockIdx.x; u < GB * 4 * 68; u += gridDim.x) { const int bl = u / (4 * 68), hu = u % (4 * 68); const bf16_t* pb = proj_s + (size_t)bl * RB * PLD;
          gla::In gp; gp.q = pb + dd::O_GQ; gp.k = pb + dd::O_GK; gp.v = pb + dd::O_GV; gp.ga = pb + dd::O_GA; gp.og = pb + dd::O_OG; gp.ld = PLD;
          gp.wa2 = a.gla_wa2 + (size_t)l * 2 * 16 * 256; gp.ba = a.gla_ba + (size_t)l * 2 * 256; gp.gnorm = a.gla_norm_g + (size_t)l * 128;
          gp.csb = (bf16_t*)(mix_s + (size_t)bl * CS_BYTES); gp.dec = (float*)(mix_s + (size_t)GB * CS_BYTES + (size_t)bl * DEC_BYTES); gp.y = (bf16_t*)pb + dd::O_OG; gp.ldy = PLD; gp.S = dd::S; gp.C = dd::C;
          gla::g1b_unit(gp, lds, hu / 68, hu % 68, 4, 68); }
        xcd_barrier(xb); }
      { TID_SETUP
        for (long i_ = gt; i_ < (long)GB * 2 * 4 * 64 * 64; i_ += gs) { const int bl = (int)(i_ / (2 * 4 * 64 * 64)); gla::In gp; gp.csb = (bf16_t*)(mix_s + (size_t)bl * CS_BYTES); gp.dec = (float*)(mix_s + (size_t)GB * CS_BYTES + (size_t)bl * DEC_BYTES); gp.S = dd::S; gp.C = dd::C;
          gla::g2_item(gp, i_ % (2 * 4 * 64 * 64), 4, 68); }
        const int combo = blockIdx.x & 7, slot = blockIdx.x >> 3, nslot = gridDim.x >> 3;
        const int per_combo = 64 + (last ? 0 : 4);
        const bool xcdm = (gridDim.x & 7) == 0;
        for (int uu = xcdm ? slot : (int)blockIdx.x; uu < (xcdm ? per_combo : 8 * per_combo); uu += xcdm ? nslot : (int)gridDim.x) { const int cmb = xcdm ? combo : uu / per_combo, ui = xcdm ? uu : uu % per_combo;
          const bool lat = ui < 64; const int bl = cmb >> 1, kvh = cmb & 1;
          const int head = kvh * 4 + (lat ? ui >> 4 : ui - 64), qb = lat ? ui & 15 : 0;
          bf16_t* pb = proj_s + (size_t)bl * RB * PLD; const size_t qrow = lat ? (size_t)qb * 256 : (size_t)dd::S, krow = lat ? 0 : (size_t)dd::S;
          att::attn_dense_body<att::bf16, PLD, PLD, PLD, true>((const att::bf16*)(pb + qrow * PLD + dd::O_AQ + head * 128), (const att::bf16*)(pb + krow * PLD + dd::O_AK + kvh * 128),
              (const att::bf16*)(pb + krow * PLD + dd::O_AV + kvh * 128), pb + qrow * PLD + dd::O_AQ + head * 128, lat ? RB : dd::C, (char*)lds_raw);
          __syncthreads(); }
        xcd_barrier(xb); }
      { const int n3 = last ? 64 : 68;
        for (int u = blockIdx.x; u < GB * 4 * n3; u += gridDim.x) { const int bl = u / (4 * n3), hu = u % (4 * n3); const bf16_t* pb = proj_s + (size_t)bl * RB * PLD;
          gla::In gp; gp.q = pb + dd::O_GQ; gp.k = pb + dd::O_GK; gp.v = pb + dd::O_GV; gp.ga = pb + dd::O_GA; gp.og = pb + dd::O_OG; gp.ld = PLD;
          gp.wa2 = a.gla_wa2 + (size_t)l * 2 * 16 * 256; gp.ba = a.gla_ba + (size_t)l * 2 * 256; gp.gnorm = a.gla_norm_g + (size_t)l * 128;
          gp.csb = (bf16_t*)(mix_s + (size_t)bl * CS_BYTES); gp.dec = (float*)(mix_s + (size_t)GB * CS_BYTES + (size_t)bl * DEC_BYTES); gp.y = (bf16_t*)pb + dd::O_OG; gp.ldy = PLD; gp.S = dd::S; gp.C = dd::C;
          gla::g3b_unit(gp, lds, hu / n3, hu % n3, 4, 68); }
        xcd_barrier(xb); }
      {
        bf16_t* ucT0 = (bf16_t*)mix_s; bf16_t* yT0 = (bf16_t*)(mix_s + GB * UCT_BYTES); float* ucc0 = (float*)(mix_s + GB * (UCT_BYTES + YT_BYTES)); float* z1c0 = (float*)(mix_s + GB * (UCT_BYTES + YT_BYTES + UCC_BYTES));
        const float* cw = a.hy_conv_w + (size_t)l * 3 * 1536; const float* cb = a.hy_conv_b + (size_t)l * 1536; const float* skp = a.hy_skip + (size_t)l * 2 * 512;
        { TID_SETUP
        { int t_ = blockIdx.x; hy::H0Regs hr = hy::h0_load(proj_s + (size_t)(t_ / (64 * 24)) * RB * PLD + dd::O_HY, PLD, t_ % (64 * 24), tz);
          for (; t_ < GB * 64 * 24; t_ += gridDim.x) { const int bl = t_ / (64 * 24), tn_ = t_ + gridDim.x; hy::H0Regs hn = hr;
            if (tn_ < GB * 64 * 24) hn = hy::h0_load(proj_s + (size_t)(tn_ / (64 * 24)) * RB * PLD + dd::O_HY, PLD, tn_ % (64 * 24), tz);
            hy::h0_compute(hr, cw, cb, ucT0 + (size_t)bl * 1536 * 4096, t_ % (64 * 24), lds, tz); hr = hn; } }
        if (!last) for (long i_ = gt; i_ < (long)GB * 256 * 1536; i_ += gs) { const int bl = (int)(i_ / (256 * 1536)); hy::cconv3_item(proj_s + ((size_t)bl * RB + dd::S) * PLD + dd::O_HY, PLD, cw, cb, ucc0 + (size_t)bl * 256 * 1536, i_ % (256 * 1536)); } }
        xcd_barrier(xb);
        { TID_SETUP
        for (int u = blockIdx.x; u < (GB / 2) * 512; u += gridDim.x) { const int bp_ = u / 512; hy::h1c_unit(ucT0 + (size_t)(2 * bp_) * 1536 * 4096, (const bf16_t*)a.tapsS, a.nrmS, skp, yT0 + (size_t)(2 * bp_) * 512 * 4096, u % 512, lds); }
        if (!last) for (long i_ = gt; i_ < (long)GB * 32 * 512; i_ += gs) { const int bl = (int)(i_ / (32 * 512)); hy::clong_item(ucc0 + (size_t)bl * 256 * 1536, nullptr, z1c0 + (size_t)bl * 256 * 512, nullptr, 0, a.tapsC, a.nrmC, skp, 0, i_ % (32 * 512)); } }
        xcd_barrier(xb);
        { TID_SETUP
        for (int t_ = blockIdx.x; t_ < GB * 64 * 8; t_ += gridDim.x) { const int bl = t_ / (64 * 8); hy::h2_tile(yT0 + (size_t)bl * 512 * 4096, proj_s + (size_t)bl * RB * PLD + dd::O_HY, PLD, t_ % (64 * 8), lds); }
        if (!last) for (long i_ = gt; i_ < (long)GB * 32 * 512; i_ += gs) { const int bl = (int)(i_ / (32 * 512)); hy::clong_item(ucc0 + (size_t)bl * 256 * 1536, z1c0 + (size_t)bl * 256 * 512, nullptr, proj_s + ((size_t)bl * RB + dd::S) * PLD + dd::O_HY, PLD, a.tapsC, a.nrmC, skp, 1, i_ % (32 * 512)); } }
        xcd_barrier(xb); }
      { { pg8::Gemm g{proj_s, ka.WhyT, RG, 1024, 1024, PLD, 1024}; MergeOrder S; S.init((int)gridDim.x, (int)blockIdx.x, last); EpiMergeS E{(const unsigned char*)(proj_s + dd::O_BR), (bf16_t*)mix_s};
          pg8::gemm_phase<EpiMergeS, MergeOrder, false>((PG8_LAS unsigned char*)(lds + RING_OFF), g, S, E, nullptr); }
        xcd_barrier(xb);
        pg8::Gemm g{(const bf16_t*)mix_s, ka.WoutT, RG, 1024, 1024, 0}; GroupOrder S; S.init(1024, (int)gridDim.x, (int)blockIdx.x, last);
        EpiOutG E{a.x, a.ctx, ka.xs + (size_t)grp * RG * 1024, a.mod, b0, !last, l != 0};
        pg8::gemm_phase<EpiOutG, GroupOrder, false>((PG8_LAS unsigned char*)(lds + RING_OFF), g, S, E, nullptr);
        xcd_barrier(xb); }
      {
        { TID_SETUP int* cnt = ka.cnt + (l * NGRP + grp) * 1024;
          LAS bf16_t* wfr = (LAS bf16_t*)(lds + RING_OFF);
          for (int i_ = tz; i_ < 1024 * 16; i_ += NTHREADS) { const int k = i_ >> 4, e = i_ & 15; const float w = a.router_w[i_]; const unsigned hi = f2bf(w); const unsigned lo = f2bf(w - __uint_as_float(hi << 16));
            const int idx = (((k >> 5) * 64 + ((k >> 3) & 3) * 16 + e) << 3) + (k & 7); wfr[idx] = (bf16_t)hi; wfr[16384 + idx] = (bf16_t)lo; }
          LAS int* lcnt = (LAS int*)(lds + RING_OFF + 65536);
          if (tz < 32) lcnt[tz] = 0;
          LAS float* ptab = (LAS float*)(lds + RING_OFF + 65536 + 1024);
          for (int i_ = tz; i_ < 5 * 1024; i_ += NTHREADS) { const int v_ = i_ >> 10, c_ = i_ & 1023; const float* md = a.mod + (size_t)(v_ < GB ? b0 + v_ : dd::B) * 6 * 1024;
            const float g_ = a.norm2_g[(size_t)l * 1024 + c_]; ptab[v_ * 2048 + c_] = g_ * md[4 * 1024 + c_] + g_; ptab[v_ * 2048 + 1024 + c_] = md[3 * 1024 + c_]; }
          __syncthreads();
          const int wv_ = __builtin_amdgcn_readfirstlane(tz >> 6);
          for (int t_ = (int)blockIdx.x + (int)gridDim.x * wv_; t_ < RG / 16; t_ += (int)gridDim.x * NWAVES) { const int rg = 16 * t_, bl = rg / RB, r = rg % RB, b = b0 + bl; if (last && r >= dd::S) continue;
            const LAS float* pt_ = ptab + (r < dd::S ? bl : GB) * 2048; (void)b;
            moe::route16(ka.xs + ((size_t)grp * RG + rg) * 1024, pt_, pt_ + 1024, hb_s + (size_t)rg * 1024, (const LAS v4u*)wfr, a.router_b, lcnt, ka.route + rg, ka.wts + 2 * rg, lane); }
          __syncthreads();
          if (tz < 16) lcnt[16 + tz] = atomicAdd(cnt + tz * 64, lcnt[tz]);
          __syncthreads();
          for (int t_ = (int)blockIdx.x + (int)gridDim.x * wv_; t_ < RG / 16; t_ += (int)gridDim.x * NWAVES) { const int rg = 16 * t_; if (last && (rg % RB) >= dd::S) continue;
            if (lane < 16) { moe::Route* rt = ka.route + rg + lane; moe::Route r_ = *rt; r_.r0 += lcnt[16 + r_.e0]; r_.r1 += lcnt[16 + r_.e1]; *rt = r_; } }
          xcd_barrier(xb); }
        { TID_SETUP int* cnt = ka.cnt + (l * NGRP + grp) * 1024;
          if (tz == 0) { int acc_ = 0; for (int e = 0; e < 16; ++e) { poff[e] = acc_; acc_ += (cnt[e * 64] + 255) >> 8; } poff[16] = acc_; }
          __syncthreads();
          for (int rg = gw; rg < RG; rg += NGW) { if (last && (rg % RB) >= dd::S) continue; const moe::Route rt = ka.route[rg];
            const v4u h0 = *(const v4u*)(hb_s + (size_t)rg * 1024 + lane * 16), h1 = *(const v4u*)(hb_s + (size_t)rg * 1024 + lane * 16 + 8);
#pragma unroll
            for (int sl = 0; sl < 2; ++sl) { const int e = sl ? rt.e1 : rt.e0, rk = sl ? rt.r1 : rt.r0; const size_t dst = (size_t)poff[e] * 256 + rk;
              *(v4u*)(ka.hp + dst * 1024 + lane * 16) = h0; *(v4u*)(ka.hp + dst * 1024 + lane * 16 + 8) = h1;
              if (lane == 0) { ka.srcrow[dst] = 2 * rg + sl; ka.wgt[dst] = ka.wts[2 * rg + sl]; } } }
          for (int e = 0; e < 16; ++e) { const int c_ = cnt[e * 64], pe = ((c_ + 255) >> 8) << 8; for (int p_ = c_ + (int)gt; p_ < pe; p_ += (int)gs) ka.srcrow[(size_t)poff[e] * 256 + p_] = -1; }
          xcd_barrier(xb); }
        { pg8::Gemm g{ka.hp, ka.WguT, 0, 0, 1024, 0}; moe::MoeOrder S{(int)gridDim.x, (int)blockIdx.x, 4, poff}; moe::EpiGU E{ka.hid};
          pg8::gemm_phase<moe::EpiGU, moe::MoeOrder, false>((PG8_LAS unsigned char*)(lds + RING_OFF), g, S, E, nullptr);
          xcd_barrier(xb); }
        { pg8::Gemm g{ka.hid, ka.WdT, 0, 0, 512, 0}; moe::MoeOrder S{(int)gridDim.x, (int)blockIdx.x, 4, poff}; moe::EpiDown E{ka.srcrow, ka.wgt, ka.contrib, (size_t)RG * 1024};
          pg8::gemm_phase<moe::EpiDown, moe::MoeOrder, false>((PG8_LAS unsigned char*)(lds + RING_OFF), g, S, E, nullptr);
          xcd_barrier(xb); }
        { TID_SETUP
          bf16_t* xsg = ka.xs + (size_t)grp * RG * 1024;
#pragma unroll 2
          for (long i_ = gt; i_ < (long)RG * 128; i_ += gs) { const int rg = (int)(i_ >> 7), c8 = (int)(i_ & 127) * 8; const int bl = rg / RB, r = rg % RB, b = b0 + bl; if (last && r >= dd::S) continue;
            const float* g2 = a.mod + (size_t)(r < dd::S ? b : dd::B) * 6 * 1024 + 5 * 1024 + c8;
            const v4u u0 = *(const v4u*)(ka.contrib + (size_t)rg * 1024 + c8), u1 = *(const v4u*)(ka.contrib + (size_t)RG * 1024 + (size_t)rg * 1024 + c8), xo = *(const v4u*)(xsg + (size_t)rg * 1024 + c8);
            const pg8::f32x4 ga_ = *(const pg8::f32x4*)g2, gb_ = *(const pg8::f32x4*)(g2 + 4);
            pg8::f32x4 ya, yb;
            ya[0] = __uint_as_float(xo.x << 16) + ga_[0] * (__uint_as_float(u0.x << 16) + __uint_as_float(u1.x << 16)); ya[1] = __uint_as_float(xo.x & 0xffff0000u) + ga_[1] * (__uint_as_float(u0.x & 0xffff0000u) + __uint_as_float(u1.x & 0xffff0000u));
            ya[2] = __uint_as_float(xo.y << 16) + ga_[2] * (__uint_as_float(u0.y << 16) + __uint_as_float(u1.y << 16)); ya[3] = __uint_as_float(xo.y & 0xffff0000u) + ga_[3] * (__uint_as_float(u0.y & 0xffff0000u) + __uint_as_float(u1.y & 0xffff0000u));
            yb[0] = __uint_as_float(xo.z << 16) + gb_[0] * (__uint_as_float(u0.z << 16) + __uint_as_float(u1.z << 16)); yb[1] = __uint_as_float(xo.z & 0xffff0000u) + gb_[1] * (__uint_as_float(u0.z & 0xffff0000u) + __uint_as_float(u1.z & 0xffff0000u));
            yb[2] = __uint_as_float(xo.w << 16) + gb_[2] * (__uint_as_float(u0.w << 16) + __uint_as_float(u1.w << 16)); yb[3] = __uint_as_float(xo.w & 0xffff0000u) + gb_[3] * (__uint_as_float(u0.w & 0xffff0000u) + __uint_as_float(u1.w & 0xffff0000u));
            if (last) { float* o = a.out + ((size_t)b * dd::S + r) * 1024 + c8; *(pg8::f32x4*)o = ya; *(pg8::f32x4*)(o + 4) = yb; }
            else { v4u w; w.x = pk2h(ya[0], ya[1]); w.y = pk2h(ya[2], ya[3]); w.z = pk2h(yb[0], yb[1]); w.w = pk2h(yb[2], yb[3]); *(v4u*)(xsg + (size_t)rg * 1024 + c8) = w; } }
          xcd_barrier(xb); }
      }
    }
  }
}
extern "C" void kernel_launch(void* const* d_in, const int* in_sizes, int n_in, void* d_out, int out_size, void* d_ws, size_t ws_size, hipStream_t stream) {
  static int grid = 0;
  if (!grid) {
    int dev = 0, cus = 0, per_cu = 0;
    (void)hipGetDevice(&dev); (void)hipDeviceGetAttribute(&cus, hipDeviceAttributeMultiprocessorCount, dev);
    (void)hipFuncSetAttribute((const void*)mega_kernel, hipFuncAttributeMaxDynamicSharedMemorySize, LDS_BYTES);
    (void)hipOccupancyMaxActiveBlocksPerMultiprocessor(&per_cu, mega_kernel, NTHREADS, LDS_BYTES);
    if (per_cu < 1) fprintf(stderr, "occupancy query says %d\n", per_cu);
    grid = cus;
  }
  KArgs ka{}; const float* ptrs[33]; for (int i = 0; i < 33; ++i) ptrs[i] = (const float*)d_in[i];
  set_inputs<TD>(ka.a, ptrs);
  char* wsb = (char*)d_ws; size_t off = BAR_BYTES;
  auto take = [&](size_t bytes) { char* p = wsb + off; off += (bytes + 255) & ~(size_t)255; return p; };
  NaiveBufs& a = ka.a;
  a.mod = (float*)take((size_t)(dd::B + 1) * 6 * 1024 * 4); a.hid2S = (float*)take((size_t)dd::S * 64 * 4); a.hid2C = (float*)take((size_t)dd::C * 64 * 4);
  a.tapsS = (float*)take((size_t)2 * 512 * 2 * 8232 * 2 + 64); a.tapsC = (float*)take((size_t)2 * 512 * 512 * 4); a.nrmS = (float*)take(1024 * 4); a.nrmC = (float*)take(1024 * 4);
  ka.xs = (bf16_t*)take((size_t)dd::B * RB * 1024 * 2);
  ka.WgaT = (bf16_t*)take((size_t)32 * 1024 * 2); ka.WinT = (bf16_t*)take((size_t)NINP * 1024 * 2); ka.WhyT = (bf16_t*)take((size_t)1024 * 1024 * 2); ka.WglaT = (bf16_t*)take((size_t)1024 * 1024 * 2); ka.WattT = (bf16_t*)take((size_t)1024 * 1024 * 2);
  ka.WoutT = (bf16_t*)take((size_t)1024 * 1024 * 2); ka.WguT = (bf16_t*)take((size_t)16 * 1024 * 1024 * 2); ka.WdT = (bf16_t*)take((size_t)16 * 1024 * 512 * 2);
  ka.hb = (bf16_t*)take((size_t)RG * 1024 * 2); ka.mix = (unsigned char*)take(MIX_BYTES);
  ka.proj = (bf16_t*)take((size_t)RG * PLD * 2);
  { char* p = (char*)ka.proj; ka.hp = (bf16_t*)p; p += (size_t)MPG * 1024 * 2; ka.hid = (bf16_t*)p; p += (size_t)MPG * 512 * 2; ka.contrib = (bf16_t*)p; p += (size_t)2 * RG * 1024 * 2;
    ka.srcrow = (int*)p; p += (size_t)MPG * 4; ka.wgt = (float*)p; p += (size_t)MPG * 4; ka.route = (moe::Route*)p; p += (size_t)RG * 16; ka.wts = (float*)p; p += (size_t)RG * 8;
    if ((size_t)(p - (char*)ka.proj) > (size_t)RG * PLD * 2) fprintf(stderr, "MoE alias region too large\n"); }
  a.out = (float*)d_out; ka.bar = (unsigned*)d_ws; ka.cnt = (int*)(wsb + CNT_OFF);
  if (off > ws_size) fprintf(stderr, "workspace too small: need %zu have %zu\n", off, ws_size);
  (void)hipMemsetAsync(d_ws, 0, BAR_BYTES, stream);
  hipLaunchKernelGGL(mega_kernel, dim3(grid), dim3(NTHREADS), LDS_BYTES, stream, ka);
}
```

```cpp
#include <hip/hip_runtime.h>
#include <cstddef>
#include <cstdio>
#include <cstdint>
#include <hip/hip_bf16.h>
#include <hip/hip_runtime.h>
namespace pg8 {
#define PG8_LAS __attribute__((address_space(3)))
typedef unsigned short bf16_t;
typedef short bf16x8 __attribute__((ext_vector_type(8)));
typedef float f32x4 __attribute__((ext_vector_type(4)));
typedef unsigned u32x4 __attribute__((ext_vector_type(4)));
constexpr int BM = 256, BK = 64, HALF = 128, HTB = HALF * BK * 2  , STAGE_BYTES = 8 * HTB, NXCD = 8, WGM = 8;

__host__ __device__ __forceinline__ int lds_byte(int r, int c) { const int st = (r >> 4) * 2 + (c >> 5), rr = r & 15, cc = c & 31, ob = rr * 64 + cc * 2; return st * 1024 + (ob ^ (((ob >> 9) & 1) << 5)); }
__host__ __device__ __forceinline__ void stage_rc(int b, int& R, int& C) { const int st = b / 1024, sb = b % 1024, swz = sb ^ (((sb >> 9) & 1) << 5); R = (st >> 1) * 16 + swz / 64; C = (st & 1) * 32 + (swz % 64) / 2; }
__host__ __device__ __forceinline__ int perm32(int rho) { const int n = rho >> 4, i = rho & 15; return 8 * (i >> 2) + 4 * n + (i & 3); }

struct Unit { int pm, pn, acol, nt; };
struct Gemm { const bf16_t* A; const bf16_t* Bt; int M, N, K; int lda; int ldb; };

struct StaticOrder {
    int nM, nN, nwg, G, c;
    __host__ __device__ void init(int M, int N, int G_, int c_) { nM = M / BM; nN = N / BM; nwg = nM * nN; G = G_; c = c_; }
    __host__ __device__ bool next(int i, Unit& u) const {
        const long L = (long)i * G + c; if (L >= nwg) return false;
        int wgid = (int)L; { const int q = nwg / NXCD, r = nwg % NXCD, xcd = wgid % NXCD, off = wgid / NXCD; wgid = (xcd < r ? xcd * (q + 1) : r * (q + 1) + (xcd - r) * q) + off; }
        const int nig = WGM * nN, gid = wgid / nig, fm = gid * WGM, gsz = (nM - fm) < WGM ? (nM - fm) : WGM;
        u.pm = fm + ((wgid % nig) % gsz); u.pn = (wgid % nig) / gsz; u.acol = 0; u.nt = 0; return true;
    }
    __device__ __forceinline__ void a_ready(const Unit&) const {}
    __device__ __forceinline__ void done(const Unit&) const {}
};
__device__ __forceinline__ unsigned cvt_pk_bf16(float lo, float hi) { unsigned r; asm volatile("v_cvt_pk_bf16_f32 %0, %1, %2" : "=v"(r) : "v"(lo), "v"(hi)); return r; }
typedef float f32x2 __attribute__((ext_vector_type(2)));
template <class Epi, class Sched, bool STAMP = false>
__device__ __forceinline__ void gemm_phase(PG8_LAS unsigned char* lds, const Gemm g, const Sched& S, const Epi& E, unsigned long long* stamps) {
    int tid = threadIdx.x; asm volatile("" : "+v"(tid)); const int wid = __builtin_amdgcn_readfirstlane(tid >> 6), lane = tid & 63, wr = wid >> 2, wc = wid & 3, fr = lane & 15, fq = lane >> 4;
    const int K = g.K, nt = K / BK, LDA = g.lda ? g.lda : g.K, LDB = g.ldb ? g.ldb : g.K;
    int ts_lo = 0, ts_hi = 0, nts = 0; const unsigned long long rt_entry = STAMP ? (unsigned long long)wall_clock64() : 0ull;
#define PG8_STAMP() do { if (STAMP && wid == 0 && nts < 64) { const unsigned long long _c = (unsigned long long)clock64(); \
        ts_lo = (lane == nts) ? (int)(unsigned)_c : ts_lo; ts_hi = (lane == nts) ? (int)(unsigned)(_c >> 32) : ts_hi; ++nts; } } while (0)
    PG8_STAMP();
    unsigned voffA[2], voffB[2];
#pragma unroll
    for (int i = 0; i < 2; ++i) { int R, C; stage_rc(tid * 16 + i * 8192, R, C); const int Rb = Epi::PERM ? ((R & ~31) + perm32(R & 31)) : R;
        voffA[i] = (unsigned)(R * LDA + C) * 2u; voffB[i] = (unsigned)(Rb * LDB + C) * 2u; }
    const size_t kstep = (size_t)(BK * 2);
    const size_t hstep = (size_t)HALF * LDB * 2;
    const size_t tstep = 2 * hstep;
    const size_t hstepA = (size_t)HALF * LDA * 2, tstepA = 2 * hstepA;
    const unsigned ldsw = (unsigned)wid * 1024u;
    const int aoff = lds_byte(wr * 64 + fr, fq * 8), boff = lds_byte(wc * 32 + fr, fq * 8);
#define PG8_SA(b, h) (((b) * 2 + (h)) * HTB)
#define PG8_SB(b, h) ((4 + (b) * 2 + (h)) * HTB)
#define PG8_STAGE(bufoff, gbase, voff) do { _Pragma("unroll") for (int _i = 0; _i < 2; ++_i) \
        __builtin_amdgcn_global_load_lds((const unsigned*)((const char*)(gbase) + (voff)[_i]), (PG8_LAS unsigned*)(lds + (bufoff) + ldsw + _i * 8192), 16, 0, 0); } while (0)
#define PG8_LDA(dst, b, h) do { _Pragma("unroll") for (int m = 0; m < 4; ++m) _Pragma("unroll") for (int k = 0; k < 2; ++k) dst[m][k] = *(const PG8_LAS bf16x8*)(lds + PG8_SA(b, h) + aoff + m * 2048 + k * 1024); } while (0)
#define PG8_LDB(dst, b, h) do { _Pragma("unroll") for (int n = 0; n < 2; ++n) _Pragma("unroll") for (int k = 0; k < 2; ++k) dst[n][k] = *(const PG8_LAS bf16x8*)(lds + PG8_SB(b, h) + boff + n * 2048 + k * 1024); } while (0)
#define PG8_MMA(ai, bj, At, Bt) do { __builtin_amdgcn_s_setprio(1); _Pragma("unroll") for (int m = 0; m < 4; ++m) _Pragma("unroll") for (int n = 0; n < 2; ++n) _Pragma("unroll") for (int k = 0; k < 2; ++k) \
        acc[ai][bj][m][n] = __builtin_amdgcn_mfma_f32_16x16x32_bf16(Bt[n][k], At[m][k], acc[ai][bj][m][n], 0, 0, 0); __builtin_amdgcn_s_setprio(0); } while (0)
#define PG8_WAIT_V(n) asm volatile("s_waitcnt vmcnt(" #n ")" ::: "memory")
#define PG8_WAIT_L(n) asm volatile("s_waitcnt lgkmcnt(" #n ")" ::: "memory")
#define PG8_BAR __builtin_amdgcn_s_barrier()
#define PG8_SCHED __builtin_amdgcn_sched_barrier(0)
    Unit cur, nxt; int ui = 0;
    if (!S.next(0, cur)) return;
    f32x4 acc[2][2][4][2];
#pragma unroll
    for (int a = 0; a < 2; ++a)
#pragma unroll
        for (int b = 0; b < 2; ++b)
#pragma unroll
            for (int m = 0; m < 4; ++m)
#pragma unroll
                for (int n = 0; n < 2; ++n) acc[a][b][m][n] = (f32x4){0.f, 0.f, 0.f, 0.f};
    bf16x8 At[4][2], B0[2][2], B1[2][2];
    const char* cA = (const char*)g.A + (size_t)cur.pm * tstepA + (size_t)cur.acol * 2; const char* cB = (const char*)g.Bt + (size_t)cur.pn * tstep;
    S.a_ready(cur);
    PG8_STAGE(PG8_SB(0, 0), cB, voffB); PG8_STAGE(PG8_SA(0, 0), cA, voffA); PG8_STAGE(PG8_SB(0, 1), cB + hstep, voffB); PG8_STAGE(PG8_SA(0, 1), cA + hstepA, voffA);
    if (wr == 1) PG8_BAR;
    PG8_WAIT_V(4); PG8_BAR;
    PG8_STAGE(PG8_SB(1, 0), cB + kstep, voffB); PG8_STAGE(PG8_SA(1, 0), cA + kstep, voffA); PG8_STAGE(PG8_SB(1, 1), cB + hstep + kstep, voffB);
    PG8_WAIT_V(6); PG8_BAR;
    PG8_STAMP();
    for (;;) {
        const bool has_next = S.next(ui + 1, nxt);
        const char* nA = has_next ? (const char*)g.A + (size_t)nxt.pm * tstepA + (size_t)nxt.acol * 2 : cA; const char* nB = has_next ? (const char*)g.Bt + (size_t)nxt.pn * tstep : cB;
        const int ntu = cur.nt ? cur.nt : nt;
        for (int t = 0; t < ntu; t += 2) {
            const bool last = (t == ntu - 2);
            const char* a1 = cA + (size_t)(t + 1) * kstep;
            const char* a2 = last ? nA : cA + (size_t)(t + 2) * kstep; const char* b2 = last ? nB : cB + (size_t)(t + 2) * kstep;
            const char* a3 = a2 + kstep; const char* b3 = b2 + kstep;
            if (last && has_next) S.a_ready(nxt);
            PG8_LDB(B0, 0, 0); PG8_SCHED; PG8_LDA(At, 0, 0); PG8_STAGE(PG8_SA(1, 1), a1 + hstepA, voffA);
            PG8_WAIT_L(8); PG8_BAR; PG8_WAIT_L(0); PG8_MMA(0, 0, At, B0); PG8_BAR; PG8_SCHED;
            PG8_LDB(B1, 0, 1); PG8_STAGE(PG8_SB(0, 0), b2, voffB);
            PG8_BAR; PG8_WAIT_L(0); PG8_MMA(0, 1, At, B1); PG8_BAR;
            PG8_LDA(At, 0, 1); PG8_STAGE(PG8_SA(0, 0), a2, voffA);
            PG8_BAR; PG8_WAIT_L(0); PG8_MMA(1, 0, At, B0); PG8_BAR; PG8_SCHED;
            PG8_STAGE(PG8_SB(0, 1), b2 + hstep, voffB);
            PG8_WAIT_V(6); PG8_BAR; PG8_MMA(1, 1, At, B1); PG8_BAR;
            PG8_LDB(B0, 1, 0); PG8_SCHED; PG8_LDA(At, 1, 0); PG8_STAGE(PG8_SA(0, 1), a2 + hstepA, voffA);
            PG8_WAIT_L(8); PG8_BAR; PG8_WAIT_L(0); PG8_MMA(0, 0, At, B0); PG8_BAR; PG8_SCHED;
            PG8_LDB(B1, 1, 1); PG8_STAGE(PG8_SB(1, 0), b3, voffB);
            PG8_BAR; PG8_WAIT_L(0); PG8_MMA(0, 1, At, B1); PG8_BAR;
            PG8_LDA(At, 1, 1); PG8_STAGE(PG8_SA(1, 0), a3, voffA);
            PG8_BAR; PG8_WAIT_L(0); PG8_MMA(1, 0, At, B0); PG8_BAR; PG8_SCHED;
            PG8_STAGE(PG8_SB(1, 1), b3 + hstep, voffB);
            PG8_WAIT_V(6); PG8_BAR; PG8_MMA(1, 1, At, B1); PG8_BAR;
        }
        PG8_STAMP();
        bool keep_acc = false;
        if constexpr (!Epi::AFTER_DRAIN) { if constexpr (Epi::CHAIN) keep_acc = E.chain(acc, cur, wr, wc, fr, fq); else E(acc, cur, wr, wc, fr, fq); S.done(cur); }
        PG8_STAMP();
        if (!has_next) break;
        if (!keep_acc)
#pragma unroll
        for (int a = 0; a < 2; ++a)
#pragma unroll
            for (int b = 0; b < 2; ++b)
#pragma unroll
                for (int m = 0; m < 4; ++m)
#pragma unroll
                    for (int n = 0; n < 2; ++n) acc[a][b][m][n] = (f32x4){0.f, 0.f, 0.f, 0.f};
        cur = nxt; cA = nA; cB = nB; ++ui;
    }
    PG8_WAIT_V(0);
    if (wr == 0) PG8_BAR;
    PG8_BAR;
    if constexpr (Epi::AFTER_DRAIN) { E.fused(acc, cur, wr, wc, fr, fq, lds, wid, lane); S.done(cur); }
    PG8_STAMP();
    if (STAMP && wid == 0) { stamps[lane] = lane < nts ? (((unsigned long long)(unsigned)ts_hi << 32) | (unsigned)ts_lo) : 0ull;
        if (lane == 62) stamps[62] = rt_entry; if (lane == 63) stamps[63] = (unsigned long long)wall_clock64(); }
#undef PG8_STAMP
#undef PG8_SA
#undef PG8_SB
#undef PG8_STAGE
#undef PG8_LDA
#undef PG8_LDB
#undef PG8_MMA
#undef PG8_WAIT_V
#undef PG8_WAIT_L
#undef PG8_BAR
#undef PG8_SCHED
}
}

#define LAS __attribute__((address_space(3)))
typedef unsigned short bf16_t;
constexpr int NWAVES = 8, NTHREADS = 512;
constexpr int LDS_BYTES = 147456;
constexpr int RING_OFF = 0;
constexpr int MISC_OFF = 131072;
constexpr int NINP = 7680;

__device__ __forceinline__ unsigned f2bf(float f) { return (unsigned)__builtin_bit_cast(unsigned short, (__bf16)f); }
typedef __bf16 bf16x2_t __attribute__((ext_vector_type(2))); typedef float f32x2_t __attribute__((ext_vector_type(2)));
__device__ __forceinline__ unsigned pk2(float lo, float hi) { const f32x2_t v = {lo, hi}; return __builtin_bit_cast(unsigned, __builtin_convertvector(v, bf16x2_t)); }
__device__ __forceinline__ unsigned pk2h(float lo, float hi) { const f32x2_t v = {lo, hi}; return __builtin_bit_cast(unsigned, __builtin_convertvector(v, bf16x2_t)); }
__device__ __forceinline__ float bf2f(bf16_t b) { return __builtin_bit_cast(float, ((unsigned)b) << 16); }
typedef unsigned v4u __attribute__((ext_vector_type(4)));

__device__ __forceinline__ void transpose_item(const float* W, int K, int N, bf16_t* WT, int row_off, LAS float* scr, int item, int lane, int ldo = 0) {
  if (ldo == 0) ldo = K;
  const int nblk = N / 32, kb = item / nblk, nb = item % nblk, k0 = 64 * kb, n0 = 32 * nb;
  float wreg[32];
#pragma unroll
  for (int i = 0; i < 32; ++i) { const int kk = 2 * i + (lane >> 5); wreg[i] = W[(size_t)(k0 + kk) * N + n0 + (lane & 31)]; }
#pragma unroll
  for (int i = 0; i < 32; ++i) { const int kk = 2 * i + (lane >> 5); scr[kk * 33 + (lane & 31)] = wreg[i]; }
  asm volatile("s_waitcnt lgkmcnt(0)" ::: "memory");
  const int c = lane & 7;
#pragma unroll
  for (int j = 0; j < 4; ++j) { const int n = (lane >> 3) + 8 * j; const LAS float* s = scr + (8 * c) * 33 + n;
    v4u o; o.x = pk2(s[0 * 33], s[1 * 33]); o.y = pk2(s[2 * 33], s[3 * 33]); o.z = pk2(s[4 * 33], s[5 * 33]); o.w = pk2(s[6 * 33], s[7 * 33]);
    *(v4u*)(WT + (size_t)(row_off + n0 + n) * ldo + k0 + 8 * c) = o; }
  asm volatile("s_waitcnt lgkmcnt(0)" ::: "memory");
}

struct EpiProjF32 {
  static constexpr bool PERM = false, AFTER_DRAIN = false;
  float* C; int ldc; int ncols;
  __device__ __forceinline__ void operator()(const pg8::f32x4 (&acc)[2][2][4][2], const pg8::Unit& u, int wr, int wc, int fr, int fq) const {
    const int row0 = u.pm * 256 + wr * 64 + fr, col0 = u.pn * 256 + wc * 32 + 4 * fq;
#pragma unroll
    for (int ai = 0; ai < 2; ++ai)
#pragma unroll
      for (int m = 0; m < 4; ++m) { float* rowp = C + (size_t)(row0 + ai * 128 + m * 16) * ldc + col0;
#pragma unroll
        for (int bj = 0; bj < 2; ++bj)
#pragma unroll
          for (int n = 0; n < 2; ++n) if (col0 + bj * 128 + n * 16 < ncols) *(pg8::f32x4*)(rowp + bj * 128 + n * 16) = acc[ai][bj][m][n]; }
  }
};

__device__ __forceinline__ float fsigmoid(float x) { return 1.f / (1.f + __expf(-x)); }
template <bool ACCUM> struct EpiMerge {
  static constexpr bool PERM = true, AFTER_DRAIN = false;
  const float* gate; int ldg; bf16_t* M; int ldm;
  __device__ __forceinline__ void operator()(const pg8::f32x4 (&acc)[2][2][4][2], const pg8::Unit& u, int wr, int wc, int fr, int fq) const {
    const int row0 = u.pm * 256 + wr * 64 + fr, col0 = u.pn * 256 + wc * 32 + 8 * fq;
#pragma unroll
    for (int ai = 0; ai < 2; ++ai)
#pragma unroll
      for (int m = 0; m < 4; ++m) { const size_t r = (size_t)(row0 + ai * 128 + m * 16);
#pragma unroll
        for (int bj = 0; bj < 2; ++bj) { const int c = col0 + bj * 128;
          const pg8::f32x4 g0 = *(const pg8::f32x4*)(gate + r * ldg + c), g1 = *(const pg8::f32x4*)(gate + r * ldg + c + 4);
          pg8::f32x4 v0 = acc[ai][bj][m][0], v1 = acc[ai][bj][m][1];
#pragma unroll
          for (int e = 0; e < 4; ++e) { v0[e] *= fsigmoid(g0[e]); v1[e] *= fsigmoid(g1[e]); }
          v4u* dst = (v4u*)(M + r * ldm + c);
          if (ACCUM) { const v4u o = *dst; v0[0] += bf2f(o.x & 0xffff); v0[1] += bf2f(o.x >> 16); v0[2] += bf2f(o.y & 0xffff); v0[3] += bf2f(o.y >> 16);
            v1[0] += bf2f(o.z & 0xffff); v1[1] += bf2f(o.z >> 16); v1[2] += bf2f(o.w & 0xffff); v1[3] += bf2f(o.w >> 16); }
          v4u o2; o2.x = pk2(v0[0], v0[1]); o2.y = pk2(v0[2], v0[3]); o2.z = pk2(v1[0], v1[1]); o2.w = pk2(v1[2], v1[3]); *dst = o2; } }
  }
};
struct EpiOut {
  static constexpr bool PERM = false, AFTER_DRAIN = false;
  const float* resL; float* outL; const float* gL;
  const float* resC; float* outC; const float* gC;
  __device__ __forceinline__ void operator()(const pg8::f32x4 (&acc)[2][2][4][2], const pg8::Unit& u, int wr, int wc, int fr, int fq) const {
    const bool isc = u.pm == 16; if (isc && outC == nullptr) return;
    const float* res = isc ? resC : resL; float* out = isc ? outC : outL; const float* gv = isc ? gC : gL;
    const int row0 = (isc ? 0 : u.pm * 256) + wr * 64 + fr, col0 = u.pn * 256 + wc * 32 + 4 * fq;
    pg8::f32x4 gg[2][2];
#pragma unroll
    for (int bj = 0; bj < 2; ++bj)
#pragma unroll
      for (int n = 0; n < 2; ++n) gg[bj][n] = *(const pg8::f32x4*)(gv + col0 + bj * 128 + n * 16);
#pragma unroll
    for (int ai = 0; ai < 2; ++ai)
#pragma unroll
      for (int m = 0; m < 4; ++m) { const size_t ro = (size_t)(row0 + ai * 128 + m * 16) * 1024 + col0;
#pragma unroll
        for (int bj = 0; bj < 2; ++bj)
#pragma unroll
          for (int n = 0; n < 2; ++n) { const pg8::f32x4 rv = *(const pg8::f32x4*)(res + ro + bj * 128 + n * 16); *(pg8::f32x4*)(out + ro + bj * 128 + n * 16) = rv + gg[bj][n] * acc[ai][bj][m][n]; } }
  }
};
namespace att {
using bf16 = __hip_bfloat16;
constexpr int D = 128, NW = 8, QBLK = 32, KVBLK = 64; constexpr float SCALE = 0.088388347648318440f; constexpr float THR = 8.f; constexpr int SDEPTH = 2;
constexpr size_t SHM_V = KVBLK * D * 2, SHM_K = KVBLK * D * 2, SHM_ATTN = 2 * SHM_V + 2 * SHM_K + NW * 64 * 4;
using bf16x8 = __attribute__((ext_vector_type(8))) short;
using s16x4  = __attribute__((ext_vector_type(4))) short;
using f32x16 = __attribute__((ext_vector_type(16))) float;
using f32x8  = __attribute__((ext_vector_type(8))) float;
using u32x4  = __attribute__((ext_vector_type(4))) unsigned;
#define KSWZ(row, colB) ((row) * 256 + ((colB) ^ (((row) & 7) << 4)))
#define SBAR() __builtin_amdgcn_sched_barrier(0)
__device__ __forceinline__ int crow(int r, int hi) { return (r & 3) + 8 * (r >> 2) + 4 * hi; }
__device__ __forceinline__ unsigned cvtpk(float lo, float hi) {
  unsigned r; asm volatile("v_cvt_pk_bf16_f32 %0, %1, %2" : "=v"(r) : "v"(lo), "v"(hi)); return r;
}
template <typename TIn> struct Stage;
template <> struct Stage<bf16>  { using T = bf16x8;
  __device__ static __forceinline__ T ld8(const bf16* p) { return *reinterpret_cast<const bf16x8*>(p); }
  __device__ static __forceinline__ bf16x8 tobf(T x) { return x; } };
template <> struct Stage<float> { using T = f32x8;
  __device__ static __forceinline__ T ld8(const float* p) { return *reinterpret_cast<const f32x8*>(p); }
  __device__ static __forceinline__ bf16x8 tobf(T x) {
    u32x4 w = {cvtpk(x[0], x[1]), cvtpk(x[2], x[3]), cvtpk(x[4], x[5]), cvtpk(x[6], x[7])}; return *reinterpret_cast<bf16x8*>(&w); } };

__device__ __forceinline__ void partialSM(f32x16& p0, f32x16& p1, float& m_reg, float& mn, float& alpha) {
  constexpr float C = SCALE * 1.4426950408889634f;
  float pmax = p0[0]; for (int r = 1; r < 16; ++r) pmax = fmaxf(pmax, p0[r]); for (int r = 0; r < 16; ++r) pmax = fmaxf(pmax, p1[r]);
  { auto rr = __builtin_amdgcn_permlane32_swap(__float_as_uint(pmax), __float_as_uint(pmax), false, false);
    pmax = fmaxf(__uint_as_float(rr[0]), __uint_as_float(rr[1])); }
  if (__builtin_expect(__all(pmax - m_reg <= THR / SCALE), 1)) { mn = m_reg; alpha = 1.f; }
  else { mn = fmaxf(m_reg, pmax); alpha = __builtin_amdgcn_exp2f((m_reg - mn) * C); m_reg = mn; }
  float mnC = -mn * C;
  for (int r = 0; r < 16; ++r) p0[r] = fmaf(p0[r], C, mnC); for (int r = 0; r < 16; ++r) p1[r] = fmaf(p1[r], C, mnC);
  for (int r = 0; r < 16; ++r) p0[r] = __builtin_amdgcn_exp2f(p0[r]);
}
__device__ __forceinline__ void finishSM(f32x16& p0, f32x16& p1, float alpha, float& l_reg, bf16x8& pa0, bf16x8& pa1, bf16x8& pa2, bf16x8& pa3) {
  for (int r = 0; r < 16; ++r) p1[r] = __builtin_amdgcn_exp2f(p1[r]);
  float ps = 0; for (int r = 0; r < 16; ++r) ps += p0[r]; for (int r = 0; r < 16; ++r) ps += p1[r];
  { auto rr = __builtin_amdgcn_permlane32_swap(__float_as_uint(ps), __float_as_uint(ps), false, false);
    ps = __uint_as_float(rr[0]) + __uint_as_float(rr[1]); }
  l_reg = l_reg * alpha + ps;
#define PK4(P, BASE, OUT) do { unsigned a0 = cvtpk(P[BASE + 0], P[BASE + 1]), a1 = cvtpk(P[BASE + 2], P[BASE + 3]);   \
    unsigned b0 = cvtpk(P[BASE + 4], P[BASE + 5]), b1 = cvtpk(P[BASE + 6], P[BASE + 7]);                              \
    auto r0 = __builtin_amdgcn_permlane32_swap(a0, b0, false, false); auto r1 = __builtin_amdgcn_permlane32_swap(a1, b1, false, false); \
    u32x4 w = {r0[0], r1[0], r0[1], r1[1]}; OUT = *reinterpret_cast<bf16x8*>(&w); } while (0)
  PK4(p0, 0, pa0); PK4(p0, 8, pa1); PK4(p1, 0, pa2); PK4(p1, 8, pa3);
#undef PK4
}
__device__ __forceinline__ void qkt(f32x16& p0, f32x16& p1, const bf16* Ks, const bf16x8* qr, int r32, int hi) {
  p0 = f32x16{}; p1 = f32x16{};
  for (int d0 = 0; d0 < 8; ++d0) { int cb = (d0 * 16 + hi * 8) * 2;
    bf16x8 b0 = *reinterpret_cast<const bf16x8*>((const char*)Ks + KSWZ(r32, cb));
    bf16x8 b1 = *reinterpret_cast<const bf16x8*>((const char*)Ks + KSWZ(32 + r32, cb));
    p0 = __builtin_amdgcn_mfma_f32_32x32x16_bf16(b0, qr[d0], p0, 0, 0, 0);
    p1 = __builtin_amdgcn_mfma_f32_32x32x16_bf16(b1, qr[d0], p1, 0, 0, 0); }
}
__device__ __forceinline__ int v_st(int k, int c) { const int kk = (k & ~0xC) | ((k & 4) << 1) | ((k & 8) >> 1); return ((kk >> 3) * 4 + (c >> 5)) * 512 + ((kk & 7) * 32 + (c & 31)) * 2; }
__device__ __forceinline__ int v_rd_base(int lane) { return ((lane & 3) << 3) | (((lane >> 2) & 3) << 6) | (((lane >> 4) & 1) << 5) | (((lane >> 5) & 1) << 8); }
constexpr int v_rd_off(int d0, int ks, int half) { return d0 * 512 + ks * 4096 + half * 2048; }
template <int OFF> __device__ __forceinline__ s16x4 tr_read(int vb) {
  s16x4 r; asm volatile("ds_read_b64_tr_b16 %0, %1 offset:%2" : "=&v"(r) : "v"(vb), "i"(OFF) : "memory"); return r;
}
template <int D0> __device__ __forceinline__ void pv_one(f32x16& od, int vb, bf16x8 pa0, bf16x8 pa1, bf16x8 pa2, bf16x8 pa3) {
  const s16x4 l0 = tr_read<v_rd_off(D0, 0, 0)>(vb), h0 = tr_read<v_rd_off(D0, 0, 1)>(vb), l1 = tr_read<v_rd_off(D0, 1, 0)>(vb), h1 = tr_read<v_rd_off(D0, 1, 1)>(vb);
  const s16x4 l2 = tr_read<v_rd_off(D0, 2, 0)>(vb), h2 = tr_read<v_rd_off(D0, 2, 1)>(vb), l3 = tr_read<v_rd_off(D0, 3, 0)>(vb), h3 = tr_read<v_rd_off(D0, 3, 1)>(vb);
  asm volatile("s_waitcnt lgkmcnt(0)" ::: "memory"); SBAR();
#define PK(L, H) (bf16x8){L[0], L[1], L[2], L[3], H[0], H[1], H[2], H[3]}
  od = __builtin_amdgcn_mfma_f32_32x32x16_bf16(pa0, PK(l0, h0), od, 0, 0, 0);
  od = __builtin_amdgcn_mfma_f32_32x32x16_bf16(pa1, PK(l1, h1), od, 0, 0, 0);
  od = __builtin_amdgcn_mfma_f32_32x32x16_bf16(pa2, PK(l2, h2), od, 0, 0, 0);
  od = __builtin_amdgcn_mfma_f32_32x32x16_bf16(pa3, PK(l3, h3), od, 0, 0, 0);
#undef PK
}
__device__ __forceinline__ void pv_d0(f32x16* o, int vb, bf16x8 pa0, bf16x8 pa1, bf16x8 pa2, bf16x8 pa3) {
  pv_one<0>(o[0], vb, pa0, pa1, pa2, pa3); pv_one<1>(o[1], vb, pa0, pa1, pa2, pa3); pv_one<2>(o[2], vb, pa0, pa1, pa2, pa3); pv_one<3>(o[3], vb, pa0, pa1, pa2, pa3);
}

template <typename TQ, int LDQ, int LDK, int LDO, bool OBF16>
__device__ __forceinline__ void attn_dense_body(const TQ* Qb, const bf16* Kh, const bf16* Vh,
                                                void* Obv, int seq, char* lds) {
  using St = Stage<bf16>; using SQ = Stage<TQ>;
  int tid = threadIdx.x; asm volatile("" : "+v"(tid)); const int wid = tid >> 6, lane = tid & 63, r32 = lane & 31, hi = lane >> 5;
  bf16* V_lds = (bf16*)lds; bf16* K_lds = (bf16*)(lds + 2 * SHM_V);
  float* ws = (float*)(lds + 2 * SHM_V + 2 * SHM_K) + wid * 64; float* li_l = ws; float* al_l = ws + 32;
  float m_reg = -1e30f, l_reg = 0; f32x16 o[4] = {}; bf16x8 qr[8];
  const TQ* Qw = Qb + (long)(wid * QBLK + r32) * LDQ + hi * 8;
#pragma unroll
  for (int d0 = 0; d0 < 8; ++d0) qr[d0] = SQ::tobf(SQ::ld8(Qw + d0 * 16));
  const int sr = tid >> 4, sc = (tid & 15) * 8, vst0 = v_st(sr, sc), vst1 = v_st(32 + sr, sc);
  const int vb0 = (int)(uintptr_t)V_lds + v_rd_base(lane);
  struct { typename St::T vs0, vs1, ks0, ks1; } sr_[SDEPTH];
#define SLOAD(i, k0) do { sr_[i].vs0 = St::ld8(&Vh[(long)((k0) + sr) * LDK + sc]); sr_[i].vs1 = St::ld8(&Vh[(long)((k0) + 32 + sr) * LDK + sc]); \
    sr_[i].ks0 = St::ld8(&Kh[(long)((k0) + sr) * LDK + sc]); sr_[i].ks1 = St::ld8(&Kh[(long)((k0) + 32 + sr) * LDK + sc]); } while (0)
#define SWRITE(b, i) do { *(bf16x8*)((char*)V_lds + (b) * SHM_V + vst0) = St::tobf(sr_[i].vs0);          \
    *(bf16x8*)((char*)V_lds + (b) * SHM_V + vst1) = St::tobf(sr_[i].vs1); int kc = sc * 2;               \
    *(bf16x8*)((char*)K_lds + (b) * SHM_K + KSWZ(sr, kc)) = St::tobf(sr_[i].ks0);                       \
    *(bf16x8*)((char*)K_lds + (b) * SHM_K + KSWZ(32 + sr, kc)) = St::tobf(sr_[i].ks1); } while (0)
#define SWAIT() do { if constexpr (SDEPTH == 2) asm volatile("s_waitcnt vmcnt(4)" ::: "memory"); else asm volatile("s_waitcnt vmcnt(0)" ::: "memory"); } while (0)
#define RESC(a) do { if (__any((a) < 1.f)) { if (hi == 0) al_l[r32] = (a); asm volatile("s_waitcnt lgkmcnt(0)" ::: "memory"); \
    for (int d = 0; d < 4; ++d) for (int r = 0; r < 16; ++r) o[d][r] *= al_l[crow(r, hi)]; } } while (0)
  f32x16 pA0, pA1, pB0, pB1; float mnA, mnB, alA, alB; bf16x8 pa0, pa1, pa2, pa3; const int NT = seq / KVBLK;
  constexpr int SE = 0, SO = SDEPTH - 1;
  SLOAD(SE, 0); asm volatile("s_waitcnt vmcnt(0)" ::: "memory"); SWRITE(0, SE); __syncthreads();
  qkt(pA0, pA1, K_lds, qr, r32, hi); partialSM(pA0, pA1, m_reg, mnA, alA);
  SLOAD(SO, KVBLK); if constexpr (SDEPTH == 2) { if (2 < NT) SLOAD(SE, 2 * KVBLK); }
  SWAIT(); SWRITE(1, SO); __syncthreads();
  for (int j = 1; j + 1 < NT; j += 2) {
    SBAR(); qkt(pB0, pB1, (bf16*)((char*)K_lds + SHM_K), qr, r32, hi);
    finishSM(pA0, pA1, alA, l_reg, pa0, pa1, pa2, pa3); SBAR();
    SLOAD(SO, (j + SDEPTH) * KVBLK); SBAR();
    pv_d0(o, vb0, pa0, pa1, pa2, pa3); partialSM(pB0, pB1, m_reg, mnB, alB);
    __syncthreads(); SWAIT(); SWRITE(0, SE);
    RESC(alB); __syncthreads();
    SBAR(); qkt(pA0, pA1, K_lds, qr, r32, hi);
    finishSM(pB0, pB1, alB, l_reg, pa0, pa1, pa2, pa3); SBAR();
    if (SDEPTH == 1 || j + 3 < NT) SLOAD(SE, (j + 1 + SDEPTH) * KVBLK); SBAR();
    pv_d0(o, vb0 + (int)SHM_V, pa0, pa1, pa2, pa3); partialSM(pA0, pA1, m_reg, mnA, alA);
    __syncthreads(); SWAIT(); SWRITE(1, SO);
    RESC(alA); __syncthreads();
  }
  SBAR(); qkt(pB0, pB1, (bf16*)((char*)K_lds + SHM_K), qr, r32, hi);
  finishSM(pA0, pA1, alA, l_reg, pa0, pa1, pa2, pa3); SBAR();
  pv_d0(o, vb0, pa0, pa1, pa2, pa3); partialSM(pB0, pB1, m_reg, mnB, alB);
  __syncthreads(); RESC(alB);
  finishSM(pB0, pB1, alB, l_reg, pa0, pa1, pa2, pa3); SBAR();
  pv_d0(o, vb0 + (int)SHM_V, pa0, pa1, pa2, pa3);
  if (hi == 0) li_l[r32] = l_reg; asm volatile("s_waitcnt lgkmcnt(0)" ::: "memory");
  float rli[16];
#pragma unroll
  for (int r = 0; r < 16; ++r) rli[r] = __builtin_amdgcn_rcpf(li_l[crow(r, hi)]);
  if constexpr (!OBF16) { float* Ow = (float*)Obv + (long)(wid * QBLK) * LDO;
#pragma unroll
  for (int r = 0; r < 16; ++r) { int orow = crow(r, hi);
    for (int d0 = 0; d0 < 4; ++d0) Ow[(long)orow * LDO + d0 * 32 + r32] = o[d0][r] * rli[r]; }
  } else { unsigned short* Ow = (unsigned short*)Obv + (long)(wid * QBLK) * LDO;
#pragma unroll
  for (int r = 0; r < 16; ++r) { int orow = crow(r, hi);
    for (int d0 = 0; d0 < 4; ++d0) { const unsigned pk = cvtpk(o[d0][r] * rli[r], 0.f); Ow[(long)orow * LDO + d0 * 32 + r32] = (unsigned short)(pk & 0xffffu); } }
  }
#undef SLOAD
#undef SWRITE
#undef SWAIT
#undef RESC
}
#undef KSWZ
#undef SBAR
}
namespace gla {
typedef float f32x16 __attribute__((ext_vector_type(16)));
typedef float f32x4v __attribute__((ext_vector_type(4)));
constexpr int LD = 65;
constexpr int OX = 0, OY = 2 * 64 * LD * 4, OV = 4 * 64 * LD * 4, OAL = OV + 64 * 128 * 4, OW2 = OAL + 64 * 32 * 4, OBA = OW2 + 2 * 16 * 64 * 4, OTOT = OBA + 2 * 64 * 4, OEND = OTOT + 2 * 64 * 4 * 4;
static_assert(OEND <= 131072, "gla lds");
static_assert(64 * 129 * 4 <= 2 * 64 * LD * 4, "O stage fits in X");

struct In {
  const bf16_t* q; const bf16_t* k; const bf16_t* v; const bf16_t* ga; const bf16_t* og; int ld;
  const float* wa2; const float* ba; const float* gnorm;
  float* cs;
  bf16_t* csb;
  float* dec;
  bf16_t* y; int ldy;
  int S, C;
};
__device__ __forceinline__ long chunk_row(const In& p, int cid) { return cid < p.S / 64 ? (long)cid * 64 : (long)p.S + (long)(cid - p.S / 64) * 64; }
__device__ __forceinline__ float logsig(float x) { return x < 0.f ? x - __logf(1.f + __expf(x)) : -__logf(1.f + __expf(-x)); }

__device__ __forceinline__ void cum_phase(const In& p, LAS unsigned char* lds, int head, long row0, int tid) {
  LAS float* AL = (LAS float*)(lds + OAL); LAS float* W2 = (LAS float*)(lds + OW2); LAS float* BA = (LAS float*)(lds + OBA); LAS float* TOT = (LAS float*)(lds + OTOT);
  { const int t = tid >> 3, r4 = (tid & 7) * 4; const unsigned long long u = *(const unsigned long long*)(p.ga + (row0 + t) * p.ld + r4);
    f32x4v a4; a4[0] = bf2f((bf16_t)u); a4[1] = bf2f((bf16_t)(u >> 16)); a4[2] = bf2f((bf16_t)(u >> 32)); a4[3] = bf2f((bf16_t)(u >> 48)); *(LAS f32x4v*)(AL + t * 32 + r4) = a4; }
  { const int e = tid * 4, dir = e >> 10, r = (e >> 6) & 15, j = e & 63; *(LAS f32x4v*)(W2 + e) = *(const f32x4v*)(p.wa2 + ((long)dir * 16 + r) * 256 + head * 64 + j); }
  if (tid < 128) BA[tid] = p.ba[(tid >> 6) * 256 + head * 64 + (tid & 63)];
  __syncthreads();
  const int dir = tid >> 8, j = tid & 63, seg = (tid >> 6) & 3;
  float w[16];
#pragma unroll
  for (int r = 0; r < 16; ++r) w[r] = W2[(dir * 16 + r) * 64 + j];
  const float bj = BA[dir * 64 + j];
  float c[16];
#pragma unroll
  for (int k = 0; k < 16; ++k) { const int t = seg * 16 + k; float z = bj;
#pragma unroll
    for (int r4 = 0; r4 < 4; ++r4) { const f32x4v a4 = *(const LAS f32x4v*)(AL + t * 32 + dir * 16 + 4 * r4); z += a4[0] * w[4 * r4] + a4[1] * w[4 * r4 + 1] + a4[2] * w[4 * r4 + 2] + a4[3] * w[4 * r4 + 3]; }
    c[k] = logsig(z) * (1.f / 16.f); }
  if (dir == 0) {
#pragma unroll
    for (int k = 1; k < 16; ++k) c[k] += c[k - 1];
    TOT[(dir * 64 + j) * 4 + seg] = c[15];
  } else {
#pragma unroll
    for (int k = 14; k >= 0; --k) c[k] += c[k + 1];
    TOT[(dir * 64 + j) * 4 + seg] = c[0];
  }
  __syncthreads();
  float off = 0.f;
#pragma unroll
  for (int s = 0; s < 4; ++s) { const float tv = TOT[(dir * 64 + j) * 4 + s]; if (dir == 0 ? s < seg : s > seg) off += tv; }
  LAS float* X = (LAS float*)(lds + OX) + dir * 64 * LD;
#pragma unroll
  for (int k = 0; k < 16; ++k) X[(seg * 16 + k) * LD + j] = c[k] + off;
}
struct VRegs { unsigned long long u[4]; };
__device__ __forceinline__ VRegs load_v_regs(const In& p, int head, long row0, int tid) { VRegs r;
#pragma unroll
  for (int m = 0; m < 4; ++m) { const int t = (tid >> 5) + 16 * m, c4 = (tid & 31) * 4; r.u[m] = *(const unsigned long long*)(p.v + (row0 + t) * p.ld + head * 128 + c4); }
  return r; }
__device__ __forceinline__ void store_v(const VRegs& r, LAS unsigned char* lds, int tid) {
  LAS float* V = (LAS float*)(lds + OV);
#pragma unroll
  for (int m = 0; m < 4; ++m) { const int t = (tid >> 5) + 16 * m, c4 = (tid & 31) * 4; const unsigned long long u = r.u[m];
    f32x4v a4; a4[0] = bf2f((bf16_t)u); a4[1] = bf2f((bf16_t)(u >> 16)); a4[2] = bf2f((bf16_t)(u >> 32)); a4[3] = bf2f((bf16_t)(u >> 48)); *(LAS f32x4v*)(V + t * 128 + c4) = a4; }
}

__device__ __forceinline__ void g1_unit(const In& p, LAS unsigned char* lds, int head, int cid, int GH, int NCH) {
  int tid = threadIdx.x; asm volatile("" : "+v"(tid));
  const int lane = tid & 63, w = __builtin_amdgcn_readfirstlane(tid >> 6);
  const long row0 = chunk_row(p, cid);
  const VRegs vr = load_v_regs(p, head, row0, tid);
  bf16_t kreg[8];
#pragma unroll
  for (int m = 0; m < 8; ++m) kreg[m] = p.k[(row0 + (tid >> 6) + 8 * m) * p.ld + head * 64 + (tid & 63)];
  cum_phase(p, lds, head, row0, tid);
  store_v(vr, lds, tid);
  __syncthreads();
  LAS float* TOT = (LAS float*)(lds + OTOT);
  { const int j = tid & 63;
#pragma unroll
    for (int dir = 0; dir < 2; ++dir) { LAS float* X = (LAS float*)(lds + OX) + dir * 64 * LD;
      const float cl = TOT[(dir * 64 + j) * 4 + 0] + TOT[(dir * 64 + j) * 4 + 1] + TOT[(dir * 64 + j) * 4 + 2] + TOT[(dir * 64 + j) * 4 + 3];
#pragma unroll
      for (int m = 0; m < 8; ++m) { const int t = (tid >> 6) + 8 * m; const float kv = bf2f(kreg[m]); X[t * LD + j] = kv * __expf(cl - X[t * LD + j]); }
      if (tid < 64) p.dec[(((long)dir * GH + head) * NCH + cid) * 64 + j] = __expf(cl); }
  }
  __syncthreads();
  { const int dir = w >> 2, di = (w >> 1) & 1, vj0 = (w & 1) * 2; const LAS float* X = (const LAS float*)(lds + OX) + dir * 64 * LD; const LAS float* V = (const LAS float*)(lds + OV);
    f32x16 a0 = {}, a1 = {}; const int li = lane & 31, lk = lane >> 5;
#pragma unroll 4
    for (int s0 = 0; s0 < 64; s0 += 2) { const float av = X[(s0 + lk) * LD + 32 * di + li]; const float b0 = V[(s0 + lk) * 128 + 32 * vj0 + li], b1 = V[(s0 + lk) * 128 + 32 * vj0 + 32 + li];
      a0 = __builtin_amdgcn_mfma_f32_32x32x2f32(av, b0, a0, 0, 0, 0); a1 = __builtin_amdgcn_mfma_f32_32x32x2f32(av, b1, a1, 0, 0, 0); }
    float* dst = p.cs + ((((long)dir * GH + head) * NCH + cid) * 64) * 128;
#pragma unroll
    for (int r = 0; r < 16; ++r) { const int d = 32 * di + (r & 3) + 8 * (r >> 2) + 4 * lk; dst[(long)d * 128 + 32 * vj0 + li] = a0[r]; dst[(long)d * 128 + 32 * vj0 + 32 + li] = a1[r]; }
  }
  __syncthreads();
}
__device__ __forceinline__ void g2_item(const In& p, long idx, int GH, int NCH) {
  const int v = 2 * (int)(idx & 63), d = (int)((idx >> 6) & 63); const int hd = (int)((idx >> 12) % GH), dir = (int)((idx >> 12) / GH);
  const int nl = p.S / 64, nc = p.C / 64; float st0 = 0.f, st1 = 0.f;
  bf16_t* base = p.csb + (((long)dir * GH + hd) * NCH) * 64 * 128 + (long)d * 128 + v; const float* db = p.dec + (((long)dir * GH + hd) * NCH) * 64 + d;
  for (int s0 = 0; s0 < nl + nc; s0 += 4) { unsigned c[4]; float dc[4]; unsigned* pp[4];
#pragma unroll
    for (int k = 0; k < 4; ++k) { const int step = s0 + k; int cid; if (step < nc) cid = nl + (dir ? nc - 1 - step : step); else cid = dir ? nl - 1 - (step - nc) : step - nc;
      pp[k] = (unsigned*)(base + (long)cid * 64 * 128); c[k] = *pp[k]; dc[k] = db[(long)cid * 64]; }
#pragma unroll
    for (int k = 0; k < 4; ++k) { *pp[k] = pk2(st0, st1); st0 = dc[k] * st0 + __uint_as_float(c[k] << 16); st1 = dc[k] * st1 + __uint_as_float(c[k] & 0xffff0000u); } }
}
__device__ __forceinline__ void g3_unit(const In& p, LAS unsigned char* lds, int head, int cid, int GH, int NCH) {
  int tid = threadIdx.x; asm volatile("" : "+v"(tid));
  const int lane = tid & 63, w = __builtin_amdgcn_readfirstlane(tid >> 6), li = lane & 31, lk = lane >> 5;
  const long row0 = chunk_row(p, cid);
  float spf[2][32];
  { const int vj_ = w & 3;
#pragma unroll
    for (int dir = 0; dir < 2; ++dir) { const float* sp = p.cs + ((((long)dir * GH + head) * NCH + cid) * 64) * 128 + 32 * vj_ + li;
#pragma unroll
      for (int i = 0; i < 32; ++i) spf[dir][i] = sp[(long)(2 * i + lk) * 128]; } }
  const VRegs vr = load_v_regs(p, head, row0, tid);
  bf16_t kreg[8], qreg[8];
#pragma unroll
  for (int m = 0; m < 8; ++m) { const long o_ = (row0 + (tid >> 6) + 8 * m) * p.ld + head * 64 + (tid & 63); kreg[m] = p.k[o_]; qreg[m] = p.q[o_]; }
  cum_phase(p, lds, head, row0, tid);
  store_v(vr, lds, tid);
  __syncthreads();
  { const int j = tid & 63;
#pragma unroll
    for (int dir = 0; dir < 2; ++dir) { LAS float* X = (LAS float*)(lds + OX) + dir * 64 * LD; LAS float* Y = (LAS float*)(lds + OY) + dir * 64 * LD;
#pragma unroll
      for (int m = 0; m < 8; ++m) { const int t = (tid >> 6) + 8 * m; const float c = X[t * LD + j];
        const float qv = bf2f(qreg[m]) * 0.125f, kv = bf2f(kreg[m]);
        X[t * LD + j] = qv * __expf(c); Y[t * LD + j] = kv * __expf(-c); } }
  }
  __syncthreads();
  {
    const int dir = w >> 2, qi = (w >> 1) & 1, si = w & 1; const bool zero = dir == 0 ? si > qi : si < qi;
    const LAS float* X = (const LAS float*)(lds + OX) + dir * 64 * LD; LAS float* Y = (LAS float*)(lds + OY) + dir * 64 * LD;
    f32x16 pa = {};
    if (!zero) {
#pragma unroll 4
      for (int d0 = 0; d0 < 64; d0 += 2) pa = __builtin_amdgcn_mfma_f32_32x32x2f32(X[(32 * qi + li) * LD + d0 + lk], Y[(32 * si + li) * LD + d0 + lk], pa, 0, 0, 0);
    }
    __syncthreads();
#pragma unroll
    for (int r = 0; r < 16; ++r) { const int q = 32 * qi + (r & 3) + 8 * (r >> 2) + 4 * lk, s = 32 * si + li; const bool keep = dir == 0 ? s <= q : s >= q;
      Y[q * LD + s] = keep ? pa[r] : 0.f; }
  }
  __syncthreads();
  f32x16 acc = {};
  { const int qi = w >> 2, vj = w & 3; const LAS float* V = (const LAS float*)(lds + OV);
#pragma unroll
    for (int dir = 0; dir < 2; ++dir) { const LAS float* X = (const LAS float*)(lds + OX) + dir * 64 * LD; const LAS float* Y = (const LAS float*)(lds + OY) + dir * 64 * LD;
#pragma unroll 4
      for (int s0 = 0; s0 < 64; s0 += 2) acc = __builtin_amdgcn_mfma_f32_32x32x2f32(Y[(32 * qi + li) * LD + s0 + lk], V[(s0 + lk) * 128 + 32 * vj + li], acc, 0, 0, 0);
#pragma unroll
      for (int i = 0; i < 32; ++i) acc = __builtin_amdgcn_mfma_f32_32x32x2f32(X[(32 * qi + li) * LD + 2 * i + lk], spf[dir][i], acc, 0, 0, 0);
    }
    __syncthreads();
    LAS float* O = (LAS float*)(lds + OX);
#pragma unroll
    for (int r = 0; r < 16; ++r) { const int q = 32 * qi + (r & 3) + 8 * (r >> 2) + 4 * lk; O[q * 129 + 32 * vj + li] = acc[r]; }
  }
  __syncthreads();
  { const int row = tid >> 3, part = tid & 7; const LAS float* O = (const LAS float*)(lds + OX) + row * 129 + part * 16;
    float o[16]; float ss = 0.f;
#pragma unroll
    for (int k = 0; k < 16; ++k) { o[k] = O[k]; ss += o[k] * o[k]; }
    ss += __shfl_xor(ss, 1); ss += __shfl_xor(ss, 2); ss += __shfl_xor(ss, 4);
    const float rs = __builtin_amdgcn_rsqf(ss * (1.f / 128.f) + 1e-6f);
    const bf16_t* ogp = p.og + (row0 + row) * p.ld + head * 128 + part * 16; const v4u og0 = *(const v4u*)ogp, og1 = *(const v4u*)(ogp + 8);
    const unsigned ogw[8] = {og0.x, og0.y, og0.z, og0.w, og1.x, og1.y, og1.z, og1.w}; bf16_t* yp = p.y + (row0 + row) * p.ldy + head * 128 + part * 16; float yy[16];
#pragma unroll
    for (int k4 = 0; k4 < 4; ++k4) { f32x4v g4; g4[0] = bf2f((bf16_t)(ogw[2 * k4] & 0xffff)); g4[1] = bf2f((bf16_t)(ogw[2 * k4] >> 16)); g4[2] = bf2f((bf16_t)(ogw[2 * k4 + 1] & 0xffff)); g4[3] = bf2f((bf16_t)(ogw[2 * k4 + 1] >> 16)); const f32x4v n4 = *(const f32x4v*)(p.gnorm + part * 16 + 4 * k4); f32x4v y4;
#pragma unroll
      for (int e = 0; e < 4; ++e) { const float gg = g4[e]; y4[e] = o[4 * k4 + e] * rs * n4[e] * (gg / (1.f + __expf(-gg))); yy[4 * k4 + e] = y4[e]; } }
    { v4u o0, o1; o0.x = pk2(yy[0], yy[1]); o0.y = pk2(yy[2], yy[3]); o0.z = pk2(yy[4], yy[5]); o0.w = pk2(yy[6], yy[7]);
      o1.x = pk2(yy[8], yy[9]); o1.y = pk2(yy[10], yy[11]); o1.z = pk2(yy[12], yy[13]); o1.w = pk2(yy[14], yy[15]); *(v4u*)yp = o0; *(v4u*)(yp + 8) = o1; }
  }
  __syncthreads();
}

typedef short bf16x8g __attribute__((ext_vector_type(8)));
constexpr int LB = 72;
constexpr int OQB = 2 * 64 * LD * 4, OKB = OQB + 2 * 64 * LB * 2, OVT = OKB + 2 * 64 * LB * 2, OBEND = OVT + 128 * LB * 2;
static_assert(OBEND <= OAL, "gla bf16 lds");
#define GMM(A, B, C) C = __builtin_amdgcn_mfma_f32_32x32x16_bf16(__builtin_bit_cast(bf16x8g, A), __builtin_bit_cast(bf16x8g, B), C, 0, 0, 0)
__device__ __forceinline__ void store_vt(const VRegs& r, LAS unsigned char* lds, int tid) {
  LAS bf16_t* Vt = (LAS bf16_t*)(lds + OVT);
#pragma unroll
  for (int m = 0; m < 4; ++m) { const int t = (tid >> 5) + 16 * m, c4 = (tid & 31) * 4; const unsigned long long u = r.u[m];
    Vt[(c4 + 0) * LB + t] = (bf16_t)u; Vt[(c4 + 1) * LB + t] = (bf16_t)(u >> 16); Vt[(c4 + 2) * LB + t] = (bf16_t)(u >> 32); Vt[(c4 + 3) * LB + t] = (bf16_t)(u >> 48); }
}
__device__ __forceinline__ void g1b_unit(const In& p, LAS unsigned char* lds, int head, int cid, int GH, int NCH) {
  int tid = threadIdx.x; asm volatile("" : "+v"(tid));
  const int lane = tid & 63, w = __builtin_amdgcn_readfirstlane(tid >> 6), li = lane & 31, lk = lane >> 5;
  const long row0 = chunk_row(p, cid);
  const VRegs vr = load_v_regs(p, head, row0, tid);
  bf16_t kreg[8];
#pragma unroll
  for (int m = 0; m < 8; ++m) kreg[m] = p.k[(row0 + (tid >> 6) + 8 * m) * p.ld + head * 64 + (tid & 63)];
  cum_phase(p, lds, head, row0, tid);
  store_vt(vr, lds, tid);
  __syncthreads();
  LAS float* TOT = (LAS float*)(lds + OTOT);
  { const int j = tid & 63;
#pragma unroll
    for (int dir = 0; dir < 2; ++dir) { const LAS float* X = (const LAS float*)(lds + OX) + dir * 64 * LD; LAS bf16_t* KeT = (LAS bf16_t*)(lds + OQB) + dir * 64 * LB;
      const float cl = TOT[(dir * 64 + j) * 4 + 0] + TOT[(dir * 64 + j) * 4 + 1] + TOT[(dir * 64 + j) * 4 + 2] + TOT[(dir * 64 + j) * 4 + 3];
#pragma unroll
      for (int m = 0; m < 8; ++m) { const int t = (tid >> 6) + 8 * m; KeT[j * LB + t] = (bf16_t)f2bf(bf2f(kreg[m]) * __expf(cl - X[t * LD + j])); }
      if (tid < 64) p.dec[(((long)dir * GH + head) * NCH + cid) * 64 + j] = __expf(cl); }
  }
  __syncthreads();
  { const int dir = w >> 2, di = (w >> 1) & 1, vj0 = (w & 1) * 2; const LAS bf16_t* KeT = (const LAS bf16_t*)(lds + OQB) + dir * 64 * LB; const LAS bf16_t* Vt = (const LAS bf16_t*)(lds + OVT);
    f32x16 a0 = {}, a1 = {};
#pragma unroll
    for (int kk = 0; kk < 4; ++kk) { const v4u av = *(const LAS v4u*)(KeT + (32 * di + li) * LB + 16 * kk + 8 * lk);
      const v4u b0 = *(const LAS v4u*)(Vt + (32 * vj0 + li) * LB + 16 * kk + 8 * lk), b1 = *(const LAS v4u*)(Vt + (32 * vj0 + 32 + li) * LB + 16 * kk + 8 * lk);
      GMM(av, b0, a0); GMM(av, b1, a1); }
    bf16_t* dst = p.csb + ((((long)dir * GH + head) * NCH + cid) * 64) * 128;
#pragma unroll
    for (int r = 0; r < 16; ++r) { const int d = 32 * di + (r & 3) + 8 * (r >> 2) + 4 * lk; dst[(long)d * 128 + 32 * vj0 + li] = (bf16_t)f2bf(a0[r]); dst[(long)d * 128 + 32 * vj0 + 32 + li] = (bf16_t)f2bf(a1[r]); }
  }
  __syncthreads();
}
__device__ __forceinline__ void g3b_unit(const In& p, LAS unsigned char* lds, int head, int cid, int GH, int NCH) {
  int tid = threadIdx.x; asm volatile("" : "+v"(tid));
  const int lane = tid & 63, w = __builtin_amdgcn_readfirstlane(tid >> 6), li = lane & 31, lk = lane >> 5;
  const long row0 = chunk_row(p, cid);
  unsigned spf[2][32];
  { const int vj_ = w & 3;
#pragma unroll
    for (int dir = 0; dir < 2; ++dir) { const bf16_t* sp = p.csb + ((((long)dir * GH + head) * NCH + cid) * 64) * 128 + 32 * vj_ + li;
#pragma unroll
      for (int i = 0; i < 32; ++i) spf[dir][i] = sp[(long)(16 * (i >> 3) + 8 * lk + (i & 7)) * 128]; } }
  const VRegs vr = load_v_regs(p, head, row0, tid);
  bf16_t kreg[8], qreg[8];
#pragma unroll
  for (int m = 0; m < 8; ++m) { const long o_ = (row0 + (tid >> 6) + 8 * m) * p.ld + head * 64 + (tid & 63); kreg[m] = p.k[o_]; qreg[m] = p.q[o_]; }
  cum_phase(p, lds, head, row0, tid);
  store_vt(vr, lds, tid);
  __syncthreads();
  { const int j = tid & 63;
#pragma unroll
    for (int dir = 0; dir < 2; ++dir) { const LAS float* X = (const LAS float*)(lds + OX) + dir * 64 * LD; LAS bf16_t* Qb = (LAS bf16_t*)(lds + OQB) + dir * 64 * LB; LAS bf16_t* Kb = (LAS bf16_t*)(lds + OKB) + dir * 64 * LB;
#pragma unroll
      for (int m = 0; m < 8; ++m) { const int t = (tid >> 6) + 8 * m; const float c = X[t * LD + j];
        Qb[t * LB + j] = (bf16_t)f2bf(bf2f(qreg[m]) * 0.125f * __expf(c)); Kb[t * LB + j] = (bf16_t)f2bf(bf2f(kreg[m]) * __expf(-c)); } }
  }
  __syncthreads();
  {
    const int dir = w >> 2, qi = (w >> 1) & 1, si = w & 1; const bool zero = dir == 0 ? si > qi : si < qi;
    const LAS bf16_t* Qb = (const LAS bf16_t*)(lds + OQB) + dir * 64 * LB; LAS bf16_t* Kb = (LAS bf16_t*)(lds + OKB) + dir * 64 * LB;
    f32x16 pa = {};
    if (!zero) {
#pragma unroll
      for (int kk = 0; kk < 4; ++kk) { const v4u av = *(const LAS v4u*)(Qb + (32 * qi + li) * LB + 16 * kk + 8 * lk), bv = *(const LAS v4u*)(Kb + (32 * si + li) * LB + 16 * kk + 8 * lk); GMM(av, bv, pa); }
    }
    __syncthreads();
#pragma unroll
    for (int r = 0; r < 16; ++r) { const int q = 32 * qi + (r & 3) + 8 * (r >> 2) + 4 * lk, s = 32 * si + li; const bool keep = dir == 0 ? s <= q : s >= q;
      Kb[q * LB + s] = (bf16_t)f2bf(keep ? pa[r] : 0.f); }
  }
  __syncthreads();
  f32x16 acc = {};
  { const int qi = w >> 2, vj = w & 3; const LAS bf16_t* Vt = (const LAS bf16_t*)(lds + OVT);
#pragma unroll
    for (int dir = 0; dir < 2; ++dir) { const LAS bf16_t* Qb = (const LAS bf16_t*)(lds + OQB) + dir * 64 * LB; const LAS bf16_t* Pb = (const LAS bf16_t*)(lds + OKB) + dir * 64 * LB;
#pragma unroll
      for (int kk = 0; kk < 4; ++kk) { const v4u av = *(const LAS v4u*)(Pb + (32 * qi + li) * LB + 16 * kk + 8 * lk), bv = *(const LAS v4u*)(Vt + (32 * vj + li) * LB + 16 * kk + 8 * lk); GMM(av, bv, acc); }
#pragma unroll
      for (int kk = 0; kk < 4; ++kk) { const v4u av = *(const LAS v4u*)(Qb + (32 * qi + li) * LB + 16 * kk + 8 * lk);
        v4u bv; bv.x = spf[dir][8 * kk + 0] | (spf[dir][8 * kk + 1] << 16); bv.y = spf[dir][8 * kk + 2] | (spf[dir][8 * kk + 3] << 16); bv.z = spf[dir][8 * kk + 4] | (spf[dir][8 * kk + 5] << 16); bv.w = spf[dir][8 * kk + 6] | (spf[dir][8 * kk + 7] << 16);
        GMM(av, bv, acc); }
    }
    LAS float* O = (LAS float*)(lds + OX);
#pragma unroll
    for (int r = 0; r < 16; ++r) { const int q = 32 * qi + (r & 3) + 8 * (r >> 2) + 4 * lk; O[q * 129 + 32 * vj + li] = acc[r]; }
  }
  __syncthreads();
  { const int row = tid >> 3, part = tid & 7; const LAS float* O = (const LAS float*)(lds + OX) + row * 129 + part * 16;
    float o[16]; float ss = 0.f;
#pragma unroll
    for (int k = 0; k < 16; ++k) { o[k] = O[k]; ss += o[k] * o[k]; }
    ss += __shfl_xor(ss, 1); ss += __shfl_xor(ss, 2); ss += __shfl_xor(ss, 4);
    const float rs = __builtin_amdgcn_rsqf(ss * (1.f / 128.f) + 1e-6f);
    const bf16_t* ogp = p.og + (row0 + row) * p.ld + head * 128 + part * 16; const v4u og0 = *(const v4u*)ogp, og1 = *(const v4u*)(ogp + 8);
    const unsigned ogw[8] = {og0.x, og0.y, og0.z, og0.w, og1.x, og1.y, og1.z, og1.w}; bf16_t* yp = p.y + (row0 + row) * p.ldy + head * 128 + part * 16; float yy[16];
#pragma unroll
    for (int k4 = 0; k4 < 4; ++k4) { f32x4v g4; g4[0] = bf2f((bf16_t)(ogw[2 * k4] & 0xffff)); g4[1] = bf2f((bf16_t)(ogw[2 * k4] >> 16)); g4[2] = bf2f((bf16_t)(ogw[2 * k4 + 1] & 0xffff)); g4[3] = bf2f((bf16_t)(ogw[2 * k4 + 1] >> 16)); const f32x4v n4 = *(const f32x4v*)(p.gnorm + part * 16 + 4 * k4);
#pragma unroll
      for (int e = 0; e < 4; ++e) { const float gg = g4[e]; yy[4 * k4 + e] = o[4 * k4 + e] * rs * n4[e] * (gg / (1.f + __expf(-gg))); } }
    { v4u o0, o1; o0.x = pk2(yy[0], yy[1]); o0.y = pk2(yy[2], yy[3]); o0.z = pk2(yy[4], yy[5]); o0.w = pk2(yy[6], yy[7]);
      o1.x = pk2(yy[8], yy[9]); o1.y = pk2(yy[10], yy[11]); o1.z = pk2(yy[12], yy[13]); o1.w = pk2(yy[14], yy[15]); *(v4u*)yp = o0; *(v4u*)(yp + 8) = o1; }
  }
  __syncthreads();
}
#undef GMM
}
namespace moe {
constexpr int NE = 16, NG = 4, EPG = 4, DE = 512, D = 1024;
__device__ __forceinline__ float wave_sum(float v) {
#pragma unroll
  for (int o = 1; o < 64; o <<= 1) v += __shfl_xor(v, o);
  return v;
}
struct Route { int e0, r0, e1, r1; };
struct MoeOrder {
  int G, c, NT; const LAS int* poff;
  __device__ __forceinline__ bool next(int i, pg8::Unit& u) const {
    const long L = (long)i * G + c; const int total = poff[NE] * NT; if (L >= total) return false;
    const int panel = (int)L / NT, j = (int)L % NT; int e = 0;
#pragma unroll
    for (int k = 1; k < NE; ++k) e += (panel >= poff[k]) ? 1 : 0;
    u.pm = panel; u.pn = e * NT + j; u.acol = 0; u.nt = 0; return true;
  }
  __device__ __forceinline__ void a_ready(const pg8::Unit&) const {}
  __device__ __forceinline__ void done(const pg8::Unit&) const {}
};
struct EpiGU {
  static constexpr bool PERM = true, AFTER_DRAIN = false, CHAIN = false;
  bf16_t* hid;
  __device__ __forceinline__ void operator()(const pg8::f32x4 (&acc)[2][2][4][2], const pg8::Unit& u, int wr, int wc, int fr, int fq) const {
    const int j = u.pn & 3; const int row0 = u.pm * 256 + wr * 64 + fr, col0 = j * 128 + wc * 32 + 8 * fq;
#pragma unroll
    for (int ai = 0; ai < 2; ++ai)
#pragma unroll
      for (int m = 0; m < 4; ++m) { const size_t r = (size_t)(row0 + ai * 128 + m * 16); float hv[8];
#pragma unroll
        for (int n = 0; n < 2; ++n)
#pragma unroll
          for (int e = 0; e < 4; ++e) { const float g = acc[ai][0][m][n][e], up = acc[ai][1][m][n][e]; hv[4 * n + e] = g / (1.f + __expf(-g)) * up; }
        v4u o; o.x = pk2(hv[0], hv[1]); o.y = pk2(hv[2], hv[3]); o.z = pk2(hv[4], hv[5]); o.w = pk2(hv[6], hv[7]);
        *(v4u*)(hid + r * DE + col0) = o; }
  }
};
struct EpiDown {
  static constexpr bool PERM = true, AFTER_DRAIN = false, CHAIN = false;
  const int* srcrow; const float* wgt; bf16_t* contrib; size_t slot_stride;
  __device__ __forceinline__ void operator()(const pg8::f32x4 (&acc)[2][2][4][2], const pg8::Unit& u, int wr, int wc, int fr, int fq) const {
    const int pn = u.pn & 3; const int row0 = u.pm * 256 + wr * 64 + fr, col0 = pn * 256 + wc * 32 + 8 * fq;
    int srcs[2][4]; float ws_[2][4];
#pragma unroll
    for (int ai = 0; ai < 2; ++ai)
#pragma unroll
      for (int m = 0; m < 4; ++m) { const int r = row0 + ai * 128 + m * 16; srcs[ai][m] = srcrow[r]; ws_[ai][m] = wgt[r]; }
#pragma unroll
    for (int ai = 0; ai < 2; ++ai)
#pragma unroll
      for (int m = 0; m < 4; ++m) { const int src = srcs[ai][m]; if (src < 0) continue; const float w = ws_[ai][m];
        bf16_t* dst = contrib + (size_t)(src & 1) * slot_stride + (size_t)(src >> 1) * D + col0;
#pragma unroll
        for (int bj = 0; bj < 2; ++bj) { const pg8::f32x4 v0 = acc[ai][bj][m][0] * w, v1 = acc[ai][bj][m][1] * w;
          v4u o; o.x = pk2(v0[0], v0[1]); o.y = pk2(v0[2], v0[3]); o.z = pk2(v1[0], v1[1]); o.w = pk2(v1[2], v1[3]); *(v4u*)(dst + bj * 128) = o; } }
  }
};
__device__ __forceinline__ void route_row(const bf16_t* xr, const float* gnorm, const float* shift, const float* scale, bf16_t* hrow, const LAS float* rwT, const float* rbias,
                                          LAS int* cnt, Route* rt, float* wts, int lane) {
  typedef float f4 __attribute__((ext_vector_type(4)));
  f4 xv[4]; float ss = 0.f;
#pragma unroll
  for (int j = 0; j < 4; ++j) { const uint2 rw = *(const uint2*)(xr + 4 * lane + 256 * j); xv[j][0] = __uint_as_float(rw.x << 16); xv[j][1] = __uint_as_float(rw.x & 0xffff0000u); xv[j][2] = __uint_as_float(rw.y << 16); xv[j][3] = __uint_as_float(rw.y & 0xffff0000u); ss += xv[j][0] * xv[j][0] + xv[j][1] * xv[j][1] + xv[j][2] * xv[j][2] + xv[j][3] * xv[j][3]; }
  const float rs = __builtin_amdgcn_rsqf(wave_sum(ss) * (1.f / 1024.f) + 1e-6f);
  float lg[NE];
#pragma unroll
  for (int e = 0; e < NE; ++e) lg[e] = 0.f;
#pragma unroll
  for (int j = 0; j < 4; ++j) { const int c = 4 * lane + 256 * j; const f4 g4 = *(const f4*)(gnorm + c), sh = *(const f4*)(shift + c), sc = *(const f4*)(scale + c);
    f4 h;
#pragma unroll
    for (int i = 0; i < 4; ++i) h[i] = xv[j][i] * rs * g4[i] * (1.f + sc[i]) + sh[i];
    *(unsigned long long*)(hrow + c) = (unsigned long long)pk2(h[0], h[1]) | ((unsigned long long)pk2(h[2], h[3]) << 32);
#pragma unroll
    for (int e = 0; e < NE; ++e) { const f4 w4 = *(const LAS f4*)(rwT + e * 1024 + c); lg[e] += h[0] * w4[0] + h[1] * w4[1] + h[2] * w4[2] + h[3] * w4[3]; } }
  { float v8[8], v4[4], v2[2], v1;
#pragma unroll
    for (int i = 0; i < 8; ++i) { const bool up = lane & 1; const float keep = up ? lg[2 * i + 1] : lg[2 * i], send = up ? lg[2 * i] : lg[2 * i + 1]; v8[i] = keep + __shfl_xor(send, 1); }
#pragma unroll
    for (int i = 0; i < 4; ++i) { const bool up = lane & 2; const float keep = up ? v8[2 * i + 1] : v8[2 * i], send = up ? v8[2 * i] : v8[2 * i + 1]; v4[i] = keep + __shfl_xor(send, 2); }
#pragma unroll
    for (int i = 0; i < 2; ++i) { const bool up = lane & 4; const float keep = up ? v4[2 * i + 1] : v4[2 * i], send = up ? v4[2 * i] : v4[2 * i + 1]; v2[i] = keep + __shfl_xor(send, 4); }
    { const bool up = lane & 8; const float keep = up ? v2[1] : v2[0], send = up ? v2[0] : v2[1]; v1 = keep + __shfl_xor(send, 8); }
    v1 += __shfl_xor(v1, 16); v1 += __shfl_xor(v1, 32);
#pragma unroll
    for (int e = 0; e < NE; ++e) lg[e] = __shfl(v1, e); }
  float sc[NE], sel[NE];
#pragma unroll
  for (int e = 0; e < NE; ++e) { sc[e] = 1.f / (1.f + __expf(-lg[e])); sel[e] = sc[e] + rbias[e]; }
  int bestg = 0; float bestgs = -1e30f;
#pragma unroll
  for (int g = 0; g < NG; ++g) { float m1 = -1e30f, m2 = -1e30f;
#pragma unroll
    for (int i = 0; i < EPG; ++i) { const float v = sel[g * EPG + i]; if (v > m1) { m2 = m1; m1 = v; } else if (v > m2) m2 = v; }
    const float gsum = m1 + m2; if (gsum > bestgs) { bestgs = gsum; bestg = g; } }
  int i1 = -1, i2 = -1; float v1 = -1e30f, v2 = -1e30f, s1 = 0.f, s2 = 0.f;
#pragma unroll
  for (int e = 0; e < NE; ++e) { if (e / EPG == bestg) { const float v = sel[e];
      if (v > v1) { v2 = v1; i2 = i1; s2 = s1; v1 = v; i1 = e; s1 = sc[e]; } else if (v > v2) { v2 = v; i2 = e; s2 = sc[e]; } } }
  if (lane == 0) { const float inv = 1.f / (s1 + s2); Route r; r.e0 = i1; r.e1 = i2; r.r0 = __hip_atomic_fetch_add(cnt + i1, 1, __ATOMIC_RELAXED, __HIP_MEMORY_SCOPE_WORKGROUP); r.r1 = __hip_atomic_fetch_add(cnt + i2, 1, __ATOMIC_RELAXED, __HIP_MEMORY_SCOPE_WORKGROUP); *rt = r; wts[0] = s1 * inv; wts[1] = s2 * inv; }
}
__device__ __forceinline__ void route16(const bf16_t* x0, const LAS float* gp, const LAS float* sp, bf16_t* h0, const LAS v4u* wfrag, const float* rbias,
                                        LAS int* cnt, Route* rt0, float* wts0, int lane) {
  typedef float f4 __attribute__((ext_vector_type(4))); typedef short b8 __attribute__((ext_vector_type(8)));
  const int fr = lane & 15, fq = lane >> 4;
  const bf16_t* xr = x0 + (size_t)fr * 1024 + 8 * fq; bf16_t* hr = h0 + (size_t)fr * 1024 + 8 * fq;
  v4u xq[32];
#pragma unroll
  for (int kk = 0; kk < 32; ++kk) xq[kk] = *(const v4u*)(xr + 32 * kk);
  float ss = 0.f;
#pragma unroll
  for (int kk = 0; kk < 32; ++kk) { const v4u q = xq[kk]; float t;
    t = __uint_as_float(q.x << 16); ss += t * t; t = __uint_as_float(q.x & 0xffff0000u); ss += t * t; t = __uint_as_float(q.y << 16); ss += t * t; t = __uint_as_float(q.y & 0xffff0000u); ss += t * t;
    t = __uint_as_float(q.z << 16); ss += t * t; t = __uint_as_float(q.z & 0xffff0000u); ss += t * t; t = __uint_as_float(q.w << 16); ss += t * t; t = __uint_as_float(q.w & 0xffff0000u); ss += t * t; }
  ss += __shfl_xor(ss, 16); ss += __shfl_xor(ss, 32);
  const float rs = __builtin_amdgcn_rsqf(ss * (1.f / 1024.f) + 1e-6f);
#pragma unroll
  for (int kk = 0; kk < 32; ++kk) asm volatile("" : "+v"(xq[kk].x), "+v"(xq[kk].y), "+v"(xq[kk].z), "+v"(xq[kk].w));
  f4 acc = {0.f, 0.f, 0.f, 0.f};
#pragma unroll
  for (int kk = 0; kk < 32; ++kk) { const int c = 32 * kk + 8 * fq; const v4u q = xq[kk];
    const f4 ga = *(const LAS f4*)(gp + c), gb = *(const LAS f4*)(gp + c + 4), ha = *(const LAS f4*)(sp + c), hb = *(const LAS f4*)(sp + c + 4);
    const v4u wh = wfrag[kk * 64 + lane], wl = wfrag[2048 + kk * 64 + lane];
    float h[8];
    h[0] = __uint_as_float(q.x << 16) * (rs * ga[0]) + ha[0]; h[1] = __uint_as_float(q.x & 0xffff0000u) * (rs * ga[1]) + ha[1];
    h[2] = __uint_as_float(q.y << 16) * (rs * ga[2]) + ha[2]; h[3] = __uint_as_float(q.y & 0xffff0000u) * (rs * ga[3]) + ha[3];
    h[4] = __uint_as_float(q.z << 16) * (rs * gb[0]) + hb[0]; h[5] = __uint_as_float(q.z & 0xffff0000u) * (rs * gb[1]) + hb[1];
    h[6] = __uint_as_float(q.w << 16) * (rs * gb[2]) + hb[2]; h[7] = __uint_as_float(q.w & 0xffff0000u) * (rs * gb[3]) + hb[3];
    v4u hq; hq.x = pk2h(h[0], h[1]); hq.y = pk2h(h[2], h[3]); hq.z = pk2h(h[4], h[5]); hq.w = pk2h(h[6], h[7]);
    *(v4u*)(hr + 32 * kk) = hq;
    v4u lq; lq.x = pk2h(h[0] - __uint_as_float(hq.x << 16), h[1] - __uint_as_float(hq.x & 0xffff0000u)); lq.y = pk2h(h[2] - __uint_as_float(hq.y << 16), h[3] - __uint_as_float(hq.y & 0xffff0000u));
    lq.z = pk2h(h[4] - __uint_as_float(hq.z << 16), h[5] - __uint_as_float(hq.z & 0xffff0000u)); lq.w = pk2h(h[6] - __uint_as_float(hq.w << 16), h[7] - __uint_as_float(hq.w & 0xffff0000u));
    acc = __builtin_amdgcn_mfma_f32_16x16x32_bf16(__builtin_bit_cast(b8, wh), __builtin_bit_cast(b8, hq), acc, 0, 0, 0);
    acc = __builtin_amdgcn_mfma_f32_16x16x32_bf16(__builtin_bit_cast(b8, wl), __builtin_bit_cast(b8, hq), acc, 0, 0, 0);
    acc = __builtin_amdgcn_mfma_f32_16x16x32_bf16(__builtin_bit_cast(b8, wh), __builtin_bit_cast(b8, lq), acc, 0, 0, 0);
    if (kk & 1) asm volatile("" ::: "memory"); }
  float sc[4], sel[4]; const f4 rb4 = *(const f4*)(rbias + 4 * fq);
#pragma unroll
  for (int i = 0; i < 4; ++i) { sc[i] = 1.f / (1.f + __expf(-acc[i])); sel[i] = sc[i] + rb4[i]; }
  int i1 = -1, i2 = -1; float v1 = -1e30f, v2 = -1e30f, s1 = 0.f, s2 = 0.f;
#pragma unroll
  for (int i = 0; i < 4; ++i) { const float v = sel[i]; if (v > v1) { v2 = v1; i2 = i1; s2 = s1; v1 = v; i1 = i; s1 = sc[i]; } else if (v > v2) { v2 = v; i2 = i; s2 = sc[i]; } }
  float bgs = v1 + v2; int bg = fq;
  { float og = __shfl_xor(bgs, 16); int oi = __shfl_xor(bg, 16); if (og > bgs || (og == bgs && oi < bg)) { bgs = og; bg = oi; }
    og = __shfl_xor(bgs, 32); oi = __shfl_xor(bg, 32); if (og > bgs || (og == bgs && oi < bg)) { bgs = og; bg = oi; } }
  if (fq == bg) { const float inv = 1.f / (s1 + s2); Route r; r.e0 = 4 * fq + i1; r.e1 = 4 * fq + i2;
    r.r0 = __hip_atomic_fetch_add(cnt + r.e0, 1, __ATOMIC_RELAXED, __HIP_MEMORY_SCOPE_WORKGROUP); r.r1 = __hip_atomic_fetch_add(cnt + r.e1, 1, __ATOMIC_RELAXED, __HIP_MEMORY_SCOPE_WORKGROUP);
    rt0[fr] = r; wts0[2 * fr] = s1 * inv; wts0[2 * fr + 1] = s2 * inv; }
}
}
namespace hy {
typedef float f32x16 __attribute__((ext_vector_type(16)));
constexpr int S = 4096, NT1 = 128, LDZ = 191, ZPAD = 31, LDX = 129;
constexpr int O_TAPS = 0, O_ZA = 32768, O_ZB = O_ZA + 32 * LDZ * 4, O_X1 = O_ZB + 32 * LDZ * 4, O_X2 = O_X1 + 32 * LDX * 4, O_RED = O_X2 + 32 * LDX * 4, O_END = O_RED + 4 * 64 * 16 * 4;
static_assert(O_END <= 131072, "hyena lds");

struct H0Regs { v4u w0, w1; };
__device__ __forceinline__ H0Regs h0_load(const bf16_t* u, int ld, int tile, int tid) {
  const int tt = tile / 24, jt = tile % 24, t0 = tt * 64, j0 = jt * 64; H0Regs r; r.w0 = (v4u){0u, 0u, 0u, 0u}; r.w1 = r.w0;
  { const int rr = tid >> 3, c8 = (tid & 7) * 8, t = t0 - 1 + rr; if (t >= 0 && t < S) r.w0 = *(const v4u*)(u + (size_t)t * ld + j0 + c8); }
  if (tid < 16) { const int rr = 64 + (tid >> 3), c8 = (tid & 7) * 8, t = t0 - 1 + rr; if (t < S) r.w1 = *(const v4u*)(u + (size_t)t * ld + j0 + c8); }
  return r;
}
__device__ __forceinline__ void h0_compute(const H0Regs& rg, const float* cw, const float* cb, bf16_t* ucT, int tile, LAS unsigned char* lds, int tid) {
  const int tt = tile / 24, jt = tile % 24, t0 = tt * 64, j0 = jt * 64;
  LAS float* U = (LAS float*)lds;
  { const int rr = tid >> 3, c8 = (tid & 7) * 8; const v4u w = rg.w0; LAS float* d = U + rr * 65 + c8;
    d[0] = bf2f(w.x & 0xffff); d[1] = bf2f(w.x >> 16); d[2] = bf2f(w.y & 0xffff); d[3] = bf2f(w.y >> 16); d[4] = bf2f(w.z & 0xffff); d[5] = bf2f(w.z >> 16); d[6] = bf2f(w.w & 0xffff); d[7] = bf2f(w.w >> 16); }
  if (tid < 16) { const int rr = 64 + (tid >> 3), c8 = (tid & 7) * 8; const v4u w = rg.w1; LAS float* d = U + rr * 65 + c8;
    d[0] = bf2f(w.x & 0xffff); d[1] = bf2f(w.x >> 16); d[2] = bf2f(w.y & 0xffff); d[3] = bf2f(w.y >> 16); d[4] = bf2f(w.z & 0xffff); d[5] = bf2f(w.z >> 16); d[6] = bf2f(w.w & 0xffff); d[7] = bf2f(w.w >> 16); }
  __syncthreads();
  { const int jj = tid >> 3, tq = (tid & 7) * 8, j = j0 + jj; const float w0 = cw[j], w1 = cw[1536 + j], w2 = cw[2 * 1536 + j], bb = cb[j]; float v[8];
#pragma unroll
    for (int k = 0; k < 8; ++k) v[k] = bb + w0 * U[(tq + k) * 65 + jj] + w1 * U[(tq + k + 1) * 65 + jj] + w2 * U[(tq + k + 2) * 65 + jj];
    v4u o; o.x = pk2(v[0], v[1]); o.y = pk2(v[2], v[3]); o.z = pk2(v[4], v[5]); o.w = pk2(v[6], v[7]); *(v4u*)(ucT + (size_t)j * S + t0 + tq) = o; }
  __syncthreads();
}
__device__ __forceinline__ void h2_tile(const bf16_t* yT, bf16_t* ybf, int ldy, int tile, LAS unsigned char* lds) {
  int tid = threadIdx.x; asm volatile("" : "+v"(tid));
  const int tt = tile / 8, ct = tile % 8, t0 = tt * 64, c0 = ct * 64;
  LAS bf16_t* T = (LAS bf16_t*)lds;
  { const int cc = tid >> 3, t8 = (tid & 7) * 8; const v4u w = *(const v4u*)(yT + (size_t)(c0 + cc) * S + t0 + t8); LAS unsigned* d = (LAS unsigned*)(T + cc * 66 + t8); d[0] = w.x; d[1] = w.y; d[2] = w.z; d[3] = w.w; }
  __syncthreads();
  { const int t = tid >> 3, c8 = (tid & 7) * 8; unsigned short e[8];
#pragma unroll
    for (int k = 0; k < 8; ++k) e[k] = T[(c8 + k) * 66 + t];
    v4u o; o.x = e[0] | ((unsigned)e[1] << 16); o.y = e[2] | ((unsigned)e[3] << 16); o.z = e[4] | ((unsigned)e[5] << 16); o.w = e[6] | ((unsigned)e[7] << 16);
    *(v4u*)(ybf + (size_t)(t0 + t) * ldy + c0 + c8) = o; }
  __syncthreads();
}
__device__ __forceinline__ void h1_unit(const bf16_t* ucT, const float* tapsT, const float* nrm, const float* skip, bf16_t* yT, int c, LAS unsigned char* lds) {
  int tid = threadIdx.x; asm volatile("" : "+v"(tid));
  const int lane = tid & 63, w = __builtin_amdgcn_readfirstlane(tid >> 6), li = lane & 31, lk = lane >> 5;
  LAS float* TAPS = (LAS float*)(lds + O_TAPS); LAS float* ZA = (LAS float*)(lds + O_ZA); LAS float* ZB = (LAS float*)(lds + O_ZB);
  LAS float* X1 = (LAS float*)(lds + O_X1); LAS float* X2 = (LAS float*)(lds + O_X2); LAS float* RED = (LAS float*)(lds + O_RED);
  for (int e = tid; e < 32 * 62; e += 512) { const int s2 = e / 62, p = e % 62, t1p = p < 31 ? p : 128 + p; ZA[s2 * LDZ + t1p] = 0.f; ZB[s2 * LDZ + t1p] = 0.f; }
  for (int t = tid; t < S; t += 512) { const int t2 = t & 31, t1 = t >> 5;
    X1[t2 * LDX + t1] = bf2f(ucT[(size_t)c * S + t]); X2[t2 * LDX + t1] = bf2f(ucT[(size_t)(512 + c) * S + t]); ZA[t2 * LDZ + t1 + ZPAD] = bf2f(ucT[(size_t)(1024 + c) * S + t]); }
#pragma unroll 1
  for (int o = 0; o < 2; ++o) {
    const float* tp = tapsT + ((size_t)o * 512 + c) * 8192;
    for (int e = tid; e < 8192; e += 512) TAPS[e] = tp[(e + 4096) & 8191];
    __syncthreads();
    const LAS float* Zin = o == 0 ? ZA : ZB;
    const int g = w & 3, dh = w >> 2;
    const int Dlo = 32 * g - 127 + (dh ? 80 : 0), Dn = dh ? 79 : 80;
    f32x16 acc = {};
    { const LAS float* ap = TAPS + 4096 + 32 * Dlo + li - lk - 30;
      const LAS float* bp = Zin + lk * LDZ + (32 * g + li - Dlo + ZPAD);
#pragma unroll 2
      for (int dd = 0; dd < Dn; ++dd) {
#pragma unroll
        for (int kk = 0; kk < 16; ++kk) acc = __builtin_amdgcn_mfma_f32_32x32x2f32(ap[(15 - kk) * 2], bp[2 * kk * LDZ], acc, 0, 0, 0);
        ap += 32; bp -= 1; }
    }
    if (dh) {
#pragma unroll
      for (int r = 0; r < 16; ++r) RED[(g * 64 + lane) * 16 + r] = acc[r]; }
    __syncthreads();
    if (!dh) { const float inv = 1.f / nrm[o * 512 + c], sk = skip[o * 512 + c]; const LAS float* G = o == 0 ? X1 : X2; LAS float* Out = o == 0 ? ZB : ZA;
#pragma unroll
      for (int r = 0; r < 16; ++r) { const int t2 = (r & 3) + 8 * (r >> 2) + 4 * lk, t1 = 32 * g + li;
        const float cv = (acc[r] + RED[(g * 64 + lane) * 16 + r]) * inv; const float zin = Zin[t2 * LDZ + t1 + ZPAD];
        Out[t2 * LDZ + t1 + ZPAD] = G[t2 * LDX + t1] * (cv + sk * zin); } }
    __syncthreads();
  }
  for (int t = tid; t < S; t += 512) yT[(size_t)c * S + t] = (bf16_t)f2bf(ZA[(t & 31) * LDZ + (t >> 5) + ZPAD]);
  __syncthreads();
}

typedef short bf16x8v __attribute__((ext_vector_type(8)));
typedef unsigned u32x2v __attribute__((ext_vector_type(2)));
constexpr int CSB = 16448;
constexpr int ZROW = 80, ZROWS = 190;
constexpr int B_CS = 0, B_ZA = 4 * CSB, B_ZB = B_ZA + 15232, B_X1 = B_ZB + 15232, B_X2 = B_X1 + 8256, B_RED = B_X2 + 8256, B_END = B_RED + 16384;
static_assert(B_END <= 131072 && B_ZA % 16 == 0 && B_X1 % 16 == 0, "hyena bf16 lds");
__device__ __forceinline__ void h1b_unit(const bf16_t* ucT, const bf16_t* tapsB, const float* nrm, const float* skip, bf16_t* yT, int c, LAS unsigned char* lds) {
  int tid = threadIdx.x; asm volatile("" : "+v"(tid));
  const int lane = tid & 63, w = __builtin_amdgcn_readfirstlane(tid >> 6), li = lane & 31, lk = lane >> 5;
  LAS bf16_t* ZA = (LAS bf16_t*)(lds + B_ZA); LAS bf16_t* ZB = (LAS bf16_t*)(lds + B_ZB); LAS bf16_t* X1 = (LAS bf16_t*)(lds + B_X1); LAS bf16_t* X2 = (LAS bf16_t*)(lds + B_X2);
  LAS float* RED = (LAS float*)(lds + B_RED);
  for (int e = tid; e < 62 * 20; e += 512) { const int p = e / 20, d = e % 20, row = p < 31 ? p : 128 + p; ((LAS unsigned*)ZA)[row * 20 + d] = 0u; ((LAS unsigned*)ZB)[row * 20 + d] = 0u; }
  { const v4u zv = *(const v4u*)(ucT + (size_t)(1024 + c) * S + tid * 8); const int t = tid * 8; *(LAS v4u*)((LAS unsigned char*)ZA + ((t >> 5) + ZPAD) * ZROW + (t & 31) * 2) = zv; }
  { const v4u xa = *(const v4u*)(ucT + (size_t)c * S + tid * 8), xb = *(const v4u*)(ucT + (size_t)(512 + c) * S + tid * 8); const int t1 = tid >> 2, t2b = (tid & 3) * 8;
    const unsigned wa[4] = {xa.x, xa.y, xa.z, xa.w}, wb[4] = {xb.x, xb.y, xb.z, xb.w};
#pragma unroll
    for (int k = 0; k < 4; ++k) { X1[(t2b + 2 * k) * LDX + t1] = (bf16_t)(wa[k] & 0xffff); X1[(t2b + 2 * k + 1) * LDX + t1] = (bf16_t)(wa[k] >> 16);
      X2[(t2b + 2 * k) * LDX + t1] = (bf16_t)(wb[k] & 0xffff); X2[(t2b + 2 * k + 1) * LDX + t1] = (bf16_t)(wb[k] >> 16); } }
  typedef unsigned u4a __attribute__((ext_vector_type(4), aligned(4))); typedef const __attribute__((address_space(1))) u4a* gp4;
  v4u cv[9];
#pragma unroll 1
  for (int o = 0; o < 2; ++o) {
#define HTAPS_LOAD(oo) { const __attribute__((address_space(1))) unsigned char* tb = (const __attribute__((address_space(1))) unsigned char*)(tapsB + ((size_t)(oo) * 512 + c) * 2 * 8232); \
      _Pragma("unroll") for (int it = 0; it < 9; ++it) { const int e = tid + 512 * it; const int s = e / 1028, q = e % 1028; cv[it] = (v4u){0u, 0u, 0u, 0u}; if (e < 4 * 1028) cv[it] = *(gp4)(tb + (size_t)(s & 1) * 16464 + 16 * q + 4 * (s >> 1)); } }
    if (o == 0) HTAPS_LOAD(0)
    {
#pragma unroll
      for (int it = 0; it < 9; ++it) { const int e = tid + 512 * it; const int s = e / 1028, q = e % 1028; if (e < 4 * 1028) *(LAS v4u*)(lds + B_CS + s * CSB + 16 * q) = cv[it]; } }
    __syncthreads();
    if (o == 0) HTAPS_LOAD(1)
    const LAS bf16_t* Zin = o == 0 ? ZA : ZB;
    const int g = w & 3, dh = w >> 2;
    const int Dlo = 32 * g - 127 + (dh ? 81 : 0), Dn = dh ? 78 : 81;
    f32x16 acc = {};
    { const int s = (4 - (li & 3)) & 3;
      const LAS unsigned char* ap = lds + B_CS + s * CSB + 2 * (4096 - 32 * Dlo - li + 8 * lk - s);
      const LAS unsigned char* bp = (const LAS unsigned char*)Zin + (32 * g + li - Dlo + ZPAD) * ZROW + 16 * lk;
#define HLD(A0, A1, B0, B1) { const u32x2v p0_ = *(const LAS u32x2v*)(ap), p1_ = *(const LAS u32x2v*)(ap2), p2_ = *(const LAS u32x2v*)(ap3), p3_ = *(const LAS u32x2v*)(ap4); \
        A0 = (v4u){p0_.x, p0_.y, p1_.x, p1_.y}; A1 = (v4u){p2_.x, p2_.y, p3_.x, p3_.y}; B0 = *(const LAS v4u*)(bp); B1 = *(const LAS v4u*)(bp + 32); ap -= 64; ap2 -= 64; ap3 -= 64; ap4 -= 64; bp -= ZROW; }
#define HMM(A, B) acc = __builtin_amdgcn_mfma_f32_32x32x16_bf16(__builtin_bit_cast(bf16x8v, A), __builtin_bit_cast(bf16x8v, B), acc, 0, 0, 0)
#define HOPQ(name, off) unsigned name##i = (unsigned)(unsigned long long)(ap + (off)); asm volatile("" : "+v"(name##i)); const LAS unsigned char* name = (const LAS unsigned char*)(unsigned long long)name##i;
      HOPQ(ap2, 8) HOPQ(ap3, 32) HOPQ(ap4, 40)
#undef HOPQ
      v4u fa0, fa1, fb0, fb1, ga0, ga1, gb0, gb1, ha0, ha1, hb0, hb1;
      HLD(fa0, fa1, fb0, fb1)
      HLD(ga0, ga1, gb0, gb1)
      for (int dd_ = 0; dd_ < Dn - 3; dd_ += 3) {
        HLD(ha0, ha1, hb0, hb1)
        HMM(fa0, fb0); HMM(fa1, fb1);
        HLD(fa0, fa1, fb0, fb1)
        HMM(ga0, gb0); HMM(ga1, gb1);
        HLD(ga0, ga1, gb0, gb1)
        HMM(ha0, hb0); HMM(ha1, hb1);
      }
      HLD(ha0, ha1, hb0, hb1)
      HMM(fa0, fb0); HMM(fa1, fb1); HMM(ga0, gb0); HMM(ga1, gb1); HMM(ha0, hb0); HMM(ha1, hb1);
#undef HLD
#undef HMM
    }
    if (dh) {
#pragma unroll
      for (int r = 0; r < 16; ++r) RED[(g * 64 + lane) * 16 + r] = acc[r]; }
    __syncthreads();
    if (!dh) { const float inv = 1.f / nrm[o * 512 + c], sk = skip[o * 512 + c]; const LAS bf16_t* G = o == 0 ? X1 : X2; LAS bf16_t* Out = o == 0 ? ZB : ZA;
#pragma unroll
      for (int r = 0; r < 16; ++r) { const int t2 = (r & 3) + 8 * (r >> 2) + 4 * lk, t1 = 32 * g + li;
        const float cv = (acc[r] + RED[(g * 64 + lane) * 16 + r]) * inv; const float zin = bf2f(Zin[(t1 + ZPAD) * (ZROW / 2) + t2]);
        Out[(t1 + ZPAD) * (ZROW / 2) + t2] = (bf16_t)f2bf(bf2f(G[t2 * LDX + t1]) * (cv + sk * zin)); } }
    __syncthreads();
  }
  { const int t = tid * 8; *(v4u*)(yT + (size_t)c * S + t) = *(const LAS v4u*)((const LAS unsigned char*)ZA + ((t >> 5) + ZPAD) * ZROW + (t & 31) * 2); }
  __syncthreads();
}
#undef HTAPS_LOAD

constexpr int C_ZP = 15, C_ZB = 159 * ZROW  , C_CS = 0, C_Z0 = 4 * CSB, C_X0 = C_Z0 + 2 * C_ZB, C_END = C_X0 + 4 * 8256;
static_assert(C_END <= 131072 && C_Z0 % 16 == 0 && C_ZB % 16 == 0 && C_X0 % 16 == 0, "hyena two-batch lds");
__device__ __forceinline__ void h1c_unit(const bf16_t* ucT2, const bf16_t* tapsB, const float* nrm, const float* skip, bf16_t* yT2, int c, LAS unsigned char* lds) {
  int tid = threadIdx.x; asm volatile("" : "+v"(tid));
  const int lane = tid & 63, g = __builtin_amdgcn_readfirstlane(tid >> 6), li = lane & 31, lk = lane >> 5, bsel = li >> 4, t1l = li & 15;
  for (int e = tid; e < 2 * 31 * 20; e += 512) { const int b = e / (31 * 20), p = (e / 20) % 31, d = e % 20, row = p < 15 ? p : 128 + p; ((LAS unsigned*)(lds + C_Z0 + b * C_ZB))[row * 20 + d] = 0u; }
#pragma unroll
  for (int b = 0; b < 2; ++b) { const bf16_t* uc = ucT2 + (size_t)b * 1536 * S; const int t = tid * 8;
    const v4u zv = *(const v4u*)(uc + (size_t)(1024 + c) * S + t), xa = *(const v4u*)(uc + (size_t)c * S + t), xb = *(const v4u*)(uc + (size_t)(512 + c) * S + t);
    *(LAS v4u*)(lds + C_Z0 + b * C_ZB + ((t >> 5) + C_ZP) * ZROW + (t & 31) * 2) = zv;
    LAS bf16_t* X1 = (LAS bf16_t*)(lds + C_X0 + (2 * b) * 8256); LAS bf16_t* X2 = (LAS bf16_t*)(lds + C_X0 + (2 * b + 1) * 8256); const int t1 = tid >> 2, t2b = (tid & 3) * 8;
    const unsigned wa[4] = {xa.x, xa.y, xa.z, xa.w}, wb[4] = {xb.x, xb.y, xb.z, xb.w};
#pragma unroll
    for (int k = 0; k < 4; ++k) { X1[(t2b + 2 * k) * LDX + t1] = (bf16_t)(wa[k] & 0xffff); X1[(t2b + 2 * k + 1) * LDX + t1] = (bf16_t)(wa[k] >> 16);
      X2[(t2b + 2 * k) * LDX + t1] = (bf16_t)(wb[k] & 0xffff); X2[(t2b + 2 * k + 1) * LDX + t1] = (bf16_t)(wb[k] >> 16); } }
  typedef unsigned u4a __attribute__((ext_vector_type(4), aligned(4))); typedef const __attribute__((address_space(1))) u4a* gp4;
  v4u cv[9];
  LAS bf16_t* Zm = (LAS bf16_t*)(lds + C_Z0 + bsel * C_ZB);
#pragma unroll 1
  for (int o = 0; o < 2; ++o) {
#define HTAPS_LOAD(oo) { const __attribute__((address_space(1))) unsigned char* tb = (const __attribute__((address_space(1))) unsigned char*)(tapsB + ((size_t)(oo) * 512 + c) * 2 * 8232); \
      _Pragma("unroll") for (int it = 0; it < 9; ++it) { const int e = tid + 512 * it; const int s = e / 1028, q = e % 1028; cv[it] = (v4u){0u, 0u, 0u, 0u}; if (e < 4 * 1028) cv[it] = *(gp4)(tb + (size_t)(s & 1) * 16464 + 16 * q + 4 * (s >> 1)); } }
    if (o == 0) HTAPS_LOAD(0)
    {
#pragma unroll
      for (int it = 0; it < 9; ++it) { const int e = tid + 512 * it; const int s = e / 1028, q = e % 1028; if (e < 4 * 1028) *(LAS v4u*)(lds + C_CS + s * CSB + 16 * q) = cv[it]; } }
    __syncthreads();
    if (o == 0) HTAPS_LOAD(1)
    const int Dlo = 16 * g - 128; constexpr int Dn = 144;
    f32x16 acc = {};
    { const int s = (4 - (li & 3)) & 3;
      const LAS unsigned char* ap = lds + C_CS + s * CSB + 2 * (4096 - 32 * Dlo - li + 8 * lk - s);
      const LAS unsigned char* bp = (const LAS unsigned char*)Zm + (16 * g + t1l - Dlo + C_ZP) * ZROW + 16 * lk;
#define HLD(A0, A1, B0, B1) { const u32x2v p0_ = *(const LAS u32x2v*)(ap), p1_ = *(const LAS u32x2v*)(ap2), p2_ = *(const LAS u32x2v*)(ap3), p3_ = *(const LAS u32x2v*)(ap4); \
        A0 = (v4u){p0_.x, p0_.y, p1_.x, p1_.y}; A1 = (v4u){p2_.x, p2_.y, p3_.x, p3_.y}; B0 = *(const LAS v4u*)(bp); B1 = *(const LAS v4u*)(bp + 32); ap -= 64; ap2 -= 64; ap3 -= 64; ap4 -= 64; bp -= ZROW; }
#define HMM(A, B) acc = __builtin_amdgcn_mfma_f32_32x32x16_bf16(__builtin_bit_cast(bf16x8v, A), __builtin_bit_cast(bf16x8v, B), acc, 0, 0, 0)
#define HOPQ(name, off) unsigned name##i = (unsigned)(unsigned long long)(ap + (off)); asm volatile("" : "+v"(name##i)); const LAS unsigned char* name = (const LAS unsigned char*)(unsigned long long)name##i;
      HOPQ(ap2, 8) HOPQ(ap3, 32) HOPQ(ap4, 40)
#undef HOPQ
      v4u fa0, fa1, fb0, fb1, ga0, ga1, gb0, gb1, ha0, ha1, hb0, hb1;
      HLD(fa0, fa1, fb0, fb1)
      HLD(ga0, ga1, gb0, gb1)
      for (int dd_ = 0; dd_ < Dn - 3; dd_ += 3) {
        HLD(ha0, ha1, hb0, hb1)
        HMM(fa0, fb0); HMM(fa1, fb1);
        HLD(fa0, fa1, fb0, fb1)
        HMM(ga0, gb0); HMM(ga1, gb1);
        HLD(ga0, ga1, gb0, gb1)
        HMM(ha0, hb0); HMM(ha1, hb1);
      }
      HLD(ha0, ha1, hb0, hb1)
      HMM(fa0, fb0); HMM(fa1, fb1); HMM(ga0, gb0); HMM(ga1, gb1); HMM(ha0, hb0); HMM(ha1, hb1);
#undef HLD
#undef HMM
    }
    __syncthreads();
    { const float inv = 1.f / nrm[o * 512 + c], sk = skip[o * 512 + c]; const LAS bf16_t* G = (const LAS bf16_t*)(lds + C_X0 + (2 * bsel + o) * 8256);
#pragma unroll
      for (int r = 0; r < 16; ++r) { const int t2 = (r & 3) + 8 * (r >> 2) + 4 * lk, t1 = 16 * g + t1l;
        const float cvv = acc[r] * inv; const float zin = bf2f(Zm[(t1 + C_ZP) * (ZROW / 2) + t2]);
        Zm[(t1 + C_ZP) * (ZROW / 2) + t2] = (bf16_t)f2bf(bf2f(G[t2 * LDX + t1]) * (cvv + sk * zin)); } }
    __syncthreads();
  }
#pragma unroll
  for (int b = 0; b < 2; ++b) { const int t = tid * 8; *(v4u*)(yT2 + (size_t)b * 512 * S + (size_t)c * S + t) = *(const LAS v4u*)(lds + C_Z0 + b * C_ZB + ((t >> 5) + C_ZP) * ZROW + (t & 31) * 2); }
  __syncthreads();
#undef HTAPS_LOAD
}
__device__ __forceinline__ void cconv3_item(const bf16_t* u, int ld, const float* cw, const float* cb, float* ucc, long idx) {
  const int j = (int)(idx % 1536); const int tc = (int)(idx / 1536);
  const bf16_t* up = u + (size_t)tc * ld + j;
  float v = cb[j] + cw[1536 + j] * bf2f(up[0]);
  if (tc > 0) v += cw[j] * bf2f(*(up - ld)); if (tc < 255) v += cw[2 * 1536 + j] * bf2f(up[ld]);
  ucc[idx] = v;
}
__device__ __forceinline__ void clong_item(const float* ucc, const float* z1c_in, float* z1c_out, bf16_t* yout, int ldy, const float* tapsC, const float* nrmC, const float* skip, int o, long idx) {
  const int c = (int)(idx % 512), t0 = (int)(idx / 512) * 8; constexpr int n = 256;
  const float* tp = tapsC + (size_t)o * 2 * n * 512 + c; const float nr = nrmC[o * 512 + c];
  const float* zs = o == 0 ? ucc + 1024 + c : z1c_in + c; const int ldz = o == 0 ? 1536 : 512;
  float acc[8], w[8];
#pragma unroll
  for (int i = 0; i < 8; ++i) { acc[i] = 0.f; const int lag = t0 + i; w[i] = tp[(size_t)lag * 512]; }
#pragma unroll 4
  for (int s = 0; s < n; ++s) { const float zv = zs[(size_t)s * ldz];
#pragma unroll
    for (int i = 0; i < 8; ++i) acc[i] += w[i] * zv;
    const int lag = t0 - s - 1;
    const float nw = tp[(size_t)(lag >= 0 ? lag : 2 * n + lag) * 512];
#pragma unroll
    for (int i = 7; i > 0; --i) w[i] = w[i - 1];
    w[0] = nw; }
  const float sk = skip[o * 512 + c];
#pragma unroll
  for (int i = 0; i < 8; ++i) { const int t = t0 + i; const float val = ucc[(size_t)t * 1536 + o * 512 + c] * (acc[i] / nr + sk * zs[(size_t)t * ldz]);
    if (o == 0) z1c_out[(size_t)t * 512 + c] = val; else yout[(size_t)t * ldy + c] = (bf16_t)f2bf(val); }
}
}
#define XB_TMO      128
#define XB_XCNT(j)  (256  + 64 * (j))
#define XB_XSUB(j)  (1280 + 64 * (j))
#define XB_XGEN(j)  (2304 + 64 * (j))
#define XB_TOP      3328
#define XB_TOPGEN   3392
#define XCD_BAR_WORDS 3456
#define XB_SPIN_CAP (1u << 18)

__device__ __forceinline__ unsigned xb_ld(unsigned* p)              { return __hip_atomic_load(p, __ATOMIC_RELAXED, __HIP_MEMORY_SCOPE_AGENT); }
__device__ __forceinline__ unsigned xb_add(unsigned* p, unsigned v) { return __hip_atomic_fetch_add(p, v, __ATOMIC_RELAXED, __HIP_MEMORY_SCOPE_AGENT); }
__device__ __forceinline__ unsigned xb_xcc_id() { return (unsigned)__builtin_amdgcn_s_getreg((3 << 11) | 20) & 0xFu; }
#define XB_SPIN(cond, bar) do { unsigned _sp = 0; while (cond) { __builtin_amdgcn_s_sleep(1); \
    if ((++_sp & 255u) == 0u) { if (xb_ld(&(bar)[XB_TMO])) break; if (_sp > XB_SPIN_CAP) { atomicAdd(&(bar)[XB_TMO], 1u); break; } } } } while (0)

struct XcdBarrier {
    unsigned* bar; unsigned x;
    volatile LAS unsigned* st;
};

__device__ __forceinline__ XcdBarrier xcd_barrier_post(unsigned* bar, volatile LAS unsigned* st) {
    XcdBarrier b; b.bar = bar; b.x = xb_xcc_id(); b.st = st;
    if (threadIdx.x == 0) (void)xb_add(&bar[XB_XCNT(b.x)], 1u);
    return b;
}
__device__ __forceinline__ void xcd_barrier_complete(unsigned* bar, unsigned x, unsigned& nloc, unsigned& nx) {
    const unsigned G = gridDim.x * gridDim.y * gridDim.z;
    unsigned sum, cnt, mine, sp = 0u;
    for (;;) {
        sum = 0u; cnt = 0u; mine = 0u;
#pragma unroll
        for (unsigned j = 0; j < 16; ++j) { const unsigned c = xb_ld(&bar[XB_XCNT(j)]); sum += c; cnt += (c > 0u) ? 1u : 0u; mine = (j == x) ? c : mine; }
        if (sum == G) break;
        __builtin_amdgcn_s_sleep(1);
        if ((++sp & 255u) == 0u) { if (xb_ld(&bar[XB_TMO])) break; if (sp > XB_SPIN_CAP) { atomicAdd(&bar[XB_TMO], 1u); break; } }
    }
    nloc = mine > 0u ? mine : 1u; nx = cnt > 0u ? cnt : 1u;
}

__device__ __forceinline__ void xcd_barrier(const XcdBarrier& b) {
    asm volatile("s_waitcnt vmcnt(0)" ::: "memory");
    __syncthreads();
    if (threadIdx.x == 0) {
        unsigned* bar = b.bar;
#define XB_SP(word) ((unsigned*)((((unsigned long long)(unsigned)__builtin_amdgcn_readfirstlane((int)((unsigned long long)(bar + (word)) >> 32))) << 32) | (unsigned)__builtin_amdgcn_readfirstlane((int)(unsigned)(unsigned long long)(bar + (word)))))
        unsigned* const p_xsub = XB_SP(XB_XSUB(b.x)); unsigned* const p_xgen = XB_SP(XB_XGEN(b.x));
        __builtin_amdgcn_s_waitcnt(0);
        unsigned nloc = b.st[0], nx = b.st[1];
        if (nloc == 0u) { xcd_barrier_complete(bar, b.x, nloc, nx); b.st[0] = nloc; b.st[1] = nx; }
        const unsigned old = xb_add(p_xsub, 1u);
        const unsigned gen = old / nloc;
        if (old + 1u == (gen + 1u) * nloc) {
            __builtin_amdgcn_fence(__ATOMIC_RELEASE, "agent");
            asm volatile("s_waitcnt vmcnt(0)" ::: "memory");
            const unsigned og = xb_add(&bar[XB_TOP], 1u);
            const unsigned tg = og / nx;
            if (og + 1u == (tg + 1u) * nx) xb_add(&bar[XB_TOPGEN], 1u);
            else XB_SPIN(xb_ld(&bar[XB_TOPGEN]) == tg, bar);
            __builtin_amdgcn_fence(__ATOMIC_ACQUIRE, "agent");
            xb_add(p_xgen, 1u);
            asm volatile("s_waitcnt vmcnt(0)" ::: "memory");
        } else {
            XB_SPIN(xb_ld(p_xgen) == gen, bar);
            __builtin_amdgcn_fence(__ATOMIC_ACQUIRE, "agent");
            asm volatile("s_waitcnt vmcnt(0)" ::: "memory");
        }
    }
    __syncthreads();
}
#include <math.h>
#ifdef HOST_TEST
#define HD
#define FEXP expf
#define FSIN sinf
#define FCOS cosf
#define FLOG logf
#define FPOW powf
#else
#define HD __device__ __forceinline__
#define FEXP __expf
#define FSIN __sinf
#define FCOS __cosf
#define FLOG __logf
#define FPOW __powf
#endif

struct FullDims { static constexpr int D=1024,B=8,S=4096,DEPTH=2,C=256,GW=64,AH=8,AKV=2,HDM=128,GH=4,GDK=64,GDV=128,GR=16,HW=512,HB=16,HF=64,NE=16,NG=4,DE=512; };
struct SmallDims { static constexpr int D=64,B=2,S=128,DEPTH=2,C=32,GW=16,AH=4,AKV=2,HDM=16,GH=2,GDK=8,GDV=16,GR=4,HW=32,HB=4,HF=8,NE=8,NG=2,DE=32; };

template <class T> struct DD {
  static constexpr int D=T::D,B=T::B,S=T::S,DEPTH=T::DEPTH,C=T::C,GW=T::GW,AH=T::AH,AKV=T::AKV,HDM=T::HDM,GH=T::GH,GDK=T::GDK,GDV=T::GDV,GR=T::GR,HW=T::HW,HB=T::HB,HF=T::HF,NE=T::NE,NG=T::NG,DE=T::DE;
  static constexpr int R=S+C, AG=AH/AKV, RP=HDM/4, HE=1+2*HB, EPG=NE/NG, AQW=AH*HDM, AKVW=AKV*HDM, GKW=GH*GDK, GVW=GH*GDV;
  static constexpr int NKV=AKVW+AKVW+GKW+GVW+2*GR, NIN=NKV+AQW+GKW+GVW+3*HW+3*D;
  static constexpr int O_AK=0, O_AV=AKVW, O_GK=2*AKVW, O_GV=2*AKVW+GKW, O_GA=2*AKVW+GKW+GVW;
  static constexpr int O_AQ=NKV, O_GQ=NKV+AQW, O_OG=O_GQ+GKW, O_HY=O_OG+GVW, O_BR=O_HY+3*HW;
};

struct NaiveBufs {
  const float *x,*c,*ctx,*c_ctx,*w_mod,*b_mod,*norm1_g,*norm2_g,*w_in,*q_norm_g,*k_norm_g,*gla_wa2,*gla_ba,*gla_norm_g,*hy_conv_w,*hy_conv_b,
    *hy_pos_w1,*hy_pos_b1,*hy_sin_freq,*hy_pos_w2,*hy_pos_b2,*hy_pos_w3,*hy_decay,*hy_skip,*w_br_hy,*w_br_gla,*w_br_att,*w_out,*router_w,*router_b,*moe_w_gate,*moe_w_up,*moe_w_down;
  float* out;
  float *mod;
  float *hid2S,*hid2C;
  float *tapsS,*tapsC;
  float *nrmS,*nrmC;
  float *rs;
  float *h;
  float *proj;
  float *qn,*kn;
  float *yatt;
  float *laf,*lab;
  float *of,*ob;
  float *ygla;
  float *uc;
  float *z1,*yhy;
  float *m;
  int   *ridx;
  float *rw;
  float *hid;
  float *xc;
};

HD float sigmoidf_(float x) { return 1.f / (1.f + FEXP(-x)); }
HD float siluf_(float x) { return x / (1.f + FEXP(-x)); }
HD float logsigmoidf_(float x) { return x < 0.f ? x - FLOG(1.f + FEXP(x)) : -FLOG(1.f + FEXP(-x)); }

template <class T> HD void st_mod(const NaiveBufs& a, int l, long idx) {
  using d = DD<T>; const int j = (int)(idx % (6 * d::D)), bb = (int)(idx / (6 * d::D));
  const float* cv = bb < d::B ? a.c + (long)bb * d::D : a.c_ctx; const float* w = a.w_mod + (long)l * d::D * 6 * d::D;
  float acc = a.b_mod[(long)l * 6 * d::D + j];
  for (int k = 0; k < d::D; ++k) acc += siluf_(cv[k]) * w[(long)k * 6 * d::D + j];
  a.mod[idx] = acc;
}
template <class T> HD void st_hyhid(const NaiveBufs& a, int l, int which, long idx) {
  using d = DD<T>; const int n = which ? d::C : d::S; float* dst = which ? a.hid2C : a.hid2S;
  const int j = (int)(idx % d::HF), t = (int)(idx / d::HF);
  const float* w1 = a.hy_pos_w1 + (long)l * d::HE * d::HF; const float* b1 = a.hy_pos_b1 + l * d::HF; const float* fr = a.hy_sin_freq + l * d::HF;
  const float* w2 = a.hy_pos_w2 + (long)l * d::HF * d::HF; const float* b2 = a.hy_pos_b2 + l * d::HF;
  const float tn = (float)t / (float)n; const float w0 = 2.f * 3.14159265358979323846f / (float)n;
  float acc2 = b2[j];
  for (int i = 0; i < d::HF; ++i) {
    float acc = b1[i] + tn * w1[0 * d::HF + i];
    for (int bnd = 0; bnd < d::HB; ++bnd) {
      const float band = 1e-4f + (float)bnd * ((float)(d::HB - 1) - 1e-4f) / (float)(d::HB - 1);
      const float ph = w0 * (float)t * band;
      acc += FCOS(ph) * w1[(1 + bnd) * d::HF + i] - FSIN(ph) * w1[(1 + d::HB + bnd) * d::HF + i];
    }
    acc2 += FSIN(fr[i] * acc) * w2[i * d::HF + j];
  }
  dst[idx] = FSIN(fr[j] * acc2);
}
template <class T> HD void st_hytaps(const NaiveBufs& a, int l, int which, long idx) {
  using d = DD<T>; const int n = which ? d::C : d::S; const float* hid2 = which ? a.hid2C : a.hid2S; float* dst = which ? a.tapsC : a.tapsS;
  const int c = (int)(idx % d::HW); const int li = (int)((idx / d::HW) % (2 * n)); const int o = (int)(idx / ((long)d::HW * 2 * n));
  float v = 0.f;
  if (li != n) {
    const int dir = li < n ? 0 : 1; const int t = li < n ? li : 2 * n - li;
    const int col = (o * 2 + dir) * d::HW + c;
    const float* w3 = a.hy_pos_w3 + (long)l * d::HF * 4 * d::HW;
    float acc = 0.f;
    for (int j = 0; j < d::HF; ++j) acc += hid2[(long)t * d::HF + j] * w3[(long)j * 4 * d::HW + col];
    const float dec = fabsf(a.hy_decay[(long)l * 4 * d::HW + col]);
    v = acc * FEXP(-((float)t / (float)n) * dec);
  }
  if (which == 0) dst[((long)o * d::HW + c) * 2 * n + li] = v; else dst[idx] = v;
}
template <class T> HD void st_hynorm(const NaiveBufs& a, int which, long idx) {
  using d = DD<T>; const int n = which ? d::C : d::S; const float* tp = which ? a.tapsC : a.tapsS; float* dst = which ? a.nrmC : a.nrmS;
  const int c = (int)(idx % d::HW), o = (int)(idx / d::HW);
  float s = 0.f; for (int li = 0; li < 2 * n; ++li) s += fabsf(which == 0 ? tp[((long)o * d::HW + c) * 2 * n + li] : tp[((long)o * 2 * n + li) * d::HW + c]);
  dst[idx] = s + 1e-6f;
}

template <class T> HD const float* xrow(const NaiveBufs& a, int l, int b, int r) {
  using d = DD<T>;
  if (r < d::S) return (l == 0 ? a.x : a.out) + ((long)b * d::S + r) * d::D;
  return (l == 0 ? a.ctx : a.xc) + ((long)b * d::C + (r - d::S)) * d::D;
}
template <class T> HD float* xrow_w(const NaiveBufs& a, int b, int r) {
  using d = DD<T>;
  if (r < d::S) return a.out + ((long)b * d::S + r) * d::D;
  return a.xc + ((long)b * d::C + (r - d::S)) * d::D;
}
template <class T> HD void st_rs(const NaiveBufs& a, int l, int b, int src, long idx) {
  using d = DD<T>; const int r = (int)idx; const float* xr = src ? (const float*)xrow_w<T>(a, b, r) : xrow<T>(a, l, b, r);
  float s = 0.f; for (int k = 0; k < d::D; ++k) s += xr[k] * xr[k];
  a.rs[r] = 1.f / sqrtf(s / (float)d::D + 1e-6f);
}
template <class T> HD void st_norm(const NaiveBufs& a, int l, int b, int which, long idx) {
  using d = DD<T>; const int j = (int)(idx % d::D), r = (int)(idx / d::D);
  const float* xr = which ? (const float*)xrow_w<T>(a, b, r) : xrow<T>(a, l, b, r);
  const float* g = (which ? a.norm2_g : a.norm1_g) + (long)l * d::D;
  const float* md = a.mod + (long)(r < d::S ? b : d::B) * 6 * d::D;
  const float shift = md[(which ? 3 : 0) * d::D + j], scale = md[(which ? 4 : 1) * d::D + j];
  a.h[idx] = xr[j] * a.rs[r] * g[j] * (1.f + scale) + shift;
}
struct GemmArgs { const float* A; int lda; const float* W; int ldw; float* Cc; int ldc; int M, N, K;
  const float* gate; int ldg;
  const float* colscale;
  const float* res; int ldr;
  int accumulate; };
HD void st_gemm(const GemmArgs& g, long idx) {
  const int nb = g.N / 4; const int cb = (int)(idx % nb), rb = (int)(idx / nb);
  float acc[4][4];
#pragma unroll
  for (int i = 0; i < 4; ++i) {
#pragma unroll
    for (int j = 0; j < 4; ++j) acc[i][j] = 0.f; }
  const float* a0 = g.A + (long)(rb * 4) * g.lda; const float* w0 = g.W + cb * 4;
  for (int k = 0; k < g.K; ++k) {
    float av[4], wv[4];
#pragma unroll
    for (int i = 0; i < 4; ++i) av[i] = a0[(long)i * g.lda + k];
#pragma unroll
    for (int j = 0; j < 4; ++j) wv[j] = w0[(long)k * g.ldw + j];
#pragma unroll
    for (int i = 0; i < 4; ++i) {
#pragma unroll
      for (int j = 0; j < 4; ++j) acc[i][j] += av[i] * wv[j]; }
  }
#pragma unroll
  for (int i = 0; i < 4; ++i)
#pragma unroll
  for (int j = 0; j < 4; ++j) {
    const int r = rb * 4 + i, c = cb * 4 + j; float v = acc[i][j];
    if (g.gate) v *= sigmoidf_(g.gate[(long)r * g.ldg + c]);
    if (g.colscale) v *= g.colscale[c];
    if (g.res) v += g.res[(long)r * g.ldr + c];
    float* p = g.Cc + (long)r * g.ldc + c;
    if (g.accumulate) v += *p;
    *p = v;
  }
}
template <class T> HD void st_qknorm(const NaiveBufs& a, int l, long idx) {
  using d = DD<T>; const int hh = (int)(idx % (d::AH + d::AKV)), r = (int)(idx / (d::AH + d::AKV));
  const bool isq = hh < d::AH; const int hd = isq ? hh : hh - d::AH;
  const float* src = a.proj + (long)r * d::NIN + (isq ? d::O_AQ : d::O_AK) + hd * d::HDM;
  float* dst = (isq ? a.qn + (long)r * d::AQW : a.kn + (long)r * d::AKVW) + hd * d::HDM;
  const float* g = (isq ? a.q_norm_g : a.k_norm_g) + (long)l * d::HDM;
  float s = 0.f; for (int k = 0; k < d::HDM; ++k) s += src[k] * src[k];
  const float rsq = 1.f / sqrtf(s / (float)d::HDM + 1e-6f);
  if (r < d::S) {
    const int row = r / d::GW, col = r % d::GW;
    for (int p = 0; p < d::HDM / 2; ++p) {
      const int fi = p < d::RP ? p : p - d::RP; const float pos = p < d::RP ? (float)row : (float)col;
      const float inv = FPOW(10000.f, -(float)fi / (float)d::RP); const float ang = pos * inv;
      const float cs = FCOS(ang), sn = FSIN(ang);
      const float x1 = src[2 * p] * rsq * g[2 * p], x2 = src[2 * p + 1] * rsq * g[2 * p + 1];
      dst[2 * p] = x1 * cs - x2 * sn; dst[2 * p + 1] = x1 * sn + x2 * cs;
    }
  } else { for (int k = 0; k < d::HDM; ++k) dst[k] = src[k] * rsq * g[k]; }
}
template <class T, int NSPLIT> HD void st_attn(const NaiveBufs& a, int r0, int nrows, long idx) {
  using d = DD<T>; constexpr int OD = d::HDM / NSPLIT;
  const int r = r0 + (int)(idx % nrows); const int hs = (int)(idx / nrows); const int part = hs % NSPLIT, hq = hs / NSPLIT; const int kv = hq / d::AG;
  const int k0 = r < d::S ? 0 : d::S, k1 = d::R;
  float q[d::HDM], o[OD];
  const float scale = 1.f / sqrtf((float)d::HDM);
#pragma unroll
  for (int k = 0; k < d::HDM; ++k) q[k] = a.qn[(long)r * d::AQW + hq * d::HDM + k] * scale;
#pragma unroll
  for (int k = 0; k < OD; ++k) o[k] = 0.f;
  float mx = -1e30f, lsum = 0.f;
  for (int kk = k0; kk < k1; ++kk) {
    const float* kr = a.kn + (long)kk * d::AKVW + kv * d::HDM;
    float s = 0.f;
#pragma unroll
    for (int k = 0; k < d::HDM; ++k) s += q[k] * kr[k];
    if (s > mx) { const float cr = FEXP(mx - s); lsum *= cr;
#pragma unroll
      for (int k = 0; k < OD; ++k) o[k] *= cr;
      mx = s; }
    const float p = FEXP(s - mx); lsum += p;
    const float* vr = a.proj + (long)kk * d::NIN + d::O_AV + kv * d::HDM + part * OD;
#pragma unroll
    for (int k = 0; k < OD; ++k) o[k] += p * vr[k];
  }
  const float inv = 1.f / lsum;
#pragma unroll
  for (int k = 0; k < OD; ++k) a.yatt[(long)r * d::AQW + hq * d::HDM + part * OD + k] = o[k] * inv;
}
template <class T> HD void st_glala(const NaiveBufs& a, int l, long idx) {
  using d = DD<T>; const int j = (int)(idx % d::GKW); const int dir = (int)((idx / d::GKW) % 2); const int r = (int)(idx / (2 * d::GKW));
  const float* al = a.proj + (long)r * d::NIN + d::O_GA + dir * d::GR;
  const float* w2 = a.gla_wa2 + ((long)l * 2 + dir) * d::GR * d::GKW; float z = a.gla_ba[((long)l * 2 + dir) * d::GKW + j];
  for (int k = 0; k < d::GR; ++k) z += al[k] * w2[(long)k * d::GKW + j];
  (dir ? a.lab : a.laf)[(long)r * d::GKW + j] = FEXP(logsigmoidf_(z) / 16.f);
}
template <class T> HD void st_glascan(const NaiveBufs& a, long idx) {
  using d = DD<T>; const int v = (int)(idx % d::GDV); const int hd = (int)((idx / d::GDV) % d::GH); const int dir = (int)(idx / (d::GDV * d::GH));
  float st[d::GDK];
#pragma unroll
  for (int k = 0; k < d::GDK; ++k) st[k] = 0.f;
  const float qs = 1.f / sqrtf((float)d::GDK);
  const float* la = dir ? a.lab : a.laf; float* od = dir ? a.ob : a.of;
  for (int step = 0; step < d::R; ++step) {
    int r;
    if (step < d::C) r = d::S + (dir ? d::C - 1 - step : step); else r = dir ? d::S - 1 - (step - d::C) : step - d::C;
    const float* pr = a.proj + (long)r * d::NIN;
    const float vv = pr[d::O_GV + hd * d::GDV + v];
    float o = 0.f;
#pragma unroll
    for (int k = 0; k < d::GDK; ++k) {
      st[k] = la[(long)r * d::GKW + hd * d::GDK + k] * st[k] + pr[d::O_GK + hd * d::GDK + k] * vv;
      o += pr[d::O_GQ + hd * d::GDK + k] * qs * st[k];
    }
    od[(long)r * d::GVW + hd * d::GDV + v] = o;
  }
}
template <class T> HD void st_glaout(const NaiveBufs& a, int l, long idx) {
  using d = DD<T>; const int hd = (int)(idx % d::GH), r = (int)(idx / d::GH);
  const long base = (long)r * d::GVW + hd * d::GDV; float s = 0.f;
  for (int v = 0; v < d::GDV; ++v) { const float o = a.of[base + v] + a.ob[base + v]; s += o * o; }
  const float rsq = 1.f / sqrtf(s / (float)d::GDV + 1e-6f);
  for (int v = 0; v < d::GDV; ++v) { const float o = a.of[base + v] + a.ob[base + v];
    a.ygla[base + v] = o * rsq * a.gla_norm_g[(long)l * d::GDV + v] * siluf_(a.proj[(long)r * d::NIN + d::O_OG + hd * d::GDV + v]); }
}
template <class T> HD void st_hyconv3(const NaiveBufs& a, int l, long idx) {
  using d = DD<T>; const int j = (int)(idx % (3 * d::HW)), r = (int)(idx / (3 * d::HW));
  const int lo = r < d::S ? 0 : d::S, hi = r < d::S ? d::S : d::R;
  const float* w = a.hy_conv_w + (long)l * 3 * 3 * d::HW;
  float v = a.hy_conv_b[(long)l * 3 * d::HW + j] + a.proj[(long)r * d::NIN + d::O_HY + j] * w[1 * 3 * d::HW + j];
  if (r - 1 >= lo) v += a.proj[(long)(r - 1) * d::NIN + d::O_HY + j] * w[0 * 3 * d::HW + j];
  if (r + 1 < hi) v += a.proj[(long)(r + 1) * d::NIN + d::O_HY + j] * w[2 * 3 * d::HW + j];
  a.uc[idx] = v;
}
template <class T> HD void st_hylong(const NaiveBufs& a, int l, int o, long idx) {
  using d = DD<T>; const int c = (int)(idx % d::HW); const int rb = (int)(idx / d::HW); const int r0 = rb * 4;
  const bool lat = r0 < d::S; const int n = lat ? d::S : d::C; const int base = lat ? 0 : d::S; const int t0 = r0 - base;
  const float* tp = (lat ? a.tapsS : a.tapsC) + (long)o * 2 * n * d::HW + c; const float nr = (lat ? a.nrmS : a.nrmC)[o * d::HW + c];
  const float* zs = o == 0 ? a.uc + 2 * d::HW + c : a.z1 + c; const int ldz = o == 0 ? 3 * d::HW : d::HW;
  float acc0 = 0.f, acc1 = 0.f, acc2 = 0.f, acc3 = 0.f;
  auto tap = [&](int lag) { const int li = lag >= 0 ? lag : 2 * n + lag; return tp[(long)li * d::HW]; };
  float w0 = tap(t0), w1 = tap(t0 + 1), w2 = tap(t0 + 2), w3 = tap(t0 + 3);
  for (int s = 0; s < n; ++s) {
    const float zv = zs[(long)(base + s) * ldz];
    acc0 += w0 * zv; acc1 += w1 * zv; acc2 += w2 * zv; acc3 += w3 * zv;
    w3 = w2; w2 = w1; w1 = w0; w0 = (s + 1 < n) ? tap(t0 - s - 1) : 0.f;
  }
  const float sk = a.hy_skip[((long)l * 2 + o) * d::HW + c];
  float* dst = o == 0 ? a.z1 : a.yhy;
  const float accs[4] = {acc0, acc1, acc2, acc3};
#pragma unroll
  for (int i = 0; i < 4; ++i) { const int r = r0 + i; const float zr = zs[(long)r * ldz];
    dst[(long)r * d::HW + c] = a.uc[(long)r * 3 * d::HW + o * d::HW + c] * (accs[i] / nr + sk * zr); }
}
template <class T> HD void st_router(const NaiveBufs& a, long idx) {
  using d = DD<T>; const int r = (int)idx; const float* hr = a.h + (long)r * d::D;
  float sc[d::NE], sel[d::NE];
#pragma unroll
  for (int e = 0; e < d::NE; ++e) sc[e] = 0.f;
  for (int k = 0; k < d::D; ++k) { const float hv = hr[k];
#pragma unroll
    for (int e = 0; e < d::NE; ++e) sc[e] += hv * a.router_w[(long)k * d::NE + e]; }
#pragma unroll
  for (int e = 0; e < d::NE; ++e) { sc[e] = sigmoidf_(sc[e]); sel[e] = sc[e] + a.router_b[e]; }
  int bestg = 0; float bestgs = -1e30f;
#pragma unroll
  for (int g = 0; g < d::NG; ++g) { float m1 = -1e30f, m2 = -1e30f;
#pragma unroll
    for (int i = 0; i < d::EPG; ++i) { const float v = sel[g * d::EPG + i]; if (v > m1) { m2 = m1; m1 = v; } else if (v > m2) m2 = v; }
    const float gs = m1 + m2; if (gs > bestgs) { bestgs = gs; bestg = g; } }
  int i1 = -1, i2 = -1; float v1 = -1e30f, v2 = -1e30f, s1 = 0.f, s2 = 0.f;
#pragma unroll
  for (int e = 0; e < d::NE; ++e) { if (e / d::EPG == bestg) { const float v = sel[e];
      if (v > v1) { v2 = v1; i2 = i1; s2 = s1; v1 = v; i1 = e; s1 = sc[e]; } else if (v > v2) { v2 = v; i2 = e; s2 = sc[e]; } } }
  const float inv = 1.f / (s1 + s2);
  a.ridx[2 * r] = i1; a.ridx[2 * r + 1] = i2; a.rw[2 * r] = s1 * inv; a.rw[2 * r + 1] = s2 * inv;
}
template <class T> HD void st_moehid(const NaiveBufs& a, int l, long idx) {
  using d = DD<T>; const int j = (int)(idx % d::DE); const int k = (int)((idx / d::DE) % 2); const int r = (int)(idx / (2 * d::DE));
  const int e = a.ridx[2 * r + k]; const float* hr = a.h + (long)r * d::D;
  const float* wg = a.moe_w_gate + (((long)l * d::NE + e) * d::D) * d::DE + j; const float* wu = a.moe_w_up + (((long)l * d::NE + e) * d::D) * d::DE + j;
  float g = 0.f, u = 0.f;
  for (int i = 0; i < d::D; ++i) { const float hv = hr[i]; g += hv * wg[(long)i * d::DE]; u += hv * wu[(long)i * d::DE]; }
  a.hid[idx] = siluf_(g) * u;
}
template <class T> HD void st_moeout(const NaiveBufs& a, int l, int b, long idx) {
  using d = DD<T>; const int dd = (int)(idx % d::D), r = (int)(idx / d::D);
  float acc = 0.f;
  for (int k = 0; k < 2; ++k) { const int e = a.ridx[2 * r + k]; const float* hk = a.hid + ((long)r * 2 + k) * d::DE;
    const float* wd = a.moe_w_down + (((long)l * d::NE + e) * d::DE) * d::D + dd; float s = 0.f;
    for (int j = 0; j < d::DE; ++j) s += hk[j] * wd[(long)j * d::D];
    acc += a.rw[2 * r + k] * s; }
  const float g2 = a.mod[(long)(r < d::S ? b : d::B) * 6 * d::D + 5 * d::D + dd];
  float* xr = xrow_w<T>(a, b, r); xr[dd] += g2 * acc;
}
enum { L_MOD = 0, L_HID_S, L_HID_C, L_TAPS_S, L_TAPS_C, L_NRM_S, L_NRM_C, N_LSTAGES,
       P_RS1 = 16, P_NORM1, P_INPROJ, P_QKNORM, P_ATTN_L, P_ATTN_C, P_GLALA, P_GLASCAN, P_GLAOUT, P_HYC3, P_HYL0, P_HYL1,
       P_MRG_HY, P_MRG_GLA, P_MRG_ATT, P_OUT_L, P_OUT_C, P_RS2, P_NORM2, P_ROUTER, P_MOEHID, P_MOEOUT, P_END };
constexpr int ATT_NSPLIT = 4;

template <class T> HD long stage_items(int st, int l) {
  using d = DD<T>; const bool last = (l == d::DEPTH - 1);
  switch (st) {
    case L_MOD: return (long)(d::B + 1) * 6 * d::D;
    case L_HID_S: return (long)d::S * d::HF;
    case L_HID_C: return (long)d::C * d::HF;
    case L_TAPS_S: return 2L * 2 * d::S * d::HW;
    case L_TAPS_C: return 2L * 2 * d::C * d::HW;
    case L_NRM_S: case L_NRM_C: return 2L * d::HW;
    case P_RS1: case P_RS2: case P_ROUTER: return d::R;
    case P_NORM1: case P_NORM2: return (long)d::R * d::D;
    case P_INPROJ: return (long)(d::R / 4) * (d::NIN / 4);
    case P_QKNORM: return (long)d::R * (d::AH + d::AKV);
    case P_ATTN_L: return (long)d::S * d::AH * ATT_NSPLIT;
    case P_ATTN_C: return last ? 0 : (long)d::C * d::AH * ATT_NSPLIT;
    case P_GLALA: return (long)d::R * 2 * d::GKW;
    case P_GLASCAN: return 2L * d::GH * d::GDV;
    case P_GLAOUT: return (long)d::R * d::GH;
    case P_HYC3: return (long)d::R * 3 * d::HW;
    case P_HYL0: case P_HYL1: return (long)(d::R / 4) * d::HW;
    case P_MRG_HY: case P_MRG_GLA: case P_MRG_ATT: return (long)(d::R / 4) * (d::D / 4);
    case P_OUT_L: return (long)(d::S / 4) * (d::D / 4);
    case P_OUT_C: return last ? 0 : (long)(d::C / 4) * (d::D / 4);
    case P_MOEHID: return (long)d::R * 2 * d::DE;
    case P_MOEOUT: return (long)(last ? d::S : d::R) * d::D;
  }
  return 0;
}

template <class T, int ST> HD void stage_run(const NaiveBufs& a, int l, int b, long idx) {
  using d = DD<T>;
  if constexpr (ST == L_MOD) st_mod<T>(a, l, idx);
  else if constexpr (ST == L_HID_S) st_hyhid<T>(a, l, 0, idx);
  else if constexpr (ST == L_HID_C) st_hyhid<T>(a, l, 1, idx);
  else if constexpr (ST == L_TAPS_S) st_hytaps<T>(a, l, 0, idx);
  else if constexpr (ST == L_TAPS_C) st_hytaps<T>(a, l, 1, idx);
  else if constexpr (ST == L_NRM_S) st_hynorm<T>(a, 0, idx);
  else if constexpr (ST == L_NRM_C) st_hynorm<T>(a, 1, idx);
  else if constexpr (ST == P_RS1) st_rs<T>(a, l, b, 0, idx);
  else if constexpr (ST == P_RS2) st_rs<T>(a, l, b, 1, idx);
  else if constexpr (ST == P_NORM1) st_norm<T>(a, l, b, 0, idx);
  else if constexpr (ST == P_NORM2) st_norm<T>(a, l, b, 1, idx);
  else if constexpr (ST == P_INPROJ) { GemmArgs g{a.h, d::D, a.w_in + (long)l * d::D * d::NIN, d::NIN, a.proj, d::NIN, d::R, d::NIN, d::D, nullptr, 0, nullptr, nullptr, 0, 0}; st_gemm(g, idx); }
  else if constexpr (ST == P_QKNORM) st_qknorm<T>(a, l, idx);
  else if constexpr (ST == P_ATTN_L) st_attn<T, ATT_NSPLIT>(a, 0, d::S, idx);
  else if constexpr (ST == P_ATTN_C) st_attn<T, ATT_NSPLIT>(a, d::S, d::C, idx);
  else if constexpr (ST == P_GLALA) st_glala<T>(a, l, idx);
  else if constexpr (ST == P_GLASCAN) st_glascan<T>(a, idx);
  else if constexpr (ST == P_GLAOUT) st_glaout<T>(a, l, idx);
  else if constexpr (ST == P_HYC3) st_hyconv3<T>(a, l, idx);
  else if constexpr (ST == P_HYL0) st_hylong<T>(a, l, 0, idx);
  else if constexpr (ST == P_HYL1) st_hylong<T>(a, l, 1, idx);
  else if constexpr (ST == P_MRG_HY) { GemmArgs g{a.yhy, d::HW, a.w_br_hy + (long)l * d::HW * d::D, d::D, a.m, d::D, d::R, d::D, d::HW, a.proj + d::O_BR, d::NIN, nullptr, nullptr, 0, 0}; st_gemm(g, idx); }
  else if constexpr (ST == P_MRG_GLA) { GemmArgs g{a.ygla, d::GVW, a.w_br_gla + (long)l * d::GVW * d::D, d::D, a.m, d::D, d::R, d::D, d::GVW, a.proj + d::O_BR + d::D, d::NIN, nullptr, nullptr, 0, 1}; st_gemm(g, idx); }
  else if constexpr (ST == P_MRG_ATT) { GemmArgs g{a.yatt, d::AQW, a.w_br_att + (long)l * d::AQW * d::D, d::D, a.m, d::D, d::R, d::D, d::AQW, a.proj + d::O_BR + 2 * d::D, d::NIN, nullptr, nullptr, 0, 1}; st_gemm(g, idx); }
  else if constexpr (ST == P_OUT_L) { const float* res = (l == 0 ? a.x : (const float*)a.out) + (long)b * d::S * d::D;
    GemmArgs g{a.m, d::D, a.w_out + (long)l * d::D * d::D, d::D, a.out + (long)b * d::S * d::D, d::D, d::S, d::D, d::D, nullptr, 0, a.mod + (long)b * 6 * d::D + 2 * d::D, res, d::D, 0}; st_gemm(g, idx); }
  else if constexpr (ST == P_OUT_C) { const float* res = (l == 0 ? a.ctx : (const float*)a.xc) + (long)b * d::C * d::D;
    GemmArgs g{a.m + (long)d::S * d::D, d::D, a.w_out + (long)l * d::D * d::D, d::D, a.xc + (long)b * d::C * d::D, d::D, d::C, d::D, d::D, nullptr, 0, a.mod + (long)d::B * 6 * d::D + 2 * d::D, res, d::D, 0}; st_gemm(g, idx); }
  else if constexpr (ST == P_ROUTER) st_router<T>(a, idx);
  else if constexpr (ST == P_MOEHID) st_moehid<T>(a, l, idx);
  else if constexpr (ST == P_MOEOUT) st_moeout<T>(a, l, b, idx);
}

template <class T> inline size_t carve(NaiveBufs& a, float* ws) {
  using d = DD<T>; size_t o = 0; auto take = [&](size_t n) { float* p = ws ? ws + o : nullptr; o += (n + 63) & ~(size_t)63; return p; };
  a.mod = take((size_t)(d::B + 1) * 6 * d::D);
  a.hid2S = take((size_t)d::S * d::HF); a.hid2C = take((size_t)d::C * d::HF);
  a.tapsS = take((size_t)2 * 2 * d::S * d::HW); a.tapsC = take((size_t)2 * 2 * d::C * d::HW);
  a.nrmS = take(2 * d::HW); a.nrmC = take(2 * d::HW);
  a.rs = take(d::R); a.h = take((size_t)d::R * d::D); a.proj = take((size_t)d::R * d::NIN);
  a.qn = take((size_t)d::R * d::AQW); a.kn = take((size_t)d::R * d::AKVW);
  a.uc = take((size_t)d::R * 3 * d::HW); a.z1 = take((size_t)d::R * d::HW); a.yhy = take((size_t)d::R * d::HW);
  a.xc = take((size_t)d::B * d::C * d::D);
#ifdef HOST_TEST
  a.yatt = take((size_t)d::R * d::AQW); a.laf = take((size_t)d::R * d::GKW); a.lab = take((size_t)d::R * d::GKW);
  a.of = take((size_t)d::R * d::GVW); a.ob = take((size_t)d::R * d::GVW); a.ygla = take((size_t)d::R * d::GVW);
  a.m = take((size_t)d::R * d::D); a.ridx = (int*)take((size_t)d::R * 2); a.rw = take((size_t)d::R * 2); a.hid = take((size_t)d::R * 2 * d::DE);
#endif
  return o;
}
template <class T> inline void set_inputs(NaiveBufs& a, const float* const* in) {
  int i = 0;
  a.x = in[i++]; a.c = in[i++]; a.ctx = in[i++]; a.c_ctx = in[i++]; a.w_mod = in[i++]; a.b_mod = in[i++]; a.norm1_g = in[i++]; a.norm2_g = in[i++];
  a.w_in = in[i++]; a.q_norm_g = in[i++]; a.k_norm_g = in[i++]; a.gla_wa2 = in[i++]; a.gla_ba = in[i++]; a.gla_norm_g = in[i++];
  a.hy_conv_w = in[i++]; a.hy_conv_b = in[i++]; a.hy_pos_w1 = in[i++]; a.hy_pos_b1 = in[i++]; a.hy_sin_freq = in[i++]; a.hy_pos_w2 = in[i++];
  a.hy_pos_b2 = in[i++]; a.hy_pos_w3 = in[i++]; a.hy_decay = in[i++]; a.hy_skip = in[i++]; a.w_br_hy = in[i++]; a.w_br_gla = in[i++];
  a.w_br_att = in[i++]; a.w_out = in[i++]; a.router_w = in[i++]; a.router_b = in[i++]; a.moe_w_gate = in[i++]; a.moe_w_up = in[i++]; a.moe_w_down = in[i++];
}

#define LSTAGES(X) X(L_MOD) X(L_HID_S) X(L_HID_C) X(L_TAPS_S) X(L_TAPS_C) X(L_NRM_S) X(L_NRM_C)
#define PSTAGES(X) X(P_RS1) X(P_NORM1) X(P_INPROJ) X(P_QKNORM) X(P_ATTN_L) X(P_ATTN_C) X(P_GLALA) X(P_GLASCAN) X(P_GLAOUT) X(P_HYC3) X(P_HYL0) X(P_HYL1) \
  X(P_MRG_HY) X(P_MRG_GLA) X(P_MRG_ATT) X(P_OUT_L) X(P_OUT_C) X(P_RS2) X(P_NORM2) X(P_ROUTER) X(P_MOEHID) X(P_MOEOUT)
namespace pro {
__device__ __forceinline__ void mod_phase(const NaiveBufs& a, int l, LAS unsigned char* lds) {
  int tz = threadIdx.x; asm volatile("" : "+v"(tz));
  __syncthreads();
  LAS float* sl = (LAS float*)lds; LAS float* part = sl + 9 * 1024;
  for (int e = tz; e < 9 * 1024; e += NTHREADS) { const int bb = e >> 10, k = e & 1023; const float cv = bb < 8 ? a.c[bb * 1024 + k] : a.c_ctx[k]; sl[e] = cv / (1.f + __expf(-cv)); }
  __syncthreads();
  const float* w = a.w_mod + (size_t)l * 1024 * 6144;
  const int jl = tz & 63, ks = tz >> 6;
  for (int cb = blockIdx.x; cb < 96; cb += gridDim.x) { const int j = cb * 64 + jl; float acc[9];
#pragma unroll
    for (int q = 0; q < 9; ++q) acc[q] = 0.f;
#pragma unroll 4
    for (int k = ks * 128; k < ks * 128 + 128; ++k) { const float wv = w[(size_t)k * 6144 + j];
#pragma unroll
      for (int q = 0; q < 9; ++q) acc[q] += sl[q * 1024 + k] * wv; }
#pragma unroll
    for (int q = 0; q < 9; ++q) part[(ks * 9 + q) * 64 + jl] = acc[q];
    __syncthreads();
    for (int e = tz; e < 9 * 64; e += NTHREADS) { const int q = e >> 6, jj = e & 63; float s = a.b_mod[(size_t)l * 6144 + cb * 64 + jj];
#pragma unroll
      for (int k8 = 0; k8 < 8; ++k8) s += part[(k8 * 9 + q) * 64 + jj];
      a.mod[(size_t)q * 6144 + cb * 64 + jj] = s; }
    __syncthreads(); }
  __syncthreads();
}
__device__ __forceinline__ void hid_phase(const NaiveBufs& a, int l, int n, float* dst, LAS unsigned char* lds) {
  int tz = threadIdx.x; asm volatile("" : "+v"(tz));
  LAS float* Z = (LAS float*)(lds + 40960); LAS float* H1 = Z + 8 * 36;
  const float* w1 = a.hy_pos_w1 + (size_t)l * 33 * 64; const float* b1 = a.hy_pos_b1 + l * 64; const float* fr = a.hy_sin_freq + l * 64;
  const float* w2 = a.hy_pos_w2 + (size_t)l * 64 * 64; const float* b2 = a.hy_pos_b2 + l * 64;
  const float w0 = 2.f * 3.14159265358979323846f / (float)n;
  for (int t0 = blockIdx.x * 8; t0 < n; t0 += gridDim.x * 8) {
    if (tz < 8 * 33) { const int tt = tz / 33, e = tz % 33, t = t0 + tt; float v;
      if (e == 0) v = (float)t / (float)n; else { const int bnd = (e - 1) & 15; const float band = 1e-4f + (float)bnd * (15.f - 1e-4f) / 15.f; const float ph = w0 * (float)t * band; v = e <= 16 ? cosf(ph) : -sinf(ph); }
      Z[tt * 36 + e] = v; }
    __syncthreads();
    { const int tt = tz >> 6, i = tz & 63; float acc = b1[i];
#pragma unroll
      for (int e = 0; e < 33; ++e) acc += Z[tt * 36 + e] * w1[e * 64 + i];
      H1[tt * 64 + i] = sinf(fr[i] * acc); }
    __syncthreads();
    { const int tt = tz >> 6, j = tz & 63; float acc = b2[j];
#pragma unroll 8
      for (int i = 0; i < 64; ++i) acc += H1[tt * 64 + i] * w2[i * 64 + j];
      if (t0 + tt < n) dst[(size_t)(t0 + tt) * 64 + j] = sinf(fr[j] * acc); }
    __syncthreads();
  }
}
__device__ __forceinline__ void nrmS_phase(const NaiveBufs& a) {
  int tz = threadIdx.x; asm volatile("" : "+v"(tz)); const int lane = tz & 63, wave = __builtin_amdgcn_readfirstlane(tz >> 6);
  for (int oc = blockIdx.x * NWAVES + wave; oc < 1024; oc += gridDim.x * NWAVES) { const float* tp = a.tapsS + (size_t)oc * 8192; float s = 0.f;
#pragma unroll 8
    for (int k = lane; k < 8192; k += 64) s += fabsf(tp[k]);
    s = moe::wave_sum(s); if (lane == 0) a.nrmS[oc] = s + 1e-6f; }
}
constexpr int TCOPY = 8232;
__device__ __forceinline__ void tapsB_phase(const NaiveBufs& a, int l, bf16_t* tapsB, LAS unsigned char* lds) {
  int tz = threadIdx.x; asm volatile("" : "+v"(tz));
  const float* w3 = a.hy_pos_w3 + (size_t)l * 64 * 2048; const float* dcy = a.hy_decay + (size_t)l * 2048;
  typedef float f4 __attribute__((ext_vector_type(4)));
  LAS float* W = (LAS float*)lds;
  for (int cp = blockIdx.x; cp < 256; cp += gridDim.x) {
    __syncthreads();
    { const int ch = tz >> 8, e = tz & 255, c = cp + 256 * ch; W[tz] = w3[(size_t)(e >> 2) * 2048 + (e & 3) * 512 + c]; if (tz < 8) W[512 + tz] = fabsf(dcy[(tz & 3) * 512 + cp + 256 * (tz >> 2)]); }
    __syncthreads();
    for (int t = tz; t < 4096; t += NTHREADS) {
      const f4* h2 = (const f4*)(a.hid2S + (size_t)t * 64); f4 acc0 = {0.f, 0.f, 0.f, 0.f}, acc1 = {0.f, 0.f, 0.f, 0.f};
#pragma unroll 4
      for (int j4 = 0; j4 < 16; ++j4) { const f4 h = h2[j4];
#pragma unroll
        for (int e = 0; e < 4; ++e) { acc0 += h[e] * *(const LAS f4*)(W + (4 * j4 + e) * 4); acc1 += h[e] * *(const LAS f4*)(W + 256 + (4 * j4 + e) * 4); } }
      const float tn = (float)t * (1.f / 4096.f);
#pragma unroll
      for (int ch = 0; ch < 2; ++ch)
#pragma unroll
        for (int q = 0; q < 4; ++q) { const int o = q >> 1, dir = q & 1; if (dir == 1 && t == 0) continue; const int c = cp + 256 * ch;
          const bf16_t bv = (bf16_t)f2bf((ch ? acc1[q] : acc0[q]) * __expf(-tn * W[512 + 4 * ch + q]));
          bf16_t* base = tapsB + ((size_t)o * 512 + c) * 2 * TCOPY; const int x0 = dir ? 4096 + t : 4096 - t;
          base[x0] = bv; base[TCOPY + x0 - 1] = bv; } } }
  for (long idx = (long)blockIdx.x * NTHREADS + tz; idx < 1024L * 96; idx += (long)gridDim.x * NTHREADS) { const int oc = (int)(idx / 96), e = (int)(idx % 96); bf16_t* base = tapsB + (size_t)oc * 2 * TCOPY;
    if (e < 40) base[8192 + e] = 0; else if (e < 81) base[TCOPY + 8191 + (e - 40)] = 0; else if (e == 81) base[0] = 0; }
}
__device__ __forceinline__ void nrmB_phase(const NaiveBufs& a, const bf16_t* tapsB) {
  int tz = threadIdx.x; asm volatile("" : "+v"(tz)); const int lane = tz & 63, wave = __builtin_amdgcn_readfirstlane(tz >> 6);
  for (int oc = blockIdx.x * NWAVES + wave; oc < 1024; oc += gridDim.x * NWAVES) { const bf16_t* tp = tapsB + (size_t)oc * 2 * TCOPY; float s = 0.f;
#pragma unroll 8
    for (int k = lane; k < 8192; k += 64) s += fabsf(bf2f(tp[k]));
    s = moe::wave_sum(s); if (lane == 0) a.nrmS[oc] = s + 1e-6f; }
}
}
using TD = FullDims;
using dd = DD<TD>;
constexpr int GB = 4, NGRP = 2, RB = dd::R  , RG = GB * RB, PLD = dd::O_BR + 1536  , PANELS = RG / 256, PPB = RB / 256  ;
constexpr size_t BAR_BYTES = 16384 + 4 * 4096; constexpr int CNT_OFF = 16384;
constexpr int MPG = 38912;
constexpr size_t CS_BYTES = (size_t)2 * 4 * 68 * 64 * 128 * 2, DEC_BYTES = (size_t)2 * 4 * 68 * 64 * 4;
constexpr size_t UCT_BYTES = (size_t)1536 * 4096 * 2, YT_BYTES = (size_t)512 * 4096 * 2, UCC_BYTES = (size_t)256 * 1536 * 4, Z1C_BYTES = (size_t)256 * 512 * 4;
constexpr size_t MIX_BYTES = GB * (CS_BYTES + DEC_BYTES) > GB * (UCT_BYTES + YT_BYTES + UCC_BYTES + Z1C_BYTES) ? GB * (CS_BYTES + DEC_BYTES) : GB * (UCT_BYTES + YT_BYTES + UCC_BYTES + Z1C_BYTES);

struct KArgs { NaiveBufs a; unsigned* bar; int* cnt; bf16_t *xs; bf16_t *WgaT; bf16_t *WinT, *WhyT, *WglaT, *WattT, *WoutT, *WguT, *WdT, *hb, *proj; unsigned char* mix;
  bf16_t *hp, *hid, *contrib; int* srcrow; float* wgt; moe::Route* route; float* wts; };

struct EpiProjBf16 {
  static constexpr bool PERM = true, AFTER_DRAIN = false, CHAIN = false;
  bf16_t* P;
  __device__ __forceinline__ void operator()(const pg8::f32x4 (&acc)[2][2][4][2], const pg8::Unit& u, int wr, int wc, int fr, int fq) const {
    const int row0 = u.pm * 256 + wr * 64 + fr, col0 = u.pn * 256 + wc * 32 + 8 * fq;
    const int cr0 = col0 + (col0 >= dd::O_GA ? 32 : 0), cr1 = col0 + 128 + (col0 + 128 >= dd::O_GA ? 32 : 0);
    if (u.pn >= (dd::O_BR - 32) / 256) {
      unsigned char* Pg = (unsigned char*)P + (size_t)dd::O_BR * 2 + (col0 - (dd::O_BR - 32));
#pragma unroll
      for (int ai = 0; ai < 2; ++ai)
#pragma unroll
        for (int m = 0; m < 4; ++m) { unsigned char* rowp = Pg + (size_t)(row0 + ai * 128 + m * 16) * (PLD * 2);
#pragma unroll
          for (int bj = 0; bj < 2; ++bj) { const pg8::f32x4 v0 = acc[ai][bj][m][0], v1 = acc[ai][bj][m][1]; uint2 o;
            o.x = (unsigned)(fsigmoid(v0[0]) * 255.f + 0.5f) | ((unsigned)(fsigmoid(v0[1]) * 255.f + 0.5f) << 8) | ((unsigned)(fsigmoid(v0[2]) * 255.f + 0.5f) << 16) | ((unsigned)(fsigmoid(v0[3]) * 255.f + 0.5f) << 24);
            o.y = (unsigned)(fsigmoid(v1[0]) * 255.f + 0.5f) | ((unsigned)(fsigmoid(v1[1]) * 255.f + 0.5f) << 8) | ((unsigned)(fsigmoid(v1[2]) * 255.f + 0.5f) << 16) | ((unsigned)(fsigmoid(v1[3]) * 255.f + 0.5f) << 24);
            *(uint2*)(rowp + bj * 128) = o; } }
      return; }
#pragma unroll
    for (int ai = 0; ai < 2; ++ai)
#pragma unroll
      for (int m = 0; m < 4; ++m) { bf16_t* rowp = P + (size_t)(row0 + ai * 128 + m * 16) * PLD;
#pragma unroll
        for (int bj = 0; bj < 2; ++bj) { const pg8::f32x4 v0 = acc[ai][bj][m][0], v1 = acc[ai][bj][m][1];
          v4u o; o.x = pk2(v0[0], v0[1]); o.y = pk2(v0[2], v0[3]); o.z = pk2(v1[0], v1[1]); o.w = pk2(v1[2], v1[3]); *(v4u*)(rowp + (bj ? cr1 : cr0)) = o; } }
  }
};
template <bool ACCUM> struct EpiMergeB {
  static constexpr bool PERM = true, AFTER_DRAIN = false;
  const bf16_t* gate; bf16_t* M;
  __device__ __forceinline__ void operator()(const pg8::f32x4 (&acc)[2][2][4][2], const pg8::Unit& u, int wr, int wc, int fr, int fq) const {
    const int row0 = u.pm * 256 + wr * 64 + fr, col0 = u.pn * 256 + wc * 32 + 8 * fq;
#pragma unroll
    for (int ai2 = 0; ai2 < 4; ++ai2) { const int ai = ai2 >> 1, m0 = (ai2 & 1) * 2;
      v4u gw[4][2], mo[4][2];
#pragma unroll
      for (int m = m0; m < m0 + 2; ++m)
#pragma unroll
        for (int bj = 0; bj < 2; ++bj) { const size_t r = (size_t)(row0 + ai * 128 + m * 16); const int c = col0 + bj * 128; gw[m][bj] = *(const v4u*)(gate + r * PLD + c); if (ACCUM) mo[m][bj] = *(const v4u*)(M + r * 1024 + c); }
#pragma unroll
      for (int m = m0; m < m0 + 2; ++m)
#pragma unroll
        for (int bj = 0; bj < 2; ++bj) { const size_t r = (size_t)(row0 + ai * 128 + m * 16); const int c = col0 + bj * 128; const v4u g4 = gw[m][bj];
          pg8::f32x4 v0 = acc[ai][bj][m][0], v1 = acc[ai][bj][m][1];
          v0[0] *= fsigmoid(bf2f(g4.x & 0xffff)); v0[1] *= fsigmoid(bf2f(g4.x >> 16)); v0[2] *= fsigmoid(bf2f(g4.y & 0xffff)); v0[3] *= fsigmoid(bf2f(g4.y >> 16));
          v1[0] *= fsigmoid(bf2f(g4.z & 0xffff)); v1[1] *= fsigmoid(bf2f(g4.z >> 16)); v1[2] *= fsigmoid(bf2f(g4.w & 0xffff)); v1[3] *= fsigmoid(bf2f(g4.w >> 16));
          if (ACCUM) { const v4u o = mo[m][bj]; v0[0] += bf2f(o.x & 0xffff); v0[1] += bf2f(o.x >> 16); v0[2] += bf2f(o.y & 0xffff); v0[3] += bf2f(o.y >> 16);
            v1[0] += bf2f(o.z & 0xffff); v1[1] += bf2f(o.z >> 16); v1[2] += bf2f(o.w & 0xffff); v1[3] += bf2f(o.w >> 16); }
          v4u o2; o2.x = pk2(v0[0], v0[1]); o2.y = pk2(v0[2], v0[3]); o2.z = pk2(v1[0], v1[1]); o2.w = pk2(v1[2], v1[3]); *(v4u*)(M + r * 1024 + c) = o2; } }
  }
};
struct EpiOutG {
  static constexpr bool PERM = true, AFTER_DRAIN = false, CHAIN = false;
  const float* resL; const float* resC; bf16_t* xs; const float* mod; int b0; bool ctx_on, resbf;
  __device__ __forceinline__ void operator()(const pg8::f32x4 (&acc)[2][2][4][2], const pg8::Unit& u, int wr, int wc, int fr, int fq) const {
    const int bl = u.pm / PPB, lp = u.pm % PPB; const bool isc = lp == PPB - 1; if (isc && !ctx_on) return;
    const int b = b0 + bl;
    const float* res = isc ? resC + (size_t)b * dd::C * 1024 : resL + ((size_t)b * dd::S + lp * 256) * 1024;
    bf16_t* out = xs + (size_t)u.pm * 256 * 1024;
    const float* gv = mod + (size_t)(isc ? dd::B : b) * 6 * 1024 + 2 * 1024;
    int row0 = wr * 64 + fr, col0 = u.pn * 256 + wc * 32 + 8 * fq; asm volatile("" : "+v"(row0), "+v"(col0));
    pg8::f32x4 gg[2][2];
#pragma unroll
    for (int bj = 0; bj < 2; ++bj)
#pragma unroll
      for (int n = 0; n < 2; ++n) gg[bj][n] = *(const pg8::f32x4*)(gv + col0 + bj * 128 + n * 4);
    if (resbf) {
#pragma unroll
      for (int ai2 = 0; ai2 < 4; ++ai2) { const int ai = ai2 >> 1, m0 = (ai2 & 1) * 2; v4u rb[4][2];
#pragma unroll
        for (int m = m0; m < m0 + 2; ++m)
#pragma unroll
          for (int bj = 0; bj < 2; ++bj) rb[m][bj] = *(const v4u*)(out + (size_t)(row0 + ai * 128 + m * 16) * 1024 + col0 + bj * 128);
#pragma unroll
        for (int m = m0; m < m0 + 2; ++m)
#pragma unroll
          for (int bj = 0; bj < 2; ++bj) { const v4u o = rb[m][bj]; const pg8::f32x4 v0 = gg[bj][0] * acc[ai][bj][m][0], v1 = gg[bj][1] * acc[ai][bj][m][1]; v4u w;
            w.x = pk2(v0[0] + __uint_as_float(o.x << 16), v0[1] + __uint_as_float(o.x & 0xffff0000u)); w.y = pk2(v0[2] + __uint_as_float(o.y << 16), v0[3] + __uint_as_float(o.y & 0xffff0000u));
            w.z = pk2(v1[0] + __uint_as_float(o.z << 16), v1[1] + __uint_as_float(o.z & 0xffff0000u)); w.w = pk2(v1[2] + __uint_as_float(o.w << 16), v1[3] + __uint_as_float(o.w & 0xffff0000u));
            *(v4u*)(out + (size_t)(row0 + ai * 128 + m * 16) * 1024 + col0 + bj * 128) = w; } }
    } else {
#pragma unroll
      for (int ai2 = 0; ai2 < 4; ++ai2) { const int ai = ai2 >> 1, m0 = (ai2 & 1) * 2;
        pg8::f32x4 rv[4][2][2];
#pragma unroll
        for (int m = m0; m < m0 + 2; ++m)
#pragma unroll
          for (int bj = 0; bj < 2; ++bj)
#pragma unroll
            for (int n = 0; n < 2; ++n) rv[m][bj][n] = *(const pg8::f32x4*)(res + (size_t)(row0 + ai * 128 + m * 16) * 1024 + col0 + bj * 128 + n * 4);
#pragma unroll
        for (int m = m0; m < m0 + 2; ++m)
#pragma unroll
          for (int bj = 0; bj < 2; ++bj) { const pg8::f32x4 v0 = rv[m][bj][0] + gg[bj][0] * acc[ai][bj][m][0], v1 = rv[m][bj][1] + gg[bj][1] * acc[ai][bj][m][1];
            v4u w; w.x = pk2(v0[0], v0[1]); w.y = pk2(v0[2], v0[3]); w.z = pk2(v1[0], v1[1]); w.w = pk2(v1[2], v1[3]);
            *(v4u*)(out + (size_t)(row0 + ai * 128 + m * 16) * 1024 + col0 + bj * 128) = w; } }
    }
  }
};
struct GroupOrder {
  int nN, nwg, G, c; bool lat;
  __device__ void init(int N, int G_, int c_, bool lat_) { nN = N / 256; lat = lat_; nwg = (lat ? GB * 16 : PANELS) * nN; G = G_; c = c_; }
  __device__ __forceinline__ bool next(int i, pg8::Unit& u) const { const long L = (long)i * G + c; if (L >= nwg) return false; const int p = (int)L / nN; u.pm = lat ? (p >> 4) * PPB + (p & 15) : p; u.pn = (int)L % nN; u.acol = 0; u.nt = 0; return true; }
  __device__ __forceinline__ void a_ready(const pg8::Unit&) const {}
  __device__ __forceinline__ void done(const pg8::Unit&) const {}
};
struct MergeOrder {
  int ntiles, G, c; bool lat;
  __device__ void init(int G_, int c_, bool lat_) { lat = lat_; ntiles = (lat ? GB * 16 : PANELS) * 4; G = G_; c = c_; }
  __device__ __forceinline__ bool next(int i, pg8::Unit& u) const { const int rnd = i / 3, gi = i - 3 * rnd; const long tile = (long)rnd * G + c; if (tile >= ntiles) return false; const int p = (int)tile >> 2;
    u.pm = lat ? (p >> 4) * PPB + (p & 15) : p; u.pn = gi * 4 + ((int)tile & 3); u.acol = gi == 0 ? dd::O_HY : gi == 1 ? dd::O_OG : dd::O_AQ; u.nt = gi == 2 ? 16 : 8; return true; }
  __device__ __forceinline__ void a_ready(const pg8::Unit&) const {}
  __device__ __forceinline__ void done(const pg8::Unit&) const {}
};
struct EpiMergeS {
  static constexpr bool PERM = true, AFTER_DRAIN = false, CHAIN = true;
  const unsigned char* gate0; bf16_t* M;
  __device__ __forceinline__ bool chain(pg8::f32x4 (&acc)[2][2][4][2], const pg8::Unit& u, int wr, int wc, int fr, int fq) const {
    const int gi = u.pn >> 2; const unsigned char* gate = gate0 + gi * 1024;
    int row0 = u.pm * 256 + wr * 64 + fr, col0 = (u.pn & 3) * 256 + wc * 32 + 8 * fq; asm volatile("" : "+v"(row0), "+v"(col0));
    if (gi < 2) {
      const float lo_c = gi == 0 ? 0.f : 0.5f;
#pragma unroll
      for (int ai2 = 0; ai2 < 4; ++ai2) { const int ai = ai2 >> 1, m0 = (ai2 & 1) * 2;
        uint2 gc[4][2], gn[4][2];
#pragma unroll
        for (int m = m0; m < m0 + 2; ++m)
#pragma unroll
          for (int bj = 0; bj < 2; ++bj) { const unsigned char* gp_ = gate + (size_t)(row0 + ai * 128 + m * 16) * (PLD * 2) + col0 + bj * 128; gc[m][bj] = *(const uint2*)gp_; gn[m][bj] = *(const uint2*)(gp_ + 1024); }
#pragma unroll
        for (int m = m0; m < m0 + 2; ++m)
#pragma unroll
          for (int bj = 0; bj < 2; ++bj) { const uint2 c2 = gc[m][bj], n2 = gn[m][bj];
#pragma unroll
            for (int e = 0; e < 4; ++e) {
              acc[ai][bj][m][0][e] *= fmaxf((float)((c2.x >> (8 * e)) & 255u), lo_c) * __builtin_amdgcn_rcpf(fmaxf((float)((n2.x >> (8 * e)) & 255u), 0.5f));
              acc[ai][bj][m][1][e] *= fmaxf((float)((c2.y >> (8 * e)) & 255u), lo_c) * __builtin_amdgcn_rcpf(fmaxf((float)((n2.y >> (8 * e)) & 255u), 0.5f)); } } }
      return true; }
#pragma unroll
    for (int ai2 = 0; ai2 < 4; ++ai2) { const int ai = ai2 >> 1, m0 = (ai2 & 1) * 2;
      uint2 gw[4][2];
#pragma unroll
      for (int m = m0; m < m0 + 2; ++m)
#pragma unroll
        for (int bj = 0; bj < 2; ++bj) gw[m][bj] = *(const uint2*)(gate + (size_t)(row0 + ai * 128 + m * 16) * (PLD * 2) + col0 + bj * 128);
#pragma unroll
      for (int m = m0; m < m0 + 2; ++m)
#pragma unroll
        for (int bj = 0; bj < 2; ++bj) { const size_t r = (size_t)(row0 + ai * 128 + m * 16); const int c = col0 + bj * 128; const uint2 g2 = gw[m][bj]; constexpr float q = 1.f / 255.f;
          pg8::f32x4 v0 = acc[ai][bj][m][0], v1 = acc[ai][bj][m][1];
#pragma unroll
          for (int e = 0; e < 4; ++e) { v0[e] *= fmaxf((float)((g2.x >> (8 * e)) & 255u), 0.5f) * q; v1[e] *= fmaxf((float)((g2.y >> (8 * e)) & 255u), 0.5f) * q; }
          v4u o2; o2.x = pk2(v0[0], v0[1]); o2.y = pk2(v0[2], v0[3]); o2.z = pk2(v1[0], v1[1]); o2.w = pk2(v1[2], v1[3]); *(v4u*)(M + r * 1024 + c) = o2; } }
    return false;
  }
};
__device__ __forceinline__ const float* xrow_in(const NaiveBufs& a, int l, int b, int r) {
  if (r < dd::S) return (l == 0 ? a.x : (const float*)a.out) + ((size_t)b * dd::S + r) * 1024;
  return (l == 0 ? a.ctx : (const float*)a.xc) + ((size_t)b * dd::C + (r - dd::S)) * 1024;
}
__device__ __forceinline__ float* xrow_cur(const NaiveBufs& a, int b, int r) {
  if (r < dd::S) return a.out + ((size_t)b * dd::S + r) * 1024;
  return a.xc + ((size_t)b * dd::C + (r - dd::S)) * 1024;
}
template <bool BF> __device__ __forceinline__ void norm_row(const void* xr, const float* gnorm, const float* shift, const float* scale, bf16_t* hrow, int lane) {
  typedef float f4 __attribute__((ext_vector_type(4)));
  f4 xv[4]; float ss = 0.f;
#pragma unroll
  for (int j = 0; j < 4; ++j) {
    if (BF) { const uint2 rw = *(const uint2*)((const bf16_t*)xr + 4 * lane + 256 * j); xv[j][0] = __uint_as_float(rw.x << 16); xv[j][1] = __uint_as_float(rw.x & 0xffff0000u); xv[j][2] = __uint_as_float(rw.y << 16); xv[j][3] = __uint_as_float(rw.y & 0xffff0000u); }
    else xv[j] = *(const f4*)((const float*)xr + 4 * lane + 256 * j);
    ss += xv[j][0] * xv[j][0] + xv[j][1] * xv[j][1] + xv[j][2] * xv[j][2] + xv[j][3] * xv[j][3]; }
  const float rs = __builtin_amdgcn_rsqf(moe::wave_sum(ss) * (1.f / 1024.f) + 1e-6f);
#pragma unroll
  for (int j = 0; j < 4; ++j) { const int c = 4 * lane + 256 * j; const f4 g4 = *(const f4*)(gnorm + c), sh = *(const f4*)(shift + c), sc = *(const f4*)(scale + c);
    f4 h;
#pragma unroll
    for (int i = 0; i < 4; ++i) h[i] = xv[j][i] * rs * g4[i] * (1.f + sc[i]) + sh[i];
    *(unsigned long long*)(hrow + c) = (unsigned long long)pk2h(h[0], h[1]) | ((unsigned long long)pk2h(h[2], h[3]) << 32); }
}
__device__ __forceinline__ void qknorm_row(bf16_t* prow, const float* qg, const float* kg, int r, int lane) {
  const bool lat = r < dd::S; const int grow = r / dd::GW, gcol = r % dd::GW;
  const int fi = lane & 31; const float pos = (lane < 32) ? (float)grow : (float)gcol;
  const float ang = pos * __builtin_amdgcn_exp2f(-(float)fi * (13.287712379549449f / 32.f));
  const float cs = lat ? __cosf(ang) : 1.f, sn = lat ? __sinf(ang) : 0.f;
  unsigned wv[10];
#pragma unroll
  for (int hh = 0; hh < 10; ++hh) wv[hh] = *((const unsigned*)(prow + (hh < 8 ? dd::O_AQ + hh * 128 : dd::O_AK + (hh - 8) * 128)) + lane);
  float ss[10];
#pragma unroll
  for (int hh = 0; hh < 10; ++hh) { const float x1 = bf2f(wv[hh] & 0xffff), x2 = bf2f(wv[hh] >> 16); ss[hh] = x1 * x1 + x2 * x2; }
#pragma unroll
  for (int o = 1; o < 64; o <<= 1) {
#pragma unroll
    for (int hh = 0; hh < 10; ++hh) ss[hh] += __shfl_xor(ss[hh], o); }
  const float q1 = qg[2 * lane], q2 = qg[2 * lane + 1], k1 = kg[2 * lane], k2 = kg[2 * lane + 1];
#pragma unroll
  for (int hh = 0; hh < 10; ++hh) { unsigned* p = (unsigned*)(prow + (hh < 8 ? dd::O_AQ + hh * 128 : dd::O_AK + (hh - 8) * 128)) + lane;
    const float x1 = bf2f(wv[hh] & 0xffff), x2 = bf2f(wv[hh] >> 16); const float rs = __builtin_amdgcn_rsqf(ss[hh] * (1.f / 128.f) + 1e-6f);
    const float y1 = x1 * rs * (hh < 8 ? q1 : k1), y2 = x2 * rs * (hh < 8 ? q2 : k2);
    *p = pk2h(y1 * cs - y2 * sn, y1 * sn + y2 * cs); }
}

__device__ __forceinline__ void ga_task(const bf16_t* hb, const bf16_t* WgaT, bf16_t* proj, int wt) {
  int tid = threadIdx.x; asm volatile("" : "+v"(tid));
  const int lane = tid & 63, li = lane & 31, lk = lane >> 5; typedef short b8 __attribute__((ext_vector_type(8))); typedef float f16v __attribute__((ext_vector_type(16)));
  const bf16_t* ap = hb + ((size_t)wt * 32 + li) * 1024 + 8 * lk; const bf16_t* bp = WgaT + (size_t)li * 1024 + 8 * lk;
  f16v acc = {};
  for (int k8 = 0; k8 < 8; ++k8) { v4u av[8], bv[8];
#pragma unroll
    for (int j = 0; j < 8; ++j) { av[j] = *(const v4u*)(ap + 128 * k8 + 16 * j); bv[j] = *(const v4u*)(bp + 128 * k8 + 16 * j); }
#pragma unroll
    for (int j = 0; j < 8; ++j) acc = __builtin_amdgcn_mfma_f32_32x32x16_bf16(__builtin_bit_cast(b8, av[j]), __builtin_bit_cast(b8, bv[j]), acc, 0, 0, 0); }
#pragma unroll
  for (int r = 0; r < 16; ++r) { const int row = wt * 32 + (r & 3) + 8 * (r >> 2) + 4 * lk; proj[(size_t)row * PLD + dd::O_GA + li] = (bf16_t)f2bf(acc[r]); }
}

__global__ void __launch_bounds__(NTHREADS, 2) mega_kernel(KArgs ka_unused) {
  extern __shared__ __attribute__((aligned(16))) unsigned char lds_raw[];
  LAS unsigned char* lds = (LAS unsigned char*)lds_raw;
  volatile LAS unsigned* MISC = (volatile LAS unsigned*)(lds + MISC_OFF);
  constexpr int ARGS_OFF = MISC_OFF + 256;
  static_assert(ARGS_OFF + sizeof(KArgs) <= LDS_BYTES, "LDS map");
  { const unsigned __attribute__((address_space(4)))* kp = (const unsigned __attribute__((address_space(4)))*)__builtin_amdgcn_kernarg_segment_ptr();
    for (int i = threadIdx.x; i < (int)(sizeof(KArgs) / 4); i += NTHREADS) ((LAS unsigned*)(lds + ARGS_OFF))[i] = kp[i]; }
  if (threadIdx.x < 64) MISC[threadIdx.x] = 0u;
  __syncthreads();
  const KArgs& ka = *(const KArgs*)(const LAS KArgs*)(lds + ARGS_OFF);
  const NaiveBufs& a = ka.a;
  unsigned* bar_s; { const unsigned long long bp = (unsigned long long)ka.bar; const unsigned lo_ = __builtin_amdgcn_readfirstlane((unsigned)bp), hi_ = __builtin_amdgcn_readfirstlane((unsigned)(bp >> 32));
    bar_s = (unsigned*)(((unsigned long long)hi_ << 32) | lo_); }
  XcdBarrier xb = xcd_barrier_post(bar_s, MISC);
#define SPTR(T, name, src) T* name; { const unsigned long long bp_ = (unsigned long long)(src); const unsigned lo_ = __builtin_amdgcn_readfirstlane((unsigned)bp_), hi_ = __builtin_amdgcn_readfirstlane((unsigned)(bp_ >> 32)); name = (T*)(((unsigned long long)hi_ << 32) | lo_); }
  SPTR(bf16_t, proj_s, ka.proj) SPTR(bf16_t, hb_s, ka.hb) SPTR(unsigned char, mix_s, ka.mix)
  const long gs = (long)gridDim.x * NTHREADS;
  LAS int* poff = (LAS int*)(lds + MISC_OFF + 64);
#define TID_SETUP int tz = threadIdx.x; asm volatile("" : "+v"(tz)); const int lane = tz & 63, wave = __builtin_amdgcn_readfirstlane(tz >> 6); \
    const int gw = blockIdx.x * NWAVES + wave, NGW = gridDim.x * NWAVES; const long gt = (long)blockIdx.x * NTHREADS + tz; (void)lane; (void)gw; (void)NGW; (void)gt;
#define LSTAGE(ST) { TID_SETUP const long n_ = stage_items<TD>(ST, l); for (long i_ = gt; i_ < n_; i_ += gs) stage_run<TD, ST>(a, l, 0, i_); }
  for (int l = 0; l < dd::DEPTH; ++l) {
    const bool last = (l == dd::DEPTH - 1);
    { TID_SETUP
      LAS float* scr = (LAS float*)(lds + RING_OFF + wave * 16384);
      constexpr int NIT = (dd::D / 64) * (dd::NIN / 32);
      for (int it = gw; it < NIT; it += NGW) { const int n0 = 32 * (it % (dd::NIN / 32));
        if (n0 == dd::O_GA) transpose_item(a.w_in + (size_t)l * dd::D * dd::NIN, dd::D, dd::NIN, ka.WgaT, -dd::O_GA, scr, it, lane);
        else transpose_item(a.w_in + (size_t)l * dd::D * dd::NIN, dd::D, dd::NIN, ka.WinT, n0 < dd::O_GA ? 0 : -32, scr, it, lane); }
      { constexpr int I0 = (dd::HW / 64) * (dd::D / 32), I1 = (dd::GVW / 64) * (dd::D / 32), I2 = (dd::AQW / 64) * (dd::D / 32), I3 = (dd::D / 64) * (dd::D / 32);
        for (int it = gw; it < I0 + I1 + I2 + I3; it += NGW) { int r = it;
          if (r < I0) { transpose_item(a.w_br_hy + (size_t)l * dd::HW * dd::D, dd::HW, dd::D, ka.WhyT, 0, scr, r, lane, 1024); continue; } r -= I0;
          if (r < I1) { transpose_item(a.w_br_gla + (size_t)l * dd::GVW * dd::D, dd::GVW, dd::D, ka.WglaT, 0, scr, r, lane, 1024); continue; } r -= I1;
          if (r < I2) { transpose_item(a.w_br_att + (size_t)l * dd::AQW * dd::D, dd::AQW, dd::D, ka.WattT, 0, scr, r, lane); continue; } r -= I2;
          transpose_item(a.w_out + (size_t)l * dd::D * dd::D, dd::D, dd::D, ka.WoutT, 0, scr, r, lane); } }
      { constexpr int IG = (dd::D / 64) * (dd::DE / 32), IDN = (dd::DE / 64) * (dd::D / 32);
        for (int it = gw; it < dd::NE * (2 * IG + IDN); it += NGW) { const int e = it / (2 * IG + IDN); int r = it % (2 * IG + IDN);
          if (r < 2 * IG) { const int up = r >= IG; if (up) r -= IG; const int n0 = 32 * (r % (dd::DE / 32));
            transpose_item((up ? a.moe_w_up : a.moe_w_gate) + ((size_t)l * dd::NE + e) * dd::D * dd::DE, dd::D, dd::DE, ka.WguT, e * 1024 + 128 * (n0 >> 7) + (up ? 128 : 0), scr, r, lane); }
          else { r -= 2 * IG; transpose_item(a.moe_w_down + ((size_t)l * dd::NE + e) * dd::DE * dd::D, dd::DE, dd::D, ka.WdT, e * 1024, scr, r, lane); } } }
      (void)gt;
    }
    pro::mod_phase(a, l, lds); pro::hid_phase(a, l, dd::S, a.hid2S, lds); if (!last) pro::hid_phase(a, l, dd::C, a.hid2C, lds);
    xcd_barrier(xb);
    pro::tapsB_phase(a, l, (bf16_t*)a.tapsS, lds); if (!last) LSTAGE(L_TAPS_C)
    xcd_barrier(xb);
    pro::nrmB_phase(a, (const bf16_t*)a.tapsS); if (!last) LSTAGE(L_NRM_C)
    xcd_barrier(xb);
    for (int grp = 0; grp < NGRP; ++grp) {
      const int b0 = grp * GB;
      { TID_SETUP
        for (int rg = gw; rg < RG; rg += NGW) { const int bl = rg / RB, r = rg % RB, b = b0 + bl; const float* md = a.mod + (size_t)(r < dd::S ? b : dd::B) * 6 * 1024;
          if (l == 0) norm_row<false>(xrow_in(a, 0, b, r), a.norm1_g, md, md + 1024, hb_s + (size_t)rg * 1024, lane);
          else norm_row<true>(ka.xs + ((size_t)grp * RG + rg) * 1024, a.norm1_g + (size_t)l * 1024, md, md + 1024, hb_s + (size_t)rg * 1024, lane); }
        xcd_barrier(xb); }
      { pg8::Gemm g{hb_s, ka.WinT, RG, NINP, dd::D, 0}; pg8::StaticOrder S; S.init(RG, NINP, (int)gridDim.x, (int)blockIdx.x); EpiProjBf16 E{proj_s};
        pg8::gemm_phase<EpiProjBf16, pg8::StaticOrder, false>((PG8_LAS unsigned char*)(lds + RING_OFF), g, S, E, nullptr);
        { int tq = threadIdx.x; asm volatile("" : "+v"(tq)); const int wv_ = __builtin_amdgcn_readfirstlane(tq >> 6);
          for (int wt = (int)blockIdx.x + (int)gridDim.x * wv_; wt < PANELS * 8; wt += (int)gridDim.x * NWAVES) ga_task(hb_s, ka.WgaT, proj_s, wt); }
        xcd_barrier(xb); }
      { TID_SETUP
        for (int rg = gw; rg < RG; rg += NGW) qknorm_row(proj_s + (size_t)rg * PLD, a.q_norm_g + (size_t)l * 128, a.k_norm_g + (size_t)l * 128, rg % RB, lane);
        for (int u = blockIdx.x; u < GB * 4 * 68; u += gridDim.x) { const int bl = u / (4 * 68), hu = u % (4 * 68); const bf16_t* pb = proj_s + (size_t)bl * RB * PLD;
          gla::In gp; gp.q = pb + dd::O_GQ; gp.k = pb + dd::O_GK; gp.v = pb + dd::O_GV; gp.ga = pb + dd::O_GA; gp.og = pb + dd::O_OG; gp.ld = PLD;
          gp.wa2 = a.gla_wa2 + (size_t)l * 2 * 16 * 256; gp.ba = a.gla_ba + (size_t)l * 2 * 256; gp.gnorm = a.gla_norm_g + (size_t)l * 128;
          gp.csb = (bf16_t*)(mix_s + (size_t)bl * CS_BYTES); gp.dec = (float*)(mix_s + (size_t)GB * CS_BYTES + (size_t)bl * DEC_BYTES); gp.y = (bf16_t*)pb + dd::O_OG; gp.ldy = PLD; gp.S = dd::S; gp.C = dd::C;
          gla::g1b_unit(gp, lds, hu / 68, hu % 68, 4, 68); }
        xcd_barrier(xb); }
      { TID_SETUP
        for (long i_ = gt; i_ < (long)GB * 2 * 4 * 64 * 64; i_ += gs) { const int bl = (int)(i_ / (2 * 4 * 64 * 64)); gla::In gp; gp.csb = (bf16_t*)(mix_s + (size_t)bl * CS_BYTES); gp.dec = (float*)(mix_s + (size_t)GB * CS_BYTES + (size_t)bl * DEC_BYTES); gp.S = dd::S; gp.C = dd::C;
          gla::g2_item(gp, i_ % (2 * 4 * 64 * 64), 4, 68); }
        const int combo = blockIdx.x & 7, slot = blockIdx.x >> 3, nslot = gridDim.x >> 3;
        const int per_combo = 64 + (last ? 0 : 4);
        const bool xcdm = (gridDim.x & 7) == 0;
        for (int uu = xcdm ? slot : (int)blockIdx.x; uu < (xcdm ? per_combo : 8 * per_combo); uu += xcdm ? nslot : (int)gridDim.x) { const int cmb = xcdm ? combo : uu / per_combo, ui = xcdm ? uu : uu % per_combo;
          const bool lat = ui < 64; const int bl = cmb >> 1, kvh = cmb & 1;
          const int head = kvh * 4 + (lat ? ui >> 4 : ui - 64), qb = lat ? ui & 15 : 0;
          bf16_t* pb = proj_s + (size_t)bl * RB * PLD; const size_t qrow = lat ? (size_t)qb * 256 : (size_t)dd::S, krow = lat ? 0 : (size_t)dd::S;
          att::attn_dense_body<att::bf16, PLD, PLD, PLD, true>((const att::bf16*)(pb + qrow * PLD + dd::O_AQ + head * 128), (const att::bf16*)(pb + krow * PLD + dd::O_AK + kvh * 128),
              (const att::bf16*)(pb + krow * PLD + dd::O_AV + kvh * 128), pb + qrow * PLD + dd::O_AQ + head * 128, lat ? RB : dd::C, (char*)lds_raw);
          __syncthreads(); }
        xcd_barrier(xb); }
      { const int n3 = last ? 64 : 68;
        for (int u = blockIdx.x; u < GB * 4 * n3; u += gridDim.x) { const int bl = u / (4 * n3), hu = u % (4 * n3); const bf16_t* pb = proj_s + (size_t)bl * RB * PLD;
          gla::In gp; gp.q = pb + dd::O_GQ; gp.k = pb + dd::O_GK; gp.v = pb + dd::O_GV; gp.ga = pb + dd::O_GA; gp.og = pb + dd::O_OG; gp.ld = PLD;
          gp.wa2 = a.gla_wa2 + (size_t)l * 2 * 16 * 256; gp.ba = a.gla_ba + (size_t)l * 2 * 256; gp.gnorm = a.gla_norm_g + (size_t)l * 128;
          gp.csb = (bf16_t*)(mix_s + (size_t)bl * CS_BYTES); gp.dec = (float*)(mix_s + (size_t)GB * CS_BYTES + (size_t)bl * DEC_BYTES); gp.y = (bf16_t*)pb + dd::O_OG; gp.ldy = PLD; gp.S = dd::S; gp.C = dd::C;
          gla::g3b_unit(gp, lds, hu / n3, hu % n3, 4, 68); }
        xcd_barrier(xb); }
      {
        bf16_t* ucT0 = (bf16_t*)mix_s; bf16_t* yT0 = (bf16_t*)(mix_s + GB * UCT_BYTES); float* ucc0 = (float*)(mix_s + GB * (UCT_BYTES + YT_BYTES)); float* z1c0 = (float*)(mix_s + GB * (UCT_BYTES + YT_BYTES + UCC_BYTES));
        const float* cw = a.hy_conv_w + (size_t)l * 3 * 1536; const float* cb = a.hy_conv_b + (size_t)l * 1536; const float* skp = a.hy_skip + (size_t)l * 2 * 512;
        { TID_SETUP
        { int t_ = blockIdx.x; hy::H0Regs hr = hy::h0_load(proj_s + (size_t)(t_ / (64 * 24)) * RB * PLD + dd::O_HY, PLD, t_ % (64 * 24), tz);
          for (; t_ < GB * 64 * 24; t_ += gridDim.x) { const int bl = t_ / (64 * 24), tn_ = t_ + gridDim.x; hy::H0Regs hn = hr;
            if (tn_ < GB * 64 * 24) hn = hy::h0_load(proj_s + (size_t)(tn_ / (64 * 24)) * RB * PLD + dd::O_HY, PLD, tn_ % (64 * 24), tz);
            hy::h0_compute(hr, cw, cb, ucT0 + (size_t)bl * 1536 * 4096, t_ % (64 * 24), lds, tz); hr = hn; } }
        if (!last) for (long i_ = gt; i_ < (long)GB * 256 * 1536; i_ += gs) { const int bl = (int)(i_ / (256 * 1536)); hy::cconv3_item(proj_s + ((size_t)bl * RB + dd::S) * PLD + dd::O_HY, PLD, cw, cb, ucc0 + (size_t)bl * 256 * 1536, i_ % (256 * 1536)); } }
        xcd_barrier(xb);
        { TID_SETUP
        for (int u = blockIdx.x; u < (GB / 2) * 512; u += gridDim.x) { const int bp_ = u / 512; hy::h1c_unit(ucT0 + (size_t)(2 * bp_) * 1536 * 4096, (const bf16_t*)a.tapsS, a.nrmS, skp, yT0 + (size_t)(2 * bp_) * 512 * 4096, u % 512, lds); }
        if (!last) for (long i_ = gt; i_ < (long)GB * 32 * 512; i_ += gs) { const int bl = (int)(i_ / (32 * 512)); hy::clong_item(ucc0 + (size_t)bl * 256 * 1536, nullptr, z1c0 + (size_t)bl * 256 * 512, nullptr, 0, a.tapsC, a.nrmC, skp, 0, i_ % (32 * 512)); } }
        xcd_barrier(xb);
        { TID_SETUP
        for (int t_ = blockIdx.x; t_ < GB * 64 * 8; t_ += gridDim.x) { const int bl = t_ / (64 * 8); hy::h2_tile(yT0 + (size_t)bl * 512 * 4096, proj_s + (size_t)bl * RB * PLD + dd::O_HY, PLD, t_ % (64 * 8), lds); }
        if (!last) for (long i_ = gt; i_ < (long)GB * 32 * 512; i_ += gs) { const int bl = (int)(i_ / (32 * 512)); hy::clong_item(ucc0 + (size_t)bl * 256 * 1536, z1c0 + (size_t)bl * 256 * 512, nullptr, proj_s + ((size_t)bl * RB + dd::S) * PLD + dd::O_HY, PLD, a.tapsC, a.nrmC, skp, 1, i_ % (32 * 512)); } }
        xcd_barrier(xb); }
      { { pg8::Gemm g{proj_s, ka.WhyT, RG, 1024, 1024, PLD, 1024}; MergeOrder S; S.init((int)gridDim.x, (int)blockIdx.x, last); EpiMergeS E{(const unsigned char*)(proj_s + dd::O_BR), (bf16_t*)mix_s};
          pg8::gemm_phase<EpiMergeS, MergeOrder, false>((PG8_LAS unsigned char*)(lds + RING_OFF), g, S, E, nullptr); }
        xcd_barrier(xb);
        pg8::Gemm g{(const bf16_t*)mix_s, ka.WoutT, RG, 1024, 1024, 0}; GroupOrder S; S.init(1024, (int)gridDim.x, (int)blockIdx.x, last);
        EpiOutG E{a.x, a.ctx, ka.xs + (size_t)grp * RG * 1024, a.mod, b0, !last, l != 0};
        pg8::gemm_phase<EpiOutG, GroupOrder, false>((PG8_LAS unsigned char*)(lds + RING_OFF), g, S, E, nullptr);
        xcd_barrier(xb); }
      {
        { TID_SETUP int* cnt = ka.cnt + (l * NGRP + grp) * 1024;
          LAS bf16_t* wfr = (LAS bf16_t*)(lds + RING_OFF);
          for (int i_ = tz; i_ < 1024 * 16; i_ += NTHREADS) { const int k = i_ >> 4, e = i_ & 15; const float w = a.router_w[i_]; const unsigned hi = f2bf(w); const unsigned lo = f2bf(w - __uint_as_float(hi << 16));
            const int idx = (((k >> 5) * 64 + ((k >> 3) & 3) * 16 + e) << 3) + (k & 7); wfr[idx] = (bf16_t)hi; wfr[16384 + idx] = (bf16_t)lo; }
          LAS int* lcnt = (LAS int*)(lds + RING_OFF + 65536);
          if (tz < 32) lcnt[tz] = 0;
          LAS float* ptab = (LAS float*)(lds + RING_OFF + 65536 + 1024);
          for (int i_ = tz; i_ < 5 * 1024; i_ += NTHREADS) { const int v_ = i_ >> 10, c_ = i_ & 1023; const float* md = a.mod + (size_t)(v_ < GB ? b0 + v_ : dd::B) * 6 * 1024;
            const float g_ = a.norm2_g[(size_t)l * 1024 + c_]; ptab[v_ * 2048 + c_] = g_ * md[4 * 1024 + c_] + g_; ptab[v_ * 2048 + 1024 + c_] = md[3 * 1024 + c_]; }
          __syncthreads();
          const int wv_ = __builtin_amdgcn_readfirstlane(tz >> 6);
          for (int t_ = (int)blockIdx.x + (int)gridDim.x * wv_; t_ < RG / 16; t_ += (int)gridDim.x * NWAVES) { const int rg = 16 * t_, bl = rg / RB, r = rg % RB, b = b0 + bl; if (last && r >= dd::S) continue;
            const LAS float* pt_ = ptab + (r < dd::S ? bl : GB) * 2048; (void)b;
            moe::route16(ka.xs + ((size_t)grp * RG + rg) * 1024, pt_, pt_ + 1024, hb_s + (size_t)rg * 1024, (const LAS v4u*)wfr, a.router_b, lcnt, ka.route + rg, ka.wts + 2 * rg, lane); }
          __syncthreads();
          if (tz < 16) lcnt[16 + tz] = atomicAdd(cnt + tz * 64, lcnt[tz]);
          __syncthreads();
          for (int t_ = (int)blockIdx.x + (int)gridDim.x * wv_; t_ < RG / 16; t_ += (int)gridDim.x * NWAVES) { const int rg = 16 * t_; if (last && (rg % RB) >= dd::S) continue;
            if (lane < 16) { moe::Route* rt = ka.route + rg + lane; moe::Route r_ = *rt; r_.r0 += lcnt[16 + r_.e0]; r_.r1 += lcnt[16 + r_.e1]; *rt = r_; } }
          xcd_barrier(xb); }
        { TID_SETUP int* cnt = ka.cnt + (l * NGRP + grp) * 1024;
          if (tz == 0) { int acc_ = 0; for (int e = 0; e < 16; ++e) { poff[e] = acc_; acc_ += (cnt[e * 64] + 255) >> 8; } poff[16] = acc_; }
          __syncthreads();
          for (int rg = gw; rg < RG; rg += NGW) { if (last && (rg % RB) >= dd::S) continue; const moe::Route rt = ka.route[rg];
            const v4u h0 = *(const v4u*)(hb_s + (size_t)rg * 1024 + lane * 16), h1 = *(const v4u*)(hb_s + (size_t)rg * 1024 + lane * 16 + 8);
#pragma unroll
            for (int sl = 0; sl < 2; ++sl) { const int e = sl ? rt.e1 : rt.e0, rk = sl ? rt.r1 : rt.r0; const size_t dst = (size_t)poff[e] * 256 + rk;
              *(v4u*)(ka.hp + dst * 1024 + lane * 16) = h0; *(v4u*)(ka.hp + dst * 1024 + lane * 16 + 8) = h1;
              if (lane == 0) { ka.srcrow[dst] = 2 * rg + sl; ka.wgt[dst] = ka.wts[2 * rg + sl]; } } }
          for (int e = 0; e < 16; ++e) { const int c_ = cnt[e * 64], pe = ((c_ + 255) >> 8) << 8; for (int p_ = c_ + (int)gt; p_ < pe; p_ += (int)gs) ka.srcrow[(size_t)poff[e] * 256 + p_] = -1; }
          xcd_barrier(xb); }
        { pg8::Gemm g{ka.hp, ka.WguT, 0, 0, 1024, 0}; moe::MoeOrder S{(int)gridDim.x, (int)blockIdx.x, 4, poff}; moe::EpiGU E{ka.hid};
          pg8::gemm_phase<moe::EpiGU, moe::MoeOrder, false>((PG8_LAS unsigned char*)(lds + RING_OFF), g, S, E, nullptr);
          xcd_barrier(xb); }
        { pg8::Gemm g{ka.hid, ka.WdT, 0, 0, 512, 0}; moe::MoeOrder S{(int)gridDim.x, (int)blockIdx.x, 4, poff}; moe::EpiDown E{ka.srcrow, ka.wgt, ka.contrib, (size_t)RG * 1024};
          pg8::gemm_phase<moe::EpiDown, moe::MoeOrder, false>((PG8_LAS unsigned char*)(lds + RING_OFF), g, S, E, nullptr);
          xcd_barrier(xb); }
        { TID_SETUP
          bf16_t* xsg = ka.xs + (size_t)grp * RG * 1024;
#pragma unroll 2
          for (long i_ = gt; i_ < (long)RG * 128; i_ += gs) { const int rg = (int)(i_ >> 7), c8 = (int)(i_ & 127) * 8; const int bl = rg / RB, r = rg % RB, b = b0 + bl; if (last && r >= dd::S) continue;
            const float* g2 = a.mod + (size_t)(r < dd::S ? b : dd::B) * 6 * 1024 + 5 * 1024 + c8;
            const v4u u0 = *(const v4u*)(ka.contrib + (size_t)rg * 1024 + c8), u1 = *(const v4u*)(ka.contrib + (size_t)RG * 1024 + (size_t)rg * 1024 + c8), xo = *(const v4u*)(xsg + (size_t)rg * 1024 + c8);
            const pg8::f32x4 ga_ = *(const pg8::f32x4*)g2, gb_ = *(const pg8::f32x4*)(g2 + 4);
            pg8::f32x4 ya, yb;
            ya[0] = __uint_as_float(xo.x << 16) + ga_[0] * (__uint_as_float(u0.x << 16) + __uint_as_float(u1.x << 16)); ya[1] = __uint_as_float(xo.x & 0xffff0000u) + ga_[1] * (__uint_as_float(u0.x & 0xffff0000u) + __uint_as_float(u1.x & 0xffff0000u));
            ya[2] = __uint_as_float(xo.y << 16) + ga_[2] * (__uint_as_float(u0.y << 16) + __uint_as_float(u1.y << 16)); ya[3] = __uint_as_float(xo.y & 0xffff0000u) + ga_[3] * (__uint_as_float(u0.y & 0xffff0000u) + __uint_as_float(u1.y & 0xffff0000u));
            yb[0] = __uint_as_float(xo.z << 16) + gb_[0] * (__uint_as_float(u0.z << 16) + __uint_as_float(u1.z << 16)); yb[1] = __uint_as_float(xo.z & 0xffff0000u) + gb_[1] * (__uint_as_float(u0.z & 0xffff0000u) + __uint_as_float(u1.z & 0xffff0000u));
            yb[2] = __uint_as_float(xo.w << 16) + gb_[2] * (__uint_as_float(u0.w << 16) + __uint_as_float(u1.w << 16)); yb[3] = __uint_as_float(xo.w & 0xffff0000u) + gb_[3] * (__uint_as_float(u0.w & 0xffff0000u) + __uint_as_float(u1.w & 0xffff0000u));
            if (last) { float* o = a.out + ((size_t)b * dd::S + r) * 1024 + c8; *(pg8::f32x4*)o = ya; *(pg8::f32x4*)(o + 4) = yb; }
            else { v4u w; w.x = pk2h(ya[0], ya[1]); w.y = pk2h(ya[2], ya[3]); w.z = pk2h(yb[0], yb[1]); w.w = pk2h(yb[2], yb[3]); *(v4u*)(xsg + (size_t)rg * 1024 + c8) = w; } }
          xcd_barrier(xb); }
      }
    }
  }
}
extern "C" void kernel_launch(void* const* d_in, const int* in_sizes, int n_in, void* d_out, int out_size, void* d_ws, size_t ws_size, hipStream_t stream) {
  static int grid = 0;
  if (!grid) {
    int dev = 0, cus = 0, per_cu = 0;
    (void)hipGetDevice(&dev); (void)hipDeviceGetAttribute(&cus, hipDeviceAttributeMultiprocessorCount, dev);
    (void)hipFuncSetAttribute((const void*)mega_kernel, hipFuncAttributeMaxDynamicSharedMemorySize, LDS_BYTES);
    (void)hipOccupancyMaxActiveBlocksPerMultiprocessor(&per_cu, mega_kernel, NTHREADS, LDS_BYTES);
    if (per_cu < 1) fprintf(stderr, "occupancy query says %d\n", per_cu);
    grid = cus;
  }
  KArgs ka{}; const float* ptrs[33]; for (int i = 0; i < 33; ++i) ptrs[i] = (const float*)d_in[i];
  set_inputs<TD>(ka.a, ptrs);
  char* wsb = (char*)d_ws; size_t off = BAR_BYTES;
  auto take = [&](size_t bytes) { char* p = wsb + off; off += (bytes + 255) & ~(size_t)255; return p; };
  NaiveBufs& a = ka.a;
  a.mod = (float*)take((size_t)(dd::B + 1) * 6 * 1024 * 4); a.hid2S = (float*)take((size_t)dd::S * 64 * 4); a.hid2C = (float*)take((size_t)dd::C * 64 * 4);
  a.tapsS = (float*)take((size_t)2 * 512 * 2 * 8232 * 2 + 64); a.tapsC = (float*)take((size_t)2 * 512 * 512 * 4); a.nrmS = (float*)take(1024 * 4); a.nrmC = (float*)take(1024 * 4);
  ka.xs = (bf16_t*)take((size_t)dd::B * RB * 1024 * 2);
  ka.WgaT = (bf16_t*)take((size_t)32 * 1024 * 2); ka.WinT = (bf16_t*)take((size_t)NINP * 1024 * 2); ka.WhyT = (bf16_t*)take((size_t)1024 * 1024 * 2); ka.WglaT = (bf16_t*)take((size_t)1024 * 1024 * 2); ka.WattT = (bf16_t*)take((size_t)1024 * 1024 * 2);
  ka.WoutT = (bf16_t*)take((size_t)1024 * 1024 * 2); ka.WguT = (bf16_t*)take((size_t)16 * 1024 * 1024 * 2); ka.WdT = (bf16_t*)take((size_t)16 * 1024 * 512 * 2);
  ka.hb = (bf16_t*)take((size_t)RG * 1024 * 2); ka.mix = (unsigned char*)take(MIX_BYTES);
  ka.proj = (bf16_t*)take((size_t)RG * PLD * 2);
  { char* p = (char*)ka.proj; ka.hp = (bf16_t*)p; p += (size_t)MPG * 1024 * 2; ka.hid = (bf16_t*)p; p += (size_t)MPG * 512 * 2; ka.contrib = (bf16_t*)p; p += (size_t)2 * RG * 1024 * 2;
    ka.srcrow = (int*)p; p += (size_t)MPG * 4; ka.wgt = (float*)p; p += (size_t)MPG * 4; ka.route = (moe::Route*)p; p += (size_t)RG * 16; ka.wts = (float*)p; p += (size_t)RG * 8;
    if ((size_t)(p - (char*)ka.proj) > (size_t)RG * PLD * 2) fprintf(stderr, "MoE alias region too large\n"); }
  a.out = (float*)d_out; ka.bar = (unsigned*)d_ws; ka.cnt = (int*)(wsb + CNT_OFF);
  if (off > ws_size) fprintf(stderr, "workspace too small: need %zu have %zu\n", off, ws_size);
  (void)hipMemsetAsync(d_ws, 0, BAR_BYTES, stream);
  hipLaunchKernelGGL(mega_kernel, dim3(grid), dim3(NTHREADS), LDS_BYTES, stream, ka);
}
```

```cpp
#include <hip/hip_runtime.h>
#include <cstddef>
#include <cstdio>
#include <cstdint>
#include <hip/hip_bf16.h>
#include <hip/hip_runtime.h>
namespace pg8 {
#define PG8_LAS __attribute__((address_space(3)))
typedef unsigned short bf16_t;
typedef short bf16x8 __attribute__((ext_vector_type(8)));
typedef float f32x4 __attribute__((ext_vector_type(4)));
typedef unsigned u32x4 __attribute__((ext_vector_type(4)));
constexpr int BM = 256, BK = 64, HALF = 128, HTB = HALF * BK * 2  , STAGE_BYTES = 8 * HTB, NXCD = 8, WGM = 8;

__host__ __device__ __forceinline__ int lds_byte(int r, int c) { const int st = (r >> 4) * 2 + (c >> 5), rr = r & 15, cc = c & 31, ob = rr * 64 + cc * 2; return st * 1024 + (ob ^ (((ob >> 9) & 1) << 5)); }
__host__ __device__ __forceinline__ void stage_rc(int b, int& R, int& C) { const int st = b / 1024, sb = b % 1024, swz = sb ^ (((sb >> 9) & 1) << 5); R = (st >> 1) * 16 + swz / 64; C = (st & 1) * 32 + (swz % 64) / 2; }
__host__ __device__ __forceinline__ int perm32(int rho) { const int n = rho >> 4, i = rho & 15; return 8 * (i >> 2) + 4 * n + (i & 3); }

struct Unit { int pm, pn, acol, nt; };
struct Gemm { const bf16_t* A; const bf16_t* Bt; int M, N, K; int lda; int ldb; const int* arow; };

struct StaticOrder {
    int nM, nN, nwg, G, c;
    __host__ __device__ void init(int M, int N, int G_, int c_) { nM = M / BM; nN = N / BM; nwg = nM * nN; G = G_; c = c_; }
    __host__ __device__ bool next(int i, Unit& u) const {
        const long L = (long)i * G + c; if (L >= nwg) return false;
        int wgid = (int)L; { const int q = nwg / NXCD, r = nwg % NXCD, xcd = wgid % NXCD, off = wgid / NXCD; wgid = (xcd < r ? xcd * (q + 1) : r * (q + 1) + (xcd - r) * q) + off; }
        const int nig = WGM * nN, gid = wgid / nig, fm = gid * WGM, gsz = (nM - fm) < WGM ? (nM - fm) : WGM;
        u.pm = fm + ((wgid % nig) % gsz); u.pn = (wgid % nig) / gsz; u.acol = 0; u.nt = 0; return true;
    }
    __device__ __forceinline__ void a_ready(const Unit&) const {}
    __device__ __forceinline__ void done(const Unit&) const {}
};
__device__ __forceinline__ unsigned cvt_pk_bf16(float lo, float hi) { unsigned r; asm volatile("v_cvt_pk_bf16_f32 %0, %1, %2" : "=v"(r) : "v"(lo), "v"(hi)); return r; }
typedef float f32x2 __attribute__((ext_vector_type(2)));
template <class Epi, class Sched, bool STAMP = false, bool GA = false>
__device__ __forceinline__ void gemm_phase(PG8_LAS unsigned char* lds, const Gemm g, const Sched& S, const Epi& E, unsigned long long* stamps) {
    int tid = threadIdx.x; asm volatile("" : "+v"(tid)); const int wid = __builtin_amdgcn_readfirstlane(tid >> 6), lane = tid & 63, wr = wid >> 2, wc = wid & 3, fr = lane & 15, fq = lane >> 4;
    const int K = g.K, nt = K / BK, LDA = g.lda ? g.lda : g.K, LDB = g.ldb ? g.ldb : g.K;
    int ts_lo = 0, ts_hi = 0, nts = 0; const unsigned long long rt_entry = STAMP ? (unsigned long long)wall_clock64() : 0ull;
#define PG8_STAMP() do { if (STAMP && wid == 0 && nts < 64) { const unsigned long long _c = (unsigned long long)clock64(); \
        ts_lo = (lane == nts) ? (int)(unsigned)_c : ts_lo; ts_hi = (lane == nts) ? (int)(unsigned)(_c >> 32) : ts_hi; ++nts; } } while (0)
    PG8_STAMP();
    unsigned voffA[2], voffB[2];
#pragma unroll
    for (int i = 0; i < 2; ++i) { int R, C; stage_rc(tid * 16 + i * 8192, R, C); const int Rb = Epi::PERM ? ((R & ~31) + perm32(R & 31)) : R;
        voffA[i] = (unsigned)(R * LDA + C) * 2u; voffB[i] = (unsigned)(Rb * LDB + C) * 2u; }
    const size_t kstep = (size_t)(BK * 2);
    const size_t hstep = (size_t)HALF * LDB * 2;
    const size_t tstep = 2 * hstep;
    const size_t hstepA = (size_t)HALF * LDA * 2, tstepA = 2 * hstepA;
    const unsigned ldsw = (unsigned)wid * 1024u;
    const int aoff = lds_byte(wr * 64 + fr, fq * 8), boff = lds_byte(wc * 32 + fr, fq * 8);
#define PG8_SA(b, h) (((b) * 2 + (h)) * HTB)
#define PG8_SB(b, h) ((4 + (b) * 2 + (h)) * HTB)
#define PG8_STAGE(bufoff, gbase, voff) do { _Pragma("unroll") for (int _i = 0; _i < 2; ++_i) \
        __builtin_amdgcn_global_load_lds((const unsigned*)((const char*)(gbase) + (voff)[_i]), (PG8_LAS unsigned*)(lds + (bufoff) + ldsw + _i * 8192), 16, 0, 0); } while (0)
#define PG8_STAGE_A(bufoff, kb, h, usenext) do { if constexpr (GA) { const unsigned pk_ = (usenext) ? vAn[h] : vAc[h]; unsigned vv_[2] = { ((pk_ & 0xffffu) * (unsigned)LDA + (unsigned)gaC) * 2u, ((pk_ >> 16) * (unsigned)LDA + (unsigned)gaC) * 2u }; PG8_STAGE(bufoff, kb, vv_); } \
        else PG8_STAGE(bufoff, (kb) + (h) * hstepA, voffA); } while (0)
#define PG8_ROWOFF(dst, pm_) do { _Pragma("unroll") for (int h_ = 0; h_ < 2; ++h_) { const int* ar_ = g.arow + (pm_) * 256 + h_ * 128 + gaR; dst[h_] = (unsigned)ar_[0] | ((unsigned)ar_[64] << 16); } } while (0)
#define PG8_LDA(dst, b, h) do { _Pragma("unroll") for (int m = 0; m < 4; ++m) _Pragma("unroll") for (int k = 0; k < 2; ++k) dst[m][k] = *(const PG8_LAS bf16x8*)(lds + PG8_SA(b, h) + aoff + m * 2048 + k * 1024); } while (0)
#define PG8_LDB(dst, b, h) do { _Pragma("unroll") for (int n = 0; n < 2; ++n) _Pragma("unroll") for (int k = 0; k < 2; ++k) dst[n][k] = *(const PG8_LAS bf16x8*)(lds + PG8_SB(b, h) + boff + n * 2048 + k * 1024); } while (0)
#define PG8_MMA(ai, bj, At, Bt) do { __builtin_amdgcn_s_setprio(1); _Pragma("unroll") for (int m = 0; m < 4; ++m) _Pragma("unroll") for (int n = 0; n < 2; ++n) _Pragma("unroll") for (int k = 0; k < 2; ++k) \
        acc[ai][bj][m][n] = __builtin_amdgcn_mfma_f32_16x16x32_bf16(Bt[n][k], At[m][k], acc[ai][bj][m][n], 0, 0, 0); __builtin_amdgcn_s_setprio(0); } while (0)
#define PG8_WAIT_V(n) asm volatile("s_waitcnt vmcnt(" #n ")" ::: "memory")
#define PG8_WAIT_L(n) asm volatile("s_waitcnt lgkmcnt(" #n ")" ::: "memory")
#define PG8_BAR __builtin_amdgcn_s_barrier()
#define PG8_SCHED __builtin_amdgcn_sched_barrier(0)
    Unit cur, nxt; int ui = 0;
    if (!S.next(0, cur)) return;
    f32x4 acc[2][2][4][2];
#pragma unroll
    for (int a = 0; a < 2; ++a)
#pragma unroll
        for (int b = 0; b < 2; ++b)
#pragma unroll
            for (int m = 0; m < 4; ++m)
#pragma unroll
                for (int n = 0; n < 2; ++n) acc[a][b][m][n] = (f32x4){0.f, 0.f, 0.f, 0.f};
    bf16x8 At[4][2], B0[2][2], B1[2][2];
    const char* cA = (const char*)g.A + (GA ? (size_t)0 : (size_t)cur.pm * tstepA) + (size_t)cur.acol * 2; const char* cB = (const char*)g.Bt + (size_t)cur.pn * tstep;
    unsigned vAc[2] = {0u, 0u}, vAn[2] = {0u, 0u}; int gaR = 0, gaC = 0; if constexpr (GA) { stage_rc(tid * 16, gaR, gaC); }
    S.a_ready(cur);
    if constexpr (GA) PG8_ROWOFF(vAc, cur.pm);
    PG8_STAGE(PG8_SB(0, 0), cB, voffB); PG8_STAGE_A(PG8_SA(0, 0), cA, 0, false); PG8_STAGE(PG8_SB(0, 1), cB + hstep, voffB); PG8_STAGE_A(PG8_SA(0, 1), cA, 1, false);
    if (wr == 1) PG8_BAR;
    PG8_WAIT_V(4); PG8_BAR;
    PG8_STAGE(PG8_SB(1, 0), cB + kstep, voffB); PG8_STAGE_A(PG8_SA(1, 0), cA + kstep, 0, false); PG8_STAGE(PG8_SB(1, 1), cB + hstep + kstep, voffB);
    PG8_WAIT_V(6); PG8_BAR;
    PG8_STAMP();
    for (;;) {
        const bool has_next = S.next(ui + 1, nxt);
        const char* nA = has_next ? (const char*)g.A + (GA ? (size_t)0 : (size_t)nxt.pm * tstepA) + (size_t)nxt.acol * 2 : cA;
        if constexpr (GA) { if (has_next) PG8_ROWOFF(vAn, nxt.pm); else { vAn[0] = vAc[0]; vAn[1] = vAc[1]; } } const char* nB = has_next ? (const char*)g.Bt + (size_t)nxt.pn * tstep : cB;
        const int ntu = cur.nt ? cur.nt : nt;
        for (int t = 0; t < ntu; t += 2) {
            const bool last = (t == ntu - 2);
            const char* a1 = cA + (size_t)(t + 1) * kstep;
            const char* a2 = last ? nA : cA + (size_t)(t + 2) * kstep; const char* b2 = last ? nB : cB + (size_t)(t + 2) * kstep;
            const char* a3 = a2 + kstep; const char* b3 = b2 + kstep;
            if (last && has_next) S.a_ready(nxt);
            PG8_LDB(B0, 0, 0); PG8_SCHED; PG8_LDA(At, 0, 0); PG8_STAGE_A(PG8_SA(1, 1), a1, 1, false);
            PG8_WAIT_L(8); PG8_BAR; PG8_WAIT_L(0); PG8_MMA(0, 0, At, B0); PG8_BAR; PG8_SCHED;
            PG8_LDB(B1, 0, 1); PG8_STAGE(PG8_SB(0, 0), b2, voffB);
            PG8_BAR; PG8_WAIT_L(0); PG8_MMA(0, 1, At, B1); PG8_BAR;
            PG8_LDA(At, 0, 1); PG8_STAGE_A(PG8_SA(0, 0), a2, 0, last);
            PG8_BAR; PG8_WAIT_L(0); PG8_MMA(1, 0, At, B0); PG8_BAR; PG8_SCHED;
            PG8_STAGE(PG8_SB(0, 1), b2 + hstep, voffB);
            PG8_WAIT_V(6); PG8_BAR; PG8_MMA(1, 1, At, B1); PG8_BAR;
            PG8_LDB(B0, 1, 0); PG8_SCHED; PG8_LDA(At, 1, 0); PG8_STAGE_A(PG8_SA(0, 1), a2, 1, last);
            PG8_WAIT_L(8); PG8_BAR; PG8_WAIT_L(0); PG8_MMA(0, 0, At, B0); PG8_BAR; PG8_SCHED;
            PG8_LDB(B1, 1, 1); PG8_STAGE(PG8_SB(1, 0), b3, voffB);
            PG8_BAR; PG8_WAIT_L(0); PG8_MMA(0, 1, At, B1); PG8_BAR;
            PG8_LDA(At, 1, 1); PG8_STAGE_A(PG8_SA(1, 0), a3, 0, last);
            PG8_BAR; PG8_WAIT_L(0); PG8_MMA(1, 0, At, B0); PG8_BAR; PG8_SCHED;
            PG8_STAGE(PG8_SB(1, 1), b3 + hstep, voffB);
            PG8_WAIT_V(6); PG8_BAR; PG8_MMA(1, 1, At, B1); PG8_BAR;
        }
        PG8_STAMP();
        bool keep_acc = false;
        if constexpr (!Epi::AFTER_DRAIN) { if constexpr (Epi::CHAIN) keep_acc = E.chain(acc, cur, wr, wc, fr, fq); else E(acc, cur, wr, wc, fr, fq); S.done(cur); }
        PG8_STAMP();
        if (!has_next) break;
        if (!keep_acc)
#pragma unroll
        for (int a = 0; a < 2; ++a)
#pragma unroll
            for (int b = 0; b < 2; ++b)
#pragma unroll
                for (int m = 0; m < 4; ++m)
#pragma unroll
                    for (int n = 0; n < 2; ++n) acc[a][b][m][n] = (f32x4){0.f, 0.f, 0.f, 0.f};
        cur = nxt; cA = nA; cB = nB; ++ui;
        if constexpr (GA) { vAc[0] = vAn[0]; vAc[1] = vAn[1]; }
    }
    PG8_WAIT_V(0);
    if (wr == 0) PG8_BAR;
    PG8_BAR;
    if constexpr (Epi::AFTER_DRAIN) { E.fused(acc, cur, wr, wc, fr, fq, lds, wid, lane); S.done(cur); }
    PG8_STAMP();
    if (STAMP && wid == 0) { stamps[lane] = lane < nts ? (((unsigned long long)(unsigned)ts_hi << 32) | (unsigned)ts_lo) : 0ull;
        if (lane == 62) stamps[62] = rt_entry; if (lane == 63) stamps[63] = (unsigned long long)wall_clock64(); }
#undef PG8_STAMP
#undef PG8_SA
#undef PG8_SB
#undef PG8_STAGE
#undef PG8_STAGE_A
#undef PG8_ROWOFF
#undef PG8_LDA
#undef PG8_LDB
#undef PG8_MMA
#undef PG8_WAIT_V
#undef PG8_WAIT_L
#undef PG8_BAR
#undef PG8_SCHED
}
}

#define LAS __attribute__((address_space(3)))
typedef unsigned short bf16_t;
constexpr int NWAVES = 8, NTHREADS = 512;
constexpr int LDS_BYTES = 147456;
constexpr int RING_OFF = 0;
constexpr int MISC_OFF = 131072;
constexpr int NINP = 7680;

__device__ __forceinline__ unsigned f2bf(float f) { return (unsigned)__builtin_bit_cast(unsigned short, (__bf16)f); }
typedef __bf16 bf16x2_t __attribute__((ext_vector_type(2))); typedef float f32x2_t __attribute__((ext_vector_type(2)));
__device__ __forceinline__ unsigned pk2(float lo, float hi) { const f32x2_t v = {lo, hi}; return __builtin_bit_cast(unsigned, __builtin_convertvector(v, bf16x2_t)); }
__device__ __forceinline__ unsigned pk2h(float lo, float hi) { const f32x2_t v = {lo, hi}; return __builtin_bit_cast(unsigned, __builtin_convertvector(v, bf16x2_t)); }
__device__ __forceinline__ float bf2f(bf16_t b) { return __builtin_bit_cast(float, ((unsigned)b) << 16); }
typedef unsigned v4u __attribute__((ext_vector_type(4)));

__device__ __forceinline__ void transpose_item(const float* W, int K, int N, bf16_t* WT, int row_off, LAS float* scr, int item, int lane, int ldo = 0) {
  if (ldo == 0) ldo = K;
  const int nblk = N / 32, kb = item / nblk, nb = item % nblk, k0 = 64 * kb, n0 = 32 * nb;
  float wreg[32];
#pragma unroll
  for (int i = 0; i < 32; ++i) { const int kk = 2 * i + (lane >> 5); wreg[i] = W[(size_t)(k0 + kk) * N + n0 + (lane & 31)]; }
#pragma unroll
  for (int i = 0; i < 32; ++i) { const int kk = 2 * i + (lane >> 5); scr[kk * 33 + (lane & 31)] = wreg[i]; }
  asm volatile("s_waitcnt lgkmcnt(0)" ::: "memory");
  const int c = lane & 7;
#pragma unroll
  for (int j = 0; j < 4; ++j) { const int n = (lane >> 3) + 8 * j; const LAS float* s = scr + (8 * c) * 33 + n;
    v4u o; o.x = pk2(s[0 * 33], s[1 * 33]); o.y = pk2(s[2 * 33], s[3 * 33]); o.z = pk2(s[4 * 33], s[5 * 33]); o.w = pk2(s[6 * 33], s[7 * 33]);
    *(v4u*)(WT + (size_t)(row_off + n0 + n) * ldo + k0 + 8 * c) = o; }
  asm volatile("s_waitcnt lgkmcnt(0)" ::: "memory");
}

struct EpiProjF32 {
  static constexpr bool PERM = false, AFTER_DRAIN = false;
  float* C; int ldc; int ncols;
  __device__ __forceinline__ void operator()(const pg8::f32x4 (&acc)[2][2][4][2], const pg8::Unit& u, int wr, int wc, int fr, int fq) const {
    const int row0 = u.pm * 256 + wr * 64 + fr, col0 = u.pn * 256 + wc * 32 + 4 * fq;
#pragma unroll
    for (int ai = 0; ai < 2; ++ai)
#pragma unroll
      for (int m = 0; m < 4; ++m) { float* rowp = C + (size_t)(row0 + ai * 128 + m * 16) * ldc + col0;
#pragma unroll
        for (int bj = 0; bj < 2; ++bj)
#pragma unroll
          for (int n = 0; n < 2; ++n) if (col0 + bj * 128 + n * 16 < ncols) *(pg8::f32x4*)(rowp + bj * 128 + n * 16) = acc[ai][bj][m][n]; }
  }
};

__device__ __forceinline__ float fsigmoid(float x) { return __builtin_amdgcn_rcpf(1.f + __expf(-x)); }
template <bool ACCUM> struct EpiMerge {
  static constexpr bool PERM = true, AFTER_DRAIN = false;
  const float* gate; int ldg; bf16_t* M; int ldm;
  __device__ __forceinline__ void operator()(const pg8::f32x4 (&acc)[2][2][4][2], const pg8::Unit& u, int wr, int wc, int fr, int fq) const {
    const int row0 = u.pm * 256 + wr * 64 + fr, col0 = u.pn * 256 + wc * 32 + 8 * fq;
#pragma unroll
    for (int ai = 0; ai < 2; ++ai)
#pragma unroll
      for (int m = 0; m < 4; ++m) { const size_t r = (size_t)(row0 + ai * 128 + m * 16);
#pragma unroll
        for (int bj = 0; bj < 2; ++bj) { const int c = col0 + bj * 128;
          const pg8::f32x4 g0 = *(const pg8::f32x4*)(gate + r * ldg + c), g1 = *(const pg8::f32x4*)(gate + r * ldg + c + 4);
          pg8::f32x4 v0 = acc[ai][bj][m][0], v1 = acc[ai][bj][m][1];
#pragma unroll
          for (int e = 0; e < 4; ++e) { v0[e] *= fsigmoid(g0[e]); v1[e] *= fsigmoid(g1[e]); }
          v4u* dst = (v4u*)(M + r * ldm + c);
          if (ACCUM) { const v4u o = *dst; v0[0] += bf2f(o.x & 0xffff); v0[1] += bf2f(o.x >> 16); v0[2] += bf2f(o.y & 0xffff); v0[3] += bf2f(o.y >> 16);
            v1[0] += bf2f(o.z & 0xffff); v1[1] += bf2f(o.z >> 16); v1[2] += bf2f(o.w & 0xffff); v1[3] += bf2f(o.w >> 16); }
          v4u o2; o2.x = pk2(v0[0], v0[1]); o2.y = pk2(v0[2], v0[3]); o2.z = pk2(v1[0], v1[1]); o2.w = pk2(v1[2], v1[3]); *dst = o2; } }
  }
};
struct EpiOut {
  static constexpr bool PERM = false, AFTER_DRAIN = false;
  const float* resL; float* outL; const float* gL;
  const float* resC; float* outC; const float* gC;
  __device__ __forceinline__ void operator()(const pg8::f32x4 (&acc)[2][2][4][2], const pg8::Unit& u, int wr, int wc, int fr, int fq) const {
    const bool isc = u.pm == 16; if (isc && outC == nullptr) return;
    const float* res = isc ? resC : resL; float* out = isc ? outC : outL; const float* gv = isc ? gC : gL;
    const int row0 = (isc ? 0 : u.pm * 256) + wr * 64 + fr, col0 = u.pn * 256 + wc * 32 + 4 * fq;
    pg8::f32x4 gg[2][2];
#pragma unroll
    for (int bj = 0; bj < 2; ++bj)
#pragma unroll
      for (int n = 0; n < 2; ++n) gg[bj][n] = *(const pg8::f32x4*)(gv + col0 + bj * 128 + n * 16);
#pragma unroll
    for (int ai = 0; ai < 2; ++ai)
#pragma unroll
      for (int m = 0; m < 4; ++m) { const size_t ro = (size_t)(row0 + ai * 128 + m * 16) * 1024 + col0;
#pragma unroll
        for (int bj = 0; bj < 2; ++bj)
#pragma unroll
          for (int n = 0; n < 2; ++n) { const pg8::f32x4 rv = *(const pg8::f32x4*)(res + ro + bj * 128 + n * 16); *(pg8::f32x4*)(out + ro + bj * 128 + n * 16) = rv + gg[bj][n] * acc[ai][bj][m][n]; } }
  }
};
namespace att {
using bf16 = __hip_bfloat16;
constexpr int D = 128, NW = 8, QBLK = 32, KVBLK = 64; constexpr float SCALE = 0.088388347648318440f; constexpr float THR = 8.f; constexpr int SDEPTH = 2;
constexpr size_t SHM_V = KVBLK * D * 2, SHM_K = KVBLK * D * 2, SHM_ATTN = 2 * SHM_V + 2 * SHM_K + NW * 64 * 4;
using bf16x8 = __attribute__((ext_vector_type(8))) short;
using s16x4  = __attribute__((ext_vector_type(4))) short;
using f32x16 = __attribute__((ext_vector_type(16))) float;
using f32x8  = __attribute__((ext_vector_type(8))) float;
using u32x4  = __attribute__((ext_vector_type(4))) unsigned;
#define KSWZ(row, colB) ((row) * 256 + ((colB) ^ (((row) & 7) << 4)))
#define SBAR() __builtin_amdgcn_sched_barrier(0)
__device__ __forceinline__ int crow(int r, int hi) { return (r & 3) + 8 * (r >> 2) + 4 * hi; }
__device__ __forceinline__ unsigned cvtpk(float lo, float hi) {
  unsigned r; asm volatile("v_cvt_pk_bf16_f32 %0, %1, %2" : "=v"(r) : "v"(lo), "v"(hi)); return r;
}
template <typename TIn> struct Stage;
template <> struct Stage<bf16>  { using T = bf16x8;
  __device__ static __forceinline__ T ld8(const bf16* p) { return *reinterpret_cast<const bf16x8*>(p); }
  __device__ static __forceinline__ bf16x8 tobf(T x) { return x; } };
template <> struct Stage<float> { using T = f32x8;
  __device__ static __forceinline__ T ld8(const float* p) { return *reinterpret_cast<const f32x8*>(p); }
  __device__ static __forceinline__ bf16x8 tobf(T x) {
    u32x4 w = {cvtpk(x[0], x[1]), cvtpk(x[2], x[3]), cvtpk(x[4], x[5]), cvtpk(x[6], x[7])}; return *reinterpret_cast<bf16x8*>(&w); } };

__device__ __forceinline__ void partialSM(f32x16& p0, f32x16& p1, float& m_reg, float& mn, float& alpha) {
  constexpr float C = SCALE * 1.4426950408889634f;
  float pmax = p0[0]; for (int r = 1; r < 16; ++r) pmax = fmaxf(pmax, p0[r]); for (int r = 0; r < 16; ++r) pmax = fmaxf(pmax, p1[r]);
  { auto rr = __builtin_amdgcn_permlane32_swap(__float_as_uint(pmax), __float_as_uint(pmax), false, false);
    pmax = fmaxf(__uint_as_float(rr[0]), __uint_as_float(rr[1])); }
  if (__builtin_expect(__all(pmax - m_reg <= THR / SCALE), 1)) { mn = m_reg; alpha = 1.f; }
  else { mn = fmaxf(m_reg, pmax); alpha = __builtin_amdgcn_exp2f((m_reg - mn) * C); m_reg = mn; }
  float mnC = -mn * C;
  for (int r = 0; r < 16; ++r) p0[r] = fmaf(p0[r], C, mnC); for (int r = 0; r < 16; ++r) p1[r] = fmaf(p1[r], C, mnC);
  for (int r = 0; r < 16; ++r) p0[r] = __builtin_amdgcn_exp2f(p0[r]);
}
__device__ __forceinline__ void finishSM(f32x16& p0, f32x16& p1, float alpha, float& l_reg, bf16x8& pa0, bf16x8& pa1, bf16x8& pa2, bf16x8& pa3) {
  for (int r = 0; r < 16; ++r) p1[r] = __builtin_amdgcn_exp2f(p1[r]);
  float ps = 0; for (int r = 0; r < 16; ++r) ps += p0[r]; for (int r = 0; r < 16; ++r) ps += p1[r];
  { auto rr = __builtin_amdgcn_permlane32_swap(__float_as_uint(ps), __float_as_uint(ps), false, false);
    ps = __uint_as_float(rr[0]) + __uint_as_float(rr[1]); }
  l_reg = l_reg * alpha + ps;
#define PK4(P, BASE, OUT) do { unsigned a0 = cvtpk(P[BASE + 0], P[BASE + 1]), a1 = cvtpk(P[BASE + 2], P[BASE + 3]);   \
    unsigned b0 = cvtpk(P[BASE + 4], P[BASE + 5]), b1 = cvtpk(P[BASE + 6], P[BASE + 7]);                              \
    auto r0 = __builtin_amdgcn_permlane32_swap(a0, b0, false, false); auto r1 = __builtin_amdgcn_permlane32_swap(a1, b1, false, false); \
    u32x4 w = {r0[0], r1[0], r0[1], r1[1]}; OUT = *reinterpret_cast<bf16x8*>(&w); } while (0)
  PK4(p0, 0, pa0); PK4(p0, 8, pa1); PK4(p1, 0, pa2); PK4(p1, 8, pa3);
#undef PK4
}
__device__ __forceinline__ void qkt(f32x16& p0, f32x16& p1, const bf16* Ks, const bf16x8* qr, int r32, int hi) {
  p0 = f32x16{}; p1 = f32x16{};
  for (int d0 = 0; d0 < 8; ++d0) { int cb = (d0 * 16 + hi * 8) * 2;
    bf16x8 b0 = *reinterpret_cast<const bf16x8*>((const char*)Ks + KSWZ(r32, cb));
    bf16x8 b1 = *reinterpret_cast<const bf16x8*>((const char*)Ks + KSWZ(32 + r32, cb));
    p0 = __builtin_amdgcn_mfma_f32_32x32x16_bf16(b0, qr[d0], p0, 0, 0, 0);
    p1 = __builtin_amdgcn_mfma_f32_32x32x16_bf16(b1, qr[d0], p1, 0, 0, 0); }
}
__device__ __forceinline__ int v_st(int k, int c) { const int kk = (k & ~0xC) | ((k & 4) << 1) | ((k & 8) >> 1); return ((kk >> 3) * 4 + (c >> 5)) * 512 + ((kk & 7) * 32 + (c & 31)) * 2; }
__device__ __forceinline__ int v_rd_base(int lane) { return ((lane & 3) << 3) | (((lane >> 2) & 3) << 6) | (((lane >> 4) & 1) << 5) | (((lane >> 5) & 1) << 8); }
constexpr int v_rd_off(int d0, int ks, int half) { return d0 * 512 + ks * 4096 + half * 2048; }
template <int OFF> __device__ __forceinline__ s16x4 tr_read(int vb) {
  s16x4 r; asm volatile("ds_read_b64_tr_b16 %0, %1 offset:%2" : "=&v"(r) : "v"(vb), "i"(OFF) : "memory"); return r;
}
template <int D0> __device__ __forceinline__ void pv_one(f32x16& od, int vb, bf16x8 pa0, bf16x8 pa1, bf16x8 pa2, bf16x8 pa3) {
  const s16x4 l0 = tr_read<v_rd_off(D0, 0, 0)>(vb), h0 = tr_read<v_rd_off(D0, 0, 1)>(vb), l1 = tr_read<v_rd_off(D0, 1, 0)>(vb), h1 = tr_read<v_rd_off(D0, 1, 1)>(vb);
  const s16x4 l2 = tr_read<v_rd_off(D0, 2, 0)>(vb), h2 = tr_read<v_rd_off(D0, 2, 1)>(vb), l3 = tr_read<v_rd_off(D0, 3, 0)>(vb), h3 = tr_read<v_rd_off(D0, 3, 1)>(vb);
  asm volatile("s_waitcnt lgkmcnt(0)" ::: "memory"); SBAR();
#define PK(L, H) (bf16x8){L[0], L[1], L[2], L[3], H[0], H[1], H[2], H[3]}
  od = __builtin_amdgcn_mfma_f32_32x32x16_bf16(pa0, PK(l0, h0), od, 0, 0, 0);
  od = __builtin_amdgcn_mfma_f32_32x32x16_bf16(pa1, PK(l1, h1), od, 0, 0, 0);
  od = __builtin_amdgcn_mfma_f32_32x32x16_bf16(pa2, PK(l2, h2), od, 0, 0, 0);
  od = __builtin_amdgcn_mfma_f32_32x32x16_bf16(pa3, PK(l3, h3), od, 0, 0, 0);
#undef PK
}
__device__ __forceinline__ void pv_d0(f32x16* o, int vb, bf16x8 pa0, bf16x8 pa1, bf16x8 pa2, bf16x8 pa3) {
  pv_one<0>(o[0], vb, pa0, pa1, pa2, pa3); pv_one<1>(o[1], vb, pa0, pa1, pa2, pa3); pv_one<2>(o[2], vb, pa0, pa1, pa2, pa3); pv_one<3>(o[3], vb, pa0, pa1, pa2, pa3);
}

template <typename TQ, int LDQ, int LDK, int LDO, bool OBF16>
__device__ __forceinline__ void attn_dense_body(const TQ* Qb, const bf16* Kh, const bf16* Vh,
                                                void* Obv, int seq, char* lds) {
  using St = Stage<bf16>; using SQ = Stage<TQ>;
  int tid = threadIdx.x; asm volatile("" : "+v"(tid)); const int wid = tid >> 6, lane = tid & 63, r32 = lane & 31, hi = lane >> 5;
  bf16* V_lds = (bf16*)lds; bf16* K_lds = (bf16*)(lds + 2 * SHM_V);
  float* ws = (float*)(lds + 2 * SHM_V + 2 * SHM_K) + wid * 64; float* li_l = ws; float* al_l = ws + 32;
  float m_reg = -1e30f, l_reg = 0; f32x16 o[4] = {}; bf16x8 qr[8];
  const TQ* Qw = Qb + (long)(wid * QBLK + r32) * LDQ + hi * 8;
#pragma unroll
  for (int d0 = 0; d0 < 8; ++d0) qr[d0] = SQ::tobf(SQ::ld8(Qw + d0 * 16));
  const int sr = tid >> 4, sc = (tid & 15) * 8, vst0 = v_st(sr, sc), vst1 = v_st(32 + sr, sc);
  const int vb0 = (int)(uintptr_t)V_lds + v_rd_base(lane);
  struct { typename St::T vs0, vs1, ks0, ks1; } sr_[SDEPTH];
#define SLOAD(i, k0) do { sr_[i].vs0 = St::ld8(&Vh[(long)((k0) + sr) * LDK + sc]); sr_[i].vs1 = St::ld8(&Vh[(long)((k0) + 32 + sr) * LDK + sc]); \
    sr_[i].ks0 = St::ld8(&Kh[(long)((k0) + sr) * LDK + sc]); sr_[i].ks1 = St::ld8(&Kh[(long)((k0) + 32 + sr) * LDK + sc]); } while (0)
#define SWRITE(b, i) do { *(bf16x8*)((char*)V_lds + (b) * SHM_V + vst0) = St::tobf(sr_[i].vs0);          \
    *(bf16x8*)((char*)V_lds + (b) * SHM_V + vst1) = St::tobf(sr_[i].vs1); int kc = sc * 2;               \
    *(bf16x8*)((char*)K_lds + (b) * SHM_K + KSWZ(sr, kc)) = St::tobf(sr_[i].ks0);                       \
    *(bf16x8*)((char*)K_lds + (b) * SHM_K + KSWZ(32 + sr, kc)) = St::tobf(sr_[i].ks1); } while (0)
#define SWAIT() do { if constexpr (SDEPTH == 2) asm volatile("s_waitcnt vmcnt(4)" ::: "memory"); else asm volatile("s_waitcnt vmcnt(0)" ::: "memory"); } while (0)
#define RESC(a) do { if (__any((a) < 1.f)) { if (hi == 0) al_l[r32] = (a); asm volatile("s_waitcnt lgkmcnt(0)" ::: "memory"); \
    for (int d = 0; d < 4; ++d) for (int r = 0; r < 16; ++r) o[d][r] *= al_l[crow(r, hi)]; } } while (0)
  f32x16 pA0, pA1, pB0, pB1; float mnA, mnB, alA, alB; bf16x8 pa0, pa1, pa2, pa3; const int NT = seq / KVBLK;
  constexpr int SE = 0, SO = SDEPTH - 1;
  SLOAD(SE, 0); asm volatile("s_waitcnt vmcnt(0)" ::: "memory"); SWRITE(0, SE); __syncthreads();
  qkt(pA0, pA1, K_lds, qr, r32, hi); partialSM(pA0, pA1, m_reg, mnA, alA);
  SLOAD(SO, KVBLK); if constexpr (SDEPTH == 2) { if (2 < NT) SLOAD(SE, 2 * KVBLK); }
  SWAIT(); SWRITE(1, SO); __syncthreads();
  for (int j = 1; j + 1 < NT; j += 2) {
    SBAR(); qkt(pB0, pB1, (bf16*)((char*)K_lds + SHM_K), qr, r32, hi);
    finishSM(pA0, pA1, alA, l_reg, pa0, pa1, pa2, pa3); SBAR();
    SLOAD(SO, (j + SDEPTH) * KVBLK); SBAR();
    pv_d0(o, vb0, pa0, pa1, pa2, pa3); partialSM(pB0, pB1, m_reg, mnB, alB);
    __syncthreads(); SWAIT(); SWRITE(0, SE);
    RESC(alB); __syncthreads();
    SBAR(); qkt(pA0, pA1, K_lds, qr, r32, hi);
    finishSM(pB0, pB1, alB, l_reg, pa0, pa1, pa2, pa3); SBAR();
    if (SDEPTH == 1 || j + 3 < NT) SLOAD(SE, (j + 1 + SDEPTH) * KVBLK); SBAR();
    pv_d0(o, vb0 + (int)SHM_V, pa0, pa1, pa2, pa3); partialSM(pA0, pA1, m_reg, mnA, alA);
    __syncthreads(); SWAIT(); SWRITE(1, SO);
    RESC(alA); __syncthreads();
  }
  SBAR(); qkt(pB0, pB1, (bf16*)((char*)K_lds + SHM_K), qr, r32, hi);
  finishSM(pA0, pA1, alA, l_reg, pa0, pa1, pa2, pa3); SBAR();
  pv_d0(o, vb0, pa0, pa1, pa2, pa3); partialSM(pB0, pB1, m_reg, mnB, alB);
  __syncthreads(); RESC(alB);
  finishSM(pB0, pB1, alB, l_reg, pa0, pa1, pa2, pa3); SBAR();
  pv_d0(o, vb0 + (int)SHM_V, pa0, pa1, pa2, pa3);
  if (hi == 0) li_l[r32] = l_reg; asm volatile("s_waitcnt lgkmcnt(0)" ::: "memory");
  float rli[16];
#pragma unroll
  for (int r = 0; r < 16; ++r) rli[r] = __builtin_amdgcn_rcpf(li_l[crow(r, hi)]);
  if constexpr (!OBF16) { float* Ow = (float*)Obv + (long)(wid * QBLK) * LDO;
#pragma unroll
  for (int r = 0; r < 16; ++r) { int orow = crow(r, hi);
    for (int d0 = 0; d0 < 4; ++d0) Ow[(long)orow * LDO + d0 * 32 + r32] = o[d0][r] * rli[r]; }
  } else { unsigned short* Ow = (unsigned short*)Obv + (long)(wid * QBLK) * LDO;
#pragma unroll
  for (int r = 0; r < 16; ++r) { int orow = crow(r, hi);
    for (int d0 = 0; d0 < 4; ++d0) { const unsigned pk = cvtpk(o[d0][r] * rli[r], 0.f); Ow[(long)orow * LDO + d0 * 32 + r32] = (unsigned short)(pk & 0xffffu); } }
  }
#undef SLOAD
#undef SWRITE
#undef SWAIT
#undef RESC
}
#undef KSWZ
#undef SBAR
}
namespace gla {
typedef float f32x16 __attribute__((ext_vector_type(16)));
typedef float f32x4v __attribute__((ext_vector_type(4)));
constexpr int LD = 65;
constexpr int OX = 0, OY = 2 * 64 * LD * 4, OV = 4 * 64 * LD * 4, OAL = OV + 64 * 128 * 4, OW2 = OAL + 64 * 32 * 4, OBA = OW2 + 2 * 16 * 64 * 4, OTOT = OBA + 2 * 64 * 4, OEND = OTOT + 2 * 64 * 4 * 4;
static_assert(OEND <= 131072, "gla lds");
static_assert(64 * 129 * 4 <= 2 * 64 * LD * 4, "O stage fits in X");

struct In {
  const bf16_t* q; const bf16_t* k; const bf16_t* v; const bf16_t* ga; const bf16_t* og; int ld;
  const float* wa2; const float* ba; const float* gnorm;
  float* cs;
  bf16_t* csb;
  float* dec;
  bf16_t* y; int ldy;
  int S, C;
};
__device__ __forceinline__ long chunk_row(const In& p, int cid) { return cid < p.S / 64 ? (long)cid * 64 : (long)p.S + (long)(cid - p.S / 64) * 64; }
__device__ __forceinline__ float logsig(float x) { return x < 0.f ? x - __logf(1.f + __expf(x)) : -__logf(1.f + __expf(-x)); }

__device__ __forceinline__ void cum_phase(const In& p, LAS unsigned char* lds, int head, long row0, int tid) {
  LAS float* AL = (LAS float*)(lds + OAL); LAS float* W2 = (LAS float*)(lds + OW2); LAS float* BA = (LAS float*)(lds + OBA); LAS float* TOT = (LAS float*)(lds + OTOT);
  { const int t = tid >> 3, r4 = (tid & 7) * 4; const unsigned long long u = *(const unsigned long long*)(p.ga + (row0 + t) * p.ld + r4);
    f32x4v a4; a4[0] = bf2f((bf16_t)u); a4[1] = bf2f((bf16_t)(u >> 16)); a4[2] = bf2f((bf16_t)(u >> 32)); a4[3] = bf2f((bf16_t)(u >> 48)); *(LAS f32x4v*)(AL + t * 32 + r4) = a4; }
  { const int e = tid * 4, dir = e >> 10, r = (e >> 6) & 15, j = e & 63; *(LAS f32x4v*)(W2 + e) = *(const f32x4v*)(p.wa2 + ((long)dir * 16 + r) * 256 + head * 64 + j); }
  if (tid < 128) BA[tid] = p.ba[(tid >> 6) * 256 + head * 64 + (tid & 63)];
  __syncthreads();
  const int dir = tid >> 8, j = tid & 63, seg = (tid >> 6) & 3;
  float w[16];
#pragma unroll
  for (int r = 0; r < 16; ++r) w[r] = W2[(dir * 16 + r) * 64 + j];
  const float bj = BA[dir * 64 + j];
  float c[16];
#pragma unroll
  for (int k = 0; k < 16; ++k) { const int t = seg * 16 + k; float z = bj;
#pragma unroll
    for (int r4 = 0; r4 < 4; ++r4) { const f32x4v a4 = *(const LAS f32x4v*)(AL + t * 32 + dir * 16 + 4 * r4); z += a4[0] * w[4 * r4] + a4[1] * w[4 * r4 + 1] + a4[2] * w[4 * r4 + 2] + a4[3] * w[4 * r4 + 3]; }
    c[k] = logsig(z) * (1.f / 16.f); }
  if (dir == 0) {
#pragma unroll
    for (int k = 1; k < 16; ++k) c[k] += c[k - 1];
    TOT[(dir * 64 + j) * 4 + seg] = c[15];
  } else {
#pragma unroll
    for (int k = 14; k >= 0; --k) c[k] += c[k + 1];
    TOT[(dir * 64 + j) * 4 + seg] = c[0];
  }
  __syncthreads();
  float off = 0.f;
#pragma unroll
  for (int s = 0; s < 4; ++s) { const float tv = TOT[(dir * 64 + j) * 4 + s]; if (dir == 0 ? s < seg : s > seg) off += tv; }
  LAS float* X = (LAS float*)(lds + OX) + dir * 64 * LD;
#pragma unroll
  for (int k = 0; k < 16; ++k) X[(seg * 16 + k) * LD + j] = c[k] + off;
}
struct VRegs { unsigned long long u[4]; };
__device__ __forceinline__ VRegs load_v_regs(const In& p, int head, long row0, int tid) { VRegs r;
#pragma unroll
  for (int m = 0; m < 4; ++m) { const int t = (tid >> 5) + 16 * m, c4 = (tid & 31) * 4; r.u[m] = *(const unsigned long long*)(p.v + (row0 + t) * p.ld + head * 128 + c4); }
  return r; }
__device__ __forceinline__ void store_v(const VRegs& r, LAS unsigned char* lds, int tid) {
  LAS float* V = (LAS float*)(lds + OV);
#pragma unroll
  for (int m = 0; m < 4; ++m) { const int t = (tid >> 5) + 16 * m, c4 = (tid & 31) * 4; const unsigned long long u = r.u[m];
    f32x4v a4; a4[0] = bf2f((bf16_t)u); a4[1] = bf2f((bf16_t)(u >> 16)); a4[2] = bf2f((bf16_t)(u >> 32)); a4[3] = bf2f((bf16_t)(u >> 48)); *(LAS f32x4v*)(V + t * 128 + c4) = a4; }
}

__device__ __forceinline__ void g1_unit(const In& p, LAS unsigned char* lds, int head, int cid, int GH, int NCH) {
  int tid = threadIdx.x; asm volatile("" : "+v"(tid));
  const int lane = tid & 63, w = __builtin_amdgcn_readfirstlane(tid >> 6);
  const long row0 = chunk_row(p, cid);
  const VRegs vr = load_v_regs(p, head, row0, tid);
  bf16_t kreg[8];
#pragma unroll
  for (int m = 0; m < 8; ++m) kreg[m] = p.k[(row0 + (tid >> 6) + 8 * m) * p.ld + head * 64 + (tid & 63)];
  cum_phase(p, lds, head, row0, tid);
  store_v(vr, lds, tid);
  __syncthreads();
  LAS float* TOT = (LAS float*)(lds + OTOT);
  { const int j = tid & 63;
#pragma unroll
    for (int dir = 0; dir < 2; ++dir) { LAS float* X = (LAS float*)(lds + OX) + dir * 64 * LD;
      const float cl = TOT[(dir * 64 + j) * 4 + 0] + TOT[(dir * 64 + j) * 4 + 1] + TOT[(dir * 64 + j) * 4 + 2] + TOT[(dir * 64 + j) * 4 + 3];
#pragma unroll
      for (int m = 0; m < 8; ++m) { const int t = (tid >> 6) + 8 * m; const float kv = bf2f(kreg[m]); X[t * LD + j] = kv * __expf(cl - X[t * LD + j]); }
      if (tid < 64) p.dec[(((long)dir * GH + head) * NCH + cid) * 64 + j] = __expf(cl); }
  }
  __syncthreads();
  { const int dir = w >> 2, di = (w >> 1) & 1, vj0 = (w & 1) * 2; const LAS float* X = (const LAS float*)(lds + OX) + dir * 64 * LD; const LAS float* V = (const LAS float*)(lds + OV);
    f32x16 a0 = {}, a1 = {}; const int li = lane & 31, lk = lane >> 5;
#pragma unroll 4
    for (int s0 = 0; s0 < 64; s0 += 2) { const float av = X[(s0 + lk) * LD + 32 * di + li]; const float b0 = V[(s0 + lk) * 128 + 32 * vj0 + li], b1 = V[(s0 + lk) * 128 + 32 * vj0 + 32 + li];
      a0 = __builtin_amdgcn_mfma_f32_32x32x2f32(av, b0, a0, 0, 0, 0); a1 = __builtin_amdgcn_mfma_f32_32x32x2f32(av, b1, a1, 0, 0, 0); }
    float* dst = p.cs + ((((long)dir * GH + head) * NCH + cid) * 64) * 128;
#pragma unroll
    for (int r = 0; r < 16; ++r) { const int d = 32 * di + (r & 3) + 8 * (r >> 2) + 4 * lk; dst[(long)d * 128 + 32 * vj0 + li] = a0[r]; dst[(long)d * 128 + 32 * vj0 + 32 + li] = a1[r]; }
  }
  __syncthreads();
}
__device__ __forceinline__ void g2_item(const In& p, long idx, int GH, int NCH) {
  const int v = 2 * (int)(idx & 63), d = (int)((idx >> 6) & 63); const int hd = (int)((idx >> 12) % GH), dir = (int)((idx >> 12) / GH);
  const int nl = p.S / 64, nc = p.C / 64; float st0 = 0.f, st1 = 0.f;
  bf16_t* base = p.csb + (((long)dir * GH + hd) * NCH) * 64 * 128 + (long)d * 128 + v; const float* db = p.dec + (((long)dir * GH + hd) * NCH) * 64 + d;
  for (int s0 = 0; s0 < nl + nc; s0 += 17) { unsigned c[17]; float dc[17]; int ci[17];
#pragma unroll
    for (int k = 0; k < 17; ++k) { const int step = s0 + k; int cid = 0; const bool ok = step < nl + nc; if (step < nc) cid = nl + (dir ? nc - 1 - step : step); else if (ok) cid = dir ? nl - 1 - (step - nc) : step - nc;
      ci[k] = ok ? cid : -1; c[k] = *(const unsigned*)(base + (long)cid * 64 * 128); dc[k] = db[(long)cid * 64]; }
#pragma unroll
    for (int k = 0; k < 17; ++k) { if (ci[k] >= 0) { *(unsigned*)(base + (long)ci[k] * 64 * 128) = pk2(st0, st1); st0 = dc[k] * st0 + __uint_as_float(c[k] << 16); st1 = dc[k] * st1 + __uint_as_float(c[k] & 0xffff0000u); } } }
}
__device__ __forceinline__ void g3_unit(const In& p, LAS unsigned char* lds, int head, int cid, int GH, int NCH) {
  int tid = threadIdx.x; asm volatile("" : "+v"(tid));
  const int lane = tid & 63, w = __builtin_amdgcn_readfirstlane(tid >> 6), li = lane & 31, lk = lane >> 5;
  const long row0 = chunk_row(p, cid);
  float spf[2][32];
  { const int vj_ = w & 3;
#pragma unroll
    for (int dir = 0; dir < 2; ++dir) { const float* sp = p.cs + ((((long)dir * GH + head) * NCH + cid) * 64) * 128 + 32 * vj_ + li;
#pragma unroll
      for (int i = 0; i < 32; ++i) spf[dir][i] = sp[(long)(2 * i + lk) * 128]; } }
  const VRegs vr = load_v_regs(p, head, row0, tid);
  bf16_t kreg[8], qreg[8];
#pragma unroll
  for (int m = 0; m < 8; ++m) { const long o_ = (row0 + (tid >> 6) + 8 * m) * p.ld + head * 64 + (tid & 63); kreg[m] = p.k[o_]; qreg[m] = p.q[o_]; }
  cum_phase(p, lds, head, row0, tid);
  store_v(vr, lds, tid);
  __syncthreads();
  { const int j = tid & 63;
#pragma unroll
    for (int dir = 0; dir < 2; ++dir) { LAS float* X = (LAS float*)(lds + OX) + dir * 64 * LD; LAS float* Y = (LAS float*)(lds + OY) + dir * 64 * LD;
#pragma unroll
      for (int m = 0; m < 8; ++m) { const int t = (tid >> 6) + 8 * m; const float c = X[t * LD + j];
        const float qv = bf2f(qreg[m]) * 0.125f, kv = bf2f(kreg[m]);
        X[t * LD + j] = qv * __expf(c); Y[t * LD + j] = kv * __expf(-c); } }
  }
  __syncthreads();
  {
    const int dir = w >> 2, qi = (w >> 1) & 1, si = w & 1; const bool zero = dir == 0 ? si > qi : si < qi;
    const LAS float* X = (const LAS float*)(lds + OX) + dir * 64 * LD; LAS float* Y = (LAS float*)(lds + OY) + dir * 64 * LD;
    f32x16 pa = {};
    if (!zero) {
#pragma unroll 4
      for (int d0 = 0; d0 < 64; d0 += 2) pa = __builtin_amdgcn_mfma_f32_32x32x2f32(X[(32 * qi + li) * LD + d0 + lk], Y[(32 * si + li) * LD + d0 + lk], pa, 0, 0, 0);
    }
    __syncthreads();
#pragma unroll
    for (int r = 0; r < 16; ++r) { const int q = 32 * qi + (r & 3) + 8 * (r >> 2) + 4 * lk, s = 32 * si + li; const bool keep = dir == 0 ? s <= q : s >= q;
      Y[q * LD + s] = keep ? pa[r] : 0.f; }
  }
  __syncthreads();
  f32x16 acc = {};
  { const int qi = w >> 2, vj = w & 3; const LAS float* V = (const LAS float*)(lds + OV);
#pragma unroll
    for (int dir = 0; dir < 2; ++dir) { const LAS float* X = (const LAS float*)(lds + OX) + dir * 64 * LD; const LAS float* Y = (const LAS float*)(lds + OY) + dir * 64 * LD;
#pragma unroll 4
      for (int s0 = 0; s0 < 64; s0 += 2) acc = __builtin_amdgcn_mfma_f32_32x32x2f32(Y[(32 * qi + li) * LD + s0 + lk], V[(s0 + lk) * 128 + 32 * vj + li], acc, 0, 0, 0);
#pragma unroll
      for (int i = 0; i < 32; ++i) acc = __builtin_amdgcn_mfma_f32_32x32x2f32(X[(32 * qi + li) * LD + 2 * i + lk], spf[dir][i], acc, 0, 0, 0);
    }
    __syncthreads();
    LAS float* O = (LAS float*)(lds + OX);
#pragma unroll
    for (int r = 0; r < 16; ++r) { const int q = 32 * qi + (r & 3) + 8 * (r >> 2) + 4 * lk; O[q * 129 + 32 * vj + li] = acc[r]; }
  }
  __syncthreads();
  { const int row = tid >> 3, part = tid & 7; const LAS float* O = (const LAS float*)(lds + OX) + row * 129 + part * 16;
    float o[16]; float ss = 0.f;
#pragma unroll
    for (int k = 0; k < 16; ++k) { o[k] = O[k]; ss += o[k] * o[k]; }
    ss += __shfl_xor(ss, 1); ss += __shfl_xor(ss, 2); ss += __shfl_xor(ss, 4);
    const float rs = __builtin_amdgcn_rsqf(ss * (1.f / 128.f) + 1e-6f);
    const bf16_t* ogp = p.og + (row0 + row) * p.ld + head * 128 + part * 16; const v4u og0 = *(const v4u*)ogp, og1 = *(const v4u*)(ogp + 8);
    const unsigned ogw[8] = {og0.x, og0.y, og0.z, og0.w, og1.x, og1.y, og1.z, og1.w}; bf16_t* yp = p.y + (row0 + row) * p.ldy + head * 128 + part * 16; float yy[16];
#pragma unroll
    for (int k4 = 0; k4 < 4; ++k4) { f32x4v g4; g4[0] = bf2f((bf16_t)(ogw[2 * k4] & 0xffff)); g4[1] = bf2f((bf16_t)(ogw[2 * k4] >> 16)); g4[2] = bf2f((bf16_t)(ogw[2 * k4 + 1] & 0xffff)); g4[3] = bf2f((bf16_t)(ogw[2 * k4 + 1] >> 16)); const f32x4v n4 = *(const f32x4v*)(p.gnorm + part * 16 + 4 * k4); f32x4v y4;
#pragma unroll
      for (int e = 0; e < 4; ++e) { const float gg = g4[e]; y4[e] = o[4 * k4 + e] * rs * n4[e] * (gg / (1.f + __expf(-gg))); yy[4 * k4 + e] = y4[e]; } }
    { v4u o0, o1; o0.x = pk2(yy[0], yy[1]); o0.y = pk2(yy[2], yy[3]); o0.z = pk2(yy[4], yy[5]); o0.w = pk2(yy[6], yy[7]);
      o1.x = pk2(yy[8], yy[9]); o1.y = pk2(yy[10], yy[11]); o1.z = pk2(yy[12], yy[13]); o1.w = pk2(yy[14], yy[15]); *(v4u*)yp = o0; *(v4u*)(yp + 8) = o1; }
  }
  __syncthreads();
}

typedef short bf16x8g __attribute__((ext_vector_type(8)));
constexpr int LB = 72;
constexpr int OQB = 2 * 64 * LD * 4, OKB = OQB + 2 * 64 * LB * 2, OVT = OKB + 2 * 64 * LB * 2, OBEND = OVT + 128 * LB * 2;
static_assert(OBEND <= OAL, "gla bf16 lds");
#define GMM(A, B, C) C = __builtin_amdgcn_mfma_f32_32x32x16_bf16(__builtin_bit_cast(bf16x8g, A), __builtin_bit_cast(bf16x8g, B), C, 0, 0, 0)
__device__ __forceinline__ void store_vt(const VRegs& r, LAS unsigned char* lds, int tid) {
  LAS bf16_t* Vt = (LAS bf16_t*)(lds + OVT);
#pragma unroll
  for (int m = 0; m < 4; ++m) { const int t = (tid >> 5) + 16 * m, c4 = (tid & 31) * 4; const unsigned long long u = r.u[m];
    Vt[(c4 + 0) * LB + t] = (bf16_t)u; Vt[(c4 + 1) * LB + t] = (bf16_t)(u >> 16); Vt[(c4 + 2) * LB + t] = (bf16_t)(u >> 32); Vt[(c4 + 3) * LB + t] = (bf16_t)(u >> 48); }
}
__device__ __forceinline__ void g1b_unit(const In& p, LAS unsigned char* lds, int head, int cid, int GH, int NCH) {
  int tid = threadIdx.x; asm volatile("" : "+v"(tid));
  const int lane = tid & 63, w = __builtin_amdgcn_readfirstlane(tid >> 6), li = lane & 31, lk = lane >> 5;
  const long row0 = chunk_row(p, cid);
  const VRegs vr = load_v_regs(p, head, row0, tid);
  bf16_t kreg[8];
#pragma unroll
  for (int m = 0; m < 8; ++m) kreg[m] = p.k[(row0 + (tid >> 6) + 8 * m) * p.ld + head * 64 + (tid & 63)];
  cum_phase(p, lds, head, row0, tid);
  store_vt(vr, lds, tid);
  __syncthreads();
  LAS float* TOT = (LAS float*)(lds + OTOT);
  { const int j = tid & 63;
#pragma unroll
    for (int dir = 0; dir < 2; ++dir) { const LAS float* X = (const LAS float*)(lds + OX) + dir * 64 * LD; LAS bf16_t* KeT = (LAS bf16_t*)(lds + OQB) + dir * 64 * LB;
      const float cl = TOT[(dir * 64 + j) * 4 + 0] + TOT[(dir * 64 + j) * 4 + 1] + TOT[(dir * 64 + j) * 4 + 2] + TOT[(dir * 64 + j) * 4 + 3];
#pragma unroll
      for (int m = 0; m < 8; ++m) { const int t = (tid >> 6) + 8 * m; KeT[j * LB + t] = (bf16_t)f2bf(bf2f(kreg[m]) * __expf(cl - X[t * LD + j])); }
      if (tid < 64) p.dec[(((long)dir * GH + head) * NCH + cid) * 64 + j] = __expf(cl); }
  }
  __syncthreads();
  { const int dir = w >> 2, di = (w >> 1) & 1, vj0 = (w & 1) * 2; const LAS bf16_t* KeT = (const LAS bf16_t*)(lds + OQB) + dir * 64 * LB; const LAS bf16_t* Vt = (const LAS bf16_t*)(lds + OVT);
    f32x16 a0 = {}, a1 = {};
#pragma unroll
    for (int kk = 0; kk < 4; ++kk) { const v4u av = *(const LAS v4u*)(KeT + (32 * di + li) * LB + 16 * kk + 8 * lk);
      const v4u b0 = *(const LAS v4u*)(Vt + (32 * vj0 + li) * LB + 16 * kk + 8 * lk), b1 = *(const LAS v4u*)(Vt + (32 * vj0 + 32 + li) * LB + 16 * kk + 8 * lk);
      GMM(av, b0, a0); GMM(av, b1, a1); }
    bf16_t* dst = p.csb + ((((long)dir * GH + head) * NCH + cid) * 64) * 128;
#pragma unroll
    for (int r = 0; r < 16; ++r) { const int d = 32 * di + (r & 3) + 8 * (r >> 2) + 4 * lk; dst[(long)d * 128 + 32 * vj0 + li] = (bf16_t)f2bf(a0[r]); dst[(long)d * 128 + 32 * vj0 + 32 + li] = (bf16_t)f2bf(a1[r]); }
  }
  __syncthreads();
}
__device__ __forceinline__ void g3b_unit(const In& p, LAS unsigned char* lds, int head, int cid, int GH, int NCH) {
  int tid = threadIdx.x; asm volatile("" : "+v"(tid));
  const int lane = tid & 63, w = __builtin_amdgcn_readfirstlane(tid >> 6), li = lane & 31, lk = lane >> 5;
  const long row0 = chunk_row(p, cid);
  unsigned spf[2][32];
  { const int vj_ = w & 3;
#pragma unroll
    for (int dir = 0; dir < 2; ++dir) { const bf16_t* sp = p.csb + ((((long)dir * GH + head) * NCH + cid) * 64) * 128 + 32 * vj_ + li;
#pragma unroll
      for (int i = 0; i < 32; ++i) spf[dir][i] = sp[(long)(16 * (i >> 3) + 8 * lk + (i & 7)) * 128]; } }
  const VRegs vr = load_v_regs(p, head, row0, tid);
  bf16_t kreg[8], qreg[8];
#pragma unroll
  for (int m = 0; m < 8; ++m) { const long o_ = (row0 + (tid >> 6) + 8 * m) * p.ld + head * 64 + (tid & 63); kreg[m] = p.k[o_]; qreg[m] = p.q[o_]; }
  cum_phase(p, lds, head, row0, tid);
  store_vt(vr, lds, tid);
  __syncthreads();
  { const int j = tid & 63;
#pragma unroll
    for (int dir = 0; dir < 2; ++dir) { const LAS float* X = (const LAS float*)(lds + OX) + dir * 64 * LD; LAS bf16_t* Qb = (LAS bf16_t*)(lds + OQB) + dir * 64 * LB; LAS bf16_t* Kb = (LAS bf16_t*)(lds + OKB) + dir * 64 * LB;
#pragma unroll
      for (int m = 0; m < 8; ++m) { const int t = (tid >> 6) + 8 * m; const float c = X[t * LD + j];
        Qb[t * LB + j] = (bf16_t)f2bf(bf2f(qreg[m]) * 0.125f * __expf(c)); Kb[t * LB + j] = (bf16_t)f2bf(bf2f(kreg[m]) * __expf(-c)); } }
  }
  __syncthreads();
  {
    const int dir = w >> 2, qi = (w >> 1) & 1, si = w & 1; const bool zero = dir == 0 ? si > qi : si < qi;
    const LAS bf16_t* Qb = (const LAS bf16_t*)(lds + OQB) + dir * 64 * LB; LAS bf16_t* Kb = (LAS bf16_t*)(lds + OKB) + dir * 64 * LB;
    f32x16 pa = {};
    if (!zero) {
#pragma unroll
      for (int kk = 0; kk < 4; ++kk) { const v4u av = *(const LAS v4u*)(Qb + (32 * qi + li) * LB + 16 * kk + 8 * lk), bv = *(const LAS v4u*)(Kb + (32 * si + li) * LB + 16 * kk + 8 * lk); GMM(av, bv, pa); }
    }
    __syncthreads();
#pragma unroll
    for (int r = 0; r < 16; ++r) { const int q = 32 * qi + (r & 3) + 8 * (r >> 2) + 4 * lk, s = 32 * si + li; const bool keep = dir == 0 ? s <= q : s >= q;
      Kb[q * LB + s] = (bf16_t)f2bf(keep ? pa[r] : 0.f); }
  }
  __syncthreads();
  f32x16 acc = {};
  { const int qi = w >> 2, vj = w & 3; const LAS bf16_t* Vt = (const LAS bf16_t*)(lds + OVT);
#pragma unroll
    for (int dir = 0; dir < 2; ++dir) { const LAS bf16_t* Qb = (const LAS bf16_t*)(lds + OQB) + dir * 64 * LB; const LAS bf16_t* Pb = (const LAS bf16_t*)(lds + OKB) + dir * 64 * LB;
#pragma unroll
      for (int kk = 0; kk < 4; ++kk) { const v4u av = *(const LAS v4u*)(Pb + (32 * qi + li) * LB + 16 * kk + 8 * lk), bv = *(const LAS v4u*)(Vt + (32 * vj + li) * LB + 16 * kk + 8 * lk); GMM(av, bv, acc); }
#pragma unroll
      for (int kk = 0; kk < 4; ++kk) { const v4u av = *(const LAS v4u*)(Qb + (32 * qi + li) * LB + 16 * kk + 8 * lk);
        v4u bv; bv.x = spf[dir][8 * kk + 0] | (spf[dir][8 * kk + 1] << 16); bv.y = spf[dir][8 * kk + 2] | (spf[dir][8 * kk + 3] << 16); bv.z = spf[dir][8 * kk + 4] | (spf[dir][8 * kk + 5] << 16); bv.w = spf[dir][8 * kk + 6] | (spf[dir][8 * kk + 7] << 16);
        GMM(av, bv, acc); }
    }
    LAS float* O = (LAS float*)(lds + OX);
#pragma unroll
    for (int r = 0; r < 16; ++r) { const int q = 32 * qi + (r & 3) + 8 * (r >> 2) + 4 * lk; O[q * 129 + 32 * vj + li] = acc[r]; }
  }
  __syncthreads();
  { const int row = tid >> 3, part = tid & 7; const LAS float* O = (const LAS float*)(lds + OX) + row * 129 + part * 16;
    float o[16]; float ss = 0.f;
#pragma unroll
    for (int k = 0; k < 16; ++k) { o[k] = O[k]; ss += o[k] * o[k]; }
    ss += __shfl_xor(ss, 1); ss += __shfl_xor(ss, 2); ss += __shfl_xor(ss, 4);
    const float rs = __builtin_amdgcn_rsqf(ss * (1.f / 128.f) + 1e-6f);
    const bf16_t* ogp = p.og + (row0 + row) * p.ld + head * 128 + part * 16; const v4u og0 = *(const v4u*)ogp, og1 = *(const v4u*)(ogp + 8);
    const unsigned ogw[8] = {og0.x, og0.y, og0.z, og0.w, og1.x, og1.y, og1.z, og1.w}; bf16_t* yp = p.y + (row0 + row) * p.ldy + head * 128 + part * 16; float yy[16];
#pragma unroll
    for (int k4 = 0; k4 < 4; ++k4) { f32x4v g4; g4[0] = bf2f((bf16_t)(ogw[2 * k4] & 0xffff)); g4[1] = bf2f((bf16_t)(ogw[2 * k4] >> 16)); g4[2] = bf2f((bf16_t)(ogw[2 * k4 + 1] & 0xffff)); g4[3] = bf2f((bf16_t)(ogw[2 * k4 + 1] >> 16)); const f32x4v n4 = *(const f32x4v*)(p.gnorm + part * 16 + 4 * k4);
#pragma unroll
      for (int e = 0; e < 4; ++e) { const float gg = g4[e]; yy[4 * k4 + e] = o[4 * k4 + e] * rs * n4[e] * (gg * __builtin_amdgcn_rcpf(1.f + __expf(-gg))); } }
    { v4u o0, o1; o0.x = pk2(yy[0], yy[1]); o0.y = pk2(yy[2], yy[3]); o0.z = pk2(yy[4], yy[5]); o0.w = pk2(yy[6], yy[7]);
      o1.x = pk2(yy[8], yy[9]); o1.y = pk2(yy[10], yy[11]); o1.z = pk2(yy[12], yy[13]); o1.w = pk2(yy[14], yy[15]); *(v4u*)yp = o0; *(v4u*)(yp + 8) = o1; }
  }
  __syncthreads();
}
#undef GMM
}
namespace moe {
constexpr int NE = 16, NG = 4, EPG = 4, DE = 512, D = 1024;
__device__ __forceinline__ float wave_sum(float v) {
#pragma unroll
  for (int o = 1; o < 64; o <<= 1) v += __shfl_xor(v, o);
  return v;
}
struct Route { int e0, r0, e1, r1; };
struct MoeOrder {
  int G, c, NT; const LAS int* poff;
  __device__ __forceinline__ bool next(int i, pg8::Unit& u) const {
    const long L = (long)i * G + c; const int total = poff[NE] * NT; if (L >= total) return false;
    const int panel = (int)L / NT, j = (int)L % NT; int e = 0;
#pragma unroll
    for (int k = 1; k < NE; ++k) e += (panel >= poff[k]) ? 1 : 0;
    u.pm = panel; u.pn = e * NT + j; u.acol = 0; u.nt = 0; return true;
  }
  __device__ __forceinline__ void a_ready(const pg8::Unit&) const {}
  __device__ __forceinline__ void done(const pg8::Unit&) const {}
};
struct EpiGU {
  static constexpr bool PERM = true, AFTER_DRAIN = false, CHAIN = false;
  bf16_t* hid;
  __device__ __forceinline__ void operator()(const pg8::f32x4 (&acc)[2][2][4][2], const pg8::Unit& u, int wr, int wc, int fr, int fq) const {
    const int j = u.pn & 3; const int row0 = u.pm * 256 + wr * 64 + fr, col0 = j * 128 + wc * 32 + 8 * fq;
#pragma unroll
    for (int ai = 0; ai < 2; ++ai)
#pragma unroll
      for (int m = 0; m < 4; ++m) { const size_t r = (size_t)(row0 + ai * 128 + m * 16); float hv[8];
#pragma unroll
        for (int n = 0; n < 2; ++n)
#pragma unroll
          for (int e = 0; e < 4; ++e) { const float g = acc[ai][0][m][n][e], up = acc[ai][1][m][n][e]; hv[4 * n + e] = g * __builtin_amdgcn_rcpf(1.f + __expf(-g)) * up; }
        v4u o; o.x = pk2(hv[0], hv[1]); o.y = pk2(hv[2], hv[3]); o.z = pk2(hv[4], hv[5]); o.w = pk2(hv[6], hv[7]);
        *(v4u*)(hid + r * DE + col0) = o; }
  }
};
struct EpiDown {
  static constexpr bool PERM = true, AFTER_DRAIN = false, CHAIN = false;
  const int* srcrow; const float* wgt; bf16_t* contrib; size_t slot_stride;
  __device__ __forceinline__ void operator()(const pg8::f32x4 (&acc)[2][2][4][2], const pg8::Unit& u, int wr, int wc, int fr, int fq) const {
    const int pn = u.pn & 3; const int row0 = u.pm * 256 + wr * 64 + fr, col0 = pn * 256 + wc * 32 + 8 * fq;
    int srcs[2][4]; float ws_[2][4];
#pragma unroll
    for (int ai = 0; ai < 2; ++ai)
#pragma unroll
      for (int m = 0; m < 4; ++m) { const int r = row0 + ai * 128 + m * 16; srcs[ai][m] = srcrow[r]; ws_[ai][m] = wgt[r]; }
#pragma unroll
    for (int ai = 0; ai < 2; ++ai)
#pragma unroll
      for (int m = 0; m < 4; ++m) { const int src = srcs[ai][m]; if (src < 0) continue; const float w = ws_[ai][m];
        bf16_t* dst = contrib + (size_t)(src & 1) * slot_stride + (size_t)(src >> 1) * D + col0;
#pragma unroll
        for (int bj = 0; bj < 2; ++bj) { const pg8::f32x4 v0 = acc[ai][bj][m][0] * w, v1 = acc[ai][bj][m][1] * w;
          v4u o; o.x = pk2(v0[0], v0[1]); o.y = pk2(v0[2], v0[3]); o.z = pk2(v1[0], v1[1]); o.w = pk2(v1[2], v1[3]); *(v4u*)(dst + bj * 128) = o; } }
  }
};
__device__ __forceinline__ void route_row(const bf16_t* xr, const float* gnorm, const float* shift, const float* scale, bf16_t* hrow, const LAS float* rwT, const float* rbias,
                                          LAS int* cnt, Route* rt, float* wts, int lane) {
  typedef float f4 __attribute__((ext_vector_type(4)));
  f4 xv[4]; float ss = 0.f;
#pragma unroll
  for (int j = 0; j < 4; ++j) { const uint2 rw = *(const uint2*)(xr + 4 * lane + 256 * j); xv[j][0] = __uint_as_float(rw.x << 16); xv[j][1] = __uint_as_float(rw.x & 0xffff0000u); xv[j][2] = __uint_as_float(rw.y << 16); xv[j][3] = __uint_as_float(rw.y & 0xffff0000u); ss += xv[j][0] * xv[j][0] + xv[j][1] * xv[j][1] + xv[j][2] * xv[j][2] + xv[j][3] * xv[j][3]; }
  const float rs = __builtin_amdgcn_rsqf(wave_sum(ss) * (1.f / 1024.f) + 1e-6f);
  float lg[NE];
#pragma unroll
  for (int e = 0; e < NE; ++e) lg[e] = 0.f;
#pragma unroll
  for (int j = 0; j < 4; ++j) { const int c = 4 * lane + 256 * j; const f4 g4 = *(const f4*)(gnorm + c), sh = *(const f4*)(shift + c), sc = *(const f4*)(scale + c);
    f4 h;
#pragma unroll
    for (int i = 0; i < 4; ++i) h[i] = xv[j][i] * rs * g4[i] * (1.f + sc[i]) + sh[i];
    *(unsigned long long*)(hrow + c) = (unsigned long long)pk2(h[0], h[1]) | ((unsigned long long)pk2(h[2], h[3]) << 32);
#pragma unroll
    for (int e = 0; e < NE; ++e) { const f4 w4 = *(const LAS f4*)(rwT + e * 1024 + c); lg[e] += h[0] * w4[0] + h[1] * w4[1] + h[2] * w4[2] + h[3] * w4[3]; } }
  { float v8[8], v4[4], v2[2], v1;
#pragma unroll
    for (int i = 0; i < 8; ++i) { const bool up = lane & 1; const float keep = up ? lg[2 * i + 1] : lg[2 * i], send = up ? lg[2 * i] : lg[2 * i + 1]; v8[i] = keep + __shfl_xor(send, 1); }
#pragma unroll
    for (int i = 0; i < 4; ++i) { const bool up = lane & 2; const float keep = up ? v8[2 * i + 1] : v8[2 * i], send = up ? v8[2 * i] : v8[2 * i + 1]; v4[i] = keep + __shfl_xor(send, 2); }
#pragma unroll
    for (int i = 0; i < 2; ++i) { const bool up = lane & 4; const float keep = up ? v4[2 * i + 1] : v4[2 * i], send = up ? v4[2 * i] : v4[2 * i + 1]; v2[i] = keep + __shfl_xor(send, 4); }
    { const bool up = lane & 8; const float keep = up ? v2[1] : v2[0], send = up ? v2[0] : v2[1]; v1 = keep + __shfl_xor(send, 8); }
    v1 += __shfl_xor(v1, 16); v1 += __shfl_xor(v1, 32);
#pragma unroll
    for (int e = 0; e < NE; ++e) lg[e] = __shfl(v1, e); }
  float sc[NE], sel[NE];
#pragma unroll
  for (int e = 0; e < NE; ++e) { sc[e] = 1.f / (1.f + __expf(-lg[e])); sel[e] = sc[e] + rbias[e]; }
  int bestg = 0; float bestgs = -1e30f;
#pragma unroll
  for (int g = 0; g < NG; ++g) { float m1 = -1e30f, m2 = -1e30f;
#pragma unroll
    for (int i = 0; i < EPG; ++i) { const float v = sel[g * EPG + i]; if (v > m1) { m2 = m1; m1 = v; } else if (v > m2) m2 = v; }
    const float gsum = m1 + m2; if (gsum > bestgs) { bestgs = gsum; bestg = g; } }
  int i1 = -1, i2 = -1; float v1 = -1e30f, v2 = -1e30f, s1 = 0.f, s2 = 0.f;
#pragma unroll
  for (int e = 0; e < NE; ++e) { if (e / EPG == bestg) { const float v = sel[e];
      if (v > v1) { v2 = v1; i2 = i1; s2 = s1; v1 = v; i1 = e; s1 = sc[e]; } else if (v > v2) { v2 = v; i2 = e; s2 = sc[e]; } } }
  if (lane == 0) { const float inv = 1.f / (s1 + s2); Route r; r.e0 = i1; r.e1 = i2; r.r0 = __hip_atomic_fetch_add(cnt + i1, 1, __ATOMIC_RELAXED, __HIP_MEMORY_SCOPE_WORKGROUP); r.r1 = __hip_atomic_fetch_add(cnt + i2, 1, __ATOMIC_RELAXED, __HIP_MEMORY_SCOPE_WORKGROUP); *rt = r; wts[0] = s1 * inv; wts[1] = s2 * inv; }
}
__device__ __forceinline__ void route16(const bf16_t* x0, const LAS float* gp, const LAS float* sp, bf16_t* h0, const LAS v4u* wfrag, const float* rbias,
                                        LAS int* cnt, Route* rt0, float* wts0, int lane) {
  typedef float f4 __attribute__((ext_vector_type(4))); typedef short b8 __attribute__((ext_vector_type(8)));
  const int fr = lane & 15, fq = lane >> 4;
  const bf16_t* xr = x0 + (size_t)fr * 1024 + 8 * fq; bf16_t* hr = h0 + (size_t)fr * 1024 + 8 * fq;
  v4u xq[32];
#pragma unroll
  for (int kk = 0; kk < 32; ++kk) xq[kk] = *(const v4u*)(xr + 32 * kk);
  float ss = 0.f;
#pragma unroll
  for (int kk = 0; kk < 32; ++kk) { const v4u q = xq[kk]; float t;
    t = __uint_as_float(q.x << 16); ss += t * t; t = __uint_as_float(q.x & 0xffff0000u); ss += t * t; t = __uint_as_float(q.y << 16); ss += t * t; t = __uint_as_float(q.y & 0xffff0000u); ss += t * t;
    t = __uint_as_float(q.z << 16); ss += t * t; t = __uint_as_float(q.z & 0xffff0000u); ss += t * t; t = __uint_as_float(q.w << 16); ss += t * t; t = __uint_as_float(q.w & 0xffff0000u); ss += t * t; }
  ss += __shfl_xor(ss, 16); ss += __shfl_xor(ss, 32);
  const float rs = __builtin_amdgcn_rsqf(ss * (1.f / 1024.f) + 1e-6f);
#pragma unroll
  for (int kk = 0; kk < 32; ++kk) asm volatile("" : "+v"(xq[kk].x), "+v"(xq[kk].y), "+v"(xq[kk].z), "+v"(xq[kk].w));
  f4 acc = {0.f, 0.f, 0.f, 0.f};
#pragma unroll
  for (int kk = 0; kk < 32; ++kk) { const int c = 32 * kk + 8 * fq; const v4u q = xq[kk];
    const f4 ga = *(const LAS f4*)(gp + c), gb = *(const LAS f4*)(gp + c + 4), ha = *(const LAS f4*)(sp + c), hb = *(const LAS f4*)(sp + c + 4);
    const v4u wh = wfrag[kk * 64 + lane], wl = wfrag[2048 + kk * 64 + lane];
    float h[8];
    h[0] = __uint_as_float(q.x << 16) * (rs * ga[0]) + ha[0]; h[1] = __uint_as_float(q.x & 0xffff0000u) * (rs * ga[1]) + ha[1];
    h[2] = __uint_as_float(q.y << 16) * (rs * ga[2]) + ha[2]; h[3] = __uint_as_float(q.y & 0xffff0000u) * (rs * ga[3]) + ha[3];
    h[4] = __uint_as_float(q.z << 16) * (rs * gb[0]) + hb[0]; h[5] = __uint_as_float(q.z & 0xffff0000u) * (rs * gb[1]) + hb[1];
    h[6] = __uint_as_float(q.w << 16) * (rs * gb[2]) + hb[2]; h[7] = __uint_as_float(q.w & 0xffff0000u) * (rs * gb[3]) + hb[3];
    v4u hq; hq.x = pk2h(h[0], h[1]); hq.y = pk2h(h[2], h[3]); hq.z = pk2h(h[4], h[5]); hq.w = pk2h(h[6], h[7]);
    *(v4u*)(hr + 32 * kk) = hq;
    v4u lq; lq.x = pk2h(h[0] - __uint_as_float(hq.x << 16), h[1] - __uint_as_float(hq.x & 0xffff0000u)); lq.y = pk2h(h[2] - __uint_as_float(hq.y << 16), h[3] - __uint_as_float(hq.y & 0xffff0000u));
    lq.z = pk2h(h[4] - __uint_as_float(hq.z << 16), h[5] - __uint_as_float(hq.z & 0xffff0000u)); lq.w = pk2h(h[6] - __uint_as_float(hq.w << 16), h[7] - __uint_as_float(hq.w & 0xffff0000u));
    acc = __builtin_amdgcn_mfma_f32_16x16x32_bf16(__builtin_bit_cast(b8, wh), __builtin_bit_cast(b8, hq), acc, 0, 0, 0);
    acc = __builtin_amdgcn_mfma_f32_16x16x32_bf16(__builtin_bit_cast(b8, wl), __builtin_bit_cast(b8, hq), acc, 0, 0, 0);
    acc = __builtin_amdgcn_mfma_f32_16x16x32_bf16(__builtin_bit_cast(b8, wh), __builtin_bit_cast(b8, lq), acc, 0, 0, 0);
    if (kk & 1) asm volatile("" ::: "memory"); }
  float sc[4], sel[4]; const f4 rb4 = *(const f4*)(rbias + 4 * fq);
#pragma unroll
  for (int i = 0; i < 4; ++i) { sc[i] = 1.f / (1.f + __expf(-acc[i])); sel[i] = sc[i] + rb4[i]; }
  int i1 = -1, i2 = -1; float v1 = -1e30f, v2 = -1e30f, s1 = 0.f, s2 = 0.f;
#pragma unroll
  for (int i = 0; i < 4; ++i) { const float v = sel[i]; if (v > v1) { v2 = v1; i2 = i1; s2 = s1; v1 = v; i1 = i; s1 = sc[i]; } else if (v > v2) { v2 = v; i2 = i; s2 = sc[i]; } }
  float bgs = v1 + v2; int bg = fq;
  { float og = __shfl_xor(bgs, 16); int oi = __shfl_xor(bg, 16); if (og > bgs || (og == bgs && oi < bg)) { bgs = og; bg = oi; }
    og = __shfl_xor(bgs, 32); oi = __shfl_xor(bg, 32); if (og > bgs || (og == bgs && oi < bg)) { bgs = og; bg = oi; } }
  if (fq == bg) { const float inv = 1.f / (s1 + s2); Route r; r.e0 = 4 * fq + i1; r.e1 = 4 * fq + i2;
    r.r0 = __hip_atomic_fetch_add(cnt + r.e0, 1, __ATOMIC_RELAXED, __HIP_MEMORY_SCOPE_WORKGROUP); r.r1 = __hip_atomic_fetch_add(cnt + r.e1, 1, __ATOMIC_RELAXED, __HIP_MEMORY_SCOPE_WORKGROUP);
    rt0[fr] = r; wts0[2 * fr] = s1 * inv; wts0[2 * fr + 1] = s2 * inv; }
}
}
namespace hy {
typedef float f32x16 __attribute__((ext_vector_type(16)));
constexpr int S = 4096, NT1 = 128, LDZ = 191, ZPAD = 31, LDX = 129;
constexpr int O_TAPS = 0, O_ZA = 32768, O_ZB = O_ZA + 32 * LDZ * 4, O_X1 = O_ZB + 32 * LDZ * 4, O_X2 = O_X1 + 32 * LDX * 4, O_RED = O_X2 + 32 * LDX * 4, O_END = O_RED + 4 * 64 * 16 * 4;
static_assert(O_END <= 131072, "hyena lds");

struct H0Regs { v4u w0, w1; };
__device__ __forceinline__ H0Regs h0_load(const bf16_t* u, int ld, int tile, int tid) {
  const int tt = tile / 24, jt = tile % 24, t0 = tt * 64, j0 = jt * 64; H0Regs r; r.w0 = (v4u){0u, 0u, 0u, 0u}; r.w1 = r.w0;
  { const int rr = tid >> 3, c8 = (tid & 7) * 8, t = t0 - 1 + rr; if (t >= 0 && t < S) r.w0 = *(const v4u*)(u + (size_t)t * ld + j0 + c8); }
  if (tid < 16) { const int rr = 64 + (tid >> 3), c8 = (tid & 7) * 8, t = t0 - 1 + rr; if (t < S) r.w1 = *(const v4u*)(u + (size_t)t * ld + j0 + c8); }
  return r;
}
__device__ __forceinline__ void h0_compute(const H0Regs& rg, const float* cw, const float* cb, bf16_t* ucT, int tile, LAS unsigned char* lds, int tid) {
  const int tt = tile / 24, jt = tile % 24, t0 = tt * 64, j0 = jt * 64;
  LAS float* U = (LAS float*)lds;
  { const int rr = tid >> 3, c8 = (tid & 7) * 8; const v4u w = rg.w0; LAS float* d = U + rr * 65 + c8;
    d[0] = bf2f(w.x & 0xffff); d[1] = bf2f(w.x >> 16); d[2] = bf2f(w.y & 0xffff); d[3] = bf2f(w.y >> 16); d[4] = bf2f(w.z & 0xffff); d[5] = bf2f(w.z >> 16); d[6] = bf2f(w.w & 0xffff); d[7] = bf2f(w.w >> 16); }
  if (tid < 16) { const int rr = 64 + (tid >> 3), c8 = (tid & 7) * 8; const v4u w = rg.w1; LAS float* d = U + rr * 65 + c8;
    d[0] = bf2f(w.x & 0xffff); d[1] = bf2f(w.x >> 16); d[2] = bf2f(w.y & 0xffff); d[3] = bf2f(w.y >> 16); d[4] = bf2f(w.z & 0xffff); d[5] = bf2f(w.z >> 16); d[6] = bf2f(w.w & 0xffff); d[7] = bf2f(w.w >> 16); }
  __syncthreads();
  { const int jj = tid >> 3, tq = (tid & 7) * 8, j = j0 + jj; const float w0 = cw[j], w1 = cw[1536 + j], w2 = cw[2 * 1536 + j], bb = cb[j]; float v[8];
#pragma unroll
    for (int k = 0; k < 8; ++k) v[k] = bb + w0 * U[(tq + k) * 65 + jj] + w1 * U[(tq + k + 1) * 65 + jj] + w2 * U[(tq + k + 2) * 65 + jj];
    v4u o; o.x = pk2(v[0], v[1]); o.y = pk2(v[2], v[3]); o.z = pk2(v[4], v[5]); o.w = pk2(v[6], v[7]); *(v4u*)(ucT + (size_t)j * S + t0 + tq) = o; }
  __syncthreads();
}
__device__ __forceinline__ void h2_tile(const bf16_t* yT, bf16_t* ybf, int ldy, int tile, LAS unsigned char* lds) {
  int tid = threadIdx.x; asm volatile("" : "+v"(tid));
  const int tt = tile / 8, ct = tile % 8, t0 = tt * 64, c0 = ct * 64;
  LAS bf16_t* T = (LAS bf16_t*)lds;
  { const int cc = tid >> 3, t8 = (tid & 7) * 8; const v4u w = *(const v4u*)(yT + (size_t)(c0 + cc) * S + t0 + t8); LAS unsigned* d = (LAS unsigned*)(T + cc * 66 + t8); d[0] = w.x; d[1] = w.y; d[2] = w.z; d[3] = w.w; }
  __syncthreads();
  { const int t = tid >> 3, c8 = (tid & 7) * 8; unsigned short e[8];
#pragma unroll
    for (int k = 0; k < 8; ++k) e[k] = T[(c8 + k) * 66 + t];
    v4u o; o.x = e[0] | ((unsigned)e[1] << 16); o.y = e[2] | ((unsigned)e[3] << 16); o.z = e[4] | ((unsigned)e[5] << 16); o.w = e[6] | ((unsigned)e[7] << 16);
    *(v4u*)(ybf + (size_t)(t0 + t) * ldy + c0 + c8) = o; }
  __syncthreads();
}
__device__ __forceinline__ void h1_unit(const bf16_t* ucT, const float* tapsT, const float* nrm, const float* skip, bf16_t* yT, int c, LAS unsigned char* lds) {
  int tid = threadIdx.x; asm volatile("" : "+v"(tid));
  const int lane = tid & 63, w = __builtin_amdgcn_readfirstlane(tid >> 6), li = lane & 31, lk = lane >> 5;
  LAS float* TAPS = (LAS float*)(lds + O_TAPS); LAS float* ZA = (LAS float*)(lds + O_ZA); LAS float* ZB = (LAS float*)(lds + O_ZB);
  LAS float* X1 = (LAS float*)(lds + O_X1); LAS float* X2 = (LAS float*)(lds + O_X2); LAS float* RED = (LAS float*)(lds + O_RED);
  for (int e = tid; e < 32 * 62; e += 512) { const int s2 = e / 62, p = e % 62, t1p = p < 31 ? p : 128 + p; ZA[s2 * LDZ + t1p] = 0.f; ZB[s2 * LDZ + t1p] = 0.f; }
  for (int t = tid; t < S; t += 512) { const int t2 = t & 31, t1 = t >> 5;
    X1[t2 * LDX + t1] = bf2f(ucT[(size_t)c * S + t]); X2[t2 * LDX + t1] = bf2f(ucT[(size_t)(512 + c) * S + t]); ZA[t2 * LDZ + t1 + ZPAD] = bf2f(ucT[(size_t)(1024 + c) * S + t]); }
#pragma unroll 1
  for (int o = 0; o < 2; ++o) {
    const float* tp = tapsT + ((size_t)o * 512 + c) * 8192;
    for (int e = tid; e < 8192; e += 512) TAPS[e] = tp[(e + 4096) & 8191];
    __syncthreads();
    const LAS float* Zin = o == 0 ? ZA : ZB;
    const int g = w & 3, dh = w >> 2;
    const int Dlo = 32 * g - 127 + (dh ? 80 : 0), Dn = dh ? 79 : 80;
    f32x16 acc = {};
    { const LAS float* ap = TAPS + 4096 + 32 * Dlo + li - lk - 30;
      const LAS float* bp = Zin + lk * LDZ + (32 * g + li - Dlo + ZPAD);
#pragma unroll 2
      for (int dd = 0; dd < Dn; ++dd) {
#pragma unroll
        for (int kk = 0; kk < 16; ++kk) acc = __builtin_amdgcn_mfma_f32_32x32x2f32(ap[(15 - kk) * 2], bp[2 * kk * LDZ], acc, 0, 0, 0);
        ap += 32; bp -= 1; }
    }
    if (dh) {
#pragma unroll
      for (int r = 0; r < 16; ++r) RED[(g * 64 + lane) * 16 + r] = acc[r]; }
    __syncthreads();
    if (!dh) { const float inv = 1.f / nrm[o * 512 + c], sk = skip[o * 512 + c]; const LAS float* G = o == 0 ? X1 : X2; LAS float* Out = o == 0 ? ZB : ZA;
#pragma unroll
      for (int r = 0; r < 16; ++r) { const int t2 = (r & 3) + 8 * (r >> 2) + 4 * lk, t1 = 32 * g + li;
        const float cv = (acc[r] + RED[(g * 64 + lane) * 16 + r]) * inv; const float zin = Zin[t2 * LDZ + t1 + ZPAD];
        Out[t2 * LDZ + t1 + ZPAD] = G[t2 * LDX + t1] * (cv + sk * zin); } }
    __syncthreads();
  }
  for (int t = tid; t < S; t += 512) yT[(size_t)c * S + t] = (bf16_t)f2bf(ZA[(t & 31) * LDZ + (t >> 5) + ZPAD]);
  __syncthreads();
}

typedef short bf16x8v __attribute__((ext_vector_type(8)));
typedef unsigned u32x2v __attribute__((ext_vector_type(2)));
constexpr int CSB = 16448;
constexpr int ZROW = 80, ZROWS = 190;
constexpr int B_CS = 0, B_ZA = 4 * CSB, B_ZB = B_ZA + 15232, B_X1 = B_ZB + 15232, B_X2 = B_X1 + 8256, B_RED = B_X2 + 8256, B_END = B_RED + 16384;
static_assert(B_END <= 131072 && B_ZA % 16 == 0 && B_X1 % 16 == 0, "hyena bf16 lds");
__device__ __forceinline__ void h1b_unit(const bf16_t* ucT, const bf16_t* tapsB, const float* nrm, const float* skip, bf16_t* yT, int c, LAS unsigned char* lds) {
  int tid = threadIdx.x; asm volatile("" : "+v"(tid));
  const int lane = tid & 63, w = __builtin_amdgcn_readfirstlane(tid >> 6), li = lane & 31, lk = lane >> 5;
  LAS bf16_t* ZA = (LAS bf16_t*)(lds + B_ZA); LAS bf16_t* ZB = (LAS bf16_t*)(lds + B_ZB); LAS bf16_t* X1 = (LAS bf16_t*)(lds + B_X1); LAS bf16_t* X2 = (LAS bf16_t*)(lds + B_X2);
  LAS float* RED = (LAS float*)(lds + B_RED);
  for (int e = tid; e < 62 * 20; e += 512) { const int p = e / 20, d = e % 20, row = p < 31 ? p : 128 + p; ((LAS unsigned*)ZA)[row * 20 + d] = 0u; ((LAS unsigned*)ZB)[row * 20 + d] = 0u; }
  { const v4u zv = *(const v4u*)(ucT + (size_t)(1024 + c) * S + tid * 8); const int t = tid * 8; *(LAS v4u*)((LAS unsigned char*)ZA + ((t >> 5) + ZPAD) * ZROW + (t & 31) * 2) = zv; }
  { const v4u xa = *(const v4u*)(ucT + (size_t)c * S + tid * 8), xb = *(const v4u*)(ucT + (size_t)(512 + c) * S + tid * 8); const int t1 = tid >> 2, t2b = (tid & 3) * 8;
    const unsigned wa[4] = {xa.x, xa.y, xa.z, xa.w}, wb[4] = {xb.x, xb.y, xb.z, xb.w};
#pragma unroll
    for (int k = 0; k < 4; ++k) { X1[(t2b + 2 * k) * LDX + t1] = (bf16_t)(wa[k] & 0xffff); X1[(t2b + 2 * k + 1) * LDX + t1] = (bf16_t)(wa[k] >> 16);
      X2[(t2b + 2 * k) * LDX + t1] = (bf16_t)(wb[k] & 0xffff); X2[(t2b + 2 * k + 1) * LDX + t1] = (bf16_t)(wb[k] >> 16); } }
  typedef unsigned u4a __attribute__((ext_vector_type(4), aligned(4))); typedef const __attribute__((address_space(1))) u4a* gp4;
  v4u cv[9];
#pragma unroll 1
  for (int o = 0; o < 2; ++o) {
#define HTAPS_LOAD(oo) { const __attribute__((address_space(1))) unsigned char* tb = (const __attribute__((address_space(1))) unsigned char*)(tapsB + ((size_t)(oo) * 512 + c) * 2 * 8232); \
      _Pragma("unroll") for (int it = 0; it < 9; ++it) { const int e = tid + 512 * it; const int s = e / 1028, q = e % 1028; cv[it] = (v4u){0u, 0u, 0u, 0u}; if (e < 4 * 1028) cv[it] = *(gp4)(tb + (size_t)(s & 1) * 16464 + 16 * q + 4 * (s >> 1)); } }
    if (o == 0) HTAPS_LOAD(0)
    {
#pragma unroll
      for (int it = 0; it < 9; ++it) { const int e = tid + 512 * it; const int s = e / 1028, q = e % 1028; if (e < 4 * 1028) *(LAS v4u*)(lds + B_CS + s * CSB + 16 * q) = cv[it]; } }
    __syncthreads();
    if (o == 0) HTAPS_LOAD(1)
    const LAS bf16_t* Zin = o == 0 ? ZA : ZB;
    const int g = w & 3, dh = w >> 2;
    const int Dlo = 32 * g - 127 + (dh ? 81 : 0), Dn = dh ? 78 : 81;
    f32x16 acc = {};
    { const int s = (4 - (li & 3)) & 3;
      const LAS unsigned char* ap = lds + B_CS + s * CSB + 2 * (4096 - 32 * Dlo - li + 8 * lk - s);
      const LAS unsigned char* bp = (const LAS unsigned char*)Zin + (32 * g + li - Dlo + ZPAD) * ZROW + 16 * lk;
#define HLD(A0, A1, B0, B1) { const u32x2v p0_ = *(const LAS u32x2v*)(ap), p1_ = *(const LAS u32x2v*)(ap2), p2_ = *(const LAS u32x2v*)(ap3), p3_ = *(const LAS u32x2v*)(ap4); \
        A0 = (v4u){p0_.x, p0_.y, p1_.x, p1_.y}; A1 = (v4u){p2_.x, p2_.y, p3_.x, p3_.y}; B0 = *(const LAS v4u*)(bp); B1 = *(const LAS v4u*)(bp + 32); ap -= 64; ap2 -= 64; ap3 -= 64; ap4 -= 64; bp -= ZROW; }
#define HMM(A, B) acc = __builtin_amdgcn_mfma_f32_32x32x16_bf16(__builtin_bit_cast(bf16x8v, A), __builtin_bit_cast(bf16x8v, B), acc, 0, 0, 0)
#define HOPQ(name, off) unsigned name##i = (unsigned)(unsigned long long)(ap + (off)); asm volatile("" : "+v"(name##i)); const LAS unsigned char* name = (const LAS unsigned char*)(unsigned long long)name##i;
      HOPQ(ap2, 8) HOPQ(ap3, 32) HOPQ(ap4, 40)
#undef HOPQ
      v4u fa0, fa1, fb0, fb1, ga0, ga1, gb0, gb1, ha0, ha1, hb0, hb1;
      HLD(fa0, fa1, fb0, fb1)
      HLD(ga0, ga1, gb0, gb1)
      for (int dd_ = 0; dd_ < Dn - 3; dd_ += 3) {
        HLD(ha0, ha1, hb0, hb1)
        HMM(fa0, fb0); HMM(fa1, fb1);
        HLD(fa0, fa1, fb0, fb1)
        HMM(ga0, gb0); HMM(ga1, gb1);
        HLD(ga0, ga1, gb0, gb1)
        HMM(ha0, hb0); HMM(ha1, hb1);
      }
      HLD(ha0, ha1, hb0, hb1)
      HMM(fa0, fb0); HMM(fa1, fb1); HMM(ga0, gb0); HMM(ga1, gb1); HMM(ha0, hb0); HMM(ha1, hb1);
#undef HLD
#undef HMM
    }
    if (dh) {
#pragma unroll
      for (int r = 0; r < 16; ++r) RED[(g * 64 + lane) * 16 + r] = acc[r]; }
    __syncthreads();
    if (!dh) { const float inv = 1.f / nrm[o * 512 + c], sk = skip[o * 512 + c]; const LAS bf16_t* G = o == 0 ? X1 : X2; LAS bf16_t* Out = o == 0 ? ZB : ZA;
#pragma unroll
      for (int r = 0; r < 16; ++r) { const int t2 = (r & 3) + 8 * (r >> 2) + 4 * lk, t1 = 32 * g + li;
        const float cv = (acc[r] + RED[(g * 64 + lane) * 16 + r]) * inv; const float zin = bf2f(Zin[(t1 + ZPAD) * (ZROW / 2) + t2]);
        Out[(t1 + ZPAD) * (ZROW / 2) + t2] = (bf16_t)f2bf(bf2f(G[t2 * LDX + t1]) * (cv + sk * zin)); } }
    __syncthreads();
  }
  { const int t = tid * 8; *(v4u*)(yT + (size_t)c * S + t) = *(const LAS v4u*)((const LAS unsigned char*)ZA + ((t >> 5) + ZPAD) * ZROW + (t & 31) * 2); }
  __syncthreads();
}
#undef HTAPS_LOAD

constexpr int C_ZP = 15, C_ZB = 159 * ZROW  , C_CS = 0, C_Z0 = 4 * CSB, C_X0 = C_Z0 + 2 * C_ZB, C_END = C_X0 + 4 * 8256;
static_assert(C_END <= 131072 && C_Z0 % 16 == 0 && C_ZB % 16 == 0 && C_X0 % 16 == 0, "hyena two-batch lds");
__device__ __forceinline__ void h1c_unit(const bf16_t* ucT2, const bf16_t* tapsB, const float* nrm, const float* skip, bf16_t* yT2, int c, LAS unsigned char* lds) {
  int tid = threadIdx.x; asm volatile("" : "+v"(tid));
  const int lane = tid & 63, g = __builtin_amdgcn_readfirstlane(tid >> 6), li = lane & 31, lk = lane >> 5, bsel = li >> 4, t1l = li & 15;
  for (int e = tid; e < 2 * 31 * 20; e += 512) { const int b = e / (31 * 20), p = (e / 20) % 31, d = e % 20, row = p < 15 ? p : 128 + p; ((LAS unsigned*)(lds + C_Z0 + b * C_ZB))[row * 20 + d] = 0u; }
#pragma unroll
  for (int b = 0; b < 2; ++b) { const bf16_t* uc = ucT2 + (size_t)b * 1536 * S; const int t = tid * 8;
    const v4u zv = *(const v4u*)(uc + (size_t)(1024 + c) * S + t), xa = *(const v4u*)(uc + (size_t)c * S + t), xb = *(const v4u*)(uc + (size_t)(512 + c) * S + t);
    *(LAS v4u*)(lds + C_Z0 + b * C_ZB + ((t >> 5) + C_ZP) * ZROW + (t & 31) * 2) = zv;
    LAS bf16_t* X1 = (LAS bf16_t*)(lds + C_X0 + (2 * b) * 8256); LAS bf16_t* X2 = (LAS bf16_t*)(lds + C_X0 + (2 * b + 1) * 8256); const int t1 = tid >> 2, t2b = (tid & 3) * 8;
    const unsigned wa[4] = {xa.x, xa.y, xa.z, xa.w}, wb[4] = {xb.x, xb.y, xb.z, xb.w};
#pragma unroll
    for (int k = 0; k < 4; ++k) { X1[(t2b + 2 * k) * LDX + t1] = (bf16_t)(wa[k] & 0xffff); X1[(t2b + 2 * k + 1) * LDX + t1] = (bf16_t)(wa[k] >> 16);
      X2[(t2b + 2 * k) * LDX + t1] = (bf16_t)(wb[k] & 0xffff); X2[(t2b + 2 * k + 1) * LDX + t1] = (bf16_t)(wb[k] >> 16); } }
  typedef unsigned u4a __attribute__((ext_vector_type(4), aligned(4))); typedef const __attribute__((address_space(1))) u4a* gp4;
  v4u cv[9];
  LAS bf16_t* Zm = (LAS bf16_t*)(lds + C_Z0 + bsel * C_ZB);
#pragma unroll 1
  for (int o = 0; o < 2; ++o) {
#define HTAPS_LOAD(oo) { const __attribute__((address_space(1))) unsigned char* tb = (const __attribute__((address_space(1))) unsigned char*)(tapsB + ((size_t)(oo) * 512 + c) * 2 * 8232); \
      _Pragma("unroll") for (int it = 0; it < 9; ++it) { const int e = tid + 512 * it; const int s = e / 1028, q = e % 1028; cv[it] = (v4u){0u, 0u, 0u, 0u}; if (e < 4 * 1028) cv[it] = *(gp4)(tb + (size_t)(s & 1) * 16464 + 16 * q + 4 * (s >> 1)); } }
    if (o == 0) HTAPS_LOAD(0)
    {
#pragma unroll
      for (int it = 0; it < 9; ++it) { const int e = tid + 512 * it; const int s = e / 1028, q = e % 1028; if (e < 4 * 1028) *(LAS v4u*)(lds + C_CS + s * CSB + 16 * q) = cv[it]; } }
    __syncthreads();
    if (o == 0) HTAPS_LOAD(1)
    const int Dlo = 16 * g - 128; constexpr int Dn = 144;
    f32x16 acc = {};
    { const int s = (4 - (li & 3)) & 3;
      const LAS unsigned char* ap = lds + C_CS + s * CSB + 2 * (4096 - 32 * Dlo - li + 8 * lk - s);
      const LAS unsigned char* bp = (const LAS unsigned char*)Zm + (16 * g + t1l - Dlo + C_ZP) * ZROW + 16 * lk;
#define HLD(A0, A1, B0, B1) { const u32x2v p0_ = *(const LAS u32x2v*)(ap), p1_ = *(const LAS u32x2v*)(ap2), p2_ = *(const LAS u32x2v*)(ap3), p3_ = *(const LAS u32x2v*)(ap4); \
        A0 = (v4u){p0_.x, p0_.y, p1_.x, p1_.y}; A1 = (v4u){p2_.x, p2_.y, p3_.x, p3_.y}; B0 = *(const LAS v4u*)(bp); B1 = *(const LAS v4u*)(bp + 32); ap -= 64; ap2 -= 64; ap3 -= 64; ap4 -= 64; bp -= ZROW; }
#define HMM(A, B) acc = __builtin_amdgcn_mfma_f32_32x32x16_bf16(__builtin_bit_cast(bf16x8v, A), __builtin_bit_cast(bf16x8v, B), acc, 0, 0, 0)
#define HOPQ(name, off) unsigned name##i = (unsigned)(unsigned long long)(ap + (off)); asm volatile("" : "+v"(name##i)); const LAS unsigned char* name = (const LAS unsigned char*)(unsigned long long)name##i;
      HOPQ(ap2, 8) HOPQ(ap3, 32) HOPQ(ap4, 40)
#undef HOPQ
      v4u fa0, fa1, fb0, fb1, ga0, ga1, gb0, gb1, ha0, ha1, hb0, hb1;
      HLD(fa0, fa1, fb0, fb1)
      HLD(ga0, ga1, gb0, gb1)
      for (int dd_ = 0; dd_ < Dn - 3; dd_ += 3) {
        HLD(ha0, ha1, hb0, hb1)
        HMM(fa0, fb0); HMM(fa1, fb1);
        HLD(fa0, fa1, fb0, fb1)
        HMM(ga0, gb0); HMM(ga1, gb1);
        HLD(ga0, ga1, gb0, gb1)
        HMM(ha0, hb0); HMM(ha1, hb1);
      }
      HLD(ha0, ha1, hb0, hb1)
      HMM(fa0, fb0); HMM(fa1, fb1); HMM(ga0, gb0); HMM(ga1, gb1); HMM(ha0, hb0); HMM(ha1, hb1);
#undef HLD
#undef HMM
    }
    __syncthreads();
    { const float inv = 1.f / nrm[o * 512 + c], sk = skip[o * 512 + c]; const LAS bf16_t* G = (const LAS bf16_t*)(lds + C_X0 + (2 * bsel + o) * 8256);
#pragma unroll
      for (int r = 0; r < 16; ++r) { const int t2 = (r & 3) + 8 * (r >> 2) + 4 * lk, t1 = 16 * g + t1l;
        const float cvv = acc[r] * inv; const float zin = bf2f(Zm[(t1 + C_ZP) * (ZROW / 2) + t2]);
        Zm[(t1 + C_ZP) * (ZROW / 2) + t2] = (bf16_t)f2bf(bf2f(G[t2 * LDX + t1]) * (cvv + sk * zin)); } }
    __syncthreads();
  }
#pragma unroll
  for (int b = 0; b < 2; ++b) { const int t = tid * 8; *(v4u*)(yT2 + (size_t)b * 512 * S + (size_t)c * S + t) = *(const LAS v4u*)(lds + C_Z0 + b * C_ZB + ((t >> 5) + C_ZP) * ZROW + (t & 31) * 2); }
  __syncthreads();
#undef HTAPS_LOAD
}
__device__ __forceinline__ void cconv3_item(const bf16_t* u, int ld, const float* cw, const float* cb, float* ucc, long idx) {
  const int j = (int)(idx % 1536); const int tc = (int)(idx / 1536);
  const bf16_t* up = u + (size_t)tc * ld + j;
  float v = cb[j] + cw[1536 + j] * bf2f(up[0]);
  if (tc > 0) v += cw[j] * bf2f(*(up - ld)); if (tc < 255) v += cw[2 * 1536 + j] * bf2f(up[ld]);
  ucc[idx] = v;
}
__device__ __forceinline__ void clong_item(const float* ucc, const float* z1c_in, float* z1c_out, bf16_t* yout, int ldy, const float* tapsC, const float* nrmC, const float* skip, int o, long idx) {
  const int c = (int)(idx % 512), t0 = (int)(idx / 512) * 4; constexpr int n = 256;
  const float* tp = tapsC + (size_t)o * 2 * n * 512 + c; const float nr = nrmC[o * 512 + c];
  const float* zs = o == 0 ? ucc + 1024 + c : z1c_in + c; const int ldz = o == 0 ? 1536 : 512;
  float acc[4], w[4];
#pragma unroll
  for (int i = 0; i < 4; ++i) { acc[i] = 0.f; const int lag = t0 + i; w[i] = tp[(size_t)lag * 512]; }
  for (int s0 = 0; s0 < n; s0 += 32) { float zv[32], nw[32];
#pragma unroll
    for (int k = 0; k < 32; ++k) { const int s = s0 + k; zv[k] = zs[(size_t)s * ldz]; const int lag = t0 - s - 1; nw[k] = tp[(size_t)(lag >= 0 ? lag : 2 * n + lag) * 512]; }
#pragma unroll
    for (int k = 0; k < 32; ++k) {
#pragma unroll
      for (int i = 0; i < 4; ++i) acc[i] += w[i] * zv[k];
#pragma unroll
      for (int i = 3; i > 0; --i) w[i] = w[i - 1];
      w[0] = nw[k]; } }
  const float sk = skip[o * 512 + c];
#pragma unroll
  for (int i = 0; i < 4; ++i) { const int t = t0 + i; const float val = ucc[(size_t)t * 1536 + o * 512 + c] * (acc[i] / nr + sk * zs[(size_t)t * ldz]);
    if (o == 0) z1c_out[(size_t)t * 512 + c] = val; else yout[(size_t)t * ldy + c] = (bf16_t)f2bf(val); }
}
}
#define XB_TMO      128
#define XB_XCNT(j)  (256  + 64 * (j))
#define XB_XSUB(j)  (1280 + 64 * (j))
#define XB_XGEN(j)  (2304 + 64 * (j))
#define XB_TOP      3328
#define XB_TOPGEN   3392
#define XCD_BAR_WORDS 3456
#define XB_SPIN_CAP (1u << 18)

__device__ __forceinline__ unsigned xb_ld(unsigned* p)              { return __hip_atomic_load(p, __ATOMIC_RELAXED, __HIP_MEMORY_SCOPE_AGENT); }
__device__ __forceinline__ unsigned xb_add(unsigned* p, unsigned v) { return __hip_atomic_fetch_add(p, v, __ATOMIC_RELAXED, __HIP_MEMORY_SCOPE_AGENT); }
__device__ __forceinline__ unsigned xb_xcc_id() { return (unsigned)__builtin_amdgcn_s_getreg((3 << 11) | 20) & 0xFu; }
#define XB_SPIN(cond, bar) do { unsigned _sp = 0; while (cond) { __builtin_amdgcn_s_sleep(1); \
    if ((++_sp & 255u) == 0u) { if (xb_ld(&(bar)[XB_TMO])) break; if (_sp > XB_SPIN_CAP) { atomicAdd(&(bar)[XB_TMO], 1u); break; } } } } while (0)

struct XcdBarrier {
    unsigned* bar; unsigned x;
    volatile LAS unsigned* st;
};

__device__ __forceinline__ XcdBarrier xcd_barrier_post(unsigned* bar, volatile LAS unsigned* st) {
    XcdBarrier b; b.bar = bar; b.x = xb_xcc_id(); b.st = st;
    if (threadIdx.x == 0) (void)xb_add(&bar[XB_XCNT(b.x)], 1u);
    return b;
}
__device__ __forceinline__ void xcd_barrier_complete(unsigned* bar, unsigned x, unsigned& nloc, unsigned& nx) {
    const unsigned G = gridDim.x * gridDim.y * gridDim.z;
    unsigned sum, cnt, mine, sp = 0u;
    for (;;) {
        sum = 0u; cnt = 0u; mine = 0u;
#pragma unroll
        for (unsigned j = 0; j < 16; ++j) { const unsigned c = xb_ld(&bar[XB_XCNT(j)]); sum += c; cnt += (c > 0u) ? 1u : 0u; mine = (j == x) ? c : mine; }
        if (sum == G) break;
        __builtin_amdgcn_s_sleep(1);
        if ((++sp & 255u) == 0u) { if (xb_ld(&bar[XB_TMO])) break; if (sp > XB_SPIN_CAP) { atomicAdd(&bar[XB_TMO], 1u); break; } }
    }
    nloc = mine > 0u ? mine : 1u; nx = cnt > 0u ? cnt : 1u;
}

__device__ __forceinline__ void xcd_barrier(const XcdBarrier& b) {
    asm volatile("s_waitcnt vmcnt(0)" ::: "memory");
    __syncthreads();
    if (threadIdx.x == 0) {
        unsigned* bar = b.bar;
#define XB_SP(word) ((unsigned*)((((unsigned long long)(unsigned)__builtin_amdgcn_readfirstlane((int)((unsigned long long)(bar + (word)) >> 32))) << 32) | (unsigned)__builtin_amdgcn_readfirstlane((int)(unsigned)(unsigned long long)(bar + (word)))))
        unsigned* const p_xsub = XB_SP(XB_XSUB(b.x)); unsigned* const p_xgen = XB_SP(XB_XGEN(b.x));
        __builtin_amdgcn_s_waitcnt(0);
        unsigned nloc = b.st[0], nx = b.st[1];
        if (nloc == 0u) { xcd_barrier_complete(bar, b.x, nloc, nx); b.st[0] = nloc; b.st[1] = nx; }
        const unsigned old = xb_add(p_xsub, 1u);
        const unsigned gen = old / nloc;
        if (old + 1u == (gen + 1u) * nloc) {
            __builtin_amdgcn_fence(__ATOMIC_RELEASE, "agent");
            asm volatile("s_waitcnt vmcnt(0)" ::: "memory");
            const unsigned og = xb_add(&bar[XB_TOP], 1u);
            const unsigned tg = og / nx;
            if (og + 1u == (tg + 1u) * nx) xb_add(&bar[XB_TOPGEN], 1u);
            else XB_SPIN(xb_ld(&bar[XB_TOPGEN]) == tg, bar);
            __builtin_amdgcn_fence(__ATOMIC_ACQUIRE, "agent");
            xb_add(p_xgen, 1u);
            asm volatile("s_waitcnt vmcnt(0)" ::: "memory");
        } else {
            XB_SPIN(xb_ld(p_xgen) == gen, bar);
            __builtin_amdgcn_fence(__ATOMIC_ACQUIRE, "agent");
            asm volatile("s_waitcnt vmcnt(0)" ::: "memory");
        }
    }
    __syncthreads();
}
#include <math.h>
#ifdef HOST_TEST
#define HD
#define FEXP expf
#define FSIN sinf
#define FCOS cosf
#define FLOG logf
#define FPOW powf
#else
#define HD __device__ __forceinline__
#define FEXP __expf
#define FSIN __sinf
#define FCOS __cosf
#define FLOG __logf
#define FPOW __powf
#endif

struct FullDims { static constexpr int D=1024,B=8,S=4096,DEPTH=2,C=256,GW=64,AH=8,AKV=2,HDM=128,GH=4,GDK=64,GDV=128,GR=16,HW=512,HB=16,HF=64,NE=16,NG=4,DE=512; };
struct SmallDims { static constexpr int D=64,B=2,S=128,DEPTH=2,C=32,GW=16,AH=4,AKV=2,HDM=16,GH=2,GDK=8,GDV=16,GR=4,HW=32,HB=4,HF=8,NE=8,NG=2,DE=32; };

template <class T> struct DD {
  static constexpr int D=T::D,B=T::B,S=T::S,DEPTH=T::DEPTH,C=T::C,GW=T::GW,AH=T::AH,AKV=T::AKV,HDM=T::HDM,GH=T::GH,GDK=T::GDK,GDV=T::GDV,GR=T::GR,HW=T::HW,HB=T::HB,HF=T::HF,NE=T::NE,NG=T::NG,DE=T::DE;
  static constexpr int R=S+C, AG=AH/AKV, RP=HDM/4, HE=1+2*HB, EPG=NE/NG, AQW=AH*HDM, AKVW=AKV*HDM, GKW=GH*GDK, GVW=GH*GDV;
  static constexpr int NKV=AKVW+AKVW+GKW+GVW+2*GR, NIN=NKV+AQW+GKW+GVW+3*HW+3*D;
  static constexpr int O_AK=0, O_AV=AKVW, O_GK=2*AKVW, O_GV=2*AKVW+GKW, O_GA=2*AKVW+GKW+GVW;
  static constexpr int O_AQ=NKV, O_GQ=NKV+AQW, O_OG=O_GQ+GKW, O_HY=O_OG+GVW, O_BR=O_HY+3*HW;
};

struct NaiveBufs {
  const float *x,*c,*ctx,*c_ctx,*w_mod,*b_mod,*norm1_g,*norm2_g,*w_in,*q_norm_g,*k_norm_g,*gla_wa2,*gla_ba,*gla_norm_g,*hy_conv_w,*hy_conv_b,
    *hy_pos_w1,*hy_pos_b1,*hy_sin_freq,*hy_pos_w2,*hy_pos_b2,*hy_pos_w3,*hy_decay,*hy_skip,*w_br_hy,*w_br_gla,*w_br_att,*w_out,*router_w,*router_b,*moe_w_gate,*moe_w_up,*moe_w_down;
  float* out;
  float *mod;
  float *hid2S,*hid2C;
  float *tapsS,*tapsC;
  float *nrmS,*nrmC;
  float *rs;
  float *h;
  float *proj;
  float *qn,*kn;
  float *yatt;
  float *laf,*lab;
  float *of,*ob;
  float *ygla;
  float *uc;
  float *z1,*yhy;
  float *m;
  int   *ridx;
  float *rw;
  float *hid;
  float *xc;
};

HD float sigmoidf_(float x) { return 1.f / (1.f + FEXP(-x)); }
HD float siluf_(float x) { return x / (1.f + FEXP(-x)); }
HD float logsigmoidf_(float x) { return x < 0.f ? x - FLOG(1.f + FEXP(x)) : -FLOG(1.f + FEXP(-x)); }

template <class T> HD void st_mod(const NaiveBufs& a, int l, long idx) {
  using d = DD<T>; const int j = (int)(idx % (6 * d::D)), bb = (int)(idx / (6 * d::D));
  const float* cv = bb < d::B ? a.c + (long)bb * d::D : a.c_ctx; const float* w = a.w_mod + (long)l * d::D * 6 * d::D;
  float acc = a.b_mod[(long)l * 6 * d::D + j];
  for (int k = 0; k < d::D; ++k) acc += siluf_(cv[k]) * w[(long)k * 6 * d::D + j];
  a.mod[idx] = acc;
}
template <class T> HD void st_hyhid(const NaiveBufs& a, int l, int which, long idx) {
  using d = DD<T>; const int n = which ? d::C : d::S; float* dst = which ? a.hid2C : a.hid2S;
  const int j = (int)(idx % d::HF), t = (int)(idx / d::HF);
  const float* w1 = a.hy_pos_w1 + (long)l * d::HE * d::HF; const float* b1 = a.hy_pos_b1 + l * d::HF; const float* fr = a.hy_sin_freq + l * d::HF;
  const float* w2 = a.hy_pos_w2 + (long)l * d::HF * d::HF; const float* b2 = a.hy_pos_b2 + l * d::HF;
  const float tn = (float)t / (float)n; const float w0 = 2.f * 3.14159265358979323846f / (float)n;
  float acc2 = b2[j];
  for (int i = 0; i < d::HF; ++i) {
    float acc = b1[i] + tn * w1[0 * d::HF + i];
    for (int bnd = 0; bnd < d::HB; ++bnd) {
      const float band = 1e-4f + (float)bnd * ((float)(d::HB - 1) - 1e-4f) / (float)(d::HB - 1);
      const float ph = w0 * (float)t * band;
      acc += FCOS(ph) * w1[(1 + bnd) * d::HF + i] - FSIN(ph) * w1[(1 + d::HB + bnd) * d::HF + i];
    }
    acc2 += FSIN(fr[i] * acc) * w2[i * d::HF + j];
  }
  dst[idx] = FSIN(fr[j] * acc2);
}
template <class T> HD void st_hytaps(const NaiveBufs& a, int l, int which, long idx) {
  using d = DD<T>; const int n = which ? d::C : d::S; const float* hid2 = which ? a.hid2C : a.hid2S; float* dst = which ? a.tapsC : a.tapsS;
  const int c = (int)(idx % d::HW); const int li = (int)((idx / d::HW) % (2 * n)); const int o = (int)(idx / ((long)d::HW * 2 * n));
  float v = 0.f;
  if (li != n) {
    const int dir = li < n ? 0 : 1; const int t = li < n ? li : 2 * n - li;
    const int col = (o * 2 + dir) * d::HW + c;
    const float* w3 = a.hy_pos_w3 + (long)l * d::HF * 4 * d::HW;
    float acc = 0.f;
    for (int j = 0; j < d::HF; ++j) acc += hid2[(long)t * d::HF + j] * w3[(long)j * 4 * d::HW + col];
    const float dec = fabsf(a.hy_decay[(long)l * 4 * d::HW + col]);
    v = acc * FEXP(-((float)t / (float)n) * dec);
  }
  if (which == 0) dst[((long)o * d::HW + c) * 2 * n + li] = v; else dst[idx] = v;
}
template <class T> HD void st_hynorm(const NaiveBufs& a, int which, long idx) {
  using d = DD<T>; const int n = which ? d::C : d::S; const float* tp = which ? a.tapsC : a.tapsS; float* dst = which ? a.nrmC : a.nrmS;
  const int c = (int)(idx % d::HW), o = (int)(idx / d::HW);
  float s = 0.f; for (int li = 0; li < 2 * n; ++li) s += fabsf(which == 0 ? tp[((long)o * d::HW + c) * 2 * n + li] : tp[((long)o * 2 * n + li) * d::HW + c]);
  dst[idx] = s + 1e-6f;
}

template <class T> HD const float* xrow(const NaiveBufs& a, int l, int b, int r) {
  using d = DD<T>;
  if (r < d::S) return (l == 0 ? a.x : a.out) + ((long)b * d::S + r) * d::D;
  return (l == 0 ? a.ctx : a.xc) + ((long)b * d::C + (r - d::S)) * d::D;
}
template <class T> HD float* xrow_w(const NaiveBufs& a, int b, int r) {
  using d = DD<T>;
  if (r < d::S) return a.out + ((long)b * d::S + r) * d::D;
  return a.xc + ((long)b * d::C + (r - d::S)) * d::D;
}
template <class T> HD void st_rs(const NaiveBufs& a, int l, int b, int src, long idx) {
  using d = DD<T>; const int r = (int)idx; const float* xr = src ? (const float*)xrow_w<T>(a, b, r) : xrow<T>(a, l, b, r);
  float s = 0.f; for (int k = 0; k < d::D; ++k) s += xr[k] * xr[k];
  a.rs[r] = 1.f / sqrtf(s / (float)d::D + 1e-6f);
}
template <class T> HD void st_norm(const NaiveBufs& a, int l, int b, int which, long idx) {
  using d = DD<T>; const int j = (int)(idx % d::D), r = (int)(idx / d::D);
  const float* xr = which ? (const float*)xrow_w<T>(a, b, r) : xrow<T>(a, l, b, r);
  const float* g = (which ? a.norm2_g : a.norm1_g) + (long)l * d::D;
  const float* md = a.mod + (long)(r < d::S ? b : d::B) * 6 * d::D;
  const float shift = md[(which ? 3 : 0) * d::D + j], scale = md[(which ? 4 : 1) * d::D + j];
  a.h[idx] = xr[j] * a.rs[r] * g[j] * (1.f + scale) + shift;
}
struct GemmArgs { const float* A; int lda; const float* W; int ldw; float* Cc; int ldc; int M, N, K;
  const float* gate; int ldg;
  const float* colscale;
  const float* res; int ldr;
  int accumulate; };
HD void st_gemm(const GemmArgs& g, long idx) {
  const int nb = g.N / 4; const int cb = (int)(idx % nb), rb = (int)(idx / nb);
  float acc[4][4];
#pragma unroll
  for (int i = 0; i < 4; ++i) {
#pragma unroll
    for (int j = 0; j < 4; ++j) acc[i][j] = 0.f; }
  const float* a0 = g.A + (long)(rb * 4) * g.lda; const float* w0 = g.W + cb * 4;
  for (int k = 0; k < g.K; ++k) {
    float av[4], wv[4];
#pragma unroll
    for (int i = 0; i < 4; ++i) av[i] = a0[(long)i * g.lda + k];
#pragma unroll
    for (int j = 0; j < 4; ++j) wv[j] = w0[(long)k * g.ldw + j];
#pragma unroll
    for (int i = 0; i < 4; ++i) {
#pragma unroll
      for (int j = 0; j < 4; ++j) acc[i][j] += av[i] * wv[j]; }
  }
#pragma unroll
  for (int i = 0; i < 4; ++i)
#pragma unroll
  for (int j = 0; j < 4; ++j) {
    const int r = rb * 4 + i, c = cb * 4 + j; float v = acc[i][j];
    if (g.gate) v *= sigmoidf_(g.gate[(long)r * g.ldg + c]);
    if (g.colscale) v *= g.colscale[c];
    if (g.res) v += g.res[(long)r * g.ldr + c];
    float* p = g.Cc + (long)r * g.ldc + c;
    if (g.accumulate) v += *p;
    *p = v;
  }
}
template <class T> HD void st_qknorm(const NaiveBufs& a, int l, long idx) {
  using d = DD<T>; const int hh = (int)(idx % (d::AH + d::AKV)), r = (int)(idx / (d::AH + d::AKV));
  const bool isq = hh < d::AH; const int hd = isq ? hh : hh - d::AH;
  const float* src = a.proj + (long)r * d::NIN + (isq ? d::O_AQ : d::O_AK) + hd * d::HDM;
  float* dst = (isq ? a.qn + (long)r * d::AQW : a.kn + (long)r * d::AKVW) + hd * d::HDM;
  const float* g = (isq ? a.q_norm_g : a.k_norm_g) + (long)l * d::HDM;
  float s = 0.f; for (int k = 0; k < d::HDM; ++k) s += src[k] * src[k];
  const float rsq = 1.f / sqrtf(s / (float)d::HDM + 1e-6f);
  if (r < d::S) {
    const int row = r / d::GW, col = r % d::GW;
    for (int p = 0; p < d::HDM / 2; ++p) {
      const int fi = p < d::RP ? p : p - d::RP; const float pos = p < d::RP ? (float)row : (float)col;
      const float inv = FPOW(10000.f, -(float)fi / (float)d::RP); const float ang = pos * inv;
      const float cs = FCOS(ang), sn = FSIN(ang);
      const float x1 = src[2 * p] * rsq * g[2 * p], x2 = src[2 * p + 1] * rsq * g[2 * p + 1];
      dst[2 * p] = x1 * cs - x2 * sn; dst[2 * p + 1] = x1 * sn + x2 * cs;
    }
  } else { for (int k = 0; k < d::HDM; ++k) dst[k] = src[k] * rsq * g[k]; }
}
template <class T, int NSPLIT> HD void st_attn(const NaiveBufs& a, int r0, int nrows, long idx) {
  using d = DD<T>; constexpr int OD = d::HDM / NSPLIT;
  const int r = r0 + (int)(idx % nrows); const int hs = (int)(idx / nrows); const int part = hs % NSPLIT, hq = hs / NSPLIT; const int kv = hq / d::AG;
  const int k0 = r < d::S ? 0 : d::S, k1 = d::R;
  float q[d::HDM], o[OD];
  const float scale = 1.f / sqrtf((float)d::HDM);
#pragma unroll
  for (int k = 0; k < d::HDM; ++k) q[k] = a.qn[(long)r * d::AQW + hq * d::HDM + k] * scale;
#pragma unroll
  for (int k = 0; k < OD; ++k) o[k] = 0.f;
  float mx = -1e30f, lsum = 0.f;
  for (int kk = k0; kk < k1; ++kk) {
    const float* kr = a.kn + (long)kk * d::AKVW + kv * d::HDM;
    float s = 0.f;
#pragma unroll
    for (int k = 0; k < d::HDM; ++k) s += q[k] * kr[k];
    if (s > mx) { const float cr = FEXP(mx - s); lsum *= cr;
#pragma unroll
      for (int k = 0; k < OD; ++k) o[k] *= cr;
      mx = s; }
    const float p = FEXP(s - mx); lsum += p;
    const float* vr = a.proj + (long)kk * d::NIN + d::O_AV + kv * d::HDM + part * OD;
#pragma unroll
    for (int k = 0; k < OD; ++k) o[k] += p * vr[k];
  }
  const float inv = 1.f / lsum;
#pragma unroll
  for (int k = 0; k < OD; ++k) a.yatt[(long)r * d::AQW + hq * d::HDM + part * OD + k] = o[k] * inv;
}
template <class T> HD void st_glala(const NaiveBufs& a, int l, long idx) {
  using d = DD<T>; const int j = (int)(idx % d::GKW); const int dir = (int)((idx / d::GKW) % 2); const int r = (int)(idx / (2 * d::GKW));
  const float* al = a.proj + (long)r * d::NIN + d::O_GA + dir * d::GR;
  const float* w2 = a.gla_wa2 + ((long)l * 2 + dir) * d::GR * d::GKW; float z = a.gla_ba[((long)l * 2 + dir) * d::GKW + j];
  for (int k = 0; k < d::GR; ++k) z += al[k] * w2[(long)k * d::GKW + j];
  (dir ? a.lab : a.laf)[(long)r * d::GKW + j] = FEXP(logsigmoidf_(z) / 16.f);
}
template <class T> HD void st_glascan(const NaiveBufs& a, long idx) {
  using d = DD<T>; const int v = (int)(idx % d::GDV); const int hd = (int)((idx / d::GDV) % d::GH); const int dir = (int)(idx / (d::GDV * d::GH));
  float st[d::GDK];
#pragma unroll
  for (int k = 0; k < d::GDK; ++k) st[k] = 0.f;
  const float qs = 1.f / sqrtf((float)d::GDK);
  const float* la = dir ? a.lab : a.laf; float* od = dir ? a.ob : a.of;
  for (int step = 0; step < d::R; ++step) {
    int r;
    if (step < d::C) r = d::S + (dir ? d::C - 1 - step : step); else r = dir ? d::S - 1 - (step - d::C) : step - d::C;
    const float* pr = a.proj + (long)r * d::NIN;
    const float vv = pr[d::O_GV + hd * d::GDV + v];
    float o = 0.f;
#pragma unroll
    for (int k = 0; k < d::GDK; ++k) {
      st[k] = la[(long)r * d::GKW + hd * d::GDK + k] * st[k] + pr[d::O_GK + hd * d::GDK + k] * vv;
      o += pr[d::O_GQ + hd * d::GDK + k] * qs * st[k];
    }
    od[(long)r * d::GVW + hd * d::GDV + v] = o;
  }
}
template <class T> HD void st_glaout(const NaiveBufs& a, int l, long idx) {
  using d = DD<T>; const int hd = (int)(idx % d::GH), r = (int)(idx / d::GH);
  const long base = (long)r * d::GVW + hd * d::GDV; float s = 0.f;
  for (int v = 0; v < d::GDV; ++v) { const float o = a.of[base + v] + a.ob[base + v]; s += o * o; }
  const float rsq = 1.f / sqrtf(s / (float)d::GDV + 1e-6f);
  for (int v = 0; v < d::GDV; ++v) { const float o = a.of[base + v] + a.ob[base + v];
    a.ygla[base + v] = o * rsq * a.gla_norm_g[(long)l * d::GDV + v] * siluf_(a.proj[(long)r * d::NIN + d::O_OG + hd * d::GDV + v]); }
}
template <class T> HD void st_hyconv3(const NaiveBufs& a, int l, long idx) {
  using d = DD<T>; const int j = (int)(idx % (3 * d::HW)), r = (int)(idx / (3 * d::HW));
  const int lo = r < d::S ? 0 : d::S, hi = r < d::S ? d::S : d::R;
  const float* w = a.hy_conv_w + (long)l * 3 * 3 * d::HW;
  float v = a.hy_conv_b[(long)l * 3 * d::HW + j] + a.proj[(long)r * d::NIN + d::O_HY + j] * w[1 * 3 * d::HW + j];
  if (r - 1 >= lo) v += a.proj[(long)(r - 1) * d::NIN + d::O_HY + j] * w[0 * 3 * d::HW + j];
  if (r + 1 < hi) v += a.proj[(long)(r + 1) * d::NIN + d::O_HY + j] * w[2 * 3 * d::HW + j];
  a.uc[idx] = v;
}
template <class T> HD void st_hylong(const NaiveBufs& a, int l, int o, long idx) {
  using d = DD<T>; const int c = (int)(idx % d::HW); const int rb = (int)(idx / d::HW); const int r0 = rb * 4;
  const bool lat = r0 < d::S; const int n = lat ? d::S : d::C; const int base = lat ? 0 : d::S; const int t0 = r0 - base;
  const float* tp = (lat ? a.tapsS : a.tapsC) + (long)o * 2 * n * d::HW + c; const float nr = (lat ? a.nrmS : a.nrmC)[o * d::HW + c];
  const float* zs = o == 0 ? a.uc + 2 * d::HW + c : a.z1 + c; const int ldz = o == 0 ? 3 * d::HW : d::HW;
  float acc0 = 0.f, acc1 = 0.f, acc2 = 0.f, acc3 = 0.f;
  auto tap = [&](int lag) { const int li = lag >= 0 ? lag : 2 * n + lag; return tp[(long)li * d::HW]; };
  float w0 = tap(t0), w1 = tap(t0 + 1), w2 = tap(t0 + 2), w3 = tap(t0 + 3);
  for (int s = 0; s < n; ++s) {
    const float zv = zs[(long)(base + s) * ldz];
    acc0 += w0 * zv; acc1 += w1 * zv; acc2 += w2 * zv; acc3 += w3 * zv;
    w3 = w2; w2 = w1; w1 = w0; w0 = (s + 1 < n) ? tap(t0 - s - 1) : 0.f;
  }
  const float sk = a.hy_skip[((long)l * 2 + o) * d::HW + c];
  float* dst = o == 0 ? a.z1 : a.yhy;
  const float accs[4] = {acc0, acc1, acc2, acc3};
#pragma unroll
  for (int i = 0; i < 4; ++i) { const int r = r0 + i; const float zr = zs[(long)r * ldz];
    dst[(long)r * d::HW + c] = a.uc[(long)r * 3 * d::HW + o * d::HW + c] * (accs[i] / nr + sk * zr); }
}
template <class T> HD void st_router(const NaiveBufs& a, long idx) {
  using d = DD<T>; const int r = (int)idx; const float* hr = a.h + (long)r * d::D;
  float sc[d::NE], sel[d::NE];
#pragma unroll
  for (int e = 0; e < d::NE; ++e) sc[e] = 0.f;
  for (int k = 0; k < d::D; ++k) { const float hv = hr[k];
#pragma unroll
    for (int e = 0; e < d::NE; ++e) sc[e] += hv * a.router_w[(long)k * d::NE + e]; }
#pragma unroll
  for (int e = 0; e < d::NE; ++e) { sc[e] = sigmoidf_(sc[e]); sel[e] = sc[e] + a.router_b[e]; }
  int bestg = 0; float bestgs = -1e30f;
#pragma unroll
  for (int g = 0; g < d::NG; ++g) { float m1 = -1e30f, m2 = -1e30f;
#pragma unroll
    for (int i = 0; i < d::EPG; ++i) { const float v = sel[g * d::EPG + i]; if (v > m1) { m2 = m1; m1 = v; } else if (v > m2) m2 = v; }
    const float gs = m1 + m2; if (gs > bestgs) { bestgs = gs; bestg = g; } }
  int i1 = -1, i2 = -1; float v1 = -1e30f, v2 = -1e30f, s1 = 0.f, s2 = 0.f;
#pragma unroll
  for (int e = 0; e < d::NE; ++e) { if (e / d::EPG == bestg) { const float v = sel[e];
      if (v > v1) { v2 = v1; i2 = i1; s2 = s1; v1 = v; i1 = e; s1 = sc[e]; } else if (v > v2) { v2 = v; i2 = e; s2 = sc[e]; } } }
  const float inv = 1.f / (s1 + s2);
  a.ridx[2 * r] = i1; a.ridx[2 * r + 1] = i2; a.rw[2 * r] = s1 * inv; a.rw[2 * r + 1] = s2 * inv;
}
template <class T> HD void st_moehid(const NaiveBufs& a, int l, long idx) {
  using d = DD<T>; const int j = (int)(idx % d::DE); const int k = (int)((idx / d::DE) % 2); const int r = (int)(idx / (2 * d::DE));
  const int e = a.ridx[2 * r + k]; const float* hr = a.h + (long)r * d::D;
  const float* wg = a.moe_w_gate + (((long)l * d::NE + e) * d::D) * d::DE + j; const float* wu = a.moe_w_up + (((long)l * d::NE + e) * d::D) * d::DE + j;
  float g = 0.f, u = 0.f;
  for (int i = 0; i < d::D; ++i) { const float hv = hr[i]; g += hv * wg[(long)i * d::DE]; u += hv * wu[(long)i * d::DE]; }
  a.hid[idx] = siluf_(g) * u;
}
template <class T> HD void st_moeout(const NaiveBufs& a, int l, int b, long idx) {
  using d = DD<T>; const int dd = (int)(idx % d::D), r = (int)(idx / d::D);
  float acc = 0.f;
  for (int k = 0; k < 2; ++k) { const int e = a.ridx[2 * r + k]; const float* hk = a.hid + ((long)r * 2 + k) * d::DE;
    const float* wd = a.moe_w_down + (((long)l * d::NE + e) * d::DE) * d::D + dd; float s = 0.f;
    for (int j = 0; j < d::DE; ++j) s += hk[j] * wd[(long)j * d::D];
    acc += a.rw[2 * r + k] * s; }
  const float g2 = a.mod[(long)(r < d::S ? b : d::B) * 6 * d::D + 5 * d::D + dd];
  float* xr = xrow_w<T>(a, b, r); xr[dd] += g2 * acc;
}
enum { L_MOD = 0, L_HID_S, L_HID_C, L_TAPS_S, L_TAPS_C, L_NRM_S, L_NRM_C, N_LSTAGES,
       P_RS1 = 16, P_NORM1, P_INPROJ, P_QKNORM, P_ATTN_L, P_ATTN_C, P_GLALA, P_GLASCAN, P_GLAOUT, P_HYC3, P_HYL0, P_HYL1,
       P_MRG_HY, P_MRG_GLA, P_MRG_ATT, P_OUT_L, P_OUT_C, P_RS2, P_NORM2, P_ROUTER, P_MOEHID, P_MOEOUT, P_END };
constexpr int ATT_NSPLIT = 4;

template <class T> HD long stage_items(int st, int l) {
  using d = DD<T>; const bool last = (l == d::DEPTH - 1);
  switch (st) {
    case L_MOD: return (long)(d::B + 1) * 6 * d::D;
    case L_HID_S: return (long)d::S * d::HF;
    case L_HID_C: return (long)d::C * d::HF;
    case L_TAPS_S: return 2L * 2 * d::S * d::HW;
    case L_TAPS_C: return 2L * 2 * d::C * d::HW;
    case L_NRM_S: case L_NRM_C: return 2L * d::HW;
    case P_RS1: case P_RS2: case P_ROUTER: return d::R;
    case P_NORM1: case P_NORM2: return (long)d::R * d::D;
    case P_INPROJ: return (long)(d::R / 4) * (d::NIN / 4);
    case P_QKNORM: return (long)d::R * (d::AH + d::AKV);
    case P_ATTN_L: return (long)d::S * d::AH * ATT_NSPLIT;
    case P_ATTN_C: return last ? 0 : (long)d::C * d::AH * ATT_NSPLIT;
    case P_GLALA: return (long)d::R * 2 * d::GKW;
    case P_GLASCAN: return 2L * d::GH * d::GDV;
    case P_GLAOUT: return (long)d::R * d::GH;
    case P_HYC3: return (long)d::R * 3 * d::HW;
    case P_HYL0: case P_HYL1: return (long)(d::R / 4) * d::HW;
    case P_MRG_HY: case P_MRG_GLA: case P_MRG_ATT: return (long)(d::R / 4) * (d::D / 4);
    case P_OUT_L: return (long)(d::S / 4) * (d::D / 4);
    case P_OUT_C: return last ? 0 : (long)(d::C / 4) * (d::D / 4);
    case P_MOEHID: return (long)d::R * 2 * d::DE;
    case P_MOEOUT: return (long)(last ? d::S : d::R) * d::D;
  }
  return 0;
}

template <class T, int ST> HD void stage_run(const NaiveBufs& a, int l, int b, long idx) {
  using d = DD<T>;
  if constexpr (ST == L_MOD) st_mod<T>(a, l, idx);
  else if constexpr (ST == L_HID_S) st_hyhid<T>(a, l, 0, idx);
  else if constexpr (ST == L_HID_C) st_hyhid<T>(a, l, 1, idx);
  else if constexpr (ST == L_TAPS_S) st_hytaps<T>(a, l, 0, idx);
  else if constexpr (ST == L_TAPS_C) st_hytaps<T>(a, l, 1, idx);
  else if constexpr (ST == L_NRM_S) st_hynorm<T>(a, 0, idx);
  else if constexpr (ST == L_NRM_C) st_hynorm<T>(a, 1, idx);
  else if constexpr (ST == P_RS1) st_rs<T>(a, l, b, 0, idx);
  else if constexpr (ST == P_RS2) st_rs<T>(a, l, b, 1, idx);
  else if constexpr (ST == P_NORM1) st_norm<T>(a, l, b, 0, idx);
  else if constexpr (ST == P_NORM2) st_norm<T>(a, l, b, 1, idx);
  else if constexpr (ST == P_INPROJ) { GemmArgs g{a.h, d::D, a.w_in + (long)l * d::D * d::NIN, d::NIN, a.proj, d::NIN, d::R, d::NIN, d::D, nullptr, 0, nullptr, nullptr, 0, 0}; st_gemm(g, idx); }
  else if constexpr (ST == P_QKNORM) st_qknorm<T>(a, l, idx);
  else if constexpr (ST == P_ATTN_L) st_attn<T, ATT_NSPLIT>(a, 0, d::S, idx);
  else if constexpr (ST == P_ATTN_C) st_attn<T, ATT_NSPLIT>(a, d::S, d::C, idx);
  else if constexpr (ST == P_GLALA) st_glala<T>(a, l, idx);
  else if constexpr (ST == P_GLASCAN) st_glascan<T>(a, idx);
  else if constexpr (ST == P_GLAOUT) st_glaout<T>(a, l, idx);
  else if constexpr (ST == P_HYC3) st_hyconv3<T>(a, l, idx);
  else if constexpr (ST == P_HYL0) st_hylong<T>(a, l, 0, idx);
  else if constexpr (ST == P_HYL1) st_hylong<T>(a, l, 1, idx);
  else if constexpr (ST == P_MRG_HY) { GemmArgs g{a.yhy, d::HW, a.w_br_hy + (long)l * d::HW * d::D, d::D, a.m, d::D, d::R, d::D, d::HW, a.proj + d::O_BR, d::NIN, nullptr, nullptr, 0, 0}; st_gemm(g, idx); }
  else if constexpr (ST == P_MRG_GLA) { GemmArgs g{a.ygla, d::GVW, a.w_br_gla + (long)l * d::GVW * d::D, d::D, a.m, d::D, d::R, d::D, d::GVW, a.proj + d::O_BR + d::D, d::NIN, nullptr, nullptr, 0, 1}; st_gemm(g, idx); }
  else if constexpr (ST == P_MRG_ATT) { GemmArgs g{a.yatt, d::AQW, a.w_br_att + (long)l * d::AQW * d::D, d::D, a.m, d::D, d::R, d::D, d::AQW, a.proj + d::O_BR + 2 * d::D, d::NIN, nullptr, nullptr, 0, 1}; st_gemm(g, idx); }
  else if constexpr (ST == P_OUT_L) { const float* res = (l == 0 ? a.x : (const float*)a.out) + (long)b * d::S * d::D;
    GemmArgs g{a.m, d::D, a.w_out + (long)l * d::D * d::D, d::D, a.out + (long)b * d::S * d::D, d::D, d::S, d::D, d::D, nullptr, 0, a.mod + (long)b * 6 * d::D + 2 * d::D, res, d::D, 0}; st_gemm(g, idx); }
  else if constexpr (ST == P_OUT_C) { const float* res = (l == 0 ? a.ctx : (const float*)a.xc) + (long)b * d::C * d::D;
    GemmArgs g{a.m + (long)d::S * d::D, d::D, a.w_out + (long)l * d::D * d::D, d::D, a.xc + (long)b * d::C * d::D, d::D, d::C, d::D, d::D, nullptr, 0, a.mod + (long)d::B * 6 * d::D + 2 * d::D, res, d::D, 0}; st_gemm(g, idx); }
  else if constexpr (ST == P_ROUTER) st_router<T>(a, idx);
  else if constexpr (ST == P_MOEHID) st_moehid<T>(a, l, idx);
  else if constexpr (ST == P_MOEOUT) st_moeout<T>(a, l, b, idx);
}

template <class T> inline size_t carve(NaiveBufs& a, float* ws) {
  using d = DD<T>; size_t o = 0; auto take = [&](size_t n) { float* p = ws ? ws + o : nullptr; o += (n + 63) & ~(size_t)63; return p; };
  a.mod = take((size_t)(d::B + 1) * 6 * d::D);
  a.hid2S = take((size_t)d::S * d::HF); a.hid2C = take((size_t)d::C * d::HF);
  a.tapsS = take((size_t)2 * 2 * d::S * d::HW); a.tapsC = take((size_t)2 * 2 * d::C * d::HW);
  a.nrmS = take(2 * d::HW); a.nrmC = take(2 * d::HW);
  a.rs = take(d::R); a.h = take((size_t)d::R * d::D); a.proj = take((size_t)d::R * d::NIN);
  a.qn = take((size_t)d::R * d::AQW); a.kn = take((size_t)d::R * d::AKVW);
  a.uc = take((size_t)d::R * 3 * d::HW); a.z1 = take((size_t)d::R * d::HW); a.yhy = take((size_t)d::R * d::HW);
  a.xc = take((size_t)d::B * d::C * d::D);
#ifdef HOST_TEST
  a.yatt = take((size_t)d::R * d::AQW); a.laf = take((size_t)d::R * d::GKW); a.lab = take((size_t)d::R * d::GKW);
  a.of = take((size_t)d::R * d::GVW); a.ob = take((size_t)d::R * d::GVW); a.ygla = take((size_t)d::R * d::GVW);
  a.m = take((size_t)d::R * d::D); a.ridx = (int*)take((size_t)d::R * 2); a.rw = take((size_t)d::R * 2); a.hid = take((size_t)d::R * 2 * d::DE);
#endif
  return o;
}
template <class T> inline void set_inputs(NaiveBufs& a, const float* const* in) {
  int i = 0;
  a.x = in[i++]; a.c = in[i++]; a.ctx = in[i++]; a.c_ctx = in[i++]; a.w_mod = in[i++]; a.b_mod = in[i++]; a.norm1_g = in[i++]; a.norm2_g = in[i++];
  a.w_in = in[i++]; a.q_norm_g = in[i++]; a.k_norm_g = in[i++]; a.gla_wa2 = in[i++]; a.gla_ba = in[i++]; a.gla_norm_g = in[i++];
  a.hy_conv_w = in[i++]; a.hy_conv_b = in[i++]; a.hy_pos_w1 = in[i++]; a.hy_pos_b1 = in[i++]; a.hy_sin_freq = in[i++]; a.hy_pos_w2 = in[i++];
  a.hy_pos_b2 = in[i++]; a.hy_pos_w3 = in[i++]; a.hy_decay = in[i++]; a.hy_skip = in[i++]; a.w_br_hy = in[i++]; a.w_br_gla = in[i++];
  a.w_br_att = in[i++]; a.w_out = in[i++]; a.router_w = in[i++]; a.router_b = in[i++]; a.moe_w_gate = in[i++]; a.moe_w_up = in[i++]; a.moe_w_down = in[i++];
}

#define LSTAGES(X) X(L_MOD) X(L_HID_S) X(L_HID_C) X(L_TAPS_S) X(L_TAPS_C) X(L_NRM_S) X(L_NRM_C)
#define PSTAGES(X) X(P_RS1) X(P_NORM1) X(P_INPROJ) X(P_QKNORM) X(P_ATTN_L) X(P_ATTN_C) X(P_GLALA) X(P_GLASCAN) X(P_GLAOUT) X(P_HYC3) X(P_HYL0) X(P_HYL1) \
  X(P_MRG_HY) X(P_MRG_GLA) X(P_MRG_ATT) X(P_OUT_L) X(P_OUT_C) X(P_RS2) X(P_NORM2) X(P_ROUTER) X(P_MOEHID) X(P_MOEOUT)
namespace pro {
__device__ __forceinline__ void mod_phase(const NaiveBufs& a, int l, LAS unsigned char* lds) {
  int tz = threadIdx.x; asm volatile("" : "+v"(tz));
  __syncthreads();
  LAS float* sl = (LAS float*)lds; LAS float* part = sl + 9 * 1024;
  for (int e = tz; e < 9 * 1024; e += NTHREADS) { const int bb = e >> 10, k = e & 1023; const float cv = bb < 8 ? a.c[bb * 1024 + k] : a.c_ctx[k]; sl[e] = cv / (1.f + __expf(-cv)); }
  __syncthreads();
  const float* w = a.w_mod + (size_t)l * 1024 * 6144;
  const int jl = tz & 31, ks = tz >> 5;
  for (int cb = blockIdx.x; cb < 192; cb += gridDim.x) { const int j = cb * 32 + jl; float acc[9];
#pragma unroll
    for (int q = 0; q < 9; ++q) acc[q] = 0.f;
    for (int k0 = ks * 64; k0 < ks * 64 + 64; k0 += 16) { float wv[16];
#pragma unroll
      for (int kk = 0; kk < 16; ++kk) wv[kk] = w[(size_t)(k0 + kk) * 6144 + j];
#pragma unroll
      for (int kk = 0; kk < 16; ++kk)
#pragma unroll
        for (int q = 0; q < 9; ++q) acc[q] += sl[q * 1024 + k0 + kk] * wv[kk]; }
#pragma unroll
    for (int q = 0; q < 9; ++q) part[(ks * 9 + q) * 32 + jl] = acc[q];
    __syncthreads();
    for (int e = tz; e < 9 * 32; e += NTHREADS) { const int q = e >> 5, jj = e & 31; float s = a.b_mod[(size_t)l * 6144 + cb * 32 + jj];
#pragma unroll
      for (int k16 = 0; k16 < 16; ++k16) s += part[(k16 * 9 + q) * 32 + jj];
      a.mod[(size_t)q * 6144 + cb * 32 + jj] = s; }
    __syncthreads(); }
  __syncthreads();
}
__device__ __forceinline__ void hid_phase(const NaiveBufs& a, int l, int n, float* dst, LAS unsigned char* lds) {
  int tz = threadIdx.x; asm volatile("" : "+v"(tz));
  LAS float* Z = (LAS float*)(lds + 40960); LAS float* H1 = Z + 8 * 36;
  const float* w1 = a.hy_pos_w1 + (size_t)l * 33 * 64; const float* b1 = a.hy_pos_b1 + l * 64; const float* fr = a.hy_sin_freq + l * 64;
  const float* w2 = a.hy_pos_w2 + (size_t)l * 64 * 64; const float* b2 = a.hy_pos_b2 + l * 64;
  const float w0 = 2.f * 3.14159265358979323846f / (float)n;
  for (int t0 = blockIdx.x * 8; t0 < n; t0 += gridDim.x * 8) {
    if (tz < 8 * 33) { const int tt = tz / 33, e = tz % 33, t = t0 + tt; float v;
      if (e == 0) v = (float)t / (float)n; else { const int bnd = (e - 1) & 15; const float band = 1e-4f + (float)bnd * (15.f - 1e-4f) / 15.f; const float ph = w0 * (float)t * band; v = e <= 16 ? cosf(ph) : -sinf(ph); }
      Z[tt * 36 + e] = v; }
    __syncthreads();
    { const int tt = tz >> 6, i = tz & 63; float acc = b1[i];
#pragma unroll
      for (int e = 0; e < 33; ++e) acc += Z[tt * 36 + e] * w1[e * 64 + i];
      H1[tt * 64 + i] = sinf(fr[i] * acc); }
    __syncthreads();
    { const int tt = tz >> 6, j = tz & 63; float acc = b2[j];
#pragma unroll 8
      for (int i = 0; i < 64; ++i) acc += H1[tt * 64 + i] * w2[i * 64 + j];
      if (t0 + tt < n) dst[(size_t)(t0 + tt) * 64 + j] = sinf(fr[j] * acc); }
    __syncthreads();
  }
}
__device__ __forceinline__ void nrmS_phase(const NaiveBufs& a) {
  int tz = threadIdx.x; asm volatile("" : "+v"(tz)); const int lane = tz & 63, wave = __builtin_amdgcn_readfirstlane(tz >> 6);
  for (int oc = blockIdx.x * NWAVES + wave; oc < 1024; oc += gridDim.x * NWAVES) { const float* tp = a.tapsS + (size_t)oc * 8192; float s = 0.f;
#pragma unroll 8
    for (int k = lane; k < 8192; k += 64) s += fabsf(tp[k]);
    s = moe::wave_sum(s); if (lane == 0) a.nrmS[oc] = s + 1e-6f; }
}
constexpr int TCOPY = 8232;
__device__ __forceinline__ void tapsB_phase(const NaiveBufs& a, int l, bf16_t* tapsB, LAS unsigned char* lds) {
  int tz = threadIdx.x; asm volatile("" : "+v"(tz));
  const float* w3 = a.hy_pos_w3 + (size_t)l * 64 * 2048; const float* dcy = a.hy_decay + (size_t)l * 2048;
  typedef float f4 __attribute__((ext_vector_type(4)));
  LAS float* W = (LAS float*)lds;
  for (int cp = blockIdx.x; cp < 256; cp += gridDim.x) {
    __syncthreads();
    { const int ch = tz >> 8, e = tz & 255, c = cp + 256 * ch; W[tz] = w3[(size_t)(e >> 2) * 2048 + (e & 3) * 512 + c]; if (tz < 8) W[512 + tz] = fabsf(dcy[(tz & 3) * 512 + cp + 256 * (tz >> 2)]); }
    __syncthreads();
    for (int t = tz; t < 4096; t += NTHREADS) {
      const f4* h2 = (const f4*)(a.hid2S + (size_t)t * 64); f4 acc0 = {0.f, 0.f, 0.f, 0.f}, acc1 = {0.f, 0.f, 0.f, 0.f};
#pragma unroll 4
      for (int j4 = 0; j4 < 16; ++j4) { const f4 h = h2[j4];
#pragma unroll
        for (int e = 0; e < 4; ++e) { acc0 += h[e] * *(const LAS f4*)(W + (4 * j4 + e) * 4); acc1 += h[e] * *(const LAS f4*)(W + 256 + (4 * j4 + e) * 4); } }
      const float tn = (float)t * (1.f / 4096.f);
#pragma unroll
      for (int ch = 0; ch < 2; ++ch)
#pragma unroll
        for (int q = 0; q < 4; ++q) { const int o = q >> 1, dir = q & 1; if (dir == 1 && t == 0) continue; const int c = cp + 256 * ch;
          const bf16_t bv = (bf16_t)f2bf((ch ? acc1[q] : acc0[q]) * __expf(-tn * W[512 + 4 * ch + q]));
          bf16_t* base = tapsB + ((size_t)o * 512 + c) * 2 * TCOPY; const int x0 = dir ? 4096 + t : 4096 - t;
          base[x0] = bv; base[TCOPY + x0 - 1] = bv; } } }
  for (long idx = (long)blockIdx.x * NTHREADS + tz; idx < 1024L * 96; idx += (long)gridDim.x * NTHREADS) { const int oc = (int)(idx / 96), e = (int)(idx % 96); bf16_t* base = tapsB + (size_t)oc * 2 * TCOPY;
    if (e < 40) base[8192 + e] = 0; else if (e < 81) base[TCOPY + 8191 + (e - 40)] = 0; else if (e == 81) base[0] = 0; }
}
__device__ __forceinline__ void tapsM_phase(const NaiveBufs& a, int l, bf16_t* tapsB, int bx = -1, int gx = 0) {
  if (bx < 0) { bx = (int)blockIdx.x; gx = (int)gridDim.x; }
  int tz = threadIdx.x; asm volatile("" : "+v"(tz));
  const int lane = tz & 63, li = lane & 31, lk = lane >> 5; const int wg = bx * NWAVES + __builtin_amdgcn_readfirstlane(tz >> 6), NW = gx * NWAVES;
  typedef short b8 __attribute__((ext_vector_type(8))); typedef float f16v __attribute__((ext_vector_type(16))); typedef float f4 __attribute__((ext_vector_type(4)));
  const float* w3 = a.hy_pos_w3 + (size_t)l * 64 * 2048; const float* dcy = a.hy_decay + (size_t)l * 2048;
  for (int task = wg; task < 64 * 32; task += NW) { const int ct = task & 63, tg = task >> 6, col0 = 32 * ct, q = col0 >> 9, o = q >> 1, dir = q & 1;
    v4u Ah[4], Al[4];
#pragma unroll
    for (int ks = 0; ks < 4; ++ks) { float x[8];
#pragma unroll
      for (int jj = 0; jj < 8; ++jj) x[jj] = w3[(size_t)(16 * ks + 8 * lk + jj) * 2048 + col0 + li];
      v4u h; h.x = pk2(x[0], x[1]); h.y = pk2(x[2], x[3]); h.z = pk2(x[4], x[5]); h.w = pk2(x[6], x[7]); Ah[ks] = h;
      v4u lo; lo.x = pk2(x[0] - __uint_as_float(h.x << 16), x[1] - __uint_as_float(h.x & 0xffff0000u)); lo.y = pk2(x[2] - __uint_as_float(h.y << 16), x[3] - __uint_as_float(h.y & 0xffff0000u));
      lo.z = pk2(x[4] - __uint_as_float(h.z << 16), x[5] - __uint_as_float(h.z & 0xffff0000u)); lo.w = pk2(x[6] - __uint_as_float(h.w << 16), x[7] - __uint_as_float(h.w & 0xffff0000u)); Al[ks] = lo; }
    float dk[16];
#pragma unroll
    for (int r = 0; r < 16; ++r) dk[r] = fabsf(dcy[col0 + (r & 3) + 8 * (r >> 2) + 4 * lk]);
    bf16_t* cbase = tapsB + ((size_t)o * 512 + (col0 & 511) + 4 * lk) * 2 * TCOPY;
    for (int tt = 0; tt < 4; ++tt) { const int t = 32 * (tg + 32 * tt) + li; const float* hrow = a.hid2S + (size_t)t * 64 + 8 * lk;
      f4 hv[8];
#pragma unroll
      for (int ks = 0; ks < 4; ++ks) { hv[2 * ks] = *(const f4*)(hrow + 16 * ks); hv[2 * ks + 1] = *(const f4*)(hrow + 16 * ks + 4); }
      f16v acc = {};
#pragma unroll
      for (int ks = 0; ks < 4; ++ks) { const f4 xa = hv[2 * ks], xb = hv[2 * ks + 1];
        v4u h; h.x = pk2(xa[0], xa[1]); h.y = pk2(xa[2], xa[3]); h.z = pk2(xb[0], xb[1]); h.w = pk2(xb[2], xb[3]);
        v4u lo; lo.x = pk2(xa[0] - __uint_as_float(h.x << 16), xa[1] - __uint_as_float(h.x & 0xffff0000u)); lo.y = pk2(xa[2] - __uint_as_float(h.y << 16), xa[3] - __uint_as_float(h.y & 0xffff0000u));
        lo.z = pk2(xb[0] - __uint_as_float(h.z << 16), xb[1] - __uint_as_float(h.z & 0xffff0000u)); lo.w = pk2(xb[2] - __uint_as_float(h.w << 16), xb[3] - __uint_as_float(h.w & 0xffff0000u));
        acc = __builtin_amdgcn_mfma_f32_32x32x16_bf16(__builtin_bit_cast(b8, Ah[ks]), __builtin_bit_cast(b8, h), acc, 0, 0, 0);
        acc = __builtin_amdgcn_mfma_f32_32x32x16_bf16(__builtin_bit_cast(b8, Al[ks]), __builtin_bit_cast(b8, h), acc, 0, 0, 0);
        acc = __builtin_amdgcn_mfma_f32_32x32x16_bf16(__builtin_bit_cast(b8, Ah[ks]), __builtin_bit_cast(b8, lo), acc, 0, 0, 0); }
      const float tn = (float)t * (1.f / 4096.f); const int x0 = dir ? 4096 + t : 4096 - t;
      if (!(dir == 1 && t == 0)) {
#pragma unroll
        for (int r = 0; r < 16; ++r) { const bf16_t bv = (bf16_t)f2bf(acc[r] * __expf(-tn * dk[r])); bf16_t* base = cbase + (size_t)((r & 3) + 8 * (r >> 2)) * 2 * TCOPY; base[x0] = bv; base[TCOPY + x0 - 1] = bv; } } } }
  for (long idx = (long)bx * NTHREADS + tz; idx < 1024L * 96; idx += (long)gx * NTHREADS) { const int oc = (int)(idx / 96), e = (int)(idx % 96); bf16_t* base = tapsB + (size_t)oc * 2 * TCOPY;
    if (e < 40) base[8192 + e] = 0; else if (e < 81) base[TCOPY + 8191 + (e - 40)] = 0; else if (e == 81) base[0] = 0; }
}
__device__ __forceinline__ void tapsMC_phase(const NaiveBufs& a, int l, float* tapsC) {
  int tz = threadIdx.x; asm volatile("" : "+v"(tz));
  const int lane = tz & 63, li = lane & 31, lk = lane >> 5; const int wg = blockIdx.x * NWAVES + __builtin_amdgcn_readfirstlane(tz >> 6), NW = gridDim.x * NWAVES;
  typedef short b8 __attribute__((ext_vector_type(8))); typedef float f16v __attribute__((ext_vector_type(16))); typedef float f4 __attribute__((ext_vector_type(4)));
  const float* w3 = a.hy_pos_w3 + (size_t)l * 64 * 2048; const float* dcy = a.hy_decay + (size_t)l * 2048; constexpr int n = 256;
  for (int task = wg; task < 64 * 8; task += NW) { const int ct = task & 63, t0 = 32 * (task >> 6), col0 = 32 * ct, q = col0 >> 9, o = q >> 1, dir = q & 1;
    const float* hrow = a.hid2C + (size_t)(t0 + li) * 64 + 8 * lk;
    f16v acc = {};
#pragma unroll
    for (int ks = 0; ks < 4; ++ks) { float x[8];
#pragma unroll
      for (int jj = 0; jj < 8; ++jj) x[jj] = w3[(size_t)(16 * ks + 8 * lk + jj) * 2048 + col0 + li];
      v4u wh; wh.x = pk2(x[0], x[1]); wh.y = pk2(x[2], x[3]); wh.z = pk2(x[4], x[5]); wh.w = pk2(x[6], x[7]);
      v4u wl; wl.x = pk2(x[0] - __uint_as_float(wh.x << 16), x[1] - __uint_as_float(wh.x & 0xffff0000u)); wl.y = pk2(x[2] - __uint_as_float(wh.y << 16), x[3] - __uint_as_float(wh.y & 0xffff0000u));
      wl.z = pk2(x[4] - __uint_as_float(wh.z << 16), x[5] - __uint_as_float(wh.z & 0xffff0000u)); wl.w = pk2(x[6] - __uint_as_float(wh.w << 16), x[7] - __uint_as_float(wh.w & 0xffff0000u));
      const f4 xa = *(const f4*)(hrow + 16 * ks), xb = *(const f4*)(hrow + 16 * ks + 4);
      v4u h; h.x = pk2(xa[0], xa[1]); h.y = pk2(xa[2], xa[3]); h.z = pk2(xb[0], xb[1]); h.w = pk2(xb[2], xb[3]);
      v4u lo; lo.x = pk2(xa[0] - __uint_as_float(h.x << 16), xa[1] - __uint_as_float(h.x & 0xffff0000u)); lo.y = pk2(xa[2] - __uint_as_float(h.y << 16), xa[3] - __uint_as_float(h.y & 0xffff0000u));
      lo.z = pk2(xb[0] - __uint_as_float(h.z << 16), xb[1] - __uint_as_float(h.z & 0xffff0000u)); lo.w = pk2(xb[2] - __uint_as_float(h.w << 16), xb[3] - __uint_as_float(h.w & 0xffff0000u));
      acc = __builtin_amdgcn_mfma_f32_32x32x16_bf16(__builtin_bit_cast(b8, h), __builtin_bit_cast(b8, wh), acc, 0, 0, 0);
      acc = __builtin_amdgcn_mfma_f32_32x32x16_bf16(__builtin_bit_cast(b8, lo), __builtin_bit_cast(b8, wh), acc, 0, 0, 0);
      acc = __builtin_amdgcn_mfma_f32_32x32x16_bf16(__builtin_bit_cast(b8, h), __builtin_bit_cast(b8, wl), acc, 0, 0, 0); }
    const float dk = fabsf(dcy[col0 + li]); float* dst = tapsC + (size_t)o * 2 * n * 512 + (col0 & 511) + li;
#pragma unroll
    for (int r = 0; r < 16; ++r) { const int t = t0 + (r & 3) + 8 * (r >> 2) + 4 * lk; if (dir == 1 && t == 0) continue;
      dst[(size_t)(dir ? 2 * n - t : t) * 512] = acc[r] * __expf(-((float)t * (1.f / (float)n)) * dk); } }
  for (int i = blockIdx.x * NTHREADS + tz; i < 2 * 512; i += gridDim.x * NTHREADS) tapsC[((size_t)(i >> 9) * 2 * n + n) * 512 + (i & 511)] = 0.f;
}
__device__ __forceinline__ void nrmB_phase(const NaiveBufs& a, const bf16_t* tapsB) {
  int tz = threadIdx.x; asm volatile("" : "+v"(tz)); const int lane = tz & 63, wave = __builtin_amdgcn_readfirstlane(tz >> 6);
  for (int oc = blockIdx.x * NWAVES + wave; oc < 1024; oc += gridDim.x * NWAVES) { const bf16_t* tp = tapsB + (size_t)oc * 2 * TCOPY; float s = 0.f;
    v4u q[16];
#pragma unroll
    for (int i = 0; i < 16; ++i) q[i] = *(const v4u*)(tp + 8 * lane + 512 * i);
#pragma unroll
    for (int i = 0; i < 16; ++i) { s += fabsf(__uint_as_float(q[i].x << 16)) + fabsf(__uint_as_float(q[i].x & 0xffff0000u)) + fabsf(__uint_as_float(q[i].y << 16)) + fabsf(__uint_as_float(q[i].y & 0xffff0000u))
        + fabsf(__uint_as_float(q[i].z << 16)) + fabsf(__uint_as_float(q[i].z & 0xffff0000u)) + fabsf(__uint_as_float(q[i].w << 16)) + fabsf(__uint_as_float(q[i].w & 0xffff0000u)); }
    s = moe::wave_sum(s); if (lane == 0) a.nrmS[oc] = s + 1e-6f; }
}
__device__ __forceinline__ void nrmC_phase(const NaiveBufs& a, LAS unsigned char* lds) {
  int tz = threadIdx.x; asm volatile("" : "+v"(tz)); const int lane = tz & 63, wave = __builtin_amdgcn_readfirstlane(tz >> 6);
  LAS float* part = (LAS float*)lds;
  for (int task = blockIdx.x; task < 16; task += gridDim.x) { const int o = task >> 3, c = (task & 7) * 64 + lane;
    const float* tp = a.tapsC + ((size_t)o * 512 + wave * 64) * 512 + c; float v[64];
#pragma unroll
    for (int k = 0; k < 64; ++k) v[k] = tp[(size_t)k * 512];
    float s = 0.f;
#pragma unroll
    for (int k = 0; k < 64; ++k) s += fabsf(v[k]);
    __syncthreads(); part[wave * 64 + lane] = s; __syncthreads();
    if (wave == 0) { float t = 0.f;
#pragma unroll
      for (int w2 = 0; w2 < 8; ++w2) t += part[w2 * 64 + lane];
      a.nrmC[o * 512 + c] = t + 1e-6f; } }
}
}
using TD = FullDims;
using dd = DD<TD>;
constexpr int GB = 4, NGRP = 2, RB = dd::R  , RG = GB * RB, PLD = dd::O_BR + 1536  , PANELS = RG / 256, PPB = RB / 256  ;
constexpr size_t BAR_BYTES = 16384 + 4 * 4096; constexpr int CNT_OFF = 16384;
constexpr int MPG = 38912;
constexpr size_t CS_BYTES = (size_t)2 * 4 * 68 * 64 * 128 * 2, DEC_BYTES = (size_t)2 * 4 * 68 * 64 * 4;
constexpr size_t UCT_BYTES = (size_t)1536 * 4096 * 2, YT_BYTES = (size_t)512 * 4096 * 2, UCC_BYTES = (size_t)256 * 1536 * 4, Z1C_BYTES = (size_t)256 * 512 * 4;
constexpr size_t MIX_BYTES = GB * (CS_BYTES + DEC_BYTES) > GB * (UCT_BYTES + YT_BYTES + UCC_BYTES + Z1C_BYTES) ? GB * (CS_BYTES + DEC_BYTES) : GB * (UCT_BYTES + YT_BYTES + UCC_BYTES + Z1C_BYTES);

struct KArgs { NaiveBufs a; unsigned* bar; int* cnt; bf16_t *xs; bf16_t *wfg; bf16_t *WgaT; bf16_t *WinT, *WhyT, *WglaT, *WattT, *WoutT, *WguT, *WdT, *hb, *proj; unsigned char* mix;
  bf16_t *hp, *hid, *contrib; int* srcrow; float* wgt; moe::Route* route; float* wts; float* gdec; };

struct EpiProjBf16 {
  static constexpr bool PERM = true, AFTER_DRAIN = false, CHAIN = false;
  bf16_t* P;
  __device__ __forceinline__ void operator()(const pg8::f32x4 (&acc)[2][2][4][2], const pg8::Unit& u, int wr, int wc, int fr, int fq) const {
    const int row0 = u.pm * 256 + wr * 64 + fr, col0 = u.pn * 256 + wc * 32 + 8 * fq;
    const int cr0 = col0 + (col0 >= dd::O_GA ? 32 : 0), cr1 = col0 + 128 + (col0 + 128 >= dd::O_GA ? 32 : 0);
    if (u.pn >= (dd::O_BR - 32) / 256) {
      unsigned char* Pg = (unsigned char*)P + (size_t)dd::O_BR * 2 + (col0 - (dd::O_BR - 32));
#pragma unroll
      for (int ai = 0; ai < 2; ++ai)
#pragma unroll
        for (int m = 0; m < 4; ++m) { unsigned char* rowp = Pg + (size_t)(row0 + ai * 128 + m * 16) * (PLD * 2);
#pragma unroll
          for (int bj = 0; bj < 2; ++bj) { const pg8::f32x4 v0 = acc[ai][bj][m][0], v1 = acc[ai][bj][m][1]; uint2 o;
            o.x = (unsigned)(fsigmoid(v0[0]) * 255.f + 0.5f) | ((unsigned)(fsigmoid(v0[1]) * 255.f + 0.5f) << 8) | ((unsigned)(fsigmoid(v0[2]) * 255.f + 0.5f) << 16) | ((unsigned)(fsigmoid(v0[3]) * 255.f + 0.5f) << 24);
            o.y = (unsigned)(fsigmoid(v1[0]) * 255.f + 0.5f) | ((unsigned)(fsigmoid(v1[1]) * 255.f + 0.5f) << 8) | ((unsigned)(fsigmoid(v1[2]) * 255.f + 0.5f) << 16) | ((unsigned)(fsigmoid(v1[3]) * 255.f + 0.5f) << 24);
            *(uint2*)(rowp + bj * 128) = o; } }
      return; }
#pragma unroll
    for (int ai = 0; ai < 2; ++ai)
#pragma unroll
      for (int m = 0; m < 4; ++m) { bf16_t* rowp = P + (size_t)(row0 + ai * 128 + m * 16) * PLD;
#pragma unroll
        for (int bj = 0; bj < 2; ++bj) { const pg8::f32x4 v0 = acc[ai][bj][m][0], v1 = acc[ai][bj][m][1];
          v4u o; o.x = pk2(v0[0], v0[1]); o.y = pk2(v0[2], v0[3]); o.z = pk2(v1[0], v1[1]); o.w = pk2(v1[2], v1[3]); *(v4u*)(rowp + (bj ? cr1 : cr0)) = o; } }
  }
};
template <bool ACCUM> struct EpiMergeB {
  static constexpr bool PERM = true, AFTER_DRAIN = false;
  const bf16_t* gate; bf16_t* M;
  __device__ __forceinline__ void operator()(const pg8::f32x4 (&acc)[2][2][4][2], const pg8::Unit& u, int wr, int wc, int fr, int fq) const {
    const int row0 = u.pm * 256 + wr * 64 + fr, col0 = u.pn * 256 + wc * 32 + 8 * fq;
#pragma unroll
    for (int ai2 = 0; ai2 < 4; ++ai2) { const int ai = ai2 >> 1, m0 = (ai2 & 1) * 2;
      v4u gw[4][2], mo[4][2];
#pragma unroll
      for (int m = m0; m < m0 + 2; ++m)
#pragma unroll
        for (int bj = 0; bj < 2; ++bj) { const size_t r = (size_t)(row0 + ai * 128 + m * 16); const int c = col0 + bj * 128; gw[m][bj] = *(const v4u*)(gate + r * PLD + c); if (ACCUM) mo[m][bj] = *(const v4u*)(M + r * 1024 + c); }
#pragma unroll
      for (int m = m0; m < m0 + 2; ++m)
#pragma unroll
        for (int bj = 0; bj < 2; ++bj) { const size_t r = (size_t)(row0 + ai * 128 + m * 16); const int c = col0 + bj * 128; const v4u g4 = gw[m][bj];
          pg8::f32x4 v0 = acc[ai][bj][m][0], v1 = acc[ai][bj][m][1];
          v0[0] *= fsigmoid(bf2f(g4.x & 0xffff)); v0[1] *= fsigmoid(bf2f(g4.x >> 16)); v0[2] *= fsigmoid(bf2f(g4.y & 0xffff)); v0[3] *= fsigmoid(bf2f(g4.y >> 16));
          v1[0] *= fsigmoid(bf2f(g4.z & 0xffff)); v1[1] *= fsigmoid(bf2f(g4.z >> 16)); v1[2] *= fsigmoid(bf2f(g4.w & 0xffff)); v1[3] *= fsigmoid(bf2f(g4.w >> 16));
          if (ACCUM) { const v4u o = mo[m][bj]; v0[0] += bf2f(o.x & 0xffff); v0[1] += bf2f(o.x >> 16); v0[2] += bf2f(o.y & 0xffff); v0[3] += bf2f(o.y >> 16);
            v1[0] += bf2f(o.z & 0xffff); v1[1] += bf2f(o.z >> 16); v1[2] += bf2f(o.w & 0xffff); v1[3] += bf2f(o.w >> 16); }
          v4u o2; o2.x = pk2(v0[0], v0[1]); o2.y = pk2(v0[2], v0[3]); o2.z = pk2(v1[0], v1[1]); o2.w = pk2(v1[2], v1[3]); *(v4u*)(M + r * 1024 + c) = o2; } }
  }
};
struct EpiOutG {
  static constexpr bool PERM = true, AFTER_DRAIN = false, CHAIN = false;
  const float* resL; const float* resC; bf16_t* xs; const float* mod; int b0; bool ctx_on, resbf;
  __device__ __forceinline__ void operator()(const pg8::f32x4 (&acc)[2][2][4][2], const pg8::Unit& u, int wr, int wc, int fr, int fq) const {
    const int bl = u.pm / PPB, lp = u.pm % PPB; const bool isc = lp == PPB - 1; if (isc && !ctx_on) return;
    const int b = b0 + bl;
    const float* res = isc ? resC + (size_t)b * dd::C * 1024 : resL + ((size_t)b * dd::S + lp * 256) * 1024;
    bf16_t* out = xs + (size_t)u.pm * 256 * 1024;
    const float* gv = mod + (size_t)(isc ? dd::B : b) * 6 * 1024 + 2 * 1024;
    int row0 = wr * 64 + fr, col0 = u.pn * 256 + wc * 32 + 8 * fq; asm volatile("" : "+v"(row0), "+v"(col0));
    pg8::f32x4 gg[2][2];
#pragma unroll
    for (int bj = 0; bj < 2; ++bj)
#pragma unroll
      for (int n = 0; n < 2; ++n) gg[bj][n] = *(const pg8::f32x4*)(gv + col0 + bj * 128 + n * 4);
    if (resbf) {
#pragma unroll
      for (int ai2 = 0; ai2 < 4; ++ai2) { const int ai = ai2 >> 1, m0 = (ai2 & 1) * 2; v4u rb[4][2];
#pragma unroll
        for (int m = m0; m < m0 + 2; ++m)
#pragma unroll
          for (int bj = 0; bj < 2; ++bj) rb[m][bj] = *(const v4u*)(out + (size_t)(row0 + ai * 128 + m * 16) * 1024 + col0 + bj * 128);
#pragma unroll
        for (int m = m0; m < m0 + 2; ++m)
#pragma unroll
          for (int bj = 0; bj < 2; ++bj) { const v4u o = rb[m][bj]; const pg8::f32x4 v0 = gg[bj][0] * acc[ai][bj][m][0], v1 = gg[bj][1] * acc[ai][bj][m][1]; v4u w;
            w.x = pk2(v0[0] + __uint_as_float(o.x << 16), v0[1] + __uint_as_float(o.x & 0xffff0000u)); w.y = pk2(v0[2] + __uint_as_float(o.y << 16), v0[3] + __uint_as_float(o.y & 0xffff0000u));
            w.z = pk2(v1[0] + __uint_as_float(o.z << 16), v1[1] + __uint_as_float(o.z & 0xffff0000u)); w.w = pk2(v1[2] + __uint_as_float(o.w << 16), v1[3] + __uint_as_float(o.w & 0xffff0000u));
            *(v4u*)(out + (size_t)(row0 + ai * 128 + m * 16) * 1024 + col0 + bj * 128) = w; } }
    } else {
#pragma unroll
      for (int ai2 = 0; ai2 < 4; ++ai2) { const int ai = ai2 >> 1, m0 = (ai2 & 1) * 2;
        pg8::f32x4 rv[4][2][2];
#pragma unroll
        for (int m = m0; m < m0 + 2; ++m)
#pragma unroll
          for (int bj = 0; bj < 2; ++bj)
#pragma unroll
            for (int n = 0; n < 2; ++n) rv[m][bj][n] = *(const pg8::f32x4*)(res + (size_t)(row0 + ai * 128 + m * 16) * 1024 + col0 + bj * 128 + n * 4);
#pragma unroll
        for (int m = m0; m < m0 + 2; ++m)
#pragma unroll
          for (int bj = 0; bj < 2; ++bj) { const pg8::f32x4 v0 = rv[m][bj][0] + gg[bj][0] * acc[ai][bj][m][0], v1 = rv[m][bj][1] + gg[bj][1] * acc[ai][bj][m][1];
            v4u w; w.x = pk2(v0[0], v0[1]); w.y = pk2(v0[2], v0[3]); w.z = pk2(v1[0], v1[1]); w.w = pk2(v1[2], v1[3]);
            *(v4u*)(out + (size_t)(row0 + ai * 128 + m * 16) * 1024 + col0 + bj * 128) = w; } }
    }
  }
};
struct GroupOrder {
  int nN, nwg, G, c; bool lat;
  __device__ void init(int N, int G_, int c_, bool lat_) { nN = N / 256; lat = lat_; nwg = (lat ? GB * 16 : PANELS) * nN; G = G_; c = c_; }
  __device__ __forceinline__ bool next(int i, pg8::Unit& u) const { const long L = (long)i * G + c; if (L >= nwg) return false; const int p = (int)L / nN; u.pm = lat ? (p >> 4) * PPB + (p & 15) : p; u.pn = (int)L % nN; u.acol = 0; u.nt = 0; return true; }
  __device__ __forceinline__ void a_ready(const pg8::Unit&) const {}
  __device__ __forceinline__ void done(const pg8::Unit&) const {}
};
struct MergeOrder {
  int ntiles, G, c; bool lat;
  __device__ void init(int G_, int c_, bool lat_) { lat = lat_; ntiles = (lat ? GB * 16 : PANELS) * 4; G = G_; c = c_; }
  __device__ __forceinline__ bool next(int i, pg8::Unit& u) const { const int rnd = i / 3, gi = i - 3 * rnd; const long tile = (long)rnd * G + c; if (tile >= ntiles) return false; const int p = (int)tile >> 2;
    u.pm = lat ? (p >> 4) * PPB + (p & 15) : p; u.pn = gi * 4 + ((int)tile & 3); u.acol = gi == 0 ? dd::O_HY : gi == 1 ? dd::O_OG : dd::O_AQ; u.nt = gi == 2 ? 16 : 8; return true; }
  __device__ __forceinline__ void a_ready(const pg8::Unit&) const {}
  __device__ __forceinline__ void done(const pg8::Unit&) const {}
};
struct EpiMergeS {
  static constexpr bool PERM = true, AFTER_DRAIN = false, CHAIN = true;
  const unsigned char* gate0; bf16_t* M;
  __device__ __forceinline__ bool chain(pg8::f32x4 (&acc)[2][2][4][2], const pg8::Unit& u, int wr, int wc, int fr, int fq) const {
    const int gi = u.pn >> 2; const unsigned char* gate = gate0 + gi * 1024;
    int row0 = u.pm * 256 + wr * 64 + fr, col0 = (u.pn & 3) * 256 + wc * 32 + 8 * fq; asm volatile("" : "+v"(row0), "+v"(col0));
    if (gi < 2) {
      const float lo_c = gi == 0 ? 0.f : 0.5f;
#pragma unroll
      for (int ai2 = 0; ai2 < 4; ++ai2) { const int ai = ai2 >> 1, m0 = (ai2 & 1) * 2;
        uint2 gc[4][2], gn[4][2];
#pragma unroll
        for (int m = m0; m < m0 + 2; ++m)
#pragma unroll
          for (int bj = 0; bj < 2; ++bj) { const unsigned char* gp_ = gate + (size_t)(row0 + ai * 128 + m * 16) * (PLD * 2) + col0 + bj * 128; gc[m][bj] = *(const uint2*)gp_; gn[m][bj] = *(const uint2*)(gp_ + 1024); }
#pragma unroll
        for (int m = m0; m < m0 + 2; ++m)
#pragma unroll
          for (int bj = 0; bj < 2; ++bj) { const uint2 c2 = gc[m][bj], n2 = gn[m][bj];
#pragma unroll
            for (int e = 0; e < 4; ++e) {
              acc[ai][bj][m][0][e] *= fmaxf((float)((c2.x >> (8 * e)) & 255u), lo_c) * __builtin_amdgcn_rcpf(fmaxf((float)((n2.x >> (8 * e)) & 255u), 0.5f));
              acc[ai][bj][m][1][e] *= fmaxf((float)((c2.y >> (8 * e)) & 255u), lo_c) * __builtin_amdgcn_rcpf(fmaxf((float)((n2.y >> (8 * e)) & 255u), 0.5f)); } } }
      return true; }
#pragma unroll
    for (int ai2 = 0; ai2 < 4; ++ai2) { const int ai = ai2 >> 1, m0 = (ai2 & 1) * 2;
      uint2 gw[4][2];
#pragma unroll
      for (int m = m0; m < m0 + 2; ++m)
#pragma unroll
        for (int bj = 0; bj < 2; ++bj) gw[m][bj] = *(const uint2*)(gate + (size_t)(row0 + ai * 128 + m * 16) * (PLD * 2) + col0 + bj * 128);
#pragma unroll
      for (int m = m0; m < m0 + 2; ++m)
#pragma unroll
        for (int bj = 0; bj < 2; ++bj) { const size_t r = (size_t)(row0 + ai * 128 + m * 16); const int c = col0 + bj * 128; const uint2 g2 = gw[m][bj]; constexpr float q = 1.f / 255.f;
          pg8::f32x4 v0 = acc[ai][bj][m][0], v1 = acc[ai][bj][m][1];
#pragma unroll
          for (int e = 0; e < 4; ++e) { v0[e] *= fmaxf((float)((g2.x >> (8 * e)) & 255u), 0.5f) * q; v1[e] *= fmaxf((float)((g2.y >> (8 * e)) & 255u), 0.5f) * q; }
          v4u o2; o2.x = pk2(v0[0], v0[1]); o2.y = pk2(v0[2], v0[3]); o2.z = pk2(v1[0], v1[1]); o2.w = pk2(v1[2], v1[3]); *(v4u*)(M + r * 1024 + c) = o2; } }
    return false;
  }
};
__device__ __forceinline__ const float* xrow_in(const NaiveBufs& a, int l, int b, int r) {
  if (r < dd::S) return (l == 0 ? a.x : (const float*)a.out) + ((size_t)b * dd::S + r) * 1024;
  return (l == 0 ? a.ctx : (const float*)a.xc) + ((size_t)b * dd::C + (r - dd::S)) * 1024;
}
__device__ __forceinline__ float* xrow_cur(const NaiveBufs& a, int b, int r) {
  if (r < dd::S) return a.out + ((size_t)b * dd::S + r) * 1024;
  return a.xc + ((size_t)b * dd::C + (r - dd::S)) * 1024;
}
template <bool BF> __device__ __forceinline__ void norm_row(const void* xr, const float* gnorm, const float* shift, const float* scale, bf16_t* hrow, int lane) {
  typedef float f4 __attribute__((ext_vector_type(4)));
  f4 xv[4]; float ss = 0.f;
#pragma unroll
  for (int j = 0; j < 4; ++j) {
    if (BF) { const uint2 rw = *(const uint2*)((const bf16_t*)xr + 4 * lane + 256 * j); xv[j][0] = __uint_as_float(rw.x << 16); xv[j][1] = __uint_as_float(rw.x & 0xffff0000u); xv[j][2] = __uint_as_float(rw.y << 16); xv[j][3] = __uint_as_float(rw.y & 0xffff0000u); }
    else xv[j] = *(const f4*)((const float*)xr + 4 * lane + 256 * j);
    ss += xv[j][0] * xv[j][0] + xv[j][1] * xv[j][1] + xv[j][2] * xv[j][2] + xv[j][3] * xv[j][3]; }
  const float rs = __builtin_amdgcn_rsqf(moe::wave_sum(ss) * (1.f / 1024.f) + 1e-6f);
#pragma unroll
  for (int j = 0; j < 4; ++j) { const int c = 4 * lane + 256 * j; const f4 g4 = *(const f4*)(gnorm + c), sh = *(const f4*)(shift + c), sc = *(const f4*)(scale + c);
    f4 h;
#pragma unroll
    for (int i = 0; i < 4; ++i) h[i] = xv[j][i] * rs * g4[i] * (1.f + sc[i]) + sh[i];
    *(unsigned long long*)(hrow + c) = (unsigned long long)pk2h(h[0], h[1]) | ((unsigned long long)pk2h(h[2], h[3]) << 32); }
}
template <bool BF> __device__ __forceinline__ void norm16(const void* x0, const LAS float* gp, const LAS float* sp, bf16_t* h0, int lane) {
  typedef float f4 __attribute__((ext_vector_type(4)));
  const int fr = lane & 15, fq = lane >> 4; bf16_t* hr = h0 + (size_t)fr * 1024 + 8 * fq;
  v4u xq[32]; float ss = 0.f;
  if (BF) { const bf16_t* xr = (const bf16_t*)x0 + (size_t)fr * 1024 + 8 * fq;
#pragma unroll
    for (int kk = 0; kk < 32; ++kk) xq[kk] = *(const v4u*)(xr + 32 * kk);
#pragma unroll
    for (int kk = 0; kk < 32; ++kk) { const v4u q = xq[kk]; float t;
      t = __uint_as_float(q.x << 16); ss += t * t; t = __uint_as_float(q.x & 0xffff0000u); ss += t * t; t = __uint_as_float(q.y << 16); ss += t * t; t = __uint_as_float(q.y & 0xffff0000u); ss += t * t;
      t = __uint_as_float(q.z << 16); ss += t * t; t = __uint_as_float(q.z & 0xffff0000u); ss += t * t; t = __uint_as_float(q.w << 16); ss += t * t; t = __uint_as_float(q.w & 0xffff0000u); ss += t * t; }
  } else { const float* xr = (const float*)x0 + (size_t)fr * 1024 + 8 * fq;
#pragma unroll
    for (int k8 = 0; k8 < 4; ++k8) { f4 va[8], vb[8];
#pragma unroll
      for (int j = 0; j < 8; ++j) { va[j] = *(const f4*)(xr + 32 * (8 * k8 + j)); vb[j] = *(const f4*)(xr + 32 * (8 * k8 + j) + 4); }
#pragma unroll
      for (int j = 0; j < 8; ++j) { const f4 x = va[j], y = vb[j]; ss += x[0] * x[0] + x[1] * x[1] + x[2] * x[2] + x[3] * x[3] + y[0] * y[0] + y[1] * y[1] + y[2] * y[2] + y[3] * y[3];
        v4u q; q.x = pk2h(x[0], x[1]); q.y = pk2h(x[2], x[3]); q.z = pk2h(y[0], y[1]); q.w = pk2h(y[2], y[3]); xq[8 * k8 + j] = q; } } }
  ss += __shfl_xor(ss, 16); ss += __shfl_xor(ss, 32);
  const float rs = __builtin_amdgcn_rsqf(ss * (1.f / 1024.f) + 1e-6f);
#pragma unroll
  for (int kk = 0; kk < 32; ++kk) asm volatile("" : "+v"(xq[kk].x), "+v"(xq[kk].y), "+v"(xq[kk].z), "+v"(xq[kk].w));
#pragma unroll
  for (int kk = 0; kk < 32; ++kk) { const int c = 32 * kk + 8 * fq; const v4u q = xq[kk];
    const f4 ga = *(const LAS f4*)(gp + c), gb = *(const LAS f4*)(gp + c + 4), ha = *(const LAS f4*)(sp + c), hb = *(const LAS f4*)(sp + c + 4);
    v4u hq;
    hq.x = pk2h(__uint_as_float(q.x << 16) * (rs * ga[0]) + ha[0], __uint_as_float(q.x & 0xffff0000u) * (rs * ga[1]) + ha[1]); hq.y = pk2h(__uint_as_float(q.y << 16) * (rs * ga[2]) + ha[2], __uint_as_float(q.y & 0xffff0000u) * (rs * ga[3]) + ha[3]);
    hq.z = pk2h(__uint_as_float(q.z << 16) * (rs * gb[0]) + hb[0], __uint_as_float(q.z & 0xffff0000u) * (rs * gb[1]) + hb[1]); hq.w = pk2h(__uint_as_float(q.w << 16) * (rs * gb[2]) + hb[2], __uint_as_float(q.w & 0xffff0000u) * (rs * gb[3]) + hb[3]);
    *(v4u*)(hr + 32 * kk) = hq;
    if ((kk & 3) == 3) asm volatile("" ::: "memory"); }
}
__device__ __forceinline__ void qknorm16(bf16_t* prow0, const LAS float* ct, const LAS float* st, const LAS float* gq, const LAS float* gk, int r0, int lane) {
  typedef float f4 __attribute__((ext_vector_type(4)));
  const int fr = lane & 15, fq = lane >> 4, r = r0 + fr; const bool lat = r < dd::S; const int grow = (r / dd::GW) & 63, gcol = r % dd::GW;
  bf16_t* prow = prow0 + (size_t)fr * PLD + 8 * fq;
#pragma unroll
  for (int half = 0; half < 2; ++half) { v4u xq[5][4];
#pragma unroll
    for (int h5 = 0; h5 < 5; ++h5) { const int hh = 5 * half + h5; const bf16_t* hp_ = prow + (hh < 8 ? dd::O_AQ + hh * 128 : dd::O_AK + (hh - 8) * 128);
#pragma unroll
      for (int kk = 0; kk < 4; ++kk) xq[h5][kk] = *(const v4u*)(hp_ + 32 * kk); }
#pragma unroll
    for (int h5 = 0; h5 < 5; ++h5) { const int hh = 5 * half + h5; bf16_t* hp_ = prow + (hh < 8 ? dd::O_AQ + hh * 128 : dd::O_AK + (hh - 8) * 128); const LAS float* gn = hh < 8 ? gq : gk;
      float x[4][8]; float ss = 0.f;
#pragma unroll
      for (int kk = 0; kk < 4; ++kk) { const v4u q = xq[h5][kk];
        x[kk][0] = __uint_as_float(q.x << 16); x[kk][1] = __uint_as_float(q.x & 0xffff0000u); x[kk][2] = __uint_as_float(q.y << 16); x[kk][3] = __uint_as_float(q.y & 0xffff0000u);
        x[kk][4] = __uint_as_float(q.z << 16); x[kk][5] = __uint_as_float(q.z & 0xffff0000u); x[kk][6] = __uint_as_float(q.w << 16); x[kk][7] = __uint_as_float(q.w & 0xffff0000u);
#pragma unroll
        for (int e = 0; e < 8; ++e) ss += x[kk][e] * x[kk][e]; }
      ss += __shfl_xor(ss, 16); ss += __shfl_xor(ss, 32);
      const float rs = __builtin_amdgcn_rsqf(ss * (1.f / 128.f) + 1e-6f);
#pragma unroll
      for (int kk = 0; kk < 4; ++kk) { const int c = 32 * kk + 8 * fq; const f4 ga = *(const LAS f4*)(gn + c), gb = *(const LAS f4*)(gn + c + 4);
        const int ti = (kk < 2 ? grow : gcol) * 32 + 16 * (kk & 1) + 4 * fq; f4 c4 = *(const LAS f4*)(ct + ti), s4 = *(const LAS f4*)(st + ti);
        if (!lat) { c4 = (f4){1.f, 1.f, 1.f, 1.f}; s4 = (f4){0.f, 0.f, 0.f, 0.f}; }
        const float y0 = x[kk][0] * rs * ga[0], y1 = x[kk][1] * rs * ga[1], y2 = x[kk][2] * rs * ga[2], y3 = x[kk][3] * rs * ga[3];
        const float y4 = x[kk][4] * rs * gb[0], y5 = x[kk][5] * rs * gb[1], y6 = x[kk][6] * rs * gb[2], y7 = x[kk][7] * rs * gb[3];
        v4u o; o.x = pk2h(y0 * c4[0] - y1 * s4[0], y0 * s4[0] + y1 * c4[0]); o.y = pk2h(y2 * c4[1] - y3 * s4[1], y2 * s4[1] + y3 * c4[1]);
        o.z = pk2h(y4 * c4[2] - y5 * s4[2], y4 * s4[2] + y5 * c4[2]); o.w = pk2h(y6 * c4[3] - y7 * s4[3], y6 * s4[3] + y7 * c4[3]);
        *(v4u*)(hp_ + 32 * kk) = o; } } }
}
__device__ __forceinline__ void qknorm_row(bf16_t* prow, const float* qg, const float* kg, int r, int lane) {
  const bool lat = r < dd::S; const int grow = r / dd::GW, gcol = r % dd::GW;
  const int fi = lane & 31; const float pos = (lane < 32) ? (float)grow : (float)gcol;
  const float ang = pos * __builtin_amdgcn_exp2f(-(float)fi * (13.287712379549449f / 32.f));
  const float cs = lat ? __cosf(ang) : 1.f, sn = lat ? __sinf(ang) : 0.f;
  unsigned wv[10];
#pragma unroll
  for (int hh = 0; hh < 10; ++hh) wv[hh] = *((const unsigned*)(prow + (hh < 8 ? dd::O_AQ + hh * 128 : dd::O_AK + (hh - 8) * 128)) + lane);
  float ss[10];
#pragma unroll
  for (int hh = 0; hh < 10; ++hh) { const float x1 = bf2f(wv[hh] & 0xffff), x2 = bf2f(wv[hh] >> 16); ss[hh] = x1 * x1 + x2 * x2; }
#pragma unroll
  for (int o = 1; o < 64; o <<= 1) {
#pragma unroll
    for (int hh = 0; hh < 10; ++hh) ss[hh] += __shfl_xor(ss[hh], o); }
  const float q1 = qg[2 * lane], q2 = qg[2 * lane + 1], k1 = kg[2 * lane], k2 = kg[2 * lane + 1];
#pragma unroll
  for (int hh = 0; hh < 10; ++hh) { unsigned* p = (unsigned*)(prow + (hh < 8 ? dd::O_AQ + hh * 128 : dd::O_AK + (hh - 8) * 128)) + lane;
    const float x1 = bf2f(wv[hh] & 0xffff), x2 = bf2f(wv[hh] >> 16); const float rs = __builtin_amdgcn_rsqf(ss[hh] * (1.f / 128.f) + 1e-6f);
    const float y1 = x1 * rs * (hh < 8 ? q1 : k1), y2 = x2 * rs * (hh < 8 ? q2 : k2);
    *p = pk2h(y1 * cs - y2 * sn, y1 * sn + y2 * cs); }
}

__device__ __forceinline__ void ga_task(const bf16_t* hb, const bf16_t* WgaT, bf16_t* proj, int wt) {
  int tid = threadIdx.x; asm volatile("" : "+v"(tid));
  const int lane = tid & 63, li = lane & 31, lk = lane >> 5; typedef short b8 __attribute__((ext_vector_type(8))); typedef float f16v __attribute__((ext_vector_type(16)));
  const bf16_t* ap = hb + ((size_t)wt * 32 + li) * 1024 + 8 * lk; const bf16_t* bp = WgaT + (size_t)li * 1024 + 8 * lk;
  f16v acc = {};
  for (int k8 = 0; k8 < 8; ++k8) { v4u av[8], bv[8];
#pragma unroll
    for (int j = 0; j < 8; ++j) { av[j] = *(const v4u*)(ap + 128 * k8 + 16 * j); bv[j] = *(const v4u*)(bp + 128 * k8 + 16 * j); }
#pragma unroll
    for (int j = 0; j < 8; ++j) acc = __builtin_amdgcn_mfma_f32_32x32x16_bf16(__builtin_bit_cast(b8, av[j]), __builtin_bit_cast(b8, bv[j]), acc, 0, 0, 0); }
#pragma unroll
  for (int r = 0; r < 16; ++r) { const int row = wt * 32 + (r & 3) + 8 * (r >> 2) + 4 * lk; proj[(size_t)row * PLD + dd::O_GA + li] = (bf16_t)f2bf(acc[r]); }
}

#define CONV_NONMOE(LL, GW0, NGW0) { \
      constexpr int NIT = (dd::D / 64) * (dd::NIN / 32); \
      for (int it = (GW0); it < NIT; it += (NGW0)) { const int n0 = 32 * (it % (dd::NIN / 32)); \
        if (n0 == dd::O_GA) transpose_item(a.w_in + (size_t)(LL) * dd::D * dd::NIN, dd::D, dd::NIN, ka.WgaT, -dd::O_GA, scr, it, lane); \
        else transpose_item(a.w_in + (size_t)(LL) * dd::D * dd::NIN, dd::D, dd::NIN, ka.WinT, n0 < dd::O_GA ? 0 : -32, scr, it, lane); } \
      { constexpr int I0 = (dd::HW / 64) * (dd::D / 32), I1 = (dd::GVW / 64) * (dd::D / 32), I2 = (dd::AQW / 64) * (dd::D / 32), I3 = (dd::D / 64) * (dd::D / 32); \
        for (int it = (GW0); it < I0 + I1 + I2 + I3; it += (NGW0)) { int r = it; \
          if (r < I0) { transpose_item(a.w_br_hy + (size_t)(LL) * dd::HW * dd::D, dd::HW, dd::D, ka.WhyT, 0, scr, r, lane, 1024); continue; } r -= I0; \
          if (r < I1) { transpose_item(a.w_br_gla + (size_t)(LL) * dd::GVW * dd::D, dd::GVW, dd::D, ka.WglaT, 0, scr, r, lane, 1024); continue; } r -= I1; \
          if (r < I2) { transpose_item(a.w_br_att + (size_t)(LL) * dd::AQW * dd::D, dd::AQW, dd::D, ka.WattT, 0, scr, r, lane); continue; } r -= I2; \
          transpose_item(a.w_out + (size_t)(LL) * dd::D * dd::D, dd::D, dd::D, ka.WoutT, 0, scr, r, lane); } } }
__global__ void __launch_bounds__(NTHREADS, 2) mega_kernel(KArgs ka_unused) {
  extern __shared__ __attribute__((aligned(16))) unsigned char lds_raw[];
  LAS unsigned char* lds = (LAS unsigned char*)lds_raw;
  volatile LAS unsigned* MISC = (volatile LAS unsigned*)(lds + MISC_OFF);
  constexpr int ARGS_OFF = MISC_OFF + 256;
  static_assert(ARGS_OFF + sizeof(KArgs) <= LDS_BYTES, "LDS map");
  { const unsigned __attribute__((address_space(4)))* kp = (const unsigned __attribute__((address_space(4)))*)__builtin_amdgcn_kernarg_segment_ptr();
    for (int i = threadIdx.x; i < (int)(sizeof(KArgs) / 4); i += NTHREADS) ((LAS unsigned*)(lds + ARGS_OFF))[i] = kp[i]; }
  if (threadIdx.x < 64) MISC[threadIdx.x] = 0u;
  __syncthreads();
  const KArgs& ka = *(const KArgs*)(const LAS KArgs*)(lds + ARGS_OFF);
  const NaiveBufs& a = ka.a;
  unsigned* bar_s; { const unsigned long long bp = (unsigned long long)ka.bar; const unsigned lo_ = __builtin_amdgcn_readfirstlane((unsigned)bp), hi_ = __builtin_amdgcn_readfirstlane((unsigned)(bp >> 32));
    bar_s = (unsigned*)(((unsigned long long)hi_ << 32) | lo_); }
  XcdBarrier xb = xcd_barrier_post(bar_s, MISC);
#define SPTR(T, name, src) T* name; { const unsigned long long bp_ = (unsigned long long)(src); const unsigned lo_ = __builtin_amdgcn_readfirstlane((unsigned)bp_), hi_ = __builtin_amdgcn_readfirstlane((unsigned)(bp_ >> 32)); name = (T*)(((unsigned long long)hi_ << 32) | lo_); }
  SPTR(bf16_t, proj_s, ka.proj) SPTR(bf16_t, hb_s, ka.hb) SPTR(unsigned char, mix_s, ka.mix)
  const long gs = (long)gridDim.x * NTHREADS;
  LAS int* poff = (LAS int*)(lds + MISC_OFF + 64);
#define TID_SETUP int tz = threadIdx.x; asm volatile("" : "+v"(tz)); const int lane = tz & 63, wave = __builtin_amdgcn_readfirstlane(tz >> 6); \
    const int gw = blockIdx.x * NWAVES + wave, NGW = gridDim.x * NWAVES; const long gt = (long)blockIdx.x * NTHREADS + tz; (void)lane; (void)gw; (void)NGW; (void)gt;
#define LSTAGE(ST) { TID_SETUP const long n_ = stage_items<TD>(ST, l); for (long i_ = gt; i_ < n_; i_ += gs) stage_run<TD, ST>(a, l, 0, i_); }
  for (int l = 0; l < dd::DEPTH; ++l) {
    const bool last = (l == dd::DEPTH - 1);
    { TID_SETUP
      LAS float* scr = (LAS float*)(lds + RING_OFF + wave * 16384);
      if (l == 0) CONV_NONMOE(l, gw, NGW)
      { constexpr int IG = (dd::D / 64) * (dd::DE / 32), IDN = (dd::DE / 64) * (dd::D / 32);
        for (int it = gw; it < dd::NE * (2 * IG + IDN); it += NGW) { const int e = it / (2 * IG + IDN); int r = it % (2 * IG + IDN);
          if (r < 2 * IG) { const int up = r >= IG; if (up) r -= IG; const int n0 = 32 * (r % (dd::DE / 32));
            transpose_item((up ? a.moe_w_up : a.moe_w_gate) + ((size_t)l * dd::NE + e) * dd::D * dd::DE, dd::D, dd::DE, ka.WguT, e * 1024 + 128 * (n0 >> 7) + (up ? 128 : 0), scr, r, lane); }
          else { r -= 2 * IG; transpose_item(a.moe_w_down + ((size_t)l * dd::NE + e) * dd::DE * dd::D, dd::DE, dd::D, ka.WdT, e * 1024, scr, r, lane); } } }
      (void)gt;
    }
    if (l == 0) { TID_SETUP
      for (long i_ = gt; i_ < 1024 * 16; i_ += gs) { const int k = (int)(i_ >> 4), e = (int)(i_ & 15); const float w = a.router_w[i_]; const unsigned hi = f2bf(w); const unsigned lo = f2bf(w - __uint_as_float(hi << 16));
        const int idx = (((k >> 5) * 64 + ((k >> 3) & 3) * 16 + e) << 3) + (k & 7); ka.wfg[idx] = (bf16_t)hi; ka.wfg[16384 + idx] = (bf16_t)lo; } }
    const bool pre = l > 0;
    pro::mod_phase(a, l, lds); if (!pre) pro::hid_phase(a, l, dd::S, a.hid2S, lds); if (!last) pro::hid_phase(a, l, dd::C, a.hid2C, lds);
    xcd_barrier(xb);
    if (!pre || !last) {
      if (!pre) pro::tapsM_phase(a, l, (bf16_t*)a.tapsS); if (!last) pro::tapsMC_phase(a, l, a.tapsC);
      xcd_barrier(xb);
      if (!pre) pro::nrmB_phase(a, (const bf16_t*)a.tapsS); if (!last) pro::nrmC_phase(a, lds); }
    for (int grp = 0; grp < NGRP; ++grp) {
      const int b0 = grp * GB;
      { TID_SETUP
        __syncthreads();
        LAS float* ptab = (LAS float*)(lds + RING_OFF);
        { float g_[10], sc_[10], sh_[10];
#pragma unroll
          for (int k_ = 0; k_ < 10; ++k_) { const int i_ = tz + NTHREADS * k_, v_ = i_ >> 10, c_ = i_ & 1023; const float* md = a.mod + (size_t)(v_ < GB ? b0 + v_ : dd::B) * 6 * 1024;
            g_[k_] = a.norm1_g[(size_t)l * 1024 + c_]; sc_[k_] = md[1024 + c_]; sh_[k_] = md[c_]; }
#pragma unroll
          for (int k_ = 0; k_ < 10; ++k_) { const int i_ = tz + NTHREADS * k_, v_ = i_ >> 10, c_ = i_ & 1023; ptab[v_ * 2048 + c_] = g_[k_] * sc_[k_] + g_[k_]; ptab[v_ * 2048 + 1024 + c_] = sh_[k_]; } }
        __syncthreads();
        for (int t_ = (int)blockIdx.x + (int)gridDim.x * wave; t_ < RG / 16; t_ += (int)gridDim.x * NWAVES) { const int rg = 16 * t_, bl = rg / RB, r = rg % RB, b = b0 + bl; const LAS float* pt_ = ptab + (r < dd::S ? bl : GB) * 2048;
          if (l == 0) norm16<false>(xrow_in(a, 0, b, r), pt_, pt_ + 1024, hb_s + (size_t)rg * 1024, lane);
          else norm16<true>(ka.xs + ((size_t)grp * RG + rg) * 1024, pt_, pt_ + 1024, hb_s + (size_t)rg * 1024, lane); }
        xcd_barrier(xb); }
      { pg8::Gemm g{hb_s, ka.WinT, RG, NINP, dd::D, 0}; pg8::StaticOrder S; S.init(RG, NINP, (int)gridDim.x, (int)blockIdx.x); EpiProjBf16 E{proj_s};
        pg8::gemm_phase<EpiProjBf16, pg8::StaticOrder, false>((PG8_LAS unsigned char*)(lds + RING_OFF), g, S, E, nullptr);
        { int tq = threadIdx.x; asm volatile("" : "+v"(tq)); const int wv_ = __builtin_amdgcn_readfirstlane(tq >> 6);
          for (int wt = (int)blockIdx.x + (int)gridDim.x * wv_; wt < PANELS * 8; wt += (int)gridDim.x * NWAVES) ga_task(hb_s, ka.WgaT, proj_s, wt); }
        xcd_barrier(xb); }
        bf16_t* ucT0 = (bf16_t*)mix_s; bf16_t* yT0 = (bf16_t*)(mix_s + GB * UCT_BYTES); float* ucc0 = (float*)(mix_s + GB * (UCT_BYTES + YT_BYTES)); float* z1c0 = (float*)(mix_s + GB * (UCT_BYTES + YT_BYTES + UCC_BYTES));
      { TID_SETUP
        { LAS float* ct = (LAS float*)(lds + RING_OFF); LAS float* st = ct + 2048; LAS float* gq = st + 2048; LAS float* gk = gq + 128;
          for (int i_ = tz; i_ < 2048; i_ += NTHREADS) { const float ang = (float)(i_ >> 5) * __builtin_amdgcn_exp2f(-(float)(i_ & 31) * (13.287712379549449f / 32.f)); ct[i_] = __cosf(ang); st[i_] = __sinf(ang); }
          if (tz < 128) gq[tz] = a.q_norm_g[(size_t)l * 128 + tz]; else if (tz < 256) gk[tz - 128] = a.k_norm_g[(size_t)l * 128 + tz - 128];
          __syncthreads();
          { const int nu_ = GB * 4 * 68, hv_ = nu_ % (int)gridDim.x, lt_ = (int)gridDim.x - hv_;
            if ((int)blockIdx.x >= hv_) for (int t_ = ((int)blockIdx.x - hv_) + lt_ * wave; t_ < RG / 16; t_ += lt_ * NWAVES) qknorm16(proj_s + (size_t)(16 * t_) * PLD, ct, st, gq, gk, (16 * t_) % RB, lane); }
          __syncthreads(); }
        for (int u = blockIdx.x; u < GB * 4 * 68; u += gridDim.x) { const int bl = u / (4 * 68), hu = u % (4 * 68); const bf16_t* pb = proj_s + (size_t)bl * RB * PLD;
          gla::In gp; gp.q = pb + dd::O_GQ; gp.k = pb + dd::O_GK; gp.v = pb + dd::O_GV; gp.ga = pb + dd::O_GA; gp.og = pb + dd::O_OG; gp.ld = PLD;
          gp.wa2 = a.gla_wa2 + (size_t)l * 2 * 16 * 256; gp.ba = a.gla_ba + (size_t)l * 2 * 256; gp.gnorm = a.gla_norm_g + (size_t)l * 128;
          gp.csb = (bf16_t*)((unsigned char*)hb_s + (size_t)bl * CS_BYTES); gp.dec = (float*)((unsigned char*)ka.gdec + (size_t)bl * DEC_BYTES); gp.y = (bf16_t*)pb + dd::O_OG; gp.ldy = PLD; gp.S = dd::S; gp.C = dd::C;
          gla::g1b_unit(gp, lds, hu / 68, hu % 68, 4, 68); }
        { TID_SETUP const float* cw = a.hy_conv_w + (size_t)l * 3 * 1536; const float* cb = a.hy_conv_b + (size_t)l * 1536;
        { int t_ = blockIdx.x; hy::H0Regs hr = hy::h0_load(proj_s + (size_t)(t_ / (64 * 24)) * RB * PLD + dd::O_HY, PLD, t_ % (64 * 24), tz);
          for (; t_ < GB * 64 * 24; t_ += gridDim.x) { const int bl = t_ / (64 * 24), tn_ = t_ + gridDim.x; hy::H0Regs hn = hr;
            if (tn_ < GB * 64 * 24) hn = hy::h0_load(proj_s + (size_t)(tn_ / (64 * 24)) * RB * PLD + dd::O_HY, PLD, tn_ % (64 * 24), tz);
            hy::h0_compute(hr, cw, cb, ucT0 + (size_t)bl * 1536 * 4096, t_ % (64 * 24), lds, tz); hr = hn; } }
        if (!last) for (long i0_ = gt; i0_ < (long)GB * 256 * 1536; i0_ += 4 * gs) {
          float um_[4], u0_[4], up_[4], wm_[4], w0_[4], wp_[4], b_[4]; bool ok_[4];
#pragma unroll
          for (int q_ = 0; q_ < 4; ++q_) { const long i_ = i0_ + q_ * gs; ok_[q_] = i_ < (long)GB * 256 * 1536; const long ii_ = ok_[q_] ? i_ : gt; const int bl = (int)(ii_ / (256 * 1536)), r_ = (int)(ii_ % (256 * 1536)), j_ = r_ % 1536, tc_ = r_ / 1536;
            const bf16_t* up = proj_s + ((size_t)bl * RB + dd::S + tc_) * PLD + dd::O_HY + j_;
            u0_[q_] = bf2f(up[0]); um_[q_] = tc_ > 0 ? bf2f(*(up - PLD)) : 0.f; up_[q_] = tc_ < 255 ? bf2f(up[PLD]) : 0.f; wm_[q_] = cw[j_]; w0_[q_] = cw[1536 + j_]; wp_[q_] = cw[2 * 1536 + j_]; b_[q_] = cb[j_]; }
#pragma unroll
          for (int q_ = 0; q_ < 4; ++q_) if (ok_[q_]) { const long i_ = i0_ + q_ * gs; const int bl = (int)(i_ / (256 * 1536)); (ucc0 + (size_t)bl * 256 * 1536)[i_ % (256 * 1536)] = b_[q_] + w0_[q_] * u0_[q_] + wm_[q_] * um_[q_] + wp_[q_] * up_[q_]; } } }
        xcd_barrier(xb); }
      { TID_SETUP
        for (long i_ = gt; i_ < (long)GB * 2 * 4 * 64 * 64; i_ += gs) { const int bl = (int)(i_ / (2 * 4 * 64 * 64)); gla::In gp; gp.csb = (bf16_t*)((unsigned char*)hb_s + (size_t)bl * CS_BYTES); gp.dec = (float*)((unsigned char*)ka.gdec + (size_t)bl * DEC_BYTES); gp.S = dd::S; gp.C = dd::C;
          gla::g2_item(gp, i_ % (2 * 4 * 64 * 64), 4, 68); }
        const int combo = blockIdx.x & 7, slot = blockIdx.x >> 3, nslot = gridDim.x >> 3;
        const int per_combo = 64 + (last ? 0 : 4);
        const bool xcdm = (gridDim.x & 7) == 0;
        for (int uu = xcdm ? slot : (int)blockIdx.x; uu < (xcdm ? per_combo : 8 * per_combo); uu += xcdm ? nslot : (int)gridDim.x) { const int cmb = xcdm ? combo : uu / per_combo, ui = xcdm ? uu : uu % per_combo;
          const bool lat = ui < 64; const int bl = cmb >> 1, kvh = cmb & 1;
          const int head = kvh * 4 + (lat ? ui >> 4 : ui - 64), qb = lat ? ui & 15 : 0;
          bf16_t* pb = proj_s + (size_t)bl * RB * PLD; const size_t qrow = lat ? (size_t)qb * 256 : (size_t)dd::S, krow = lat ? 0 : (size_t)dd::S;
          att::attn_dense_body<att::bf16, PLD, PLD, PLD, true>((const att::bf16*)(pb + qrow * PLD + dd::O_AQ + head * 128), (const att::bf16*)(pb + krow * PLD + dd::O_AK + kvh * 128),
              (const att::bf16*)(pb + krow * PLD + dd::O_AV + kvh * 128), pb + qrow * PLD + dd::O_AQ + head * 128, lat ? RB : dd::C, (char*)lds_raw);
          __syncthreads(); }
        const float* skp = a.hy_skip + (size_t)l * 2 * 512;
        for (int u = blockIdx.x; u < (GB / 2) * 512; u += gridDim.x) { const int bp_ = u / 512; hy::h1c_unit(ucT0 + (size_t)(2 * bp_) * 1536 * 4096, (const bf16_t*)a.tapsS, a.nrmS, skp, yT0 + (size_t)(2 * bp_) * 512 * 4096, u % 512, lds); }
        if (!last) for (long i_ = gt; i_ < (long)GB * 64 * 512; i_ += gs) { const int bl = (int)(i_ / (64 * 512)); hy::clong_item(ucc0 + (size_t)bl * 256 * 1536, nullptr, z1c0 + (size_t)bl * 256 * 512, nullptr, 0, a.tapsC, a.nrmC, skp, 0, i_ % (64 * 512)); }
        xcd_barrier(xb); }
      { const int n3 = last ? 64 : 68;
        for (int u = blockIdx.x; u < GB * 4 * n3; u += gridDim.x) { const int bl = u / (4 * n3), hu = u % (4 * n3); const bf16_t* pb = proj_s + (size_t)bl * RB * PLD;
          gla::In gp; gp.q = pb + dd::O_GQ; gp.k = pb + dd::O_GK; gp.v = pb + dd::O_GV; gp.ga = pb + dd::O_GA; gp.og = pb + dd::O_OG; gp.ld = PLD;
          gp.wa2 = a.gla_wa2 + (size_t)l * 2 * 16 * 256; gp.ba = a.gla_ba + (size_t)l * 2 * 256; gp.gnorm = a.gla_norm_g + (size_t)l * 128;
          gp.csb = (bf16_t*)((unsigned char*)hb_s + (size_t)bl * CS_BYTES); gp.dec = (float*)((unsigned char*)ka.gdec + (size_t)bl * DEC_BYTES); gp.y = (bf16_t*)pb + dd::O_OG; gp.ldy = PLD; gp.S = dd::S; gp.C = dd::C;
          gla::g3b_unit(gp, lds, hu / n3, hu % n3, 4, 68); }
        { TID_SETUP const float* skp = a.hy_skip + (size_t)l * 2 * 512;
        { const int hv_ = (GB * 4 * n3) % (int)gridDim.x, lt_ = (int)gridDim.x - hv_, T_ = GB * 64 * 8, TB_ = hv_ > 0 ? (T_ / 2 / (int)gridDim.x) * (int)gridDim.x : 0;
          for (int t_ = blockIdx.x; t_ < TB_; t_ += gridDim.x) { const int bl = t_ / (64 * 8); hy::h2_tile(yT0 + (size_t)bl * 512 * 4096, proj_s + (size_t)bl * RB * PLD + dd::O_HY, PLD, t_ % (64 * 8), lds); }
          if ((int)blockIdx.x >= hv_) for (int t_ = TB_ + (int)blockIdx.x - hv_; t_ < T_; t_ += lt_) { const int bl = t_ / (64 * 8); hy::h2_tile(yT0 + (size_t)bl * 512 * 4096, proj_s + (size_t)bl * RB * PLD + dd::O_HY, PLD, t_ % (64 * 8), lds); } }
        if (!last) for (long i_ = gt; i_ < (long)GB * 64 * 512; i_ += gs) { const int bl = (int)(i_ / (64 * 512)); hy::clong_item(ucc0 + (size_t)bl * 256 * 1536, z1c0 + (size_t)bl * 256 * 512, nullptr, proj_s + ((size_t)bl * RB + dd::S) * PLD + dd::O_HY, PLD, a.tapsC, a.nrmC, skp, 1, i_ % (64 * 512)); } }
        xcd_barrier(xb); }
      { { pg8::Gemm g{proj_s, ka.WhyT, RG, 1024, 1024, PLD, 1024}; MergeOrder S; S.init((int)gridDim.x, (int)blockIdx.x, last); EpiMergeS E{(const unsigned char*)(proj_s + dd::O_BR), (bf16_t*)mix_s};
          pg8::gemm_phase<EpiMergeS, MergeOrder, false>((PG8_LAS unsigned char*)(lds + RING_OFF), g, S, E, nullptr); }
        xcd_barrier(xb);
        pg8::Gemm g{(const bf16_t*)mix_s, ka.WoutT, RG, 1024, 1024, 0}; GroupOrder S; S.init(1024, (int)gridDim.x, (int)blockIdx.x, last);
        EpiOutG E{a.x, a.ctx, ka.xs + (size_t)grp * RG * 1024, a.mod, b0, !last, l != 0};
        pg8::gemm_phase<EpiOutG, GroupOrder, false>((PG8_LAS unsigned char*)(lds + RING_OFF), g, S, E, nullptr);
        xcd_barrier(xb); }
      {
        { TID_SETUP int* cnt = ka.cnt + (l * NGRP + grp) * 1024;
          LAS bf16_t* wfr = (LAS bf16_t*)(lds + RING_OFF);
          { v4u t_[8];
#pragma unroll
            for (int i_ = 0; i_ < 8; ++i_) t_[i_] = ((const v4u*)ka.wfg)[tz + NTHREADS * i_];
#pragma unroll
            for (int i_ = 0; i_ < 8; ++i_) ((LAS v4u*)wfr)[tz + NTHREADS * i_] = t_[i_]; }
          LAS int* lcnt = (LAS int*)(lds + RING_OFF + 65536);
          if (tz < 32) lcnt[tz] = 0;
          LAS float* ptab = (LAS float*)(lds + RING_OFF + 65536 + 1024);
          { float g_[10], sc_[10], sh_[10];
#pragma unroll
            for (int k_ = 0; k_ < 10; ++k_) { const int i_ = tz + NTHREADS * k_, v_ = i_ >> 10, c_ = i_ & 1023; const float* md = a.mod + (size_t)(v_ < GB ? b0 + v_ : dd::B) * 6 * 1024;
              g_[k_] = a.norm2_g[(size_t)l * 1024 + c_]; sc_[k_] = md[4 * 1024 + c_]; sh_[k_] = md[3 * 1024 + c_]; }
#pragma unroll
            for (int k_ = 0; k_ < 10; ++k_) { const int i_ = tz + NTHREADS * k_, v_ = i_ >> 10, c_ = i_ & 1023; ptab[v_ * 2048 + c_] = g_[k_] * sc_[k_] + g_[k_]; ptab[v_ * 2048 + 1024 + c_] = sh_[k_]; } }
          __syncthreads();
          const int wv_ = __builtin_amdgcn_readfirstlane(tz >> 6);
          for (int t_ = (int)blockIdx.x + (int)gridDim.x * wv_; t_ < RG / 16; t_ += (int)gridDim.x * NWAVES) { const int rg = 16 * t_, bl = rg / RB, r = rg % RB, b = b0 + bl; if (last && r >= dd::S) continue;
            const LAS float* pt_ = ptab + (r < dd::S ? bl : GB) * 2048; (void)b;
            moe::route16(ka.xs + ((size_t)grp * RG + rg) * 1024, pt_, pt_ + 1024, hb_s + (size_t)rg * 1024, (const LAS v4u*)wfr, a.router_b, lcnt, ka.route + rg, ka.wts + 2 * rg, lane); }
          __syncthreads();
          if (tz < 16) lcnt[16 + tz] = atomicAdd(cnt + tz * 64, lcnt[tz]);
          __syncthreads();
          for (int t_ = (int)blockIdx.x + (int)gridDim.x * wv_; t_ < RG / 16; t_ += (int)gridDim.x * NWAVES) { const int rg = 16 * t_; if (last && (rg % RB) >= dd::S) continue;
            if (lane < 16) { moe::Route* rt = ka.route + rg + lane; moe::Route r_ = *rt; r_.r0 += lcnt[16 + r_.e0]; r_.r1 += lcnt[16 + r_.e1]; *rt = r_; } }
          xcd_barrier(xb); }
        { TID_SETUP int* cnt = ka.cnt + (l * NGRP + grp) * 1024;
          if (tz == 0) { int acc_ = 0; for (int e = 0; e < 16; ++e) { poff[e] = acc_; acc_ += (cnt[e * 64] + 255) >> 8; } poff[16] = acc_; }
          __syncthreads();
          int* arow = (int*)ka.hp;
          for (int rg = (int)gt; rg < RG; rg += (int)gs) { if (last && (rg % RB) >= dd::S) continue; const moe::Route rt = ka.route[rg]; const float2 wt = *(const float2*)(ka.wts + 2 * rg);
            const size_t d0 = (size_t)poff[rt.e0] * 256 + rt.r0, d1 = (size_t)poff[rt.e1] * 256 + rt.r1;
            arow[d0] = rg; ka.srcrow[d0] = 2 * rg; ka.wgt[d0] = wt.x; arow[d1] = rg; ka.srcrow[d1] = 2 * rg + 1; ka.wgt[d1] = wt.y; }
          for (int e = 0; e < 16; ++e) { const int c_ = cnt[e * 64], pe = ((c_ + 255) >> 8) << 8; for (int p_ = c_ + (int)gt; p_ < pe; p_ += (int)gs) { ka.srcrow[(size_t)poff[e] * 256 + p_] = -1; arow[(size_t)poff[e] * 256 + p_] = 0; } }
          xcd_barrier(xb); }
        { pg8::Gemm g{hb_s, ka.WguT, 0, 0, 1024, 0, 0, (const int*)ka.hp}; moe::MoeOrder S{(int)gridDim.x, (int)blockIdx.x, 4, poff}; moe::EpiGU E{ka.hid};
          pg8::gemm_phase<moe::EpiGU, moe::MoeOrder, false, true>((PG8_LAS unsigned char*)(lds + RING_OFF), g, S, E, nullptr);
          if (grp + 1 == NGRP && !last) { { TID_SETUP LAS float* scr = (LAS float*)(lds + RING_OFF + wave * 16384); const int hv_ = (poff[16] * 4) % (int)gridDim.x;
              if ((int)blockIdx.x >= hv_) CONV_NONMOE(l + 1, ((int)blockIdx.x - hv_) * NWAVES + wave, ((int)gridDim.x - hv_) * NWAVES) (void)gt; }
            __syncthreads(); }
          if (grp + 1 == NGRP && !last) pro::hid_phase(a, l + 1, dd::S, a.hid2S, lds);
          xcd_barrier(xb); }
        { pg8::Gemm g{ka.hid, ka.WdT, 0, 0, 512, 0}; moe::MoeOrder S{(int)gridDim.x, (int)blockIdx.x, 4, poff}; moe::EpiDown E{ka.srcrow, ka.wgt, ka.contrib, (size_t)RG * 1024};
          pg8::gemm_phase<moe::EpiDown, moe::MoeOrder, false>((PG8_LAS unsigned char*)(lds + RING_OFF), g, S, E, nullptr);
          if (grp + 1 == NGRP && !last) { const int hv_ = (poff[16] * 4) % (int)gridDim.x;
            if ((int)blockIdx.x >= hv_) pro::tapsM_phase(a, l + 1, (bf16_t*)a.tapsS, (int)blockIdx.x - hv_, (int)gridDim.x - hv_); }
          xcd_barrier(xb); }
        { TID_SETUP
          bf16_t* xsg = ka.xs + (size_t)grp * RG * 1024;
#pragma unroll 2
          for (long i_ = gt; i_ < (long)RG * 128; i_ += gs) { const int rg = (int)(i_ >> 7), c8 = (int)(i_ & 127) * 8; const int bl = rg / RB, r = rg % RB, b = b0 + bl; if (last && r >= dd::S) continue;
            const float* g2 = a.mod + (size_t)(r < dd::S ? b : dd::B) * 6 * 1024 + 5 * 1024 + c8;
            const v4u u0 = *(const v4u*)(ka.contrib + (size_t)rg * 1024 + c8), u1 = *(const v4u*)(ka.contrib + (size_t)RG * 1024 + (size_t)rg * 1024 + c8), xo = *(const v4u*)(xsg + (size_t)rg * 1024 + c8);
            const pg8::f32x4 ga_ = *(const pg8::f32x4*)g2, gb_ = *(const pg8::f32x4*)(g2 + 4);
            pg8::f32x4 ya, yb;
            ya[0] = __uint_as_float(xo.x << 16) + ga_[0] * (__uint_as_float(u0.x << 16) + __uint_as_float(u1.x << 16)); ya[1] = __uint_as_float(xo.x & 0xffff0000u) + ga_[1] * (__uint_as_float(u0.x & 0xffff0000u) + __uint_as_float(u1.x & 0xffff0000u));
            ya[2] = __uint_as_float(xo.y << 16) + ga_[2] * (__uint_as_float(u0.y << 16) + __uint_as_float(u1.y << 16)); ya[3] = __uint_as_float(xo.y & 0xffff0000u) + ga_[3] * (__uint_as_float(u0.y & 0xffff0000u) + __uint_as_float(u1.y & 0xffff0000u));
            yb[0] = __uint_as_float(xo.z << 16) + gb_[0] * (__uint_as_float(u0.z << 16) + __uint_as_float(u1.z << 16)); yb[1] = __uint_as_float(xo.z & 0xffff0000u) + gb_[1] * (__uint_as_float(u0.z & 0xffff0000u) + __uint_as_float(u1.z & 0xffff0000u));
            yb[2] = __uint_as_float(xo.w << 16) + gb_[2] * (__uint_as_float(u0.w << 16) + __uint_as_float(u1.w << 16)); yb[3] = __uint_as_float(xo.w & 0xffff0000u) + gb_[3] * (__uint_as_float(u0.w & 0xffff0000u) + __uint_as_float(u1.w & 0xffff0000u));
            if (last) { float* o = a.out + ((size_t)b * dd::S + r) * 1024 + c8; *(pg8::f32x4*)o = ya; *(pg8::f32x4*)(o + 4) = yb; }
            else { v4u w; w.x = pk2h(ya[0], ya[1]); w.y = pk2h(ya[2], ya[3]); w.z = pk2h(yb[0], yb[1]); w.w = pk2h(yb[2], yb[3]); *(v4u*)(xsg + (size_t)rg * 1024 + c8) = w; } }
          if (grp + 1 == NGRP && !last) { pro::nrmB_phase(a, (const bf16_t*)a.tapsS); xcd_barrier(xb); } }
      }
    }
  }
}
extern "C" void kernel_launch(void* const* d_in, const int* in_sizes, int n_in, void* d_out, int out_size, void* d_ws, size_t ws_size, hipStream_t stream) {
  static int grid = 0;
  if (!grid) {
    int dev = 0, cus = 0, per_cu = 0;
    (void)hipGetDevice(&dev); (void)hipDeviceGetAttribute(&cus, hipDeviceAttributeMultiprocessorCount, dev);
    (void)hipFuncSetAttribute((const void*)mega_kernel, hipFuncAttributeMaxDynamicSharedMemorySize, LDS_BYTES);
    (void)hipOccupancyMaxActiveBlocksPerMultiprocessor(&per_cu, mega_kernel, NTHREADS, LDS_BYTES);
    if (per_cu < 1) fprintf(stderr, "occupancy query says %d\n", per_cu);
    grid = cus;
  }
  KArgs ka{}; const float* ptrs[33]; for (int i = 0; i < 33; ++i) ptrs[i] = (const float*)d_in[i];
  set_inputs<TD>(ka.a, ptrs);
  char* wsb = (char*)d_ws; size_t off = BAR_BYTES;
  auto take = [&](size_t bytes) { char* p = wsb + off; off += (bytes + 255) & ~(size_t)255; return p; };
  NaiveBufs& a = ka.a;
  a.mod = (float*)take((size_t)(dd::B + 1) * 6 * 1024 * 4); a.hid2S = (float*)take((size_t)dd::S * 64 * 4); a.hid2C = (float*)take((size_t)dd::C * 64 * 4);
  a.tapsS = (float*)take((size_t)2 * 512 * 2 * 8232 * 2 + 64); a.tapsC = (float*)take((size_t)2 * 512 * 512 * 4); a.nrmS = (float*)take(1024 * 4); a.nrmC = (float*)take(1024 * 4);
  ka.xs = (bf16_t*)take((size_t)dd::B * RB * 1024 * 2);
  ka.wfg = (bf16_t*)take((size_t)2 * 16384 * 2); ka.WgaT = (bf16_t*)take((size_t)32 * 1024 * 2); ka.WinT = (bf16_t*)take((size_t)NINP * 1024 * 2); ka.WhyT = (bf16_t*)take((size_t)1024 * 1024 * 2); ka.WglaT = (bf16_t*)take((size_t)1024 * 1024 * 2); ka.WattT = (bf16_t*)take((size_t)1024 * 1024 * 2);
  ka.WoutT = (bf16_t*)take((size_t)1024 * 1024 * 2); ka.WguT = (bf16_t*)take((size_t)16 * 1024 * 1024 * 2); ka.WdT = (bf16_t*)take((size_t)16 * 1024 * 512 * 2);
  ka.gdec = (float*)take((size_t)GB * DEC_BYTES); static_assert((size_t)GB * CS_BYTES <= (size_t)RG * 1024 * 2, "GLA chunk states must fit the norm1 buffer");
  ka.hb = (bf16_t*)take((size_t)RG * 1024 * 2); ka.mix = (unsigned char*)take(MIX_BYTES);
  ka.proj = (bf16_t*)take((size_t)RG * PLD * 2);
  { char* p = (char*)ka.proj; ka.hp = (bf16_t*)p; p += (size_t)MPG * 1024 * 2; ka.hid = (bf16_t*)p; p += (size_t)MPG * 512 * 2; ka.contrib = (bf16_t*)p; p += (size_t)2 * RG * 1024 * 2;
    ka.srcrow = (int*)p; p += (size_t)MPG * 4; ka.wgt = (float*)p; p += (size_t)MPG * 4; ka.route = (moe::Route*)p; p += (size_t)RG * 16; ka.wts = (float*)p; p += (size_t)RG * 8;
    if ((size_t)(p - (char*)ka.proj) > (size_t)RG * PLD * 2) fprintf(stderr, "MoE alias region too large\n"); }
  a.out = (float*)d_out; ka.bar = (unsigned*)d_ws; ka.cnt = (int*)(wsb + CNT_OFF);
  if (off > ws_size) fprintf(stderr, "workspace too small: need %zu have %zu\n", off, ws_size);
  (void)hipMemsetAsync(d_ws, 0, BAR_BYTES, stream);
  hipLaunchKernelGGL(mega_kernel, dim3(grid), dim3(NTHREADS), LDS_BYTES, stream, ka);
}
```
